# Optimizing an MI355X kernel written in HIP

```python
import math
import jax
import jax.numpy as jnp
from jax import lax
import numpy as np

D_MODEL = 1024
BATCH = 8
SEQ = 2048
DEPTH = 1

N_META = 16
EPS = 1e-6
DA_HEADS = 4
DA_HEAD_DIM = 64
DA_V_DIM = 2 * DA_HEAD_DIM
DA_WIDTH = DA_HEADS * DA_V_DIM
ROPE_THETA = 500000.0
ROPE_DIM = DA_HEAD_DIM // 4
Q_BLOCK = 128
GLA_HEADS = 4
GLA_DK = 64
GLA_DV = 128
GLA_WIDTH = GLA_HEADS * GLA_DV
GLA_GATE_RANK = 16
GLA_TAU = 16.0
GLA_CHUNK = 64
MIX_WIDTH = DA_WIDTH + GLA_WIDTH
IN_SIZES = (DA_HEADS * 2 * DA_HEAD_DIM, DA_HEADS * 2 * DA_HEAD_DIM, DA_WIDTH, GLA_HEADS * GLA_DK, GLA_HEADS * GLA_DK, GLA_WIDTH, GLA_WIDTH, GLA_GATE_RANK, GLA_GATE_RANK)
IN_WIDTH = sum(IN_SIZES)
PEER_HEADS = 8
PEER_NKEYS = 128
PEER_EXPERTS = PEER_NKEYS * PEER_NKEYS
PEER_KEY_DIM = 128
PEER_TOPK = 16
PEER_BLOCK = 256

kernel_name = 'hymba_diffattn_gla_peer_encoder'


def rmsnorm(x, w):
    xf = x.astype(jnp.float32)
    y = xf * lax.rsqrt(jnp.mean(xf * xf, axis=-1, keepdims=True) + EPS)
    return (y * w.astype(jnp.float32)).astype(x.dtype)


def partial_rope(x, pos):
    inv = jnp.power(ROPE_THETA, -jnp.arange(0, ROPE_DIM, 2, dtype=jnp.float32) / ROPE_DIM)
    ang = pos.astype(jnp.float32)[:, None] * inv[None, :]
    cos = jnp.cos(ang)[None, :, None, None, :]
    sin = jnp.sin(ang)[None, :, None, None, :]
    xr = x[..., :ROPE_DIM].astype(jnp.float32)
    x1, x2 = xr[..., :ROPE_DIM // 2], xr[..., ROPE_DIM // 2:]
    rot = jnp.concatenate([x1 * cos - x2 * sin, x2 * cos + x1 * sin], axis=-1)
    return jnp.concatenate([rot.astype(x.dtype), x[..., ROPE_DIM:]], axis=-1)


def diff_attention(q, k, v, lam, pos):
    B, T = q.shape[0], q.shape[1]
    q = partial_rope(q, pos) * (DA_HEAD_DIM ** -0.5)
    k = partial_rope(k, pos)
    nb = -(-T // Q_BLOCK)
    qp = jnp.pad(q, ((0, 0), (0, nb * Q_BLOCK - T), (0, 0), (0, 0), (0, 0)))
    qb = qp.reshape(B, nb, Q_BLOCK, DA_HEADS, 2, DA_HEAD_DIM).transpose(1, 0, 2, 3, 4, 5)

    def block(qi):
        s = jnp.einsum('bqhcd,bkhcd->bhcqk', qi, k).astype(jnp.float32)
        p = jax.nn.softmax(s, axis=-1)
        a = p[:, :, 0] - lam * p[:, :, 1]
        return jnp.einsum('bhqk,bkhv->bqhv', a.astype(v.dtype), v)

    o = lax.map(block, qb)
    return o.transpose(1, 0, 2, 3, 4).reshape(B, nb * Q_BLOCK, DA_HEADS, DA_V_DIM)[:, :T]


def gla_chunk_scan(q, k, v, g):
    B, L = q.shape[0], q.shape[1]
    n = L // GLA_CHUNK

    def to_chunks(a):
        return a.reshape(B, n, GLA_CHUNK, a.shape[2], a.shape[3]).transpose(1, 0, 3, 2, 4)

    mask = jnp.tril(jnp.ones((GLA_CHUNK, GLA_CHUNK), dtype=bool))[:, :, None]

    def step(state, inp):
        qc, kc, vc, gc = inp
        b = jnp.cumsum(gc, axis=2)
        rel = b[:, :, :, None, :] - b[:, :, None, :, :]
        decay = jnp.exp(jnp.where(mask, rel, -jnp.inf))
        attn = jnp.einsum('bhid,bhjd,bhijd->bhij', qc, kc, decay)
        o = jnp.einsum('bhij,bhjv->bhiv', attn, vc) + jnp.einsum('bhid,bhdv->bhiv', qc * jnp.exp(b), state)
        b_last = b[:, :, -1]
        state = state * jnp.exp(b_last)[..., None] + jnp.einsum('bhjd,bhjv->bhdv', kc * jnp.exp(b_last[:, :, None] - b), vc)
        return state, o

    state0 = jnp.zeros((B, q.shape[2], q.shape[3], v.shape[3]), jnp.float32)
    _, o = lax.scan(step, state0, (to_chunks(q), to_chunks(k), to_chunks(v), to_chunks(g)))
    return o.transpose(1, 0, 3, 2, 4).reshape(B, L, q.shape[2], v.shape[3])


def gla_bidirectional(q, k, v, g_f, g_b):
    pad = (-N_META) % GLA_CHUNK
    padf = lambda a: jnp.pad(a, ((0, 0), (pad, 0), (0, 0), (0, 0)))
    flip = lambda a: a[:, ::-1]
    qp, kp, vp = padf(q), padf(k), padf(v)
    o_f = gla_chunk_scan(qp, kp, vp, padf(g_f))
    o_b = flip(gla_chunk_scan(flip(qp), flip(kp), flip(vp), flip(padf(g_b))))
    return (o_f + o_b)[:, pad:]


def peer_ffn(x, w_q, sub_keys, u, v):
    N, D = x.shape
    nb = -(-N // PEER_BLOCK)
    xb = jnp.pad(x, ((0, nb * PEER_BLOCK - N), (0, 0))).reshape(nb, PEER_BLOCK, D)

    def block(xi):
        n = xi.shape[0]
        q = (xi @ w_q).reshape(n, PEER_HEADS, 2, PEER_KEY_DIM)
        s = jnp.einsum('nhpc,hpkc->nhpk', q, sub_keys).astype(jnp.float32)
        ts, ti = lax.top_k(s, PEER_TOPK)
        cand_s = (ts[:, :, 0, :, None] + ts[:, :, 1, None, :]).reshape(n, PEER_HEADS, PEER_TOPK * PEER_TOPK)
        cand_i = (ti[:, :, 0, :, None] * PEER_NKEYS + ti[:, :, 1, None, :]).reshape(n, PEER_HEADS, PEER_TOPK * PEER_TOPK)
        best_s, best_p = lax.top_k(cand_s, PEER_TOPK)
        idx = jnp.take_along_axis(cand_i, best_p, axis=-1)
        gate = jax.nn.softmax(best_s, axis=-1)
        act = jax.nn.gelu(jnp.einsum('nd,nhkd->nhk', xi, u[idx]).astype(jnp.float32), approximate=False)
        return jnp.einsum('nhk,nhkd->nd', (gate * act).astype(xi.dtype), v[idx])

    return lax.map(block, xb).reshape(nb * PEER_BLOCK, D)[:N]


def setup_inputs(seed: int = 0) -> dict:
    key = jax.random.key(seed)
    ks = jax.random.split(key, 24)
    nrm = lambda k, shape, s: jax.random.normal(k, shape, jnp.float32) * s
    gain = lambda k, shape: 1.0 + 0.02 * jax.random.normal(k, shape, jnp.float32)
    return {
        'x': nrm(ks[0], (BATCH, SEQ, D_MODEL), 1.0),
        'meta_tokens': nrm(ks[1], (N_META, D_MODEL), 1.0),
        'ln1_w': gain(ks[2], (DEPTH, D_MODEL)),
        'w_in': nrm(ks[3], (DEPTH, D_MODEL, IN_WIDTH), D_MODEL ** -0.5),
        'da_lambda_q1': nrm(ks[4], (DEPTH, DA_HEAD_DIM), 0.1),
        'da_lambda_k1': nrm(ks[5], (DEPTH, DA_HEAD_DIM), 0.1),
        'da_lambda_q2': nrm(ks[6], (DEPTH, DA_HEAD_DIM), 0.1),
        'da_lambda_k2': nrm(ks[7], (DEPTH, DA_HEAD_DIM), 0.1),
        'da_subln_w': gain(ks[8], (DEPTH, DA_V_DIM)),
        'gla_gate_w2_f': nrm(ks[9], (DEPTH, GLA_GATE_RANK, GLA_HEADS * GLA_DK), GLA_GATE_RANK ** -0.5),
        'gla_gate_b_f': nrm(ks[10], (DEPTH, GLA_HEADS * GLA_DK), 0.1),
        'gla_gate_w2_b': nrm(ks[11], (DEPTH, GLA_GATE_RANK, GLA_HEADS * GLA_DK), GLA_GATE_RANK ** -0.5),
        'gla_gate_b_b': nrm(ks[12], (DEPTH, GLA_HEADS * GLA_DK), 0.1),
        'gla_norm_w': gain(ks[13], (DEPTH, GLA_DV)),
        'w_out': nrm(ks[14], (DEPTH, MIX_WIDTH, D_MODEL), MIX_WIDTH ** -0.5),
        'ln2_w': gain(ks[15], (DEPTH, D_MODEL)),
        'peer_w_q': nrm(ks[16], (DEPTH, D_MODEL, PEER_HEADS * 2 * PEER_KEY_DIM), D_MODEL ** -0.5),
        'peer_sub_keys': nrm(ks[17], (DEPTH, PEER_HEADS, 2, PEER_NKEYS, PEER_KEY_DIM), PEER_KEY_DIM ** -0.5),
        'peer_u': nrm(ks[18], (DEPTH, PEER_EXPERTS, D_MODEL), D_MODEL ** -0.5),
        'peer_v': nrm(ks[19], (DEPTH, PEER_EXPERTS, D_MODEL), PEER_HEADS ** -0.5),
        'final_norm_w': gain(ks[20], (D_MODEL,)),
    }


def reference(x, meta_tokens, ln1_w, w_in, da_lambda_q1, da_lambda_k1, da_lambda_q2, da_lambda_k2, da_subln_w, gla_gate_w2_f, gla_gate_b_f, gla_gate_w2_b, gla_gate_b_b, gla_norm_w, w_out, ln2_w, peer_w_q, peer_sub_keys, peer_u, peer_v, final_norm_w):
    B = x.shape[0]
    meta = jnp.broadcast_to(meta_tokens.astype(x.dtype)[None], (B, N_META, D_MODEL))
    h = jnp.concatenate([meta, x], axis=1)
    T = h.shape[1]
    pos = jnp.arange(T)
    splits = np.cumsum(IN_SIZES)[:-1].tolist()
    for l in range(DEPTH):
        xn = rmsnorm(h, ln1_w[l])
        proj = xn @ w_in[l]
        dq, dk, dv, gq, gk, gv, gr, zf, zb = jnp.split(proj, splits, axis=-1)

        lam_init = 0.8 - 0.6 * math.exp(-0.3 * l)
        lam = (jnp.exp(jnp.sum(da_lambda_q1[l].astype(jnp.float32) * da_lambda_k1[l].astype(jnp.float32)))
               - jnp.exp(jnp.sum(da_lambda_q2[l].astype(jnp.float32) * da_lambda_k2[l].astype(jnp.float32))) + lam_init)
        da = diff_attention(dq.reshape(B, T, DA_HEADS, 2, DA_HEAD_DIM), dk.reshape(B, T, DA_HEADS, 2, DA_HEAD_DIM),
                            dv.reshape(B, T, DA_HEADS, DA_V_DIM), lam, pos)
        da = (rmsnorm(da, da_subln_w[l]) * (1.0 - lam_init)).reshape(B, T, DA_WIDTH)

        f32 = jnp.float32
        log_g_f = jax.nn.log_sigmoid((zf @ gla_gate_w2_f[l] + gla_gate_b_f[l]).astype(f32)) / GLA_TAU
        log_g_b = jax.nn.log_sigmoid((zb @ gla_gate_w2_b[l] + gla_gate_b_b[l]).astype(f32)) / GLA_TAU
        go = gla_bidirectional((gq.astype(f32) * (GLA_DK ** -0.5)).reshape(B, T, GLA_HEADS, GLA_DK),
                               gk.astype(f32).reshape(B, T, GLA_HEADS, GLA_DK),
                               gv.astype(f32).reshape(B, T, GLA_HEADS, GLA_DV),
                               log_g_f.reshape(B, T, GLA_HEADS, GLA_DK),
                               log_g_b.reshape(B, T, GLA_HEADS, GLA_DK))
        go = rmsnorm(go, gla_norm_w[l]).reshape(B, T, GLA_WIDTH).astype(h.dtype) * jax.nn.silu(gr)

        h = h + jnp.concatenate([da, go], axis=-1) @ w_out[l]
        if l == DEPTH - 1:
            h = h[:, N_META:]

        hn = rmsnorm(h, ln2_w[l])
        h = h + peer_ffn(hn.reshape(-1, D_MODEL), peer_w_q[l], peer_sub_keys[l], peer_u[l], peer_v[l]).reshape(h.shape)
    return rmsnorm(h, final_norm_w)
```

```cpp
#include <hip/hip_runtime.h>
#include <hip/hip_cooperative_groups.h>
#include <cstdio>
#include <cstdint>
namespace cg = cooperative_groups;

constexpr int DM = 1024;
constexpr int NB = 8, SEQ = 2048, NMETA = 16;
constexpr int NTOK = NB * SEQ;
constexpr int MROWS = 16512;
constexpr int NIN = 3584;
constexpr int TPOS = NMETA + SEQ;
constexpr float EPS = 1e-6f;
constexpr float QSCALE = 0.125f * 1.4426950408889634f;
constexpr int NEXP = 16384;
constexpr int NTHR = 512;

constexpr size_t MiB = 1u << 20;
constexpr size_t OFF_CTL = 0, CTL_BYTES = 64 * 1024;
constexpr size_t OFF_MISC = 512 * 1024;
constexpr size_t OFF_ROPE = 1 * MiB;
constexpr size_t OFF_WOUT = 2 * MiB;
constexpr size_t OFF_WQ = 4 * MiB;
constexpr size_t OFF_KEYS = 8 * MiB;
constexpr size_t OFF_SSQP = 8 * MiB + 512 * 1024;
constexpr size_t OFF_UB = 9 * MiB;
constexpr size_t OFF_VB = 41 * MiB;
constexpr size_t OFF_XN = 73 * MiB;
constexpr size_t OFF_MIX = 73 * MiB;
constexpr size_t OFF_WIN = 106 * MiB;
constexpr size_t OFF_QB = 113 * MiB;
constexpr size_t OFF_KB = OFF_QB + 16 * MiB + 256 * 1024;
constexpr size_t OFF_VT = OFF_KB + 16 * MiB + 256 * 1024;
constexpr size_t OFF_H2B = 113 * MiB;
constexpr size_t OFF_GQ = 162 * MiB;
constexpr size_t OFF_GK = OFF_GQ + 8 * MiB + 256 * 1024;
constexpr size_t OFF_GVT = OFF_GK + 8 * MiB + 256 * 1024;
constexpr size_t OFF_GF = OFF_GVT + 16 * MiB + 256 * 1024;
constexpr size_t OFF_GB = OFF_GF + 16 * MiB + 256 * 1024;
constexpr size_t OFF_GR = OFF_GB + 16 * MiB + 256 * 1024;
constexpr size_t OFF_IDX = 162 * MiB;
constexpr size_t OFF_GATE = 171 * MiB;
constexpr size_t WS_END = OFF_GR + 16 * MiB + 256 * 1024;
static_assert(WS_END <= 256 * MiB, "workspace map");
static_assert(OFF_VT + (size_t)512 * MROWS * 2 <= OFF_GQ, "map D");
static_assert(OFF_WIN + (size_t)NIN * DM * 2 <= OFF_QB, "map C");

constexpr int LDS_BYTES = 147456;

typedef unsigned short bf16_t;
typedef float f32x4 __attribute__((ext_vector_type(4)));
typedef float f32x2 __attribute__((ext_vector_type(2)));
typedef unsigned u32x4 __attribute__((ext_vector_type(4)));
typedef unsigned u32x2 __attribute__((ext_vector_type(2)));
typedef __bf16 bf16x2_t __attribute__((ext_vector_type(2)));

struct Params {
    const float* in[21];
    float* out;
    unsigned char* ws;
    int ph_lo, ph_hi;
};

__device__ __forceinline__ unsigned f2bf(float f) { unsigned u = __float_as_uint(f); return (u + 0x7fffu + ((u >> 16) & 1u)) >> 16; }
__device__ __forceinline__ float bf2f(unsigned h) { return __uint_as_float(h << 16); }
__device__ __forceinline__ unsigned pk2(float lo, float hi) { return f2bf(lo) | (f2bf(hi) << 16); }
__device__ __forceinline__ float bflo(unsigned w) { return __uint_as_float(w << 16); }
__device__ __forceinline__ float bfhi(unsigned w) { return __uint_as_float(w & 0xffff0000u); }
__device__ __forceinline__ float dot2(unsigned a, unsigned b, float c) {
    return __builtin_amdgcn_fdot2_f32_bf16(__builtin_bit_cast(bf16x2_t, a), __builtin_bit_cast(bf16x2_t, b), c, false);
}
__device__ __forceinline__ float dot8(u32x4 a, u32x4 b, float c) { c = dot2(a.x, b.x, c); c = dot2(a.y, b.y, c); c = dot2(a.z, b.z, c); return dot2(a.w, b.w, c); }
__device__ __forceinline__ float wave_sum(float v) {
#pragma unroll
    for (int o = 1; o < 64; o <<= 1) v += __shfl_xor(v, o);
    return v;
}
__device__ __forceinline__ float wave_max(float v) {
#pragma unroll
    for (int o = 1; o < 64; o <<= 1) v = fmaxf(v, __shfl_xor(v, o));
    return v;
}
__device__ __forceinline__ float silu_f(float x) { return x / (1.f + __expf(-x)); }
__device__ __forceinline__ float logsig_f(float x) { return fminf(x, 0.f) - log1pf(__expf(-fabsf(x))); }
__device__ __forceinline__ float gelu_f(float x) { return 0.5f * x * (1.f + erff(x * 0.70710678118654752f)); }

__device__ __forceinline__ float win_src(const Params& p, int k, int n) {
    const float* W = p.in[3] + (size_t)k * 3104;
    if (n < 1024) {
        const int base = n & ~63, dp = n & 63, d = dp < 16 ? ((dp >> 1) + 8 * (dp & 1)) : dp;
        return W[base + d];
    } else if (n < 3072) return W[n];
    const int j = (n - 3072) & 255, dir = (n - 3072) >> 8;
    const float* w2 = p.in[dir ? 11 : 9];
    const float* wz = W + 3072 + dir * 16;
    float s = 0.f;
#pragma unroll
    for (int r = 0; r < 16; ++r) s += wz[r] * w2[r * 256 + j];
    return s;
}

template <int WHICH>
__device__ __forceinline__ void p0_transpose_item(const Params& p, float* scr, int item, int lane) {
    constexpr int N = WHICH == 0 ? NIN : (WHICH == 1 ? 1024 : 2048);
    constexpr int nblk = N / 32;
    const int kb = item / nblk, nb = item % nblk, k0 = 64 * kb, n0 = 32 * nb;
    bf16_t* WT = (bf16_t*)(p.ws + (WHICH == 0 ? OFF_WIN : (WHICH == 1 ? OFF_WOUT : OFF_WQ)));
#pragma unroll 4
    for (int i = 0; i < 32; ++i) {
        const int kk = 2 * i + (lane >> 5), k = k0 + kk, n = n0 + (lane & 31);
        float v;
        if (WHICH == 0) v = win_src(p, k, n);
        else if (WHICH == 1) v = p.in[14][(size_t)k * 1024 + n];
        else v = p.in[16][(size_t)k * 2048 + n] * p.in[15][k];
        scr[kk * 33 + (lane & 31)] = v;
    }
    __builtin_amdgcn_s_waitcnt(0xC07F); __builtin_amdgcn_wave_barrier();
    const int c = lane & 7;
#pragma unroll
    for (int j = 0; j < 4; ++j) {
        const int n = (lane >> 3) + 8 * j; const float* s = scr + (8 * c) * 33 + n;
        u32x4 o; o.x = pk2(s[0 * 33], s[1 * 33]); o.y = pk2(s[2 * 33], s[3 * 33]); o.z = pk2(s[4 * 33], s[5 * 33]); o.w = pk2(s[6 * 33], s[7 * 33]);
        *(u32x4*)(WT + (size_t)(n0 + n) * 1024 + k0 + 8 * c) = o;
    }
    __builtin_amdgcn_s_waitcnt(0xC07F); __builtin_amdgcn_wave_barrier();
}

__device__ __forceinline__ void phase0(const Params& p, unsigned char* lds) {
    const int tid = threadIdx.x, lane = tid & 63, wave = tid >> 6;
    const int gw = blockIdx.x * 8 + wave, NGW = gridDim.x * 8;
    const long gt = (long)blockIdx.x * NTHR + tid, NGT = (long)gridDim.x * NTHR;
    {
        const f32x4* lw = (const f32x4*)p.in[2];
        bf16_t* XN = (bf16_t*)(p.ws + OFF_XN);
        for (int r = gw; r < MROWS; r += NGW) {
            const float* src = r < NTOK ? p.in[0] + (size_t)r * DM : (r < NTOK + NMETA ? p.in[1] + (size_t)(r - NTOK) * DM : nullptr);
            f32x4 v[4]; float s = 0.f;
#pragma unroll
            for (int j = 0; j < 4; ++j) { v[j] = src ? ((const f32x4*)src)[lane + 64 * j] : (f32x4){0.f, 0.f, 0.f, 0.f}; s += v[j].x * v[j].x + v[j].y * v[j].y + v[j].z * v[j].z + v[j].w * v[j].w; }
            const float rs = rsqrtf(wave_sum(s) * (1.f / DM) + EPS);
#pragma unroll
            for (int j = 0; j < 4; ++j) { const f32x4 w = lw[lane + 64 * j]; u32x2 o; o.x = pk2(v[j].x * rs * w.x, v[j].y * rs * w.y); o.y = pk2(v[j].z * rs * w.z, v[j].w * rs * w.w);
                *(u32x2*)(XN + (size_t)r * DM + 4 * (lane + 64 * j)) = o; }
        }
    }
    {
        float* scr = (float*)lds + wave * (64 * 33);
        constexpr int I0 = 16 * (NIN / 32), I1 = 16 * 32, I2 = 16 * 64;
        for (int it = gw; it < I0 + I1 + I2; it += NGW) {
            if (it < I0) p0_transpose_item<0>(p, scr, it, lane);
            else if (it < I0 + I1) p0_transpose_item<1>(p, scr, it - I0, lane);
            else p0_transpose_item<2>(p, scr, it - I0 - I1, lane);
        }
    }
    {
        bf16_t* KEYS = (bf16_t*)(p.ws + OFF_KEYS); bf16_t* UB = (bf16_t*)(p.ws + OFF_UB); bf16_t* VB = (bf16_t*)(p.ws + OFF_VB);
        const long NK8 = 262144 / 8, NU8 = (long)NEXP * DM / 8;
        for (long i = gt; i < NK8 + 2 * NU8; i += NGT) {
            const float* src; bf16_t* dst; long e; bool scale = false;
            if (i < NK8) { src = p.in[17]; dst = KEYS; e = i * 8; }
            else if (i < NK8 + NU8) { src = p.in[18]; dst = UB; e = (i - NK8) * 8; scale = true; }
            else { src = p.in[19]; dst = VB; e = (i - NK8 - NU8) * 8; }
            f32x4 a = *(const f32x4*)(src + e), b = *(const f32x4*)(src + e + 4);
            if (scale) { const f32x4 wa = *(const f32x4*)(p.in[15] + (e & 1023)), wb = *(const f32x4*)(p.in[15] + (e & 1023) + 4); a *= wa; b *= wb; }
            u32x4 o; o.x = pk2(a.x, a.y); o.y = pk2(a.z, a.w); o.z = pk2(b.x, b.y); o.w = pk2(b.z, b.w);
            *(u32x4*)(dst + e) = o;
        }
    }
    {
        f32x2* rope = (f32x2*)(p.ws + OFF_ROPE);
        for (long i = gt; i < TPOS * 8; i += NGT) {
            const int t = (int)(i >> 3), j = (int)(i & 7);
            const float inv = powf(500000.0f, -(float)j * 0.125f);
            const float ang = (float)t * inv;
            rope[i] = (f32x2){cosf(ang), sinf(ang)};
        }
        if (gt == 0) {
            float a = 0.f, b = 0.f;
            for (int i = 0; i < 64; ++i) { a += p.in[4][i] * p.in[5][i]; b += p.in[6][i] * p.in[7][i]; }
            ((float*)(p.ws + OFF_MISC))[0] = expf(a) - expf(b) + 0.2f;
        }
    }
}

__device__ __forceinline__ void p1_store(const Params& p, int row, int n0, float v0, float v1, float v2, float v3) {
    if (n0 < 1024) {
        const int dp = n0 & 63;
        if (dp < 16) {
            const int pos = row < NTOK ? NMETA + (row & (SEQ - 1)) : (row - NTOK);
            const f32x4 cs = *(const f32x4*)((const float*)(p.ws + OFF_ROPE) + ((size_t)pos * 8 + (dp >> 1)) * 2);
            const float a0 = v0 * cs.x - v1 * cs.y, b0 = v1 * cs.x + v0 * cs.y;
            const float a1 = v2 * cs.z - v3 * cs.w, b1 = v3 * cs.z + v2 * cs.w;
            v0 = a0; v1 = b0; v2 = a1; v3 = b1;
        }
        if (n0 < 512) { u32x2 o; o.x = pk2(v0 * QSCALE, v1 * QSCALE); o.y = pk2(v2 * QSCALE, v3 * QSCALE); *(u32x2*)((bf16_t*)(p.ws + OFF_QB) + (size_t)row * 512 + n0) = o; }
        else { u32x2 o; o.x = pk2(v0, v1); o.y = pk2(v2, v3); *(u32x2*)((bf16_t*)(p.ws + OFF_KB) + (size_t)row * 512 + (n0 - 512)) = o; }
    } else if (n0 < 1536) {
        bf16_t* VT = (bf16_t*)(p.ws + OFF_VT) + (size_t)(n0 - 1024) * MROWS + row;
        VT[0] = (bf16_t)f2bf(v0); VT[MROWS] = (bf16_t)f2bf(v1); VT[2 * MROWS] = (bf16_t)f2bf(v2); VT[3 * (size_t)MROWS] = (bf16_t)f2bf(v3);
    } else if (n0 < 1792) {
        u32x2 o; o.x = pk2(v0 * 0.125f, v1 * 0.125f); o.y = pk2(v2 * 0.125f, v3 * 0.125f); *(u32x2*)((bf16_t*)(p.ws + OFF_GQ) + (size_t)row * 256 + (n0 - 1536)) = o;
    } else if (n0 < 2048) {
        u32x2 o; o.x = pk2(v0, v1); o.y = pk2(v2, v3); *(u32x2*)((bf16_t*)(p.ws + OFF_GK) + (size_t)row * 256 + (n0 - 1792)) = o;
    } else if (n0 < 2560) {
        bf16_t* VT = (bf16_t*)(p.ws + OFF_GVT) + (size_t)(n0 - 2048) * MROWS + row;
        VT[0] = (bf16_t)f2bf(v0); VT[MROWS] = (bf16_t)f2bf(v1); VT[2 * MROWS] = (bf16_t)f2bf(v2); VT[3 * (size_t)MROWS] = (bf16_t)f2bf(v3);
    } else if (n0 < 3072) {
        u32x2 o; o.x = pk2(silu_f(v0), silu_f(v1)); o.y = pk2(silu_f(v2), silu_f(v3)); *(u32x2*)((bf16_t*)(p.ws + OFF_GR) + (size_t)row * 512 + (n0 - 2560)) = o;
    } else {
        const int dir = (n0 - 3072) >> 8, j = (n0 - 3072) & 255;
        const f32x4 bb = *(const f32x4*)(p.in[dir ? 12 : 10] + j);
        f32x4 o; o.x = logsig_f(v0 + bb.x) * 0.0625f; o.y = logsig_f(v1 + bb.y) * 0.0625f; o.z = logsig_f(v2 + bb.z) * 0.0625f; o.w = logsig_f(v3 + bb.w) * 0.0625f;
        *(f32x4*)((float*)(p.ws + (dir ? OFF_GB : OFF_GF)) + (size_t)row * 256 + j) = o;
    }
}

__device__ __forceinline__ void phase1_naive(const Params& p) {
    const long gt = (long)blockIdx.x * NTHR + threadIdx.x, NGT = (long)gridDim.x * NTHR;
    const bf16_t* XN = (const bf16_t*)(p.ws + OFF_XN); const bf16_t* WT = (const bf16_t*)(p.ws + OFF_WIN);
    for (long it = gt; it < (long)MROWS * (NIN / 4); it += NGT) {
        const int row = (int)(it / (NIN / 4)), n0 = (int)(it % (NIN / 4)) * 4;
        const u32x4* a = (const u32x4*)(XN + (size_t)row * DM);
        const u32x4* w0 = (const u32x4*)(WT + (size_t)n0 * DM);
        float c0 = 0.f, c1 = 0.f, c2 = 0.f, c3 = 0.f;
        for (int kc = 0; kc < 128; ++kc) { const u32x4 av = a[kc]; c0 = dot8(av, w0[kc], c0); c1 = dot8(av, w0[kc + 128], c1); c2 = dot8(av, w0[kc + 256], c2); c3 = dot8(av, w0[kc + 384], c3); }
        p1_store(p, row, n0, c0, c1, c2, c3);
    }
}

__device__ __forceinline__ void phase2_attn_naive(const Params& p, unsigned char* lds) {
    const int tid = threadIdx.x, lane = tid & 63, wave = tid >> 6;
    const int gw = blockIdx.x * 8 + wave, NGW = gridDim.x * 8;
    const bf16_t* QB = (const bf16_t*)(p.ws + OFF_QB); const bf16_t* KB = (const bf16_t*)(p.ws + OFF_KB); const bf16_t* VT = (const bf16_t*)(p.ws + OFF_VT);
    bf16_t* MIX = (bf16_t*)(p.ws + OFF_MIX);
    const float lam = ((const float*)(p.ws + OFF_MISC))[0];
    float* wl = (float*)lds + wave * 64;
    for (int it = gw; it < NB * 4 * SEQ; it += NGW) {
        const int q = it & (SEQ - 1), h = (it >> 11) & 3, b = it >> 13;
        const int row = b * SEQ + q;
        u32x4 qv[16];
#pragma unroll
        for (int i = 0; i < 16; ++i) qv[i] = *(const u32x4*)(QB + (size_t)row * 512 + h * 128 + 8 * i);
        float m0 = -1e30f, m1 = -1e30f, l0 = 0.f, l1 = 0.f;
        for (int kc = 0; kc < 33; ++kc) {
            const bool valid = kc < 32 || lane < 16;
            const int krow = kc < 32 ? b * SEQ + kc * 64 + lane : NTOK + lane;
            const u32x4* kp = (const u32x4*)(KB + (size_t)krow * 512 + h * 128);
            float s0 = 0.f, s1 = 0.f;
#pragma unroll
            for (int i = 0; i < 8; ++i) { s0 = dot8(qv[i], kp[i], s0); s1 = dot8(qv[8 + i], kp[8 + i], s1); }
            if (valid) {
                const float n0 = fmaxf(m0, s0), n1 = fmaxf(m1, s1);
                l0 = l0 * exp2f(m0 - n0) + exp2f(s0 - n0); m0 = n0;
                l1 = l1 * exp2f(m1 - n1) + exp2f(s1 - n1); m1 = n1;
            }
        }
        const float M0 = wave_max(m0), M1 = wave_max(m1);
        const float L0 = wave_sum(l0 * exp2f(m0 - M0)), L1 = wave_sum(l1 * exp2f(m1 - M1));
        const float i0 = 1.f / L0, i1 = lam / L1;
        float o0 = 0.f, o1 = 0.f;
        const bf16_t* vp0 = VT + (size_t)(h * 128 + lane) * MROWS; const bf16_t* vp1 = vp0 + (size_t)64 * MROWS;
        for (int kc = 0; kc < 33; ++kc) {
            const bool valid = kc < 32 || lane < 16;
            const int kbase = kc < 32 ? b * SEQ + kc * 64 : NTOK;
            const u32x4* kp = (const u32x4*)(KB + (size_t)(kbase + lane) * 512 + h * 128);
            float s0 = 0.f, s1 = 0.f;
#pragma unroll
            for (int i = 0; i < 8; ++i) { s0 = dot8(qv[i], kp[i], s0); s1 = dot8(qv[8 + i], kp[8 + i], s1); }
            const float a = valid ? exp2f(s0 - M0) * i0 - exp2f(s1 - M1) * i1 : 0.f;
            __builtin_amdgcn_wave_barrier();
            wl[lane] = a;
            __builtin_amdgcn_s_waitcnt(0xC07F); __builtin_amdgcn_wave_barrier();
#pragma unroll 2
            for (int k8 = 0; k8 < 8; ++k8) {
                const u32x4 va = *(const u32x4*)(vp0 + kbase + 8 * k8), vb = *(const u32x4*)(vp1 + kbase + 8 * k8);
                const f32x4 w0 = *(const f32x4*)(wl + 8 * k8), w1 = *(const f32x4*)(wl + 8 * k8 + 4);
                o0 += w0.x * bflo(va.x) + w0.y * bfhi(va.x) + w0.z * bflo(va.y) + w0.w * bfhi(va.y) + w1.x * bflo(va.z) + w1.y * bfhi(va.z) + w1.z * bflo(va.w) + w1.w * bfhi(va.w);
                o1 += w0.x * bflo(vb.x) + w0.y * bfhi(vb.x) + w0.z * bflo(vb.y) + w0.w * bfhi(vb.y) + w1.x * bflo(vb.z) + w1.y * bfhi(vb.z) + w1.z * bflo(vb.w) + w1.w * bfhi(vb.w);
            }
            __builtin_amdgcn_s_waitcnt(0xC07F);
        }
        const float rs = rsqrtf(wave_sum(o0 * o0 + o1 * o1) * (1.f / 128.f) + EPS) * 0.8f;
        MIX[(size_t)row * DM + h * 128 + lane] = (bf16_t)f2bf(o0 * rs * p.in[8][lane]);
        MIX[(size_t)row * DM + h * 128 + 64 + lane] = (bf16_t)f2bf(o1 * rs * p.in[8][64 + lane]);
    }
}

__device__ __forceinline__ void phase2_gla_naive(const Params& p) {
    const int tid = threadIdx.x, lane = tid & 63, wave = tid >> 6;
    const int gw = blockIdx.x * 8 + wave, NGW = gridDim.x * 8;
    const bf16_t* GQ = (const bf16_t*)(p.ws + OFF_GQ); const bf16_t* GK = (const bf16_t*)(p.ws + OFF_GK); const bf16_t* GVT = (const bf16_t*)(p.ws + OFF_GVT);
    for (int it = gw; it < NB * 4 * 2 * 8; it += NGW) {
        const int sl = it & 7, dir = (it >> 3) & 1, h = (it >> 4) & 3, b = it >> 6;
        const int dv = sl * 16 + (lane & 15), dkq = lane >> 4;
        const float* G = (const float*)(p.ws + (dir ? OFF_GB : OFF_GF));
        float* O = p.out + (dir ? (size_t)NTOK * 512 : 0);
        float S[16];
#pragma unroll
        for (int i = 0; i < 16; ++i) S[i] = 0.f;
        const int nsteps = dir ? SEQ : SEQ + NMETA;
        for (int st = 0; st < nsteps; ++st) {
            int row; bool outp = true;
            if (dir == 0) { if (st < NMETA) { row = NTOK + st; outp = false; } else row = b * SEQ + (st - NMETA); }
            else row = b * SEQ + (SEQ - 1 - st);
            const f32x4* gp = (const f32x4*)(G + (size_t)row * 256 + h * 64 + dkq * 16);
            const u32x4* kp = (const u32x4*)(GK + (size_t)row * 256 + h * 64 + dkq * 16);
            const u32x4* qp = (const u32x4*)(GQ + (size_t)row * 256 + h * 64 + dkq * 16);
            const float v = bf2f(GVT[(size_t)(h * 128 + dv) * MROWS + row]);
            float gg[16], kk[16], qq[16];
#pragma unroll
            for (int i = 0; i < 4; ++i) { const f32x4 t = gp[i]; gg[4 * i] = t.x; gg[4 * i + 1] = t.y; gg[4 * i + 2] = t.z; gg[4 * i + 3] = t.w; }
#pragma unroll
            for (int i = 0; i < 2; ++i) { const u32x4 t = kp[i], u = qp[i];
                kk[8 * i] = bflo(t.x); kk[8 * i + 1] = bfhi(t.x); kk[8 * i + 2] = bflo(t.y); kk[8 * i + 3] = bfhi(t.y); kk[8 * i + 4] = bflo(t.z); kk[8 * i + 5] = bfhi(t.z); kk[8 * i + 6] = bflo(t.w); kk[8 * i + 7] = bfhi(t.w);
                qq[8 * i] = bflo(u.x); qq[8 * i + 1] = bfhi(u.x); qq[8 * i + 2] = bflo(u.y); qq[8 * i + 3] = bfhi(u.y); qq[8 * i + 4] = bflo(u.z); qq[8 * i + 5] = bfhi(u.z); qq[8 * i + 6] = bflo(u.w); qq[8 * i + 7] = bfhi(u.w); }
            float o = 0.f;
#pragma unroll
            for (int i = 0; i < 16; ++i) { S[i] = S[i] * __expf(gg[i]) + kk[i] * v; o += qq[i] * S[i]; }
            o += __shfl_xor(o, 16); o += __shfl_xor(o, 32);
            if (outp && dkq == 0) O[(size_t)row * 512 + h * 128 + dv] = o;
        }
    }
}

__device__ __forceinline__ void phase2c(const Params& p) {
    const int tid = threadIdx.x, lane = tid & 63, wave = tid >> 6;
    const int gw = blockIdx.x * 8 + wave, NGW = gridDim.x * 8;
    const bf16_t* GR = (const bf16_t*)(p.ws + OFF_GR); bf16_t* MIX = (bf16_t*)(p.ws + OFF_MIX);
    const float* OF = p.out; const float* OBk = p.out + (size_t)NTOK * 512;
    const int c0 = lane * 8;
    const f32x4 w0 = *(const f32x4*)(p.in[13] + (c0 & 127)), w1 = *(const f32x4*)(p.in[13] + (c0 & 127) + 4);
    for (int r = gw; r < NTOK; r += NGW) {
        const f32x4 a0 = *(const f32x4*)(OF + (size_t)r * 512 + c0), a1 = *(const f32x4*)(OF + (size_t)r * 512 + c0 + 4);
        const f32x4 b0 = *(const f32x4*)(OBk + (size_t)r * 512 + c0), b1 = *(const f32x4*)(OBk + (size_t)r * 512 + c0 + 4);
        const f32x4 x0 = a0 + b0, x1 = a1 + b1;
        float s = x0.x * x0.x + x0.y * x0.y + x0.z * x0.z + x0.w * x0.w + x1.x * x1.x + x1.y * x1.y + x1.z * x1.z + x1.w * x1.w;
        s += __shfl_xor(s, 1); s += __shfl_xor(s, 2); s += __shfl_xor(s, 4); s += __shfl_xor(s, 8);
        const float rs = rsqrtf(s * (1.f / 128.f) + EPS);
        const u32x4 g = *(const u32x4*)(GR + (size_t)r * 512 + c0);
        u32x4 o;
        o.x = pk2(x0.x * rs * w0.x * bflo(g.x), x0.y * rs * w0.y * bfhi(g.x)); o.y = pk2(x0.z * rs * w0.z * bflo(g.y), x0.w * rs * w0.w * bfhi(g.y));
        o.z = pk2(x1.x * rs * w1.x * bflo(g.z), x1.y * rs * w1.y * bfhi(g.z)); o.w = pk2(x1.z * rs * w1.z * bflo(g.w), x1.w * rs * w1.w * bfhi(g.w));
        *(u32x4*)(MIX + (size_t)r * DM + 512 + c0) = o;
    }
}

__device__ __forceinline__ void phase3_naive(const Params& p) {
    const int tid = threadIdx.x, lane = tid & 63, wave = tid >> 6;
    const int gw = blockIdx.x * 8 + wave, NGW = gridDim.x * 8;
    const bf16_t* MIX = (const bf16_t*)(p.ws + OFF_MIX); const bf16_t* WT = (const bf16_t*)(p.ws + OFF_WOUT);
    bf16_t* H2B = (bf16_t*)(p.ws + OFF_H2B); float* SSQ = (float*)(p.ws + OFF_SSQP);
    for (int r = gw; r < NTOK; r += NGW) {
        const u32x4* a = (const u32x4*)(MIX + (size_t)r * DM);
        float ss = 0.f;
        for (int j = 0; j < 4; ++j) {
            const int n0 = 4 * (lane + 64 * j);
            const u32x4* w0 = (const u32x4*)(WT + (size_t)n0 * DM);
            float c0 = 0.f, c1 = 0.f, c2 = 0.f, c3 = 0.f;
            for (int kc = 0; kc < 128; ++kc) { const u32x4 av = a[kc]; c0 = dot8(av, w0[kc], c0); c1 = dot8(av, w0[kc + 128], c1); c2 = dot8(av, w0[kc + 256], c2); c3 = dot8(av, w0[kc + 384], c3); }
            const f32x4 xr = *(const f32x4*)(p.in[0] + (size_t)r * DM + n0);
            const f32x4 hv = (f32x4){xr.x + c0, xr.y + c1, xr.z + c2, xr.w + c3};
            *(f32x4*)(p.out + (size_t)r * DM + n0) = hv;
            u32x2 o; o.x = pk2(hv.x, hv.y); o.y = pk2(hv.z, hv.w); *(u32x2*)(H2B + (size_t)r * DM + n0) = o;
            ss += hv.x * hv.x + hv.y * hv.y + hv.z * hv.z + hv.w * hv.w;
        }
        ss = wave_sum(ss);
        if (lane < 8) SSQ[(size_t)r * 8 + lane] = lane == 0 ? ss : 0.f;
    }
}

#define INS16(LV, LI, xv, xi) do { float _v = (xv); int _i = (xi); \
    _Pragma("unroll") for (int _s = 0; _s < 16; ++_s) { const bool _g = _v > LV[_s]; const float _tv = LV[_s]; const int _ti = LI[_s]; \
        LV[_s] = _g ? _v : _tv; LI[_s] = _g ? _i : _ti; _v = _g ? _tv : _v; _i = _g ? _ti : _i; } } while (0)

__device__ __forceinline__ void phase4_naive(const Params& p, unsigned char* lds) {
    const int tid = threadIdx.x;
    float* hn = (float*)lds;
    float* qs = hn + 1024;
    float* sc = qs + 2048;
    float* tsv = sc + 2048;
    int* tsi = (int*)(tsv + 256);
    const bf16_t* H2B = (const bf16_t*)(p.ws + OFF_H2B); const bf16_t* WQ = (const bf16_t*)(p.ws + OFF_WQ); const bf16_t* KEYS = (const bf16_t*)(p.ws + OFF_KEYS);
    const float* SSQ = (const float*)(p.ws + OFF_SSQP);
    int* IDX = (int*)(p.ws + OFF_IDX); float* GATE = (float*)(p.ws + OFF_GATE);
    for (int r = blockIdx.x; r < NTOK; r += gridDim.x) {
        float ss = 0.f;
#pragma unroll
        for (int i = 0; i < 8; ++i) ss += SSQ[(size_t)r * 8 + i];
        const float rstd = rsqrtf(ss * (1.f / DM) + EPS);
        { const unsigned w = *(const unsigned*)(H2B + (size_t)r * DM + 2 * tid); hn[2 * tid] = bflo(w) * rstd; hn[2 * tid + 1] = bfhi(w) * rstd; }
        __syncthreads();
        for (int j = 0; j < 4; ++j) {
            const int n = tid + 512 * j; const u32x4* w = (const u32x4*)(WQ + (size_t)n * DM); float c = 0.f;
            for (int kc = 0; kc < 128; ++kc) { const u32x4 wv = w[kc]; const f32x4 h0 = *(const f32x4*)(hn + 8 * kc), h1 = *(const f32x4*)(hn + 8 * kc + 4);
                c += h0.x * bflo(wv.x) + h0.y * bfhi(wv.x) + h0.z * bflo(wv.y) + h0.w * bfhi(wv.y) + h1.x * bflo(wv.z) + h1.y * bfhi(wv.z) + h1.z * bflo(wv.w) + h1.w * bfhi(wv.w); }
            qs[n] = c;
        }
        __syncthreads();
        for (int j = 0; j < 4; ++j) {
            const int sidx = tid + 512 * j, hp = sidx >> 7; const u32x4* kp = (const u32x4*)(KEYS + (size_t)sidx * 128); const float* qq = qs + hp * 128; float c = 0.f;
            for (int kc = 0; kc < 16; ++kc) { const u32x4 wv = kp[kc]; const f32x4 h0 = *(const f32x4*)(qq + 8 * kc), h1 = *(const f32x4*)(qq + 8 * kc + 4);
                c += h0.x * bflo(wv.x) + h0.y * bfhi(wv.x) + h0.z * bflo(wv.y) + h0.w * bfhi(wv.y) + h1.x * bflo(wv.z) + h1.y * bfhi(wv.z) + h1.z * bflo(wv.w) + h1.w * bfhi(wv.w); }
            sc[sidx] = c;
        }
        __syncthreads();
        if (tid < 16) {
            float LV[16]; int LI[16];
#pragma unroll
            for (int s = 0; s < 16; ++s) { LV[s] = -3.0e38f; LI[s] = 0; }
            for (int k = 0; k < 128; ++k) INS16(LV, LI, sc[tid * 128 + k], k);
#pragma unroll
            for (int s = 0; s < 16; ++s) { tsv[tid * 16 + s] = LV[s]; tsi[tid * 16 + s] = LI[s]; }
        }
        __syncthreads();
        if (tid < 8) {
            float LV[16]; int LI[16];
#pragma unroll
            for (int s = 0; s < 16; ++s) { LV[s] = -3.0e38f; LI[s] = 0; }
            for (int c = 0; c < 256; ++c) INS16(LV, LI, tsv[(2 * tid) * 16 + (c >> 4)] + tsv[(2 * tid + 1) * 16 + (c & 15)], c);
            float den = 0.f, e[16];
#pragma unroll
            for (int s = 0; s < 16; ++s) { e[s] = __expf(LV[s] - LV[0]); den += e[s]; }
            const float inv = 1.f / den;
#pragma unroll
            for (int s = 0; s < 16; ++s) { const int c = LI[s];
                IDX[(size_t)r * 128 + tid * 16 + s] = tsi[(2 * tid) * 16 + (c >> 4)] * 128 + tsi[(2 * tid + 1) * 16 + (c & 15)];
                GATE[(size_t)r * 128 + tid * 16 + s] = e[s] * inv; }
        }
        __syncthreads();
    }
}

__device__ __forceinline__ void phase5(const Params& p) {
    const int tid = threadIdx.x, lane = tid & 63, wave = tid >> 6;
    const int gw = blockIdx.x * 8 + wave, NGW = gridDim.x * 8;
    const bf16_t* H2B = (const bf16_t*)(p.ws + OFF_H2B); const bf16_t* UB = (const bf16_t*)(p.ws + OFF_UB); const bf16_t* VB = (const bf16_t*)(p.ws + OFF_VB);
    const float* SSQ = (const float*)(p.ws + OFF_SSQP); const int* IDX = (const int*)(p.ws + OFF_IDX); const float* GATE = (const float*)(p.ws + OFF_GATE);
    const int e0 = 8 * lane;
    for (int r = gw; r < NTOK; r += NGW) {
        float ss = 0.f;
#pragma unroll
        for (int i = 0; i < 8; ++i) ss += SSQ[(size_t)r * 8 + i];
        const float rstd = rsqrtf(ss * (1.f / DM) + EPS);
        const u32x4 ha = *(const u32x4*)(H2B + (size_t)r * DM + e0), hb = *(const u32x4*)(H2B + (size_t)r * DM + 512 + e0);
        float acc[16];
#pragma unroll
        for (int i = 0; i < 16; ++i) acc[i] = 0.f;
        for (int k = 0; k < 128; ++k) {
            const int e = IDX[(size_t)r * 128 + k]; const float g = GATE[(size_t)r * 128 + k];
            const u32x4 ua = *(const u32x4*)(UB + (size_t)e * DM + e0), ub = *(const u32x4*)(UB + (size_t)e * DM + 512 + e0);
            const u32x4 va = *(const u32x4*)(VB + (size_t)e * DM + e0), vb = *(const u32x4*)(VB + (size_t)e * DM + 512 + e0);
            float d = dot8(ha, ua, 0.f); d = dot8(hb, ub, d);
            d = wave_sum(d) * rstd;
            const float w = g * gelu_f(d);
            acc[0] += w * bflo(va.x); acc[1] += w * bfhi(va.x); acc[2] += w * bflo(va.y); acc[3] += w * bfhi(va.y);
            acc[4] += w * bflo(va.z); acc[5] += w * bfhi(va.z); acc[6] += w * bflo(va.w); acc[7] += w * bfhi(va.w);
            acc[8] += w * bflo(vb.x); acc[9] += w * bfhi(vb.x); acc[10] += w * bflo(vb.y); acc[11] += w * bfhi(vb.y);
            acc[12] += w * bflo(vb.z); acc[13] += w * bfhi(vb.z); acc[14] += w * bflo(vb.w); acc[15] += w * bfhi(vb.w);
        }
        float* orow = p.out + (size_t)r * DM;
        f32x4 h0 = *(const f32x4*)(orow + e0), h1 = *(const f32x4*)(orow + e0 + 4), h2 = *(const f32x4*)(orow + 512 + e0), h3 = *(const f32x4*)(orow + 512 + e0 + 4);
        h0 += (f32x4){acc[0], acc[1], acc[2], acc[3]}; h1 += (f32x4){acc[4], acc[5], acc[6], acc[7]};
        h2 += (f32x4){acc[8], acc[9], acc[10], acc[11]}; h3 += (f32x4){acc[12], acc[13], acc[14], acc[15]};
        float s2 = h0.x * h0.x + h0.y * h0.y + h0.z * h0.z + h0.w * h0.w + h1.x * h1.x + h1.y * h1.y + h1.z * h1.z + h1.w * h1.w
                 + h2.x * h2.x + h2.y * h2.y + h2.z * h2.z + h2.w * h2.w + h3.x * h3.x + h3.y * h3.y + h3.z * h3.z + h3.w * h3.w;
        const float rs = rsqrtf(wave_sum(s2) * (1.f / DM) + EPS);
        const float* fw = p.in[20];
        *(f32x4*)(orow + e0) = h0 * rs * *(const f32x4*)(fw + e0); *(f32x4*)(orow + e0 + 4) = h1 * rs * *(const f32x4*)(fw + e0 + 4);
        *(f32x4*)(orow + 512 + e0) = h2 * rs * *(const f32x4*)(fw + 512 + e0); *(f32x4*)(orow + 512 + e0 + 4) = h3 * rs * *(const f32x4*)(fw + 512 + e0 + 4);
    }
}

constexpr int NPHASE = 7;
__global__ void __launch_bounds__(NTHR, 2) mega(Params p) {
    extern __shared__ __attribute__((aligned(16))) unsigned char lds[];
    cg::grid_group grid = cg::this_grid();
    for (int ph = p.ph_lo; ph < p.ph_hi; ++ph) {
        switch (ph) {
            case 0: phase0(p, lds); break;
            case 1: phase1_naive(p); break;
            case 2: phase2_gla_naive(p); phase2_attn_naive(p, lds); break;
            case 3: phase2c(p); break;
            case 4: phase3_naive(p); break;
            case 5: phase4_naive(p, lds); break;
            case 6: phase5(p); break;
        }
        if (ph + 1 < p.ph_hi) grid.sync();
    }
}

extern "C" void kernel_launch(void* const* d_in, const int* in_sizes, int n_in, void* d_out, int out_size, void* d_ws, size_t ws_size, hipStream_t stream) {
    static int grid = 0;
    if (grid == 0) {
        if (n_in != 21 || out_size != NTOK * DM || ws_size < WS_END) { fprintf(stderr, "kernel_launch: unexpected shapes (n_in %d out %d ws %zu)\n", n_in, out_size, ws_size); grid = -1; return; }
        int dev = 0, cus = 0, per_cu = 0;
        hipGetDevice(&dev);
        hipDeviceGetAttribute(&cus, hipDeviceAttributeMultiprocessorCount, dev);
        hipFuncSetAttribute((const void*)mega, hipFuncAttributeMaxDynamicSharedMemorySize, LDS_BYTES);
        hipOccupancyMaxActiveBlocksPerMultiprocessor(&per_cu, (const void*)mega, NTHR, LDS_BYTES);
        if (per_cu < 1) { fprintf(stderr, "kernel_launch: occupancy query says %d blocks/CU\n", per_cu); per_cu = 1; }
        grid = cus * 1;
        (void)hipGetLastError();
    }
    if (grid < 0) return;
    hipMemsetAsync((char*)d_ws + OFF_CTL, 0, CTL_BYTES, stream);
    Params p{};
    for (int i = 0; i < 21; ++i) p.in[i] = (const float*)d_in[i];
    p.out = (float*)d_out; p.ws = (unsigned char*)d_ws; p.ph_lo = 0; p.ph_hi = NPHASE;
    void* args[] = {&p};
    hipError_t e = hipLaunchCooperativeKernel((const void*)mega, dim3(grid), dim3(NTHR), args, LDS_BYTES, stream);
    if (e != hipSuccess) fprintf(stderr, "cooperative launch failed: %s (grid %d)\n", hipGetErrorString(e), grid);
}
```

```cpp
#include <hip/hip_runtime.h>
#include <hip/hip_cooperative_groups.h>
#include <cstdio>
#include <cstdint>
namespace cg = cooperative_groups;

constexpr int DM = 1024;
constexpr int NB = 8, SEQ = 2048, NMETA = 16;
constexpr int NTOK = NB * SEQ;
constexpr int MROWS = 16512;
constexpr int NIN = 3584;
constexpr int TPOS = NMETA + SEQ;
constexpr float EPS = 1e-6f;
constexpr float QSCALE = 0.125f * 1.4426950408889634f;
constexpr int NEXP = 16384;
constexpr int NTHR = 512;

constexpr size_t MiB = 1u << 20;
constexpr size_t OFF_CTL = 0, CTL_BYTES = 64 * 1024;
constexpr size_t OFF_MISC = 512 * 1024;
constexpr size_t OFF_ROPE = 1 * MiB;
constexpr size_t OFF_WOUT = 2 * MiB;
constexpr size_t OFF_WQ = 4 * MiB;
constexpr size_t OFF_KEYS = 8 * MiB;
constexpr size_t OFF_SSQP = 8 * MiB + 512 * 1024;
constexpr size_t OFF_UB = 9 * MiB;
constexpr size_t OFF_VB = 41 * MiB;
constexpr size_t OFF_XN = 73 * MiB;
constexpr size_t OFF_MIX = 73 * MiB;
constexpr size_t OFF_WIN = 106 * MiB;
constexpr size_t OFF_QB = 113 * MiB;
constexpr size_t OFF_KB = OFF_QB + 16 * MiB + 256 * 1024;
constexpr size_t OFF_VT = OFF_KB + 16 * MiB + 256 * 1024;
constexpr size_t OFF_H2B = 113 * MiB;
constexpr size_t OFF_GQ = 162 * MiB;
constexpr size_t OFF_GK = OFF_GQ + 8 * MiB + 256 * 1024;
constexpr size_t OFF_GVT = OFF_GK + 8 * MiB + 256 * 1024;
constexpr size_t OFF_GF = OFF_GVT + 16 * MiB + 256 * 1024;
constexpr size_t OFF_GB = OFF_GF + 16 * MiB + 256 * 1024;
constexpr size_t OFF_GR = OFF_GB + 16 * MiB + 256 * 1024;
constexpr size_t OFF_IDX = 162 * MiB;
constexpr size_t OFF_GATE = 171 * MiB;
constexpr size_t WS_END = OFF_GR + 16 * MiB + 256 * 1024;
static_assert(WS_END <= 256 * MiB, "workspace map");
static_assert(OFF_VT + (size_t)512 * MROWS * 2 <= OFF_GQ, "map D");
static_assert(OFF_WIN + (size_t)NIN * DM * 2 <= OFF_QB, "map C");

constexpr int LDS_BYTES = 147456;

typedef unsigned short bf16_t;
typedef float f32x4 __attribute__((ext_vector_type(4)));
typedef float f32x2 __attribute__((ext_vector_type(2)));
typedef unsigned u32x4 __attribute__((ext_vector_type(4)));
typedef unsigned u32x2 __attribute__((ext_vector_type(2)));
typedef __bf16 bf16x2_t __attribute__((ext_vector_type(2)));

struct Params {
    const float* in[21];
    float* out;
    unsigned char* ws;
    int ph_lo, ph_hi;
};

__device__ __forceinline__ unsigned f2bf(float f) { unsigned u = __float_as_uint(f); return (u + 0x7fffu + ((u >> 16) & 1u)) >> 16; }
__device__ __forceinline__ float bf2f(unsigned h) { return __uint_as_float(h << 16); }
__device__ __forceinline__ unsigned pk2(float lo, float hi) { return __builtin_bit_cast(unsigned, __builtin_convertvector((f32x2){lo, hi}, bf16x2_t)); }
__device__ __forceinline__ float bflo(unsigned w) { return __uint_as_float(w << 16); }
__device__ __forceinline__ float bfhi(unsigned w) { return __uint_as_float(w & 0xffff0000u); }
__device__ __forceinline__ float dot2(unsigned a, unsigned b, float c) {
    return __builtin_amdgcn_fdot2_f32_bf16(__builtin_bit_cast(bf16x2_t, a), __builtin_bit_cast(bf16x2_t, b), c, false);
}
__device__ __forceinline__ float dot8(u32x4 a, u32x4 b, float c) { c = dot2(a.x, b.x, c); c = dot2(a.y, b.y, c); c = dot2(a.z, b.z, c); return dot2(a.w, b.w, c); }
__device__ __forceinline__ float wave_sum(float v) {
#pragma unroll
    for (int o = 1; o < 64; o <<= 1) v += __shfl_xor(v, o);
    return v;
}
__device__ __forceinline__ float wave_max(float v) {
#pragma unroll
    for (int o = 1; o < 64; o <<= 1) v = fmaxf(v, __shfl_xor(v, o));
    return v;
}
__device__ __forceinline__ float silu_f(float x) { return x / (1.f + __expf(-x)); }
__device__ __forceinline__ float logsig_f(float x) { return fminf(x, 0.f) - log1pf(__expf(-fabsf(x))); }
__device__ __forceinline__ float gelu_f(float x) { return 0.5f * x * (1.f + erff(x * 0.70710678118654752f)); }

__device__ __forceinline__ float win_src(const Params& p, int k, int n) {
    const float* W = p.in[3] + (size_t)k * 3104;
    if (n < 1024) {
        const int base = n & ~63, dp = n & 63, d = dp < 16 ? ((dp >> 1) + 8 * (dp & 1)) : dp;
        return W[base + d];
    } else if (n < 3072) return W[n];
    const int j = (n - 3072) & 255, dir = (n - 3072) >> 8;
    const float* w2 = p.in[dir ? 11 : 9];
    const float* wz = W + 3072 + dir * 16;
    float s = 0.f;
#pragma unroll
    for (int r = 0; r < 16; ++r) s += wz[r] * w2[r * 256 + j];
    return s;
}

template <int WHICH>
__device__ __forceinline__ void p0_transpose_item(const Params& p, float* scr, int item, int lane) {
    constexpr int N = WHICH == 0 ? NIN : (WHICH == 1 ? 1024 : 2048);
    constexpr int nblk = N / 32;
    const int kb = item / nblk, nb = item % nblk, k0 = 64 * kb, n0 = 32 * nb;
    bf16_t* WT = (bf16_t*)(p.ws + (WHICH == 0 ? OFF_WIN : (WHICH == 1 ? OFF_WOUT : OFF_WQ)));
#pragma unroll 4
    for (int i = 0; i < 32; ++i) {
        const int kk = 2 * i + (lane >> 5), k = k0 + kk, n = n0 + (lane & 31);
        float v;
        if (WHICH == 0) v = win_src(p, k, n);
        else if (WHICH == 1) v = p.in[14][(size_t)k * 1024 + n];
        else v = p.in[16][(size_t)k * 2048 + n] * p.in[15][k];
        scr[kk * 33 + (lane & 31)] = v;
    }
    __builtin_amdgcn_s_waitcnt(0xC07F); __builtin_amdgcn_wave_barrier();
    const int c = lane & 7;
#pragma unroll
    for (int j = 0; j < 4; ++j) {
        const int n = (lane >> 3) + 8 * j; const float* s = scr + (8 * c) * 33 + n;
        u32x4 o; o.x = pk2(s[0 * 33], s[1 * 33]); o.y = pk2(s[2 * 33], s[3 * 33]); o.z = pk2(s[4 * 33], s[5 * 33]); o.w = pk2(s[6 * 33], s[7 * 33]);
        *(u32x4*)(WT + (size_t)(n0 + n) * 1024 + k0 + 8 * c) = o;
    }
    __builtin_amdgcn_s_waitcnt(0xC07F); __builtin_amdgcn_wave_barrier();
}

__device__ __forceinline__ void phase0(const Params& p, unsigned char* lds) {
    const int tid = threadIdx.x, lane = tid & 63, wave = tid >> 6;
    const int gw = blockIdx.x * 8 + wave, NGW = gridDim.x * 8;
    const long gt = (long)blockIdx.x * NTHR + tid, NGT = (long)gridDim.x * NTHR;
    {
        const f32x4* lw = (const f32x4*)p.in[2];
        bf16_t* XN = (bf16_t*)(p.ws + OFF_XN);
        for (int r = gw; r < MROWS; r += NGW) {
            const float* src = r < NTOK ? p.in[0] + (size_t)r * DM : (r < NTOK + NMETA ? p.in[1] + (size_t)(r - NTOK) * DM : nullptr);
            f32x4 v[4]; float s = 0.f;
#pragma unroll
            for (int j = 0; j < 4; ++j) { v[j] = src ? ((const f32x4*)src)[lane + 64 * j] : (f32x4){0.f, 0.f, 0.f, 0.f}; s += v[j].x * v[j].x + v[j].y * v[j].y + v[j].z * v[j].z + v[j].w * v[j].w; }
            const float rs = rsqrtf(wave_sum(s) * (1.f / DM) + EPS);
#pragma unroll
            for (int j = 0; j < 4; ++j) { const f32x4 w = lw[lane + 64 * j]; u32x2 o; o.x = pk2(v[j].x * rs * w.x, v[j].y * rs * w.y); o.y = pk2(v[j].z * rs * w.z, v[j].w * rs * w.w);
                *(u32x2*)(XN + (size_t)r * DM + 4 * (lane + 64 * j)) = o; }
        }
    }
    {
        float* scr = (float*)lds + wave * (64 * 33);
        constexpr int I0 = 16 * (NIN / 32), I1 = 16 * 32, I2 = 16 * 64;
        for (int it = gw; it < I0 + I1 + I2; it += NGW) {
            if (it < I0) p0_transpose_item<0>(p, scr, it, lane);
            else if (it < I0 + I1) p0_transpose_item<1>(p, scr, it - I0, lane);
            else p0_transpose_item<2>(p, scr, it - I0 - I1, lane);
        }
    }
    {
        bf16_t* KEYS = (bf16_t*)(p.ws + OFF_KEYS); bf16_t* UB = (bf16_t*)(p.ws + OFF_UB); bf16_t* VB = (bf16_t*)(p.ws + OFF_VB);
        const long NK8 = 262144 / 8, NU8 = (long)NEXP * DM / 8;
        for (long i = gt; i < NK8 + 2 * NU8; i += NGT) {
            const float* src; bf16_t* dst; long e; bool scale = false;
            if (i < NK8) { src = p.in[17]; dst = KEYS; e = i * 8; }
            else if (i < NK8 + NU8) { src = p.in[18]; dst = UB; e = (i - NK8) * 8; scale = true; }
            else { src = p.in[19]; dst = VB; e = (i - NK8 - NU8) * 8; }
            f32x4 a = *(const f32x4*)(src + e), b = *(const f32x4*)(src + e + 4);
            if (scale) { const f32x4 wa = *(const f32x4*)(p.in[15] + (e & 1023)), wb = *(const f32x4*)(p.in[15] + (e & 1023) + 4); a *= wa; b *= wb; }
            u32x4 o; o.x = pk2(a.x, a.y); o.y = pk2(a.z, a.w); o.z = pk2(b.x, b.y); o.w = pk2(b.z, b.w);
            *(u32x4*)(dst + e) = o;
        }
    }
    {
        f32x2* rope = (f32x2*)(p.ws + OFF_ROPE);
        for (long i = gt; i < TPOS * 8; i += NGT) {
            const int t = (int)(i >> 3), j = (int)(i & 7);
            const float inv = powf(500000.0f, -(float)j * 0.125f);
            const float ang = (float)t * inv;
            rope[i] = (f32x2){cosf(ang), sinf(ang)};
        }
        if (gt == 0) {
            float a = 0.f, b = 0.f;
            for (int i = 0; i < 64; ++i) { a += p.in[4][i] * p.in[5][i]; b += p.in[6][i] * p.in[7][i]; }
            ((float*)(p.ws + OFF_MISC))[0] = expf(a) - expf(b) + 0.2f;
        }
    }
}

__device__ __forceinline__ void p1_store(const Params& p, int row, int n0, float v0, float v1, float v2, float v3) {
    if (n0 < 1024) {
        const int dp = n0 & 63;
        if (dp < 16) {
            const int pos = row < NTOK ? NMETA + (row & (SEQ - 1)) : (row - NTOK);
            const f32x4 cs = *(const f32x4*)((const float*)(p.ws + OFF_ROPE) + ((size_t)pos * 8 + (dp >> 1)) * 2);
            const float a0 = v0 * cs.x - v1 * cs.y, b0 = v1 * cs.x + v0 * cs.y;
            const float a1 = v2 * cs.z - v3 * cs.w, b1 = v3 * cs.z + v2 * cs.w;
            v0 = a0; v1 = b0; v2 = a1; v3 = b1;
        }
        if (n0 < 512) { u32x2 o; o.x = pk2(v0 * QSCALE, v1 * QSCALE); o.y = pk2(v2 * QSCALE, v3 * QSCALE); *(u32x2*)((bf16_t*)(p.ws + OFF_QB) + (size_t)row * 512 + n0) = o; }
        else { u32x2 o; o.x = pk2(v0, v1); o.y = pk2(v2, v3); *(u32x2*)((bf16_t*)(p.ws + OFF_KB) + (size_t)row * 512 + (n0 - 512)) = o; }
    } else if (n0 < 1536) {
        bf16_t* VT = (bf16_t*)(p.ws + OFF_VT) + (size_t)(n0 - 1024) * MROWS + row;
        VT[0] = (bf16_t)f2bf(v0); VT[MROWS] = (bf16_t)f2bf(v1); VT[2 * MROWS] = (bf16_t)f2bf(v2); VT[3 * (size_t)MROWS] = (bf16_t)f2bf(v3);
    } else if (n0 < 1792) {
        u32x2 o; o.x = pk2(v0 * 0.125f, v1 * 0.125f); o.y = pk2(v2 * 0.125f, v3 * 0.125f); *(u32x2*)((bf16_t*)(p.ws + OFF_GQ) + (size_t)row * 256 + (n0 - 1536)) = o;
    } else if (n0 < 2048) {
        u32x2 o; o.x = pk2(v0, v1); o.y = pk2(v2, v3); *(u32x2*)((bf16_t*)(p.ws + OFF_GK) + (size_t)row * 256 + (n0 - 1792)) = o;
    } else if (n0 < 2560) {
        bf16_t* VT = (bf16_t*)(p.ws + OFF_GVT) + (size_t)(n0 - 2048) * MROWS + row;
        VT[0] = (bf16_t)f2bf(v0); VT[MROWS] = (bf16_t)f2bf(v1); VT[2 * MROWS] = (bf16_t)f2bf(v2); VT[3 * (size_t)MROWS] = (bf16_t)f2bf(v3);
    } else if (n0 < 3072) {
        u32x2 o; o.x = pk2(silu_f(v0), silu_f(v1)); o.y = pk2(silu_f(v2), silu_f(v3)); *(u32x2*)((bf16_t*)(p.ws + OFF_GR) + (size_t)row * 512 + (n0 - 2560)) = o;
    } else {
        const int dir = (n0 - 3072) >> 8, j = (n0 - 3072) & 255;
        const f32x4 bb = *(const f32x4*)(p.in[dir ? 12 : 10] + j);
        f32x4 o; o.x = logsig_f(v0 + bb.x) * 0.0625f; o.y = logsig_f(v1 + bb.y) * 0.0625f; o.z = logsig_f(v2 + bb.z) * 0.0625f; o.w = logsig_f(v3 + bb.w) * 0.0625f;
        *(f32x4*)((float*)(p.ws + (dir ? OFF_GB : OFF_GF)) + (size_t)row * 256 + j) = o;
    }
}

__device__ __forceinline__ void phase1_naive(const Params& p) {
    const long gt = (long)blockIdx.x * NTHR + threadIdx.x, NGT = (long)gridDim.x * NTHR;
    const bf16_t* XN = (const bf16_t*)(p.ws + OFF_XN); const bf16_t* WT = (const bf16_t*)(p.ws + OFF_WIN);
    for (long it = gt; it < (long)MROWS * (NIN / 4); it += NGT) {
        const int row = (int)(it / (NIN / 4)), n0 = (int)(it % (NIN / 4)) * 4;
        const u32x4* a = (const u32x4*)(XN + (size_t)row * DM);
        const u32x4* w0 = (const u32x4*)(WT + (size_t)n0 * DM);
        float c0 = 0.f, c1 = 0.f, c2 = 0.f, c3 = 0.f;
        for (int kc = 0; kc < 128; ++kc) { const u32x4 av = a[kc]; c0 = dot8(av, w0[kc], c0); c1 = dot8(av, w0[kc + 128], c1); c2 = dot8(av, w0[kc + 256], c2); c3 = dot8(av, w0[kc + 384], c3); }
        p1_store(p, row, n0, c0, c1, c2, c3);
    }
}


#define LAS __attribute__((address_space(3)))
typedef short bf16x8 __attribute__((ext_vector_type(8)));
constexpr int GBUF = 49152;

template <int ROWS>
__device__ __forceinline__ void stage_tile(const bf16_t* G, int ldk, int r0, int k0, LAS unsigned char* buf, int wave, int lane) {
    const int rr = lane >> 3, c = (lane & 7) ^ rr;
#pragma unroll
    for (int i = 0; i < ROWS / 64; ++i) {
        const int grp = wave + 8 * i;
        const bf16_t* src = G + (size_t)(r0 + grp * 8 + rr) * ldk + k0 + c * 8;
        __builtin_amdgcn_global_load_lds((const unsigned*)src, (LAS unsigned*)(buf + grp * 1024), 16, 0, 0);
    }
}
__device__ __forceinline__ bf16x8 ldfrag(const LAS unsigned char* buf, int row, int c) {
    return *(const LAS bf16x8*)(buf + row * 128 + ((c ^ (row & 7)) << 4));
}
template <bool SWAP>
__device__ __forceinline__ void gemm_tile_256(const bf16_t* A, const bf16_t* Bt, int K, int m0, int n0, LAS unsigned char* lds, f32x4 (&acc)[4][4]) {
    const int tid = threadIdx.x, lane = tid & 63, wave = __builtin_amdgcn_readfirstlane(tid >> 6), wm = wave >> 2, wn = wave & 3, l15 = lane & 15, g = lane >> 4;
#pragma unroll
    for (int i = 0; i < 4; ++i)
#pragma unroll
        for (int j = 0; j < 4; ++j) acc[i][j] = (f32x4){0.f, 0.f, 0.f, 0.f};
    const int nk = K / 64;
    stage_tile<128>(A, K, m0, 0, lds, wave, lane);
    stage_tile<256>(Bt, K, n0, 0, lds + 16384, wave, lane);
    for (int kt = 0; kt < nk; ++kt) {
        asm volatile("s_waitcnt vmcnt(0)" ::: "memory");
        __syncthreads();
        if (kt + 1 < nk) {
            LAS unsigned char* nb = lds + ((kt + 1) & 1) * GBUF;
            stage_tile<128>(A, K, m0, (kt + 1) * 64, nb, wave, lane);
            stage_tile<256>(Bt, K, n0, (kt + 1) * 64, nb + 16384, wave, lane);
        }
        const LAS unsigned char* a = lds + (kt & 1) * GBUF; const LAS unsigned char* b = a + 16384;
#pragma unroll
        for (int ks = 0; ks < 2; ++ks) {
            bf16x8 af[4], bfr[4];
#pragma unroll
            for (int i = 0; i < 4; ++i) { af[i] = ldfrag(a, wm * 64 + i * 16 + l15, ks * 4 + g); bfr[i] = ldfrag(b, wn * 64 + i * 16 + l15, ks * 4 + g); }
#pragma unroll
            for (int i = 0; i < 4; ++i)
#pragma unroll
                for (int j = 0; j < 4; ++j)
                    acc[i][j] = SWAP ? __builtin_amdgcn_mfma_f32_16x16x32_bf16(af[i], bfr[j], acc[i][j], 0, 0, 0)
                                     : __builtin_amdgcn_mfma_f32_16x16x32_bf16(bfr[j], af[i], acc[i][j], 0, 0, 0);
        }
    }
}
__device__ __forceinline__ int vcu_of_block() { const int G = gridDim.x, bx = blockIdx.x; return (G % 8 == 0) ? (bx % 8) * (G / 8) + bx / 8 : bx; }

__device__ __forceinline__ void phase1_mfma(const Params& p, LAS unsigned char* lds) {
    const int tid = threadIdx.x, lane = tid & 63, wave = __builtin_amdgcn_readfirstlane(tid >> 6), wm = wave >> 2, wn = wave & 3, l15 = lane & 15, g = lane >> 4;
    const bf16_t* XN = (const bf16_t*)(p.ws + OFF_XN); const bf16_t* WT = (const bf16_t*)(p.ws + OFF_WIN);
    constexpr int NTN = NIN / 256, NTM = MROWS / 128;
    for (int t = vcu_of_block(); t < NTM * NTN; t += gridDim.x) {
        const int m0 = (t / NTN) * 128, n0 = (t % NTN) * 256;
        const bool vtype = (n0 >= 1024 && n0 < 1536) || (n0 >= 2048 && n0 < 2560);
        f32x4 acc[4][4];
        if (vtype) {
            gemm_tile_256<true>(XN, WT, DM, m0, n0, lds, acc);
            bf16_t* base = (bf16_t*)(p.ws + (n0 < 1536 ? OFF_VT : OFF_GVT)) + (size_t)((n0 < 1536 ? n0 - 1024 : n0 - 2048) + wn * 64 + l15) * MROWS + m0 + wm * 64 + 4 * g;
#pragma unroll
            for (int i = 0; i < 4; ++i)
#pragma unroll
                for (int j = 0; j < 4; ++j) { u32x2 o; o.x = pk2(acc[i][j][0], acc[i][j][1]); o.y = pk2(acc[i][j][2], acc[i][j][3]); *(u32x2*)(base + (size_t)(j * 16) * MROWS + i * 16) = o; }
        } else {
            gemm_tile_256<false>(XN, WT, DM, m0, n0, lds, acc);
#pragma unroll
            for (int i = 0; i < 4; ++i)
#pragma unroll
                for (int j = 0; j < 4; ++j) p1_store(p, m0 + wm * 64 + i * 16 + l15, n0 + wn * 64 + j * 16 + 4 * g, acc[i][j][0], acc[i][j][1], acc[i][j][2], acc[i][j][3]);
        }
    }
}

__device__ __forceinline__ void phase3_mfma(const Params& p, LAS unsigned char* lds) {
    const int tid = threadIdx.x, lane = tid & 63, wave = __builtin_amdgcn_readfirstlane(tid >> 6), wm = wave >> 2, wn = wave & 3, l15 = lane & 15, g = lane >> 4;
    const bf16_t* MIX = (const bf16_t*)(p.ws + OFF_MIX); const bf16_t* WT = (const bf16_t*)(p.ws + OFF_WOUT);
    bf16_t* H2B = (bf16_t*)(p.ws + OFF_H2B); float* SSQ = (float*)(p.ws + OFF_SSQP);
    LAS float* sred = (LAS float*)(lds + 2 * GBUF);
    for (int t = vcu_of_block(); t < 128 * 4; t += gridDim.x) {
        const int m0 = (t >> 2) * 128, nt_ = t & 3, n0 = nt_ * 256;
        f32x4 acc[4][4];
        gemm_tile_256<false>(MIX, WT, DM, m0, n0, lds, acc);
#pragma unroll
        for (int i = 0; i < 4; ++i) {
            const int row = m0 + wm * 64 + i * 16 + l15; float ss = 0.f;
#pragma unroll
            for (int j = 0; j < 4; ++j) {
                const int n = n0 + wn * 64 + j * 16 + 4 * g;
                const f32x4 hv = *(const f32x4*)(p.in[0] + (size_t)row * DM + n) + acc[i][j];
                *(f32x4*)(p.out + (size_t)row * DM + n) = hv;
                u32x2 o; o.x = pk2(hv.x, hv.y); o.y = pk2(hv.z, hv.w); *(u32x2*)(H2B + (size_t)row * DM + n) = o;
                ss += hv.x * hv.x + hv.y * hv.y + hv.z * hv.z + hv.w * hv.w;
            }
            ss += __shfl_xor(ss, 16); ss += __shfl_xor(ss, 32);
            if (g == 0) sred[(wm * 64 + i * 16 + l15) * 4 + wn] = ss;
        }
        __syncthreads();
        if (tid < 128) SSQ[(size_t)(m0 + tid) * 4 + nt_] = (sred[tid * 4] + sred[tid * 4 + 1]) + (sred[tid * 4 + 2] + sred[tid * 4 + 3]);
        __syncthreads();
    }
}

__device__ __forceinline__ void phase2_attn_naive(const Params& p, unsigned char* lds) {
    const int tid = threadIdx.x, lane = tid & 63, wave = tid >> 6;
    const int gw = blockIdx.x * 8 + wave, NGW = gridDim.x * 8;
    const bf16_t* QB = (const bf16_t*)(p.ws + OFF_QB); const bf16_t* KB = (const bf16_t*)(p.ws + OFF_KB); const bf16_t* VT = (const bf16_t*)(p.ws + OFF_VT);
    bf16_t* MIX = (bf16_t*)(p.ws + OFF_MIX);
    const float lam = ((const float*)(p.ws + OFF_MISC))[0];
    float* wl = (float*)lds + wave * 64;
    for (int it = gw; it < NB * 4 * SEQ; it += NGW) {
        const int q = it & (SEQ - 1), h = (it >> 11) & 3, b = it >> 13;
        const int row = b * SEQ + q;
        u32x4 qv[16];
#pragma unroll
        for (int i = 0; i < 16; ++i) qv[i] = *(const u32x4*)(QB + (size_t)row * 512 + h * 128 + 8 * i);
        float m0 = -1e30f, m1 = -1e30f, l0 = 0.f, l1 = 0.f;
        for (int kc = 0; kc < 33; ++kc) {
            const bool valid = kc < 32 || lane < 16;
            const int krow = kc < 32 ? b * SEQ + kc * 64 + lane : NTOK + lane;
            const u32x4* kp = (const u32x4*)(KB + (size_t)krow * 512 + h * 128);
            float s0 = 0.f, s1 = 0.f;
#pragma unroll
            for (int i = 0; i < 8; ++i) { s0 = dot8(qv[i], kp[i], s0); s1 = dot8(qv[8 + i], kp[8 + i], s1); }
            if (valid) {
                const float n0 = fmaxf(m0, s0), n1 = fmaxf(m1, s1);
                l0 = l0 * exp2f(m0 - n0) + exp2f(s0 - n0); m0 = n0;
                l1 = l1 * exp2f(m1 - n1) + exp2f(s1 - n1); m1 = n1;
            }
        }
        const float M0 = wave_max(m0), M1 = wave_max(m1);
        const float L0 = wave_sum(l0 * exp2f(m0 - M0)), L1 = wave_sum(l1 * exp2f(m1 - M1));
        const float i0 = 1.f / L0, i1 = lam / L1;
        float o0 = 0.f, o1 = 0.f;
        const bf16_t* vp0 = VT + (size_t)(h * 128 + lane) * MROWS; const bf16_t* vp1 = vp0 + (size_t)64 * MROWS;
        for (int kc = 0; kc < 33; ++kc) {
            const bool valid = kc < 32 || lane < 16;
            const int kbase = kc < 32 ? b * SEQ + kc * 64 : NTOK;
            const u32x4* kp = (const u32x4*)(KB + (size_t)(kbase + lane) * 512 + h * 128);
            float s0 = 0.f, s1 = 0.f;
#pragma unroll
            for (int i = 0; i < 8; ++i) { s0 = dot8(qv[i], kp[i], s0); s1 = dot8(qv[8 + i], kp[8 + i], s1); }
            const float a = valid ? exp2f(s0 - M0) * i0 - exp2f(s1 - M1) * i1 : 0.f;
            __builtin_amdgcn_wave_barrier();
            wl[lane] = a;
            __builtin_amdgcn_s_waitcnt(0xC07F); __builtin_amdgcn_wave_barrier();
#pragma unroll 2
            for (int k8 = 0; k8 < 8; ++k8) {
                const u32x4 va = *(const u32x4*)(vp0 + kbase + 8 * k8), vb = *(const u32x4*)(vp1 + kbase + 8 * k8);
                const f32x4 w0 = *(const f32x4*)(wl + 8 * k8), w1 = *(const f32x4*)(wl + 8 * k8 + 4);
                o0 += w0.x * bflo(va.x) + w0.y * bfhi(va.x) + w0.z * bflo(va.y) + w0.w * bfhi(va.y) + w1.x * bflo(va.z) + w1.y * bfhi(va.z) + w1.z * bflo(va.w) + w1.w * bfhi(va.w);
                o1 += w0.x * bflo(vb.x) + w0.y * bfhi(vb.x) + w0.z * bflo(vb.y) + w0.w * bfhi(vb.y) + w1.x * bflo(vb.z) + w1.y * bfhi(vb.z) + w1.z * bflo(vb.w) + w1.w * bfhi(vb.w);
            }
            __builtin_amdgcn_s_waitcnt(0xC07F);
        }
        const float rs = rsqrtf(wave_sum(o0 * o0 + o1 * o1) * (1.f / 128.f) + EPS) * 0.8f;
        MIX[(size_t)row * DM + h * 128 + lane] = (bf16_t)f2bf(o0 * rs * p.in[8][lane]);
        MIX[(size_t)row * DM + h * 128 + 64 + lane] = (bf16_t)f2bf(o1 * rs * p.in[8][64 + lane]);
    }
}


typedef float f32x16 __attribute__((ext_vector_type(16)));
constexpr int AT_KROW = 272, AT_VROW = 136, AT_KBYTES = 64 * AT_KROW, AT_VBYTES = 128 * AT_VROW, AT_STAGE = AT_KBYTES + AT_VBYTES;
__device__ __forceinline__ void attn_item(const Params& p, LAS unsigned char* lds, int item) {
    const int tid = threadIdx.x, lane = tid & 63, wave = __builtin_amdgcn_readfirstlane(tid >> 6), qg = wave >> 1, c = wave & 1, l31 = lane & 31, hh = lane >> 5;
    const int qt = item & 15, h = (item >> 4) & 3, b = item >> 6;
    const int r0 = b * SEQ + qt * 128;
    const bf16_t* QB = (const bf16_t*)(p.ws + OFF_QB); const bf16_t* KB = (const bf16_t*)(p.ws + OFF_KB); const bf16_t* VT = (const bf16_t*)(p.ws + OFF_VT);
    bf16x8 qf[4];
    {
        const bf16_t* qp = QB + (size_t)(r0 + qg * 32 + l31) * 512 + h * 128 + c * 64 + 8 * hh;
#pragma unroll
        for (int s = 0; s < 4; ++s) qf[s] = *(const bf16x8*)(qp + 16 * s);
    }
    f32x16 O[4];
#pragma unroll
    for (int i = 0; i < 4; ++i)
#pragma unroll
        for (int r = 0; r < 16; ++r) O[i][r] = 0.f;
    float m = -1e30f, l = 0.f;
    const int kq0 = tid, kq1 = tid + 512;
    const bf16_t* kg0 = KB + (size_t)(kq0 >> 4) * 512 + h * 128 + (kq0 & 15) * 8; const bf16_t* kg1 = KB + (size_t)(kq1 >> 4) * 512 + h * 128 + (kq1 & 15) * 8;
    const bf16_t* vg0 = VT + (size_t)(h * 128 + (kq0 >> 3)) * MROWS + (kq0 & 7) * 8; const bf16_t* vg1 = VT + (size_t)(h * 128 + (kq1 >> 3)) * MROWS + (kq1 & 7) * 8;
    const int kl0 = (kq0 >> 4) * AT_KROW + (kq0 & 15) * 16, kl1 = (kq1 >> 4) * AT_KROW + (kq1 & 15) * 16;
    const int vl0 = AT_KBYTES + (kq0 >> 3) * AT_VROW + (kq0 & 7) * 16, vl1 = AT_KBYTES + (kq1 >> 3) * AT_VROW + (kq1 & 7) * 16;
    u32x4 kr0, kr1, vr0, vr1;
#define AT_LOAD(t) do { const size_t kro = (size_t)((t) < 32 ? b * SEQ + (t) * 64 : NTOK); \
        kr0 = *(const u32x4*)(kg0 + kro * 512); kr1 = *(const u32x4*)(kg1 + kro * 512); vr0 = *(const u32x4*)(vg0 + kro); vr1 = *(const u32x4*)(vg1 + kro); } while (0)
#define AT_WRITE(buf) do { LAS unsigned char* _b = lds + (buf) * AT_STAGE; \
        *(LAS u32x4*)(_b + kl0) = kr0; *(LAS u32x4*)(_b + kl1) = kr1; \
        *(LAS u32x2*)(_b + vl0) = (u32x2){vr0.x, vr0.y}; *(LAS u32x2*)(_b + vl0 + 8) = (u32x2){vr0.z, vr0.w}; \
        *(LAS u32x2*)(_b + vl1) = (u32x2){vr1.x, vr1.y}; *(LAS u32x2*)(_b + vl1 + 8) = (u32x2){vr1.z, vr1.w}; } while (0)
    __syncthreads();
    AT_LOAD(0); AT_WRITE(0);
    __syncthreads();
    for (int t = 0; t < 33; ++t) {
        if (t + 1 < 33) AT_LOAD(t + 1);
        const LAS unsigned char* kb_ = lds + (t & 1) * AT_STAGE; const LAS unsigned char* vb_ = kb_ + AT_KBYTES;
        f32x16 s0, s1;
#pragma unroll
        for (int r = 0; r < 16; ++r) { s0[r] = 0.f; s1[r] = 0.f; }
#pragma unroll
        for (int s = 0; s < 4; ++s) {
            const bf16x8 k0 = *(const LAS bf16x8*)(kb_ + l31 * AT_KROW + (c * 64 + 16 * s + 8 * hh) * 2);
            const bf16x8 k1 = *(const LAS bf16x8*)(kb_ + (32 + l31) * AT_KROW + (c * 64 + 16 * s + 8 * hh) * 2);
            s0 = __builtin_amdgcn_mfma_f32_32x32x16_bf16(k0, qf[s], s0, 0, 0, 0);
            s1 = __builtin_amdgcn_mfma_f32_32x32x16_bf16(k1, qf[s], s1, 0, 0, 0);
        }
        if (t == 32) {
#pragma unroll
            for (int r = 0; r < 16; ++r) { const int key = (r & 3) + 8 * (r >> 2) + 4 * hh; if (key >= 16) s0[r] = -1e30f; s1[r] = -1e30f; }
        }
        float mx = s0[0];
#pragma unroll
        for (int r = 1; r < 16; ++r) mx = fmaxf(mx, s0[r]);
#pragma unroll
        for (int r = 0; r < 16; ++r) mx = fmaxf(mx, s1[r]);
        mx = fmaxf(mx, __shfl_xor(mx, 32));
        const float mn = fmaxf(m, mx), alpha = __builtin_amdgcn_exp2f(m - mn);
        m = mn; l *= alpha;
#pragma unroll
        for (int i = 0; i < 4; ++i) O[i] = O[i] * alpha;
        float ps = 0.f;
#pragma unroll
        for (int r = 0; r < 16; ++r) { s0[r] = __builtin_amdgcn_exp2f(s0[r] - mn); s1[r] = __builtin_amdgcn_exp2f(s1[r] - mn); ps += s0[r] + s1[r]; }
        l += ps;
        bf16x8 pf[2][2];
#pragma unroll
        for (int s2 = 0; s2 < 2; ++s2) {
            u32x4 a, bq;
            a.x = pk2(s0[8 * s2 + 0], s0[8 * s2 + 1]); a.y = pk2(s0[8 * s2 + 2], s0[8 * s2 + 3]); a.z = pk2(s0[8 * s2 + 4], s0[8 * s2 + 5]); a.w = pk2(s0[8 * s2 + 6], s0[8 * s2 + 7]);
            bq.x = pk2(s1[8 * s2 + 0], s1[8 * s2 + 1]); bq.y = pk2(s1[8 * s2 + 2], s1[8 * s2 + 3]); bq.z = pk2(s1[8 * s2 + 4], s1[8 * s2 + 5]); bq.w = pk2(s1[8 * s2 + 6], s1[8 * s2 + 7]);
            pf[0][s2] = __builtin_bit_cast(bf16x8, a); pf[1][s2] = __builtin_bit_cast(bf16x8, bq);
        }
#pragma unroll
        for (int vb = 0; vb < 4; ++vb)
#pragma unroll
            for (int kb = 0; kb < 2; ++kb)
#pragma unroll
                for (int s2 = 0; s2 < 2; ++s2) {
                    const LAS unsigned char* vp = vb_ + (vb * 32 + l31) * AT_VROW + (kb * 32 + 16 * s2 + 4 * hh) * 2;
                    const u32x2 lo = *(const LAS u32x2*)vp, hi = *(const LAS u32x2*)(vp + 16);
                    const bf16x8 vf = __builtin_bit_cast(bf16x8, (u32x4){lo.x, lo.y, hi.x, hi.y});
                    O[vb] = __builtin_amdgcn_mfma_f32_32x32x16_bf16(vf, pf[kb][s2], O[vb], 0, 0, 0);
                }
        if (t + 1 < 33) AT_WRITE((t + 1) & 1);
        __syncthreads();
    }
    const float inv = 1.f / (l + __shfl_xor(l, 32));
    LAS float* X = (LAS float*)lds + qg * 4096;
    if (c == 1) {
#pragma unroll
        for (int vb = 0; vb < 4; ++vb)
#pragma unroll
            for (int r = 0; r < 16; ++r) X[(vb * 16 + r) * 64 + lane] = O[vb][r] * inv;
    }
    __syncthreads();
    if (c == 0) {
        const float lam = ((const float*)(p.ws + OFF_MISC))[0];
        float ss = 0.f;
#pragma unroll
        for (int vb = 0; vb < 4; ++vb)
#pragma unroll
            for (int r = 0; r < 16; ++r) { const float y = O[vb][r] * inv - lam * X[(vb * 16 + r) * 64 + lane]; O[vb][r] = y; ss += y * y; }
        ss += __shfl_xor(ss, 32);
        const float rs = rsqrtf(ss * (1.f / 128.f) + EPS) * 0.8f;
        bf16_t* orow = (bf16_t*)(p.ws + OFF_MIX) + (size_t)(r0 + qg * 32 + l31) * DM + h * 128;
#pragma unroll
        for (int vb = 0; vb < 4; ++vb)
#pragma unroll
            for (int rq = 0; rq < 4; ++rq) {
                const int v0 = vb * 32 + 8 * rq + 4 * hh;
                const f32x4 w = *(const f32x4*)(p.in[8] + v0);
                u32x2 o; o.x = pk2(O[vb][4 * rq] * rs * w.x, O[vb][4 * rq + 1] * rs * w.y); o.y = pk2(O[vb][4 * rq + 2] * rs * w.z, O[vb][4 * rq + 3] * rs * w.w);
                *(u32x2*)(orow + v0) = o;
            }
    }
#undef AT_LOAD
#undef AT_WRITE
}
__device__ __forceinline__ void phase2_attn_mfma(const Params& p, LAS unsigned char* lds) {
    for (int it = vcu_of_block(); it < NB * 4 * 16; it += gridDim.x) attn_item(p, lds, it);
}

__device__ __forceinline__ void phase2_gla_naive(const Params& p) {
    const int tid = threadIdx.x, lane = tid & 63, wave = tid >> 6;
    const int gw = blockIdx.x * 8 + wave, NGW = gridDim.x * 8;
    const bf16_t* GQ = (const bf16_t*)(p.ws + OFF_GQ); const bf16_t* GK = (const bf16_t*)(p.ws + OFF_GK); const bf16_t* GVT = (const bf16_t*)(p.ws + OFF_GVT);
    for (int it = gw; it < NB * 4 * 2 * 8; it += NGW) {
        const int sl = it & 7, dir = (it >> 3) & 1, h = (it >> 4) & 3, b = it >> 6;
        const int dv = sl * 16 + (lane & 15), dkq = lane >> 4;
        const float* G = (const float*)(p.ws + (dir ? OFF_GB : OFF_GF));
        float* O = p.out + (dir ? (size_t)NTOK * 512 : 0);
        float S[16];
#pragma unroll
        for (int i = 0; i < 16; ++i) S[i] = 0.f;
        const int nsteps = dir ? SEQ : SEQ + NMETA;
        for (int st = 0; st < nsteps; ++st) {
            int row; bool outp = true;
            if (dir == 0) { if (st < NMETA) { row = NTOK + st; outp = false; } else row = b * SEQ + (st - NMETA); }
            else row = b * SEQ + (SEQ - 1 - st);
            const f32x4* gp = (const f32x4*)(G + (size_t)row * 256 + h * 64 + dkq * 16);
            const u32x4* kp = (const u32x4*)(GK + (size_t)row * 256 + h * 64 + dkq * 16);
            const u32x4* qp = (const u32x4*)(GQ + (size_t)row * 256 + h * 64 + dkq * 16);
            const float v = bf2f(GVT[(size_t)(h * 128 + dv) * MROWS + row]);
            float gg[16], kk[16], qq[16];
#pragma unroll
            for (int i = 0; i < 4; ++i) { const f32x4 t = gp[i]; gg[4 * i] = t.x; gg[4 * i + 1] = t.y; gg[4 * i + 2] = t.z; gg[4 * i + 3] = t.w; }
#pragma unroll
            for (int i = 0; i < 2; ++i) { const u32x4 t = kp[i], u = qp[i];
                kk[8 * i] = bflo(t.x); kk[8 * i + 1] = bfhi(t.x); kk[8 * i + 2] = bflo(t.y); kk[8 * i + 3] = bfhi(t.y); kk[8 * i + 4] = bflo(t.z); kk[8 * i + 5] = bfhi(t.z); kk[8 * i + 6] = bflo(t.w); kk[8 * i + 7] = bfhi(t.w);
                qq[8 * i] = bflo(u.x); qq[8 * i + 1] = bfhi(u.x); qq[8 * i + 2] = bflo(u.y); qq[8 * i + 3] = bfhi(u.y); qq[8 * i + 4] = bflo(u.z); qq[8 * i + 5] = bfhi(u.z); qq[8 * i + 6] = bflo(u.w); qq[8 * i + 7] = bfhi(u.w); }
            float o = 0.f;
#pragma unroll
            for (int i = 0; i < 16; ++i) { S[i] = S[i] * __expf(gg[i]) + kk[i] * v; o += qq[i] * S[i]; }
            o += __shfl_xor(o, 16); o += __shfl_xor(o, 32);
            if (outp && dkq == 0) O[(size_t)row * 512 + h * 128 + dv] = o;
        }
    }
}

__device__ __forceinline__ void phase2c(const Params& p) {
    const int tid = threadIdx.x, lane = tid & 63, wave = tid >> 6;
    const int gw = blockIdx.x * 8 + wave, NGW = gridDim.x * 8;
    const bf16_t* GR = (const bf16_t*)(p.ws + OFF_GR); bf16_t* MIX = (bf16_t*)(p.ws + OFF_MIX);
    const float* OF = p.out; const float* OBk = p.out + (size_t)NTOK * 512;
    const int c0 = lane * 8;
    const f32x4 w0 = *(const f32x4*)(p.in[13] + (c0 & 127)), w1 = *(const f32x4*)(p.in[13] + (c0 & 127) + 4);
    for (int r = gw; r < NTOK; r += NGW) {
        const f32x4 a0 = *(const f32x4*)(OF + (size_t)r * 512 + c0), a1 = *(const f32x4*)(OF + (size_t)r * 512 + c0 + 4);
        const f32x4 b0 = *(const f32x4*)(OBk + (size_t)r * 512 + c0), b1 = *(const f32x4*)(OBk + (size_t)r * 512 + c0 + 4);
        const f32x4 x0 = a0 + b0, x1 = a1 + b1;
        float s = x0.x * x0.x + x0.y * x0.y + x0.z * x0.z + x0.w * x0.w + x1.x * x1.x + x1.y * x1.y + x1.z * x1.z + x1.w * x1.w;
        s += __shfl_xor(s, 1); s += __shfl_xor(s, 2); s += __shfl_xor(s, 4); s += __shfl_xor(s, 8);
        const float rs = rsqrtf(s * (1.f / 128.f) + EPS);
        const u32x4 g = *(const u32x4*)(GR + (size_t)r * 512 + c0);
        u32x4 o;
        o.x = pk2(x0.x * rs * w0.x * bflo(g.x), x0.y * rs * w0.y * bfhi(g.x)); o.y = pk2(x0.z * rs * w0.z * bflo(g.y), x0.w * rs * w0.w * bfhi(g.y));
        o.z = pk2(x1.x * rs * w1.x * bflo(g.z), x1.y * rs * w1.y * bfhi(g.z)); o.w = pk2(x1.z * rs * w1.z * bflo(g.w), x1.w * rs * w1.w * bfhi(g.w));
        *(u32x4*)(MIX + (size_t)r * DM + 512 + c0) = o;
    }
}

__device__ __forceinline__ void phase3_naive(const Params& p) {
    const int tid = threadIdx.x, lane = tid & 63, wave = tid >> 6;
    const int gw = blockIdx.x * 8 + wave, NGW = gridDim.x * 8;
    const bf16_t* MIX = (const bf16_t*)(p.ws + OFF_MIX); const bf16_t* WT = (const bf16_t*)(p.ws + OFF_WOUT);
    bf16_t* H2B = (bf16_t*)(p.ws + OFF_H2B); float* SSQ = (float*)(p.ws + OFF_SSQP);
    for (int r = gw; r < NTOK; r += NGW) {
        const u32x4* a = (const u32x4*)(MIX + (size_t)r * DM);
        float ss = 0.f;
        for (int j = 0; j < 4; ++j) {
            const int n0 = 4 * (lane + 64 * j);
            const u32x4* w0 = (const u32x4*)(WT + (size_t)n0 * DM);
            float c0 = 0.f, c1 = 0.f, c2 = 0.f, c3 = 0.f;
            for (int kc = 0; kc < 128; ++kc) { const u32x4 av = a[kc]; c0 = dot8(av, w0[kc], c0); c1 = dot8(av, w0[kc + 128], c1); c2 = dot8(av, w0[kc + 256], c2); c3 = dot8(av, w0[kc + 384], c3); }
            const f32x4 xr = *(const f32x4*)(p.in[0] + (size_t)r * DM + n0);
            const f32x4 hv = (f32x4){xr.x + c0, xr.y + c1, xr.z + c2, xr.w + c3};
            *(f32x4*)(p.out + (size_t)r * DM + n0) = hv;
            u32x2 o; o.x = pk2(hv.x, hv.y); o.y = pk2(hv.z, hv.w); *(u32x2*)(H2B + (size_t)r * DM + n0) = o;
            ss += hv.x * hv.x + hv.y * hv.y + hv.z * hv.z + hv.w * hv.w;
        }
        ss = wave_sum(ss);
        if (lane < 4) SSQ[(size_t)r * 4 + lane] = lane == 0 ? ss : 0.f;
    }
}

#define INS16(LV, LI, xv, xi) do { float _v = (xv); int _i = (xi); \
    _Pragma("unroll") for (int _s = 0; _s < 16; ++_s) { const bool _g = _v > LV[_s]; const float _tv = LV[_s]; const int _ti = LI[_s]; \
        LV[_s] = _g ? _v : _tv; LI[_s] = _g ? _i : _ti; _v = _g ? _tv : _v; _i = _g ? _ti : _i; } } while (0)

__device__ __forceinline__ void phase4_naive(const Params& p, unsigned char* lds) {
    const int tid = threadIdx.x;
    float* hn = (float*)lds;
    float* qs = hn + 1024;
    float* sc = qs + 2048;
    float* tsv = sc + 2048;
    int* tsi = (int*)(tsv + 256);
    const bf16_t* H2B = (const bf16_t*)(p.ws + OFF_H2B); const bf16_t* WQ = (const bf16_t*)(p.ws + OFF_WQ); const bf16_t* KEYS = (const bf16_t*)(p.ws + OFF_KEYS);
    const float* SSQ = (const float*)(p.ws + OFF_SSQP);
    int* IDX = (int*)(p.ws + OFF_IDX); float* GATE = (float*)(p.ws + OFF_GATE);
    for (int r = blockIdx.x; r < NTOK; r += gridDim.x) {
        float ss = 0.f;
#pragma unroll
        for (int i = 0; i < 4; ++i) ss += SSQ[(size_t)r * 4 + i];
        const float rstd = rsqrtf(ss * (1.f / DM) + EPS);
        { const unsigned w = *(const unsigned*)(H2B + (size_t)r * DM + 2 * tid); hn[2 * tid] = bflo(w) * rstd; hn[2 * tid + 1] = bfhi(w) * rstd; }
        __syncthreads();
        for (int j = 0; j < 4; ++j) {
            const int n = tid + 512 * j; const u32x4* w = (const u32x4*)(WQ + (size_t)n * DM); float c = 0.f;
            for (int kc = 0; kc < 128; ++kc) { const u32x4 wv = w[kc]; const f32x4 h0 = *(const f32x4*)(hn + 8 * kc), h1 = *(const f32x4*)(hn + 8 * kc + 4);
                c += h0.x * bflo(wv.x) + h0.y * bfhi(wv.x) + h0.z * bflo(wv.y) + h0.w * bfhi(wv.y) + h1.x * bflo(wv.z) + h1.y * bfhi(wv.z) + h1.z * bflo(wv.w) + h1.w * bfhi(wv.w); }
            qs[n] = c;
        }
        __syncthreads();
        for (int j = 0; j < 4; ++j) {
            const int sidx = tid + 512 * j, hp = sidx >> 7; const u32x4* kp = (const u32x4*)(KEYS + (size_t)sidx * 128); const float* qq = qs + hp * 128; float c = 0.f;
            for (int kc = 0; kc < 16; ++kc) { const u32x4 wv = kp[kc]; const f32x4 h0 = *(const f32x4*)(qq + 8 * kc), h1 = *(const f32x4*)(qq + 8 * kc + 4);
                c += h0.x * bflo(wv.x) + h0.y * bfhi(wv.x) + h0.z * bflo(wv.y) + h0.w * bfhi(wv.y) + h1.x * bflo(wv.z) + h1.y * bfhi(wv.z) + h1.z * bflo(wv.w) + h1.w * bfhi(wv.w); }
            sc[sidx] = c;
        }
        __syncthreads();
        if (tid < 16) {
            float LV[16]; int LI[16];
#pragma unroll
            for (int s = 0; s < 16; ++s) { LV[s] = -3.0e38f; LI[s] = 0; }
            for (int k = 0; k < 128; ++k) INS16(LV, LI, sc[tid * 128 + k], k);
#pragma unroll
            for (int s = 0; s < 16; ++s) { tsv[tid * 16 + s] = LV[s]; tsi[tid * 16 + s] = LI[s]; }
        }
        __syncthreads();
        if (tid < 8) {
            float LV[16]; int LI[16];
#pragma unroll
            for (int s = 0; s < 16; ++s) { LV[s] = -3.0e38f; LI[s] = 0; }
            for (int c = 0; c < 256; ++c) INS16(LV, LI, tsv[(2 * tid) * 16 + (c >> 4)] + tsv[(2 * tid + 1) * 16 + (c & 15)], c);
            float den = 0.f, e[16];
#pragma unroll
            for (int s = 0; s < 16; ++s) { e[s] = __expf(LV[s] - LV[0]); den += e[s]; }
            const float inv = 1.f / den;
#pragma unroll
            for (int s = 0; s < 16; ++s) { const int c = LI[s];
                IDX[(size_t)r * 128 + tid * 16 + s] = tsi[(2 * tid) * 16 + (c >> 4)] * 128 + tsi[(2 * tid + 1) * 16 + (c & 15)];
                GATE[(size_t)r * 128 + tid * 16 + s] = e[s] * inv; }
        }
        __syncthreads();
    }
}


#define TOPK_INS(L, x) do { float _x = (x); _Pragma("unroll") for (int _s = 0; _s < 16; ++_s) { const float _t = fmaxf(L[_s], _x); _x = fminf(L[_s], _x); L[_s] = _t; } } while (0)
constexpr int P4_QROW = 528, P4_SC0 = 128 * P4_QROW  , P4_TLROW = 144;
__device__ __forceinline__ void phase4_mfma(const Params& p, LAS unsigned char* lds) {
    const int tid = threadIdx.x, lane = tid & 63, wave = __builtin_amdgcn_readfirstlane(tid >> 6), wm = wave >> 2, wn = wave & 3, l15 = lane & 15, g = lane >> 4;
    const bf16_t* H2B = (const bf16_t*)(p.ws + OFF_H2B); const bf16_t* WQ = (const bf16_t*)(p.ws + OFF_WQ); const bf16_t* KEYS = (const bf16_t*)(p.ws + OFF_KEYS);
    const float* SSQ = (const float*)(p.ws + OFF_SSQP);
    int* IDX = (int*)(p.ws + OFF_IDX); float* GATE = (float*)(p.ws + OFF_GATE);
    for (int it = vcu_of_block(); it < 128 * 8; it += gridDim.x) {
        const int m0 = (it >> 3) * 128, h = it & 7;
        {
            f32x4 acc[4][4];
            gemm_tile_256<false>(H2B, WQ, DM, m0, h * 256, lds, acc);
            __syncthreads();
#pragma unroll
            for (int i = 0; i < 4; ++i) {
                const int rl = wm * 64 + i * 16 + l15;
                const f32x4 sq = *(const f32x4*)(SSQ + (size_t)(m0 + rl) * 4);
                const float rstd = rsqrtf(((sq.x + sq.y) + (sq.z + sq.w)) * (1.f / DM) + EPS);
#pragma unroll
                for (int j = 0; j < 4; ++j) { u32x2 o; o.x = pk2(acc[i][j][0] * rstd, acc[i][j][1] * rstd); o.y = pk2(acc[i][j][2] * rstd, acc[i][j][3] * rstd);
                    *(LAS u32x2*)(lds + rl * P4_QROW + (wn * 64 + j * 16 + 4 * g) * 2) = o; }
            }
        }
        __syncthreads();
        {
            const int wr = wave >> 1, wk = wave & 1;
            f32x4 sc[2][2][4];
#pragma unroll
            for (int pp = 0; pp < 2; ++pp) {
#pragma unroll
                for (int rb = 0; rb < 2; ++rb)
#pragma unroll
                    for (int kk = 0; kk < 4; ++kk) sc[pp][rb][kk] = (f32x4){0.f, 0.f, 0.f, 0.f};
                const bf16_t* kbase = KEYS + (size_t)((h * 2 + pp) * 128 + 64 * wk + l15) * 128 + 8 * g;
#pragma unroll
                for (int ks = 0; ks < 4; ++ks) {
                    bf16x8 qf[2], kf[4];
#pragma unroll
                    for (int rb = 0; rb < 2; ++rb) qf[rb] = *(const LAS bf16x8*)(lds + (32 * wr + 16 * rb + l15) * P4_QROW + (pp * 128 + ks * 32 + 8 * g) * 2);
#pragma unroll
                    for (int kk = 0; kk < 4; ++kk) kf[kk] = *(const bf16x8*)(kbase + (size_t)(16 * kk) * 128 + ks * 32);
#pragma unroll
                    for (int rb = 0; rb < 2; ++rb)
#pragma unroll
                        for (int kk = 0; kk < 4; ++kk) sc[pp][rb][kk] = __builtin_amdgcn_mfma_f32_16x16x32_bf16(kf[kk], qf[rb], sc[pp][rb][kk], 0, 0, 0);
                }
            }
#pragma unroll
            for (int rb = 0; rb < 2; ++rb)
#pragma unroll
                for (int kk = 0; kk < 4; ++kk) *(LAS f32x4*)(lds + P4_SC0 + (32 * wr + 16 * rb + l15) * P4_QROW + (64 * wk + 16 * kk + 4 * g) * 4) = sc[0][rb][kk];
            __syncthreads();
#pragma unroll
            for (int rb = 0; rb < 2; ++rb)
#pragma unroll
                for (int kk = 0; kk < 4; ++kk) *(LAS f32x4*)(lds + (32 * wr + 16 * rb + l15) * P4_QROW + (64 * wk + 16 * kk + 4 * g) * 4) = sc[1][rb][kk];
        }
        __syncthreads();
        {
            const int hf = tid & 1, row = (tid >> 1) & 127, pp = tid >> 8;
            const LAS unsigned char* sp = lds + (pp ? 0 : P4_SC0) + row * P4_QROW + hf * 256;
            float L[16];
#pragma unroll
            for (int s = 0; s < 16; ++s) L[s] = -3.0e38f;
#pragma unroll 4
            for (int q4 = 0; q4 < 16; ++q4) {
                const f32x4 v = *(const LAS f32x4*)(sp + q4 * 16);
                const unsigned kb = (unsigned)(hf * 64 + q4 * 4);
                TOPK_INS(L, __uint_as_float((__float_as_uint(v.x) & ~127u) | kb));
                TOPK_INS(L, __uint_as_float((__float_as_uint(v.y) & ~127u) | (kb + 1)));
                TOPK_INS(L, __uint_as_float((__float_as_uint(v.z) & ~127u) | (kb + 2)));
                TOPK_INS(L, __uint_as_float((__float_as_uint(v.w) & ~127u) | (kb + 3)));
            }
            float Oth[16];
#pragma unroll
            for (int s = 0; s < 16; ++s) Oth[s] = __shfl_xor(L[s], 1);
#pragma unroll
            for (int s = 0; s < 16; ++s) TOPK_INS(L, Oth[s]);
            __syncthreads();
            if (hf == 0) {
                LAS f32x4* tl = (LAS f32x4*)(lds + P4_SC0 + row * (2 * P4_TLROW) + pp * P4_TLROW);
                tl[0] = (f32x4){L[0], L[1], L[2], L[3]}; tl[1] = (f32x4){L[4], L[5], L[6], L[7]}; tl[2] = (f32x4){L[8], L[9], L[10], L[11]}; tl[3] = (f32x4){L[12], L[13], L[14], L[15]};
            }
        }
        __syncthreads();
        if (tid < 128) {
            const LAS unsigned char* tl = lds + P4_SC0 + tid * (2 * P4_TLROW);
            float A[16], Bv[16];
#pragma unroll
            for (int q4 = 0; q4 < 4; ++q4) { const f32x4 a = *(const LAS f32x4*)(tl + q4 * 16), b = *(const LAS f32x4*)(tl + P4_TLROW + q4 * 16);
                A[4 * q4] = a.x; A[4 * q4 + 1] = a.y; A[4 * q4 + 2] = a.z; A[4 * q4 + 3] = a.w; Bv[4 * q4] = b.x; Bv[4 * q4 + 1] = b.y; Bv[4 * q4 + 2] = b.z; Bv[4 * q4 + 3] = b.w; }
#pragma unroll
            for (int s = 0; s < 16; ++s) { A[s] = __uint_as_float(__float_as_uint(A[s]) & ~127u); Bv[s] = __uint_as_float(__float_as_uint(Bv[s]) & ~127u); }
            float L[16];
#pragma unroll
            for (int s = 0; s < 16; ++s) L[s] = -3.0e38f;
#pragma unroll
            for (int i = 0; i < 16; ++i)
#pragma unroll
                for (int j = 0; j < 16; ++j)
                    if ((i + 1) * (j + 1) <= 16) TOPK_INS(L, __uint_as_float((__float_as_uint(A[i] + Bv[j]) & ~255u) | (unsigned)(i * 16 + j)));
            const float v0 = __uint_as_float(__float_as_uint(L[0]) & ~255u);
            float e[16], den = 0.f; int id[16];
#pragma unroll
            for (int s = 0; s < 16; ++s) {
                const unsigned u = __float_as_uint(L[s]);
                e[s] = __expf(__uint_as_float(u & ~255u) - v0); den += e[s];
                const unsigned i = (u >> 4) & 15u, j = u & 15u;
                const unsigned ka = *(const LAS unsigned*)(tl + i * 4) & 127u, kb = *(const LAS unsigned*)(tl + P4_TLROW + j * 4) & 127u;
                id[s] = (int)(ka * 128u + kb);
            }
            const float inv = 1.f / den;
            int* ip = IDX + (size_t)(m0 + tid) * 128 + h * 16; float* gp = GATE + (size_t)(m0 + tid) * 128 + h * 16;
#pragma unroll
            for (int q4 = 0; q4 < 4; ++q4) { *(int4*)(ip + 4 * q4) = make_int4(id[4 * q4], id[4 * q4 + 1], id[4 * q4 + 2], id[4 * q4 + 3]);
                *(f32x4*)(gp + 4 * q4) = (f32x4){e[4 * q4] * inv, e[4 * q4 + 1] * inv, e[4 * q4 + 2] * inv, e[4 * q4 + 3] * inv}; }
        }
        __syncthreads();
    }
}

__device__ __forceinline__ void phase5(const Params& p) {
    const int tid = threadIdx.x, lane = tid & 63, wave = tid >> 6;
    const int gw = blockIdx.x * 8 + wave, NGW = gridDim.x * 8;
    const bf16_t* H2B = (const bf16_t*)(p.ws + OFF_H2B); const bf16_t* UB = (const bf16_t*)(p.ws + OFF_UB); const bf16_t* VB = (const bf16_t*)(p.ws + OFF_VB);
    const float* SSQ = (const float*)(p.ws + OFF_SSQP); const int* IDX = (const int*)(p.ws + OFF_IDX); const float* GATE = (const float*)(p.ws + OFF_GATE);
    const int e0 = 8 * lane;
    for (int r = gw; r < NTOK; r += NGW) {
        float ss = 0.f;
#pragma unroll
        for (int i = 0; i < 4; ++i) ss += SSQ[(size_t)r * 4 + i];
        const float rstd = rsqrtf(ss * (1.f / DM) + EPS);
        const u32x4 ha = *(const u32x4*)(H2B + (size_t)r * DM + e0), hb = *(const u32x4*)(H2B + (size_t)r * DM + 512 + e0);
        float acc[16];
#pragma unroll
        for (int i = 0; i < 16; ++i) acc[i] = 0.f;
        for (int k = 0; k < 128; ++k) {
            const int e = IDX[(size_t)r * 128 + k]; const float g = GATE[(size_t)r * 128 + k];
            const u32x4 ua = *(const u32x4*)(UB + (size_t)e * DM + e0), ub = *(const u32x4*)(UB + (size_t)e * DM + 512 + e0);
            const u32x4 va = *(const u32x4*)(VB + (size_t)e * DM + e0), vb = *(const u32x4*)(VB + (size_t)e * DM + 512 + e0);
            float d = dot8(ha, ua, 0.f); d = dot8(hb, ub, d);
            d = wave_sum(d) * rstd;
            const float w = g * gelu_f(d);
            acc[0] += w * bflo(va.x); acc[1] += w * bfhi(va.x); acc[2] += w * bflo(va.y); acc[3] += w * bfhi(va.y);
            acc[4] += w * bflo(va.z); acc[5] += w * bfhi(va.z); acc[6] += w * bflo(va.w); acc[7] += w * bfhi(va.w);
            acc[8] += w * bflo(vb.x); acc[9] += w * bfhi(vb.x); acc[10] += w * bflo(vb.y); acc[11] += w * bfhi(vb.y);
            acc[12] += w * bflo(vb.z); acc[13] += w * bfhi(vb.z); acc[14] += w * bflo(vb.w); acc[15] += w * bfhi(vb.w);
        }
        float* orow = p.out + (size_t)r * DM;
        f32x4 h0 = *(const f32x4*)(orow + e0), h1 = *(const f32x4*)(orow + e0 + 4), h2 = *(const f32x4*)(orow + 512 + e0), h3 = *(const f32x4*)(orow + 512 + e0 + 4);
        h0 += (f32x4){acc[0], acc[1], acc[2], acc[3]}; h1 += (f32x4){acc[4], acc[5], acc[6], acc[7]};
        h2 += (f32x4){acc[8], acc[9], acc[10], acc[11]}; h3 += (f32x4){acc[12], acc[13], acc[14], acc[15]};
        float s2 = h0.x * h0.x + h0.y * h0.y + h0.z * h0.z + h0.w * h0.w + h1.x * h1.x + h1.y * h1.y + h1.z * h1.z + h1.w * h1.w
                 + h2.x * h2.x + h2.y * h2.y + h2.z * h2.z + h2.w * h2.w + h3.x * h3.x + h3.y * h3.y + h3.z * h3.z + h3.w * h3.w;
        const float rs = rsqrtf(wave_sum(s2) * (1.f / DM) + EPS);
        const float* fw = p.in[20];
        *(f32x4*)(orow + e0) = h0 * rs * *(const f32x4*)(fw + e0); *(f32x4*)(orow + e0 + 4) = h1 * rs * *(const f32x4*)(fw + e0 + 4);
        *(f32x4*)(orow + 512 + e0) = h2 * rs * *(const f32x4*)(fw + 512 + e0); *(f32x4*)(orow + 512 + e0 + 4) = h3 * rs * *(const f32x4*)(fw + 512 + e0 + 4);
    }
}

constexpr int NPHASE = 7;
__global__ void __launch_bounds__(NTHR, 2) mega(Params p) {
    extern __shared__ __attribute__((aligned(16))) unsigned char lds[];
    cg::grid_group grid = cg::this_grid();
#define PH_ON(k) (p.ph_lo <= (k) && (k) < p.ph_hi)
#define PH_SYNC(k) do { if (PH_ON(k) && PH_ON((k) + 1)) grid.sync(); } while (0)
    if (PH_ON(0)) phase0(p, lds);
    PH_SYNC(0);
    if (PH_ON(1)) phase1_mfma(p, (LAS unsigned char*)lds);
    PH_SYNC(1);
    if (PH_ON(2)) { phase2_gla_naive(p); phase2_attn_mfma(p, (LAS unsigned char*)lds); }
    PH_SYNC(2);
    if (PH_ON(3)) phase2c(p);
    PH_SYNC(3);
    if (PH_ON(4)) phase3_mfma(p, (LAS unsigned char*)lds);
    PH_SYNC(4);
    if (PH_ON(5)) phase4_mfma(p, (LAS unsigned char*)lds);
    PH_SYNC(5);
    if (PH_ON(6)) phase5(p);
}

extern "C" void kernel_launch(void* const* d_in, const int* in_sizes, int n_in, void* d_out, int out_size, void* d_ws, size_t ws_size, hipStream_t stream) {
    static int grid = 0;
    if (grid == 0) {
        if (n_in != 21 || out_size != NTOK * DM || ws_size < WS_END) { fprintf(stderr, "kernel_launch: unexpected shapes (n_in %d out %d ws %zu)\n", n_in, out_size, ws_size); grid = -1; return; }
        int dev = 0, cus = 0, per_cu = 0;
        hipGetDevice(&dev);
        hipDeviceGetAttribute(&cus, hipDeviceAttributeMultiprocessorCount, dev);
        hipFuncSetAttribute((const void*)mega, hipFuncAttributeMaxDynamicSharedMemorySize, LDS_BYTES);
        hipOccupancyMaxActiveBlocksPerMultiprocessor(&per_cu, (const void*)mega, NTHR, LDS_BYTES);
        if (per_cu < 1) { fprintf(stderr, "kernel_launch: occupancy query says %d blocks/CU\n", per_cu); per_cu = 1; }
        grid = cus * 1;
        (void)hipGetLastError();
    }
    if (grid < 0) return;
    hipMemsetAsync((char*)d_ws + OFF_CTL, 0, CTL_BYTES, stream);
    Params p{};
    for (int i = 0; i < 21; ++i) p.in[i] = (const float*)d_in[i];
    p.out = (float*)d_out; p.ws = (unsigned char*)d_ws; p.ph_lo = 0; p.ph_hi = NPHASE;
    void* args[] = {&p};
    hipError_t e = hipLaunchCooperativeKernel((const void*)mega, dim3(grid), dim3(NTHR), args, LDS_BYTES, stream);
    if (e != hipSuccess) fprintf(stderr, "cooperative launch failed: %s (grid %d)\n", hipGetErrorString(e), grid);
}
```

```cpp
#include <hip/hip_runtime.h>
#include <hip/hip_cooperative_groups.h>
#include <cstdio>
#include <cstdint>
namespace cg = cooperative_groups;

constexpr int DM = 1024;
constexpr int NB = 8, SEQ = 2048, NMETA = 16;
constexpr int NTOK = NB * SEQ;
constexpr int MROWS = 16512;
constexpr int NIN = 3584;
constexpr int TPOS = NMETA + SEQ;
constexpr float EPS = 1e-6f;
constexpr float QSCALE = 0.125f * 1.4426950408889634f;
constexpr int NEXP = 16384;
constexpr int NTHR = 512;
#ifndef PROBE_DUP
#define PROBE_DUP 0
#endif

constexpr size_t MiB = 1u << 20;
constexpr size_t OFF_CTL = 0, CTL_BYTES = 64 * 1024;
constexpr size_t OFF_MISC = 512 * 1024;
constexpr size_t OFF_ROPE = 1 * MiB;
constexpr size_t OFF_WOUT = 2 * MiB;
constexpr size_t OFF_WQ = 4 * MiB;
constexpr size_t OFF_KEYS = 8 * MiB;
constexpr size_t OFF_SSQP = 8 * MiB + 512 * 1024;
constexpr size_t OFF_UB = 9 * MiB;
constexpr size_t OFF_VB = 41 * MiB;
constexpr size_t OFF_XN = 73 * MiB;
constexpr size_t OFF_MIX = 73 * MiB;
constexpr size_t OFF_WIN = 106 * MiB;
constexpr size_t OFF_QB = 113 * MiB;
constexpr size_t OFF_KB = OFF_QB + 16 * MiB + 256 * 1024;
constexpr size_t OFF_VT = OFF_KB + 16 * MiB + 256 * 1024;
constexpr size_t OFF_H2B = 113 * MiB;
constexpr size_t OFF_GQ = 162 * MiB;
constexpr size_t OFF_GK = OFF_GQ + 8 * MiB + 256 * 1024;
constexpr size_t OFF_GVT = OFF_GK + 8 * MiB + 256 * 1024;
constexpr size_t OFF_GF = OFF_GVT + 16 * MiB + 256 * 1024;
constexpr size_t OFF_GB = OFF_GF + 16 * MiB + 256 * 1024;
constexpr size_t OFF_GR = OFF_GB + 16 * MiB + 256 * 1024;
constexpr size_t OFF_PW0 = 162 * MiB;
constexpr size_t OFF_USC = 8 * MiB + 768 * 1024;
constexpr size_t WS_END = OFF_GR + 16 * MiB + 256 * 1024;
static_assert(WS_END <= 256 * MiB, "workspace map");
static_assert(OFF_VT + (size_t)512 * MROWS * 2 <= OFF_GQ, "map D");
static_assert(OFF_WIN + (size_t)NIN * DM * 2 <= OFF_QB, "map C");

constexpr int LDS_BYTES = 147456;

typedef unsigned short bf16_t;
typedef float f32x4 __attribute__((ext_vector_type(4)));
typedef float f32x2 __attribute__((ext_vector_type(2)));
typedef unsigned u32x4 __attribute__((ext_vector_type(4)));
typedef unsigned u32x2 __attribute__((ext_vector_type(2)));
typedef __bf16 bf16x2_t __attribute__((ext_vector_type(2)));

struct Params {
    const float* in[21];
    float* out;
    unsigned char* ws;
    int ph_lo, ph_hi;
};

__device__ __forceinline__ unsigned f2bf(float f) { unsigned u = __float_as_uint(f); return (u + 0x7fffu + ((u >> 16) & 1u)) >> 16; }
__device__ __forceinline__ float bf2f(unsigned h) { return __uint_as_float(h << 16); }
__device__ __forceinline__ unsigned pk2(float lo, float hi) { return __builtin_bit_cast(unsigned, __builtin_convertvector((f32x2){lo, hi}, bf16x2_t)); }
__device__ __forceinline__ float bflo(unsigned w) { return __uint_as_float(w << 16); }
__device__ __forceinline__ float bfhi(unsigned w) { return __uint_as_float(w & 0xffff0000u); }
__device__ __forceinline__ float dot2(unsigned a, unsigned b, float c) {
    return __builtin_amdgcn_fdot2_f32_bf16(__builtin_bit_cast(bf16x2_t, a), __builtin_bit_cast(bf16x2_t, b), c, false);
}
__device__ __forceinline__ float dot8(u32x4 a, u32x4 b, float c) { c = dot2(a.x, b.x, c); c = dot2(a.y, b.y, c); c = dot2(a.z, b.z, c); return dot2(a.w, b.w, c); }
__device__ __forceinline__ float wave_sum(float v) {
#pragma unroll
    for (int o = 1; o < 64; o <<= 1) v += __shfl_xor(v, o);
    return v;
}
__device__ __forceinline__ float wave_max(float v) {
#pragma unroll
    for (int o = 1; o < 64; o <<= 1) v = fmaxf(v, __shfl_xor(v, o));
    return v;
}
__device__ __forceinline__ float silu_f(float x) { return x / (1.f + __expf(-x)); }
__device__ __forceinline__ float logsig_f(float x) { return fminf(x, 0.f) - log1pf(__expf(-fabsf(x))); }
__device__ __forceinline__ float gelu_f(float x) { return 0.5f * x * (1.f + erff(x * 0.70710678118654752f)); }

__device__ __forceinline__ float win_src(const Params& p, int k, int n) {
    const float* W = p.in[3] + (size_t)k * 3104;
    if (n < 1024) {
        const int base = n & ~63, dp = n & 63, d = dp < 16 ? ((dp >> 1) + 8 * (dp & 1)) : dp;
        return W[base + d];
    } else if (n < 3072) return W[n];
    const int j = (n - 3072) & 255, dir = (n - 3072) >> 8;
    const float* w2 = p.in[dir ? 11 : 9];
    const float* wz = W + 3072 + dir * 16;
    float s = 0.f;
#pragma unroll
    for (int r = 0; r < 16; ++r) s += wz[r] * w2[r * 256 + j];
    return s;
}

template <int WHICH>
__device__ __forceinline__ void p0_transpose_item(const Params& p, float* scr, int item, int lane) {
    constexpr int N = WHICH == 0 ? NIN : (WHICH == 1 ? 1024 : 2048);
    constexpr int nblk = N / 32;
    const int kb = item / nblk, nb = item % nblk, k0 = 64 * kb, n0 = 32 * nb;
    bf16_t* WT = (bf16_t*)(p.ws + (WHICH == 0 ? OFF_WIN : (WHICH == 1 ? OFF_WOUT : OFF_WQ)));
#pragma unroll 4
    for (int i = 0; i < 32; ++i) {
        const int kk = 2 * i + (lane >> 5), k = k0 + kk, n = n0 + (lane & 31);
        float v;
        if (WHICH == 0) v = win_src(p, k, n);
        else if (WHICH == 1) v = p.in[14][(size_t)k * 1024 + n];
        else v = p.in[16][(size_t)k * 2048 + n] * p.in[15][k];
        scr[kk * 33 + (lane & 31)] = v;
    }
    __builtin_amdgcn_s_waitcnt(0xC07F); __builtin_amdgcn_wave_barrier();
    const int c = lane & 7;
#pragma unroll
    for (int j = 0; j < 4; ++j) {
        const int n = (lane >> 3) + 8 * j; const float* s = scr + (8 * c) * 33 + n;
        u32x4 o; o.x = pk2(s[0 * 33], s[1 * 33]); o.y = pk2(s[2 * 33], s[3 * 33]); o.z = pk2(s[4 * 33], s[5 * 33]); o.w = pk2(s[6 * 33], s[7 * 33]);
        *(u32x4*)(WT + (size_t)(n0 + n) * 1024 + k0 + 8 * c) = o;
    }
    __builtin_amdgcn_s_waitcnt(0xC07F); __builtin_amdgcn_wave_barrier();
}

__device__ __forceinline__ void phase0(const Params& p, unsigned char* lds) {
    const int tid = threadIdx.x, lane = tid & 63, wave = tid >> 6;
    const int gw = blockIdx.x * 8 + wave, NGW = gridDim.x * 8;
    const long gt = (long)blockIdx.x * NTHR + tid, NGT = (long)gridDim.x * NTHR;
    {
        const f32x4* lw = (const f32x4*)p.in[2];
        bf16_t* XN = (bf16_t*)(p.ws + OFF_XN);
        for (int r = gw; r < MROWS; r += NGW) {
            const float* src = r < NTOK ? p.in[0] + (size_t)r * DM : (r < NTOK + NMETA ? p.in[1] + (size_t)(r - NTOK) * DM : nullptr);
            f32x4 v[4]; float s = 0.f;
#pragma unroll
            for (int j = 0; j < 4; ++j) { v[j] = src ? ((const f32x4*)src)[lane + 64 * j] : (f32x4){0.f, 0.f, 0.f, 0.f}; s += v[j].x * v[j].x + v[j].y * v[j].y + v[j].z * v[j].z + v[j].w * v[j].w; }
            const float rs = rsqrtf(wave_sum(s) * (1.f / DM) + EPS);
#pragma unroll
            for (int j = 0; j < 4; ++j) { const f32x4 w = lw[lane + 64 * j]; u32x2 o; o.x = pk2(v[j].x * rs * w.x, v[j].y * rs * w.y); o.y = pk2(v[j].z * rs * w.z, v[j].w * rs * w.w);
                *(u32x2*)(XN + (size_t)r * DM + 4 * (lane + 64 * j)) = o; }
        }
    }
    {
        float* scr = (float*)lds + wave * (64 * 33);
        constexpr int I0 = 16 * (NIN / 32), I1 = 16 * 32, I2 = 16 * 64;
        for (int it = gw; it < I0 + I1 + I2; it += NGW) {
            if (it < I0) p0_transpose_item<0>(p, scr, it, lane);
            else if (it < I0 + I1) p0_transpose_item<1>(p, scr, it - I0, lane);
            else p0_transpose_item<2>(p, scr, it - I0 - I1, lane);
        }
    }
    {
        bf16_t* KEYS = (bf16_t*)(p.ws + OFF_KEYS);
        const long NK8 = 262144 / 8;
        for (long i = gt; i < NK8; i += NGT) {
            const long e = i * 8;
            const f32x4 a = *(const f32x4*)(p.in[17] + e), b = *(const f32x4*)(p.in[17] + e + 4);
            u32x4 o; o.x = pk2(a.x, a.y); o.y = pk2(a.z, a.w); o.z = pk2(b.x, b.y); o.w = pk2(b.z, b.w);
            *(u32x4*)(KEYS + e) = o;
        }
        unsigned char* UQ = p.ws + OFF_UB; float* USC = (float*)(p.ws + OFF_USC);
        for (int r = gw; r < NEXP; r += NGW) {
            const float* ur = p.in[18] + (size_t)r * DM + 16 * lane; const float* lw = p.in[15] + 16 * lane;
            f32x4 v[4]; float am = 0.f;
#pragma unroll
            for (int j = 0; j < 4; ++j) { v[j] = ((const f32x4*)ur)[j] * ((const f32x4*)lw)[j]; am = fmaxf(am, fmaxf(fmaxf(fabsf(v[j].x), fabsf(v[j].y)), fmaxf(fabsf(v[j].z), fabsf(v[j].w)))); }
            am = fmaxf(wave_max(am), 1e-30f);
            const float sc = 224.f / am;
            u32x4 o;
#pragma unroll
            for (int j = 0; j < 4; ++j) { int w = __builtin_amdgcn_cvt_pk_fp8_f32(v[j].x * sc, v[j].y * sc, 0, false); w = __builtin_amdgcn_cvt_pk_fp8_f32(v[j].z * sc, v[j].w * sc, w, true); o[j] = (unsigned)w; }
            *(u32x4*)(UQ + (size_t)r * DM + 16 * lane) = o;
            if (lane == 0) USC[r] = am * (1.f / 224.f);
        }
    }
    {
        __syncthreads();
        bf16_t* VS = (bf16_t*)(p.ws + OFF_VB);
        for (int tile = blockIdx.x; tile < NEXP / 64; tile += gridDim.x) {
            const float* srcv = p.in[19] + (size_t)tile * 64 * DM;
#pragma unroll 4
            for (int i = 0; i < 32; ++i) {
                const int q = tid + NTHR * i, er = q >> 8, c4 = (q & 255) * 4;
                const f32x4 a = *(const f32x4*)(srcv + (size_t)er * DM + c4);
                *(u32x2*)(lds + er * 2056 + c4 * 2) = (u32x2){pk2(a.x, a.y), pk2(a.z, a.w)};
            }
            __syncthreads();
#pragma unroll 4
            for (int i = 0; i < 32; ++i) {
                const int s = wave + 8 * i;
                *(u32x2*)(VS + ((size_t)s * NEXP + tile * 64 + lane) * 4) = *(const u32x2*)(lds + lane * 2056 + s * 8);
            }
            __syncthreads();
        }
    }
    {
        f32x2* rope = (f32x2*)(p.ws + OFF_ROPE);
        for (long i = gt; i < TPOS * 8; i += NGT) {
            const int t = (int)(i >> 3), j = (int)(i & 7);
            const float inv = powf(500000.0f, -(float)j * 0.125f);
            const float ang = (float)t * inv;
            rope[i] = (f32x2){cosf(ang), sinf(ang)};
        }
        if (gt == 0) {
            float a = 0.f, b = 0.f;
            for (int i = 0; i < 64; ++i) { a += p.in[4][i] * p.in[5][i]; b += p.in[6][i] * p.in[7][i]; }
            ((float*)(p.ws + OFF_MISC))[0] = expf(a) - expf(b) + 0.2f;
        }
    }
}

__device__ __forceinline__ void p1_store(const Params& p, int row, int n0, float v0, float v1, float v2, float v3) {
    if (n0 < 1024) {
        const int dp = n0 & 63;
        if (dp < 16) {
            const int pos = row < NTOK ? NMETA + (row & (SEQ - 1)) : (row - NTOK);
            const f32x4 cs = *(const f32x4*)((const float*)(p.ws + OFF_ROPE) + ((size_t)pos * 8 + (dp >> 1)) * 2);
            const float a0 = v0 * cs.x - v1 * cs.y, b0 = v1 * cs.x + v0 * cs.y;
            const float a1 = v2 * cs.z - v3 * cs.w, b1 = v3 * cs.z + v2 * cs.w;
            v0 = a0; v1 = b0; v2 = a1; v3 = b1;
        }
        if (n0 < 512) { u32x2 o; o.x = pk2(v0 * QSCALE, v1 * QSCALE); o.y = pk2(v2 * QSCALE, v3 * QSCALE); *(u32x2*)((bf16_t*)(p.ws + OFF_QB) + (size_t)row * 512 + n0) = o; }
        else { u32x2 o; o.x = pk2(v0, v1); o.y = pk2(v2, v3); *(u32x2*)((bf16_t*)(p.ws + OFF_KB) + (size_t)row * 512 + (n0 - 512)) = o; }
    } else if (n0 < 1536) {
        bf16_t* VT = (bf16_t*)(p.ws + OFF_VT) + (size_t)(n0 - 1024) * MROWS + row;
        VT[0] = (bf16_t)f2bf(v0); VT[MROWS] = (bf16_t)f2bf(v1); VT[2 * MROWS] = (bf16_t)f2bf(v2); VT[3 * (size_t)MROWS] = (bf16_t)f2bf(v3);
    } else if (n0 < 1792) {
        u32x2 o; o.x = pk2(v0 * 0.125f, v1 * 0.125f); o.y = pk2(v2 * 0.125f, v3 * 0.125f); *(u32x2*)((bf16_t*)(p.ws + OFF_GQ) + (size_t)row * 256 + (n0 - 1536)) = o;
    } else if (n0 < 2048) {
        u32x2 o; o.x = pk2(v0, v1); o.y = pk2(v2, v3); *(u32x2*)((bf16_t*)(p.ws + OFF_GK) + (size_t)row * 256 + (n0 - 1792)) = o;
    } else if (n0 < 2560) {
        bf16_t* VT = (bf16_t*)(p.ws + OFF_GVT) + (size_t)(n0 - 2048) * MROWS + row;
        VT[0] = (bf16_t)f2bf(v0); VT[MROWS] = (bf16_t)f2bf(v1); VT[2 * MROWS] = (bf16_t)f2bf(v2); VT[3 * (size_t)MROWS] = (bf16_t)f2bf(v3);
    } else if (n0 < 3072) {
        u32x2 o; o.x = pk2(silu_f(v0), silu_f(v1)); o.y = pk2(silu_f(v2), silu_f(v3)); *(u32x2*)((bf16_t*)(p.ws + OFF_GR) + (size_t)row * 512 + (n0 - 2560)) = o;
    } else {
        const int dir = (n0 - 3072) >> 8, j = (n0 - 3072) & 255;
        const f32x4 bb = *(const f32x4*)(p.in[dir ? 12 : 10] + j);
        f32x4 o; o.x = logsig_f(v0 + bb.x) * 0.0625f; o.y = logsig_f(v1 + bb.y) * 0.0625f; o.z = logsig_f(v2 + bb.z) * 0.0625f; o.w = logsig_f(v3 + bb.w) * 0.0625f;
        *(f32x4*)((float*)(p.ws + (dir ? OFF_GB : OFF_GF)) + (size_t)row * 256 + j) = o;
    }
}


#define LAS __attribute__((address_space(3)))
typedef short bf16x8 __attribute__((ext_vector_type(8)));
constexpr int GBUF = 49152;

template <int ROWS>
__device__ __forceinline__ void stage_tile(const bf16_t* G, int ldk, int r0, int k0, LAS unsigned char* buf, int wave, int lane) {
    const int rr = lane >> 3, c = (lane & 7) ^ rr;
#pragma unroll
    for (int i = 0; i < ROWS / 64; ++i) {
        const int grp = wave + 8 * i;
        const bf16_t* src = G + (size_t)(r0 + grp * 8 + rr) * ldk + k0 + c * 8;
        __builtin_amdgcn_global_load_lds((const unsigned*)src, (LAS unsigned*)(buf + grp * 1024), 16, 0, 0);
    }
}
__device__ __forceinline__ bf16x8 ldfrag(const LAS unsigned char* buf, int row, int c) {
    return *(const LAS bf16x8*)(buf + row * 128 + ((c ^ (row & 7)) << 4));
}
template <bool SWAP>
__device__ __forceinline__ void gemm_tile_256(const bf16_t* A, const bf16_t* Bt, int K, int m0, int n0, LAS unsigned char* lds, f32x4 (&acc)[4][4]) {
    const int tid = threadIdx.x, lane = tid & 63, wave = __builtin_amdgcn_readfirstlane(tid >> 6), wm = wave >> 2, wn = wave & 3, l15 = lane & 15, g = lane >> 4;
#pragma unroll
    for (int i = 0; i < 4; ++i)
#pragma unroll
        for (int j = 0; j < 4; ++j) acc[i][j] = (f32x4){0.f, 0.f, 0.f, 0.f};
    const int nk = K / 64;
    stage_tile<128>(A, K, m0, 0, lds, wave, lane);
    stage_tile<256>(Bt, K, n0, 0, lds + 16384, wave, lane);
    for (int kt = 0; kt < nk; ++kt) {
        asm volatile("s_waitcnt vmcnt(0)" ::: "memory");
        __syncthreads();
        if (kt + 1 < nk) {
            LAS unsigned char* nb = lds + ((kt + 1) & 1) * GBUF;
            stage_tile<128>(A, K, m0, (kt + 1) * 64, nb, wave, lane);
            stage_tile<256>(Bt, K, n0, (kt + 1) * 64, nb + 16384, wave, lane);
        }
        const LAS unsigned char* a = lds + (kt & 1) * GBUF; const LAS unsigned char* b = a + 16384;
#pragma unroll
        for (int ks = 0; ks < 2; ++ks) {
            bf16x8 af[4], bfr[4];
#pragma unroll
            for (int i = 0; i < 4; ++i) { af[i] = ldfrag(a, wm * 64 + i * 16 + l15, ks * 4 + g); bfr[i] = ldfrag(b, wn * 64 + i * 16 + l15, ks * 4 + g); }
#pragma unroll
            for (int i = 0; i < 4; ++i)
#pragma unroll
                for (int j = 0; j < 4; ++j)
                    acc[i][j] = SWAP ? __builtin_amdgcn_mfma_f32_16x16x32_bf16(af[i], bfr[j], acc[i][j], 0, 0, 0)
                                     : __builtin_amdgcn_mfma_f32_16x16x32_bf16(bfr[j], af[i], acc[i][j], 0, 0, 0);
        }
    }
}
__device__ __forceinline__ int vcu_of_block() { const int G = gridDim.x, bx = blockIdx.x; return (G % 8 == 0) ? (bx % 8) * (G / 8) + bx / 8 : bx; }

__device__ __forceinline__ void phase1_mfma(const Params& p, LAS unsigned char* lds) {
    const int tid = threadIdx.x, lane = tid & 63, wave = __builtin_amdgcn_readfirstlane(tid >> 6), wm = wave >> 2, wn = wave & 3, l15 = lane & 15, g = lane >> 4;
    const bf16_t* XN = (const bf16_t*)(p.ws + OFF_XN); const bf16_t* WT = (const bf16_t*)(p.ws + OFF_WIN);
    constexpr int NTN = NIN / 256, NTM = MROWS / 128;
    for (int t = vcu_of_block(); t < NTM * NTN; t += gridDim.x) {
        const int m0 = (t / NTN) * 128, n0 = (t % NTN) * 256;
        const bool vtype = (n0 >= 1024 && n0 < 1536) || (n0 >= 2048 && n0 < 2560);
        f32x4 acc[4][4];
        if (vtype) {
            gemm_tile_256<true>(XN, WT, DM, m0, n0, lds, acc);
            bf16_t* base = (bf16_t*)(p.ws + (n0 < 1536 ? OFF_VT : OFF_GVT)) + (size_t)((n0 < 1536 ? n0 - 1024 : n0 - 2048) + wn * 64 + l15) * MROWS + m0 + wm * 64 + 4 * g;
#pragma unroll
            for (int i = 0; i < 4; ++i)
#pragma unroll
                for (int j = 0; j < 4; ++j) { u32x2 o; o.x = pk2(acc[i][j][0], acc[i][j][1]); o.y = pk2(acc[i][j][2], acc[i][j][3]); *(u32x2*)(base + (size_t)(j * 16) * MROWS + i * 16) = o; }
        } else {
            gemm_tile_256<false>(XN, WT, DM, m0, n0, lds, acc);
#pragma unroll
            for (int i = 0; i < 4; ++i)
#pragma unroll
                for (int j = 0; j < 4; ++j) p1_store(p, m0 + wm * 64 + i * 16 + l15, n0 + wn * 64 + j * 16 + 4 * g, acc[i][j][0], acc[i][j][1], acc[i][j][2], acc[i][j][3]);
        }
    }
}

__device__ __forceinline__ void phase3_mfma(const Params& p, LAS unsigned char* lds) {
    const int tid = threadIdx.x, lane = tid & 63, wave = __builtin_amdgcn_readfirstlane(tid >> 6), wm = wave >> 2, wn = wave & 3, l15 = lane & 15, g = lane >> 4;
    const bf16_t* MIX = (const bf16_t*)(p.ws + OFF_MIX); const bf16_t* WT = (const bf16_t*)(p.ws + OFF_WOUT);
    bf16_t* H2B = (bf16_t*)(p.ws + OFF_H2B); float* SSQ = (float*)(p.ws + OFF_SSQP);
    LAS float* sred = (LAS float*)(lds + 2 * GBUF);
    for (int t = vcu_of_block(); t < 128 * 4; t += gridDim.x) {
        const int m0 = (t >> 2) * 128, nt_ = t & 3, n0 = nt_ * 256;
        f32x4 acc[4][4];
        gemm_tile_256<false>(MIX, WT, DM, m0, n0, lds, acc);
#pragma unroll
        for (int i = 0; i < 4; ++i) {
            const int row = m0 + wm * 64 + i * 16 + l15; float ss = 0.f;
#pragma unroll
            for (int j = 0; j < 4; ++j) {
                const int n = n0 + wn * 64 + j * 16 + 4 * g;
                const f32x4 hv = *(const f32x4*)(p.in[0] + (size_t)row * DM + n) + acc[i][j];
                *(f32x4*)(p.out + (size_t)row * DM + n) = hv;
                u32x2 o; o.x = pk2(hv.x, hv.y); o.y = pk2(hv.z, hv.w); *(u32x2*)(H2B + (size_t)row * DM + n) = o;
                ss += hv.x * hv.x + hv.y * hv.y + hv.z * hv.z + hv.w * hv.w;
            }
            ss += __shfl_xor(ss, 16); ss += __shfl_xor(ss, 32);
            if (g == 0) sred[(wm * 64 + i * 16 + l15) * 4 + wn] = ss;
        }
        __syncthreads();
        if (tid < 128) SSQ[(size_t)(m0 + tid) * 4 + nt_] = (sred[tid * 4] + sred[tid * 4 + 1]) + (sred[tid * 4 + 2] + sred[tid * 4 + 3]);
        __syncthreads();
    }
}


typedef float f32x16 __attribute__((ext_vector_type(16)));
constexpr int AT_KROW = 272, AT_VROW = 136, AT_KBYTES = 64 * AT_KROW, AT_VBYTES = 128 * AT_VROW, AT_STAGE = AT_KBYTES + AT_VBYTES;
__device__ __forceinline__ void attn_item(const Params& p, LAS unsigned char* lds, int item) {
    const int tid = threadIdx.x, lane = tid & 63, wave = __builtin_amdgcn_readfirstlane(tid >> 6), qg = wave >> 1, c = wave & 1, l31 = lane & 31, hh = lane >> 5;
    const int qt = item & 15, h = (item >> 4) & 3, b = item >> 6;
    const int r0 = b * SEQ + qt * 128;
    const bf16_t* QB = (const bf16_t*)(p.ws + OFF_QB); const bf16_t* KB = (const bf16_t*)(p.ws + OFF_KB); const bf16_t* VT = (const bf16_t*)(p.ws + OFF_VT);
    bf16x8 qf[4];
    {
        const bf16_t* qp = QB + (size_t)(r0 + qg * 32 + l31) * 512 + h * 128 + c * 64 + 8 * hh;
#pragma unroll
        for (int s = 0; s < 4; ++s) qf[s] = *(const bf16x8*)(qp + 16 * s);
    }
    f32x16 O[4];
#pragma unroll
    for (int i = 0; i < 4; ++i)
#pragma unroll
        for (int r = 0; r < 16; ++r) O[i][r] = 0.f;
    float m = -1e30f, l = 0.f;
    const int kq0 = tid, kq1 = tid + 512;
    const bf16_t* kg0 = KB + (size_t)(kq0 >> 4) * 512 + h * 128 + (kq0 & 15) * 8; const bf16_t* kg1 = KB + (size_t)(kq1 >> 4) * 512 + h * 128 + (kq1 & 15) * 8;
    const bf16_t* vg0 = VT + (size_t)(h * 128 + (kq0 >> 3)) * MROWS + (kq0 & 7) * 8; const bf16_t* vg1 = VT + (size_t)(h * 128 + (kq1 >> 3)) * MROWS + (kq1 & 7) * 8;
    const int kl0 = (kq0 >> 4) * AT_KROW + (kq0 & 15) * 16, kl1 = (kq1 >> 4) * AT_KROW + (kq1 & 15) * 16;
    const int vl0 = AT_KBYTES + (kq0 >> 3) * AT_VROW + (kq0 & 7) * 16, vl1 = AT_KBYTES + (kq1 >> 3) * AT_VROW + (kq1 & 7) * 16;
    u32x4 kr0, kr1, vr0, vr1;
#define AT_LOAD(t) do { const size_t kro = (size_t)((t) < 32 ? b * SEQ + (t) * 64 : NTOK); \
        kr0 = *(const u32x4*)(kg0 + kro * 512); kr1 = *(const u32x4*)(kg1 + kro * 512); vr0 = *(const u32x4*)(vg0 + kro); vr1 = *(const u32x4*)(vg1 + kro); } while (0)
#define AT_WRITE(buf) do { LAS unsigned char* _b = lds + (buf) * AT_STAGE; \
        *(LAS u32x4*)(_b + kl0) = kr0; *(LAS u32x4*)(_b + kl1) = kr1; \
        *(LAS u32x2*)(_b + vl0) = (u32x2){vr0.x, vr0.y}; *(LAS u32x2*)(_b + vl0 + 8) = (u32x2){vr0.z, vr0.w}; \
        *(LAS u32x2*)(_b + vl1) = (u32x2){vr1.x, vr1.y}; *(LAS u32x2*)(_b + vl1 + 8) = (u32x2){vr1.z, vr1.w}; } while (0)
    __syncthreads();
    AT_LOAD(0); AT_WRITE(0);
    __syncthreads();
    for (int t = 0; t < 33; ++t) {
        if (t + 1 < 33) AT_LOAD(t + 1);
        const LAS unsigned char* kb_ = lds + (t & 1) * AT_STAGE; const LAS unsigned char* vb_ = kb_ + AT_KBYTES;
        f32x16 s0, s1;
#pragma unroll
        for (int r = 0; r < 16; ++r) { s0[r] = 0.f; s1[r] = 0.f; }
#pragma unroll
        for (int s = 0; s < 4; ++s) {
            const bf16x8 k0 = *(const LAS bf16x8*)(kb_ + l31 * AT_KROW + (c * 64 + 16 * s + 8 * hh) * 2);
            const bf16x8 k1 = *(const LAS bf16x8*)(kb_ + (32 + l31) * AT_KROW + (c * 64 + 16 * s + 8 * hh) * 2);
            s0 = __builtin_amdgcn_mfma_f32_32x32x16_bf16(k0, qf[s], s0, 0, 0, 0);
            s1 = __builtin_amdgcn_mfma_f32_32x32x16_bf16(k1, qf[s], s1, 0, 0, 0);
        }
        if (t == 32) {
#pragma unroll
            for (int r = 0; r < 16; ++r) { const int key = (r & 3) + 8 * (r >> 2) + 4 * hh; if (key >= 16) s0[r] = -1e30f; s1[r] = -1e30f; }
        }
        float mx = s0[0];
#pragma unroll
        for (int r = 1; r < 16; ++r) mx = fmaxf(mx, s0[r]);
#pragma unroll
        for (int r = 0; r < 16; ++r) mx = fmaxf(mx, s1[r]);
        mx = fmaxf(mx, __shfl_xor(mx, 32));
        const float mn = fmaxf(m, mx), alpha = __builtin_amdgcn_exp2f(m - mn);
        m = mn; l *= alpha;
#pragma unroll
        for (int i = 0; i < 4; ++i) O[i] = O[i] * alpha;
        float ps = 0.f;
#pragma unroll
        for (int r = 0; r < 16; ++r) { s0[r] = __builtin_amdgcn_exp2f(s0[r] - mn); s1[r] = __builtin_amdgcn_exp2f(s1[r] - mn); ps += s0[r] + s1[r]; }
        l += ps;
        bf16x8 pf[2][2];
#pragma unroll
        for (int s2 = 0; s2 < 2; ++s2) {
            u32x4 a, bq;
            a.x = pk2(s0[8 * s2 + 0], s0[8 * s2 + 1]); a.y = pk2(s0[8 * s2 + 2], s0[8 * s2 + 3]); a.z = pk2(s0[8 * s2 + 4], s0[8 * s2 + 5]); a.w = pk2(s0[8 * s2 + 6], s0[8 * s2 + 7]);
            bq.x = pk2(s1[8 * s2 + 0], s1[8 * s2 + 1]); bq.y = pk2(s1[8 * s2 + 2], s1[8 * s2 + 3]); bq.z = pk2(s1[8 * s2 + 4], s1[8 * s2 + 5]); bq.w = pk2(s1[8 * s2 + 6], s1[8 * s2 + 7]);
            pf[0][s2] = __builtin_bit_cast(bf16x8, a); pf[1][s2] = __builtin_bit_cast(bf16x8, bq);
        }
#pragma unroll
        for (int vb = 0; vb < 4; ++vb)
#pragma unroll
            for (int kb = 0; kb < 2; ++kb)
#pragma unroll
                for (int s2 = 0; s2 < 2; ++s2) {
                    const LAS unsigned char* vp = vb_ + (vb * 32 + l31) * AT_VROW + (kb * 32 + 16 * s2 + 4 * hh) * 2;
                    const u32x2 lo = *(const LAS u32x2*)vp, hi = *(const LAS u32x2*)(vp + 16);
                    const bf16x8 vf = __builtin_bit_cast(bf16x8, (u32x4){lo.x, lo.y, hi.x, hi.y});
                    O[vb] = __builtin_amdgcn_mfma_f32_32x32x16_bf16(vf, pf[kb][s2], O[vb], 0, 0, 0);
                }
        if (t + 1 < 33) AT_WRITE((t + 1) & 1);
        __syncthreads();
    }
    const float inv = 1.f / (l + __shfl_xor(l, 32));
    LAS float* X = (LAS float*)lds + qg * 4096;
    if (c == 1) {
#pragma unroll
        for (int vb = 0; vb < 4; ++vb)
#pragma unroll
            for (int r = 0; r < 16; ++r) X[(vb * 16 + r) * 64 + lane] = O[vb][r] * inv;
    }
    __syncthreads();
    if (c == 0) {
        const float lam = ((const float*)(p.ws + OFF_MISC))[0];
        float ss = 0.f;
#pragma unroll
        for (int vb = 0; vb < 4; ++vb)
#pragma unroll
            for (int r = 0; r < 16; ++r) { const float y = O[vb][r] * inv - lam * X[(vb * 16 + r) * 64 + lane]; O[vb][r] = y; ss += y * y; }
        ss += __shfl_xor(ss, 32);
        const float rs = rsqrtf(ss * (1.f / 128.f) + EPS) * 0.8f;
        bf16_t* orow = (bf16_t*)(p.ws + OFF_MIX) + (size_t)(r0 + qg * 32 + l31) * DM + h * 128;
#pragma unroll
        for (int vb = 0; vb < 4; ++vb)
#pragma unroll
            for (int rq = 0; rq < 4; ++rq) {
                const int v0 = vb * 32 + 8 * rq + 4 * hh;
                const f32x4 w = *(const f32x4*)(p.in[8] + v0);
                u32x2 o; o.x = pk2(O[vb][4 * rq] * rs * w.x, O[vb][4 * rq + 1] * rs * w.y); o.y = pk2(O[vb][4 * rq + 2] * rs * w.z, O[vb][4 * rq + 3] * rs * w.w);
                *(u32x2*)(orow + v0) = o;
            }
    }
#undef AT_LOAD
#undef AT_WRITE
}
__device__ __forceinline__ void phase2_attn_mfma(const Params& p, LAS unsigned char* lds) {
    for (int it = vcu_of_block(); it < NB * 4 * 16; it += gridDim.x) attn_item(p, lds, it);
}


__device__ __forceinline__ int gsw(int row, int chunk) { return row * 128 + ((chunk ^ (row & 7)) << 4); }
constexpr int GL_QS = 0, GL_KS = 8192, GL_KT = 16384, GL_AT = 24576, GL_VT = 32768, GL_ST = 49152  , GL_DV = 81920;
__device__ __forceinline__ void gla_chain(const Params& p, LAS unsigned char* lds, int item) {
    const int tid = threadIdx.x, lane = tid & 63, wave = __builtin_amdgcn_readfirstlane(tid >> 6), l15 = lane & 15, g = lane >> 4;
    const int dir = item & 1, h = (item >> 1) & 3, b = item >> 3;
    const bf16_t* GQ = (const bf16_t*)(p.ws + OFF_GQ); const bf16_t* GK = (const bf16_t*)(p.ws + OFF_GK); const bf16_t* GVT = (const bf16_t*)(p.ws + OFF_GVT);
    const float* G = (const float*)(p.ws + (dir ? OFF_GB : OFF_GF));
    float* O = p.out + (dir ? (size_t)NTOK * 512 : 0);
    const int nsteps = dir ? 32 : 33;
    f32x4 accS[4];
#pragma unroll
    for (int i = 0; i < 4; ++i) accS[i] = (f32x4){0.f, 0.f, 0.f, 0.f};
    f32x4 g0, g1; u32x4 q8, k8, v0, v1;
    const int vdv = tid >> 2, vch = (tid & 3) * 2;
#define GL_ROWBASE(st) (dir ? b * SEQ + (31 - (st)) * 64 : ((st) == 0 ? NTOK : b * SEQ + ((st) - 1) * 64))
#define GL_LOAD(st) do { const int _rb = GL_ROWBASE(st); const size_t _r = (size_t)(_rb + lane); \
        g0 = *(const f32x4*)(G + _r * 256 + h * 64 + 8 * wave); g1 = *(const f32x4*)(G + _r * 256 + h * 64 + 8 * wave + 4); \
        q8 = *(const u32x4*)(GQ + _r * 256 + h * 64 + 8 * wave); k8 = *(const u32x4*)(GK + _r * 256 + h * 64 + 8 * wave); \
        v0 = *(const u32x4*)(GVT + (size_t)(h * 128 + vdv) * MROWS + _rb + vch * 8); v1 = *(const u32x4*)(GVT + (size_t)(h * 128 + vdv) * MROWS + _rb + vch * 8 + 8); } while (0)
    __syncthreads();
    *(LAS u32x4*)(lds + GL_ST + tid * 32) = (u32x4){0u, 0u, 0u, 0u}; *(LAS u32x4*)(lds + GL_ST + tid * 32 + 16) = (u32x4){0u, 0u, 0u, 0u};
    GL_LOAD(0);
    for (int st = 0; st < nsteps; ++st) {
        const bool meta = (dir == 0 && st == 0);
        const int rowbase = GL_ROWBASE(st);
        float gg[8] = {g0.x, g0.y, g0.z, g0.w, g1.x, g1.y, g1.z, g1.w};
        if (meta && lane >= NMETA) {
#pragma unroll
            for (int e = 0; e < 8; ++e) gg[e] = 0.f;
        }
        float P[8];
#pragma unroll
        for (int e = 0; e < 8; ++e) P[e] = gg[e];
#pragma unroll
        for (int off = 1; off < 64; off <<= 1) {
#pragma unroll
            for (int e = 0; e < 8; ++e) { const float t = __shfl_up(P[e], off); P[e] += (lane >= off) ? t : 0.f; }
        }
        float qv[8] = {bflo(q8.x), bfhi(q8.x), bflo(q8.y), bfhi(q8.y), bflo(q8.z), bfhi(q8.z), bflo(q8.w), bfhi(q8.w)};
        float kv[8] = {bflo(k8.x), bfhi(k8.x), bflo(k8.y), bfhi(k8.y), bflo(k8.z), bfhi(k8.z), bflo(k8.w), bfhi(k8.w)};
        float qn[8], kn[8], ks[8];
#pragma unroll
        for (int e = 0; e < 8; ++e) {
            const float T = __shfl(P[e], 63);
            const float Bv = dir ? (T - P[e] + gg[e]) : P[e];
            qn[e] = qv[e] * __expf(Bv); kn[e] = kv[e] * __expf(-Bv); ks[e] = kv[e] * __expf(T - Bv);
            if (lane == 0) *(LAS float*)(lds + GL_DV + (8 * wave + e) * 4) = __expf(T);
        }
        *(LAS u32x4*)(lds + GL_QS + gsw(lane, wave)) = (u32x4){pk2(qn[0], qn[1]), pk2(qn[2], qn[3]), pk2(qn[4], qn[5]), pk2(qn[6], qn[7])};
        *(LAS u32x4*)(lds + GL_KS + gsw(lane, wave)) = (u32x4){pk2(kn[0], kn[1]), pk2(kn[2], kn[3]), pk2(kn[4], kn[5]), pk2(kn[6], kn[7])};
#pragma unroll
        for (int e = 0; e < 8; ++e) *(LAS unsigned short*)(lds + GL_KT + gsw(8 * wave + e, lane >> 3) + (lane & 7) * 2) = (unsigned short)f2bf(ks[e]);
        *(LAS u32x4*)(lds + GL_VT + gsw(vdv, vch)) = v0; *(LAS u32x4*)(lds + GL_VT + gsw(vdv, vch + 1)) = v1;
        if (st + 1 < nsteps) GL_LOAD(st + 1);
        __syncthreads();
        const LAS unsigned char* STo = lds + GL_ST + (st & 1) * 16384; LAS unsigned char* STn = lds + GL_ST + ((st + 1) & 1) * 16384;
        if (!meta) {
            const int jb = wave >> 1;
#pragma unroll
            for (int ii = 0; ii < 2; ++ii) {
                const int ib = 2 * (wave & 1) + ii;
                f32x4 a = (f32x4){0.f, 0.f, 0.f, 0.f};
                const bool live = dir ? (jb >= ib) : (jb <= ib);
                if (live) {
#pragma unroll
                    for (int ks2 = 0; ks2 < 2; ++ks2) {
                        const bf16x8 kf = *(const LAS bf16x8*)(lds + GL_KS + gsw(jb * 16 + l15, ks2 * 4 + g));
                        const bf16x8 qf = *(const LAS bf16x8*)(lds + GL_QS + gsw(ib * 16 + l15, ks2 * 4 + g));
                        a = __builtin_amdgcn_mfma_f32_16x16x32_bf16(kf, qf, a, 0, 0, 0);
                    }
                    const int i = ib * 16 + l15, j0 = jb * 16 + 4 * g;
#pragma unroll
                    for (int r = 0; r < 4; ++r) { const bool keep = dir ? (j0 + r >= i) : (j0 + r <= i); a[r] = keep ? a[r] : 0.f; }
                }
                const int i = ib * 16 + l15, j0 = jb * 16 + 4 * g;
                *(LAS u32x2*)(lds + GL_AT + gsw(i, j0 >> 3) + (j0 & 7) * 2) = (u32x2){pk2(a[0], a[1]), pk2(a[2], a[3])};
            }
        }
        if (st + 1 < nsteps) {
#pragma unroll
            for (int kb = 0; kb < 4; ++kb) {
                const f32x4 dvv = *(const LAS f32x4*)(lds + GL_DV + (kb * 16 + 4 * g) * 4);
                f32x4 a = accS[kb] * dvv;
#pragma unroll
                for (int ks2 = 0; ks2 < 2; ++ks2) {
                    const bf16x8 kf = *(const LAS bf16x8*)(lds + GL_KT + gsw(kb * 16 + l15, ks2 * 4 + g));
                    const bf16x8 vf = *(const LAS bf16x8*)(lds + GL_VT + gsw(wave * 16 + l15, ks2 * 4 + g));
                    a = __builtin_amdgcn_mfma_f32_16x16x32_bf16(kf, vf, a, 0, 0, 0);
                }
                accS[kb] = a;
                const int dk0 = kb * 16 + 4 * g;
                *(LAS u32x2*)(STn + gsw(wave * 16 + l15, dk0 >> 3) + (dk0 & 7) * 2) = (u32x2){pk2(a[0], a[1]), pk2(a[2], a[3])};
            }
        }
        __syncthreads();
        if (!meta) {
#pragma unroll
            for (int ib = 0; ib < 4; ++ib) {
                f32x4 a = (f32x4){0.f, 0.f, 0.f, 0.f};
#pragma unroll
                for (int ks2 = 0; ks2 < 2; ++ks2) {
                    const bf16x8 vf = *(const LAS bf16x8*)(lds + GL_VT + gsw(wave * 16 + l15, ks2 * 4 + g));
                    const bf16x8 af = *(const LAS bf16x8*)(lds + GL_AT + gsw(ib * 16 + l15, ks2 * 4 + g));
                    a = __builtin_amdgcn_mfma_f32_16x16x32_bf16(vf, af, a, 0, 0, 0);
                    const bf16x8 sf = *(const LAS bf16x8*)(STo + gsw(wave * 16 + l15, ks2 * 4 + g));
                    const bf16x8 qf = *(const LAS bf16x8*)(lds + GL_QS + gsw(ib * 16 + l15, ks2 * 4 + g));
                    a = __builtin_amdgcn_mfma_f32_16x16x32_bf16(sf, qf, a, 0, 0, 0);
                }
                *(f32x4*)(O + (size_t)(rowbase + ib * 16 + l15) * 512 + h * 128 + wave * 16 + 4 * g) = a;
            }
        }
        __syncthreads();
    }
#undef GL_LOAD
#undef GL_ROWBASE
}


constexpr int LDS_Q = LDS_BYTES - 16;
__device__ __forceinline__ void phase2(const Params& p, LAS unsigned char* lds, int qslot = 0) {
    unsigned* ctr = (unsigned*)(p.ws + OFF_CTL) + qslot * 64;
    for (;;) {
        __syncthreads();
        if (threadIdx.x == 0) *(LAS unsigned*)(lds + LDS_Q) = atomicAdd(ctr, 1u);
        __syncthreads();
        const int it = (int)*(LAS unsigned*)(lds + LDS_Q);
        if (it >= 64 + NB * 4 * 16) break;
        if (it < 64) gla_chain(p, lds, it); else attn_item(p, lds, it - 64);
    }
}

__device__ __forceinline__ void phase2c(const Params& p) {
    const int tid = threadIdx.x, lane = tid & 63, wave = tid >> 6;
    const int gw = blockIdx.x * 8 + wave, NGW = gridDim.x * 8;
    const bf16_t* GR = (const bf16_t*)(p.ws + OFF_GR); bf16_t* MIX = (bf16_t*)(p.ws + OFF_MIX);
    const float* OF = p.out; const float* OBk = p.out + (size_t)NTOK * 512;
    const int c0 = lane * 8;
    const f32x4 w0 = *(const f32x4*)(p.in[13] + (c0 & 127)), w1 = *(const f32x4*)(p.in[13] + (c0 & 127) + 4);
    for (int r = gw; r < NTOK; r += NGW) {
        const f32x4 a0 = *(const f32x4*)(OF + (size_t)r * 512 + c0), a1 = *(const f32x4*)(OF + (size_t)r * 512 + c0 + 4);
        const f32x4 b0 = *(const f32x4*)(OBk + (size_t)r * 512 + c0), b1 = *(const f32x4*)(OBk + (size_t)r * 512 + c0 + 4);
        const f32x4 x0 = a0 + b0, x1 = a1 + b1;
        float s = x0.x * x0.x + x0.y * x0.y + x0.z * x0.z + x0.w * x0.w + x1.x * x1.x + x1.y * x1.y + x1.z * x1.z + x1.w * x1.w;
        s += __shfl_xor(s, 1); s += __shfl_xor(s, 2); s += __shfl_xor(s, 4); s += __shfl_xor(s, 8);
        const float rs = rsqrtf(s * (1.f / 128.f) + EPS);
        const u32x4 g = *(const u32x4*)(GR + (size_t)r * 512 + c0);
        u32x4 o;
        o.x = pk2(x0.x * rs * w0.x * bflo(g.x), x0.y * rs * w0.y * bfhi(g.x)); o.y = pk2(x0.z * rs * w0.z * bflo(g.y), x0.w * rs * w0.w * bfhi(g.y));
        o.z = pk2(x1.x * rs * w1.x * bflo(g.z), x1.y * rs * w1.y * bfhi(g.z)); o.w = pk2(x1.z * rs * w1.z * bflo(g.w), x1.w * rs * w1.w * bfhi(g.w));
        *(u32x4*)(MIX + (size_t)r * DM + 512 + c0) = o;
    }
}


#define TOPK_INS(L, x) do { float _x = (x); _Pragma("unroll") for (int _s = 0; _s < 16; ++_s) { const float _t = fmaxf(L[_s], _x); _x = fminf(L[_s], _x); L[_s] = _t; } } while (0)
constexpr int P4_QROW = 528, P4_SC0 = 128 * P4_QROW  , P4_TLROW = 144;
__device__ __forceinline__ void phase4_mfma(const Params& p, LAS unsigned char* lds) {
    const int tid = threadIdx.x, lane = tid & 63, wave = __builtin_amdgcn_readfirstlane(tid >> 6), wm = wave >> 2, wn = wave & 3, l15 = lane & 15, g = lane >> 4;
    const bf16_t* H2B = (const bf16_t*)(p.ws + OFF_H2B); const bf16_t* WQ = (const bf16_t*)(p.ws + OFF_WQ); const bf16_t* KEYS = (const bf16_t*)(p.ws + OFF_KEYS);
    const float* SSQ = (const float*)(p.ws + OFF_SSQP);
    unsigned* PW0 = (unsigned*)(p.ws + OFF_PW0);
    for (int it = vcu_of_block(); it < 128 * 8; it += gridDim.x) {
        const int m0 = (it >> 3) * 128, h = it & 7;
        {
            f32x4 acc[4][4];
            gemm_tile_256<false>(H2B, WQ, DM, m0, h * 256, lds, acc);
            __syncthreads();
#pragma unroll
            for (int i = 0; i < 4; ++i) {
                const int rl = wm * 64 + i * 16 + l15;
                const f32x4 sq = *(const f32x4*)(SSQ + (size_t)(m0 + rl) * 4);
                const float rstd = rsqrtf(((sq.x + sq.y) + (sq.z + sq.w)) * (1.f / DM) + EPS);
#pragma unroll
                for (int j = 0; j < 4; ++j) { u32x2 o; o.x = pk2(acc[i][j][0] * rstd, acc[i][j][1] * rstd); o.y = pk2(acc[i][j][2] * rstd, acc[i][j][3] * rstd);
                    *(LAS u32x2*)(lds + rl * P4_QROW + (wn * 64 + j * 16 + 4 * g) * 2) = o; }
            }
        }
        __syncthreads();
        {
            const int wr = wave >> 1, wk = wave & 1;
            f32x4 sc[2][2][4];
#pragma unroll
            for (int pp = 0; pp < 2; ++pp) {
#pragma unroll
                for (int rb = 0; rb < 2; ++rb)
#pragma unroll
                    for (int kk = 0; kk < 4; ++kk) sc[pp][rb][kk] = (f32x4){0.f, 0.f, 0.f, 0.f};
                const bf16_t* kbase = KEYS + (size_t)((h * 2 + pp) * 128 + 64 * wk + l15) * 128 + 8 * g;
#pragma unroll
                for (int ks = 0; ks < 4; ++ks) {
                    bf16x8 qf[2], kf[4];
#pragma unroll
                    for (int rb = 0; rb < 2; ++rb) qf[rb] = *(const LAS bf16x8*)(lds + (32 * wr + 16 * rb + l15) * P4_QROW + (pp * 128 + ks * 32 + 8 * g) * 2);
#pragma unroll
                    for (int kk = 0; kk < 4; ++kk) kf[kk] = *(const bf16x8*)(kbase + (size_t)(16 * kk) * 128 + ks * 32);
#pragma unroll
                    for (int rb = 0; rb < 2; ++rb)
#pragma unroll
                        for (int kk = 0; kk < 4; ++kk) sc[pp][rb][kk] = __builtin_amdgcn_mfma_f32_16x16x32_bf16(kf[kk], qf[rb], sc[pp][rb][kk], 0, 0, 0);
                }
            }
#pragma unroll
            for (int rb = 0; rb < 2; ++rb)
#pragma unroll
                for (int kk = 0; kk < 4; ++kk) *(LAS f32x4*)(lds + P4_SC0 + (32 * wr + 16 * rb + l15) * P4_QROW + (64 * wk + 16 * kk + 4 * g) * 4) = sc[0][rb][kk];
            __syncthreads();
#pragma unroll
            for (int rb = 0; rb < 2; ++rb)
#pragma unroll
                for (int kk = 0; kk < 4; ++kk) *(LAS f32x4*)(lds + (32 * wr + 16 * rb + l15) * P4_QROW + (64 * wk + 16 * kk + 4 * g) * 4) = sc[1][rb][kk];
        }
        __syncthreads();
        {
            const int hf = tid & 1, row = (tid >> 1) & 127, pp = tid >> 8;
            const LAS unsigned char* sp = lds + (pp ? 0 : P4_SC0) + row * P4_QROW + hf * 256;
            float L[16];
#pragma unroll
            for (int s = 0; s < 16; ++s) L[s] = -3.0e38f;
#pragma unroll 4
            for (int q4 = 0; q4 < 16; ++q4) {
                const f32x4 v = *(const LAS f32x4*)(sp + q4 * 16);
                const unsigned kb = (unsigned)(hf * 64 + q4 * 4);
                TOPK_INS(L, __uint_as_float((__float_as_uint(v.x) & ~127u) | kb));
                TOPK_INS(L, __uint_as_float((__float_as_uint(v.y) & ~127u) | (kb + 1)));
                TOPK_INS(L, __uint_as_float((__float_as_uint(v.z) & ~127u) | (kb + 2)));
                TOPK_INS(L, __uint_as_float((__float_as_uint(v.w) & ~127u) | (kb + 3)));
            }
            float Oth[16];
#pragma unroll
            for (int s = 0; s < 16; ++s) Oth[s] = __shfl_xor(L[s], 1);
#pragma unroll
            for (int s = 0; s < 16; ++s) TOPK_INS(L, Oth[s]);
            __syncthreads();
            if (hf == 0) {
                LAS f32x4* tl = (LAS f32x4*)(lds + P4_SC0 + row * (2 * P4_TLROW) + pp * P4_TLROW);
                tl[0] = (f32x4){L[0], L[1], L[2], L[3]}; tl[1] = (f32x4){L[4], L[5], L[6], L[7]}; tl[2] = (f32x4){L[8], L[9], L[10], L[11]}; tl[3] = (f32x4){L[12], L[13], L[14], L[15]};
            }
        }
        __syncthreads();
        if (tid < 128) {
            const LAS unsigned char* tl = lds + P4_SC0 + tid * (2 * P4_TLROW);
            float A[16], Bv[16];
#pragma unroll
            for (int q4 = 0; q4 < 4; ++q4) { const f32x4 a = *(const LAS f32x4*)(tl + q4 * 16), b = *(const LAS f32x4*)(tl + P4_TLROW + q4 * 16);
                A[4 * q4] = a.x; A[4 * q4 + 1] = a.y; A[4 * q4 + 2] = a.z; A[4 * q4 + 3] = a.w; Bv[4 * q4] = b.x; Bv[4 * q4 + 1] = b.y; Bv[4 * q4 + 2] = b.z; Bv[4 * q4 + 3] = b.w; }
#pragma unroll
            for (int s = 0; s < 16; ++s) { A[s] = __uint_as_float(__float_as_uint(A[s]) & ~127u); Bv[s] = __uint_as_float(__float_as_uint(Bv[s]) & ~127u); }
            float L[16];
#pragma unroll
            for (int s = 0; s < 16; ++s) L[s] = -3.0e38f;
#pragma unroll
            for (int i = 0; i < 16; ++i)
#pragma unroll
                for (int j = 0; j < 16; ++j)
                    if ((i + 1) * (j + 1) <= 16) TOPK_INS(L, __uint_as_float((__float_as_uint(A[i] + Bv[j]) & ~255u) | (unsigned)(i * 16 + j)));
            const float v0 = __uint_as_float(__float_as_uint(L[0]) & ~255u);
            float e[16], den = 0.f; int id[16];
#pragma unroll
            for (int s = 0; s < 16; ++s) {
                const unsigned u = __float_as_uint(L[s]);
                e[s] = __expf(__uint_as_float(u & ~255u) - v0); den += e[s];
                const unsigned i = (u >> 4) & 15u, j = u & 15u;
                const unsigned ka = *(const LAS unsigned*)(tl + i * 4) & 127u, kb = *(const LAS unsigned*)(tl + P4_TLROW + j * 4) & 127u;
                id[s] = (int)(ka * 128u + kb);
            }
            const float inv = 1.f / den;
            unsigned* ip = PW0 + (size_t)(m0 + tid) * 128 + h * 16;
#pragma unroll
            for (int q4 = 0; q4 < 4; ++q4) { u32x4 o;
#pragma unroll
                for (int c = 0; c < 4; ++c) o[c] = (unsigned)id[4 * q4 + c] | (f2bf(e[4 * q4 + c] * inv) << 16);
                *(u32x4*)(ip + 4 * q4) = o; }
        }
        __syncthreads();
    }
}


constexpr size_t OFF_PW = 73 * MiB;
constexpr size_t OFF_OUTS = 179 * MiB;
static_assert(OFF_OUTS >= OFF_PW0 + (size_t)NTOK * 128 * 4 && OFF_OUTS + (size_t)NTOK * DM * 4 <= 256 * MiB, "P5 map");
__device__ __forceinline__ float dot_fp8_bf16(u32x4 uq, u32x4 h0, u32x4 h1, float c) {
#define DQ2(word, hsel, hw) c = dot2(__builtin_bit_cast(unsigned, __builtin_amdgcn_cvt_scalef32_pk_bf16_fp8((int)(word), 1.0f, hsel)), hw, c)
    DQ2(uq.x, false, h0.x); DQ2(uq.x, true, h0.y); DQ2(uq.y, false, h0.z); DQ2(uq.y, true, h0.w);
    DQ2(uq.z, false, h1.x); DQ2(uq.z, true, h1.y); DQ2(uq.w, false, h1.z); DQ2(uq.w, true, h1.w);
#undef DQ2
    return c;
}
constexpr int P5A_WAVE = 12288, P5A_PW0 = 8192, P5A_LIST = 10240, P5A_RSTD = 11264;
__device__ __forceinline__ void p5a_step(const Params& p, LAS unsigned char* wl, int t0, int part, int lane) {
    const bf16_t* H2B = (const bf16_t*)(p.ws + OFF_H2B); const unsigned char* UQ = p.ws + OFF_UB; const float* USC = (const float*)(p.ws + OFF_USC);
    const unsigned* PW0 = (const unsigned*)(p.ws + OFF_PW0); unsigned* PW = (unsigned*)(p.ws + OFF_PW);
    int n = 0;
    {
        u32x4 hr[4][2]; unsigned xl[4], xh[4];
#pragma unroll
        for (int k = 0; k < 4; ++k) {
            const size_t t = (size_t)(t0 + k);
            hr[k][0] = *(const u32x4*)(H2B + t * DM + 8 * lane); hr[k][1] = *(const u32x4*)(H2B + t * DM + 512 + 8 * lane);
            xl[k] = PW0[t * 128 + lane]; xh[k] = PW0[t * 128 + 64 + lane];
        }
        if (lane < 4) { const f32x4 sq = *(const f32x4*)((const float*)(p.ws + OFF_SSQP) + (size_t)(t0 + lane) * 4);
            *(LAS float*)(wl + P5A_RSTD + lane * 4) = rsqrtf(((sq.x + sq.y) + (sq.z + sq.w)) * (1.f / DM) + EPS); }
#pragma unroll
        for (int k = 0; k < 4; ++k) {
            *(LAS u32x4*)(wl + k * 2048 + (lane & 1) * 1024 + (lane >> 1) * 16) = hr[k][0];
            *(LAS u32x4*)(wl + k * 2048 + (lane & 1) * 1024 + (32 + (lane >> 1)) * 16) = hr[k][1];
            *(LAS unsigned*)(wl + P5A_PW0 + (k * 128 + lane) * 4) = xl[k]; *(LAS unsigned*)(wl + P5A_PW0 + (k * 128 + 64 + lane) * 4) = xh[k];
            const bool ml = (int)(xl[k] & 7u) == part, mh = (int)(xh[k] & 7u) == part;
            const unsigned long long bl = __ballot(ml), bh = __ballot(mh);
            const int rl = __builtin_amdgcn_mbcnt_hi((unsigned)(bl >> 32), __builtin_amdgcn_mbcnt_lo((unsigned)bl, 0u));
            if (ml) *(LAS unsigned short*)(wl + P5A_LIST + (n + rl) * 2) = (unsigned short)(k * 128 + lane);
            n += __popcll(bl);
            const int rh = __builtin_amdgcn_mbcnt_hi((unsigned)(bh >> 32), __builtin_amdgcn_mbcnt_lo((unsigned)bh, 0u));
            if (mh) *(LAS unsigned short*)(wl + P5A_LIST + (n + rh) * 2) = (unsigned short)(k * 128 + 64 + lane);
            n += __popcll(bh);
        }
    }
    __builtin_amdgcn_s_waitcnt(0xC07F); __builtin_amdgcn_wave_barrier();
    if (n == 0) return;
    const int nbat = (n + 7) >> 3;
    u32x4 urA[8], urB[8]; float scA[8], scB[8];
#define P5A_ISSUE(UR, SC, bt) do { _Pragma("unroll") for (int _j = 0; _j < 8; ++_j) { int _i = (bt) * 8 + _j; _i = _i < n ? _i : n - 1; \
        const unsigned _code = (unsigned)__builtin_amdgcn_readfirstlane((int)*(const LAS unsigned short*)(wl + P5A_LIST + _i * 2)); \
        const unsigned _e = (unsigned)__builtin_amdgcn_readfirstlane((int)*(const LAS unsigned*)(wl + P5A_PW0 + _code * 4)) & 0x3fffu; \
        UR[_j] = *(const u32x4*)(UQ + (size_t)_e * DM + 16 * lane); SC[_j] = USC[_e]; } } while (0)
#define P5A_COMPUTE(UR, SC, bt) do { float v[8]; \
        _Pragma("unroll") for (int _j = 0; _j < 8; ++_j) { int _i = (bt) * 8 + _j; _i = _i < n ? _i : n - 1; \
            const int _tk = __builtin_amdgcn_readfirstlane((int)*(const LAS unsigned short*)(wl + P5A_LIST + _i * 2)) >> 7; \
            const u32x4 _h0 = *(const LAS u32x4*)(wl + _tk * 2048 + lane * 16), _h1 = *(const LAS u32x4*)(wl + _tk * 2048 + 1024 + lane * 16); \
            v[_j] = dot_fp8_bf16(UR[_j], _h0, _h1, 0.f) * SC[_j]; } \
        _Pragma("unroll") for (int i = 0; i < 4; ++i) { const bool up = lane & 4; const float keep = up ? v[i + 4] : v[i], send = up ? v[i] : v[i + 4]; v[i] = keep + __shfl_xor(send, 4); } \
        _Pragma("unroll") for (int i = 0; i < 2; ++i) { const bool up = lane & 2; const float keep = up ? v[i + 2] : v[i], send = up ? v[i] : v[i + 2]; v[i] = keep + __shfl_xor(send, 2); } \
        { const bool up = lane & 1; const float keep = up ? v[1] : v[0], send = up ? v[0] : v[1]; v[0] = keep + __shfl_xor(send, 1); } \
        float d = v[0]; d += __shfl_xor(d, 8); d += __shfl_xor(d, 16); d += __shfl_xor(d, 32); \
        const int _mi = (bt) * 8 + (lane & 7); \
        if (lane < 8 && _mi < n) { \
            const unsigned code = *(const LAS unsigned short*)(wl + P5A_LIST + _mi * 2); const unsigned xs = *(const LAS unsigned*)(wl + P5A_PW0 + code * 4); \
            const int tk = (int)(code >> 7), sl = (int)(code & 127u), t = t0 + tk; \
            const float w = __uint_as_float(xs & 0xffff0000u) * gelu_f(d * *(const LAS float*)(wl + P5A_RSTD + tk * 4)); \
            PW[(((size_t)(t >> 6) * 32 + (sl >> 2)) * 64 + (t & 63)) * 4 + (sl & 3)] = (xs & 0x3fffu) | (f2bf(w) << 16); } } while (0)
    P5A_ISSUE(urA, scA, 0);
    for (int bt = 0; bt < nbat; bt += 2) {
        if (bt + 1 < nbat) P5A_ISSUE(urB, scB, bt + 1);
        P5A_COMPUTE(urA, scA, bt);
        if (bt + 1 < nbat) {
            if (bt + 2 < nbat) P5A_ISSUE(urA, scA, bt + 2);
            P5A_COMPUTE(urB, scB, bt + 1);
        }
    }
#undef P5A_ISSUE
#undef P5A_COMPUTE
    __builtin_amdgcn_s_waitcnt(0xC07F); __builtin_amdgcn_wave_barrier();
}
__device__ __forceinline__ void phase5a(const Params& p, LAS unsigned char* lds, int qoff = 0) {
    const int tid = threadIdx.x, lane = tid & 63, wave = __builtin_amdgcn_readfirstlane(tid >> 6);
    const int xcc = (int)(__builtin_amdgcn_s_getreg((3 << 11) | 20) & 7u);
    unsigned* qc = (unsigned*)(p.ws + OFF_CTL) + 256 + qoff;
    LAS unsigned char* wl = lds + wave * P5A_WAVE;
    for (int pi = 0; pi < 8; ++pi) {
        const int part = (xcc + pi) & 7;
        for (;;) {
            __syncthreads();
            if (tid == 0) *(LAS unsigned*)(lds + LDS_Q) = atomicAdd(qc + part * 64, 1u);
            __syncthreads();
            const int it = (int)*(LAS unsigned*)(lds + LDS_Q);
            if (it >= NTOK / 64) break;
            p5a_step(p, wl, it * 64 + wave * 8, part, lane);
            p5a_step(p, wl, it * 64 + wave * 8 + 4, part, lane);
        }
    }
}

__device__ __forceinline__ void p5b_quad(const LAS unsigned char* lds, u32x4 q, float& a0, float& a1, float& a2, float& a3) {
#pragma unroll
    for (int c = 0; c < 4; ++c) {
        const unsigned x = q[c];
        const u32x2 vv = *(const LAS u32x2*)(lds + ((x & 0x3fffu) << 3));
        const unsigned wlo = x >> 16, whi = x & 0xffff0000u;
        a0 = dot2(wlo, vv.x, a0); a1 = dot2(whi, vv.x, a1); a2 = dot2(wlo, vv.y, a2); a3 = dot2(whi, vv.y, a3);
    }
}
__device__ __forceinline__ void phase5b(const Params& p, LAS unsigned char* lds) {
    const int tid = threadIdx.x, lane = tid & 63, wave = __builtin_amdgcn_readfirstlane(tid >> 6);
    const bf16_t* VS = (const bf16_t*)(p.ws + OFF_VB); const u32x4* PW = (const u32x4*)(p.ws + OFF_PW); float* OUTS = (float*)(p.ws + OFF_OUTS);
    for (int s = blockIdx.x; s < 256; s += gridDim.x) {
        __syncthreads();
#pragma unroll 4
        for (int i = 0; i < 16; ++i) *(LAS u32x4*)(lds + (tid + NTHR * i) * 16) = *(const u32x4*)((const unsigned char*)VS + (size_t)s * 131072 + (size_t)(tid + NTHR * i) * 16);
        __syncthreads();
        u32x4 A[8], Bq[8];
#define P5B_LOAD(R, gi) do { const int _T = wave + 8 * ((gi) >> 2), _g = (gi) & 3; const u32x4* _p = PW + ((size_t)_T * 32 + _g * 8) * 64 + lane; \
        _Pragma("unroll") for (int _i = 0; _i < 8; ++_i) R[_i] = _p[_i * 64]; } while (0)
        float a0 = 0.f, a1 = 0.f, a2 = 0.f, a3 = 0.f;
        P5B_LOAD(A, 0);
        for (int gi = 0; gi < 128; gi += 2) {
            P5B_LOAD(Bq, gi + 1);
#pragma unroll
            for (int i = 0; i < 8; ++i) p5b_quad(lds, A[i], a0, a1, a2, a3);
            if (gi + 2 < 128) P5B_LOAD(A, gi + 2);
#pragma unroll
            for (int i = 0; i < 8; ++i) p5b_quad(lds, Bq[i], a0, a1, a2, a3);
            if (((gi + 1) & 3) == 3) {
                const int T = wave + 8 * (gi >> 2);
                *(f32x4*)(OUTS + ((size_t)s * NTOK + T * 64 + lane) * 4) = (f32x4){a0, a1, a2, a3};
                a0 = 0.f; a1 = 0.f; a2 = 0.f; a3 = 0.f;
            }
        }
#undef P5B_LOAD
    }
}

__device__ __forceinline__ void phase5c(const Params& p, LAS unsigned char* lds) {
    const int tid = threadIdx.x, lane = tid & 63, wave = __builtin_amdgcn_readfirstlane(tid >> 6);
    const float* OUTS = (const float*)(p.ws + OFF_OUTS); const float* fw = p.in[20];
    for (int it = blockIdx.x; it < NTOK / 32; it += gridDim.x) {
        const int t0 = it * 32;
        __syncthreads();
#pragma unroll 4
        for (int i = 0; i < 16; ++i) {
            const int s = (tid >> 5) + 16 * i, tt = tid & 31;
            *(LAS f32x4*)(lds + tt * 4112 + s * 16) = *(const f32x4*)(OUTS + ((size_t)s * NTOK + t0 + tt) * 4);
        }
        __syncthreads();
        for (int i = 0; i < 4; ++i) {
            const int tt = wave * 4 + i; float* orow = p.out + (size_t)(t0 + tt) * DM;
            f32x4 h[4]; float ss = 0.f;
#pragma unroll
            for (int j = 0; j < 4; ++j) { h[j] = *(const f32x4*)(orow + 4 * lane + 256 * j) + *(const LAS f32x4*)(lds + tt * 4112 + (4 * lane + 256 * j) * 4);
                ss += h[j].x * h[j].x + h[j].y * h[j].y + h[j].z * h[j].z + h[j].w * h[j].w; }
            const float rs = rsqrtf(wave_sum(ss) * (1.f / DM) + EPS);
#pragma unroll
            for (int j = 0; j < 4; ++j) *(f32x4*)(orow + 4 * lane + 256 * j) = h[j] * rs * *(const f32x4*)(fw + 4 * lane + 256 * j);
        }
    }
}


#define XB_TMO      128
#define XB_XCNT(j)  (256  + 64 * (j))
#define XB_XSUB(j)  (1280 + 64 * (j))
#define XB_XGEN(j)  (2304 + 64 * (j))
#define XB_TOP      3328
#define XB_TOPGEN   3392
#define XCD_BAR_WORDS 3456
#define XB_SPIN_CAP (1u << 18)
__device__ __forceinline__ unsigned xb_ld(unsigned* p)              { return __hip_atomic_load(p, __ATOMIC_RELAXED, __HIP_MEMORY_SCOPE_AGENT); }
__device__ __forceinline__ unsigned xb_add(unsigned* p, unsigned v) { return __hip_atomic_fetch_add(p, v, __ATOMIC_RELAXED, __HIP_MEMORY_SCOPE_AGENT); }
__device__ __forceinline__ unsigned xb_xcc_id() { return (unsigned)__builtin_amdgcn_s_getreg((3 << 11) | 20) & 0xFu; }
#define XB_SPIN(cond, bar) do { unsigned _sp = 0; while (cond) { __builtin_amdgcn_s_sleep(1); \
    if ((++_sp & 255u) == 0u) { if (xb_ld(&(bar)[XB_TMO])) break; if (_sp > XB_SPIN_CAP) { atomicAdd(&(bar)[XB_TMO], 1u); break; } } } } while (0)
struct XcdBarrier { unsigned* bar; unsigned x; volatile LAS unsigned* st; };
__device__ __forceinline__ XcdBarrier xcd_barrier_post(unsigned* bar, volatile LAS unsigned* st) {
    XcdBarrier b; b.bar = bar; b.x = xb_xcc_id(); b.st = st;
    if (threadIdx.x == 0) (void)xb_add(&bar[XB_XCNT(b.x)], 1u);
    return b;
}
__device__ __forceinline__ void xcd_barrier_complete(unsigned* bar, unsigned x, unsigned& nloc, unsigned& nx) {
    const unsigned G = gridDim.x * gridDim.y * gridDim.z;
    unsigned sum, cnt, mine, sp = 0u;
    for (;;) {
        sum = 0u; cnt = 0u; mine = 0u;
#pragma unroll
        for (unsigned j = 0; j < 16; ++j) { const unsigned c = xb_ld(&bar[XB_XCNT(j)]); sum += c; cnt += (c > 0u) ? 1u : 0u; mine = (j == x) ? c : mine; }
        if (sum == G) break;
        __builtin_amdgcn_s_sleep(1);
        if ((++sp & 255u) == 0u) { if (xb_ld(&bar[XB_TMO])) break; if (sp > XB_SPIN_CAP) { atomicAdd(&bar[XB_TMO], 1u); break; } }
    }
    nloc = mine > 0u ? mine : 1u; nx = cnt > 0u ? cnt : 1u;
}
__device__ __forceinline__ void xcd_barrier(const XcdBarrier& b) {
    asm volatile("s_waitcnt vmcnt(0)" ::: "memory");
    __syncthreads();
    if (threadIdx.x == 0) {
        unsigned* bar = b.bar;
        __builtin_amdgcn_s_waitcnt(0);
        unsigned nloc = b.st[0], nx = b.st[1];
        if (nloc == 0u) { xcd_barrier_complete(bar, b.x, nloc, nx); b.st[0] = nloc; b.st[1] = nx; }
        const unsigned old = xb_add(&bar[XB_XSUB(b.x)], 1u);
        const unsigned gen = old / nloc;
        if (old + 1u == (gen + 1u) * nloc) {
            __builtin_amdgcn_fence(__ATOMIC_RELEASE, "agent");
            asm volatile("s_waitcnt vmcnt(0)" ::: "memory");
            const unsigned og = xb_add(&bar[XB_TOP], 1u);
            const unsigned tg = og / nx;
            if (og + 1u == (tg + 1u) * nx) xb_add(&bar[XB_TOPGEN], 1u);
            else XB_SPIN(xb_ld(&bar[XB_TOPGEN]) == tg, bar);
            __builtin_amdgcn_fence(__ATOMIC_ACQUIRE, "agent");
            xb_add(&bar[XB_XGEN(b.x)], 1u);
            asm volatile("s_waitcnt vmcnt(0)" ::: "memory");
        } else {
            XB_SPIN(xb_ld(&bar[XB_XGEN(b.x)]) == gen, bar);
            __builtin_amdgcn_fence(__ATOMIC_ACQUIRE, "agent");
            asm volatile("s_waitcnt vmcnt(0)" ::: "memory");
        }
    }
    __syncthreads();
}

constexpr int NPHASE = 9;
__global__ void __launch_bounds__(NTHR, 2) mega(Params p) {
    extern __shared__ __attribute__((aligned(16))) unsigned char lds[];
    cg::grid_group grid = cg::this_grid();
#define PH_ON(k) (p.ph_lo <= (k) && (k) < p.ph_hi)
    if (threadIdx.x < 2) ((LAS unsigned*)((LAS unsigned char*)lds + LDS_BYTES - 32))[threadIdx.x] = 0u;
    __syncthreads();
    const XcdBarrier xbar = xcd_barrier_post((unsigned*)(p.ws + OFF_CTL) + 8192, (volatile LAS unsigned*)((LAS unsigned char*)lds + LDS_BYTES - 32));
#define PH_SYNC(k) do { if (PH_ON(k) && PH_ON((k) + 1)) { if ((k) == 0) grid.sync(); else xcd_barrier(xbar); } } while (0)
    if (PH_ON(0)) phase0(p, lds);
    PH_SYNC(0);
    if (PH_ON(1)) phase1_mfma(p, (LAS unsigned char*)lds);
#if PROBE_DUP == 1
    grid.sync(); phase1_mfma(p, (LAS unsigned char*)lds);
#endif
    PH_SYNC(1);
    if (PH_ON(2)) phase2(p, (LAS unsigned char*)lds);
#if PROBE_DUP == 2
    grid.sync(); phase2(p, (LAS unsigned char*)lds, 1);
#endif
    PH_SYNC(2);
    if (PH_ON(3)) phase2c(p);
    PH_SYNC(3);
    if (PH_ON(4)) phase3_mfma(p, (LAS unsigned char*)lds);
#if PROBE_DUP == 4
    grid.sync(); phase3_mfma(p, (LAS unsigned char*)lds);
#endif
    PH_SYNC(4);
    if (PH_ON(5)) phase4_mfma(p, (LAS unsigned char*)lds);
#if PROBE_DUP == 5
    grid.sync(); phase4_mfma(p, (LAS unsigned char*)lds);
#endif
    PH_SYNC(5);
    if (PH_ON(6)) phase5a(p, (LAS unsigned char*)lds);
#if PROBE_DUP == 6
    grid.sync(); phase5a(p, (LAS unsigned char*)lds, 1024);
#endif
    PH_SYNC(6);
    if (PH_ON(7)) phase5b(p, (LAS unsigned char*)lds);
#if PROBE_DUP == 7
    grid.sync(); phase5b(p, (LAS unsigned char*)lds);
#endif
    PH_SYNC(7);
    if (PH_ON(8)) phase5c(p, (LAS unsigned char*)lds);
}

extern "C" void kernel_launch(void* const* d_in, const int* in_sizes, int n_in, void* d_out, int out_size, void* d_ws, size_t ws_size, hipStream_t stream) {
    static int grid = 0;
    if (grid == 0) {
        if (n_in != 21 || out_size != NTOK * DM || ws_size < WS_END) { fprintf(stderr, "kernel_launch: unexpected shapes (n_in %d out %d ws %zu)\n", n_in, out_size, ws_size); grid = -1; return; }
        int dev = 0, cus = 0, per_cu = 0;
        hipGetDevice(&dev);
        hipDeviceGetAttribute(&cus, hipDeviceAttributeMultiprocessorCount, dev);
        hipFuncSetAttribute((const void*)mega, hipFuncAttributeMaxDynamicSharedMemorySize, LDS_BYTES);
        hipOccupancyMaxActiveBlocksPerMultiprocessor(&per_cu, (const void*)mega, NTHR, LDS_BYTES);
        if (per_cu < 1) { fprintf(stderr, "kernel_launch: occupancy query says %d blocks/CU\n", per_cu); per_cu = 1; }
        grid = cus * 1;
        (void)hipGetLastError();
    }
    if (grid < 0) return;
    hipMemsetAsync((char*)d_ws + OFF_CTL, 0, CTL_BYTES, stream);
    Params p{};
    for (int i = 0; i < 21; ++i) p.in[i] = (const float*)d_in[i];
    p.out = (float*)d_out; p.ws = (unsigned char*)d_ws; p.ph_lo = 0; p.ph_hi = NPHASE;
    void* args[] = {&p};
    hipError_t e = hipLaunchCooperativeKernel((const void*)mega, dim3(grid), dim3(NTHR), args, LDS_BYTES, stream);
    if (e != hipSuccess) fprintf(stderr, "cooperative launch failed: %s (grid %d)\n", hipGetErrorString(e), grid);
}
```

```cpp
#include <hip/hip_runtime.h>
#include <hip/hip_cooperative_groups.h>
#include <cstdio>
#include <cstdint>
namespace cg = cooperative_groups;

constexpr int DM = 1024;
constexpr int NB = 8, SEQ = 2048, NMETA = 16;
constexpr int NTOK = NB * SEQ;
constexpr int MROWS = 16512;
constexpr int NIN = 3584;
constexpr int TPOS = NMETA + SEQ;
constexpr float EPS = 1e-6f;
constexpr float QSCALE = 0.125f * 1.4426950408889634f;
constexpr int NEXP = 16384;
constexpr int NTHR = 512;
#ifndef PROBE_DUP
#define PROBE_DUP 0
#endif

constexpr size_t MiB = 1u << 20;
constexpr size_t OFF_CTL = 0, CTL_BYTES = 64 * 1024;
constexpr size_t OFF_MISC = 512 * 1024;
constexpr size_t OFF_ROPE = 1 * MiB;
constexpr size_t OFF_WOUT = 2 * MiB;
constexpr size_t OFF_WQ = 4 * MiB;
constexpr size_t OFF_KEYS = 8 * MiB;
constexpr size_t OFF_SSQP = 8 * MiB + 512 * 1024;
constexpr size_t OFF_UB = 9 * MiB;
constexpr size_t OFF_VB = 41 * MiB;
constexpr size_t OFF_XN = 73 * MiB;
constexpr size_t OFF_MIX = 73 * MiB;
constexpr size_t OFF_WIN = 106 * MiB;
constexpr size_t OFF_QB = 113 * MiB;
constexpr size_t OFF_KB = OFF_QB + 16 * MiB + 256 * 1024;
constexpr size_t OFF_VT = OFF_KB + 16 * MiB + 256 * 1024;
constexpr size_t OFF_H2B = 113 * MiB;
constexpr size_t OFF_GQ = 162 * MiB;
constexpr size_t OFF_GK = OFF_GQ + 8 * MiB + 256 * 1024;
constexpr size_t OFF_GVT = OFF_GK + 8 * MiB + 256 * 1024;
constexpr size_t OFF_GF = OFF_GVT + 16 * MiB + 256 * 1024;
constexpr size_t OFF_GB = OFF_GF + 16 * MiB + 256 * 1024;
constexpr size_t OFF_GR = OFF_GB + 16 * MiB + 256 * 1024;
constexpr size_t OFF_PW0 = 162 * MiB;
constexpr size_t OFF_USC = 8 * MiB + 768 * 1024;
constexpr size_t WS_END = OFF_GR + 16 * MiB + 256 * 1024;
static_assert(WS_END <= 256 * MiB, "workspace map");
static_assert(OFF_VT + (size_t)512 * MROWS * 2 <= OFF_GQ, "map D");
static_assert(OFF_WIN + (size_t)NIN * DM * 2 <= OFF_QB, "map C");

constexpr int LDS_BYTES = 163840;

typedef unsigned short bf16_t;
typedef float f32x4 __attribute__((ext_vector_type(4)));
typedef float f32x2 __attribute__((ext_vector_type(2)));
typedef unsigned u32x4 __attribute__((ext_vector_type(4)));
typedef unsigned u32x2 __attribute__((ext_vector_type(2)));
typedef __bf16 bf16x2_t __attribute__((ext_vector_type(2)));

struct Params {
    const float* in[21];
    float* out;
    unsigned char* ws;
    int ph_lo, ph_hi;
};

__device__ __forceinline__ unsigned f2bf(float f) { unsigned u = __float_as_uint(f); return (u + 0x7fffu + ((u >> 16) & 1u)) >> 16; }
__device__ __forceinline__ float bf2f(unsigned h) { return __uint_as_float(h << 16); }
__device__ __forceinline__ unsigned pk2(float lo, float hi) { return __builtin_bit_cast(unsigned, __builtin_convertvector((f32x2){lo, hi}, bf16x2_t)); }
__device__ __forceinline__ float bflo(unsigned w) { return __uint_as_float(w << 16); }
__device__ __forceinline__ float bfhi(unsigned w) { return __uint_as_float(w & 0xffff0000u); }
__device__ __forceinline__ float dot2(unsigned a, unsigned b, float c) {
    return __builtin_amdgcn_fdot2_f32_bf16(__builtin_bit_cast(bf16x2_t, a), __builtin_bit_cast(bf16x2_t, b), c, false);
}
__device__ __forceinline__ float dot8(u32x4 a, u32x4 b, float c) { c = dot2(a.x, b.x, c); c = dot2(a.y, b.y, c); c = dot2(a.z, b.z, c); return dot2(a.w, b.w, c); }
__device__ __forceinline__ float wave_sum(float v) {
#pragma unroll
    for (int o = 1; o < 64; o <<= 1) v += __shfl_xor(v, o);
    return v;
}
__device__ __forceinline__ float wave_max(float v) {
#pragma unroll
    for (int o = 1; o < 64; o <<= 1) v = fmaxf(v, __shfl_xor(v, o));
    return v;
}
__device__ __forceinline__ float silu_f(float x) { return x / (1.f + __expf(-x)); }
__device__ __forceinline__ float logsig_f(float x) { return fminf(x, 0.f) - log1pf(__expf(-fabsf(x))); }
__device__ __forceinline__ float gelu_f(float v) {
    const float av = fabsf(v), t = __builtin_amdgcn_rcpf(av * 0.2316418882f + 1.0f);
    float q = t * 0.5307027145f + (-0.7265760135f); q = q * t + 0.7107068705f; q = q * t + (-0.142248368f); q = q * t + 0.127414796f; q = q * t;
    const float m = v * (q * __builtin_amdgcn_exp2f(v * v * (-0.72134752044f)));
    return v < 0.f ? m : v - m;
}

__device__ __forceinline__ float win_src(const Params& p, int k, int n) {
    const float* W = p.in[3] + (size_t)k * 3104;
    if (n < 1024) {
        const int base = n & ~63, dp = n & 63, d = dp < 16 ? ((dp >> 1) + 8 * (dp & 1)) : dp;
        return W[base + d];
    } else if (n < 3072) return W[n];
    const int j = (n - 3072) & 255, dir = (n - 3072) >> 8;
    const float* w2 = p.in[dir ? 11 : 9];
    const float* wz = W + 3072 + dir * 16;
    float s = 0.f;
#pragma unroll
    for (int r = 0; r < 16; ++r) s += wz[r] * w2[r * 256 + j];
    return s;
}

template <int WHICH>
__device__ __forceinline__ void p0_transpose_item(const Params& p, float* scr, int item, int lane) {
    constexpr int N = WHICH == 0 ? NIN : (WHICH == 1 ? 1024 : 2048);
    constexpr int nblk = N / 32;
    const int kb = item / nblk, nb = item % nblk, k0 = 64 * kb, n0 = 32 * nb;
    bf16_t* WT = (bf16_t*)(p.ws + (WHICH == 0 ? OFF_WIN : (WHICH == 1 ? OFF_WOUT : OFF_WQ)));
#pragma unroll 4
    for (int i = 0; i < 32; ++i) {
        const int kk = 2 * i + (lane >> 5), k = k0 + kk, n = n0 + (lane & 31);
        float v;
        if (WHICH == 0) v = win_src(p, k, n);
        else if (WHICH == 1) v = p.in[14][(size_t)k * 1024 + n];
        else v = p.in[16][(size_t)k * 2048 + n] * p.in[15][k];
        scr[kk * 33 + (lane & 31)] = v;
    }
    __builtin_amdgcn_s_waitcnt(0xC07F); __builtin_amdgcn_wave_barrier();
    const int c = lane & 7;
#pragma unroll
    for (int j = 0; j < 4; ++j) {
        const int n = (lane >> 3) + 8 * j; const float* s = scr + (8 * c) * 33 + n;
        u32x4 o; o.x = pk2(s[0 * 33], s[1 * 33]); o.y = pk2(s[2 * 33], s[3 * 33]); o.z = pk2(s[4 * 33], s[5 * 33]); o.w = pk2(s[6 * 33], s[7 * 33]);
        *(u32x4*)(WT + (size_t)(n0 + n) * 1024 + k0 + 8 * c) = o;
    }
    __builtin_amdgcn_s_waitcnt(0xC07F); __builtin_amdgcn_wave_barrier();
}

__device__ __forceinline__ void phase0(const Params& p, unsigned char* lds) {
    const int tid = threadIdx.x, lane = tid & 63, wave = tid >> 6;
    const int gw = blockIdx.x * 8 + wave, NGW = gridDim.x * 8;
    const long gt = (long)blockIdx.x * NTHR + tid, NGT = (long)gridDim.x * NTHR;
    {
        const f32x4* lw = (const f32x4*)p.in[2];
        bf16_t* XN = (bf16_t*)(p.ws + OFF_XN);
        for (int r = gw; r < MROWS; r += NGW) {
            const float* src = r < NTOK ? p.in[0] + (size_t)r * DM : (r < NTOK + NMETA ? p.in[1] + (size_t)(r - NTOK) * DM : nullptr);
            f32x4 v[4]; float s = 0.f;
#pragma unroll
            for (int j = 0; j < 4; ++j) { v[j] = src ? ((const f32x4*)src)[lane + 64 * j] : (f32x4){0.f, 0.f, 0.f, 0.f}; s += v[j].x * v[j].x + v[j].y * v[j].y + v[j].z * v[j].z + v[j].w * v[j].w; }
            const float rs = rsqrtf(wave_sum(s) * (1.f / DM) + EPS);
#pragma unroll
            for (int j = 0; j < 4; ++j) { const f32x4 w = lw[lane + 64 * j]; u32x2 o; o.x = pk2(v[j].x * rs * w.x, v[j].y * rs * w.y); o.y = pk2(v[j].z * rs * w.z, v[j].w * rs * w.w);
                *(u32x2*)(XN + (size_t)r * DM + 4 * (lane + 64 * j)) = o; }
        }
    }
    {
        float* scr = (float*)lds + wave * (64 * 33);
        constexpr int I0 = 16 * (NIN / 32);
        for (int it = gw; it < I0; it += NGW) p0_transpose_item<0>(p, scr, it, lane);
    }
    {
        f32x2* rope = (f32x2*)(p.ws + OFF_ROPE);
        for (long i = gt; i < TPOS * 8; i += NGT) {
            const int t = (int)(i >> 3), j = (int)(i & 7);
            const float inv = powf(500000.0f, -(float)j * 0.125f);
            const float ang = (float)t * inv;
            rope[i] = (f32x2){cosf(ang), sinf(ang)};
        }
        if (gt == 0) {
            float a = 0.f, b = 0.f;
            for (int i = 0; i < 64; ++i) { a += p.in[4][i] * p.in[5][i]; b += p.in[6][i] * p.in[7][i]; }
            ((float*)(p.ws + OFF_MISC))[0] = expf(a) - expf(b) + 0.2f;
        }
    }
}
constexpr int CV_WOUT = 64, CV_WQ = 128, CV_KEYS = 8, CV_U = 256, CV_V = 256, CV_ITEMS = CV_WOUT + CV_WQ + CV_KEYS + CV_U + CV_V;
__device__ __forceinline__ void conv_item(const Params& p, unsigned char* lds, int c) {
    const int tid = threadIdx.x, lane = tid & 63, wave = tid >> 6;
    __syncthreads();
    if (c < CV_WOUT) { p0_transpose_item<1>(p, (float*)lds + wave * (64 * 33), c * 8 + wave, lane); return; }
    c -= CV_WOUT;
    if (c < CV_WQ) { p0_transpose_item<2>(p, (float*)lds + wave * (64 * 33), c * 8 + wave, lane); return; }
    c -= CV_WQ;
    if (c < CV_KEYS) {
        bf16_t* KEYS = (bf16_t*)(p.ws + OFF_KEYS);
#pragma unroll 2
        for (int j = 0; j < 8; ++j) {
            const long e = ((long)c * 4096 + tid + NTHR * j) * 8;
            const f32x4 a = *(const f32x4*)(p.in[17] + e), b = *(const f32x4*)(p.in[17] + e + 4);
            u32x4 o; o.x = pk2(a.x, a.y); o.y = pk2(a.z, a.w); o.z = pk2(b.x, b.y); o.w = pk2(b.z, b.w);
            *(u32x4*)(KEYS + e) = o;
        }
        return;
    }
    c -= CV_KEYS;
    if (c < CV_U) {
        unsigned char* UQ = p.ws + OFF_UB; float* USC = (float*)(p.ws + OFF_USC);
#pragma unroll 2
        for (int i = 0; i < 8; ++i) {
            const int r = c * 64 + wave * 8 + i;
            const float* ur = p.in[18] + (size_t)r * DM + 16 * lane; const float* lw = p.in[15] + 16 * lane;
            f32x4 v[4]; float am = 0.f;
#pragma unroll
            for (int j = 0; j < 4; ++j) { v[j] = ((const f32x4*)ur)[j] * ((const f32x4*)lw)[j]; am = fmaxf(am, fmaxf(fmaxf(fabsf(v[j].x), fabsf(v[j].y)), fmaxf(fabsf(v[j].z), fabsf(v[j].w)))); }
            am = fmaxf(wave_max(am), 1e-30f);
            const float sc = 224.f / am;
            u32x4 o;
#pragma unroll
            for (int j = 0; j < 4; ++j) { int w = __builtin_amdgcn_cvt_pk_fp8_f32(v[j].x * sc, v[j].y * sc, 0, false); w = __builtin_amdgcn_cvt_pk_fp8_f32(v[j].z * sc, v[j].w * sc, w, true); o[j] = (unsigned)w; }
            *(u32x4*)(UQ + (size_t)r * DM + 16 * lane) = o;
            if (lane == 0) USC[r] = am * (1.f / 224.f);
        }
        return;
    }
    c -= CV_U;
    {
        bf16_t* VS = (bf16_t*)(p.ws + OFF_VB);
        const int tile = c;
        const float* srcv = p.in[19] + (size_t)tile * 64 * DM;
#pragma unroll 4
        for (int i = 0; i < 32; ++i) {
            const int q = tid + NTHR * i, er = q >> 8, c4 = (q & 255) * 4;
            const f32x4 a = *(const f32x4*)(srcv + (size_t)er * DM + c4);
            *(u32x2*)(lds + er * 2056 + c4 * 2) = (u32x2){pk2(a.x, a.y), pk2(a.z, a.w)};
        }
        __syncthreads();
#pragma unroll 4
        for (int i = 0; i < 32; ++i) {
            const int s = wave + 8 * i;
            *(u32x2*)(VS + ((size_t)s * NEXP + tile * 64 + lane) * 4) = *(const u32x2*)(lds + lane * 2056 + s * 8);
        }
    }
}

__device__ __forceinline__ void p1_store(const Params& p, int row, int n0, float v0, float v1, float v2, float v3) {
    if (n0 < 1024) {
        const int dp = n0 & 63;
        if (dp < 16) {
            const int pos = row < NTOK ? NMETA + (row & (SEQ - 1)) : (row - NTOK);
            const f32x4 cs = *(const f32x4*)((const float*)(p.ws + OFF_ROPE) + ((size_t)pos * 8 + (dp >> 1)) * 2);
            const float a0 = v0 * cs.x - v1 * cs.y, b0 = v1 * cs.x + v0 * cs.y;
            const float a1 = v2 * cs.z - v3 * cs.w, b1 = v3 * cs.z + v2 * cs.w;
            v0 = a0; v1 = b0; v2 = a1; v3 = b1;
        }
        if (n0 < 512) { u32x2 o; o.x = pk2(v0 * QSCALE, v1 * QSCALE); o.y = pk2(v2 * QSCALE, v3 * QSCALE); *(u32x2*)((bf16_t*)(p.ws + OFF_QB) + (size_t)row * 512 + n0) = o; }
        else { u32x2 o; o.x = pk2(v0, v1); o.y = pk2(v2, v3); *(u32x2*)((bf16_t*)(p.ws + OFF_KB) + (size_t)row * 512 + (n0 - 512)) = o; }
    } else if (n0 < 1536) {
        bf16_t* VT = (bf16_t*)(p.ws + OFF_VT) + (size_t)(n0 - 1024) * MROWS + row;
        VT[0] = (bf16_t)f2bf(v0); VT[MROWS] = (bf16_t)f2bf(v1); VT[2 * MROWS] = (bf16_t)f2bf(v2); VT[3 * (size_t)MROWS] = (bf16_t)f2bf(v3);
    } else if (n0 < 1792) {
        u32x2 o; o.x = pk2(v0 * 0.125f, v1 * 0.125f); o.y = pk2(v2 * 0.125f, v3 * 0.125f); *(u32x2*)((bf16_t*)(p.ws + OFF_GQ) + (size_t)row * 256 + (n0 - 1536)) = o;
    } else if (n0 < 2048) {
        u32x2 o; o.x = pk2(v0, v1); o.y = pk2(v2, v3); *(u32x2*)((bf16_t*)(p.ws + OFF_GK) + (size_t)row * 256 + (n0 - 1792)) = o;
    } else if (n0 < 2560) {
        bf16_t* VT = (bf16_t*)(p.ws + OFF_GVT) + (size_t)(n0 - 2048) * MROWS + row;
        VT[0] = (bf16_t)f2bf(v0); VT[MROWS] = (bf16_t)f2bf(v1); VT[2 * MROWS] = (bf16_t)f2bf(v2); VT[3 * (size_t)MROWS] = (bf16_t)f2bf(v3);
    } else if (n0 < 3072) {
        u32x2 o; o.x = pk2(silu_f(v0), silu_f(v1)); o.y = pk2(silu_f(v2), silu_f(v3)); *(u32x2*)((bf16_t*)(p.ws + OFF_GR) + (size_t)row * 512 + (n0 - 2560)) = o;
    } else {
        const int dir = (n0 - 3072) >> 8, j = (n0 - 3072) & 255;
        const f32x4 bb = *(const f32x4*)(p.in[dir ? 12 : 10] + j);
        f32x4 o; o.x = logsig_f(v0 + bb.x) * 0.0625f; o.y = logsig_f(v1 + bb.y) * 0.0625f; o.z = logsig_f(v2 + bb.z) * 0.0625f; o.w = logsig_f(v3 + bb.w) * 0.0625f;
        *(f32x4*)((float*)(p.ws + (dir ? OFF_GB : OFF_GF)) + (size_t)row * 256 + j) = o;
    }
}


#define LAS __attribute__((address_space(3)))
typedef short bf16x8 __attribute__((ext_vector_type(8)));
constexpr int GBUF = 49152;

template <int ROWS>
__device__ __forceinline__ void stage_tile(const bf16_t* G, int ldk, int r0, int k0, LAS unsigned char* buf, int wave, int lane) {
    const int rr = lane >> 3, c = (lane & 7) ^ rr;
#pragma unroll
    for (int i = 0; i < ROWS / 64; ++i) {
        const int grp = wave + 8 * i;
        const bf16_t* src = G + (size_t)(r0 + grp * 8 + rr) * ldk + k0 + c * 8;
        __builtin_amdgcn_global_load_lds((const unsigned*)src, (LAS unsigned*)(buf + grp * 1024), 16, 0, 0);
    }
}
__device__ __forceinline__ bf16x8 ldfrag(const LAS unsigned char* buf, int row, int c) {
    return *(const LAS bf16x8*)(buf + row * 128 + ((c ^ (row & 7)) << 4));
}
template <bool SWAP>
__device__ __forceinline__ void gemm_tile_256(const bf16_t* A, const bf16_t* Bt, int K, int m0, int n0, LAS unsigned char* lds, f32x4 (&acc)[4][4]) {
    const int tid = threadIdx.x, lane = tid & 63, wave = __builtin_amdgcn_readfirstlane(tid >> 6), wm = wave >> 2, wn = wave & 3, l15 = lane & 15, g = lane >> 4;
#pragma unroll
    for (int i = 0; i < 4; ++i)
#pragma unroll
        for (int j = 0; j < 4; ++j) acc[i][j] = (f32x4){0.f, 0.f, 0.f, 0.f};
    const int nk = K / 64;
    stage_tile<128>(A, K, m0, 0, lds, wave, lane);
    stage_tile<256>(Bt, K, n0, 0, lds + 16384, wave, lane);
    for (int kt = 0; kt < nk; ++kt) {
        asm volatile("s_waitcnt vmcnt(0)" ::: "memory");
        __syncthreads();
        if (kt + 1 < nk) {
            LAS unsigned char* nb = lds + ((kt + 1) & 1) * GBUF;
            stage_tile<128>(A, K, m0, (kt + 1) * 64, nb, wave, lane);
            stage_tile<256>(Bt, K, n0, (kt + 1) * 64, nb + 16384, wave, lane);
        }
        const LAS unsigned char* a = lds + (kt & 1) * GBUF; const LAS unsigned char* b = a + 16384;
#pragma unroll
        for (int ks = 0; ks < 2; ++ks) {
            bf16x8 af[4], bfr[4];
#pragma unroll
            for (int i = 0; i < 4; ++i) { af[i] = ldfrag(a, wm * 64 + i * 16 + l15, ks * 4 + g); bfr[i] = ldfrag(b, wn * 64 + i * 16 + l15, ks * 4 + g); }
#pragma unroll
            for (int i = 0; i < 4; ++i)
#pragma unroll
                for (int j = 0; j < 4; ++j)
                    acc[i][j] = SWAP ? __builtin_amdgcn_mfma_f32_16x16x32_bf16(af[i], bfr[j], acc[i][j], 0, 0, 0)
                                     : __builtin_amdgcn_mfma_f32_16x16x32_bf16(bfr[j], af[i], acc[i][j], 0, 0, 0);
        }
    }
}
__device__ __forceinline__ int vcu_of_block() { const int G = gridDim.x, bx = blockIdx.x; return (G % 8 == 0) ? (bx % 8) * (G / 8) + bx / 8 : bx; }

__device__ __forceinline__ void phase1_mfma(const Params& p, LAS unsigned char* lds) {
    const int tid = threadIdx.x, lane = tid & 63, wave = __builtin_amdgcn_readfirstlane(tid >> 6), wm = wave >> 2, wn = wave & 3, l15 = lane & 15, g = lane >> 4;
    const bf16_t* XN = (const bf16_t*)(p.ws + OFF_XN); const bf16_t* WT = (const bf16_t*)(p.ws + OFF_WIN);
    constexpr int NTN = NIN / 256, NTM = MROWS / 128;
    for (int t = vcu_of_block(); t < NTM * NTN; t += gridDim.x) {
        const int m0 = (t / NTN) * 128, n0 = (t % NTN) * 256;
        const bool vtype = (n0 >= 1024 && n0 < 1536) || (n0 >= 2048 && n0 < 2560);
        f32x4 acc[4][4];
        if (vtype) {
            gemm_tile_256<true>(XN, WT, DM, m0, n0, lds, acc);
            bf16_t* base = (bf16_t*)(p.ws + (n0 < 1536 ? OFF_VT : OFF_GVT)) + (size_t)((n0 < 1536 ? n0 - 1024 : n0 - 2048) + wn * 64 + l15) * MROWS + m0 + wm * 64 + 4 * g;
#pragma unroll
            for (int i = 0; i < 4; ++i)
#pragma unroll
                for (int j = 0; j < 4; ++j) { u32x2 o; o.x = pk2(acc[i][j][0], acc[i][j][1]); o.y = pk2(acc[i][j][2], acc[i][j][3]); *(u32x2*)(base + (size_t)(j * 16) * MROWS + i * 16) = o; }
        } else {
            gemm_tile_256<false>(XN, WT, DM, m0, n0, lds, acc);
#pragma unroll
            for (int i = 0; i < 4; ++i)
#pragma unroll
                for (int j = 0; j < 4; ++j) p1_store(p, m0 + wm * 64 + i * 16 + l15, n0 + wn * 64 + j * 16 + 4 * g, acc[i][j][0], acc[i][j][1], acc[i][j][2], acc[i][j][3]);
        }
    }
}

__device__ __forceinline__ void phase3_mfma(const Params& p, LAS unsigned char* lds) {
    const int tid = threadIdx.x, lane = tid & 63, wave = __builtin_amdgcn_readfirstlane(tid >> 6), wm = wave >> 2, wn = wave & 3, l15 = lane & 15, g = lane >> 4;
    const bf16_t* MIX = (const bf16_t*)(p.ws + OFF_MIX); const bf16_t* WT = (const bf16_t*)(p.ws + OFF_WOUT);
    bf16_t* H2B = (bf16_t*)(p.ws + OFF_H2B); float* SSQ = (float*)(p.ws + OFF_SSQP);
    LAS float* sred = (LAS float*)(lds + 2 * GBUF);
    for (int t = vcu_of_block(); t < 128 * 4; t += gridDim.x) {
        const int m0 = (t >> 2) * 128, nt_ = t & 3, n0 = nt_ * 256;
        f32x4 acc[4][4];
        gemm_tile_256<false>(MIX, WT, DM, m0, n0, lds, acc);
#pragma unroll
        for (int i = 0; i < 4; ++i) {
            const int row = m0 + wm * 64 + i * 16 + l15; float ss = 0.f;
#pragma unroll
            for (int j = 0; j < 4; ++j) {
                const int n = n0 + wn * 64 + j * 16 + 4 * g;
                const f32x4 hv = *(const f32x4*)(p.in[0] + (size_t)row * DM + n) + acc[i][j];
                *(f32x4*)(p.out + (size_t)row * DM + n) = hv;
                u32x2 o; o.x = pk2(hv.x, hv.y); o.y = pk2(hv.z, hv.w); *(u32x2*)(H2B + (size_t)row * DM + n) = o;
                ss += hv.x * hv.x + hv.y * hv.y + hv.z * hv.z + hv.w * hv.w;
            }
            ss += __shfl_xor(ss, 16); ss += __shfl_xor(ss, 32);
            if (g == 0) sred[(wm * 64 + i * 16 + l15) * 4 + wn] = ss;
        }
        __syncthreads();
        if (tid < 128) SSQ[(size_t)(m0 + tid) * 4 + nt_] = (sred[tid * 4] + sred[tid * 4 + 1]) + (sred[tid * 4 + 2] + sred[tid * 4 + 3]);
        __syncthreads();
    }
}


typedef float f32x16 __attribute__((ext_vector_type(16)));
constexpr int AT_KROW = 272, AT_VROW = 136, AT_KBYTES = 64 * AT_KROW, AT_VBYTES = 128 * AT_VROW, AT_STAGE = AT_KBYTES + AT_VBYTES;
__device__ __forceinline__ void attn_item(const Params& p, LAS unsigned char* lds, int item) {
    const int tid = threadIdx.x, lane = tid & 63, wave = __builtin_amdgcn_readfirstlane(tid >> 6), qg = wave >> 1, c = wave & 1, l31 = lane & 31, hh = lane >> 5;
    const int qt = item & 15, h = (item >> 4) & 3, b = item >> 6;
    const int r0 = b * SEQ + qt * 128;
    const bf16_t* QB = (const bf16_t*)(p.ws + OFF_QB); const bf16_t* KB = (const bf16_t*)(p.ws + OFF_KB); const bf16_t* VT = (const bf16_t*)(p.ws + OFF_VT);
    bf16x8 qf[4];
    {
        const bf16_t* qp = QB + (size_t)(r0 + qg * 32 + l31) * 512 + h * 128 + c * 64 + 8 * hh;
#pragma unroll
        for (int s = 0; s < 4; ++s) qf[s] = *(const bf16x8*)(qp + 16 * s);
    }
    f32x16 O[4];
#pragma unroll
    for (int i = 0; i < 4; ++i)
#pragma unroll
        for (int r = 0; r < 16; ++r) O[i][r] = 0.f;
    float m = -1e30f, l = 0.f;
    const int kq0 = tid, kq1 = tid + 512;
    const bf16_t* kg0 = KB + (size_t)(kq0 >> 4) * 512 + h * 128 + (kq0 & 15) * 8; const bf16_t* kg1 = KB + (size_t)(kq1 >> 4) * 512 + h * 128 + (kq1 & 15) * 8;
    const bf16_t* vg0 = VT + (size_t)(h * 128 + (kq0 >> 3)) * MROWS + (kq0 & 7) * 8; const bf16_t* vg1 = VT + (size_t)(h * 128 + (kq1 >> 3)) * MROWS + (kq1 & 7) * 8;
    const int kl0 = (kq0 >> 4) * AT_KROW + (kq0 & 15) * 16, kl1 = (kq1 >> 4) * AT_KROW + (kq1 & 15) * 16;
    const int vl0 = AT_KBYTES + (kq0 >> 3) * AT_VROW + (kq0 & 7) * 16, vl1 = AT_KBYTES + (kq1 >> 3) * AT_VROW + (kq1 & 7) * 16;
    u32x4 kr0, kr1, vr0, vr1;
#define AT_LOAD(t) do { const size_t kro = (size_t)((t) < 32 ? b * SEQ + (t) * 64 : NTOK); \
        kr0 = *(const u32x4*)(kg0 + kro * 512); kr1 = *(const u32x4*)(kg1 + kro * 512); vr0 = *(const u32x4*)(vg0 + kro); vr1 = *(const u32x4*)(vg1 + kro); } while (0)
#define AT_WRITE(buf) do { LAS unsigned char* _b = lds + (buf) * AT_STAGE; \
        *(LAS u32x4*)(_b + kl0) = kr0; *(LAS u32x4*)(_b + kl1) = kr1; \
        *(LAS u32x2*)(_b + vl0) = (u32x2){vr0.x, vr0.y}; *(LAS u32x2*)(_b + vl0 + 8) = (u32x2){vr0.z, vr0.w}; \
        *(LAS u32x2*)(_b + vl1) = (u32x2){vr1.x, vr1.y}; *(LAS u32x2*)(_b + vl1 + 8) = (u32x2){vr1.z, vr1.w}; } while (0)
    __syncthreads();
    AT_LOAD(0); AT_WRITE(0);
    __syncthreads();
    for (int t = 0; t < 33; ++t) {
        if (t + 1 < 33) AT_LOAD(t + 1);
        const LAS unsigned char* kb_ = lds + (t & 1) * AT_STAGE; const LAS unsigned char* vb_ = kb_ + AT_KBYTES;
        f32x16 s0, s1;
#pragma unroll
        for (int r = 0; r < 16; ++r) { s0[r] = 0.f; s1[r] = 0.f; }
#pragma unroll
        for (int s = 0; s < 4; ++s) {
            const bf16x8 k0 = *(const LAS bf16x8*)(kb_ + l31 * AT_KROW + (c * 64 + 16 * s + 8 * hh) * 2);
            const bf16x8 k1 = *(const LAS bf16x8*)(kb_ + (32 + l31) * AT_KROW + (c * 64 + 16 * s + 8 * hh) * 2);
            s0 = __builtin_amdgcn_mfma_f32_32x32x16_bf16(k0, qf[s], s0, 0, 0, 0);
            s1 = __builtin_amdgcn_mfma_f32_32x32x16_bf16(k1, qf[s], s1, 0, 0, 0);
        }
        if (t == 32) {
#pragma unroll
            for (int r = 0; r < 16; ++r) { const int key = (r & 3) + 8 * (r >> 2) + 4 * hh; if (key >= 16) s0[r] = -1e30f; s1[r] = -1e30f; }
        }
        float mx = s0[0];
#pragma unroll
        for (int r = 1; r < 16; ++r) mx = fmaxf(mx, s0[r]);
#pragma unroll
        for (int r = 0; r < 16; ++r) mx = fmaxf(mx, s1[r]);
        mx = fmaxf(mx, __shfl_xor(mx, 32));
        const float mn = fmaxf(m, mx), alpha = __builtin_amdgcn_exp2f(m - mn);
        m = mn; l *= alpha;
#pragma unroll
        for (int i = 0; i < 4; ++i) O[i] = O[i] * alpha;
        float ps = 0.f;
#pragma unroll
        for (int r = 0; r < 16; ++r) { s0[r] = __builtin_amdgcn_exp2f(s0[r] - mn); s1[r] = __builtin_amdgcn_exp2f(s1[r] - mn); ps += s0[r] + s1[r]; }
        l += ps;
        bf16x8 pf[2][2];
#pragma unroll
        for (int s2 = 0; s2 < 2; ++s2) {
            u32x4 a, bq;
            a.x = pk2(s0[8 * s2 + 0], s0[8 * s2 + 1]); a.y = pk2(s0[8 * s2 + 2], s0[8 * s2 + 3]); a.z = pk2(s0[8 * s2 + 4], s0[8 * s2 + 5]); a.w = pk2(s0[8 * s2 + 6], s0[8 * s2 + 7]);
            bq.x = pk2(s1[8 * s2 + 0], s1[8 * s2 + 1]); bq.y = pk2(s1[8 * s2 + 2], s1[8 * s2 + 3]); bq.z = pk2(s1[8 * s2 + 4], s1[8 * s2 + 5]); bq.w = pk2(s1[8 * s2 + 6], s1[8 * s2 + 7]);
            pf[0][s2] = __builtin_bit_cast(bf16x8, a); pf[1][s2] = __builtin_bit_cast(bf16x8, bq);
        }
#pragma unroll
        for (int vb = 0; vb < 4; ++vb)
#pragma unroll
            for (int kb = 0; kb < 2; ++kb)
#pragma unroll
                for (int s2 = 0; s2 < 2; ++s2) {
                    const LAS unsigned char* vp = vb_ + (vb * 32 + l31) * AT_VROW + (kb * 32 + 16 * s2 + 4 * hh) * 2;
                    const u32x2 lo = *(const LAS u32x2*)vp, hi = *(const LAS u32x2*)(vp + 16);
                    const bf16x8 vf = __builtin_bit_cast(bf16x8, (u32x4){lo.x, lo.y, hi.x, hi.y});
                    O[vb] = __builtin_amdgcn_mfma_f32_32x32x16_bf16(vf, pf[kb][s2], O[vb], 0, 0, 0);
                }
        if (t + 1 < 33) AT_WRITE((t + 1) & 1);
        __syncthreads();
    }
    const float inv = 1.f / (l + __shfl_xor(l, 32));
    LAS float* X = (LAS float*)lds + qg * 4096;
    if (c == 1) {
#pragma unroll
        for (int vb = 0; vb < 4; ++vb)
#pragma unroll
            for (int r = 0; r < 16; ++r) X[(vb * 16 + r) * 64 + lane] = O[vb][r] * inv;
    }
    __syncthreads();
    if (c == 0) {
        const float lam = ((const float*)(p.ws + OFF_MISC))[0];
        float ss = 0.f;
#pragma unroll
        for (int vb = 0; vb < 4; ++vb)
#pragma unroll
            for (int r = 0; r < 16; ++r) { const float y = O[vb][r] * inv - lam * X[(vb * 16 + r) * 64 + lane]; O[vb][r] = y; ss += y * y; }
        ss += __shfl_xor(ss, 32);
        const float rs = rsqrtf(ss * (1.f / 128.f) + EPS) * 0.8f;
        bf16_t* orow = (bf16_t*)(p.ws + OFF_MIX) + (size_t)(r0 + qg * 32 + l31) * DM + h * 128;
#pragma unroll
        for (int vb = 0; vb < 4; ++vb)
#pragma unroll
            for (int rq = 0; rq < 4; ++rq) {
                const int v0 = vb * 32 + 8 * rq + 4 * hh;
                const f32x4 w = *(const f32x4*)(p.in[8] + v0);
                u32x2 o; o.x = pk2(O[vb][4 * rq] * rs * w.x, O[vb][4 * rq + 1] * rs * w.y); o.y = pk2(O[vb][4 * rq + 2] * rs * w.z, O[vb][4 * rq + 3] * rs * w.w);
                *(u32x2*)(orow + v0) = o;
            }
    }
#undef AT_LOAD
#undef AT_WRITE
}
__device__ __forceinline__ void phase2_attn_mfma(const Params& p, LAS unsigned char* lds) {
    for (int it = vcu_of_block(); it < NB * 4 * 16; it += gridDim.x) attn_item(p, lds, it);
}


__device__ __forceinline__ int gsw(int row, int chunk) { return row * 128 + ((chunk ^ (row & 7)) << 4); }
constexpr int GL_QS = 0, GL_KS = 8192, GL_KT = 16384, GL_AT = 24576, GL_VT = 32768, GL_ST = 49152  , GL_DV = 81920;
__device__ __forceinline__ void gla_chain(const Params& p, LAS unsigned char* lds, int item) {
    const int tid = threadIdx.x, lane = tid & 63, wave = __builtin_amdgcn_readfirstlane(tid >> 6), l15 = lane & 15, g = lane >> 4;
    const int dir = item & 1, h = (item >> 1) & 3, b = item >> 3;
    const bf16_t* GQ = (const bf16_t*)(p.ws + OFF_GQ); const bf16_t* GK = (const bf16_t*)(p.ws + OFF_GK); const bf16_t* GVT = (const bf16_t*)(p.ws + OFF_GVT);
    const float* G = (const float*)(p.ws + (dir ? OFF_GB : OFF_GF));
    float* O = p.out + (dir ? (size_t)NTOK * 512 : 0);
    const int nsteps = dir ? 32 : 33;
    f32x4 accS[4];
#pragma unroll
    for (int i = 0; i < 4; ++i) accS[i] = (f32x4){0.f, 0.f, 0.f, 0.f};
    f32x4 g0, g1; u32x4 q8, k8, v0, v1;
    const int vdv = tid >> 2, vch = (tid & 3) * 2;
#define GL_ROWBASE(st) (dir ? b * SEQ + (31 - (st)) * 64 : ((st) == 0 ? NTOK : b * SEQ + ((st) - 1) * 64))
#define GL_LOAD(st) do { const int _rb = GL_ROWBASE(st); const size_t _r = (size_t)(_rb + lane); \
        g0 = *(const f32x4*)(G + _r * 256 + h * 64 + 8 * wave); g1 = *(const f32x4*)(G + _r * 256 + h * 64 + 8 * wave + 4); \
        q8 = *(const u32x4*)(GQ + _r * 256 + h * 64 + 8 * wave); k8 = *(const u32x4*)(GK + _r * 256 + h * 64 + 8 * wave); \
        v0 = *(const u32x4*)(GVT + (size_t)(h * 128 + vdv) * MROWS + _rb + vch * 8); v1 = *(const u32x4*)(GVT + (size_t)(h * 128 + vdv) * MROWS + _rb + vch * 8 + 8); } while (0)
    __syncthreads();
    *(LAS u32x4*)(lds + GL_ST + tid * 32) = (u32x4){0u, 0u, 0u, 0u}; *(LAS u32x4*)(lds + GL_ST + tid * 32 + 16) = (u32x4){0u, 0u, 0u, 0u};
    GL_LOAD(0);
    for (int st = 0; st < nsteps; ++st) {
        const bool meta = (dir == 0 && st == 0);
        const int rowbase = GL_ROWBASE(st);
        float gg[8] = {g0.x, g0.y, g0.z, g0.w, g1.x, g1.y, g1.z, g1.w};
        if (meta && lane >= NMETA) {
#pragma unroll
            for (int e = 0; e < 8; ++e) gg[e] = 0.f;
        }
        float P[8];
#pragma unroll
        for (int e = 0; e < 8; ++e) P[e] = gg[e];
#pragma unroll
        for (int off = 1; off < 64; off <<= 1) {
#pragma unroll
            for (int e = 0; e < 8; ++e) { const float t = __shfl_up(P[e], off); P[e] += (lane >= off) ? t : 0.f; }
        }
        float qv[8] = {bflo(q8.x), bfhi(q8.x), bflo(q8.y), bfhi(q8.y), bflo(q8.z), bfhi(q8.z), bflo(q8.w), bfhi(q8.w)};
        float kv[8] = {bflo(k8.x), bfhi(k8.x), bflo(k8.y), bfhi(k8.y), bflo(k8.z), bfhi(k8.z), bflo(k8.w), bfhi(k8.w)};
        float qn[8], kn[8], ks[8];
#pragma unroll
        for (int e = 0; e < 8; ++e) {
            const float T = __shfl(P[e], 63);
            const float Bv = dir ? (T - P[e] + gg[e]) : P[e];
            qn[e] = qv[e] * __expf(Bv); kn[e] = kv[e] * __expf(-Bv); ks[e] = kv[e] * __expf(T - Bv);
            if (lane == 0) *(LAS float*)(lds + GL_DV + (8 * wave + e) * 4) = __expf(T);
        }
        *(LAS u32x4*)(lds + GL_QS + gsw(lane, wave)) = (u32x4){pk2(qn[0], qn[1]), pk2(qn[2], qn[3]), pk2(qn[4], qn[5]), pk2(qn[6], qn[7])};
        *(LAS u32x4*)(lds + GL_KS + gsw(lane, wave)) = (u32x4){pk2(kn[0], kn[1]), pk2(kn[2], kn[3]), pk2(kn[4], kn[5]), pk2(kn[6], kn[7])};
#pragma unroll
        for (int e = 0; e < 8; ++e) *(LAS unsigned short*)(lds + GL_KT + gsw(8 * wave + e, lane >> 3) + (lane & 7) * 2) = (unsigned short)f2bf(ks[e]);
        *(LAS u32x4*)(lds + GL_VT + gsw(vdv, vch)) = v0; *(LAS u32x4*)(lds + GL_VT + gsw(vdv, vch + 1)) = v1;
        if (st + 1 < nsteps) GL_LOAD(st + 1);
        __syncthreads();
        const LAS unsigned char* STo = lds + GL_ST + (st & 1) * 16384; LAS unsigned char* STn = lds + GL_ST + ((st + 1) & 1) * 16384;
        if (!meta) {
            const int jb = wave >> 1;
#pragma unroll
            for (int ii = 0; ii < 2; ++ii) {
                const int ib = 2 * (wave & 1) + ii;
                f32x4 a = (f32x4){0.f, 0.f, 0.f, 0.f};
                const bool live = dir ? (jb >= ib) : (jb <= ib);
                if (live) {
#pragma unroll
                    for (int ks2 = 0; ks2 < 2; ++ks2) {
                        const bf16x8 kf = *(const LAS bf16x8*)(lds + GL_KS + gsw(jb * 16 + l15, ks2 * 4 + g));
                        const bf16x8 qf = *(const LAS bf16x8*)(lds + GL_QS + gsw(ib * 16 + l15, ks2 * 4 + g));
                        a = __builtin_amdgcn_mfma_f32_16x16x32_bf16(kf, qf, a, 0, 0, 0);
                    }
                    const int i = ib * 16 + l15, j0 = jb * 16 + 4 * g;
#pragma unroll
                    for (int r = 0; r < 4; ++r) { const bool keep = dir ? (j0 + r >= i) : (j0 + r <= i); a[r] = keep ? a[r] : 0.f; }
                }
                const int i = ib * 16 + l15, j0 = jb * 16 + 4 * g;
                *(LAS u32x2*)(lds + GL_AT + gsw(i, j0 >> 3) + (j0 & 7) * 2) = (u32x2){pk2(a[0], a[1]), pk2(a[2], a[3])};
            }
        }
        if (st + 1 < nsteps) {
#pragma unroll
            for (int kb = 0; kb < 4; ++kb) {
                const f32x4 dvv = *(const LAS f32x4*)(lds + GL_DV + (kb * 16 + 4 * g) * 4);
                f32x4 a = accS[kb] * dvv;
#pragma unroll
                for (int ks2 = 0; ks2 < 2; ++ks2) {
                    const bf16x8 kf = *(const LAS bf16x8*)(lds + GL_KT + gsw(kb * 16 + l15, ks2 * 4 + g));
                    const bf16x8 vf = *(const LAS bf16x8*)(lds + GL_VT + gsw(wave * 16 + l15, ks2 * 4 + g));
                    a = __builtin_amdgcn_mfma_f32_16x16x32_bf16(kf, vf, a, 0, 0, 0);
                }
                accS[kb] = a;
                const int dk0 = kb * 16 + 4 * g;
                *(LAS u32x2*)(STn + gsw(wave * 16 + l15, dk0 >> 3) + (dk0 & 7) * 2) = (u32x2){pk2(a[0], a[1]), pk2(a[2], a[3])};
            }
        }
        __syncthreads();
        if (!meta) {
#pragma unroll
            for (int ib = 0; ib < 4; ++ib) {
                f32x4 a = (f32x4){0.f, 0.f, 0.f, 0.f};
#pragma unroll
                for (int ks2 = 0; ks2 < 2; ++ks2) {
                    const bf16x8 vf = *(const LAS bf16x8*)(lds + GL_VT + gsw(wave * 16 + l15, ks2 * 4 + g));
                    const bf16x8 af = *(const LAS bf16x8*)(lds + GL_AT + gsw(ib * 16 + l15, ks2 * 4 + g));
                    a = __builtin_amdgcn_mfma_f32_16x16x32_bf16(vf, af, a, 0, 0, 0);
                    const bf16x8 sf = *(const LAS bf16x8*)(STo + gsw(wave * 16 + l15, ks2 * 4 + g));
                    const bf16x8 qf = *(const LAS bf16x8*)(lds + GL_QS + gsw(ib * 16 + l15, ks2 * 4 + g));
                    a = __builtin_amdgcn_mfma_f32_16x16x32_bf16(sf, qf, a, 0, 0, 0);
                }
                *(f32x4*)(O + (size_t)(rowbase + ib * 16 + l15) * 512 + h * 128 + wave * 16 + 4 * g) = a;
            }
        }
        __syncthreads();
    }
#undef GL_LOAD
#undef GL_ROWBASE
}


constexpr int LDS_Q = LDS_BYTES - 16;
__device__ __forceinline__ void phase2(const Params& p, LAS unsigned char* lds, int qslot = 0) {
    unsigned* ctr = (unsigned*)(p.ws + OFF_CTL) + qslot * 64;
    for (;;) {
        __syncthreads();
        if (threadIdx.x == 0) *(LAS unsigned*)(lds + LDS_Q) = atomicAdd(ctr, 1u);
        __syncthreads();
        const int it = (int)*(LAS unsigned*)(lds + LDS_Q);
        if (it >= 64 + NB * 4 * 16) break;
        if (it < 64) gla_chain(p, lds, it); else attn_item(p, lds, it - 64);
    }
    if (qslot) return;
    for (;;) {
        __syncthreads();
        if (threadIdx.x == 0) *(LAS unsigned*)(lds + LDS_Q) = atomicAdd(ctr + 128, 1u);
        __syncthreads();
        const int it = (int)*(LAS unsigned*)(lds + LDS_Q);
        if (it >= CV_ITEMS) break;
        conv_item(p, (unsigned char*)lds, it);
    }
}

__device__ __forceinline__ void phase2c(const Params& p) {
    const int tid = threadIdx.x, lane = tid & 63, wave = tid >> 6;
    const int gw = blockIdx.x * 8 + wave, NGW = gridDim.x * 8;
    const bf16_t* GR = (const bf16_t*)(p.ws + OFF_GR); bf16_t* MIX = (bf16_t*)(p.ws + OFF_MIX);
    const float* OF = p.out; const float* OBk = p.out + (size_t)NTOK * 512;
    const int c0 = lane * 8;
    const f32x4 w0 = *(const f32x4*)(p.in[13] + (c0 & 127)), w1 = *(const f32x4*)(p.in[13] + (c0 & 127) + 4);
    for (int r = gw; r < NTOK; r += NGW) {
        const f32x4 a0 = *(const f32x4*)(OF + (size_t)r * 512 + c0), a1 = *(const f32x4*)(OF + (size_t)r * 512 + c0 + 4);
        const f32x4 b0 = *(const f32x4*)(OBk + (size_t)r * 512 + c0), b1 = *(const f32x4*)(OBk + (size_t)r * 512 + c0 + 4);
        const f32x4 x0 = a0 + b0, x1 = a1 + b1;
        float s = x0.x * x0.x + x0.y * x0.y + x0.z * x0.z + x0.w * x0.w + x1.x * x1.x + x1.y * x1.y + x1.z * x1.z + x1.w * x1.w;
        s += __shfl_xor(s, 1); s += __shfl_xor(s, 2); s += __shfl_xor(s, 4); s += __shfl_xor(s, 8);
        const float rs = rsqrtf(s * (1.f / 128.f) + EPS);
        const u32x4 g = *(const u32x4*)(GR + (size_t)r * 512 + c0);
        u32x4 o;
        o.x = pk2(x0.x * rs * w0.x * bflo(g.x), x0.y * rs * w0.y * bfhi(g.x)); o.y = pk2(x0.z * rs * w0.z * bflo(g.y), x0.w * rs * w0.w * bfhi(g.y));
        o.z = pk2(x1.x * rs * w1.x * bflo(g.z), x1.y * rs * w1.y * bfhi(g.z)); o.w = pk2(x1.z * rs * w1.z * bflo(g.w), x1.w * rs * w1.w * bfhi(g.w));
        *(u32x4*)(MIX + (size_t)r * DM + 512 + c0) = o;
    }
}


#define TOPK_INS(L, x) do { float _x = (x); _Pragma("unroll") for (int _s = 0; _s < 16; ++_s) { const float _t = fmaxf(L[_s], _x); _x = fminf(L[_s], _x); L[_s] = _t; } } while (0)
constexpr int P4_QROW = 528, P4_SC0 = 128 * P4_QROW  , P4_TLROW = 144;
__device__ __forceinline__ void phase4_mfma(const Params& p, LAS unsigned char* lds) {
    const int tid = threadIdx.x, lane = tid & 63, wave = __builtin_amdgcn_readfirstlane(tid >> 6), wm = wave >> 2, wn = wave & 3, l15 = lane & 15, g = lane >> 4;
    const bf16_t* H2B = (const bf16_t*)(p.ws + OFF_H2B); const bf16_t* WQ = (const bf16_t*)(p.ws + OFF_WQ); const bf16_t* KEYS = (const bf16_t*)(p.ws + OFF_KEYS);
    const float* SSQ = (const float*)(p.ws + OFF_SSQP);
    unsigned* PW0 = (unsigned*)(p.ws + OFF_PW0);
    for (int it = vcu_of_block(); it < 128 * 8; it += gridDim.x) {
        const int m0 = (it >> 3) * 128, h = it & 7;
        {
            f32x4 acc[4][4];
            gemm_tile_256<false>(H2B, WQ, DM, m0, h * 256, lds, acc);
            __syncthreads();
#pragma unroll
            for (int i = 0; i < 4; ++i) {
                const int rl = wm * 64 + i * 16 + l15;
                const f32x4 sq = *(const f32x4*)(SSQ + (size_t)(m0 + rl) * 4);
                const float rstd = rsqrtf(((sq.x + sq.y) + (sq.z + sq.w)) * (1.f / DM) + EPS);
#pragma unroll
                for (int j = 0; j < 4; ++j) { u32x2 o; o.x = pk2(acc[i][j][0] * rstd, acc[i][j][1] * rstd); o.y = pk2(acc[i][j][2] * rstd, acc[i][j][3] * rstd);
                    *(LAS u32x2*)(lds + rl * P4_QROW + (wn * 64 + j * 16 + 4 * g) * 2) = o; }
            }
        }
        __syncthreads();
        {
            const int wr = wave >> 1, wk = wave & 1;
            f32x4 sc[2][2][4];
#pragma unroll
            for (int pp = 0; pp < 2; ++pp) {
#pragma unroll
                for (int rb = 0; rb < 2; ++rb)
#pragma unroll
                    for (int kk = 0; kk < 4; ++kk) sc[pp][rb][kk] = (f32x4){0.f, 0.f, 0.f, 0.f};
                const bf16_t* kbase = KEYS + (size_t)((h * 2 + pp) * 128 + 64 * wk + l15) * 128 + 8 * g;
#pragma unroll
                for (int ks = 0; ks < 4; ++ks) {
                    bf16x8 qf[2], kf[4];
#pragma unroll
                    for (int rb = 0; rb < 2; ++rb) qf[rb] = *(const LAS bf16x8*)(lds + (32 * wr + 16 * rb + l15) * P4_QROW + (pp * 128 + ks * 32 + 8 * g) * 2);
#pragma unroll
                    for (int kk = 0; kk < 4; ++kk) kf[kk] = *(const bf16x8*)(kbase + (size_t)(16 * kk) * 128 + ks * 32);
#pragma unroll
                    for (int rb = 0; rb < 2; ++rb)
#pragma unroll
                        for (int kk = 0; kk < 4; ++kk) sc[pp][rb][kk] = __builtin_amdgcn_mfma_f32_16x16x32_bf16(kf[kk], qf[rb], sc[pp][rb][kk], 0, 0, 0);
                }
            }
#pragma unroll
            for (int rb = 0; rb < 2; ++rb)
#pragma unroll
                for (int kk = 0; kk < 4; ++kk) *(LAS f32x4*)(lds + P4_SC0 + (32 * wr + 16 * rb + l15) * P4_QROW + (64 * wk + 16 * kk + 4 * g) * 4) = sc[0][rb][kk];
            __syncthreads();
#pragma unroll
            for (int rb = 0; rb < 2; ++rb)
#pragma unroll
                for (int kk = 0; kk < 4; ++kk) *(LAS f32x4*)(lds + (32 * wr + 16 * rb + l15) * P4_QROW + (64 * wk + 16 * kk + 4 * g) * 4) = sc[1][rb][kk];
        }
        __syncthreads();
        {
            const int hf = tid & 1, row = (tid >> 1) & 127, pp = tid >> 8;
            const LAS unsigned char* sp = lds + (pp ? 0 : P4_SC0) + row * P4_QROW + hf * 256;
            float L[16];
#pragma unroll
            for (int s = 0; s < 16; ++s) L[s] = -3.0e38f;
#pragma unroll 4
            for (int q4 = 0; q4 < 16; ++q4) {
                const f32x4 v = *(const LAS f32x4*)(sp + q4 * 16);
                const unsigned kb = (unsigned)(hf * 64 + q4 * 4);
                TOPK_INS(L, __uint_as_float((__float_as_uint(v.x) & ~127u) | kb));
                TOPK_INS(L, __uint_as_float((__float_as_uint(v.y) & ~127u) | (kb + 1)));
                TOPK_INS(L, __uint_as_float((__float_as_uint(v.z) & ~127u) | (kb + 2)));
                TOPK_INS(L, __uint_as_float((__float_as_uint(v.w) & ~127u) | (kb + 3)));
            }
            float Oth[16];
#pragma unroll
            for (int s = 0; s < 16; ++s) Oth[s] = __shfl_xor(L[s], 1);
#pragma unroll
            for (int s = 0; s < 16; ++s) TOPK_INS(L, Oth[s]);
            __syncthreads();
            if (hf == 0) {
                LAS f32x4* tl = (LAS f32x4*)(lds + P4_SC0 + row * (2 * P4_TLROW) + pp * P4_TLROW);
                tl[0] = (f32x4){L[0], L[1], L[2], L[3]}; tl[1] = (f32x4){L[4], L[5], L[6], L[7]}; tl[2] = (f32x4){L[8], L[9], L[10], L[11]}; tl[3] = (f32x4){L[12], L[13], L[14], L[15]};
            }
        }
        __syncthreads();
        if (tid < 128) {
            const LAS unsigned char* tl = lds + P4_SC0 + tid * (2 * P4_TLROW);
            float A[16], Bv[16];
#pragma unroll
            for (int q4 = 0; q4 < 4; ++q4) { const f32x4 a = *(const LAS f32x4*)(tl + q4 * 16), b = *(const LAS f32x4*)(tl + P4_TLROW + q4 * 16);
                A[4 * q4] = a.x; A[4 * q4 + 1] = a.y; A[4 * q4 + 2] = a.z; A[4 * q4 + 3] = a.w; Bv[4 * q4] = b.x; Bv[4 * q4 + 1] = b.y; Bv[4 * q4 + 2] = b.z; Bv[4 * q4 + 3] = b.w; }
#pragma unroll
            for (int s = 0; s < 16; ++s) { A[s] = __uint_as_float(__float_as_uint(A[s]) & ~127u); Bv[s] = __uint_as_float(__float_as_uint(Bv[s]) & ~127u); }
            float L[16];
#pragma unroll
            for (int s = 0; s < 16; ++s) L[s] = -3.0e38f;
#pragma unroll
            for (int i = 0; i < 16; ++i)
#pragma unroll
                for (int j = 0; j < 16; ++j)
                    if ((i + 1) * (j + 1) <= 16) TOPK_INS(L, __uint_as_float((__float_as_uint(A[i] + Bv[j]) & ~255u) | (unsigned)(i * 16 + j)));
            const float v0 = __uint_as_float(__float_as_uint(L[0]) & ~255u);
            float e[16], den = 0.f; int id[16];
#pragma unroll
            for (int s = 0; s < 16; ++s) {
                const unsigned u = __float_as_uint(L[s]);
                e[s] = __expf(__uint_as_float(u & ~255u) - v0); den += e[s];
                const unsigned i = (u >> 4) & 15u, j = u & 15u;
                const unsigned ka = *(const LAS unsigned*)(tl + i * 4) & 127u, kb = *(const LAS unsigned*)(tl + P4_TLROW + j * 4) & 127u;
                id[s] = (int)(ka * 128u + kb);
            }
            const float inv = 1.f / den;
            unsigned* ip = PW0 + (size_t)(m0 + tid) * 128 + h * 16;
#pragma unroll
            for (int q4 = 0; q4 < 4; ++q4) { u32x4 o;
#pragma unroll
                for (int c = 0; c < 4; ++c) o[c] = (unsigned)id[4 * q4 + c] | (f2bf(e[4 * q4 + c] * inv) << 16);
                *(u32x4*)(ip + 4 * q4) = o; }
        }
        __syncthreads();
    }
}


constexpr size_t OFF_PW = 73 * MiB;
constexpr size_t OFF_OUTS = 179 * MiB;
static_assert(OFF_OUTS >= OFF_PW0 + (size_t)NTOK * 128 * 4 && OFF_OUTS + (size_t)NTOK * DM * 4 <= 256 * MiB, "P5 map");
__device__ __forceinline__ float dot_fp8_bf16(u32x4 uq, u32x4 h0, u32x4 h1, float c) {
#define DQ2(word, hsel, hw) c = dot2(__builtin_bit_cast(unsigned, __builtin_amdgcn_cvt_scalef32_pk_bf16_fp8((int)(word), 1.0f, hsel)), hw, c)
    DQ2(uq.x, false, h0.x); DQ2(uq.x, true, h0.y); DQ2(uq.y, false, h0.z); DQ2(uq.y, true, h0.w);
    DQ2(uq.z, false, h1.x); DQ2(uq.z, true, h1.y); DQ2(uq.w, false, h1.z); DQ2(uq.w, true, h1.w);
#undef DQ2
    return c;
}
constexpr int P5A_RS = 1040, P5A_LIST = 16640, P5A_RES = 18688, P5A_TSC = 18752, P5A_WAVE = 19456;
constexpr size_t OFF_HQ = 146 * MiB;
constexpr size_t OFF_HSC = 8 * MiB + 896 * 1024;
static_assert(8 * P5A_WAVE <= LDS_BYTES - 32, "P5a LDS");
static_assert(OFF_HQ >= OFF_H2B + (size_t)NTOK * DM * 2 && OFF_HQ + (size_t)NTOK * DM <= OFF_PW0, "HQ map");
__device__ __forceinline__ void quantize_hn(const Params& p) {
    const int tid = threadIdx.x, lane = tid & 63, wave = tid >> 6;
    const bf16_t* H2B = (const bf16_t*)(p.ws + OFF_H2B); unsigned char* HQ = p.ws + OFF_HQ; float* HSC = (float*)(p.ws + OFF_HSC);
    for (int t = blockIdx.x * 8 + wave; t < NTOK; t += gridDim.x * 8) {
        const u32x4 h0 = *(const u32x4*)(H2B + (size_t)t * DM + 16 * lane), h1 = *(const u32x4*)(H2B + (size_t)t * DM + 16 * lane + 8);
        float m = 0.f;
#pragma unroll
        for (int c = 0; c < 4; ++c) { m = fmaxf(m, fmaxf(fabsf(bflo(h0[c])), fabsf(bfhi(h0[c])))); m = fmaxf(m, fmaxf(fabsf(bflo(h1[c])), fabsf(bfhi(h1[c])))); }
        const float am = fmaxf(wave_max(m), 1e-30f), qs = 224.f / am;
        u32x4 o;
#pragma unroll
        for (int c = 0; c < 2; ++c) {
            int w = __builtin_amdgcn_cvt_pk_fp8_f32(bflo(h0[2 * c]) * qs, bfhi(h0[2 * c]) * qs, 0, false); w = __builtin_amdgcn_cvt_pk_fp8_f32(bflo(h0[2 * c + 1]) * qs, bfhi(h0[2 * c + 1]) * qs, w, true); o[c] = (unsigned)w;
            int x = __builtin_amdgcn_cvt_pk_fp8_f32(bflo(h1[2 * c]) * qs, bfhi(h1[2 * c]) * qs, 0, false); x = __builtin_amdgcn_cvt_pk_fp8_f32(bflo(h1[2 * c + 1]) * qs, bfhi(h1[2 * c + 1]) * qs, x, true); o[2 + c] = (unsigned)x;
        }
        *(u32x4*)(HQ + (size_t)t * DM + 16 * lane) = o;
        if (lane == 0) { const f32x4 sq = *(const f32x4*)((const float*)(p.ws + OFF_SSQP) + (size_t)t * 4);
            HSC[t] = rsqrtf(((sq.x + sq.y) + (sq.z + sq.w)) * (1.f / DM) + EPS) * am * (1.f / 224.f); }
    }
}
__device__ __forceinline__ void p5a_wave(const Params& p, LAS unsigned char* wl, int tb, int part, int lane, __amdgpu_buffer_rsrc_t urs, __amdgpu_buffer_rsrc_t hrs) {
    const float* USC = (const float*)(p.ws + OFF_USC); const float* HSC = (const float*)(p.ws + OFF_HSC);
    const unsigned* PW0 = (const unsigned*)(p.ws + OFF_PW0); unsigned* PW = (unsigned*)(p.ws + OFF_PW);
    const int l15 = lane & 15, g = lane >> 4;
    unsigned xl[4], xh[4]; float hsc = 0.f;
#define P5A_STAGE(t0_) do { _Pragma("unroll") for (int _k = 0; _k < 4; ++_k) { \
        __builtin_amdgcn_raw_ptr_buffer_load_lds(hrs, (LAS unsigned*)(wl + _k * 1024), 16, lane * 16, ((t0_) + _k) * 1024, 0, 0); \
        xl[_k] = PW0[(size_t)((t0_) + _k) * 128 + lane]; xh[_k] = PW0[(size_t)((t0_) + _k) * 128 + 64 + lane]; } \
        hsc = HSC[(t0_) + (lane & 3)]; } while (0)
#define P5A_GATHER(tile_) do { int _li = (tile_) * 16 + l15; _li = _li < n ? _li : n - 1; \
        const int _ev = (int)((*(const LAS unsigned*)(wl + P5A_LIST + _li * 4) & 0x3fffu) << 10); \
        _Pragma("unroll") for (int _r = 0; _r < 16; ++_r) \
            __builtin_amdgcn_raw_ptr_buffer_load_lds(urs, (LAS unsigned*)(wl + _r * P5A_RS), 16, lane * 16, __builtin_amdgcn_readlane(_ev, _r), 0, 0); } while (0)
    P5A_STAGE(tb);
    for (int st = 0; st < 4; ++st) {
        const int t0 = tb + 4 * st;
        asm volatile("s_waitcnt vmcnt(0)" ::: "memory");
        long bq[32];
#pragma unroll
        for (int s = 0; s < 32; ++s) bq[s] = __builtin_bit_cast(long, *(const LAS u32x2*)(wl + (l15 & 3) * 1024 + 32 * s + 8 * g));
        if (lane < 4) *(LAS float*)(wl + P5A_TSC + lane * 4) = hsc;
        int n = 0;
#pragma unroll
        for (int k = 0; k < 4; ++k) {
            const bool ml = (int)((xl[k] >> 11) & 7u) == part, mh = (int)((xh[k] >> 11) & 7u) == part;
            const unsigned long long bl = __ballot(ml), bh = __ballot(mh);
            const int rl = __builtin_amdgcn_mbcnt_hi((unsigned)(bl >> 32), __builtin_amdgcn_mbcnt_lo((unsigned)bl, 0u));
            if (ml) *(LAS unsigned*)(wl + P5A_LIST + (n + rl) * 4) = (xl[k] & 0x3fffu) | ((unsigned)lane << 14) | ((unsigned)k << 21);
            n += __popcll(bl);
            const int rh = __builtin_amdgcn_mbcnt_hi((unsigned)(bh >> 32), __builtin_amdgcn_mbcnt_lo((unsigned)bh, 0u));
            if (mh) *(LAS unsigned*)(wl + P5A_LIST + (n + rh) * 4) = (xh[k] & 0x3fffu) | ((unsigned)(64 + lane) << 14) | ((unsigned)k << 21);
            n += __popcll(bh);
        }
        __builtin_amdgcn_s_waitcnt(0xC07F); __builtin_amdgcn_wave_barrier();
        asm volatile("" ::: "memory");
        const int ntile = (n + 15) >> 4;
        if (ntile == 0) { if (st < 3) P5A_STAGE(t0 + 4); continue; }
        P5A_GATHER(0);
        for (int tile = 0; tile < ntile; ++tile) {
            asm volatile("s_waitcnt vmcnt(0)" ::: "memory");
            int ei = tile * 16 + l15; const bool eok = ei < n; ei = eok ? ei : n - 1;
            const unsigned ent = *(const LAS unsigned*)(wl + P5A_LIST + ei * 4);
            const unsigned ee = ent & 0x3fffu; const int sl = (int)((ent >> 14) & 127u), tk = (int)(ent >> 21), t = t0 + tk;
            float usc = USC[ee]; unsigned xg = PW0[(size_t)t * 128 + sl];
            long aq[32];
#pragma unroll
            for (int s = 0; s < 32; ++s) aq[s] = __builtin_bit_cast(long, *(const LAS u32x2*)(wl + l15 * P5A_RS + 32 * s + 8 * g));
            asm volatile("s_waitcnt vmcnt(0) lgkmcnt(0)" : "+v"(usc), "+v"(xg) :: "memory");
#pragma unroll
            for (int s = 0; s < 32; ++s) asm volatile("" : "+v"(aq[s]));
            if (tile + 1 < ntile) P5A_GATHER(tile + 1); else if (st < 3) P5A_STAGE(t0 + 4);
            f32x4 acc = (f32x4){0.f, 0.f, 0.f, 0.f};
#pragma unroll
            for (int s = 0; s < 32; ++s) acc = __builtin_amdgcn_mfma_f32_16x16x32_fp8_fp8(aq[s], bq[s], acc, 0, 0, 0);
            {
                const u32x4 en = *(const LAS u32x4*)(wl + P5A_LIST + (tile * 16 + 4 * g) * 4);
#pragma unroll
                for (int r = 0; r < 4; ++r) if ((int)(en[r] >> 21) == l15) *(LAS float*)(wl + P5A_RES + (4 * g + r) * 4) = acc[r];
            }
            __builtin_amdgcn_s_waitcnt(0xC07F); __builtin_amdgcn_wave_barrier();
            asm volatile("" ::: "memory");
            if (lane < 16 && eok) {
                const float d = *(const LAS float*)(wl + P5A_RES + lane * 4) * usc * *(const LAS float*)(wl + P5A_TSC + tk * 4);
                const float w = __uint_as_float(xg & 0xffff0000u) * gelu_f(d);
                PW[(((size_t)(t >> 6) * 32 + (sl >> 2)) * 64 + (t & 63)) * 4 + (sl & 3)] = ee | (f2bf(w) << 16);
            }
            __builtin_amdgcn_s_waitcnt(0xC07F); __builtin_amdgcn_wave_barrier();
            asm volatile("" ::: "memory");
        }
    }
    asm volatile("s_waitcnt vmcnt(0)" ::: "memory");
#undef P5A_STAGE
#undef P5A_GATHER
}
__device__ __forceinline__ void phase5a(const Params& p, LAS unsigned char* lds, int qoff = 0) {
    const int tid = threadIdx.x, lane = tid & 63, wave = __builtin_amdgcn_readfirstlane(tid >> 6);
    const int xcc = (int)(__builtin_amdgcn_s_getreg((3 << 11) | 20) & 7u);
    unsigned* qc = (unsigned*)(p.ws + OFF_CTL) + 256 + qoff;
    LAS unsigned char* wl = lds + wave * P5A_WAVE;
    const __amdgpu_buffer_rsrc_t urs = __builtin_amdgcn_make_buffer_rsrc((void*)(p.ws + OFF_UB), 0, NEXP * DM, 0x00020000);
    const __amdgpu_buffer_rsrc_t hrs = __builtin_amdgcn_make_buffer_rsrc((void*)(p.ws + OFF_HQ), 0, NTOK * DM, 0x00020000);
    for (int pi = 0; pi < 8; ++pi) {
        const int part = (xcc + pi) & 7;
        for (;;) {
            __syncthreads();
            if (tid == 0) *(LAS unsigned*)(lds + LDS_Q) = atomicAdd(qc + part * 64, 1u);
            __syncthreads();
            const int it = (int)*(LAS unsigned*)(lds + LDS_Q);
            if (it >= NTOK / 128) break;
            p5a_wave(p, wl, it * 128 + wave * 16, part, lane, urs, hrs);
        }
    }
}

__device__ __forceinline__ void p5b_quad(const LAS unsigned char* lds, u32x4 q, float& a0, float& a1, float& a2, float& a3) {
#pragma unroll
    for (int c = 0; c < 4; ++c) {
        const unsigned x = q[c];
        const u32x2 vv = *(const LAS u32x2*)(lds + ((x & 0x3fffu) << 3));
        const unsigned wlo = x >> 16, whi = x & 0xffff0000u;
        a0 = dot2(wlo, vv.x, a0); a1 = dot2(whi, vv.x, a1); a2 = dot2(wlo, vv.y, a2); a3 = dot2(whi, vv.y, a3);
    }
}
__device__ __forceinline__ void phase5b(const Params& p, LAS unsigned char* lds) {
    const int tid = threadIdx.x, lane = tid & 63, wave = __builtin_amdgcn_readfirstlane(tid >> 6);
    const bf16_t* VS = (const bf16_t*)(p.ws + OFF_VB); const u32x4* PW = (const u32x4*)(p.ws + OFF_PW); float* OUTS = (float*)(p.ws + OFF_OUTS);
    for (int s = blockIdx.x; s < 256; s += gridDim.x) {
        __syncthreads();
#pragma unroll 4
        for (int i = 0; i < 16; ++i) *(LAS u32x4*)(lds + (tid + NTHR * i) * 16) = *(const u32x4*)((const unsigned char*)VS + (size_t)s * 131072 + (size_t)(tid + NTHR * i) * 16);
        __syncthreads();
        u32x4 A[8], Bq[8];
#define P5B_LOAD(R, gi) do { const int _T = wave + 8 * ((gi) >> 2), _g = (gi) & 3; const u32x4* _p = PW + ((size_t)_T * 32 + _g * 8) * 64 + lane; \
        _Pragma("unroll") for (int _i = 0; _i < 8; ++_i) R[_i] = _p[_i * 64]; } while (0)
        float a0 = 0.f, a1 = 0.f, a2 = 0.f, a3 = 0.f;
        P5B_LOAD(A, 0);
        for (int gi = 0; gi < 128; gi += 2) {
            P5B_LOAD(Bq, gi + 1);
#pragma unroll
            for (int i = 0; i < 8; ++i) p5b_quad(lds, A[i], a0, a1, a2, a3);
            if (gi + 2 < 128) P5B_LOAD(A, gi + 2);
#pragma unroll
            for (int i = 0; i < 8; ++i) p5b_quad(lds, Bq[i], a0, a1, a2, a3);
            if (((gi + 1) & 3) == 3) {
                const int T = wave + 8 * (gi >> 2);
                *(f32x4*)(OUTS + ((size_t)s * NTOK + T * 64 + lane) * 4) = (f32x4){a0, a1, a2, a3};
                a0 = 0.f; a1 = 0.f; a2 = 0.f; a3 = 0.f;
            }
        }
#undef P5B_LOAD
    }
}

__device__ __forceinline__ void phase5c(const Params& p, LAS unsigned char* lds) {
    const int tid = threadIdx.x, lane = tid & 63, wave = __builtin_amdgcn_readfirstlane(tid >> 6);
    const float* OUTS = (const float*)(p.ws + OFF_OUTS); const float* fw = p.in[20];
    for (int it = blockIdx.x; it < NTOK / 32; it += gridDim.x) {
        const int t0 = it * 32;
        __syncthreads();
#pragma unroll 4
        for (int i = 0; i < 16; ++i) {
            const int s = (tid >> 5) + 16 * i, tt = tid & 31;
            *(LAS f32x4*)(lds + tt * 4112 + s * 16) = *(const f32x4*)(OUTS + ((size_t)s * NTOK + t0 + tt) * 4);
        }
        __syncthreads();
        for (int i = 0; i < 4; ++i) {
            const int tt = wave * 4 + i; float* orow = p.out + (size_t)(t0 + tt) * DM;
            f32x4 h[4]; float ss = 0.f;
#pragma unroll
            for (int j = 0; j < 4; ++j) { h[j] = *(const f32x4*)(orow + 4 * lane + 256 * j) + *(const LAS f32x4*)(lds + tt * 4112 + (4 * lane + 256 * j) * 4);
                ss += h[j].x * h[j].x + h[j].y * h[j].y + h[j].z * h[j].z + h[j].w * h[j].w; }
            const float rs = rsqrtf(wave_sum(ss) * (1.f / DM) + EPS);
#pragma unroll
            for (int j = 0; j < 4; ++j) *(f32x4*)(orow + 4 * lane + 256 * j) = h[j] * rs * *(const f32x4*)(fw + 4 * lane + 256 * j);
        }
    }
}


#define XB_TMO      128
#define XB_XCNT(j)  (256  + 64 * (j))
#define XB_XSUB(j)  (1280 + 64 * (j))
#define XB_XGEN(j)  (2304 + 64 * (j))
#define XB_TOP      3328
#define XB_TOPGEN   3392
#define XCD_BAR_WORDS 3456
#define XB_SPIN_CAP (1u << 18)
__device__ __forceinline__ unsigned xb_ld(unsigned* p)              { return __hip_atomic_load(p, __ATOMIC_RELAXED, __HIP_MEMORY_SCOPE_AGENT); }
__device__ __forceinline__ unsigned xb_add(unsigned* p, unsigned v) { return __hip_atomic_fetch_add(p, v, __ATOMIC_RELAXED, __HIP_MEMORY_SCOPE_AGENT); }
__device__ __forceinline__ unsigned xb_xcc_id() { return (unsigned)__builtin_amdgcn_s_getreg((3 << 11) | 20) & 0xFu; }
#define XB_SPIN(cond, bar) do { unsigned _sp = 0; while (cond) { __builtin_amdgcn_s_sleep(1); \
    if ((++_sp & 255u) == 0u) { if (xb_ld(&(bar)[XB_TMO])) break; if (_sp > XB_SPIN_CAP) { atomicAdd(&(bar)[XB_TMO], 1u); break; } } } } while (0)
struct XcdBarrier { unsigned* bar; unsigned x; volatile LAS unsigned* st; };
__device__ __forceinline__ XcdBarrier xcd_barrier_post(unsigned* bar, volatile LAS unsigned* st) {
    XcdBarrier b; b.bar = bar; b.x = xb_xcc_id(); b.st = st;
    if (threadIdx.x == 0) (void)xb_add(&bar[XB_XCNT(b.x)], 1u);
    return b;
}
__device__ __forceinline__ void xcd_barrier_complete(unsigned* bar, unsigned x, unsigned& nloc, unsigned& nx) {
    const unsigned G = gridDim.x * gridDim.y * gridDim.z;
    unsigned sum, cnt, mine, sp = 0u;
    for (;;) {
        sum = 0u; cnt = 0u; mine = 0u;
#pragma unroll
        for (unsigned j = 0; j < 16; ++j) { const unsigned c = xb_ld(&bar[XB_XCNT(j)]); sum += c; cnt += (c > 0u) ? 1u : 0u; mine = (j == x) ? c : mine; }
        if (sum == G) break;
        __builtin_amdgcn_s_sleep(1);
        if ((++sp & 255u) == 0u) { if (xb_ld(&bar[XB_TMO])) break; if (sp > XB_SPIN_CAP) { atomicAdd(&bar[XB_TMO], 1u); break; } }
    }
    nloc = mine > 0u ? mine : 1u; nx = cnt > 0u ? cnt : 1u;
}
__device__ __forceinline__ void xcd_barrier(const XcdBarrier& b) {
    asm volatile("s_waitcnt vmcnt(0)" ::: "memory");
    __syncthreads();
    if (threadIdx.x == 0) {
        unsigned* bar = b.bar;
        __builtin_amdgcn_s_waitcnt(0);
        unsigned nloc = b.st[0], nx = b.st[1];
        if (nloc == 0u) { xcd_barrier_complete(bar, b.x, nloc, nx); b.st[0] = nloc; b.st[1] = nx; }
        const unsigned old = xb_add(&bar[XB_XSUB(b.x)], 1u);
        const unsigned gen = old / nloc;
        if (old + 1u == (gen + 1u) * nloc) {
            __builtin_amdgcn_fence(__ATOMIC_RELEASE, "agent");
            asm volatile("s_waitcnt vmcnt(0)" ::: "memory");
            const unsigned og = xb_add(&bar[XB_TOP], 1u);
            const unsigned tg = og / nx;
            if (og + 1u == (tg + 1u) * nx) xb_add(&bar[XB_TOPGEN], 1u);
            else XB_SPIN(xb_ld(&bar[XB_TOPGEN]) == tg, bar);
            __builtin_amdgcn_fence(__ATOMIC_ACQUIRE, "agent");
            xb_add(&bar[XB_XGEN(b.x)], 1u);
            asm volatile("s_waitcnt vmcnt(0)" ::: "memory");
        } else {
            XB_SPIN(xb_ld(&bar[XB_XGEN(b.x)]) == gen, bar);
            __builtin_amdgcn_fence(__ATOMIC_ACQUIRE, "agent");
            asm volatile("s_waitcnt vmcnt(0)" ::: "memory");
        }
    }
    __syncthreads();
}

constexpr int NPHASE = 9;
__global__ void __launch_bounds__(NTHR, 2) mega(Params p) {
    extern __shared__ __attribute__((aligned(16))) unsigned char lds[];
    cg::grid_group grid = cg::this_grid();
#define PH_ON(k) (p.ph_lo <= (k) && (k) < p.ph_hi)
    if (threadIdx.x < 2) ((LAS unsigned*)((LAS unsigned char*)lds + LDS_BYTES - 32))[threadIdx.x] = 0u;
    __syncthreads();
    const XcdBarrier xbar = xcd_barrier_post((unsigned*)(p.ws + OFF_CTL) + 8192, (volatile LAS unsigned*)((LAS unsigned char*)lds + LDS_BYTES - 32));
#define PH_SYNC(k) do { if (PH_ON(k) && PH_ON((k) + 1)) { if ((k) == 0) grid.sync(); else xcd_barrier(xbar); } } while (0)
    if (PH_ON(0)) phase0(p, lds);
    PH_SYNC(0);
    if (PH_ON(1)) phase1_mfma(p, (LAS unsigned char*)lds);
#if PROBE_DUP == 1
    grid.sync(); phase1_mfma(p, (LAS unsigned char*)lds);
#endif
    PH_SYNC(1);
    if (PH_ON(2)) phase2(p, (LAS unsigned char*)lds);
#if PROBE_DUP == 2
    grid.sync(); phase2(p, (LAS unsigned char*)lds, 1);
#endif
    PH_SYNC(2);
    if (PH_ON(3)) phase2c(p);
    PH_SYNC(3);
    if (PH_ON(4)) phase3_mfma(p, (LAS unsigned char*)lds);
#if PROBE_DUP == 4
    grid.sync(); phase3_mfma(p, (LAS unsigned char*)lds);
#endif
    PH_SYNC(4);
    if (PH_ON(5)) { phase4_mfma(p, (LAS unsigned char*)lds); quantize_hn(p); }
#if PROBE_DUP == 5
    grid.sync(); phase4_mfma(p, (LAS unsigned char*)lds);
#endif
    PH_SYNC(5);
    if (PH_ON(6)) phase5a(p, (LAS unsigned char*)lds);
#if PROBE_DUP == 6
    grid.sync(); phase5a(p, (LAS unsigned char*)lds, 1024);
#endif
    PH_SYNC(6);
    if (PH_ON(7)) phase5b(p, (LAS unsigned char*)lds);
#if PROBE_DUP == 7
    grid.sync(); phase5b(p, (LAS unsigned char*)lds);
#endif
    PH_SYNC(7);
    if (PH_ON(8)) phase5c(p, (LAS unsigned char*)lds);
}

extern "C" void kernel_launch(void* const* d_in, const int* in_sizes, int n_in, void* d_out, int out_size, void* d_ws, size_t ws_size, hipStream_t stream) {
    static int grid = 0;
    if (grid == 0) {
        if (n_in != 21 || out_size != NTOK * DM || ws_size < WS_END) { fprintf(stderr, "kernel_launch: unexpected shapes (n_in %d out %d ws %zu)\n", n_in, out_size, ws_size); grid = -1; return; }
        int dev = 0, cus = 0, per_cu = 0;
        hipGetDevice(&dev);
        hipDeviceGetAttribute(&cus, hipDeviceAttributeMultiprocessorCount, dev);
        hipFuncSetAttribute((const void*)mega, hipFuncAttributeMaxDynamicSharedMemorySize, LDS_BYTES);
        hipOccupancyMaxActiveBlocksPerMultiprocessor(&per_cu, (const void*)mega, NTHR, LDS_BYTES);
        if (per_cu < 1) { fprintf(stderr, "kernel_launch: occupancy query says %d blocks/CU\n", per_cu); per_cu = 1; }
        grid = cus * 1;
        (void)hipGetLastError();
    }
    if (grid < 0) return;
    hipMemsetAsync((char*)d_ws + OFF_CTL, 0, CTL_BYTES, stream);
    Params p{};
    for (int i = 0; i < 21; ++i) p.in[i] = (const float*)d_in[i];
    p.out = (float*)d_out; p.ws = (unsigned char*)d_ws; p.ph_lo = 0; p.ph_hi = NPHASE;
    void* args[] = {&p};
    hipError_t e = hipLaunchCooperativeKernel((const void*)mega, dim3(grid), dim3(NTHR), args, LDS_BYTES, stream);
    if (e != hipSuccess) fprintf(stderr, "cooperative launch failed: %s (grid %d)\n", hipGetErrorString(e), grid);
}
```

```cpp
#include <hip/hip_runtime.h>
#include <hip/hip_cooperative_groups.h>
#include <cstdio>
#include <cstdint>
namespace cg = cooperative_groups;

constexpr int DM = 1024;
constexpr int NB = 8, SEQ = 2048, NMETA = 16;
constexpr int NTOK = NB * SEQ;
constexpr int MROWS = 16640;
constexpr int NIN = 3584;
constexpr int TPOS = NMETA + SEQ;
constexpr float EPS = 1e-6f;
constexpr float QSCALE = 0.125f * 1.4426950408889634f;
constexpr int NEXP = 16384;
constexpr int NTHR = 512;
#ifndef PROBE_DUP
#define PROBE_DUP 0
#endif

constexpr size_t MiB = 1u << 20;
constexpr size_t OFF_CTL = 0, CTL_BYTES = 64 * 1024;
constexpr size_t OFF_MISC = 512 * 1024;
constexpr size_t OFF_ROPE = 1 * MiB;
constexpr size_t OFF_WOUT = 2 * MiB;
constexpr size_t OFF_WQ = 4 * MiB;
constexpr size_t OFF_KEYS = 8 * MiB;
constexpr size_t OFF_SSQP = 25 * MiB;
constexpr size_t OFF_UB = 9 * MiB;
constexpr size_t OFF_VB = 41 * MiB;
constexpr size_t OFF_XN = 73 * MiB;
constexpr size_t OFF_MIX = 73 * MiB;
constexpr size_t OFF_WIN = 106 * MiB;
constexpr size_t OFF_QB = 113 * MiB;
constexpr size_t OFF_KB = OFF_QB + 16 * MiB + 256 * 1024;
constexpr size_t OFF_VT = OFF_KB + 16 * MiB + 256 * 1024;
constexpr size_t OFF_H2B = 113 * MiB;
constexpr size_t OFF_GQ = 162 * MiB;
constexpr size_t OFF_GK = OFF_GQ + 8 * MiB + 256 * 1024;
constexpr size_t OFF_GVT = OFF_GK + 8 * MiB + 256 * 1024;
constexpr size_t OFF_GF = OFF_GVT + 16 * MiB + 256 * 1024;
constexpr size_t OFF_GB = OFF_GF + 16 * MiB + 256 * 1024;
constexpr size_t OFF_GR = OFF_GB + 16 * MiB + 256 * 1024;
constexpr size_t OFF_PW0 = 162 * MiB;
constexpr size_t OFF_USC = 64 * 1024;
constexpr size_t OFF_VSC = 128 * 1024;
constexpr size_t WS_END = OFF_GR + 16 * MiB + 256 * 1024;
static_assert(WS_END <= 256 * MiB, "workspace map");
static_assert(OFF_VT + (size_t)512 * MROWS * 2 <= OFF_GQ, "map D");
static_assert(OFF_WIN + (size_t)NIN * DM * 2 <= OFF_QB, "map C");

constexpr int LDS_BYTES = 163840;

typedef unsigned short bf16_t;
typedef float f32x4 __attribute__((ext_vector_type(4)));
typedef float f32x2 __attribute__((ext_vector_type(2)));
typedef unsigned u32x4 __attribute__((ext_vector_type(4)));
typedef unsigned u32x2 __attribute__((ext_vector_type(2)));
typedef __bf16 bf16x2_t __attribute__((ext_vector_type(2)));

struct Params {
    const float* in[21];
    float* out;
    unsigned char* ws;
    int ph_lo, ph_hi;
};

__device__ __forceinline__ unsigned f2bf(float f) { unsigned u = __float_as_uint(f); return (u + 0x7fffu + ((u >> 16) & 1u)) >> 16; }
__device__ __forceinline__ float bf2f(unsigned h) { return __uint_as_float(h << 16); }
__device__ __forceinline__ unsigned pk2(float lo, float hi) { return __builtin_bit_cast(unsigned, __builtin_convertvector((f32x2){lo, hi}, bf16x2_t)); }
__device__ __forceinline__ float bflo(unsigned w) { return __uint_as_float(w << 16); }
__device__ __forceinline__ float bfhi(unsigned w) { return __uint_as_float(w & 0xffff0000u); }
__device__ __forceinline__ float dot2(unsigned a, unsigned b, float c) {
    return __builtin_amdgcn_fdot2_f32_bf16(__builtin_bit_cast(bf16x2_t, a), __builtin_bit_cast(bf16x2_t, b), c, false);
}
__device__ __forceinline__ float dot8(u32x4 a, u32x4 b, float c) { c = dot2(a.x, b.x, c); c = dot2(a.y, b.y, c); c = dot2(a.z, b.z, c); return dot2(a.w, b.w, c); }
__device__ __forceinline__ float wave_sum(float v) {
#pragma unroll
    for (int o = 1; o < 64; o <<= 1) v += __shfl_xor(v, o);
    return v;
}
__device__ __forceinline__ float wave_max(float v) {
#pragma unroll
    for (int o = 1; o < 64; o <<= 1) v = fmaxf(v, __shfl_xor(v, o));
    return v;
}
__device__ __forceinline__ float silu_f(float x) { return x / (1.f + __expf(-x)); }
__device__ __forceinline__ float logsig_f(float x) { return fminf(x, 0.f) - log1pf(__expf(-fabsf(x))); }
__device__ __forceinline__ float gelu_f(float v) {
    const float av = fabsf(v), t = __builtin_amdgcn_rcpf(av * 0.2316418882f + 1.0f);
    float q = t * 0.5307027145f + (-0.7265760135f); q = q * t + 0.7107068705f; q = q * t + (-0.142248368f); q = q * t + 0.127414796f; q = q * t;
    const float m = v * (q * __builtin_amdgcn_exp2f(v * v * (-0.72134752044f)));
    return v < 0.f ? m : v - m;
}

__device__ __forceinline__ float win_src(const Params& p, int k, int n) {
    const float* W = p.in[3] + (size_t)k * 3104;
    if (n < 1024) {
        const int base = n & ~63, dp = n & 63, d = dp < 16 ? ((dp >> 1) + 8 * (dp & 1)) : dp;
        return W[base + d];
    } else if (n < 3072) return W[n];
    const int j = (n - 3072) & 255, dir = (n - 3072) >> 8;
    const float* w2 = p.in[dir ? 11 : 9];
    const float* wz = W + 3072 + dir * 16;
    float s = 0.f;
#pragma unroll
    for (int r = 0; r < 16; ++r) s += wz[r] * w2[r * 256 + j];
    return s;
}

template <int WHICH>
__device__ __forceinline__ void p0_transpose_item(const Params& p, float* scr, int item, int lane) {
    constexpr int N = WHICH == 0 ? NIN : (WHICH == 1 ? 1024 : 2048);
    constexpr int nblk = N / 32;
    const int kb = item / nblk, nb = item % nblk, k0 = 64 * kb, n0 = 32 * nb;
    bf16_t* WT = (bf16_t*)(p.ws + (WHICH == 0 ? OFF_WIN : (WHICH == 1 ? OFF_WOUT : OFF_WQ)));
#pragma unroll 4
    for (int i = 0; i < 32; ++i) {
        const int kk = 2 * i + (lane >> 5), k = k0 + kk, n = n0 + (lane & 31);
        float v;
        if (WHICH == 0) v = win_src(p, k, n);
        else if (WHICH == 1) v = p.in[14][(size_t)k * 1024 + n];
        else v = p.in[16][(size_t)k * 2048 + n] * p.in[15][k];
        scr[kk * 33 + (lane & 31)] = v;
    }
    __builtin_amdgcn_s_waitcnt(0xC07F); __builtin_amdgcn_wave_barrier();
    const int c = lane & 7;
#pragma unroll
    for (int j = 0; j < 4; ++j) {
        const int n = (lane >> 3) + 8 * j; const float* s = scr + (8 * c) * 33 + n;
        u32x4 o; o.x = pk2(s[0 * 33], s[1 * 33]); o.y = pk2(s[2 * 33], s[3 * 33]); o.z = pk2(s[4 * 33], s[5 * 33]); o.w = pk2(s[6 * 33], s[7 * 33]);
        *(u32x4*)(WT + (size_t)(n0 + n) * 1024 + k0 + 8 * c) = o;
    }
    __builtin_amdgcn_s_waitcnt(0xC07F); __builtin_amdgcn_wave_barrier();
}

__device__ __forceinline__ void phase0(const Params& p, unsigned char* lds) {
    const int tid = threadIdx.x, lane = tid & 63, wave = tid >> 6;
    const int gw = blockIdx.x * 8 + wave, NGW = gridDim.x * 8;
    const long gt = (long)blockIdx.x * NTHR + tid, NGT = (long)gridDim.x * NTHR;
    {
        const f32x4* lw = (const f32x4*)p.in[2];
        bf16_t* XN = (bf16_t*)(p.ws + OFF_XN);
        for (int r = gw; r < MROWS; r += NGW) {
            const float* src = r < NTOK ? p.in[0] + (size_t)r * DM : (r < NTOK + NMETA ? p.in[1] + (size_t)(r - NTOK) * DM : nullptr);
            f32x4 v[4]; float s = 0.f;
#pragma unroll
            for (int j = 0; j < 4; ++j) { v[j] = src ? ((const f32x4*)src)[lane + 64 * j] : (f32x4){0.f, 0.f, 0.f, 0.f}; s += v[j].x * v[j].x + v[j].y * v[j].y + v[j].z * v[j].z + v[j].w * v[j].w; }
            const float rs = rsqrtf(wave_sum(s) * (1.f / DM) + EPS);
#pragma unroll
            for (int j = 0; j < 4; ++j) { const f32x4 w = lw[lane + 64 * j]; u32x2 o; o.x = pk2(v[j].x * rs * w.x, v[j].y * rs * w.y); o.y = pk2(v[j].z * rs * w.z, v[j].w * rs * w.w);
                *(u32x2*)(XN + (size_t)r * DM + 4 * (lane + 64 * j)) = o; }
        }
    }
    {
        float* scr = (float*)lds + wave * (64 * 33);
        constexpr int I0 = 16 * (NIN / 32);
        for (int it = gw; it < I0; it += NGW) p0_transpose_item<0>(p, scr, it, lane);
    }
    {
        f32x2* rope = (f32x2*)(p.ws + OFF_ROPE);
        for (long i = gt; i < TPOS * 8; i += NGT) {
            const int t = (int)(i >> 3), j = (int)(i & 7);
            const float inv = powf(500000.0f, -(float)j * 0.125f);
            const float ang = (float)t * inv;
            rope[i] = (f32x2){cosf(ang), sinf(ang)};
        }
        if (gt == 0) {
            float a = 0.f, b = 0.f;
            for (int i = 0; i < 64; ++i) { a += p.in[4][i] * p.in[5][i]; b += p.in[6][i] * p.in[7][i]; }
            ((float*)(p.ws + OFF_MISC))[0] = expf(a) - expf(b) + 0.2f;
        }
    }
}
constexpr int CV_WOUT = 64, CV_WQ = 128, CV_KEYS = 8, CV_U = 256, CV_V = 256, CV_ITEMS = CV_WOUT + CV_WQ + CV_KEYS + CV_U + CV_V;
__device__ __forceinline__ void conv_item(const Params& p, unsigned char* lds, int c) {
    const int tid = threadIdx.x, lane = tid & 63, wave = tid >> 6;
    __syncthreads();
    if (c < CV_WOUT) { p0_transpose_item<1>(p, (float*)lds + wave * (64 * 33), c * 8 + wave, lane); return; }
    c -= CV_WOUT;
    if (c < CV_WQ) { p0_transpose_item<2>(p, (float*)lds + wave * (64 * 33), c * 8 + wave, lane); return; }
    c -= CV_WQ;
    if (c < CV_KEYS) {
        bf16_t* KEYS = (bf16_t*)(p.ws + OFF_KEYS);
#pragma unroll 2
        for (int j = 0; j < 8; ++j) {
            const long e = ((long)c * 4096 + tid + NTHR * j) * 8;
            const f32x4 a = *(const f32x4*)(p.in[17] + e), b = *(const f32x4*)(p.in[17] + e + 4);
            u32x4 o; o.x = pk2(a.x, a.y); o.y = pk2(a.z, a.w); o.z = pk2(b.x, b.y); o.w = pk2(b.z, b.w);
            *(u32x4*)(KEYS + e) = o;
        }
        return;
    }
    c -= CV_KEYS;
    if (c < CV_U) {
        unsigned char* UQ = p.ws + OFF_UB; float* USC = (float*)(p.ws + OFF_USC);
#pragma unroll 2
        for (int i = 0; i < 8; ++i) {
            const int r = c * 64 + wave * 8 + i;
            const float* ur = p.in[18] + (size_t)r * DM + 16 * lane; const float* lw = p.in[15] + 16 * lane;
            f32x4 v[4]; float am = 0.f;
#pragma unroll
            for (int j = 0; j < 4; ++j) { v[j] = ((const f32x4*)ur)[j] * ((const f32x4*)lw)[j]; am = fmaxf(am, fmaxf(fmaxf(fabsf(v[j].x), fabsf(v[j].y)), fmaxf(fabsf(v[j].z), fabsf(v[j].w)))); }
            am = fmaxf(wave_max(am), 1e-30f);
            const float sc = 224.f / am;
            u32x4 o;
#pragma unroll
            for (int j = 0; j < 4; ++j) { int w = __builtin_amdgcn_cvt_pk_fp8_f32(v[j].x * sc, v[j].y * sc, 0, false); w = __builtin_amdgcn_cvt_pk_fp8_f32(v[j].z * sc, v[j].w * sc, w, true); o[j] = (unsigned)w; }
            *(u32x4*)(UQ + (size_t)r * DM + 16 * lane) = o;
            if (lane == 0) USC[r] = am * (1.f / 224.f);
        }
        return;
    }
    c -= CV_U;
    {
        unsigned char* VS = p.ws + OFF_VB; float* VSC = (float*)(p.ws + OFF_VSC);
        const int tile = c;
#pragma unroll 2
        for (int i = 0; i < 8; ++i) {
            const int er = wave * 8 + i, r = tile * 64 + er;
            const float* vr = p.in[19] + (size_t)r * DM + 16 * lane;
            f32x4 v[4]; float am = 0.f;
#pragma unroll
            for (int j = 0; j < 4; ++j) { v[j] = ((const f32x4*)vr)[j]; am = fmaxf(am, fmaxf(fmaxf(fabsf(v[j].x), fabsf(v[j].y)), fmaxf(fabsf(v[j].z), fabsf(v[j].w)))); }
            am = fmaxf(wave_max(am), 1e-30f);
            const float sc = 224.f / am;
            u32x4 o;
#pragma unroll
            for (int j = 0; j < 4; ++j) { int w = __builtin_amdgcn_cvt_pk_fp8_f32(v[j].x * sc, v[j].y * sc, 0, false); w = __builtin_amdgcn_cvt_pk_fp8_f32(v[j].z * sc, v[j].w * sc, w, true); o[j] = (unsigned)w; }
            *(u32x2*)(lds + er * 1032 + 16 * lane) = (u32x2){o.x, o.y}; *(u32x2*)(lds + er * 1032 + 16 * lane + 8) = (u32x2){o.z, o.w};
            if (lane == 0) VSC[r] = am * (1.f / 224.f);
        }
        __syncthreads();
#pragma unroll 4
        for (int i = 0; i < 16; ++i) {
            const int s = wave + 8 * i;
            *(u32x2*)(VS + ((size_t)s * NEXP + tile * 64 + lane) * 8) = *(const u32x2*)(lds + lane * 1032 + s * 8);
        }
    }
}

struct P1Ptrs { unsigned char* ws; const float* bias_f; const float* bias_b; };
__device__ __forceinline__ void p1_store(const P1Ptrs p, int row, int n0, float v0, float v1, float v2, float v3) {
    if (n0 < 1024) {
        const int dp = n0 & 63;
        if (dp < 16) {
            const int pos = row < NTOK ? NMETA + (row & (SEQ - 1)) : (row - NTOK);
            const f32x4 cs = *(const f32x4*)((const float*)(p.ws + OFF_ROPE) + ((size_t)pos * 8 + (dp >> 1)) * 2);
            const float a0 = v0 * cs.x - v1 * cs.y, b0 = v1 * cs.x + v0 * cs.y;
            const float a1 = v2 * cs.z - v3 * cs.w, b1 = v3 * cs.z + v2 * cs.w;
            v0 = a0; v1 = b0; v2 = a1; v3 = b1;
        }
        if (n0 < 512) { u32x2 o; o.x = pk2(v0 * QSCALE, v1 * QSCALE); o.y = pk2(v2 * QSCALE, v3 * QSCALE); *(u32x2*)((bf16_t*)(p.ws + OFF_QB) + (size_t)row * 512 + n0) = o; }
        else { u32x2 o; o.x = pk2(v0, v1); o.y = pk2(v2, v3); *(u32x2*)((bf16_t*)(p.ws + OFF_KB) + (size_t)row * 512 + (n0 - 512)) = o; }
    } else if (n0 < 1536) {
        bf16_t* VT = (bf16_t*)(p.ws + OFF_VT) + (size_t)(n0 - 1024) * MROWS + row;
        VT[0] = (bf16_t)f2bf(v0); VT[MROWS] = (bf16_t)f2bf(v1); VT[2 * MROWS] = (bf16_t)f2bf(v2); VT[3 * (size_t)MROWS] = (bf16_t)f2bf(v3);
    } else if (n0 < 1792) {
        u32x2 o; o.x = pk2(v0 * 0.125f, v1 * 0.125f); o.y = pk2(v2 * 0.125f, v3 * 0.125f); *(u32x2*)((bf16_t*)(p.ws + OFF_GQ) + (size_t)row * 256 + (n0 - 1536)) = o;
    } else if (n0 < 2048) {
        u32x2 o; o.x = pk2(v0, v1); o.y = pk2(v2, v3); *(u32x2*)((bf16_t*)(p.ws + OFF_GK) + (size_t)row * 256 + (n0 - 1792)) = o;
    } else if (n0 < 2560) {
        bf16_t* VT = (bf16_t*)(p.ws + OFF_GVT) + (size_t)(n0 - 2048) * MROWS + row;
        VT[0] = (bf16_t)f2bf(v0); VT[MROWS] = (bf16_t)f2bf(v1); VT[2 * MROWS] = (bf16_t)f2bf(v2); VT[3 * (size_t)MROWS] = (bf16_t)f2bf(v3);
    } else if (n0 < 3072) {
        u32x2 o; o.x = pk2(silu_f(v0), silu_f(v1)); o.y = pk2(silu_f(v2), silu_f(v3)); *(u32x2*)((bf16_t*)(p.ws + OFF_GR) + (size_t)row * 512 + (n0 - 2560)) = o;
    } else {
        const int dir = (n0 - 3072) >> 8, j = (n0 - 3072) & 255;
        const f32x4 bb = *(const f32x4*)((dir ? p.bias_b : p.bias_f) + j);
        f32x4 o; o.x = logsig_f(v0 + bb.x) * 0.0625f; o.y = logsig_f(v1 + bb.y) * 0.0625f; o.z = logsig_f(v2 + bb.z) * 0.0625f; o.w = logsig_f(v3 + bb.w) * 0.0625f;
        *(f32x4*)((float*)(p.ws + (dir ? OFF_GB : OFF_GF)) + (size_t)row * 256 + j) = o;
    }
}


#define LAS __attribute__((address_space(3)))
typedef short bf16x8 __attribute__((ext_vector_type(8)));
constexpr int GBUF = 49152;

template <int ROWS>
__device__ __forceinline__ void stage_tile(const bf16_t* G, int ldk, int r0, int k0, LAS unsigned char* buf, int wave, int lane) {
    const int rr = lane >> 3, c = (lane & 7) ^ rr;
#pragma unroll
    for (int i = 0; i < ROWS / 64; ++i) {
        const int grp = wave + 8 * i;
        const bf16_t* src = G + (size_t)(r0 + grp * 8 + rr) * ldk + k0 + c * 8;
        __builtin_amdgcn_global_load_lds((const unsigned*)src, (LAS unsigned*)(buf + grp * 1024), 16, 0, 0);
    }
}
__device__ __forceinline__ bf16x8 ldfrag(const LAS unsigned char* buf, int row, int c) {
    return *(const LAS bf16x8*)(buf + row * 128 + ((c ^ (row & 7)) << 4));
}
template <bool SWAP>
__device__ __forceinline__ void gemm_tile_256(const bf16_t* A, const bf16_t* Bt, int K, int m0, int n0, LAS unsigned char* lds, f32x4 (&acc)[4][4]) {
    const int tid = threadIdx.x, lane = tid & 63, wave = __builtin_amdgcn_readfirstlane(tid >> 6), wm = wave >> 2, wn = wave & 3, l15 = lane & 15, g = lane >> 4;
#pragma unroll
    for (int i = 0; i < 4; ++i)
#pragma unroll
        for (int j = 0; j < 4; ++j) acc[i][j] = (f32x4){0.f, 0.f, 0.f, 0.f};
    const int nk = K / 64;
    stage_tile<128>(A, K, m0, 0, lds, wave, lane);
    stage_tile<256>(Bt, K, n0, 0, lds + 16384, wave, lane);
    for (int kt = 0; kt < nk; ++kt) {
        asm volatile("s_waitcnt vmcnt(0)" ::: "memory");
        __syncthreads();
        if (kt + 1 < nk) {
            LAS unsigned char* nb = lds + ((kt + 1) & 1) * GBUF;
            stage_tile<128>(A, K, m0, (kt + 1) * 64, nb, wave, lane);
            stage_tile<256>(Bt, K, n0, (kt + 1) * 64, nb + 16384, wave, lane);
        }
        const LAS unsigned char* a = lds + (kt & 1) * GBUF; const LAS unsigned char* b = a + 16384;
#pragma unroll
        for (int ks = 0; ks < 2; ++ks) {
            bf16x8 af[4], bfr[4];
#pragma unroll
            for (int i = 0; i < 4; ++i) { af[i] = ldfrag(a, wm * 64 + i * 16 + l15, ks * 4 + g); bfr[i] = ldfrag(b, wn * 64 + i * 16 + l15, ks * 4 + g); }
#pragma unroll
            for (int i = 0; i < 4; ++i)
#pragma unroll
                for (int j = 0; j < 4; ++j)
                    acc[i][j] = SWAP ? __builtin_amdgcn_mfma_f32_16x16x32_bf16(af[i], bfr[j], acc[i][j], 0, 0, 0)
                                     : __builtin_amdgcn_mfma_f32_16x16x32_bf16(bfr[j], af[i], acc[i][j], 0, 0, 0);
        }
    }
}
__device__ __forceinline__ int vcu_of_block() { const int G = gridDim.x, bx = blockIdx.x; return (G % 8 == 0) ? (bx % 8) * (G / 8) + bx / 8 : bx; }

namespace pg8 {
#define PG8_LAS __attribute__((address_space(3)))
typedef unsigned short bf16_t;
typedef short bf16x8 __attribute__((ext_vector_type(8)));
typedef float f32x4 __attribute__((ext_vector_type(4)));
typedef unsigned u32x4 __attribute__((ext_vector_type(4)));
constexpr int BM = 256, BK = 64, HALF = 128, HTB = HALF * BK * 2  , STAGE_BYTES = 8 * HTB, NXCD = 8, WGM = 8;

__host__ __device__ __forceinline__ int lds_byte(int r, int c) { const int st = (r >> 4) * 2 + (c >> 5), rr = r & 15, cc = c & 31, ob = rr * 64 + cc * 2; return st * 1024 + (ob ^ (((ob >> 9) & 1) << 5)); }
__host__ __device__ __forceinline__ void stage_rc(int b, int& R, int& C) { const int st = b / 1024, sb = b % 1024, swz = sb ^ (((sb >> 9) & 1) << 5); R = (st >> 1) * 16 + swz / 64; C = (st & 1) * 32 + (swz % 64) / 2; }
__host__ __device__ __forceinline__ int perm32(int rho) { const int n = rho >> 4, i = rho & 15; return 8 * (i >> 2) + 4 * n + (i & 3); }

struct Unit { int pm, pn; };
struct Gemm { const bf16_t* A; const bf16_t* Bt; int M, N, K; };

struct StaticOrder {
    int nM, nN, nwg, G, c;
    __host__ __device__ void init(int M, int N, int G_, int c_) { nM = M / BM; nN = N / BM; nwg = nM * nN; G = G_; c = c_; }
    __host__ __device__ bool next(int i, Unit& u) const {
        const long L = (long)i * G + c; if (L >= nwg) return false;
        int wgid = (int)L; { const int q = nwg / NXCD, r = nwg % NXCD, xcd = wgid % NXCD, off = wgid / NXCD; wgid = (xcd < r ? xcd * (q + 1) : r * (q + 1) + (xcd - r) * q) + off; }
        const int nig = WGM * nN, gid = wgid / nig, fm = gid * WGM, gsz = (nM - fm) < WGM ? (nM - fm) : WGM;
        u.pm = fm + ((wgid % nig) % gsz); u.pn = (wgid % nig) / gsz; return true;
    }
    __device__ __forceinline__ void a_ready(const Unit&) const {}
    __device__ __forceinline__ void done(const Unit&) const {}
};

struct EpiP1 {
    static constexpr bool PERM = false, AFTER_DRAIN = false;
    P1Ptrs p;
    __device__ __forceinline__ void operator()(const f32x4 (&acc)[2][2][4][2], const Unit& u, int wr, int wc, int fr, int fq) const {
#pragma unroll
        for (int bj = 0; bj < 2; ++bj) {
            const int nw = u.pn * BM + bj * HALF + wc * 32;
            const int rowb = u.pm * BM + wr * 64 + fr;
            if (nw >= 3072) {
                const int dir = (nw - 3072) >> 8, j0 = ((nw - 3072) & 255) + 4 * fq;
                float* G = (float*)(p.ws + (dir ? OFF_GB : OFF_GF)); const float* bias = dir ? p.bias_b : p.bias_f;
#pragma unroll
                for (int n = 0; n < 2; ++n) { const f32x4 bb = *(const f32x4*)(bias + j0 + 16 * n);
#pragma unroll
                    for (int ai = 0; ai < 2; ++ai)
#pragma unroll
                        for (int m = 0; m < 4; ++m) { const f32x4 v = acc[ai][bj][m][n]; f32x4 o;
                            o.x = logsig_f(v.x + bb.x) * 0.0625f; o.y = logsig_f(v.y + bb.y) * 0.0625f; o.z = logsig_f(v.z + bb.z) * 0.0625f; o.w = logsig_f(v.w + bb.w) * 0.0625f;
                            *(f32x4*)(G + (size_t)(rowb + ai * HALF + m * 16) * 256 + j0 + 16 * n) = o; } }
            } else if ((nw >= 1024 && nw < 1536) || (nw >= 2048 && nw < 2560)) {
                bf16_t* T = (bf16_t*)(p.ws + (nw < 1536 ? OFF_VT : OFF_GVT)) + (size_t)((nw < 1536 ? nw - 1024 : nw - 2048) + 4 * fq) * MROWS + rowb;
#pragma unroll
                for (int n = 0; n < 2; ++n)
#pragma unroll
                    for (int ai = 0; ai < 2; ++ai)
#pragma unroll
                        for (int m = 0; m < 4; ++m) { const f32x4 v = acc[ai][bj][m][n]; bf16_t* t = T + (size_t)(16 * n) * MROWS + ai * HALF + m * 16;
                            t[0] = (bf16_t)f2bf(v.x); t[MROWS] = (bf16_t)f2bf(v.y); t[2 * MROWS] = (bf16_t)f2bf(v.z); t[3 * (size_t)MROWS] = (bf16_t)f2bf(v.w); }
            } else {
                bf16_t* base; int ld, c0; float sc = 1.f; bool silu = false;
                if (nw < 512) { base = (bf16_t*)(p.ws + OFF_QB); ld = 512; c0 = nw; sc = QSCALE; }
                else if (nw < 1024) { base = (bf16_t*)(p.ws + OFF_KB); ld = 512; c0 = nw - 512; }
                else if (nw < 1792) { base = (bf16_t*)(p.ws + OFF_GQ); ld = 256; c0 = nw - 1536; sc = 0.125f; }
                else if (nw < 2048) { base = (bf16_t*)(p.ws + OFF_GK); ld = 256; c0 = nw - 1792; }
                else { base = (bf16_t*)(p.ws + OFF_GR); ld = 512; c0 = nw - 2560; silu = true; }
                const bool rope = nw < 1024 && (nw & 63) == 0;
#pragma unroll
                for (int ai = 0; ai < 2; ++ai)
#pragma unroll
                    for (int m = 0; m < 4; ++m) {
                        const int row = rowb + ai * HALF + m * 16;
#pragma unroll
                        for (int n = 0; n < 2; ++n) {
                            f32x4 v = acc[ai][bj][m][n];
                            if (n == 0 && rope) {
                                const int pos = row < NTOK ? NMETA + (row & (SEQ - 1)) : (row - NTOK < TPOS ? row - NTOK : 0);
                                const f32x4 cs = *(const f32x4*)((const float*)(p.ws + OFF_ROPE) + ((size_t)pos * 8 + 2 * fq) * 2);
                                const float a0 = v.x * cs.x - v.y * cs.y, b0 = v.y * cs.x + v.x * cs.y, a1 = v.z * cs.z - v.w * cs.w, b1 = v.w * cs.z + v.z * cs.w;
                                v = (f32x4){a0, b0, a1, b1};
                            }
                            if (silu) v = (f32x4){silu_f(v.x), silu_f(v.y), silu_f(v.z), silu_f(v.w)}; else v = v * sc;
                            *(u32x2*)(base + (size_t)row * ld + c0 + 16 * n + 4 * fq) = (u32x2){pk2(v.x, v.y), pk2(v.z, v.w)};
                        }
                    }
            }
        }
    }
};
struct EpiP3 {
    static constexpr bool PERM = false, AFTER_DRAIN = false;
    const float* x; float* out; bf16_t* h2b; float* ssq;
    __device__ __forceinline__ void operator()(const f32x4 (&acc)[2][2][4][2], const Unit& u, int wr, int wc, int fr, int fq) const {
#pragma unroll
        for (int ai = 0; ai < 2; ++ai)
#pragma unroll
            for (int m = 0; m < 4; ++m) { const int row = u.pm * BM + ai * HALF + wr * 64 + m * 16 + fr; float ss = 0.f;
#pragma unroll
                for (int bj = 0; bj < 2; ++bj)
#pragma unroll
                    for (int n = 0; n < 2; ++n) { const int col = u.pn * BM + bj * HALF + wc * 32 + n * 16 + 4 * fq;
                        const f32x4 hv = *(const f32x4*)(x + (size_t)row * DM + col) + acc[ai][bj][m][n];
                        *(f32x4*)(out + (size_t)row * DM + col) = hv;
                        *(u32x2*)(h2b + (size_t)row * DM + col) = (u32x2){pk2(hv.x, hv.y), pk2(hv.z, hv.w)};
                        ss += hv.x * hv.x + hv.y * hv.y + hv.z * hv.z + hv.w * hv.w; }
                ss += __shfl_xor(ss, 16); ss += __shfl_xor(ss, 32);
                if (fq == 0) ssq[(size_t)row * 16 + u.pn * 4 + wc] = ss; }
    }
};
struct OneUnit {
    Unit u; bool valid;
    __device__ __forceinline__ bool next(int i, Unit& o) const { if (i != 0 || !valid) return false; o = u; return true; }
    __device__ __forceinline__ void a_ready(const Unit&) const {}
    __device__ __forceinline__ void done(const Unit&) const {}
};

template <class Epi, class Sched, bool ALIGN_EPI = false, bool SP2 = false>
__device__ __forceinline__ void gemm_phase(PG8_LAS unsigned char* lds, const Gemm g, const Sched& S, const Epi& E) {
    const int tid = threadIdx.x, wid = __builtin_amdgcn_readfirstlane(tid >> 6), lane = tid & 63, wr = wid >> 2, wc = wid & 3, fr = lane & 15, fq = lane >> 4;
    const int K = g.K, nt = K / BK;
    unsigned voffA[2], voffB[2];
#pragma unroll
    for (int i = 0; i < 2; ++i) { int R, C; stage_rc(tid * 16 + i * 8192, R, C); const int Rb = Epi::PERM ? ((R & ~31) + perm32(R & 31)) : R;
        voffA[i] = (unsigned)(R * K + C) * 2u; voffB[i] = (unsigned)(Rb * K + C) * 2u; }
    const size_t kstep = (size_t)(BK * 2);
    const size_t hstep = (size_t)HALF * K * 2;
    const size_t tstep = 2 * hstep;
    const unsigned ldsw = (unsigned)wid * 1024u;
    const int aoff = lds_byte(wr * 64 + fr, fq * 8), boff = lds_byte(wc * 32 + fr, fq * 8);
#define PG8_SA(b, h) (((b) * 2 + (h)) * HTB)
#define PG8_SB(b, h) ((4 + (b) * 2 + (h)) * HTB)
#define PG8_STAGE(bufoff, gbase, voff) do { _Pragma("unroll") for (int _i = 0; _i < 2; ++_i) \
        __builtin_amdgcn_global_load_lds((const unsigned*)((const char*)(gbase) + (voff)[_i]), (PG8_LAS unsigned*)(lds + (bufoff) + ldsw + _i * 8192), 16, 0, 0); } while (0)
#define PG8_LDA(dst, b, h) do { _Pragma("unroll") for (int m = 0; m < 4; ++m) _Pragma("unroll") for (int k = 0; k < 2; ++k) dst[m][k] = *(const PG8_LAS bf16x8*)(lds + PG8_SA(b, h) + aoff + m * 2048 + k * 1024); } while (0)
#define PG8_LDB(dst, b, h) do { _Pragma("unroll") for (int n = 0; n < 2; ++n) _Pragma("unroll") for (int k = 0; k < 2; ++k) dst[n][k] = *(const PG8_LAS bf16x8*)(lds + PG8_SB(b, h) + boff + n * 2048 + k * 1024); } while (0)
#define PG8_MMA(ai, bj, At, Bt) do { __builtin_amdgcn_s_setprio(1); _Pragma("unroll") for (int m = 0; m < 4; ++m) _Pragma("unroll") for (int n = 0; n < 2; ++n) _Pragma("unroll") for (int k = 0; k < 2; ++k) \
        acc[ai][bj][m][n] = __builtin_amdgcn_mfma_f32_16x16x32_bf16(Bt[n][k], At[m][k], acc[ai][bj][m][n], 0, 0, 0); __builtin_amdgcn_s_setprio(0); } while (0)
#define PG8_WAIT_V(n) asm volatile("s_waitcnt vmcnt(" #n ")" ::: "memory")
#define PG8_WAIT_L(n) asm volatile("s_waitcnt lgkmcnt(" #n ")" ::: "memory")
#define PG8_BAR __builtin_amdgcn_s_barrier()
#define PG8_SCHED __builtin_amdgcn_sched_barrier(0)
    Unit cur, nxt; int ui = 0;
    if (!S.next(0, cur)) return;
    f32x4 acc[2][2][4][2];
#pragma unroll
    for (int a = 0; a < 2; ++a)
#pragma unroll
        for (int b = 0; b < 2; ++b)
#pragma unroll
            for (int m = 0; m < 4; ++m)
#pragma unroll
                for (int n = 0; n < 2; ++n) acc[a][b][m][n] = (f32x4){0.f, 0.f, 0.f, 0.f};
    bf16x8 At[4][2], B0[2][2], B1[2][2];
    const char* cA = (const char*)g.A + (size_t)cur.pm * tstep; const char* cB = (const char*)g.Bt + (size_t)cur.pn * tstep;
    S.a_ready(cur);
    if constexpr (SP2) {
        PG8_STAGE(PG8_SB(0, 0), cB, voffB); PG8_STAGE(PG8_SB(0, 1), cB + hstep, voffB); PG8_STAGE(PG8_SA(0, 0), cA, voffA); PG8_STAGE(PG8_SA(0, 1), cA + hstep, voffA);
        if (wr == 1) PG8_BAR;
        PG8_WAIT_V(2); PG8_BAR;
        PG8_STAGE(PG8_SB(1, 0), cB + kstep, voffB); PG8_STAGE(PG8_SA(1, 0), cA + kstep, voffA); PG8_STAGE(PG8_SB(1, 1), cB + hstep + kstep, voffB);
        PG8_WAIT_V(6); PG8_BAR;
    } else {
        PG8_STAGE(PG8_SB(0, 0), cB, voffB); PG8_STAGE(PG8_SA(0, 0), cA, voffA); PG8_STAGE(PG8_SB(0, 1), cB + hstep, voffB); PG8_STAGE(PG8_SA(0, 1), cA + hstep, voffA);
        if (wr == 1) PG8_BAR;
        PG8_WAIT_V(4); PG8_BAR;
        PG8_STAGE(PG8_SB(1, 0), cB + kstep, voffB); PG8_STAGE(PG8_SA(1, 0), cA + kstep, voffA); PG8_STAGE(PG8_SB(1, 1), cB + hstep + kstep, voffB);
        PG8_WAIT_V(6); PG8_BAR;
    }
    for (;;) {
        const bool has_next = S.next(ui + 1, nxt);
        const char* nA = has_next ? (const char*)g.A + (size_t)nxt.pm * tstep : cA; const char* nB = has_next ? (const char*)g.Bt + (size_t)nxt.pn * tstep : cB;
        for (int t = 0; t < nt; t += 2) {
            const bool last = (t == nt - 2);
            const char* a1 = cA + (size_t)(t + 1) * kstep;
            const char* a2 = last ? nA : cA + (size_t)(t + 2) * kstep; const char* b2 = last ? nB : cB + (size_t)(t + 2) * kstep;
            const char* a3 = a2 + kstep; const char* b3 = b2 + kstep;
            if (last && has_next) S.a_ready(nxt);
            if constexpr (SP2) {
            PG8_LDB(B0, 0, 0); PG8_LDB(B1, 0, 1); PG8_SCHED; PG8_LDA(At, 0, 0); PG8_STAGE(PG8_SA(1, 1), a1 + hstep, voffA);
            PG8_WAIT_V(8); PG8_WAIT_L(0); PG8_BAR; PG8_MMA(0, 0, At, B0); PG8_MMA(0, 1, At, B1); PG8_BAR; PG8_SCHED;
            PG8_LDA(At, 0, 1); PG8_STAGE(PG8_SB(0, 0), b2, voffB); PG8_STAGE(PG8_SB(0, 1), b2 + hstep, voffB); PG8_STAGE(PG8_SA(0, 0), a2, voffA);
            PG8_WAIT_V(8); PG8_WAIT_L(0); PG8_BAR; PG8_MMA(1, 0, At, B0); PG8_MMA(1, 1, At, B1); PG8_BAR; PG8_SCHED;
            PG8_LDB(B0, 1, 0); PG8_LDB(B1, 1, 1); PG8_SCHED; PG8_LDA(At, 1, 0); PG8_STAGE(PG8_SA(0, 1), a2 + hstep, voffA);
            PG8_WAIT_V(8); PG8_WAIT_L(0); PG8_BAR; PG8_MMA(0, 0, At, B0); PG8_MMA(0, 1, At, B1); PG8_BAR; PG8_SCHED;
            PG8_LDA(At, 1, 1); PG8_STAGE(PG8_SB(1, 0), b3, voffB); PG8_STAGE(PG8_SB(1, 1), b3 + hstep, voffB); PG8_STAGE(PG8_SA(1, 0), a3, voffA);
            PG8_WAIT_V(8); PG8_WAIT_L(0); PG8_BAR; PG8_MMA(1, 0, At, B0); PG8_MMA(1, 1, At, B1); PG8_BAR; PG8_SCHED;
            } else {
            PG8_LDB(B0, 0, 0); PG8_SCHED; PG8_LDA(At, 0, 0); PG8_STAGE(PG8_SA(1, 1), a1 + hstep, voffA);
            PG8_WAIT_L(8); PG8_BAR; PG8_WAIT_L(0); PG8_MMA(0, 0, At, B0); PG8_BAR; PG8_SCHED;
            PG8_LDB(B1, 0, 1); PG8_STAGE(PG8_SB(0, 0), b2, voffB);
            PG8_BAR; PG8_WAIT_L(0); PG8_MMA(0, 1, At, B1); PG8_BAR;
            PG8_LDA(At, 0, 1); PG8_STAGE(PG8_SA(0, 0), a2, voffA);
            PG8_BAR; PG8_WAIT_L(0); PG8_MMA(1, 0, At, B0); PG8_BAR; PG8_SCHED;
            PG8_STAGE(PG8_SB(0, 1), b2 + hstep, voffB);
            PG8_WAIT_V(6); PG8_BAR; PG8_MMA(1, 1, At, B1); PG8_BAR;
            PG8_LDB(B0, 1, 0); PG8_SCHED; PG8_LDA(At, 1, 0); PG8_STAGE(PG8_SA(0, 1), a2 + hstep, voffA);
            PG8_WAIT_L(8); PG8_BAR; PG8_WAIT_L(0); PG8_MMA(0, 0, At, B0); PG8_BAR; PG8_SCHED;
            PG8_LDB(B1, 1, 1); PG8_STAGE(PG8_SB(1, 0), b3, voffB);
            PG8_BAR; PG8_WAIT_L(0); PG8_MMA(0, 1, At, B1); PG8_BAR;
            PG8_LDA(At, 1, 1); PG8_STAGE(PG8_SA(1, 0), a3, voffA);
            PG8_BAR; PG8_WAIT_L(0); PG8_MMA(1, 0, At, B0); PG8_BAR; PG8_SCHED;
            PG8_STAGE(PG8_SB(1, 1), b3 + hstep, voffB);
            PG8_WAIT_V(6); PG8_BAR; PG8_MMA(1, 1, At, B1); PG8_BAR;
            }
        }
        if constexpr (ALIGN_EPI) { if (wr == 0) PG8_BAR; }
        if constexpr (!Epi::AFTER_DRAIN) { E(acc, cur, wr, wc, fr, fq); S.done(cur); }
        if (!has_next) break;
#pragma unroll
        for (int a = 0; a < 2; ++a)
#pragma unroll
            for (int b = 0; b < 2; ++b)
#pragma unroll
                for (int m = 0; m < 4; ++m)
#pragma unroll
                    for (int n = 0; n < 2; ++n) acc[a][b][m][n] = (f32x4){0.f, 0.f, 0.f, 0.f};
        cur = nxt; cA = nA; cB = nB; ++ui;
        if constexpr (ALIGN_EPI) { if (wr == 1) PG8_BAR; }
    }
    PG8_WAIT_V(0);
    if constexpr (!ALIGN_EPI) { if (wr == 0) PG8_BAR; }
    PG8_BAR;
    if constexpr (Epi::AFTER_DRAIN) { E.fused(acc, cur, wr, wc, fr, fq, lds, wid, lane); S.done(cur); }
#undef PG8_SA
#undef PG8_SB
#undef PG8_STAGE
#undef PG8_LDA
#undef PG8_LDB
#undef PG8_MMA
#undef PG8_WAIT_V
#undef PG8_WAIT_L
#undef PG8_BAR
#undef PG8_SCHED
}
}
__device__ __forceinline__ float row_rstd(const float* ssq, int row) {
    const f32x4* q = (const f32x4*)(ssq + (size_t)row * 16);
    const f32x4 a = q[0], b = q[1], c = q[2], d = q[3];
    return rsqrtf(((((a.x + a.y) + (a.z + a.w)) + ((b.x + b.y) + (b.z + b.w))) + (((c.x + c.y) + (c.z + c.w)) + ((d.x + d.y) + (d.z + d.w)))) * (1.f / DM) + EPS);
}
__device__ __forceinline__ void phase1_mfma(const Params& p, LAS unsigned char* lds) {
    pg8::Gemm g{(const pg8::bf16_t*)(p.ws + OFF_XN), (const pg8::bf16_t*)(p.ws + OFF_WIN), MROWS, NIN, DM};
    pg8::StaticOrder S; S.init(MROWS, NIN, (int)gridDim.x, (int)blockIdx.x);
    pg8::EpiP1 E{P1Ptrs{p.ws, p.in[10], p.in[12]}};
    pg8::gemm_phase<pg8::EpiP1, pg8::StaticOrder, true, true>(lds, g, S, E);
}
__device__ __forceinline__ void phase3_mfma(const Params& p, LAS unsigned char* lds) {
    pg8::Gemm g{(const pg8::bf16_t*)(p.ws + OFF_MIX), (const pg8::bf16_t*)(p.ws + OFF_WOUT), NTOK, DM, DM};
    pg8::StaticOrder S; S.init(NTOK, DM, (int)gridDim.x, (int)blockIdx.x);
    pg8::EpiP3 E{p.in[0], p.out, (bf16_t*)(p.ws + OFF_H2B), (float*)(p.ws + OFF_SSQP)};
    pg8::gemm_phase<pg8::EpiP3, pg8::StaticOrder, true, true>(lds, g, S, E);
}

typedef float f32x16 __attribute__((ext_vector_type(16)));
constexpr int AT_KROW = 272, AT_VROW = 136, AT_KBYTES = 64 * AT_KROW, AT_VBYTES = 128 * AT_VROW, AT_STAGE = AT_KBYTES + AT_VBYTES;
__device__ __forceinline__ void attn_item(const Params& p, LAS unsigned char* lds, int item) {
    const int tid = threadIdx.x, lane = tid & 63, wave = __builtin_amdgcn_readfirstlane(tid >> 6), qg = wave >> 1, c = wave & 1, l31 = lane & 31, hh = lane >> 5;
    const int qt = item & 15, h = (item >> 4) & 3, b = item >> 6;
    const int r0 = b * SEQ + qt * 128;
    const bf16_t* QB = (const bf16_t*)(p.ws + OFF_QB); const bf16_t* KB = (const bf16_t*)(p.ws + OFF_KB); const bf16_t* VT = (const bf16_t*)(p.ws + OFF_VT);
    bf16x8 qf[4];
    {
        const bf16_t* qp = QB + (size_t)(r0 + qg * 32 + l31) * 512 + h * 128 + c * 64 + 8 * hh;
#pragma unroll
        for (int s = 0; s < 4; ++s) qf[s] = *(const bf16x8*)(qp + 16 * s);
    }
    f32x16 O[4];
#pragma unroll
    for (int i = 0; i < 4; ++i)
#pragma unroll
        for (int r = 0; r < 16; ++r) O[i][r] = 0.f;
    float m = -1e30f, l = 0.f;
    const int kq0 = tid, kq1 = tid + 512;
    const bf16_t* kg0 = KB + (size_t)(kq0 >> 4) * 512 + h * 128 + (kq0 & 15) * 8; const bf16_t* kg1 = KB + (size_t)(kq1 >> 4) * 512 + h * 128 + (kq1 & 15) * 8;
    const bf16_t* vg0 = VT + (size_t)(h * 128 + (kq0 >> 3)) * MROWS + (kq0 & 7) * 8; const bf16_t* vg1 = VT + (size_t)(h * 128 + (kq1 >> 3)) * MROWS + (kq1 & 7) * 8;
    const int kl0 = (kq0 >> 4) * AT_KROW + (kq0 & 15) * 16, kl1 = (kq1 >> 4) * AT_KROW + (kq1 & 15) * 16;
    const int vl0 = AT_KBYTES + (kq0 >> 3) * AT_VROW + (kq0 & 7) * 16, vl1 = AT_KBYTES + (kq1 >> 3) * AT_VROW + (kq1 & 7) * 16;
    u32x4 kr0, kr1, vr0, vr1;
#define AT_LOAD(t) do { const size_t kro = (size_t)((t) < 32 ? b * SEQ + (t) * 64 : NTOK); \
        kr0 = *(const u32x4*)(kg0 + kro * 512); kr1 = *(const u32x4*)(kg1 + kro * 512); vr0 = *(const u32x4*)(vg0 + kro); vr1 = *(const u32x4*)(vg1 + kro); } while (0)
#define AT_WRITE(buf) do { LAS unsigned char* _b = lds + (buf) * AT_STAGE; \
        *(LAS u32x4*)(_b + kl0) = kr0; *(LAS u32x4*)(_b + kl1) = kr1; \
        *(LAS u32x2*)(_b + vl0) = (u32x2){vr0.x, vr0.y}; *(LAS u32x2*)(_b + vl0 + 8) = (u32x2){vr0.z, vr0.w}; \
        *(LAS u32x2*)(_b + vl1) = (u32x2){vr1.x, vr1.y}; *(LAS u32x2*)(_b + vl1 + 8) = (u32x2){vr1.z, vr1.w}; } while (0)
    __syncthreads();
    AT_LOAD(0); AT_WRITE(0);
    __syncthreads();
    for (int t = 0; t < 33; ++t) {
        if (t + 1 < 33) AT_LOAD(t + 1);
        const LAS unsigned char* kb_ = lds + (t & 1) * AT_STAGE; const LAS unsigned char* vb_ = kb_ + AT_KBYTES;
        f32x16 s0, s1;
#pragma unroll
        for (int r = 0; r < 16; ++r) { s0[r] = 0.f; s1[r] = 0.f; }
#pragma unroll
        for (int s = 0; s < 4; ++s) {
            const bf16x8 k0 = *(const LAS bf16x8*)(kb_ + l31 * AT_KROW + (c * 64 + 16 * s + 8 * hh) * 2);
            const bf16x8 k1 = *(const LAS bf16x8*)(kb_ + (32 + l31) * AT_KROW + (c * 64 + 16 * s + 8 * hh) * 2);
            s0 = __builtin_amdgcn_mfma_f32_32x32x16_bf16(k0, qf[s], s0, 0, 0, 0);
            s1 = __builtin_amdgcn_mfma_f32_32x32x16_bf16(k1, qf[s], s1, 0, 0, 0);
        }
        if (t == 32) {
#pragma unroll
            for (int r = 0; r < 16; ++r) { const int key = (r & 3) + 8 * (r >> 2) + 4 * hh; if (key >= 16) s0[r] = -1e30f; s1[r] = -1e30f; }
        }
        float mx = s0[0];
#pragma unroll
        for (int r = 1; r < 16; ++r) mx = fmaxf(mx, s0[r]);
#pragma unroll
        for (int r = 0; r < 16; ++r) mx = fmaxf(mx, s1[r]);
        mx = fmaxf(mx, __shfl_xor(mx, 32));
        const float mn = fmaxf(m, mx), alpha = __builtin_amdgcn_exp2f(m - mn);
        m = mn; l *= alpha;
#pragma unroll
        for (int i = 0; i < 4; ++i) O[i] = O[i] * alpha;
        float ps = 0.f;
#pragma unroll
        for (int r = 0; r < 16; ++r) { s0[r] = __builtin_amdgcn_exp2f(s0[r] - mn); s1[r] = __builtin_amdgcn_exp2f(s1[r] - mn); ps += s0[r] + s1[r]; }
        l += ps;
        bf16x8 pf[2][2];
#pragma unroll
        for (int s2 = 0; s2 < 2; ++s2) {
            u32x4 a, bq;
            a.x = pk2(s0[8 * s2 + 0], s0[8 * s2 + 1]); a.y = pk2(s0[8 * s2 + 2], s0[8 * s2 + 3]); a.z = pk2(s0[8 * s2 + 4], s0[8 * s2 + 5]); a.w = pk2(s0[8 * s2 + 6], s0[8 * s2 + 7]);
            bq.x = pk2(s1[8 * s2 + 0], s1[8 * s2 + 1]); bq.y = pk2(s1[8 * s2 + 2], s1[8 * s2 + 3]); bq.z = pk2(s1[8 * s2 + 4], s1[8 * s2 + 5]); bq.w = pk2(s1[8 * s2 + 6], s1[8 * s2 + 7]);
            pf[0][s2] = __builtin_bit_cast(bf16x8, a); pf[1][s2] = __builtin_bit_cast(bf16x8, bq);
        }
#pragma unroll
        for (int vb = 0; vb < 4; ++vb)
#pragma unroll
            for (int kb = 0; kb < 2; ++kb)
#pragma unroll
                for (int s2 = 0; s2 < 2; ++s2) {
                    const LAS unsigned char* vp = vb_ + (vb * 32 + l31) * AT_VROW + (kb * 32 + 16 * s2 + 4 * hh) * 2;
                    const u32x2 lo = *(const LAS u32x2*)vp, hi = *(const LAS u32x2*)(vp + 16);
                    const bf16x8 vf = __builtin_bit_cast(bf16x8, (u32x4){lo.x, lo.y, hi.x, hi.y});
                    O[vb] = __builtin_amdgcn_mfma_f32_32x32x16_bf16(vf, pf[kb][s2], O[vb], 0, 0, 0);
                }
        if (t + 1 < 33) AT_WRITE((t + 1) & 1);
        __syncthreads();
    }
    const float inv = 1.f / (l + __shfl_xor(l, 32));
    LAS float* X = (LAS float*)lds + qg * 4096;
    if (c == 1) {
#pragma unroll
        for (int vb = 0; vb < 4; ++vb)
#pragma unroll
            for (int r = 0; r < 16; ++r) X[(vb * 16 + r) * 64 + lane] = O[vb][r] * inv;
    }
    __syncthreads();
    if (c == 0) {
        const float lam = ((const float*)(p.ws + OFF_MISC))[0];
        float ss = 0.f;
#pragma unroll
        for (int vb = 0; vb < 4; ++vb)
#pragma unroll
            for (int r = 0; r < 16; ++r) { const float y = O[vb][r] * inv - lam * X[(vb * 16 + r) * 64 + lane]; O[vb][r] = y; ss += y * y; }
        ss += __shfl_xor(ss, 32);
        const float rs = rsqrtf(ss * (1.f / 128.f) + EPS) * 0.8f;
        bf16_t* orow = (bf16_t*)(p.ws + OFF_MIX) + (size_t)(r0 + qg * 32 + l31) * DM + h * 128;
#pragma unroll
        for (int vb = 0; vb < 4; ++vb)
#pragma unroll
            for (int rq = 0; rq < 4; ++rq) {
                const int v0 = vb * 32 + 8 * rq + 4 * hh;
                const f32x4 w = *(const f32x4*)(p.in[8] + v0);
                u32x2 o; o.x = pk2(O[vb][4 * rq] * rs * w.x, O[vb][4 * rq + 1] * rs * w.y); o.y = pk2(O[vb][4 * rq + 2] * rs * w.z, O[vb][4 * rq + 3] * rs * w.w);
                *(u32x2*)(orow + v0) = o;
            }
    }
#undef AT_LOAD
#undef AT_WRITE
}
__device__ __forceinline__ void phase2_attn_mfma(const Params& p, LAS unsigned char* lds) {
    for (int it = vcu_of_block(); it < NB * 4 * 16; it += gridDim.x) attn_item(p, lds, it);
}


__device__ __forceinline__ int gsw(int row, int chunk) { return row * 128 + ((chunk ^ (row & 7)) << 4); }
constexpr int GL_QS = 0, GL_KS = 8192, GL_KT = 16384, GL_AT = 24576, GL_VT = 32768, GL_ST = 49152  , GL_DV = 81920;
__device__ __forceinline__ void gla_chain(const Params& p, LAS unsigned char* lds, int item) {
    const int tid = threadIdx.x, lane = tid & 63, wave = __builtin_amdgcn_readfirstlane(tid >> 6), l15 = lane & 15, g = lane >> 4;
    const int dir = item & 1, h = (item >> 1) & 3, b = item >> 3;
    const bf16_t* GQ = (const bf16_t*)(p.ws + OFF_GQ); const bf16_t* GK = (const bf16_t*)(p.ws + OFF_GK); const bf16_t* GVT = (const bf16_t*)(p.ws + OFF_GVT);
    const float* G = (const float*)(p.ws + (dir ? OFF_GB : OFF_GF));
    float* O = p.out + (dir ? (size_t)NTOK * 512 : 0);
    const int nsteps = dir ? 32 : 33;
    f32x4 accS[4];
#pragma unroll
    for (int i = 0; i < 4; ++i) accS[i] = (f32x4){0.f, 0.f, 0.f, 0.f};
    f32x4 g0, g1; u32x4 q8, k8, v0, v1;
    const int vdv = tid >> 2, vch = (tid & 3) * 2;
#define GL_ROWBASE(st) (dir ? b * SEQ + (31 - (st)) * 64 : ((st) == 0 ? NTOK : b * SEQ + ((st) - 1) * 64))
#define GL_LOAD(st) do { const int _rb = GL_ROWBASE(st); const size_t _r = (size_t)(_rb + lane); \
        g0 = *(const f32x4*)(G + _r * 256 + h * 64 + 8 * wave); g1 = *(const f32x4*)(G + _r * 256 + h * 64 + 8 * wave + 4); \
        q8 = *(const u32x4*)(GQ + _r * 256 + h * 64 + 8 * wave); k8 = *(const u32x4*)(GK + _r * 256 + h * 64 + 8 * wave); \
        v0 = *(const u32x4*)(GVT + (size_t)(h * 128 + vdv) * MROWS + _rb + vch * 8); v1 = *(const u32x4*)(GVT + (size_t)(h * 128 + vdv) * MROWS + _rb + vch * 8 + 8); } while (0)
    __syncthreads();
    *(LAS u32x4*)(lds + GL_ST + tid * 32) = (u32x4){0u, 0u, 0u, 0u}; *(LAS u32x4*)(lds + GL_ST + tid * 32 + 16) = (u32x4){0u, 0u, 0u, 0u};
    GL_LOAD(0);
    for (int st = 0; st < nsteps; ++st) {
        const bool meta = (dir == 0 && st == 0);
        const int rowbase = GL_ROWBASE(st);
        float gg[8] = {g0.x, g0.y, g0.z, g0.w, g1.x, g1.y, g1.z, g1.w};
        if (meta && lane >= NMETA) {
#pragma unroll
            for (int e = 0; e < 8; ++e) gg[e] = 0.f;
        }
        float P[8];
#pragma unroll
        for (int e = 0; e < 8; ++e) P[e] = gg[e];
#pragma unroll
        for (int off = 1; off < 64; off <<= 1) {
#pragma unroll
            for (int e = 0; e < 8; ++e) { const float t = __shfl_up(P[e], off); P[e] += (lane >= off) ? t : 0.f; }
        }
        float qv[8] = {bflo(q8.x), bfhi(q8.x), bflo(q8.y), bfhi(q8.y), bflo(q8.z), bfhi(q8.z), bflo(q8.w), bfhi(q8.w)};
        float kv[8] = {bflo(k8.x), bfhi(k8.x), bflo(k8.y), bfhi(k8.y), bflo(k8.z), bfhi(k8.z), bflo(k8.w), bfhi(k8.w)};
        float qn[8], kn[8], ks[8];
#pragma unroll
        for (int e = 0; e < 8; ++e) {
            const float T = __shfl(P[e], 63);
            const float Bv = dir ? (T - P[e] + gg[e]) : P[e];
            qn[e] = qv[e] * __expf(Bv); kn[e] = kv[e] * __expf(-Bv); ks[e] = kv[e] * __expf(T - Bv);
            if (lane == 0) *(LAS float*)(lds + GL_DV + (8 * wave + e) * 4) = __expf(T);
        }
        *(LAS u32x4*)(lds + GL_QS + gsw(lane, wave)) = (u32x4){pk2(qn[0], qn[1]), pk2(qn[2], qn[3]), pk2(qn[4], qn[5]), pk2(qn[6], qn[7])};
        *(LAS u32x4*)(lds + GL_KS + gsw(lane, wave)) = (u32x4){pk2(kn[0], kn[1]), pk2(kn[2], kn[3]), pk2(kn[4], kn[5]), pk2(kn[6], kn[7])};
#pragma unroll
        for (int e = 0; e < 8; ++e) *(LAS unsigned short*)(lds + GL_KT + gsw(8 * wave + e, lane >> 3) + (lane & 7) * 2) = (unsigned short)f2bf(ks[e]);
        *(LAS u32x4*)(lds + GL_VT + gsw(vdv, vch)) = v0; *(LAS u32x4*)(lds + GL_VT + gsw(vdv, vch + 1)) = v1;
        if (st + 1 < nsteps) GL_LOAD(st + 1);
        __syncthreads();
        const LAS unsigned char* STo = lds + GL_ST + (st & 1) * 16384; LAS unsigned char* STn = lds + GL_ST + ((st + 1) & 1) * 16384;
        if (!meta) {
            const int jb = wave >> 1;
#pragma unroll
            for (int ii = 0; ii < 2; ++ii) {
                const int ib = 2 * (wave & 1) + ii;
                f32x4 a = (f32x4){0.f, 0.f, 0.f, 0.f};
                const bool live = dir ? (jb >= ib) : (jb <= ib);
                if (live) {
#pragma unroll
                    for (int ks2 = 0; ks2 < 2; ++ks2) {
                        const bf16x8 kf = *(const LAS bf16x8*)(lds + GL_KS + gsw(jb * 16 + l15, ks2 * 4 + g));
                        const bf16x8 qf = *(const LAS bf16x8*)(lds + GL_QS + gsw(ib * 16 + l15, ks2 * 4 + g));
                        a = __builtin_amdgcn_mfma_f32_16x16x32_bf16(kf, qf, a, 0, 0, 0);
                    }
                    const int i = ib * 16 + l15, j0 = jb * 16 + 4 * g;
#pragma unroll
                    for (int r = 0; r < 4; ++r) { const bool keep = dir ? (j0 + r >= i) : (j0 + r <= i); a[r] = keep ? a[r] : 0.f; }
                }
                const int i = ib * 16 + l15, j0 = jb * 16 + 4 * g;
                *(LAS u32x2*)(lds + GL_AT + gsw(i, j0 >> 3) + (j0 & 7) * 2) = (u32x2){pk2(a[0], a[1]), pk2(a[2], a[3])};
            }
        }
        if (st + 1 < nsteps) {
#pragma unroll
            for (int kb = 0; kb < 4; ++kb) {
                const f32x4 dvv = *(const LAS f32x4*)(lds + GL_DV + (kb * 16 + 4 * g) * 4);
                f32x4 a = accS[kb] * dvv;
#pragma unroll
                for (int ks2 = 0; ks2 < 2; ++ks2) {
                    const bf16x8 kf = *(const LAS bf16x8*)(lds + GL_KT + gsw(kb * 16 + l15, ks2 * 4 + g));
                    const bf16x8 vf = *(const LAS bf16x8*)(lds + GL_VT + gsw(wave * 16 + l15, ks2 * 4 + g));
                    a = __builtin_amdgcn_mfma_f32_16x16x32_bf16(kf, vf, a, 0, 0, 0);
                }
                accS[kb] = a;
                const int dk0 = kb * 16 + 4 * g;
                *(LAS u32x2*)(STn + gsw(wave * 16 + l15, dk0 >> 3) + (dk0 & 7) * 2) = (u32x2){pk2(a[0], a[1]), pk2(a[2], a[3])};
            }
        }
        __syncthreads();
        if (!meta) {
#pragma unroll
            for (int ib = 0; ib < 4; ++ib) {
                f32x4 a = (f32x4){0.f, 0.f, 0.f, 0.f};
#pragma unroll
                for (int ks2 = 0; ks2 < 2; ++ks2) {
                    const bf16x8 vf = *(const LAS bf16x8*)(lds + GL_VT + gsw(wave * 16 + l15, ks2 * 4 + g));
                    const bf16x8 af = *(const LAS bf16x8*)(lds + GL_AT + gsw(ib * 16 + l15, ks2 * 4 + g));
                    a = __builtin_amdgcn_mfma_f32_16x16x32_bf16(vf, af, a, 0, 0, 0);
                    const bf16x8 sf = *(const LAS bf16x8*)(STo + gsw(wave * 16 + l15, ks2 * 4 + g));
                    const bf16x8 qf = *(const LAS bf16x8*)(lds + GL_QS + gsw(ib * 16 + l15, ks2 * 4 + g));
                    a = __builtin_amdgcn_mfma_f32_16x16x32_bf16(sf, qf, a, 0, 0, 0);
                }
                *(f32x4*)(O + (size_t)(rowbase + ib * 16 + l15) * 512 + h * 128 + wave * 16 + 4 * g) = a;
            }
        }
        __syncthreads();
    }
#undef GL_LOAD
#undef GL_ROWBASE
}


constexpr int LDS_Q = LDS_BYTES - 16;
__device__ __forceinline__ void phase2(const Params& p, LAS unsigned char* lds, int qslot = 0) {
    unsigned* ctr = (unsigned*)(p.ws + OFF_CTL) + qslot * 64;
    for (;;) {
        __syncthreads();
        if (threadIdx.x == 0) *(LAS unsigned*)(lds + LDS_Q) = atomicAdd(ctr, 1u);
        __syncthreads();
        const int it = (int)*(LAS unsigned*)(lds + LDS_Q);
        if (it >= 64 + NB * 4 * 16) break;
        if (it < 64) gla_chain(p, lds, it); else attn_item(p, lds, it - 64);
    }
    if (qslot) return;
    for (;;) {
        __syncthreads();
        if (threadIdx.x == 0) *(LAS unsigned*)(lds + LDS_Q) = atomicAdd(ctr + 128, 1u);
        __syncthreads();
        const int it = (int)*(LAS unsigned*)(lds + LDS_Q);
        if (it >= CV_ITEMS) break;
        conv_item(p, (unsigned char*)lds, it);
    }
}

__device__ __forceinline__ void phase2c(const Params& p) {
    const int tid = threadIdx.x, lane = tid & 63, wave = tid >> 6;
    const int gw = blockIdx.x * 8 + wave, NGW = gridDim.x * 8;
    const bf16_t* GR = (const bf16_t*)(p.ws + OFF_GR); bf16_t* MIX = (bf16_t*)(p.ws + OFF_MIX);
    const float* OF = p.out; const float* OBk = p.out + (size_t)NTOK * 512;
    const int c0 = lane * 8;
    const f32x4 w0 = *(const f32x4*)(p.in[13] + (c0 & 127)), w1 = *(const f32x4*)(p.in[13] + (c0 & 127) + 4);
    for (int r = gw; r < NTOK; r += NGW) {
        const f32x4 a0 = *(const f32x4*)(OF + (size_t)r * 512 + c0), a1 = *(const f32x4*)(OF + (size_t)r * 512 + c0 + 4);
        const f32x4 b0 = *(const f32x4*)(OBk + (size_t)r * 512 + c0), b1 = *(const f32x4*)(OBk + (size_t)r * 512 + c0 + 4);
        const f32x4 x0 = a0 + b0, x1 = a1 + b1;
        float s = x0.x * x0.x + x0.y * x0.y + x0.z * x0.z + x0.w * x0.w + x1.x * x1.x + x1.y * x1.y + x1.z * x1.z + x1.w * x1.w;
        s += __shfl_xor(s, 1); s += __shfl_xor(s, 2); s += __shfl_xor(s, 4); s += __shfl_xor(s, 8);
        const float rs = rsqrtf(s * (1.f / 128.f) + EPS);
        const u32x4 g = *(const u32x4*)(GR + (size_t)r * 512 + c0);
        u32x4 o;
        o.x = pk2(x0.x * rs * w0.x * bflo(g.x), x0.y * rs * w0.y * bfhi(g.x)); o.y = pk2(x0.z * rs * w0.z * bflo(g.y), x0.w * rs * w0.w * bfhi(g.y));
        o.z = pk2(x1.x * rs * w1.x * bflo(g.z), x1.y * rs * w1.y * bfhi(g.z)); o.w = pk2(x1.z * rs * w1.z * bflo(g.w), x1.w * rs * w1.w * bfhi(g.w));
        *(u32x4*)(MIX + (size_t)r * DM + 512 + c0) = o;
    }
}


#define TOPK_INS(L, x) do { float _x = (x); _Pragma("unroll") for (int _s = 0; _s < 16; ++_s) { const float _t = fmaxf(L[_s], _x); _x = fminf(L[_s], _x); L[_s] = _t; } } while (0)
constexpr int P4_QROW = 528, P4_SC0 = 128 * P4_QROW  , P4_TLROW = 144;
__device__ __forceinline__ void p4_route_half(const Params& p, LAS unsigned char* lds, int m0, int h) {
    const int tid = threadIdx.x, lane = tid & 63, wave = __builtin_amdgcn_readfirstlane(tid >> 6), l15 = lane & 15, g = lane >> 4;
    const bf16_t* KEYS = (const bf16_t*)(p.ws + OFF_KEYS); unsigned* PW0 = (unsigned*)(p.ws + OFF_PW0);
        {
            const int wr = wave >> 1, wk = wave & 1;
            f32x4 sc[2][2][4];
#pragma unroll
            for (int pp = 0; pp < 2; ++pp) {
#pragma unroll
                for (int rb = 0; rb < 2; ++rb)
#pragma unroll
                    for (int kk = 0; kk < 4; ++kk) sc[pp][rb][kk] = (f32x4){0.f, 0.f, 0.f, 0.f};
                const bf16_t* kbase = KEYS + (size_t)((h * 2 + pp) * 128 + 64 * wk + l15) * 128 + 8 * g;
#pragma unroll
                for (int ks = 0; ks < 4; ++ks) {
                    bf16x8 qf[2], kf[4];
#pragma unroll
                    for (int rb = 0; rb < 2; ++rb) qf[rb] = *(const LAS bf16x8*)(lds + (32 * wr + 16 * rb + l15) * P4_QROW + (pp * 128 + ks * 32 + 8 * g) * 2);
#pragma unroll
                    for (int kk = 0; kk < 4; ++kk) kf[kk] = *(const bf16x8*)(kbase + (size_t)(16 * kk) * 128 + ks * 32);
#pragma unroll
                    for (int rb = 0; rb < 2; ++rb)
#pragma unroll
                        for (int kk = 0; kk < 4; ++kk) sc[pp][rb][kk] = __builtin_amdgcn_mfma_f32_16x16x32_bf16(kf[kk], qf[rb], sc[pp][rb][kk], 0, 0, 0);
                }
            }
#pragma unroll
            for (int rb = 0; rb < 2; ++rb)
#pragma unroll
                for (int kk = 0; kk < 4; ++kk) *(LAS f32x4*)(lds + P4_SC0 + (32 * wr + 16 * rb + l15) * P4_QROW + (64 * wk + 16 * kk + 4 * g) * 4) = sc[0][rb][kk];
            __syncthreads();
#pragma unroll
            for (int rb = 0; rb < 2; ++rb)
#pragma unroll
                for (int kk = 0; kk < 4; ++kk) *(LAS f32x4*)(lds + (32 * wr + 16 * rb + l15) * P4_QROW + (64 * wk + 16 * kk + 4 * g) * 4) = sc[1][rb][kk];
        }
        __syncthreads();
        {
            const int hf = tid & 1, row = (tid >> 1) & 127, pp = tid >> 8;
            const LAS unsigned char* sp = lds + (pp ? 0 : P4_SC0) + row * P4_QROW + hf * 256;
            float L[16];
#pragma unroll
            for (int s = 0; s < 16; ++s) L[s] = -3.0e38f;
#pragma unroll 4
            for (int q4 = 0; q4 < 16; ++q4) {
                const f32x4 v = *(const LAS f32x4*)(sp + q4 * 16);
                const unsigned kb = (unsigned)(hf * 64 + q4 * 4);
                TOPK_INS(L, __uint_as_float((__float_as_uint(v.x) & ~127u) | kb));
                TOPK_INS(L, __uint_as_float((__float_as_uint(v.y) & ~127u) | (kb + 1)));
                TOPK_INS(L, __uint_as_float((__float_as_uint(v.z) & ~127u) | (kb + 2)));
                TOPK_INS(L, __uint_as_float((__float_as_uint(v.w) & ~127u) | (kb + 3)));
            }
            float Oth[16];
#pragma unroll
            for (int s = 0; s < 16; ++s) Oth[s] = __shfl_xor(L[s], 1);
#pragma unroll
            for (int s = 0; s < 16; ++s) TOPK_INS(L, Oth[s]);
            __syncthreads();
            if (hf == 0) {
                LAS f32x4* tl = (LAS f32x4*)(lds + P4_SC0 + row * (2 * P4_TLROW) + pp * P4_TLROW);
                tl[0] = (f32x4){L[0], L[1], L[2], L[3]}; tl[1] = (f32x4){L[4], L[5], L[6], L[7]}; tl[2] = (f32x4){L[8], L[9], L[10], L[11]}; tl[3] = (f32x4){L[12], L[13], L[14], L[15]};
            }
        }
        __syncthreads();
        if (tid < 128) {
            const LAS unsigned char* tl = lds + P4_SC0 + tid * (2 * P4_TLROW);
            float A[16], Bv[16];
#pragma unroll
            for (int q4 = 0; q4 < 4; ++q4) { const f32x4 a = *(const LAS f32x4*)(tl + q4 * 16), b = *(const LAS f32x4*)(tl + P4_TLROW + q4 * 16);
                A[4 * q4] = a.x; A[4 * q4 + 1] = a.y; A[4 * q4 + 2] = a.z; A[4 * q4 + 3] = a.w; Bv[4 * q4] = b.x; Bv[4 * q4 + 1] = b.y; Bv[4 * q4 + 2] = b.z; Bv[4 * q4 + 3] = b.w; }
#pragma unroll
            for (int s = 0; s < 16; ++s) { A[s] = __uint_as_float(__float_as_uint(A[s]) & ~127u); Bv[s] = __uint_as_float(__float_as_uint(Bv[s]) & ~127u); }
            float L[16];
#pragma unroll
            for (int s = 0; s < 16; ++s) L[s] = -3.0e38f;
#pragma unroll
            for (int i = 0; i < 16; ++i)
#pragma unroll
                for (int j = 0; j < 16; ++j)
                    if ((i + 1) * (j + 1) <= 16) TOPK_INS(L, __uint_as_float((__float_as_uint(A[i] + Bv[j]) & ~255u) | (unsigned)(i * 16 + j)));
            const float v0 = __uint_as_float(__float_as_uint(L[0]) & ~255u);
            float e[16], den = 0.f; int id[16];
#pragma unroll
            for (int s = 0; s < 16; ++s) {
                const unsigned u = __float_as_uint(L[s]);
                e[s] = __expf(__uint_as_float(u & ~255u) - v0); den += e[s];
                const unsigned i = (u >> 4) & 15u, j = u & 15u;
                const unsigned ka = *(const LAS unsigned*)(tl + i * 4) & 127u, kb = *(const LAS unsigned*)(tl + P4_TLROW + j * 4) & 127u;
                id[s] = (int)(ka * 128u + kb);
            }
            const float inv = 1.f / den;
            unsigned* ip = PW0 + (size_t)(m0 + tid) * 128 + h * 16;
#pragma unroll
            for (int q4 = 0; q4 < 4; ++q4) { u32x4 o;
#pragma unroll
                for (int c = 0; c < 4; ++c) o[c] = (unsigned)id[4 * q4 + c] | (f2bf(e[4 * q4 + c] * inv) << 16);
                *(u32x4*)(ip + 4 * q4) = o; }
        }
        __syncthreads();
}

namespace pg8 {
struct EpiP4 {
    static constexpr bool PERM = false, AFTER_DRAIN = true;
    const Params* pp; const float* ssq;
    __device__ __forceinline__ void operator()(const f32x4 (&)[2][2][4][2], const Unit&, int, int, int, int) const {}
    __device__ __forceinline__ void fused(f32x4 (&acc)[2][2][4][2], const Unit& u, int wr, int wc, int fr, int fq, PG8_LAS unsigned char* lds, int wid, int lane) const {
#pragma unroll
        for (int ai = 0; ai < 2; ++ai) {
            const int m0 = u.pm * BM + ai * HALF;
#pragma unroll
            for (int m = 0; m < 4; ++m) {
                const int rl = wr * 64 + m * 16 + fr;
                const float rstd = row_rstd(ssq, m0 + rl);
#pragma unroll
                for (int bj = 0; bj < 2; ++bj)
#pragma unroll
                    for (int n = 0; n < 2; ++n) { const f32x4 v = acc[ai][bj][m][n] * rstd;
                        *(PG8_LAS u32x2*)(lds + rl * P4_QROW + (bj * HALF + wc * 32 + n * 16 + 4 * fq) * 2) = (u32x2){pk2(v.x, v.y), pk2(v.z, v.w)}; }
            }
            __syncthreads();
            p4_route_half(*pp, lds, m0, u.pn);
        }
    }
};
}
__device__ __forceinline__ void phase4_mfma(const Params& p, LAS unsigned char* lds) {
    pg8::Gemm g{(const pg8::bf16_t*)(p.ws + OFF_H2B), (const pg8::bf16_t*)(p.ws + OFF_WQ), NTOK, 2048, DM};
    pg8::EpiP4 E{&p, (const float*)(p.ws + OFF_SSQP)};
    const int vcu = vcu_of_block();
    for (int r = 0; r * (int)gridDim.x < 512; ++r) {
        const int L = r * (int)gridDim.x + vcu;
        pg8::OneUnit S; S.u.pm = L >> 3; S.u.pn = L & 7; S.valid = L < 512;
        pg8::gemm_phase<pg8::EpiP4, pg8::OneUnit, false, true>(lds, g, S, E);
        __syncthreads();
    }
}


constexpr size_t OFF_PW = 73 * MiB;
constexpr size_t OFF_OUTS = 179 * MiB;
static_assert(OFF_OUTS >= OFF_PW0 + (size_t)NTOK * 128 * 4 && OFF_OUTS + (size_t)NTOK * DM * 4 <= 256 * MiB, "P5 map");
__device__ __forceinline__ float dot_fp8_bf16(u32x4 uq, u32x4 h0, u32x4 h1, float c) {
#define DQ2(word, hsel, hw) c = dot2(__builtin_bit_cast(unsigned, __builtin_amdgcn_cvt_scalef32_pk_bf16_fp8((int)(word), 1.0f, hsel)), hw, c)
    DQ2(uq.x, false, h0.x); DQ2(uq.x, true, h0.y); DQ2(uq.y, false, h0.z); DQ2(uq.y, true, h0.w);
    DQ2(uq.z, false, h1.x); DQ2(uq.z, true, h1.y); DQ2(uq.w, false, h1.z); DQ2(uq.w, true, h1.w);
#undef DQ2
    return c;
}
constexpr int P5A_RS = 1040, P5A_LIST = 16640, P5A_RES = 18688, P5A_TSC = 18752, P5A_WAVE = 19456;
constexpr size_t OFF_HQ = 146 * MiB;
constexpr size_t OFF_HSC = 192 * 1024;
static_assert(8 * P5A_WAVE <= LDS_BYTES - 32, "P5a LDS");
static_assert(OFF_HQ >= OFF_H2B + (size_t)NTOK * DM * 2 && OFF_HQ + (size_t)NTOK * DM <= OFF_PW0, "HQ map");
__device__ __forceinline__ void quantize_hn(const Params& p) {
    const int tid = threadIdx.x, lane = tid & 63, wave = tid >> 6;
    const bf16_t* H2B = (const bf16_t*)(p.ws + OFF_H2B); unsigned char* HQ = p.ws + OFF_HQ; float* HSC = (float*)(p.ws + OFF_HSC);
    for (int t = blockIdx.x * 8 + wave; t < NTOK; t += gridDim.x * 8) {
        const u32x4 h0 = *(const u32x4*)(H2B + (size_t)t * DM + 16 * lane), h1 = *(const u32x4*)(H2B + (size_t)t * DM + 16 * lane + 8);
        float m = 0.f;
#pragma unroll
        for (int c = 0; c < 4; ++c) { m = fmaxf(m, fmaxf(fabsf(bflo(h0[c])), fabsf(bfhi(h0[c])))); m = fmaxf(m, fmaxf(fabsf(bflo(h1[c])), fabsf(bfhi(h1[c])))); }
        const float am = fmaxf(wave_max(m), 1e-30f), qs = 224.f / am;
        u32x4 o;
#pragma unroll
        for (int c = 0; c < 2; ++c) {
            int w = __builtin_amdgcn_cvt_pk_fp8_f32(bflo(h0[2 * c]) * qs, bfhi(h0[2 * c]) * qs, 0, false); w = __builtin_amdgcn_cvt_pk_fp8_f32(bflo(h0[2 * c + 1]) * qs, bfhi(h0[2 * c + 1]) * qs, w, true); o[c] = (unsigned)w;
            int x = __builtin_amdgcn_cvt_pk_fp8_f32(bflo(h1[2 * c]) * qs, bfhi(h1[2 * c]) * qs, 0, false); x = __builtin_amdgcn_cvt_pk_fp8_f32(bflo(h1[2 * c + 1]) * qs, bfhi(h1[2 * c + 1]) * qs, x, true); o[2 + c] = (unsigned)x;
        }
        *(u32x4*)(HQ + (size_t)t * DM + 16 * lane) = o;
        if (lane == 0) HSC[t] = row_rstd((const float*)(p.ws + OFF_SSQP), t) * am * (1.f / 224.f);
    }
}
__device__ __forceinline__ void p5a_wave(const Params& p, LAS unsigned char* wl, int tb, int part, int lane, __amdgpu_buffer_rsrc_t urs, __amdgpu_buffer_rsrc_t hrs) {
    const float* USC = (const float*)(p.ws + OFF_USC); const float* VSC = (const float*)(p.ws + OFF_VSC); const float* HSC = (const float*)(p.ws + OFF_HSC);
    const unsigned* PW0 = (const unsigned*)(p.ws + OFF_PW0); unsigned* PW = (unsigned*)(p.ws + OFF_PW);
    const int l15 = lane & 15, g = lane >> 4;
    unsigned xl[4], xh[4]; float hsc = 0.f;
#define P5A_STAGE(t0_) do { _Pragma("unroll") for (int _k = 0; _k < 4; ++_k) { \
        __builtin_amdgcn_raw_ptr_buffer_load_lds(hrs, (LAS unsigned*)(wl + _k * 1024), 16, lane * 16, ((t0_) + _k) * 1024, 0, 0); \
        xl[_k] = PW0[(size_t)((t0_) + _k) * 128 + lane]; xh[_k] = PW0[(size_t)((t0_) + _k) * 128 + 64 + lane]; } \
        hsc = HSC[(t0_) + (lane & 3)]; } while (0)
#define P5A_GATHER(tile_) do { int _li = (tile_) * 16 + l15; _li = _li < n ? _li : n - 1; \
        const int _ev = (int)((*(const LAS unsigned*)(wl + P5A_LIST + _li * 4) & 0x3fffu) << 10); \
        _Pragma("unroll") for (int _r = 0; _r < 16; ++_r) \
            __builtin_amdgcn_raw_ptr_buffer_load_lds(urs, (LAS unsigned*)(wl + _r * P5A_RS), 16, lane * 16, __builtin_amdgcn_readlane(_ev, _r), 0, 0); } while (0)
    P5A_STAGE(tb);
    for (int st = 0; st < 4; ++st) {
        const int t0 = tb + 4 * st;
        asm volatile("s_waitcnt vmcnt(0)" ::: "memory");
        long bq[32];
#pragma unroll
        for (int s = 0; s < 32; ++s) bq[s] = __builtin_bit_cast(long, *(const LAS u32x2*)(wl + (l15 & 3) * 1024 + 32 * s + 8 * g));
        if (lane < 4) *(LAS float*)(wl + P5A_TSC + lane * 4) = hsc;
        int n = 0;
#pragma unroll
        for (int k = 0; k < 4; ++k) {
            const bool ml = (int)((xl[k] >> 11) & 7u) == part, mh = (int)((xh[k] >> 11) & 7u) == part;
            const unsigned long long bl = __ballot(ml), bh = __ballot(mh);
            const int rl = __builtin_amdgcn_mbcnt_hi((unsigned)(bl >> 32), __builtin_amdgcn_mbcnt_lo((unsigned)bl, 0u));
            if (ml) *(LAS unsigned*)(wl + P5A_LIST + (n + rl) * 4) = (xl[k] & 0x3fffu) | ((unsigned)lane << 14) | ((unsigned)k << 21);
            n += __popcll(bl);
            const int rh = __builtin_amdgcn_mbcnt_hi((unsigned)(bh >> 32), __builtin_amdgcn_mbcnt_lo((unsigned)bh, 0u));
            if (mh) *(LAS unsigned*)(wl + P5A_LIST + (n + rh) * 4) = (xh[k] & 0x3fffu) | ((unsigned)(64 + lane) << 14) | ((unsigned)k << 21);
            n += __popcll(bh);
        }
        __builtin_amdgcn_s_waitcnt(0xC07F); __builtin_amdgcn_wave_barrier();
        asm volatile("" ::: "memory");
        const int ntile = (n + 15) >> 4;
        if (ntile == 0) { if (st < 3) P5A_STAGE(t0 + 4); continue; }
        P5A_GATHER(0);
        for (int tile = 0; tile < ntile; ++tile) {
            asm volatile("s_waitcnt vmcnt(0)" ::: "memory");
            int ei = tile * 16 + l15; const bool eok = ei < n; ei = eok ? ei : n - 1;
            const unsigned ent = *(const LAS unsigned*)(wl + P5A_LIST + ei * 4);
            const unsigned ee = ent & 0x3fffu; const int sl = (int)((ent >> 14) & 127u), tk = (int)(ent >> 21), t = t0 + tk;
            float usc = USC[ee], vsc = VSC[ee]; unsigned xg = PW0[(size_t)t * 128 + sl];
            long aq[32];
#pragma unroll
            for (int s = 0; s < 32; ++s) aq[s] = __builtin_bit_cast(long, *(const LAS u32x2*)(wl + l15 * P5A_RS + 32 * s + 8 * g));
            asm volatile("s_waitcnt vmcnt(0) lgkmcnt(0)" : "+v"(usc), "+v"(vsc), "+v"(xg) :: "memory");
#pragma unroll
            for (int s = 0; s < 32; ++s) asm volatile("" : "+v"(aq[s]));
            if (tile + 1 < ntile) P5A_GATHER(tile + 1); else if (st < 3) P5A_STAGE(t0 + 4);
            f32x4 acc = (f32x4){0.f, 0.f, 0.f, 0.f};
#pragma unroll
            for (int s = 0; s < 32; ++s) acc = __builtin_amdgcn_mfma_f32_16x16x32_fp8_fp8(aq[s], bq[s], acc, 0, 0, 0);
            {
                const u32x4 en = *(const LAS u32x4*)(wl + P5A_LIST + (tile * 16 + 4 * g) * 4);
#pragma unroll
                for (int r = 0; r < 4; ++r) if ((int)(en[r] >> 21) == l15) *(LAS float*)(wl + P5A_RES + (4 * g + r) * 4) = acc[r];
            }
            __builtin_amdgcn_s_waitcnt(0xC07F); __builtin_amdgcn_wave_barrier();
            asm volatile("" ::: "memory");
            if (lane < 16 && eok) {
                const float d = *(const LAS float*)(wl + P5A_RES + lane * 4) * usc * *(const LAS float*)(wl + P5A_TSC + tk * 4);
                const float w = __uint_as_float(xg & 0xffff0000u) * gelu_f(d) * vsc;
                PW[(((size_t)(t >> 6) * 32 + (sl >> 2)) * 64 + (t & 63)) * 4 + (sl & 3)] = ee | (f2bf(w) << 16);
            }
            __builtin_amdgcn_s_waitcnt(0xC07F); __builtin_amdgcn_wave_barrier();
            asm volatile("" ::: "memory");
        }
    }
    asm volatile("s_waitcnt vmcnt(0)" ::: "memory");
#undef P5A_STAGE
#undef P5A_GATHER
}
__device__ __forceinline__ void phase5a(const Params& p, LAS unsigned char* lds, int qoff = 0) {
    const int tid = threadIdx.x, lane = tid & 63, wave = __builtin_amdgcn_readfirstlane(tid >> 6);
    const int xcc = (int)(__builtin_amdgcn_s_getreg((3 << 11) | 20) & 7u);
    unsigned* qc = (unsigned*)(p.ws + OFF_CTL) + 256 + qoff;
    LAS unsigned char* wl = lds + wave * P5A_WAVE;
    const __amdgpu_buffer_rsrc_t urs = __builtin_amdgcn_make_buffer_rsrc((void*)(p.ws + OFF_UB), 0, NEXP * DM, 0x00020000);
    const __amdgpu_buffer_rsrc_t hrs = __builtin_amdgcn_make_buffer_rsrc((void*)(p.ws + OFF_HQ), 0, NTOK * DM, 0x00020000);
    for (int pi = 0; pi < 8; ++pi) {
        const int part = (xcc + pi) & 7;
        for (;;) {
            __syncthreads();
            if (tid == 0) *(LAS unsigned*)(lds + LDS_Q) = atomicAdd(qc + part * 64, 1u);
            __syncthreads();
            const int it = (int)*(LAS unsigned*)(lds + LDS_Q);
            if (it >= NTOK / 128) break;
            p5a_wave(p, wl, it * 128 + wave * 16, part, lane, urs, hrs);
        }
    }
}

__device__ __forceinline__ void p5b_quad(const LAS unsigned char* lds, u32x4 q, f32x2& a0, f32x2& a1, f32x2& a2, f32x2& a3) {
#pragma unroll
    for (int c = 0; c < 4; ++c) {
        const unsigned x = q[c];
        const u32x2 vv = *(const LAS u32x2*)(lds + ((x & 0x3fffu) << 3));
        const float w = __uint_as_float(x & 0xffff0000u); const f32x2 ww = (f32x2){w, w};
        a0 += ww * __builtin_amdgcn_cvt_pk_f32_fp8((int)vv.x, false); a1 += ww * __builtin_amdgcn_cvt_pk_f32_fp8((int)vv.x, true);
        a2 += ww * __builtin_amdgcn_cvt_pk_f32_fp8((int)vv.y, false); a3 += ww * __builtin_amdgcn_cvt_pk_f32_fp8((int)vv.y, true);
    }
}
__device__ __forceinline__ void phase5b(const Params& p, LAS unsigned char* lds) {
    const int tid = threadIdx.x, lane = tid & 63, wave = __builtin_amdgcn_readfirstlane(tid >> 6);
    const unsigned char* VS = p.ws + OFF_VB; const u32x4* PW = (const u32x4*)(p.ws + OFF_PW); float* OUTS = (float*)(p.ws + OFF_OUTS);
    for (int it = blockIdx.x; it < 256; it += gridDim.x) {
        const int s = it >> 1, tbase = (it & 1) * 128;
        __syncthreads();
#pragma unroll 4
        for (int i = 0; i < 16; ++i) *(LAS u32x4*)(lds + (tid + NTHR * i) * 16) = *(const u32x4*)(VS + (size_t)s * 131072 + (size_t)(tid + NTHR * i) * 16);
        __syncthreads();
        u32x4 A[8], Bq[8];
#define P5B_LOAD(R, gi) do { const int _T = tbase + wave + 8 * ((gi) >> 2), _g = (gi) & 3; const u32x4* _p = PW + ((size_t)_T * 32 + _g * 8) * 64 + lane; \
        _Pragma("unroll") for (int _i = 0; _i < 8; ++_i) R[_i] = _p[_i * 64]; } while (0)
        f32x2 a0 = {0.f, 0.f}, a1 = {0.f, 0.f}, a2 = {0.f, 0.f}, a3 = {0.f, 0.f};
        P5B_LOAD(A, 0);
        for (int gi = 0; gi < 64; gi += 2) {
            P5B_LOAD(Bq, gi + 1);
#pragma unroll
            for (int i = 0; i < 8; ++i) p5b_quad(lds, A[i], a0, a1, a2, a3);
            if (gi + 2 < 64) P5B_LOAD(A, gi + 2);
#pragma unroll
            for (int i = 0; i < 8; ++i) p5b_quad(lds, Bq[i], a0, a1, a2, a3);
            if (((gi + 1) & 3) == 3) {
                const int T = tbase + wave + 8 * (gi >> 2);
                float* o = OUTS + ((size_t)s * NTOK + T * 64 + lane) * 8;
                *(f32x4*)o = (f32x4){a0.x, a0.y, a1.x, a1.y}; *(f32x4*)(o + 4) = (f32x4){a2.x, a2.y, a3.x, a3.y};
                a0 = (f32x2){0.f, 0.f}; a1 = a0; a2 = a0; a3 = a0;
            }
        }
#undef P5B_LOAD
    }
}

__device__ __forceinline__ void phase5c(const Params& p, LAS unsigned char* lds) {
    const int tid = threadIdx.x, lane = tid & 63, wave = __builtin_amdgcn_readfirstlane(tid >> 6);
    const float* OUTS = (const float*)(p.ws + OFF_OUTS); const float* fw = p.in[20];
    for (int it = blockIdx.x; it < NTOK / 32; it += gridDim.x) {
        const int t0 = it * 32;
        __syncthreads();
#pragma unroll 4
        for (int i = 0; i < 16; ++i) {
            const int q = tid + NTHR * i, s = q >> 6, tt = (q >> 1) & 31, hf = q & 1;
            *(LAS f32x4*)(lds + tt * 4112 + (s * 8 + hf * 4) * 4) = *(const f32x4*)(OUTS + ((size_t)s * NTOK + t0 + tt) * 8 + hf * 4);
        }
        __syncthreads();
        for (int i = 0; i < 4; ++i) {
            const int tt = wave * 4 + i; float* orow = p.out + (size_t)(t0 + tt) * DM;
            f32x4 h[4]; float ss = 0.f;
#pragma unroll
            for (int j = 0; j < 4; ++j) { h[j] = *(const f32x4*)(orow + 4 * lane + 256 * j) + *(const LAS f32x4*)(lds + tt * 4112 + (4 * lane + 256 * j) * 4);
                ss += h[j].x * h[j].x + h[j].y * h[j].y + h[j].z * h[j].z + h[j].w * h[j].w; }
            const float rs = rsqrtf(wave_sum(ss) * (1.f / DM) + EPS);
#pragma unroll
            for (int j = 0; j < 4; ++j) *(f32x4*)(orow + 4 * lane + 256 * j) = h[j] * rs * *(const f32x4*)(fw + 4 * lane + 256 * j);
        }
    }
}


#define XB_TMO      128
#define XB_XCNT(j)  (256  + 64 * (j))
#define XB_XSUB(j)  (1280 + 64 * (j))
#define XB_XGEN(j)  (2304 + 64 * (j))
#define XB_TOP      3328
#define XB_TOPGEN   3392
#define XCD_BAR_WORDS 3456
#define XB_SPIN_CAP (1u << 18)
__device__ __forceinline__ unsigned xb_ld(unsigned* p)              { return __hip_atomic_load(p, __ATOMIC_RELAXED, __HIP_MEMORY_SCOPE_AGENT); }
__device__ __forceinline__ unsigned xb_add(unsigned* p, unsigned v) { return __hip_atomic_fetch_add(p, v, __ATOMIC_RELAXED, __HIP_MEMORY_SCOPE_AGENT); }
__device__ __forceinline__ unsigned xb_xcc_id() { return (unsigned)__builtin_amdgcn_s_getreg((3 << 11) | 20) & 0xFu; }
#define XB_SPIN(cond, bar) do { unsigned _sp = 0; while (cond) { __builtin_amdgcn_s_sleep(1); \
    if ((++_sp & 255u) == 0u) { if (xb_ld(&(bar)[XB_TMO])) break; if (_sp > XB_SPIN_CAP) { atomicAdd(&(bar)[XB_TMO], 1u); break; } } } } while (0)
struct XcdBarrier { unsigned* bar; unsigned x; volatile LAS unsigned* st; };
__device__ __forceinline__ XcdBarrier xcd_barrier_post(unsigned* bar, volatile LAS unsigned* st) {
    XcdBarrier b; b.bar = bar; b.x = xb_xcc_id(); b.st = st;
    if (threadIdx.x == 0) (void)xb_add(&bar[XB_XCNT(b.x)], 1u);
    return b;
}
__device__ __forceinline__ void xcd_barrier_complete(unsigned* bar, unsigned x, unsigned& nloc, unsigned& nx) {
    const unsigned G = gridDim.x * gridDim.y * gridDim.z;
    unsigned sum, cnt, mine, sp = 0u;
    for (;;) {
        sum = 0u; cnt = 0u; mine = 0u;
#pragma unroll
        for (unsigned j = 0; j < 16; ++j) { const unsigned c = xb_ld(&bar[XB_XCNT(j)]); sum += c; cnt += (c > 0u) ? 1u : 0u; mine = (j == x) ? c : mine; }
        if (sum == G) break;
        __builtin_amdgcn_s_sleep(1);
        if ((++sp & 255u) == 0u) { if (xb_ld(&bar[XB_TMO])) break; if (sp > XB_SPIN_CAP) { atomicAdd(&bar[XB_TMO], 1u); break; } }
    }
    nloc = mine > 0u ? mine : 1u; nx = cnt > 0u ? cnt : 1u;
}
__device__ __forceinline__ void xcd_barrier(const XcdBarrier& b) {
    asm volatile("s_waitcnt vmcnt(0)" ::: "memory");
    __syncthreads();
    if (threadIdx.x == 0) {
        unsigned* bar = b.bar;
        __builtin_amdgcn_s_waitcnt(0);
        unsigned nloc = b.st[0], nx = b.st[1];
        if (nloc == 0u) { xcd_barrier_complete(bar, b.x, nloc, nx); b.st[0] = nloc; b.st[1] = nx; }
        const unsigned old = xb_add(&bar[XB_XSUB(b.x)], 1u);
        const unsigned gen = old / nloc;
        if (old + 1u == (gen + 1u) * nloc) {
            __builtin_amdgcn_fence(__ATOMIC_RELEASE, "agent");
            asm volatile("s_waitcnt vmcnt(0)" ::: "memory");
            const unsigned og = xb_add(&bar[XB_TOP], 1u);
            const unsigned tg = og / nx;
            if (og + 1u == (tg + 1u) * nx) xb_add(&bar[XB_TOPGEN], 1u);
            else XB_SPIN(xb_ld(&bar[XB_TOPGEN]) == tg, bar);
            __builtin_amdgcn_fence(__ATOMIC_ACQUIRE, "agent");
            xb_add(&bar[XB_XGEN(b.x)], 1u);
            asm volatile("s_waitcnt vmcnt(0)" ::: "memory");
        } else {
            XB_SPIN(xb_ld(&bar[XB_XGEN(b.x)]) == gen, bar);
            __builtin_amdgcn_fence(__ATOMIC_ACQUIRE, "agent");
            asm volatile("s_waitcnt vmcnt(0)" ::: "memory");
        }
    }
    __syncthreads();
}

constexpr int NPHASE = 9;
__global__ void __launch_bounds__(NTHR, 2) mega(Params p) {
    extern __shared__ __attribute__((aligned(16))) unsigned char lds[];
    cg::grid_group grid = cg::this_grid();
#define PH_ON(k) (p.ph_lo <= (k) && (k) < p.ph_hi)
    if (threadIdx.x < 2) ((LAS unsigned*)((LAS unsigned char*)lds + LDS_BYTES - 32))[threadIdx.x] = 0u;
    __syncthreads();
    const XcdBarrier xbar = xcd_barrier_post((unsigned*)(p.ws + OFF_CTL) + 8192, (volatile LAS unsigned*)((LAS unsigned char*)lds + LDS_BYTES - 32));
#define PH_SYNC(k) do { if (PH_ON(k) && PH_ON((k) + 1)) { if ((k) == 0) grid.sync(); else xcd_barrier(xbar); } } while (0)
    if (PH_ON(0)) phase0(p, lds);
    PH_SYNC(0);
    if (PH_ON(1)) phase1_mfma(p, (LAS unsigned char*)lds);
#if PROBE_DUP == 1
    grid.sync(); phase1_mfma(p, (LAS unsigned char*)lds);
#endif
    PH_SYNC(1);
    if (PH_ON(2)) phase2(p, (LAS unsigned char*)lds);
#if PROBE_DUP == 2
    grid.sync(); phase2(p, (LAS unsigned char*)lds, 1);
#endif
    PH_SYNC(2);
    if (PH_ON(3)) phase2c(p);
    PH_SYNC(3);
    if (PH_ON(4)) phase3_mfma(p, (LAS unsigned char*)lds);
#if PROBE_DUP == 4
    grid.sync(); phase3_mfma(p, (LAS unsigned char*)lds);
#endif
    PH_SYNC(4);
    if (PH_ON(5)) { phase4_mfma(p, (LAS unsigned char*)lds); quantize_hn(p); }
#if PROBE_DUP == 5
    grid.sync(); phase4_mfma(p, (LAS unsigned char*)lds);
#endif
    PH_SYNC(5);
    if (PH_ON(6)) phase5a(p, (LAS unsigned char*)lds);
#if PROBE_DUP == 6
    grid.sync(); phase5a(p, (LAS unsigned char*)lds, 1024);
#endif
    PH_SYNC(6);
    if (PH_ON(7)) phase5b(p, (LAS unsigned char*)lds);
#if PROBE_DUP == 7
    grid.sync(); phase5b(p, (LAS unsigned char*)lds);
#endif
    PH_SYNC(7);
    if (PH_ON(8)) phase5c(p, (LAS unsigned char*)lds);
}

extern "C" void kernel_launch(void* const* d_in, const int* in_sizes, int n_in, void* d_out, int out_size, void* d_ws, size_t ws_size, hipStream_t stream) {
    static int grid = 0;
    if (grid == 0) {
        if (n_in != 21 || out_size != NTOK * DM || ws_size < WS_END) { fprintf(stderr, "kernel_launch: unexpected shapes (n_in %d out %d ws %zu)\n", n_in, out_size, ws_size); grid = -1; return; }
        int dev = 0, cus = 0, per_cu = 0;
        hipGetDevice(&dev);
        hipDeviceGetAttribute(&cus, hipDeviceAttributeMultiprocessorCount, dev);
        hipFuncSetAttribute((const void*)mega, hipFuncAttributeMaxDynamicSharedMemorySize, LDS_BYTES);
        hipOccupancyMaxActiveBlocksPerMultiprocessor(&per_cu, (const void*)mega, NTHR, LDS_BYTES);
        if (per_cu < 1) { fprintf(stderr, "kernel_launch: occupancy query says %d blocks/CU\n", per_cu); per_cu = 1; }
        grid = cus * 1;
        (void)hipGetLastError();
    }
    if (grid < 0) return;
    hipMemsetAsync((char*)d_ws + OFF_CTL, 0, CTL_BYTES, stream);
    Params p{};
    for (int i = 0; i < 21; ++i) p.in[i] = (const float*)d_in[i];
    p.out = (float*)d_out; p.ws = (unsigned char*)d_ws; p.ph_lo = 0; p.ph_hi = NPHASE;
    void* args[] = {&p};
    hipError_t e = hipLaunchCooperativeKernel((const void*)mega, dim3(grid), dim3(NTHR), args, LDS_BYTES, stream);
    if (e != hipSuccess) fprintf(stderr, "cooperative launch failed: %s (grid %d)\n", hipGetErrorString(e), grid);
}
```

```cpp
#include <hip/hip_runtime.h>
#include <hip/hip_cooperative_groups.h>
#include <cstdio>
#include <cstdint>
namespace cg = cooperative_groups;

constexpr int DM = 1024;
constexpr int NB = 8, SEQ = 2048, NMETA = 16;
constexpr int NTOK = NB * SEQ;
constexpr int MROWS = 16640;
constexpr int NIN = 3584;
constexpr int TPOS = NMETA + SEQ;
constexpr float EPS = 1e-6f;
constexpr float QSCALE = 0.125f * 1.4426950408889634f;
constexpr int NEXP = 16384;
constexpr int NTHR = 512;
#ifndef PROBE_DUP
#define PROBE_DUP 0
#endif

constexpr size_t MiB = 1u << 20;
constexpr size_t OFF_CTL = 0, CTL_BYTES = 64 * 1024;
constexpr size_t OFF_MISC = 512 * 1024;
constexpr size_t OFF_ROPE = 1 * MiB;
constexpr size_t OFF_WOUT = 2 * MiB;
constexpr size_t OFF_WQ = 4 * MiB;
constexpr size_t OFF_KEYS = 8 * MiB;
constexpr size_t OFF_SSQP = 25 * MiB;
constexpr size_t OFF_UB = 9 * MiB;
constexpr size_t OFF_VB = 41 * MiB;
constexpr size_t OFF_XN = 73 * MiB;
constexpr size_t OFF_MIX = 73 * MiB;
constexpr size_t OFF_WIN = 106 * MiB;
constexpr size_t OFF_QB = 113 * MiB;
constexpr size_t OFF_KB = OFF_QB + 16 * MiB + 256 * 1024;
constexpr size_t OFF_VT = OFF_KB + 16 * MiB + 256 * 1024;
constexpr size_t OFF_H2B = 113 * MiB;
constexpr size_t OFF_GQ = 162 * MiB;
constexpr size_t OFF_GK = OFF_GQ + 8 * MiB + 256 * 1024;
constexpr size_t OFF_GVT = OFF_GK + 8 * MiB + 256 * 1024;
constexpr size_t OFF_GF = OFF_GVT + 16 * MiB + 256 * 1024;
constexpr size_t OFF_GB = OFF_GF + 16 * MiB + 256 * 1024;
constexpr size_t OFF_GR = OFF_GB + 16 * MiB + 256 * 1024;
constexpr size_t OFF_PW0 = 162 * MiB;
constexpr size_t OFF_USC = 64 * 1024;
constexpr size_t OFF_VSC = 128 * 1024;
constexpr size_t WS_END = OFF_GR + 16 * MiB + 256 * 1024;
static_assert(WS_END <= 256 * MiB, "workspace map");
static_assert(OFF_VT + (size_t)512 * MROWS * 2 <= OFF_GQ, "map D");
static_assert(OFF_WIN + (size_t)NIN * DM * 2 <= OFF_QB, "map C");

constexpr int LDS_BYTES = 163840;

typedef unsigned short bf16_t;
typedef float f32x4 __attribute__((ext_vector_type(4)));
typedef float f32x2 __attribute__((ext_vector_type(2)));
typedef unsigned u32x4 __attribute__((ext_vector_type(4)));
typedef unsigned u32x2 __attribute__((ext_vector_type(2)));
typedef __bf16 bf16x2_t __attribute__((ext_vector_type(2)));

struct Params {
    const float* in[21];
    float* out;
    unsigned char* ws;
    int ph_lo, ph_hi;
};

__device__ __forceinline__ unsigned f2bf(float f) { unsigned u = __float_as_uint(f); return (u + 0x7fffu + ((u >> 16) & 1u)) >> 16; }
__device__ __forceinline__ float bf2f(unsigned h) { return __uint_as_float(h << 16); }
__device__ __forceinline__ unsigned pk2(float lo, float hi) { return __builtin_bit_cast(unsigned, __builtin_convertvector((f32x2){lo, hi}, bf16x2_t)); }
__device__ __forceinline__ float bflo(unsigned w) { return __uint_as_float(w << 16); }
__device__ __forceinline__ float bfhi(unsigned w) { return __uint_as_float(w & 0xffff0000u); }
__device__ __forceinline__ float dot2(unsigned a, unsigned b, float c) {
    return __builtin_amdgcn_fdot2_f32_bf16(__builtin_bit_cast(bf16x2_t, a), __builtin_bit_cast(bf16x2_t, b), c, false);
}
__device__ __forceinline__ float dot8(u32x4 a, u32x4 b, float c) { c = dot2(a.x, b.x, c); c = dot2(a.y, b.y, c); c = dot2(a.z, b.z, c); return dot2(a.w, b.w, c); }
__device__ __forceinline__ float wave_sum(float v) {
#pragma unroll
    for (int o = 1; o < 64; o <<= 1) v += __shfl_xor(v, o);
    return v;
}
__device__ __forceinline__ float wave_max(float v) {
#pragma unroll
    for (int o = 1; o < 64; o <<= 1) v = fmaxf(v, __shfl_xor(v, o));
    return v;
}
__device__ __forceinline__ float silu_f(float x) { return x / (1.f + __expf(-x)); }
__device__ __forceinline__ float logsig_f(float x) { return fminf(x, 0.f) - log1pf(__expf(-fabsf(x))); }
__device__ __forceinline__ float gelu_f(float v) {
    const float av = fabsf(v), t = __builtin_amdgcn_rcpf(av * 0.2316418882f + 1.0f);
    float q = t * 0.5307027145f + (-0.7265760135f); q = q * t + 0.7107068705f; q = q * t + (-0.142248368f); q = q * t + 0.127414796f; q = q * t;
    const float m = v * (q * __builtin_amdgcn_exp2f(v * v * (-0.72134752044f)));
    return v < 0.f ? m : v - m;
}

__device__ __forceinline__ float win_src(const Params& p, int k, int n) {
    const float* W = p.in[3] + (size_t)k * 3104;
    if (n < 1024) {
        const int base = n & ~63, dp = n & 63, d = dp < 16 ? ((dp >> 1) + 8 * (dp & 1)) : dp;
        return W[base + d];
    } else if (n < 3072) return W[n];
    const int j = (n - 3072) & 255, dir = (n - 3072) >> 8;
    const float* w2 = p.in[dir ? 11 : 9];
    const float* wz = W + 3072 + dir * 16;
    float s = 0.f;
#pragma unroll
    for (int r = 0; r < 16; ++r) s += wz[r] * w2[r * 256 + j];
    return s;
}

template <int WHICH>
__device__ __forceinline__ void p0_transpose_item(const Params& p, float* scr, int item, int lane) {
    constexpr int N = WHICH == 0 ? NIN : (WHICH == 1 ? 1024 : 2048);
    constexpr int nblk = N / 32;
    const int kb = item / nblk, nb = item % nblk, k0 = 64 * kb, n0 = 32 * nb;
    bf16_t* WT = (bf16_t*)(p.ws + (WHICH == 0 ? OFF_WIN : (WHICH == 1 ? OFF_WOUT : OFF_WQ)));
#pragma unroll 4
    for (int i = 0; i < 32; ++i) {
        const int kk = 2 * i + (lane >> 5), k = k0 + kk, n = n0 + (lane & 31);
        float v;
        if (WHICH == 0) v = win_src(p, k, n);
        else if (WHICH == 1) v = p.in[14][(size_t)k * 1024 + n];
        else v = p.in[16][(size_t)k * 2048 + n] * p.in[15][k];
        scr[kk * 33 + (lane & 31)] = v;
    }
    __builtin_amdgcn_s_waitcnt(0xC07F); __builtin_amdgcn_wave_barrier();
    const int c = lane & 7;
#pragma unroll
    for (int j = 0; j < 4; ++j) {
        const int n = (lane >> 3) + 8 * j; const float* s = scr + (8 * c) * 33 + n;
        u32x4 o; o.x = pk2(s[0 * 33], s[1 * 33]); o.y = pk2(s[2 * 33], s[3 * 33]); o.z = pk2(s[4 * 33], s[5 * 33]); o.w = pk2(s[6 * 33], s[7 * 33]);
        *(u32x4*)(WT + (size_t)(n0 + n) * 1024 + k0 + 8 * c) = o;
    }
    __builtin_amdgcn_s_waitcnt(0xC07F); __builtin_amdgcn_wave_barrier();
}

__device__ __forceinline__ void phase0(const Params& p, unsigned char* lds) {
    const int tid = threadIdx.x, lane = tid & 63, wave = tid >> 6;
    const int gw = blockIdx.x * 8 + wave, NGW = gridDim.x * 8;
    const long gt = (long)blockIdx.x * NTHR + tid, NGT = (long)gridDim.x * NTHR;
    {
        const f32x4* lw = (const f32x4*)p.in[2];
        bf16_t* XN = (bf16_t*)(p.ws + OFF_XN);
        for (int r = gw; r < MROWS; r += NGW) {
            const float* src = r < NTOK ? p.in[0] + (size_t)r * DM : (r < NTOK + NMETA ? p.in[1] + (size_t)(r - NTOK) * DM : nullptr);
            f32x4 v[4]; float s = 0.f;
#pragma unroll
            for (int j = 0; j < 4; ++j) { v[j] = src ? ((const f32x4*)src)[lane + 64 * j] : (f32x4){0.f, 0.f, 0.f, 0.f}; s += v[j].x * v[j].x + v[j].y * v[j].y + v[j].z * v[j].z + v[j].w * v[j].w; }
            const float rs = rsqrtf(wave_sum(s) * (1.f / DM) + EPS);
#pragma unroll
            for (int j = 0; j < 4; ++j) { const f32x4 w = lw[lane + 64 * j]; u32x2 o; o.x = pk2(v[j].x * rs * w.x, v[j].y * rs * w.y); o.y = pk2(v[j].z * rs * w.z, v[j].w * rs * w.w);
                *(u32x2*)(XN + (size_t)r * DM + 4 * (lane + 64 * j)) = o; }
        }
    }
    {
        float* scr = (float*)lds + wave * (64 * 33);
        constexpr int I0 = 16 * (NIN / 32);
        for (int it = gw; it < I0; it += NGW) p0_transpose_item<0>(p, scr, it, lane);
    }
    {
        f32x2* rope = (f32x2*)(p.ws + OFF_ROPE);
        for (long i = gt; i < TPOS * 8; i += NGT) {
            const int t = (int)(i >> 3), j = (int)(i & 7);
            const float inv = powf(500000.0f, -(float)j * 0.125f);
            const float ang = (float)t * inv;
            rope[i] = (f32x2){cosf(ang), sinf(ang)};
        }
        if (gt == 0) {
            float a = 0.f, b = 0.f;
            for (int i = 0; i < 64; ++i) { a += p.in[4][i] * p.in[5][i]; b += p.in[6][i] * p.in[7][i]; }
            ((float*)(p.ws + OFF_MISC))[0] = expf(a) - expf(b) + 0.2f;
        }
    }
}
constexpr int CV_WOUT = 64, CV_WQ = 128, CV_KEYS = 8, CV_U = 256, CV_V = 256, CV_ITEMS = CV_WOUT + CV_WQ + CV_KEYS + CV_U + CV_V;
__device__ __forceinline__ void conv_item(const Params& p, unsigned char* lds, int c) {
    const int tid = threadIdx.x, lane = tid & 63, wave = tid >> 6;
    __syncthreads();
    if (c < CV_WOUT) { p0_transpose_item<1>(p, (float*)lds + wave * (64 * 33), c * 8 + wave, lane); return; }
    c -= CV_WOUT;
    if (c < CV_WQ) { p0_transpose_item<2>(p, (float*)lds + wave * (64 * 33), c * 8 + wave, lane); return; }
    c -= CV_WQ;
    if (c < CV_KEYS) {
        bf16_t* KEYS = (bf16_t*)(p.ws + OFF_KEYS);
#pragma unroll 2
        for (int j = 0; j < 8; ++j) {
            const long e = ((long)c * 4096 + tid + NTHR * j) * 8;
            const f32x4 a = *(const f32x4*)(p.in[17] + e), b = *(const f32x4*)(p.in[17] + e + 4);
            u32x4 o; o.x = pk2(a.x, a.y); o.y = pk2(a.z, a.w); o.z = pk2(b.x, b.y); o.w = pk2(b.z, b.w);
            *(u32x4*)(KEYS + e) = o;
        }
        return;
    }
    c -= CV_KEYS;
    if (c < CV_U) {
        unsigned char* UQ = p.ws + OFF_UB; float* USC = (float*)(p.ws + OFF_USC);
#pragma unroll 2
        for (int i = 0; i < 8; ++i) {
            const int r = c * 64 + wave * 8 + i;
            const float* ur = p.in[18] + (size_t)r * DM + 16 * lane; const float* lw = p.in[15] + 16 * lane;
            f32x4 v[4]; float am = 0.f;
#pragma unroll
            for (int j = 0; j < 4; ++j) { v[j] = ((const f32x4*)ur)[j] * ((const f32x4*)lw)[j]; am = fmaxf(am, fmaxf(fmaxf(fabsf(v[j].x), fabsf(v[j].y)), fmaxf(fabsf(v[j].z), fabsf(v[j].w)))); }
            am = fmaxf(wave_max(am), 1e-30f);
            const float sc = 224.f / am;
            u32x4 o;
#pragma unroll
            for (int j = 0; j < 4; ++j) { int w = __builtin_amdgcn_cvt_pk_fp8_f32(v[j].x * sc, v[j].y * sc, 0, false); w = __builtin_amdgcn_cvt_pk_fp8_f32(v[j].z * sc, v[j].w * sc, w, true); o[j] = (unsigned)w; }
            *(u32x4*)(UQ + (size_t)r * DM + 16 * lane) = o;
            if (lane == 0) USC[r] = am * (1.f / 224.f);
        }
        return;
    }
    c -= CV_U;
    {
        unsigned char* VS = p.ws + OFF_VB; float* VSC = (float*)(p.ws + OFF_VSC);
        const int tile = c;
#pragma unroll 2
        for (int i = 0; i < 8; ++i) {
            const int er = wave * 8 + i, r = tile * 64 + er;
            const float* vr = p.in[19] + (size_t)r * DM + 16 * lane;
            f32x4 v[4]; float am = 0.f;
#pragma unroll
            for (int j = 0; j < 4; ++j) { v[j] = ((const f32x4*)vr)[j]; am = fmaxf(am, fmaxf(fmaxf(fabsf(v[j].x), fabsf(v[j].y)), fmaxf(fabsf(v[j].z), fabsf(v[j].w)))); }
            am = fmaxf(wave_max(am), 1e-30f);
            const float sc = 224.f / am;
            u32x4 o;
#pragma unroll
            for (int j = 0; j < 4; ++j) { int w = __builtin_amdgcn_cvt_pk_fp8_f32(v[j].x * sc, v[j].y * sc, 0, false); w = __builtin_amdgcn_cvt_pk_fp8_f32(v[j].z * sc, v[j].w * sc, w, true); o[j] = (unsigned)w; }
            *(u32x2*)(lds + er * 1032 + 16 * lane) = (u32x2){o.x, o.y}; *(u32x2*)(lds + er * 1032 + 16 * lane + 8) = (u32x2){o.z, o.w};
            if (lane == 0) VSC[r] = am * (1.f / 224.f);
        }
        __syncthreads();
#pragma unroll 4
        for (int i = 0; i < 16; ++i) {
            const int s = wave + 8 * i;
            *(u32x2*)(VS + ((size_t)s * NEXP + tile * 64 + lane) * 8) = *(const u32x2*)(lds + lane * 1032 + s * 8);
        }
    }
}

struct P1Ptrs { unsigned char* ws; const float* bias_f; const float* bias_b; };
__device__ __forceinline__ void p1_store(const P1Ptrs p, int row, int n0, float v0, float v1, float v2, float v3) {
    if (n0 < 1024) {
        const int dp = n0 & 63;
        if (dp < 16) {
            const int pos = row < NTOK ? NMETA + (row & (SEQ - 1)) : (row - NTOK);
            const f32x4 cs = *(const f32x4*)((const float*)(p.ws + OFF_ROPE) + ((size_t)pos * 8 + (dp >> 1)) * 2);
            const float a0 = v0 * cs.x - v1 * cs.y, b0 = v1 * cs.x + v0 * cs.y;
            const float a1 = v2 * cs.z - v3 * cs.w, b1 = v3 * cs.z + v2 * cs.w;
            v0 = a0; v1 = b0; v2 = a1; v3 = b1;
        }
        if (n0 < 512) { u32x2 o; o.x = pk2(v0 * QSCALE, v1 * QSCALE); o.y = pk2(v2 * QSCALE, v3 * QSCALE); *(u32x2*)((bf16_t*)(p.ws + OFF_QB) + (size_t)row * 512 + n0) = o; }
        else { u32x2 o; o.x = pk2(v0, v1); o.y = pk2(v2, v3); *(u32x2*)((bf16_t*)(p.ws + OFF_KB) + (size_t)row * 512 + (n0 - 512)) = o; }
    } else if (n0 < 1536) {
        bf16_t* VT = (bf16_t*)(p.ws + OFF_VT) + (size_t)(n0 - 1024) * MROWS + row;
        VT[0] = (bf16_t)f2bf(v0); VT[MROWS] = (bf16_t)f2bf(v1); VT[2 * MROWS] = (bf16_t)f2bf(v2); VT[3 * (size_t)MROWS] = (bf16_t)f2bf(v3);
    } else if (n0 < 1792) {
        u32x2 o; o.x = pk2(v0 * 0.125f, v1 * 0.125f); o.y = pk2(v2 * 0.125f, v3 * 0.125f); *(u32x2*)((bf16_t*)(p.ws + OFF_GQ) + (size_t)row * 256 + (n0 - 1536)) = o;
    } else if (n0 < 2048) {
        u32x2 o; o.x = pk2(v0, v1); o.y = pk2(v2, v3); *(u32x2*)((bf16_t*)(p.ws + OFF_GK) + (size_t)row * 256 + (n0 - 1792)) = o;
    } else if (n0 < 2560) {
        bf16_t* VT = (bf16_t*)(p.ws + OFF_GVT) + (size_t)(n0 - 2048) * MROWS + row;
        VT[0] = (bf16_t)f2bf(v0); VT[MROWS] = (bf16_t)f2bf(v1); VT[2 * MROWS] = (bf16_t)f2bf(v2); VT[3 * (size_t)MROWS] = (bf16_t)f2bf(v3);
    } else if (n0 < 3072) {
        u32x2 o; o.x = pk2(silu_f(v0), silu_f(v1)); o.y = pk2(silu_f(v2), silu_f(v3)); *(u32x2*)((bf16_t*)(p.ws + OFF_GR) + (size_t)row * 512 + (n0 - 2560)) = o;
    } else {
        const int dir = (n0 - 3072) >> 8, j = (n0 - 3072) & 255;
        const f32x4 bb = *(const f32x4*)((dir ? p.bias_b : p.bias_f) + j);
        f32x4 o; o.x = logsig_f(v0 + bb.x) * 0.0625f; o.y = logsig_f(v1 + bb.y) * 0.0625f; o.z = logsig_f(v2 + bb.z) * 0.0625f; o.w = logsig_f(v3 + bb.w) * 0.0625f;
        *(f32x4*)((float*)(p.ws + (dir ? OFF_GB : OFF_GF)) + (size_t)row * 256 + j) = o;
    }
}


#define LAS __attribute__((address_space(3)))
typedef short bf16x8 __attribute__((ext_vector_type(8)));
constexpr int GBUF = 49152;

template <int ROWS>
__device__ __forceinline__ void stage_tile(const bf16_t* G, int ldk, int r0, int k0, LAS unsigned char* buf, int wave, int lane) {
    const int rr = lane >> 3, c = (lane & 7) ^ rr;
#pragma unroll
    for (int i = 0; i < ROWS / 64; ++i) {
        const int grp = wave + 8 * i;
        const bf16_t* src = G + (size_t)(r0 + grp * 8 + rr) * ldk + k0 + c * 8;
        __builtin_amdgcn_global_load_lds((const unsigned*)src, (LAS unsigned*)(buf + grp * 1024), 16, 0, 0);
    }
}
__device__ __forceinline__ bf16x8 ldfrag(const LAS unsigned char* buf, int row, int c) {
    return *(const LAS bf16x8*)(buf + row * 128 + ((c ^ (row & 7)) << 4));
}
template <bool SWAP>
__device__ __forceinline__ void gemm_tile_256(const bf16_t* A, const bf16_t* Bt, int K, int m0, int n0, LAS unsigned char* lds, f32x4 (&acc)[4][4]) {
    const int tid = threadIdx.x, lane = tid & 63, wave = __builtin_amdgcn_readfirstlane(tid >> 6), wm = wave >> 2, wn = wave & 3, l15 = lane & 15, g = lane >> 4;
#pragma unroll
    for (int i = 0; i < 4; ++i)
#pragma unroll
        for (int j = 0; j < 4; ++j) acc[i][j] = (f32x4){0.f, 0.f, 0.f, 0.f};
    const int nk = K / 64;
    stage_tile<128>(A, K, m0, 0, lds, wave, lane);
    stage_tile<256>(Bt, K, n0, 0, lds + 16384, wave, lane);
    for (int kt = 0; kt < nk; ++kt) {
        asm volatile("s_waitcnt vmcnt(0)" ::: "memory");
        __syncthreads();
        if (kt + 1 < nk) {
            LAS unsigned char* nb = lds + ((kt + 1) & 1) * GBUF;
            stage_tile<128>(A, K, m0, (kt + 1) * 64, nb, wave, lane);
            stage_tile<256>(Bt, K, n0, (kt + 1) * 64, nb + 16384, wave, lane);
        }
        const LAS unsigned char* a = lds + (kt & 1) * GBUF; const LAS unsigned char* b = a + 16384;
#pragma unroll
        for (int ks = 0; ks < 2; ++ks) {
            bf16x8 af[4], bfr[4];
#pragma unroll
            for (int i = 0; i < 4; ++i) { af[i] = ldfrag(a, wm * 64 + i * 16 + l15, ks * 4 + g); bfr[i] = ldfrag(b, wn * 64 + i * 16 + l15, ks * 4 + g); }
#pragma unroll
            for (int i = 0; i < 4; ++i)
#pragma unroll
                for (int j = 0; j < 4; ++j)
                    acc[i][j] = SWAP ? __builtin_amdgcn_mfma_f32_16x16x32_bf16(af[i], bfr[j], acc[i][j], 0, 0, 0)
                                     : __builtin_amdgcn_mfma_f32_16x16x32_bf16(bfr[j], af[i], acc[i][j], 0, 0, 0);
        }
    }
}
__device__ __forceinline__ int vcu_of_block() { const int G = gridDim.x, bx = blockIdx.x; return (G % 8 == 0) ? (bx % 8) * (G / 8) + bx / 8 : bx; }

namespace pg8 {
#define PG8_LAS __attribute__((address_space(3)))
typedef unsigned short bf16_t;
typedef short bf16x8 __attribute__((ext_vector_type(8)));
typedef float f32x4 __attribute__((ext_vector_type(4)));
typedef unsigned u32x4 __attribute__((ext_vector_type(4)));
constexpr int BM = 256, BK = 64, HALF = 128, HTB = HALF * BK * 2  , STAGE_BYTES = 8 * HTB, NXCD = 8, WGM = 8;

__host__ __device__ __forceinline__ int lds_byte(int r, int c) { const int st = (r >> 4) * 2 + (c >> 5), rr = r & 15, cc = c & 31, ob = rr * 64 + cc * 2; return st * 1024 + (ob ^ (((ob >> 9) & 1) << 5)); }
__host__ __device__ __forceinline__ void stage_rc(int b, int& R, int& C) { const int st = b / 1024, sb = b % 1024, swz = sb ^ (((sb >> 9) & 1) << 5); R = (st >> 1) * 16 + swz / 64; C = (st & 1) * 32 + (swz % 64) / 2; }
__host__ __device__ __forceinline__ int perm32(int rho) { const int n = rho >> 4, i = rho & 15; return 8 * (i >> 2) + 4 * n + (i & 3); }

struct Unit { int pm, pn; };
struct Gemm { const bf16_t* A; const bf16_t* Bt; int M, N, K; };

struct StaticOrder {
    int nM, nN, nwg, G, c;
    __host__ __device__ void init(int M, int N, int G_, int c_) { nM = M / BM; nN = N / BM; nwg = nM * nN; G = G_; c = c_; }
    __host__ __device__ bool next(int i, Unit& u) const {
        const long L = (long)i * G + c; if (L >= nwg) return false;
        int wgid = (int)L; { const int q = nwg / NXCD, r = nwg % NXCD, xcd = wgid % NXCD, off = wgid / NXCD; wgid = (xcd < r ? xcd * (q + 1) : r * (q + 1) + (xcd - r) * q) + off; }
        const int nig = WGM * nN, gid = wgid / nig, fm = gid * WGM, gsz = (nM - fm) < WGM ? (nM - fm) : WGM;
        u.pm = fm + ((wgid % nig) % gsz); u.pn = (wgid % nig) / gsz; return true;
    }
    __device__ __forceinline__ void a_ready(const Unit&) const {}
    __device__ __forceinline__ void done(const Unit&) const {}
};

struct EpiP1 {
    static constexpr bool PERM = false, AFTER_DRAIN = false;
    P1Ptrs p;
    __device__ __forceinline__ void operator()(const f32x4 (&acc)[2][2][4][2], const Unit& u, int wr, int wc, int fr, int fq) const {
#pragma unroll
        for (int bj = 0; bj < 2; ++bj) {
            const int nw = u.pn * BM + bj * HALF + wc * 32;
            const int rowb = u.pm * BM + wr * 64 + fr;
            if (nw >= 3072) {
                const int dir = (nw - 3072) >> 8, j0 = ((nw - 3072) & 255) + 4 * fq;
                float* G = (float*)(p.ws + (dir ? OFF_GB : OFF_GF)); const float* bias = dir ? p.bias_b : p.bias_f;
#pragma unroll
                for (int n = 0; n < 2; ++n) { const f32x4 bb = *(const f32x4*)(bias + j0 + 16 * n);
#pragma unroll
                    for (int ai = 0; ai < 2; ++ai)
#pragma unroll
                        for (int m = 0; m < 4; ++m) { const f32x4 v = acc[ai][bj][m][n]; f32x4 o;
                            o.x = logsig_f(v.x + bb.x) * 0.0625f; o.y = logsig_f(v.y + bb.y) * 0.0625f; o.z = logsig_f(v.z + bb.z) * 0.0625f; o.w = logsig_f(v.w + bb.w) * 0.0625f;
                            *(f32x4*)(G + (size_t)(rowb + ai * HALF + m * 16) * 256 + j0 + 16 * n) = o; } }
            } else if ((nw >= 1024 && nw < 1536) || (nw >= 2048 && nw < 2560)) {
                bf16_t* T = (bf16_t*)(p.ws + (nw < 1536 ? OFF_VT : OFF_GVT)) + (size_t)((nw < 1536 ? nw - 1024 : nw - 2048) + 4 * fq) * MROWS + rowb;
#pragma unroll
                for (int n = 0; n < 2; ++n)
#pragma unroll
                    for (int ai = 0; ai < 2; ++ai)
#pragma unroll
                        for (int m = 0; m < 4; ++m) { const f32x4 v = acc[ai][bj][m][n]; bf16_t* t = T + (size_t)(16 * n) * MROWS + ai * HALF + m * 16;
                            t[0] = (bf16_t)f2bf(v.x); t[MROWS] = (bf16_t)f2bf(v.y); t[2 * MROWS] = (bf16_t)f2bf(v.z); t[3 * (size_t)MROWS] = (bf16_t)f2bf(v.w); }
            } else {
                bf16_t* base; int ld, c0; float sc = 1.f; bool silu = false;
                if (nw < 512) { base = (bf16_t*)(p.ws + OFF_QB); ld = 512; c0 = nw; sc = QSCALE; }
                else if (nw < 1024) { base = (bf16_t*)(p.ws + OFF_KB); ld = 512; c0 = nw - 512; }
                else if (nw < 1792) { base = (bf16_t*)(p.ws + OFF_GQ); ld = 256; c0 = nw - 1536; sc = 0.125f; }
                else if (nw < 2048) { base = (bf16_t*)(p.ws + OFF_GK); ld = 256; c0 = nw - 1792; }
                else { base = (bf16_t*)(p.ws + OFF_GR); ld = 512; c0 = nw - 2560; silu = true; }
                const bool rope = nw < 1024 && (nw & 63) == 0;
#pragma unroll
                for (int ai = 0; ai < 2; ++ai)
#pragma unroll
                    for (int m = 0; m < 4; ++m) {
                        const int row = rowb + ai * HALF + m * 16;
#pragma unroll
                        for (int n = 0; n < 2; ++n) {
                            f32x4 v = acc[ai][bj][m][n];
                            if (n == 0 && rope) {
                                const int pos = row < NTOK ? NMETA + (row & (SEQ - 1)) : (row - NTOK < TPOS ? row - NTOK : 0);
                                const f32x4 cs = *(const f32x4*)((const float*)(p.ws + OFF_ROPE) + ((size_t)pos * 8 + 2 * fq) * 2);
                                const float a0 = v.x * cs.x - v.y * cs.y, b0 = v.y * cs.x + v.x * cs.y, a1 = v.z * cs.z - v.w * cs.w, b1 = v.w * cs.z + v.z * cs.w;
                                v = (f32x4){a0, b0, a1, b1};
                            }
                            if (silu) v = (f32x4){silu_f(v.x), silu_f(v.y), silu_f(v.z), silu_f(v.w)}; else v = v * sc;
                            *(u32x2*)(base + (size_t)row * ld + c0 + 16 * n + 4 * fq) = (u32x2){pk2(v.x, v.y), pk2(v.z, v.w)};
                        }
                    }
            }
        }
    }
};
struct EpiP3 {
    static constexpr bool PERM = false, AFTER_DRAIN = false;
    const float* x; float* out; bf16_t* h2b; float* ssq;
    __device__ __forceinline__ void operator()(const f32x4 (&acc)[2][2][4][2], const Unit& u, int wr, int wc, int fr, int fq) const {
#pragma unroll
        for (int ai = 0; ai < 2; ++ai)
#pragma unroll
            for (int m = 0; m < 4; ++m) { const int row = u.pm * BM + ai * HALF + wr * 64 + m * 16 + fr; float ss = 0.f;
#pragma unroll
                for (int bj = 0; bj < 2; ++bj)
#pragma unroll
                    for (int n = 0; n < 2; ++n) { const int col = u.pn * BM + bj * HALF + wc * 32 + n * 16 + 4 * fq;
                        const f32x4 hv = *(const f32x4*)(x + (size_t)row * DM + col) + acc[ai][bj][m][n];
                        *(f32x4*)(out + (size_t)row * DM + col) = hv;
                        *(u32x2*)(h2b + (size_t)row * DM + col) = (u32x2){pk2(hv.x, hv.y), pk2(hv.z, hv.w)};
                        ss += hv.x * hv.x + hv.y * hv.y + hv.z * hv.z + hv.w * hv.w; }
                ss += __shfl_xor(ss, 16); ss += __shfl_xor(ss, 32);
                if (fq == 0) ssq[(size_t)row * 16 + u.pn * 4 + wc] = ss; }
    }
};
struct OneUnit {
    Unit u; bool valid;
    __device__ __forceinline__ bool next(int i, Unit& o) const { if (i != 0 || !valid) return false; o = u; return true; }
    __device__ __forceinline__ void a_ready(const Unit&) const {}
    __device__ __forceinline__ void done(const Unit&) const {}
};

template <class Epi, class Sched, bool ALIGN_EPI = false, bool SP2 = false>
__device__ __forceinline__ void gemm_phase(PG8_LAS unsigned char* lds, const Gemm g, const Sched& S, const Epi& E) {
    const int tid = threadIdx.x, wid = __builtin_amdgcn_readfirstlane(tid >> 6), lane = tid & 63, wr = wid >> 2, wc = wid & 3, fr = lane & 15, fq = lane >> 4;
    const int K = g.K, nt = K / BK;
    unsigned voffA[2], voffB[2];
#pragma unroll
    for (int i = 0; i < 2; ++i) { int R, C; stage_rc(tid * 16 + i * 8192, R, C); const int Rb = Epi::PERM ? ((R & ~31) + perm32(R & 31)) : R;
        voffA[i] = (unsigned)(R * K + C) * 2u; voffB[i] = (unsigned)(Rb * K + C) * 2u; }
    const size_t kstep = (size_t)(BK * 2);
    const size_t hstep = (size_t)HALF * K * 2;
    const size_t tstep = 2 * hstep;
    const unsigned ldsw = (unsigned)wid * 1024u;
    const int aoff = lds_byte(wr * 64 + fr, fq * 8), boff = lds_byte(wc * 32 + fr, fq * 8);
#define PG8_SA(b, h) (((b) * 2 + (h)) * HTB)
#define PG8_SB(b, h) ((4 + (b) * 2 + (h)) * HTB)
#define PG8_STAGE(bufoff, gbase, voff) do { _Pragma("unroll") for (int _i = 0; _i < 2; ++_i) \
        __builtin_amdgcn_global_load_lds((const unsigned*)((const char*)(gbase) + (voff)[_i]), (PG8_LAS unsigned*)(lds + (bufoff) + ldsw + _i * 8192), 16, 0, 0); } while (0)
#define PG8_LDA(dst, b, h) do { _Pragma("unroll") for (int m = 0; m < 4; ++m) _Pragma("unroll") for (int k = 0; k < 2; ++k) dst[m][k] = *(const PG8_LAS bf16x8*)(lds + PG8_SA(b, h) + aoff + m * 2048 + k * 1024); } while (0)
#define PG8_LDB(dst, b, h) do { _Pragma("unroll") for (int n = 0; n < 2; ++n) _Pragma("unroll") for (int k = 0; k < 2; ++k) dst[n][k] = *(const PG8_LAS bf16x8*)(lds + PG8_SB(b, h) + boff + n * 2048 + k * 1024); } while (0)
#define PG8_MMA(ai, bj, At, Bt) do { __builtin_amdgcn_s_setprio(1); _Pragma("unroll") for (int m = 0; m < 4; ++m) _Pragma("unroll") for (int n = 0; n < 2; ++n) _Pragma("unroll") for (int k = 0; k < 2; ++k) \
        acc[ai][bj][m][n] = __builtin_amdgcn_mfma_f32_16x16x32_bf16(Bt[n][k], At[m][k], acc[ai][bj][m][n], 0, 0, 0); __builtin_amdgcn_s_setprio(0); } while (0)
#define PG8_WAIT_V(n) asm volatile("s_waitcnt vmcnt(" #n ")" ::: "memory")
#define PG8_WAIT_L(n) asm volatile("s_waitcnt lgkmcnt(" #n ")" ::: "memory")
#define PG8_BAR __builtin_amdgcn_s_barrier()
#define PG8_SCHED __builtin_amdgcn_sched_barrier(0)
    Unit cur, nxt; int ui = 0;
    if (!S.next(0, cur)) return;
    f32x4 acc[2][2][4][2];
#pragma unroll
    for (int a = 0; a < 2; ++a)
#pragma unroll
        for (int b = 0; b < 2; ++b)
#pragma unroll
            for (int m = 0; m < 4; ++m)
#pragma unroll
                for (int n = 0; n < 2; ++n) acc[a][b][m][n] = (f32x4){0.f, 0.f, 0.f, 0.f};
    bf16x8 At[4][2], B0[2][2], B1[2][2];
    const char* cA = (const char*)g.A + (size_t)cur.pm * tstep; const char* cB = (const char*)g.Bt + (size_t)cur.pn * tstep;
    S.a_ready(cur);
    if constexpr (SP2) {
        PG8_STAGE(PG8_SB(0, 0), cB, voffB); PG8_STAGE(PG8_SB(0, 1), cB + hstep, voffB); PG8_STAGE(PG8_SA(0, 0), cA, voffA); PG8_STAGE(PG8_SA(0, 1), cA + hstep, voffA);
        if (wr == 1) PG8_BAR;
        PG8_WAIT_V(2); PG8_BAR;
        PG8_STAGE(PG8_SB(1, 0), cB + kstep, voffB); PG8_STAGE(PG8_SA(1, 0), cA + kstep, voffA); PG8_STAGE(PG8_SB(1, 1), cB + hstep + kstep, voffB);
        PG8_WAIT_V(6); PG8_BAR;
    } else {
        PG8_STAGE(PG8_SB(0, 0), cB, voffB); PG8_STAGE(PG8_SA(0, 0), cA, voffA); PG8_STAGE(PG8_SB(0, 1), cB + hstep, voffB); PG8_STAGE(PG8_SA(0, 1), cA + hstep, voffA);
        if (wr == 1) PG8_BAR;
        PG8_WAIT_V(4); PG8_BAR;
        PG8_STAGE(PG8_SB(1, 0), cB + kstep, voffB); PG8_STAGE(PG8_SA(1, 0), cA + kstep, voffA); PG8_STAGE(PG8_SB(1, 1), cB + hstep + kstep, voffB);
        PG8_WAIT_V(6); PG8_BAR;
    }
    for (;;) {
        const bool has_next = S.next(ui + 1, nxt);
        const char* nA = has_next ? (const char*)g.A + (size_t)nxt.pm * tstep : cA; const char* nB = has_next ? (const char*)g.Bt + (size_t)nxt.pn * tstep : cB;
        for (int t = 0; t < nt; t += 2) {
            const bool last = (t == nt - 2);
            const char* a1 = cA + (size_t)(t + 1) * kstep;
            const char* a2 = last ? nA : cA + (size_t)(t + 2) * kstep; const char* b2 = last ? nB : cB + (size_t)(t + 2) * kstep;
            const char* a3 = a2 + kstep; const char* b3 = b2 + kstep;
            if (last && has_next) S.a_ready(nxt);
            if constexpr (SP2) {
            PG8_LDB(B0, 0, 0); PG8_LDB(B1, 0, 1); PG8_SCHED; PG8_LDA(At, 0, 0); PG8_STAGE(PG8_SA(1, 1), a1 + hstep, voffA);
            PG8_WAIT_V(8); PG8_WAIT_L(0); PG8_BAR; PG8_MMA(0, 0, At, B0); PG8_MMA(0, 1, At, B1); PG8_BAR; PG8_SCHED;
            PG8_LDA(At, 0, 1); PG8_STAGE(PG8_SB(0, 0), b2, voffB); PG8_STAGE(PG8_SB(0, 1), b2 + hstep, voffB); PG8_STAGE(PG8_SA(0, 0), a2, voffA);
            PG8_WAIT_V(8); PG8_WAIT_L(0); PG8_BAR; PG8_MMA(1, 0, At, B0); PG8_MMA(1, 1, At, B1); PG8_BAR; PG8_SCHED;
            PG8_LDB(B0, 1, 0); PG8_LDB(B1, 1, 1); PG8_SCHED; PG8_LDA(At, 1, 0); PG8_STAGE(PG8_SA(0, 1), a2 + hstep, voffA);
            PG8_WAIT_V(8); PG8_WAIT_L(0); PG8_BAR; PG8_MMA(0, 0, At, B0); PG8_MMA(0, 1, At, B1); PG8_BAR; PG8_SCHED;
            PG8_LDA(At, 1, 1); PG8_STAGE(PG8_SB(1, 0), b3, voffB); PG8_STAGE(PG8_SB(1, 1), b3 + hstep, voffB); PG8_STAGE(PG8_SA(1, 0), a3, voffA);
            PG8_WAIT_V(8); PG8_WAIT_L(0); PG8_BAR; PG8_MMA(1, 0, At, B0); PG8_MMA(1, 1, At, B1); PG8_BAR; PG8_SCHED;
            } else {
            PG8_LDB(B0, 0, 0); PG8_SCHED; PG8_LDA(At, 0, 0); PG8_STAGE(PG8_SA(1, 1), a1 + hstep, voffA);
            PG8_WAIT_L(8); PG8_BAR; PG8_WAIT_L(0); PG8_MMA(0, 0, At, B0); PG8_BAR; PG8_SCHED;
            PG8_LDB(B1, 0, 1); PG8_STAGE(PG8_SB(0, 0), b2, voffB);
            PG8_BAR; PG8_WAIT_L(0); PG8_MMA(0, 1, At, B1); PG8_BAR;
            PG8_LDA(At, 0, 1); PG8_STAGE(PG8_SA(0, 0), a2, voffA);
            PG8_BAR; PG8_WAIT_L(0); PG8_MMA(1, 0, At, B0); PG8_BAR; PG8_SCHED;
            PG8_STAGE(PG8_SB(0, 1), b2 + hstep, voffB);
            PG8_WAIT_V(6); PG8_BAR; PG8_MMA(1, 1, At, B1); PG8_BAR;
            PG8_LDB(B0, 1, 0); PG8_SCHED; PG8_LDA(At, 1, 0); PG8_STAGE(PG8_SA(0, 1), a2 + hstep, voffA);
            PG8_WAIT_L(8); PG8_BAR; PG8_WAIT_L(0); PG8_MMA(0, 0, At, B0); PG8_BAR; PG8_SCHED;
            PG8_LDB(B1, 1, 1); PG8_STAGE(PG8_SB(1, 0), b3, voffB);
            PG8_BAR; PG8_WAIT_L(0); PG8_MMA(0, 1, At, B1); PG8_BAR;
            PG8_LDA(At, 1, 1); PG8_STAGE(PG8_SA(1, 0), a3, voffA);
            PG8_BAR; PG8_WAIT_L(0); PG8_MMA(1, 0, At, B0); PG8_BAR; PG8_SCHED;
            PG8_STAGE(PG8_SB(1, 1), b3 + hstep, voffB);
            PG8_WAIT_V(6); PG8_BAR; PG8_MMA(1, 1, At, B1); PG8_BAR;
            }
        }
        if constexpr (ALIGN_EPI) { if (wr == 0) PG8_BAR; }
        if constexpr (!Epi::AFTER_DRAIN) { E(acc, cur, wr, wc, fr, fq); S.done(cur); }
        if (!has_next) break;
#pragma unroll
        for (int a = 0; a < 2; ++a)
#pragma unroll
            for (int b = 0; b < 2; ++b)
#pragma unroll
                for (int m = 0; m < 4; ++m)
#pragma unroll
                    for (int n = 0; n < 2; ++n) acc[a][b][m][n] = (f32x4){0.f, 0.f, 0.f, 0.f};
        cur = nxt; cA = nA; cB = nB; ++ui;
        if constexpr (ALIGN_EPI) { if (wr == 1) PG8_BAR; }
    }
    PG8_WAIT_V(0);
    if constexpr (!ALIGN_EPI) { if (wr == 0) PG8_BAR; }
    PG8_BAR;
    if constexpr (Epi::AFTER_DRAIN) { E.fused(acc, cur, wr, wc, fr, fq, lds, wid, lane); S.done(cur); }
#undef PG8_SA
#undef PG8_SB
#undef PG8_STAGE
#undef PG8_LDA
#undef PG8_LDB
#undef PG8_MMA
#undef PG8_WAIT_V
#undef PG8_WAIT_L
#undef PG8_BAR
#undef PG8_SCHED
}
}
__device__ __forceinline__ float row_rstd(const float* ssq, int row) {
    const f32x4* q = (const f32x4*)(ssq + (size_t)row * 16);
    const f32x4 a = q[0], b = q[1], c = q[2], d = q[3];
    return rsqrtf(((((a.x + a.y) + (a.z + a.w)) + ((b.x + b.y) + (b.z + b.w))) + (((c.x + c.y) + (c.z + c.w)) + ((d.x + d.y) + (d.z + d.w)))) * (1.f / DM) + EPS);
}
__device__ __forceinline__ void phase1_mfma(const Params& p, LAS unsigned char* lds) {
    pg8::Gemm g{(const pg8::bf16_t*)(p.ws + OFF_XN), (const pg8::bf16_t*)(p.ws + OFF_WIN), MROWS, NIN, DM};
    pg8::StaticOrder S; S.init(MROWS, NIN, (int)gridDim.x, (int)blockIdx.x);
    pg8::EpiP1 E{P1Ptrs{p.ws, p.in[10], p.in[12]}};
    pg8::gemm_phase<pg8::EpiP1, pg8::StaticOrder, true, true>(lds, g, S, E);
}
__device__ __forceinline__ void phase3_mfma(const Params& p, LAS unsigned char* lds) {
    pg8::Gemm g{(const pg8::bf16_t*)(p.ws + OFF_MIX), (const pg8::bf16_t*)(p.ws + OFF_WOUT), NTOK, DM, DM};
    pg8::StaticOrder S; S.init(NTOK, DM, (int)gridDim.x, (int)blockIdx.x);
    pg8::EpiP3 E{p.in[0], p.out, (bf16_t*)(p.ws + OFF_H2B), (float*)(p.ws + OFF_SSQP)};
    pg8::gemm_phase<pg8::EpiP3, pg8::StaticOrder, true, true>(lds, g, S, E);
}

typedef float f32x16 __attribute__((ext_vector_type(16)));
constexpr int AT_KROW = 272, AT_VROW = 136, AT_KBYTES = 64 * AT_KROW, AT_VBYTES = 128 * AT_VROW, AT_STAGE = AT_KBYTES + AT_VBYTES;
__device__ __forceinline__ void attn_item(const Params& p, LAS unsigned char* lds, int item) {
    const int tid = threadIdx.x, lane = tid & 63, wave = __builtin_amdgcn_readfirstlane(tid >> 6), qg = wave >> 1, c = wave & 1, l31 = lane & 31, hh = lane >> 5;
    const int qt = item & 15, h = (item >> 4) & 3, b = item >> 6;
    const int r0 = b * SEQ + qt * 128;
    const bf16_t* QB = (const bf16_t*)(p.ws + OFF_QB); const bf16_t* KB = (const bf16_t*)(p.ws + OFF_KB); const bf16_t* VT = (const bf16_t*)(p.ws + OFF_VT);
    bf16x8 qf[4];
    {
        const bf16_t* qp = QB + (size_t)(r0 + qg * 32 + l31) * 512 + h * 128 + c * 64 + 8 * hh;
#pragma unroll
        for (int s = 0; s < 4; ++s) qf[s] = *(const bf16x8*)(qp + 16 * s);
    }
    f32x16 O[4];
#pragma unroll
    for (int i = 0; i < 4; ++i)
#pragma unroll
        for (int r = 0; r < 16; ++r) O[i][r] = 0.f;
    float m = 0.f, l = 0.f;
    const int kq0 = tid, kq1 = tid + 512;
    const bf16_t* kg0 = KB + (size_t)(kq0 >> 4) * 512 + h * 128 + (kq0 & 15) * 8; const bf16_t* kg1 = KB + (size_t)(kq1 >> 4) * 512 + h * 128 + (kq1 & 15) * 8;
    const bf16_t* vg0 = VT + (size_t)(h * 128 + (kq0 >> 3)) * MROWS + (kq0 & 7) * 8; const bf16_t* vg1 = VT + (size_t)(h * 128 + (kq1 >> 3)) * MROWS + (kq1 & 7) * 8;
    const int kl0 = (kq0 >> 4) * AT_KROW + (kq0 & 15) * 16, kl1 = (kq1 >> 4) * AT_KROW + (kq1 & 15) * 16;
    const int vl0 = AT_KBYTES + (kq0 >> 3) * AT_VROW + (kq0 & 7) * 16, vl1 = AT_KBYTES + (kq1 >> 3) * AT_VROW + (kq1 & 7) * 16;
    u32x4 kr0, kr1, vr0, vr1;
#define AT_LOAD(t) do { const size_t kro = (size_t)((t) < 32 ? b * SEQ + (t) * 64 : NTOK); \
        kr0 = *(const u32x4*)(kg0 + kro * 512); kr1 = *(const u32x4*)(kg1 + kro * 512); vr0 = *(const u32x4*)(vg0 + kro); vr1 = *(const u32x4*)(vg1 + kro); } while (0)
#define AT_WRITE(buf) do { LAS unsigned char* _b = lds + (buf) * AT_STAGE; \
        *(LAS u32x4*)(_b + kl0) = kr0; *(LAS u32x4*)(_b + kl1) = kr1; \
        *(LAS u32x2*)(_b + vl0) = (u32x2){vr0.x, vr0.y}; *(LAS u32x2*)(_b + vl0 + 8) = (u32x2){vr0.z, vr0.w}; \
        *(LAS u32x2*)(_b + vl1) = (u32x2){vr1.x, vr1.y}; *(LAS u32x2*)(_b + vl1 + 8) = (u32x2){vr1.z, vr1.w}; } while (0)
    __syncthreads();
    AT_LOAD(0); AT_WRITE(0);
    __syncthreads();
    for (int t = 0; t < 33; ++t) {
        if (t + 1 < 33) AT_LOAD(t + 1);
        const LAS unsigned char* kb_ = lds + (t & 1) * AT_STAGE; const LAS unsigned char* vb_ = kb_ + AT_KBYTES;
        f32x16 s0, s1;
#pragma unroll
        for (int r = 0; r < 16; ++r) { s0[r] = -m; s1[r] = -m; }
#pragma unroll
        for (int s = 0; s < 4; ++s) {
            const bf16x8 k0 = *(const LAS bf16x8*)(kb_ + l31 * AT_KROW + (c * 64 + 16 * s + 8 * hh) * 2);
            const bf16x8 k1 = *(const LAS bf16x8*)(kb_ + (32 + l31) * AT_KROW + (c * 64 + 16 * s + 8 * hh) * 2);
            s0 = __builtin_amdgcn_mfma_f32_32x32x16_bf16(k0, qf[s], s0, 0, 0, 0);
            s1 = __builtin_amdgcn_mfma_f32_32x32x16_bf16(k1, qf[s], s1, 0, 0, 0);
        }
        if (t == 32) {
#pragma unroll
            for (int r = 0; r < 16; ++r) { const int key = (r & 3) + 8 * (r >> 2) + 4 * hh; if (key >= 16) s0[r] = -1e30f; s1[r] = -1e30f; }
        }
        float mx = s0[0];
#pragma unroll
        for (int r = 1; r < 16; ++r) mx = fmaxf(mx, s0[r]);
#pragma unroll
        for (int r = 0; r < 16; ++r) mx = fmaxf(mx, s1[r]);
        mx = fmaxf(mx, __shfl_xor(mx, 32));
        if (t == 0 || __any(mx > 8.0f)) {
            const float d = t == 0 ? mx : fmaxf(mx, 0.f), alpha = __builtin_amdgcn_exp2f(-d);
            m += d; l *= alpha;
#pragma unroll
            for (int i = 0; i < 4; ++i) O[i] = O[i] * alpha;
#pragma unroll
            for (int r = 0; r < 16; ++r) { s0[r] -= d; s1[r] -= d; }
        }
        float ps = 0.f;
#pragma unroll
        for (int r = 0; r < 16; ++r) { s0[r] = __builtin_amdgcn_exp2f(s0[r]); s1[r] = __builtin_amdgcn_exp2f(s1[r]); ps += s0[r] + s1[r]; }
        l += ps;
        bf16x8 pf[2][2];
#pragma unroll
        for (int s2 = 0; s2 < 2; ++s2) {
            u32x4 a, bq;
            a.x = pk2(s0[8 * s2 + 0], s0[8 * s2 + 1]); a.y = pk2(s0[8 * s2 + 2], s0[8 * s2 + 3]); a.z = pk2(s0[8 * s2 + 4], s0[8 * s2 + 5]); a.w = pk2(s0[8 * s2 + 6], s0[8 * s2 + 7]);
            bq.x = pk2(s1[8 * s2 + 0], s1[8 * s2 + 1]); bq.y = pk2(s1[8 * s2 + 2], s1[8 * s2 + 3]); bq.z = pk2(s1[8 * s2 + 4], s1[8 * s2 + 5]); bq.w = pk2(s1[8 * s2 + 6], s1[8 * s2 + 7]);
            pf[0][s2] = __builtin_bit_cast(bf16x8, a); pf[1][s2] = __builtin_bit_cast(bf16x8, bq);
        }
#pragma unroll
        for (int vb = 0; vb < 4; ++vb)
#pragma unroll
            for (int kb = 0; kb < 2; ++kb)
#pragma unroll
                for (int s2 = 0; s2 < 2; ++s2) {
                    const LAS unsigned char* vp = vb_ + (vb * 32 + l31) * AT_VROW + (kb * 32 + 16 * s2 + 4 * hh) * 2;
                    const u32x2 lo = *(const LAS u32x2*)vp, hi = *(const LAS u32x2*)(vp + 16);
                    const bf16x8 vf = __builtin_bit_cast(bf16x8, (u32x4){lo.x, lo.y, hi.x, hi.y});
                    O[vb] = __builtin_amdgcn_mfma_f32_32x32x16_bf16(vf, pf[kb][s2], O[vb], 0, 0, 0);
                }
        if (t + 1 < 33) AT_WRITE((t + 1) & 1);
        __syncthreads();
    }
    const float inv = 1.f / (l + __shfl_xor(l, 32));
    LAS float* X = (LAS float*)lds + qg * 4096;
    if (c == 1) {
#pragma unroll
        for (int vb = 0; vb < 4; ++vb)
#pragma unroll
            for (int r = 0; r < 16; ++r) X[(vb * 16 + r) * 64 + lane] = O[vb][r] * inv;
    }
    __syncthreads();
    if (c == 0) {
        const float lam = ((const float*)(p.ws + OFF_MISC))[0];
        float ss = 0.f;
#pragma unroll
        for (int vb = 0; vb < 4; ++vb)
#pragma unroll
            for (int r = 0; r < 16; ++r) { const float y = O[vb][r] * inv - lam * X[(vb * 16 + r) * 64 + lane]; O[vb][r] = y; ss += y * y; }
        ss += __shfl_xor(ss, 32);
        const float rs = rsqrtf(ss * (1.f / 128.f) + EPS) * 0.8f;
        bf16_t* orow = (bf16_t*)(p.ws + OFF_MIX) + (size_t)(r0 + qg * 32 + l31) * DM + h * 128;
#pragma unroll
        for (int vb = 0; vb < 4; ++vb)
#pragma unroll
            for (int rq = 0; rq < 4; ++rq) {
                const int v0 = vb * 32 + 8 * rq + 4 * hh;
                const f32x4 w = *(const f32x4*)(p.in[8] + v0);
                u32x2 o; o.x = pk2(O[vb][4 * rq] * rs * w.x, O[vb][4 * rq + 1] * rs * w.y); o.y = pk2(O[vb][4 * rq + 2] * rs * w.z, O[vb][4 * rq + 3] * rs * w.w);
                *(u32x2*)(orow + v0) = o;
            }
    }
#undef AT_LOAD
#undef AT_WRITE
}
__device__ __forceinline__ void phase2_attn_mfma(const Params& p, LAS unsigned char* lds) {
    for (int it = vcu_of_block(); it < NB * 4 * 16; it += gridDim.x) attn_item(p, lds, it);
}


__device__ __forceinline__ int gsw(int row, int chunk) { return row * 128 + ((chunk ^ (row & 7)) << 4); }
constexpr int GL_SET = 40960;
constexpr int GL_QS = 0, GL_KS = 8192, GL_KT = 16384, GL_VT = 24576, GL_AT = 2 * GL_SET, GL_ST = GL_AT + 8192  , GL_DV = GL_ST + 32768  ;
__device__ __forceinline__ float dpp_scan64(float v) {
    v += __builtin_bit_cast(float, __builtin_amdgcn_update_dpp(0, __builtin_bit_cast(int, v), 0x111, 0xf, 0xf, false));
    v += __builtin_bit_cast(float, __builtin_amdgcn_update_dpp(0, __builtin_bit_cast(int, v), 0x112, 0xf, 0xf, false));
    v += __builtin_bit_cast(float, __builtin_amdgcn_update_dpp(0, __builtin_bit_cast(int, v), 0x114, 0xf, 0xf, false));
    v += __builtin_bit_cast(float, __builtin_amdgcn_update_dpp(0, __builtin_bit_cast(int, v), 0x118, 0xf, 0xf, false));
    v += __builtin_bit_cast(float, __builtin_amdgcn_update_dpp(0, __builtin_bit_cast(int, v), 0x142, 0xa, 0xf, false));
    v += __builtin_bit_cast(float, __builtin_amdgcn_update_dpp(0, __builtin_bit_cast(int, v), 0x143, 0xc, 0xf, false));
    return v;
}
__device__ __forceinline__ void gla_chain(const Params& p, LAS unsigned char* lds, int item) {
    const int tid = threadIdx.x, lane = tid & 63, wave = __builtin_amdgcn_readfirstlane(tid >> 6), l15 = lane & 15, g = lane >> 4;
    const int dir = item & 1, h = (item >> 1) & 3, b = item >> 3;
    const bf16_t* GQ = (const bf16_t*)(p.ws + OFF_GQ); const bf16_t* GK = (const bf16_t*)(p.ws + OFF_GK); const bf16_t* GVT = (const bf16_t*)(p.ws + OFF_GVT);
    const float* G = (const float*)(p.ws + (dir ? OFF_GB : OFF_GF));
    float* O = p.out + (dir ? (size_t)NTOK * 512 : 0);
    const int nsteps = dir ? 32 : 33;
    f32x4 accS[4];
#pragma unroll
    for (int i = 0; i < 4; ++i) accS[i] = (f32x4){0.f, 0.f, 0.f, 0.f};
    f32x4 g0, g1; u32x4 q8, k8, v0, v1;
    const int vdv = tid >> 2, vch = (tid & 3) * 2;
#define GL_ROWBASE(st) (dir ? b * SEQ + (31 - (st)) * 64 : ((st) == 0 ? NTOK : b * SEQ + ((st) - 1) * 64))
#define GL_LOAD(st) do { const int _rb = GL_ROWBASE(st); const size_t _r = (size_t)(_rb + lane); \
        g0 = *(const f32x4*)(G + _r * 256 + h * 64 + 8 * wave); g1 = *(const f32x4*)(G + _r * 256 + h * 64 + 8 * wave + 4); \
        q8 = *(const u32x4*)(GQ + _r * 256 + h * 64 + 8 * wave); k8 = *(const u32x4*)(GK + _r * 256 + h * 64 + 8 * wave); \
        v0 = *(const u32x4*)(GVT + (size_t)(h * 128 + vdv) * MROWS + _rb + vch * 8); v1 = *(const u32x4*)(GVT + (size_t)(h * 128 + vdv) * MROWS + _rb + vch * 8 + 8); } while (0)
    __syncthreads();
    *(LAS u32x4*)(lds + GL_ST + tid * 32) = (u32x4){0u, 0u, 0u, 0u}; *(LAS u32x4*)(lds + GL_ST + tid * 32 + 16) = (u32x4){0u, 0u, 0u, 0u};
    GL_LOAD(0);
    for (int st = 0; st < nsteps; ++st) {
        const bool meta = (dir == 0 && st == 0);
        const int rowbase = GL_ROWBASE(st);
        LAS unsigned char* sb = lds + (st & 1) * GL_SET;
        float gg[8] = {g0.x, g0.y, g0.z, g0.w, g1.x, g1.y, g1.z, g1.w};
        if (meta && lane >= NMETA) {
#pragma unroll
            for (int e = 0; e < 8; ++e) gg[e] = 0.f;
        }
        float qv[8] = {bflo(q8.x), bfhi(q8.x), bflo(q8.y), bfhi(q8.y), bflo(q8.z), bfhi(q8.z), bflo(q8.w), bfhi(q8.w)};
        float kv[8] = {bflo(k8.x), bfhi(k8.x), bflo(k8.y), bfhi(k8.y), bflo(k8.z), bfhi(k8.z), bflo(k8.w), bfhi(k8.w)};
        float qn[8], kn[8], ks[8];
#pragma unroll
        for (int e = 0; e < 8; ++e) {
            const float P = dpp_scan64(gg[e]);
            const float T = __builtin_bit_cast(float, __builtin_amdgcn_readlane(__builtin_bit_cast(int, P), 63));
            const float Bv = dir ? (T - P + gg[e]) : P;
            const float eb = __expf(Bv), en = __builtin_amdgcn_rcpf(eb), eT = __expf(T);
            qn[e] = qv[e] * eb; kn[e] = kv[e] * en; ks[e] = kn[e] * eT;
            if (lane == 0) *(LAS float*)(lds + GL_DV + (st & 1) * 256 + (8 * wave + e) * 4) = eT;
        }
        *(LAS u32x4*)(sb + GL_QS + gsw(lane, wave)) = (u32x4){pk2(qn[0], qn[1]), pk2(qn[2], qn[3]), pk2(qn[4], qn[5]), pk2(qn[6], qn[7])};
        *(LAS u32x4*)(sb + GL_KS + gsw(lane, wave)) = (u32x4){pk2(kn[0], kn[1]), pk2(kn[2], kn[3]), pk2(kn[4], kn[5]), pk2(kn[6], kn[7])};
#pragma unroll
        for (int e = 0; e < 8; e += 2) { const unsigned w = pk2(ks[e], ks[e + 1]);
            *(LAS unsigned short*)(sb + GL_KT + gsw(8 * wave + e, lane >> 3) + (lane & 7) * 2) = (unsigned short)w;
            *(LAS unsigned short*)(sb + GL_KT + gsw(8 * wave + e + 1, lane >> 3) + (lane & 7) * 2) = (unsigned short)(w >> 16); }
        *(LAS u32x4*)(sb + GL_VT + gsw(vdv, vch)) = v0; *(LAS u32x4*)(sb + GL_VT + gsw(vdv, vch + 1)) = v1;
        if (st + 1 < nsteps) GL_LOAD(st + 1);
        __syncthreads();
        const LAS unsigned char* STo = lds + GL_ST + (st & 1) * 16384; LAS unsigned char* STn = lds + GL_ST + ((st + 1) & 1) * 16384;
        if (!meta) {
            const int jb = wave >> 1;
#pragma unroll
            for (int ii = 0; ii < 2; ++ii) {
                const int ib = 2 * (wave & 1) + ii;
                f32x4 a = (f32x4){0.f, 0.f, 0.f, 0.f};
                const bool live = dir ? (jb >= ib) : (jb <= ib);
                if (live) {
#pragma unroll
                    for (int ks2 = 0; ks2 < 2; ++ks2) {
                        const bf16x8 kf = *(const LAS bf16x8*)(sb + GL_KS + gsw(jb * 16 + l15, ks2 * 4 + g));
                        const bf16x8 qf = *(const LAS bf16x8*)(sb + GL_QS + gsw(ib * 16 + l15, ks2 * 4 + g));
                        a = __builtin_amdgcn_mfma_f32_16x16x32_bf16(kf, qf, a, 0, 0, 0);
                    }
                    const int i = ib * 16 + l15, j0 = jb * 16 + 4 * g;
#pragma unroll
                    for (int r = 0; r < 4; ++r) { const bool keep = dir ? (j0 + r >= i) : (j0 + r <= i); a[r] = keep ? a[r] : 0.f; }
                }
                const int i = ib * 16 + l15, j0 = jb * 16 + 4 * g;
                *(LAS u32x2*)(lds + GL_AT + gsw(i, j0 >> 3) + (j0 & 7) * 2) = (u32x2){pk2(a[0], a[1]), pk2(a[2], a[3])};
            }
        }
        if (st + 1 < nsteps) {
#pragma unroll
            for (int kb = 0; kb < 4; ++kb) {
                const f32x4 dvv = *(const LAS f32x4*)(lds + GL_DV + (st & 1) * 256 + (kb * 16 + 4 * g) * 4);
                f32x4 a = accS[kb] * dvv;
#pragma unroll
                for (int ks2 = 0; ks2 < 2; ++ks2) {
                    const bf16x8 kf = *(const LAS bf16x8*)(sb + GL_KT + gsw(kb * 16 + l15, ks2 * 4 + g));
                    const bf16x8 vf = *(const LAS bf16x8*)(sb + GL_VT + gsw(wave * 16 + l15, ks2 * 4 + g));
                    a = __builtin_amdgcn_mfma_f32_16x16x32_bf16(kf, vf, a, 0, 0, 0);
                }
                accS[kb] = a;
                const int dk0 = kb * 16 + 4 * g;
                *(LAS u32x2*)(STn + gsw(wave * 16 + l15, dk0 >> 3) + (dk0 & 7) * 2) = (u32x2){pk2(a[0], a[1]), pk2(a[2], a[3])};
            }
        }
        __syncthreads();
        if (!meta) {
#pragma unroll
            for (int ib = 0; ib < 4; ++ib) {
                f32x4 a = (f32x4){0.f, 0.f, 0.f, 0.f};
#pragma unroll
                for (int ks2 = 0; ks2 < 2; ++ks2) {
                    const bf16x8 vf = *(const LAS bf16x8*)(sb + GL_VT + gsw(wave * 16 + l15, ks2 * 4 + g));
                    const bf16x8 af = *(const LAS bf16x8*)(lds + GL_AT + gsw(ib * 16 + l15, ks2 * 4 + g));
                    a = __builtin_amdgcn_mfma_f32_16x16x32_bf16(vf, af, a, 0, 0, 0);
                    const bf16x8 sf = *(const LAS bf16x8*)(STo + gsw(wave * 16 + l15, ks2 * 4 + g));
                    const bf16x8 qf = *(const LAS bf16x8*)(sb + GL_QS + gsw(ib * 16 + l15, ks2 * 4 + g));
                    a = __builtin_amdgcn_mfma_f32_16x16x32_bf16(sf, qf, a, 0, 0, 0);
                }
                *(f32x4*)(O + (size_t)(rowbase + ib * 16 + l15) * 512 + h * 128 + wave * 16 + 4 * g) = a;
            }
        }
    }
#undef GL_LOAD
#undef GL_ROWBASE
}

constexpr int LDS_Q = LDS_BYTES - 16;
__device__ __forceinline__ void phase2(const Params& p, LAS unsigned char* lds, int qslot = 0) {
    unsigned* ctr = (unsigned*)(p.ws + OFF_CTL) + (qslot >= 2 ? 2048 + qslot * 64 : qslot * 64);
    int it;
#define P2_NEXT() do { __syncthreads(); if (threadIdx.x == 0) *(LAS unsigned*)(lds + LDS_Q) = atomicAdd(ctr, 1u); __syncthreads(); it = (int)*(LAS unsigned*)(lds + LDS_Q); } while (0)
    P2_NEXT();
    if (qslot != 3) { while (it < 64) { gla_chain(p, lds, it); P2_NEXT(); } }
    if (qslot == 2) return;
    if (qslot == 3) it += 64;
    while (it < 64 + NB * 4 * 16) { attn_item(p, lds, it - 64); P2_NEXT(); if (qslot == 3) it += 64; }
    if (qslot) return;
    for (;;) {
        __syncthreads();
        if (threadIdx.x == 0) *(LAS unsigned*)(lds + LDS_Q) = atomicAdd(ctr + 128, 1u);
        __syncthreads();
        const int c = (int)*(LAS unsigned*)(lds + LDS_Q);
        if (c >= CV_ITEMS) break;
        conv_item(p, (unsigned char*)lds, c);
    }
#undef P2_NEXT
}

__device__ __forceinline__ void phase2c(const Params& p) {
    const int tid = threadIdx.x, lane = tid & 63, wave = tid >> 6;
    const int gw = blockIdx.x * 8 + wave, NGW = gridDim.x * 8;
    const bf16_t* GR = (const bf16_t*)(p.ws + OFF_GR); bf16_t* MIX = (bf16_t*)(p.ws + OFF_MIX);
    const float* OF = p.out; const float* OBk = p.out + (size_t)NTOK * 512;
    const int c0 = lane * 8;
    const f32x4 w0 = *(const f32x4*)(p.in[13] + (c0 & 127)), w1 = *(const f32x4*)(p.in[13] + (c0 & 127) + 4);
    for (int r = gw; r < NTOK; r += NGW) {
        const f32x4 a0 = *(const f32x4*)(OF + (size_t)r * 512 + c0), a1 = *(const f32x4*)(OF + (size_t)r * 512 + c0 + 4);
        const f32x4 b0 = *(const f32x4*)(OBk + (size_t)r * 512 + c0), b1 = *(const f32x4*)(OBk + (size_t)r * 512 + c0 + 4);
        const f32x4 x0 = a0 + b0, x1 = a1 + b1;
        float s = x0.x * x0.x + x0.y * x0.y + x0.z * x0.z + x0.w * x0.w + x1.x * x1.x + x1.y * x1.y + x1.z * x1.z + x1.w * x1.w;
        s += __shfl_xor(s, 1); s += __shfl_xor(s, 2); s += __shfl_xor(s, 4); s += __shfl_xor(s, 8);
        const float rs = rsqrtf(s * (1.f / 128.f) + EPS);
        const u32x4 g = *(const u32x4*)(GR + (size_t)r * 512 + c0);
        u32x4 o;
        o.x = pk2(x0.x * rs * w0.x * bflo(g.x), x0.y * rs * w0.y * bfhi(g.x)); o.y = pk2(x0.z * rs * w0.z * bflo(g.y), x0.w * rs * w0.w * bfhi(g.y));
        o.z = pk2(x1.x * rs * w1.x * bflo(g.z), x1.y * rs * w1.y * bfhi(g.z)); o.w = pk2(x1.z * rs * w1.z * bflo(g.w), x1.w * rs * w1.w * bfhi(g.w));
        *(u32x4*)(MIX + (size_t)r * DM + 512 + c0) = o;
    }
}


#define TOPK_INS(L, x) do { float _x = (x); _Pragma("unroll") for (int _s = 0; _s < 16; ++_s) { const float _t = fmaxf(L[_s], _x); _x = fminf(L[_s], _x); L[_s] = _t; } } while (0)
constexpr int P4_QROW = 528, P4_SC0 = 128 * P4_QROW  , P4_TLROW = 144;
__device__ __forceinline__ void p4_route_half(const Params& p, LAS unsigned char* lds, int m0, int h) {
    const int tid = threadIdx.x, lane = tid & 63, wave = __builtin_amdgcn_readfirstlane(tid >> 6), l15 = lane & 15, g = lane >> 4;
    const bf16_t* KEYS = (const bf16_t*)(p.ws + OFF_KEYS); unsigned* PW0 = (unsigned*)(p.ws + OFF_PW0);
        {
            const int wr = wave >> 1, wk = wave & 1;
            f32x4 sc[2][2][4];
#pragma unroll
            for (int pp = 0; pp < 2; ++pp) {
#pragma unroll
                for (int rb = 0; rb < 2; ++rb)
#pragma unroll
                    for (int kk = 0; kk < 4; ++kk) sc[pp][rb][kk] = (f32x4){0.f, 0.f, 0.f, 0.f};
                const bf16_t* kbase = KEYS + (size_t)((h * 2 + pp) * 128 + 64 * wk + l15) * 128 + 8 * g;
#pragma unroll
                for (int ks = 0; ks < 4; ++ks) {
                    bf16x8 qf[2], kf[4];
#pragma unroll
                    for (int rb = 0; rb < 2; ++rb) qf[rb] = *(const LAS bf16x8*)(lds + (32 * wr + 16 * rb + l15) * P4_QROW + (pp * 128 + ks * 32 + 8 * g) * 2);
#pragma unroll
                    for (int kk = 0; kk < 4; ++kk) kf[kk] = *(const bf16x8*)(kbase + (size_t)(16 * kk) * 128 + ks * 32);
#pragma unroll
                    for (int rb = 0; rb < 2; ++rb)
#pragma unroll
                        for (int kk = 0; kk < 4; ++kk) sc[pp][rb][kk] = __builtin_amdgcn_mfma_f32_16x16x32_bf16(kf[kk], qf[rb], sc[pp][rb][kk], 0, 0, 0);
                }
            }
#pragma unroll
            for (int rb = 0; rb < 2; ++rb)
#pragma unroll
                for (int kk = 0; kk < 4; ++kk) *(LAS f32x4*)(lds + P4_SC0 + (32 * wr + 16 * rb + l15) * P4_QROW + (64 * wk + 16 * kk + 4 * g) * 4) = sc[0][rb][kk];
            __syncthreads();
#pragma unroll
            for (int rb = 0; rb < 2; ++rb)
#pragma unroll
                for (int kk = 0; kk < 4; ++kk) *(LAS f32x4*)(lds + (32 * wr + 16 * rb + l15) * P4_QROW + (64 * wk + 16 * kk + 4 * g) * 4) = sc[1][rb][kk];
        }
        __syncthreads();
        {
            const int hf = tid & 1, row = (tid >> 1) & 127, pp = tid >> 8;
            const LAS unsigned char* sp = lds + (pp ? 0 : P4_SC0) + row * P4_QROW + hf * 256;
            float L[16];
#pragma unroll
            for (int s = 0; s < 16; ++s) L[s] = -3.0e38f;
#pragma unroll 4
            for (int q4 = 0; q4 < 16; ++q4) {
                const f32x4 v = *(const LAS f32x4*)(sp + q4 * 16);
                const unsigned kb = (unsigned)(hf * 64 + q4 * 4);
                TOPK_INS(L, __uint_as_float((__float_as_uint(v.x) & ~127u) | kb));
                TOPK_INS(L, __uint_as_float((__float_as_uint(v.y) & ~127u) | (kb + 1)));
                TOPK_INS(L, __uint_as_float((__float_as_uint(v.z) & ~127u) | (kb + 2)));
                TOPK_INS(L, __uint_as_float((__float_as_uint(v.w) & ~127u) | (kb + 3)));
            }
            float Oth[16];
#pragma unroll
            for (int s = 0; s < 16; ++s) Oth[s] = __shfl_xor(L[s], 1);
#pragma unroll
            for (int s = 0; s < 16; ++s) TOPK_INS(L, Oth[s]);
            __syncthreads();
            if (hf == 0) {
                LAS f32x4* tl = (LAS f32x4*)(lds + P4_SC0 + row * (2 * P4_TLROW) + pp * P4_TLROW);
                tl[0] = (f32x4){L[0], L[1], L[2], L[3]}; tl[1] = (f32x4){L[4], L[5], L[6], L[7]}; tl[2] = (f32x4){L[8], L[9], L[10], L[11]}; tl[3] = (f32x4){L[12], L[13], L[14], L[15]};
            }
        }
        __syncthreads();
        if (tid < 128) {
            const LAS unsigned char* tl = lds + P4_SC0 + tid * (2 * P4_TLROW);
            float A[16], Bv[16];
#pragma unroll
            for (int q4 = 0; q4 < 4; ++q4) { const f32x4 a = *(const LAS f32x4*)(tl + q4 * 16), b = *(const LAS f32x4*)(tl + P4_TLROW + q4 * 16);
                A[4 * q4] = a.x; A[4 * q4 + 1] = a.y; A[4 * q4 + 2] = a.z; A[4 * q4 + 3] = a.w; Bv[4 * q4] = b.x; Bv[4 * q4 + 1] = b.y; Bv[4 * q4 + 2] = b.z; Bv[4 * q4 + 3] = b.w; }
#pragma unroll
            for (int s = 0; s < 16; ++s) { A[s] = __uint_as_float(__float_as_uint(A[s]) & ~127u); Bv[s] = __uint_as_float(__float_as_uint(Bv[s]) & ~127u); }
            float L[16];
#pragma unroll
            for (int s = 0; s < 16; ++s) L[s] = -3.0e38f;
#pragma unroll
            for (int i = 0; i < 16; ++i)
#pragma unroll
                for (int j = 0; j < 16; ++j)
                    if ((i + 1) * (j + 1) <= 16) TOPK_INS(L, __uint_as_float((__float_as_uint(A[i] + Bv[j]) & ~255u) | (unsigned)(i * 16 + j)));
            const float v0 = __uint_as_float(__float_as_uint(L[0]) & ~255u);
            float e[16], den = 0.f; int id[16];
#pragma unroll
            for (int s = 0; s < 16; ++s) {
                const unsigned u = __float_as_uint(L[s]);
                e[s] = __expf(__uint_as_float(u & ~255u) - v0); den += e[s];
                const unsigned i = (u >> 4) & 15u, j = u & 15u;
                const unsigned ka = *(const LAS unsigned*)(tl + i * 4) & 127u, kb = *(const LAS unsigned*)(tl + P4_TLROW + j * 4) & 127u;
                id[s] = (int)(ka * 128u + kb);
            }
            const float inv = 1.f / den;
            unsigned* ip = PW0 + (size_t)(m0 + tid) * 128 + h * 16;
#pragma unroll
            for (int q4 = 0; q4 < 4; ++q4) { u32x4 o;
#pragma unroll
                for (int c = 0; c < 4; ++c) o[c] = (unsigned)id[4 * q4 + c] | (f2bf(e[4 * q4 + c] * inv) << 16);
                *(u32x4*)(ip + 4 * q4) = o; }
        }
        __syncthreads();
}

namespace pg8 {
struct EpiP4 {
    static constexpr bool PERM = false, AFTER_DRAIN = true;
    const Params* pp; const float* ssq;
    __device__ __forceinline__ void operator()(const f32x4 (&)[2][2][4][2], const Unit&, int, int, int, int) const {}
    __device__ __forceinline__ void fused(f32x4 (&acc)[2][2][4][2], const Unit& u, int wr, int wc, int fr, int fq, PG8_LAS unsigned char* lds, int wid, int lane) const {
#pragma unroll
        for (int ai = 0; ai < 2; ++ai) {
            const int m0 = u.pm * BM + ai * HALF;
#pragma unroll
            for (int m = 0; m < 4; ++m) {
                const int rl = wr * 64 + m * 16 + fr;
                const float rstd = row_rstd(ssq, m0 + rl);
#pragma unroll
                for (int bj = 0; bj < 2; ++bj)
#pragma unroll
                    for (int n = 0; n < 2; ++n) { const f32x4 v = acc[ai][bj][m][n] * rstd;
                        *(PG8_LAS u32x2*)(lds + rl * P4_QROW + (bj * HALF + wc * 32 + n * 16 + 4 * fq) * 2) = (u32x2){pk2(v.x, v.y), pk2(v.z, v.w)}; }
            }
            __syncthreads();
            p4_route_half(*pp, lds, m0, u.pn);
        }
    }
};
}
__device__ __forceinline__ void phase4_mfma(const Params& p, LAS unsigned char* lds) {
    pg8::Gemm g{(const pg8::bf16_t*)(p.ws + OFF_H2B), (const pg8::bf16_t*)(p.ws + OFF_WQ), NTOK, 2048, DM};
    pg8::EpiP4 E{&p, (const float*)(p.ws + OFF_SSQP)};
    const int vcu = vcu_of_block();
    for (int r = 0; r * (int)gridDim.x < 512; ++r) {
        const int L = r * (int)gridDim.x + vcu;
        pg8::OneUnit S; S.u.pm = L >> 3; S.u.pn = L & 7; S.valid = L < 512;
        pg8::gemm_phase<pg8::EpiP4, pg8::OneUnit, false, true>(lds, g, S, E);
        __syncthreads();
    }
}


constexpr size_t OFF_PW = 73 * MiB;
constexpr size_t OFF_OUTS = 179 * MiB;
static_assert(OFF_OUTS >= OFF_PW0 + (size_t)NTOK * 128 * 4 && OFF_OUTS + (size_t)NTOK * DM * 4 <= 256 * MiB, "P5 map");
__device__ __forceinline__ float dot_fp8_bf16(u32x4 uq, u32x4 h0, u32x4 h1, float c) {
#define DQ2(word, hsel, hw) c = dot2(__builtin_bit_cast(unsigned, __builtin_amdgcn_cvt_scalef32_pk_bf16_fp8((int)(word), 1.0f, hsel)), hw, c)
    DQ2(uq.x, false, h0.x); DQ2(uq.x, true, h0.y); DQ2(uq.y, false, h0.z); DQ2(uq.y, true, h0.w);
    DQ2(uq.z, false, h1.x); DQ2(uq.z, true, h1.y); DQ2(uq.w, false, h1.z); DQ2(uq.w, true, h1.w);
#undef DQ2
    return c;
}
constexpr int P5A_RS = 1040, P5A_LIST = 16640, P5A_RES = 18688, P5A_TSC = 18752, P5A_WAVE = 19456;
constexpr size_t OFF_HQ = 146 * MiB;
constexpr size_t OFF_HSC = 192 * 1024;
static_assert(8 * P5A_WAVE <= LDS_BYTES - 32, "P5a LDS");
static_assert(OFF_HQ >= OFF_H2B + (size_t)NTOK * DM * 2 && OFF_HQ + (size_t)NTOK * DM <= OFF_PW0, "HQ map");
__device__ __forceinline__ void quantize_hn(const Params& p) {
    const int tid = threadIdx.x, lane = tid & 63, wave = tid >> 6;
    const bf16_t* H2B = (const bf16_t*)(p.ws + OFF_H2B); unsigned char* HQ = p.ws + OFF_HQ; float* HSC = (float*)(p.ws + OFF_HSC);
    for (int t = blockIdx.x * 8 + wave; t < NTOK; t += gridDim.x * 8) {
        const u32x4 h0 = *(const u32x4*)(H2B + (size_t)t * DM + 16 * lane), h1 = *(const u32x4*)(H2B + (size_t)t * DM + 16 * lane + 8);
        float m = 0.f;
#pragma unroll
        for (int c = 0; c < 4; ++c) { m = fmaxf(m, fmaxf(fabsf(bflo(h0[c])), fabsf(bfhi(h0[c])))); m = fmaxf(m, fmaxf(fabsf(bflo(h1[c])), fabsf(bfhi(h1[c])))); }
        const float am = fmaxf(wave_max(m), 1e-30f), qs = 224.f / am;
        u32x4 o;
#pragma unroll
        for (int c = 0; c < 2; ++c) {
            int w = __builtin_amdgcn_cvt_pk_fp8_f32(bflo(h0[2 * c]) * qs, bfhi(h0[2 * c]) * qs, 0, false); w = __builtin_amdgcn_cvt_pk_fp8_f32(bflo(h0[2 * c + 1]) * qs, bfhi(h0[2 * c + 1]) * qs, w, true); o[c] = (unsigned)w;
            int x = __builtin_amdgcn_cvt_pk_fp8_f32(bflo(h1[2 * c]) * qs, bfhi(h1[2 * c]) * qs, 0, false); x = __builtin_amdgcn_cvt_pk_fp8_f32(bflo(h1[2 * c + 1]) * qs, bfhi(h1[2 * c + 1]) * qs, x, true); o[2 + c] = (unsigned)x;
        }
        *(u32x4*)(HQ + (size_t)t * DM + 16 * lane) = o;
        if (lane == 0) HSC[t] = row_rstd((const float*)(p.ws + OFF_SSQP), t) * am * (1.f / 224.f);
    }
}
__device__ __forceinline__ void p5a_wave(const Params& p, LAS unsigned char* wl, int tb, int part, int lane, __amdgpu_buffer_rsrc_t urs, __amdgpu_buffer_rsrc_t hrs) {
    const float* USC = (const float*)(p.ws + OFF_USC); const float* VSC = (const float*)(p.ws + OFF_VSC); const float* HSC = (const float*)(p.ws + OFF_HSC);
    const unsigned* PW0 = (const unsigned*)(p.ws + OFF_PW0); unsigned* PW = (unsigned*)(p.ws + OFF_PW);
    const int l15 = lane & 15, g = lane >> 4;
    unsigned xl[4], xh[4]; float hsc = 0.f;
#define P5A_STAGE(t0_) do { _Pragma("unroll") for (int _k = 0; _k < 4; ++_k) { \
        __builtin_amdgcn_raw_ptr_buffer_load_lds(hrs, (LAS unsigned*)(wl + _k * 1024), 16, lane * 16, ((t0_) + _k) * 1024, 0, 0); \
        xl[_k] = PW0[(size_t)((t0_) + _k) * 128 + lane]; xh[_k] = PW0[(size_t)((t0_) + _k) * 128 + 64 + lane]; } \
        hsc = HSC[(t0_) + (lane & 3)]; } while (0)
#define P5A_GATHER(tile_) do { int _li = (tile_) * 16 + l15; _li = _li < n ? _li : n - 1; \
        const int _ev = (int)((*(const LAS unsigned*)(wl + P5A_LIST + _li * 4) & 0x3fffu) << 10); \
        _Pragma("unroll") for (int _r = 0; _r < 16; ++_r) \
            __builtin_amdgcn_raw_ptr_buffer_load_lds(urs, (LAS unsigned*)(wl + _r * P5A_RS), 16, lane * 16, __builtin_amdgcn_readlane(_ev, _r), 0, 0); } while (0)
    P5A_STAGE(tb);
    for (int st = 0; st < 4; ++st) {
        const int t0 = tb + 4 * st;
        asm volatile("s_waitcnt vmcnt(0)" ::: "memory");
        long bq[32];
#pragma unroll
        for (int s = 0; s < 32; ++s) bq[s] = __builtin_bit_cast(long, *(const LAS u32x2*)(wl + (l15 & 3) * 1024 + 32 * s + 8 * g));
        if (lane < 4) *(LAS float*)(wl + P5A_TSC + lane * 4) = hsc;
        int n = 0;
#pragma unroll
        for (int k = 0; k < 4; ++k) {
            const bool ml = (int)((xl[k] >> 11) & 7u) == part, mh = (int)((xh[k] >> 11) & 7u) == part;
            const unsigned long long bl = __ballot(ml), bh = __ballot(mh);
            const int rl = __builtin_amdgcn_mbcnt_hi((unsigned)(bl >> 32), __builtin_amdgcn_mbcnt_lo((unsigned)bl, 0u));
            if (ml) *(LAS unsigned*)(wl + P5A_LIST + (n + rl) * 4) = (xl[k] & 0x3fffu) | ((unsigned)lane << 14) | ((unsigned)k << 21);
            n += __popcll(bl);
            const int rh = __builtin_amdgcn_mbcnt_hi((unsigned)(bh >> 32), __builtin_amdgcn_mbcnt_lo((unsigned)bh, 0u));
            if (mh) *(LAS unsigned*)(wl + P5A_LIST + (n + rh) * 4) = (xh[k] & 0x3fffu) | ((unsigned)(64 + lane) << 14) | ((unsigned)k << 21);
            n += __popcll(bh);
        }
        __builtin_amdgcn_s_waitcnt(0xC07F); __builtin_amdgcn_wave_barrier();
        asm volatile("" ::: "memory");
        const int ntile = (n + 15) >> 4;
        if (ntile == 0) { if (st < 3) P5A_STAGE(t0 + 4); continue; }
        P5A_GATHER(0);
        for (int tile = 0; tile < ntile; ++tile) {
            asm volatile("s_waitcnt vmcnt(0)" ::: "memory");
            int ei = tile * 16 + l15; const bool eok = ei < n; ei = eok ? ei : n - 1;
            const unsigned ent = *(const LAS unsigned*)(wl + P5A_LIST + ei * 4);
            const unsigned ee = ent & 0x3fffu; const int sl = (int)((ent >> 14) & 127u), tk = (int)(ent >> 21), t = t0 + tk;
            float usc = USC[ee], vsc = VSC[ee]; unsigned xg = PW0[(size_t)t * 128 + sl];
            long aq[32];
#pragma unroll
            for (int s = 0; s < 32; ++s) aq[s] = __builtin_bit_cast(long, *(const LAS u32x2*)(wl + l15 * P5A_RS + 32 * s + 8 * g));
            asm volatile("s_waitcnt vmcnt(0) lgkmcnt(0)" : "+v"(usc), "+v"(vsc), "+v"(xg) :: "memory");
#pragma unroll
            for (int s = 0; s < 32; ++s) asm volatile("" : "+v"(aq[s]));
            if (tile + 1 < ntile) P5A_GATHER(tile + 1); else if (st < 3) P5A_STAGE(t0 + 4);
            f32x4 acc = (f32x4){0.f, 0.f, 0.f, 0.f};
#pragma unroll
            for (int s = 0; s < 32; ++s) acc = __builtin_amdgcn_mfma_f32_16x16x32_fp8_fp8(aq[s], bq[s], acc, 0, 0, 0);
            {
                const u32x4 en = *(const LAS u32x4*)(wl + P5A_LIST + (tile * 16 + 4 * g) * 4);
#pragma unroll
                for (int r = 0; r < 4; ++r) if ((int)(en[r] >> 21) == l15) *(LAS float*)(wl + P5A_RES + (4 * g + r) * 4) = acc[r];
            }
            __builtin_amdgcn_s_waitcnt(0xC07F); __builtin_amdgcn_wave_barrier();
            asm volatile("" ::: "memory");
            if (lane < 16 && eok) {
                const float d = *(const LAS float*)(wl + P5A_RES + lane * 4) * usc * *(const LAS float*)(wl + P5A_TSC + tk * 4);
                const float w = __uint_as_float(xg & 0xffff0000u) * gelu_f(d) * vsc;
                PW[(((size_t)(t >> 6) * 32 + (sl >> 2)) * 64 + (t & 63)) * 4 + (sl & 3)] = ee | (f2bf(w) << 16);
            }
            __builtin_amdgcn_s_waitcnt(0xC07F); __builtin_amdgcn_wave_barrier();
            asm volatile("" ::: "memory");
        }
    }
    asm volatile("s_waitcnt vmcnt(0)" ::: "memory");
#undef P5A_STAGE
#undef P5A_GATHER
}
__device__ __forceinline__ void phase5a(const Params& p, LAS unsigned char* lds, int qoff = 0) {
    const int tid = threadIdx.x, lane = tid & 63, wave = __builtin_amdgcn_readfirstlane(tid >> 6);
    const int xcc = (int)(__builtin_amdgcn_s_getreg((3 << 11) | 20) & 7u);
    unsigned* qc = (unsigned*)(p.ws + OFF_CTL) + 256 + qoff;
    LAS unsigned char* wl = lds + wave * P5A_WAVE;
    const __amdgpu_buffer_rsrc_t urs = __builtin_amdgcn_make_buffer_rsrc((void*)(p.ws + OFF_UB), 0, NEXP * DM, 0x00020000);
    const __amdgpu_buffer_rsrc_t hrs = __builtin_amdgcn_make_buffer_rsrc((void*)(p.ws + OFF_HQ), 0, NTOK * DM, 0x00020000);
    for (int pi = 0; pi < 8; ++pi) {
        const int part = (xcc + pi) & 7;
        for (;;) {
            __syncthreads();
            if (tid == 0) *(LAS unsigned*)(lds + LDS_Q) = atomicAdd(qc + part * 64, 1u);
            __syncthreads();
            const int it = (int)*(LAS unsigned*)(lds + LDS_Q);
            if (it >= NTOK / 128) break;
            p5a_wave(p, wl, it * 128 + wave * 16, part, lane, urs, hrs);
        }
    }
}

__device__ __forceinline__ void p5b_quad(const LAS unsigned char* lds, u32x4 q, f32x2& a0, f32x2& a1, f32x2& a2, f32x2& a3) {
#pragma unroll
    for (int c = 0; c < 4; ++c) {
        const unsigned x = q[c];
        const u32x2 vv = *(const LAS u32x2*)(lds + ((x & 0x3fffu) << 3));
        const float w = __uint_as_float(x & 0xffff0000u); const f32x2 ww = (f32x2){w, w};
        a0 += ww * __builtin_amdgcn_cvt_pk_f32_fp8((int)vv.x, false); a1 += ww * __builtin_amdgcn_cvt_pk_f32_fp8((int)vv.x, true);
        a2 += ww * __builtin_amdgcn_cvt_pk_f32_fp8((int)vv.y, false); a3 += ww * __builtin_amdgcn_cvt_pk_f32_fp8((int)vv.y, true);
    }
}
__device__ __forceinline__ void phase5b(const Params& p, LAS unsigned char* lds) {
    const int tid = threadIdx.x, lane = tid & 63, wave = __builtin_amdgcn_readfirstlane(tid >> 6);
    const unsigned char* VS = p.ws + OFF_VB; const u32x4* PW = (const u32x4*)(p.ws + OFF_PW); float* OUTS = (float*)(p.ws + OFF_OUTS);
    for (int it = blockIdx.x; it < 256; it += gridDim.x) {
        const int s = it >> 1, tbase = (it & 1) * 128;
        __syncthreads();
#pragma unroll 4
        for (int i = 0; i < 16; ++i) *(LAS u32x4*)(lds + (tid + NTHR * i) * 16) = *(const u32x4*)(VS + (size_t)s * 131072 + (size_t)(tid + NTHR * i) * 16);
        __syncthreads();
        u32x4 A[8], Bq[8];
#define P5B_LOAD(R, gi) do { const int _T = tbase + wave + 8 * ((gi) >> 2), _g = (gi) & 3; const u32x4* _p = PW + ((size_t)_T * 32 + _g * 8) * 64 + lane; \
        _Pragma("unroll") for (int _i = 0; _i < 8; ++_i) R[_i] = _p[_i * 64]; } while (0)
        f32x2 a0 = {0.f, 0.f}, a1 = {0.f, 0.f}, a2 = {0.f, 0.f}, a3 = {0.f, 0.f};
        P5B_LOAD(A, 0);
        for (int gi = 0; gi < 64; gi += 2) {
            P5B_LOAD(Bq, gi + 1);
#pragma unroll
            for (int i = 0; i < 8; ++i) p5b_quad(lds, A[i], a0, a1, a2, a3);
            if (gi + 2 < 64) P5B_LOAD(A, gi + 2);
#pragma unroll
            for (int i = 0; i < 8; ++i) p5b_quad(lds, Bq[i], a0, a1, a2, a3);
            if (((gi + 1) & 3) == 3) {
                const int T = tbase + wave + 8 * (gi >> 2);
                float* o = OUTS + ((size_t)s * NTOK + T * 64 + lane) * 8;
                *(f32x4*)o = (f32x4){a0.x, a0.y, a1.x, a1.y}; *(f32x4*)(o + 4) = (f32x4){a2.x, a2.y, a3.x, a3.y};
                a0 = (f32x2){0.f, 0.f}; a1 = a0; a2 = a0; a3 = a0;
            }
        }
#undef P5B_LOAD
    }
}

__device__ __forceinline__ void phase5c(const Params& p, LAS unsigned char* lds) {
    const int tid = threadIdx.x, lane = tid & 63, wave = __builtin_amdgcn_readfirstlane(tid >> 6);
    const float* OUTS = (const float*)(p.ws + OFF_OUTS); const float* fw = p.in[20];
    for (int it = blockIdx.x; it < NTOK / 32; it += gridDim.x) {
        const int t0 = it * 32;
        __syncthreads();
#pragma unroll 4
        for (int i = 0; i < 16; ++i) {
            const int q = tid + NTHR * i, s = q >> 6, tt = (q >> 1) & 31, hf = q & 1;
            *(LAS f32x4*)(lds + tt * 4112 + (s * 8 + hf * 4) * 4) = *(const f32x4*)(OUTS + ((size_t)s * NTOK + t0 + tt) * 8 + hf * 4);
        }
        __syncthreads();
        for (int i = 0; i < 4; ++i) {
            const int tt = wave * 4 + i; float* orow = p.out + (size_t)(t0 + tt) * DM;
            f32x4 h[4]; float ss = 0.f;
#pragma unroll
            for (int j = 0; j < 4; ++j) { h[j] = *(const f32x4*)(orow + 4 * lane + 256 * j) + *(const LAS f32x4*)(lds + tt * 4112 + (4 * lane + 256 * j) * 4);
                ss += h[j].x * h[j].x + h[j].y * h[j].y + h[j].z * h[j].z + h[j].w * h[j].w; }
            const float rs = rsqrtf(wave_sum(ss) * (1.f / DM) + EPS);
#pragma unroll
            for (int j = 0; j < 4; ++j) *(f32x4*)(orow + 4 * lane + 256 * j) = h[j] * rs * *(const f32x4*)(fw + 4 * lane + 256 * j);
        }
    }
}


#define XB_TMO      128
#define XB_XCNT(j)  (256  + 64 * (j))
#define XB_XSUB(j)  (1280 + 64 * (j))
#define XB_XGEN(j)  (2304 + 64 * (j))
#define XB_TOP      3328
#define XB_TOPGEN   3392
#define XCD_BAR_WORDS 3456
#define XB_SPIN_CAP (1u << 18)
__device__ __forceinline__ unsigned xb_ld(unsigned* p)              { return __hip_atomic_load(p, __ATOMIC_RELAXED, __HIP_MEMORY_SCOPE_AGENT); }
__device__ __forceinline__ unsigned xb_add(unsigned* p, unsigned v) { return __hip_atomic_fetch_add(p, v, __ATOMIC_RELAXED, __HIP_MEMORY_SCOPE_AGENT); }
__device__ __forceinline__ unsigned xb_xcc_id() { return (unsigned)__builtin_amdgcn_s_getreg((3 << 11) | 20) & 0xFu; }
#define XB_SPIN(cond, bar) do { unsigned _sp = 0; while (cond) { __builtin_amdgcn_s_sleep(1); \
    if ((++_sp & 255u) == 0u) { if (xb_ld(&(bar)[XB_TMO])) break; if (_sp > XB_SPIN_CAP) { atomicAdd(&(bar)[XB_TMO], 1u); break; } } } } while (0)
struct XcdBarrier { unsigned* bar; unsigned x; volatile LAS unsigned* st; };
__device__ __forceinline__ XcdBarrier xcd_barrier_post(unsigned* bar, volatile LAS unsigned* st) {
    XcdBarrier b; b.bar = bar; b.x = xb_xcc_id(); b.st = st;
    if (threadIdx.x == 0) (void)xb_add(&bar[XB_XCNT(b.x)], 1u);
    return b;
}
__device__ __forceinline__ void xcd_barrier_complete(unsigned* bar, unsigned x, unsigned& nloc, unsigned& nx) {
    const unsigned G = gridDim.x * gridDim.y * gridDim.z;
    unsigned sum, cnt, mine, sp = 0u;
    for (;;) {
        sum = 0u; cnt = 0u; mine = 0u;
#pragma unroll
        for (unsigned j = 0; j < 16; ++j) { const unsigned c = xb_ld(&bar[XB_XCNT(j)]); sum += c; cnt += (c > 0u) ? 1u : 0u; mine = (j == x) ? c : mine; }
        if (sum == G) break;
        __builtin_amdgcn_s_sleep(1);
        if ((++sp & 255u) == 0u) { if (xb_ld(&bar[XB_TMO])) break; if (sp > XB_SPIN_CAP) { atomicAdd(&bar[XB_TMO], 1u); break; } }
    }
    nloc = mine > 0u ? mine : 1u; nx = cnt > 0u ? cnt : 1u;
}
__device__ __forceinline__ void xcd_barrier(const XcdBarrier& b) {
    asm volatile("s_waitcnt vmcnt(0)" ::: "memory");
    __syncthreads();
    if (threadIdx.x == 0) {
        unsigned* bar = b.bar;
        __builtin_amdgcn_s_waitcnt(0);
        unsigned nloc = b.st[0], nx = b.st[1];
        if (nloc == 0u) { xcd_barrier_complete(bar, b.x, nloc, nx); b.st[0] = nloc; b.st[1] = nx; }
        const unsigned old = xb_add(&bar[XB_XSUB(b.x)], 1u);
        const unsigned gen = old / nloc;
        if (old + 1u == (gen + 1u) * nloc) {
            __builtin_amdgcn_fence(__ATOMIC_RELEASE, "agent");
            asm volatile("s_waitcnt vmcnt(0)" ::: "memory");
            const unsigned og = xb_add(&bar[XB_TOP], 1u);
            const unsigned tg = og / nx;
            if (og + 1u == (tg + 1u) * nx) xb_add(&bar[XB_TOPGEN], 1u);
            else XB_SPIN(xb_ld(&bar[XB_TOPGEN]) == tg, bar);
            __builtin_amdgcn_fence(__ATOMIC_ACQUIRE, "agent");
            xb_add(&bar[XB_XGEN(b.x)], 1u);
            asm volatile("s_waitcnt vmcnt(0)" ::: "memory");
        } else {
            XB_SPIN(xb_ld(&bar[XB_XGEN(b.x)]) == gen, bar);
            __builtin_amdgcn_fence(__ATOMIC_ACQUIRE, "agent");
            asm volatile("s_waitcnt vmcnt(0)" ::: "memory");
        }
    }
    __syncthreads();
}

constexpr int NPHASE = 9;
__global__ void __launch_bounds__(NTHR, 2) mega(Params p) {
    extern __shared__ __attribute__((aligned(16))) unsigned char lds[];
    cg::grid_group grid = cg::this_grid();
#define PH_ON(k) (p.ph_lo <= (k) && (k) < p.ph_hi)
    if (threadIdx.x < 2) ((LAS unsigned*)((LAS unsigned char*)lds + LDS_BYTES - 32))[threadIdx.x] = 0u;
    __syncthreads();
    const XcdBarrier xbar = xcd_barrier_post((unsigned*)(p.ws + OFF_CTL) + 8192, (volatile LAS unsigned*)((LAS unsigned char*)lds + LDS_BYTES - 32));
#define PH_SYNC(k) do { if (PH_ON(k) && PH_ON((k) + 1)) { xcd_barrier(xbar); } } while (0)
    if (PH_ON(0)) phase0(p, lds);
    PH_SYNC(0);
    if (PH_ON(1)) phase1_mfma(p, (LAS unsigned char*)lds);
#if PROBE_DUP == 1
    grid.sync(); phase1_mfma(p, (LAS unsigned char*)lds);
#endif
    PH_SYNC(1);
    if (PH_ON(2)) phase2(p, (LAS unsigned char*)lds);
#if PROBE_DUP == 2
    grid.sync(); phase2(p, (LAS unsigned char*)lds, 1);
#endif
#if PROBE_DUP == 21
    grid.sync(); phase2(p, (LAS unsigned char*)lds, 2);
#endif
#if PROBE_DUP == 22
    grid.sync(); phase2(p, (LAS unsigned char*)lds, 3);
#endif
    PH_SYNC(2);
    if (PH_ON(3)) phase2c(p);
    PH_SYNC(3);
    if (PH_ON(4)) phase3_mfma(p, (LAS unsigned char*)lds);
#if PROBE_DUP == 4
    grid.sync(); phase3_mfma(p, (LAS unsigned char*)lds);
#endif
    PH_SYNC(4);
    if (PH_ON(5)) { phase4_mfma(p, (LAS unsigned char*)lds); quantize_hn(p); }
#if PROBE_DUP == 5
    grid.sync(); phase4_mfma(p, (LAS unsigned char*)lds);
#endif
    PH_SYNC(5);
    if (PH_ON(6)) phase5a(p, (LAS unsigned char*)lds);
#if PROBE_DUP == 6
    grid.sync(); phase5a(p, (LAS unsigned char*)lds, 1024);
#endif
    PH_SYNC(6);
    if (PH_ON(7)) phase5b(p, (LAS unsigned char*)lds);
#if PROBE_DUP == 7
    grid.sync(); phase5b(p, (LAS unsigned char*)lds);
#endif
    PH_SYNC(7);
    if (PH_ON(8)) phase5c(p, (LAS unsigned char*)lds);
}

extern "C" void kernel_launch(void* const* d_in, const int* in_sizes, int n_in, void* d_out, int out_size, void* d_ws, size_t ws_size, hipStream_t stream) {
    static int grid = 0;
    if (grid == 0) {
        if (n_in != 21 || out_size != NTOK * DM || ws_size < WS_END) { fprintf(stderr, "kernel_launch: unexpected shapes (n_in %d out %d ws %zu)\n", n_in, out_size, ws_size); grid = -1; return; }
        int dev = 0, cus = 0, per_cu = 0;
        hipGetDevice(&dev);
        hipDeviceGetAttribute(&cus, hipDeviceAttributeMultiprocessorCount, dev);
        hipFuncSetAttribute((const void*)mega, hipFuncAttributeMaxDynamicSharedMemorySize, LDS_BYTES);
        hipOccupancyMaxActiveBlocksPerMultiprocessor(&per_cu, (const void*)mega, NTHR, LDS_BYTES);
        if (per_cu < 1) { fprintf(stderr, "kernel_launch: occupancy query says %d blocks/CU\n", per_cu); per_cu = 1; }
        grid = cus * 1;
        (void)hipGetLastError();
    }
    if (grid < 0) return;
    hipMemsetAsync((char*)d_ws + OFF_CTL, 0, CTL_BYTES, stream);
    Params p{};
    for (int i = 0; i < 21; ++i) p.in[i] = (const float*)d_in[i];
    p.out = (float*)d_out; p.ws = (unsigned char*)d_ws; p.ph_lo = 0; p.ph_hi = NPHASE;
    void* args[] = {&p};
    hipError_t e = hipLaunchCooperativeKernel((const void*)mega, dim3(grid), dim3(NTHR), args, LDS_BYTES, stream);
    if (e != hipSuccess) fprintf(stderr, "cooperative launch failed: %s (grid %d)\n", hipGetErrorString(e), grid);
}
```

```cpp
#include <hip/hip_runtime.h>
#include <hip/hip_cooperative_groups.h>
#include <cstdio>
#include <cstdint>
namespace cg = cooperative_groups;

constexpr int DM = 1024;
constexpr int NB = 8, SEQ = 2048, NMETA = 16;
constexpr int NTOK = NB * SEQ;
constexpr int MROWS = 16640;
constexpr int NIN = 3584;
constexpr int TPOS = NMETA + SEQ;
constexpr float EPS = 1e-6f;
constexpr float QSCALE = 0.125f * 1.4426950408889634f;
constexpr int NEXP = 16384;
constexpr int NTHR = 512;
#ifndef PROBE_DUP
#define PROBE_DUP 0
#endif

constexpr size_t MiB = 1u << 20;
constexpr size_t OFF_CTL = 0, CTL_BYTES = 64 * 1024;
constexpr size_t OFF_MISC = 512 * 1024;
constexpr size_t OFF_ROPE = 1 * MiB;
constexpr size_t OFF_WOUT = 2 * MiB;
constexpr size_t OFF_WQ = 4 * MiB;
constexpr size_t OFF_KEYS = 8 * MiB;
constexpr size_t OFF_SSQP = 25 * MiB;
constexpr size_t OFF_UB = 9 * MiB;
constexpr size_t OFF_VB = 41 * MiB;
constexpr size_t OFF_XN = 73 * MiB;
constexpr size_t OFF_MIX = 73 * MiB;
constexpr size_t OFF_WIN = 106 * MiB;
constexpr size_t OFF_QB = 113 * MiB;
constexpr size_t OFF_KB = OFF_QB + 16 * MiB + 256 * 1024;
constexpr size_t OFF_VT = OFF_KB + 16 * MiB + 256 * 1024;
constexpr size_t OFF_H2B = 113 * MiB;
constexpr size_t OFF_GQ = 162 * MiB;
constexpr size_t OFF_GK = OFF_GQ + 8 * MiB + 256 * 1024;
constexpr size_t OFF_GVT = OFF_GK + 8 * MiB + 256 * 1024;
constexpr size_t OFF_GF = OFF_GVT + 16 * MiB + 256 * 1024;
constexpr size_t OFF_GB = OFF_GF + 16 * MiB + 256 * 1024;
constexpr size_t OFF_GR = OFF_GB + 16 * MiB + 256 * 1024;
constexpr size_t OFF_PW0 = 162 * MiB;
constexpr size_t OFF_USC = 64 * 1024;
constexpr size_t OFF_VSC = 128 * 1024;
constexpr size_t WS_END = OFF_GR + 16 * MiB + 256 * 1024;
static_assert(WS_END <= 256 * MiB, "workspace map");
static_assert(OFF_VT + (size_t)512 * MROWS * 2 <= OFF_GQ, "map D");
static_assert(OFF_WIN + (size_t)NIN * DM * 2 <= OFF_QB, "map C");

constexpr int LDS_BYTES = 163840;

typedef unsigned short bf16_t;
typedef float f32x4 __attribute__((ext_vector_type(4)));
typedef float f32x2 __attribute__((ext_vector_type(2)));
typedef unsigned u32x4 __attribute__((ext_vector_type(4)));
typedef unsigned u32x2 __attribute__((ext_vector_type(2)));
typedef __bf16 bf16x2_t __attribute__((ext_vector_type(2)));

struct Params {
    const float* in[21];
    float* out;
    unsigned char* ws;
    int ph_lo, ph_hi;
};

__device__ __forceinline__ unsigned f2bf(float f) { unsigned u = __float_as_uint(f); return (u + 0x7fffu + ((u >> 16) & 1u)) >> 16; }
__device__ __forceinline__ float bf2f(unsigned h) { return __uint_as_float(h << 16); }
__device__ __forceinline__ unsigned pk2(float lo, float hi) { return __builtin_bit_cast(unsigned, __builtin_convertvector((f32x2){lo, hi}, bf16x2_t)); }
__device__ __forceinline__ float bflo(unsigned w) { return __uint_as_float(w << 16); }
__device__ __forceinline__ float bfhi(unsigned w) { return __uint_as_float(w & 0xffff0000u); }
__device__ __forceinline__ float dot2(unsigned a, unsigned b, float c) {
    return __builtin_amdgcn_fdot2_f32_bf16(__builtin_bit_cast(bf16x2_t, a), __builtin_bit_cast(bf16x2_t, b), c, false);
}
__device__ __forceinline__ float dot8(u32x4 a, u32x4 b, float c) { c = dot2(a.x, b.x, c); c = dot2(a.y, b.y, c); c = dot2(a.z, b.z, c); return dot2(a.w, b.w, c); }
__device__ __forceinline__ float wave_sum(float v) {
#pragma unroll
    for (int o = 1; o < 64; o <<= 1) v += __shfl_xor(v, o);
    return v;
}
__device__ __forceinline__ float wave_max(float v) {
#pragma unroll
    for (int o = 1; o < 64; o <<= 1) v = fmaxf(v, __shfl_xor(v, o));
    return v;
}
__device__ __forceinline__ float silu_f(float x) { return x / (1.f + __expf(-x)); }
__device__ __forceinline__ float logsig_f(float x) { return fminf(x, 0.f) - log1pf(__expf(-fabsf(x))); }
__device__ __forceinline__ float gelu_f(float v) {
    const float av = fabsf(v), t = __builtin_amdgcn_rcpf(av * 0.2316418882f + 1.0f);
    float q = t * 0.5307027145f + (-0.7265760135f); q = q * t + 0.7107068705f; q = q * t + (-0.142248368f); q = q * t + 0.127414796f; q = q * t;
    const float m = v * (q * __builtin_amdgcn_exp2f(v * v * (-0.72134752044f)));
    return v < 0.f ? m : v - m;
}

__device__ __forceinline__ float win_src(const Params& p, int k, int n) {
    const float* W = p.in[3] + (size_t)k * 3104;
    if (n < 1024) {
        const int base = n & ~63, dp = n & 63, d = dp < 16 ? ((dp >> 1) + 8 * (dp & 1)) : dp;
        return W[base + d];
    } else if (n < 3072) return W[n];
    const int j = (n - 3072) & 255, dir = (n - 3072) >> 8;
    const float* w2 = p.in[dir ? 11 : 9];
    const float* wz = W + 3072 + dir * 16;
    float s = 0.f;
#pragma unroll
    for (int r = 0; r < 16; ++r) s += wz[r] * w2[r * 256 + j];
    return s;
}

template <int WHICH>
__device__ __forceinline__ void p0_transpose_item(const Params& p, float* scr, int item, int lane) {
    constexpr int N = WHICH == 0 ? NIN : (WHICH == 1 ? 1024 : 2048);
    constexpr int nblk = N / 32;
    const int kb = item / nblk, nb = item % nblk, k0 = 64 * kb, n0 = 32 * nb;
    bf16_t* WT = (bf16_t*)(p.ws + (WHICH == 0 ? OFF_WIN : (WHICH == 1 ? OFF_WOUT : OFF_WQ)));
#pragma unroll 4
    for (int i = 0; i < 32; ++i) {
        const int kk = 2 * i + (lane >> 5), k = k0 + kk, n = n0 + (lane & 31);
        float v;
        if (WHICH == 0) v = win_src(p, k, n);
        else if (WHICH == 1) v = p.in[14][(size_t)k * 1024 + n];
        else v = p.in[16][(size_t)k * 2048 + n] * p.in[15][k];
        scr[kk * 33 + (lane & 31)] = v;
    }
    __builtin_amdgcn_s_waitcnt(0xC07F); __builtin_amdgcn_wave_barrier();
    const int c = lane & 7;
#pragma unroll
    for (int j = 0; j < 4; ++j) {
        const int n = (lane >> 3) + 8 * j; const float* s = scr + (8 * c) * 33 + n;
        u32x4 o; o.x = pk2(s[0 * 33], s[1 * 33]); o.y = pk2(s[2 * 33], s[3 * 33]); o.z = pk2(s[4 * 33], s[5 * 33]); o.w = pk2(s[6 * 33], s[7 * 33]);
        *(u32x4*)(WT + (size_t)(n0 + n) * 1024 + k0 + 8 * c) = o;
    }
    __builtin_amdgcn_s_waitcnt(0xC07F); __builtin_amdgcn_wave_barrier();
}

__device__ __forceinline__ void phase0(const Params& p, unsigned char* lds) {
    const int tid = threadIdx.x, lane = tid & 63, wave = tid >> 6;
    const int gw = blockIdx.x * 8 + wave, NGW = gridDim.x * 8;
    const long gt = (long)blockIdx.x * NTHR + tid, NGT = (long)gridDim.x * NTHR;
    {
        const f32x4* lw = (const f32x4*)p.in[2];
        bf16_t* XN = (bf16_t*)(p.ws + OFF_XN);
        for (int r = gw; r < MROWS; r += NGW) {
            const float* src = r < NTOK ? p.in[0] + (size_t)r * DM : (r < NTOK + NMETA ? p.in[1] + (size_t)(r - NTOK) * DM : nullptr);
            f32x4 v[4]; float s = 0.f;
#pragma unroll
            for (int j = 0; j < 4; ++j) { v[j] = src ? ((const f32x4*)src)[lane + 64 * j] : (f32x4){0.f, 0.f, 0.f, 0.f}; s += v[j].x * v[j].x + v[j].y * v[j].y + v[j].z * v[j].z + v[j].w * v[j].w; }
            const float rs = rsqrtf(wave_sum(s) * (1.f / DM) + EPS);
#pragma unroll
            for (int j = 0; j < 4; ++j) { const f32x4 w = lw[lane + 64 * j]; u32x2 o; o.x = pk2(v[j].x * rs * w.x, v[j].y * rs * w.y); o.y = pk2(v[j].z * rs * w.z, v[j].w * rs * w.w);
                *(u32x2*)(XN + (size_t)r * DM + 4 * (lane + 64 * j)) = o; }
        }
    }
    {
        float* scr = (float*)lds + wave * (64 * 33);
        constexpr int I0 = 16 * (NIN / 32);
        for (int it = gw; it < I0; it += NGW) p0_transpose_item<0>(p, scr, it, lane);
    }
    {
        f32x2* rope = (f32x2*)(p.ws + OFF_ROPE);
        for (long i = gt; i < TPOS * 8; i += NGT) {
            const int t = (int)(i >> 3), j = (int)(i & 7);
            const float inv = powf(500000.0f, -(float)j * 0.125f);
            const float ang = (float)t * inv;
            rope[i] = (f32x2){cosf(ang), sinf(ang)};
        }
        if (gt == 0) {
            float a = 0.f, b = 0.f;
            for (int i = 0; i < 64; ++i) { a += p.in[4][i] * p.in[5][i]; b += p.in[6][i] * p.in[7][i]; }
            ((float*)(p.ws + OFF_MISC))[0] = expf(a) - expf(b) + 0.2f;
        }
    }
}
constexpr int CV_WOUT = 64, CV_WQ = 128, CV_KEYS = 8, CV_U = 256, CV_V = 256, CV_ITEMS = CV_WOUT + CV_WQ + CV_KEYS + CV_U + CV_V;
__device__ __forceinline__ void conv_item(const Params& p, unsigned char* lds, int c) {
    const int tid = threadIdx.x, lane = tid & 63, wave = tid >> 6;
    __syncthreads();
    if (c < CV_WOUT) { p0_transpose_item<1>(p, (float*)lds + wave * (64 * 33), c * 8 + wave, lane); return; }
    c -= CV_WOUT;
    if (c < CV_WQ) { p0_transpose_item<2>(p, (float*)lds + wave * (64 * 33), c * 8 + wave, lane); return; }
    c -= CV_WQ;
    if (c < CV_KEYS) {
        bf16_t* KEYS = (bf16_t*)(p.ws + OFF_KEYS);
#pragma unroll 2
        for (int j = 0; j < 8; ++j) {
            const long e = ((long)c * 4096 + tid + NTHR * j) * 8;
            const f32x4 a = *(const f32x4*)(p.in[17] + e), b = *(const f32x4*)(p.in[17] + e + 4);
            u32x4 o; o.x = pk2(a.x, a.y); o.y = pk2(a.z, a.w); o.z = pk2(b.x, b.y); o.w = pk2(b.z, b.w);
            *(u32x4*)(KEYS + e) = o;
        }
        return;
    }
    c -= CV_KEYS;
    if (c < CV_U) {
        unsigned char* UQ = p.ws + OFF_UB; float* USC = (float*)(p.ws + OFF_USC);
#pragma unroll 2
        for (int i = 0; i < 8; ++i) {
            const int r = c * 64 + wave * 8 + i;
            const float* ur = p.in[18] + (size_t)r * DM + 16 * lane; const float* lw = p.in[15] + 16 * lane;
            f32x4 v[4]; float am = 0.f;
#pragma unroll
            for (int j = 0; j < 4; ++j) { v[j] = ((const f32x4*)ur)[j] * ((const f32x4*)lw)[j]; am = fmaxf(am, fmaxf(fmaxf(fabsf(v[j].x), fabsf(v[j].y)), fmaxf(fabsf(v[j].z), fabsf(v[j].w)))); }
            am = fmaxf(wave_max(am), 1e-30f);
            const float sc = 224.f / am;
            u32x4 o;
#pragma unroll
            for (int j = 0; j < 4; ++j) { int w = __builtin_amdgcn_cvt_pk_fp8_f32(v[j].x * sc, v[j].y * sc, 0, false); w = __builtin_amdgcn_cvt_pk_fp8_f32(v[j].z * sc, v[j].w * sc, w, true); o[j] = (unsigned)w; }
            *(u32x4*)(UQ + (size_t)r * DM + 16 * lane) = o;
            if (lane == 0) USC[r] = am * (1.f / 224.f);
        }
        return;
    }
    c -= CV_U;
    {
        unsigned char* VS = p.ws + OFF_VB; float* VSC = (float*)(p.ws + OFF_VSC);
        const int tile = c;
#pragma unroll 2
        for (int i = 0; i < 8; ++i) {
            const int er = wave * 8 + i, r = tile * 64 + er;
            const float* vr = p.in[19] + (size_t)r * DM + 16 * lane;
            f32x4 v[4]; float am = 0.f;
#pragma unroll
            for (int j = 0; j < 4; ++j) { v[j] = ((const f32x4*)vr)[j]; am = fmaxf(am, fmaxf(fmaxf(fabsf(v[j].x), fabsf(v[j].y)), fmaxf(fabsf(v[j].z), fabsf(v[j].w)))); }
            am = fmaxf(wave_max(am), 1e-30f);
            const float sc = 224.f / am;
            u32x4 o;
#pragma unroll
            for (int j = 0; j < 4; ++j) { int w = __builtin_amdgcn_cvt_pk_fp8_f32(v[j].x * sc, v[j].y * sc, 0, false); w = __builtin_amdgcn_cvt_pk_fp8_f32(v[j].z * sc, v[j].w * sc, w, true); o[j] = (unsigned)w; }
            *(u32x2*)(lds + er * 1032 + 16 * lane) = (u32x2){o.x, o.y}; *(u32x2*)(lds + er * 1032 + 16 * lane + 8) = (u32x2){o.z, o.w};
            if (lane == 0) VSC[r] = am * (1.f / 224.f);
        }
        __syncthreads();
#pragma unroll 4
        for (int i = 0; i < 16; ++i) {
            const int s = wave + 8 * i;
            *(u32x2*)(VS + ((size_t)s * NEXP + tile * 64 + lane) * 8) = *(const u32x2*)(lds + lane * 1032 + s * 8);
        }
    }
}

struct P1Ptrs { unsigned char* ws; const float* bias_f; const float* bias_b; };
__device__ __forceinline__ void p1_store(const P1Ptrs p, int row, int n0, float v0, float v1, float v2, float v3) {
    if (n0 < 1024) {
        const int dp = n0 & 63;
        if (dp < 16) {
            const int pos = row < NTOK ? NMETA + (row & (SEQ - 1)) : (row - NTOK);
            const f32x4 cs = *(const f32x4*)((const float*)(p.ws + OFF_ROPE) + ((size_t)pos * 8 + (dp >> 1)) * 2);
            const float a0 = v0 * cs.x - v1 * cs.y, b0 = v1 * cs.x + v0 * cs.y;
            const float a1 = v2 * cs.z - v3 * cs.w, b1 = v3 * cs.z + v2 * cs.w;
            v0 = a0; v1 = b0; v2 = a1; v3 = b1;
        }
        if (n0 < 512) { u32x2 o; o.x = pk2(v0 * QSCALE, v1 * QSCALE); o.y = pk2(v2 * QSCALE, v3 * QSCALE); *(u32x2*)((bf16_t*)(p.ws + OFF_QB) + (size_t)row * 512 + n0) = o; }
        else { u32x2 o; o.x = pk2(v0, v1); o.y = pk2(v2, v3); *(u32x2*)((bf16_t*)(p.ws + OFF_KB) + (size_t)row * 512 + (n0 - 512)) = o; }
    } else if (n0 < 1536) {
        bf16_t* VT = (bf16_t*)(p.ws + OFF_VT) + (size_t)(n0 - 1024) * MROWS + row;
        VT[0] = (bf16_t)f2bf(v0); VT[MROWS] = (bf16_t)f2bf(v1); VT[2 * MROWS] = (bf16_t)f2bf(v2); VT[3 * (size_t)MROWS] = (bf16_t)f2bf(v3);
    } else if (n0 < 1792) {
        u32x2 o; o.x = pk2(v0 * 0.125f, v1 * 0.125f); o.y = pk2(v2 * 0.125f, v3 * 0.125f); *(u32x2*)((bf16_t*)(p.ws + OFF_GQ) + (size_t)row * 256 + (n0 - 1536)) = o;
    } else if (n0 < 2048) {
        u32x2 o; o.x = pk2(v0, v1); o.y = pk2(v2, v3); *(u32x2*)((bf16_t*)(p.ws + OFF_GK) + (size_t)row * 256 + (n0 - 1792)) = o;
    } else if (n0 < 2560) {
        bf16_t* VT = (bf16_t*)(p.ws + OFF_GVT) + (size_t)(n0 - 2048) * MROWS + row;
        VT[0] = (bf16_t)f2bf(v0); VT[MROWS] = (bf16_t)f2bf(v1); VT[2 * MROWS] = (bf16_t)f2bf(v2); VT[3 * (size_t)MROWS] = (bf16_t)f2bf(v3);
    } else if (n0 < 3072) {
        u32x2 o; o.x = pk2(silu_f(v0), silu_f(v1)); o.y = pk2(silu_f(v2), silu_f(v3)); *(u32x2*)((bf16_t*)(p.ws + OFF_GR) + (size_t)row * 512 + (n0 - 2560)) = o;
    } else {
        const int dir = (n0 - 3072) >> 8, j = (n0 - 3072) & 255;
        const f32x4 bb = *(const f32x4*)((dir ? p.bias_b : p.bias_f) + j);
        f32x4 o; o.x = logsig_f(v0 + bb.x) * 0.0625f; o.y = logsig_f(v1 + bb.y) * 0.0625f; o.z = logsig_f(v2 + bb.z) * 0.0625f; o.w = logsig_f(v3 + bb.w) * 0.0625f;
        *(f32x4*)((float*)(p.ws + (dir ? OFF_GB : OFF_GF)) + (size_t)row * 256 + j) = o;
    }
}


#define LAS __attribute__((address_space(3)))
typedef short bf16x8 __attribute__((ext_vector_type(8)));
constexpr int GBUF = 49152;

template <int ROWS>
__device__ __forceinline__ void stage_tile(const bf16_t* G, int ldk, int r0, int k0, LAS unsigned char* buf, int wave, int lane) {
    const int rr = lane >> 3, c = (lane & 7) ^ rr;
#pragma unroll
    for (int i = 0; i < ROWS / 64; ++i) {
        const int grp = wave + 8 * i;
        const bf16_t* src = G + (size_t)(r0 + grp * 8 + rr) * ldk + k0 + c * 8;
        __builtin_amdgcn_global_load_lds((const unsigned*)src, (LAS unsigned*)(buf + grp * 1024), 16, 0, 0);
    }
}
__device__ __forceinline__ bf16x8 ldfrag(const LAS unsigned char* buf, int row, int c) {
    return *(const LAS bf16x8*)(buf + row * 128 + ((c ^ (row & 7)) << 4));
}
template <bool SWAP>
__device__ __forceinline__ void gemm_tile_256(const bf16_t* A, const bf16_t* Bt, int K, int m0, int n0, LAS unsigned char* lds, f32x4 (&acc)[4][4]) {
    const int tid = threadIdx.x, lane = tid & 63, wave = __builtin_amdgcn_readfirstlane(tid >> 6), wm = wave >> 2, wn = wave & 3, l15 = lane & 15, g = lane >> 4;
#pragma unroll
    for (int i = 0; i < 4; ++i)
#pragma unroll
        for (int j = 0; j < 4; ++j) acc[i][j] = (f32x4){0.f, 0.f, 0.f, 0.f};
    const int nk = K / 64;
    stage_tile<128>(A, K, m0, 0, lds, wave, lane);
    stage_tile<256>(Bt, K, n0, 0, lds + 16384, wave, lane);
    for (int kt = 0; kt < nk; ++kt) {
        asm volatile("s_waitcnt vmcnt(0)" ::: "memory");
        __syncthreads();
        if (kt + 1 < nk) {
            LAS unsigned char* nb = lds + ((kt + 1) & 1) * GBUF;
            stage_tile<128>(A, K, m0, (kt + 1) * 64, nb, wave, lane);
            stage_tile<256>(Bt, K, n0, (kt + 1) * 64, nb + 16384, wave, lane);
        }
        const LAS unsigned char* a = lds + (kt & 1) * GBUF; const LAS unsigned char* b = a + 16384;
#pragma unroll
        for (int ks = 0; ks < 2; ++ks) {
            bf16x8 af[4], bfr[4];
#pragma unroll
            for (int i = 0; i < 4; ++i) { af[i] = ldfrag(a, wm * 64 + i * 16 + l15, ks * 4 + g); bfr[i] = ldfrag(b, wn * 64 + i * 16 + l15, ks * 4 + g); }
#pragma unroll
            for (int i = 0; i < 4; ++i)
#pragma unroll
                for (int j = 0; j < 4; ++j)
                    acc[i][j] = SWAP ? __builtin_amdgcn_mfma_f32_16x16x32_bf16(af[i], bfr[j], acc[i][j], 0, 0, 0)
                                     : __builtin_amdgcn_mfma_f32_16x16x32_bf16(bfr[j], af[i], acc[i][j], 0, 0, 0);
        }
    }
}
__device__ __forceinline__ int vcu_of_block() { const int G = gridDim.x, bx = blockIdx.x; return (G % 8 == 0) ? (bx % 8) * (G / 8) + bx / 8 : bx; }

namespace pg8 {
#define PG8_LAS __attribute__((address_space(3)))
typedef unsigned short bf16_t;
typedef short bf16x8 __attribute__((ext_vector_type(8)));
typedef float f32x4 __attribute__((ext_vector_type(4)));
typedef unsigned u32x4 __attribute__((ext_vector_type(4)));
constexpr int BM = 256, BK = 64, HALF = 128, HTB = HALF * BK * 2  , STAGE_BYTES = 8 * HTB, NXCD = 8, WGM = 8;

__host__ __device__ __forceinline__ int lds_byte(int r, int c) { const int st = (r >> 4) * 2 + (c >> 5), rr = r & 15, cc = c & 31, ob = rr * 64 + cc * 2; return st * 1024 + (ob ^ (((ob >> 9) & 1) << 5)); }
__host__ __device__ __forceinline__ void stage_rc(int b, int& R, int& C) { const int st = b / 1024, sb = b % 1024, swz = sb ^ (((sb >> 9) & 1) << 5); R = (st >> 1) * 16 + swz / 64; C = (st & 1) * 32 + (swz % 64) / 2; }
__host__ __device__ __forceinline__ int perm32(int rho) { const int n = rho >> 4, i = rho & 15; return 8 * (i >> 2) + 4 * n + (i & 3); }

struct Unit { int pm, pn; };
struct Gemm { const bf16_t* A; const bf16_t* Bt; int M, N, K; };

struct StaticOrder {
    int nM, nN, nwg, G, c;
    __host__ __device__ void init(int M, int N, int G_, int c_) { nM = M / BM; nN = N / BM; nwg = nM * nN; G = G_; c = c_; }
    __host__ __device__ bool next(int i, Unit& u) const {
        const long L = (long)i * G + c; if (L >= nwg) return false;
        int wgid = (int)L; { const int q = nwg / NXCD, r = nwg % NXCD, xcd = wgid % NXCD, off = wgid / NXCD; wgid = (xcd < r ? xcd * (q + 1) : r * (q + 1) + (xcd - r) * q) + off; }
        const int nig = WGM * nN, gid = wgid / nig, fm = gid * WGM, gsz = (nM - fm) < WGM ? (nM - fm) : WGM;
        u.pm = fm + ((wgid % nig) % gsz); u.pn = (wgid % nig) / gsz; return true;
    }
    __device__ __forceinline__ void a_ready(const Unit&) const {}
    __device__ __forceinline__ void done(const Unit&) const {}
};

struct EpiP1 {
    static constexpr bool PERM = false, AFTER_DRAIN = false;
    P1Ptrs p;
    __device__ __forceinline__ void operator()(const f32x4 (&acc)[2][2][4][2], const Unit& u, int wr, int wc, int fr, int fq) const {
#pragma unroll
        for (int bj = 0; bj < 2; ++bj) {
            const int nw = u.pn * BM + bj * HALF + wc * 32;
            const int rowb = u.pm * BM + wr * 64 + fr;
            if (nw >= 3072) {
                const int dir = (nw - 3072) >> 8, j0 = ((nw - 3072) & 255) + 4 * fq;
                float* G = (float*)(p.ws + (dir ? OFF_GB : OFF_GF)); const float* bias = dir ? p.bias_b : p.bias_f;
#pragma unroll
                for (int n = 0; n < 2; ++n) { const f32x4 bb = *(const f32x4*)(bias + j0 + 16 * n);
#pragma unroll
                    for (int ai = 0; ai < 2; ++ai)
#pragma unroll
                        for (int m = 0; m < 4; ++m) { const f32x4 v = acc[ai][bj][m][n]; f32x4 o;
                            o.x = logsig_f(v.x + bb.x) * 0.0625f; o.y = logsig_f(v.y + bb.y) * 0.0625f; o.z = logsig_f(v.z + bb.z) * 0.0625f; o.w = logsig_f(v.w + bb.w) * 0.0625f;
                            *(f32x4*)(G + (size_t)(rowb + ai * HALF + m * 16) * 256 + j0 + 16 * n) = o; } }
            } else if ((nw >= 1024 && nw < 1536) || (nw >= 2048 && nw < 2560)) {
                bf16_t* T = (bf16_t*)(p.ws + (nw < 1536 ? OFF_VT : OFF_GVT)) + (size_t)((nw < 1536 ? nw - 1024 : nw - 2048) + 4 * fq) * MROWS + rowb;
#pragma unroll
                for (int n = 0; n < 2; ++n)
#pragma unroll
                    for (int ai = 0; ai < 2; ++ai)
#pragma unroll
                        for (int m = 0; m < 4; ++m) { const f32x4 v = acc[ai][bj][m][n]; bf16_t* t = T + (size_t)(16 * n) * MROWS + ai * HALF + m * 16;
                            t[0] = (bf16_t)f2bf(v.x); t[MROWS] = (bf16_t)f2bf(v.y); t[2 * MROWS] = (bf16_t)f2bf(v.z); t[3 * (size_t)MROWS] = (bf16_t)f2bf(v.w); }
            } else {
                bf16_t* base; int ld, c0; float sc = 1.f; bool silu = false;
                if (nw < 512) { base = (bf16_t*)(p.ws + OFF_QB); ld = 512; c0 = nw; sc = QSCALE; }
                else if (nw < 1024) { base = (bf16_t*)(p.ws + OFF_KB); ld = 512; c0 = nw - 512; }
                else if (nw < 1792) { base = (bf16_t*)(p.ws + OFF_GQ); ld = 256; c0 = nw - 1536; sc = 0.125f; }
                else if (nw < 2048) { base = (bf16_t*)(p.ws + OFF_GK); ld = 256; c0 = nw - 1792; }
                else { base = (bf16_t*)(p.ws + OFF_GR); ld = 512; c0 = nw - 2560; silu = true; }
                const bool rope = nw < 1024 && (nw & 63) == 0;
#pragma unroll
                for (int ai = 0; ai < 2; ++ai)
#pragma unroll
                    for (int m = 0; m < 4; ++m) {
                        const int row = rowb + ai * HALF + m * 16;
#pragma unroll
                        for (int n = 0; n < 2; ++n) {
                            f32x4 v = acc[ai][bj][m][n];
                            if (n == 0 && rope) {
                                const int pos = row < NTOK ? NMETA + (row & (SEQ - 1)) : (row - NTOK < TPOS ? row - NTOK : 0);
                                const f32x4 cs = *(const f32x4*)((const float*)(p.ws + OFF_ROPE) + ((size_t)pos * 8 + 2 * fq) * 2);
                                const float a0 = v.x * cs.x - v.y * cs.y, b0 = v.y * cs.x + v.x * cs.y, a1 = v.z * cs.z - v.w * cs.w, b1 = v.w * cs.z + v.z * cs.w;
                                v = (f32x4){a0, b0, a1, b1};
                            }
                            if (silu) v = (f32x4){silu_f(v.x), silu_f(v.y), silu_f(v.z), silu_f(v.w)}; else v = v * sc;
                            *(u32x2*)(base + (size_t)row * ld + c0 + 16 * n + 4 * fq) = (u32x2){pk2(v.x, v.y), pk2(v.z, v.w)};
                        }
                    }
            }
        }
    }
};
struct EpiP3 {
    static constexpr bool PERM = false, AFTER_DRAIN = false;
    const float* x; float* out; bf16_t* h2b; float* ssq;
    __device__ __forceinline__ void operator()(const f32x4 (&acc)[2][2][4][2], const Unit& u, int wr, int wc, int fr, int fq) const {
#pragma unroll
        for (int ai = 0; ai < 2; ++ai)
#pragma unroll
            for (int m = 0; m < 4; ++m) { const int row = u.pm * BM + ai * HALF + wr * 64 + m * 16 + fr; float ss = 0.f;
#pragma unroll
                for (int bj = 0; bj < 2; ++bj)
#pragma unroll
                    for (int n = 0; n < 2; ++n) { const int col = u.pn * BM + bj * HALF + wc * 32 + n * 16 + 4 * fq;
                        const f32x4 hv = *(const f32x4*)(x + (size_t)row * DM + col) + acc[ai][bj][m][n];
                        *(f32x4*)(out + (size_t)row * DM + col) = hv;
                        *(u32x2*)(h2b + (size_t)row * DM + col) = (u32x2){pk2(hv.x, hv.y), pk2(hv.z, hv.w)};
                        ss += hv.x * hv.x + hv.y * hv.y + hv.z * hv.z + hv.w * hv.w; }
                ss += __shfl_xor(ss, 16); ss += __shfl_xor(ss, 32);
                if (fq == 0) ssq[(size_t)row * 16 + u.pn * 4 + wc] = ss; }
    }
};
struct OneUnit {
    Unit u; bool valid;
    __device__ __forceinline__ bool next(int i, Unit& o) const { if (i != 0 || !valid) return false; o = u; return true; }
    __device__ __forceinline__ void a_ready(const Unit&) const {}
    __device__ __forceinline__ void done(const Unit&) const {}
};

template <class Epi, class Sched, bool ALIGN_EPI = false, bool SP2 = false>
__device__ __forceinline__ void gemm_phase(PG8_LAS unsigned char* lds, const Gemm g, const Sched& S, const Epi& E) {
    int tid_ = threadIdx.x; asm volatile("" : "+v"(tid_));
    const int tid = tid_, wid = __builtin_amdgcn_readfirstlane(tid >> 6), lane = tid & 63, wr = wid >> 2, wc = wid & 3, fr = lane & 15, fq = lane >> 4;
    const int K = g.K, nt = K / BK;
    unsigned voffA[2], voffB[2];
#pragma unroll
    for (int i = 0; i < 2; ++i) { int R, C; stage_rc(tid * 16 + i * 8192, R, C); const int Rb = Epi::PERM ? ((R & ~31) + perm32(R & 31)) : R;
        voffA[i] = (unsigned)(R * K + C) * 2u; voffB[i] = (unsigned)(Rb * K + C) * 2u; }
    const size_t kstep = (size_t)(BK * 2);
    const size_t hstep = (size_t)HALF * K * 2;
    const size_t tstep = 2 * hstep;
    const unsigned ldsw = (unsigned)wid * 1024u;
    const int aoff = lds_byte(wr * 64 + fr, fq * 8), boff = lds_byte(wc * 32 + fr, fq * 8);
#define PG8_SA(b, h) (((b) * 2 + (h)) * HTB)
#define PG8_SB(b, h) ((4 + (b) * 2 + (h)) * HTB)
#define PG8_STAGE(bufoff, gbase, voff) do { _Pragma("unroll") for (int _i = 0; _i < 2; ++_i) \
        __builtin_amdgcn_global_load_lds((const unsigned*)((const char*)(gbase) + (voff)[_i]), (PG8_LAS unsigned*)(lds + (bufoff) + ldsw + _i * 8192), 16, 0, 0); } while (0)
#define PG8_LDA(dst, b, h) do { _Pragma("unroll") for (int m = 0; m < 4; ++m) _Pragma("unroll") for (int k = 0; k < 2; ++k) dst[m][k] = *(const PG8_LAS bf16x8*)(lds + PG8_SA(b, h) + aoff + m * 2048 + k * 1024); } while (0)
#define PG8_LDB(dst, b, h) do { _Pragma("unroll") for (int n = 0; n < 2; ++n) _Pragma("unroll") for (int k = 0; k < 2; ++k) dst[n][k] = *(const PG8_LAS bf16x8*)(lds + PG8_SB(b, h) + boff + n * 2048 + k * 1024); } while (0)
#define PG8_MMA(ai, bj, At, Bt) do { __builtin_amdgcn_s_setprio(1); _Pragma("unroll") for (int m = 0; m < 4; ++m) _Pragma("unroll") for (int n = 0; n < 2; ++n) _Pragma("unroll") for (int k = 0; k < 2; ++k) \
        acc[ai][bj][m][n] = __builtin_amdgcn_mfma_f32_16x16x32_bf16(Bt[n][k], At[m][k], acc[ai][bj][m][n], 0, 0, 0); __builtin_amdgcn_s_setprio(0); } while (0)
#define PG8_WAIT_V(n) asm volatile("s_waitcnt vmcnt(" #n ")" ::: "memory")
#define PG8_WAIT_L(n) asm volatile("s_waitcnt lgkmcnt(" #n ")" ::: "memory")
#define PG8_BAR __builtin_amdgcn_s_barrier()
#define PG8_SCHED __builtin_amdgcn_sched_barrier(0)
    Unit cur, nxt; int ui = 0;
    if (!S.next(0, cur)) return;
    f32x4 acc[2][2][4][2];
#pragma unroll
    for (int a = 0; a < 2; ++a)
#pragma unroll
        for (int b = 0; b < 2; ++b)
#pragma unroll
            for (int m = 0; m < 4; ++m)
#pragma unroll
                for (int n = 0; n < 2; ++n) acc[a][b][m][n] = (f32x4){0.f, 0.f, 0.f, 0.f};
    bf16x8 At[4][2], B0[2][2], B1[2][2];
    const char* cA = (const char*)g.A + (size_t)cur.pm * tstep; const char* cB = (const char*)g.Bt + (size_t)cur.pn * tstep;
    S.a_ready(cur);
    if constexpr (SP2) {
        PG8_STAGE(PG8_SB(0, 0), cB, voffB); PG8_STAGE(PG8_SB(0, 1), cB + hstep, voffB); PG8_STAGE(PG8_SA(0, 0), cA, voffA); PG8_STAGE(PG8_SA(0, 1), cA + hstep, voffA);
        if (wr == 1) PG8_BAR;
        PG8_WAIT_V(2); PG8_BAR;
        PG8_STAGE(PG8_SB(1, 0), cB + kstep, voffB); PG8_STAGE(PG8_SA(1, 0), cA + kstep, voffA); PG8_STAGE(PG8_SB(1, 1), cB + hstep + kstep, voffB);
        PG8_WAIT_V(6); PG8_BAR;
    } else {
        PG8_STAGE(PG8_SB(0, 0), cB, voffB); PG8_STAGE(PG8_SA(0, 0), cA, voffA); PG8_STAGE(PG8_SB(0, 1), cB + hstep, voffB); PG8_STAGE(PG8_SA(0, 1), cA + hstep, voffA);
        if (wr == 1) PG8_BAR;
        PG8_WAIT_V(4); PG8_BAR;
        PG8_STAGE(PG8_SB(1, 0), cB + kstep, voffB); PG8_STAGE(PG8_SA(1, 0), cA + kstep, voffA); PG8_STAGE(PG8_SB(1, 1), cB + hstep + kstep, voffB);
        PG8_WAIT_V(6); PG8_BAR;
    }
    for (;;) {
        const bool has_next = S.next(ui + 1, nxt);
        const char* nA = has_next ? (const char*)g.A + (size_t)nxt.pm * tstep : cA; const char* nB = has_next ? (const char*)g.Bt + (size_t)nxt.pn * tstep : cB;
        for (int t = 0; t < nt; t += 2) {
            const bool last = (t == nt - 2);
            const char* a1 = cA + (size_t)(t + 1) * kstep;
            const char* a2 = last ? nA : cA + (size_t)(t + 2) * kstep; const char* b2 = last ? nB : cB + (size_t)(t + 2) * kstep;
            const char* a3 = a2 + kstep; const char* b3 = b2 + kstep;
            if (last && has_next) S.a_ready(nxt);
            if constexpr (SP2) {
            PG8_LDB(B0, 0, 0); PG8_LDB(B1, 0, 1); PG8_SCHED; PG8_LDA(At, 0, 0); PG8_STAGE(PG8_SA(1, 1), a1 + hstep, voffA);
            PG8_WAIT_V(8); PG8_WAIT_L(0); PG8_BAR; PG8_MMA(0, 0, At, B0); PG8_MMA(0, 1, At, B1); PG8_BAR; PG8_SCHED;
            PG8_LDA(At, 0, 1); PG8_STAGE(PG8_SB(0, 0), b2, voffB); PG8_STAGE(PG8_SB(0, 1), b2 + hstep, voffB); PG8_STAGE(PG8_SA(0, 0), a2, voffA);
            PG8_WAIT_V(8); PG8_WAIT_L(0); PG8_BAR; PG8_MMA(1, 0, At, B0); PG8_MMA(1, 1, At, B1); PG8_BAR; PG8_SCHED;
            PG8_LDB(B0, 1, 0); PG8_LDB(B1, 1, 1); PG8_SCHED; PG8_LDA(At, 1, 0); PG8_STAGE(PG8_SA(0, 1), a2 + hstep, voffA);
            PG8_WAIT_V(8); PG8_WAIT_L(0); PG8_BAR; PG8_MMA(0, 0, At, B0); PG8_MMA(0, 1, At, B1); PG8_BAR; PG8_SCHED;
            PG8_LDA(At, 1, 1); PG8_STAGE(PG8_SB(1, 0), b3, voffB); PG8_STAGE(PG8_SB(1, 1), b3 + hstep, voffB); PG8_STAGE(PG8_SA(1, 0), a3, voffA);
            PG8_WAIT_V(8); PG8_WAIT_L(0); PG8_BAR; PG8_MMA(1, 0, At, B0); PG8_MMA(1, 1, At, B1); PG8_BAR; PG8_SCHED;
            } else {
            PG8_LDB(B0, 0, 0); PG8_SCHED; PG8_LDA(At, 0, 0); PG8_STAGE(PG8_SA(1, 1), a1 + hstep, voffA);
            PG8_WAIT_L(8); PG8_BAR; PG8_WAIT_L(0); PG8_MMA(0, 0, At, B0); PG8_BAR; PG8_SCHED;
            PG8_LDB(B1, 0, 1); PG8_STAGE(PG8_SB(0, 0), b2, voffB);
            PG8_BAR; PG8_WAIT_L(0); PG8_MMA(0, 1, At, B1); PG8_BAR;
            PG8_LDA(At, 0, 1); PG8_STAGE(PG8_SA(0, 0), a2, voffA);
            PG8_BAR; PG8_WAIT_L(0); PG8_MMA(1, 0, At, B0); PG8_BAR; PG8_SCHED;
            PG8_STAGE(PG8_SB(0, 1), b2 + hstep, voffB);
            PG8_WAIT_V(6); PG8_BAR; PG8_MMA(1, 1, At, B1); PG8_BAR;
            PG8_LDB(B0, 1, 0); PG8_SCHED; PG8_LDA(At, 1, 0); PG8_STAGE(PG8_SA(0, 1), a2 + hstep, voffA);
            PG8_WAIT_L(8); PG8_BAR; PG8_WAIT_L(0); PG8_MMA(0, 0, At, B0); PG8_BAR; PG8_SCHED;
            PG8_LDB(B1, 1, 1); PG8_STAGE(PG8_SB(1, 0), b3, voffB);
            PG8_BAR; PG8_WAIT_L(0); PG8_MMA(0, 1, At, B1); PG8_BAR;
            PG8_LDA(At, 1, 1); PG8_STAGE(PG8_SA(1, 0), a3, voffA);
            PG8_BAR; PG8_WAIT_L(0); PG8_MMA(1, 0, At, B0); PG8_BAR; PG8_SCHED;
            PG8_STAGE(PG8_SB(1, 1), b3 + hstep, voffB);
            PG8_WAIT_V(6); PG8_BAR; PG8_MMA(1, 1, At, B1); PG8_BAR;
            }
        }
        if constexpr (ALIGN_EPI) { if (wr == 0) PG8_BAR; }
        if constexpr (!Epi::AFTER_DRAIN) { E(acc, cur, wr, wc, fr, fq); S.done(cur); }
        if (!has_next) break;
#pragma unroll
        for (int a = 0; a < 2; ++a)
#pragma unroll
            for (int b = 0; b < 2; ++b)
#pragma unroll
                for (int m = 0; m < 4; ++m)
#pragma unroll
                    for (int n = 0; n < 2; ++n) acc[a][b][m][n] = (f32x4){0.f, 0.f, 0.f, 0.f};
        cur = nxt; cA = nA; cB = nB; ++ui;
        if constexpr (ALIGN_EPI) { if (wr == 1) PG8_BAR; }
    }
    PG8_WAIT_V(0);
    if constexpr (!ALIGN_EPI) { if (wr == 0) PG8_BAR; }
    PG8_BAR;
    if constexpr (Epi::AFTER_DRAIN) { E.fused(acc, cur, wr, wc, fr, fq, lds, wid, lane); S.done(cur); }
#undef PG8_SA
#undef PG8_SB
#undef PG8_STAGE
#undef PG8_LDA
#undef PG8_LDB
#undef PG8_MMA
#undef PG8_WAIT_V
#undef PG8_WAIT_L
#undef PG8_BAR
#undef PG8_SCHED
}
}
__device__ __forceinline__ float row_rstd(const float* ssq, int row) {
    const f32x4* q = (const f32x4*)(ssq + (size_t)row * 16);
    const f32x4 a = q[0], b = q[1], c = q[2], d = q[3];
    return rsqrtf(((((a.x + a.y) + (a.z + a.w)) + ((b.x + b.y) + (b.z + b.w))) + (((c.x + c.y) + (c.z + c.w)) + ((d.x + d.y) + (d.z + d.w)))) * (1.f / DM) + EPS);
}
__device__ __forceinline__ void phase1_mfma(const Params& p, LAS unsigned char* lds) {
    pg8::Gemm g{(const pg8::bf16_t*)(p.ws + OFF_XN), (const pg8::bf16_t*)(p.ws + OFF_WIN), MROWS, NIN, DM};
    pg8::StaticOrder S; S.init(MROWS, NIN, (int)gridDim.x, (int)blockIdx.x);
    pg8::EpiP1 E{P1Ptrs{p.ws, p.in[10], p.in[12]}};
    pg8::gemm_phase<pg8::EpiP1, pg8::StaticOrder, true, true>(lds, g, S, E);
}
__device__ __forceinline__ void phase3_mfma(const Params& p, LAS unsigned char* lds) {
    pg8::Gemm g{(const pg8::bf16_t*)(p.ws + OFF_MIX), (const pg8::bf16_t*)(p.ws + OFF_WOUT), NTOK, DM, DM};
    pg8::StaticOrder S; S.init(NTOK, DM, (int)gridDim.x, (int)blockIdx.x);
    pg8::EpiP3 E{p.in[0], p.out, (bf16_t*)(p.ws + OFF_H2B), (float*)(p.ws + OFF_SSQP)};
    pg8::gemm_phase<pg8::EpiP3, pg8::StaticOrder, true, true>(lds, g, S, E);
}

typedef float f32x16 __attribute__((ext_vector_type(16)));
constexpr int AT_KROW = 272, AT_VROW = 136, AT_KBYTES = 64 * AT_KROW, AT_VBYTES = 128 * AT_VROW, AT_STAGE = AT_KBYTES + AT_VBYTES;
__device__ __forceinline__ void attn_item(const Params& p, LAS unsigned char* lds, int item) {
    const int tid = threadIdx.x, lane = tid & 63, wave = __builtin_amdgcn_readfirstlane(tid >> 6), qg = wave >> 1, c = wave & 1, l31 = lane & 31, hh = lane >> 5;
    const int qt = item & 15, h = (item >> 4) & 3, b = item >> 6;
    const int r0 = b * SEQ + qt * 128;
    const bf16_t* QB = (const bf16_t*)(p.ws + OFF_QB); const bf16_t* KB = (const bf16_t*)(p.ws + OFF_KB); const bf16_t* VT = (const bf16_t*)(p.ws + OFF_VT);
    bf16x8 qf[4];
    {
        const bf16_t* qp = QB + (size_t)(r0 + qg * 32 + l31) * 512 + h * 128 + c * 64 + 8 * hh;
#pragma unroll
        for (int s = 0; s < 4; ++s) qf[s] = *(const bf16x8*)(qp + 16 * s);
    }
    f32x16 O[4];
#pragma unroll
    for (int i = 0; i < 4; ++i)
#pragma unroll
        for (int r = 0; r < 16; ++r) O[i][r] = 0.f;
    float m = 0.f, l = 0.f;
    const int kq0 = tid, kq1 = tid + 512;
    const bf16_t* kg0 = KB + (size_t)(kq0 >> 4) * 512 + h * 128 + (kq0 & 15) * 8; const bf16_t* kg1 = KB + (size_t)(kq1 >> 4) * 512 + h * 128 + (kq1 & 15) * 8;
    const bf16_t* vg0 = VT + (size_t)(h * 128 + (kq0 >> 3)) * MROWS + (kq0 & 7) * 8; const bf16_t* vg1 = VT + (size_t)(h * 128 + (kq1 >> 3)) * MROWS + (kq1 & 7) * 8;
    const int kl0 = (kq0 >> 4) * AT_KROW + (kq0 & 15) * 16, kl1 = (kq1 >> 4) * AT_KROW + (kq1 & 15) * 16;
    const int vl0 = AT_KBYTES + (kq0 >> 3) * AT_VROW + (kq0 & 7) * 16, vl1 = AT_KBYTES + (kq1 >> 3) * AT_VROW + (kq1 & 7) * 16;
    u32x4 kr0, kr1, vr0, vr1;
#define AT_LOAD(t) do { const size_t kro = (size_t)((t) < 32 ? b * SEQ + (t) * 64 : NTOK); \
        kr0 = *(const u32x4*)(kg0 + kro * 512); kr1 = *(const u32x4*)(kg1 + kro * 512); vr0 = *(const u32x4*)(vg0 + kro); vr1 = *(const u32x4*)(vg1 + kro); } while (0)
#define AT_WRITE(buf) do { LAS unsigned char* _b = lds + (buf) * AT_STAGE; \
        *(LAS u32x4*)(_b + kl0) = kr0; *(LAS u32x4*)(_b + kl1) = kr1; \
        *(LAS u32x2*)(_b + vl0) = (u32x2){vr0.x, vr0.y}; *(LAS u32x2*)(_b + vl0 + 8) = (u32x2){vr0.z, vr0.w}; \
        *(LAS u32x2*)(_b + vl1) = (u32x2){vr1.x, vr1.y}; *(LAS u32x2*)(_b + vl1 + 8) = (u32x2){vr1.z, vr1.w}; } while (0)
    __syncthreads();
    AT_LOAD(0); AT_WRITE(0);
    __syncthreads();
    for (int t = 0; t < 33; ++t) {
        if (t + 1 < 33) AT_LOAD(t + 1);
        const LAS unsigned char* kb_ = lds + (t & 1) * AT_STAGE; const LAS unsigned char* vb_ = kb_ + AT_KBYTES;
        f32x16 s0, s1;
#pragma unroll
        for (int r = 0; r < 16; ++r) { s0[r] = -m; s1[r] = -m; }
#pragma unroll
        for (int s = 0; s < 4; ++s) {
            const bf16x8 k0 = *(const LAS bf16x8*)(kb_ + l31 * AT_KROW + (c * 64 + 16 * s + 8 * hh) * 2);
            s0 = __builtin_amdgcn_mfma_f32_32x32x16_bf16(k0, qf[s], s0, 0, 0, 0);
        }
#pragma unroll
        for (int s = 0; s < 4; ++s) {
            const bf16x8 k1 = *(const LAS bf16x8*)(kb_ + (32 + l31) * AT_KROW + (c * 64 + 16 * s + 8 * hh) * 2);
            s1 = __builtin_amdgcn_mfma_f32_32x32x16_bf16(k1, qf[s], s1, 0, 0, 0);
        }
        if (t == 32) {
#pragma unroll
            for (int r = 0; r < 16; ++r) { const int key = (r & 3) + 8 * (r >> 2) + 4 * hh; if (key >= 16) s0[r] = -1e30f; s1[r] = -1e30f; }
        }
        float mx = s0[0];
#pragma unroll
        for (int r = 1; r < 16; ++r) mx = fmaxf(mx, s0[r]);
#pragma unroll
        for (int r = 0; r < 16; ++r) mx = fmaxf(mx, s1[r]);
        mx = fmaxf(mx, __shfl_xor(mx, 32));
        if (t == 0 || __any(mx > 8.0f)) {
            const float d = t == 0 ? mx : fmaxf(mx, 0.f), alpha = __builtin_amdgcn_exp2f(-d);
            m += d; l *= alpha;
#pragma unroll
            for (int i = 0; i < 4; ++i) O[i] = O[i] * alpha;
#pragma unroll
            for (int r = 0; r < 16; ++r) { s0[r] -= d; s1[r] -= d; }
        }
        float ps = 0.f;
#define AT_PV(SREG, kb) do { \
        _Pragma("unroll") for (int r = 0; r < 16; ++r) { SREG[r] = __builtin_amdgcn_exp2f(SREG[r]); ps += SREG[r]; } \
        bf16x8 pf0, pf1; \
        { u32x4 a; a.x = pk2(SREG[0], SREG[1]); a.y = pk2(SREG[2], SREG[3]); a.z = pk2(SREG[4], SREG[5]); a.w = pk2(SREG[6], SREG[7]); pf0 = __builtin_bit_cast(bf16x8, a); \
          u32x4 bq; bq.x = pk2(SREG[8], SREG[9]); bq.y = pk2(SREG[10], SREG[11]); bq.z = pk2(SREG[12], SREG[13]); bq.w = pk2(SREG[14], SREG[15]); pf1 = __builtin_bit_cast(bf16x8, bq); } \
        _Pragma("unroll") for (int vb = 0; vb < 4; ++vb) { \
            const LAS unsigned char* vp = vb_ + (vb * 32 + l31) * AT_VROW + ((kb) * 32 + 4 * hh) * 2; \
            const u32x2 lo0 = *(const LAS u32x2*)vp, hi0 = *(const LAS u32x2*)(vp + 16), lo1 = *(const LAS u32x2*)(vp + 32), hi1 = *(const LAS u32x2*)(vp + 48); \
            O[vb] = __builtin_amdgcn_mfma_f32_32x32x16_bf16(__builtin_bit_cast(bf16x8, (u32x4){lo0.x, lo0.y, hi0.x, hi0.y}), pf0, O[vb], 0, 0, 0); \
            O[vb] = __builtin_amdgcn_mfma_f32_32x32x16_bf16(__builtin_bit_cast(bf16x8, (u32x4){lo1.x, lo1.y, hi1.x, hi1.y}), pf1, O[vb], 0, 0, 0); } } while (0)
        AT_PV(s0, 0);
        AT_PV(s1, 1);
#undef AT_PV
        l += ps;
        if (t + 1 < 33) AT_WRITE((t + 1) & 1);
        __syncthreads();
    }
    const float inv = 1.f / (l + __shfl_xor(l, 32));
    LAS float* X = (LAS float*)lds + qg * 4096;
    if (c == 1) {
#pragma unroll
        for (int vb = 0; vb < 4; ++vb)
#pragma unroll
            for (int r = 0; r < 16; ++r) X[(vb * 16 + r) * 64 + lane] = O[vb][r] * inv;
    }
    __syncthreads();
    if (c == 0) {
        const float lam = ((const float*)(p.ws + OFF_MISC))[0];
        float ss = 0.f;
#pragma unroll
        for (int vb = 0; vb < 4; ++vb)
#pragma unroll
            for (int r = 0; r < 16; ++r) { const float y = O[vb][r] * inv - lam * X[(vb * 16 + r) * 64 + lane]; O[vb][r] = y; ss += y * y; }
        ss += __shfl_xor(ss, 32);
        const float rs = rsqrtf(ss * (1.f / 128.f) + EPS) * 0.8f;
        bf16_t* orow = (bf16_t*)(p.ws + OFF_MIX) + (size_t)(r0 + qg * 32 + l31) * DM + h * 128;
#pragma unroll
        for (int vb = 0; vb < 4; ++vb)
#pragma unroll
            for (int rq = 0; rq < 4; ++rq) {
                const int v0 = vb * 32 + 8 * rq + 4 * hh;
                const f32x4 w = *(const f32x4*)(p.in[8] + v0);
                u32x2 o; o.x = pk2(O[vb][4 * rq] * rs * w.x, O[vb][4 * rq + 1] * rs * w.y); o.y = pk2(O[vb][4 * rq + 2] * rs * w.z, O[vb][4 * rq + 3] * rs * w.w);
                *(u32x2*)(orow + v0) = o;
            }
    }
#undef AT_LOAD
#undef AT_WRITE
}
__device__ __forceinline__ void phase2_attn_mfma(const Params& p, LAS unsigned char* lds) {
    for (int it = vcu_of_block(); it < NB * 4 * 16; it += gridDim.x) attn_item(p, lds, it);
}


__device__ __forceinline__ int gsw(int row, int chunk) { return row * 128 + ((chunk ^ (row & 7)) << 4); }
constexpr int GL_SET = 40960;
constexpr int GL_QS = 0, GL_KS = 8192, GL_KT = 16384, GL_VT = 24576, GL_AT = 2 * GL_SET, GL_ST = GL_AT + 8192  , GL_DV = GL_ST + 32768  ;
__device__ __forceinline__ float dpp_scan64(float v) {
    v += __builtin_bit_cast(float, __builtin_amdgcn_update_dpp(0, __builtin_bit_cast(int, v), 0x111, 0xf, 0xf, false));
    v += __builtin_bit_cast(float, __builtin_amdgcn_update_dpp(0, __builtin_bit_cast(int, v), 0x112, 0xf, 0xf, false));
    v += __builtin_bit_cast(float, __builtin_amdgcn_update_dpp(0, __builtin_bit_cast(int, v), 0x114, 0xf, 0xf, false));
    v += __builtin_bit_cast(float, __builtin_amdgcn_update_dpp(0, __builtin_bit_cast(int, v), 0x118, 0xf, 0xf, false));
    v += __builtin_bit_cast(float, __builtin_amdgcn_update_dpp(0, __builtin_bit_cast(int, v), 0x142, 0xa, 0xf, false));
    v += __builtin_bit_cast(float, __builtin_amdgcn_update_dpp(0, __builtin_bit_cast(int, v), 0x143, 0xc, 0xf, false));
    return v;
}
struct GlaPre { f32x4 g0, g1; u32x4 q8, k8, v0, v1; };
struct GlaCtx { const bf16_t* GQ; const bf16_t* GK; const bf16_t* GVT; const float* G; float* O; int dir, h, b, nsteps, lane, wave, l15, g, vdv, vch; };
__device__ __forceinline__ int gla_rowbase(const GlaCtx& c, int st) { return c.dir ? c.b * SEQ + (31 - st) * 64 : (st == 0 ? NTOK : c.b * SEQ + (st - 1) * 64); }
__device__ __forceinline__ void gla_load(const GlaCtx& c, GlaPre& r, int st) {
    const int rb = gla_rowbase(c, st); const size_t row = (size_t)(rb + c.lane);
    r.g0 = *(const f32x4*)(c.G + row * 256 + c.h * 64 + 8 * c.wave); r.g1 = *(const f32x4*)(c.G + row * 256 + c.h * 64 + 8 * c.wave + 4);
    r.q8 = *(const u32x4*)(c.GQ + row * 256 + c.h * 64 + 8 * c.wave); r.k8 = *(const u32x4*)(c.GK + row * 256 + c.h * 64 + 8 * c.wave);
    r.v0 = *(const u32x4*)(c.GVT + (size_t)(c.h * 128 + c.vdv) * MROWS + rb + c.vch * 8); r.v1 = *(const u32x4*)(c.GVT + (size_t)(c.h * 128 + c.vdv) * MROWS + rb + c.vch * 8 + 8);
}
__device__ __forceinline__ void gla_step(const GlaCtx& c, LAS unsigned char* lds, GlaPre& r, f32x4 (&accS)[4], int st) {
    const int lane = c.lane, wave = c.wave, l15 = c.l15, g = c.g, dir = c.dir;
    const bool meta = (dir == 0 && st == 0);
    const int rowbase = gla_rowbase(c, st);
    LAS unsigned char* sb = lds + (st & 1) * GL_SET;
    float gg[8] = {r.g0.x, r.g0.y, r.g0.z, r.g0.w, r.g1.x, r.g1.y, r.g1.z, r.g1.w};
    if (meta && lane >= NMETA) {
#pragma unroll
        for (int e = 0; e < 8; ++e) gg[e] = 0.f;
    }
    const u32x4 q8 = r.q8, k8 = r.k8;
    float qv[8] = {bflo(q8.x), bfhi(q8.x), bflo(q8.y), bfhi(q8.y), bflo(q8.z), bfhi(q8.z), bflo(q8.w), bfhi(q8.w)};
    float kv[8] = {bflo(k8.x), bfhi(k8.x), bflo(k8.y), bfhi(k8.y), bflo(k8.z), bfhi(k8.z), bflo(k8.w), bfhi(k8.w)};
    float qn[8], kn[8], ks[8];
#pragma unroll
    for (int e = 0; e < 8; ++e) {
        const float P = dpp_scan64(gg[e]);
        const float T = __builtin_bit_cast(float, __builtin_amdgcn_readlane(__builtin_bit_cast(int, P), 63));
        const float Bv = dir ? (T - P + gg[e]) : P;
        const float eb = __expf(Bv), en = __builtin_amdgcn_rcpf(eb), eT = __expf(T);
        qn[e] = qv[e] * eb; kn[e] = kv[e] * en; ks[e] = kn[e] * eT;
        if (lane == 0) *(LAS float*)(lds + GL_DV + (st & 1) * 256 + (8 * wave + e) * 4) = eT;
    }
    *(LAS u32x4*)(sb + GL_QS + gsw(lane, wave)) = (u32x4){pk2(qn[0], qn[1]), pk2(qn[2], qn[3]), pk2(qn[4], qn[5]), pk2(qn[6], qn[7])};
    *(LAS u32x4*)(sb + GL_KS + gsw(lane, wave)) = (u32x4){pk2(kn[0], kn[1]), pk2(kn[2], kn[3]), pk2(kn[4], kn[5]), pk2(kn[6], kn[7])};
#pragma unroll
    for (int e = 0; e < 8; e += 2) { const unsigned w = pk2(ks[e], ks[e + 1]);
        *(LAS unsigned short*)(sb + GL_KT + gsw(8 * wave + e, lane >> 3) + (lane & 7) * 2) = (unsigned short)w;
        *(LAS unsigned short*)(sb + GL_KT + gsw(8 * wave + e + 1, lane >> 3) + (lane & 7) * 2) = (unsigned short)(w >> 16); }
    *(LAS u32x4*)(sb + GL_VT + gsw(c.vdv, c.vch)) = r.v0; *(LAS u32x4*)(sb + GL_VT + gsw(c.vdv, c.vch + 1)) = r.v1;
    if (st + 2 < c.nsteps) gla_load(c, r, st + 2);
    __syncthreads();
    const LAS unsigned char* STo = lds + GL_ST + (st & 1) * 16384; LAS unsigned char* STn = lds + GL_ST + ((st + 1) & 1) * 16384;
    if (!meta) {
        const int jb = wave >> 1;
#pragma unroll
        for (int ii = 0; ii < 2; ++ii) {
            const int ib = 2 * (wave & 1) + ii;
            f32x4 a = (f32x4){0.f, 0.f, 0.f, 0.f};
            const bool live = dir ? (jb >= ib) : (jb <= ib);
            if (live) {
#pragma unroll
                for (int ks2 = 0; ks2 < 2; ++ks2) {
                    const bf16x8 kf = *(const LAS bf16x8*)(sb + GL_KS + gsw(jb * 16 + l15, ks2 * 4 + g));
                    const bf16x8 qf = *(const LAS bf16x8*)(sb + GL_QS + gsw(ib * 16 + l15, ks2 * 4 + g));
                    a = __builtin_amdgcn_mfma_f32_16x16x32_bf16(kf, qf, a, 0, 0, 0);
                }
                const int i = ib * 16 + l15, j0 = jb * 16 + 4 * g;
#pragma unroll
                for (int rr = 0; rr < 4; ++rr) { const bool keep = dir ? (j0 + rr >= i) : (j0 + rr <= i); a[rr] = keep ? a[rr] : 0.f; }
            }
            const int i = ib * 16 + l15, j0 = jb * 16 + 4 * g;
            *(LAS u32x2*)(lds + GL_AT + gsw(i, j0 >> 3) + (j0 & 7) * 2) = (u32x2){pk2(a[0], a[1]), pk2(a[2], a[3])};
        }
    }
    if (st + 1 < c.nsteps) {
#pragma unroll
        for (int kb = 0; kb < 4; ++kb) {
            const f32x4 dvv = *(const LAS f32x4*)(lds + GL_DV + (st & 1) * 256 + (kb * 16 + 4 * g) * 4);
            f32x4 a = accS[kb] * dvv;
#pragma unroll
            for (int ks2 = 0; ks2 < 2; ++ks2) {
                const bf16x8 kf = *(const LAS bf16x8*)(sb + GL_KT + gsw(kb * 16 + l15, ks2 * 4 + g));
                const bf16x8 vf = *(const LAS bf16x8*)(sb + GL_VT + gsw(wave * 16 + l15, ks2 * 4 + g));
                a = __builtin_amdgcn_mfma_f32_16x16x32_bf16(kf, vf, a, 0, 0, 0);
            }
            accS[kb] = a;
            const int dk0 = kb * 16 + 4 * g;
            *(LAS u32x2*)(STn + gsw(wave * 16 + l15, dk0 >> 3) + (dk0 & 7) * 2) = (u32x2){pk2(a[0], a[1]), pk2(a[2], a[3])};
        }
    }
    __syncthreads();
    if (!meta) {
#pragma unroll
        for (int ib = 0; ib < 4; ++ib) {
            f32x4 a = (f32x4){0.f, 0.f, 0.f, 0.f};
#pragma unroll
            for (int ks2 = 0; ks2 < 2; ++ks2) {
                const bf16x8 vf = *(const LAS bf16x8*)(sb + GL_VT + gsw(wave * 16 + l15, ks2 * 4 + g));
                const bf16x8 af = *(const LAS bf16x8*)(lds + GL_AT + gsw(ib * 16 + l15, ks2 * 4 + g));
                a = __builtin_amdgcn_mfma_f32_16x16x32_bf16(vf, af, a, 0, 0, 0);
                const bf16x8 sf = *(const LAS bf16x8*)(STo + gsw(wave * 16 + l15, ks2 * 4 + g));
                const bf16x8 qf = *(const LAS bf16x8*)(sb + GL_QS + gsw(ib * 16 + l15, ks2 * 4 + g));
                a = __builtin_amdgcn_mfma_f32_16x16x32_bf16(sf, qf, a, 0, 0, 0);
            }
            *(f32x4*)(c.O + (size_t)(rowbase + ib * 16 + l15) * 512 + c.h * 128 + wave * 16 + 4 * g) = a;
        }
    }
}
__device__ __forceinline__ void gla_chain(const Params& p, LAS unsigned char* lds, int item) {
    const int tid = threadIdx.x;
    GlaCtx c;
    c.lane = tid & 63; c.wave = __builtin_amdgcn_readfirstlane(tid >> 6); c.l15 = c.lane & 15; c.g = c.lane >> 4;
    c.dir = item & 1; c.h = (item >> 1) & 3; c.b = item >> 3;
    c.GQ = (const bf16_t*)(p.ws + OFF_GQ); c.GK = (const bf16_t*)(p.ws + OFF_GK); c.GVT = (const bf16_t*)(p.ws + OFF_GVT);
    c.G = (const float*)(p.ws + (c.dir ? OFF_GB : OFF_GF));
    c.O = p.out + (c.dir ? (size_t)NTOK * 512 : 0);
    c.nsteps = c.dir ? 32 : 33; c.vdv = tid >> 2; c.vch = (tid & 3) * 2;
    f32x4 accS[4];
#pragma unroll
    for (int i = 0; i < 4; ++i) accS[i] = (f32x4){0.f, 0.f, 0.f, 0.f};
    __syncthreads();
    *(LAS u32x4*)(lds + GL_ST + tid * 32) = (u32x4){0u, 0u, 0u, 0u}; *(LAS u32x4*)(lds + GL_ST + tid * 32 + 16) = (u32x4){0u, 0u, 0u, 0u};
    GlaPre X, Y;
    gla_load(c, X, 0); gla_load(c, Y, 1);
    for (int st = 0; st < c.nsteps; st += 2) {
        gla_step(c, lds, X, accS, st);
        if (st + 1 < c.nsteps) gla_step(c, lds, Y, accS, st + 1);
    }
}

constexpr int LDS_Q = LDS_BYTES - 16;
__device__ __forceinline__ void phase2(const Params& p, LAS unsigned char* lds, int qslot = 0) {
    unsigned* ctr = (unsigned*)(p.ws + OFF_CTL) + (qslot >= 2 ? 2048 + qslot * 64 : qslot * 64);
    int it;
#define P2_NEXT() do { __syncthreads(); if (threadIdx.x == 0) *(LAS unsigned*)(lds + LDS_Q) = atomicAdd(ctr, 1u); __syncthreads(); it = (int)*(LAS unsigned*)(lds + LDS_Q); } while (0)
    P2_NEXT();
    if (qslot != 3) { while (it < 64) { gla_chain(p, lds, it); P2_NEXT(); } }
    if (qslot == 2) return;
    if (qslot == 3) it += 64;
    while (it < 64 + NB * 4 * 16) { attn_item(p, lds, it - 64); P2_NEXT(); if (qslot == 3) it += 64; }
    if (qslot) return;
    for (;;) {
        __syncthreads();
        if (threadIdx.x == 0) *(LAS unsigned*)(lds + LDS_Q) = atomicAdd(ctr + 128, 1u);
        __syncthreads();
        const int c = (int)*(LAS unsigned*)(lds + LDS_Q);
        if (c >= CV_ITEMS) break;
        conv_item(p, (unsigned char*)lds, c);
    }
#undef P2_NEXT
}

__device__ __forceinline__ void phase2c(const Params& p) {
    const int tid = threadIdx.x, lane = tid & 63, wave = tid >> 6;
    const int gw = blockIdx.x * 8 + wave, NGW = gridDim.x * 8;
    const bf16_t* GR = (const bf16_t*)(p.ws + OFF_GR); bf16_t* MIX = (bf16_t*)(p.ws + OFF_MIX);
    const float* OF = p.out; const float* OBk = p.out + (size_t)NTOK * 512;
    const int c0 = lane * 8;
    const f32x4 w0 = *(const f32x4*)(p.in[13] + (c0 & 127)), w1 = *(const f32x4*)(p.in[13] + (c0 & 127) + 4);
    for (int r = gw; r < NTOK; r += NGW) {
        const f32x4 a0 = *(const f32x4*)(OF + (size_t)r * 512 + c0), a1 = *(const f32x4*)(OF + (size_t)r * 512 + c0 + 4);
        const f32x4 b0 = *(const f32x4*)(OBk + (size_t)r * 512 + c0), b1 = *(const f32x4*)(OBk + (size_t)r * 512 + c0 + 4);
        const f32x4 x0 = a0 + b0, x1 = a1 + b1;
        float s = x0.x * x0.x + x0.y * x0.y + x0.z * x0.z + x0.w * x0.w + x1.x * x1.x + x1.y * x1.y + x1.z * x1.z + x1.w * x1.w;
        s += __shfl_xor(s, 1); s += __shfl_xor(s, 2); s += __shfl_xor(s, 4); s += __shfl_xor(s, 8);
        const float rs = rsqrtf(s * (1.f / 128.f) + EPS);
        const u32x4 g = *(const u32x4*)(GR + (size_t)r * 512 + c0);
        u32x4 o;
        o.x = pk2(x0.x * rs * w0.x * bflo(g.x), x0.y * rs * w0.y * bfhi(g.x)); o.y = pk2(x0.z * rs * w0.z * bflo(g.y), x0.w * rs * w0.w * bfhi(g.y));
        o.z = pk2(x1.x * rs * w1.x * bflo(g.z), x1.y * rs * w1.y * bfhi(g.z)); o.w = pk2(x1.z * rs * w1.z * bflo(g.w), x1.w * rs * w1.w * bfhi(g.w));
        *(u32x4*)(MIX + (size_t)r * DM + 512 + c0) = o;
    }
}


#define TOPK_INS(L, x) do { float _x = (x); _Pragma("unroll") for (int _s = 0; _s < 16; ++_s) { const float _t = fmaxf(L[_s], _x); _x = fminf(L[_s], _x); L[_s] = _t; } } while (0)
constexpr int P4_QROW = 528, P4_SC0 = 128 * P4_QROW  , P4_TLROW = 144;

#define CE_DESC(a, b) do { const float _hi = fmaxf(a, b), _lo = fminf(a, b); a = _hi; b = _lo; } while (0)
__device__ __forceinline__ void bitonic_sort16_desc(float (&x)[16]) {
#pragma unroll
    for (int k = 2; k <= 16; k <<= 1)
#pragma unroll
        for (int j = k >> 1; j > 0; j >>= 1)
#pragma unroll
            for (int i = 0; i < 16; ++i) { const int l = i ^ j; if (l > i) { if ((i & k) == 0) CE_DESC(x[i], x[l]); else CE_DESC(x[l], x[i]); } }
}
__device__ __forceinline__ void bitonic_merge16_desc(float (&x)[16]) {
#pragma unroll
    for (int j = 8; j > 0; j >>= 1)
#pragma unroll
        for (int i = 0; i < 16; ++i) { const int l = i ^ j; if (l > i) CE_DESC(x[i], x[l]); }
}
__device__ __forceinline__ void top16_merge(float (&L)[16], const float (&x)[16]) {
#pragma unroll
    for (int i = 0; i < 16; ++i) L[i] = fmaxf(L[i], x[15 - i]);
    bitonic_merge16_desc(L);
}

template <int Q> struct CandIJ {
    static constexpr int compute() { int c = 0; for (int i = 0; i < 16; ++i) for (int j = 0; j < 16; ++j) if ((i + 1) * (j + 1) <= 16) { if (c == Q) return i * 16 + j; ++c; } return -1; }
    static constexpr int v = compute();
};
template <int G, int S> __device__ __forceinline__ void cand_fill(float (&x)[16], const float (&A)[16], const float (&Bv)[16]) {
    constexpr int ij = CandIJ<G * 16 + S>::v;
    if constexpr (ij >= 0) x[S] = __uint_as_float((__float_as_uint(A[ij >> 4] + Bv[ij & 15]) & ~255u) | (unsigned)ij); else x[S] = -3.0e38f;
    if constexpr (S + 1 < 16) cand_fill<G, S + 1>(x, A, Bv);
}
__device__ __forceinline__ void p4_route_half(const Params& p, LAS unsigned char* lds, int m0, int h) {
    int tid_ = threadIdx.x; asm volatile("" : "+v"(tid_));
    const int tid = tid_, lane = tid & 63, wave = __builtin_amdgcn_readfirstlane(tid >> 6), l15 = lane & 15, g = lane >> 4;
    const bf16_t* KEYS = (const bf16_t*)(p.ws + OFF_KEYS); unsigned* PW0 = (unsigned*)(p.ws + OFF_PW0);
        {
            const int wr = wave >> 1, wk = wave & 1;
            f32x4 sc[2][2][4];
#pragma unroll
            for (int pp = 0; pp < 2; ++pp) {
#pragma unroll
                for (int rb = 0; rb < 2; ++rb)
#pragma unroll
                    for (int kk = 0; kk < 4; ++kk) sc[pp][rb][kk] = (f32x4){0.f, 0.f, 0.f, 0.f};
                const bf16_t* kbase = KEYS + (size_t)((h * 2 + pp) * 128 + 64 * wk + l15) * 128 + 8 * g;
#pragma unroll
                for (int ks = 0; ks < 4; ++ks) {
                    bf16x8 qf[2], kf[4];
#pragma unroll
                    for (int rb = 0; rb < 2; ++rb) qf[rb] = *(const LAS bf16x8*)(lds + (32 * wr + 16 * rb + l15) * P4_QROW + (pp * 128 + ks * 32 + 8 * g) * 2);
#pragma unroll
                    for (int kk = 0; kk < 4; ++kk) kf[kk] = *(const bf16x8*)(kbase + (size_t)(16 * kk) * 128 + ks * 32);
#pragma unroll
                    for (int rb = 0; rb < 2; ++rb)
#pragma unroll
                        for (int kk = 0; kk < 4; ++kk) sc[pp][rb][kk] = __builtin_amdgcn_mfma_f32_16x16x32_bf16(kf[kk], qf[rb], sc[pp][rb][kk], 0, 0, 0);
                }
            }
#pragma unroll
            for (int rb = 0; rb < 2; ++rb)
#pragma unroll
                for (int kk = 0; kk < 4; ++kk) *(LAS f32x4*)(lds + P4_SC0 + (32 * wr + 16 * rb + l15) * P4_QROW + (64 * wk + 16 * kk + 4 * g) * 4) = sc[0][rb][kk];
            __syncthreads();
#pragma unroll
            for (int rb = 0; rb < 2; ++rb)
#pragma unroll
                for (int kk = 0; kk < 4; ++kk) *(LAS f32x4*)(lds + (32 * wr + 16 * rb + l15) * P4_QROW + (64 * wk + 16 * kk + 4 * g) * 4) = sc[1][rb][kk];
        }
        __syncthreads();
        {
            const int hf = tid & 1, row = (tid >> 1) & 127, pp = tid >> 8;
            const LAS unsigned char* sp = lds + (pp ? 0 : P4_SC0) + row * P4_QROW + hf * 256;
            float L[16];
#pragma unroll
            for (int grp = 0; grp < 4; ++grp) {
                float x[16];
#pragma unroll
                for (int q4 = 0; q4 < 4; ++q4) {
                    const f32x4 v = *(const LAS f32x4*)(sp + (grp * 4 + q4) * 16);
                    const unsigned kb = (unsigned)(hf * 64 + grp * 16 + q4 * 4);
                    x[4 * q4 + 0] = __uint_as_float((__float_as_uint(v.x) & ~127u) | kb);
                    x[4 * q4 + 1] = __uint_as_float((__float_as_uint(v.y) & ~127u) | (kb + 1));
                    x[4 * q4 + 2] = __uint_as_float((__float_as_uint(v.z) & ~127u) | (kb + 2));
                    x[4 * q4 + 3] = __uint_as_float((__float_as_uint(v.w) & ~127u) | (kb + 3));
                }
                bitonic_sort16_desc(x);
                if (grp == 0) {
#pragma unroll
                    for (int s = 0; s < 16; ++s) L[s] = x[s];
                } else top16_merge(L, x);
            }
            {
                float Oth[16];
#pragma unroll
                for (int s = 0; s < 16; ++s) Oth[s] = __shfl_xor(L[s], 1);
                top16_merge(L, Oth);
            }
            __syncthreads();
            if (hf == 0) {
                LAS f32x4* tl = (LAS f32x4*)(lds + P4_SC0 + row * (2 * P4_TLROW) + pp * P4_TLROW);
                tl[0] = (f32x4){L[0], L[1], L[2], L[3]}; tl[1] = (f32x4){L[4], L[5], L[6], L[7]}; tl[2] = (f32x4){L[8], L[9], L[10], L[11]}; tl[3] = (f32x4){L[12], L[13], L[14], L[15]};
            }
        }
        __syncthreads();
        if (tid < 128) {
            const LAS unsigned char* tl = lds + P4_SC0 + tid * (2 * P4_TLROW);
            float A[16], Bv[16];
#pragma unroll
            for (int q4 = 0; q4 < 4; ++q4) { const f32x4 a = *(const LAS f32x4*)(tl + q4 * 16), b = *(const LAS f32x4*)(tl + P4_TLROW + q4 * 16);
                A[4 * q4] = a.x; A[4 * q4 + 1] = a.y; A[4 * q4 + 2] = a.z; A[4 * q4 + 3] = a.w; Bv[4 * q4] = b.x; Bv[4 * q4 + 1] = b.y; Bv[4 * q4 + 2] = b.z; Bv[4 * q4 + 3] = b.w; }
#pragma unroll
            for (int s = 0; s < 16; ++s) { A[s] = __uint_as_float(__float_as_uint(A[s]) & ~127u); Bv[s] = __uint_as_float(__float_as_uint(Bv[s]) & ~127u); }
            float L[16];
            {
                float x[16];
                cand_fill<0, 0>(x, A, Bv); bitonic_sort16_desc(x);
#pragma unroll
                for (int s = 0; s < 16; ++s) L[s] = x[s];
                cand_fill<1, 0>(x, A, Bv); bitonic_sort16_desc(x); top16_merge(L, x);
                cand_fill<2, 0>(x, A, Bv); bitonic_sort16_desc(x); top16_merge(L, x);
                cand_fill<3, 0>(x, A, Bv); bitonic_sort16_desc(x); top16_merge(L, x);
            }
            const float v0 = __uint_as_float(__float_as_uint(L[0]) & ~255u);
            float e[16], den = 0.f; int id[16];
#pragma unroll
            for (int s = 0; s < 16; ++s) {
                const unsigned u = __float_as_uint(L[s]);
                e[s] = __expf(__uint_as_float(u & ~255u) - v0); den += e[s];
                const unsigned i = (u >> 4) & 15u, j = u & 15u;
                const unsigned ka = *(const LAS unsigned*)(tl + i * 4) & 127u, kb = *(const LAS unsigned*)(tl + P4_TLROW + j * 4) & 127u;
                id[s] = (int)(ka * 128u + kb);
            }
            const float inv = 1.f / den;
            unsigned* ip = PW0 + (size_t)(m0 + tid) * 128 + h * 16;
#pragma unroll
            for (int q4 = 0; q4 < 4; ++q4) { u32x4 o;
#pragma unroll
                for (int c = 0; c < 4; ++c) o[c] = (unsigned)id[4 * q4 + c] | (f2bf(e[4 * q4 + c] * inv) << 16);
                *(u32x4*)(ip + 4 * q4) = o; }
        }
        __syncthreads();
}

namespace pg8 {
struct EpiP4 {
    static constexpr bool PERM = false, AFTER_DRAIN = true;
    const Params* pp; const float* ssq;
    __device__ __forceinline__ void operator()(const f32x4 (&)[2][2][4][2], const Unit&, int, int, int, int) const {}
    __device__ __forceinline__ void fused(f32x4 (&acc)[2][2][4][2], const Unit& u, int wr, int wc, int fr, int fq, PG8_LAS unsigned char* lds, int wid, int lane) const {
#pragma unroll
        for (int ai = 0; ai < 2; ++ai) {
            const int m0 = u.pm * BM + ai * HALF;
#pragma unroll
            for (int m = 0; m < 4; ++m) {
                const int rl = wr * 64 + m * 16 + fr;
                const float rstd = row_rstd(ssq, m0 + rl);
#pragma unroll
                for (int bj = 0; bj < 2; ++bj)
#pragma unroll
                    for (int n = 0; n < 2; ++n) { const f32x4 v = acc[ai][bj][m][n] * rstd;
                        *(PG8_LAS u32x2*)(lds + rl * P4_QROW + (bj * HALF + wc * 32 + n * 16 + 4 * fq) * 2) = (u32x2){pk2(v.x, v.y), pk2(v.z, v.w)}; }
            }
            __syncthreads();
            p4_route_half(*pp, lds, m0, u.pn);
        }
    }
};
}
__device__ __forceinline__ void phase4_mfma(const Params& p, LAS unsigned char* lds) {
    pg8::Gemm g{(const pg8::bf16_t*)(p.ws + OFF_H2B), (const pg8::bf16_t*)(p.ws + OFF_WQ), NTOK, 2048, DM};
    pg8::EpiP4 E{&p, (const float*)(p.ws + OFF_SSQP)};
    const int vcu = vcu_of_block();
    for (int r = 0; r * (int)gridDim.x < 512; ++r) {
        const int L = r * (int)gridDim.x + vcu;
        pg8::OneUnit S; S.u.pm = L >> 3; S.u.pn = L & 7; S.valid = L < 512;
        pg8::gemm_phase<pg8::EpiP4, pg8::OneUnit, false, true>(lds, g, S, E);
        __syncthreads();
    }
}


constexpr size_t OFF_PW = 73 * MiB;
constexpr size_t OFF_OUTS = 179 * MiB;
static_assert(OFF_OUTS >= OFF_PW0 + (size_t)NTOK * 128 * 4 && OFF_OUTS + (size_t)NTOK * DM * 4 <= 256 * MiB, "P5 map");
__device__ __forceinline__ float dot_fp8_bf16(u32x4 uq, u32x4 h0, u32x4 h1, float c) {
#define DQ2(word, hsel, hw) c = dot2(__builtin_bit_cast(unsigned, __builtin_amdgcn_cvt_scalef32_pk_bf16_fp8((int)(word), 1.0f, hsel)), hw, c)
    DQ2(uq.x, false, h0.x); DQ2(uq.x, true, h0.y); DQ2(uq.y, false, h0.z); DQ2(uq.y, true, h0.w);
    DQ2(uq.z, false, h1.x); DQ2(uq.z, true, h1.y); DQ2(uq.w, false, h1.z); DQ2(uq.w, true, h1.w);
#undef DQ2
    return c;
}
constexpr int P5A_RS = 1040, P5A_LIST = 16640, P5A_RES = 18688, P5A_TSC = 18752, P5A_WAVE = 19456;
constexpr size_t OFF_HQ = 146 * MiB;
constexpr size_t OFF_HSC = 192 * 1024;
static_assert(8 * P5A_WAVE <= LDS_BYTES - 32, "P5a LDS");
static_assert(OFF_HQ >= OFF_H2B + (size_t)NTOK * DM * 2 && OFF_HQ + (size_t)NTOK * DM <= OFF_PW0, "HQ map");
__device__ __forceinline__ void quantize_hn(const Params& p) {
    const int tid = threadIdx.x, lane = tid & 63, wave = tid >> 6;
    const bf16_t* H2B = (const bf16_t*)(p.ws + OFF_H2B); unsigned char* HQ = p.ws + OFF_HQ; float* HSC = (float*)(p.ws + OFF_HSC);
    for (int t = blockIdx.x * 8 + wave; t < NTOK; t += gridDim.x * 8) {
        const u32x4 h0 = *(const u32x4*)(H2B + (size_t)t * DM + 16 * lane), h1 = *(const u32x4*)(H2B + (size_t)t * DM + 16 * lane + 8);
        float m = 0.f;
#pragma unroll
        for (int c = 0; c < 4; ++c) { m = fmaxf(m, fmaxf(fabsf(bflo(h0[c])), fabsf(bfhi(h0[c])))); m = fmaxf(m, fmaxf(fabsf(bflo(h1[c])), fabsf(bfhi(h1[c])))); }
        const float am = fmaxf(wave_max(m), 1e-30f), qs = 224.f / am;
        u32x4 o;
#pragma unroll
        for (int c = 0; c < 2; ++c) {
            int w = __builtin_amdgcn_cvt_pk_fp8_f32(bflo(h0[2 * c]) * qs, bfhi(h0[2 * c]) * qs, 0, false); w = __builtin_amdgcn_cvt_pk_fp8_f32(bflo(h0[2 * c + 1]) * qs, bfhi(h0[2 * c + 1]) * qs, w, true); o[c] = (unsigned)w;
            int x = __builtin_amdgcn_cvt_pk_fp8_f32(bflo(h1[2 * c]) * qs, bfhi(h1[2 * c]) * qs, 0, false); x = __builtin_amdgcn_cvt_pk_fp8_f32(bflo(h1[2 * c + 1]) * qs, bfhi(h1[2 * c + 1]) * qs, x, true); o[2 + c] = (unsigned)x;
        }
        *(u32x4*)(HQ + (size_t)t * DM + 16 * lane) = o;
        if (lane == 0) HSC[t] = row_rstd((const float*)(p.ws + OFF_SSQP), t) * am * (1.f / 224.f);
    }
}
__device__ __forceinline__ void p5a_wave(const Params& p, LAS unsigned char* wl, int tb, int part, int lane, __amdgpu_buffer_rsrc_t urs, __amdgpu_buffer_rsrc_t hrs) {
    const float* USC = (const float*)(p.ws + OFF_USC); const float* VSC = (const float*)(p.ws + OFF_VSC); const float* HSC = (const float*)(p.ws + OFF_HSC);
    const unsigned* PW0 = (const unsigned*)(p.ws + OFF_PW0); unsigned* PW = (unsigned*)(p.ws + OFF_PW);
    const int l15 = lane & 15, g = lane >> 4;
    unsigned xl[4], xh[4]; float hsc = 0.f;
#define P5A_STAGE(t0_) do { _Pragma("unroll") for (int _k = 0; _k < 4; ++_k) { \
        __builtin_amdgcn_raw_ptr_buffer_load_lds(hrs, (LAS unsigned*)(wl + _k * 1024), 16, lane * 16, ((t0_) + _k) * 1024, 0, 0); \
        xl[_k] = PW0[(size_t)((t0_) + _k) * 128 + lane]; xh[_k] = PW0[(size_t)((t0_) + _k) * 128 + 64 + lane]; } \
        hsc = HSC[(t0_) + (lane & 3)]; } while (0)
#define P5A_GATHER(tile_) do { int _li = (tile_) * 16 + l15; _li = _li < n ? _li : n - 1; \
        const int _ev = (int)((*(const LAS unsigned*)(wl + P5A_LIST + _li * 4) & 0x3fffu) << 10); \
        _Pragma("unroll") for (int _r = 0; _r < 16; ++_r) \
            __builtin_amdgcn_raw_ptr_buffer_load_lds(urs, (LAS unsigned*)(wl + _r * P5A_RS), 16, lane * 16, __builtin_amdgcn_readlane(_ev, _r), 0, 0); } while (0)
    P5A_STAGE(tb);
    for (int st = 0; st < 4; ++st) {
        const int t0 = tb + 4 * st;
        asm volatile("s_waitcnt vmcnt(0)" ::: "memory");
        long bq[32];
#pragma unroll
        for (int s = 0; s < 32; ++s) bq[s] = __builtin_bit_cast(long, *(const LAS u32x2*)(wl + (l15 & 3) * 1024 + 32 * s + 8 * g));
        if (lane < 4) *(LAS float*)(wl + P5A_TSC + lane * 4) = hsc;
        int n = 0;
#pragma unroll
        for (int k = 0; k < 4; ++k) {
            const bool ml = (int)((xl[k] >> 11) & 7u) == part, mh = (int)((xh[k] >> 11) & 7u) == part;
            const unsigned long long bl = __ballot(ml), bh = __ballot(mh);
            const int rl = __builtin_amdgcn_mbcnt_hi((unsigned)(bl >> 32), __builtin_amdgcn_mbcnt_lo((unsigned)bl, 0u));
            if (ml) *(LAS unsigned*)(wl + P5A_LIST + (n + rl) * 4) = (xl[k] & 0x3fffu) | ((unsigned)lane << 14) | ((unsigned)k << 21);
            n += __popcll(bl);
            const int rh = __builtin_amdgcn_mbcnt_hi((unsigned)(bh >> 32), __builtin_amdgcn_mbcnt_lo((unsigned)bh, 0u));
            if (mh) *(LAS unsigned*)(wl + P5A_LIST + (n + rh) * 4) = (xh[k] & 0x3fffu) | ((unsigned)(64 + lane) << 14) | ((unsigned)k << 21);
            n += __popcll(bh);
        }
        __builtin_amdgcn_s_waitcnt(0xC07F); __builtin_amdgcn_wave_barrier();
        asm volatile("" ::: "memory");
        const int ntile = (n + 15) >> 4;
        if (ntile == 0) { if (st < 3) P5A_STAGE(t0 + 4); continue; }
        P5A_GATHER(0);
        for (int tile = 0; tile < ntile; ++tile) {
            asm volatile("s_waitcnt vmcnt(0)" ::: "memory");
            int ei = tile * 16 + l15; const bool eok = ei < n; ei = eok ? ei : n - 1;
            const unsigned ent = *(const LAS unsigned*)(wl + P5A_LIST + ei * 4);
            const unsigned ee = ent & 0x3fffu; const int sl = (int)((ent >> 14) & 127u), tk = (int)(ent >> 21), t = t0 + tk;
            float usc = USC[ee], vsc = VSC[ee]; unsigned xg = PW0[(size_t)t * 128 + sl];
            long aq[32];
#pragma unroll
            for (int s = 0; s < 32; ++s) aq[s] = __builtin_bit_cast(long, *(const LAS u32x2*)(wl + l15 * P5A_RS + 32 * s + 8 * g));
            asm volatile("s_waitcnt vmcnt(0) lgkmcnt(0)" : "+v"(usc), "+v"(vsc), "+v"(xg) :: "memory");
#pragma unroll
            for (int s = 0; s < 32; ++s) asm volatile("" : "+v"(aq[s]));
            if (tile + 1 < ntile) P5A_GATHER(tile + 1); else if (st < 3) P5A_STAGE(t0 + 4);
            f32x4 acc = (f32x4){0.f, 0.f, 0.f, 0.f};
#pragma unroll
            for (int s = 0; s < 32; ++s) acc = __builtin_amdgcn_mfma_f32_16x16x32_fp8_fp8(aq[s], bq[s], acc, 0, 0, 0);
            {
                const u32x4 en = *(const LAS u32x4*)(wl + P5A_LIST + (tile * 16 + 4 * g) * 4);
#pragma unroll
                for (int r = 0; r < 4; ++r) if ((int)(en[r] >> 21) == l15) *(LAS float*)(wl + P5A_RES + (4 * g + r) * 4) = acc[r];
            }
            __builtin_amdgcn_s_waitcnt(0xC07F); __builtin_amdgcn_wave_barrier();
            asm volatile("" ::: "memory");
            if (lane < 16 && eok) {
                const float d = *(const LAS float*)(wl + P5A_RES + lane * 4) * usc * *(const LAS float*)(wl + P5A_TSC + tk * 4);
                const float w = __uint_as_float(xg & 0xffff0000u) * gelu_f(d) * vsc;
                PW[(((size_t)(t >> 6) * 32 + (sl >> 2)) * 64 + (t & 63)) * 4 + (sl & 3)] = ee | (f2bf(w) << 16);
            }
            __builtin_amdgcn_s_waitcnt(0xC07F); __builtin_amdgcn_wave_barrier();
            asm volatile("" ::: "memory");
        }
    }
    asm volatile("s_waitcnt vmcnt(0)" ::: "memory");
#undef P5A_STAGE
#undef P5A_GATHER
}
__device__ __forceinline__ void phase5a(const Params& p, LAS unsigned char* lds, int qoff = 0) {
    const int tid = threadIdx.x, lane = tid & 63, wave = __builtin_amdgcn_readfirstlane(tid >> 6);
    const int xcc = (int)(__builtin_amdgcn_s_getreg((3 << 11) | 20) & 7u);
    unsigned* qc = (unsigned*)(p.ws + OFF_CTL) + 256 + qoff;
    LAS unsigned char* wl = lds + wave * P5A_WAVE;
    const __amdgpu_buffer_rsrc_t urs = __builtin_amdgcn_make_buffer_rsrc((void*)(p.ws + OFF_UB), 0, NEXP * DM, 0x00020000);
    const __amdgpu_buffer_rsrc_t hrs = __builtin_amdgcn_make_buffer_rsrc((void*)(p.ws + OFF_HQ), 0, NTOK * DM, 0x00020000);
    for (int pi = 0; pi < 8; ++pi) {
        const int part = (xcc + pi) & 7;
        for (;;) {
            __syncthreads();
            if (tid == 0) *(LAS unsigned*)(lds + LDS_Q) = atomicAdd(qc + part * 64, 1u);
            __syncthreads();
            const int it = (int)*(LAS unsigned*)(lds + LDS_Q);
            if (it >= NTOK / 128) break;
            p5a_wave(p, wl, it * 128 + wave * 16, part, lane, urs, hrs);
        }
    }
}

__device__ __forceinline__ void p5b_quad(const LAS unsigned char* lds, u32x4 q, f32x2& a0, f32x2& a1, f32x2& a2, f32x2& a3) {
#pragma unroll
    for (int c = 0; c < 4; ++c) {
        const unsigned x = q[c];
        const u32x2 vv = *(const LAS u32x2*)(lds + ((x & 0x3fffu) << 3));
        const float w = __uint_as_float(x & 0xffff0000u); const f32x2 ww = (f32x2){w, w};
        a0 += ww * __builtin_amdgcn_cvt_pk_f32_fp8((int)vv.x, false); a1 += ww * __builtin_amdgcn_cvt_pk_f32_fp8((int)vv.x, true);
        a2 += ww * __builtin_amdgcn_cvt_pk_f32_fp8((int)vv.y, false); a3 += ww * __builtin_amdgcn_cvt_pk_f32_fp8((int)vv.y, true);
    }
}
__device__ __forceinline__ void phase5b(const Params& p, LAS unsigned char* lds) {
    const int tid = threadIdx.x, lane = tid & 63, wave = __builtin_amdgcn_readfirstlane(tid >> 6);
    const unsigned char* VS = p.ws + OFF_VB; const u32x4* PW = (const u32x4*)(p.ws + OFF_PW); float* OUTS = (float*)(p.ws + OFF_OUTS);
    for (int it = blockIdx.x; it < 256; it += gridDim.x) {
        const int s = it >> 1, tbase = (it & 1) * 128;
        __syncthreads();
#pragma unroll 4
        for (int i = 0; i < 16; ++i) *(LAS u32x4*)(lds + (tid + NTHR * i) * 16) = *(const u32x4*)(VS + (size_t)s * 131072 + (size_t)(tid + NTHR * i) * 16);
        __syncthreads();
        u32x4 A[8], Bq[8];
#define P5B_LOAD(R, gi) do { const int _T = tbase + wave + 8 * ((gi) >> 2), _g = (gi) & 3; const u32x4* _p = PW + ((size_t)_T * 32 + _g * 8) * 64 + lane; \
        _Pragma("unroll") for (int _i = 0; _i < 8; ++_i) R[_i] = _p[_i * 64]; } while (0)
        f32x2 a0 = {0.f, 0.f}, a1 = {0.f, 0.f}, a2 = {0.f, 0.f}, a3 = {0.f, 0.f};
        P5B_LOAD(A, 0);
        for (int gi = 0; gi < 64; gi += 2) {
            P5B_LOAD(Bq, gi + 1);
#pragma unroll
            for (int i = 0; i < 8; ++i) p5b_quad(lds, A[i], a0, a1, a2, a3);
            if (gi + 2 < 64) P5B_LOAD(A, gi + 2);
#pragma unroll
            for (int i = 0; i < 8; ++i) p5b_quad(lds, Bq[i], a0, a1, a2, a3);
            if (((gi + 1) & 3) == 3) {
                const int T = tbase + wave + 8 * (gi >> 2);
                float* o = OUTS + ((size_t)s * NTOK + T * 64 + lane) * 8;
                *(f32x4*)o = (f32x4){a0.x, a0.y, a1.x, a1.y}; *(f32x4*)(o + 4) = (f32x4){a2.x, a2.y, a3.x, a3.y};
                a0 = (f32x2){0.f, 0.f}; a1 = a0; a2 = a0; a3 = a0;
            }
        }
#undef P5B_LOAD
    }
}

__device__ __forceinline__ void phase5c(const Params& p, LAS unsigned char* lds) {
    const int tid = threadIdx.x, lane = tid & 63, wave = __builtin_amdgcn_readfirstlane(tid >> 6);
    const float* OUTS = (const float*)(p.ws + OFF_OUTS); const float* fw = p.in[20];
    for (int it = blockIdx.x; it < NTOK / 32; it += gridDim.x) {
        const int t0 = it * 32;
        __syncthreads();
#pragma unroll 4
        for (int i = 0; i < 16; ++i) {
            const int q = tid + NTHR * i, s = q >> 6, tt = (q >> 1) & 31, hf = q & 1;
            *(LAS f32x4*)(lds + tt * 4112 + (s * 8 + hf * 4) * 4) = *(const f32x4*)(OUTS + ((size_t)s * NTOK + t0 + tt) * 8 + hf * 4);
        }
        __syncthreads();
        for (int i = 0; i < 4; ++i) {
            const int tt = wave * 4 + i; float* orow = p.out + (size_t)(t0 + tt) * DM;
            f32x4 h[4]; float ss = 0.f;
#pragma unroll
            for (int j = 0; j < 4; ++j) { h[j] = *(const f32x4*)(orow + 4 * lane + 256 * j) + *(const LAS f32x4*)(lds + tt * 4112 + (4 * lane + 256 * j) * 4);
                ss += h[j].x * h[j].x + h[j].y * h[j].y + h[j].z * h[j].z + h[j].w * h[j].w; }
            const float rs = rsqrtf(wave_sum(ss) * (1.f / DM) + EPS);
#pragma unroll
            for (int j = 0; j < 4; ++j) *(f32x4*)(orow + 4 * lane + 256 * j) = h[j] * rs * *(const f32x4*)(fw + 4 * lane + 256 * j);
        }
    }
}


#define XB_TMO      128
#define XB_XCNT(j)  (256  + 64 * (j))
#define XB_XSUB(j)  (1280 + 64 * (j))
#define XB_XGEN(j)  (2304 + 64 * (j))
#define XB_TOP      3328
#define XB_TOPGEN   3392
#define XCD_BAR_WORDS 3456
#define XB_SPIN_CAP (1u << 18)
__device__ __forceinline__ unsigned xb_ld(unsigned* p)              { return __hip_atomic_load(p, __ATOMIC_RELAXED, __HIP_MEMORY_SCOPE_AGENT); }
__device__ __forceinline__ unsigned xb_add(unsigned* p, unsigned v) { return __hip_atomic_fetch_add(p, v, __ATOMIC_RELAXED, __HIP_MEMORY_SCOPE_AGENT); }
__device__ __forceinline__ unsigned xb_xcc_id() { return (unsigned)__builtin_amdgcn_s_getreg((3 << 11) | 20) & 0xFu; }
#define XB_SPIN(cond, bar) do { unsigned _sp = 0; while (cond) { __builtin_amdgcn_s_sleep(1); \
    if ((++_sp & 255u) == 0u) { if (xb_ld(&(bar)[XB_TMO])) break; if (_sp > XB_SPIN_CAP) { atomicAdd(&(bar)[XB_TMO], 1u); break; } } } } while (0)
struct XcdBarrier { unsigned* bar; unsigned x; volatile LAS unsigned* st; };
__device__ __forceinline__ XcdBarrier xcd_barrier_post(unsigned* bar, volatile LAS unsigned* st) {
    XcdBarrier b; b.bar = bar; b.x = xb_xcc_id(); b.st = st;
    if (threadIdx.x == 0) (void)xb_add(&bar[XB_XCNT(b.x)], 1u);
    return b;
}
__device__ __forceinline__ void xcd_barrier_complete(unsigned* bar, unsigned x, unsigned& nloc, unsigned& nx) {
    const unsigned G = gridDim.x * gridDim.y * gridDim.z;
    unsigned sum, cnt, mine, sp = 0u;
    for (;;) {
        sum = 0u; cnt = 0u; mine = 0u;
#pragma unroll
        for (unsigned j = 0; j < 16; ++j) { const unsigned c = xb_ld(&bar[XB_XCNT(j)]); sum += c; cnt += (c > 0u) ? 1u : 0u; mine = (j == x) ? c : mine; }
        if (sum == G) break;
        __builtin_amdgcn_s_sleep(1);
        if ((++sp & 255u) == 0u) { if (xb_ld(&bar[XB_TMO])) break; if (sp > XB_SPIN_CAP) { atomicAdd(&bar[XB_TMO], 1u); break; } }
    }
    nloc = mine > 0u ? mine : 1u; nx = cnt > 0u ? cnt : 1u;
}
__device__ __forceinline__ void xcd_barrier(const XcdBarrier& b) {
    asm volatile("s_waitcnt vmcnt(0)" ::: "memory");
    __syncthreads();
    if (threadIdx.x == 0) {
        unsigned* bar = b.bar;
        __builtin_amdgcn_s_waitcnt(0);
        unsigned nloc = b.st[0], nx = b.st[1];
        if (nloc == 0u) { xcd_barrier_complete(bar, b.x, nloc, nx); b.st[0] = nloc; b.st[1] = nx; }
        const unsigned old = xb_add(&bar[XB_XSUB(b.x)], 1u);
        const unsigned gen = old / nloc;
        if (old + 1u == (gen + 1u) * nloc) {
            __builtin_amdgcn_fence(__ATOMIC_RELEASE, "agent");
            asm volatile("s_waitcnt vmcnt(0)" ::: "memory");
            const unsigned og = xb_add(&bar[XB_TOP], 1u);
            const unsigned tg = og / nx;
            if (og + 1u == (tg + 1u) * nx) xb_add(&bar[XB_TOPGEN], 1u);
            else XB_SPIN(xb_ld(&bar[XB_TOPGEN]) == tg, bar);
            __builtin_amdgcn_fence(__ATOMIC_ACQUIRE, "agent");
            xb_add(&bar[XB_XGEN(b.x)], 1u);
            asm volatile("s_waitcnt vmcnt(0)" ::: "memory");
        } else {
            XB_SPIN(xb_ld(&bar[XB_XGEN(b.x)]) == gen, bar);
            __builtin_amdgcn_fence(__ATOMIC_ACQUIRE, "agent");
            asm volatile("s_waitcnt vmcnt(0)" ::: "memory");
        }
    }
    __syncthreads();
}

constexpr int NPHASE = 9;
__global__ void __launch_bounds__(NTHR, 2) mega(Params p) {
    extern __shared__ __attribute__((aligned(16))) unsigned char lds[];
    cg::grid_group grid = cg::this_grid();
#define PH_ON(k) (p.ph_lo <= (k) && (k) < p.ph_hi)
    if (threadIdx.x < 2) ((LAS unsigned*)((LAS unsigned char*)lds + LDS_BYTES - 32))[threadIdx.x] = 0u;
    __syncthreads();
    const XcdBarrier xbar = xcd_barrier_post((unsigned*)(p.ws + OFF_CTL) + 8192, (volatile LAS unsigned*)((LAS unsigned char*)lds + LDS_BYTES - 32));
#define PH_SYNC(k) do { if (PH_ON(k) && PH_ON((k) + 1)) { xcd_barrier(xbar); } } while (0)
    if (PH_ON(0)) phase0(p, lds);
    PH_SYNC(0);
    if (PH_ON(1)) phase1_mfma(p, (LAS unsigned char*)lds);
#if PROBE_DUP == 1
    grid.sync(); phase1_mfma(p, (LAS unsigned char*)lds);
#endif
    PH_SYNC(1);
    if (PH_ON(2)) phase2(p, (LAS unsigned char*)lds);
#if PROBE_DUP == 2
    grid.sync(); phase2(p, (LAS unsigned char*)lds, 1);
#endif
#if PROBE_DUP == 21
    grid.sync(); phase2(p, (LAS unsigned char*)lds, 2);
#endif
#if PROBE_DUP == 22
    grid.sync(); phase2(p, (LAS unsigned char*)lds, 3);
#endif
    PH_SYNC(2);
    if (PH_ON(3)) phase2c(p);
    PH_SYNC(3);
    if (PH_ON(4)) phase3_mfma(p, (LAS unsigned char*)lds);
#if PROBE_DUP == 4
    grid.sync(); phase3_mfma(p, (LAS unsigned char*)lds);
#endif
    PH_SYNC(4);
    if (PH_ON(5)) { phase4_mfma(p, (LAS unsigned char*)lds); quantize_hn(p); }
#if PROBE_DUP == 5
    grid.sync(); phase4_mfma(p, (LAS unsigned char*)lds);
#endif
    PH_SYNC(5);
    if (PH_ON(6)) phase5a(p, (LAS unsigned char*)lds);
#if PROBE_DUP == 6
    grid.sync(); phase5a(p, (LAS unsigned char*)lds, 1024);
#endif
    PH_SYNC(6);
    if (PH_ON(7)) phase5b(p, (LAS unsigned char*)lds);
#if PROBE_DUP == 7
    grid.sync(); phase5b(p, (LAS unsigned char*)lds);
#endif
    PH_SYNC(7);
    if (PH_ON(8)) phase5c(p, (LAS unsigned char*)lds);
}

extern "C" void kernel_launch(void* const* d_in, const int* in_sizes, int n_in, void* d_out, int out_size, void* d_ws, size_t ws_size, hipStream_t stream) {
    static int grid = 0;
    if (grid == 0) {
        if (n_in != 21 || out_size != NTOK * DM || ws_size < WS_END) { fprintf(stderr, "kernel_launch: unexpected shapes (n_in %d out %d ws %zu)\n", n_in, out_size, ws_size); grid = -1; return; }
        int dev = 0, cus = 0, per_cu = 0;
        hipGetDevice(&dev);
        hipDeviceGetAttribute(&cus, hipDeviceAttributeMultiprocessorCount, dev);
        hipFuncSetAttribute((const void*)mega, hipFuncAttributeMaxDynamicSharedMemorySize, LDS_BYTES);
        hipOccupancyMaxActiveBlocksPerMultiprocessor(&per_cu, (const void*)mega, NTHR, LDS_BYTES);
        if (per_cu < 1) { fprintf(stderr, "kernel_launch: occupancy query says %d blocks/CU\n", per_cu); per_cu = 1; }
        grid = cus * 1;
        (void)hipGetLastError();
    }
    if (grid < 0) return;
    hipMemsetAsync((char*)d_ws + OFF_CTL, 0, CTL_BYTES, stream);
    Params p{};
    for (int i = 0; i < 21; ++i) p.in[i] = (const float*)d_in[i];
    p.out = (float*)d_out; p.ws = (unsigned char*)d_ws; p.ph_lo = 0; p.ph_hi = NPHASE;
    void* args[] = {&p};
    hipError_t e = hipLaunchCooperativeKernel((const void*)mega, dim3(grid), dim3(NTHR), args, LDS_BYTES, stream);
    if (e != hipSuccess) fprintf(stderr, "cooperative launch failed: %s (grid %d)\n", hipGetErrorString(e), grid);
}
```

```cpp
#include <hip/hip_runtime.h>
#include <hip/hip_cooperative_groups.h>
#include <cstdio>
#include <cstdint>
namespace cg = cooperative_groups;

constexpr int DM = 1024;
constexpr int NB = 8, SEQ = 2048, NMETA = 16;
constexpr int NTOK = NB * SEQ;
constexpr int MROWS = 16640;
constexpr int NIN = 3584;
constexpr int TPOS = NMETA + SEQ;
constexpr float EPS = 1e-6f;
constexpr float QSCALE = 0.125f * 1.4426950408889634f;
constexpr int NEXP = 16384;
constexpr int NTHR = 512;
#ifndef PROBE_DUP
#define PROBE_DUP 0
#endif

constexpr size_t MiB = 1u << 20;
constexpr size_t OFF_CTL = 0, CTL_BYTES = 64 * 1024;
constexpr size_t OFF_MISC = 512 * 1024;
constexpr size_t OFF_ROPE = 1 * MiB;
constexpr size_t OFF_WOUT = 2 * MiB;
constexpr size_t OFF_WQ = 4 * MiB;
constexpr size_t OFF_KEYS = 8 * MiB;
constexpr size_t OFF_SSQP = 25 * MiB;
constexpr size_t OFF_UB = 9 * MiB;
constexpr size_t OFF_VB = 41 * MiB;
constexpr size_t OFF_XN = 73 * MiB;
constexpr size_t OFF_MIX = 73 * MiB;
constexpr size_t OFF_WIN = 106 * MiB;
constexpr size_t OFF_QB = 113 * MiB;
constexpr size_t OFF_KB = OFF_QB + 16 * MiB + 256 * 1024;
constexpr size_t OFF_VT = OFF_KB + 16 * MiB + 256 * 1024;
constexpr size_t OFF_H2B = 113 * MiB;
constexpr size_t OFF_GQ = 162 * MiB;
constexpr size_t OFF_GK = OFF_GQ + 8 * MiB + 256 * 1024;
constexpr size_t OFF_GVT = OFF_GK + 8 * MiB + 256 * 1024;
constexpr size_t OFF_GF = OFF_GVT + 16 * MiB + 256 * 1024;
constexpr size_t OFF_GB = OFF_GF + 16 * MiB + 256 * 1024;
constexpr size_t OFF_GR = OFF_GB + 16 * MiB + 256 * 1024;
constexpr size_t OFF_PW0 = 162 * MiB;
constexpr size_t OFF_USC = 64 * 1024;
constexpr size_t OFF_VSC = 128 * 1024;
constexpr size_t WS_END = OFF_GR + 16 * MiB + 256 * 1024;
static_assert(WS_END <= 256 * MiB, "workspace map");
static_assert(OFF_VT + (size_t)512 * MROWS * 2 <= OFF_GQ, "map D");
static_assert(OFF_WIN + (size_t)NIN * DM * 2 <= OFF_QB, "map C");

constexpr int LDS_BYTES = 163840;

typedef unsigned short bf16_t;
typedef float f32x4 __attribute__((ext_vector_type(4)));
typedef float f32x2 __attribute__((ext_vector_type(2)));
typedef unsigned u32x4 __attribute__((ext_vector_type(4)));
typedef unsigned u32x2 __attribute__((ext_vector_type(2)));
typedef __bf16 bf16x2_t __attribute__((ext_vector_type(2)));

struct Params {
    const float* in[21];
    float* out;
    unsigned char* ws;
    int ph_lo, ph_hi;
};

__device__ __forceinline__ unsigned f2bf(float f) { unsigned u = __float_as_uint(f); return (u + 0x7fffu + ((u >> 16) & 1u)) >> 16; }
__device__ __forceinline__ float bf2f(unsigned h) { return __uint_as_float(h << 16); }
__device__ __forceinline__ unsigned pk2(float lo, float hi) { return __builtin_bit_cast(unsigned, __builtin_convertvector((f32x2){lo, hi}, bf16x2_t)); }
__device__ __forceinline__ float bflo(unsigned w) { return __uint_as_float(w << 16); }
__device__ __forceinline__ float bfhi(unsigned w) { return __uint_as_float(w & 0xffff0000u); }
__device__ __forceinline__ float dot2(unsigned a, unsigned b, float c) {
    return __builtin_amdgcn_fdot2_f32_bf16(__builtin_bit_cast(bf16x2_t, a), __builtin_bit_cast(bf16x2_t, b), c, false);
}
__device__ __forceinline__ float dot8(u32x4 a, u32x4 b, float c) { c = dot2(a.x, b.x, c); c = dot2(a.y, b.y, c); c = dot2(a.z, b.z, c); return dot2(a.w, b.w, c); }
__device__ __forceinline__ float wave_sum(float v) {
#pragma unroll
    for (int o = 1; o < 64; o <<= 1) v += __shfl_xor(v, o);
    return v;
}
__device__ __forceinline__ float wave_max(float v) {
#pragma unroll
    for (int o = 1; o < 64; o <<= 1) v = fmaxf(v, __shfl_xor(v, o));
    return v;
}
__device__ __forceinline__ float silu_f(float x) { return x / (1.f + __expf(-x)); }
__device__ __forceinline__ float logsig_f(float x) { return fminf(x, 0.f) - log1pf(__expf(-fabsf(x))); }
__device__ __forceinline__ float gelu_f(float v) {
    const float av = fabsf(v), t = __builtin_amdgcn_rcpf(av * 0.2316418882f + 1.0f);
    float q = t * 0.5307027145f + (-0.7265760135f); q = q * t + 0.7107068705f; q = q * t + (-0.142248368f); q = q * t + 0.127414796f; q = q * t;
    const float m = v * (q * __builtin_amdgcn_exp2f(v * v * (-0.72134752044f)));
    return v < 0.f ? m : v - m;
}

__device__ __forceinline__ float win_src(const Params& p, int k, int n) {
    const float* W = p.in[3] + (size_t)k * 3104;
    if (n < 1024) {
        const int base = n & ~63, dp = n & 63, d = dp < 16 ? ((dp >> 1) + 8 * (dp & 1)) : dp;
        return W[base + d];
    } else if (n < 3072) return W[n];
    const int j = (n - 3072) & 255, dir = (n - 3072) >> 8;
    const float* w2 = p.in[dir ? 11 : 9];
    const float* wz = W + 3072 + dir * 16;
    float s = 0.f;
#pragma unroll
    for (int r = 0; r < 16; ++r) s += wz[r] * w2[r * 256 + j];
    return s;
}

template <int WHICH>
__device__ __forceinline__ void p0_transpose_item(const Params& p, float* scr, int item, int lane) {
    constexpr int N = WHICH == 0 ? NIN : (WHICH == 1 ? 1024 : 2048);
    constexpr int nblk = N / 32;
    const int kb = item / nblk, nb = item % nblk, k0 = 64 * kb, n0 = 32 * nb;
    bf16_t* WT = (bf16_t*)(p.ws + (WHICH == 0 ? OFF_WIN : (WHICH == 1 ? OFF_WOUT : OFF_WQ)));
#pragma unroll 4
    for (int i = 0; i < 32; ++i) {
        const int kk = 2 * i + (lane >> 5), k = k0 + kk, n = n0 + (lane & 31);
        float v;
        if (WHICH == 0) v = win_src(p, k, n);
        else if (WHICH == 1) v = p.in[14][(size_t)k * 1024 + n];
        else v = p.in[16][(size_t)k * 2048 + n] * p.in[15][k];
        scr[kk * 33 + (lane & 31)] = v;
    }
    __builtin_amdgcn_s_waitcnt(0xC07F); __builtin_amdgcn_wave_barrier();
    const int c = lane & 7;
#pragma unroll
    for (int j = 0; j < 4; ++j) {
        const int n = (lane >> 3) + 8 * j; const float* s = scr + (8 * c) * 33 + n;
        u32x4 o; o.x = pk2(s[0 * 33], s[1 * 33]); o.y = pk2(s[2 * 33], s[3 * 33]); o.z = pk2(s[4 * 33], s[5 * 33]); o.w = pk2(s[6 * 33], s[7 * 33]);
        *(u32x4*)(WT + (size_t)(n0 + n) * 1024 + k0 + 8 * c) = o;
    }
    __builtin_amdgcn_s_waitcnt(0xC07F); __builtin_amdgcn_wave_barrier();
}

__device__ __forceinline__ void phase0(const Params& p, unsigned char* lds) {
    const int tid = threadIdx.x, lane = tid & 63, wave = tid >> 6;
    const int gw = blockIdx.x * 8 + wave, NGW = gridDim.x * 8;
    const long gt = (long)blockIdx.x * NTHR + tid, NGT = (long)gridDim.x * NTHR;
    {
        const f32x4* lw = (const f32x4*)p.in[2];
        bf16_t* XN = (bf16_t*)(p.ws + OFF_XN);
        for (int r = gw; r < MROWS; r += NGW) {
            const float* src = r < NTOK ? p.in[0] + (size_t)r * DM : (r < NTOK + NMETA ? p.in[1] + (size_t)(r - NTOK) * DM : nullptr);
            f32x4 v[4]; float s = 0.f;
#pragma unroll
            for (int j = 0; j < 4; ++j) { v[j] = src ? ((const f32x4*)src)[lane + 64 * j] : (f32x4){0.f, 0.f, 0.f, 0.f}; s += v[j].x * v[j].x + v[j].y * v[j].y + v[j].z * v[j].z + v[j].w * v[j].w; }
            const float rs = rsqrtf(wave_sum(s) * (1.f / DM) + EPS);
#pragma unroll
            for (int j = 0; j < 4; ++j) { const f32x4 w = lw[lane + 64 * j]; u32x2 o; o.x = pk2(v[j].x * rs * w.x, v[j].y * rs * w.y); o.y = pk2(v[j].z * rs * w.z, v[j].w * rs * w.w);
                *(u32x2*)(XN + (size_t)r * DM + 4 * (lane + 64 * j)) = o; }
        }
    }
    {
        float* scr = (float*)lds + wave * (64 * 33);
        constexpr int I0 = 16 * (NIN / 32);
        for (int it = gw; it < I0; it += NGW) p0_transpose_item<0>(p, scr, it, lane);
    }
    {
        f32x2* rope = (f32x2*)(p.ws + OFF_ROPE);
        for (long i = gt; i < TPOS * 8; i += NGT) {
            const int t = (int)(i >> 3), j = (int)(i & 7);
            const float inv = powf(500000.0f, -(float)j * 0.125f);
            const float ang = (float)t * inv;
            rope[i] = (f32x2){cosf(ang), sinf(ang)};
        }
        if (gt == 0) {
            float a = 0.f, b = 0.f;
            for (int i = 0; i < 64; ++i) { a += p.in[4][i] * p.in[5][i]; b += p.in[6][i] * p.in[7][i]; }
            ((float*)(p.ws + OFF_MISC))[0] = expf(a) - expf(b) + 0.2f;
        }
    }
}
constexpr int CV_WOUT = 64, CV_WQ = 128, CV_KEYS = 8, CV_U = 256, CV_V = 256, CV_ITEMS = CV_WOUT + CV_WQ + CV_KEYS + CV_U + CV_V;
__device__ __forceinline__ void conv_item(const Params& p, unsigned char* lds, int c) {
    const int tid = threadIdx.x, lane = tid & 63, wave = tid >> 6;
    __syncthreads();
    if (c < CV_WOUT) { p0_transpose_item<1>(p, (float*)lds + wave * (64 * 33), c * 8 + wave, lane); return; }
    c -= CV_WOUT;
    if (c < CV_WQ) { p0_transpose_item<2>(p, (float*)lds + wave * (64 * 33), c * 8 + wave, lane); return; }
    c -= CV_WQ;
    if (c < CV_KEYS) {
        bf16_t* KEYS = (bf16_t*)(p.ws + OFF_KEYS);
#pragma unroll 2
        for (int j = 0; j < 8; ++j) {
            const long e = ((long)c * 4096 + tid + NTHR * j) * 8;
            const f32x4 a = *(const f32x4*)(p.in[17] + e), b = *(const f32x4*)(p.in[17] + e + 4);
            u32x4 o; o.x = pk2(a.x, a.y); o.y = pk2(a.z, a.w); o.z = pk2(b.x, b.y); o.w = pk2(b.z, b.w);
            *(u32x4*)(KEYS + e) = o;
        }
        return;
    }
    c -= CV_KEYS;
    if (c < CV_U) {
        unsigned char* UQ = p.ws + OFF_UB; float* USC = (float*)(p.ws + OFF_USC);
#pragma unroll 2
        for (int i = 0; i < 8; ++i) {
            const int r = c * 64 + wave * 8 + i;
            const float* ur = p.in[18] + (size_t)r * DM + 16 * lane; const float* lw = p.in[15] + 16 * lane;
            f32x4 v[4]; float am = 0.f;
#pragma unroll
            for (int j = 0; j < 4; ++j) { v[j] = ((const f32x4*)ur)[j] * ((const f32x4*)lw)[j]; am = fmaxf(am, fmaxf(fmaxf(fabsf(v[j].x), fabsf(v[j].y)), fmaxf(fabsf(v[j].z), fabsf(v[j].w)))); }
            am = fmaxf(wave_max(am), 1e-30f);
            const float sc = 224.f / am;
            u32x4 o;
#pragma unroll
            for (int j = 0; j < 4; ++j) { int w = __builtin_amdgcn_cvt_pk_fp8_f32(v[j].x * sc, v[j].y * sc, 0, false); w = __builtin_amdgcn_cvt_pk_fp8_f32(v[j].z * sc, v[j].w * sc, w, true); o[j] = (unsigned)w; }
            *(u32x4*)(UQ + (size_t)r * DM + 16 * lane) = o;
            if (lane == 0) USC[r] = am * (1.f / 224.f);
        }
        return;
    }
    c -= CV_U;
    {
        unsigned char* VS = p.ws + OFF_VB; float* VSC = (float*)(p.ws + OFF_VSC);
        const int tile = c;
#pragma unroll 2
        for (int i = 0; i < 8; ++i) {
            const int er = wave * 8 + i, r = tile * 64 + er;
            const float* vr = p.in[19] + (size_t)r * DM + 16 * lane;
            f32x4 v[4]; float am = 0.f;
#pragma unroll
            for (int j = 0; j < 4; ++j) { v[j] = ((const f32x4*)vr)[j]; am = fmaxf(am, fmaxf(fmaxf(fabsf(v[j].x), fabsf(v[j].y)), fmaxf(fabsf(v[j].z), fabsf(v[j].w)))); }
            am = fmaxf(wave_max(am), 1e-30f);
            const float sc = 224.f / am;
            u32x4 o;
#pragma unroll
            for (int j = 0; j < 4; ++j) { int w = __builtin_amdgcn_cvt_pk_fp8_f32(v[j].x * sc, v[j].y * sc, 0, false); w = __builtin_amdgcn_cvt_pk_fp8_f32(v[j].z * sc, v[j].w * sc, w, true); o[j] = (unsigned)w; }
            *(u32x2*)(lds + er * 1032 + 16 * lane) = (u32x2){o.x, o.y}; *(u32x2*)(lds + er * 1032 + 16 * lane + 8) = (u32x2){o.z, o.w};
            if (lane == 0) VSC[r] = am * (1.f / 224.f);
        }
        __syncthreads();
#pragma unroll 4
        for (int i = 0; i < 16; ++i) {
            const int s = wave + 8 * i;
            *(u32x2*)(VS + ((size_t)s * NEXP + tile * 64 + lane) * 8) = *(const u32x2*)(lds + lane * 1032 + s * 8);
        }
    }
}

struct P1Ptrs { unsigned char* ws; const float* bias_f; const float* bias_b; };
__device__ __forceinline__ void p1_store(const P1Ptrs p, int row, int n0, float v0, float v1, float v2, float v3) {
    if (n0 < 1024) {
        const int dp = n0 & 63;
        if (dp < 16) {
            const int pos = row < NTOK ? NMETA + (row & (SEQ - 1)) : (row - NTOK);
            const f32x4 cs = *(const f32x4*)((const float*)(p.ws + OFF_ROPE) + ((size_t)pos * 8 + (dp >> 1)) * 2);
            const float a0 = v0 * cs.x - v1 * cs.y, b0 = v1 * cs.x + v0 * cs.y;
            const float a1 = v2 * cs.z - v3 * cs.w, b1 = v3 * cs.z + v2 * cs.w;
            v0 = a0; v1 = b0; v2 = a1; v3 = b1;
        }
        if (n0 < 512) { u32x2 o; o.x = pk2(v0 * QSCALE, v1 * QSCALE); o.y = pk2(v2 * QSCALE, v3 * QSCALE); *(u32x2*)((bf16_t*)(p.ws + OFF_QB) + (size_t)row * 512 + n0) = o; }
        else { u32x2 o; o.x = pk2(v0, v1); o.y = pk2(v2, v3); *(u32x2*)((bf16_t*)(p.ws + OFF_KB) + (size_t)row * 512 + (n0 - 512)) = o; }
    } else if (n0 < 1536) {
        bf16_t* VT = (bf16_t*)(p.ws + OFF_VT) + (size_t)(n0 - 1024) * MROWS + row;
        VT[0] = (bf16_t)f2bf(v0); VT[MROWS] = (bf16_t)f2bf(v1); VT[2 * MROWS] = (bf16_t)f2bf(v2); VT[3 * (size_t)MROWS] = (bf16_t)f2bf(v3);
    } else if (n0 < 1792) {
        u32x2 o; o.x = pk2(v0 * 0.125f, v1 * 0.125f); o.y = pk2(v2 * 0.125f, v3 * 0.125f); *(u32x2*)((bf16_t*)(p.ws + OFF_GQ) + (size_t)row * 256 + (n0 - 1536)) = o;
    } else if (n0 < 2048) {
        u32x2 o; o.x = pk2(v0, v1); o.y = pk2(v2, v3); *(u32x2*)((bf16_t*)(p.ws + OFF_GK) + (size_t)row * 256 + (n0 - 1792)) = o;
    } else if (n0 < 2560) {
        bf16_t* VT = (bf16_t*)(p.ws + OFF_GVT) + (size_t)(n0 - 2048) * MROWS + row;
        VT[0] = (bf16_t)f2bf(v0); VT[MROWS] = (bf16_t)f2bf(v1); VT[2 * MROWS] = (bf16_t)f2bf(v2); VT[3 * (size_t)MROWS] = (bf16_t)f2bf(v3);
    } else if (n0 < 3072) {
        u32x2 o; o.x = pk2(silu_f(v0), silu_f(v1)); o.y = pk2(silu_f(v2), silu_f(v3)); *(u32x2*)((bf16_t*)(p.ws + OFF_GR) + (size_t)row * 512 + (n0 - 2560)) = o;
    } else {
        const int dir = (n0 - 3072) >> 8, j = (n0 - 3072) & 255;
        const f32x4 bb = *(const f32x4*)((dir ? p.bias_b : p.bias_f) + j);
        f32x4 o; o.x = logsig_f(v0 + bb.x) * 0.0625f; o.y = logsig_f(v1 + bb.y) * 0.0625f; o.z = logsig_f(v2 + bb.z) * 0.0625f; o.w = logsig_f(v3 + bb.w) * 0.0625f;
        *(f32x4*)((float*)(p.ws + (dir ? OFF_GB : OFF_GF)) + (size_t)row * 256 + j) = o;
    }
}


#define LAS __attribute__((address_space(3)))
typedef short bf16x8 __attribute__((ext_vector_type(8)));
constexpr int GBUF = 49152;

template <int ROWS>
__device__ __forceinline__ void stage_tile(const bf16_t* G, int ldk, int r0, int k0, LAS unsigned char* buf, int wave, int lane) {
    const int rr = lane >> 3, c = (lane & 7) ^ rr;
#pragma unroll
    for (int i = 0; i < ROWS / 64; ++i) {
        const int grp = wave + 8 * i;
        const bf16_t* src = G + (size_t)(r0 + grp * 8 + rr) * ldk + k0 + c * 8;
        __builtin_amdgcn_global_load_lds((const unsigned*)src, (LAS unsigned*)(buf + grp * 1024), 16, 0, 0);
    }
}
__device__ __forceinline__ bf16x8 ldfrag(const LAS unsigned char* buf, int row, int c) {
    return *(const LAS bf16x8*)(buf + row * 128 + ((c ^ (row & 7)) << 4));
}
template <bool SWAP>
__device__ __forceinline__ void gemm_tile_256(const bf16_t* A, const bf16_t* Bt, int K, int m0, int n0, LAS unsigned char* lds, f32x4 (&acc)[4][4]) {
    const int tid = threadIdx.x, lane = tid & 63, wave = __builtin_amdgcn_readfirstlane(tid >> 6), wm = wave >> 2, wn = wave & 3, l15 = lane & 15, g = lane >> 4;
#pragma unroll
    for (int i = 0; i < 4; ++i)
#pragma unroll
        for (int j = 0; j < 4; ++j) acc[i][j] = (f32x4){0.f, 0.f, 0.f, 0.f};
    const int nk = K / 64;
    stage_tile<128>(A, K, m0, 0, lds, wave, lane);
    stage_tile<256>(Bt, K, n0, 0, lds + 16384, wave, lane);
    for (int kt = 0; kt < nk; ++kt) {
        asm volatile("s_waitcnt vmcnt(0)" ::: "memory");
        __syncthreads();
        if (kt + 1 < nk) {
            LAS unsigned char* nb = lds + ((kt + 1) & 1) * GBUF;
            stage_tile<128>(A, K, m0, (kt + 1) * 64, nb, wave, lane);
            stage_tile<256>(Bt, K, n0, (kt + 1) * 64, nb + 16384, wave, lane);
        }
        const LAS unsigned char* a = lds + (kt & 1) * GBUF; const LAS unsigned char* b = a + 16384;
#pragma unroll
        for (int ks = 0; ks < 2; ++ks) {
            bf16x8 af[4], bfr[4];
#pragma unroll
            for (int i = 0; i < 4; ++i) { af[i] = ldfrag(a, wm * 64 + i * 16 + l15, ks * 4 + g); bfr[i] = ldfrag(b, wn * 64 + i * 16 + l15, ks * 4 + g); }
#pragma unroll
            for (int i = 0; i < 4; ++i)
#pragma unroll
                for (int j = 0; j < 4; ++j)
                    acc[i][j] = SWAP ? __builtin_amdgcn_mfma_f32_16x16x32_bf16(af[i], bfr[j], acc[i][j], 0, 0, 0)
                                     : __builtin_amdgcn_mfma_f32_16x16x32_bf16(bfr[j], af[i], acc[i][j], 0, 0, 0);
        }
    }
}
__device__ __forceinline__ int vcu_of_block() { const int G = gridDim.x, bx = blockIdx.x; return (G % 8 == 0) ? (bx % 8) * (G / 8) + bx / 8 : bx; }

namespace pg8 {
#define PG8_LAS __attribute__((address_space(3)))
typedef unsigned short bf16_t;
typedef short bf16x8 __attribute__((ext_vector_type(8)));
typedef float f32x4 __attribute__((ext_vector_type(4)));
typedef unsigned u32x4 __attribute__((ext_vector_type(4)));
constexpr int BM = 256, BK = 64, HALF = 128, HTB = HALF * BK * 2  , STAGE_BYTES = 8 * HTB, NXCD = 8, WGM = 8;

__host__ __device__ __forceinline__ int lds_byte(int r, int c) { const int st = (r >> 4) * 2 + (c >> 5), rr = r & 15, cc = c & 31, ob = rr * 64 + cc * 2; return st * 1024 + (ob ^ (((ob >> 9) & 1) << 5)); }
__host__ __device__ __forceinline__ void stage_rc(int b, int& R, int& C) { const int st = b / 1024, sb = b % 1024, swz = sb ^ (((sb >> 9) & 1) << 5); R = (st >> 1) * 16 + swz / 64; C = (st & 1) * 32 + (swz % 64) / 2; }
__host__ __device__ __forceinline__ int perm32(int rho) { const int n = rho >> 4, i = rho & 15; return 8 * (i >> 2) + 4 * n + (i & 3); }

struct Unit { int pm, pn; };
struct Gemm { const bf16_t* A; const bf16_t* Bt; int M, N, K; };

struct StaticOrder {
    int nM, nN, nwg, G, c;
    __host__ __device__ void init(int M, int N, int G_, int c_) { nM = M / BM; nN = N / BM; nwg = nM * nN; G = G_; c = c_; }
    __host__ __device__ bool next(int i, Unit& u) const {
        const long L = (long)i * G + c; if (L >= nwg) return false;
        int wgid = (int)L; { const int q = nwg / NXCD, r = nwg % NXCD, xcd = wgid % NXCD, off = wgid / NXCD; wgid = (xcd < r ? xcd * (q + 1) : r * (q + 1) + (xcd - r) * q) + off; }
        const int nig = WGM * nN, gid = wgid / nig, fm = gid * WGM, gsz = (nM - fm) < WGM ? (nM - fm) : WGM;
        u.pm = fm + ((wgid % nig) % gsz); u.pn = (wgid % nig) / gsz; return true;
    }
    __device__ __forceinline__ void a_ready(const Unit&) const {}
    __device__ __forceinline__ void done(const Unit&) const {}
};

struct EpiP1 {
    static constexpr bool PERM = false, AFTER_DRAIN = false;
    P1Ptrs p;
    __device__ __forceinline__ void operator()(const f32x4 (&acc)[2][2][4][2], const Unit& u, int wr, int wc, int fr, int fq) const {
#pragma unroll
        for (int bj = 0; bj < 2; ++bj) {
            const int nw = u.pn * BM + bj * HALF + wc * 32;
            const int rowb = u.pm * BM + wr * 64 + fr;
            if (nw >= 3072) {
                const int dir = (nw - 3072) >> 8, j0 = ((nw - 3072) & 255) + 4 * fq;
                float* G = (float*)(p.ws + (dir ? OFF_GB : OFF_GF)); const float* bias = dir ? p.bias_b : p.bias_f;
#pragma unroll
                for (int n = 0; n < 2; ++n) { const f32x4 bb = *(const f32x4*)(bias + j0 + 16 * n);
#pragma unroll
                    for (int ai = 0; ai < 2; ++ai)
#pragma unroll
                        for (int m = 0; m < 4; ++m) { const f32x4 v = acc[ai][bj][m][n]; f32x4 o;
                            o.x = logsig_f(v.x + bb.x) * 0.0625f; o.y = logsig_f(v.y + bb.y) * 0.0625f; o.z = logsig_f(v.z + bb.z) * 0.0625f; o.w = logsig_f(v.w + bb.w) * 0.0625f;
                            *(f32x4*)(G + (size_t)(rowb + ai * HALF + m * 16) * 256 + j0 + 16 * n) = o; } }
            } else if ((nw >= 1024 && nw < 1536) || (nw >= 2048 && nw < 2560)) {
                bf16_t* T = (bf16_t*)(p.ws + (nw < 1536 ? OFF_VT : OFF_GVT)) + (size_t)((nw < 1536 ? nw - 1024 : nw - 2048) + 4 * fq) * MROWS + rowb;
#pragma unroll
                for (int n = 0; n < 2; ++n)
#pragma unroll
                    for (int ai = 0; ai < 2; ++ai)
#pragma unroll
                        for (int m = 0; m < 4; ++m) { const f32x4 v = acc[ai][bj][m][n]; bf16_t* t = T + (size_t)(16 * n) * MROWS + ai * HALF + m * 16;
                            t[0] = (bf16_t)f2bf(v.x); t[MROWS] = (bf16_t)f2bf(v.y); t[2 * MROWS] = (bf16_t)f2bf(v.z); t[3 * (size_t)MROWS] = (bf16_t)f2bf(v.w); }
            } else {
                bf16_t* base; int ld, c0; float sc = 1.f; bool silu = false;
                if (nw < 512) { base = (bf16_t*)(p.ws + OFF_QB); ld = 512; c0 = nw; sc = QSCALE; }
                else if (nw < 1024) { base = (bf16_t*)(p.ws + OFF_KB); ld = 512; c0 = nw - 512; }
                else if (nw < 1792) { base = (bf16_t*)(p.ws + OFF_GQ); ld = 256; c0 = nw - 1536; sc = 0.125f; }
                else if (nw < 2048) { base = (bf16_t*)(p.ws + OFF_GK); ld = 256; c0 = nw - 1792; }
                else { base = (bf16_t*)(p.ws + OFF_GR); ld = 512; c0 = nw - 2560; silu = true; }
                const bool rope = nw < 1024 && (nw & 63) == 0;
#pragma unroll
                for (int ai = 0; ai < 2; ++ai)
#pragma unroll
                    for (int m = 0; m < 4; ++m) {
                        const int row = rowb + ai * HALF + m * 16;
#pragma unroll
                        for (int n = 0; n < 2; ++n) {
                            f32x4 v = acc[ai][bj][m][n];
                            if (n == 0 && rope) {
                                const int pos = row < NTOK ? NMETA + (row & (SEQ - 1)) : (row - NTOK < TPOS ? row - NTOK : 0);
                                const f32x4 cs = *(const f32x4*)((const float*)(p.ws + OFF_ROPE) + ((size_t)pos * 8 + 2 * fq) * 2);
                                const float a0 = v.x * cs.x - v.y * cs.y, b0 = v.y * cs.x + v.x * cs.y, a1 = v.z * cs.z - v.w * cs.w, b1 = v.w * cs.z + v.z * cs.w;
                                v = (f32x4){a0, b0, a1, b1};
                            }
                            if (silu) v = (f32x4){silu_f(v.x), silu_f(v.y), silu_f(v.z), silu_f(v.w)}; else v = v * sc;
                            *(u32x2*)(base + (size_t)row * ld + c0 + 16 * n + 4 * fq) = (u32x2){pk2(v.x, v.y), pk2(v.z, v.w)};
                        }
                    }
            }
        }
    }
};
struct EpiP3 {
    static constexpr bool PERM = false, AFTER_DRAIN = false;
    const float* x; float* out; bf16_t* h2b; float* ssq;
    __device__ __forceinline__ void operator()(const f32x4 (&acc)[2][2][4][2], const Unit& u, int wr, int wc, int fr, int fq) const {
#pragma unroll
        for (int ai = 0; ai < 2; ++ai)
#pragma unroll
            for (int m = 0; m < 4; ++m) { const int row = u.pm * BM + ai * HALF + wr * 64 + m * 16 + fr; float ss = 0.f;
#pragma unroll
                for (int bj = 0; bj < 2; ++bj)
#pragma unroll
                    for (int n = 0; n < 2; ++n) { const int col = u.pn * BM + bj * HALF + wc * 32 + n * 16 + 4 * fq;
                        const f32x4 hv = *(const f32x4*)(x + (size_t)row * DM + col) + acc[ai][bj][m][n];
                        *(u32x2*)(h2b + (size_t)row * DM + col) = (u32x2){pk2(hv.x, hv.y), pk2(hv.z, hv.w)};
                        ss += hv.x * hv.x + hv.y * hv.y + hv.z * hv.z + hv.w * hv.w; }
                ss += __shfl_xor(ss, 16); ss += __shfl_xor(ss, 32);
                if (fq == 0) ssq[(size_t)row * 16 + u.pn * 4 + wc] = ss; }
    }
};
struct OneUnit {
    Unit u; bool valid;
    __device__ __forceinline__ bool next(int i, Unit& o) const { if (i != 0 || !valid) return false; o = u; return true; }
    __device__ __forceinline__ void a_ready(const Unit&) const {}
    __device__ __forceinline__ void done(const Unit&) const {}
};

template <class Epi, class Sched, bool ALIGN_EPI = false, bool SP2 = false>
__device__ __forceinline__ void gemm_phase(PG8_LAS unsigned char* lds, const Gemm g, const Sched& S, const Epi& E) {
    int tid_ = threadIdx.x; asm volatile("" : "+v"(tid_));
    const int tid = tid_, wid = __builtin_amdgcn_readfirstlane(tid >> 6), lane = tid & 63, wr = wid >> 2, wc = wid & 3, fr = lane & 15, fq = lane >> 4;
    const int K = g.K, nt = K / BK;
    unsigned voffA[2], voffB[2];
#pragma unroll
    for (int i = 0; i < 2; ++i) { int R, C; stage_rc(tid * 16 + i * 8192, R, C); const int Rb = Epi::PERM ? ((R & ~31) + perm32(R & 31)) : R;
        voffA[i] = (unsigned)(R * K + C) * 2u; voffB[i] = (unsigned)(Rb * K + C) * 2u; }
    const size_t kstep = (size_t)(BK * 2);
    const size_t hstep = (size_t)HALF * K * 2;
    const size_t tstep = 2 * hstep;
    const unsigned ldsw = (unsigned)wid * 1024u;
    const int aoff = lds_byte(wr * 64 + fr, fq * 8), boff = lds_byte(wc * 32 + fr, fq * 8);
#define PG8_SA(b, h) (((b) * 2 + (h)) * HTB)
#define PG8_SB(b, h) ((4 + (b) * 2 + (h)) * HTB)
#define PG8_STAGE(bufoff, gbase, voff) do { _Pragma("unroll") for (int _i = 0; _i < 2; ++_i) \
        __builtin_amdgcn_global_load_lds((const unsigned*)((const char*)(gbase) + (voff)[_i]), (PG8_LAS unsigned*)(lds + (bufoff) + ldsw + _i * 8192), 16, 0, 0); } while (0)
#define PG8_LDA(dst, b, h) do { _Pragma("unroll") for (int m = 0; m < 4; ++m) _Pragma("unroll") for (int k = 0; k < 2; ++k) dst[m][k] = *(const PG8_LAS bf16x8*)(lds + PG8_SA(b, h) + aoff + m * 2048 + k * 1024); } while (0)
#define PG8_LDB(dst, b, h) do { _Pragma("unroll") for (int n = 0; n < 2; ++n) _Pragma("unroll") for (int k = 0; k < 2; ++k) dst[n][k] = *(const PG8_LAS bf16x8*)(lds + PG8_SB(b, h) + boff + n * 2048 + k * 1024); } while (0)
#define PG8_MMA(ai, bj, At, Bt) do { __builtin_amdgcn_s_setprio(1); _Pragma("unroll") for (int m = 0; m < 4; ++m) _Pragma("unroll") for (int n = 0; n < 2; ++n) _Pragma("unroll") for (int k = 0; k < 2; ++k) \
        acc[ai][bj][m][n] = __builtin_amdgcn_mfma_f32_16x16x32_bf16(Bt[n][k], At[m][k], acc[ai][bj][m][n], 0, 0, 0); __builtin_amdgcn_s_setprio(0); } while (0)
#define PG8_WAIT_V(n) asm volatile("s_waitcnt vmcnt(" #n ")" ::: "memory")
#define PG8_WAIT_L(n) asm volatile("s_waitcnt lgkmcnt(" #n ")" ::: "memory")
#define PG8_BAR __builtin_amdgcn_s_barrier()
#define PG8_SCHED __builtin_amdgcn_sched_barrier(0)
    Unit cur, nxt; int ui = 0;
    if (!S.next(0, cur)) return;
    f32x4 acc[2][2][4][2];
#pragma unroll
    for (int a = 0; a < 2; ++a)
#pragma unroll
        for (int b = 0; b < 2; ++b)
#pragma unroll
            for (int m = 0; m < 4; ++m)
#pragma unroll
                for (int n = 0; n < 2; ++n) acc[a][b][m][n] = (f32x4){0.f, 0.f, 0.f, 0.f};
    bf16x8 At[4][2], B0[2][2], B1[2][2];
    const char* cA = (const char*)g.A + (size_t)cur.pm * tstep; const char* cB = (const char*)g.Bt + (size_t)cur.pn * tstep;
    S.a_ready(cur);
    if constexpr (SP2) {
        PG8_STAGE(PG8_SB(0, 0), cB, voffB); PG8_STAGE(PG8_SB(0, 1), cB + hstep, voffB); PG8_STAGE(PG8_SA(0, 0), cA, voffA); PG8_STAGE(PG8_SA(0, 1), cA + hstep, voffA);
        if (wr == 1) PG8_BAR;
        PG8_WAIT_V(2); PG8_BAR;
        PG8_STAGE(PG8_SB(1, 0), cB + kstep, voffB); PG8_STAGE(PG8_SA(1, 0), cA + kstep, voffA); PG8_STAGE(PG8_SB(1, 1), cB + hstep + kstep, voffB);
        PG8_WAIT_V(6); PG8_BAR;
    } else {
        PG8_STAGE(PG8_SB(0, 0), cB, voffB); PG8_STAGE(PG8_SA(0, 0), cA, voffA); PG8_STAGE(PG8_SB(0, 1), cB + hstep, voffB); PG8_STAGE(PG8_SA(0, 1), cA + hstep, voffA);
        if (wr == 1) PG8_BAR;
        PG8_WAIT_V(4); PG8_BAR;
        PG8_STAGE(PG8_SB(1, 0), cB + kstep, voffB); PG8_STAGE(PG8_SA(1, 0), cA + kstep, voffA); PG8_STAGE(PG8_SB(1, 1), cB + hstep + kstep, voffB);
        PG8_WAIT_V(6); PG8_BAR;
    }
    for (;;) {
        const bool has_next = S.next(ui + 1, nxt);
        const char* nA = has_next ? (const char*)g.A + (size_t)nxt.pm * tstep : cA; const char* nB = has_next ? (const char*)g.Bt + (size_t)nxt.pn * tstep : cB;
        for (int t = 0; t < nt; t += 2) {
            const bool last = (t == nt - 2);
            const char* a1 = cA + (size_t)(t + 1) * kstep;
            const char* a2 = last ? nA : cA + (size_t)(t + 2) * kstep; const char* b2 = last ? nB : cB + (size_t)(t + 2) * kstep;
            const char* a3 = a2 + kstep; const char* b3 = b2 + kstep;
            if (last && has_next) S.a_ready(nxt);
            if constexpr (SP2) {
            PG8_LDB(B0, 0, 0); PG8_LDB(B1, 0, 1); PG8_SCHED; PG8_LDA(At, 0, 0); PG8_STAGE(PG8_SA(1, 1), a1 + hstep, voffA);
            PG8_WAIT_V(8); PG8_WAIT_L(0); PG8_BAR; PG8_MMA(0, 0, At, B0); PG8_MMA(0, 1, At, B1); PG8_BAR; PG8_SCHED;
            PG8_LDA(At, 0, 1); PG8_STAGE(PG8_SB(0, 0), b2, voffB); PG8_STAGE(PG8_SB(0, 1), b2 + hstep, voffB); PG8_STAGE(PG8_SA(0, 0), a2, voffA);
            PG8_WAIT_V(8); PG8_WAIT_L(0); PG8_BAR; PG8_MMA(1, 0, At, B0); PG8_MMA(1, 1, At, B1); PG8_BAR; PG8_SCHED;
            PG8_LDB(B0, 1, 0); PG8_LDB(B1, 1, 1); PG8_SCHED; PG8_LDA(At, 1, 0); PG8_STAGE(PG8_SA(0, 1), a2 + hstep, voffA);
            PG8_WAIT_V(8); PG8_WAIT_L(0); PG8_BAR; PG8_MMA(0, 0, At, B0); PG8_MMA(0, 1, At, B1); PG8_BAR; PG8_SCHED;
            PG8_LDA(At, 1, 1); PG8_STAGE(PG8_SB(1, 0), b3, voffB); PG8_STAGE(PG8_SB(1, 1), b3 + hstep, voffB); PG8_STAGE(PG8_SA(1, 0), a3, voffA);
            PG8_WAIT_V(8); PG8_WAIT_L(0); PG8_BAR; PG8_MMA(1, 0, At, B0); PG8_MMA(1, 1, At, B1); PG8_BAR; PG8_SCHED;
            } else {
            PG8_LDB(B0, 0, 0); PG8_SCHED; PG8_LDA(At, 0, 0); PG8_STAGE(PG8_SA(1, 1), a1 + hstep, voffA);
            PG8_WAIT_L(8); PG8_BAR; PG8_WAIT_L(0); PG8_MMA(0, 0, At, B0); PG8_BAR; PG8_SCHED;
            PG8_LDB(B1, 0, 1); PG8_STAGE(PG8_SB(0, 0), b2, voffB);
            PG8_BAR; PG8_WAIT_L(0); PG8_MMA(0, 1, At, B1); PG8_BAR;
            PG8_LDA(At, 0, 1); PG8_STAGE(PG8_SA(0, 0), a2, voffA);
            PG8_BAR; PG8_WAIT_L(0); PG8_MMA(1, 0, At, B0); PG8_BAR; PG8_SCHED;
            PG8_STAGE(PG8_SB(0, 1), b2 + hstep, voffB);
            PG8_WAIT_V(6); PG8_BAR; PG8_MMA(1, 1, At, B1); PG8_BAR;
            PG8_LDB(B0, 1, 0); PG8_SCHED; PG8_LDA(At, 1, 0); PG8_STAGE(PG8_SA(0, 1), a2 + hstep, voffA);
            PG8_WAIT_L(8); PG8_BAR; PG8_WAIT_L(0); PG8_MMA(0, 0, At, B0); PG8_BAR; PG8_SCHED;
            PG8_LDB(B1, 1, 1); PG8_STAGE(PG8_SB(1, 0), b3, voffB);
            PG8_BAR; PG8_WAIT_L(0); PG8_MMA(0, 1, At, B1); PG8_BAR;
            PG8_LDA(At, 1, 1); PG8_STAGE(PG8_SA(1, 0), a3, voffA);
            PG8_BAR; PG8_WAIT_L(0); PG8_MMA(1, 0, At, B0); PG8_BAR; PG8_SCHED;
            PG8_STAGE(PG8_SB(1, 1), b3 + hstep, voffB);
            PG8_WAIT_V(6); PG8_BAR; PG8_MMA(1, 1, At, B1); PG8_BAR;
            }
        }
        if constexpr (ALIGN_EPI) { if (wr == 0) PG8_BAR; }
        if constexpr (!Epi::AFTER_DRAIN) { E(acc, cur, wr, wc, fr, fq); S.done(cur); }
        if (!has_next) break;
#pragma unroll
        for (int a = 0; a < 2; ++a)
#pragma unroll
            for (int b = 0; b < 2; ++b)
#pragma unroll
                for (int m = 0; m < 4; ++m)
#pragma unroll
                    for (int n = 0; n < 2; ++n) acc[a][b][m][n] = (f32x4){0.f, 0.f, 0.f, 0.f};
        cur = nxt; cA = nA; cB = nB; ++ui;
        if constexpr (ALIGN_EPI) { if (wr == 1) PG8_BAR; }
    }
    PG8_WAIT_V(0);
    if constexpr (!ALIGN_EPI) { if (wr == 0) PG8_BAR; }
    PG8_BAR;
    if constexpr (Epi::AFTER_DRAIN) { E.fused(acc, cur, wr, wc, fr, fq, lds, wid, lane); S.done(cur); }
#undef PG8_SA
#undef PG8_SB
#undef PG8_STAGE
#undef PG8_LDA
#undef PG8_LDB
#undef PG8_MMA
#undef PG8_WAIT_V
#undef PG8_WAIT_L
#undef PG8_BAR
#undef PG8_SCHED
}
}
__device__ __forceinline__ float row_rstd(const float* ssq, int row) {
    const f32x4* q = (const f32x4*)(ssq + (size_t)row * 16);
    const f32x4 a = q[0], b = q[1], c = q[2], d = q[3];
    return rsqrtf(((((a.x + a.y) + (a.z + a.w)) + ((b.x + b.y) + (b.z + b.w))) + (((c.x + c.y) + (c.z + c.w)) + ((d.x + d.y) + (d.z + d.w)))) * (1.f / DM) + EPS);
}
__device__ __forceinline__ void phase1_mfma(const Params& p, LAS unsigned char* lds) {
    pg8::Gemm g{(const pg8::bf16_t*)(p.ws + OFF_XN), (const pg8::bf16_t*)(p.ws + OFF_WIN), MROWS, NIN, DM};
    pg8::StaticOrder S; S.init(MROWS, NIN, (int)gridDim.x, (int)blockIdx.x);
    pg8::EpiP1 E{P1Ptrs{p.ws, p.in[10], p.in[12]}};
    pg8::gemm_phase<pg8::EpiP1, pg8::StaticOrder, true, true>(lds, g, S, E);
}
__device__ __forceinline__ void phase3_mfma(const Params& p, LAS unsigned char* lds) {
    pg8::Gemm g{(const pg8::bf16_t*)(p.ws + OFF_MIX), (const pg8::bf16_t*)(p.ws + OFF_WOUT), NTOK, DM, DM};
    pg8::StaticOrder S; S.init(NTOK, DM, (int)gridDim.x, (int)blockIdx.x);
    pg8::EpiP3 E{p.in[0], p.out, (bf16_t*)(p.ws + OFF_H2B), (float*)(p.ws + OFF_SSQP)};
    pg8::gemm_phase<pg8::EpiP3, pg8::StaticOrder, true, true>(lds, g, S, E);
}

typedef float f32x16 __attribute__((ext_vector_type(16)));
constexpr int AT_KROW = 272, AT_VROW = 144, AT_KBYTES = 64 * AT_KROW, AT_VBYTES = 128 * AT_VROW, AT_STAGE = AT_KBYTES + AT_VBYTES;
__device__ __forceinline__ void attn_item(const Params& p, LAS unsigned char* lds, int item) {
    const int tid = threadIdx.x, lane = tid & 63, wave = __builtin_amdgcn_readfirstlane(tid >> 6), qg = wave >> 1, c = wave & 1, l31 = lane & 31, hh = lane >> 5;
    const int qt = item & 15, h = (item >> 4) & 3, b = item >> 6;
    const int r0 = b * SEQ + qt * 128;
    const bf16_t* QB = (const bf16_t*)(p.ws + OFF_QB); const bf16_t* KB = (const bf16_t*)(p.ws + OFF_KB); const bf16_t* VT = (const bf16_t*)(p.ws + OFF_VT);
    bf16x8 qf[4];
    {
        const bf16_t* qp = QB + (size_t)(r0 + qg * 32 + l31) * 512 + h * 128 + c * 64 + 8 * hh;
#pragma unroll
        for (int s = 0; s < 4; ++s) qf[s] = *(const bf16x8*)(qp + 16 * s);
    }
    f32x16 O[4];
#pragma unroll
    for (int i = 0; i < 4; ++i)
#pragma unroll
        for (int r = 0; r < 16; ++r) O[i][r] = 0.f;
    float m = 0.f, l = 0.f;
    const int kq0 = tid, kq1 = tid + 512;
    const bf16_t* kg0 = KB + (size_t)(kq0 >> 4) * 512 + h * 128 + (kq0 & 15) * 8; const bf16_t* kg1 = KB + (size_t)(kq1 >> 4) * 512 + h * 128 + (kq1 & 15) * 8;
    const bf16_t* vg0 = VT + (size_t)(h * 128 + (kq0 >> 3)) * MROWS + (kq0 & 7) * 8; const bf16_t* vg1 = VT + (size_t)(h * 128 + (kq1 >> 3)) * MROWS + (kq1 & 7) * 8;
    const int kl0 = (kq0 >> 4) * AT_KROW + (kq0 & 15) * 16, kl1 = (kq1 >> 4) * AT_KROW + (kq1 & 15) * 16;
    const int vl0 = AT_KBYTES + (kq0 >> 3) * AT_VROW + ((kq0 & 7) >> 1) * 32 + (kq0 & 1) * 8, vl1 = AT_KBYTES + (kq1 >> 3) * AT_VROW + ((kq1 & 7) >> 1) * 32 + (kq1 & 1) * 8;
    u32x4 kr0, kr1, vr0, vr1;
#define AT_LOAD(t) do { const size_t kro = (size_t)((t) < 32 ? b * SEQ + (t) * 64 : NTOK); \
        kr0 = *(const u32x4*)(kg0 + kro * 512); kr1 = *(const u32x4*)(kg1 + kro * 512); vr0 = *(const u32x4*)(vg0 + kro); vr1 = *(const u32x4*)(vg1 + kro); } while (0)
#define AT_WRITE(buf) do { LAS unsigned char* _b = lds + (buf) * AT_STAGE; \
        *(LAS u32x4*)(_b + kl0) = kr0; *(LAS u32x4*)(_b + kl1) = kr1; \
        *(LAS u32x2*)(_b + vl0) = (u32x2){vr0.x, vr0.y}; *(LAS u32x2*)(_b + vl0 + 16) = (u32x2){vr0.z, vr0.w}; \
        *(LAS u32x2*)(_b + vl1) = (u32x2){vr1.x, vr1.y}; *(LAS u32x2*)(_b + vl1 + 16) = (u32x2){vr1.z, vr1.w}; } while (0)
    __syncthreads();
    AT_LOAD(0); AT_WRITE(0);
    __syncthreads();
    for (int t = 0; t < 33; ++t) {
        if (t + 1 < 33) AT_LOAD(t + 1);
        const LAS unsigned char* kb_ = lds + (t & 1) * AT_STAGE; const LAS unsigned char* vb_ = kb_ + AT_KBYTES;
        f32x16 s0, s1;
#pragma unroll
        for (int r = 0; r < 16; ++r) { s0[r] = -m; s1[r] = -m; }
#pragma unroll
        for (int s = 0; s < 4; ++s) {
            const bf16x8 k0 = *(const LAS bf16x8*)(kb_ + l31 * AT_KROW + (c * 64 + 16 * s + 8 * hh) * 2);
            s0 = __builtin_amdgcn_mfma_f32_32x32x16_bf16(k0, qf[s], s0, 0, 0, 0);
        }
#pragma unroll
        for (int s = 0; s < 4; ++s) {
            const bf16x8 k1 = *(const LAS bf16x8*)(kb_ + (32 + l31) * AT_KROW + (c * 64 + 16 * s + 8 * hh) * 2);
            s1 = __builtin_amdgcn_mfma_f32_32x32x16_bf16(k1, qf[s], s1, 0, 0, 0);
        }
        if (t == 32) {
#pragma unroll
            for (int r = 0; r < 16; ++r) { const int key = (r & 3) + 8 * (r >> 2) + 4 * hh; if (key >= 16) s0[r] = -1e30f; s1[r] = -1e30f; }
        }
        float mx = s0[0];
#pragma unroll
        for (int r = 1; r < 16; ++r) mx = fmaxf(mx, s0[r]);
#pragma unroll
        for (int r = 0; r < 16; ++r) mx = fmaxf(mx, s1[r]);
        mx = fmaxf(mx, __shfl_xor(mx, 32));
        if (t == 0 || __any(mx > 8.0f)) {
            const float d = t == 0 ? mx : fmaxf(mx, 0.f), alpha = __builtin_amdgcn_exp2f(-d);
            m += d; l *= alpha;
#pragma unroll
            for (int i = 0; i < 4; ++i) O[i] = O[i] * alpha;
#pragma unroll
            for (int r = 0; r < 16; ++r) { s0[r] -= d; s1[r] -= d; }
        }
        float ps = 0.f;
#define AT_PV(SREG, kb) do { \
        _Pragma("unroll") for (int r = 0; r < 16; ++r) { SREG[r] = __builtin_amdgcn_exp2f(SREG[r]); ps += SREG[r]; } \
        bf16x8 pf0, pf1; \
        { u32x4 a; a.x = pk2(SREG[0], SREG[1]); a.y = pk2(SREG[2], SREG[3]); a.z = pk2(SREG[4], SREG[5]); a.w = pk2(SREG[6], SREG[7]); pf0 = __builtin_bit_cast(bf16x8, a); \
          u32x4 bq; bq.x = pk2(SREG[8], SREG[9]); bq.y = pk2(SREG[10], SREG[11]); bq.z = pk2(SREG[12], SREG[13]); bq.w = pk2(SREG[14], SREG[15]); pf1 = __builtin_bit_cast(bf16x8, bq); } \
        _Pragma("unroll") for (int vb = 0; vb < 4; ++vb) { \
            const LAS unsigned char* vp = vb_ + (vb * 32 + l31) * AT_VROW + (kb) * 64 + hh * 16; \
            O[vb] = __builtin_amdgcn_mfma_f32_32x32x16_bf16(*(const LAS bf16x8*)vp, pf0, O[vb], 0, 0, 0); \
            O[vb] = __builtin_amdgcn_mfma_f32_32x32x16_bf16(*(const LAS bf16x8*)(vp + 32), pf1, O[vb], 0, 0, 0); } } while (0)
        AT_PV(s0, 0);
        AT_PV(s1, 1);
#undef AT_PV
        l += ps;
        if (t + 1 < 33) AT_WRITE((t + 1) & 1);
        __syncthreads();
    }
    const float inv = 1.f / (l + __shfl_xor(l, 32));
    LAS float* X = (LAS float*)lds + qg * 4096;
    if (c == 1) {
#pragma unroll
        for (int vb = 0; vb < 4; ++vb)
#pragma unroll
            for (int r = 0; r < 16; ++r) X[(vb * 16 + r) * 64 + lane] = O[vb][r] * inv;
    }
    __syncthreads();
    if (c == 0) {
        const float lam = ((const float*)(p.ws + OFF_MISC))[0];
        float ss = 0.f;
#pragma unroll
        for (int vb = 0; vb < 4; ++vb)
#pragma unroll
            for (int r = 0; r < 16; ++r) { const float y = O[vb][r] * inv - lam * X[(vb * 16 + r) * 64 + lane]; O[vb][r] = y; ss += y * y; }
        ss += __shfl_xor(ss, 32);
        const float rs = rsqrtf(ss * (1.f / 128.f) + EPS) * 0.8f;
        bf16_t* orow = (bf16_t*)(p.ws + OFF_MIX) + (size_t)(r0 + qg * 32 + l31) * DM + h * 128;
#pragma unroll
        for (int vb = 0; vb < 4; ++vb)
#pragma unroll
            for (int rq = 0; rq < 4; ++rq) {
                const int v0 = vb * 32 + 8 * rq + 4 * hh;
                const f32x4 wlo = *(const f32x4*)(p.in[8] + vb * 32 + 8 * rq), whi = *(const f32x4*)(p.in[8] + vb * 32 + 8 * rq + 4);
                const f32x4 w = hh ? whi : wlo;
                u32x2 o; o.x = pk2(O[vb][4 * rq] * rs * w.x, O[vb][4 * rq + 1] * rs * w.y); o.y = pk2(O[vb][4 * rq + 2] * rs * w.z, O[vb][4 * rq + 3] * rs * w.w);
                *(u32x2*)(orow + v0) = o;
            }
    }
#undef AT_LOAD
#undef AT_WRITE
}
__device__ __forceinline__ void phase2_attn_mfma(const Params& p, LAS unsigned char* lds) {
    for (int it = vcu_of_block(); it < NB * 4 * 16; it += gridDim.x) attn_item(p, lds, it);
}


__device__ __forceinline__ int gsw(int row, int chunk) { return row * 128 + ((chunk ^ (row & 7)) << 4); }
constexpr int GL_SET = 40960;
constexpr int GL_QS = 0, GL_KS = 8192, GL_KT = 16384, GL_VT = 24576, GL_AT = 2 * GL_SET, GL_ST = GL_AT + 8192  , GL_DV = GL_ST + 32768  ;
__device__ __forceinline__ float dpp_scan64(float v) {
    v += __builtin_bit_cast(float, __builtin_amdgcn_update_dpp(0, __builtin_bit_cast(int, v), 0x111, 0xf, 0xf, false));
    v += __builtin_bit_cast(float, __builtin_amdgcn_update_dpp(0, __builtin_bit_cast(int, v), 0x112, 0xf, 0xf, false));
    v += __builtin_bit_cast(float, __builtin_amdgcn_update_dpp(0, __builtin_bit_cast(int, v), 0x114, 0xf, 0xf, false));
    v += __builtin_bit_cast(float, __builtin_amdgcn_update_dpp(0, __builtin_bit_cast(int, v), 0x118, 0xf, 0xf, false));
    v += __builtin_bit_cast(float, __builtin_amdgcn_update_dpp(0, __builtin_bit_cast(int, v), 0x142, 0xa, 0xf, false));
    v += __builtin_bit_cast(float, __builtin_amdgcn_update_dpp(0, __builtin_bit_cast(int, v), 0x143, 0xc, 0xf, false));
    return v;
}
struct GlaPre { f32x4 g0, g1; u32x4 q8, k8, v0, v1; };
struct GlaCtx { const bf16_t* GQ; const bf16_t* GK; const bf16_t* GVT; const float* G; bf16_t* O; int dir, h, b, nsteps, lane, wave, l15, g, vdv, vch; };
__device__ __forceinline__ int gla_rowbase(const GlaCtx& c, int st) { return c.dir ? c.b * SEQ + (31 - st) * 64 : (st == 0 ? NTOK : c.b * SEQ + (st - 1) * 64); }
__device__ __forceinline__ void gla_load(const GlaCtx& c, GlaPre& r, int st) {
    const int rb = gla_rowbase(c, st); const size_t row = (size_t)(rb + c.lane);
    r.g0 = *(const f32x4*)(c.G + row * 256 + c.h * 64 + 8 * c.wave); r.g1 = *(const f32x4*)(c.G + row * 256 + c.h * 64 + 8 * c.wave + 4);
    r.q8 = *(const u32x4*)(c.GQ + row * 256 + c.h * 64 + 8 * c.wave); r.k8 = *(const u32x4*)(c.GK + row * 256 + c.h * 64 + 8 * c.wave);
    r.v0 = *(const u32x4*)(c.GVT + (size_t)(c.h * 128 + c.vdv) * MROWS + rb + c.vch * 8); r.v1 = *(const u32x4*)(c.GVT + (size_t)(c.h * 128 + c.vdv) * MROWS + rb + c.vch * 8 + 8);
}
__device__ __forceinline__ void gla_step(const GlaCtx& c, LAS unsigned char* lds, GlaPre& r, f32x4 (&accS)[4], int st) {
    const int lane = c.lane, wave = c.wave, l15 = c.l15, g = c.g, dir = c.dir;
    const bool meta = (dir == 0 && st == 0);
    const int rowbase = gla_rowbase(c, st);
    LAS unsigned char* sb = lds + (st & 1) * GL_SET;
    float gg[8] = {r.g0.x, r.g0.y, r.g0.z, r.g0.w, r.g1.x, r.g1.y, r.g1.z, r.g1.w};
    if (meta && lane >= NMETA) {
#pragma unroll
        for (int e = 0; e < 8; ++e) gg[e] = 0.f;
    }
    const u32x4 q8 = r.q8, k8 = r.k8;
    float qv[8] = {bflo(q8.x), bfhi(q8.x), bflo(q8.y), bfhi(q8.y), bflo(q8.z), bfhi(q8.z), bflo(q8.w), bfhi(q8.w)};
    float kv[8] = {bflo(k8.x), bfhi(k8.x), bflo(k8.y), bfhi(k8.y), bflo(k8.z), bfhi(k8.z), bflo(k8.w), bfhi(k8.w)};
    float qn[8], kn[8], ks[8];
#pragma unroll
    for (int e = 0; e < 8; ++e) {
        const float P = dpp_scan64(gg[e]);
        const float T = __builtin_bit_cast(float, __builtin_amdgcn_readlane(__builtin_bit_cast(int, P), 63));
        const float Bv = dir ? (T - P + gg[e]) : P;
        const float eb = __expf(Bv), en = __builtin_amdgcn_rcpf(eb), eT = __expf(T);
        qn[e] = qv[e] * eb; kn[e] = kv[e] * en; ks[e] = kn[e] * eT;
        if (lane == 0) *(LAS float*)(lds + GL_DV + (st & 1) * 256 + (8 * wave + e) * 4) = eT;
    }
    *(LAS u32x4*)(sb + GL_QS + gsw(lane, wave)) = (u32x4){pk2(qn[0], qn[1]), pk2(qn[2], qn[3]), pk2(qn[4], qn[5]), pk2(qn[6], qn[7])};
    *(LAS u32x4*)(sb + GL_KS + gsw(lane, wave)) = (u32x4){pk2(kn[0], kn[1]), pk2(kn[2], kn[3]), pk2(kn[4], kn[5]), pk2(kn[6], kn[7])};
#pragma unroll
    for (int e = 0; e < 8; e += 2) { const unsigned w = pk2(ks[e], ks[e + 1]);
        *(LAS unsigned short*)(sb + GL_KT + gsw(8 * wave + e, lane >> 3) + (lane & 7) * 2) = (unsigned short)w;
        *(LAS unsigned short*)(sb + GL_KT + gsw(8 * wave + e + 1, lane >> 3) + (lane & 7) * 2) = (unsigned short)(w >> 16); }
    *(LAS u32x4*)(sb + GL_VT + gsw(c.vdv, c.vch)) = r.v0; *(LAS u32x4*)(sb + GL_VT + gsw(c.vdv, c.vch + 1)) = r.v1;
    if (st + 2 < c.nsteps) gla_load(c, r, st + 2);
    __syncthreads();
    const LAS unsigned char* STo = lds + GL_ST + (st & 1) * 16384; LAS unsigned char* STn = lds + GL_ST + ((st + 1) & 1) * 16384;
    if (!meta) {
        const int jb = wave >> 1;
#pragma unroll
        for (int ii = 0; ii < 2; ++ii) {
            const int ib = 2 * (wave & 1) + ii;
            f32x4 a = (f32x4){0.f, 0.f, 0.f, 0.f};
            const bool live = dir ? (jb >= ib) : (jb <= ib);
            if (live) {
#pragma unroll
                for (int ks2 = 0; ks2 < 2; ++ks2) {
                    const bf16x8 kf = *(const LAS bf16x8*)(sb + GL_KS + gsw(jb * 16 + l15, ks2 * 4 + g));
                    const bf16x8 qf = *(const LAS bf16x8*)(sb + GL_QS + gsw(ib * 16 + l15, ks2 * 4 + g));
                    a = __builtin_amdgcn_mfma_f32_16x16x32_bf16(kf, qf, a, 0, 0, 0);
                }
                const int i = ib * 16 + l15, j0 = jb * 16 + 4 * g;
#pragma unroll
                for (int rr = 0; rr < 4; ++rr) { const bool keep = dir ? (j0 + rr >= i) : (j0 + rr <= i); a[rr] = keep ? a[rr] : 0.f; }
            }
            const int i = ib * 16 + l15, j0 = jb * 16 + 4 * g;
            *(LAS u32x2*)(lds + GL_AT + gsw(i, j0 >> 3) + (j0 & 7) * 2) = (u32x2){pk2(a[0], a[1]), pk2(a[2], a[3])};
        }
    }
    if (st + 1 < c.nsteps) {
#pragma unroll
        for (int kb = 0; kb < 4; ++kb) {
            const f32x4 dvv = *(const LAS f32x4*)(lds + GL_DV + (st & 1) * 256 + (kb * 16 + 4 * g) * 4);
            f32x4 a = accS[kb] * dvv;
#pragma unroll
            for (int ks2 = 0; ks2 < 2; ++ks2) {
                const bf16x8 kf = *(const LAS bf16x8*)(sb + GL_KT + gsw(kb * 16 + l15, ks2 * 4 + g));
                const bf16x8 vf = *(const LAS bf16x8*)(sb + GL_VT + gsw(wave * 16 + l15, ks2 * 4 + g));
                a = __builtin_amdgcn_mfma_f32_16x16x32_bf16(kf, vf, a, 0, 0, 0);
            }
            accS[kb] = a;
            const int dk0 = kb * 16 + 4 * g;
            *(LAS u32x2*)(STn + gsw(wave * 16 + l15, dk0 >> 3) + (dk0 & 7) * 2) = (u32x2){pk2(a[0], a[1]), pk2(a[2], a[3])};
        }
    }
    __syncthreads();
    if (!meta) {
#pragma unroll
        for (int ib = 0; ib < 4; ++ib) {
            f32x4 a = (f32x4){0.f, 0.f, 0.f, 0.f};
#pragma unroll
            for (int ks2 = 0; ks2 < 2; ++ks2) {
                const bf16x8 vf = *(const LAS bf16x8*)(sb + GL_VT + gsw(wave * 16 + l15, ks2 * 4 + g));
                const bf16x8 af = *(const LAS bf16x8*)(lds + GL_AT + gsw(ib * 16 + l15, ks2 * 4 + g));
                a = __builtin_amdgcn_mfma_f32_16x16x32_bf16(vf, af, a, 0, 0, 0);
                const bf16x8 sf = *(const LAS bf16x8*)(STo + gsw(wave * 16 + l15, ks2 * 4 + g));
                const bf16x8 qf = *(const LAS bf16x8*)(sb + GL_QS + gsw(ib * 16 + l15, ks2 * 4 + g));
                a = __builtin_amdgcn_mfma_f32_16x16x32_bf16(sf, qf, a, 0, 0, 0);
            }
            *(u32x2*)(c.O + (size_t)(rowbase + ib * 16 + l15) * 512 + c.h * 128 + wave * 16 + 4 * g) = (u32x2){pk2(a[0], a[1]), pk2(a[2], a[3])};
        }
    }
}
__device__ __forceinline__ void gla_chain(const Params& p, LAS unsigned char* lds, int item) {
    const int tid = threadIdx.x;
    GlaCtx c;
    c.lane = tid & 63; c.wave = __builtin_amdgcn_readfirstlane(tid >> 6); c.l15 = c.lane & 15; c.g = c.lane >> 4;
    c.dir = item & 1; c.h = (item >> 1) & 3; c.b = item >> 3;
    c.GQ = (const bf16_t*)(p.ws + OFF_GQ); c.GK = (const bf16_t*)(p.ws + OFF_GK); c.GVT = (const bf16_t*)(p.ws + OFF_GVT);
    c.G = (const float*)(p.ws + (c.dir ? OFF_GB : OFF_GF));
    c.O = (bf16_t*)p.out + (c.dir ? (size_t)NTOK * 512 : 0);
    c.nsteps = c.dir ? 32 : 33; c.vdv = tid >> 2; c.vch = (tid & 3) * 2;
    f32x4 accS[4];
#pragma unroll
    for (int i = 0; i < 4; ++i) accS[i] = (f32x4){0.f, 0.f, 0.f, 0.f};
    __syncthreads();
    *(LAS u32x4*)(lds + GL_ST + tid * 32) = (u32x4){0u, 0u, 0u, 0u}; *(LAS u32x4*)(lds + GL_ST + tid * 32 + 16) = (u32x4){0u, 0u, 0u, 0u};
    GlaPre X, Y;
    gla_load(c, X, 0); gla_load(c, Y, 1);
    for (int st = 0; st < c.nsteps; st += 2) {
        gla_step(c, lds, X, accS, st);
        if (st + 1 < c.nsteps) gla_step(c, lds, Y, accS, st + 1);
    }
    asm volatile("s_waitcnt vmcnt(0)" ::: "memory");
    __syncthreads();
    if (tid == 0) {
        __builtin_amdgcn_fence(__ATOMIC_RELEASE, "agent");
        asm volatile("s_waitcnt vmcnt(0)" ::: "memory");
        __hip_atomic_fetch_add((unsigned*)(p.ws + OFF_CTL) + 4096 + (item >> 1) * 64, 1u, __ATOMIC_RELAXED, __HIP_MEMORY_SCOPE_AGENT);
    }
}
__device__ __forceinline__ void gla_combine_item(const Params& p, LAS unsigned char* lds, int item) {
    const int tid = threadIdx.x, lane = tid & 63, wave = tid >> 6;
    const int bh = item >> 3, part = item & 7, b = bh >> 2, h = bh & 3;
    if (tid == 0) {
        unsigned* flag = (unsigned*)(p.ws + OFF_CTL) + 4096 + bh * 64;
        unsigned spins = 0;
        while (__hip_atomic_load(flag, __ATOMIC_RELAXED, __HIP_MEMORY_SCOPE_AGENT) < 2u) { __builtin_amdgcn_s_sleep(8); if (++spins > (1u << 22)) break; }
        __builtin_amdgcn_fence(__ATOMIC_ACQUIRE, "agent");
        asm volatile("s_waitcnt vmcnt(0)" ::: "memory");
    }
    __syncthreads();
    const bf16_t* GR = (const bf16_t*)(p.ws + OFF_GR); bf16_t* MIX = (bf16_t*)(p.ws + OFF_MIX);
    const bf16_t* OF = (const bf16_t*)p.out; const bf16_t* OBk = OF + (size_t)NTOK * 512;
    const int c0 = h * 128 + (lane & 15) * 8;
    const f32x4 w0 = *(const f32x4*)(p.in[13] + (lane & 15) * 8), w1 = *(const f32x4*)(p.in[13] + (lane & 15) * 8 + 4);
#pragma unroll 2
    for (int i = 0; i < 8; ++i) {
        const int r = b * SEQ + part * 256 + wave * 32 + i * 4 + (lane >> 4);
        const u32x4 a = *(const u32x4*)(OF + (size_t)r * 512 + c0), bq = *(const u32x4*)(OBk + (size_t)r * 512 + c0);
        const f32x4 x0 = (f32x4){bflo(a.x) + bflo(bq.x), bfhi(a.x) + bfhi(bq.x), bflo(a.y) + bflo(bq.y), bfhi(a.y) + bfhi(bq.y)};
        const f32x4 x1 = (f32x4){bflo(a.z) + bflo(bq.z), bfhi(a.z) + bfhi(bq.z), bflo(a.w) + bflo(bq.w), bfhi(a.w) + bfhi(bq.w)};
        float s = x0.x * x0.x + x0.y * x0.y + x0.z * x0.z + x0.w * x0.w + x1.x * x1.x + x1.y * x1.y + x1.z * x1.z + x1.w * x1.w;
        s += __shfl_xor(s, 1); s += __shfl_xor(s, 2); s += __shfl_xor(s, 4); s += __shfl_xor(s, 8);
        const float rs = rsqrtf(s * (1.f / 128.f) + EPS);
        const u32x4 g = *(const u32x4*)(GR + (size_t)r * 512 + c0);
        u32x4 o;
        o.x = pk2(x0.x * rs * w0.x * bflo(g.x), x0.y * rs * w0.y * bfhi(g.x)); o.y = pk2(x0.z * rs * w0.z * bflo(g.y), x0.w * rs * w0.w * bfhi(g.y));
        o.z = pk2(x1.x * rs * w1.x * bflo(g.z), x1.y * rs * w1.y * bfhi(g.z)); o.w = pk2(x1.z * rs * w1.z * bflo(g.w), x1.w * rs * w1.w * bfhi(g.w));
        *(u32x4*)(MIX + (size_t)r * DM + 512 + c0) = o;
    }
}

constexpr int LDS_Q = LDS_BYTES - 16;
__device__ __forceinline__ void phase2(const Params& p, LAS unsigned char* lds, int qslot = 0) {
    unsigned* ctr = (unsigned*)(p.ws + OFF_CTL) + (qslot >= 2 ? 2048 + qslot * 64 : qslot * 64);
    int it;
#define P2_NEXT() do { __syncthreads(); if (threadIdx.x == 0) *(LAS unsigned*)(lds + LDS_Q) = atomicAdd(ctr, 1u); __syncthreads(); it = (int)*(LAS unsigned*)(lds + LDS_Q); } while (0)
    P2_NEXT();
    if (qslot != 3) { while (it < 64) { gla_chain(p, lds, it); P2_NEXT(); } }
    if (qslot == 2) return;
    if (qslot == 3) it += 64;
    while (it < 64 + NB * 4 * 16) { attn_item(p, lds, it - 64); P2_NEXT(); if (qslot == 3) it += 64; }
    if (qslot) return;
    for (;;) {
        __syncthreads();
        if (threadIdx.x == 0) *(LAS unsigned*)(lds + LDS_Q) = atomicAdd(ctr + 192, 1u);
        __syncthreads();
        const int c = (int)*(LAS unsigned*)(lds + LDS_Q);
        if (c >= 256) break;
        gla_combine_item(p, lds, c);
    }
    for (;;) {
        __syncthreads();
        if (threadIdx.x == 0) *(LAS unsigned*)(lds + LDS_Q) = atomicAdd(ctr + 128, 1u);
        __syncthreads();
        const int c = (int)*(LAS unsigned*)(lds + LDS_Q);
        if (c >= CV_ITEMS) break;
        conv_item(p, (unsigned char*)lds, c);
    }
#undef P2_NEXT
}

__device__ __forceinline__ void phase2c(const Params& p) {
    const int tid = threadIdx.x, lane = tid & 63, wave = tid >> 6;
    const int gw = blockIdx.x * 8 + wave, NGW = gridDim.x * 8;
    const bf16_t* GR = (const bf16_t*)(p.ws + OFF_GR); bf16_t* MIX = (bf16_t*)(p.ws + OFF_MIX);
    const bf16_t* OF = (const bf16_t*)p.out; const bf16_t* OBk = OF + (size_t)NTOK * 512;
    const int c0 = lane * 8;
    const f32x4 w0 = *(const f32x4*)(p.in[13] + (c0 & 127)), w1 = *(const f32x4*)(p.in[13] + (c0 & 127) + 4);
    for (int r = gw; r < NTOK; r += NGW) {
        const u32x4 a = *(const u32x4*)(OF + (size_t)r * 512 + c0), bq = *(const u32x4*)(OBk + (size_t)r * 512 + c0);
        const f32x4 x0 = (f32x4){bflo(a.x) + bflo(bq.x), bfhi(a.x) + bfhi(bq.x), bflo(a.y) + bflo(bq.y), bfhi(a.y) + bfhi(bq.y)};
        const f32x4 x1 = (f32x4){bflo(a.z) + bflo(bq.z), bfhi(a.z) + bfhi(bq.z), bflo(a.w) + bflo(bq.w), bfhi(a.w) + bfhi(bq.w)};
        float s = x0.x * x0.x + x0.y * x0.y + x0.z * x0.z + x0.w * x0.w + x1.x * x1.x + x1.y * x1.y + x1.z * x1.z + x1.w * x1.w;
        s += __shfl_xor(s, 1); s += __shfl_xor(s, 2); s += __shfl_xor(s, 4); s += __shfl_xor(s, 8);
        const float rs = rsqrtf(s * (1.f / 128.f) + EPS);
        const u32x4 g = *(const u32x4*)(GR + (size_t)r * 512 + c0);
        u32x4 o;
        o.x = pk2(x0.x * rs * w0.x * bflo(g.x), x0.y * rs * w0.y * bfhi(g.x)); o.y = pk2(x0.z * rs * w0.z * bflo(g.y), x0.w * rs * w0.w * bfhi(g.y));
        o.z = pk2(x1.x * rs * w1.x * bflo(g.z), x1.y * rs * w1.y * bfhi(g.z)); o.w = pk2(x1.z * rs * w1.z * bflo(g.w), x1.w * rs * w1.w * bfhi(g.w));
        *(u32x4*)(MIX + (size_t)r * DM + 512 + c0) = o;
    }
}


#define TOPK_INS(L, x) do { float _x = (x); _Pragma("unroll") for (int _s = 0; _s < 16; ++_s) { const float _t = fmaxf(L[_s], _x); _x = fminf(L[_s], _x); L[_s] = _t; } } while (0)
constexpr int P4_QROW = 528, P4_SC0 = 128 * P4_QROW  , P4_TLROW = 144;

#define CE_DESC(a, b) do { const float _hi = fmaxf(a, b), _lo = fminf(a, b); a = _hi; b = _lo; } while (0)
__device__ __forceinline__ void bitonic_sort16_desc(float (&x)[16]) {
#pragma unroll
    for (int k = 2; k <= 16; k <<= 1)
#pragma unroll
        for (int j = k >> 1; j > 0; j >>= 1)
#pragma unroll
            for (int i = 0; i < 16; ++i) { const int l = i ^ j; if (l > i) { if ((i & k) == 0) CE_DESC(x[i], x[l]); else CE_DESC(x[l], x[i]); } }
}
__device__ __forceinline__ void bitonic_merge16_desc(float (&x)[16]) {
#pragma unroll
    for (int j = 8; j > 0; j >>= 1)
#pragma unroll
        for (int i = 0; i < 16; ++i) { const int l = i ^ j; if (l > i) CE_DESC(x[i], x[l]); }
}
__device__ __forceinline__ void top16_merge(float (&L)[16], const float (&x)[16]) {
#pragma unroll
    for (int i = 0; i < 16; ++i) L[i] = fmaxf(L[i], x[15 - i]);
    bitonic_merge16_desc(L);
}

template <int Q> struct CandIJ {
    static constexpr int compute() { int c = 0; for (int i = 0; i < 16; ++i) for (int j = 0; j < 16; ++j) if ((i + 1) * (j + 1) <= 16) { if (c == Q) return i * 16 + j; ++c; } return -1; }
    static constexpr int v = compute();
};
template <int G, int S> __device__ __forceinline__ void cand_fill(float (&x)[16], const float (&A)[16], const float (&Bv)[16]) {
    constexpr int ij = CandIJ<G * 16 + S>::v;
    if constexpr (ij >= 0) x[S] = __uint_as_float((__float_as_uint(A[ij >> 4] + Bv[ij & 15]) & ~255u) | (unsigned)ij); else x[S] = -3.0e38f;
    if constexpr (S + 1 < 16) cand_fill<G, S + 1>(x, A, Bv);
}
__device__ __forceinline__ void p4_route_half(const Params& p, LAS unsigned char* lds, int m0, int h) {
    int tid_ = threadIdx.x; asm volatile("" : "+v"(tid_));
    const int tid = tid_, lane = tid & 63, wave = __builtin_amdgcn_readfirstlane(tid >> 6), l15 = lane & 15, g = lane >> 4;
    const bf16_t* KEYS = (const bf16_t*)(p.ws + OFF_KEYS); unsigned* PW0 = (unsigned*)(p.ws + OFF_PW0);
        {
            const int wr = wave >> 1, wk = wave & 1;
            f32x4 sc[2][2][4];
#pragma unroll
            for (int pp = 0; pp < 2; ++pp) {
#pragma unroll
                for (int rb = 0; rb < 2; ++rb)
#pragma unroll
                    for (int kk = 0; kk < 4; ++kk) sc[pp][rb][kk] = (f32x4){0.f, 0.f, 0.f, 0.f};
                const bf16_t* kbase = KEYS + (size_t)((h * 2 + pp) * 128 + 64 * wk + l15) * 128 + 8 * g;
#pragma unroll
                for (int ks = 0; ks < 4; ++ks) {
                    bf16x8 qf[2], kf[4];
#pragma unroll
                    for (int rb = 0; rb < 2; ++rb) qf[rb] = *(const LAS bf16x8*)(lds + (32 * wr + 16 * rb + l15) * P4_QROW + (pp * 128 + ks * 32 + 8 * g) * 2);
#pragma unroll
                    for (int kk = 0; kk < 4; ++kk) kf[kk] = *(const bf16x8*)(kbase + (size_t)(16 * kk) * 128 + ks * 32);
#pragma unroll
                    for (int rb = 0; rb < 2; ++rb)
#pragma unroll
                        for (int kk = 0; kk < 4; ++kk) sc[pp][rb][kk] = __builtin_amdgcn_mfma_f32_16x16x32_bf16(kf[kk], qf[rb], sc[pp][rb][kk], 0, 0, 0);
                }
            }
#pragma unroll
            for (int rb = 0; rb < 2; ++rb)
#pragma unroll
                for (int kk = 0; kk < 4; ++kk) *(LAS f32x4*)(lds + P4_SC0 + (32 * wr + 16 * rb + l15) * P4_QROW + (64 * wk + 16 * kk + 4 * g) * 4) = sc[0][rb][kk];
            __syncthreads();
#pragma unroll
            for (int rb = 0; rb < 2; ++rb)
#pragma unroll
                for (int kk = 0; kk < 4; ++kk) *(LAS f32x4*)(lds + (32 * wr + 16 * rb + l15) * P4_QROW + (64 * wk + 16 * kk + 4 * g) * 4) = sc[1][rb][kk];
        }
        __syncthreads();
        {
            const int hf = tid & 1, row = (tid >> 1) & 127, pp = tid >> 8;
            const LAS unsigned char* sp = lds + (pp ? 0 : P4_SC0) + row * P4_QROW + hf * 256;
            float L[16];
#pragma unroll
            for (int grp = 0; grp < 4; ++grp) {
                float x[16];
#pragma unroll
                for (int q4 = 0; q4 < 4; ++q4) {
                    const f32x4 v = *(const LAS f32x4*)(sp + (grp * 4 + q4) * 16);
                    const unsigned kb = (unsigned)(hf * 64 + grp * 16 + q4 * 4);
                    x[4 * q4 + 0] = __uint_as_float((__float_as_uint(v.x) & ~127u) | kb);
                    x[4 * q4 + 1] = __uint_as_float((__float_as_uint(v.y) & ~127u) | (kb + 1));
                    x[4 * q4 + 2] = __uint_as_float((__float_as_uint(v.z) & ~127u) | (kb + 2));
                    x[4 * q4 + 3] = __uint_as_float((__float_as_uint(v.w) & ~127u) | (kb + 3));
                }
                bitonic_sort16_desc(x);
                if (grp == 0) {
#pragma unroll
                    for (int s = 0; s < 16; ++s) L[s] = x[s];
                } else top16_merge(L, x);
            }
            {
                float Oth[16];
#pragma unroll
                for (int s = 0; s < 16; ++s) Oth[s] = __shfl_xor(L[s], 1);
                top16_merge(L, Oth);
            }
            __syncthreads();
            if (hf == 0) {
                LAS f32x4* tl = (LAS f32x4*)(lds + P4_SC0 + row * (2 * P4_TLROW) + pp * P4_TLROW);
                tl[0] = (f32x4){L[0], L[1], L[2], L[3]}; tl[1] = (f32x4){L[4], L[5], L[6], L[7]}; tl[2] = (f32x4){L[8], L[9], L[10], L[11]}; tl[3] = (f32x4){L[12], L[13], L[14], L[15]};
            }
        }
        __syncthreads();
        if (tid < 128) {
            const LAS unsigned char* tl = lds + P4_SC0 + tid * (2 * P4_TLROW);
            float A[16], Bv[16];
#pragma unroll
            for (int q4 = 0; q4 < 4; ++q4) { const f32x4 a = *(const LAS f32x4*)(tl + q4 * 16), b = *(const LAS f32x4*)(tl + P4_TLROW + q4 * 16);
                A[4 * q4] = a.x; A[4 * q4 + 1] = a.y; A[4 * q4 + 2] = a.z; A[4 * q4 + 3] = a.w; Bv[4 * q4] = b.x; Bv[4 * q4 + 1] = b.y; Bv[4 * q4 + 2] = b.z; Bv[4 * q4 + 3] = b.w; }
#pragma unroll
            for (int s = 0; s < 16; ++s) { A[s] = __uint_as_float(__float_as_uint(A[s]) & ~127u); Bv[s] = __uint_as_float(__float_as_uint(Bv[s]) & ~127u); }
            float L[16];
            {
                float x[16];
                cand_fill<0, 0>(x, A, Bv); bitonic_sort16_desc(x);
#pragma unroll
                for (int s = 0; s < 16; ++s) L[s] = x[s];
                cand_fill<1, 0>(x, A, Bv); bitonic_sort16_desc(x); top16_merge(L, x);
                cand_fill<2, 0>(x, A, Bv); bitonic_sort16_desc(x); top16_merge(L, x);
                cand_fill<3, 0>(x, A, Bv); bitonic_sort16_desc(x); top16_merge(L, x);
            }
            const float v0 = __uint_as_float(__float_as_uint(L[0]) & ~255u);
            float e[16], den = 0.f; int id[16];
#pragma unroll
            for (int s = 0; s < 16; ++s) {
                const unsigned u = __float_as_uint(L[s]);
                e[s] = __expf(__uint_as_float(u & ~255u) - v0); den += e[s];
                const unsigned i = (u >> 4) & 15u, j = u & 15u;
                const unsigned ka = *(const LAS unsigned*)(tl + i * 4) & 127u, kb = *(const LAS unsigned*)(tl + P4_TLROW + j * 4) & 127u;
                id[s] = (int)(ka * 128u + kb);
            }
            const float inv = 1.f / den;
            unsigned* ip = PW0 + (size_t)(m0 + tid) * 128 + h * 16;
#pragma unroll
            for (int q4 = 0; q4 < 4; ++q4) { u32x4 o;
#pragma unroll
                for (int c = 0; c < 4; ++c) o[c] = (unsigned)id[4 * q4 + c] | (f2bf(e[4 * q4 + c] * inv) << 16);
                *(u32x4*)(ip + 4 * q4) = o; }
        }
        __syncthreads();
}

namespace pg8 {
struct EpiP4 {
    static constexpr bool PERM = false, AFTER_DRAIN = true;
    const Params* pp; const float* ssq;
    __device__ __forceinline__ void operator()(const f32x4 (&)[2][2][4][2], const Unit&, int, int, int, int) const {}
    __device__ __forceinline__ void fused(f32x4 (&acc)[2][2][4][2], const Unit& u, int wr, int wc, int fr, int fq, PG8_LAS unsigned char* lds, int wid, int lane) const {
#pragma unroll
        for (int ai = 0; ai < 2; ++ai) {
            const int m0 = u.pm * BM + ai * HALF;
#pragma unroll
            for (int m = 0; m < 4; ++m) {
                const int rl = wr * 64 + m * 16 + fr;
                const float rstd = row_rstd(ssq, m0 + rl);
#pragma unroll
                for (int bj = 0; bj < 2; ++bj)
#pragma unroll
                    for (int n = 0; n < 2; ++n) { const f32x4 v = acc[ai][bj][m][n] * rstd;
                        *(PG8_LAS u32x2*)(lds + rl * P4_QROW + (bj * HALF + wc * 32 + n * 16 + 4 * fq) * 2) = (u32x2){pk2(v.x, v.y), pk2(v.z, v.w)}; }
            }
            __syncthreads();
            p4_route_half(*pp, lds, m0, u.pn);
        }
    }
};
}
__device__ __forceinline__ void phase4_mfma(const Params& p, LAS unsigned char* lds) {
    pg8::Gemm g{(const pg8::bf16_t*)(p.ws + OFF_H2B), (const pg8::bf16_t*)(p.ws + OFF_WQ), NTOK, 2048, DM};
    pg8::EpiP4 E{&p, (const float*)(p.ws + OFF_SSQP)};
    const int vcu = vcu_of_block();
    for (int r = 0; r * (int)gridDim.x < 512; ++r) {
        const int L = r * (int)gridDim.x + vcu;
        pg8::OneUnit S; S.u.pm = L >> 3; S.u.pn = L & 7; S.valid = L < 512;
        pg8::gemm_phase<pg8::EpiP4, pg8::OneUnit, false, true>(lds, g, S, E);
        __syncthreads();
    }
}


constexpr size_t OFF_PW = 73 * MiB;
constexpr size_t OFF_OUTS = 179 * MiB;
static_assert(OFF_OUTS >= OFF_PW0 + (size_t)NTOK * 128 * 4 && OFF_OUTS + (size_t)NTOK * DM * 4 <= 256 * MiB, "P5 map");
__device__ __forceinline__ float dot_fp8_bf16(u32x4 uq, u32x4 h0, u32x4 h1, float c) {
#define DQ2(word, hsel, hw) c = dot2(__builtin_bit_cast(unsigned, __builtin_amdgcn_cvt_scalef32_pk_bf16_fp8((int)(word), 1.0f, hsel)), hw, c)
    DQ2(uq.x, false, h0.x); DQ2(uq.x, true, h0.y); DQ2(uq.y, false, h0.z); DQ2(uq.y, true, h0.w);
    DQ2(uq.z, false, h1.x); DQ2(uq.z, true, h1.y); DQ2(uq.w, false, h1.z); DQ2(uq.w, true, h1.w);
#undef DQ2
    return c;
}
constexpr int P5A_RS = 1040, P5A_LIST = 16640, P5A_RES = 18688, P5A_TSC = 18752, P5A_WAVE = 19456;
constexpr size_t OFF_HQ = 146 * MiB;
constexpr size_t OFF_HSC = 192 * 1024;
static_assert(8 * P5A_WAVE <= LDS_BYTES - 32, "P5a LDS");
static_assert(OFF_HQ >= OFF_H2B + (size_t)NTOK * DM * 2 && OFF_HQ + (size_t)NTOK * DM <= OFF_PW0, "HQ map");
__device__ __forceinline__ void quantize_hn(const Params& p) {
    const int tid = threadIdx.x, lane = tid & 63, wave = tid >> 6;
    const bf16_t* H2B = (const bf16_t*)(p.ws + OFF_H2B); unsigned char* HQ = p.ws + OFF_HQ; float* HSC = (float*)(p.ws + OFF_HSC);
    for (int t = blockIdx.x * 8 + wave; t < NTOK; t += gridDim.x * 8) {
        const u32x4 h0 = *(const u32x4*)(H2B + (size_t)t * DM + 16 * lane), h1 = *(const u32x4*)(H2B + (size_t)t * DM + 16 * lane + 8);
        float m = 0.f;
#pragma unroll
        for (int c = 0; c < 4; ++c) { m = fmaxf(m, fmaxf(fabsf(bflo(h0[c])), fabsf(bfhi(h0[c])))); m = fmaxf(m, fmaxf(fabsf(bflo(h1[c])), fabsf(bfhi(h1[c])))); }
        const float am = fmaxf(wave_max(m), 1e-30f), qs = 224.f / am;
        u32x4 o;
#pragma unroll
        for (int c = 0; c < 2; ++c) {
            int w = __builtin_amdgcn_cvt_pk_fp8_f32(bflo(h0[2 * c]) * qs, bfhi(h0[2 * c]) * qs, 0, false); w = __builtin_amdgcn_cvt_pk_fp8_f32(bflo(h0[2 * c + 1]) * qs, bfhi(h0[2 * c + 1]) * qs, w, true); o[c] = (unsigned)w;
            int x = __builtin_amdgcn_cvt_pk_fp8_f32(bflo(h1[2 * c]) * qs, bfhi(h1[2 * c]) * qs, 0, false); x = __builtin_amdgcn_cvt_pk_fp8_f32(bflo(h1[2 * c + 1]) * qs, bfhi(h1[2 * c + 1]) * qs, x, true); o[2 + c] = (unsigned)x;
        }
        *(u32x4*)(HQ + (size_t)t * DM + 16 * lane) = o;
        if (lane == 0) HSC[t] = row_rstd((const float*)(p.ws + OFF_SSQP), t) * am * (1.f / 224.f);
    }
}
__device__ __forceinline__ void p5a_wave(const Params& p, LAS unsigned char* wl, int tb, int part, int lane, __amdgpu_buffer_rsrc_t urs, __amdgpu_buffer_rsrc_t hrs) {
    const float* USC = (const float*)(p.ws + OFF_USC); const float* VSC = (const float*)(p.ws + OFF_VSC); const float* HSC = (const float*)(p.ws + OFF_HSC);
    const unsigned* PW0 = (const unsigned*)(p.ws + OFF_PW0); unsigned* PW = (unsigned*)(p.ws + OFF_PW);
    const int l15 = lane & 15, g = lane >> 4;
    unsigned xl[4], xh[4]; float hsc = 0.f;
#define P5A_STAGE(t0_) do { _Pragma("unroll") for (int _k = 0; _k < 4; ++_k) { \
        __builtin_amdgcn_raw_ptr_buffer_load_lds(hrs, (LAS unsigned*)(wl + _k * 1024), 16, lane * 16, ((t0_) + _k) * 1024, 0, 0); \
        xl[_k] = PW0[(size_t)((t0_) + _k) * 128 + lane]; xh[_k] = PW0[(size_t)((t0_) + _k) * 128 + 64 + lane]; } \
        hsc = HSC[(t0_) + (lane & 3)]; } while (0)
#define P5A_GATHER(tile_) do { int _li = (tile_) * 16 + l15; _li = _li < n ? _li : n - 1; \
        const int _ev = (int)((*(const LAS unsigned*)(wl + P5A_LIST + _li * 4) & 0x3fffu) << 10); \
        _Pragma("unroll") for (int _r = 0; _r < 16; ++_r) \
            __builtin_amdgcn_raw_ptr_buffer_load_lds(urs, (LAS unsigned*)(wl + _r * P5A_RS), 16, lane * 16, __builtin_amdgcn_readlane(_ev, _r), 0, 0); } while (0)
    P5A_STAGE(tb);
    for (int st = 0; st < 4; ++st) {
        const int t0 = tb + 4 * st;
        asm volatile("s_waitcnt vmcnt(0)" ::: "memory");
        long bq[32];
#pragma unroll
        for (int s = 0; s < 32; ++s) bq[s] = __builtin_bit_cast(long, *(const LAS u32x2*)(wl + (l15 & 3) * 1024 + 32 * s + 8 * g));
        if (lane < 4) *(LAS float*)(wl + P5A_TSC + lane * 4) = hsc;
        int n = 0;
#pragma unroll
        for (int k = 0; k < 4; ++k) {
            const bool ml = (int)((xl[k] >> 11) & 7u) == part, mh = (int)((xh[k] >> 11) & 7u) == part;
            const unsigned long long bl = __ballot(ml), bh = __ballot(mh);
            const int rl = __builtin_amdgcn_mbcnt_hi((unsigned)(bl >> 32), __builtin_amdgcn_mbcnt_lo((unsigned)bl, 0u));
            if (ml) *(LAS unsigned*)(wl + P5A_LIST + (n + rl) * 4) = (xl[k] & 0x3fffu) | ((unsigned)lane << 14) | ((unsigned)k << 21);
            n += __popcll(bl);
            const int rh = __builtin_amdgcn_mbcnt_hi((unsigned)(bh >> 32), __builtin_amdgcn_mbcnt_lo((unsigned)bh, 0u));
            if (mh) *(LAS unsigned*)(wl + P5A_LIST + (n + rh) * 4) = (xh[k] & 0x3fffu) | ((unsigned)(64 + lane) << 14) | ((unsigned)k << 21);
            n += __popcll(bh);
        }
        __builtin_amdgcn_s_waitcnt(0xC07F); __builtin_amdgcn_wave_barrier();
        asm volatile("" ::: "memory");
        const int ntile = (n + 15) >> 4;
        if (ntile == 0) { if (st < 3) P5A_STAGE(t0 + 4); continue; }
        P5A_GATHER(0);
        for (int tile = 0; tile < ntile; ++tile) {
            asm volatile("s_waitcnt vmcnt(0)" ::: "memory");
            int ei = tile * 16 + l15; const bool eok = ei < n; ei = eok ? ei : n - 1;
            const unsigned ent = *(const LAS unsigned*)(wl + P5A_LIST + ei * 4);
            const unsigned ee = ent & 0x3fffu; const int sl = (int)((ent >> 14) & 127u), tk = (int)(ent >> 21), t = t0 + tk;
            float usc = USC[ee], vsc = VSC[ee]; unsigned xg = PW0[(size_t)t * 128 + sl];
            long aq[32];
#pragma unroll
            for (int s = 0; s < 32; ++s) aq[s] = __builtin_bit_cast(long, *(const LAS u32x2*)(wl + l15 * P5A_RS + 32 * s + 8 * g));
            asm volatile("s_waitcnt vmcnt(0) lgkmcnt(0)" : "+v"(usc), "+v"(vsc), "+v"(xg) :: "memory");
#pragma unroll
            for (int s = 0; s < 32; ++s) asm volatile("" : "+v"(aq[s]));
            if (tile + 1 < ntile) P5A_GATHER(tile + 1); else if (st < 3) P5A_STAGE(t0 + 4);
            f32x4 acc = (f32x4){0.f, 0.f, 0.f, 0.f};
#pragma unroll
            for (int s = 0; s < 32; ++s) acc = __builtin_amdgcn_mfma_f32_16x16x32_fp8_fp8(aq[s], bq[s], acc, 0, 0, 0);
            {
                const u32x4 en = *(const LAS u32x4*)(wl + P5A_LIST + (tile * 16 + 4 * g) * 4);
#pragma unroll
                for (int r = 0; r < 4; ++r) if ((int)(en[r] >> 21) == l15) *(LAS float*)(wl + P5A_RES + (4 * g + r) * 4) = acc[r];
            }
            __builtin_amdgcn_s_waitcnt(0xC07F); __builtin_amdgcn_wave_barrier();
            asm volatile("" ::: "memory");
            if (lane < 16 && eok) {
                const float d = *(const LAS float*)(wl + P5A_RES + lane * 4) * usc * *(const LAS float*)(wl + P5A_TSC + tk * 4);
                const float w = __uint_as_float(xg & 0xffff0000u) * gelu_f(d) * vsc;
                PW[(((size_t)(t >> 6) * 32 + (sl >> 2)) * 64 + (t & 63)) * 4 + (sl & 3)] = ee | (f2bf(w) << 16);
            }
            __builtin_amdgcn_s_waitcnt(0xC07F); __builtin_amdgcn_wave_barrier();
            asm volatile("" ::: "memory");
        }
    }
    asm volatile("s_waitcnt vmcnt(0)" ::: "memory");
#undef P5A_STAGE
#undef P5A_GATHER
}
__device__ __forceinline__ void phase5a(const Params& p, LAS unsigned char* lds, int qoff = 0) {
    const int tid = threadIdx.x, lane = tid & 63, wave = __builtin_amdgcn_readfirstlane(tid >> 6);
    const int xcc = (int)(__builtin_amdgcn_s_getreg((3 << 11) | 20) & 7u);
    unsigned* qc = (unsigned*)(p.ws + OFF_CTL) + 256 + qoff;
    LAS unsigned char* wl = lds + wave * P5A_WAVE;
    const __amdgpu_buffer_rsrc_t urs = __builtin_amdgcn_make_buffer_rsrc((void*)(p.ws + OFF_UB), 0, NEXP * DM, 0x00020000);
    const __amdgpu_buffer_rsrc_t hrs = __builtin_amdgcn_make_buffer_rsrc((void*)(p.ws + OFF_HQ), 0, NTOK * DM, 0x00020000);
    for (int pi = 0; pi < 8; ++pi) {
        const int part = (xcc + pi) & 7;
        for (;;) {
            __syncthreads();
            if (tid == 0) *(LAS unsigned*)(lds + LDS_Q) = atomicAdd(qc + part * 64, 1u);
            __syncthreads();
            const int it = (int)*(LAS unsigned*)(lds + LDS_Q);
            if (it >= NTOK / 128) break;
            p5a_wave(p, wl, it * 128 + wave * 16, part, lane, urs, hrs);
        }
    }
}

__device__ __forceinline__ void p5b_quad(const LAS unsigned char* lds, u32x4 q, f32x2& a0, f32x2& a1, f32x2& a2, f32x2& a3) {
#pragma unroll
    for (int c = 0; c < 4; ++c) {
        const unsigned x = q[c];
        const u32x2 vv = *(const LAS u32x2*)(lds + ((x & 0x3fffu) << 3));
        const float w = __uint_as_float(x & 0xffff0000u); const f32x2 ww = (f32x2){w, w};
        a0 += ww * __builtin_amdgcn_cvt_pk_f32_fp8((int)vv.x, false); a1 += ww * __builtin_amdgcn_cvt_pk_f32_fp8((int)vv.x, true);
        a2 += ww * __builtin_amdgcn_cvt_pk_f32_fp8((int)vv.y, false); a3 += ww * __builtin_amdgcn_cvt_pk_f32_fp8((int)vv.y, true);
    }
}
__device__ __forceinline__ void phase5b(const Params& p, LAS unsigned char* lds) {
    const int tid = threadIdx.x, lane = tid & 63, wave = __builtin_amdgcn_readfirstlane(tid >> 6);
    const unsigned char* VS = p.ws + OFF_VB; const u32x4* PW = (const u32x4*)(p.ws + OFF_PW); bf16_t* OUTS = (bf16_t*)(p.ws + OFF_OUTS);
    for (int it = blockIdx.x; it < 256; it += gridDim.x) {
        const int s = it >> 1, tbase = (it & 1) * 128;
        __syncthreads();
#pragma unroll 4
        for (int i = 0; i < 16; ++i) *(LAS u32x4*)(lds + (tid + NTHR * i) * 16) = *(const u32x4*)(VS + (size_t)s * 131072 + (size_t)(tid + NTHR * i) * 16);
        __syncthreads();
        u32x4 A[8], Bq[8];
#define P5B_LOAD(R, gi) do { const int _T = tbase + wave + 8 * ((gi) >> 2), _g = (gi) & 3; const u32x4* _p = PW + ((size_t)_T * 32 + _g * 8) * 64 + lane; \
        _Pragma("unroll") for (int _i = 0; _i < 8; ++_i) R[_i] = _p[_i * 64]; } while (0)
        f32x2 a0 = {0.f, 0.f}, a1 = {0.f, 0.f}, a2 = {0.f, 0.f}, a3 = {0.f, 0.f};
        P5B_LOAD(A, 0);
        for (int gi = 0; gi < 64; gi += 2) {
            P5B_LOAD(Bq, gi + 1);
#pragma unroll
            for (int i = 0; i < 8; ++i) p5b_quad(lds, A[i], a0, a1, a2, a3);
            if (gi + 2 < 64) P5B_LOAD(A, gi + 2);
#pragma unroll
            for (int i = 0; i < 8; ++i) p5b_quad(lds, Bq[i], a0, a1, a2, a3);
            if (((gi + 1) & 3) == 3) {
                const int T = tbase + wave + 8 * (gi >> 2);
                *(u32x4*)(OUTS + ((size_t)s * NTOK + T * 64 + lane) * 8) = (u32x4){pk2(a0.x, a0.y), pk2(a1.x, a1.y), pk2(a2.x, a2.y), pk2(a3.x, a3.y)};
                a0 = (f32x2){0.f, 0.f}; a1 = a0; a2 = a0; a3 = a0;
            }
        }
#undef P5B_LOAD
    }
}

__device__ __forceinline__ void phase5c(const Params& p, LAS unsigned char* lds) {
    const int tid = threadIdx.x, lane = tid & 63, wave = __builtin_amdgcn_readfirstlane(tid >> 6);
    const bf16_t* OUTS = (const bf16_t*)(p.ws + OFF_OUTS); const bf16_t* H2B = (const bf16_t*)(p.ws + OFF_H2B); const float* fw = p.in[20];
    for (int it = blockIdx.x; it < NTOK / 32; it += gridDim.x) {
        const int t0 = it * 32;
        __syncthreads();
#pragma unroll 4
        for (int i = 0; i < 8; ++i) {
            const int q = tid + NTHR * i, s = q >> 5, tt = q & 31;
            *(LAS u32x4*)(lds + tt * 2064 + s * 16) = *(const u32x4*)(OUTS + ((size_t)s * NTOK + t0 + tt) * 8);
        }
        __syncthreads();
        for (int i = 0; i < 4; ++i) {
            const int tt = wave * 4 + i; float* orow = p.out + (size_t)(t0 + tt) * DM;
            f32x4 h[4]; float ss = 0.f;
#pragma unroll
            for (int j = 0; j < 2; ++j) {
                const u32x4 a = *(const u32x4*)(H2B + (size_t)(t0 + tt) * DM + 512 * j + 8 * lane), pq = *(const LAS u32x4*)(lds + tt * 2064 + (512 * j + 8 * lane) * 2);
                h[2 * j] = (f32x4){bflo(a.x) + bflo(pq.x), bfhi(a.x) + bfhi(pq.x), bflo(a.y) + bflo(pq.y), bfhi(a.y) + bfhi(pq.y)};
                h[2 * j + 1] = (f32x4){bflo(a.z) + bflo(pq.z), bfhi(a.z) + bfhi(pq.z), bflo(a.w) + bflo(pq.w), bfhi(a.w) + bfhi(pq.w)};
            }
#pragma unroll
            for (int j = 0; j < 4; ++j) ss += h[j].x * h[j].x + h[j].y * h[j].y + h[j].z * h[j].z + h[j].w * h[j].w;
            const float rs = rsqrtf(wave_sum(ss) * (1.f / DM) + EPS);
#pragma unroll
            for (int j = 0; j < 2; ++j) {
                float* o = orow + 512 * j + 8 * lane; const float* w = fw + 512 * j + 8 * lane;
                *(f32x4*)o = h[2 * j] * rs * *(const f32x4*)w; *(f32x4*)(o + 4) = h[2 * j + 1] * rs * *(const f32x4*)(w + 4);
            }
        }
    }
}


#define XB_TMO      128
#define XB_XCNT(j)  (256  + 64 * (j))
#define XB_XSUB(j)  (1280 + 64 * (j))
#define XB_XGEN(j)  (2304 + 64 * (j))
#define XB_TOP      3328
#define XB_TOPGEN   3392
#define XCD_BAR_WORDS 3456
#define XB_SPIN_CAP (1u << 18)
__device__ __forceinline__ unsigned xb_ld(unsigned* p)              { return __hip_atomic_load(p, __ATOMIC_RELAXED, __HIP_MEMORY_SCOPE_AGENT); }
__device__ __forceinline__ unsigned xb_add(unsigned* p, unsigned v) { return __hip_atomic_fetch_add(p, v, __ATOMIC_RELAXED, __HIP_MEMORY_SCOPE_AGENT); }
__device__ __forceinline__ unsigned xb_xcc_id() { return (unsigned)__builtin_amdgcn_s_getreg((3 << 11) | 20) & 0xFu; }
#define XB_SPIN(cond, bar) do { unsigned _sp = 0; while (cond) { __builtin_amdgcn_s_sleep(1); \
    if ((++_sp & 255u) == 0u) { if (xb_ld(&(bar)[XB_TMO])) break; if (_sp > XB_SPIN_CAP) { atomicAdd(&(bar)[XB_TMO], 1u); break; } } } } while (0)
struct XcdBarrier { unsigned* bar; unsigned x; volatile LAS unsigned* st; };
__device__ __forceinline__ XcdBarrier xcd_barrier_post(unsigned* bar, volatile LAS unsigned* st) {
    XcdBarrier b; b.bar = bar; b.x = xb_xcc_id(); b.st = st;
    if (threadIdx.x == 0) (void)xb_add(&bar[XB_XCNT(b.x)], 1u);
    return b;
}
__device__ __forceinline__ void xcd_barrier_complete(unsigned* bar, unsigned x, unsigned& nloc, unsigned& nx) {
    const unsigned G = gridDim.x * gridDim.y * gridDim.z;
    unsigned sum, cnt, mine, sp = 0u;
    for (;;) {
        sum = 0u; cnt = 0u; mine = 0u;
#pragma unroll
        for (unsigned j = 0; j < 16; ++j) { const unsigned c = xb_ld(&bar[XB_XCNT(j)]); sum += c; cnt += (c > 0u) ? 1u : 0u; mine = (j == x) ? c : mine; }
        if (sum == G) break;
        __builtin_amdgcn_s_sleep(1);
        if ((++sp & 255u) == 0u) { if (xb_ld(&bar[XB_TMO])) break; if (sp > XB_SPIN_CAP) { atomicAdd(&bar[XB_TMO], 1u); break; } }
    }
    nloc = mine > 0u ? mine : 1u; nx = cnt > 0u ? cnt : 1u;
}
__device__ __forceinline__ void xcd_barrier(const XcdBarrier& b) {
    asm volatile("s_waitcnt vmcnt(0)" ::: "memory");
    __syncthreads();
    if (threadIdx.x == 0) {
        unsigned* bar = b.bar;
        __builtin_amdgcn_s_waitcnt(0);
        unsigned nloc = b.st[0], nx = b.st[1];
        if (nloc == 0u) { xcd_barrier_complete(bar, b.x, nloc, nx); b.st[0] = nloc; b.st[1] = nx; }
        const unsigned old = xb_add(&bar[XB_XSUB(b.x)], 1u);
        const unsigned gen = old / nloc;
        if (old + 1u == (gen + 1u) * nloc) {
            __builtin_amdgcn_fence(__ATOMIC_RELEASE, "agent");
            asm volatile("s_waitcnt vmcnt(0)" ::: "memory");
            const unsigned og = xb_add(&bar[XB_TOP], 1u);
            const unsigned tg = og / nx;
            if (og + 1u == (tg + 1u) * nx) xb_add(&bar[XB_TOPGEN], 1u);
            else XB_SPIN(xb_ld(&bar[XB_TOPGEN]) == tg, bar);
            __builtin_amdgcn_fence(__ATOMIC_ACQUIRE, "agent");
            xb_add(&bar[XB_XGEN(b.x)], 1u);
            asm volatile("s_waitcnt vmcnt(0)" ::: "memory");
        } else {
            XB_SPIN(xb_ld(&bar[XB_XGEN(b.x)]) == gen, bar);
            __builtin_amdgcn_fence(__ATOMIC_ACQUIRE, "agent");
            asm volatile("s_waitcnt vmcnt(0)" ::: "memory");
        }
    }
    __syncthreads();
}

constexpr int NPHASE = 9;
__global__ void __launch_bounds__(NTHR, 2) mega(Params p) {
    extern __shared__ __attribute__((aligned(16))) unsigned char lds[];
    cg::grid_group grid = cg::this_grid();
#define PH_ON(k) (p.ph_lo <= (k) && (k) < p.ph_hi)
    if (threadIdx.x < 2) ((LAS unsigned*)((LAS unsigned char*)lds + LDS_BYTES - 32))[threadIdx.x] = 0u;
    __syncthreads();
    const XcdBarrier xbar = xcd_barrier_post((unsigned*)(p.ws + OFF_CTL) + 8192, (volatile LAS unsigned*)((LAS unsigned char*)lds + LDS_BYTES - 32));
#define PH_SYNC(k) do { if (PH_ON(k) && PH_ON((k) + 1)) { xcd_barrier(xbar); } } while (0)
    if (PH_ON(0)) phase0(p, lds);
    PH_SYNC(0);
    if (PH_ON(1)) phase1_mfma(p, (LAS unsigned char*)lds);
#if PROBE_DUP == 1
    grid.sync(); phase1_mfma(p, (LAS unsigned char*)lds);
#endif
    PH_SYNC(1);
    if (PH_ON(2)) phase2(p, (LAS unsigned char*)lds);
#if PROBE_DUP == 2
    grid.sync(); phase2(p, (LAS unsigned char*)lds, 1);
#endif
#if PROBE_DUP == 21
    grid.sync(); phase2(p, (LAS unsigned char*)lds, 2);
#endif
#if PROBE_DUP == 22
    grid.sync(); phase2(p, (LAS unsigned char*)lds, 3);
#endif
    PH_SYNC(2);
    if (PH_ON(4)) phase3_mfma(p, (LAS unsigned char*)lds);
#if PROBE_DUP == 4
    grid.sync(); phase3_mfma(p, (LAS unsigned char*)lds);
#endif
    PH_SYNC(4);
    if (PH_ON(5)) { phase4_mfma(p, (LAS unsigned char*)lds); quantize_hn(p); }
#if PROBE_DUP == 5
    grid.sync(); phase4_mfma(p, (LAS unsigned char*)lds);
#endif
    PH_SYNC(5);
    if (PH_ON(6)) phase5a(p, (LAS unsigned char*)lds);
#if PROBE_DUP == 6
    grid.sync(); phase5a(p, (LAS unsigned char*)lds, 1024);
#endif
    PH_SYNC(6);
    if (PH_ON(7)) phase5b(p, (LAS unsigned char*)lds);
#if PROBE_DUP == 7
    grid.sync(); phase5b(p, (LAS unsigned char*)lds);
#endif
    PH_SYNC(7);
    if (PH_ON(8)) phase5c(p, (LAS unsigned char*)lds);
}

extern "C" void kernel_launch(void* const* d_in, const int* in_sizes, int n_in, void* d_out, int out_size, void* d_ws, size_t ws_size, hipStream_t stream) {
    static int grid = 0;
    if (grid == 0) {
        if (n_in != 21 || out_size != NTOK * DM || ws_size < WS_END) { fprintf(stderr, "kernel_launch: unexpected shapes (n_in %d out %d ws %zu)\n", n_in, out_size, ws_size); grid = -1; return; }
        int dev = 0, cus = 0, per_cu = 0;
        hipGetDevice(&dev);
        hipDeviceGetAttribute(&cus, hipDeviceAttributeMultiprocessorCount, dev);
        hipFuncSetAttribute((const void*)mega, hipFuncAttributeMaxDynamicSharedMemorySize, LDS_BYTES);
        hipOccupancyMaxActiveBlocksPerMultiprocessor(&per_cu, (const void*)mega, NTHR, LDS_BYTES);
        if (per_cu < 1) { fprintf(stderr, "kernel_launch: occupancy query says %d blocks/CU\n", per_cu); per_cu = 1; }
        grid = cus * 1;
        (void)hipGetLastError();
    }
    if (grid < 0) return;
    hipMemsetAsync((char*)d_ws + OFF_CTL, 0, CTL_BYTES, stream);
    Params p{};
    for (int i = 0; i < 21; ++i) p.in[i] = (const float*)d_in[i];
    p.out = (float*)d_out; p.ws = (unsigned char*)d_ws; p.ph_lo = 0; p.ph_hi = NPHASE;
    void* args[] = {&p};
    hipError_t e = hipLaunchCooperativeKernel((const void*)mega, dim3(grid), dim3(NTHR), args, LDS_BYTES, stream);
    if (e != hipSuccess) fprintf(stderr, "cooperative launch failed: %s (grid %d)\n", hipGetErrorString(e), grid);
}
```

```cpp
#include <hip/hip_runtime.h>
#include <hip/hip_cooperative_groups.h>
#include <cstdio>
#include <cstdint>
namespace cg = cooperative_groups;

constexpr int DM = 1024;
constexpr int NB = 8, SEQ = 2048, NMETA = 16;
constexpr int NTOK = NB * SEQ;
constexpr int MROWS = 16640;
constexpr int NIN = 3584;
constexpr int TPOS = NMETA + SEQ;
constexpr float EPS = 1e-6f;
constexpr float QSCALE = 0.125f * 1.4426950408889634f;
constexpr int NEXP = 16384;
constexpr int NTHR = 512;
#ifndef PROBE_DUP
#define PROBE_DUP 0
#endif

constexpr size_t MiB = 1u << 20;
constexpr size_t OFF_CTL = 0, CTL_BYTES = 64 * 1024;
constexpr size_t OFF_MISC = 512 * 1024;
constexpr size_t OFF_ROPE = 1 * MiB;
constexpr size_t OFF_WOUT = 2 * MiB;
constexpr size_t OFF_WQ = 4 * MiB;
constexpr size_t OFF_KEYS = 8 * MiB;
constexpr size_t OFF_SSQP = 25 * MiB;
constexpr size_t OFF_UB = 9 * MiB;
constexpr size_t OFF_VB = 41 * MiB;
constexpr size_t OFF_XN = 73 * MiB;
constexpr size_t OFF_MIX = 73 * MiB;
constexpr size_t OFF_WIN = 106 * MiB;
constexpr size_t OFF_QB = 113 * MiB;
constexpr size_t OFF_KB = OFF_QB + 16 * MiB + 256 * 1024;
constexpr size_t OFF_VT = OFF_KB + 16 * MiB + 256 * 1024;
constexpr size_t OFF_H2B = 113 * MiB;
constexpr size_t OFF_GQ = 162 * MiB;
constexpr size_t OFF_GK = OFF_GQ + 8 * MiB + 256 * 1024;
constexpr size_t OFF_GVT = OFF_GK + 8 * MiB + 256 * 1024;
constexpr size_t OFF_GF = OFF_GVT + 16 * MiB + 256 * 1024;
constexpr size_t OFF_GB = OFF_GF + 16 * MiB + 256 * 1024;
constexpr size_t OFF_GR = OFF_GB + 16 * MiB + 256 * 1024;
constexpr size_t OFF_PW0 = 162 * MiB;
constexpr size_t OFF_USC = 64 * 1024;
constexpr size_t OFF_VSC = 128 * 1024;
constexpr size_t WS_END = OFF_GR + 16 * MiB + 256 * 1024;
static_assert(WS_END <= 256 * MiB, "workspace map");
static_assert(OFF_VT + (size_t)512 * MROWS * 2 <= OFF_GQ, "map D");
static_assert(OFF_WIN + (size_t)NIN * DM * 2 <= OFF_QB, "map C");

constexpr int LDS_BYTES = 163840;

typedef unsigned short bf16_t;
typedef float f32x4 __attribute__((ext_vector_type(4)));
typedef float f32x2 __attribute__((ext_vector_type(2)));
typedef unsigned u32x4 __attribute__((ext_vector_type(4)));
typedef unsigned u32x2 __attribute__((ext_vector_type(2)));
typedef __bf16 bf16x2_t __attribute__((ext_vector_type(2)));

struct Params {
    const float* in[21];
    float* out;
    unsigned char* ws;
    int ph_lo, ph_hi;
};

__device__ __forceinline__ unsigned f2bf(float f) { unsigned u = __float_as_uint(f); return (u + 0x7fffu + ((u >> 16) & 1u)) >> 16; }
__device__ __forceinline__ float bf2f(unsigned h) { return __uint_as_float(h << 16); }
__device__ __forceinline__ unsigned pk2(float lo, float hi) { return __builtin_bit_cast(unsigned, __builtin_convertvector((f32x2){lo, hi}, bf16x2_t)); }
__device__ __forceinline__ float bflo(unsigned w) { return __uint_as_float(w << 16); }
__device__ __forceinline__ float bfhi(unsigned w) { return __uint_as_float(w & 0xffff0000u); }
__device__ __forceinline__ float dot2(unsigned a, unsigned b, float c) {
    return __builtin_amdgcn_fdot2_f32_bf16(__builtin_bit_cast(bf16x2_t, a), __builtin_bit_cast(bf16x2_t, b), c, false);
}
__device__ __forceinline__ float dot8(u32x4 a, u32x4 b, float c) { c = dot2(a.x, b.x, c); c = dot2(a.y, b.y, c); c = dot2(a.z, b.z, c); return dot2(a.w, b.w, c); }
__device__ __forceinline__ float wave_sum(float v) {
#pragma unroll
    for (int o = 1; o < 64; o <<= 1) v += __shfl_xor(v, o);
    return v;
}
__device__ __forceinline__ float wave_max(float v) {
#pragma unroll
    for (int o = 1; o < 64; o <<= 1) v = fmaxf(v, __shfl_xor(v, o));
    return v;
}
__device__ __forceinline__ float silu_f(float x) { return x / (1.f + __expf(-x)); }
__device__ __forceinline__ float logsig_f(float x) { return fminf(x, 0.f) - log1pf(__expf(-fabsf(x))); }
__device__ __forceinline__ float gelu_f(float v) {
    const float av = fabsf(v), t = __builtin_amdgcn_rcpf(av * 0.2316418882f + 1.0f);
    float q = t * 0.5307027145f + (-0.7265760135f); q = q * t + 0.7107068705f; q = q * t + (-0.142248368f); q = q * t + 0.127414796f; q = q * t;
    const float m = v * (q * __builtin_amdgcn_exp2f(v * v * (-0.72134752044f)));
    return v < 0.f ? m : v - m;
}

__device__ __forceinline__ float win_src(const Params& p, int k, int n) {
    const float* W = p.in[3] + (size_t)k * 3104;
    if (n < 1024) {
        const int base = n & ~63, dp = n & 63, d = dp < 16 ? ((dp >> 1) + 8 * (dp & 1)) : dp;
        return W[base + d];
    } else if (n < 3072) return W[n];
    const int j = (n - 3072) & 255, dir = (n - 3072) >> 8;
    const float* w2 = p.in[dir ? 11 : 9];
    const float* wz = W + 3072 + dir * 16;
    float s = 0.f;
#pragma unroll
    for (int r = 0; r < 16; ++r) s += wz[r] * w2[r * 256 + j];
    return s;
}

template <int WHICH>
__device__ __forceinline__ void p0_transpose_item(const Params& p, float* scr, int item, int lane) {
    constexpr int N = WHICH == 0 ? NIN : (WHICH == 1 ? 1024 : 2048);
    constexpr int nblk = N / 32;
    const int kb = item / nblk, nb = item % nblk, k0 = 64 * kb, n0 = 32 * nb;
    bf16_t* WT = (bf16_t*)(p.ws + (WHICH == 0 ? OFF_WIN : (WHICH == 1 ? OFF_WOUT : OFF_WQ)));
#pragma unroll 4
    for (int i = 0; i < 32; ++i) {
        const int kk = 2 * i + (lane >> 5), k = k0 + kk, n = n0 + (lane & 31);
        float v;
        if (WHICH == 0) v = win_src(p, k, n);
        else if (WHICH == 1) v = p.in[14][(size_t)k * 1024 + n];
        else v = p.in[16][(size_t)k * 2048 + n] * p.in[15][k];
        scr[kk * 33 + (lane & 31)] = v;
    }
    __builtin_amdgcn_s_waitcnt(0xC07F); __builtin_amdgcn_wave_barrier();
    const int c = lane & 7;
#pragma unroll
    for (int j = 0; j < 4; ++j) {
        const int n = (lane >> 3) + 8 * j; const float* s = scr + (8 * c) * 33 + n;
        u32x4 o; o.x = pk2(s[0 * 33], s[1 * 33]); o.y = pk2(s[2 * 33], s[3 * 33]); o.z = pk2(s[4 * 33], s[5 * 33]); o.w = pk2(s[6 * 33], s[7 * 33]);
        *(u32x4*)(WT + (size_t)(n0 + n) * 1024 + k0 + 8 * c) = o;
    }
    __builtin_amdgcn_s_waitcnt(0xC07F); __builtin_amdgcn_wave_barrier();
}

__device__ __forceinline__ void phase0(const Params& p, unsigned char* lds) {
    const int tid = threadIdx.x, lane = tid & 63, wave = tid >> 6;
    const int gw = blockIdx.x * 8 + wave, NGW = gridDim.x * 8;
    const long gt = (long)blockIdx.x * NTHR + tid, NGT = (long)gridDim.x * NTHR;
    {
        const f32x4* lw = (const f32x4*)p.in[2];
        bf16_t* XN = (bf16_t*)(p.ws + OFF_XN);
        for (int r = gw; r < MROWS; r += NGW) {
            const float* src = r < NTOK ? p.in[0] + (size_t)r * DM : (r < NTOK + NMETA ? p.in[1] + (size_t)(r - NTOK) * DM : nullptr);
            f32x4 v[4]; float s = 0.f;
#pragma unroll
            for (int j = 0; j < 4; ++j) { v[j] = src ? ((const f32x4*)src)[lane + 64 * j] : (f32x4){0.f, 0.f, 0.f, 0.f}; s += v[j].x * v[j].x + v[j].y * v[j].y + v[j].z * v[j].z + v[j].w * v[j].w; }
            const float rs = rsqrtf(wave_sum(s) * (1.f / DM) + EPS);
#pragma unroll
            for (int j = 0; j < 4; ++j) { const f32x4 w = lw[lane + 64 * j]; u32x2 o; o.x = pk2(v[j].x * rs * w.x, v[j].y * rs * w.y); o.y = pk2(v[j].z * rs * w.z, v[j].w * rs * w.w);
                *(u32x2*)(XN + (size_t)r * DM + 4 * (lane + 64 * j)) = o; }
        }
    }
    {
        float* scr = (float*)lds + wave * (64 * 33);
        constexpr int I0 = 16 * (NIN / 32);
        for (int it = gw; it < I0; it += NGW) p0_transpose_item<0>(p, scr, it, lane);
    }
    {
        f32x2* rope = (f32x2*)(p.ws + OFF_ROPE);
        for (long i = gt; i < TPOS * 8; i += NGT) {
            const int t = (int)(i >> 3), j = (int)(i & 7);
            const float inv = powf(500000.0f, -(float)j * 0.125f);
            const float ang = (float)t * inv;
            rope[i] = (f32x2){cosf(ang), sinf(ang)};
        }
        if (gt == 0) {
            float a = 0.f, b = 0.f;
            for (int i = 0; i < 64; ++i) { a += p.in[4][i] * p.in[5][i]; b += p.in[6][i] * p.in[7][i]; }
            ((float*)(p.ws + OFF_MISC))[0] = expf(a) - expf(b) + 0.2f;
        }
    }
}
constexpr int CV_WOUT = 64, CV_WQ = 128, CV_KEYS = 8, CV_U = 256, CV_V = 256, CV_ITEMS = CV_WOUT + CV_WQ + CV_KEYS + CV_U + CV_V;
__device__ __forceinline__ void conv_item(const Params& p, unsigned char* lds, int c) {
    const int tid = threadIdx.x, lane = tid & 63, wave = tid >> 6;
    __syncthreads();
    if (c < CV_WOUT) { p0_transpose_item<1>(p, (float*)lds + wave * (64 * 33), c * 8 + wave, lane); return; }
    c -= CV_WOUT;
    if (c < CV_WQ) { p0_transpose_item<2>(p, (float*)lds + wave * (64 * 33), c * 8 + wave, lane); return; }
    c -= CV_WQ;
    if (c < CV_KEYS) {
        bf16_t* KEYS = (bf16_t*)(p.ws + OFF_KEYS);
#pragma unroll 2
        for (int j = 0; j < 8; ++j) {
            const long e = ((long)c * 4096 + tid + NTHR * j) * 8;
            const f32x4 a = *(const f32x4*)(p.in[17] + e), b = *(const f32x4*)(p.in[17] + e + 4);
            u32x4 o; o.x = pk2(a.x, a.y); o.y = pk2(a.z, a.w); o.z = pk2(b.x, b.y); o.w = pk2(b.z, b.w);
            *(u32x4*)(KEYS + e) = o;
        }
        return;
    }
    c -= CV_KEYS;
    if (c < CV_U) {
        unsigned char* UQ = p.ws + OFF_UB; float* USC = (float*)(p.ws + OFF_USC);
#pragma unroll 2
        for (int i = 0; i < 8; ++i) {
            const int r = c * 64 + wave * 8 + i;
            const float* ur = p.in[18] + (size_t)r * DM + 16 * lane; const float* lw = p.in[15] + 16 * lane;
            f32x4 v[4]; float am = 0.f;
#pragma unroll
            for (int j = 0; j < 4; ++j) { v[j] = ((const f32x4*)ur)[j] * ((const f32x4*)lw)[j]; am = fmaxf(am, fmaxf(fmaxf(fabsf(v[j].x), fabsf(v[j].y)), fmaxf(fabsf(v[j].z), fabsf(v[j].w)))); }
            am = fmaxf(wave_max(am), 1e-30f);
            const float sc = 224.f / am;
            u32x4 o;
#pragma unroll
            for (int j = 0; j < 4; ++j) { int w = __builtin_amdgcn_cvt_pk_fp8_f32(v[j].x * sc, v[j].y * sc, 0, false); w = __builtin_amdgcn_cvt_pk_fp8_f32(v[j].z * sc, v[j].w * sc, w, true); o[j] = (unsigned)w; }
            *(u32x4*)(UQ + (size_t)r * DM + 16 * lane) = o;
            if (lane == 0) USC[r] = am * (1.f / 224.f);
        }
        return;
    }
    c -= CV_U;
    {
        unsigned char* VS = p.ws + OFF_VB; float* VSC = (float*)(p.ws + OFF_VSC);
        const int tile = c;
#pragma unroll 2
        for (int i = 0; i < 8; ++i) {
            const int er = wave * 8 + i, r = tile * 64 + er;
            const float* vr = p.in[19] + (size_t)r * DM + 16 * lane;
            f32x4 v[4]; float am = 0.f;
#pragma unroll
            for (int j = 0; j < 4; ++j) { v[j] = ((const f32x4*)vr)[j]; am = fmaxf(am, fmaxf(fmaxf(fabsf(v[j].x), fabsf(v[j].y)), fmaxf(fabsf(v[j].z), fabsf(v[j].w)))); }
            am = fmaxf(wave_max(am), 1e-30f);
            const float sc = 224.f / am;
            u32x4 o;
#pragma unroll
            for (int j = 0; j < 4; ++j) { int w = __builtin_amdgcn_cvt_pk_fp8_f32(v[j].x * sc, v[j].y * sc, 0, false); w = __builtin_amdgcn_cvt_pk_fp8_f32(v[j].z * sc, v[j].w * sc, w, true); o[j] = (unsigned)w; }
            *(u32x2*)(lds + er * 1032 + 16 * lane) = (u32x2){o.x, o.y}; *(u32x2*)(lds + er * 1032 + 16 * lane + 8) = (u32x2){o.z, o.w};
            if (lane == 0) VSC[r] = am * (1.f / 224.f);
        }
        __syncthreads();
#pragma unroll 4
        for (int i = 0; i < 16; ++i) {
            const int s = wave + 8 * i;
            *(u32x2*)(VS + ((size_t)s * NEXP + tile * 64 + lane) * 8) = *(const u32x2*)(lds + lane * 1032 + s * 8);
        }
    }
}

struct P1Ptrs { unsigned char* ws; const float* bias_f; const float* bias_b; };
__device__ __forceinline__ void p1_store(const P1Ptrs p, int row, int n0, float v0, float v1, float v2, float v3) {
    if (n0 < 1024) {
        const int dp = n0 & 63;
        if (dp < 16) {
            const int pos = row < NTOK ? NMETA + (row & (SEQ - 1)) : (row - NTOK);
            const f32x4 cs = *(const f32x4*)((const float*)(p.ws + OFF_ROPE) + ((size_t)pos * 8 + (dp >> 1)) * 2);
            const float a0 = v0 * cs.x - v1 * cs.y, b0 = v1 * cs.x + v0 * cs.y;
            const float a1 = v2 * cs.z - v3 * cs.w, b1 = v3 * cs.z + v2 * cs.w;
            v0 = a0; v1 = b0; v2 = a1; v3 = b1;
        }
        if (n0 < 512) { u32x2 o; o.x = pk2(v0 * QSCALE, v1 * QSCALE); o.y = pk2(v2 * QSCALE, v3 * QSCALE); *(u32x2*)((bf16_t*)(p.ws + OFF_QB) + (size_t)row * 512 + n0) = o; }
        else { u32x2 o; o.x = pk2(v0, v1); o.y = pk2(v2, v3); *(u32x2*)((bf16_t*)(p.ws + OFF_KB) + (size_t)row * 512 + (n0 - 512)) = o; }
    } else if (n0 < 1536) {
        bf16_t* VT = (bf16_t*)(p.ws + OFF_VT) + (size_t)(n0 - 1024) * MROWS + row;
        VT[0] = (bf16_t)f2bf(v0); VT[MROWS] = (bf16_t)f2bf(v1); VT[2 * MROWS] = (bf16_t)f2bf(v2); VT[3 * (size_t)MROWS] = (bf16_t)f2bf(v3);
    } else if (n0 < 1792) {
        u32x2 o; o.x = pk2(v0 * 0.125f, v1 * 0.125f); o.y = pk2(v2 * 0.125f, v3 * 0.125f); *(u32x2*)((bf16_t*)(p.ws + OFF_GQ) + (size_t)row * 256 + (n0 - 1536)) = o;
    } else if (n0 < 2048) {
        u32x2 o; o.x = pk2(v0, v1); o.y = pk2(v2, v3); *(u32x2*)((bf16_t*)(p.ws + OFF_GK) + (size_t)row * 256 + (n0 - 1792)) = o;
    } else if (n0 < 2560) {
        bf16_t* VT = (bf16_t*)(p.ws + OFF_GVT) + (size_t)(n0 - 2048) * MROWS + row;
        VT[0] = (bf16_t)f2bf(v0); VT[MROWS] = (bf16_t)f2bf(v1); VT[2 * MROWS] = (bf16_t)f2bf(v2); VT[3 * (size_t)MROWS] = (bf16_t)f2bf(v3);
    } else if (n0 < 3072) {
        u32x2 o; o.x = pk2(silu_f(v0), silu_f(v1)); o.y = pk2(silu_f(v2), silu_f(v3)); *(u32x2*)((bf16_t*)(p.ws + OFF_GR) + (size_t)row * 512 + (n0 - 2560)) = o;
    } else {
        const int dir = (n0 - 3072) >> 8, j = (n0 - 3072) & 255;
        const f32x4 bb = *(const f32x4*)((dir ? p.bias_b : p.bias_f) + j);
        f32x4 o; o.x = logsig_f(v0 + bb.x) * 0.0625f; o.y = logsig_f(v1 + bb.y) * 0.0625f; o.z = logsig_f(v2 + bb.z) * 0.0625f; o.w = logsig_f(v3 + bb.w) * 0.0625f;
        *(f32x4*)((float*)(p.ws + (dir ? OFF_GB : OFF_GF)) + (size_t)row * 256 + j) = o;
    }
}


#define LAS __attribute__((address_space(3)))
typedef short bf16x8 __attribute__((ext_vector_type(8)));
constexpr int GBUF = 49152;

template <int ROWS>
__device__ __forceinline__ void stage_tile(const bf16_t* G, int ldk, int r0, int k0, LAS unsigned char* buf, int wave, int lane) {
    const int rr = lane >> 3, c = (lane & 7) ^ rr;
#pragma unroll
    for (int i = 0; i < ROWS / 64; ++i) {
        const int grp = wave + 8 * i;
        const bf16_t* src = G + (size_t)(r0 + grp * 8 + rr) * ldk + k0 + c * 8;
        __builtin_amdgcn_global_load_lds((const unsigned*)src, (LAS unsigned*)(buf + grp * 1024), 16, 0, 0);
    }
}
__device__ __forceinline__ bf16x8 ldfrag(const LAS unsigned char* buf, int row, int c) {
    return *(const LAS bf16x8*)(buf + row * 128 + ((c ^ (row & 7)) << 4));
}
template <bool SWAP>
__device__ __forceinline__ void gemm_tile_256(const bf16_t* A, const bf16_t* Bt, int K, int m0, int n0, LAS unsigned char* lds, f32x4 (&acc)[4][4]) {
    const int tid = threadIdx.x, lane = tid & 63, wave = __builtin_amdgcn_readfirstlane(tid >> 6), wm = wave >> 2, wn = wave & 3, l15 = lane & 15, g = lane >> 4;
#pragma unroll
    for (int i = 0; i < 4; ++i)
#pragma unroll
        for (int j = 0; j < 4; ++j) acc[i][j] = (f32x4){0.f, 0.f, 0.f, 0.f};
    const int nk = K / 64;
    stage_tile<128>(A, K, m0, 0, lds, wave, lane);
    stage_tile<256>(Bt, K, n0, 0, lds + 16384, wave, lane);
    for (int kt = 0; kt < nk; ++kt) {
        asm volatile("s_waitcnt vmcnt(0)" ::: "memory");
        __syncthreads();
        if (kt + 1 < nk) {
            LAS unsigned char* nb = lds + ((kt + 1) & 1) * GBUF;
            stage_tile<128>(A, K, m0, (kt + 1) * 64, nb, wave, lane);
            stage_tile<256>(Bt, K, n0, (kt + 1) * 64, nb + 16384, wave, lane);
        }
        const LAS unsigned char* a = lds + (kt & 1) * GBUF; const LAS unsigned char* b = a + 16384;
#pragma unroll
        for (int ks = 0; ks < 2; ++ks) {
            bf16x8 af[4], bfr[4];
#pragma unroll
            for (int i = 0; i < 4; ++i) { af[i] = ldfrag(a, wm * 64 + i * 16 + l15, ks * 4 + g); bfr[i] = ldfrag(b, wn * 64 + i * 16 + l15, ks * 4 + g); }
#pragma unroll
            for (int i = 0; i < 4; ++i)
#pragma unroll
                for (int j = 0; j < 4; ++j)
                    acc[i][j] = SWAP ? __builtin_amdgcn_mfma_f32_16x16x32_bf16(af[i], bfr[j], acc[i][j], 0, 0, 0)
                                     : __builtin_amdgcn_mfma_f32_16x16x32_bf16(bfr[j], af[i], acc[i][j], 0, 0, 0);
        }
    }
}
__device__ __forceinline__ int vcu_of_block() { const int G = gridDim.x, bx = blockIdx.x; return (G % 8 == 0) ? (bx % 8) * (G / 8) + bx / 8 : bx; }

namespace pg8 {
#define PG8_LAS __attribute__((address_space(3)))
typedef unsigned short bf16_t;
typedef short bf16x8 __attribute__((ext_vector_type(8)));
typedef float f32x4 __attribute__((ext_vector_type(4)));
typedef unsigned u32x4 __attribute__((ext_vector_type(4)));
constexpr int BM = 256, BK = 64, HALF = 128, HTB = HALF * BK * 2  , STAGE_BYTES = 8 * HTB, NXCD = 8, WGM = 8;

__host__ __device__ __forceinline__ int lds_byte(int r, int c) { const int st = (r >> 4) * 2 + (c >> 5), rr = r & 15, cc = c & 31, ob = rr * 64 + cc * 2; return st * 1024 + (ob ^ (((ob >> 9) & 1) << 5)); }
__host__ __device__ __forceinline__ void stage_rc(int b, int& R, int& C) { const int st = b / 1024, sb = b % 1024, swz = sb ^ (((sb >> 9) & 1) << 5); R = (st >> 1) * 16 + swz / 64; C = (st & 1) * 32 + (swz % 64) / 2; }
__host__ __device__ __forceinline__ int perm32(int rho) { const int n = rho >> 4, i = rho & 15; return 8 * (i >> 2) + 4 * n + (i & 3); }

struct Unit { int pm, pn; };
struct Gemm { const bf16_t* A; const bf16_t* Bt; int M, N, K; };

struct StaticOrder {
    int nM, nN, nwg, G, c;
    __host__ __device__ void init(int M, int N, int G_, int c_) { nM = M / BM; nN = N / BM; nwg = nM * nN; G = G_; c = c_; }
    __host__ __device__ bool next(int i, Unit& u) const {
        const long L = (long)i * G + c; if (L >= nwg) return false;
        int wgid = (int)L; { const int q = nwg / NXCD, r = nwg % NXCD, xcd = wgid % NXCD, off = wgid / NXCD; wgid = (xcd < r ? xcd * (q + 1) : r * (q + 1) + (xcd - r) * q) + off; }
        const int nig = WGM * nN, gid = wgid / nig, fm = gid * WGM, gsz = (nM - fm) < WGM ? (nM - fm) : WGM;
        u.pm = fm + ((wgid % nig) % gsz); u.pn = (wgid % nig) / gsz; return true;
    }
    __device__ __forceinline__ void a_ready(const Unit&) const {}
    __device__ __forceinline__ void done(const Unit&) const {}
};

struct EpiP1 {
    static constexpr bool PERM = false, AFTER_DRAIN = false;
    P1Ptrs p;
    __device__ __forceinline__ void operator()(const f32x4 (&acc)[2][2][4][2], const Unit& u, int wr, int wc, int fr, int fq) const {
#pragma unroll
        for (int bj = 0; bj < 2; ++bj) {
            const int nw = u.pn * BM + bj * HALF + wc * 32;
            const int rowb = u.pm * BM + wr * 64 + fr;
            if (nw >= 3072) {
                const int dir = (nw - 3072) >> 8, j0 = ((nw - 3072) & 255) + 4 * fq;
                float* G = (float*)(p.ws + (dir ? OFF_GB : OFF_GF)); const float* bias = dir ? p.bias_b : p.bias_f;
#pragma unroll
                for (int n = 0; n < 2; ++n) { const f32x4 bb = *(const f32x4*)(bias + j0 + 16 * n);
#pragma unroll
                    for (int ai = 0; ai < 2; ++ai)
#pragma unroll
                        for (int m = 0; m < 4; ++m) { const f32x4 v = acc[ai][bj][m][n]; f32x4 o;
                            o.x = logsig_f(v.x + bb.x) * 0.0625f; o.y = logsig_f(v.y + bb.y) * 0.0625f; o.z = logsig_f(v.z + bb.z) * 0.0625f; o.w = logsig_f(v.w + bb.w) * 0.0625f;
                            *(f32x4*)(G + (size_t)(rowb + ai * HALF + m * 16) * 256 + j0 + 16 * n) = o; } }
            } else if ((nw >= 1024 && nw < 1536) || (nw >= 2048 && nw < 2560)) {
                bf16_t* T = (bf16_t*)(p.ws + (nw < 1536 ? OFF_VT : OFF_GVT)) + (size_t)((nw < 1536 ? nw - 1024 : nw - 2048) + 4 * fq) * MROWS + rowb;
#pragma unroll
                for (int n = 0; n < 2; ++n)
#pragma unroll
                    for (int ai = 0; ai < 2; ++ai)
#pragma unroll
                        for (int m = 0; m < 4; ++m) { const f32x4 v = acc[ai][bj][m][n]; bf16_t* t = T + (size_t)(16 * n) * MROWS + ai * HALF + m * 16;
                            t[0] = (bf16_t)f2bf(v.x); t[MROWS] = (bf16_t)f2bf(v.y); t[2 * MROWS] = (bf16_t)f2bf(v.z); t[3 * (size_t)MROWS] = (bf16_t)f2bf(v.w); }
            } else {
                bf16_t* base; int ld, c0; float sc = 1.f; bool silu = false;
                if (nw < 512) { base = (bf16_t*)(p.ws + OFF_QB); ld = 512; c0 = nw; sc = QSCALE; }
                else if (nw < 1024) { base = (bf16_t*)(p.ws + OFF_KB); ld = 512; c0 = nw - 512; }
                else if (nw < 1792) { base = (bf16_t*)(p.ws + OFF_GQ); ld = 256; c0 = nw - 1536; sc = 0.125f; }
                else if (nw < 2048) { base = (bf16_t*)(p.ws + OFF_GK); ld = 256; c0 = nw - 1792; }
                else { base = (bf16_t*)(p.ws + OFF_GR); ld = 512; c0 = nw - 2560; silu = true; }
                const bool rope = nw < 1024 && (nw & 63) == 0;
#pragma unroll
                for (int ai = 0; ai < 2; ++ai)
#pragma unroll
                    for (int m = 0; m < 4; ++m) {
                        const int row = rowb + ai * HALF + m * 16;
#pragma unroll
                        for (int n = 0; n < 2; ++n) {
                            f32x4 v = acc[ai][bj][m][n];
                            if (n == 0 && rope) {
                                const int pos = row < NTOK ? NMETA + (row & (SEQ - 1)) : (row - NTOK < TPOS ? row - NTOK : 0);
                                const f32x4 cs = *(const f32x4*)((const float*)(p.ws + OFF_ROPE) + ((size_t)pos * 8 + 2 * fq) * 2);
                                const float a0 = v.x * cs.x - v.y * cs.y, b0 = v.y * cs.x + v.x * cs.y, a1 = v.z * cs.z - v.w * cs.w, b1 = v.w * cs.z + v.z * cs.w;
                                v = (f32x4){a0, b0, a1, b1};
                            }
                            if (silu) v = (f32x4){silu_f(v.x), silu_f(v.y), silu_f(v.z), silu_f(v.w)}; else v = v * sc;
                            *(u32x2*)(base + (size_t)row * ld + c0 + 16 * n + 4 * fq) = (u32x2){pk2(v.x, v.y), pk2(v.z, v.w)};
                        }
                    }
            }
        }
    }
};
struct EpiP3 {
    static constexpr bool PERM = false, AFTER_DRAIN = false;
    const float* x; float* out; bf16_t* h2b; float* ssq;
    __device__ __forceinline__ void operator()(const f32x4 (&acc)[2][2][4][2], const Unit& u, int wr, int wc, int fr, int fq) const {
#pragma unroll
        for (int ai = 0; ai < 2; ++ai)
#pragma unroll
            for (int m = 0; m < 4; ++m) { const int row = u.pm * BM + ai * HALF + wr * 64 + m * 16 + fr; float ss = 0.f;
#pragma unroll
                for (int bj = 0; bj < 2; ++bj)
#pragma unroll
                    for (int n = 0; n < 2; ++n) { const int col = u.pn * BM + bj * HALF + wc * 32 + n * 16 + 4 * fq;
                        const f32x4 hv = *(const f32x4*)(x + (size_t)row * DM + col) + acc[ai][bj][m][n];
                        *(u32x2*)(h2b + (size_t)row * DM + col) = (u32x2){pk2(hv.x, hv.y), pk2(hv.z, hv.w)};
                        ss += hv.x * hv.x + hv.y * hv.y + hv.z * hv.z + hv.w * hv.w; }
                ss += __shfl_xor(ss, 16); ss += __shfl_xor(ss, 32);
                if (fq == 0) ssq[(size_t)row * 16 + u.pn * 4 + wc] = ss; }
    }
};
struct OneUnit {
    Unit u; bool valid;
    __device__ __forceinline__ bool next(int i, Unit& o) const { if (i != 0 || !valid) return false; o = u; return true; }
    __device__ __forceinline__ void a_ready(const Unit&) const {}
    __device__ __forceinline__ void done(const Unit&) const {}
};

template <class Epi, class Sched, bool ALIGN_EPI = false, bool SP2 = false>
__device__ __forceinline__ void gemm_phase(PG8_LAS unsigned char* lds, const Gemm g, const Sched& S, const Epi& E) {
    int tid_ = threadIdx.x; asm volatile("" : "+v"(tid_));
    const int tid = tid_, wid = __builtin_amdgcn_readfirstlane(tid >> 6), lane = tid & 63, wr = wid >> 2, wc = wid & 3, fr = lane & 15, fq = lane >> 4;
    const int K = g.K, nt = K / BK;
    unsigned voffA[2], voffB[2];
#pragma unroll
    for (int i = 0; i < 2; ++i) { int R, C; stage_rc(tid * 16 + i * 8192, R, C); const int Rb = Epi::PERM ? ((R & ~31) + perm32(R & 31)) : R;
        voffA[i] = (unsigned)(R * K + C) * 2u; voffB[i] = (unsigned)(Rb * K + C) * 2u; }
    const size_t kstep = (size_t)(BK * 2);
    const size_t hstep = (size_t)HALF * K * 2;
    const size_t tstep = 2 * hstep;
    const unsigned ldsw = (unsigned)wid * 1024u;
    const int aoff = lds_byte(wr * 64 + fr, fq * 8), boff = lds_byte(wc * 32 + fr, fq * 8);
#define PG8_SA(b, h) (((b) * 2 + (h)) * HTB)
#define PG8_SB(b, h) ((4 + (b) * 2 + (h)) * HTB)
#define PG8_STAGE(bufoff, gbase, voff) do { _Pragma("unroll") for (int _i = 0; _i < 2; ++_i) \
        __builtin_amdgcn_global_load_lds((const unsigned*)((const char*)(gbase) + (voff)[_i]), (PG8_LAS unsigned*)(lds + (bufoff) + ldsw + _i * 8192), 16, 0, 0); } while (0)
#define PG8_LDA(dst, b, h) do { _Pragma("unroll") for (int m = 0; m < 4; ++m) _Pragma("unroll") for (int k = 0; k < 2; ++k) dst[m][k] = *(const PG8_LAS bf16x8*)(lds + PG8_SA(b, h) + aoff + m * 2048 + k * 1024); } while (0)
#define PG8_LDB(dst, b, h) do { _Pragma("unroll") for (int n = 0; n < 2; ++n) _Pragma("unroll") for (int k = 0; k < 2; ++k) dst[n][k] = *(const PG8_LAS bf16x8*)(lds + PG8_SB(b, h) + boff + n * 2048 + k * 1024); } while (0)
#define PG8_MMA(ai, bj, At, Bt) do { __builtin_amdgcn_s_setprio(1); _Pragma("unroll") for (int m = 0; m < 4; ++m) _Pragma("unroll") for (int n = 0; n < 2; ++n) _Pragma("unroll") for (int k = 0; k < 2; ++k) \
        acc[ai][bj][m][n] = __builtin_amdgcn_mfma_f32_16x16x32_bf16(Bt[n][k], At[m][k], acc[ai][bj][m][n], 0, 0, 0); __builtin_amdgcn_s_setprio(0); } while (0)
#define PG8_WAIT_V(n) asm volatile("s_waitcnt vmcnt(" #n ")" ::: "memory")
#define PG8_WAIT_L(n) asm volatile("s_waitcnt lgkmcnt(" #n ")" ::: "memory")
#define PG8_BAR __builtin_amdgcn_s_barrier()
#define PG8_SCHED __builtin_amdgcn_sched_barrier(0)
    Unit cur, nxt; int ui = 0;
    if (!S.next(0, cur)) return;
    f32x4 acc[2][2][4][2];
#pragma unroll
    for (int a = 0; a < 2; ++a)
#pragma unroll
        for (int b = 0; b < 2; ++b)
#pragma unroll
            for (int m = 0; m < 4; ++m)
#pragma unroll
                for (int n = 0; n < 2; ++n) acc[a][b][m][n] = (f32x4){0.f, 0.f, 0.f, 0.f};
    bf16x8 At[4][2], B0[2][2], B1[2][2];
    const char* cA = (const char*)g.A + (size_t)cur.pm * tstep; const char* cB = (const char*)g.Bt + (size_t)cur.pn * tstep;
    S.a_ready(cur);
    if constexpr (SP2) {
        PG8_STAGE(PG8_SB(0, 0), cB, voffB); PG8_STAGE(PG8_SB(0, 1), cB + hstep, voffB); PG8_STAGE(PG8_SA(0, 0), cA, voffA); PG8_STAGE(PG8_SA(0, 1), cA + hstep, voffA);
        if (wr == 1) PG8_BAR;
        PG8_WAIT_V(2); PG8_BAR;
        PG8_STAGE(PG8_SB(1, 0), cB + kstep, voffB); PG8_STAGE(PG8_SA(1, 0), cA + kstep, voffA); PG8_STAGE(PG8_SB(1, 1), cB + hstep + kstep, voffB);
        PG8_WAIT_V(6); PG8_BAR;
    } else {
        PG8_STAGE(PG8_SB(0, 0), cB, voffB); PG8_STAGE(PG8_SA(0, 0), cA, voffA); PG8_STAGE(PG8_SB(0, 1), cB + hstep, voffB); PG8_STAGE(PG8_SA(0, 1), cA + hstep, voffA);
        if (wr == 1) PG8_BAR;
        PG8_WAIT_V(4); PG8_BAR;
        PG8_STAGE(PG8_SB(1, 0), cB + kstep, voffB); PG8_STAGE(PG8_SA(1, 0), cA + kstep, voffA); PG8_STAGE(PG8_SB(1, 1), cB + hstep + kstep, voffB);
        PG8_WAIT_V(6); PG8_BAR;
    }
    for (;;) {
        const bool has_next = S.next(ui + 1, nxt);
        const char* nA = has_next ? (const char*)g.A + (size_t)nxt.pm * tstep : cA; const char* nB = has_next ? (const char*)g.Bt + (size_t)nxt.pn * tstep : cB;
        for (int t = 0; t < nt; t += 2) {
            const bool last = (t == nt - 2);
            const char* a1 = cA + (size_t)(t + 1) * kstep;
            const char* a2 = last ? nA : cA + (size_t)(t + 2) * kstep; const char* b2 = last ? nB : cB + (size_t)(t + 2) * kstep;
            const char* a3 = a2 + kstep; const char* b3 = b2 + kstep;
            if (last && has_next) S.a_ready(nxt);
            if constexpr (SP2) {
            PG8_LDB(B0, 0, 0); PG8_LDB(B1, 0, 1); PG8_SCHED; PG8_LDA(At, 0, 0); PG8_STAGE(PG8_SA(1, 1), a1 + hstep, voffA);
            PG8_WAIT_V(8); PG8_WAIT_L(0); PG8_BAR; PG8_MMA(0, 0, At, B0); PG8_MMA(0, 1, At, B1); PG8_BAR; PG8_SCHED;
            PG8_LDA(At, 0, 1); PG8_STAGE(PG8_SB(0, 0), b2, voffB); PG8_STAGE(PG8_SB(0, 1), b2 + hstep, voffB); PG8_STAGE(PG8_SA(0, 0), a2, voffA);
            PG8_WAIT_V(8); PG8_WAIT_L(0); PG8_BAR; PG8_MMA(1, 0, At, B0); PG8_MMA(1, 1, At, B1); PG8_BAR; PG8_SCHED;
            PG8_LDB(B0, 1, 0); PG8_LDB(B1, 1, 1); PG8_SCHED; PG8_LDA(At, 1, 0); PG8_STAGE(PG8_SA(0, 1), a2 + hstep, voffA);
            PG8_WAIT_V(8); PG8_WAIT_L(0); PG8_BAR; PG8_MMA(0, 0, At, B0); PG8_MMA(0, 1, At, B1); PG8_BAR; PG8_SCHED;
            PG8_LDA(At, 1, 1); PG8_STAGE(PG8_SB(1, 0), b3, voffB); PG8_STAGE(PG8_SB(1, 1), b3 + hstep, voffB); PG8_STAGE(PG8_SA(1, 0), a3, voffA);
            PG8_WAIT_V(8); PG8_WAIT_L(0); PG8_BAR; PG8_MMA(1, 0, At, B0); PG8_MMA(1, 1, At, B1); PG8_BAR; PG8_SCHED;
            } else {
            PG8_LDB(B0, 0, 0); PG8_SCHED; PG8_LDA(At, 0, 0); PG8_STAGE(PG8_SA(1, 1), a1 + hstep, voffA);
            PG8_WAIT_L(8); PG8_BAR; PG8_WAIT_L(0); PG8_MMA(0, 0, At, B0); PG8_BAR; PG8_SCHED;
            PG8_LDB(B1, 0, 1); PG8_STAGE(PG8_SB(0, 0), b2, voffB);
            PG8_BAR; PG8_WAIT_L(0); PG8_MMA(0, 1, At, B1); PG8_BAR;
            PG8_LDA(At, 0, 1); PG8_STAGE(PG8_SA(0, 0), a2, voffA);
            PG8_BAR; PG8_WAIT_L(0); PG8_MMA(1, 0, At, B0); PG8_BAR; PG8_SCHED;
            PG8_STAGE(PG8_SB(0, 1), b2 + hstep, voffB);
            PG8_WAIT_V(6); PG8_BAR; PG8_MMA(1, 1, At, B1); PG8_BAR;
            PG8_LDB(B0, 1, 0); PG8_SCHED; PG8_LDA(At, 1, 0); PG8_STAGE(PG8_SA(0, 1), a2 + hstep, voffA);
            PG8_WAIT_L(8); PG8_BAR; PG8_WAIT_L(0); PG8_MMA(0, 0, At, B0); PG8_BAR; PG8_SCHED;
            PG8_LDB(B1, 1, 1); PG8_STAGE(PG8_SB(1, 0), b3, voffB);
            PG8_BAR; PG8_WAIT_L(0); PG8_MMA(0, 1, At, B1); PG8_BAR;
            PG8_LDA(At, 1, 1); PG8_STAGE(PG8_SA(1, 0), a3, voffA);
            PG8_BAR; PG8_WAIT_L(0); PG8_MMA(1, 0, At, B0); PG8_BAR; PG8_SCHED;
            PG8_STAGE(PG8_SB(1, 1), b3 + hstep, voffB);
            PG8_WAIT_V(6); PG8_BAR; PG8_MMA(1, 1, At, B1); PG8_BAR;
            }
        }
        if constexpr (ALIGN_EPI) { if (wr == 0) PG8_BAR; }
        if constexpr (!Epi::AFTER_DRAIN) { E(acc, cur, wr, wc, fr, fq); S.done(cur); }
        if (!has_next) break;
#pragma unroll
        for (int a = 0; a < 2; ++a)
#pragma unroll
            for (int b = 0; b < 2; ++b)
#pragma unroll
                for (int m = 0; m < 4; ++m)
#pragma unroll
                    for (int n = 0; n < 2; ++n) acc[a][b][m][n] = (f32x4){0.f, 0.f, 0.f, 0.f};
        cur = nxt; cA = nA; cB = nB; ++ui;
        if constexpr (ALIGN_EPI) { if (wr == 1) PG8_BAR; }
    }
    PG8_WAIT_V(0);
    if constexpr (!ALIGN_EPI) { if (wr == 0) PG8_BAR; }
    PG8_BAR;
    if constexpr (Epi::AFTER_DRAIN) { E.fused(acc, cur, wr, wc, fr, fq, lds, wid, lane); S.done(cur); }
#undef PG8_SA
#undef PG8_SB
#undef PG8_STAGE
#undef PG8_LDA
#undef PG8_LDB
#undef PG8_MMA
#undef PG8_WAIT_V
#undef PG8_WAIT_L
#undef PG8_BAR
#undef PG8_SCHED
}
}
__device__ __forceinline__ float row_rstd(const float* ssq, int row) {
    const f32x4* q = (const f32x4*)(ssq + (size_t)row * 16);
    const f32x4 a = q[0], b = q[1], c = q[2], d = q[3];
    return rsqrtf(((((a.x + a.y) + (a.z + a.w)) + ((b.x + b.y) + (b.z + b.w))) + (((c.x + c.y) + (c.z + c.w)) + ((d.x + d.y) + (d.z + d.w)))) * (1.f / DM) + EPS);
}
__device__ __forceinline__ void phase1_mfma(const Params& p, LAS unsigned char* lds) {
    pg8::Gemm g{(const pg8::bf16_t*)(p.ws + OFF_XN), (const pg8::bf16_t*)(p.ws + OFF_WIN), MROWS, NIN, DM};
    pg8::StaticOrder S; S.init(MROWS, NIN, (int)gridDim.x, (int)blockIdx.x);
    pg8::EpiP1 E{P1Ptrs{p.ws, p.in[10], p.in[12]}};
    pg8::gemm_phase<pg8::EpiP1, pg8::StaticOrder, true, true>(lds, g, S, E);
}
__device__ __forceinline__ void phase3_mfma(const Params& p, LAS unsigned char* lds) {
    pg8::Gemm g{(const pg8::bf16_t*)(p.ws + OFF_MIX), (const pg8::bf16_t*)(p.ws + OFF_WOUT), NTOK, DM, DM};
    pg8::StaticOrder S; S.init(NTOK, DM, (int)gridDim.x, (int)blockIdx.x);
    pg8::EpiP3 E{p.in[0], p.out, (bf16_t*)(p.ws + OFF_H2B), (float*)(p.ws + OFF_SSQP)};
    pg8::gemm_phase<pg8::EpiP3, pg8::StaticOrder, true, true>(lds, g, S, E);
}

typedef float f32x16 __attribute__((ext_vector_type(16)));
constexpr int AT_KROW = 272, AT_VROW = 144, AT_KBYTES = 64 * AT_KROW, AT_VBYTES = 128 * AT_VROW, AT_STAGE = AT_KBYTES + AT_VBYTES;
__device__ __forceinline__ void attn_item(const Params& p, LAS unsigned char* lds, int item) {
    const int tid = threadIdx.x, lane = tid & 63, wave = __builtin_amdgcn_readfirstlane(tid >> 6), qg = wave >> 1, c = wave & 1, l31 = lane & 31, hh = lane >> 5;
    const int qt = item & 15, h = (item >> 4) & 3, b = item >> 6;
    const int r0 = b * SEQ + qt * 128;
    const bf16_t* QB = (const bf16_t*)(p.ws + OFF_QB); const bf16_t* KB = (const bf16_t*)(p.ws + OFF_KB); const bf16_t* VT = (const bf16_t*)(p.ws + OFF_VT);
    bf16x8 qf[4];
    {
        const bf16_t* qp = QB + (size_t)(r0 + qg * 32 + l31) * 512 + h * 128 + c * 64 + 8 * hh;
#pragma unroll
        for (int s = 0; s < 4; ++s) qf[s] = *(const bf16x8*)(qp + 16 * s);
    }
    f32x16 O[4];
#pragma unroll
    for (int i = 0; i < 4; ++i)
#pragma unroll
        for (int r = 0; r < 16; ++r) O[i][r] = 0.f;
    float m = 0.f, l = 0.f;
    const int kq0 = tid, kq1 = tid + 512;
    const bf16_t* kg0 = KB + (size_t)(kq0 >> 4) * 512 + h * 128 + (kq0 & 15) * 8; const bf16_t* kg1 = KB + (size_t)(kq1 >> 4) * 512 + h * 128 + (kq1 & 15) * 8;
    const bf16_t* vg0 = VT + (size_t)(h * 128 + (kq0 >> 3)) * MROWS + (kq0 & 7) * 8; const bf16_t* vg1 = VT + (size_t)(h * 128 + (kq1 >> 3)) * MROWS + (kq1 & 7) * 8;
    const int kl0 = (kq0 >> 4) * AT_KROW + (kq0 & 15) * 16, kl1 = (kq1 >> 4) * AT_KROW + (kq1 & 15) * 16;
    const int vl0 = AT_KBYTES + (kq0 >> 3) * AT_VROW + ((kq0 & 7) >> 1) * 32 + (kq0 & 1) * 8, vl1 = AT_KBYTES + (kq1 >> 3) * AT_VROW + ((kq1 & 7) >> 1) * 32 + (kq1 & 1) * 8;
    u32x4 kr0, kr1, vr0, vr1;
#define AT_LOAD(t) do { const size_t kro = (size_t)((t) < 32 ? b * SEQ + (t) * 64 : NTOK); \
        kr0 = *(const u32x4*)(kg0 + kro * 512); kr1 = *(const u32x4*)(kg1 + kro * 512); vr0 = *(const u32x4*)(vg0 + kro); vr1 = *(const u32x4*)(vg1 + kro); } while (0)
#define AT_WRITE(buf) do { LAS unsigned char* _b = lds + (buf) * AT_STAGE; \
        *(LAS u32x4*)(_b + kl0) = kr0; *(LAS u32x4*)(_b + kl1) = kr1; \
        *(LAS u32x2*)(_b + vl0) = (u32x2){vr0.x, vr0.y}; *(LAS u32x2*)(_b + vl0 + 16) = (u32x2){vr0.z, vr0.w}; \
        *(LAS u32x2*)(_b + vl1) = (u32x2){vr1.x, vr1.y}; *(LAS u32x2*)(_b + vl1 + 16) = (u32x2){vr1.z, vr1.w}; } while (0)
    __syncthreads();
    AT_LOAD(0); AT_WRITE(0);
    __syncthreads();
    for (int t = 0; t < 33; ++t) {
        if (t + 1 < 33) AT_LOAD(t + 1);
        const LAS unsigned char* kb_ = lds + (t & 1) * AT_STAGE; const LAS unsigned char* vb_ = kb_ + AT_KBYTES;
        f32x16 s0, s1;
#pragma unroll
        for (int r = 0; r < 16; ++r) { s0[r] = -m; s1[r] = -m; }
#pragma unroll
        for (int s = 0; s < 4; ++s) {
            const bf16x8 k0 = *(const LAS bf16x8*)(kb_ + l31 * AT_KROW + (c * 64 + 16 * s + 8 * hh) * 2);
            s0 = __builtin_amdgcn_mfma_f32_32x32x16_bf16(k0, qf[s], s0, 0, 0, 0);
        }
#pragma unroll
        for (int s = 0; s < 4; ++s) {
            const bf16x8 k1 = *(const LAS bf16x8*)(kb_ + (32 + l31) * AT_KROW + (c * 64 + 16 * s + 8 * hh) * 2);
            s1 = __builtin_amdgcn_mfma_f32_32x32x16_bf16(k1, qf[s], s1, 0, 0, 0);
        }
        if (t == 32) {
#pragma unroll
            for (int r = 0; r < 16; ++r) { const int key = (r & 3) + 8 * (r >> 2) + 4 * hh; if (key >= 16) s0[r] = -1e30f; s1[r] = -1e30f; }
        }
        float mx = s0[0];
#pragma unroll
        for (int r = 1; r < 16; ++r) mx = fmaxf(mx, s0[r]);
#pragma unroll
        for (int r = 0; r < 16; ++r) mx = fmaxf(mx, s1[r]);
        mx = fmaxf(mx, __shfl_xor(mx, 32));
        if (t == 0 || __any(mx > 8.0f)) {
            const float d = t == 0 ? mx : fmaxf(mx, 0.f), alpha = __builtin_amdgcn_exp2f(-d);
            m += d; l *= alpha;
#pragma unroll
            for (int i = 0; i < 4; ++i) O[i] = O[i] * alpha;
#pragma unroll
            for (int r = 0; r < 16; ++r) { s0[r] -= d; s1[r] -= d; }
        }
        float ps = 0.f;
#define AT_PV(SREG, kb) do { \
        _Pragma("unroll") for (int r = 0; r < 16; ++r) { SREG[r] = __builtin_amdgcn_exp2f(SREG[r]); ps += SREG[r]; } \
        bf16x8 pf0, pf1; \
        { u32x4 a; a.x = pk2(SREG[0], SREG[1]); a.y = pk2(SREG[2], SREG[3]); a.z = pk2(SREG[4], SREG[5]); a.w = pk2(SREG[6], SREG[7]); pf0 = __builtin_bit_cast(bf16x8, a); \
          u32x4 bq; bq.x = pk2(SREG[8], SREG[9]); bq.y = pk2(SREG[10], SREG[11]); bq.z = pk2(SREG[12], SREG[13]); bq.w = pk2(SREG[14], SREG[15]); pf1 = __builtin_bit_cast(bf16x8, bq); } \
        _Pragma("unroll") for (int vb = 0; vb < 4; ++vb) { \
            const LAS unsigned char* vp = vb_ + (vb * 32 + l31) * AT_VROW + (kb) * 64 + hh * 16; \
            O[vb] = __builtin_amdgcn_mfma_f32_32x32x16_bf16(*(const LAS bf16x8*)vp, pf0, O[vb], 0, 0, 0); \
            O[vb] = __builtin_amdgcn_mfma_f32_32x32x16_bf16(*(const LAS bf16x8*)(vp + 32), pf1, O[vb], 0, 0, 0); } } while (0)
        AT_PV(s0, 0);
        AT_PV(s1, 1);
#undef AT_PV
        l += ps;
        if (t + 1 < 33) AT_WRITE((t + 1) & 1);
        __syncthreads();
    }
    const float inv = 1.f / (l + __shfl_xor(l, 32));
    LAS float* X = (LAS float*)lds + qg * 4096;
    if (c == 1) {
#pragma unroll
        for (int vb = 0; vb < 4; ++vb)
#pragma unroll
            for (int r = 0; r < 16; ++r) X[(vb * 16 + r) * 64 + lane] = O[vb][r] * inv;
    }
    __syncthreads();
    if (c == 0) {
        const float lam = ((const float*)(p.ws + OFF_MISC))[0];
        float ss = 0.f;
#pragma unroll
        for (int vb = 0; vb < 4; ++vb)
#pragma unroll
            for (int r = 0; r < 16; ++r) { const float y = O[vb][r] * inv - lam * X[(vb * 16 + r) * 64 + lane]; O[vb][r] = y; ss += y * y; }
        ss += __shfl_xor(ss, 32);
        const float rs = rsqrtf(ss * (1.f / 128.f) + EPS) * 0.8f;
        bf16_t* orow = (bf16_t*)(p.ws + OFF_MIX) + (size_t)(r0 + qg * 32 + l31) * DM + h * 128;
#pragma unroll
        for (int vb = 0; vb < 4; ++vb)
#pragma unroll
            for (int rq = 0; rq < 4; ++rq) {
                const int v0 = vb * 32 + 8 * rq + 4 * hh;
                const f32x4 wlo = *(const f32x4*)(p.in[8] + vb * 32 + 8 * rq), whi = *(const f32x4*)(p.in[8] + vb * 32 + 8 * rq + 4);
                const f32x4 w = hh ? whi : wlo;
                u32x2 o; o.x = pk2(O[vb][4 * rq] * rs * w.x, O[vb][4 * rq + 1] * rs * w.y); o.y = pk2(O[vb][4 * rq + 2] * rs * w.z, O[vb][4 * rq + 3] * rs * w.w);
                *(u32x2*)(orow + v0) = o;
            }
    }
#undef AT_LOAD
#undef AT_WRITE
}
__device__ __forceinline__ void phase2_attn_mfma(const Params& p, LAS unsigned char* lds) {
    for (int it = vcu_of_block(); it < NB * 4 * 16; it += gridDim.x) attn_item(p, lds, it);
}


__device__ __forceinline__ int gsw(int row, int chunk) { return row * 128 + ((chunk ^ (row & 7)) << 4); }
constexpr int GL_SET = 40960;
constexpr int GL_QS = 0, GL_KS = 8192, GL_KT = 16384, GL_VT = 24576, GL_AT = 2 * GL_SET, GL_ST = GL_AT + 8192  , GL_DV = GL_ST + 32768  ;
__device__ __forceinline__ float dpp_scan64(float v) {
    v += __builtin_bit_cast(float, __builtin_amdgcn_update_dpp(0, __builtin_bit_cast(int, v), 0x111, 0xf, 0xf, false));
    v += __builtin_bit_cast(float, __builtin_amdgcn_update_dpp(0, __builtin_bit_cast(int, v), 0x112, 0xf, 0xf, false));
    v += __builtin_bit_cast(float, __builtin_amdgcn_update_dpp(0, __builtin_bit_cast(int, v), 0x114, 0xf, 0xf, false));
    v += __builtin_bit_cast(float, __builtin_amdgcn_update_dpp(0, __builtin_bit_cast(int, v), 0x118, 0xf, 0xf, false));
    v += __builtin_bit_cast(float, __builtin_amdgcn_update_dpp(0, __builtin_bit_cast(int, v), 0x142, 0xa, 0xf, false));
    v += __builtin_bit_cast(float, __builtin_amdgcn_update_dpp(0, __builtin_bit_cast(int, v), 0x143, 0xc, 0xf, false));
    return v;
}
struct GlaPre { f32x4 g0, g1; u32x4 q8, k8, v0, v1; };
struct GlaCtx { const bf16_t* GQ; const bf16_t* GK; const bf16_t* GVT; const float* G; bf16_t* O; int dir, h, b, nsteps, lane, wave, l15, g, vdv, vch; };
__device__ __forceinline__ int gla_rowbase(const GlaCtx& c, int st) { return c.dir ? c.b * SEQ + (31 - st) * 64 : (st == 0 ? NTOK : c.b * SEQ + (st - 1) * 64); }
__device__ __forceinline__ void gla_load(const GlaCtx& c, GlaPre& r, int st) {
    const int rb = gla_rowbase(c, st); const size_t row = (size_t)(rb + c.lane);
    r.g0 = *(const f32x4*)(c.G + row * 256 + c.h * 64 + 8 * c.wave); r.g1 = *(const f32x4*)(c.G + row * 256 + c.h * 64 + 8 * c.wave + 4);
    r.q8 = *(const u32x4*)(c.GQ + row * 256 + c.h * 64 + 8 * c.wave); r.k8 = *(const u32x4*)(c.GK + row * 256 + c.h * 64 + 8 * c.wave);
    r.v0 = *(const u32x4*)(c.GVT + (size_t)(c.h * 128 + c.vdv) * MROWS + rb + c.vch * 8); r.v1 = *(const u32x4*)(c.GVT + (size_t)(c.h * 128 + c.vdv) * MROWS + rb + c.vch * 8 + 8);
}
__device__ __forceinline__ void gla_step(const GlaCtx& c, LAS unsigned char* lds, GlaPre& r, f32x4 (&accS)[4], int st) {
    const int lane = c.lane, wave = c.wave, l15 = c.l15, g = c.g, dir = c.dir;
    const bool meta = (dir == 0 && st == 0);
    const int rowbase = gla_rowbase(c, st);
    LAS unsigned char* sb = lds + (st & 1) * GL_SET;
    float gg[8] = {r.g0.x, r.g0.y, r.g0.z, r.g0.w, r.g1.x, r.g1.y, r.g1.z, r.g1.w};
    if (meta && lane >= NMETA) {
#pragma unroll
        for (int e = 0; e < 8; ++e) gg[e] = 0.f;
    }
    const u32x4 q8 = r.q8, k8 = r.k8;
    float qv[8] = {bflo(q8.x), bfhi(q8.x), bflo(q8.y), bfhi(q8.y), bflo(q8.z), bfhi(q8.z), bflo(q8.w), bfhi(q8.w)};
    float kv[8] = {bflo(k8.x), bfhi(k8.x), bflo(k8.y), bfhi(k8.y), bflo(k8.z), bfhi(k8.z), bflo(k8.w), bfhi(k8.w)};
    float qn[8], kn[8], ks[8];
#pragma unroll
    for (int e = 0; e < 8; ++e) {
        const float P = dpp_scan64(gg[e]);
        const float T = __builtin_bit_cast(float, __builtin_amdgcn_readlane(__builtin_bit_cast(int, P), 63));
        const float Bv = dir ? (T - P + gg[e]) : P;
        const float eb = __expf(Bv), en = __builtin_amdgcn_rcpf(eb), eT = __expf(T);
        qn[e] = qv[e] * eb; kn[e] = kv[e] * en; ks[e] = kn[e] * eT;
        if (lane == 0) *(LAS float*)(lds + GL_DV + (st & 1) * 256 + (8 * wave + e) * 4) = eT;
    }
    *(LAS u32x4*)(sb + GL_QS + gsw(lane, wave)) = (u32x4){pk2(qn[0], qn[1]), pk2(qn[2], qn[3]), pk2(qn[4], qn[5]), pk2(qn[6], qn[7])};
    *(LAS u32x4*)(sb + GL_KS + gsw(lane, wave)) = (u32x4){pk2(kn[0], kn[1]), pk2(kn[2], kn[3]), pk2(kn[4], kn[5]), pk2(kn[6], kn[7])};
#pragma unroll
    for (int e = 0; e < 8; e += 2) { const unsigned w = pk2(ks[e], ks[e + 1]);
        *(LAS unsigned short*)(sb + GL_KT + gsw(8 * wave + e, lane >> 3) + (lane & 7) * 2) = (unsigned short)w;
        *(LAS unsigned short*)(sb + GL_KT + gsw(8 * wave + e + 1, lane >> 3) + (lane & 7) * 2) = (unsigned short)(w >> 16); }
    *(LAS u32x4*)(sb + GL_VT + gsw(c.vdv, c.vch)) = r.v0; *(LAS u32x4*)(sb + GL_VT + gsw(c.vdv, c.vch + 1)) = r.v1;
    if (st + 2 < c.nsteps) gla_load(c, r, st + 2);
    __syncthreads();
    const LAS unsigned char* STo = lds + GL_ST + (st & 1) * 16384; LAS unsigned char* STn = lds + GL_ST + ((st + 1) & 1) * 16384;
    if (!meta) {
        const int jb = wave >> 1;
#pragma unroll
        for (int ii = 0; ii < 2; ++ii) {
            const int ib = 2 * (wave & 1) + ii;
            f32x4 a = (f32x4){0.f, 0.f, 0.f, 0.f};
            const bool live = dir ? (jb >= ib) : (jb <= ib);
            if (live) {
#pragma unroll
                for (int ks2 = 0; ks2 < 2; ++ks2) {
                    const bf16x8 kf = *(const LAS bf16x8*)(sb + GL_KS + gsw(jb * 16 + l15, ks2 * 4 + g));
                    const bf16x8 qf = *(const LAS bf16x8*)(sb + GL_QS + gsw(ib * 16 + l15, ks2 * 4 + g));
                    a = __builtin_amdgcn_mfma_f32_16x16x32_bf16(kf, qf, a, 0, 0, 0);
                }
                const int i = ib * 16 + l15, j0 = jb * 16 + 4 * g;
#pragma unroll
                for (int rr = 0; rr < 4; ++rr) { const bool keep = dir ? (j0 + rr >= i) : (j0 + rr <= i); a[rr] = keep ? a[rr] : 0.f; }
            }
            const int i = ib * 16 + l15, j0 = jb * 16 + 4 * g;
            *(LAS u32x2*)(lds + GL_AT + gsw(i, j0 >> 3) + (j0 & 7) * 2) = (u32x2){pk2(a[0], a[1]), pk2(a[2], a[3])};
        }
    }
    if (st + 1 < c.nsteps) {
#pragma unroll
        for (int kb = 0; kb < 4; ++kb) {
            const f32x4 dvv = *(const LAS f32x4*)(lds + GL_DV + (st & 1) * 256 + (kb * 16 + 4 * g) * 4);
            f32x4 a = accS[kb] * dvv;
#pragma unroll
            for (int ks2 = 0; ks2 < 2; ++ks2) {
                const bf16x8 kf = *(const LAS bf16x8*)(sb + GL_KT + gsw(kb * 16 + l15, ks2 * 4 + g));
                const bf16x8 vf = *(const LAS bf16x8*)(sb + GL_VT + gsw(wave * 16 + l15, ks2 * 4 + g));
                a = __builtin_amdgcn_mfma_f32_16x16x32_bf16(kf, vf, a, 0, 0, 0);
            }
            accS[kb] = a;
            const int dk0 = kb * 16 + 4 * g;
            *(LAS u32x2*)(STn + gsw(wave * 16 + l15, dk0 >> 3) + (dk0 & 7) * 2) = (u32x2){pk2(a[0], a[1]), pk2(a[2], a[3])};
        }
    }
    __syncthreads();
    if (!meta) {
#pragma unroll
        for (int ib = 0; ib < 4; ++ib) {
            f32x4 a = (f32x4){0.f, 0.f, 0.f, 0.f};
#pragma unroll
            for (int ks2 = 0; ks2 < 2; ++ks2) {
                const bf16x8 vf = *(const LAS bf16x8*)(sb + GL_VT + gsw(wave * 16 + l15, ks2 * 4 + g));
                const bf16x8 af = *(const LAS bf16x8*)(lds + GL_AT + gsw(ib * 16 + l15, ks2 * 4 + g));
                a = __builtin_amdgcn_mfma_f32_16x16x32_bf16(vf, af, a, 0, 0, 0);
                const bf16x8 sf = *(const LAS bf16x8*)(STo + gsw(wave * 16 + l15, ks2 * 4 + g));
                const bf16x8 qf = *(const LAS bf16x8*)(sb + GL_QS + gsw(ib * 16 + l15, ks2 * 4 + g));
                a = __builtin_amdgcn_mfma_f32_16x16x32_bf16(sf, qf, a, 0, 0, 0);
            }
            *(u32x2*)(c.O + (size_t)(rowbase + ib * 16 + l15) * 512 + c.h * 128 + wave * 16 + 4 * g) = (u32x2){pk2(a[0], a[1]), pk2(a[2], a[3])};
        }
    }
}
__device__ __forceinline__ void gla_chain(const Params& p, LAS unsigned char* lds, int item) {
    const int tid = threadIdx.x;
    GlaCtx c;
    c.lane = tid & 63; c.wave = __builtin_amdgcn_readfirstlane(tid >> 6); c.l15 = c.lane & 15; c.g = c.lane >> 4;
    c.dir = item & 1; c.h = (item >> 1) & 3; c.b = item >> 3;
    c.GQ = (const bf16_t*)(p.ws + OFF_GQ); c.GK = (const bf16_t*)(p.ws + OFF_GK); c.GVT = (const bf16_t*)(p.ws + OFF_GVT);
    c.G = (const float*)(p.ws + (c.dir ? OFF_GB : OFF_GF));
    c.O = (bf16_t*)p.out + (c.dir ? (size_t)NTOK * 512 : 0);
    c.nsteps = c.dir ? 32 : 33; c.vdv = tid >> 2; c.vch = (tid & 3) * 2;
    f32x4 accS[4];
#pragma unroll
    for (int i = 0; i < 4; ++i) accS[i] = (f32x4){0.f, 0.f, 0.f, 0.f};
    __syncthreads();
    *(LAS u32x4*)(lds + GL_ST + tid * 32) = (u32x4){0u, 0u, 0u, 0u}; *(LAS u32x4*)(lds + GL_ST + tid * 32 + 16) = (u32x4){0u, 0u, 0u, 0u};
    GlaPre X, Y;
    gla_load(c, X, 0); gla_load(c, Y, 1);
    for (int st = 0; st < c.nsteps; st += 2) {
        gla_step(c, lds, X, accS, st);
        if (st + 1 < c.nsteps) gla_step(c, lds, Y, accS, st + 1);
    }
    asm volatile("s_waitcnt vmcnt(0)" ::: "memory");
    __syncthreads();
    if (tid == 0) {
        __builtin_amdgcn_fence(__ATOMIC_RELEASE, "agent");
        asm volatile("s_waitcnt vmcnt(0)" ::: "memory");
        __hip_atomic_fetch_add((unsigned*)(p.ws + OFF_CTL) + 4096 + (item >> 1) * 64, 1u, __ATOMIC_RELAXED, __HIP_MEMORY_SCOPE_AGENT);
    }
}
__device__ __forceinline__ void gla_combine_item(const Params& p, LAS unsigned char* lds, int item) {
    const int tid = threadIdx.x, lane = tid & 63, wave = tid >> 6;
    const int bh = item >> 3, part = item & 7, b = bh >> 2, h = bh & 3;
    if (tid == 0) {
        unsigned* flag = (unsigned*)(p.ws + OFF_CTL) + 4096 + bh * 64;
        unsigned spins = 0;
        while (__hip_atomic_load(flag, __ATOMIC_RELAXED, __HIP_MEMORY_SCOPE_AGENT) < 2u) { __builtin_amdgcn_s_sleep(8); if (++spins > (1u << 22)) break; }
        __builtin_amdgcn_fence(__ATOMIC_ACQUIRE, "agent");
        asm volatile("s_waitcnt vmcnt(0)" ::: "memory");
    }
    __syncthreads();
    const bf16_t* GR = (const bf16_t*)(p.ws + OFF_GR); bf16_t* MIX = (bf16_t*)(p.ws + OFF_MIX);
    const bf16_t* OF = (const bf16_t*)p.out; const bf16_t* OBk = OF + (size_t)NTOK * 512;
    const int c0 = h * 128 + (lane & 15) * 8;
    const f32x4 w0 = *(const f32x4*)(p.in[13] + (lane & 15) * 8), w1 = *(const f32x4*)(p.in[13] + (lane & 15) * 8 + 4);
#pragma unroll 2
    for (int i = 0; i < 8; ++i) {
        const int r = b * SEQ + part * 256 + wave * 32 + i * 4 + (lane >> 4);
        const u32x4 a = *(const u32x4*)(OF + (size_t)r * 512 + c0), bq = *(const u32x4*)(OBk + (size_t)r * 512 + c0);
        const f32x4 x0 = (f32x4){bflo(a.x) + bflo(bq.x), bfhi(a.x) + bfhi(bq.x), bflo(a.y) + bflo(bq.y), bfhi(a.y) + bfhi(bq.y)};
        const f32x4 x1 = (f32x4){bflo(a.z) + bflo(bq.z), bfhi(a.z) + bfhi(bq.z), bflo(a.w) + bflo(bq.w), bfhi(a.w) + bfhi(bq.w)};
        float s = x0.x * x0.x + x0.y * x0.y + x0.z * x0.z + x0.w * x0.w + x1.x * x1.x + x1.y * x1.y + x1.z * x1.z + x1.w * x1.w;
        s += __shfl_xor(s, 1); s += __shfl_xor(s, 2); s += __shfl_xor(s, 4); s += __shfl_xor(s, 8);
        const float rs = rsqrtf(s * (1.f / 128.f) + EPS);
        const u32x4 g = *(const u32x4*)(GR + (size_t)r * 512 + c0);
        u32x4 o;
        o.x = pk2(x0.x * rs * w0.x * bflo(g.x), x0.y * rs * w0.y * bfhi(g.x)); o.y = pk2(x0.z * rs * w0.z * bflo(g.y), x0.w * rs * w0.w * bfhi(g.y));
        o.z = pk2(x1.x * rs * w1.x * bflo(g.z), x1.y * rs * w1.y * bfhi(g.z)); o.w = pk2(x1.z * rs * w1.z * bflo(g.w), x1.w * rs * w1.w * bfhi(g.w));
        *(u32x4*)(MIX + (size_t)r * DM + 512 + c0) = o;
    }
}

constexpr int LDS_Q = LDS_BYTES - 16;
__device__ __forceinline__ void phase2(const Params& p, LAS unsigned char* lds, int qslot = 0) {
    unsigned* ctr = (unsigned*)(p.ws + OFF_CTL) + (qslot >= 2 ? 2048 + qslot * 64 : qslot * 64);
    int it;
#define P2_NEXT() do { __syncthreads(); if (threadIdx.x == 0) *(LAS unsigned*)(lds + LDS_Q) = atomicAdd(ctr, 1u); __syncthreads(); it = (int)*(LAS unsigned*)(lds + LDS_Q); } while (0)
    P2_NEXT();
    if (qslot != 3) { while (it < 64) { gla_chain(p, lds, it); P2_NEXT(); } }
    if (qslot == 2) return;
    if (qslot == 3) it += 64;
    while (it < 64 + NB * 4 * 16) { attn_item(p, lds, it - 64); P2_NEXT(); if (qslot == 3) it += 64; }
    if (qslot) return;
    for (;;) {
        __syncthreads();
        if (threadIdx.x == 0) *(LAS unsigned*)(lds + LDS_Q) = atomicAdd(ctr + 192, 1u);
        __syncthreads();
        const int c = (int)*(LAS unsigned*)(lds + LDS_Q);
        if (c >= 256) break;
        gla_combine_item(p, lds, c);
    }
    for (;;) {
        __syncthreads();
        if (threadIdx.x == 0) *(LAS unsigned*)(lds + LDS_Q) = atomicAdd(ctr + 128, 1u);
        __syncthreads();
        const int c = (int)*(LAS unsigned*)(lds + LDS_Q);
        if (c >= CV_ITEMS) break;
        conv_item(p, (unsigned char*)lds, c);
    }
#undef P2_NEXT
}

__device__ __forceinline__ void phase2c(const Params& p) {
    const int tid = threadIdx.x, lane = tid & 63, wave = tid >> 6;
    const int gw = blockIdx.x * 8 + wave, NGW = gridDim.x * 8;
    const bf16_t* GR = (const bf16_t*)(p.ws + OFF_GR); bf16_t* MIX = (bf16_t*)(p.ws + OFF_MIX);
    const bf16_t* OF = (const bf16_t*)p.out; const bf16_t* OBk = OF + (size_t)NTOK * 512;
    const int c0 = lane * 8;
    const f32x4 w0 = *(const f32x4*)(p.in[13] + (c0 & 127)), w1 = *(const f32x4*)(p.in[13] + (c0 & 127) + 4);
    for (int r = gw; r < NTOK; r += NGW) {
        const u32x4 a = *(const u32x4*)(OF + (size_t)r * 512 + c0), bq = *(const u32x4*)(OBk + (size_t)r * 512 + c0);
        const f32x4 x0 = (f32x4){bflo(a.x) + bflo(bq.x), bfhi(a.x) + bfhi(bq.x), bflo(a.y) + bflo(bq.y), bfhi(a.y) + bfhi(bq.y)};
        const f32x4 x1 = (f32x4){bflo(a.z) + bflo(bq.z), bfhi(a.z) + bfhi(bq.z), bflo(a.w) + bflo(bq.w), bfhi(a.w) + bfhi(bq.w)};
        float s = x0.x * x0.x + x0.y * x0.y + x0.z * x0.z + x0.w * x0.w + x1.x * x1.x + x1.y * x1.y + x1.z * x1.z + x1.w * x1.w;
        s += __shfl_xor(s, 1); s += __shfl_xor(s, 2); s += __shfl_xor(s, 4); s += __shfl_xor(s, 8);
        const float rs = rsqrtf(s * (1.f / 128.f) + EPS);
        const u32x4 g = *(const u32x4*)(GR + (size_t)r * 512 + c0);
        u32x4 o;
        o.x = pk2(x0.x * rs * w0.x * bflo(g.x), x0.y * rs * w0.y * bfhi(g.x)); o.y = pk2(x0.z * rs * w0.z * bflo(g.y), x0.w * rs * w0.w * bfhi(g.y));
        o.z = pk2(x1.x * rs * w1.x * bflo(g.z), x1.y * rs * w1.y * bfhi(g.z)); o.w = pk2(x1.z * rs * w1.z * bflo(g.w), x1.w * rs * w1.w * bfhi(g.w));
        *(u32x4*)(MIX + (size_t)r * DM + 512 + c0) = o;
    }
}


#define TOPK_INS(L, x) do { float _x = (x); _Pragma("unroll") for (int _s = 0; _s < 16; ++_s) { const float _t = fmaxf(L[_s], _x); _x = fminf(L[_s], _x); L[_s] = _t; } } while (0)
constexpr int P4_QROW = 528, P4_SC0 = 128 * P4_QROW  , P4_TLROW = 144;

#define CE_DESC(a, b) do { const float _hi = fmaxf(a, b), _lo = fminf(a, b); a = _hi; b = _lo; } while (0)
__device__ __forceinline__ void bitonic_sort16_desc(float (&x)[16]) {
#pragma unroll
    for (int k = 2; k <= 16; k <<= 1)
#pragma unroll
        for (int j = k >> 1; j > 0; j >>= 1)
#pragma unroll
            for (int i = 0; i < 16; ++i) { const int l = i ^ j; if (l > i) { if ((i & k) == 0) CE_DESC(x[i], x[l]); else CE_DESC(x[l], x[i]); } }
}
__device__ __forceinline__ void bitonic_merge16_desc(float (&x)[16]) {
#pragma unroll
    for (int j = 8; j > 0; j >>= 1)
#pragma unroll
        for (int i = 0; i < 16; ++i) { const int l = i ^ j; if (l > i) CE_DESC(x[i], x[l]); }
}
__device__ __forceinline__ void top16_merge(float (&L)[16], const float (&x)[16]) {
#pragma unroll
    for (int i = 0; i < 16; ++i) L[i] = fmaxf(L[i], x[15 - i]);
    bitonic_merge16_desc(L);
}

template <int Q> struct CandIJ {
    static constexpr int compute() { int c = 0; for (int i = 0; i < 16; ++i) for (int j = 0; j < 16; ++j) if ((i + 1) * (j + 1) <= 16) { if (c == Q) return i * 16 + j; ++c; } return -1; }
    static constexpr int v = compute();
};
template <int G, int S> __device__ __forceinline__ void cand_fill(float (&x)[16], const float (&A)[16], const float (&Bv)[16]) {
    constexpr int ij = CandIJ<G * 16 + S>::v;
    if constexpr (ij >= 0) x[S] = __uint_as_float((__float_as_uint(A[ij >> 4] + Bv[ij & 15]) & ~255u) | (unsigned)ij); else x[S] = -3.0e38f;
    if constexpr (S + 1 < 16) cand_fill<G, S + 1>(x, A, Bv);
}
__device__ __forceinline__ void p4_route_half(const Params& p, LAS unsigned char* lds, int m0, int h) {
    int tid_ = threadIdx.x; asm volatile("" : "+v"(tid_));
    const int tid = tid_, lane = tid & 63, wave = __builtin_amdgcn_readfirstlane(tid >> 6), l15 = lane & 15, g = lane >> 4;
    const bf16_t* KEYS = (const bf16_t*)(p.ws + OFF_KEYS); unsigned* PW0 = (unsigned*)(p.ws + OFF_PW0);
        {
            const int wr = wave >> 1, wk = wave & 1;
            f32x4 sc[2][2][4];
#pragma unroll
            for (int pp = 0; pp < 2; ++pp) {
#pragma unroll
                for (int rb = 0; rb < 2; ++rb)
#pragma unroll
                    for (int kk = 0; kk < 4; ++kk) sc[pp][rb][kk] = (f32x4){0.f, 0.f, 0.f, 0.f};
                const bf16_t* kbase = KEYS + (size_t)((h * 2 + pp) * 128 + 64 * wk + l15) * 128 + 8 * g;
#pragma unroll
                for (int ks = 0; ks < 4; ++ks) {
                    bf16x8 qf[2], kf[4];
#pragma unroll
                    for (int rb = 0; rb < 2; ++rb) qf[rb] = *(const LAS bf16x8*)(lds + (32 * wr + 16 * rb + l15) * P4_QROW + (pp * 128 + ks * 32 + 8 * g) * 2);
#pragma unroll
                    for (int kk = 0; kk < 4; ++kk) kf[kk] = *(const bf16x8*)(kbase + (size_t)(16 * kk) * 128 + ks * 32);
#pragma unroll
                    for (int rb = 0; rb < 2; ++rb)
#pragma unroll
                        for (int kk = 0; kk < 4; ++kk) sc[pp][rb][kk] = __builtin_amdgcn_mfma_f32_16x16x32_bf16(kf[kk], qf[rb], sc[pp][rb][kk], 0, 0, 0);
                }
            }
#pragma unroll
            for (int rb = 0; rb < 2; ++rb)
#pragma unroll
                for (int kk = 0; kk < 4; ++kk) *(LAS f32x4*)(lds + P4_SC0 + (32 * wr + 16 * rb + l15) * P4_QROW + (64 * wk + 16 * kk + 4 * g) * 4) = sc[0][rb][kk];
            __syncthreads();
#pragma unroll
            for (int rb = 0; rb < 2; ++rb)
#pragma unroll
                for (int kk = 0; kk < 4; ++kk) *(LAS f32x4*)(lds + (32 * wr + 16 * rb + l15) * P4_QROW + (64 * wk + 16 * kk + 4 * g) * 4) = sc[1][rb][kk];
        }
        __syncthreads();
        {
            const int hf = tid & 1, row = (tid >> 1) & 127, pp = tid >> 8;
            const LAS unsigned char* sp = lds + (pp ? 0 : P4_SC0) + row * P4_QROW + hf * 256;
            float L[16];
#pragma unroll
            for (int grp = 0; grp < 4; ++grp) {
                float x[16];
#pragma unroll
                for (int q4 = 0; q4 < 4; ++q4) {
                    const f32x4 v = *(const LAS f32x4*)(sp + (grp * 4 + q4) * 16);
                    const unsigned kb = (unsigned)(hf * 64 + grp * 16 + q4 * 4);
                    x[4 * q4 + 0] = __uint_as_float((__float_as_uint(v.x) & ~127u) | kb);
                    x[4 * q4 + 1] = __uint_as_float((__float_as_uint(v.y) & ~127u) | (kb + 1));
                    x[4 * q4 + 2] = __uint_as_float((__float_as_uint(v.z) & ~127u) | (kb + 2));
                    x[4 * q4 + 3] = __uint_as_float((__float_as_uint(v.w) & ~127u) | (kb + 3));
                }
                bitonic_sort16_desc(x);
                if (grp == 0) {
#pragma unroll
                    for (int s = 0; s < 16; ++s) L[s] = x[s];
                } else top16_merge(L, x);
            }
            {
                float Oth[16];
#pragma unroll
                for (int s = 0; s < 16; ++s) Oth[s] = __shfl_xor(L[s], 1);
                top16_merge(L, Oth);
            }
            __syncthreads();
            if (hf == 0) {
                LAS f32x4* tl = (LAS f32x4*)(lds + P4_SC0 + row * (2 * P4_TLROW) + pp * P4_TLROW);
                tl[0] = (f32x4){L[0], L[1], L[2], L[3]}; tl[1] = (f32x4){L[4], L[5], L[6], L[7]}; tl[2] = (f32x4){L[8], L[9], L[10], L[11]}; tl[3] = (f32x4){L[12], L[13], L[14], L[15]};
            }
        }
        __syncthreads();
        if (tid < 128) {
            const LAS unsigned char* tl = lds + P4_SC0 + tid * (2 * P4_TLROW);
            float A[16], Bv[16];
#pragma unroll
            for (int q4 = 0; q4 < 4; ++q4) { const f32x4 a = *(const LAS f32x4*)(tl + q4 * 16), b = *(const LAS f32x4*)(tl + P4_TLROW + q4 * 16);
                A[4 * q4] = a.x; A[4 * q4 + 1] = a.y; A[4 * q4 + 2] = a.z; A[4 * q4 + 3] = a.w; Bv[4 * q4] = b.x; Bv[4 * q4 + 1] = b.y; Bv[4 * q4 + 2] = b.z; Bv[4 * q4 + 3] = b.w; }
#pragma unroll
            for (int s = 0; s < 16; ++s) { A[s] = __uint_as_float(__float_as_uint(A[s]) & ~127u); Bv[s] = __uint_as_float(__float_as_uint(Bv[s]) & ~127u); }
            float L[16];
            {
                float x[16];
                cand_fill<0, 0>(x, A, Bv); bitonic_sort16_desc(x);
#pragma unroll
                for (int s = 0; s < 16; ++s) L[s] = x[s];
                cand_fill<1, 0>(x, A, Bv); bitonic_sort16_desc(x); top16_merge(L, x);
                cand_fill<2, 0>(x, A, Bv); bitonic_sort16_desc(x); top16_merge(L, x);
                cand_fill<3, 0>(x, A, Bv); bitonic_sort16_desc(x); top16_merge(L, x);
            }
            const float v0 = __uint_as_float(__float_as_uint(L[0]) & ~255u);
            float e[16], den = 0.f; int id[16];
#pragma unroll
            for (int s = 0; s < 16; ++s) {
                const unsigned u = __float_as_uint(L[s]);
                e[s] = __expf(__uint_as_float(u & ~255u) - v0); den += e[s];
                const unsigned i = (u >> 4) & 15u, j = u & 15u;
                const unsigned ka = *(const LAS unsigned*)(tl + i * 4) & 127u, kb = *(const LAS unsigned*)(tl + P4_TLROW + j * 4) & 127u;
                id[s] = (int)(ka * 128u + kb);
            }
            const float inv = 1.f / den;
            unsigned* ip = PW0 + (size_t)(m0 + tid) * 128 + h * 16;
#pragma unroll
            for (int q4 = 0; q4 < 4; ++q4) { u32x4 o;
#pragma unroll
                for (int c = 0; c < 4; ++c) o[c] = (unsigned)id[4 * q4 + c] | (f2bf(e[4 * q4 + c] * inv) << 16);
                *(u32x4*)(ip + 4 * q4) = o; }
        }
        __syncthreads();
}

namespace pg8 {
struct EpiP4 {
    static constexpr bool PERM = false, AFTER_DRAIN = true;
    const Params* pp; const float* ssq;
    __device__ __forceinline__ void operator()(const f32x4 (&)[2][2][4][2], const Unit&, int, int, int, int) const {}
    __device__ __forceinline__ void fused(f32x4 (&acc)[2][2][4][2], const Unit& u, int wr, int wc, int fr, int fq, PG8_LAS unsigned char* lds, int wid, int lane) const {
#pragma unroll
        for (int ai = 0; ai < 2; ++ai) {
            const int m0 = u.pm * BM + ai * HALF;
#pragma unroll
            for (int m = 0; m < 4; ++m) {
                const int rl = wr * 64 + m * 16 + fr;
                const float rstd = row_rstd(ssq, m0 + rl);
#pragma unroll
                for (int bj = 0; bj < 2; ++bj)
#pragma unroll
                    for (int n = 0; n < 2; ++n) { const f32x4 v = acc[ai][bj][m][n] * rstd;
                        *(PG8_LAS u32x2*)(lds + rl * P4_QROW + (bj * HALF + wc * 32 + n * 16 + 4 * fq) * 2) = (u32x2){pk2(v.x, v.y), pk2(v.z, v.w)}; }
            }
            __syncthreads();
            p4_route_half(*pp, lds, m0, u.pn);
        }
    }
};
}
__device__ __forceinline__ void phase4_mfma(const Params& p, LAS unsigned char* lds) {
    pg8::Gemm g{(const pg8::bf16_t*)(p.ws + OFF_H2B), (const pg8::bf16_t*)(p.ws + OFF_WQ), NTOK, 2048, DM};
    pg8::EpiP4 E{&p, (const float*)(p.ws + OFF_SSQP)};
    const int vcu = vcu_of_block();
    for (int r = 0; r * (int)gridDim.x < 512; ++r) {
        const int L = r * (int)gridDim.x + vcu;
        pg8::OneUnit S; S.u.pm = L >> 3; S.u.pn = L & 7; S.valid = L < 512;
        pg8::gemm_phase<pg8::EpiP4, pg8::OneUnit, false, true>(lds, g, S, E);
        __syncthreads();
    }
}


constexpr size_t OFF_PW = 73 * MiB;
constexpr size_t OFF_OUTS = 179 * MiB;
static_assert(OFF_OUTS >= OFF_PW0 + (size_t)NTOK * 128 * 4 && OFF_OUTS + (size_t)NTOK * DM * 4 <= 256 * MiB, "P5 map");
__device__ __forceinline__ float dot_fp8_bf16(u32x4 uq, u32x4 h0, u32x4 h1, float c) {
#define DQ2(word, hsel, hw) c = dot2(__builtin_bit_cast(unsigned, __builtin_amdgcn_cvt_scalef32_pk_bf16_fp8((int)(word), 1.0f, hsel)), hw, c)
    DQ2(uq.x, false, h0.x); DQ2(uq.x, true, h0.y); DQ2(uq.y, false, h0.z); DQ2(uq.y, true, h0.w);
    DQ2(uq.z, false, h1.x); DQ2(uq.z, true, h1.y); DQ2(uq.w, false, h1.z); DQ2(uq.w, true, h1.w);
#undef DQ2
    return c;
}
constexpr int P5A_RS = 1040, P5A_LIST = 16640, P5A_RES = 18688, P5A_TSC = 18752, P5A_WAVE = 19456;
constexpr size_t OFF_HQ = 146 * MiB;
constexpr size_t OFF_HSC = 192 * 1024;
static_assert(8 * P5A_WAVE <= LDS_BYTES - 32, "P5a LDS");
static_assert(OFF_HQ >= OFF_H2B + (size_t)NTOK * DM * 2 && OFF_HQ + (size_t)NTOK * DM <= OFF_PW0, "HQ map");
__device__ __forceinline__ void quantize_hn(const Params& p) {
    const int tid = threadIdx.x, lane = tid & 63, wave = tid >> 6;
    const bf16_t* H2B = (const bf16_t*)(p.ws + OFF_H2B); unsigned char* HQ = p.ws + OFF_HQ; float* HSC = (float*)(p.ws + OFF_HSC);
    for (int t = blockIdx.x * 8 + wave; t < NTOK; t += gridDim.x * 8) {
        const u32x4 h0 = *(const u32x4*)(H2B + (size_t)t * DM + 16 * lane), h1 = *(const u32x4*)(H2B + (size_t)t * DM + 16 * lane + 8);
        float m = 0.f;
#pragma unroll
        for (int c = 0; c < 4; ++c) { m = fmaxf(m, fmaxf(fabsf(bflo(h0[c])), fabsf(bfhi(h0[c])))); m = fmaxf(m, fmaxf(fabsf(bflo(h1[c])), fabsf(bfhi(h1[c])))); }
        const float am = fmaxf(wave_max(m), 1e-30f), qs = 224.f / am;
        u32x4 o;
#pragma unroll
        for (int c = 0; c < 2; ++c) {
            int w = __builtin_amdgcn_cvt_pk_fp8_f32(bflo(h0[2 * c]) * qs, bfhi(h0[2 * c]) * qs, 0, false); w = __builtin_amdgcn_cvt_pk_fp8_f32(bflo(h0[2 * c + 1]) * qs, bfhi(h0[2 * c + 1]) * qs, w, true); o[c] = (unsigned)w;
            int x = __builtin_amdgcn_cvt_pk_fp8_f32(bflo(h1[2 * c]) * qs, bfhi(h1[2 * c]) * qs, 0, false); x = __builtin_amdgcn_cvt_pk_fp8_f32(bflo(h1[2 * c + 1]) * qs, bfhi(h1[2 * c + 1]) * qs, x, true); o[2 + c] = (unsigned)x;
        }
        *(u32x4*)(HQ + (size_t)t * DM + 16 * lane) = o;
        if (lane == 0) HSC[t] = row_rstd((const float*)(p.ws + OFF_SSQP), t) * am * (1.f / 224.f);
    }
}
__device__ __forceinline__ void p5a_wave(const Params& p, LAS unsigned char* wl, int tb, int part, int lane, __amdgpu_buffer_rsrc_t urs, __amdgpu_buffer_rsrc_t hrs) {
    const float* USC = (const float*)(p.ws + OFF_USC); const float* VSC = (const float*)(p.ws + OFF_VSC); const float* HSC = (const float*)(p.ws + OFF_HSC);
    const unsigned* PW0 = (const unsigned*)(p.ws + OFF_PW0); unsigned* PW = (unsigned*)(p.ws + OFF_PW);
    const int l15 = lane & 15, g = lane >> 4;
    unsigned xl[4], xh[4]; float hsc = 0.f;
#define P5A_STAGE(t0_) do { _Pragma("unroll") for (int _k = 0; _k < 4; ++_k) { \
        __builtin_amdgcn_raw_ptr_buffer_load_lds(hrs, (LAS unsigned*)(wl + _k * 1024), 16, lane * 16, ((t0_) + _k) * 1024, 0, 0); \
        xl[_k] = PW0[(size_t)((t0_) + _k) * 128 + lane]; xh[_k] = PW0[(size_t)((t0_) + _k) * 128 + 64 + lane]; } \
        hsc = HSC[(t0_) + (lane & 3)]; } while (0)
#define P5A_GATHER(tile_) do { int _li = (tile_) * 16 + l15; _li = _li < n ? _li : n - 1; \
        const int _ev = (int)((*(const LAS unsigned*)(wl + P5A_LIST + _li * 4) & 0x3fffu) << 10); \
        _Pragma("unroll") for (int _r = 0; _r < 16; ++_r) \
            __builtin_amdgcn_raw_ptr_buffer_load_lds(urs, (LAS unsigned*)(wl + _r * P5A_RS), 16, lane * 16, __builtin_amdgcn_readlane(_ev, _r), 0, 0); } while (0)
    P5A_STAGE(tb);
    for (int st = 0; st < 4; ++st) {
        const int t0 = tb + 4 * st;
        asm volatile("s_waitcnt vmcnt(0)" ::: "memory");
        long bq[32];
#pragma unroll
        for (int i = 0; i < 16; ++i) { const u32x4 w = *(const LAS u32x4*)(wl + (l15 & 3) * 1024 + 64 * i + 16 * g);
            bq[2 * i] = __builtin_bit_cast(long, (u32x2){w.x, w.y}); bq[2 * i + 1] = __builtin_bit_cast(long, (u32x2){w.z, w.w}); }
        if (lane < 4) *(LAS float*)(wl + P5A_TSC + lane * 4) = hsc;
        int n = 0;
#pragma unroll
        for (int k = 0; k < 4; ++k) {
            const bool ml = (int)((xl[k] >> 11) & 7u) == part, mh = (int)((xh[k] >> 11) & 7u) == part;
            const unsigned long long bl = __ballot(ml), bh = __ballot(mh);
            const int rl = __builtin_amdgcn_mbcnt_hi((unsigned)(bl >> 32), __builtin_amdgcn_mbcnt_lo((unsigned)bl, 0u));
            if (ml) *(LAS unsigned*)(wl + P5A_LIST + (n + rl) * 4) = (xl[k] & 0x3fffu) | ((unsigned)lane << 14) | ((unsigned)k << 21);
            n += __popcll(bl);
            const int rh = __builtin_amdgcn_mbcnt_hi((unsigned)(bh >> 32), __builtin_amdgcn_mbcnt_lo((unsigned)bh, 0u));
            if (mh) *(LAS unsigned*)(wl + P5A_LIST + (n + rh) * 4) = (xh[k] & 0x3fffu) | ((unsigned)(64 + lane) << 14) | ((unsigned)k << 21);
            n += __popcll(bh);
        }
        __builtin_amdgcn_s_waitcnt(0xC07F); __builtin_amdgcn_wave_barrier();
        asm volatile("" ::: "memory");
        const int ntile = (n + 15) >> 4;
        if (ntile == 0) { if (st < 3) P5A_STAGE(t0 + 4); continue; }
#define P5A_OPS(tile_, EOK, EE, SL, TK, USCV, VSCV, XGV) do { int _ei = (tile_) * 16 + l15; EOK = _ei < n; _ei = EOK ? _ei : n - 1; \
        const unsigned _ent = *(const LAS unsigned*)(wl + P5A_LIST + _ei * 4); \
        EE = _ent & 0x3fffu; SL = (int)((_ent >> 14) & 127u); TK = (int)(_ent >> 21); \
        USCV = USC[EE]; VSCV = VSC[EE]; XGV = PW0[(size_t)(t0 + TK) * 128 + SL]; } while (0)
        bool eokN; unsigned eeN; int slN, tkN; float uscN, vscN; unsigned xgN;
        P5A_GATHER(0);
        P5A_OPS(0, eokN, eeN, slN, tkN, uscN, vscN, xgN);
        for (int tile = 0; tile < ntile; ++tile) {
            asm volatile("s_waitcnt vmcnt(0)" : "+v"(uscN), "+v"(vscN), "+v"(xgN) :: "memory");
            const bool eok = eokN; const unsigned ee = eeN; const int sl = slN, tk = tkN, t = t0 + tkN; const float usc = uscN, vsc = vscN; const unsigned xg = xgN;
            long aq[32];
#pragma unroll
            for (int i = 0; i < 16; ++i) { const u32x4 w = *(const LAS u32x4*)(wl + l15 * P5A_RS + 64 * i + 16 * g);
                aq[2 * i] = __builtin_bit_cast(long, (u32x2){w.x, w.y}); aq[2 * i + 1] = __builtin_bit_cast(long, (u32x2){w.z, w.w}); }
            asm volatile("s_waitcnt lgkmcnt(0)" ::: "memory");
#pragma unroll
            for (int s = 0; s < 32; ++s) asm volatile("" : "+v"(aq[s]));
            if (tile + 1 < ntile) { P5A_GATHER(tile + 1); P5A_OPS(tile + 1, eokN, eeN, slN, tkN, uscN, vscN, xgN); } else if (st < 3) P5A_STAGE(t0 + 4);
            f32x4 acc = (f32x4){0.f, 0.f, 0.f, 0.f};
#pragma unroll
            for (int s = 0; s < 32; ++s) acc = __builtin_amdgcn_mfma_f32_16x16x32_fp8_fp8(aq[s], bq[s], acc, 0, 0, 0);
            {
                const u32x4 en = *(const LAS u32x4*)(wl + P5A_LIST + (tile * 16 + 4 * g) * 4);
#pragma unroll
                for (int r = 0; r < 4; ++r) if ((int)(en[r] >> 21) == l15) *(LAS float*)(wl + P5A_RES + (4 * g + r) * 4) = acc[r];
            }
            __builtin_amdgcn_s_waitcnt(0xC07F); __builtin_amdgcn_wave_barrier();
            asm volatile("" ::: "memory");
            if (lane < 16 && eok) {
                const float d = *(const LAS float*)(wl + P5A_RES + lane * 4) * usc * *(const LAS float*)(wl + P5A_TSC + tk * 4);
                const float w = __uint_as_float(xg & 0xffff0000u) * gelu_f(d) * vsc;
                PW[(((size_t)(t >> 6) * 32 + (sl >> 2)) * 64 + (t & 63)) * 4 + (sl & 3)] = ee | (f2bf(w) << 16);
            }
            __builtin_amdgcn_s_waitcnt(0xC07F); __builtin_amdgcn_wave_barrier();
            asm volatile("" ::: "memory");
        }
#undef P5A_OPS
    }
    asm volatile("s_waitcnt vmcnt(0)" ::: "memory");
#undef P5A_STAGE
#undef P5A_GATHER
}
__device__ __forceinline__ void phase5a(const Params& p, LAS unsigned char* lds, int qoff = 0) {
    const int tid = threadIdx.x, lane = tid & 63, wave = __builtin_amdgcn_readfirstlane(tid >> 6);
    const int xcc = (int)(__builtin_amdgcn_s_getreg((3 << 11) | 20) & 7u);
    unsigned* qc = (unsigned*)(p.ws + OFF_CTL) + 256 + qoff;
    LAS unsigned char* wl = lds + wave * P5A_WAVE;
    const __amdgpu_buffer_rsrc_t urs = __builtin_amdgcn_make_buffer_rsrc((void*)(p.ws + OFF_UB), 0, NEXP * DM, 0x00020000);
    const __amdgpu_buffer_rsrc_t hrs = __builtin_amdgcn_make_buffer_rsrc((void*)(p.ws + OFF_HQ), 0, NTOK * DM, 0x00020000);
    for (int pi = 0; pi < 8; ++pi) {
        const int part = (xcc + pi) & 7;
        for (;;) {
            __syncthreads();
            if (tid == 0) *(LAS unsigned*)(lds + LDS_Q) = atomicAdd(qc + part * 64, 1u);
            __syncthreads();
            const int it = (int)*(LAS unsigned*)(lds + LDS_Q);
            if (it >= NTOK / 128) break;
            p5a_wave(p, wl, it * 128 + wave * 16, part, lane, urs, hrs);
        }
    }
}

__device__ __forceinline__ void p5b_quad(const LAS unsigned char* lds, u32x4 q, f32x2& a0, f32x2& a1, f32x2& a2, f32x2& a3) {
#pragma unroll
    for (int c = 0; c < 4; ++c) {
        const unsigned x = q[c];
        const u32x2 vv = *(const LAS u32x2*)(lds + ((x & 0x3fffu) << 3));
        const float w = __uint_as_float(x & 0xffff0000u); const f32x2 ww = (f32x2){w, w};
        a0 += ww * __builtin_amdgcn_cvt_pk_f32_fp8((int)vv.x, false); a1 += ww * __builtin_amdgcn_cvt_pk_f32_fp8((int)vv.x, true);
        a2 += ww * __builtin_amdgcn_cvt_pk_f32_fp8((int)vv.y, false); a3 += ww * __builtin_amdgcn_cvt_pk_f32_fp8((int)vv.y, true);
    }
}
__device__ __forceinline__ void phase5b(const Params& p, LAS unsigned char* lds) {
    const int tid = threadIdx.x, lane = tid & 63, wave = __builtin_amdgcn_readfirstlane(tid >> 6);
    const unsigned char* VS = p.ws + OFF_VB; const u32x4* PW = (const u32x4*)(p.ws + OFF_PW); bf16_t* OUTS = (bf16_t*)(p.ws + OFF_OUTS);
    for (int it = blockIdx.x; it < 256; it += gridDim.x) {
        const int s = it >> 1, tbase = (it & 1) * 128;
        __syncthreads();
#pragma unroll 4
        for (int i = 0; i < 16; ++i) *(LAS u32x4*)(lds + (tid + NTHR * i) * 16) = *(const u32x4*)(VS + (size_t)s * 131072 + (size_t)(tid + NTHR * i) * 16);
        __syncthreads();
        u32x4 A[8], Bq[8];
#define P5B_LOAD(R, gi) do { const int _T = tbase + wave + 8 * ((gi) >> 2), _g = (gi) & 3; const u32x4* _p = PW + ((size_t)_T * 32 + _g * 8) * 64 + lane; \
        _Pragma("unroll") for (int _i = 0; _i < 8; ++_i) R[_i] = _p[_i * 64]; } while (0)
        f32x2 a0 = {0.f, 0.f}, a1 = {0.f, 0.f}, a2 = {0.f, 0.f}, a3 = {0.f, 0.f};
        P5B_LOAD(A, 0);
        for (int gi = 0; gi < 64; gi += 2) {
            P5B_LOAD(Bq, gi + 1);
#pragma unroll
            for (int i = 0; i < 8; ++i) p5b_quad(lds, A[i], a0, a1, a2, a3);
            if (gi + 2 < 64) P5B_LOAD(A, gi + 2);
#pragma unroll
            for (int i = 0; i < 8; ++i) p5b_quad(lds, Bq[i], a0, a1, a2, a3);
            if (((gi + 1) & 3) == 3) {
                const int T = tbase + wave + 8 * (gi >> 2);
                *(u32x4*)(OUTS + ((size_t)s * NTOK + T * 64 + lane) * 8) = (u32x4){pk2(a0.x, a0.y), pk2(a1.x, a1.y), pk2(a2.x, a2.y), pk2(a3.x, a3.y)};
                a0 = (f32x2){0.f, 0.f}; a1 = a0; a2 = a0; a3 = a0;
            }
        }
#undef P5B_LOAD
    }
}

__device__ __forceinline__ void phase5c(const Params& p, LAS unsigned char* lds) {
    const int tid = threadIdx.x, lane = tid & 63, wave = __builtin_amdgcn_readfirstlane(tid >> 6);
    const bf16_t* OUTS = (const bf16_t*)(p.ws + OFF_OUTS); const bf16_t* H2B = (const bf16_t*)(p.ws + OFF_H2B); const float* fw = p.in[20];
    for (int it = blockIdx.x; it < NTOK / 32; it += gridDim.x) {
        const int t0 = it * 32;
        __syncthreads();
#pragma unroll 4
        for (int i = 0; i < 8; ++i) {
            const int q = tid + NTHR * i, s = q >> 5, tt = q & 31;
            *(LAS u32x4*)(lds + tt * 2064 + s * 16) = *(const u32x4*)(OUTS + ((size_t)s * NTOK + t0 + tt) * 8);
        }
        __syncthreads();
        for (int i = 0; i < 4; ++i) {
            const int tt = wave * 4 + i; float* orow = p.out + (size_t)(t0 + tt) * DM;
            f32x4 h[4]; float ss = 0.f;
#pragma unroll
            for (int j = 0; j < 2; ++j) {
                const u32x4 a = *(const u32x4*)(H2B + (size_t)(t0 + tt) * DM + 512 * j + 8 * lane), pq = *(const LAS u32x4*)(lds + tt * 2064 + (512 * j + 8 * lane) * 2);
                h[2 * j] = (f32x4){bflo(a.x) + bflo(pq.x), bfhi(a.x) + bfhi(pq.x), bflo(a.y) + bflo(pq.y), bfhi(a.y) + bfhi(pq.y)};
                h[2 * j + 1] = (f32x4){bflo(a.z) + bflo(pq.z), bfhi(a.z) + bfhi(pq.z), bflo(a.w) + bflo(pq.w), bfhi(a.w) + bfhi(pq.w)};
            }
#pragma unroll
            for (int j = 0; j < 4; ++j) ss += h[j].x * h[j].x + h[j].y * h[j].y + h[j].z * h[j].z + h[j].w * h[j].w;
            const float rs = rsqrtf(wave_sum(ss) * (1.f / DM) + EPS);
#pragma unroll
            for (int j = 0; j < 2; ++j) {
                float* o = orow + 512 * j + 8 * lane; const float* w = fw + 512 * j + 8 * lane;
                *(f32x4*)o = h[2 * j] * rs * *(const f32x4*)w; *(f32x4*)(o + 4) = h[2 * j + 1] * rs * *(const f32x4*)(w + 4);
            }
        }
    }
}


#define XB_TMO      128
#define XB_XCNT(j)  (256  + 64 * (j))
#define XB_XSUB(j)  (1280 + 64 * (j))
#define XB_XGEN(j)  (2304 + 64 * (j))
#define XB_TOP      3328
#define XB_TOPGEN   3392
#define XCD_BAR_WORDS 3456
#define XB_SPIN_CAP (1u << 18)
__device__ __forceinline__ unsigned xb_ld(unsigned* p)              { return __hip_atomic_load(p, __ATOMIC_RELAXED, __HIP_MEMORY_SCOPE_AGENT); }
__device__ __forceinline__ unsigned xb_add(unsigned* p, unsigned v) { return __hip_atomic_fetch_add(p, v, __ATOMIC_RELAXED, __HIP_MEMORY_SCOPE_AGENT); }
__device__ __forceinline__ unsigned xb_xcc_id() { return (unsigned)__builtin_amdgcn_s_getreg((3 << 11) | 20) & 0xFu; }
#define XB_SPIN(cond, bar) do { unsigned _sp = 0; while (cond) { __builtin_amdgcn_s_sleep(1); \
    if ((++_sp & 255u) == 0u) { if (xb_ld(&(bar)[XB_TMO])) break; if (_sp > XB_SPIN_CAP) { atomicAdd(&(bar)[XB_TMO], 1u); break; } } } } while (0)
struct XcdBarrier { unsigned* bar; unsigned x; volatile LAS unsigned* st; };
__device__ __forceinline__ XcdBarrier xcd_barrier_post(unsigned* bar, volatile LAS unsigned* st) {
    XcdBarrier b; b.bar = bar; b.x = xb_xcc_id(); b.st = st;
    if (threadIdx.x == 0) (void)xb_add(&bar[XB_XCNT(b.x)], 1u);
    return b;
}
__device__ __forceinline__ void xcd_barrier_complete(unsigned* bar, unsigned x, unsigned& nloc, unsigned& nx) {
    const unsigned G = gridDim.x * gridDim.y * gridDim.z;
    unsigned sum, cnt, mine, sp = 0u;
    for (;;) {
        sum = 0u; cnt = 0u; mine = 0u;
#pragma unroll
        for (unsigned j = 0; j < 16; ++j) { const unsigned c = xb_ld(&bar[XB_XCNT(j)]); sum += c; cnt += (c > 0u) ? 1u : 0u; mine = (j == x) ? c : mine; }
        if (sum == G) break;
        __builtin_amdgcn_s_sleep(1);
        if ((++sp & 255u) == 0u) { if (xb_ld(&bar[XB_TMO])) break; if (sp > XB_SPIN_CAP) { atomicAdd(&bar[XB_TMO], 1u); break; } }
    }
    nloc = mine > 0u ? mine : 1u; nx = cnt > 0u ? cnt : 1u;
}
__device__ __forceinline__ void xcd_barrier(const XcdBarrier& b) {
    asm volatile("s_waitcnt vmcnt(0)" ::: "memory");
    __syncthreads();
    if (threadIdx.x == 0) {
        unsigned* bar = b.bar;
        __builtin_amdgcn_s_waitcnt(0);
        unsigned nloc = b.st[0], nx = b.st[1];
        if (nloc == 0u) { xcd_barrier_complete(bar, b.x, nloc, nx); b.st[0] = nloc; b.st[1] = nx; }
        const unsigned old = xb_add(&bar[XB_XSUB(b.x)], 1u);
        const unsigned gen = old / nloc;
        if (old + 1u == (gen + 1u) * nloc) {
            __builtin_amdgcn_fence(__ATOMIC_RELEASE, "agent");
            asm volatile("s_waitcnt vmcnt(0)" ::: "memory");
            const unsigned og = xb_add(&bar[XB_TOP], 1u);
            const unsigned tg = og / nx;
            if (og + 1u == (tg + 1u) * nx) xb_add(&bar[XB_TOPGEN], 1u);
            else XB_SPIN(xb_ld(&bar[XB_TOPGEN]) == tg, bar);
            __builtin_amdgcn_fence(__ATOMIC_ACQUIRE, "agent");
            xb_add(&bar[XB_XGEN(b.x)], 1u);
            asm volatile("s_waitcnt vmcnt(0)" ::: "memory");
        } else {
            XB_SPIN(xb_ld(&bar[XB_XGEN(b.x)]) == gen, bar);
            __builtin_amdgcn_fence(__ATOMIC_ACQUIRE, "agent");
            asm volatile("s_waitcnt vmcnt(0)" ::: "memory");
        }
    }
    __syncthreads();
}

constexpr int NPHASE = 9;
__global__ void __launch_bounds__(NTHR, 2) mega(Params p) {
    extern __shared__ __attribute__((aligned(16))) unsigned char lds[];
    cg::grid_group grid = cg::this_grid();
#define PH_ON(k) (p.ph_lo <= (k) && (k) < p.ph_hi)
    if (threadIdx.x < 2) ((LAS unsigned*)((LAS unsigned char*)lds + LDS_BYTES - 32))[threadIdx.x] = 0u;
    __syncthreads();
    const XcdBarrier xbar = xcd_barrier_post((unsigned*)(p.ws + OFF_CTL) + 8192, (volatile LAS unsigned*)((LAS unsigned char*)lds + LDS_BYTES - 32));
#define PH_SYNC(k) do { if (PH_ON(k) && PH_ON((k) + 1)) { xcd_barrier(xbar); } } while (0)
    if (PH_ON(0)) phase0(p, lds);
    PH_SYNC(0);
    if (PH_ON(1)) phase1_mfma(p, (LAS unsigned char*)lds);
#if PROBE_DUP == 1
    grid.sync(); phase1_mfma(p, (LAS unsigned char*)lds);
#endif
    PH_SYNC(1);
    if (PH_ON(2)) phase2(p, (LAS unsigned char*)lds);
#if PROBE_DUP == 2
    grid.sync(); phase2(p, (LAS unsigned char*)lds, 1);
#endif
#if PROBE_DUP == 21
    grid.sync(); phase2(p, (LAS unsigned char*)lds, 2);
#endif
#if PROBE_DUP == 22
    grid.sync(); phase2(p, (LAS unsigned char*)lds, 3);
#endif
    PH_SYNC(2);
    if (PH_ON(4)) phase3_mfma(p, (LAS unsigned char*)lds);
#if PROBE_DUP == 4
    grid.sync(); phase3_mfma(p, (LAS unsigned char*)lds);
#endif
    PH_SYNC(4);
    if (PH_ON(5)) { phase4_mfma(p, (LAS unsigned char*)lds); quantize_hn(p); }
#if PROBE_DUP == 5
    grid.sync(); phase4_mfma(p, (LAS unsigned char*)lds);
#endif
    PH_SYNC(5);
    if (PH_ON(6)) phase5a(p, (LAS unsigned char*)lds);
#if PROBE_DUP == 6
    grid.sync(); phase5a(p, (LAS unsigned char*)lds, 1024);
#endif
    PH_SYNC(6);
    if (PH_ON(7)) phase5b(p, (LAS unsigned char*)lds);
#if PROBE_DUP == 7
    grid.sync(); phase5b(p, (LAS unsigned char*)lds);
#endif
    PH_SYNC(7);
    if (PH_ON(8)) phase5c(p, (LAS unsigned char*)lds);
}

extern "C" void kernel_launch(void* const* d_in, const int* in_sizes, int n_in, void* d_out, int out_size, void* d_ws, size_t ws_size, hipStream_t stream) {
    static int grid = 0;
    if (grid == 0) {
        if (n_in != 21 || out_size != NTOK * DM || ws_size < WS_END) { fprintf(stderr, "kernel_launch: unexpected shapes (n_in %d out %d ws %zu)\n", n_in, out_size, ws_size); grid = -1; return; }
        int dev = 0, cus = 0, per_cu = 0;
        hipGetDevice(&dev);
        hipDeviceGetAttribute(&cus, hipDeviceAttributeMultiprocessorCount, dev);
        hipFuncSetAttribute((const void*)mega, hipFuncAttributeMaxDynamicSharedMemorySize, LDS_BYTES);
        hipOccupancyMaxActiveBlocksPerMultiprocessor(&per_cu, (const void*)mega, NTHR, LDS_BYTES);
        if (per_cu < 1) { fprintf(stderr, "kernel_launch: occupancy query says %d blocks/CU\n", per_cu); per_cu = 1; }
        grid = cus * 1;
        (void)hipGetLastError();
    }
    if (grid < 0) return;
    hipMemsetAsync((char*)d_ws + OFF_CTL, 0, CTL_BYTES, stream);
    Params p{};
    for (int i = 0; i < 21; ++i) p.in[i] = (const float*)d_in[i];
    p.out = (float*)d_out; p.ws = (unsigned char*)d_ws; p.ph_lo = 0; p.ph_hi = NPHASE;
    void* args[] = {&p};
    hipError_t e = hipLaunchCooperativeKernel((const void*)mega, dim3(grid), dim3(NTHR), args, LDS_BYTES, stream);
    if (e != hipSuccess) fprintf(stderr, "cooperative launch failed: %s (grid %d)\n", hipGetErrorString(e), grid);
}
```

```cpp
#include <hip/hip_runtime.h>
#include <hip/hip_cooperative_groups.h>
#include <cstdio>
#include <cstdint>
namespace cg = cooperative_groups;

constexpr int DM = 1024;
constexpr int NB = 8, SEQ = 2048, NMETA = 16;
constexpr int NTOK = NB * SEQ;
constexpr int MROWS = 16640;
constexpr int NIN = 3584;
constexpr int TPOS = NMETA + SEQ;
constexpr float EPS = 1e-6f;
constexpr float QSCALE = 0.125f * 1.4426950408889634f;
constexpr int NEXP = 16384;
constexpr int NTHR = 512;
#ifndef PROBE_DUP
#define PROBE_DUP 0
#endif

constexpr size_t MiB = 1u << 20;
constexpr size_t OFF_CTL = 0, CTL_BYTES = 64 * 1024;
constexpr size_t OFF_MISC = 512 * 1024;
constexpr size_t OFF_ROPE = 1 * MiB;
constexpr size_t OFF_WOUT = 2 * MiB;
constexpr size_t OFF_WQ = 4 * MiB;
constexpr size_t OFF_KEYS = 8 * MiB;
constexpr size_t OFF_SSQP = 25 * MiB;
constexpr size_t OFF_UB = 9 * MiB;
constexpr size_t OFF_VB = 41 * MiB;
constexpr size_t OFF_XN = 73 * MiB;
constexpr size_t OFF_MIX = 73 * MiB;
constexpr size_t OFF_WIN = 106 * MiB;
constexpr size_t OFF_QB = 113 * MiB;
constexpr size_t OFF_KB = OFF_QB + 16 * MiB + 256 * 1024;
constexpr size_t OFF_VT = OFF_KB + 16 * MiB + 256 * 1024;
constexpr size_t OFF_H2B = 113 * MiB;
constexpr size_t OFF_GQ = 162 * MiB;
constexpr size_t OFF_GK = OFF_GQ + 8 * MiB + 256 * 1024;
constexpr size_t OFF_GVT = OFF_GK + 8 * MiB + 256 * 1024;
constexpr size_t OFF_GF = OFF_GVT + 16 * MiB + 256 * 1024;
constexpr size_t OFF_GB = OFF_GF + 16 * MiB + 256 * 1024;
constexpr size_t OFF_GR = OFF_GB + 16 * MiB + 256 * 1024;
constexpr size_t OFF_PW0 = 162 * MiB;
constexpr size_t OFF_USC = 64 * 1024;
constexpr size_t OFF_VSC = 128 * 1024;
constexpr size_t WS_END = OFF_GR + 16 * MiB + 256 * 1024;
static_assert(WS_END <= 256 * MiB, "workspace map");
static_assert(OFF_VT + (size_t)512 * MROWS * 2 <= OFF_GQ, "map D");
static_assert(OFF_WIN + (size_t)NIN * DM * 2 <= OFF_QB, "map C");

constexpr int LDS_BYTES = 163840;

typedef unsigned short bf16_t;
typedef float f32x4 __attribute__((ext_vector_type(4)));
typedef float f32x2 __attribute__((ext_vector_type(2)));
typedef unsigned u32x4 __attribute__((ext_vector_type(4)));
typedef unsigned u32x2 __attribute__((ext_vector_type(2)));
typedef __bf16 bf16x2_t __attribute__((ext_vector_type(2)));

struct Params {
    const float* in[21];
    float* out;
    unsigned char* ws;
    int ph_lo, ph_hi;
};

__device__ __forceinline__ unsigned f2bf(float f) { unsigned u = __float_as_uint(f); return (u + 0x7fffu + ((u >> 16) & 1u)) >> 16; }
__device__ __forceinline__ float bf2f(unsigned h) { return __uint_as_float(h << 16); }
__device__ __forceinline__ unsigned pk2(float lo, float hi) { return __builtin_bit_cast(unsigned, __builtin_convertvector((f32x2){lo, hi}, bf16x2_t)); }
__device__ __forceinline__ float bflo(unsigned w) { return __uint_as_float(w << 16); }
__device__ __forceinline__ float bfhi(unsigned w) { return __uint_as_float(w & 0xffff0000u); }
__device__ __forceinline__ float dot2(unsigned a, unsigned b, float c) {
    return __builtin_amdgcn_fdot2_f32_bf16(__builtin_bit_cast(bf16x2_t, a), __builtin_bit_cast(bf16x2_t, b), c, false);
}
__device__ __forceinline__ float dot8(u32x4 a, u32x4 b, float c) { c = dot2(a.x, b.x, c); c = dot2(a.y, b.y, c); c = dot2(a.z, b.z, c); return dot2(a.w, b.w, c); }
__device__ __forceinline__ float wave_sum(float v) {
#pragma unroll
    for (int o = 1; o < 64; o <<= 1) v += __shfl_xor(v, o);
    return v;
}
__device__ __forceinline__ float wave_max(float v) {
#pragma unroll
    for (int o = 1; o < 64; o <<= 1) v = fmaxf(v, __shfl_xor(v, o));
    return v;
}
__device__ __forceinline__ float silu_f(float x) { return x * __builtin_amdgcn_rcpf(1.f + __expf(-x)); }
__device__ __forceinline__ float logsig_f(float x) { return fminf(x, 0.f) - __logf(1.f + __expf(-fabsf(x))); }
__device__ __forceinline__ float gelu_f(float v) {
    const float av = fabsf(v), t = __builtin_amdgcn_rcpf(av * 0.2316418882f + 1.0f);
    float q = t * 0.5307027145f + (-0.7265760135f); q = q * t + 0.7107068705f; q = q * t + (-0.142248368f); q = q * t + 0.127414796f; q = q * t;
    const float m = v * (q * __builtin_amdgcn_exp2f(v * v * (-0.72134752044f)));
    return v < 0.f ? m : v - m;
}

__device__ __forceinline__ float win_src(const Params& p, int k, int n) {
    const float* W = p.in[3] + (size_t)k * 3104;
    if (n < 1024) {
        const int base = n & ~63, dp = n & 63, d = dp < 16 ? ((dp >> 1) + 8 * (dp & 1)) : dp;
        return W[base + d];
    } else if (n < 3072) return W[n];
    const int j = (n - 3072) & 255, dir = (n - 3072) >> 8;
    const float* w2 = p.in[dir ? 11 : 9];
    const float* wz = W + 3072 + dir * 16;
    float s = 0.f;
#pragma unroll
    for (int r = 0; r < 16; ++r) s += wz[r] * w2[r * 256 + j];
    return s;
}

template <int WHICH>
__device__ __forceinline__ void p0_transpose_item(const Params& p, float* scr, int item, int lane) {
    constexpr int N = WHICH == 0 ? NIN : (WHICH == 1 ? 1024 : 2048);
    constexpr int nblk = N / 32;
    const int kb = item / nblk, nb = item % nblk, k0 = 64 * kb, n0 = 32 * nb;
    bf16_t* WT = (bf16_t*)(p.ws + (WHICH == 0 ? OFF_WIN : (WHICH == 1 ? OFF_WOUT : OFF_WQ)));
#pragma unroll 4
    for (int i = 0; i < 32; ++i) {
        const int kk = 2 * i + (lane >> 5), k = k0 + kk, n = n0 + (lane & 31);
        float v;
        if (WHICH == 0) v = win_src(p, k, n);
        else if (WHICH == 1) v = p.in[14][(size_t)k * 1024 + n];
        else v = p.in[16][(size_t)k * 2048 + n] * p.in[15][k];
        scr[kk * 33 + (lane & 31)] = v;
    }
    __builtin_amdgcn_s_waitcnt(0xC07F); __builtin_amdgcn_wave_barrier();
    const int c = lane & 7;
#pragma unroll
    for (int j = 0; j < 4; ++j) {
        const int n = (lane >> 3) + 8 * j; const float* s = scr + (8 * c) * 33 + n;
        u32x4 o; o.x = pk2(s[0 * 33], s[1 * 33]); o.y = pk2(s[2 * 33], s[3 * 33]); o.z = pk2(s[4 * 33], s[5 * 33]); o.w = pk2(s[6 * 33], s[7 * 33]);
        *(u32x4*)(WT + (size_t)(n0 + n) * 1024 + k0 + 8 * c) = o;
    }
    __builtin_amdgcn_s_waitcnt(0xC07F); __builtin_amdgcn_wave_barrier();
}

__device__ __forceinline__ void phase0(const Params& p, unsigned char* lds) {
    const int tid = threadIdx.x, lane = tid & 63, wave = tid >> 6;
    const int gw = blockIdx.x * 8 + wave, NGW = gridDim.x * 8;
    const long gt = (long)blockIdx.x * NTHR + tid, NGT = (long)gridDim.x * NTHR;
    {
        const f32x4* lw = (const f32x4*)p.in[2];
        bf16_t* XN = (bf16_t*)(p.ws + OFF_XN);
        for (int r = gw; r < MROWS; r += NGW) {
            const float* src = r < NTOK ? p.in[0] + (size_t)r * DM : (r < NTOK + NMETA ? p.in[1] + (size_t)(r - NTOK) * DM : nullptr);
            f32x4 v[4]; float s = 0.f;
#pragma unroll
            for (int j = 0; j < 4; ++j) { v[j] = src ? ((const f32x4*)src)[lane + 64 * j] : (f32x4){0.f, 0.f, 0.f, 0.f}; s += v[j].x * v[j].x + v[j].y * v[j].y + v[j].z * v[j].z + v[j].w * v[j].w; }
            const float rs = rsqrtf(wave_sum(s) * (1.f / DM) + EPS);
#pragma unroll
            for (int j = 0; j < 4; ++j) { const f32x4 w = lw[lane + 64 * j]; u32x2 o; o.x = pk2(v[j].x * rs * w.x, v[j].y * rs * w.y); o.y = pk2(v[j].z * rs * w.z, v[j].w * rs * w.w);
                *(u32x2*)(XN + (size_t)r * DM + 4 * (lane + 64 * j)) = o; }
        }
    }
    {
        float* scr = (float*)lds + wave * (64 * 33);
        constexpr int I0 = 16 * (NIN / 32);
        for (int it = gw; it < I0; it += NGW) p0_transpose_item<0>(p, scr, it, lane);
    }
    {
        f32x2* rope = (f32x2*)(p.ws + OFF_ROPE);
        for (long i = gt; i < TPOS * 8; i += NGT) {
            const int t = (int)(i >> 3), j = (int)(i & 7);
            const float inv = powf(500000.0f, -(float)j * 0.125f);
            const float ang = (float)t * inv;
            rope[i] = (f32x2){cosf(ang), sinf(ang)};
        }
        if (gt == 0) {
            float a = 0.f, b = 0.f;
            for (int i = 0; i < 64; ++i) { a += p.in[4][i] * p.in[5][i]; b += p.in[6][i] * p.in[7][i]; }
            ((float*)(p.ws + OFF_MISC))[0] = expf(a) - expf(b) + 0.2f;
        }
    }
}
constexpr int CV_WOUT = 64, CV_WQ = 128, CV_KEYS = 8, CV_U = 256, CV_V = 256, CV_ITEMS = CV_WOUT + CV_WQ + CV_KEYS + CV_U + CV_V;
__device__ __forceinline__ void conv_item(const Params& p, unsigned char* lds, int c) {
    const int tid = threadIdx.x, lane = tid & 63, wave = tid >> 6;
    __syncthreads();
    if (c < CV_WOUT) { p0_transpose_item<1>(p, (float*)lds + wave * (64 * 33), c * 8 + wave, lane); return; }
    c -= CV_WOUT;
    if (c < CV_WQ) { p0_transpose_item<2>(p, (float*)lds + wave * (64 * 33), c * 8 + wave, lane); return; }
    c -= CV_WQ;
    if (c < CV_KEYS) {
        bf16_t* KEYS = (bf16_t*)(p.ws + OFF_KEYS);
#pragma unroll 2
        for (int j = 0; j < 8; ++j) {
            const long e = ((long)c * 4096 + tid + NTHR * j) * 8;
            const f32x4 a = *(const f32x4*)(p.in[17] + e), b = *(const f32x4*)(p.in[17] + e + 4);
            u32x4 o; o.x = pk2(a.x, a.y); o.y = pk2(a.z, a.w); o.z = pk2(b.x, b.y); o.w = pk2(b.z, b.w);
            *(u32x4*)(KEYS + e) = o;
        }
        return;
    }
    c -= CV_KEYS;
    if (c < CV_U) {
        unsigned char* UQ = p.ws + OFF_UB; float* USC = (float*)(p.ws + OFF_USC);
#pragma unroll 2
        for (int i = 0; i < 8; ++i) {
            const int r = c * 64 + wave * 8 + i;
            const float* ur = p.in[18] + (size_t)r * DM + 16 * lane; const float* lw = p.in[15] + 16 * lane;
            f32x4 v[4]; float am = 0.f;
#pragma unroll
            for (int j = 0; j < 4; ++j) { v[j] = ((const f32x4*)ur)[j] * ((const f32x4*)lw)[j]; am = fmaxf(am, fmaxf(fmaxf(fabsf(v[j].x), fabsf(v[j].y)), fmaxf(fabsf(v[j].z), fabsf(v[j].w)))); }
            am = fmaxf(wave_max(am), 1e-30f);
            const float sc = 224.f / am;
            u32x4 o;
#pragma unroll
            for (int j = 0; j < 4; ++j) { int w = __builtin_amdgcn_cvt_pk_fp8_f32(v[j].x * sc, v[j].y * sc, 0, false); w = __builtin_amdgcn_cvt_pk_fp8_f32(v[j].z * sc, v[j].w * sc, w, true); o[j] = (unsigned)w; }
            *(u32x4*)(UQ + (size_t)r * DM + 16 * lane) = o;
            if (lane == 0) USC[r] = am * (1.f / 224.f);
        }
        return;
    }
    c -= CV_U;
    {
        unsigned char* VS = p.ws + OFF_VB; float* VSC = (float*)(p.ws + OFF_VSC);
        const int tile = c;
#pragma unroll 2
        for (int i = 0; i < 8; ++i) {
            const int er = wave * 8 + i, r = tile * 64 + er;
            const float* vr = p.in[19] + (size_t)r * DM + 16 * lane;
            f32x4 v[4]; float am = 0.f;
#pragma unroll
            for (int j = 0; j < 4; ++j) { v[j] = ((const f32x4*)vr)[j]; am = fmaxf(am, fmaxf(fmaxf(fabsf(v[j].x), fabsf(v[j].y)), fmaxf(fabsf(v[j].z), fabsf(v[j].w)))); }
            am = fmaxf(wave_max(am), 1e-30f);
            const float sc = 224.f / am;
            u32x4 o;
#pragma unroll
            for (int j = 0; j < 4; ++j) { int w = __builtin_amdgcn_cvt_pk_fp8_f32(v[j].x * sc, v[j].y * sc, 0, false); w = __builtin_amdgcn_cvt_pk_fp8_f32(v[j].z * sc, v[j].w * sc, w, true); o[j] = (unsigned)w; }
            *(u32x2*)(lds + er * 1032 + 16 * lane) = (u32x2){o.x, o.y}; *(u32x2*)(lds + er * 1032 + 16 * lane + 8) = (u32x2){o.z, o.w};
            if (lane == 0) VSC[r] = am * (1.f / 224.f);
        }
        __syncthreads();
#pragma unroll 4
        for (int i = 0; i < 16; ++i) {
            const int s = wave + 8 * i;
            *(u32x2*)(VS + ((size_t)s * NEXP + tile * 64 + lane) * 8) = *(const u32x2*)(lds + lane * 1032 + s * 8);
        }
    }
}

struct P1Ptrs { unsigned char* ws; const float* bias_f; const float* bias_b; };
__device__ __forceinline__ void p1_store(const P1Ptrs p, int row, int n0, float v0, float v1, float v2, float v3) {
    if (n0 < 1024) {
        const int dp = n0 & 63;
        if (dp < 16) {
            const int pos = row < NTOK ? NMETA + (row & (SEQ - 1)) : (row - NTOK);
            const f32x4 cs = *(const f32x4*)((const float*)(p.ws + OFF_ROPE) + ((size_t)pos * 8 + (dp >> 1)) * 2);
            const float a0 = v0 * cs.x - v1 * cs.y, b0 = v1 * cs.x + v0 * cs.y;
            const float a1 = v2 * cs.z - v3 * cs.w, b1 = v3 * cs.z + v2 * cs.w;
            v0 = a0; v1 = b0; v2 = a1; v3 = b1;
        }
        if (n0 < 512) { u32x2 o; o.x = pk2(v0 * QSCALE, v1 * QSCALE); o.y = pk2(v2 * QSCALE, v3 * QSCALE); *(u32x2*)((bf16_t*)(p.ws + OFF_QB) + (size_t)row * 512 + n0) = o; }
        else { u32x2 o; o.x = pk2(v0, v1); o.y = pk2(v2, v3); *(u32x2*)((bf16_t*)(p.ws + OFF_KB) + (size_t)row * 512 + (n0 - 512)) = o; }
    } else if (n0 < 1536) {
        bf16_t* VT = (bf16_t*)(p.ws + OFF_VT) + (size_t)(n0 - 1024) * MROWS + row;
        VT[0] = (bf16_t)f2bf(v0); VT[MROWS] = (bf16_t)f2bf(v1); VT[2 * MROWS] = (bf16_t)f2bf(v2); VT[3 * (size_t)MROWS] = (bf16_t)f2bf(v3);
    } else if (n0 < 1792) {
        u32x2 o; o.x = pk2(v0 * 0.125f, v1 * 0.125f); o.y = pk2(v2 * 0.125f, v3 * 0.125f); *(u32x2*)((bf16_t*)(p.ws + OFF_GQ) + (size_t)row * 256 + (n0 - 1536)) = o;
    } else if (n0 < 2048) {
        u32x2 o; o.x = pk2(v0, v1); o.y = pk2(v2, v3); *(u32x2*)((bf16_t*)(p.ws + OFF_GK) + (size_t)row * 256 + (n0 - 1792)) = o;
    } else if (n0 < 2560) {
        bf16_t* VT = (bf16_t*)(p.ws + OFF_GVT) + (size_t)(n0 - 2048) * MROWS + row;
        VT[0] = (bf16_t)f2bf(v0); VT[MROWS] = (bf16_t)f2bf(v1); VT[2 * MROWS] = (bf16_t)f2bf(v2); VT[3 * (size_t)MROWS] = (bf16_t)f2bf(v3);
    } else if (n0 < 3072) {
        u32x2 o; o.x = pk2(silu_f(v0), silu_f(v1)); o.y = pk2(silu_f(v2), silu_f(v3)); *(u32x2*)((bf16_t*)(p.ws + OFF_GR) + (size_t)row * 512 + (n0 - 2560)) = o;
    } else {
        const int dir = (n0 - 3072) >> 8, j = (n0 - 3072) & 255;
        const f32x4 bb = *(const f32x4*)((dir ? p.bias_b : p.bias_f) + j);
        f32x4 o; o.x = logsig_f(v0 + bb.x) * 0.0625f; o.y = logsig_f(v1 + bb.y) * 0.0625f; o.z = logsig_f(v2 + bb.z) * 0.0625f; o.w = logsig_f(v3 + bb.w) * 0.0625f;
        *(f32x4*)((float*)(p.ws + (dir ? OFF_GB : OFF_GF)) + (size_t)row * 256 + j) = o;
    }
}


#define LAS __attribute__((address_space(3)))
typedef short bf16x8 __attribute__((ext_vector_type(8)));
constexpr int GBUF = 49152;

template <int ROWS>
__device__ __forceinline__ void stage_tile(const bf16_t* G, int ldk, int r0, int k0, LAS unsigned char* buf, int wave, int lane) {
    const int rr = lane >> 3, c = (lane & 7) ^ rr;
#pragma unroll
    for (int i = 0; i < ROWS / 64; ++i) {
        const int grp = wave + 8 * i;
        const bf16_t* src = G + (size_t)(r0 + grp * 8 + rr) * ldk + k0 + c * 8;
        __builtin_amdgcn_global_load_lds((const unsigned*)src, (LAS unsigned*)(buf + grp * 1024), 16, 0, 0);
    }
}
__device__ __forceinline__ bf16x8 ldfrag(const LAS unsigned char* buf, int row, int c) {
    return *(const LAS bf16x8*)(buf + row * 128 + ((c ^ (row & 7)) << 4));
}
template <bool SWAP>
__device__ __forceinline__ void gemm_tile_256(const bf16_t* A, const bf16_t* Bt, int K, int m0, int n0, LAS unsigned char* lds, f32x4 (&acc)[4][4]) {
    const int tid = threadIdx.x, lane = tid & 63, wave = __builtin_amdgcn_readfirstlane(tid >> 6), wm = wave >> 2, wn = wave & 3, l15 = lane & 15, g = lane >> 4;
#pragma unroll
    for (int i = 0; i < 4; ++i)
#pragma unroll
        for (int j = 0; j < 4; ++j) acc[i][j] = (f32x4){0.f, 0.f, 0.f, 0.f};
    const int nk = K / 64;
    stage_tile<128>(A, K, m0, 0, lds, wave, lane);
    stage_tile<256>(Bt, K, n0, 0, lds + 16384, wave, lane);
    for (int kt = 0; kt < nk; ++kt) {
        asm volatile("s_waitcnt vmcnt(0)" ::: "memory");
        __syncthreads();
        if (kt + 1 < nk) {
            LAS unsigned char* nb = lds + ((kt + 1) & 1) * GBUF;
            stage_tile<128>(A, K, m0, (kt + 1) * 64, nb, wave, lane);
            stage_tile<256>(Bt, K, n0, (kt + 1) * 64, nb + 16384, wave, lane);
        }
        const LAS unsigned char* a = lds + (kt & 1) * GBUF; const LAS unsigned char* b = a + 16384;
#pragma unroll
        for (int ks = 0; ks < 2; ++ks) {
            bf16x8 af[4], bfr[4];
#pragma unroll
            for (int i = 0; i < 4; ++i) { af[i] = ldfrag(a, wm * 64 + i * 16 + l15, ks * 4 + g); bfr[i] = ldfrag(b, wn * 64 + i * 16 + l15, ks * 4 + g); }
#pragma unroll
            for (int i = 0; i < 4; ++i)
#pragma unroll
                for (int j = 0; j < 4; ++j)
                    acc[i][j] = SWAP ? __builtin_amdgcn_mfma_f32_16x16x32_bf16(af[i], bfr[j], acc[i][j], 0, 0, 0)
                                     : __builtin_amdgcn_mfma_f32_16x16x32_bf16(bfr[j], af[i], acc[i][j], 0, 0, 0);
        }
    }
}
__device__ __forceinline__ int vcu_of_block() { const int G = gridDim.x, bx = blockIdx.x; return (G % 8 == 0) ? (bx % 8) * (G / 8) + bx / 8 : bx; }

namespace pg8 {
#define PG8_LAS __attribute__((address_space(3)))
typedef unsigned short bf16_t;
typedef short bf16x8 __attribute__((ext_vector_type(8)));
typedef float f32x4 __attribute__((ext_vector_type(4)));
typedef unsigned u32x4 __attribute__((ext_vector_type(4)));
constexpr int BM = 256, BK = 64, HALF = 128, HTB = HALF * BK * 2  , STAGE_BYTES = 8 * HTB, NXCD = 8, WGM = 8;

__host__ __device__ __forceinline__ int lds_byte(int r, int c) { const int st = (r >> 4) * 2 + (c >> 5), rr = r & 15, cc = c & 31, ob = rr * 64 + cc * 2; return st * 1024 + (ob ^ (((ob >> 9) & 1) << 5)); }
__host__ __device__ __forceinline__ void stage_rc(int b, int& R, int& C) { const int st = b / 1024, sb = b % 1024, swz = sb ^ (((sb >> 9) & 1) << 5); R = (st >> 1) * 16 + swz / 64; C = (st & 1) * 32 + (swz % 64) / 2; }
__host__ __device__ __forceinline__ int perm32(int rho) { const int n = rho >> 4, i = rho & 15; return 8 * (i >> 2) + 4 * n + (i & 3); }

struct Unit { int pm, pn; };
struct Gemm { const bf16_t* A; const bf16_t* Bt; int M, N, K; };

struct StaticOrder {
    int nM, nN, nwg, G, c;
    __host__ __device__ void init(int M, int N, int G_, int c_) { nM = M / BM; nN = N / BM; nwg = nM * nN; G = G_; c = c_; }
    __host__ __device__ bool next(int i, Unit& u) const {
        const long L = (long)i * G + c; if (L >= nwg) return false;
        int wgid = (int)L; { const int q = nwg / NXCD, r = nwg % NXCD, xcd = wgid % NXCD, off = wgid / NXCD; wgid = (xcd < r ? xcd * (q + 1) : r * (q + 1) + (xcd - r) * q) + off; }
        const int nig = WGM * nN, gid = wgid / nig, fm = gid * WGM, gsz = (nM - fm) < WGM ? (nM - fm) : WGM;
        u.pm = fm + ((wgid % nig) % gsz); u.pn = (wgid % nig) / gsz; return true;
    }
    __device__ __forceinline__ void a_ready(const Unit&) const {}
    __device__ __forceinline__ void done(const Unit&) const {}
};

struct EpiP1 {
    static constexpr bool PERM = true, AFTER_DRAIN = false, SWAPPABLE = true;
    P1Ptrs p;
    static __device__ __forceinline__ bool swap_unit(const Unit& u) { return u.pn == 4 || u.pn == 5 || u.pn == 8 || u.pn == 9; }
    __device__ __forceinline__ void operator()(const f32x4 (&acc)[2][2][4][2], const Unit& u, int wr, int wc, int fr, int fq) const {
        if (swap_unit(u)) {
            const int cb = u.pn * BM, nbase = cb < 1536 ? cb - 1024 : cb - 2048;
            bf16_t* T = (bf16_t*)(p.ws + (cb < 1536 ? OFF_VT : OFF_GVT)) + (size_t)(nbase + wc * 32 + 8 * (fr >> 2) + (fr & 3)) * MROWS + u.pm * BM + wr * 64 + 4 * fq;
#pragma unroll
            for (int bj = 0; bj < 2; ++bj)
#pragma unroll
                for (int n = 0; n < 2; ++n)
#pragma unroll
                    for (int ai = 0; ai < 2; ++ai)
#pragma unroll
                        for (int m = 0; m < 4; ++m) { const f32x4 v = acc[ai][bj][m][n];
                            *(u32x2*)(T + (size_t)(bj * HALF + n * 4) * MROWS + ai * HALF + m * 16) = (u32x2){pk2(v.x, v.y), pk2(v.z, v.w)}; }
            return;
        }
#pragma unroll
        for (int bj = 0; bj < 2; ++bj) {
            const int nw = u.pn * BM + bj * HALF + wc * 32;
            const int rowb = u.pm * BM + wr * 64 + fr;
            if (nw >= 3072) {
                const int dir = (nw - 3072) >> 8, j0 = ((nw - 3072) & 255) + 8 * fq;
                float* G = (float*)(p.ws + (dir ? OFF_GB : OFF_GF)); const float* bias = dir ? p.bias_b : p.bias_f;
                const f32x4 b0 = *(const f32x4*)(bias + j0), b1 = *(const f32x4*)(bias + j0 + 4);
#pragma unroll
                for (int ai = 0; ai < 2; ++ai)
#pragma unroll
                    for (int m = 0; m < 4; ++m) { const f32x4 v0 = acc[ai][bj][m][0], v1 = acc[ai][bj][m][1]; f32x4 o0, o1;
                        o0.x = logsig_f(v0.x + b0.x) * 0.0625f; o0.y = logsig_f(v0.y + b0.y) * 0.0625f; o0.z = logsig_f(v0.z + b0.z) * 0.0625f; o0.w = logsig_f(v0.w + b0.w) * 0.0625f;
                        o1.x = logsig_f(v1.x + b1.x) * 0.0625f; o1.y = logsig_f(v1.y + b1.y) * 0.0625f; o1.z = logsig_f(v1.z + b1.z) * 0.0625f; o1.w = logsig_f(v1.w + b1.w) * 0.0625f;
                        float* gp = G + (size_t)(rowb + ai * HALF + m * 16) * 256 + j0; *(f32x4*)gp = o0; *(f32x4*)(gp + 4) = o1; }
            } else {
                bf16_t* base; int ld, c0; float sc = 1.f; bool silu = false;
                if (nw < 512) { base = (bf16_t*)(p.ws + OFF_QB); ld = 512; c0 = nw; sc = QSCALE; }
                else if (nw < 1024) { base = (bf16_t*)(p.ws + OFF_KB); ld = 512; c0 = nw - 512; }
                else if (nw < 1792) { base = (bf16_t*)(p.ws + OFF_GQ); ld = 256; c0 = nw - 1536; sc = 0.125f; }
                else if (nw < 2048) { base = (bf16_t*)(p.ws + OFF_GK); ld = 256; c0 = nw - 1792; }
                else { base = (bf16_t*)(p.ws + OFF_GR); ld = 512; c0 = nw - 2560; silu = true; }
                const bool rope = nw < 1024 && (nw & 63) == 0 && fq < 2;
#pragma unroll
                for (int ai = 0; ai < 2; ++ai)
#pragma unroll
                    for (int m = 0; m < 4; ++m) {
                        const int row = rowb + ai * HALF + m * 16;
                        f32x4 v0 = acc[ai][bj][m][0], v1 = acc[ai][bj][m][1];
                        if (rope) {
                            const int pos = row < NTOK ? NMETA + (row & (SEQ - 1)) : (row - NTOK < TPOS ? row - NTOK : 0);
                            const f32x4* cp = (const f32x4*)((const float*)(p.ws + OFF_ROPE) + ((size_t)pos * 8 + 4 * fq) * 2);
                            const f32x4 ca = cp[0], cb2 = cp[1];
                            v0 = (f32x4){v0.x * ca.x - v0.y * ca.y, v0.y * ca.x + v0.x * ca.y, v0.z * ca.z - v0.w * ca.w, v0.w * ca.z + v0.z * ca.w};
                            v1 = (f32x4){v1.x * cb2.x - v1.y * cb2.y, v1.y * cb2.x + v1.x * cb2.y, v1.z * cb2.z - v1.w * cb2.w, v1.w * cb2.z + v1.z * cb2.w};
                        }
                        if (silu) { v0 = (f32x4){silu_f(v0.x), silu_f(v0.y), silu_f(v0.z), silu_f(v0.w)}; v1 = (f32x4){silu_f(v1.x), silu_f(v1.y), silu_f(v1.z), silu_f(v1.w)}; }
                        else { v0 = v0 * sc; v1 = v1 * sc; }
                        *(u32x4*)(base + (size_t)row * ld + c0 + 8 * fq) = (u32x4){pk2(v0.x, v0.y), pk2(v0.z, v0.w), pk2(v1.x, v1.y), pk2(v1.z, v1.w)};
                    }
            }
        }
    }
};
struct EpiP3 {
    static constexpr bool PERM = true, AFTER_DRAIN = false, SWAPPABLE = false;
    const float* x; float* out; bf16_t* h2b; float* ssq;
    __device__ __forceinline__ void operator()(const f32x4 (&acc)[2][2][4][2], const Unit& u, int wr, int wc, int fr, int fq) const {
#pragma unroll
        for (int ai = 0; ai < 2; ++ai)
#pragma unroll
            for (int m = 0; m < 4; ++m) { const int row = u.pm * BM + ai * HALF + wr * 64 + m * 16 + fr; float ss = 0.f;
#pragma unroll
                for (int bj = 0; bj < 2; ++bj) { const int col = u.pn * BM + bj * HALF + wc * 32 + 8 * fq;
                    const f32x4 h0 = *(const f32x4*)(x + (size_t)row * DM + col) + acc[ai][bj][m][0], h1 = *(const f32x4*)(x + (size_t)row * DM + col + 4) + acc[ai][bj][m][1];
                    *(u32x4*)(h2b + (size_t)row * DM + col) = (u32x4){pk2(h0.x, h0.y), pk2(h0.z, h0.w), pk2(h1.x, h1.y), pk2(h1.z, h1.w)};
                    ss += (h0.x * h0.x + h0.y * h0.y + h0.z * h0.z + h0.w * h0.w) + (h1.x * h1.x + h1.y * h1.y + h1.z * h1.z + h1.w * h1.w); }
                ss += __shfl_xor(ss, 16); ss += __shfl_xor(ss, 32);
                if (fq == 0) ssq[(size_t)row * 16 + u.pn * 4 + wc] = ss; }
    }
};

struct P1Order {
    int G, c, ncol, nM; bool vt;
    __device__ __forceinline__ bool next(int i, Unit& u) const {
        const int nwg = nM * ncol; const int L = i * G + (vt ? (G - 1 - c) : c); if (L >= nwg) return false;
        const int pm = L / ncol, j = L % ncol;
        u.pm = pm; u.pn = vt ? (j < 2 ? 4 + j : 6 + j) : (j < 4 ? j : (j < 6 ? j + 2 : j + 4));
        return true;
    }
    __device__ __forceinline__ void a_ready(const Unit&) const {}
    __device__ __forceinline__ void done(const Unit&) const {}
};
struct OneUnit {
    Unit u; bool valid;
    __device__ __forceinline__ bool next(int i, Unit& o) const { if (i != 0 || !valid) return false; o = u; return true; }
    __device__ __forceinline__ void a_ready(const Unit&) const {}
    __device__ __forceinline__ void done(const Unit&) const {}
};

template <class Epi, class Sched, bool ALIGN_EPI = false, bool SP2 = false, bool SWP = false>
__device__ __forceinline__ void gemm_phase(PG8_LAS unsigned char* lds, const Gemm g, const Sched& S, const Epi& E) {
    int tid_ = threadIdx.x; asm volatile("" : "+v"(tid_));
    const int tid = tid_, wid = __builtin_amdgcn_readfirstlane(tid >> 6), lane = tid & 63, wr = wid >> 2, wc = wid & 3, fr = lane & 15, fq = lane >> 4;
    const int K = g.K, nt = K / BK;
    unsigned voffA[2], voffB[2];
#pragma unroll
    for (int i = 0; i < 2; ++i) { int R, C; stage_rc(tid * 16 + i * 8192, R, C); const int Rb = Epi::PERM ? ((R & ~31) + perm32(R & 31)) : R;
        voffA[i] = (unsigned)(R * K + C) * 2u; voffB[i] = (unsigned)(Rb * K + C) * 2u; }
    const size_t kstep = (size_t)(BK * 2);
    const size_t hstep = (size_t)HALF * K * 2;
    const size_t tstep = 2 * hstep;
    const unsigned ldsw = (unsigned)wid * 1024u;
    const int aoff = lds_byte(wr * 64 + fr, fq * 8), boff = lds_byte(wc * 32 + fr, fq * 8);
#define PG8_SA(b, h) (((b) * 2 + (h)) * HTB)
#define PG8_SB(b, h) ((4 + (b) * 2 + (h)) * HTB)
#define PG8_STAGE(bufoff, gbase, voff) do { _Pragma("unroll") for (int _i = 0; _i < 2; ++_i) \
        __builtin_amdgcn_global_load_lds((const unsigned*)((const char*)(gbase) + (voff)[_i]), (PG8_LAS unsigned*)(lds + (bufoff) + ldsw + _i * 8192), 16, 0, 0); } while (0)
#define PG8_LDA(dst, b, h) do { _Pragma("unroll") for (int m = 0; m < 4; ++m) _Pragma("unroll") for (int k = 0; k < 2; ++k) dst[m][k] = *(const PG8_LAS bf16x8*)(lds + PG8_SA(b, h) + aoff + m * 2048 + k * 1024); } while (0)
#define PG8_LDB(dst, b, h) do { _Pragma("unroll") for (int n = 0; n < 2; ++n) _Pragma("unroll") for (int k = 0; k < 2; ++k) dst[n][k] = *(const PG8_LAS bf16x8*)(lds + PG8_SB(b, h) + boff + n * 2048 + k * 1024); } while (0)
#define PG8_MMA(ai, bj, At, Bt) do { __builtin_amdgcn_s_setprio(1); \
        if (SWP) { _Pragma("unroll") for (int m = 0; m < 4; ++m) _Pragma("unroll") for (int n = 0; n < 2; ++n) _Pragma("unroll") for (int k = 0; k < 2; ++k) \
            acc[ai][bj][m][n] = __builtin_amdgcn_mfma_f32_16x16x32_bf16(At[m][k], Bt[n][k], acc[ai][bj][m][n], 0, 0, 0); } \
        else { _Pragma("unroll") for (int m = 0; m < 4; ++m) _Pragma("unroll") for (int n = 0; n < 2; ++n) _Pragma("unroll") for (int k = 0; k < 2; ++k) \
            acc[ai][bj][m][n] = __builtin_amdgcn_mfma_f32_16x16x32_bf16(Bt[n][k], At[m][k], acc[ai][bj][m][n], 0, 0, 0); } \
        __builtin_amdgcn_s_setprio(0); } while (0)
#define PG8_WAIT_V(n) asm volatile("s_waitcnt vmcnt(" #n ")" ::: "memory")
#define PG8_WAIT_L(n) asm volatile("s_waitcnt lgkmcnt(" #n ")" ::: "memory")
#define PG8_BAR __builtin_amdgcn_s_barrier()
#define PG8_SCHED __builtin_amdgcn_sched_barrier(0)
    Unit cur, nxt; int ui = 0;
    if (!S.next(0, cur)) return;
    f32x4 acc[2][2][4][2];
#pragma unroll
    for (int a = 0; a < 2; ++a)
#pragma unroll
        for (int b = 0; b < 2; ++b)
#pragma unroll
            for (int m = 0; m < 4; ++m)
#pragma unroll
                for (int n = 0; n < 2; ++n) acc[a][b][m][n] = (f32x4){0.f, 0.f, 0.f, 0.f};
    bf16x8 At[4][2], B0[2][2], B1[2][2];
    const char* cA = (const char*)g.A + (size_t)cur.pm * tstep; const char* cB = (const char*)g.Bt + (size_t)cur.pn * tstep;
    S.a_ready(cur);
    if constexpr (SP2) {
        PG8_STAGE(PG8_SB(0, 0), cB, voffB); PG8_STAGE(PG8_SB(0, 1), cB + hstep, voffB); PG8_STAGE(PG8_SA(0, 0), cA, voffA); PG8_STAGE(PG8_SA(0, 1), cA + hstep, voffA);
        if (wr == 1) PG8_BAR;
        PG8_WAIT_V(2); PG8_BAR;
        PG8_STAGE(PG8_SB(1, 0), cB + kstep, voffB); PG8_STAGE(PG8_SA(1, 0), cA + kstep, voffA); PG8_STAGE(PG8_SB(1, 1), cB + hstep + kstep, voffB);
        PG8_WAIT_V(6); PG8_BAR;
    } else {
        PG8_STAGE(PG8_SB(0, 0), cB, voffB); PG8_STAGE(PG8_SA(0, 0), cA, voffA); PG8_STAGE(PG8_SB(0, 1), cB + hstep, voffB); PG8_STAGE(PG8_SA(0, 1), cA + hstep, voffA);
        if (wr == 1) PG8_BAR;
        PG8_WAIT_V(4); PG8_BAR;
        PG8_STAGE(PG8_SB(1, 0), cB + kstep, voffB); PG8_STAGE(PG8_SA(1, 0), cA + kstep, voffA); PG8_STAGE(PG8_SB(1, 1), cB + hstep + kstep, voffB);
        PG8_WAIT_V(6); PG8_BAR;
    }
    for (;;) {
        const bool has_next = S.next(ui + 1, nxt);
        const char* nA = has_next ? (const char*)g.A + (size_t)nxt.pm * tstep : cA; const char* nB = has_next ? (const char*)g.Bt + (size_t)nxt.pn * tstep : cB;
        for (int t = 0; t < nt; t += 2) {
            const bool last = (t == nt - 2);
            const char* a1 = cA + (size_t)(t + 1) * kstep;
            const char* a2 = last ? nA : cA + (size_t)(t + 2) * kstep; const char* b2 = last ? nB : cB + (size_t)(t + 2) * kstep;
            const char* a3 = a2 + kstep; const char* b3 = b2 + kstep;
            if (last && has_next) S.a_ready(nxt);
            if constexpr (SP2) {
            PG8_LDB(B0, 0, 0); PG8_LDB(B1, 0, 1); PG8_SCHED; PG8_LDA(At, 0, 0); PG8_STAGE(PG8_SA(1, 1), a1 + hstep, voffA);
            PG8_WAIT_V(8); PG8_WAIT_L(0); PG8_BAR; PG8_MMA(0, 0, At, B0); PG8_MMA(0, 1, At, B1); PG8_BAR; PG8_SCHED;
            PG8_LDA(At, 0, 1); PG8_STAGE(PG8_SB(0, 0), b2, voffB); PG8_STAGE(PG8_SB(0, 1), b2 + hstep, voffB); PG8_STAGE(PG8_SA(0, 0), a2, voffA);
            PG8_WAIT_V(8); PG8_WAIT_L(0); PG8_BAR; PG8_MMA(1, 0, At, B0); PG8_MMA(1, 1, At, B1); PG8_BAR; PG8_SCHED;
            PG8_LDB(B0, 1, 0); PG8_LDB(B1, 1, 1); PG8_SCHED; PG8_LDA(At, 1, 0); PG8_STAGE(PG8_SA(0, 1), a2 + hstep, voffA);
            PG8_WAIT_V(8); PG8_WAIT_L(0); PG8_BAR; PG8_MMA(0, 0, At, B0); PG8_MMA(0, 1, At, B1); PG8_BAR; PG8_SCHED;
            PG8_LDA(At, 1, 1); PG8_STAGE(PG8_SB(1, 0), b3, voffB); PG8_STAGE(PG8_SB(1, 1), b3 + hstep, voffB); PG8_STAGE(PG8_SA(1, 0), a3, voffA);
            PG8_WAIT_V(8); PG8_WAIT_L(0); PG8_BAR; PG8_MMA(1, 0, At, B0); PG8_MMA(1, 1, At, B1); PG8_BAR; PG8_SCHED;
            } else {
            PG8_LDB(B0, 0, 0); PG8_SCHED; PG8_LDA(At, 0, 0); PG8_STAGE(PG8_SA(1, 1), a1 + hstep, voffA);
            PG8_WAIT_L(8); PG8_BAR; PG8_WAIT_L(0); PG8_MMA(0, 0, At, B0); PG8_BAR; PG8_SCHED;
            PG8_LDB(B1, 0, 1); PG8_STAGE(PG8_SB(0, 0), b2, voffB);
            PG8_BAR; PG8_WAIT_L(0); PG8_MMA(0, 1, At, B1); PG8_BAR;
            PG8_LDA(At, 0, 1); PG8_STAGE(PG8_SA(0, 0), a2, voffA);
            PG8_BAR; PG8_WAIT_L(0); PG8_MMA(1, 0, At, B0); PG8_BAR; PG8_SCHED;
            PG8_STAGE(PG8_SB(0, 1), b2 + hstep, voffB);
            PG8_WAIT_V(6); PG8_BAR; PG8_MMA(1, 1, At, B1); PG8_BAR;
            PG8_LDB(B0, 1, 0); PG8_SCHED; PG8_LDA(At, 1, 0); PG8_STAGE(PG8_SA(0, 1), a2 + hstep, voffA);
            PG8_WAIT_L(8); PG8_BAR; PG8_WAIT_L(0); PG8_MMA(0, 0, At, B0); PG8_BAR; PG8_SCHED;
            PG8_LDB(B1, 1, 1); PG8_STAGE(PG8_SB(1, 0), b3, voffB);
            PG8_BAR; PG8_WAIT_L(0); PG8_MMA(0, 1, At, B1); PG8_BAR;
            PG8_LDA(At, 1, 1); PG8_STAGE(PG8_SA(1, 0), a3, voffA);
            PG8_BAR; PG8_WAIT_L(0); PG8_MMA(1, 0, At, B0); PG8_BAR; PG8_SCHED;
            PG8_STAGE(PG8_SB(1, 1), b3 + hstep, voffB);
            PG8_WAIT_V(6); PG8_BAR; PG8_MMA(1, 1, At, B1); PG8_BAR;
            }
        }
        if constexpr (ALIGN_EPI) { if (wr == 0) PG8_BAR; }
        if constexpr (!Epi::AFTER_DRAIN) { E(acc, cur, wr, wc, fr, fq); S.done(cur); }
        if (!has_next) break;
#pragma unroll
        for (int a = 0; a < 2; ++a)
#pragma unroll
            for (int b = 0; b < 2; ++b)
#pragma unroll
                for (int m = 0; m < 4; ++m)
#pragma unroll
                    for (int n = 0; n < 2; ++n) acc[a][b][m][n] = (f32x4){0.f, 0.f, 0.f, 0.f};
        cur = nxt; cA = nA; cB = nB; ++ui;
        if constexpr (ALIGN_EPI) { if (wr == 1) PG8_BAR; }
    }
    PG8_WAIT_V(0);
    if constexpr (!ALIGN_EPI) { if (wr == 0) PG8_BAR; }
    PG8_BAR;
    if constexpr (Epi::AFTER_DRAIN) { E.fused(acc, cur, wr, wc, fr, fq, lds, wid, lane); S.done(cur); }
#undef PG8_SA
#undef PG8_SB
#undef PG8_STAGE
#undef PG8_LDA
#undef PG8_LDB
#undef PG8_MMA
#undef PG8_WAIT_V
#undef PG8_WAIT_L
#undef PG8_BAR
#undef PG8_SCHED
}
}
__device__ __forceinline__ float row_rstd(const float* ssq, int row) {
    const f32x4* q = (const f32x4*)(ssq + (size_t)row * 16);
    const f32x4 a = q[0], b = q[1], c = q[2], d = q[3];
    return rsqrtf(((((a.x + a.y) + (a.z + a.w)) + ((b.x + b.y) + (b.z + b.w))) + (((c.x + c.y) + (c.z + c.w)) + ((d.x + d.y) + (d.z + d.w)))) * (1.f / DM) + EPS);
}
__device__ __forceinline__ void phase1_mfma(const Params& p, LAS unsigned char* lds) {
    pg8::Gemm g{(const pg8::bf16_t*)(p.ws + OFF_XN), (const pg8::bf16_t*)(p.ws + OFF_WIN), MROWS, NIN, DM};
    pg8::EpiP1 E{P1Ptrs{p.ws, p.in[10], p.in[12]}};
    const int vcu = vcu_of_block();
    pg8::P1Order S0{(int)gridDim.x, vcu, 10, MROWS / 256, false}, S1{(int)gridDim.x, vcu, 4, MROWS / 256, true};
    pg8::gemm_phase<pg8::EpiP1, pg8::P1Order, true, true, false>(lds, g, S0, E);
    pg8::gemm_phase<pg8::EpiP1, pg8::P1Order, true, true, true>(lds, g, S1, E);
}
__device__ __forceinline__ void phase3_mfma(const Params& p, LAS unsigned char* lds) {
    pg8::Gemm g{(const pg8::bf16_t*)(p.ws + OFF_MIX), (const pg8::bf16_t*)(p.ws + OFF_WOUT), NTOK, DM, DM};
    pg8::StaticOrder S; S.init(NTOK, DM, (int)gridDim.x, (int)blockIdx.x);
    pg8::EpiP3 E{p.in[0], p.out, (bf16_t*)(p.ws + OFF_H2B), (float*)(p.ws + OFF_SSQP)};
    pg8::gemm_phase<pg8::EpiP3, pg8::StaticOrder, true, true>(lds, g, S, E);
}

typedef float f32x16 __attribute__((ext_vector_type(16)));
constexpr int AT_KROW = 272, AT_VROW = 144, AT_KBYTES = 64 * AT_KROW, AT_VBYTES = 128 * AT_VROW, AT_STAGE = AT_KBYTES + AT_VBYTES;
__device__ __forceinline__ void attn_item(const Params& p, LAS unsigned char* lds, int item) {
    const int tid = threadIdx.x, lane = tid & 63, wave = __builtin_amdgcn_readfirstlane(tid >> 6), qg = wave >> 1, c = wave & 1, l31 = lane & 31, hh = lane >> 5;
    const int qt = item & 15, h = (item >> 4) & 3, b = item >> 6;
    const int r0 = b * SEQ + qt * 128;
    const bf16_t* QB = (const bf16_t*)(p.ws + OFF_QB); const bf16_t* KB = (const bf16_t*)(p.ws + OFF_KB); const bf16_t* VT = (const bf16_t*)(p.ws + OFF_VT);
    bf16x8 qf[4];
    {
        const bf16_t* qp = QB + (size_t)(r0 + qg * 32 + l31) * 512 + h * 128 + c * 64 + 8 * hh;
#pragma unroll
        for (int s = 0; s < 4; ++s) qf[s] = *(const bf16x8*)(qp + 16 * s);
    }
    f32x16 O[4];
#pragma unroll
    for (int i = 0; i < 4; ++i)
#pragma unroll
        for (int r = 0; r < 16; ++r) O[i][r] = 0.f;
    float m = 0.f, l = 0.f;
    const int kq0 = tid, kq1 = tid + 512;
    const bf16_t* kg0 = KB + (size_t)(kq0 >> 4) * 512 + h * 128 + (kq0 & 15) * 8; const bf16_t* kg1 = KB + (size_t)(kq1 >> 4) * 512 + h * 128 + (kq1 & 15) * 8;
    const bf16_t* vg0 = VT + (size_t)(h * 128 + (kq0 >> 3)) * MROWS + (kq0 & 7) * 8; const bf16_t* vg1 = VT + (size_t)(h * 128 + (kq1 >> 3)) * MROWS + (kq1 & 7) * 8;
    const int kl0 = (kq0 >> 4) * AT_KROW + (kq0 & 15) * 16, kl1 = (kq1 >> 4) * AT_KROW + (kq1 & 15) * 16;
    const int vl0 = AT_KBYTES + (kq0 >> 3) * AT_VROW + ((kq0 & 7) >> 1) * 32 + (kq0 & 1) * 8, vl1 = AT_KBYTES + (kq1 >> 3) * AT_VROW + ((kq1 & 7) >> 1) * 32 + (kq1 & 1) * 8;
    u32x4 kr0, kr1, vr0, vr1;
#define AT_LOAD(t) do { const size_t kro = (size_t)((t) < 32 ? b * SEQ + (t) * 64 : NTOK); \
        kr0 = *(const u32x4*)(kg0 + kro * 512); kr1 = *(const u32x4*)(kg1 + kro * 512); vr0 = *(const u32x4*)(vg0 + kro); vr1 = *(const u32x4*)(vg1 + kro); } while (0)
#define AT_WRITE(buf) do { LAS unsigned char* _b = lds + (buf) * AT_STAGE; \
        *(LAS u32x4*)(_b + kl0) = kr0; *(LAS u32x4*)(_b + kl1) = kr1; \
        *(LAS u32x2*)(_b + vl0) = (u32x2){vr0.x, vr0.y}; *(LAS u32x2*)(_b + vl0 + 16) = (u32x2){vr0.z, vr0.w}; \
        *(LAS u32x2*)(_b + vl1) = (u32x2){vr1.x, vr1.y}; *(LAS u32x2*)(_b + vl1 + 16) = (u32x2){vr1.z, vr1.w}; } while (0)
    __syncthreads();
    AT_LOAD(0); AT_WRITE(0);
    __syncthreads();
    for (int t = 0; t < 33; ++t) {
        if (t + 1 < 33) AT_LOAD(t + 1);
        const LAS unsigned char* kb_ = lds + (t & 1) * AT_STAGE; const LAS unsigned char* vb_ = kb_ + AT_KBYTES;
        f32x16 s0, s1;
#pragma unroll
        for (int r = 0; r < 16; ++r) { s0[r] = -m; s1[r] = -m; }
#pragma unroll
        for (int s = 0; s < 4; ++s) {
            const bf16x8 k0 = *(const LAS bf16x8*)(kb_ + l31 * AT_KROW + (c * 64 + 16 * s + 8 * hh) * 2);
            s0 = __builtin_amdgcn_mfma_f32_32x32x16_bf16(k0, qf[s], s0, 0, 0, 0);
        }
#pragma unroll
        for (int s = 0; s < 4; ++s) {
            const bf16x8 k1 = *(const LAS bf16x8*)(kb_ + (32 + l31) * AT_KROW + (c * 64 + 16 * s + 8 * hh) * 2);
            s1 = __builtin_amdgcn_mfma_f32_32x32x16_bf16(k1, qf[s], s1, 0, 0, 0);
        }
        if (t == 32) {
#pragma unroll
            for (int r = 0; r < 16; ++r) { const int key = (r & 3) + 8 * (r >> 2) + 4 * hh; if (key >= 16) s0[r] = -1e30f; s1[r] = -1e30f; }
        }
        float mx = s0[0];
#pragma unroll
        for (int r = 1; r < 16; ++r) mx = fmaxf(mx, s0[r]);
#pragma unroll
        for (int r = 0; r < 16; ++r) mx = fmaxf(mx, s1[r]);
        mx = fmaxf(mx, __shfl_xor(mx, 32));
        if (t == 0 || __any(mx > 8.0f)) {
            const float d = t == 0 ? mx : fmaxf(mx, 0.f), alpha = __builtin_amdgcn_exp2f(-d);
            m += d; l *= alpha;
#pragma unroll
            for (int i = 0; i < 4; ++i) O[i] = O[i] * alpha;
#pragma unroll
            for (int r = 0; r < 16; ++r) { s0[r] -= d; s1[r] -= d; }
        }
        float ps = 0.f;
#define AT_PV(SREG, kb) do { \
        _Pragma("unroll") for (int r = 0; r < 16; ++r) { SREG[r] = __builtin_amdgcn_exp2f(SREG[r]); ps += SREG[r]; } \
        bf16x8 pf0, pf1; \
        { u32x4 a; a.x = pk2(SREG[0], SREG[1]); a.y = pk2(SREG[2], SREG[3]); a.z = pk2(SREG[4], SREG[5]); a.w = pk2(SREG[6], SREG[7]); pf0 = __builtin_bit_cast(bf16x8, a); \
          u32x4 bq; bq.x = pk2(SREG[8], SREG[9]); bq.y = pk2(SREG[10], SREG[11]); bq.z = pk2(SREG[12], SREG[13]); bq.w = pk2(SREG[14], SREG[15]); pf1 = __builtin_bit_cast(bf16x8, bq); } \
        _Pragma("unroll") for (int vb = 0; vb < 4; ++vb) { \
            const LAS unsigned char* vp = vb_ + (vb * 32 + l31) * AT_VROW + (kb) * 64 + hh * 16; \
            O[vb] = __builtin_amdgcn_mfma_f32_32x32x16_bf16(*(const LAS bf16x8*)vp, pf0, O[vb], 0, 0, 0); \
            O[vb] = __builtin_amdgcn_mfma_f32_32x32x16_bf16(*(const LAS bf16x8*)(vp + 32), pf1, O[vb], 0, 0, 0); } } while (0)
        AT_PV(s0, 0);
        AT_PV(s1, 1);
#undef AT_PV
        l += ps;
        if (t + 1 < 33) AT_WRITE((t + 1) & 1);
        __syncthreads();
    }
    const float inv = 1.f / (l + __shfl_xor(l, 32));
    LAS float* X = (LAS float*)lds + qg * 4096;
    if (c == 1) {
#pragma unroll
        for (int vb = 0; vb < 4; ++vb)
#pragma unroll
            for (int r = 0; r < 16; ++r) X[(vb * 16 + r) * 64 + lane] = O[vb][r] * inv;
    }
    __syncthreads();
    if (c == 0) {
        const float lam = ((const float*)(p.ws + OFF_MISC))[0];
        float ss = 0.f;
#pragma unroll
        for (int vb = 0; vb < 4; ++vb)
#pragma unroll
            for (int r = 0; r < 16; ++r) { const float y = O[vb][r] * inv - lam * X[(vb * 16 + r) * 64 + lane]; O[vb][r] = y; ss += y * y; }
        ss += __shfl_xor(ss, 32);
        const float rs = rsqrtf(ss * (1.f / 128.f) + EPS) * 0.8f;
        bf16_t* orow = (bf16_t*)(p.ws + OFF_MIX) + (size_t)(r0 + qg * 32 + l31) * DM + h * 128;
#pragma unroll
        for (int vb = 0; vb < 4; ++vb)
#pragma unroll
            for (int rq = 0; rq < 4; ++rq) {
                const int v0 = vb * 32 + 8 * rq + 4 * hh;
                const f32x4 wlo = *(const f32x4*)(p.in[8] + vb * 32 + 8 * rq), whi = *(const f32x4*)(p.in[8] + vb * 32 + 8 * rq + 4);
                const f32x4 w = hh ? whi : wlo;
                u32x2 o; o.x = pk2(O[vb][4 * rq] * rs * w.x, O[vb][4 * rq + 1] * rs * w.y); o.y = pk2(O[vb][4 * rq + 2] * rs * w.z, O[vb][4 * rq + 3] * rs * w.w);
                *(u32x2*)(orow + v0) = o;
            }
    }
#undef AT_LOAD
#undef AT_WRITE
}
__device__ __forceinline__ void phase2_attn_mfma(const Params& p, LAS unsigned char* lds) {
    for (int it = vcu_of_block(); it < NB * 4 * 16; it += gridDim.x) attn_item(p, lds, it);
}


__device__ __forceinline__ int gsw(int row, int chunk) { return row * 128 + ((chunk ^ (row & 7)) << 4); }
constexpr int GL_SET = 40960;
constexpr int GL_QS = 0, GL_KS = 8192, GL_KT = 16384, GL_VT = 24576, GL_AT = 2 * GL_SET, GL_ST = GL_AT + 8192  , GL_DV = GL_ST + 32768  ;
__device__ __forceinline__ float dpp_scan64(float v) {
    v += __builtin_bit_cast(float, __builtin_amdgcn_update_dpp(0, __builtin_bit_cast(int, v), 0x111, 0xf, 0xf, false));
    v += __builtin_bit_cast(float, __builtin_amdgcn_update_dpp(0, __builtin_bit_cast(int, v), 0x112, 0xf, 0xf, false));
    v += __builtin_bit_cast(float, __builtin_amdgcn_update_dpp(0, __builtin_bit_cast(int, v), 0x114, 0xf, 0xf, false));
    v += __builtin_bit_cast(float, __builtin_amdgcn_update_dpp(0, __builtin_bit_cast(int, v), 0x118, 0xf, 0xf, false));
    v += __builtin_bit_cast(float, __builtin_amdgcn_update_dpp(0, __builtin_bit_cast(int, v), 0x142, 0xa, 0xf, false));
    v += __builtin_bit_cast(float, __builtin_amdgcn_update_dpp(0, __builtin_bit_cast(int, v), 0x143, 0xc, 0xf, false));
    return v;
}
struct GlaPre { f32x4 g0, g1; u32x4 q8, k8, v0, v1; };
struct GlaCtx { const bf16_t* GQ; const bf16_t* GK; const bf16_t* GVT; const float* G; bf16_t* O; int dir, h, b, nsteps, lane, wave, l15, g, vdv, vch; };
__device__ __forceinline__ int gla_rowbase(const GlaCtx& c, int st) { return c.dir ? c.b * SEQ + (31 - st) * 64 : (st == 0 ? NTOK : c.b * SEQ + (st - 1) * 64); }
__device__ __forceinline__ void gla_load(const GlaCtx& c, GlaPre& r, int st) {
    const int rb = gla_rowbase(c, st); const size_t row = (size_t)(rb + c.lane);
    r.g0 = *(const f32x4*)(c.G + row * 256 + c.h * 64 + 8 * c.wave); r.g1 = *(const f32x4*)(c.G + row * 256 + c.h * 64 + 8 * c.wave + 4);
    r.q8 = *(const u32x4*)(c.GQ + row * 256 + c.h * 64 + 8 * c.wave); r.k8 = *(const u32x4*)(c.GK + row * 256 + c.h * 64 + 8 * c.wave);
    r.v0 = *(const u32x4*)(c.GVT + (size_t)(c.h * 128 + c.vdv) * MROWS + rb + c.vch * 8); r.v1 = *(const u32x4*)(c.GVT + (size_t)(c.h * 128 + c.vdv) * MROWS + rb + c.vch * 8 + 8);
}
__device__ __forceinline__ void gla_step(const GlaCtx& c, LAS unsigned char* lds, GlaPre& r, f32x4 (&accS)[4], int st) {
    const int lane = c.lane, wave = c.wave, l15 = c.l15, g = c.g, dir = c.dir;
    const bool meta = (dir == 0 && st == 0);
    const int rowbase = gla_rowbase(c, st);
    LAS unsigned char* sb = lds + (st & 1) * GL_SET;
    float gg[8] = {r.g0.x, r.g0.y, r.g0.z, r.g0.w, r.g1.x, r.g1.y, r.g1.z, r.g1.w};
    if (meta && lane >= NMETA) {
#pragma unroll
        for (int e = 0; e < 8; ++e) gg[e] = 0.f;
    }
    const u32x4 q8 = r.q8, k8 = r.k8;
    float qv[8] = {bflo(q8.x), bfhi(q8.x), bflo(q8.y), bfhi(q8.y), bflo(q8.z), bfhi(q8.z), bflo(q8.w), bfhi(q8.w)};
    float kv[8] = {bflo(k8.x), bfhi(k8.x), bflo(k8.y), bfhi(k8.y), bflo(k8.z), bfhi(k8.z), bflo(k8.w), bfhi(k8.w)};
    float qn[8], kn[8], ks[8];
#pragma unroll
    for (int e = 0; e < 8; ++e) {
        const float P = dpp_scan64(gg[e]);
        const float T = __builtin_bit_cast(float, __builtin_amdgcn_readlane(__builtin_bit_cast(int, P), 63));
        const float Bv = dir ? (T - P + gg[e]) : P;
        const float eb = __expf(Bv), en = __builtin_amdgcn_rcpf(eb), eT = __expf(T);
        qn[e] = qv[e] * eb; kn[e] = kv[e] * en; ks[e] = kn[e] * eT;
        if (lane == 0) *(LAS float*)(lds + GL_DV + (st & 1) * 256 + (8 * wave + e) * 4) = eT;
    }
    *(LAS u32x4*)(sb + GL_QS + gsw(lane, wave)) = (u32x4){pk2(qn[0], qn[1]), pk2(qn[2], qn[3]), pk2(qn[4], qn[5]), pk2(qn[6], qn[7])};
    *(LAS u32x4*)(sb + GL_KS + gsw(lane, wave)) = (u32x4){pk2(kn[0], kn[1]), pk2(kn[2], kn[3]), pk2(kn[4], kn[5]), pk2(kn[6], kn[7])};
#pragma unroll
    for (int e = 0; e < 8; e += 2) { const unsigned w = pk2(ks[e], ks[e + 1]);
        *(LAS unsigned short*)(sb + GL_KT + gsw(8 * wave + e, lane >> 3) + (lane & 7) * 2) = (unsigned short)w;
        *(LAS unsigned short*)(sb + GL_KT + gsw(8 * wave + e + 1, lane >> 3) + (lane & 7) * 2) = (unsigned short)(w >> 16); }
    *(LAS u32x4*)(sb + GL_VT + gsw(c.vdv, c.vch)) = r.v0; *(LAS u32x4*)(sb + GL_VT + gsw(c.vdv, c.vch + 1)) = r.v1;
    if (st + 2 < c.nsteps) gla_load(c, r, st + 2);
    __syncthreads();
    const LAS unsigned char* STo = lds + GL_ST + (st & 1) * 16384; LAS unsigned char* STn = lds + GL_ST + ((st + 1) & 1) * 16384;
    if (!meta) {
        const int jb = wave >> 1;
#pragma unroll
        for (int ii = 0; ii < 2; ++ii) {
            const int ib = 2 * (wave & 1) + ii;
            f32x4 a = (f32x4){0.f, 0.f, 0.f, 0.f};
            const bool live = dir ? (jb >= ib) : (jb <= ib);
            if (live) {
#pragma unroll
                for (int ks2 = 0; ks2 < 2; ++ks2) {
                    const bf16x8 kf = *(const LAS bf16x8*)(sb + GL_KS + gsw(jb * 16 + l15, ks2 * 4 + g));
                    const bf16x8 qf = *(const LAS bf16x8*)(sb + GL_QS + gsw(ib * 16 + l15, ks2 * 4 + g));
                    a = __builtin_amdgcn_mfma_f32_16x16x32_bf16(kf, qf, a, 0, 0, 0);
                }
                const int i = ib * 16 + l15, j0 = jb * 16 + 4 * g;
#pragma unroll
                for (int rr = 0; rr < 4; ++rr) { const bool keep = dir ? (j0 + rr >= i) : (j0 + rr <= i); a[rr] = keep ? a[rr] : 0.f; }
            }
            const int i = ib * 16 + l15, j0 = jb * 16 + 4 * g;
            *(LAS u32x2*)(lds + GL_AT + gsw(i, j0 >> 3) + (j0 & 7) * 2) = (u32x2){pk2(a[0], a[1]), pk2(a[2], a[3])};
        }
    }
    if (st + 1 < c.nsteps) {
#pragma unroll
        for (int kb = 0; kb < 4; ++kb) {
            const f32x4 dvv = *(const LAS f32x4*)(lds + GL_DV + (st & 1) * 256 + (kb * 16 + 4 * g) * 4);
            f32x4 a = accS[kb] * dvv;
#pragma unroll
            for (int ks2 = 0; ks2 < 2; ++ks2) {
                const bf16x8 kf = *(const LAS bf16x8*)(sb + GL_KT + gsw(kb * 16 + l15, ks2 * 4 + g));
                const bf16x8 vf = *(const LAS bf16x8*)(sb + GL_VT + gsw(wave * 16 + l15, ks2 * 4 + g));
                a = __builtin_amdgcn_mfma_f32_16x16x32_bf16(kf, vf, a, 0, 0, 0);
            }
            accS[kb] = a;
            const int dk0 = kb * 16 + 4 * g;
            *(LAS u32x2*)(STn + gsw(wave * 16 + l15, dk0 >> 3) + (dk0 & 7) * 2) = (u32x2){pk2(a[0], a[1]), pk2(a[2], a[3])};
        }
    }
    __syncthreads();
    if (!meta) {
#pragma unroll
        for (int ib = 0; ib < 4; ++ib) {
            f32x4 a = (f32x4){0.f, 0.f, 0.f, 0.f};
#pragma unroll
            for (int ks2 = 0; ks2 < 2; ++ks2) {
                const bf16x8 vf = *(const LAS bf16x8*)(sb + GL_VT + gsw(wave * 16 + l15, ks2 * 4 + g));
                const bf16x8 af = *(const LAS bf16x8*)(lds + GL_AT + gsw(ib * 16 + l15, ks2 * 4 + g));
                a = __builtin_amdgcn_mfma_f32_16x16x32_bf16(vf, af, a, 0, 0, 0);
                const bf16x8 sf = *(const LAS bf16x8*)(STo + gsw(wave * 16 + l15, ks2 * 4 + g));
                const bf16x8 qf = *(const LAS bf16x8*)(sb + GL_QS + gsw(ib * 16 + l15, ks2 * 4 + g));
                a = __builtin_amdgcn_mfma_f32_16x16x32_bf16(sf, qf, a, 0, 0, 0);
            }
            *(u32x2*)(c.O + (size_t)(rowbase + ib * 16 + l15) * 512 + c.h * 128 + wave * 16 + 4 * g) = (u32x2){pk2(a[0], a[1]), pk2(a[2], a[3])};
        }
    }
}
__device__ __forceinline__ void gla_chain(const Params& p, LAS unsigned char* lds, int item) {
    const int tid = threadIdx.x;
    GlaCtx c;
    c.lane = tid & 63; c.wave = __builtin_amdgcn_readfirstlane(tid >> 6); c.l15 = c.lane & 15; c.g = c.lane >> 4;
    c.dir = item & 1; c.h = (item >> 1) & 3; c.b = item >> 3;
    c.GQ = (const bf16_t*)(p.ws + OFF_GQ); c.GK = (const bf16_t*)(p.ws + OFF_GK); c.GVT = (const bf16_t*)(p.ws + OFF_GVT);
    c.G = (const float*)(p.ws + (c.dir ? OFF_GB : OFF_GF));
    c.O = (bf16_t*)p.out + (c.dir ? (size_t)NTOK * 512 : 0);
    c.nsteps = c.dir ? 32 : 33; c.vdv = tid >> 2; c.vch = (tid & 3) * 2;
    f32x4 accS[4];
#pragma unroll
    for (int i = 0; i < 4; ++i) accS[i] = (f32x4){0.f, 0.f, 0.f, 0.f};
    __syncthreads();
    *(LAS u32x4*)(lds + GL_ST + tid * 32) = (u32x4){0u, 0u, 0u, 0u}; *(LAS u32x4*)(lds + GL_ST + tid * 32 + 16) = (u32x4){0u, 0u, 0u, 0u};
    GlaPre X, Y;
    gla_load(c, X, 0); gla_load(c, Y, 1);
    for (int st = 0; st < c.nsteps; st += 2) {
        gla_step(c, lds, X, accS, st);
        if (st + 1 < c.nsteps) gla_step(c, lds, Y, accS, st + 1);
    }
    asm volatile("s_waitcnt vmcnt(0)" ::: "memory");
    __syncthreads();
    if (tid == 0) {
        __builtin_amdgcn_fence(__ATOMIC_RELEASE, "agent");
        asm volatile("s_waitcnt vmcnt(0)" ::: "memory");
        __hip_atomic_fetch_add((unsigned*)(p.ws + OFF_CTL) + 4096 + (item >> 1) * 64, 1u, __ATOMIC_RELAXED, __HIP_MEMORY_SCOPE_AGENT);
    }
}
__device__ __forceinline__ void gla_combine_item(const Params& p, LAS unsigned char* lds, int item) {
    const int tid = threadIdx.x, lane = tid & 63, wave = tid >> 6;
    const int bh = item >> 3, part = item & 7, b = bh >> 2, h = bh & 3;
    if (tid == 0) {
        unsigned* flag = (unsigned*)(p.ws + OFF_CTL) + 4096 + bh * 64;
        unsigned spins = 0;
        while (__hip_atomic_load(flag, __ATOMIC_RELAXED, __HIP_MEMORY_SCOPE_AGENT) < 2u) { __builtin_amdgcn_s_sleep(8); if (++spins > (1u << 22)) break; }
        __builtin_amdgcn_fence(__ATOMIC_ACQUIRE, "agent");
        asm volatile("s_waitcnt vmcnt(0)" ::: "memory");
    }
    __syncthreads();
    const bf16_t* GR = (const bf16_t*)(p.ws + OFF_GR); bf16_t* MIX = (bf16_t*)(p.ws + OFF_MIX);
    const bf16_t* OF = (const bf16_t*)p.out; const bf16_t* OBk = OF + (size_t)NTOK * 512;
    const int c0 = h * 128 + (lane & 15) * 8;
    const f32x4 w0 = *(const f32x4*)(p.in[13] + (lane & 15) * 8), w1 = *(const f32x4*)(p.in[13] + (lane & 15) * 8 + 4);
#pragma unroll 2
    for (int i = 0; i < 8; ++i) {
        const int r = b * SEQ + part * 256 + wave * 32 + i * 4 + (lane >> 4);
        const u32x4 a = *(const u32x4*)(OF + (size_t)r * 512 + c0), bq = *(const u32x4*)(OBk + (size_t)r * 512 + c0);
        const f32x4 x0 = (f32x4){bflo(a.x) + bflo(bq.x), bfhi(a.x) + bfhi(bq.x), bflo(a.y) + bflo(bq.y), bfhi(a.y) + bfhi(bq.y)};
        const f32x4 x1 = (f32x4){bflo(a.z) + bflo(bq.z), bfhi(a.z) + bfhi(bq.z), bflo(a.w) + bflo(bq.w), bfhi(a.w) + bfhi(bq.w)};
        float s = x0.x * x0.x + x0.y * x0.y + x0.z * x0.z + x0.w * x0.w + x1.x * x1.x + x1.y * x1.y + x1.z * x1.z + x1.w * x1.w;
        s += __shfl_xor(s, 1); s += __shfl_xor(s, 2); s += __shfl_xor(s, 4); s += __shfl_xor(s, 8);
        const float rs = rsqrtf(s * (1.f / 128.f) + EPS);
        const u32x4 g = *(const u32x4*)(GR + (size_t)r * 512 + c0);
        u32x4 o;
        o.x = pk2(x0.x * rs * w0.x * bflo(g.x), x0.y * rs * w0.y * bfhi(g.x)); o.y = pk2(x0.z * rs * w0.z * bflo(g.y), x0.w * rs * w0.w * bfhi(g.y));
        o.z = pk2(x1.x * rs * w1.x * bflo(g.z), x1.y * rs * w1.y * bfhi(g.z)); o.w = pk2(x1.z * rs * w1.z * bflo(g.w), x1.w * rs * w1.w * bfhi(g.w));
        *(u32x4*)(MIX + (size_t)r * DM + 512 + c0) = o;
    }
}

constexpr int LDS_Q = LDS_BYTES - 16;
__device__ __forceinline__ void phase2(const Params& p, LAS unsigned char* lds, int qslot = 0) {
    unsigned* ctr = (unsigned*)(p.ws + OFF_CTL) + (qslot >= 2 ? 2048 + qslot * 64 : qslot * 64);
    int it;
#define P2_NEXT() do { __syncthreads(); if (threadIdx.x == 0) *(LAS unsigned*)(lds + LDS_Q) = atomicAdd(ctr, 1u); __syncthreads(); it = (int)*(LAS unsigned*)(lds + LDS_Q); } while (0)
    P2_NEXT();
    if (qslot != 3) { while (it < 64) { gla_chain(p, lds, it); P2_NEXT(); } }
    if (qslot == 2) return;
    if (qslot == 3) it += 64;
    while (it < 64 + NB * 4 * 16) { attn_item(p, lds, it - 64); P2_NEXT(); if (qslot == 3) it += 64; }
    if (qslot) return;
    for (;;) {
        __syncthreads();
        if (threadIdx.x == 0) *(LAS unsigned*)(lds + LDS_Q) = atomicAdd(ctr + 192, 1u);
        __syncthreads();
        const int c = (int)*(LAS unsigned*)(lds + LDS_Q);
        if (c >= 256) break;
        gla_combine_item(p, lds, c);
    }
    for (;;) {
        __syncthreads();
        if (threadIdx.x == 0) *(LAS unsigned*)(lds + LDS_Q) = atomicAdd(ctr + 128, 1u);
        __syncthreads();
        const int c = (int)*(LAS unsigned*)(lds + LDS_Q);
        if (c >= CV_ITEMS) break;
        conv_item(p, (unsigned char*)lds, c);
    }
#undef P2_NEXT
}

__device__ __forceinline__ void phase2c(const Params& p) {
    const int tid = threadIdx.x, lane = tid & 63, wave = tid >> 6;
    const int gw = blockIdx.x * 8 + wave, NGW = gridDim.x * 8;
    const bf16_t* GR = (const bf16_t*)(p.ws + OFF_GR); bf16_t* MIX = (bf16_t*)(p.ws + OFF_MIX);
    const bf16_t* OF = (const bf16_t*)p.out; const bf16_t* OBk = OF + (size_t)NTOK * 512;
    const int c0 = lane * 8;
    const f32x4 w0 = *(const f32x4*)(p.in[13] + (c0 & 127)), w1 = *(const f32x4*)(p.in[13] + (c0 & 127) + 4);
    for (int r = gw; r < NTOK; r += NGW) {
        const u32x4 a = *(const u32x4*)(OF + (size_t)r * 512 + c0), bq = *(const u32x4*)(OBk + (size_t)r * 512 + c0);
        const f32x4 x0 = (f32x4){bflo(a.x) + bflo(bq.x), bfhi(a.x) + bfhi(bq.x), bflo(a.y) + bflo(bq.y), bfhi(a.y) + bfhi(bq.y)};
        const f32x4 x1 = (f32x4){bflo(a.z) + bflo(bq.z), bfhi(a.z) + bfhi(bq.z), bflo(a.w) + bflo(bq.w), bfhi(a.w) + bfhi(bq.w)};
        float s = x0.x * x0.x + x0.y * x0.y + x0.z * x0.z + x0.w * x0.w + x1.x * x1.x + x1.y * x1.y + x1.z * x1.z + x1.w * x1.w;
        s += __shfl_xor(s, 1); s += __shfl_xor(s, 2); s += __shfl_xor(s, 4); s += __shfl_xor(s, 8);
        const float rs = rsqrtf(s * (1.f / 128.f) + EPS);
        const u32x4 g = *(const u32x4*)(GR + (size_t)r * 512 + c0);
        u32x4 o;
        o.x = pk2(x0.x * rs * w0.x * bflo(g.x), x0.y * rs * w0.y * bfhi(g.x)); o.y = pk2(x0.z * rs * w0.z * bflo(g.y), x0.w * rs * w0.w * bfhi(g.y));
        o.z = pk2(x1.x * rs * w1.x * bflo(g.z), x1.y * rs * w1.y * bfhi(g.z)); o.w = pk2(x1.z * rs * w1.z * bflo(g.w), x1.w * rs * w1.w * bfhi(g.w));
        *(u32x4*)(MIX + (size_t)r * DM + 512 + c0) = o;
    }
}


#define TOPK_INS(L, x) do { float _x = (x); _Pragma("unroll") for (int _s = 0; _s < 16; ++_s) { const float _t = fmaxf(L[_s], _x); _x = fminf(L[_s], _x); L[_s] = _t; } } while (0)
constexpr int P4_QROW = 528, P4_SC0 = 128 * P4_QROW  , P4_TLROW = 144;

#define CE_DESC(a, b) do { const float _hi = fmaxf(a, b), _lo = fminf(a, b); a = _hi; b = _lo; } while (0)
__device__ __forceinline__ void bitonic_sort16_desc(float (&x)[16]) {
#pragma unroll
    for (int k = 2; k <= 16; k <<= 1)
#pragma unroll
        for (int j = k >> 1; j > 0; j >>= 1)
#pragma unroll
            for (int i = 0; i < 16; ++i) { const int l = i ^ j; if (l > i) { if ((i & k) == 0) CE_DESC(x[i], x[l]); else CE_DESC(x[l], x[i]); } }
}
__device__ __forceinline__ void bitonic_merge16_desc(float (&x)[16]) {
#pragma unroll
    for (int j = 8; j > 0; j >>= 1)
#pragma unroll
        for (int i = 0; i < 16; ++i) { const int l = i ^ j; if (l > i) CE_DESC(x[i], x[l]); }
}
__device__ __forceinline__ void top16_merge(float (&L)[16], const float (&x)[16]) {
#pragma unroll
    for (int i = 0; i < 16; ++i) L[i] = fmaxf(L[i], x[15 - i]);
    bitonic_merge16_desc(L);
}

template <int Q> struct CandIJ {
    static constexpr int compute() { int c = 0; for (int i = 0; i < 16; ++i) for (int j = 0; j < 16; ++j) if ((i + 1) * (j + 1) <= 16) { if (c == Q) return i * 16 + j; ++c; } return -1; }
    static constexpr int v = compute();
};
template <int G, int S> __device__ __forceinline__ void cand_fill(float (&x)[16], const float (&A)[16], const float (&Bv)[16]) {
    constexpr int ij = CandIJ<G * 16 + S>::v;
    if constexpr (ij >= 0) x[S] = __uint_as_float((__float_as_uint(A[ij >> 4] + Bv[ij & 15]) & ~255u) | (unsigned)ij); else x[S] = -3.0e38f;
    if constexpr (S + 1 < 16) cand_fill<G, S + 1>(x, A, Bv);
}
__device__ __forceinline__ void p4_route_half(const Params& p, LAS unsigned char* lds, int m0, int h) {
    int tid_ = threadIdx.x; asm volatile("" : "+v"(tid_));
    const int tid = tid_, lane = tid & 63, wave = __builtin_amdgcn_readfirstlane(tid >> 6), l15 = lane & 15, g = lane >> 4;
    const bf16_t* KEYS = (const bf16_t*)(p.ws + OFF_KEYS); unsigned* PW0 = (unsigned*)(p.ws + OFF_PW0);
        {
            const int wr = wave >> 1, wk = wave & 1;
            f32x4 sc[2][2][4];
#pragma unroll
            for (int pp = 0; pp < 2; ++pp) {
#pragma unroll
                for (int rb = 0; rb < 2; ++rb)
#pragma unroll
                    for (int kk = 0; kk < 4; ++kk) sc[pp][rb][kk] = (f32x4){0.f, 0.f, 0.f, 0.f};
                const bf16_t* kbase = KEYS + (size_t)((h * 2 + pp) * 128 + 64 * wk + l15) * 128 + 8 * g;
#pragma unroll
                for (int ks = 0; ks < 4; ++ks) {
                    bf16x8 qf[2], kf[4];
#pragma unroll
                    for (int rb = 0; rb < 2; ++rb) qf[rb] = *(const LAS bf16x8*)(lds + (32 * wr + 16 * rb + l15) * P4_QROW + (pp * 128 + ks * 32 + 8 * g) * 2);
#pragma unroll
                    for (int kk = 0; kk < 4; ++kk) kf[kk] = *(const bf16x8*)(kbase + (size_t)(16 * kk) * 128 + ks * 32);
#pragma unroll
                    for (int rb = 0; rb < 2; ++rb)
#pragma unroll
                        for (int kk = 0; kk < 4; ++kk) sc[pp][rb][kk] = __builtin_amdgcn_mfma_f32_16x16x32_bf16(kf[kk], qf[rb], sc[pp][rb][kk], 0, 0, 0);
                }
            }
#pragma unroll
            for (int rb = 0; rb < 2; ++rb)
#pragma unroll
                for (int kk = 0; kk < 4; ++kk) *(LAS f32x4*)(lds + P4_SC0 + (32 * wr + 16 * rb + l15) * P4_QROW + (64 * wk + 16 * kk + 4 * g) * 4) = sc[0][rb][kk];
            __syncthreads();
#pragma unroll
            for (int rb = 0; rb < 2; ++rb)
#pragma unroll
                for (int kk = 0; kk < 4; ++kk) *(LAS f32x4*)(lds + (32 * wr + 16 * rb + l15) * P4_QROW + (64 * wk + 16 * kk + 4 * g) * 4) = sc[1][rb][kk];
        }
        __syncthreads();
        {
            const int hf = tid & 1, row = (tid >> 1) & 127, pp = tid >> 8;
            const LAS unsigned char* sp = lds + (pp ? 0 : P4_SC0) + row * P4_QROW + hf * 256;
            float L[16];
#pragma unroll
            for (int grp = 0; grp < 4; ++grp) {
                float x[16];
#pragma unroll
                for (int q4 = 0; q4 < 4; ++q4) {
                    const f32x4 v = *(const LAS f32x4*)(sp + (grp * 4 + q4) * 16);
                    const unsigned kb = (unsigned)(hf * 64 + grp * 16 + q4 * 4);
                    x[4 * q4 + 0] = __uint_as_float((__float_as_uint(v.x) & ~127u) | kb);
                    x[4 * q4 + 1] = __uint_as_float((__float_as_uint(v.y) & ~127u) | (kb + 1));
                    x[4 * q4 + 2] = __uint_as_float((__float_as_uint(v.z) & ~127u) | (kb + 2));
                    x[4 * q4 + 3] = __uint_as_float((__float_as_uint(v.w) & ~127u) | (kb + 3));
                }
                bitonic_sort16_desc(x);
                if (grp == 0) {
#pragma unroll
                    for (int s = 0; s < 16; ++s) L[s] = x[s];
                } else top16_merge(L, x);
            }
            {
                float Oth[16];
#pragma unroll
                for (int s = 0; s < 16; ++s) Oth[s] = __shfl_xor(L[s], 1);
                top16_merge(L, Oth);
            }
            __syncthreads();
            if (hf == 0) {
                LAS f32x4* tl = (LAS f32x4*)(lds + P4_SC0 + row * (2 * P4_TLROW) + pp * P4_TLROW);
                tl[0] = (f32x4){L[0], L[1], L[2], L[3]}; tl[1] = (f32x4){L[4], L[5], L[6], L[7]}; tl[2] = (f32x4){L[8], L[9], L[10], L[11]}; tl[3] = (f32x4){L[12], L[13], L[14], L[15]};
            }
        }
        __syncthreads();
        if (tid < 128) {
            const LAS unsigned char* tl = lds + P4_SC0 + tid * (2 * P4_TLROW);
            float A[16], Bv[16];
#pragma unroll
            for (int q4 = 0; q4 < 4; ++q4) { const f32x4 a = *(const LAS f32x4*)(tl + q4 * 16), b = *(const LAS f32x4*)(tl + P4_TLROW + q4 * 16);
                A[4 * q4] = a.x; A[4 * q4 + 1] = a.y; A[4 * q4 + 2] = a.z; A[4 * q4 + 3] = a.w; Bv[4 * q4] = b.x; Bv[4 * q4 + 1] = b.y; Bv[4 * q4 + 2] = b.z; Bv[4 * q4 + 3] = b.w; }
#pragma unroll
            for (int s = 0; s < 16; ++s) { A[s] = __uint_as_float(__float_as_uint(A[s]) & ~127u); Bv[s] = __uint_as_float(__float_as_uint(Bv[s]) & ~127u); }
            float L[16];
            {
                float x[16];
                cand_fill<0, 0>(x, A, Bv); bitonic_sort16_desc(x);
#pragma unroll
                for (int s = 0; s < 16; ++s) L[s] = x[s];
                cand_fill<1, 0>(x, A, Bv); bitonic_sort16_desc(x); top16_merge(L, x);
                cand_fill<2, 0>(x, A, Bv); bitonic_sort16_desc(x); top16_merge(L, x);
                cand_fill<3, 0>(x, A, Bv); bitonic_sort16_desc(x); top16_merge(L, x);
            }
            const float v0 = __uint_as_float(__float_as_uint(L[0]) & ~255u);
            float e[16], den = 0.f; int id[16];
#pragma unroll
            for (int s = 0; s < 16; ++s) {
                const unsigned u = __float_as_uint(L[s]);
                e[s] = __expf(__uint_as_float(u & ~255u) - v0); den += e[s];
                const unsigned i = (u >> 4) & 15u, j = u & 15u;
                const unsigned ka = *(const LAS unsigned*)(tl + i * 4) & 127u, kb = *(const LAS unsigned*)(tl + P4_TLROW + j * 4) & 127u;
                id[s] = (int)(ka * 128u + kb);
            }
            const float inv = 1.f / den;
            unsigned* ip = PW0 + (size_t)(m0 + tid) * 128 + h * 16;
#pragma unroll
            for (int q4 = 0; q4 < 4; ++q4) { u32x4 o;
#pragma unroll
                for (int c = 0; c < 4; ++c) o[c] = (unsigned)id[4 * q4 + c] | (f2bf(e[4 * q4 + c] * inv) << 16);
                *(u32x4*)(ip + 4 * q4) = o; }
        }
        __syncthreads();
}

namespace pg8 {
struct EpiP4 {
    static constexpr bool PERM = true, AFTER_DRAIN = true, SWAPPABLE = false;
    const Params* pp; const float* ssq;
    __device__ __forceinline__ void operator()(const f32x4 (&)[2][2][4][2], const Unit&, int, int, int, int) const {}
    __device__ __forceinline__ void fused(f32x4 (&acc)[2][2][4][2], const Unit& u, int wr, int wc, int fr, int fq, PG8_LAS unsigned char* lds, int wid, int lane) const {
#pragma unroll
        for (int ai = 0; ai < 2; ++ai) {
            const int m0 = u.pm * BM + ai * HALF;
#pragma unroll
            for (int m = 0; m < 4; ++m) {
                const int rl = wr * 64 + m * 16 + fr;
                const float rstd = row_rstd(ssq, m0 + rl);
#pragma unroll
                for (int bj = 0; bj < 2; ++bj) { const f32x4 v0 = acc[ai][bj][m][0] * rstd, v1 = acc[ai][bj][m][1] * rstd;
                    *(PG8_LAS u32x4*)(lds + rl * P4_QROW + (bj * HALF + wc * 32 + 8 * fq) * 2) = (u32x4){pk2(v0.x, v0.y), pk2(v0.z, v0.w), pk2(v1.x, v1.y), pk2(v1.z, v1.w)}; }
            }
            __syncthreads();
            p4_route_half(*pp, lds, m0, u.pn);
        }
    }
};
}
__device__ __forceinline__ void phase4_mfma(const Params& p, LAS unsigned char* lds) {
    pg8::Gemm g{(const pg8::bf16_t*)(p.ws + OFF_H2B), (const pg8::bf16_t*)(p.ws + OFF_WQ), NTOK, 2048, DM};
    pg8::EpiP4 E{&p, (const float*)(p.ws + OFF_SSQP)};
    const int vcu = vcu_of_block();
    for (int r = 0; r * (int)gridDim.x < 512; ++r) {
        const int L = r * (int)gridDim.x + vcu;
        pg8::OneUnit S; S.u.pm = L >> 3; S.u.pn = L & 7; S.valid = L < 512;
        pg8::gemm_phase<pg8::EpiP4, pg8::OneUnit, false, true>(lds, g, S, E);
        __syncthreads();
    }
}


constexpr size_t OFF_PW = 73 * MiB;
constexpr size_t OFF_OUTS = 179 * MiB;
static_assert(OFF_OUTS >= OFF_PW0 + (size_t)NTOK * 128 * 4 && OFF_OUTS + (size_t)NTOK * DM * 4 <= 256 * MiB, "P5 map");
__device__ __forceinline__ float dot_fp8_bf16(u32x4 uq, u32x4 h0, u32x4 h1, float c) {
#define DQ2(word, hsel, hw) c = dot2(__builtin_bit_cast(unsigned, __builtin_amdgcn_cvt_scalef32_pk_bf16_fp8((int)(word), 1.0f, hsel)), hw, c)
    DQ2(uq.x, false, h0.x); DQ2(uq.x, true, h0.y); DQ2(uq.y, false, h0.z); DQ2(uq.y, true, h0.w);
    DQ2(uq.z, false, h1.x); DQ2(uq.z, true, h1.y); DQ2(uq.w, false, h1.z); DQ2(uq.w, true, h1.w);
#undef DQ2
    return c;
}
constexpr int P5A_RS = 1040, P5A_LIST = 16640, P5A_RES = 18688, P5A_TSC = 18752, P5A_WAVE = 19456;
constexpr size_t OFF_HQ = 146 * MiB;
constexpr size_t OFF_HSC = 192 * 1024;
static_assert(8 * P5A_WAVE <= LDS_BYTES - 32, "P5a LDS");
static_assert(OFF_HQ >= OFF_H2B + (size_t)NTOK * DM * 2 && OFF_HQ + (size_t)NTOK * DM <= OFF_PW0, "HQ map");
__device__ __forceinline__ void quantize_hn(const Params& p) {
    const int tid = threadIdx.x, lane = tid & 63, wave = tid >> 6;
    const bf16_t* H2B = (const bf16_t*)(p.ws + OFF_H2B); unsigned char* HQ = p.ws + OFF_HQ; float* HSC = (float*)(p.ws + OFF_HSC);
    for (int t = blockIdx.x * 8 + wave; t < NTOK; t += gridDim.x * 8) {
        const u32x4 h0 = *(const u32x4*)(H2B + (size_t)t * DM + 16 * lane), h1 = *(const u32x4*)(H2B + (size_t)t * DM + 16 * lane + 8);
        float m = 0.f;
#pragma unroll
        for (int c = 0; c < 4; ++c) { m = fmaxf(m, fmaxf(fabsf(bflo(h0[c])), fabsf(bfhi(h0[c])))); m = fmaxf(m, fmaxf(fabsf(bflo(h1[c])), fabsf(bfhi(h1[c])))); }
        const float am = fmaxf(wave_max(m), 1e-30f), qs = 224.f / am;
        u32x4 o;
#pragma unroll
        for (int c = 0; c < 2; ++c) {
            int w = __builtin_amdgcn_cvt_pk_fp8_f32(bflo(h0[2 * c]) * qs, bfhi(h0[2 * c]) * qs, 0, false); w = __builtin_amdgcn_cvt_pk_fp8_f32(bflo(h0[2 * c + 1]) * qs, bfhi(h0[2 * c + 1]) * qs, w, true); o[c] = (unsigned)w;
            int x = __builtin_amdgcn_cvt_pk_fp8_f32(bflo(h1[2 * c]) * qs, bfhi(h1[2 * c]) * qs, 0, false); x = __builtin_amdgcn_cvt_pk_fp8_f32(bflo(h1[2 * c + 1]) * qs, bfhi(h1[2 * c + 1]) * qs, x, true); o[2 + c] = (unsigned)x;
        }
        *(u32x4*)(HQ + (size_t)t * DM + 16 * lane) = o;
        if (lane == 0) HSC[t] = row_rstd((const float*)(p.ws + OFF_SSQP), t) * am * (1.f / 224.f);
    }
}
__device__ __forceinline__ void p5a_wave(const Params& p, LAS unsigned char* wl, int tb, int part, int lane, __amdgpu_buffer_rsrc_t urs, __amdgpu_buffer_rsrc_t hrs) {
    const float* USC = (const float*)(p.ws + OFF_USC); const float* VSC = (const float*)(p.ws + OFF_VSC); const float* HSC = (const float*)(p.ws + OFF_HSC);
    const unsigned* PW0 = (const unsigned*)(p.ws + OFF_PW0); unsigned* PW = (unsigned*)(p.ws + OFF_PW);
    const int l15 = lane & 15, g = lane >> 4;
    unsigned xl[4], xh[4]; float hsc = 0.f;
#define P5A_STAGE(t0_) do { _Pragma("unroll") for (int _k = 0; _k < 4; ++_k) { \
        __builtin_amdgcn_raw_ptr_buffer_load_lds(hrs, (LAS unsigned*)(wl + _k * 1024), 16, lane * 16, ((t0_) + _k) * 1024, 0, 0); \
        xl[_k] = PW0[(size_t)((t0_) + _k) * 128 + lane]; xh[_k] = PW0[(size_t)((t0_) + _k) * 128 + 64 + lane]; } \
        hsc = HSC[(t0_) + (lane & 3)]; } while (0)
#define P5A_GATHER(tile_) do { int _li = (tile_) * 16 + l15; _li = _li < n ? _li : n - 1; \
        const int _ev = (int)((*(const LAS unsigned*)(wl + P5A_LIST + _li * 4) & 0x3fffu) << 10); \
        _Pragma("unroll") for (int _r = 0; _r < 16; ++_r) \
            __builtin_amdgcn_raw_ptr_buffer_load_lds(urs, (LAS unsigned*)(wl + _r * P5A_RS), 16, lane * 16, __builtin_amdgcn_readlane(_ev, _r), 0, 0); } while (0)
    P5A_STAGE(tb);
    for (int st = 0; st < 4; ++st) {
        const int t0 = tb + 4 * st;
        asm volatile("s_waitcnt vmcnt(0)" ::: "memory");
        long bq[32];
#pragma unroll
        for (int i = 0; i < 16; ++i) { const u32x4 w = *(const LAS u32x4*)(wl + (l15 & 3) * 1024 + 64 * i + 16 * g);
            bq[2 * i] = __builtin_bit_cast(long, (u32x2){w.x, w.y}); bq[2 * i + 1] = __builtin_bit_cast(long, (u32x2){w.z, w.w}); }
        if (lane < 4) *(LAS float*)(wl + P5A_TSC + lane * 4) = hsc;
        int n = 0;
#pragma unroll
        for (int k = 0; k < 4; ++k) {
            const bool ml = (int)((xl[k] >> 11) & 7u) == part, mh = (int)((xh[k] >> 11) & 7u) == part;
            const unsigned long long bl = __ballot(ml), bh = __ballot(mh);
            const int rl = __builtin_amdgcn_mbcnt_hi((unsigned)(bl >> 32), __builtin_amdgcn_mbcnt_lo((unsigned)bl, 0u));
            if (ml) *(LAS unsigned*)(wl + P5A_LIST + (n + rl) * 4) = (xl[k] & 0x3fffu) | ((unsigned)lane << 14) | ((unsigned)k << 21);
            n += __popcll(bl);
            const int rh = __builtin_amdgcn_mbcnt_hi((unsigned)(bh >> 32), __builtin_amdgcn_mbcnt_lo((unsigned)bh, 0u));
            if (mh) *(LAS unsigned*)(wl + P5A_LIST + (n + rh) * 4) = (xh[k] & 0x3fffu) | ((unsigned)(64 + lane) << 14) | ((unsigned)k << 21);
            n += __popcll(bh);
        }
        __builtin_amdgcn_s_waitcnt(0xC07F); __builtin_amdgcn_wave_barrier();
        asm volatile("" ::: "memory");
        const int ntile = (n + 15) >> 4;
        if (ntile == 0) { if (st < 3) P5A_STAGE(t0 + 4); continue; }
#define P5A_OPS(tile_, EOK, EE, SL, TK, USCV, VSCV, XGV) do { int _ei = (tile_) * 16 + l15; EOK = _ei < n; _ei = EOK ? _ei : n - 1; \
        const unsigned _ent = *(const LAS unsigned*)(wl + P5A_LIST + _ei * 4); \
        EE = _ent & 0x3fffu; SL = (int)((_ent >> 14) & 127u); TK = (int)(_ent >> 21); \
        USCV = USC[EE]; VSCV = VSC[EE]; XGV = PW0[(size_t)(t0 + TK) * 128 + SL]; } while (0)
        bool eokN; unsigned eeN; int slN, tkN; float uscN, vscN; unsigned xgN;
        P5A_GATHER(0);
        P5A_OPS(0, eokN, eeN, slN, tkN, uscN, vscN, xgN);
        for (int tile = 0; tile < ntile; ++tile) {
            asm volatile("s_waitcnt vmcnt(0)" : "+v"(uscN), "+v"(vscN), "+v"(xgN) :: "memory");
            const bool eok = eokN; const unsigned ee = eeN; const int sl = slN, tk = tkN, t = t0 + tkN; const float usc = uscN, vsc = vscN; const unsigned xg = xgN;
            long aq[32];
#pragma unroll
            for (int i = 0; i < 16; ++i) { const u32x4 w = *(const LAS u32x4*)(wl + l15 * P5A_RS + 64 * i + 16 * g);
                aq[2 * i] = __builtin_bit_cast(long, (u32x2){w.x, w.y}); aq[2 * i + 1] = __builtin_bit_cast(long, (u32x2){w.z, w.w}); }
            asm volatile("s_waitcnt lgkmcnt(0)" ::: "memory");
#pragma unroll
            for (int s = 0; s < 32; ++s) asm volatile("" : "+v"(aq[s]));
            if (tile + 1 < ntile) { P5A_GATHER(tile + 1); P5A_OPS(tile + 1, eokN, eeN, slN, tkN, uscN, vscN, xgN); } else if (st < 3) P5A_STAGE(t0 + 4);
            f32x4 acc = (f32x4){0.f, 0.f, 0.f, 0.f};
#pragma unroll
            for (int s = 0; s < 32; ++s) acc = __builtin_amdgcn_mfma_f32_16x16x32_fp8_fp8(aq[s], bq[s], acc, 0, 0, 0);
            {
                const u32x4 en = *(const LAS u32x4*)(wl + P5A_LIST + (tile * 16 + 4 * g) * 4);
#pragma unroll
                for (int r = 0; r < 4; ++r) if ((int)(en[r] >> 21) == l15) *(LAS float*)(wl + P5A_RES + (4 * g + r) * 4) = acc[r];
            }
            __builtin_amdgcn_s_waitcnt(0xC07F); __builtin_amdgcn_wave_barrier();
            asm volatile("" ::: "memory");
            if (lane < 16 && eok) {
                const float d = *(const LAS float*)(wl + P5A_RES + lane * 4) * usc * *(const LAS float*)(wl + P5A_TSC + tk * 4);
                const float w = __uint_as_float(xg & 0xffff0000u) * gelu_f(d) * vsc;
                PW[(((size_t)(t >> 6) * 32 + (sl >> 2)) * 64 + (t & 63)) * 4 + (sl & 3)] = ee | (f2bf(w) << 16);
            }
            __builtin_amdgcn_s_waitcnt(0xC07F); __builtin_amdgcn_wave_barrier();
            asm volatile("" ::: "memory");
        }
#undef P5A_OPS
    }
    asm volatile("s_waitcnt vmcnt(0)" ::: "memory");
#undef P5A_STAGE
#undef P5A_GATHER
}
__device__ __forceinline__ void phase5a(const Params& p, LAS unsigned char* lds, int qoff = 0) {
    const int tid = threadIdx.x, lane = tid & 63, wave = __builtin_amdgcn_readfirstlane(tid >> 6);
    const int xcc = (int)(__builtin_amdgcn_s_getreg((3 << 11) | 20) & 7u);
    unsigned* qc = (unsigned*)(p.ws + OFF_CTL) + 256 + qoff;
    LAS unsigned char* wl = lds + wave * P5A_WAVE;
    const __amdgpu_buffer_rsrc_t urs = __builtin_amdgcn_make_buffer_rsrc((void*)(p.ws + OFF_UB), 0, NEXP * DM, 0x00020000);
    const __amdgpu_buffer_rsrc_t hrs = __builtin_amdgcn_make_buffer_rsrc((void*)(p.ws + OFF_HQ), 0, NTOK * DM, 0x00020000);
    for (int pi = 0; pi < 8; ++pi) {
        const int part = (xcc + pi) & 7;
        for (;;) {
            __syncthreads();
            if (tid == 0) *(LAS unsigned*)(lds + LDS_Q) = atomicAdd(qc + part * 64, 1u);
            __syncthreads();
            const int it = (int)*(LAS unsigned*)(lds + LDS_Q);
            if (it >= NTOK / 128) break;
            p5a_wave(p, wl, it * 128 + wave * 16, part, lane, urs, hrs);
        }
    }
}

__device__ __forceinline__ void p5b_quad(const LAS unsigned char* lds, u32x4 q, f32x2& a0, f32x2& a1, f32x2& a2, f32x2& a3) {
#pragma unroll
    for (int c = 0; c < 4; ++c) {
        const unsigned x = q[c];
        const u32x2 vv = *(const LAS u32x2*)(lds + ((x & 0x3fffu) << 3));
        const float w = __uint_as_float(x & 0xffff0000u); const f32x2 ww = (f32x2){w, w};
        a0 += ww * __builtin_amdgcn_cvt_pk_f32_fp8((int)vv.x, false); a1 += ww * __builtin_amdgcn_cvt_pk_f32_fp8((int)vv.x, true);
        a2 += ww * __builtin_amdgcn_cvt_pk_f32_fp8((int)vv.y, false); a3 += ww * __builtin_amdgcn_cvt_pk_f32_fp8((int)vv.y, true);
    }
}
__device__ __forceinline__ void phase5b(const Params& p, LAS unsigned char* lds) {
    const int tid = threadIdx.x, lane = tid & 63, wave = __builtin_amdgcn_readfirstlane(tid >> 6);
    const unsigned char* VS = p.ws + OFF_VB; const u32x4* PW = (const u32x4*)(p.ws + OFF_PW); bf16_t* OUTS = (bf16_t*)(p.ws + OFF_OUTS);
    for (int it = blockIdx.x; it < 256; it += gridDim.x) {
        const int s = it >> 1, tbase = (it & 1) * 128;
        __syncthreads();
#pragma unroll 4
        for (int i = 0; i < 16; ++i) *(LAS u32x4*)(lds + (tid + NTHR * i) * 16) = *(const u32x4*)(VS + (size_t)s * 131072 + (size_t)(tid + NTHR * i) * 16);
        __syncthreads();
        u32x4 A[8], Bq[8];
#define P5B_LOAD(R, gi) do { const int _T = tbase + wave + 8 * ((gi) >> 2), _g = (gi) & 3; const u32x4* _p = PW + ((size_t)_T * 32 + _g * 8) * 64 + lane; \
        _Pragma("unroll") for (int _i = 0; _i < 8; ++_i) R[_i] = _p[_i * 64]; } while (0)
        f32x2 a0 = {0.f, 0.f}, a1 = {0.f, 0.f}, a2 = {0.f, 0.f}, a3 = {0.f, 0.f};
        P5B_LOAD(A, 0);
        for (int gi = 0; gi < 64; gi += 2) {
            P5B_LOAD(Bq, gi + 1);
#pragma unroll
            for (int i = 0; i < 8; ++i) p5b_quad(lds, A[i], a0, a1, a2, a3);
            if (gi + 2 < 64) P5B_LOAD(A, gi + 2);
#pragma unroll
            for (int i = 0; i < 8; ++i) p5b_quad(lds, Bq[i], a0, a1, a2, a3);
            if (((gi + 1) & 3) == 3) {
                const int T = tbase + wave + 8 * (gi >> 2);
                *(u32x4*)(OUTS + ((size_t)s * NTOK + T * 64 + lane) * 8) = (u32x4){pk2(a0.x, a0.y), pk2(a1.x, a1.y), pk2(a2.x, a2.y), pk2(a3.x, a3.y)};
                a0 = (f32x2){0.f, 0.f}; a1 = a0; a2 = a0; a3 = a0;
            }
        }
#undef P5B_LOAD
    }
}

__device__ __forceinline__ void phase5c(const Params& p, LAS unsigned char* lds) {
    const int tid = threadIdx.x, lane = tid & 63, wave = __builtin_amdgcn_readfirstlane(tid >> 6);
    const bf16_t* OUTS = (const bf16_t*)(p.ws + OFF_OUTS); const bf16_t* H2B = (const bf16_t*)(p.ws + OFF_H2B); const float* fw = p.in[20];
    for (int it = blockIdx.x; it < NTOK / 32; it += gridDim.x) {
        const int t0 = it * 32;
        __syncthreads();
#pragma unroll 4
        for (int i = 0; i < 8; ++i) {
            const int q = tid + NTHR * i, s = q >> 5, tt = q & 31;
            *(LAS u32x4*)(lds + tt * 2064 + s * 16) = *(const u32x4*)(OUTS + ((size_t)s * NTOK + t0 + tt) * 8);
        }
        __syncthreads();
        for (int i = 0; i < 4; ++i) {
            const int tt = wave * 4 + i; float* orow = p.out + (size_t)(t0 + tt) * DM;
            f32x4 h[4]; float ss = 0.f;
#pragma unroll
            for (int j = 0; j < 2; ++j) {
                const u32x4 a = *(const u32x4*)(H2B + (size_t)(t0 + tt) * DM + 512 * j + 8 * lane), pq = *(const LAS u32x4*)(lds + tt * 2064 + (512 * j + 8 * lane) * 2);
                h[2 * j] = (f32x4){bflo(a.x) + bflo(pq.x), bfhi(a.x) + bfhi(pq.x), bflo(a.y) + bflo(pq.y), bfhi(a.y) + bfhi(pq.y)};
                h[2 * j + 1] = (f32x4){bflo(a.z) + bflo(pq.z), bfhi(a.z) + bfhi(pq.z), bflo(a.w) + bflo(pq.w), bfhi(a.w) + bfhi(pq.w)};
            }
#pragma unroll
            for (int j = 0; j < 4; ++j) ss += h[j].x * h[j].x + h[j].y * h[j].y + h[j].z * h[j].z + h[j].w * h[j].w;
            const float rs = rsqrtf(wave_sum(ss) * (1.f / DM) + EPS);
#pragma unroll
            for (int j = 0; j < 2; ++j) {
                float* o = orow + 512 * j + 8 * lane; const float* w = fw + 512 * j + 8 * lane;
                *(f32x4*)o = h[2 * j] * rs * *(const f32x4*)w; *(f32x4*)(o + 4) = h[2 * j + 1] * rs * *(const f32x4*)(w + 4);
            }
        }
    }
}


#define XB_TMO      128
#define XB_XCNT(j)  (256  + 64 * (j))
#define XB_XSUB(j)  (1280 + 64 * (j))
#define XB_XGEN(j)  (2304 + 64 * (j))
#define XB_TOP      3328
#define XB_TOPGEN   3392
#define XCD_BAR_WORDS 3456
#define XB_SPIN_CAP (1u << 18)
__device__ __forceinline__ unsigned xb_ld(unsigned* p)              { return __hip_atomic_load(p, __ATOMIC_RELAXED, __HIP_MEMORY_SCOPE_AGENT); }
__device__ __forceinline__ unsigned xb_add(unsigned* p, unsigned v) { return __hip_atomic_fetch_add(p, v, __ATOMIC_RELAXED, __HIP_MEMORY_SCOPE_AGENT); }
__device__ __forceinline__ unsigned xb_xcc_id() { return (unsigned)__builtin_amdgcn_s_getreg((3 << 11) | 20) & 0xFu; }
#define XB_SPIN(cond, bar) do { unsigned _sp = 0; while (cond) { __builtin_amdgcn_s_sleep(1); \
    if ((++_sp & 255u) == 0u) { if (xb_ld(&(bar)[XB_TMO])) break; if (_sp > XB_SPIN_CAP) { atomicAdd(&(bar)[XB_TMO], 1u); break; } } } } while (0)
struct XcdBarrier { unsigned* bar; unsigned x; volatile LAS unsigned* st; };
__device__ __forceinline__ XcdBarrier xcd_barrier_post(unsigned* bar, volatile LAS unsigned* st) {
    XcdBarrier b; b.bar = bar; b.x = xb_xcc_id(); b.st = st;
    if (threadIdx.x == 0) (void)xb_add(&bar[XB_XCNT(b.x)], 1u);
    return b;
}
__device__ __forceinline__ void xcd_barrier_complete(unsigned* bar, unsigned x, unsigned& nloc, unsigned& nx) {
    const unsigned G = gridDim.x * gridDim.y * gridDim.z;
    unsigned sum, cnt, mine, sp = 0u;
    for (;;) {
        sum = 0u; cnt = 0u; mine = 0u;
#pragma unroll
        for (unsigned j = 0; j < 16; ++j) { const unsigned c = xb_ld(&bar[XB_XCNT(j)]); sum += c; cnt += (c > 0u) ? 1u : 0u; mine = (j == x) ? c : mine; }
        if (sum == G) break;
        __builtin_amdgcn_s_sleep(1);
        if ((++sp & 255u) == 0u) { if (xb_ld(&bar[XB_TMO])) break; if (sp > XB_SPIN_CAP) { atomicAdd(&bar[XB_TMO], 1u); break; } }
    }
    nloc = mine > 0u ? mine : 1u; nx = cnt > 0u ? cnt : 1u;
}
__device__ __forceinline__ void xcd_barrier(const XcdBarrier& b) {
    asm volatile("s_waitcnt vmcnt(0)" ::: "memory");
    __syncthreads();
    if (threadIdx.x == 0) {
        unsigned* bar = b.bar;
        __builtin_amdgcn_s_waitcnt(0);
        unsigned nloc = b.st[0], nx = b.st[1];
        if (nloc == 0u) { xcd_barrier_complete(bar, b.x, nloc, nx); b.st[0] = nloc; b.st[1] = nx; }
        const unsigned old = xb_add(&bar[XB_XSUB(b.x)], 1u);
        const unsigned gen = old / nloc;
        if (old + 1u == (gen + 1u) * nloc) {
            __builtin_amdgcn_fence(__ATOMIC_RELEASE, "agent");
            asm volatile("s_waitcnt vmcnt(0)" ::: "memory");
            const unsigned og = xb_add(&bar[XB_TOP], 1u);
            const unsigned tg = og / nx;
            if (og + 1u == (tg + 1u) * nx) xb_add(&bar[XB_TOPGEN], 1u);
            else XB_SPIN(xb_ld(&bar[XB_TOPGEN]) == tg, bar);
            __builtin_amdgcn_fence(__ATOMIC_ACQUIRE, "agent");
            xb_add(&bar[XB_XGEN(b.x)], 1u);
            asm volatile("s_waitcnt vmcnt(0)" ::: "memory");
        } else {
            XB_SPIN(xb_ld(&bar[XB_XGEN(b.x)]) == gen, bar);
            __builtin_amdgcn_fence(__ATOMIC_ACQUIRE, "agent");
            asm volatile("s_waitcnt vmcnt(0)" ::: "memory");
        }
    }
    __syncthreads();
}

constexpr int NPHASE = 9;
__global__ void __launch_bounds__(NTHR, 2) mega(Params p) {
    extern __shared__ __attribute__((aligned(16))) unsigned char lds[];
    cg::grid_group grid = cg::this_grid();
#define PH_ON(k) (p.ph_lo <= (k) && (k) < p.ph_hi)
    if (threadIdx.x < 2) ((LAS unsigned*)((LAS unsigned char*)lds + LDS_BYTES - 32))[threadIdx.x] = 0u;
    __syncthreads();
    const XcdBarrier xbar = xcd_barrier_post((unsigned*)(p.ws + OFF_CTL) + 8192, (volatile LAS unsigned*)((LAS unsigned char*)lds + LDS_BYTES - 32));
#define PH_SYNC(k) do { if (PH_ON(k) && PH_ON((k) + 1)) { xcd_barrier(xbar); } } while (0)
    if (PH_ON(0)) phase0(p, lds);
    PH_SYNC(0);
    if (PH_ON(1)) phase1_mfma(p, (LAS unsigned char*)lds);
#if PROBE_DUP == 1
    xcd_barrier(xbar); phase1_mfma(p, (LAS unsigned char*)lds);
#endif
    PH_SYNC(1);
    if (PH_ON(2)) phase2(p, (LAS unsigned char*)lds);
#if PROBE_DUP == 2
    xcd_barrier(xbar); phase2(p, (LAS unsigned char*)lds, 1);
#endif
#if PROBE_DUP == 21
    xcd_barrier(xbar); phase2(p, (LAS unsigned char*)lds, 2);
#endif
#if PROBE_DUP == 22
    xcd_barrier(xbar); phase2(p, (LAS unsigned char*)lds, 3);
#endif
    PH_SYNC(2);
    if (PH_ON(4)) phase3_mfma(p, (LAS unsigned char*)lds);
#if PROBE_DUP == 4
    xcd_barrier(xbar); phase3_mfma(p, (LAS unsigned char*)lds);
#endif
    PH_SYNC(4);
    if (PH_ON(5)) { phase4_mfma(p, (LAS unsigned char*)lds); quantize_hn(p); }
#if PROBE_DUP == 5
    xcd_barrier(xbar); phase4_mfma(p, (LAS unsigned char*)lds);
#endif
    PH_SYNC(5);
    if (PH_ON(6)) phase5a(p, (LAS unsigned char*)lds);
#if PROBE_DUP == 6
    xcd_barrier(xbar); phase5a(p, (LAS unsigned char*)lds, 1024);
#endif
    PH_SYNC(6);
    if (PH_ON(7)) phase5b(p, (LAS unsigned char*)lds);
#if PROBE_DUP == 7
    xcd_barrier(xbar); phase5b(p, (LAS unsigned char*)lds);
#endif
    PH_SYNC(7);
    if (PH_ON(8)) phase5c(p, (LAS unsigned char*)lds);
}

extern "C" void kernel_launch(void* const* d_in, const int* in_sizes, int n_in, void* d_out, int out_size, void* d_ws, size_t ws_size, hipStream_t stream) {
    static int grid = 0;
    if (grid == 0) {
        if (n_in != 21 || out_size != NTOK * DM || ws_size < WS_END) { fprintf(stderr, "kernel_launch: unexpected shapes (n_in %d out %d ws %zu)\n", n_in, out_size, ws_size); grid = -1; return; }
        int dev = 0, cus = 0, per_cu = 0;
        hipGetDevice(&dev);
        hipDeviceGetAttribute(&cus, hipDeviceAttributeMultiprocessorCount, dev);
        hipFuncSetAttribute((const void*)mega, hipFuncAttributeMaxDynamicSharedMemorySize, LDS_BYTES);
        hipOccupancyMaxActiveBlocksPerMultiprocessor(&per_cu, (const void*)mega, NTHR, LDS_BYTES);
        if (per_cu < 1) { fprintf(stderr, "kernel_launch: occupancy query says %d blocks/CU\n", per_cu); per_cu = 1; }
        grid = cus * 1;
        (void)hipGetLastError();
    }
    if (grid < 0) return;
    hipMemsetAsync((char*)d_ws + OFF_CTL, 0, CTL_BYTES, stream);
    Params p{};
    for (int i = 0; i < 21; ++i) p.in[i] = (const float*)d_in[i];
    p.out = (float*)d_out; p.ws = (unsigned char*)d_ws; p.ph_lo = 0; p.ph_hi = NPHASE;
    void* args[] = {&p};
    hipError_t e = hipLaunchCooperativeKernel((const void*)mega, dim3(grid), dim3(NTHR), args, LDS_BYTES, stream);
    if (e != hipSuccess) fprintf(stderr, "cooperative launch failed: %s (grid %d)\n", hipGetErrorString(e), grid);
}
```

```cpp
#include <hip/hip_runtime.h>
#include <hip/hip_cooperative_groups.h>
#include <cstdio>
#include <cstdint>
namespace cg = cooperative_groups;

constexpr int DM = 1024;
constexpr int NB = 8, SEQ = 2048, NMETA = 16;
constexpr int NTOK = NB * SEQ;
constexpr int MROWS = 16640;
constexpr int NIN = 3584;
constexpr int TPOS = NMETA + SEQ;
constexpr float EPS = 1e-6f;
constexpr float QSCALE = 0.125f * 1.4426950408889634f;
constexpr int NEXP = 16384;
constexpr int NTHR = 512;
#ifndef PROBE_DUP
#define PROBE_DUP 0
#endif

constexpr size_t MiB = 1u << 20;
constexpr size_t OFF_CTL = 0, CTL_BYTES = 64 * 1024;
constexpr size_t OFF_MISC = 512 * 1024;
constexpr size_t OFF_ROPE = 1 * MiB;
constexpr size_t OFF_WOUT = 2 * MiB;
constexpr size_t OFF_WQ = 4 * MiB;
constexpr size_t OFF_KEYS = 8 * MiB;
constexpr size_t OFF_SSQP = 25 * MiB;
constexpr size_t OFF_UB = 9 * MiB;
constexpr size_t OFF_VB = 41 * MiB;
constexpr size_t OFF_XN = 73 * MiB;
constexpr size_t OFF_MIX = 73 * MiB;
constexpr size_t OFF_WIN = 106 * MiB;
constexpr size_t OFF_QB = 113 * MiB;
constexpr size_t OFF_KB = OFF_QB + 16 * MiB + 256 * 1024;
constexpr size_t OFF_VT = OFF_KB + 16 * MiB + 256 * 1024;
constexpr size_t OFF_H2B = 113 * MiB;
constexpr size_t OFF_GQ = 162 * MiB;
constexpr size_t OFF_GK = OFF_GQ + 8 * MiB + 256 * 1024;
constexpr size_t OFF_GVT = OFF_GK + 8 * MiB + 256 * 1024;
constexpr size_t OFF_GF = OFF_GVT + 16 * MiB + 256 * 1024;
constexpr size_t OFF_GB = OFF_GF + 16 * MiB + 256 * 1024;
constexpr size_t OFF_GR = OFF_GB + 16 * MiB + 256 * 1024;
constexpr size_t OFF_PW0 = 162 * MiB;
constexpr size_t OFF_USC = 64 * 1024;
constexpr size_t OFF_VSC = 128 * 1024;
constexpr size_t WS_END = OFF_GR + 16 * MiB + 256 * 1024;
static_assert(WS_END <= 256 * MiB, "workspace map");
static_assert(OFF_VT + (size_t)512 * MROWS * 2 <= OFF_GQ, "map D");
static_assert(OFF_WIN + (size_t)NIN * DM * 2 <= OFF_QB, "map C");

constexpr int LDS_BYTES = 163840;
constexpr int LDS_Q = LDS_BYTES - 16;

typedef unsigned short bf16_t;
typedef float f32x4 __attribute__((ext_vector_type(4)));
typedef float f32x2 __attribute__((ext_vector_type(2)));
typedef unsigned u32x4 __attribute__((ext_vector_type(4)));
typedef unsigned u32x2 __attribute__((ext_vector_type(2)));
typedef __bf16 bf16x2_t __attribute__((ext_vector_type(2)));

struct Params {
    const float* in[21];
    float* out;
    unsigned char* ws;
    int ph_lo, ph_hi;
};

__device__ __forceinline__ unsigned f2bf(float f) { unsigned u = __float_as_uint(f); return (u + 0x7fffu + ((u >> 16) & 1u)) >> 16; }
__device__ __forceinline__ float bf2f(unsigned h) { return __uint_as_float(h << 16); }
__device__ __forceinline__ unsigned pk2(float lo, float hi) { return __builtin_bit_cast(unsigned, __builtin_convertvector((f32x2){lo, hi}, bf16x2_t)); }
__device__ __forceinline__ float bflo(unsigned w) { return __uint_as_float(w << 16); }
__device__ __forceinline__ float bfhi(unsigned w) { return __uint_as_float(w & 0xffff0000u); }
__device__ __forceinline__ float dot2(unsigned a, unsigned b, float c) {
    return __builtin_amdgcn_fdot2_f32_bf16(__builtin_bit_cast(bf16x2_t, a), __builtin_bit_cast(bf16x2_t, b), c, false);
}
__device__ __forceinline__ float dot8(u32x4 a, u32x4 b, float c) { c = dot2(a.x, b.x, c); c = dot2(a.y, b.y, c); c = dot2(a.z, b.z, c); return dot2(a.w, b.w, c); }
__device__ __forceinline__ float wave_sum(float v) {
#pragma unroll
    for (int o = 1; o < 64; o <<= 1) v += __shfl_xor(v, o);
    return v;
}
__device__ __forceinline__ float wave_max(float v) {
#pragma unroll
    for (int o = 1; o < 64; o <<= 1) v = fmaxf(v, __shfl_xor(v, o));
    return v;
}
__device__ __forceinline__ float silu_f(float x) { return x * __builtin_amdgcn_rcpf(1.f + __expf(-x)); }
__device__ __forceinline__ float logsig_f(float x) { return fminf(x, 0.f) - __logf(1.f + __expf(-fabsf(x))); }
__device__ __forceinline__ float gelu_f(float v) {
    const float av = fabsf(v), t = __builtin_amdgcn_rcpf(av * 0.2316418882f + 1.0f);
    float q = t * 0.5307027145f + (-0.7265760135f); q = q * t + 0.7107068705f; q = q * t + (-0.142248368f); q = q * t + 0.127414796f; q = q * t;
    const float m = v * (q * __builtin_amdgcn_exp2f(v * v * (-0.72134752044f)));
    return v < 0.f ? m : v - m;
}

__device__ __forceinline__ float win_src(const Params& p, int k, int n) {
    const float* W = p.in[3] + (size_t)k * 3104;
    if (n < 1024) {
        const int base = n & ~63, dp = n & 63, d = dp < 16 ? ((dp >> 1) + 8 * (dp & 1)) : dp;
        return W[base + d];
    } else if (n < 3072) return W[n];
    const int j = (n - 3072) & 255, dir = (n - 3072) >> 8;
    const float* w2 = p.in[dir ? 11 : 9];
    const float* wz = W + 3072 + dir * 16;
    float s = 0.f;
#pragma unroll
    for (int r = 0; r < 16; ++r) s += wz[r] * w2[r * 256 + j];
    return s;
}

template <int WHICH>
__device__ __forceinline__ void p0_transpose_item(const Params& p, float* scr, int item, int lane) {
    constexpr int N = WHICH == 0 ? NIN : (WHICH == 1 ? 1024 : 2048);
    constexpr int nblk = N / 32;
    const int kb = item / nblk, nb = item % nblk, k0 = 64 * kb, n0 = 32 * nb;
    bf16_t* WT = (bf16_t*)(p.ws + (WHICH == 0 ? OFF_WIN : (WHICH == 1 ? OFF_WOUT : OFF_WQ)));
#pragma unroll 4
    for (int i = 0; i < 32; ++i) {
        const int kk = 2 * i + (lane >> 5), k = k0 + kk, n = n0 + (lane & 31);
        float v;
        if (WHICH == 0) v = win_src(p, k, n);
        else if (WHICH == 1) v = p.in[14][(size_t)k * 1024 + n];
        else v = p.in[16][(size_t)k * 2048 + n] * p.in[15][k];
        scr[kk * 33 + (lane & 31)] = v;
    }
    __builtin_amdgcn_s_waitcnt(0xC07F); __builtin_amdgcn_wave_barrier();
    const int c = lane & 7;
#pragma unroll
    for (int j = 0; j < 4; ++j) {
        const int n = (lane >> 3) + 8 * j; const float* s = scr + (8 * c) * 33 + n;
        u32x4 o; o.x = pk2(s[0 * 33], s[1 * 33]); o.y = pk2(s[2 * 33], s[3 * 33]); o.z = pk2(s[4 * 33], s[5 * 33]); o.w = pk2(s[6 * 33], s[7 * 33]);
        *(u32x4*)(WT + (size_t)(n0 + n) * 1024 + k0 + 8 * c) = o;
    }
    __builtin_amdgcn_s_waitcnt(0xC07F); __builtin_amdgcn_wave_barrier();
}

__device__ __forceinline__ void phase0(const Params& p, unsigned char* lds) {
    const int tid = threadIdx.x, lane = tid & 63, wave = tid >> 6;
    const int gw = blockIdx.x * 8 + wave, NGW = gridDim.x * 8;
    const long gt = (long)blockIdx.x * NTHR + tid, NGT = (long)gridDim.x * NTHR;
    {
        const f32x4* lw = (const f32x4*)p.in[2];
        bf16_t* XN = (bf16_t*)(p.ws + OFF_XN);
        for (int r = gw; r < MROWS; r += NGW) {
            const float* src = r < NTOK ? p.in[0] + (size_t)r * DM : (r < NTOK + NMETA ? p.in[1] + (size_t)(r - NTOK) * DM : nullptr);
            f32x4 v[4]; float s = 0.f;
#pragma unroll
            for (int j = 0; j < 4; ++j) { v[j] = src ? ((const f32x4*)src)[lane + 64 * j] : (f32x4){0.f, 0.f, 0.f, 0.f}; s += v[j].x * v[j].x + v[j].y * v[j].y + v[j].z * v[j].z + v[j].w * v[j].w; }
            const float rs = rsqrtf(wave_sum(s) * (1.f / DM) + EPS);
#pragma unroll
            for (int j = 0; j < 4; ++j) { const f32x4 w = lw[lane + 64 * j]; u32x2 o; o.x = pk2(v[j].x * rs * w.x, v[j].y * rs * w.y); o.y = pk2(v[j].z * rs * w.z, v[j].w * rs * w.w);
                *(u32x2*)(XN + (size_t)r * DM + 4 * (lane + 64 * j)) = o; }
        }
    }
    {
        float* scr = (float*)lds + wave * (64 * 33);
        constexpr int I0 = 16 * (NIN / 32);
        for (int it = gw; it < I0; it += NGW) p0_transpose_item<0>(p, scr, it, lane);
    }
    {
        f32x2* rope = (f32x2*)(p.ws + OFF_ROPE);
        for (long i = gt; i < TPOS * 8; i += NGT) {
            const int t = (int)(i >> 3), j = (int)(i & 7);
            const float inv = powf(500000.0f, -(float)j * 0.125f);
            const float ang = (float)t * inv;
            rope[i] = (f32x2){cosf(ang), sinf(ang)};
        }
        if (gt == 0) {
            float a = 0.f, b = 0.f;
            for (int i = 0; i < 64; ++i) { a += p.in[4][i] * p.in[5][i]; b += p.in[6][i] * p.in[7][i]; }
            ((float*)(p.ws + OFF_MISC))[0] = expf(a) - expf(b) + 0.2f;
        }
    }
}
constexpr int CV_WOUT = 64, CV_WQ = 128, CV_KEYS = 8, CV_U = 256, CV_V = 256, CV_ITEMS = CV_WOUT + CV_WQ + CV_KEYS + CV_U + CV_V;
__device__ __forceinline__ void conv_item(const Params& p, unsigned char* lds, int c) {
    const int tid = threadIdx.x, lane = tid & 63, wave = tid >> 6;
    __syncthreads();
    if (c < CV_WOUT) { p0_transpose_item<1>(p, (float*)lds + wave * (64 * 33), c * 8 + wave, lane); return; }
    c -= CV_WOUT;
    if (c < CV_WQ) { p0_transpose_item<2>(p, (float*)lds + wave * (64 * 33), c * 8 + wave, lane); return; }
    c -= CV_WQ;
    if (c < CV_KEYS) {
        bf16_t* KEYS = (bf16_t*)(p.ws + OFF_KEYS);
#pragma unroll 2
        for (int j = 0; j < 8; ++j) {
            const long e = ((long)c * 4096 + tid + NTHR * j) * 8;
            const f32x4 a = *(const f32x4*)(p.in[17] + e), b = *(const f32x4*)(p.in[17] + e + 4);
            u32x4 o; o.x = pk2(a.x, a.y); o.y = pk2(a.z, a.w); o.z = pk2(b.x, b.y); o.w = pk2(b.z, b.w);
            *(u32x4*)(KEYS + e) = o;
        }
        return;
    }
    c -= CV_KEYS;
    if (c < CV_U) {
        unsigned char* UQ = p.ws + OFF_UB; float* USC = (float*)(p.ws + OFF_USC);
#pragma unroll 2
        for (int i = 0; i < 8; ++i) {
            const int r = c * 64 + wave * 8 + i;
            const float* ur = p.in[18] + (size_t)r * DM + 16 * lane; const float* lw = p.in[15] + 16 * lane;
            f32x4 v[4]; float am = 0.f;
#pragma unroll
            for (int j = 0; j < 4; ++j) { v[j] = ((const f32x4*)ur)[j] * ((const f32x4*)lw)[j]; am = fmaxf(am, fmaxf(fmaxf(fabsf(v[j].x), fabsf(v[j].y)), fmaxf(fabsf(v[j].z), fabsf(v[j].w)))); }
            am = fmaxf(wave_max(am), 1e-30f);
            const float sc = 224.f / am;
            u32x4 o;
#pragma unroll
            for (int j = 0; j < 4; ++j) { int w = __builtin_amdgcn_cvt_pk_fp8_f32(v[j].x * sc, v[j].y * sc, 0, false); w = __builtin_amdgcn_cvt_pk_fp8_f32(v[j].z * sc, v[j].w * sc, w, true); o[j] = (unsigned)w; }
            *(u32x4*)(UQ + (size_t)r * DM + 16 * lane) = o;
            if (lane == 0) USC[r] = am * (1.f / 224.f);
        }
        return;
    }
    c -= CV_U;
    {
        unsigned char* VS = p.ws + OFF_VB; float* VSC = (float*)(p.ws + OFF_VSC);
        const int tile = c;
#pragma unroll 2
        for (int i = 0; i < 8; ++i) {
            const int er = wave * 8 + i, r = tile * 64 + er;
            const float* vr = p.in[19] + (size_t)r * DM + 16 * lane;
            f32x4 v[4]; float am = 0.f;
#pragma unroll
            for (int j = 0; j < 4; ++j) { v[j] = ((const f32x4*)vr)[j]; am = fmaxf(am, fmaxf(fmaxf(fabsf(v[j].x), fabsf(v[j].y)), fmaxf(fabsf(v[j].z), fabsf(v[j].w)))); }
            am = fmaxf(wave_max(am), 1e-30f);
            const float sc = 224.f / am;
            u32x4 o;
#pragma unroll
            for (int j = 0; j < 4; ++j) { int w = __builtin_amdgcn_cvt_pk_fp8_f32(v[j].x * sc, v[j].y * sc, 0, false); w = __builtin_amdgcn_cvt_pk_fp8_f32(v[j].z * sc, v[j].w * sc, w, true); o[j] = (unsigned)w; }
            *(u32x2*)(lds + er * 1032 + 16 * lane) = (u32x2){o.x, o.y}; *(u32x2*)(lds + er * 1032 + 16 * lane + 8) = (u32x2){o.z, o.w};
            if (lane == 0) VSC[r] = am * (1.f / 224.f);
        }
        __syncthreads();
#pragma unroll 4
        for (int i = 0; i < 16; ++i) {
            const int s = wave + 8 * i;
            *(u32x2*)(VS + ((size_t)s * NEXP + tile * 64 + lane) * 8) = *(const u32x2*)(lds + lane * 1032 + s * 8);
        }
    }
}

struct P1Ptrs { unsigned char* ws; const float* bias_f; const float* bias_b; };
__device__ __forceinline__ void p1_store(const P1Ptrs p, int row, int n0, float v0, float v1, float v2, float v3) {
    if (n0 < 1024) {
        const int dp = n0 & 63;
        if (dp < 16) {
            const int pos = row < NTOK ? NMETA + (row & (SEQ - 1)) : (row - NTOK);
            const f32x4 cs = *(const f32x4*)((const float*)(p.ws + OFF_ROPE) + ((size_t)pos * 8 + (dp >> 1)) * 2);
            const float a0 = v0 * cs.x - v1 * cs.y, b0 = v1 * cs.x + v0 * cs.y;
            const float a1 = v2 * cs.z - v3 * cs.w, b1 = v3 * cs.z + v2 * cs.w;
            v0 = a0; v1 = b0; v2 = a1; v3 = b1;
        }
        if (n0 < 512) { u32x2 o; o.x = pk2(v0 * QSCALE, v1 * QSCALE); o.y = pk2(v2 * QSCALE, v3 * QSCALE); *(u32x2*)((bf16_t*)(p.ws + OFF_QB) + (size_t)row * 512 + n0) = o; }
        else { u32x2 o; o.x = pk2(v0, v1); o.y = pk2(v2, v3); *(u32x2*)((bf16_t*)(p.ws + OFF_KB) + (size_t)row * 512 + (n0 - 512)) = o; }
    } else if (n0 < 1536) {
        bf16_t* VT = (bf16_t*)(p.ws + OFF_VT) + (size_t)(n0 - 1024) * MROWS + row;
        VT[0] = (bf16_t)f2bf(v0); VT[MROWS] = (bf16_t)f2bf(v1); VT[2 * MROWS] = (bf16_t)f2bf(v2); VT[3 * (size_t)MROWS] = (bf16_t)f2bf(v3);
    } else if (n0 < 1792) {
        u32x2 o; o.x = pk2(v0 * 0.125f, v1 * 0.125f); o.y = pk2(v2 * 0.125f, v3 * 0.125f); *(u32x2*)((bf16_t*)(p.ws + OFF_GQ) + (size_t)row * 256 + (n0 - 1536)) = o;
    } else if (n0 < 2048) {
        u32x2 o; o.x = pk2(v0, v1); o.y = pk2(v2, v3); *(u32x2*)((bf16_t*)(p.ws + OFF_GK) + (size_t)row * 256 + (n0 - 1792)) = o;
    } else if (n0 < 2560) {
        bf16_t* VT = (bf16_t*)(p.ws + OFF_GVT) + (size_t)(n0 - 2048) * MROWS + row;
        VT[0] = (bf16_t)f2bf(v0); VT[MROWS] = (bf16_t)f2bf(v1); VT[2 * MROWS] = (bf16_t)f2bf(v2); VT[3 * (size_t)MROWS] = (bf16_t)f2bf(v3);
    } else if (n0 < 3072) {
        u32x2 o; o.x = pk2(silu_f(v0), silu_f(v1)); o.y = pk2(silu_f(v2), silu_f(v3)); *(u32x2*)((bf16_t*)(p.ws + OFF_GR) + (size_t)row * 512 + (n0 - 2560)) = o;
    } else {
        const int dir = (n0 - 3072) >> 8, j = (n0 - 3072) & 255;
        const f32x4 bb = *(const f32x4*)((dir ? p.bias_b : p.bias_f) + j);
        f32x4 o; o.x = logsig_f(v0 + bb.x) * 0.0625f; o.y = logsig_f(v1 + bb.y) * 0.0625f; o.z = logsig_f(v2 + bb.z) * 0.0625f; o.w = logsig_f(v3 + bb.w) * 0.0625f;
        *(f32x4*)((float*)(p.ws + (dir ? OFF_GB : OFF_GF)) + (size_t)row * 256 + j) = o;
    }
}


#define LAS __attribute__((address_space(3)))
typedef short bf16x8 __attribute__((ext_vector_type(8)));
constexpr int GBUF = 49152;

template <int ROWS>
__device__ __forceinline__ void stage_tile(const bf16_t* G, int ldk, int r0, int k0, LAS unsigned char* buf, int wave, int lane) {
    const int rr = lane >> 3, c = (lane & 7) ^ rr;
#pragma unroll
    for (int i = 0; i < ROWS / 64; ++i) {
        const int grp = wave + 8 * i;
        const bf16_t* src = G + (size_t)(r0 + grp * 8 + rr) * ldk + k0 + c * 8;
        __builtin_amdgcn_global_load_lds((const unsigned*)src, (LAS unsigned*)(buf + grp * 1024), 16, 0, 0);
    }
}
__device__ __forceinline__ bf16x8 ldfrag(const LAS unsigned char* buf, int row, int c) {
    return *(const LAS bf16x8*)(buf + row * 128 + ((c ^ (row & 7)) << 4));
}
template <bool SWAP>
__device__ __forceinline__ void gemm_tile_256(const bf16_t* A, const bf16_t* Bt, int K, int m0, int n0, LAS unsigned char* lds, f32x4 (&acc)[4][4]) {
    const int tid = threadIdx.x, lane = tid & 63, wave = __builtin_amdgcn_readfirstlane(tid >> 6), wm = wave >> 2, wn = wave & 3, l15 = lane & 15, g = lane >> 4;
#pragma unroll
    for (int i = 0; i < 4; ++i)
#pragma unroll
        for (int j = 0; j < 4; ++j) acc[i][j] = (f32x4){0.f, 0.f, 0.f, 0.f};
    const int nk = K / 64;
    stage_tile<128>(A, K, m0, 0, lds, wave, lane);
    stage_tile<256>(Bt, K, n0, 0, lds + 16384, wave, lane);
    for (int kt = 0; kt < nk; ++kt) {
        asm volatile("s_waitcnt vmcnt(0)" ::: "memory");
        __syncthreads();
        if (kt + 1 < nk) {
            LAS unsigned char* nb = lds + ((kt + 1) & 1) * GBUF;
            stage_tile<128>(A, K, m0, (kt + 1) * 64, nb, wave, lane);
            stage_tile<256>(Bt, K, n0, (kt + 1) * 64, nb + 16384, wave, lane);
        }
        const LAS unsigned char* a = lds + (kt & 1) * GBUF; const LAS unsigned char* b = a + 16384;
#pragma unroll
        for (int ks = 0; ks < 2; ++ks) {
            bf16x8 af[4], bfr[4];
#pragma unroll
            for (int i = 0; i < 4; ++i) { af[i] = ldfrag(a, wm * 64 + i * 16 + l15, ks * 4 + g); bfr[i] = ldfrag(b, wn * 64 + i * 16 + l15, ks * 4 + g); }
#pragma unroll
            for (int i = 0; i < 4; ++i)
#pragma unroll
                for (int j = 0; j < 4; ++j)
                    acc[i][j] = SWAP ? __builtin_amdgcn_mfma_f32_16x16x32_bf16(af[i], bfr[j], acc[i][j], 0, 0, 0)
                                     : __builtin_amdgcn_mfma_f32_16x16x32_bf16(bfr[j], af[i], acc[i][j], 0, 0, 0);
        }
    }
}
__device__ __forceinline__ int vcu_of_block() { const int G = gridDim.x, bx = blockIdx.x; return (G % 8 == 0) ? (bx % 8) * (G / 8) + bx / 8 : bx; }

namespace pg8 {
#define PG8_LAS __attribute__((address_space(3)))
typedef unsigned short bf16_t;
typedef short bf16x8 __attribute__((ext_vector_type(8)));
typedef float f32x4 __attribute__((ext_vector_type(4)));
typedef unsigned u32x4 __attribute__((ext_vector_type(4)));
constexpr int BM = 256, BK = 64, HALF = 128, HTB = HALF * BK * 2  , STAGE_BYTES = 8 * HTB, NXCD = 8, WGM = 8;

__host__ __device__ __forceinline__ int lds_byte(int r, int c) { const int st = (r >> 4) * 2 + (c >> 5), rr = r & 15, cc = c & 31, ob = rr * 64 + cc * 2; return st * 1024 + (ob ^ (((ob >> 9) & 1) << 5)); }
__host__ __device__ __forceinline__ void stage_rc(int b, int& R, int& C) { const int st = b / 1024, sb = b % 1024, swz = sb ^ (((sb >> 9) & 1) << 5); R = (st >> 1) * 16 + swz / 64; C = (st & 1) * 32 + (swz % 64) / 2; }
__host__ __device__ __forceinline__ int perm32(int rho) { const int n = rho >> 4, i = rho & 15; return 8 * (i >> 2) + 4 * n + (i & 3); }

struct Unit { int pm, pn; };
struct Gemm { const bf16_t* A; const bf16_t* Bt; int M, N, K; };

struct StaticOrder {
    int nM, nN, nwg, G, c;
    __host__ __device__ void init(int M, int N, int G_, int c_) { nM = M / BM; nN = N / BM; nwg = nM * nN; G = G_; c = c_; }
    __host__ __device__ bool next(int i, Unit& u) const {
        const long L = (long)i * G + c; if (L >= nwg) return false;
        int wgid = (int)L; { const int q = nwg / NXCD, r = nwg % NXCD, xcd = wgid % NXCD, off = wgid / NXCD; wgid = (xcd < r ? xcd * (q + 1) : r * (q + 1) + (xcd - r) * q) + off; }
        const int nig = WGM * nN, gid = wgid / nig, fm = gid * WGM, gsz = (nM - fm) < WGM ? (nM - fm) : WGM;
        u.pm = fm + ((wgid % nig) % gsz); u.pn = (wgid % nig) / gsz; return true;
    }
    __device__ __forceinline__ void a_ready(const Unit&) const {}
    __device__ __forceinline__ void done(const Unit&) const {}
};

struct EpiP1 {
    static constexpr bool PERM = true, AFTER_DRAIN = false, SWAPPABLE = true;
    P1Ptrs p;
    static __device__ __forceinline__ bool swap_unit(const Unit& u) { return u.pn == 4 || u.pn == 5 || u.pn == 8 || u.pn == 9; }
    __device__ __forceinline__ void operator()(const f32x4 (&acc)[2][2][4][2], const Unit& u, int wr, int wc, int fr, int fq) const {
        if (swap_unit(u)) {
            const int cb = u.pn * BM, nbase = cb < 1536 ? cb - 1024 : cb - 2048;
            bf16_t* T = (bf16_t*)(p.ws + (cb < 1536 ? OFF_VT : OFF_GVT)) + (size_t)(nbase + wc * 32 + 8 * (fr >> 2) + (fr & 3)) * MROWS + u.pm * BM + wr * 64 + 4 * fq;
#pragma unroll
            for (int bj = 0; bj < 2; ++bj)
#pragma unroll
                for (int n = 0; n < 2; ++n)
#pragma unroll
                    for (int ai = 0; ai < 2; ++ai)
#pragma unroll
                        for (int m = 0; m < 4; ++m) { const f32x4 v = acc[ai][bj][m][n];
                            *(u32x2*)(T + (size_t)(bj * HALF + n * 4) * MROWS + ai * HALF + m * 16) = (u32x2){pk2(v.x, v.y), pk2(v.z, v.w)}; }
            return;
        }
#pragma unroll
        for (int bj = 0; bj < 2; ++bj) {
            const int nw = u.pn * BM + bj * HALF + wc * 32;
            const int rowb = u.pm * BM + wr * 64 + fr;
            if (nw >= 3072) {
                const int dir = (nw - 3072) >> 8, j0 = ((nw - 3072) & 255) + 8 * fq;
                float* G = (float*)(p.ws + (dir ? OFF_GB : OFF_GF)); const float* bias = dir ? p.bias_b : p.bias_f;
                const f32x4 b0 = *(const f32x4*)(bias + j0), b1 = *(const f32x4*)(bias + j0 + 4);
#pragma unroll
                for (int ai = 0; ai < 2; ++ai)
#pragma unroll
                    for (int m = 0; m < 4; ++m) { const f32x4 v0 = acc[ai][bj][m][0], v1 = acc[ai][bj][m][1]; f32x4 o0, o1;
                        o0.x = logsig_f(v0.x + b0.x) * 0.0625f; o0.y = logsig_f(v0.y + b0.y) * 0.0625f; o0.z = logsig_f(v0.z + b0.z) * 0.0625f; o0.w = logsig_f(v0.w + b0.w) * 0.0625f;
                        o1.x = logsig_f(v1.x + b1.x) * 0.0625f; o1.y = logsig_f(v1.y + b1.y) * 0.0625f; o1.z = logsig_f(v1.z + b1.z) * 0.0625f; o1.w = logsig_f(v1.w + b1.w) * 0.0625f;
                        float* gp = G + (size_t)(rowb + ai * HALF + m * 16) * 256 + j0; *(f32x4*)gp = o0; *(f32x4*)(gp + 4) = o1; }
            } else {
                bf16_t* base; int ld, c0; float sc = 1.f; bool silu = false;
                if (nw < 512) { base = (bf16_t*)(p.ws + OFF_QB); ld = 512; c0 = nw; sc = QSCALE; }
                else if (nw < 1024) { base = (bf16_t*)(p.ws + OFF_KB); ld = 512; c0 = nw - 512; }
                else if (nw < 1792) { base = (bf16_t*)(p.ws + OFF_GQ); ld = 256; c0 = nw - 1536; sc = 0.125f; }
                else if (nw < 2048) { base = (bf16_t*)(p.ws + OFF_GK); ld = 256; c0 = nw - 1792; }
                else { base = (bf16_t*)(p.ws + OFF_GR); ld = 512; c0 = nw - 2560; silu = true; }
                const bool rope = nw < 1024 && (nw & 63) == 0 && fq < 2;
#pragma unroll
                for (int ai = 0; ai < 2; ++ai)
#pragma unroll
                    for (int m = 0; m < 4; ++m) {
                        const int row = rowb + ai * HALF + m * 16;
                        f32x4 v0 = acc[ai][bj][m][0], v1 = acc[ai][bj][m][1];
                        if (rope) {
                            const int pos = row < NTOK ? NMETA + (row & (SEQ - 1)) : (row - NTOK < TPOS ? row - NTOK : 0);
                            const f32x4* cp = (const f32x4*)((const float*)(p.ws + OFF_ROPE) + ((size_t)pos * 8 + 4 * fq) * 2);
                            const f32x4 ca = cp[0], cb2 = cp[1];
                            v0 = (f32x4){v0.x * ca.x - v0.y * ca.y, v0.y * ca.x + v0.x * ca.y, v0.z * ca.z - v0.w * ca.w, v0.w * ca.z + v0.z * ca.w};
                            v1 = (f32x4){v1.x * cb2.x - v1.y * cb2.y, v1.y * cb2.x + v1.x * cb2.y, v1.z * cb2.z - v1.w * cb2.w, v1.w * cb2.z + v1.z * cb2.w};
                        }
                        if (silu) { v0 = (f32x4){silu_f(v0.x), silu_f(v0.y), silu_f(v0.z), silu_f(v0.w)}; v1 = (f32x4){silu_f(v1.x), silu_f(v1.y), silu_f(v1.z), silu_f(v1.w)}; }
                        else { v0 = v0 * sc; v1 = v1 * sc; }
                        *(u32x4*)(base + (size_t)row * ld + c0 + 8 * fq) = (u32x4){pk2(v0.x, v0.y), pk2(v0.z, v0.w), pk2(v1.x, v1.y), pk2(v1.z, v1.w)};
                    }
            }
        }
    }
};
struct EpiP3 {
    static constexpr bool PERM = true, AFTER_DRAIN = false, SWAPPABLE = false;
    const float* x; float* out; bf16_t* h2b; float* ssq;
    __device__ __forceinline__ void operator()(const f32x4 (&acc)[2][2][4][2], const Unit& u, int wr, int wc, int fr, int fq) const {
#pragma unroll
        for (int ai = 0; ai < 2; ++ai)
#pragma unroll
            for (int m = 0; m < 4; ++m) { const int row = u.pm * BM + ai * HALF + wr * 64 + m * 16 + fr; float ss = 0.f;
#pragma unroll
                for (int bj = 0; bj < 2; ++bj) { const int col = u.pn * BM + bj * HALF + wc * 32 + 8 * fq;
                    const f32x4 h0 = *(const f32x4*)(x + (size_t)row * DM + col) + acc[ai][bj][m][0], h1 = *(const f32x4*)(x + (size_t)row * DM + col + 4) + acc[ai][bj][m][1];
                    *(u32x4*)(h2b + (size_t)row * DM + col) = (u32x4){pk2(h0.x, h0.y), pk2(h0.z, h0.w), pk2(h1.x, h1.y), pk2(h1.z, h1.w)};
                    ss += (h0.x * h0.x + h0.y * h0.y + h0.z * h0.z + h0.w * h0.w) + (h1.x * h1.x + h1.y * h1.y + h1.z * h1.z + h1.w * h1.w); }
                ss += __shfl_xor(ss, 16); ss += __shfl_xor(ss, 32);
                if (fq == 0) ssq[(size_t)row * 16 + u.pn * 4 + wc] = ss; }
    }
};

struct P1Order {
    int G, c, ncol, nM; bool vt;
    __device__ __forceinline__ bool next(int i, Unit& u) const {
        const int nwg = nM * ncol; const int L = i * G + (vt ? (G - 1 - c) : c); if (L >= nwg) return false;
        const int pm = L / ncol, j = L % ncol;
        u.pm = pm; u.pn = vt ? (j < 2 ? 4 + j : 6 + j) : (j < 4 ? j : (j < 6 ? j + 2 : j + 4));
        return true;
    }
    __device__ __forceinline__ void a_ready(const Unit&) const {}
    __device__ __forceinline__ void done(const Unit&) const {}
};
struct OneUnit {
    Unit u; bool valid;
    __device__ __forceinline__ bool next(int i, Unit& o) const { if (i != 0 || !valid) return false; o = u; return true; }
    __device__ __forceinline__ void a_ready(const Unit&) const {}
    __device__ __forceinline__ void done(const Unit&) const {}
};

template <class Epi, class Sched, bool ALIGN_EPI = false, bool SP2 = false, bool SWP = false>
__device__ __forceinline__ void gemm_phase(PG8_LAS unsigned char* lds, const Gemm g, const Sched& S, const Epi& E) {
    int tid_ = threadIdx.x; asm volatile("" : "+v"(tid_));
    const int tid = tid_, wid = __builtin_amdgcn_readfirstlane(tid >> 6), lane = tid & 63, wr = wid >> 2, wc = wid & 3, fr = lane & 15, fq = lane >> 4;
    const int K = g.K, nt = K / BK;
    unsigned voffA[2], voffB[2];
#pragma unroll
    for (int i = 0; i < 2; ++i) { int R, C; stage_rc(tid * 16 + i * 8192, R, C); const int Rb = Epi::PERM ? ((R & ~31) + perm32(R & 31)) : R;
        voffA[i] = (unsigned)(R * K + C) * 2u; voffB[i] = (unsigned)(Rb * K + C) * 2u; }
    const size_t kstep = (size_t)(BK * 2);
    const size_t hstep = (size_t)HALF * K * 2;
    const size_t tstep = 2 * hstep;
    const unsigned ldsw = (unsigned)wid * 1024u;
    const int aoff = lds_byte(wr * 64 + fr, fq * 8), boff = lds_byte(wc * 32 + fr, fq * 8);
#define PG8_SA(b, h) (((b) * 2 + (h)) * HTB)
#define PG8_SB(b, h) ((4 + (b) * 2 + (h)) * HTB)
#define PG8_STAGE(bufoff, gbase, voff) do { _Pragma("unroll") for (int _i = 0; _i < 2; ++_i) \
        __builtin_amdgcn_global_load_lds((const unsigned*)((const char*)(gbase) + (voff)[_i]), (PG8_LAS unsigned*)(lds + (bufoff) + ldsw + _i * 8192), 16, 0, 0); } while (0)
#define PG8_LDA(dst, b, h) do { _Pragma("unroll") for (int m = 0; m < 4; ++m) _Pragma("unroll") for (int k = 0; k < 2; ++k) dst[m][k] = *(const PG8_LAS bf16x8*)(lds + PG8_SA(b, h) + aoff + m * 2048 + k * 1024); } while (0)
#define PG8_LDB(dst, b, h) do { _Pragma("unroll") for (int n = 0; n < 2; ++n) _Pragma("unroll") for (int k = 0; k < 2; ++k) dst[n][k] = *(const PG8_LAS bf16x8*)(lds + PG8_SB(b, h) + boff + n * 2048 + k * 1024); } while (0)
#define PG8_MMA(ai, bj, At, Bt) do { __builtin_amdgcn_s_setprio(1); \
        if (SWP) { _Pragma("unroll") for (int m = 0; m < 4; ++m) _Pragma("unroll") for (int n = 0; n < 2; ++n) _Pragma("unroll") for (int k = 0; k < 2; ++k) \
            acc[ai][bj][m][n] = __builtin_amdgcn_mfma_f32_16x16x32_bf16(At[m][k], Bt[n][k], acc[ai][bj][m][n], 0, 0, 0); } \
        else { _Pragma("unroll") for (int m = 0; m < 4; ++m) _Pragma("unroll") for (int n = 0; n < 2; ++n) _Pragma("unroll") for (int k = 0; k < 2; ++k) \
            acc[ai][bj][m][n] = __builtin_amdgcn_mfma_f32_16x16x32_bf16(Bt[n][k], At[m][k], acc[ai][bj][m][n], 0, 0, 0); } \
        __builtin_amdgcn_s_setprio(0); } while (0)
#define PG8_WAIT_V(n) asm volatile("s_waitcnt vmcnt(" #n ")" ::: "memory")
#define PG8_WAIT_L(n) asm volatile("s_waitcnt lgkmcnt(" #n ")" ::: "memory")
#define PG8_BAR __builtin_amdgcn_s_barrier()
#define PG8_SCHED __builtin_amdgcn_sched_barrier(0)
    Unit cur, nxt; int ui = 0;
    if (!S.next(0, cur)) return;
    f32x4 acc[2][2][4][2];
#pragma unroll
    for (int a = 0; a < 2; ++a)
#pragma unroll
        for (int b = 0; b < 2; ++b)
#pragma unroll
            for (int m = 0; m < 4; ++m)
#pragma unroll
                for (int n = 0; n < 2; ++n) acc[a][b][m][n] = (f32x4){0.f, 0.f, 0.f, 0.f};
    bf16x8 At[4][2], B0[2][2], B1[2][2];
    const char* cA = (const char*)g.A + (size_t)cur.pm * tstep; const char* cB = (const char*)g.Bt + (size_t)cur.pn * tstep;
    S.a_ready(cur);
    if constexpr (SP2) {
        PG8_STAGE(PG8_SB(0, 0), cB, voffB); PG8_STAGE(PG8_SB(0, 1), cB + hstep, voffB); PG8_STAGE(PG8_SA(0, 0), cA, voffA); PG8_STAGE(PG8_SA(0, 1), cA + hstep, voffA);
        if (wr == 1) PG8_BAR;
        PG8_WAIT_V(2); PG8_BAR;
        PG8_STAGE(PG8_SB(1, 0), cB + kstep, voffB); PG8_STAGE(PG8_SA(1, 0), cA + kstep, voffA); PG8_STAGE(PG8_SB(1, 1), cB + hstep + kstep, voffB);
        PG8_WAIT_V(6); PG8_BAR;
    } else {
        PG8_STAGE(PG8_SB(0, 0), cB, voffB); PG8_STAGE(PG8_SA(0, 0), cA, voffA); PG8_STAGE(PG8_SB(0, 1), cB + hstep, voffB); PG8_STAGE(PG8_SA(0, 1), cA + hstep, voffA);
        if (wr == 1) PG8_BAR;
        PG8_WAIT_V(4); PG8_BAR;
        PG8_STAGE(PG8_SB(1, 0), cB + kstep, voffB); PG8_STAGE(PG8_SA(1, 0), cA + kstep, voffA); PG8_STAGE(PG8_SB(1, 1), cB + hstep + kstep, voffB);
        PG8_WAIT_V(6); PG8_BAR;
    }
    for (;;) {
        const bool has_next = S.next(ui + 1, nxt);
        const char* nA = has_next ? (const char*)g.A + (size_t)nxt.pm * tstep : cA; const char* nB = has_next ? (const char*)g.Bt + (size_t)nxt.pn * tstep : cB;
        for (int t = 0; t < nt; t += 2) {
            const bool last = (t == nt - 2);
            const char* a1 = cA + (size_t)(t + 1) * kstep;
            const char* a2 = last ? nA : cA + (size_t)(t + 2) * kstep; const char* b2 = last ? nB : cB + (size_t)(t + 2) * kstep;
            const char* a3 = a2 + kstep; const char* b3 = b2 + kstep;
            if (last && has_next) S.a_ready(nxt);
            if constexpr (SP2) {
            PG8_LDB(B0, 0, 0); PG8_LDB(B1, 0, 1); PG8_SCHED; PG8_LDA(At, 0, 0); PG8_STAGE(PG8_SA(1, 1), a1 + hstep, voffA);
            PG8_WAIT_V(8); PG8_WAIT_L(0); PG8_BAR; PG8_MMA(0, 0, At, B0); PG8_MMA(0, 1, At, B1); PG8_BAR; PG8_SCHED;
            PG8_LDA(At, 0, 1); PG8_STAGE(PG8_SB(0, 0), b2, voffB); PG8_STAGE(PG8_SB(0, 1), b2 + hstep, voffB); PG8_STAGE(PG8_SA(0, 0), a2, voffA);
            PG8_WAIT_V(8); PG8_WAIT_L(0); PG8_BAR; PG8_MMA(1, 0, At, B0); PG8_MMA(1, 1, At, B1); PG8_BAR; PG8_SCHED;
            PG8_LDB(B0, 1, 0); PG8_LDB(B1, 1, 1); PG8_SCHED; PG8_LDA(At, 1, 0); PG8_STAGE(PG8_SA(0, 1), a2 + hstep, voffA);
            PG8_WAIT_V(8); PG8_WAIT_L(0); PG8_BAR; PG8_MMA(0, 0, At, B0); PG8_MMA(0, 1, At, B1); PG8_BAR; PG8_SCHED;
            PG8_LDA(At, 1, 1); PG8_STAGE(PG8_SB(1, 0), b3, voffB); PG8_STAGE(PG8_SB(1, 1), b3 + hstep, voffB); PG8_STAGE(PG8_SA(1, 0), a3, voffA);
            PG8_WAIT_V(8); PG8_WAIT_L(0); PG8_BAR; PG8_MMA(1, 0, At, B0); PG8_MMA(1, 1, At, B1); PG8_BAR; PG8_SCHED;
            } else {
            PG8_LDB(B0, 0, 0); PG8_SCHED; PG8_LDA(At, 0, 0); PG8_STAGE(PG8_SA(1, 1), a1 + hstep, voffA);
            PG8_WAIT_L(8); PG8_BAR; PG8_WAIT_L(0); PG8_MMA(0, 0, At, B0); PG8_BAR; PG8_SCHED;
            PG8_LDB(B1, 0, 1); PG8_STAGE(PG8_SB(0, 0), b2, voffB);
            PG8_BAR; PG8_WAIT_L(0); PG8_MMA(0, 1, At, B1); PG8_BAR;
            PG8_LDA(At, 0, 1); PG8_STAGE(PG8_SA(0, 0), a2, voffA);
            PG8_BAR; PG8_WAIT_L(0); PG8_MMA(1, 0, At, B0); PG8_BAR; PG8_SCHED;
            PG8_STAGE(PG8_SB(0, 1), b2 + hstep, voffB);
            PG8_WAIT_V(6); PG8_BAR; PG8_MMA(1, 1, At, B1); PG8_BAR;
            PG8_LDB(B0, 1, 0); PG8_SCHED; PG8_LDA(At, 1, 0); PG8_STAGE(PG8_SA(0, 1), a2 + hstep, voffA);
            PG8_WAIT_L(8); PG8_BAR; PG8_WAIT_L(0); PG8_MMA(0, 0, At, B0); PG8_BAR; PG8_SCHED;
            PG8_LDB(B1, 1, 1); PG8_STAGE(PG8_SB(1, 0), b3, voffB);
            PG8_BAR; PG8_WAIT_L(0); PG8_MMA(0, 1, At, B1); PG8_BAR;
            PG8_LDA(At, 1, 1); PG8_STAGE(PG8_SA(1, 0), a3, voffA);
            PG8_BAR; PG8_WAIT_L(0); PG8_MMA(1, 0, At, B0); PG8_BAR; PG8_SCHED;
            PG8_STAGE(PG8_SB(1, 1), b3 + hstep, voffB);
            PG8_WAIT_V(6); PG8_BAR; PG8_MMA(1, 1, At, B1); PG8_BAR;
            }
        }
        if constexpr (ALIGN_EPI) { if (wr == 0) PG8_BAR; }
        if constexpr (!Epi::AFTER_DRAIN) { E(acc, cur, wr, wc, fr, fq); S.done(cur); }
        if (!has_next) break;
#pragma unroll
        for (int a = 0; a < 2; ++a)
#pragma unroll
            for (int b = 0; b < 2; ++b)
#pragma unroll
                for (int m = 0; m < 4; ++m)
#pragma unroll
                    for (int n = 0; n < 2; ++n) acc[a][b][m][n] = (f32x4){0.f, 0.f, 0.f, 0.f};
        cur = nxt; cA = nA; cB = nB; ++ui;
        if constexpr (ALIGN_EPI) { if (wr == 1) PG8_BAR; }
    }
    PG8_WAIT_V(0);
    if constexpr (!ALIGN_EPI) { if (wr == 0) PG8_BAR; }
    PG8_BAR;
    if constexpr (Epi::AFTER_DRAIN) { E.fused(acc, cur, wr, wc, fr, fq, lds, wid, lane); S.done(cur); }
#undef PG8_SA
#undef PG8_SB
#undef PG8_STAGE
#undef PG8_LDA
#undef PG8_LDB
#undef PG8_MMA
#undef PG8_WAIT_V
#undef PG8_WAIT_L
#undef PG8_BAR
#undef PG8_SCHED
}
}
__device__ __forceinline__ float row_rstd(const float* ssq, int row) {
    const f32x4* q = (const f32x4*)(ssq + (size_t)row * 16);
    const f32x4 a = q[0], b = q[1], c = q[2], d = q[3];
    return rsqrtf(((((a.x + a.y) + (a.z + a.w)) + ((b.x + b.y) + (b.z + b.w))) + (((c.x + c.y) + (c.z + c.w)) + ((d.x + d.y) + (d.z + d.w)))) * (1.f / DM) + EPS);
}
__device__ __forceinline__ void phase1_mfma(const Params& p, LAS unsigned char* lds) {
    pg8::Gemm g{(const pg8::bf16_t*)(p.ws + OFF_XN), (const pg8::bf16_t*)(p.ws + OFF_WIN), MROWS, NIN, DM};
    pg8::EpiP1 E{P1Ptrs{p.ws, p.in[10], p.in[12]}};
    const int vcu = vcu_of_block();
    pg8::P1Order S0{(int)gridDim.x, vcu, 10, MROWS / 256, false}, S1{(int)gridDim.x, vcu, 4, MROWS / 256, true};
    pg8::gemm_phase<pg8::EpiP1, pg8::P1Order, true, true, false>(lds, g, S0, E);
    pg8::gemm_phase<pg8::EpiP1, pg8::P1Order, true, true, true>(lds, g, S1, E);
    const int G = (int)gridDim.x, nun = MROWS / 256;
    const int mine = (10 * nun - vcu + G - 1) / G + (4 * nun - (G - 1 - vcu) + G - 1) / G, most = (10 * nun + G - 1) / G + 1;
    if (mine < most) {
        unsigned* ctr = (unsigned*)(p.ws + OFF_CTL) + 128;
        for (int k = 0; k < 3; ++k) {
            __syncthreads();
            if (threadIdx.x == 0) *(LAS unsigned*)(lds + LDS_Q) = atomicAdd(ctr, 1u);
            __syncthreads();
            const int c = (int)*(LAS unsigned*)(lds + LDS_Q);
            if (c >= CV_ITEMS) break;
            conv_item(p, (unsigned char*)lds, c);
        }
    }
}
__device__ __forceinline__ void phase3_mfma(const Params& p, LAS unsigned char* lds) {
    pg8::Gemm g{(const pg8::bf16_t*)(p.ws + OFF_MIX), (const pg8::bf16_t*)(p.ws + OFF_WOUT), NTOK, DM, DM};
    pg8::StaticOrder S; S.init(NTOK, DM, (int)gridDim.x, (int)blockIdx.x);
    pg8::EpiP3 E{p.in[0], p.out, (bf16_t*)(p.ws + OFF_H2B), (float*)(p.ws + OFF_SSQP)};
    pg8::gemm_phase<pg8::EpiP3, pg8::StaticOrder, true, true>(lds, g, S, E);
}

typedef float f32x16 __attribute__((ext_vector_type(16)));
constexpr int AT_KROW = 272, AT_VROW = 144, AT_KBYTES = 64 * AT_KROW, AT_VBYTES = 128 * AT_VROW, AT_STAGE = AT_KBYTES + AT_VBYTES;
__device__ __forceinline__ void attn_item(const Params& p, LAS unsigned char* lds, int item) {
    const int tid = threadIdx.x, lane = tid & 63, wave = __builtin_amdgcn_readfirstlane(tid >> 6), qg = wave >> 1, c = wave & 1, l31 = lane & 31, hh = lane >> 5;
    const int qt = item & 15, h = (item >> 4) & 3, b = item >> 6;
    const int r0 = b * SEQ + qt * 128;
    const bf16_t* QB = (const bf16_t*)(p.ws + OFF_QB); const bf16_t* KB = (const bf16_t*)(p.ws + OFF_KB); const bf16_t* VT = (const bf16_t*)(p.ws + OFF_VT);
    bf16x8 qf[4];
    {
        const bf16_t* qp = QB + (size_t)(r0 + qg * 32 + l31) * 512 + h * 128 + c * 64 + 8 * hh;
#pragma unroll
        for (int s = 0; s < 4; ++s) qf[s] = *(const bf16x8*)(qp + 16 * s);
    }
    f32x16 O[4];
#pragma unroll
    for (int i = 0; i < 4; ++i)
#pragma unroll
        for (int r = 0; r < 16; ++r) O[i][r] = 0.f;
    float m = 0.f, l = 0.f;
    const int kq0 = tid, kq1 = tid + 512;
    const bf16_t* kg0 = KB + (size_t)(kq0 >> 4) * 512 + h * 128 + (kq0 & 15) * 8; const bf16_t* kg1 = KB + (size_t)(kq1 >> 4) * 512 + h * 128 + (kq1 & 15) * 8;
    const bf16_t* vg0 = VT + (size_t)(h * 128 + (kq0 >> 3)) * MROWS + (kq0 & 7) * 8; const bf16_t* vg1 = VT + (size_t)(h * 128 + (kq1 >> 3)) * MROWS + (kq1 & 7) * 8;
    const int kl0 = (kq0 >> 4) * AT_KROW + (kq0 & 15) * 16, kl1 = (kq1 >> 4) * AT_KROW + (kq1 & 15) * 16;
    const int vl0 = AT_KBYTES + (kq0 >> 3) * AT_VROW + ((kq0 & 7) >> 1) * 32 + (kq0 & 1) * 8, vl1 = AT_KBYTES + (kq1 >> 3) * AT_VROW + ((kq1 & 7) >> 1) * 32 + (kq1 & 1) * 8;
    u32x4 kr0, kr1, vr0, vr1;
#define AT_LOAD(t) do { const size_t kro = (size_t)((t) < 32 ? b * SEQ + (t) * 64 : NTOK); \
        kr0 = *(const u32x4*)(kg0 + kro * 512); kr1 = *(const u32x4*)(kg1 + kro * 512); vr0 = *(const u32x4*)(vg0 + kro); vr1 = *(const u32x4*)(vg1 + kro); } while (0)
#define AT_WRITE(buf) do { LAS unsigned char* _b = lds + (buf) * AT_STAGE; \
        *(LAS u32x4*)(_b + kl0) = kr0; *(LAS u32x4*)(_b + kl1) = kr1; \
        *(LAS u32x2*)(_b + vl0) = (u32x2){vr0.x, vr0.y}; *(LAS u32x2*)(_b + vl0 + 16) = (u32x2){vr0.z, vr0.w}; \
        *(LAS u32x2*)(_b + vl1) = (u32x2){vr1.x, vr1.y}; *(LAS u32x2*)(_b + vl1 + 16) = (u32x2){vr1.z, vr1.w}; } while (0)
    __syncthreads();
    AT_LOAD(0); AT_WRITE(0);
    __syncthreads();
    for (int t = 0; t < 33; ++t) {
        if (t + 1 < 33) AT_LOAD(t + 1);
        const LAS unsigned char* kb_ = lds + (t & 1) * AT_STAGE; const LAS unsigned char* vb_ = kb_ + AT_KBYTES;
        f32x16 s0, s1;
#pragma unroll
        for (int r = 0; r < 16; ++r) { s0[r] = -m; s1[r] = -m; }
#pragma unroll
        for (int s = 0; s < 4; ++s) {
            const bf16x8 k0 = *(const LAS bf16x8*)(kb_ + l31 * AT_KROW + (c * 64 + 16 * s + 8 * hh) * 2);
            s0 = __builtin_amdgcn_mfma_f32_32x32x16_bf16(k0, qf[s], s0, 0, 0, 0);
        }
#pragma unroll
        for (int s = 0; s < 4; ++s) {
            const bf16x8 k1 = *(const LAS bf16x8*)(kb_ + (32 + l31) * AT_KROW + (c * 64 + 16 * s + 8 * hh) * 2);
            s1 = __builtin_amdgcn_mfma_f32_32x32x16_bf16(k1, qf[s], s1, 0, 0, 0);
        }
        if (t == 32) {
#pragma unroll
            for (int r = 0; r < 16; ++r) { const int key = (r & 3) + 8 * (r >> 2) + 4 * hh; if (key >= 16) s0[r] = -1e30f; s1[r] = -1e30f; }
        }
        float mx = s0[0];
#pragma unroll
        for (int r = 1; r < 16; ++r) mx = fmaxf(mx, s0[r]);
#pragma unroll
        for (int r = 0; r < 16; ++r) mx = fmaxf(mx, s1[r]);
        mx = fmaxf(mx, __shfl_xor(mx, 32));
        if (t == 0 || __any(mx > 8.0f)) {
            const float d = t == 0 ? mx : fmaxf(mx, 0.f), alpha = __builtin_amdgcn_exp2f(-d);
            m += d; l *= alpha;
#pragma unroll
            for (int i = 0; i < 4; ++i) O[i] = O[i] * alpha;
#pragma unroll
            for (int r = 0; r < 16; ++r) { s0[r] -= d; s1[r] -= d; }
        }
        float ps = 0.f;
#define AT_PV(SREG, kb) do { \
        _Pragma("unroll") for (int r = 0; r < 16; ++r) { SREG[r] = __builtin_amdgcn_exp2f(SREG[r]); ps += SREG[r]; } \
        bf16x8 pf0, pf1; \
        { u32x4 a; a.x = pk2(SREG[0], SREG[1]); a.y = pk2(SREG[2], SREG[3]); a.z = pk2(SREG[4], SREG[5]); a.w = pk2(SREG[6], SREG[7]); pf0 = __builtin_bit_cast(bf16x8, a); \
          u32x4 bq; bq.x = pk2(SREG[8], SREG[9]); bq.y = pk2(SREG[10], SREG[11]); bq.z = pk2(SREG[12], SREG[13]); bq.w = pk2(SREG[14], SREG[15]); pf1 = __builtin_bit_cast(bf16x8, bq); } \
        _Pragma("unroll") for (int vb = 0; vb < 4; ++vb) { \
            const LAS unsigned char* vp = vb_ + (vb * 32 + l31) * AT_VROW + (kb) * 64 + hh * 16; \
            O[vb] = __builtin_amdgcn_mfma_f32_32x32x16_bf16(*(const LAS bf16x8*)vp, pf0, O[vb], 0, 0, 0); \
            O[vb] = __builtin_amdgcn_mfma_f32_32x32x16_bf16(*(const LAS bf16x8*)(vp + 32), pf1, O[vb], 0, 0, 0); } } while (0)
        AT_PV(s0, 0);
        AT_PV(s1, 1);
#undef AT_PV
        l += ps;
        if (t + 1 < 33) AT_WRITE((t + 1) & 1);
        __syncthreads();
    }
    const float inv = 1.f / (l + __shfl_xor(l, 32));
    LAS float* X = (LAS float*)lds + qg * 4096;
    if (c == 1) {
#pragma unroll
        for (int vb = 0; vb < 4; ++vb)
#pragma unroll
            for (int r = 0; r < 16; ++r) X[(vb * 16 + r) * 64 + lane] = O[vb][r] * inv;
    }
    __syncthreads();
    if (c == 0) {
        const float lam = ((const float*)(p.ws + OFF_MISC))[0];
        float ss = 0.f;
#pragma unroll
        for (int vb = 0; vb < 4; ++vb)
#pragma unroll
            for (int r = 0; r < 16; ++r) { const float y = O[vb][r] * inv - lam * X[(vb * 16 + r) * 64 + lane]; O[vb][r] = y; ss += y * y; }
        ss += __shfl_xor(ss, 32);
        const float rs = rsqrtf(ss * (1.f / 128.f) + EPS) * 0.8f;
        bf16_t* orow = (bf16_t*)(p.ws + OFF_MIX) + (size_t)(r0 + qg * 32 + l31) * DM + h * 128;
#pragma unroll
        for (int vb = 0; vb < 4; ++vb)
#pragma unroll
            for (int rq = 0; rq < 4; ++rq) {
                const int v0 = vb * 32 + 8 * rq + 4 * hh;
                const f32x4 wlo = *(const f32x4*)(p.in[8] + vb * 32 + 8 * rq), whi = *(const f32x4*)(p.in[8] + vb * 32 + 8 * rq + 4);
                const f32x4 w = hh ? whi : wlo;
                u32x2 o; o.x = pk2(O[vb][4 * rq] * rs * w.x, O[vb][4 * rq + 1] * rs * w.y); o.y = pk2(O[vb][4 * rq + 2] * rs * w.z, O[vb][4 * rq + 3] * rs * w.w);
                *(u32x2*)(orow + v0) = o;
            }
    }
#undef AT_LOAD
#undef AT_WRITE
}
__device__ __forceinline__ void phase2_attn_mfma(const Params& p, LAS unsigned char* lds) {
    for (int it = vcu_of_block(); it < NB * 4 * 16; it += gridDim.x) attn_item(p, lds, it);
}


__device__ __forceinline__ int gsw(int row, int chunk) { return row * 128 + ((chunk ^ (row & 7)) << 4); }
constexpr int GL_SET = 40960;
constexpr int GL_QS = 0, GL_KS = 8192, GL_KT = 16384, GL_VT = 24576, GL_AT = 2 * GL_SET, GL_ST = GL_AT + 8192  , GL_DV = GL_ST + 32768  ;
__device__ __forceinline__ float dpp_scan64(float v) {
    v += __builtin_bit_cast(float, __builtin_amdgcn_update_dpp(0, __builtin_bit_cast(int, v), 0x111, 0xf, 0xf, false));
    v += __builtin_bit_cast(float, __builtin_amdgcn_update_dpp(0, __builtin_bit_cast(int, v), 0x112, 0xf, 0xf, false));
    v += __builtin_bit_cast(float, __builtin_amdgcn_update_dpp(0, __builtin_bit_cast(int, v), 0x114, 0xf, 0xf, false));
    v += __builtin_bit_cast(float, __builtin_amdgcn_update_dpp(0, __builtin_bit_cast(int, v), 0x118, 0xf, 0xf, false));
    v += __builtin_bit_cast(float, __builtin_amdgcn_update_dpp(0, __builtin_bit_cast(int, v), 0x142, 0xa, 0xf, false));
    v += __builtin_bit_cast(float, __builtin_amdgcn_update_dpp(0, __builtin_bit_cast(int, v), 0x143, 0xc, 0xf, false));
    return v;
}
struct GlaPre { f32x4 g0, g1; u32x4 q8, k8, v0, v1; };
struct GlaCtx { const bf16_t* GQ; const bf16_t* GK; const bf16_t* GVT; const float* G; bf16_t* O; int dir, h, b, nsteps, lane, wave, l15, g, vdv, vch; };
__device__ __forceinline__ int gla_rowbase(const GlaCtx& c, int st) { return c.dir ? c.b * SEQ + (31 - st) * 64 : (st == 0 ? NTOK : c.b * SEQ + (st - 1) * 64); }
__device__ __forceinline__ void gla_load(const GlaCtx& c, GlaPre& r, int st) {
    const int rb = gla_rowbase(c, st); const size_t row = (size_t)(rb + c.lane);
    r.g0 = *(const f32x4*)(c.G + row * 256 + c.h * 64 + 8 * c.wave); r.g1 = *(const f32x4*)(c.G + row * 256 + c.h * 64 + 8 * c.wave + 4);
    r.q8 = *(const u32x4*)(c.GQ + row * 256 + c.h * 64 + 8 * c.wave); r.k8 = *(const u32x4*)(c.GK + row * 256 + c.h * 64 + 8 * c.wave);
    r.v0 = *(const u32x4*)(c.GVT + (size_t)(c.h * 128 + c.vdv) * MROWS + rb + c.vch * 8); r.v1 = *(const u32x4*)(c.GVT + (size_t)(c.h * 128 + c.vdv) * MROWS + rb + c.vch * 8 + 8);
}
__device__ __forceinline__ void gla_step(const GlaCtx& c, LAS unsigned char* lds, GlaPre& r, f32x4 (&accS)[4], int st) {
    const int lane = c.lane, wave = c.wave, l15 = c.l15, g = c.g, dir = c.dir;
    const bool meta = (dir == 0 && st == 0);
    const int rowbase = gla_rowbase(c, st);
    LAS unsigned char* sb = lds + (st & 1) * GL_SET;
    float gg[8] = {r.g0.x, r.g0.y, r.g0.z, r.g0.w, r.g1.x, r.g1.y, r.g1.z, r.g1.w};
    if (meta && lane >= NMETA) {
#pragma unroll
        for (int e = 0; e < 8; ++e) gg[e] = 0.f;
    }
    const u32x4 q8 = r.q8, k8 = r.k8;
    float qv[8] = {bflo(q8.x), bfhi(q8.x), bflo(q8.y), bfhi(q8.y), bflo(q8.z), bfhi(q8.z), bflo(q8.w), bfhi(q8.w)};
    float kv[8] = {bflo(k8.x), bfhi(k8.x), bflo(k8.y), bfhi(k8.y), bflo(k8.z), bfhi(k8.z), bflo(k8.w), bfhi(k8.w)};
    float qn[8], kn[8], ks[8];
#pragma unroll
    for (int e = 0; e < 8; ++e) {
        const float P = dpp_scan64(gg[e]);
        const float T = __builtin_bit_cast(float, __builtin_amdgcn_readlane(__builtin_bit_cast(int, P), 63));
        const float Bv = dir ? (T - P + gg[e]) : P;
        const float eb = __expf(Bv), en = __builtin_amdgcn_rcpf(eb), eT = __expf(T);
        qn[e] = qv[e] * eb; kn[e] = kv[e] * en; ks[e] = kn[e] * eT;
        if (lane == 0) *(LAS float*)(lds + GL_DV + (st & 1) * 256 + (8 * wave + e) * 4) = eT;
    }
    *(LAS u32x4*)(sb + GL_QS + gsw(lane, wave)) = (u32x4){pk2(qn[0], qn[1]), pk2(qn[2], qn[3]), pk2(qn[4], qn[5]), pk2(qn[6], qn[7])};
    *(LAS u32x4*)(sb + GL_KS + gsw(lane, wave)) = (u32x4){pk2(kn[0], kn[1]), pk2(kn[2], kn[3]), pk2(kn[4], kn[5]), pk2(kn[6], kn[7])};
#pragma unroll
    for (int e = 0; e < 8; e += 2) { const unsigned w = pk2(ks[e], ks[e + 1]);
        *(LAS unsigned short*)(sb + GL_KT + gsw(8 * wave + e, lane >> 3) + (lane & 7) * 2) = (unsigned short)w;
        *(LAS unsigned short*)(sb + GL_KT + gsw(8 * wave + e + 1, lane >> 3) + (lane & 7) * 2) = (unsigned short)(w >> 16); }
    *(LAS u32x4*)(sb + GL_VT + gsw(c.vdv, c.vch)) = r.v0; *(LAS u32x4*)(sb + GL_VT + gsw(c.vdv, c.vch + 1)) = r.v1;
    if (st + 2 < c.nsteps) gla_load(c, r, st + 2);
    __syncthreads();
    const LAS unsigned char* STo = lds + GL_ST + (st & 1) * 16384; LAS unsigned char* STn = lds + GL_ST + ((st + 1) & 1) * 16384;
    if (!meta) {
        const int jb = wave >> 1;
#pragma unroll
        for (int ii = 0; ii < 2; ++ii) {
            const int ib = 2 * (wave & 1) + ii;
            f32x4 a = (f32x4){0.f, 0.f, 0.f, 0.f};
            const bool live = dir ? (jb >= ib) : (jb <= ib);
            if (live) {
#pragma unroll
                for (int ks2 = 0; ks2 < 2; ++ks2) {
                    const bf16x8 kf = *(const LAS bf16x8*)(sb + GL_KS + gsw(jb * 16 + l15, ks2 * 4 + g));
                    const bf16x8 qf = *(const LAS bf16x8*)(sb + GL_QS + gsw(ib * 16 + l15, ks2 * 4 + g));
                    a = __builtin_amdgcn_mfma_f32_16x16x32_bf16(kf, qf, a, 0, 0, 0);
                }
                const int i = ib * 16 + l15, j0 = jb * 16 + 4 * g;
#pragma unroll
                for (int rr = 0; rr < 4; ++rr) { const bool keep = dir ? (j0 + rr >= i) : (j0 + rr <= i); a[rr] = keep ? a[rr] : 0.f; }
            }
            const int i = ib * 16 + l15, j0 = jb * 16 + 4 * g;
            *(LAS u32x2*)(lds + GL_AT + gsw(i, j0 >> 3) + (j0 & 7) * 2) = (u32x2){pk2(a[0], a[1]), pk2(a[2], a[3])};
        }
    }
    if (st + 1 < c.nsteps) {
#pragma unroll
        for (int kb = 0; kb < 4; ++kb) {
            const f32x4 dvv = *(const LAS f32x4*)(lds + GL_DV + (st & 1) * 256 + (kb * 16 + 4 * g) * 4);
            f32x4 a = accS[kb] * dvv;
#pragma unroll
            for (int ks2 = 0; ks2 < 2; ++ks2) {
                const bf16x8 kf = *(const LAS bf16x8*)(sb + GL_KT + gsw(kb * 16 + l15, ks2 * 4 + g));
                const bf16x8 vf = *(const LAS bf16x8*)(sb + GL_VT + gsw(wave * 16 + l15, ks2 * 4 + g));
                a = __builtin_amdgcn_mfma_f32_16x16x32_bf16(kf, vf, a, 0, 0, 0);
            }
            accS[kb] = a;
            const int dk0 = kb * 16 + 4 * g;
            *(LAS u32x2*)(STn + gsw(wave * 16 + l15, dk0 >> 3) + (dk0 & 7) * 2) = (u32x2){pk2(a[0], a[1]), pk2(a[2], a[3])};
        }
    }
    __syncthreads();
    if (!meta) {
#pragma unroll
        for (int ib = 0; ib < 4; ++ib) {
            f32x4 a = (f32x4){0.f, 0.f, 0.f, 0.f};
#pragma unroll
            for (int ks2 = 0; ks2 < 2; ++ks2) {
                const bf16x8 vf = *(const LAS bf16x8*)(sb + GL_VT + gsw(wave * 16 + l15, ks2 * 4 + g));
                const bf16x8 af = *(const LAS bf16x8*)(lds + GL_AT + gsw(ib * 16 + l15, ks2 * 4 + g));
                a = __builtin_amdgcn_mfma_f32_16x16x32_bf16(vf, af, a, 0, 0, 0);
                const bf16x8 sf = *(const LAS bf16x8*)(STo + gsw(wave * 16 + l15, ks2 * 4 + g));
                const bf16x8 qf = *(const LAS bf16x8*)(sb + GL_QS + gsw(ib * 16 + l15, ks2 * 4 + g));
                a = __builtin_amdgcn_mfma_f32_16x16x32_bf16(sf, qf, a, 0, 0, 0);
            }
            *(u32x2*)(c.O + (size_t)(rowbase + ib * 16 + l15) * 512 + c.h * 128 + wave * 16 + 4 * g) = (u32x2){pk2(a[0], a[1]), pk2(a[2], a[3])};
        }
    }
}
__device__ __forceinline__ void gla_chain(const Params& p, LAS unsigned char* lds, int item) {
    const int tid = threadIdx.x;
    GlaCtx c;
    c.lane = tid & 63; c.wave = __builtin_amdgcn_readfirstlane(tid >> 6); c.l15 = c.lane & 15; c.g = c.lane >> 4;
    c.dir = item & 1; c.h = (item >> 1) & 3; c.b = item >> 3;
    c.GQ = (const bf16_t*)(p.ws + OFF_GQ); c.GK = (const bf16_t*)(p.ws + OFF_GK); c.GVT = (const bf16_t*)(p.ws + OFF_GVT);
    c.G = (const float*)(p.ws + (c.dir ? OFF_GB : OFF_GF));
    c.O = (bf16_t*)p.out + (c.dir ? (size_t)NTOK * 512 : 0);
    c.nsteps = c.dir ? 32 : 33; c.vdv = tid >> 2; c.vch = (tid & 3) * 2;
    f32x4 accS[4];
#pragma unroll
    for (int i = 0; i < 4; ++i) accS[i] = (f32x4){0.f, 0.f, 0.f, 0.f};
    __syncthreads();
    *(LAS u32x4*)(lds + GL_ST + tid * 32) = (u32x4){0u, 0u, 0u, 0u}; *(LAS u32x4*)(lds + GL_ST + tid * 32 + 16) = (u32x4){0u, 0u, 0u, 0u};
    GlaPre X, Y;
    gla_load(c, X, 0); gla_load(c, Y, 1);
    for (int st = 0; st < c.nsteps; st += 2) {
        gla_step(c, lds, X, accS, st);
        if (st + 1 < c.nsteps) gla_step(c, lds, Y, accS, st + 1);
    }
    asm volatile("s_waitcnt vmcnt(0)" ::: "memory");
    __syncthreads();
    if (tid == 0) {
        __builtin_amdgcn_fence(__ATOMIC_RELEASE, "agent");
        asm volatile("s_waitcnt vmcnt(0)" ::: "memory");
        __hip_atomic_fetch_add((unsigned*)(p.ws + OFF_CTL) + 4096 + (item >> 1) * 64, 1u, __ATOMIC_RELAXED, __HIP_MEMORY_SCOPE_AGENT);
    }
}
__device__ __forceinline__ void gla_combine_item(const Params& p, LAS unsigned char* lds, int item) {
    const int tid = threadIdx.x, lane = tid & 63, wave = tid >> 6;
    const int bh = item >> 3, part = item & 7, b = bh >> 2, h = bh & 3;
    if (tid == 0) {
        unsigned* flag = (unsigned*)(p.ws + OFF_CTL) + 4096 + bh * 64;
        unsigned spins = 0;
        while (__hip_atomic_load(flag, __ATOMIC_RELAXED, __HIP_MEMORY_SCOPE_AGENT) < 2u) { __builtin_amdgcn_s_sleep(8); if (++spins > (1u << 22)) break; }
        __builtin_amdgcn_fence(__ATOMIC_ACQUIRE, "agent");
        asm volatile("s_waitcnt vmcnt(0)" ::: "memory");
    }
    __syncthreads();
    const bf16_t* GR = (const bf16_t*)(p.ws + OFF_GR); bf16_t* MIX = (bf16_t*)(p.ws + OFF_MIX);
    const bf16_t* OF = (const bf16_t*)p.out; const bf16_t* OBk = OF + (size_t)NTOK * 512;
    const int c0 = h * 128 + (lane & 15) * 8;
    const f32x4 w0 = *(const f32x4*)(p.in[13] + (lane & 15) * 8), w1 = *(const f32x4*)(p.in[13] + (lane & 15) * 8 + 4);
#pragma unroll 2
    for (int i = 0; i < 8; ++i) {
        const int r = b * SEQ + part * 256 + wave * 32 + i * 4 + (lane >> 4);
        const u32x4 a = *(const u32x4*)(OF + (size_t)r * 512 + c0), bq = *(const u32x4*)(OBk + (size_t)r * 512 + c0);
        const f32x4 x0 = (f32x4){bflo(a.x) + bflo(bq.x), bfhi(a.x) + bfhi(bq.x), bflo(a.y) + bflo(bq.y), bfhi(a.y) + bfhi(bq.y)};
        const f32x4 x1 = (f32x4){bflo(a.z) + bflo(bq.z), bfhi(a.z) + bfhi(bq.z), bflo(a.w) + bflo(bq.w), bfhi(a.w) + bfhi(bq.w)};
        float s = x0.x * x0.x + x0.y * x0.y + x0.z * x0.z + x0.w * x0.w + x1.x * x1.x + x1.y * x1.y + x1.z * x1.z + x1.w * x1.w;
        s += __shfl_xor(s, 1); s += __shfl_xor(s, 2); s += __shfl_xor(s, 4); s += __shfl_xor(s, 8);
        const float rs = rsqrtf(s * (1.f / 128.f) + EPS);
        const u32x4 g = *(const u32x4*)(GR + (size_t)r * 512 + c0);
        u32x4 o;
        o.x = pk2(x0.x * rs * w0.x * bflo(g.x), x0.y * rs * w0.y * bfhi(g.x)); o.y = pk2(x0.z * rs * w0.z * bflo(g.y), x0.w * rs * w0.w * bfhi(g.y));
        o.z = pk2(x1.x * rs * w1.x * bflo(g.z), x1.y * rs * w1.y * bfhi(g.z)); o.w = pk2(x1.z * rs * w1.z * bflo(g.w), x1.w * rs * w1.w * bfhi(g.w));
        *(u32x4*)(MIX + (size_t)r * DM + 512 + c0) = o;
    }
}

__device__ __forceinline__ void phase2(const Params& p, LAS unsigned char* lds, int qslot = 0) {
    unsigned* ctr = (unsigned*)(p.ws + OFF_CTL) + (qslot >= 2 ? 2048 + qslot * 64 : qslot * 64);
    int it;
#define P2_NEXT() do { __syncthreads(); if (threadIdx.x == 0) *(LAS unsigned*)(lds + LDS_Q) = atomicAdd(ctr, 1u); __syncthreads(); it = (int)*(LAS unsigned*)(lds + LDS_Q); } while (0)
    P2_NEXT();
    if (qslot != 3) { while (it < 64) { gla_chain(p, lds, it); P2_NEXT(); } }
    if (qslot == 2) return;
    if (qslot == 3) it += 64;
    while (it < 64 + NB * 4 * 16) { attn_item(p, lds, it - 64); P2_NEXT(); if (qslot == 3) it += 64; }
    if (qslot) return;
    for (;;) {
        __syncthreads();
        if (threadIdx.x == 0) *(LAS unsigned*)(lds + LDS_Q) = atomicAdd(ctr + 192, 1u);
        __syncthreads();
        const int c = (int)*(LAS unsigned*)(lds + LDS_Q);
        if (c >= 256) break;
        gla_combine_item(p, lds, c);
    }
    for (;;) {
        __syncthreads();
        if (threadIdx.x == 0) *(LAS unsigned*)(lds + LDS_Q) = atomicAdd(ctr + 128, 1u);
        __syncthreads();
        const int c = (int)*(LAS unsigned*)(lds + LDS_Q);
        if (c >= CV_ITEMS) break;
        conv_item(p, (unsigned char*)lds, c);
    }
#undef P2_NEXT
}

__device__ __forceinline__ void phase2c(const Params& p) {
    const int tid = threadIdx.x, lane = tid & 63, wave = tid >> 6;
    const int gw = blockIdx.x * 8 + wave, NGW = gridDim.x * 8;
    const bf16_t* GR = (const bf16_t*)(p.ws + OFF_GR); bf16_t* MIX = (bf16_t*)(p.ws + OFF_MIX);
    const bf16_t* OF = (const bf16_t*)p.out; const bf16_t* OBk = OF + (size_t)NTOK * 512;
    const int c0 = lane * 8;
    const f32x4 w0 = *(const f32x4*)(p.in[13] + (c0 & 127)), w1 = *(const f32x4*)(p.in[13] + (c0 & 127) + 4);
    for (int r = gw; r < NTOK; r += NGW) {
        const u32x4 a = *(const u32x4*)(OF + (size_t)r * 512 + c0), bq = *(const u32x4*)(OBk + (size_t)r * 512 + c0);
        const f32x4 x0 = (f32x4){bflo(a.x) + bflo(bq.x), bfhi(a.x) + bfhi(bq.x), bflo(a.y) + bflo(bq.y), bfhi(a.y) + bfhi(bq.y)};
        const f32x4 x1 = (f32x4){bflo(a.z) + bflo(bq.z), bfhi(a.z) + bfhi(bq.z), bflo(a.w) + bflo(bq.w), bfhi(a.w) + bfhi(bq.w)};
        float s = x0.x * x0.x + x0.y * x0.y + x0.z * x0.z + x0.w * x0.w + x1.x * x1.x + x1.y * x1.y + x1.z * x1.z + x1.w * x1.w;
        s += __shfl_xor(s, 1); s += __shfl_xor(s, 2); s += __shfl_xor(s, 4); s += __shfl_xor(s, 8);
        const float rs = rsqrtf(s * (1.f / 128.f) + EPS);
        const u32x4 g = *(const u32x4*)(GR + (size_t)r * 512 + c0);
        u32x4 o;
        o.x = pk2(x0.x * rs * w0.x * bflo(g.x), x0.y * rs * w0.y * bfhi(g.x)); o.y = pk2(x0.z * rs * w0.z * bflo(g.y), x0.w * rs * w0.w * bfhi(g.y));
        o.z = pk2(x1.x * rs * w1.x * bflo(g.z), x1.y * rs * w1.y * bfhi(g.z)); o.w = pk2(x1.z * rs * w1.z * bflo(g.w), x1.w * rs * w1.w * bfhi(g.w));
        *(u32x4*)(MIX + (size_t)r * DM + 512 + c0) = o;
    }
}


#define TOPK_INS(L, x) do { float _x = (x); _Pragma("unroll") for (int _s = 0; _s < 16; ++_s) { const float _t = fmaxf(L[_s], _x); _x = fminf(L[_s], _x); L[_s] = _t; } } while (0)
constexpr int P4_QROW = 528, P4_SC0 = 128 * P4_QROW  , P4_TLROW = 144;

#define CE_DESC(a, b) do { const float _hi = fmaxf(a, b), _lo = fminf(a, b); a = _hi; b = _lo; } while (0)
__device__ __forceinline__ void bitonic_sort16_desc(float (&x)[16]) {
#pragma unroll
    for (int k = 2; k <= 16; k <<= 1)
#pragma unroll
        for (int j = k >> 1; j > 0; j >>= 1)
#pragma unroll
            for (int i = 0; i < 16; ++i) { const int l = i ^ j; if (l > i) { if ((i & k) == 0) CE_DESC(x[i], x[l]); else CE_DESC(x[l], x[i]); } }
}
__device__ __forceinline__ void bitonic_merge16_desc(float (&x)[16]) {
#pragma unroll
    for (int j = 8; j > 0; j >>= 1)
#pragma unroll
        for (int i = 0; i < 16; ++i) { const int l = i ^ j; if (l > i) CE_DESC(x[i], x[l]); }
}
__device__ __forceinline__ void top16_merge(float (&L)[16], const float (&x)[16]) {
#pragma unroll
    for (int i = 0; i < 16; ++i) L[i] = fmaxf(L[i], x[15 - i]);
    bitonic_merge16_desc(L);
}

template <int Q> struct CandIJ {
    static constexpr int compute() { int c = 0; for (int i = 0; i < 16; ++i) for (int j = 0; j < 16; ++j) if ((i + 1) * (j + 1) <= 16) { if (c == Q) return i * 16 + j; ++c; } return -1; }
    static constexpr int v = compute();
};
template <int G, int S> __device__ __forceinline__ void cand_fill(float (&x)[16], const float (&A)[16], const float (&Bv)[16]) {
    constexpr int ij = CandIJ<G * 16 + S>::v;
    if constexpr (ij >= 0) x[S] = __uint_as_float((__float_as_uint(A[ij >> 4] + Bv[ij & 15]) & ~255u) | (unsigned)ij); else x[S] = -3.0e38f;
    if constexpr (S + 1 < 16) cand_fill<G, S + 1>(x, A, Bv);
}
__device__ __forceinline__ void p4_route_half(const Params& p, LAS unsigned char* lds, int m0, int h) {
    int tid_ = threadIdx.x; asm volatile("" : "+v"(tid_));
    const int tid = tid_, lane = tid & 63, wave = __builtin_amdgcn_readfirstlane(tid >> 6), l15 = lane & 15, g = lane >> 4;
    const bf16_t* KEYS = (const bf16_t*)(p.ws + OFF_KEYS); unsigned* PW0 = (unsigned*)(p.ws + OFF_PW0);
        {
            const int wr = wave >> 1, wk = wave & 1;
            f32x4 sc[2][2][4];
#pragma unroll
            for (int pp = 0; pp < 2; ++pp) {
#pragma unroll
                for (int rb = 0; rb < 2; ++rb)
#pragma unroll
                    for (int kk = 0; kk < 4; ++kk) sc[pp][rb][kk] = (f32x4){0.f, 0.f, 0.f, 0.f};
                const bf16_t* kbase = KEYS + (size_t)((h * 2 + pp) * 128 + 64 * wk + l15) * 128 + 8 * g;
#pragma unroll
                for (int ks = 0; ks < 4; ++ks) {
                    bf16x8 qf[2], kf[4];
#pragma unroll
                    for (int rb = 0; rb < 2; ++rb) qf[rb] = *(const LAS bf16x8*)(lds + (32 * wr + 16 * rb + l15) * P4_QROW + (pp * 128 + ks * 32 + 8 * g) * 2);
#pragma unroll
                    for (int kk = 0; kk < 4; ++kk) kf[kk] = *(const bf16x8*)(kbase + (size_t)(16 * kk) * 128 + ks * 32);
#pragma unroll
                    for (int rb = 0; rb < 2; ++rb)
#pragma unroll
                        for (int kk = 0; kk < 4; ++kk) sc[pp][rb][kk] = __builtin_amdgcn_mfma_f32_16x16x32_bf16(kf[kk], qf[rb], sc[pp][rb][kk], 0, 0, 0);
                }
            }
#pragma unroll
            for (int rb = 0; rb < 2; ++rb)
#pragma unroll
                for (int kk = 0; kk < 4; ++kk) *(LAS f32x4*)(lds + P4_SC0 + (32 * wr + 16 * rb + l15) * P4_QROW + (64 * wk + 16 * kk + 4 * g) * 4) = sc[0][rb][kk];
            __syncthreads();
#pragma unroll
            for (int rb = 0; rb < 2; ++rb)
#pragma unroll
                for (int kk = 0; kk < 4; ++kk) *(LAS f32x4*)(lds + (32 * wr + 16 * rb + l15) * P4_QROW + (64 * wk + 16 * kk + 4 * g) * 4) = sc[1][rb][kk];
        }
        __syncthreads();
        {
            const int hf = tid & 1, row = (tid >> 1) & 127, pp = tid >> 8;
            const LAS unsigned char* sp = lds + (pp ? 0 : P4_SC0) + row * P4_QROW + hf * 256;
            float L[16];
#pragma unroll
            for (int grp = 0; grp < 4; ++grp) {
                float x[16];
#pragma unroll
                for (int q4 = 0; q4 < 4; ++q4) {
                    const f32x4 v = *(const LAS f32x4*)(sp + (grp * 4 + q4) * 16);
                    const unsigned kb = (unsigned)(hf * 64 + grp * 16 + q4 * 4);
                    x[4 * q4 + 0] = __uint_as_float((__float_as_uint(v.x) & ~127u) | kb);
                    x[4 * q4 + 1] = __uint_as_float((__float_as_uint(v.y) & ~127u) | (kb + 1));
                    x[4 * q4 + 2] = __uint_as_float((__float_as_uint(v.z) & ~127u) | (kb + 2));
                    x[4 * q4 + 3] = __uint_as_float((__float_as_uint(v.w) & ~127u) | (kb + 3));
                }
                bitonic_sort16_desc(x);
                if (grp == 0) {
#pragma unroll
                    for (int s = 0; s < 16; ++s) L[s] = x[s];
                } else top16_merge(L, x);
            }
            {
                float Oth[16];
#pragma unroll
                for (int s = 0; s < 16; ++s) Oth[s] = __shfl_xor(L[s], 1);
                top16_merge(L, Oth);
            }
            __syncthreads();
            if (hf == 0) {
                LAS f32x4* tl = (LAS f32x4*)(lds + P4_SC0 + row * (2 * P4_TLROW) + pp * P4_TLROW);
                tl[0] = (f32x4){L[0], L[1], L[2], L[3]}; tl[1] = (f32x4){L[4], L[5], L[6], L[7]}; tl[2] = (f32x4){L[8], L[9], L[10], L[11]}; tl[3] = (f32x4){L[12], L[13], L[14], L[15]};
            }
        }
        __syncthreads();
        if (tid < 128) {
            const LAS unsigned char* tl = lds + P4_SC0 + tid * (2 * P4_TLROW);
            float A[16], Bv[16];
#pragma unroll
            for (int q4 = 0; q4 < 4; ++q4) { const f32x4 a = *(const LAS f32x4*)(tl + q4 * 16), b = *(const LAS f32x4*)(tl + P4_TLROW + q4 * 16);
                A[4 * q4] = a.x; A[4 * q4 + 1] = a.y; A[4 * q4 + 2] = a.z; A[4 * q4 + 3] = a.w; Bv[4 * q4] = b.x; Bv[4 * q4 + 1] = b.y; Bv[4 * q4 + 2] = b.z; Bv[4 * q4 + 3] = b.w; }
#pragma unroll
            for (int s = 0; s < 16; ++s) { A[s] = __uint_as_float(__float_as_uint(A[s]) & ~127u); Bv[s] = __uint_as_float(__float_as_uint(Bv[s]) & ~127u); }
            float L[16];
            {
                float x[16];
                cand_fill<0, 0>(x, A, Bv); bitonic_sort16_desc(x);
#pragma unroll
                for (int s = 0; s < 16; ++s) L[s] = x[s];
                cand_fill<1, 0>(x, A, Bv); bitonic_sort16_desc(x); top16_merge(L, x);
                cand_fill<2, 0>(x, A, Bv); bitonic_sort16_desc(x); top16_merge(L, x);
                cand_fill<3, 0>(x, A, Bv); bitonic_sort16_desc(x); top16_merge(L, x);
            }
            const float v0 = __uint_as_float(__float_as_uint(L[0]) & ~255u);
            float e[16], den = 0.f; int id[16];
#pragma unroll
            for (int s = 0; s < 16; ++s) {
                const unsigned u = __float_as_uint(L[s]);
                e[s] = __expf(__uint_as_float(u & ~255u) - v0); den += e[s];
                const unsigned i = (u >> 4) & 15u, j = u & 15u;
                const unsigned ka = *(const LAS unsigned*)(tl + i * 4) & 127u, kb = *(const LAS unsigned*)(tl + P4_TLROW + j * 4) & 127u;
                id[s] = (int)(ka * 128u + kb);
            }
            const float inv = 1.f / den;
            unsigned* ip = PW0 + (size_t)(m0 + tid) * 128 + h * 16;
#pragma unroll
            for (int q4 = 0; q4 < 4; ++q4) { u32x4 o;
#pragma unroll
                for (int c = 0; c < 4; ++c) o[c] = (unsigned)id[4 * q4 + c] | (f2bf(e[4 * q4 + c] * inv) << 16);
                *(u32x4*)(ip + 4 * q4) = o; }
        }
        __syncthreads();
}

namespace pg8 {
struct EpiP4 {
    static constexpr bool PERM = true, AFTER_DRAIN = true, SWAPPABLE = false;
    const Params* pp; const float* ssq;
    __device__ __forceinline__ void operator()(const f32x4 (&)[2][2][4][2], const Unit&, int, int, int, int) const {}
    __device__ __forceinline__ void fused(f32x4 (&acc)[2][2][4][2], const Unit& u, int wr, int wc, int fr, int fq, PG8_LAS unsigned char* lds, int wid, int lane) const {
#pragma unroll
        for (int ai = 0; ai < 2; ++ai) {
            const int m0 = u.pm * BM + ai * HALF;
#pragma unroll
            for (int m = 0; m < 4; ++m) {
                const int rl = wr * 64 + m * 16 + fr;
                const float rstd = row_rstd(ssq, m0 + rl);
#pragma unroll
                for (int bj = 0; bj < 2; ++bj) { const f32x4 v0 = acc[ai][bj][m][0] * rstd, v1 = acc[ai][bj][m][1] * rstd;
                    *(PG8_LAS u32x4*)(lds + rl * P4_QROW + (bj * HALF + wc * 32 + 8 * fq) * 2) = (u32x4){pk2(v0.x, v0.y), pk2(v0.z, v0.w), pk2(v1.x, v1.y), pk2(v1.z, v1.w)}; }
            }
            __syncthreads();
            p4_route_half(*pp, lds, m0, u.pn);
        }
    }
};
}
__device__ __forceinline__ void phase4_mfma(const Params& p, LAS unsigned char* lds) {
    pg8::Gemm g{(const pg8::bf16_t*)(p.ws + OFF_H2B), (const pg8::bf16_t*)(p.ws + OFF_WQ), NTOK, 2048, DM};
    pg8::EpiP4 E{&p, (const float*)(p.ws + OFF_SSQP)};
    const int vcu = vcu_of_block();
    for (int r = 0; r * (int)gridDim.x < 512; ++r) {
        const int L = r * (int)gridDim.x + vcu;
        pg8::OneUnit S; S.u.pm = L >> 3; S.u.pn = L & 7; S.valid = L < 512;
        pg8::gemm_phase<pg8::EpiP4, pg8::OneUnit, false, true>(lds, g, S, E);
        __syncthreads();
    }
}


constexpr size_t OFF_PW = 73 * MiB;
constexpr size_t OFF_OUTS = 179 * MiB;
static_assert(OFF_OUTS >= OFF_PW0 + (size_t)NTOK * 128 * 4 && OFF_OUTS + (size_t)NTOK * DM * 4 <= 256 * MiB, "P5 map");
__device__ __forceinline__ float dot_fp8_bf16(u32x4 uq, u32x4 h0, u32x4 h1, float c) {
#define DQ2(word, hsel, hw) c = dot2(__builtin_bit_cast(unsigned, __builtin_amdgcn_cvt_scalef32_pk_bf16_fp8((int)(word), 1.0f, hsel)), hw, c)
    DQ2(uq.x, false, h0.x); DQ2(uq.x, true, h0.y); DQ2(uq.y, false, h0.z); DQ2(uq.y, true, h0.w);
    DQ2(uq.z, false, h1.x); DQ2(uq.z, true, h1.y); DQ2(uq.w, false, h1.z); DQ2(uq.w, true, h1.w);
#undef DQ2
    return c;
}
constexpr int P5A_RS = 1040, P5A_LIST = 16640, P5A_RES = 18688, P5A_TSC = 18752, P5A_WAVE = 19456;
constexpr size_t OFF_HQ = 146 * MiB;
constexpr size_t OFF_HSC = 192 * 1024;
static_assert(8 * P5A_WAVE <= LDS_BYTES - 32, "P5a LDS");
static_assert(OFF_HQ >= OFF_H2B + (size_t)NTOK * DM * 2 && OFF_HQ + (size_t)NTOK * DM <= OFF_PW0, "HQ map");
__device__ __forceinline__ void quantize_hn(const Params& p) {
    const int tid = threadIdx.x, lane = tid & 63, wave = tid >> 6;
    const bf16_t* H2B = (const bf16_t*)(p.ws + OFF_H2B); unsigned char* HQ = p.ws + OFF_HQ; float* HSC = (float*)(p.ws + OFF_HSC);
    for (int t = blockIdx.x * 8 + wave; t < NTOK; t += gridDim.x * 8) {
        const u32x4 h0 = *(const u32x4*)(H2B + (size_t)t * DM + 16 * lane), h1 = *(const u32x4*)(H2B + (size_t)t * DM + 16 * lane + 8);
        float m = 0.f;
#pragma unroll
        for (int c = 0; c < 4; ++c) { m = fmaxf(m, fmaxf(fabsf(bflo(h0[c])), fabsf(bfhi(h0[c])))); m = fmaxf(m, fmaxf(fabsf(bflo(h1[c])), fabsf(bfhi(h1[c])))); }
        const float am = fmaxf(wave_max(m), 1e-30f), qs = 224.f / am;
        u32x4 o;
#pragma unroll
        for (int c = 0; c < 2; ++c) {
            int w = __builtin_amdgcn_cvt_pk_fp8_f32(bflo(h0[2 * c]) * qs, bfhi(h0[2 * c]) * qs, 0, false); w = __builtin_amdgcn_cvt_pk_fp8_f32(bflo(h0[2 * c + 1]) * qs, bfhi(h0[2 * c + 1]) * qs, w, true); o[c] = (unsigned)w;
            int x = __builtin_amdgcn_cvt_pk_fp8_f32(bflo(h1[2 * c]) * qs, bfhi(h1[2 * c]) * qs, 0, false); x = __builtin_amdgcn_cvt_pk_fp8_f32(bflo(h1[2 * c + 1]) * qs, bfhi(h1[2 * c + 1]) * qs, x, true); o[2 + c] = (unsigned)x;
        }
        *(u32x4*)(HQ + (size_t)t * DM + 16 * lane) = o;
        if (lane == 0) HSC[t] = row_rstd((const float*)(p.ws + OFF_SSQP), t) * am * (1.f / 224.f);
    }
}
__device__ __forceinline__ void p5a_wave(const Params& p, LAS unsigned char* wl, int tb, int part, int lane, __amdgpu_buffer_rsrc_t urs, __amdgpu_buffer_rsrc_t hrs) {
    const float* USC = (const float*)(p.ws + OFF_USC); const float* VSC = (const float*)(p.ws + OFF_VSC); const float* HSC = (const float*)(p.ws + OFF_HSC);
    const unsigned* PW0 = (const unsigned*)(p.ws + OFF_PW0); unsigned* PW = (unsigned*)(p.ws + OFF_PW);
    const int l15 = lane & 15, g = lane >> 4;
    unsigned xl[4], xh[4]; float hsc = 0.f;
#define P5A_STAGE(t0_) do { _Pragma("unroll") for (int _k = 0; _k < 4; ++_k) { \
        __builtin_amdgcn_raw_ptr_buffer_load_lds(hrs, (LAS unsigned*)(wl + _k * 1024), 16, lane * 16, ((t0_) + _k) * 1024, 0, 0); \
        xl[_k] = PW0[(size_t)((t0_) + _k) * 128 + lane]; xh[_k] = PW0[(size_t)((t0_) + _k) * 128 + 64 + lane]; } \
        hsc = HSC[(t0_) + (lane & 3)]; } while (0)
#define P5A_GATHER(tile_) do { int _li = (tile_) * 16 + l15; _li = _li < n ? _li : n - 1; \
        const int _ev = (int)((*(const LAS unsigned*)(wl + P5A_LIST + _li * 4) & 0x3fffu) << 10); \
        _Pragma("unroll") for (int _r = 0; _r < 16; ++_r) \
            __builtin_amdgcn_raw_ptr_buffer_load_lds(urs, (LAS unsigned*)(wl + _r * P5A_RS), 16, lane * 16, __builtin_amdgcn_readlane(_ev, _r), 0, 0); } while (0)
    P5A_STAGE(tb);
    for (int st = 0; st < 4; ++st) {
        const int t0 = tb + 4 * st;
        asm volatile("s_waitcnt vmcnt(0)" ::: "memory");
        long bq[32];
#pragma unroll
        for (int i = 0; i < 16; ++i) { const u32x4 w = *(const LAS u32x4*)(wl + (l15 & 3) * 1024 + 64 * i + 16 * g);
            bq[2 * i] = __builtin_bit_cast(long, (u32x2){w.x, w.y}); bq[2 * i + 1] = __builtin_bit_cast(long, (u32x2){w.z, w.w}); }
        if (lane < 4) *(LAS float*)(wl + P5A_TSC + lane * 4) = hsc;
        int n = 0;
#pragma unroll
        for (int k = 0; k < 4; ++k) {
            const bool ml = (int)((xl[k] >> 11) & 7u) == part, mh = (int)((xh[k] >> 11) & 7u) == part;
            const unsigned long long bl = __ballot(ml), bh = __ballot(mh);
            const int rl = __builtin_amdgcn_mbcnt_hi((unsigned)(bl >> 32), __builtin_amdgcn_mbcnt_lo((unsigned)bl, 0u));
            if (ml) *(LAS unsigned*)(wl + P5A_LIST + (n + rl) * 4) = (xl[k] & 0x3fffu) | ((unsigned)lane << 14) | ((unsigned)k << 21);
            n += __popcll(bl);
            const int rh = __builtin_amdgcn_mbcnt_hi((unsigned)(bh >> 32), __builtin_amdgcn_mbcnt_lo((unsigned)bh, 0u));
            if (mh) *(LAS unsigned*)(wl + P5A_LIST + (n + rh) * 4) = (xh[k] & 0x3fffu) | ((unsigned)(64 + lane) << 14) | ((unsigned)k << 21);
            n += __popcll(bh);
        }
        __builtin_amdgcn_s_waitcnt(0xC07F); __builtin_amdgcn_wave_barrier();
        asm volatile("" ::: "memory");
        const int ntile = (n + 15) >> 4;
        if (ntile == 0) { if (st < 3) P5A_STAGE(t0 + 4); continue; }
#define P5A_OPS(tile_, EOK, EE, SL, TK, USCV, VSCV, XGV) do { int _ei = (tile_) * 16 + l15; EOK = _ei < n; _ei = EOK ? _ei : n - 1; \
        const unsigned _ent = *(const LAS unsigned*)(wl + P5A_LIST + _ei * 4); \
        EE = _ent & 0x3fffu; SL = (int)((_ent >> 14) & 127u); TK = (int)(_ent >> 21); \
        USCV = USC[EE]; VSCV = VSC[EE]; XGV = PW0[(size_t)(t0 + TK) * 128 + SL]; } while (0)
        bool eokN; unsigned eeN; int slN, tkN; float uscN, vscN; unsigned xgN;
        P5A_GATHER(0);
        P5A_OPS(0, eokN, eeN, slN, tkN, uscN, vscN, xgN);
        for (int tile = 0; tile < ntile; ++tile) {
            asm volatile("s_waitcnt vmcnt(0)" : "+v"(uscN), "+v"(vscN), "+v"(xgN) :: "memory");
            const bool eok = eokN; const unsigned ee = eeN; const int sl = slN, tk = tkN, t = t0 + tkN; const float usc = uscN, vsc = vscN; const unsigned xg = xgN;
            long aq[32];
#pragma unroll
            for (int i = 0; i < 16; ++i) { const u32x4 w = *(const LAS u32x4*)(wl + l15 * P5A_RS + 64 * i + 16 * g);
                aq[2 * i] = __builtin_bit_cast(long, (u32x2){w.x, w.y}); aq[2 * i + 1] = __builtin_bit_cast(long, (u32x2){w.z, w.w}); }
            asm volatile("s_waitcnt lgkmcnt(0)" ::: "memory");
#pragma unroll
            for (int s = 0; s < 32; ++s) asm volatile("" : "+v"(aq[s]));
            if (tile + 1 < ntile) { P5A_GATHER(tile + 1); P5A_OPS(tile + 1, eokN, eeN, slN, tkN, uscN, vscN, xgN); } else if (st < 3) P5A_STAGE(t0 + 4);
            f32x4 acc = (f32x4){0.f, 0.f, 0.f, 0.f};
#pragma unroll
            for (int s = 0; s < 32; ++s) acc = __builtin_amdgcn_mfma_f32_16x16x32_fp8_fp8(aq[s], bq[s], acc, 0, 0, 0);
            {
                const u32x4 en = *(const LAS u32x4*)(wl + P5A_LIST + (tile * 16 + 4 * g) * 4);
#pragma unroll
                for (int r = 0; r < 4; ++r) if ((int)(en[r] >> 21) == l15) *(LAS float*)(wl + P5A_RES + (4 * g + r) * 4) = acc[r];
            }
            __builtin_amdgcn_s_waitcnt(0xC07F); __builtin_amdgcn_wave_barrier();
            asm volatile("" ::: "memory");
            if (lane < 16 && eok) {
                const float d = *(const LAS float*)(wl + P5A_RES + lane * 4) * usc * *(const LAS float*)(wl + P5A_TSC + tk * 4);
                const float w = __uint_as_float(xg & 0xffff0000u) * gelu_f(d) * vsc;
                PW[(((size_t)(t >> 6) * 32 + (sl >> 2)) * 64 + (t & 63)) * 4 + (sl & 3)] = ee | (f2bf(w) << 16);
            }
            __builtin_amdgcn_s_waitcnt(0xC07F); __builtin_amdgcn_wave_barrier();
            asm volatile("" ::: "memory");
        }
#undef P5A_OPS
    }
    asm volatile("s_waitcnt vmcnt(0)" ::: "memory");
#undef P5A_STAGE
#undef P5A_GATHER
}
__device__ __forceinline__ void phase5a(const Params& p, LAS unsigned char* lds, int qoff = 0) {
    const int tid = threadIdx.x, lane = tid & 63, wave = __builtin_amdgcn_readfirstlane(tid >> 6);
    const int xcc = (int)(__builtin_amdgcn_s_getreg((3 << 11) | 20) & 7u);
    unsigned* qc = (unsigned*)(p.ws + OFF_CTL) + 256 + qoff;
    LAS unsigned char* wl = lds + wave * P5A_WAVE;
    const __amdgpu_buffer_rsrc_t urs = __builtin_amdgcn_make_buffer_rsrc((void*)(p.ws + OFF_UB), 0, NEXP * DM, 0x00020000);
    const __amdgpu_buffer_rsrc_t hrs = __builtin_amdgcn_make_buffer_rsrc((void*)(p.ws + OFF_HQ), 0, NTOK * DM, 0x00020000);
    for (int pi = 0; pi < 8; ++pi) {
        const int part = (xcc + pi) & 7;
        for (;;) {
            __syncthreads();
            if (tid == 0) *(LAS unsigned*)(lds + LDS_Q) = atomicAdd(qc + part * 64, 1u);
            __syncthreads();
            const int it = (int)*(LAS unsigned*)(lds + LDS_Q);
            if (it >= NTOK / 128) break;
            p5a_wave(p, wl, it * 128 + wave * 16, part, lane, urs, hrs);
        }
    }
}

__device__ __forceinline__ void p5b_quad(const LAS unsigned char* lds, u32x4 q, f32x2& a0, f32x2& a1, f32x2& a2, f32x2& a3) {
#pragma unroll
    for (int c = 0; c < 4; ++c) {
        const unsigned x = q[c];
        const u32x2 vv = *(const LAS u32x2*)(lds + ((x & 0x3fffu) << 3));
        const float w = __uint_as_float(x & 0xffff0000u); const f32x2 ww = (f32x2){w, w};
        a0 += ww * __builtin_amdgcn_cvt_pk_f32_fp8((int)vv.x, false); a1 += ww * __builtin_amdgcn_cvt_pk_f32_fp8((int)vv.x, true);
        a2 += ww * __builtin_amdgcn_cvt_pk_f32_fp8((int)vv.y, false); a3 += ww * __builtin_amdgcn_cvt_pk_f32_fp8((int)vv.y, true);
    }
}
__device__ __forceinline__ void phase5b(const Params& p, LAS unsigned char* lds) {
    const int tid = threadIdx.x, lane = tid & 63, wave = __builtin_amdgcn_readfirstlane(tid >> 6);
    const unsigned char* VS = p.ws + OFF_VB; const u32x4* PW = (const u32x4*)(p.ws + OFF_PW); bf16_t* OUTS = (bf16_t*)(p.ws + OFF_OUTS);
    for (int it = blockIdx.x; it < 256; it += gridDim.x) {
        const int s = it >> 1, tbase = (it & 1) * 128;
        __syncthreads();
#pragma unroll 4
        for (int i = 0; i < 16; ++i) *(LAS u32x4*)(lds + (tid + NTHR * i) * 16) = *(const u32x4*)(VS + (size_t)s * 131072 + (size_t)(tid + NTHR * i) * 16);
        __syncthreads();
        u32x4 A[8], Bq[8];
#define P5B_LOAD(R, gi) do { const int _T = tbase + wave + 8 * ((gi) >> 2), _g = (gi) & 3; const u32x4* _p = PW + ((size_t)_T * 32 + _g * 8) * 64 + lane; \
        _Pragma("unroll") for (int _i = 0; _i < 8; ++_i) R[_i] = _p[_i * 64]; } while (0)
        f32x2 a0 = {0.f, 0.f}, a1 = {0.f, 0.f}, a2 = {0.f, 0.f}, a3 = {0.f, 0.f};
        P5B_LOAD(A, 0);
        for (int gi = 0; gi < 64; gi += 2) {
            P5B_LOAD(Bq, gi + 1);
#pragma unroll
            for (int i = 0; i < 8; ++i) p5b_quad(lds, A[i], a0, a1, a2, a3);
            if (gi + 2 < 64) P5B_LOAD(A, gi + 2);
#pragma unroll
            for (int i = 0; i < 8; ++i) p5b_quad(lds, Bq[i], a0, a1, a2, a3);
            if (((gi + 1) & 3) == 3) {
                const int T = tbase + wave + 8 * (gi >> 2);
                *(u32x4*)(OUTS + ((size_t)s * NTOK + T * 64 + lane) * 8) = (u32x4){pk2(a0.x, a0.y), pk2(a1.x, a1.y), pk2(a2.x, a2.y), pk2(a3.x, a3.y)};
                a0 = (f32x2){0.f, 0.f}; a1 = a0; a2 = a0; a3 = a0;
            }
        }
#undef P5B_LOAD
    }
}

__device__ __forceinline__ void phase5c(const Params& p, LAS unsigned char* lds) {
    const int tid = threadIdx.x, lane = tid & 63, wave = __builtin_amdgcn_readfirstlane(tid >> 6);
    const bf16_t* OUTS = (const bf16_t*)(p.ws + OFF_OUTS); const bf16_t* H2B = (const bf16_t*)(p.ws + OFF_H2B); const float* fw = p.in[20];
    for (int it = blockIdx.x; it < NTOK / 32; it += gridDim.x) {
        const int t0 = it * 32;
        __syncthreads();
#pragma unroll 4
        for (int i = 0; i < 8; ++i) {
            const int q = tid + NTHR * i, s = q >> 5, tt = q & 31;
            *(LAS u32x4*)(lds + tt * 2064 + s * 16) = *(const u32x4*)(OUTS + ((size_t)s * NTOK + t0 + tt) * 8);
        }
        __syncthreads();
        for (int i = 0; i < 4; ++i) {
            const int tt = wave * 4 + i; float* orow = p.out + (size_t)(t0 + tt) * DM;
            f32x4 h[4]; float ss = 0.f;
#pragma unroll
            for (int j = 0; j < 2; ++j) {
                const u32x4 a = *(const u32x4*)(H2B + (size_t)(t0 + tt) * DM + 512 * j + 8 * lane), pq = *(const LAS u32x4*)(lds + tt * 2064 + (512 * j + 8 * lane) * 2);
                h[2 * j] = (f32x4){bflo(a.x) + bflo(pq.x), bfhi(a.x) + bfhi(pq.x), bflo(a.y) + bflo(pq.y), bfhi(a.y) + bfhi(pq.y)};
                h[2 * j + 1] = (f32x4){bflo(a.z) + bflo(pq.z), bfhi(a.z) + bfhi(pq.z), bflo(a.w) + bflo(pq.w), bfhi(a.w) + bfhi(pq.w)};
            }
#pragma unroll
            for (int j = 0; j < 4; ++j) ss += h[j].x * h[j].x + h[j].y * h[j].y + h[j].z * h[j].z + h[j].w * h[j].w;
            const float rs = rsqrtf(wave_sum(ss) * (1.f / DM) + EPS);
#pragma unroll
            for (int j = 0; j < 2; ++j) {
                float* o = orow + 512 * j + 8 * lane; const float* w = fw + 512 * j + 8 * lane;
                *(f32x4*)o = h[2 * j] * rs * *(const f32x4*)w; *(f32x4*)(o + 4) = h[2 * j + 1] * rs * *(const f32x4*)(w + 4);
            }
        }
    }
}


#define XB_TMO      128
#define XB_XCNT(j)  (256  + 64 * (j))
#define XB_XSUB(j)  (1280 + 64 * (j))
#define XB_XGEN(j)  (2304 + 64 * (j))
#define XB_TOP      3328
#define XB_TOPGEN   3392
#define XCD_BAR_WORDS 3456
#define XB_SPIN_CAP (1u << 18)
__device__ __forceinline__ unsigned xb_ld(unsigned* p)              { return __hip_atomic_load(p, __ATOMIC_RELAXED, __HIP_MEMORY_SCOPE_AGENT); }
__device__ __forceinline__ unsigned xb_add(unsigned* p, unsigned v) { return __hip_atomic_fetch_add(p, v, __ATOMIC_RELAXED, __HIP_MEMORY_SCOPE_AGENT); }
__device__ __forceinline__ unsigned xb_xcc_id() { return (unsigned)__builtin_amdgcn_s_getreg((3 << 11) | 20) & 0xFu; }
#define XB_SPIN(cond, bar) do { unsigned _sp = 0; while (cond) { __builtin_amdgcn_s_sleep(1); \
    if ((++_sp & 255u) == 0u) { if (xb_ld(&(bar)[XB_TMO])) break; if (_sp > XB_SPIN_CAP) { atomicAdd(&(bar)[XB_TMO], 1u); break; } } } } while (0)
struct XcdBarrier { unsigned* bar; unsigned x; volatile LAS unsigned* st; };
__device__ __forceinline__ XcdBarrier xcd_barrier_post(unsigned* bar, volatile LAS unsigned* st) {
    XcdBarrier b; b.bar = bar; b.x = xb_xcc_id(); b.st = st;
    if (threadIdx.x == 0) (void)xb_add(&bar[XB_XCNT(b.x)], 1u);
    return b;
}
__device__ __forceinline__ void xcd_barrier_complete(unsigned* bar, unsigned x, unsigned& nloc, unsigned& nx) {
    const unsigned G = gridDim.x * gridDim.y * gridDim.z;
    unsigned sum, cnt, mine, sp = 0u;
    for (;;) {
        sum = 0u; cnt = 0u; mine = 0u;
#pragma unroll
        for (unsigned j = 0; j < 16; ++j) { const unsigned c = xb_ld(&bar[XB_XCNT(j)]); sum += c; cnt += (c > 0u) ? 1u : 0u; mine = (j == x) ? c : mine; }
        if (sum == G) break;
        __builtin_amdgcn_s_sleep(1);
        if ((++sp & 255u) == 0u) { if (xb_ld(&bar[XB_TMO])) break; if (sp > XB_SPIN_CAP) { atomicAdd(&bar[XB_TMO], 1u); break; } }
    }
    nloc = mine > 0u ? mine : 1u; nx = cnt > 0u ? cnt : 1u;
}
__device__ __forceinline__ void xcd_barrier(const XcdBarrier& b) {
    asm volatile("s_waitcnt vmcnt(0)" ::: "memory");
    __syncthreads();
    if (threadIdx.x == 0) {
        unsigned* bar = b.bar;
        __builtin_amdgcn_s_waitcnt(0);
        unsigned nloc = b.st[0], nx = b.st[1];
        if (nloc == 0u) { xcd_barrier_complete(bar, b.x, nloc, nx); b.st[0] = nloc; b.st[1] = nx; }
        const unsigned old = xb_add(&bar[XB_XSUB(b.x)], 1u);
        const unsigned gen = old / nloc;
        if (old + 1u == (gen + 1u) * nloc) {
            __builtin_amdgcn_fence(__ATOMIC_RELEASE, "agent");
            asm volatile("s_waitcnt vmcnt(0)" ::: "memory");
            const unsigned og = xb_add(&bar[XB_TOP], 1u);
            const unsigned tg = og / nx;
            if (og + 1u == (tg + 1u) * nx) xb_add(&bar[XB_TOPGEN], 1u);
            else XB_SPIN(xb_ld(&bar[XB_TOPGEN]) == tg, bar);
            __builtin_amdgcn_fence(__ATOMIC_ACQUIRE, "agent");
            asm volatile("s_waitcnt vmcnt(0)" ::: "memory");
        } else {
            XB_SPIN(xb_ld(&bar[XB_TOPGEN]) == gen, bar);
            __builtin_amdgcn_fence(__ATOMIC_ACQUIRE, "agent");
            asm volatile("s_waitcnt vmcnt(0)" ::: "memory");
        }
    }
    __syncthreads();
}

constexpr int NPHASE = 9;
__global__ void __launch_bounds__(NTHR, 2) mega(Params p) {
    extern __shared__ __attribute__((aligned(16))) unsigned char lds[];
    cg::grid_group grid = cg::this_grid();
#define PH_ON(k) (p.ph_lo <= (k) && (k) < p.ph_hi)
    if (threadIdx.x < 2) ((LAS unsigned*)((LAS unsigned char*)lds + LDS_BYTES - 32))[threadIdx.x] = 0u;
    __syncthreads();
    const XcdBarrier xbar = xcd_barrier_post((unsigned*)(p.ws + OFF_CTL) + 8192, (volatile LAS unsigned*)((LAS unsigned char*)lds + LDS_BYTES - 32));
#define PH_SYNC(k) do { if (PH_ON(k) && PH_ON((k) + 1)) { xcd_barrier(xbar); } } while (0)
    if (PH_ON(0)) phase0(p, lds);
    PH_SYNC(0);
    if (PH_ON(1)) phase1_mfma(p, (LAS unsigned char*)lds);
#if PROBE_DUP == 1
    xcd_barrier(xbar); phase1_mfma(p, (LAS unsigned char*)lds);
#endif
    PH_SYNC(1);
    if (PH_ON(2)) phase2(p, (LAS unsigned char*)lds);
#if PROBE_DUP == 2
    xcd_barrier(xbar); phase2(p, (LAS unsigned char*)lds, 1);
#endif
#if PROBE_DUP == 21
    xcd_barrier(xbar); phase2(p, (LAS unsigned char*)lds, 2);
#endif
#if PROBE_DUP == 22
    xcd_barrier(xbar); phase2(p, (LAS unsigned char*)lds, 3);
#endif
    PH_SYNC(2);
    if (PH_ON(4)) phase3_mfma(p, (LAS unsigned char*)lds);
#if PROBE_DUP == 4
    xcd_barrier(xbar); phase3_mfma(p, (LAS unsigned char*)lds);
#endif
    PH_SYNC(4);
    if (PH_ON(5)) { phase4_mfma(p, (LAS unsigned char*)lds); quantize_hn(p); }
#if PROBE_DUP == 5
    xcd_barrier(xbar); phase4_mfma(p, (LAS unsigned char*)lds);
#endif
    PH_SYNC(5);
    if (PH_ON(6)) phase5a(p, (LAS unsigned char*)lds);
#if PROBE_DUP == 6
    xcd_barrier(xbar); phase5a(p, (LAS unsigned char*)lds, 1024);
#endif
    PH_SYNC(6);
    if (PH_ON(7)) phase5b(p, (LAS unsigned char*)lds);
#if PROBE_DUP == 7
    xcd_barrier(xbar); phase5b(p, (LAS unsigned char*)lds);
#endif
    PH_SYNC(7);
    if (PH_ON(8)) phase5c(p, (LAS unsigned char*)lds);
}

extern "C" void kernel_launch(void* const* d_in, const int* in_sizes, int n_in, void* d_out, int out_size, void* d_ws, size_t ws_size, hipStream_t stream) {
    static int grid = 0;
    if (grid == 0) {
        if (n_in != 21 || out_size != NTOK * DM || ws_size < WS_END) { fprintf(stderr, "kernel_launch: unexpected shapes (n_in %d out %d ws %zu)\n", n_in, out_size, ws_size); grid = -1; return; }
        int dev = 0, cus = 0, per_cu = 0;
        hipGetDevice(&dev);
        hipDeviceGetAttribute(&cus, hipDeviceAttributeMultiprocessorCount, dev);
        hipFuncSetAttribute((const void*)mega, hipFuncAttributeMaxDynamicSharedMemorySize, LDS_BYTES);
        hipOccupancyMaxActiveBlocksPerMultiprocessor(&per_cu, (const void*)mega, NTHR, LDS_BYTES);
        if (per_cu < 1) { fprintf(stderr, "kernel_launch: occupancy query says %d blocks/CU\n", per_cu); per_cu = 1; }
        grid = cus * 1;
        (void)hipGetLastError();
    }
    if (grid < 0) return;
    hipMemsetAsync((char*)d_ws + OFF_CTL, 0, CTL_BYTES, stream);
    Params p{};
    for (int i = 0; i < 21; ++i) p.in[i] = (const float*)d_in[i];
    p.out = (float*)d_out; p.ws = (unsigned char*)d_ws; p.ph_lo = 0; p.ph_hi = NPHASE;
    void* args[] = {&p};
    hipError_t e = hipLaunchCooperativeKernel((const void*)mega, dim3(grid), dim3(NTHR), args, LDS_BYTES, stream);
    if (e != hipSuccess) fprintf(stderr, "cooperative launch failed: %s (grid %d)\n", hipGetErrorString(e), grid);
}
```

```cpp
#include <hip/hip_runtime.h>
#include <hip/hip_cooperative_groups.h>
#include <cstdio>
#include <cstdint>
namespace cg = cooperative_groups;

constexpr int DM = 1024;
constexpr int NB = 8, SEQ = 2048, NMETA = 16;
constexpr int NTOK = NB * SEQ;
constexpr int MROWS = 16640;
constexpr int NIN = 3584;
constexpr int TPOS = NMETA + SEQ;
constexpr float EPS = 1e-6f;
constexpr float QSCALE = 0.125f * 1.4426950408889634f;
constexpr int NEXP = 16384;
constexpr int NTHR = 512;
#ifndef PROBE_DUP
#define PROBE_DUP 0
#endif

constexpr size_t MiB = 1u << 20;
constexpr size_t OFF_CTL = 0, CTL_BYTES = 64 * 1024;
constexpr size_t OFF_MISC = 512 * 1024;
constexpr size_t OFF_ROPE = 1 * MiB;
constexpr size_t OFF_WOUT = 2 * MiB;
constexpr size_t OFF_WQ = 4 * MiB;
constexpr size_t OFF_KEYS = 8 * MiB;
constexpr size_t OFF_SSQP = 25 * MiB;
constexpr size_t OFF_UB = 9 * MiB;
constexpr size_t OFF_VB = 41 * MiB;
constexpr size_t OFF_XN = 73 * MiB;
constexpr size_t OFF_MIX = 73 * MiB;
constexpr size_t OFF_WIN = 106 * MiB;
constexpr size_t OFF_QB = 113 * MiB;
constexpr size_t OFF_KB = OFF_QB + 16 * MiB + 256 * 1024;
constexpr size_t OFF_VT = OFF_KB + 16 * MiB + 256 * 1024;
constexpr size_t OFF_H2B = 113 * MiB;
constexpr size_t OFF_GQ = 162 * MiB;
constexpr size_t OFF_GK = OFF_GQ + 8 * MiB + 256 * 1024;
constexpr size_t OFF_GVT = OFF_GK + 8 * MiB + 256 * 1024;
constexpr size_t OFF_GF = OFF_GVT + 16 * MiB + 256 * 1024;
constexpr size_t OFF_GB = OFF_GF + 16 * MiB + 256 * 1024;
constexpr size_t OFF_GR = OFF_GB + 16 * MiB + 256 * 1024;
constexpr size_t OFF_PW0 = 162 * MiB;
constexpr size_t OFF_USC = 64 * 1024;
constexpr size_t OFF_VSC = 128 * 1024;
constexpr size_t WS_END = OFF_GR + 16 * MiB + 256 * 1024;
static_assert(WS_END <= 256 * MiB, "workspace map");
static_assert(OFF_VT + (size_t)512 * MROWS * 2 <= OFF_GQ, "map D");
static_assert(OFF_WIN + (size_t)NIN * DM * 2 <= OFF_QB, "map C");

constexpr int LDS_BYTES = 163840;
constexpr int LDS_Q = LDS_BYTES - 16;

typedef unsigned short bf16_t;
typedef float f32x4 __attribute__((ext_vector_type(4)));
typedef float f32x2 __attribute__((ext_vector_type(2)));
typedef unsigned u32x4 __attribute__((ext_vector_type(4)));
typedef unsigned u32x2 __attribute__((ext_vector_type(2)));
typedef __bf16 bf16x2_t __attribute__((ext_vector_type(2)));

struct Params {
    const float* in[21];
    float* out;
    unsigned char* ws;
    int ph_lo, ph_hi;
};

__device__ __forceinline__ unsigned f2bf(float f) { unsigned u = __float_as_uint(f); return (u + 0x7fffu + ((u >> 16) & 1u)) >> 16; }
__device__ __forceinline__ float bf2f(unsigned h) { return __uint_as_float(h << 16); }
__device__ __forceinline__ unsigned pk2(float lo, float hi) { return __builtin_bit_cast(unsigned, __builtin_convertvector((f32x2){lo, hi}, bf16x2_t)); }
__device__ __forceinline__ float bflo(unsigned w) { return __uint_as_float(w << 16); }
__device__ __forceinline__ float bfhi(unsigned w) { return __uint_as_float(w & 0xffff0000u); }
__device__ __forceinline__ float dot2(unsigned a, unsigned b, float c) {
    return __builtin_amdgcn_fdot2_f32_bf16(__builtin_bit_cast(bf16x2_t, a), __builtin_bit_cast(bf16x2_t, b), c, false);
}
__device__ __forceinline__ float dot8(u32x4 a, u32x4 b, float c) { c = dot2(a.x, b.x, c); c = dot2(a.y, b.y, c); c = dot2(a.z, b.z, c); return dot2(a.w, b.w, c); }
__device__ __forceinline__ float wave_sum(float v) {
#pragma unroll
    for (int o = 1; o < 64; o <<= 1) v += __shfl_xor(v, o);
    return v;
}
__device__ __forceinline__ float wave_max(float v) {
#pragma unroll
    for (int o = 1; o < 64; o <<= 1) v = fmaxf(v, __shfl_xor(v, o));
    return v;
}
__device__ __forceinline__ float silu_f(float x) { return x * __builtin_amdgcn_rcpf(1.f + __expf(-x)); }
__device__ __forceinline__ float logsig_f(float x) { return fminf(x, 0.f) - __logf(1.f + __expf(-fabsf(x))); }
__device__ __forceinline__ float gelu_f(float v) {
    const float av = fabsf(v), t = __builtin_amdgcn_rcpf(av * 0.2316418882f + 1.0f);
    float q = t * 0.5307027145f + (-0.7265760135f); q = q * t + 0.7107068705f; q = q * t + (-0.142248368f); q = q * t + 0.127414796f; q = q * t;
    const float m = v * (q * __builtin_amdgcn_exp2f(v * v * (-0.72134752044f)));
    return v < 0.f ? m : v - m;
}

__device__ __forceinline__ float win_src(const Params& p, int k, int n) {
    const float* W = p.in[3] + (size_t)k * 3104;
    if (n < 1024) {
        const int base = n & ~63, dp = n & 63, d = dp < 16 ? ((dp >> 1) + 8 * (dp & 1)) : dp;
        return W[base + d];
    } else if (n < 3072) return W[n];
    const int j = (n - 3072) & 255, dir = (n - 3072) >> 8;
    const float* w2 = p.in[dir ? 11 : 9];
    const float* wz = W + 3072 + dir * 16;
    float s = 0.f;
#pragma unroll
    for (int r = 0; r < 16; ++r) s += wz[r] * w2[r * 256 + j];
    return s;
}

template <int WHICH>
__device__ __forceinline__ void p0_transpose_item(const Params& p, float* scr, int item, int lane) {
    constexpr int N = WHICH == 0 ? NIN : (WHICH == 1 ? 1024 : 2048);
    constexpr int nblk = N / 32;
    const int kb = item / nblk, nb = item % nblk, k0 = 64 * kb, n0 = 32 * nb;
    bf16_t* WT = (bf16_t*)(p.ws + (WHICH == 0 ? OFF_WIN : (WHICH == 1 ? OFF_WOUT : OFF_WQ)));
#pragma unroll 4
    for (int i = 0; i < 32; ++i) {
        const int kk = 2 * i + (lane >> 5), k = k0 + kk, n = n0 + (lane & 31);
        float v;
        if (WHICH == 0) v = win_src(p, k, n);
        else if (WHICH == 1) v = p.in[14][(size_t)k * 1024 + n];
        else v = p.in[16][(size_t)k * 2048 + n] * p.in[15][k];
        scr[kk * 33 + (lane & 31)] = v;
    }
    __builtin_amdgcn_s_waitcnt(0xC07F); __builtin_amdgcn_wave_barrier();
    const int c = lane & 7;
#pragma unroll
    for (int j = 0; j < 4; ++j) {
        const int n = (lane >> 3) + 8 * j; const float* s = scr + (8 * c) * 33 + n;
        u32x4 o; o.x = pk2(s[0 * 33], s[1 * 33]); o.y = pk2(s[2 * 33], s[3 * 33]); o.z = pk2(s[4 * 33], s[5 * 33]); o.w = pk2(s[6 * 33], s[7 * 33]);
        *(u32x4*)(WT + (size_t)(n0 + n) * 1024 + k0 + 8 * c) = o;
    }
    __builtin_amdgcn_s_waitcnt(0xC07F); __builtin_amdgcn_wave_barrier();
}

__device__ __forceinline__ void phase0(const Params& p, unsigned char* lds) {
    const int tid = threadIdx.x, lane = tid & 63, wave = tid >> 6;
    const int gw = blockIdx.x * 8 + wave, NGW = gridDim.x * 8;
    const long gt = (long)blockIdx.x * NTHR + tid, NGT = (long)gridDim.x * NTHR;
    {
        const f32x4* lw = (const f32x4*)p.in[2];
        bf16_t* XN = (bf16_t*)(p.ws + OFF_XN);
        for (int r = gw; r < MROWS; r += NGW) {
            const float* src = r < NTOK ? p.in[0] + (size_t)r * DM : (r < NTOK + NMETA ? p.in[1] + (size_t)(r - NTOK) * DM : nullptr);
            f32x4 v[4]; float s = 0.f;
#pragma unroll
            for (int j = 0; j < 4; ++j) { v[j] = src ? ((const f32x4*)src)[lane + 64 * j] : (f32x4){0.f, 0.f, 0.f, 0.f}; s += v[j].x * v[j].x + v[j].y * v[j].y + v[j].z * v[j].z + v[j].w * v[j].w; }
            const float rs = rsqrtf(wave_sum(s) * (1.f / DM) + EPS);
#pragma unroll
            for (int j = 0; j < 4; ++j) { const f32x4 w = lw[lane + 64 * j]; u32x2 o; o.x = pk2(v[j].x * rs * w.x, v[j].y * rs * w.y); o.y = pk2(v[j].z * rs * w.z, v[j].w * rs * w.w);
                *(u32x2*)(XN + (size_t)r * DM + 4 * (lane + 64 * j)) = o; }
        }
    }
    {
        float* scr = (float*)lds + wave * (64 * 33);
        constexpr int I0 = 16 * (NIN / 32);
        for (int it = gw; it < I0; it += NGW) p0_transpose_item<0>(p, scr, it, lane);
    }
    {
        f32x2* rope = (f32x2*)(p.ws + OFF_ROPE);
        for (long i = gt; i < TPOS * 8; i += NGT) {
            const int t = (int)(i >> 3), j = (int)(i & 7);
            const float inv = powf(500000.0f, -(float)j * 0.125f);
            const float ang = (float)t * inv;
            rope[i] = (f32x2){cosf(ang), sinf(ang)};
        }
        if (gt == 0) {
            float a = 0.f, b = 0.f;
            for (int i = 0; i < 64; ++i) { a += p.in[4][i] * p.in[5][i]; b += p.in[6][i] * p.in[7][i]; }
            ((float*)(p.ws + OFF_MISC))[0] = expf(a) - expf(b) + 0.2f;
        }
    }
}
constexpr int CV_WOUT = 64, CV_WQ = 128, CV_KEYS = 8, CV_U = 256, CV_V = 256, CV_ITEMS = CV_WOUT + CV_WQ + CV_KEYS + CV_U + CV_V;
__device__ __forceinline__ void conv_item(const Params& p, unsigned char* lds, int c) {
    const int tid = threadIdx.x, lane = tid & 63, wave = tid >> 6;
    __syncthreads();
    if (c < CV_WOUT) { p0_transpose_item<1>(p, (float*)lds + wave * (64 * 33), c * 8 + wave, lane); return; }
    c -= CV_WOUT;
    if (c < CV_WQ) { p0_transpose_item<2>(p, (float*)lds + wave * (64 * 33), c * 8 + wave, lane); return; }
    c -= CV_WQ;
    if (c < CV_KEYS) {
        bf16_t* KEYS = (bf16_t*)(p.ws + OFF_KEYS);
#pragma unroll 2
        for (int j = 0; j < 8; ++j) {
            const long e = ((long)c * 4096 + tid + NTHR * j) * 8;
            const f32x4 a = *(const f32x4*)(p.in[17] + e), b = *(const f32x4*)(p.in[17] + e + 4);
            u32x4 o; o.x = pk2(a.x, a.y); o.y = pk2(a.z, a.w); o.z = pk2(b.x, b.y); o.w = pk2(b.z, b.w);
            *(u32x4*)(KEYS + e) = o;
        }
        return;
    }
    c -= CV_KEYS;
    if (c < CV_U) {
        unsigned char* UQ = p.ws + OFF_UB; float* USC = (float*)(p.ws + OFF_USC);
#pragma unroll 2
        for (int i = 0; i < 8; ++i) {
            const int r = c * 64 + wave * 8 + i;
            const float* ur = p.in[18] + (size_t)r * DM + 16 * lane; const float* lw = p.in[15] + 16 * lane;
            f32x4 v[4]; float am = 0.f;
#pragma unroll
            for (int j = 0; j < 4; ++j) { v[j] = ((const f32x4*)ur)[j] * ((const f32x4*)lw)[j]; am = fmaxf(am, fmaxf(fmaxf(fabsf(v[j].x), fabsf(v[j].y)), fmaxf(fabsf(v[j].z), fabsf(v[j].w)))); }
            am = fmaxf(wave_max(am), 1e-30f);
            const float sc = 224.f / am;
            u32x4 o;
#pragma unroll
            for (int j = 0; j < 4; ++j) { int w = __builtin_amdgcn_cvt_pk_fp8_f32(v[j].x * sc, v[j].y * sc, 0, false); w = __builtin_amdgcn_cvt_pk_fp8_f32(v[j].z * sc, v[j].w * sc, w, true); o[j] = (unsigned)w; }
            *(u32x4*)(UQ + (size_t)r * DM + 16 * lane) = o;
            if (lane == 0) USC[r] = am * (1.f / 224.f);
        }
        return;
    }
    c -= CV_U;
    {
        unsigned char* VS = p.ws + OFF_VB; float* VSC = (float*)(p.ws + OFF_VSC);
        const int tile = c;
#pragma unroll 2
        for (int i = 0; i < 8; ++i) {
            const int er = wave * 8 + i, r = tile * 64 + er;
            const float* vr = p.in[19] + (size_t)r * DM + 16 * lane;
            f32x4 v[4]; float am = 0.f;
#pragma unroll
            for (int j = 0; j < 4; ++j) { v[j] = ((const f32x4*)vr)[j]; am = fmaxf(am, fmaxf(fmaxf(fabsf(v[j].x), fabsf(v[j].y)), fmaxf(fabsf(v[j].z), fabsf(v[j].w)))); }
            am = fmaxf(wave_max(am), 1e-30f);
            const float sc = 224.f / am;
            u32x4 o;
#pragma unroll
            for (int j = 0; j < 4; ++j) { int w = __builtin_amdgcn_cvt_pk_fp8_f32(v[j].x * sc, v[j].y * sc, 0, false); w = __builtin_amdgcn_cvt_pk_fp8_f32(v[j].z * sc, v[j].w * sc, w, true); o[j] = (unsigned)w; }
            *(u32x2*)(lds + er * 1032 + 16 * lane) = (u32x2){o.x, o.y}; *(u32x2*)(lds + er * 1032 + 16 * lane + 8) = (u32x2){o.z, o.w};
            if (lane == 0) VSC[r] = am * (1.f / 224.f);
        }
        __syncthreads();
#pragma unroll 4
        for (int i = 0; i < 16; ++i) {
            const int s = wave + 8 * i;
            *(u32x2*)(VS + ((size_t)s * NEXP + tile * 64 + lane) * 8) = *(const u32x2*)(lds + lane * 1032 + s * 8);
        }
    }
}

struct P1Ptrs { unsigned char* ws; const float* bias_f; const float* bias_b; };
__device__ __forceinline__ void p1_store(const P1Ptrs p, int row, int n0, float v0, float v1, float v2, float v3) {
    if (n0 < 1024) {
        const int dp = n0 & 63;
        if (dp < 16) {
            const int pos = row < NTOK ? NMETA + (row & (SEQ - 1)) : (row - NTOK);
            const f32x4 cs = *(const f32x4*)((const float*)(p.ws + OFF_ROPE) + ((size_t)pos * 8 + (dp >> 1)) * 2);
            const float a0 = v0 * cs.x - v1 * cs.y, b0 = v1 * cs.x + v0 * cs.y;
            const float a1 = v2 * cs.z - v3 * cs.w, b1 = v3 * cs.z + v2 * cs.w;
            v0 = a0; v1 = b0; v2 = a1; v3 = b1;
        }
        if (n0 < 512) { u32x2 o; o.x = pk2(v0 * QSCALE, v1 * QSCALE); o.y = pk2(v2 * QSCALE, v3 * QSCALE); *(u32x2*)((bf16_t*)(p.ws + OFF_QB) + (size_t)row * 512 + n0) = o; }
        else { u32x2 o; o.x = pk2(v0, v1); o.y = pk2(v2, v3); *(u32x2*)((bf16_t*)(p.ws + OFF_KB) + (size_t)row * 512 + (n0 - 512)) = o; }
    } else if (n0 < 1536) {
        bf16_t* VT = (bf16_t*)(p.ws + OFF_VT) + (size_t)(n0 - 1024) * MROWS + row;
        VT[0] = (bf16_t)f2bf(v0); VT[MROWS] = (bf16_t)f2bf(v1); VT[2 * MROWS] = (bf16_t)f2bf(v2); VT[3 * (size_t)MROWS] = (bf16_t)f2bf(v3);
    } else if (n0 < 1792) {
        u32x2 o; o.x = pk2(v0 * 0.125f, v1 * 0.125f); o.y = pk2(v2 * 0.125f, v3 * 0.125f); *(u32x2*)((bf16_t*)(p.ws + OFF_GQ) + (size_t)row * 256 + (n0 - 1536)) = o;
    } else if (n0 < 2048) {
        u32x2 o; o.x = pk2(v0, v1); o.y = pk2(v2, v3); *(u32x2*)((bf16_t*)(p.ws + OFF_GK) + (size_t)row * 256 + (n0 - 1792)) = o;
    } else if (n0 < 2560) {
        bf16_t* VT = (bf16_t*)(p.ws + OFF_GVT) + (size_t)(n0 - 2048) * MROWS + row;
        VT[0] = (bf16_t)f2bf(v0); VT[MROWS] = (bf16_t)f2bf(v1); VT[2 * MROWS] = (bf16_t)f2bf(v2); VT[3 * (size_t)MROWS] = (bf16_t)f2bf(v3);
    } else if (n0 < 3072) {
        u32x2 o; o.x = pk2(silu_f(v0), silu_f(v1)); o.y = pk2(silu_f(v2), silu_f(v3)); *(u32x2*)((bf16_t*)(p.ws + OFF_GR) + (size_t)row * 512 + (n0 - 2560)) = o;
    } else {
        const int dir = (n0 - 3072) >> 8, j = (n0 - 3072) & 255;
        const f32x4 bb = *(const f32x4*)((dir ? p.bias_b : p.bias_f) + j);
        f32x4 o; o.x = logsig_f(v0 + bb.x) * 0.0625f; o.y = logsig_f(v1 + bb.y) * 0.0625f; o.z = logsig_f(v2 + bb.z) * 0.0625f; o.w = logsig_f(v3 + bb.w) * 0.0625f;
        *(f32x4*)((float*)(p.ws + (dir ? OFF_GB : OFF_GF)) + (size_t)row * 256 + j) = o;
    }
}


#define LAS __attribute__((address_space(3)))
typedef short bf16x8 __attribute__((ext_vector_type(8)));
constexpr int GBUF = 49152;

template <int ROWS>
__device__ __forceinline__ void stage_tile(const bf16_t* G, int ldk, int r0, int k0, LAS unsigned char* buf, int wave, int lane) {
    const int rr = lane >> 3, c = (lane & 7) ^ rr;
#pragma unroll
    for (int i = 0; i < ROWS / 64; ++i) {
        const int grp = wave + 8 * i;
        const bf16_t* src = G + (size_t)(r0 + grp * 8 + rr) * ldk + k0 + c * 8;
        __builtin_amdgcn_global_load_lds((const unsigned*)src, (LAS unsigned*)(buf + grp * 1024), 16, 0, 0);
    }
}
__device__ __forceinline__ bf16x8 ldfrag(const LAS unsigned char* buf, int row, int c) {
    return *(const LAS bf16x8*)(buf + row * 128 + ((c ^ (row & 7)) << 4));
}
template <bool SWAP>
__device__ __forceinline__ void gemm_tile_256(const bf16_t* A, const bf16_t* Bt, int K, int m0, int n0, LAS unsigned char* lds, f32x4 (&acc)[4][4]) {
    const int tid = threadIdx.x, lane = tid & 63, wave = __builtin_amdgcn_readfirstlane(tid >> 6), wm = wave >> 2, wn = wave & 3, l15 = lane & 15, g = lane >> 4;
#pragma unroll
    for (int i = 0; i < 4; ++i)
#pragma unroll
        for (int j = 0; j < 4; ++j) acc[i][j] = (f32x4){0.f, 0.f, 0.f, 0.f};
    const int nk = K / 64;
    stage_tile<128>(A, K, m0, 0, lds, wave, lane);
    stage_tile<256>(Bt, K, n0, 0, lds + 16384, wave, lane);
    for (int kt = 0; kt < nk; ++kt) {
        asm volatile("s_waitcnt vmcnt(0)" ::: "memory");
        __syncthreads();
        if (kt + 1 < nk) {
            LAS unsigned char* nb = lds + ((kt + 1) & 1) * GBUF;
            stage_tile<128>(A, K, m0, (kt + 1) * 64, nb, wave, lane);
            stage_tile<256>(Bt, K, n0, (kt + 1) * 64, nb + 16384, wave, lane);
        }
        const LAS unsigned char* a = lds + (kt & 1) * GBUF; const LAS unsigned char* b = a + 16384;
#pragma unroll
        for (int ks = 0; ks < 2; ++ks) {
            bf16x8 af[4], bfr[4];
#pragma unroll
            for (int i = 0; i < 4; ++i) { af[i] = ldfrag(a, wm * 64 + i * 16 + l15, ks * 4 + g); bfr[i] = ldfrag(b, wn * 64 + i * 16 + l15, ks * 4 + g); }
#pragma unroll
            for (int i = 0; i < 4; ++i)
#pragma unroll
                for (int j = 0; j < 4; ++j)
                    acc[i][j] = SWAP ? __builtin_amdgcn_mfma_f32_16x16x32_bf16(af[i], bfr[j], acc[i][j], 0, 0, 0)
                                     : __builtin_amdgcn_mfma_f32_16x16x32_bf16(bfr[j], af[i], acc[i][j], 0, 0, 0);
        }
    }
}
__device__ __forceinline__ int vcu_of_block() { const int G = gridDim.x, bx = blockIdx.x; return (G % 8 == 0) ? (bx % 8) * (G / 8) + bx / 8 : bx; }

namespace pg8 {
#define PG8_LAS __attribute__((address_space(3)))
typedef unsigned short bf16_t;
typedef short bf16x8 __attribute__((ext_vector_type(8)));
typedef float f32x4 __attribute__((ext_vector_type(4)));
typedef unsigned u32x4 __attribute__((ext_vector_type(4)));
constexpr int BM = 256, BK = 64, HALF = 128, HTB = HALF * BK * 2  , STAGE_BYTES = 8 * HTB, NXCD = 8, WGM = 8;

__host__ __device__ __forceinline__ int lds_byte(int r, int c) { const int st = (r >> 4) * 2 + (c >> 5), rr = r & 15, cc = c & 31, ob = rr * 64 + cc * 2; return st * 1024 + (ob ^ (((ob >> 9) & 1) << 5)); }
__host__ __device__ __forceinline__ void stage_rc(int b, int& R, int& C) { const int st = b / 1024, sb = b % 1024, swz = sb ^ (((sb >> 9) & 1) << 5); R = (st >> 1) * 16 + swz / 64; C = (st & 1) * 32 + (swz % 64) / 2; }
__host__ __device__ __forceinline__ int perm32(int rho) { const int n = rho >> 4, i = rho & 15; return 8 * (i >> 2) + 4 * n + (i & 3); }

struct Unit { int pm, pn; };
struct Gemm { const bf16_t* A; const bf16_t* Bt; int M, N, K; };

struct StaticOrder {
    int nM, nN, nwg, G, c;
    __host__ __device__ void init(int M, int N, int G_, int c_) { nM = M / BM; nN = N / BM; nwg = nM * nN; G = G_; c = c_; }
    __host__ __device__ bool next(int i, Unit& u) const {
        const long L = (long)i * G + c; if (L >= nwg) return false;
        int wgid = (int)L; { const int q = nwg / NXCD, r = nwg % NXCD, xcd = wgid % NXCD, off = wgid / NXCD; wgid = (xcd < r ? xcd * (q + 1) : r * (q + 1) + (xcd - r) * q) + off; }
        const int nig = WGM * nN, gid = wgid / nig, fm = gid * WGM, gsz = (nM - fm) < WGM ? (nM - fm) : WGM;
        u.pm = fm + ((wgid % nig) % gsz); u.pn = (wgid % nig) / gsz; return true;
    }
    __device__ __forceinline__ void a_ready(const Unit&) const {}
    __device__ __forceinline__ void done(const Unit&) const {}
};

struct EpiP1 {
    static constexpr bool PERM = true, AFTER_DRAIN = false, SWAPPABLE = true;
    P1Ptrs p;
    static __device__ __forceinline__ bool swap_unit(const Unit& u) { return u.pn == 4 || u.pn == 5 || u.pn == 8 || u.pn == 9; }
    __device__ __forceinline__ void operator()(const f32x4 (&acc)[2][2][4][2], const Unit& u, int wr, int wc, int fr, int fq) const {
        if (swap_unit(u)) {
            const int cb = u.pn * BM, nbase = cb < 1536 ? cb - 1024 : cb - 2048;
            bf16_t* T = (bf16_t*)(p.ws + (cb < 1536 ? OFF_VT : OFF_GVT)) + (size_t)(nbase + wc * 32 + 8 * (fr >> 2) + (fr & 3)) * MROWS + u.pm * BM + wr * 64 + 4 * fq;
#pragma unroll
            for (int bj = 0; bj < 2; ++bj)
#pragma unroll
                for (int n = 0; n < 2; ++n)
#pragma unroll
                    for (int ai = 0; ai < 2; ++ai)
#pragma unroll
                        for (int m = 0; m < 4; ++m) { const f32x4 v = acc[ai][bj][m][n];
                            *(u32x2*)(T + (size_t)(bj * HALF + n * 4) * MROWS + ai * HALF + m * 16) = (u32x2){pk2(v.x, v.y), pk2(v.z, v.w)}; }
            return;
        }
#pragma unroll
        for (int bj = 0; bj < 2; ++bj) {
            const int nw = u.pn * BM + bj * HALF + wc * 32;
            const int rowb = u.pm * BM + wr * 64 + fr;
            if (nw >= 3072) {
                const int dir = (nw - 3072) >> 8, j0 = ((nw - 3072) & 255) + 8 * fq;
                float* G = (float*)(p.ws + (dir ? OFF_GB : OFF_GF)); const float* bias = dir ? p.bias_b : p.bias_f;
                const f32x4 b0 = *(const f32x4*)(bias + j0), b1 = *(const f32x4*)(bias + j0 + 4);
#pragma unroll
                for (int ai = 0; ai < 2; ++ai)
#pragma unroll
                    for (int m = 0; m < 4; ++m) { const f32x4 v0 = acc[ai][bj][m][0], v1 = acc[ai][bj][m][1]; f32x4 o0, o1;
                        o0.x = logsig_f(v0.x + b0.x) * 0.0625f; o0.y = logsig_f(v0.y + b0.y) * 0.0625f; o0.z = logsig_f(v0.z + b0.z) * 0.0625f; o0.w = logsig_f(v0.w + b0.w) * 0.0625f;
                        o1.x = logsig_f(v1.x + b1.x) * 0.0625f; o1.y = logsig_f(v1.y + b1.y) * 0.0625f; o1.z = logsig_f(v1.z + b1.z) * 0.0625f; o1.w = logsig_f(v1.w + b1.w) * 0.0625f;
                        float* gp = G + (size_t)(rowb + ai * HALF + m * 16) * 256 + j0; *(f32x4*)gp = o0; *(f32x4*)(gp + 4) = o1; }
            } else {
                bf16_t* base; int ld, c0; float sc = 1.f; bool silu = false;
                if (nw < 512) { base = (bf16_t*)(p.ws + OFF_QB); ld = 512; c0 = nw; sc = QSCALE; }
                else if (nw < 1024) { base = (bf16_t*)(p.ws + OFF_KB); ld = 512; c0 = nw - 512; }
                else if (nw < 1792) { base = (bf16_t*)(p.ws + OFF_GQ); ld = 256; c0 = nw - 1536; sc = 0.125f; }
                else if (nw < 2048) { base = (bf16_t*)(p.ws + OFF_GK); ld = 256; c0 = nw - 1792; }
                else { base = (bf16_t*)(p.ws + OFF_GR); ld = 512; c0 = nw - 2560; silu = true; }
                const bool rope = nw < 1024 && (nw & 63) == 0 && fq < 2;
#pragma unroll
                for (int ai = 0; ai < 2; ++ai)
#pragma unroll
                    for (int m = 0; m < 4; ++m) {
                        const int row = rowb + ai * HALF + m * 16;
                        f32x4 v0 = acc[ai][bj][m][0], v1 = acc[ai][bj][m][1];
                        if (rope) {
                            const int pos = row < NTOK ? NMETA + (row & (SEQ - 1)) : (row - NTOK < TPOS ? row - NTOK : 0);
                            const f32x4* cp = (const f32x4*)((const float*)(p.ws + OFF_ROPE) + ((size_t)pos * 8 + 4 * fq) * 2);
                            const f32x4 ca = cp[0], cb2 = cp[1];
                            v0 = (f32x4){v0.x * ca.x - v0.y * ca.y, v0.y * ca.x + v0.x * ca.y, v0.z * ca.z - v0.w * ca.w, v0.w * ca.z + v0.z * ca.w};
                            v1 = (f32x4){v1.x * cb2.x - v1.y * cb2.y, v1.y * cb2.x + v1.x * cb2.y, v1.z * cb2.z - v1.w * cb2.w, v1.w * cb2.z + v1.z * cb2.w};
                        }
                        if (silu) { v0 = (f32x4){silu_f(v0.x), silu_f(v0.y), silu_f(v0.z), silu_f(v0.w)}; v1 = (f32x4){silu_f(v1.x), silu_f(v1.y), silu_f(v1.z), silu_f(v1.w)}; }
                        else { v0 = v0 * sc; v1 = v1 * sc; }
                        *(u32x4*)(base + (size_t)row * ld + c0 + 8 * fq) = (u32x4){pk2(v0.x, v0.y), pk2(v0.z, v0.w), pk2(v1.x, v1.y), pk2(v1.z, v1.w)};
                    }
            }
        }
    }
};
struct EpiP3 {
    static constexpr bool PERM = true, AFTER_DRAIN = false, SWAPPABLE = false;
    const float* x; float* out; bf16_t* h2b; float* ssq;
    __device__ __forceinline__ void operator()(const f32x4 (&acc)[2][2][4][2], const Unit& u, int wr, int wc, int fr, int fq) const {
#pragma unroll
        for (int ai = 0; ai < 2; ++ai)
#pragma unroll
            for (int m = 0; m < 4; ++m) { const int row = u.pm * BM + ai * HALF + wr * 64 + m * 16 + fr; float ss = 0.f;
#pragma unroll
                for (int bj = 0; bj < 2; ++bj) { const int col = u.pn * BM + bj * HALF + wc * 32 + 8 * fq;
                    const f32x4 h0 = *(const f32x4*)(x + (size_t)row * DM + col) + acc[ai][bj][m][0], h1 = *(const f32x4*)(x + (size_t)row * DM + col + 4) + acc[ai][bj][m][1];
                    *(u32x4*)(h2b + (size_t)row * DM + col) = (u32x4){pk2(h0.x, h0.y), pk2(h0.z, h0.w), pk2(h1.x, h1.y), pk2(h1.z, h1.w)};
                    ss += (h0.x * h0.x + h0.y * h0.y + h0.z * h0.z + h0.w * h0.w) + (h1.x * h1.x + h1.y * h1.y + h1.z * h1.z + h1.w * h1.w); }
                ss += __shfl_xor(ss, 16); ss += __shfl_xor(ss, 32);
                if (fq == 0) ssq[(size_t)row * 16 + u.pn * 4 + wc] = ss; }
    }
};

struct P1Order {
    int G, c, ncol, nM; bool vt;
    __device__ __forceinline__ bool next(int i, Unit& u) const {
        const int nwg = nM * ncol; const int L = i * G + (vt ? (G - 1 - c) : c); if (L >= nwg) return false;
        const int pm = L / ncol, j = L % ncol;
        u.pm = pm; u.pn = vt ? (j < 2 ? 4 + j : 6 + j) : (j < 4 ? j : (j < 6 ? j + 2 : j + 4));
        return true;
    }
    __device__ __forceinline__ void a_ready(const Unit&) const {}
    __device__ __forceinline__ void done(const Unit&) const {}
};
struct OneUnit {
    Unit u; bool valid;
    __device__ __forceinline__ bool next(int i, Unit& o) const { if (i != 0 || !valid) return false; o = u; return true; }
    __device__ __forceinline__ void a_ready(const Unit&) const {}
    __device__ __forceinline__ void done(const Unit&) const {}
};

template <class Epi, class Sched, bool ALIGN_EPI = false, bool SP2 = false, bool SWP = false>
__device__ __forceinline__ void gemm_phase(PG8_LAS unsigned char* lds, const Gemm g, const Sched& S, const Epi& E) {
    int tid_ = threadIdx.x; asm volatile("" : "+v"(tid_));
    const int tid = tid_, wid = __builtin_amdgcn_readfirstlane(tid >> 6), lane = tid & 63, wr = wid >> 2, wc = wid & 3, fr = lane & 15, fq = lane >> 4;
    const int K = g.K, nt = K / BK;
    unsigned voffA[2], voffB[2];
#pragma unroll
    for (int i = 0; i < 2; ++i) { int R, C; stage_rc(tid * 16 + i * 8192, R, C); const int Rb = Epi::PERM ? ((R & ~31) + perm32(R & 31)) : R;
        voffA[i] = (unsigned)(R * K + C) * 2u; voffB[i] = (unsigned)(Rb * K + C) * 2u; }
    const size_t kstep = (size_t)(BK * 2);
    const size_t hstep = (size_t)HALF * K * 2;
    const size_t tstep = 2 * hstep;
    const unsigned ldsw = (unsigned)wid * 1024u;
    const int aoff = lds_byte(wr * 64 + fr, fq * 8), boff = lds_byte(wc * 32 + fr, fq * 8);
#define PG8_SA(b, h) (((b) * 2 + (h)) * HTB)
#define PG8_SB(b, h) ((4 + (b) * 2 + (h)) * HTB)
#define PG8_STAGE(bufoff, gbase, voff) do { _Pragma("unroll") for (int _i = 0; _i < 2; ++_i) \
        __builtin_amdgcn_global_load_lds((const unsigned*)((const char*)(gbase) + (voff)[_i]), (PG8_LAS unsigned*)(lds + (bufoff) + ldsw + _i * 8192), 16, 0, 0); } while (0)
#define PG8_LDA(dst, b, h) do { _Pragma("unroll") for (int m = 0; m < 4; ++m) _Pragma("unroll") for (int k = 0; k < 2; ++k) dst[m][k] = *(const PG8_LAS bf16x8*)(lds + PG8_SA(b, h) + aoff + m * 2048 + k * 1024); } while (0)
#define PG8_LDB(dst, b, h) do { _Pragma("unroll") for (int n = 0; n < 2; ++n) _Pragma("unroll") for (int k = 0; k < 2; ++k) dst[n][k] = *(const PG8_LAS bf16x8*)(lds + PG8_SB(b, h) + boff + n * 2048 + k * 1024); } while (0)
#define PG8_MMA(ai, bj, At, Bt) do { __builtin_amdgcn_s_setprio(1); \
        if (SWP) { _Pragma("unroll") for (int m = 0; m < 4; ++m) _Pragma("unroll") for (int n = 0; n < 2; ++n) _Pragma("unroll") for (int k = 0; k < 2; ++k) \
            acc[ai][bj][m][n] = __builtin_amdgcn_mfma_f32_16x16x32_bf16(At[m][k], Bt[n][k], acc[ai][bj][m][n], 0, 0, 0); } \
        else { _Pragma("unroll") for (int m = 0; m < 4; ++m) _Pragma("unroll") for (int n = 0; n < 2; ++n) _Pragma("unroll") for (int k = 0; k < 2; ++k) \
            acc[ai][bj][m][n] = __builtin_amdgcn_mfma_f32_16x16x32_bf16(Bt[n][k], At[m][k], acc[ai][bj][m][n], 0, 0, 0); } \
        __builtin_amdgcn_s_setprio(0); } while (0)
#define PG8_WAIT_V(n) asm volatile("s_waitcnt vmcnt(" #n ")" ::: "memory")
#define PG8_WAIT_L(n) asm volatile("s_waitcnt lgkmcnt(" #n ")" ::: "memory")
#define PG8_BAR __builtin_amdgcn_s_barrier()
#define PG8_SCHED __builtin_amdgcn_sched_barrier(0)
    Unit cur, nxt; int ui = 0;
    if (!S.next(0, cur)) return;
    f32x4 acc[2][2][4][2];
#pragma unroll
    for (int a = 0; a < 2; ++a)
#pragma unroll
        for (int b = 0; b < 2; ++b)
#pragma unroll
            for (int m = 0; m < 4; ++m)
#pragma unroll
                for (int n = 0; n < 2; ++n) acc[a][b][m][n] = (f32x4){0.f, 0.f, 0.f, 0.f};
    bf16x8 At[4][2], B0[2][2], B1[2][2];
    const char* cA = (const char*)g.A + (size_t)cur.pm * tstep; const char* cB = (const char*)g.Bt + (size_t)cur.pn * tstep;
    S.a_ready(cur);
    if constexpr (SP2) {
        PG8_STAGE(PG8_SB(0, 0), cB, voffB); PG8_STAGE(PG8_SB(0, 1), cB + hstep, voffB); PG8_STAGE(PG8_SA(0, 0), cA, voffA); PG8_STAGE(PG8_SA(0, 1), cA + hstep, voffA);
        if (wr == 1) PG8_BAR;
        PG8_WAIT_V(2); PG8_BAR;
        PG8_STAGE(PG8_SB(1, 0), cB + kstep, voffB); PG8_STAGE(PG8_SA(1, 0), cA + kstep, voffA); PG8_STAGE(PG8_SB(1, 1), cB + hstep + kstep, voffB);
        PG8_WAIT_V(6); PG8_BAR;
    } else {
        PG8_STAGE(PG8_SB(0, 0), cB, voffB); PG8_STAGE(PG8_SA(0, 0), cA, voffA); PG8_STAGE(PG8_SB(0, 1), cB + hstep, voffB); PG8_STAGE(PG8_SA(0, 1), cA + hstep, voffA);
        if (wr == 1) PG8_BAR;
        PG8_WAIT_V(4); PG8_BAR;
        PG8_STAGE(PG8_SB(1, 0), cB + kstep, voffB); PG8_STAGE(PG8_SA(1, 0), cA + kstep, voffA); PG8_STAGE(PG8_SB(1, 1), cB + hstep + kstep, voffB);
        PG8_WAIT_V(6); PG8_BAR;
    }
    for (;;) {
        const bool has_next = S.next(ui + 1, nxt);
        const char* nA = has_next ? (const char*)g.A + (size_t)nxt.pm * tstep : cA; const char* nB = has_next ? (const char*)g.Bt + (size_t)nxt.pn * tstep : cB;
        for (int t = 0; t < nt; t += 2) {
            const bool last = (t == nt - 2);
            const char* a1 = cA + (size_t)(t + 1) * kstep;
            const char* a2 = last ? nA : cA + (size_t)(t + 2) * kstep; const char* b2 = last ? nB : cB + (size_t)(t + 2) * kstep;
            const char* a3 = a2 + kstep; const char* b3 = b2 + kstep;
            if (last && has_next) S.a_ready(nxt);
            if constexpr (SP2) {
            PG8_LDB(B0, 0, 0); PG8_LDB(B1, 0, 1); PG8_SCHED; PG8_LDA(At, 0, 0); PG8_STAGE(PG8_SA(1, 1), a1 + hstep, voffA);
            PG8_WAIT_V(8); PG8_WAIT_L(0); PG8_BAR; PG8_MMA(0, 0, At, B0); PG8_MMA(0, 1, At, B1); PG8_BAR; PG8_SCHED;
            PG8_LDA(At, 0, 1); PG8_STAGE(PG8_SB(0, 0), b2, voffB); PG8_STAGE(PG8_SB(0, 1), b2 + hstep, voffB); PG8_STAGE(PG8_SA(0, 0), a2, voffA);
            PG8_WAIT_V(8); PG8_WAIT_L(0); PG8_BAR; PG8_MMA(1, 0, At, B0); PG8_MMA(1, 1, At, B1); PG8_BAR; PG8_SCHED;
            PG8_LDB(B0, 1, 0); PG8_LDB(B1, 1, 1); PG8_SCHED; PG8_LDA(At, 1, 0); PG8_STAGE(PG8_SA(0, 1), a2 + hstep, voffA);
            PG8_WAIT_V(8); PG8_WAIT_L(0); PG8_BAR; PG8_MMA(0, 0, At, B0); PG8_MMA(0, 1, At, B1); PG8_BAR; PG8_SCHED;
            PG8_LDA(At, 1, 1); PG8_STAGE(PG8_SB(1, 0), b3, voffB); PG8_STAGE(PG8_SB(1, 1), b3 + hstep, voffB); PG8_STAGE(PG8_SA(1, 0), a3, voffA);
            PG8_WAIT_V(8); PG8_WAIT_L(0); PG8_BAR; PG8_MMA(1, 0, At, B0); PG8_MMA(1, 1, At, B1); PG8_BAR; PG8_SCHED;
            } else {
            PG8_LDB(B0, 0, 0); PG8_SCHED; PG8_LDA(At, 0, 0); PG8_STAGE(PG8_SA(1, 1), a1 + hstep, voffA);
            PG8_WAIT_L(8); PG8_BAR; PG8_WAIT_L(0); PG8_MMA(0, 0, At, B0); PG8_BAR; PG8_SCHED;
            PG8_LDB(B1, 0, 1); PG8_STAGE(PG8_SB(0, 0), b2, voffB);
            PG8_BAR; PG8_WAIT_L(0); PG8_MMA(0, 1, At, B1); PG8_BAR;
            PG8_LDA(At, 0, 1); PG8_STAGE(PG8_SA(0, 0), a2, voffA);
            PG8_BAR; PG8_WAIT_L(0); PG8_MMA(1, 0, At, B0); PG8_BAR; PG8_SCHED;
            PG8_STAGE(PG8_SB(0, 1), b2 + hstep, voffB);
            PG8_WAIT_V(6); PG8_BAR; PG8_MMA(1, 1, At, B1); PG8_BAR;
            PG8_LDB(B0, 1, 0); PG8_SCHED; PG8_LDA(At, 1, 0); PG8_STAGE(PG8_SA(0, 1), a2 + hstep, voffA);
            PG8_WAIT_L(8); PG8_BAR; PG8_WAIT_L(0); PG8_MMA(0, 0, At, B0); PG8_BAR; PG8_SCHED;
            PG8_LDB(B1, 1, 1); PG8_STAGE(PG8_SB(1, 0), b3, voffB);
            PG8_BAR; PG8_WAIT_L(0); PG8_MMA(0, 1, At, B1); PG8_BAR;
            PG8_LDA(At, 1, 1); PG8_STAGE(PG8_SA(1, 0), a3, voffA);
            PG8_BAR; PG8_WAIT_L(0); PG8_MMA(1, 0, At, B0); PG8_BAR; PG8_SCHED;
            PG8_STAGE(PG8_SB(1, 1), b3 + hstep, voffB);
            PG8_WAIT_V(6); PG8_BAR; PG8_MMA(1, 1, At, B1); PG8_BAR;
            }
        }
        if constexpr (ALIGN_EPI) { if (wr == 0) PG8_BAR; }
        if constexpr (!Epi::AFTER_DRAIN) { E(acc, cur, wr, wc, fr, fq); S.done(cur); }
        if (!has_next) break;
#pragma unroll
        for (int a = 0; a < 2; ++a)
#pragma unroll
            for (int b = 0; b < 2; ++b)
#pragma unroll
                for (int m = 0; m < 4; ++m)
#pragma unroll
                    for (int n = 0; n < 2; ++n) acc[a][b][m][n] = (f32x4){0.f, 0.f, 0.f, 0.f};
        cur = nxt; cA = nA; cB = nB; ++ui;
        if constexpr (ALIGN_EPI) { if (wr == 1) PG8_BAR; }
    }
    PG8_WAIT_V(0);
    if constexpr (!ALIGN_EPI) { if (wr == 0) PG8_BAR; }
    PG8_BAR;
    if constexpr (Epi::AFTER_DRAIN) { E.fused(acc, cur, wr, wc, fr, fq, lds, wid, lane); S.done(cur); }
#undef PG8_SA
#undef PG8_SB
#undef PG8_STAGE
#undef PG8_LDA
#undef PG8_LDB
#undef PG8_MMA
#undef PG8_WAIT_V
#undef PG8_WAIT_L
#undef PG8_BAR
#undef PG8_SCHED
}
}
__device__ __forceinline__ float row_rstd(const float* ssq, int row) {
    const f32x4* q = (const f32x4*)(ssq + (size_t)row * 16);
    const f32x4 a = q[0], b = q[1], c = q[2], d = q[3];
    return rsqrtf(((((a.x + a.y) + (a.z + a.w)) + ((b.x + b.y) + (b.z + b.w))) + (((c.x + c.y) + (c.z + c.w)) + ((d.x + d.y) + (d.z + d.w)))) * (1.f / DM) + EPS);
}
__device__ __forceinline__ void phase1_mfma(const Params& p, LAS unsigned char* lds) {
    pg8::Gemm g{(const pg8::bf16_t*)(p.ws + OFF_XN), (const pg8::bf16_t*)(p.ws + OFF_WIN), MROWS, NIN, DM};
    pg8::EpiP1 E{P1Ptrs{p.ws, p.in[10], p.in[12]}};
    const int vcu = vcu_of_block();
    pg8::P1Order S0{(int)gridDim.x, vcu, 10, MROWS / 256, false}, S1{(int)gridDim.x, vcu, 4, MROWS / 256, true};
    pg8::gemm_phase<pg8::EpiP1, pg8::P1Order, true, true, false>(lds, g, S0, E);
    pg8::gemm_phase<pg8::EpiP1, pg8::P1Order, true, true, true>(lds, g, S1, E);
    const int G = (int)gridDim.x, nun = MROWS / 256;
    const int mine = (10 * nun - vcu + G - 1) / G + (4 * nun - (G - 1 - vcu) + G - 1) / G, most = (10 * nun + G - 1) / G + 1;
    if (mine < most) {
        unsigned* ctr = (unsigned*)(p.ws + OFF_CTL) + 128;
        for (int k = 0; k < 3; ++k) {
            __syncthreads();
            if (threadIdx.x == 0) *(LAS unsigned*)(lds + LDS_Q) = atomicAdd(ctr, 1u);
            __syncthreads();
            const int c = (int)*(LAS unsigned*)(lds + LDS_Q);
            if (c >= CV_ITEMS) break;
            conv_item(p, (unsigned char*)lds, c);
        }
    }
}
__device__ __forceinline__ void phase3_mfma(const Params& p, LAS unsigned char* lds) {
    pg8::Gemm g{(const pg8::bf16_t*)(p.ws + OFF_MIX), (const pg8::bf16_t*)(p.ws + OFF_WOUT), NTOK, DM, DM};
    pg8::StaticOrder S; S.init(NTOK, DM, (int)gridDim.x, (int)blockIdx.x);
    pg8::EpiP3 E{p.in[0], p.out, (bf16_t*)(p.ws + OFF_H2B), (float*)(p.ws + OFF_SSQP)};
    pg8::gemm_phase<pg8::EpiP3, pg8::StaticOrder, true, true>(lds, g, S, E);
}

typedef float f32x16 __attribute__((ext_vector_type(16)));
constexpr int AT_KROW = 272, AT_VROW = 144, AT_KBYTES = 64 * AT_KROW, AT_VBYTES = 128 * AT_VROW, AT_STAGE = AT_KBYTES + AT_VBYTES;
__device__ __forceinline__ void attn_item(const Params& p, LAS unsigned char* lds, int item) {
    const int tid = threadIdx.x, lane = tid & 63, wave = __builtin_amdgcn_readfirstlane(tid >> 6), qg = wave >> 1, c = wave & 1, l31 = lane & 31, hh = lane >> 5;
    const int qt = item & 15, h = (item >> 4) & 3, b = item >> 6;
    const int r0 = b * SEQ + qt * 128;
    const bf16_t* QB = (const bf16_t*)(p.ws + OFF_QB); const bf16_t* KB = (const bf16_t*)(p.ws + OFF_KB); const bf16_t* VT = (const bf16_t*)(p.ws + OFF_VT);
    bf16x8 qf[4];
    {
        const bf16_t* qp = QB + (size_t)(r0 + qg * 32 + l31) * 512 + h * 128 + c * 64 + 8 * hh;
#pragma unroll
        for (int s = 0; s < 4; ++s) qf[s] = *(const bf16x8*)(qp + 16 * s);
    }
    f32x16 O[4];
#pragma unroll
    for (int i = 0; i < 4; ++i)
#pragma unroll
        for (int r = 0; r < 16; ++r) O[i][r] = 0.f;
    float m = 0.f, l = 0.f;
    const int kq0 = tid, kq1 = tid + 512;
    const bf16_t* kg0 = KB + (size_t)(kq0 >> 4) * 512 + h * 128 + (kq0 & 15) * 8; const bf16_t* kg1 = KB + (size_t)(kq1 >> 4) * 512 + h * 128 + (kq1 & 15) * 8;
    const bf16_t* vg0 = VT + (size_t)(h * 128 + (kq0 >> 3)) * MROWS + (kq0 & 7) * 8; const bf16_t* vg1 = VT + (size_t)(h * 128 + (kq1 >> 3)) * MROWS + (kq1 & 7) * 8;
    const int kl0 = (kq0 >> 4) * AT_KROW + (kq0 & 15) * 16, kl1 = (kq1 >> 4) * AT_KROW + (kq1 & 15) * 16;
    const int vl0 = AT_KBYTES + (kq0 >> 3) * AT_VROW + ((kq0 & 7) >> 1) * 32 + (kq0 & 1) * 8, vl1 = AT_KBYTES + (kq1 >> 3) * AT_VROW + ((kq1 & 7) >> 1) * 32 + (kq1 & 1) * 8;
    u32x4 kr0, kr1, vr0, vr1;
#define AT_LOAD(t) do { const size_t kro = (size_t)((t) < 32 ? b * SEQ + (t) * 64 : NTOK); \
        kr0 = *(const u32x4*)(kg0 + kro * 512); kr1 = *(const u32x4*)(kg1 + kro * 512); vr0 = *(const u32x4*)(vg0 + kro); vr1 = *(const u32x4*)(vg1 + kro); } while (0)
#define AT_WRITE(buf) do { LAS unsigned char* _b = lds + (buf) * AT_STAGE; \
        *(LAS u32x4*)(_b + kl0) = kr0; *(LAS u32x4*)(_b + kl1) = kr1; \
        *(LAS u32x2*)(_b + vl0) = (u32x2){vr0.x, vr0.y}; *(LAS u32x2*)(_b + vl0 + 16) = (u32x2){vr0.z, vr0.w}; \
        *(LAS u32x2*)(_b + vl1) = (u32x2){vr1.x, vr1.y}; *(LAS u32x2*)(_b + vl1 + 16) = (u32x2){vr1.z, vr1.w}; } while (0)
    __syncthreads();
    AT_LOAD(0); AT_WRITE(0); AT_LOAD(1); AT_WRITE(1);
    __syncthreads();
    int scur = 0;
    for (int t = 0; t < 33; ++t) {
        const int snxt2 = scur == 0 ? 2 : scur - 1;
        if (t + 2 < 33) AT_LOAD(t + 2);
        const LAS unsigned char* kb_ = lds + scur * AT_STAGE; const LAS unsigned char* vb_ = kb_ + AT_KBYTES;
        f32x16 s0, s1;
#pragma unroll
        for (int r = 0; r < 16; ++r) { s0[r] = -m; s1[r] = -m; }
#pragma unroll
        for (int s = 0; s < 4; ++s) {
            const bf16x8 k0 = *(const LAS bf16x8*)(kb_ + l31 * AT_KROW + (c * 64 + 16 * s + 8 * hh) * 2);
            s0 = __builtin_amdgcn_mfma_f32_32x32x16_bf16(k0, qf[s], s0, 0, 0, 0);
        }
#pragma unroll
        for (int s = 0; s < 4; ++s) {
            const bf16x8 k1 = *(const LAS bf16x8*)(kb_ + (32 + l31) * AT_KROW + (c * 64 + 16 * s + 8 * hh) * 2);
            s1 = __builtin_amdgcn_mfma_f32_32x32x16_bf16(k1, qf[s], s1, 0, 0, 0);
        }
        if (t == 32) {
#pragma unroll
            for (int r = 0; r < 16; ++r) { const int key = (r & 3) + 8 * (r >> 2) + 4 * hh; if (key >= 16) s0[r] = -1e30f; s1[r] = -1e30f; }
        }
        float mx = s0[0];
#pragma unroll
        for (int r = 1; r < 16; ++r) mx = fmaxf(mx, s0[r]);
#pragma unroll
        for (int r = 0; r < 16; ++r) mx = fmaxf(mx, s1[r]);
        mx = fmaxf(mx, __shfl_xor(mx, 32));
        if (t == 0 || __any(mx > 8.0f)) {
            const float d = t == 0 ? mx : fmaxf(mx, 0.f), alpha = __builtin_amdgcn_exp2f(-d);
            m += d; l *= alpha;
#pragma unroll
            for (int i = 0; i < 4; ++i) O[i] = O[i] * alpha;
#pragma unroll
            for (int r = 0; r < 16; ++r) { s0[r] -= d; s1[r] -= d; }
        }
        float ps = 0.f;
#define AT_PV(SREG, kb) do { \
        _Pragma("unroll") for (int r = 0; r < 16; ++r) { SREG[r] = __builtin_amdgcn_exp2f(SREG[r]); ps += SREG[r]; } \
        bf16x8 pf0, pf1; \
        { u32x4 a; a.x = pk2(SREG[0], SREG[1]); a.y = pk2(SREG[2], SREG[3]); a.z = pk2(SREG[4], SREG[5]); a.w = pk2(SREG[6], SREG[7]); pf0 = __builtin_bit_cast(bf16x8, a); \
          u32x4 bq; bq.x = pk2(SREG[8], SREG[9]); bq.y = pk2(SREG[10], SREG[11]); bq.z = pk2(SREG[12], SREG[13]); bq.w = pk2(SREG[14], SREG[15]); pf1 = __builtin_bit_cast(bf16x8, bq); } \
        _Pragma("unroll") for (int vb = 0; vb < 4; ++vb) { \
            const LAS unsigned char* vp = vb_ + (vb * 32 + l31) * AT_VROW + (kb) * 64 + hh * 16; \
            O[vb] = __builtin_amdgcn_mfma_f32_32x32x16_bf16(*(const LAS bf16x8*)vp, pf0, O[vb], 0, 0, 0); \
            O[vb] = __builtin_amdgcn_mfma_f32_32x32x16_bf16(*(const LAS bf16x8*)(vp + 32), pf1, O[vb], 0, 0, 0); } } while (0)
        AT_PV(s0, 0);
        AT_PV(s1, 1);
#undef AT_PV
        l += ps;
        if (t + 2 < 33) AT_WRITE(snxt2);
        __syncthreads();
        scur = scur == 2 ? 0 : scur + 1;
    }
    const float inv = 1.f / (l + __shfl_xor(l, 32));
    LAS float* X = (LAS float*)lds + qg * 4096;
    if (c == 1) {
#pragma unroll
        for (int vb = 0; vb < 4; ++vb)
#pragma unroll
            for (int r = 0; r < 16; ++r) X[(vb * 16 + r) * 64 + lane] = O[vb][r] * inv;
    }
    __syncthreads();
    if (c == 0) {
        const float lam = ((const float*)(p.ws + OFF_MISC))[0];
        float ss = 0.f;
#pragma unroll
        for (int vb = 0; vb < 4; ++vb)
#pragma unroll
            for (int r = 0; r < 16; ++r) { const float y = O[vb][r] * inv - lam * X[(vb * 16 + r) * 64 + lane]; O[vb][r] = y; ss += y * y; }
        ss += __shfl_xor(ss, 32);
        const float rs = rsqrtf(ss * (1.f / 128.f) + EPS) * 0.8f;
        bf16_t* orow = (bf16_t*)(p.ws + OFF_MIX) + (size_t)(r0 + qg * 32 + l31) * DM + h * 128;
#pragma unroll
        for (int vb = 0; vb < 4; ++vb)
#pragma unroll
            for (int rq = 0; rq < 4; ++rq) {
                const int v0 = vb * 32 + 8 * rq + 4 * hh;
                const f32x4 wlo = *(const f32x4*)(p.in[8] + vb * 32 + 8 * rq), whi = *(const f32x4*)(p.in[8] + vb * 32 + 8 * rq + 4);
                const f32x4 w = hh ? whi : wlo;
                u32x2 o; o.x = pk2(O[vb][4 * rq] * rs * w.x, O[vb][4 * rq + 1] * rs * w.y); o.y = pk2(O[vb][4 * rq + 2] * rs * w.z, O[vb][4 * rq + 3] * rs * w.w);
                *(u32x2*)(orow + v0) = o;
            }
    }
#undef AT_LOAD
#undef AT_WRITE
}
__device__ __forceinline__ void phase2_attn_mfma(const Params& p, LAS unsigned char* lds) {
    for (int it = vcu_of_block(); it < NB * 4 * 16; it += gridDim.x) attn_item(p, lds, it);
}


__device__ __forceinline__ int gsw(int row, int chunk) { return row * 128 + ((chunk ^ (row & 7)) << 4); }
constexpr int GL_SET = 40960;
constexpr int GL_QS = 0, GL_KS = 8192, GL_KT = 16384, GL_VT = 24576, GL_AT = 2 * GL_SET, GL_ST = GL_AT + 8192  , GL_DV = GL_ST + 32768  ;
__device__ __forceinline__ float dpp_scan64(float v) {
    v += __builtin_bit_cast(float, __builtin_amdgcn_update_dpp(0, __builtin_bit_cast(int, v), 0x111, 0xf, 0xf, false));
    v += __builtin_bit_cast(float, __builtin_amdgcn_update_dpp(0, __builtin_bit_cast(int, v), 0x112, 0xf, 0xf, false));
    v += __builtin_bit_cast(float, __builtin_amdgcn_update_dpp(0, __builtin_bit_cast(int, v), 0x114, 0xf, 0xf, false));
    v += __builtin_bit_cast(float, __builtin_amdgcn_update_dpp(0, __builtin_bit_cast(int, v), 0x118, 0xf, 0xf, false));
    v += __builtin_bit_cast(float, __builtin_amdgcn_update_dpp(0, __builtin_bit_cast(int, v), 0x142, 0xa, 0xf, false));
    v += __builtin_bit_cast(float, __builtin_amdgcn_update_dpp(0, __builtin_bit_cast(int, v), 0x143, 0xc, 0xf, false));
    return v;
}
struct GlaPre { f32x4 g0, g1; u32x4 q8, k8, v0, v1; };
struct GlaCtx { const bf16_t* GQ; const bf16_t* GK; const bf16_t* GVT; const float* G; bf16_t* O; int dir, h, b, nsteps, lane, wave, l15, g, vdv, vch; };
__device__ __forceinline__ int gla_rowbase(const GlaCtx& c, int st) { return c.dir ? c.b * SEQ + (31 - st) * 64 : (st == 0 ? NTOK : c.b * SEQ + (st - 1) * 64); }
__device__ __forceinline__ void gla_load(const GlaCtx& c, GlaPre& r, int st) {
    const int rb = gla_rowbase(c, st); const size_t row = (size_t)(rb + c.lane);
    r.g0 = *(const f32x4*)(c.G + row * 256 + c.h * 64 + 8 * c.wave); r.g1 = *(const f32x4*)(c.G + row * 256 + c.h * 64 + 8 * c.wave + 4);
    r.q8 = *(const u32x4*)(c.GQ + row * 256 + c.h * 64 + 8 * c.wave); r.k8 = *(const u32x4*)(c.GK + row * 256 + c.h * 64 + 8 * c.wave);
    r.v0 = *(const u32x4*)(c.GVT + (size_t)(c.h * 128 + c.vdv) * MROWS + rb + c.vch * 8); r.v1 = *(const u32x4*)(c.GVT + (size_t)(c.h * 128 + c.vdv) * MROWS + rb + c.vch * 8 + 8);
}
__device__ __forceinline__ void gla_step(const GlaCtx& c, LAS unsigned char* lds, GlaPre& r, f32x4 (&accS)[4], int st) {
    const int lane = c.lane, wave = c.wave, l15 = c.l15, g = c.g, dir = c.dir;
    const bool meta = (dir == 0 && st == 0);
    const int rowbase = gla_rowbase(c, st);
    LAS unsigned char* sb = lds + (st & 1) * GL_SET;
    float gg[8] = {r.g0.x, r.g0.y, r.g0.z, r.g0.w, r.g1.x, r.g1.y, r.g1.z, r.g1.w};
    if (meta && lane >= NMETA) {
#pragma unroll
        for (int e = 0; e < 8; ++e) gg[e] = 0.f;
    }
    const u32x4 q8 = r.q8, k8 = r.k8;
    float qv[8] = {bflo(q8.x), bfhi(q8.x), bflo(q8.y), bfhi(q8.y), bflo(q8.z), bfhi(q8.z), bflo(q8.w), bfhi(q8.w)};
    float kv[8] = {bflo(k8.x), bfhi(k8.x), bflo(k8.y), bfhi(k8.y), bflo(k8.z), bfhi(k8.z), bflo(k8.w), bfhi(k8.w)};
    float qn[8], kn[8], ks[8];
#pragma unroll
    for (int e = 0; e < 8; ++e) {
        const float P = dpp_scan64(gg[e]);
        const float T = __builtin_bit_cast(float, __builtin_amdgcn_readlane(__builtin_bit_cast(int, P), 63));
        const float Bv = dir ? (T - P + gg[e]) : P;
        const float eb = __expf(Bv), en = __builtin_amdgcn_rcpf(eb), eT = __expf(T);
        qn[e] = qv[e] * eb; kn[e] = kv[e] * en; ks[e] = kn[e] * eT;
        if (lane == 0) *(LAS float*)(lds + GL_DV + (st & 1) * 256 + (8 * wave + e) * 4) = eT;
    }
    *(LAS u32x4*)(sb + GL_QS + gsw(lane, wave)) = (u32x4){pk2(qn[0], qn[1]), pk2(qn[2], qn[3]), pk2(qn[4], qn[5]), pk2(qn[6], qn[7])};
    *(LAS u32x4*)(sb + GL_KS + gsw(lane, wave)) = (u32x4){pk2(kn[0], kn[1]), pk2(kn[2], kn[3]), pk2(kn[4], kn[5]), pk2(kn[6], kn[7])};
#pragma unroll
    for (int e = 0; e < 8; e += 2) { const unsigned w = pk2(ks[e], ks[e + 1]);
        *(LAS unsigned short*)(sb + GL_KT + gsw(8 * wave + e, lane >> 3) + (lane & 7) * 2) = (unsigned short)w;
        *(LAS unsigned short*)(sb + GL_KT + gsw(8 * wave + e + 1, lane >> 3) + (lane & 7) * 2) = (unsigned short)(w >> 16); }
    *(LAS u32x4*)(sb + GL_VT + gsw(c.vdv, c.vch)) = r.v0; *(LAS u32x4*)(sb + GL_VT + gsw(c.vdv, c.vch + 1)) = r.v1;
    if (st + 2 < c.nsteps) gla_load(c, r, st + 2);
    __syncthreads();
    const LAS unsigned char* STo = lds + GL_ST + (st & 1) * 16384; LAS unsigned char* STn = lds + GL_ST + ((st + 1) & 1) * 16384;
    if (!meta) {
        const int jb = wave >> 1;
#pragma unroll
        for (int ii = 0; ii < 2; ++ii) {
            const int ib = 2 * (wave & 1) + ii;
            f32x4 a = (f32x4){0.f, 0.f, 0.f, 0.f};
            const bool live = dir ? (jb >= ib) : (jb <= ib);
            if (live) {
#pragma unroll
                for (int ks2 = 0; ks2 < 2; ++ks2) {
                    const bf16x8 kf = *(const LAS bf16x8*)(sb + GL_KS + gsw(jb * 16 + l15, ks2 * 4 + g));
                    const bf16x8 qf = *(const LAS bf16x8*)(sb + GL_QS + gsw(ib * 16 + l15, ks2 * 4 + g));
                    a = __builtin_amdgcn_mfma_f32_16x16x32_bf16(kf, qf, a, 0, 0, 0);
                }
                const int i = ib * 16 + l15, j0 = jb * 16 + 4 * g;
#pragma unroll
                for (int rr = 0; rr < 4; ++rr) { const bool keep = dir ? (j0 + rr >= i) : (j0 + rr <= i); a[rr] = keep ? a[rr] : 0.f; }
            }
            const int i = ib * 16 + l15, j0 = jb * 16 + 4 * g;
            *(LAS u32x2*)(lds + GL_AT + gsw(i, j0 >> 3) + (j0 & 7) * 2) = (u32x2){pk2(a[0], a[1]), pk2(a[2], a[3])};
        }
    }
    if (st + 1 < c.nsteps) {
#pragma unroll
        for (int kb = 0; kb < 4; ++kb) {
            const f32x4 dvv = *(const LAS f32x4*)(lds + GL_DV + (st & 1) * 256 + (kb * 16 + 4 * g) * 4);
            f32x4 a = accS[kb] * dvv;
#pragma unroll
            for (int ks2 = 0; ks2 < 2; ++ks2) {
                const bf16x8 kf = *(const LAS bf16x8*)(sb + GL_KT + gsw(kb * 16 + l15, ks2 * 4 + g));
                const bf16x8 vf = *(const LAS bf16x8*)(sb + GL_VT + gsw(wave * 16 + l15, ks2 * 4 + g));
                a = __builtin_amdgcn_mfma_f32_16x16x32_bf16(kf, vf, a, 0, 0, 0);
            }
            accS[kb] = a;
            const int dk0 = kb * 16 + 4 * g;
            *(LAS u32x2*)(STn + gsw(wave * 16 + l15, dk0 >> 3) + (dk0 & 7) * 2) = (u32x2){pk2(a[0], a[1]), pk2(a[2], a[3])};
        }
    }
    __syncthreads();
    if (!meta) {
#pragma unroll
        for (int ib = 0; ib < 4; ++ib) {
            f32x4 a = (f32x4){0.f, 0.f, 0.f, 0.f};
#pragma unroll
            for (int ks2 = 0; ks2 < 2; ++ks2) {
                const bf16x8 vf = *(const LAS bf16x8*)(sb + GL_VT + gsw(wave * 16 + l15, ks2 * 4 + g));
                const bf16x8 af = *(const LAS bf16x8*)(lds + GL_AT + gsw(ib * 16 + l15, ks2 * 4 + g));
                a = __builtin_amdgcn_mfma_f32_16x16x32_bf16(vf, af, a, 0, 0, 0);
                const bf16x8 sf = *(const LAS bf16x8*)(STo + gsw(wave * 16 + l15, ks2 * 4 + g));
                const bf16x8 qf = *(const LAS bf16x8*)(sb + GL_QS + gsw(ib * 16 + l15, ks2 * 4 + g));
                a = __builtin_amdgcn_mfma_f32_16x16x32_bf16(sf, qf, a, 0, 0, 0);
            }
            *(u32x2*)(c.O + (size_t)(rowbase + ib * 16 + l15) * 512 + c.h * 128 + wave * 16 + 4 * g) = (u32x2){pk2(a[0], a[1]), pk2(a[2], a[3])};
        }
    }
}
__device__ __forceinline__ void gla_chain(const Params& p, LAS unsigned char* lds, int item) {
    const int tid = threadIdx.x;
    GlaCtx c;
    c.lane = tid & 63; c.wave = __builtin_amdgcn_readfirstlane(tid >> 6); c.l15 = c.lane & 15; c.g = c.lane >> 4;
    c.dir = item & 1; c.h = (item >> 1) & 3; c.b = item >> 3;
    c.GQ = (const bf16_t*)(p.ws + OFF_GQ); c.GK = (const bf16_t*)(p.ws + OFF_GK); c.GVT = (const bf16_t*)(p.ws + OFF_GVT);
    c.G = (const float*)(p.ws + (c.dir ? OFF_GB : OFF_GF));
    c.O = (bf16_t*)p.out + (c.dir ? (size_t)NTOK * 512 : 0);
    c.nsteps = c.dir ? 32 : 33; c.vdv = tid >> 2; c.vch = (tid & 3) * 2;
    f32x4 accS[4];
#pragma unroll
    for (int i = 0; i < 4; ++i) accS[i] = (f32x4){0.f, 0.f, 0.f, 0.f};
    __syncthreads();
    *(LAS u32x4*)(lds + GL_ST + tid * 32) = (u32x4){0u, 0u, 0u, 0u}; *(LAS u32x4*)(lds + GL_ST + tid * 32 + 16) = (u32x4){0u, 0u, 0u, 0u};
    GlaPre X, Y;
    gla_load(c, X, 0); gla_load(c, Y, 1);
    for (int st = 0; st < c.nsteps; st += 2) {
        gla_step(c, lds, X, accS, st);
        if (st + 1 < c.nsteps) gla_step(c, lds, Y, accS, st + 1);
    }
    asm volatile("s_waitcnt vmcnt(0)" ::: "memory");
    __syncthreads();
    if (tid == 0) {
        __builtin_amdgcn_fence(__ATOMIC_RELEASE, "agent");
        asm volatile("s_waitcnt vmcnt(0)" ::: "memory");
        __hip_atomic_fetch_add((unsigned*)(p.ws + OFF_CTL) + 4096 + (item >> 1) * 64, 1u, __ATOMIC_RELAXED, __HIP_MEMORY_SCOPE_AGENT);
    }
}
__device__ __forceinline__ void gla_combine_item(const Params& p, LAS unsigned char* lds, int item) {
    const int tid = threadIdx.x, lane = tid & 63, wave = tid >> 6;
    const int bh = item >> 3, part = item & 7, b = bh >> 2, h = bh & 3;
    if (tid == 0) {
        unsigned* flag = (unsigned*)(p.ws + OFF_CTL) + 4096 + bh * 64;
        unsigned spins = 0;
        while (__hip_atomic_load(flag, __ATOMIC_RELAXED, __HIP_MEMORY_SCOPE_AGENT) < 2u) { __builtin_amdgcn_s_sleep(8); if (++spins > (1u << 22)) break; }
        __builtin_amdgcn_fence(__ATOMIC_ACQUIRE, "agent");
        asm volatile("s_waitcnt vmcnt(0)" ::: "memory");
    }
    __syncthreads();
    const bf16_t* GR = (const bf16_t*)(p.ws + OFF_GR); bf16_t* MIX = (bf16_t*)(p.ws + OFF_MIX);
    const bf16_t* OF = (const bf16_t*)p.out; const bf16_t* OBk = OF + (size_t)NTOK * 512;
    const int c0 = h * 128 + (lane & 15) * 8;
    const f32x4 w0 = *(const f32x4*)(p.in[13] + (lane & 15) * 8), w1 = *(const f32x4*)(p.in[13] + (lane & 15) * 8 + 4);
#pragma unroll 2
    for (int i = 0; i < 8; ++i) {
        const int r = b * SEQ + part * 256 + wave * 32 + i * 4 + (lane >> 4);
        const u32x4 a = *(const u32x4*)(OF + (size_t)r * 512 + c0), bq = *(const u32x4*)(OBk + (size_t)r * 512 + c0);
        const f32x4 x0 = (f32x4){bflo(a.x) + bflo(bq.x), bfhi(a.x) + bfhi(bq.x), bflo(a.y) + bflo(bq.y), bfhi(a.y) + bfhi(bq.y)};
        const f32x4 x1 = (f32x4){bflo(a.z) + bflo(bq.z), bfhi(a.z) + bfhi(bq.z), bflo(a.w) + bflo(bq.w), bfhi(a.w) + bfhi(bq.w)};
        float s = x0.x * x0.x + x0.y * x0.y + x0.z * x0.z + x0.w * x0.w + x1.x * x1.x + x1.y * x1.y + x1.z * x1.z + x1.w * x1.w;
        s += __shfl_xor(s, 1); s += __shfl_xor(s, 2); s += __shfl_xor(s, 4); s += __shfl_xor(s, 8);
        const float rs = rsqrtf(s * (1.f / 128.f) + EPS);
        const u32x4 g = *(const u32x4*)(GR + (size_t)r * 512 + c0);
        u32x4 o;
        o.x = pk2(x0.x * rs * w0.x * bflo(g.x), x0.y * rs * w0.y * bfhi(g.x)); o.y = pk2(x0.z * rs * w0.z * bflo(g.y), x0.w * rs * w0.w * bfhi(g.y));
        o.z = pk2(x1.x * rs * w1.x * bflo(g.z), x1.y * rs * w1.y * bfhi(g.z)); o.w = pk2(x1.z * rs * w1.z * bflo(g.w), x1.w * rs * w1.w * bfhi(g.w));
        *(u32x4*)(MIX + (size_t)r * DM + 512 + c0) = o;
    }
}

__device__ __forceinline__ void phase2(const Params& p, LAS unsigned char* lds, int qslot = 0) {
    unsigned* ctr = (unsigned*)(p.ws + OFF_CTL) + (qslot >= 2 ? 2048 + qslot * 64 : qslot * 64);
    int it;
#define P2_NEXT() do { __syncthreads(); if (threadIdx.x == 0) *(LAS unsigned*)(lds + LDS_Q) = atomicAdd(ctr, 1u); __syncthreads(); it = (int)*(LAS unsigned*)(lds + LDS_Q); } while (0)
    P2_NEXT();
    if (qslot != 3) { while (it < 64) { gla_chain(p, lds, it); P2_NEXT(); } }
    if (qslot == 2) return;
    if (qslot == 3) it += 64;
    while (it < 64 + NB * 4 * 16) { attn_item(p, lds, it - 64); P2_NEXT(); if (qslot == 3) it += 64; }
    if (qslot) return;
    for (;;) {
        __syncthreads();
        if (threadIdx.x == 0) *(LAS unsigned*)(lds + LDS_Q) = atomicAdd(ctr + 192, 1u);
        __syncthreads();
        const int c = (int)*(LAS unsigned*)(lds + LDS_Q);
        if (c >= 256) break;
        gla_combine_item(p, lds, c);
    }
    for (;;) {
        __syncthreads();
        if (threadIdx.x == 0) *(LAS unsigned*)(lds + LDS_Q) = atomicAdd(ctr + 128, 1u);
        __syncthreads();
        const int c = (int)*(LAS unsigned*)(lds + LDS_Q);
        if (c >= CV_ITEMS) break;
        conv_item(p, (unsigned char*)lds, c);
    }
#undef P2_NEXT
}

__device__ __forceinline__ void phase2c(const Params& p) {
    const int tid = threadIdx.x, lane = tid & 63, wave = tid >> 6;
    const int gw = blockIdx.x * 8 + wave, NGW = gridDim.x * 8;
    const bf16_t* GR = (const bf16_t*)(p.ws + OFF_GR); bf16_t* MIX = (bf16_t*)(p.ws + OFF_MIX);
    const bf16_t* OF = (const bf16_t*)p.out; const bf16_t* OBk = OF + (size_t)NTOK * 512;
    const int c0 = lane * 8;
    const f32x4 w0 = *(const f32x4*)(p.in[13] + (c0 & 127)), w1 = *(const f32x4*)(p.in[13] + (c0 & 127) + 4);
    for (int r = gw; r < NTOK; r += NGW) {
        const u32x4 a = *(const u32x4*)(OF + (size_t)r * 512 + c0), bq = *(const u32x4*)(OBk + (size_t)r * 512 + c0);
        const f32x4 x0 = (f32x4){bflo(a.x) + bflo(bq.x), bfhi(a.x) + bfhi(bq.x), bflo(a.y) + bflo(bq.y), bfhi(a.y) + bfhi(bq.y)};
        const f32x4 x1 = (f32x4){bflo(a.z) + bflo(bq.z), bfhi(a.z) + bfhi(bq.z), bflo(a.w) + bflo(bq.w), bfhi(a.w) + bfhi(bq.w)};
        float s = x0.x * x0.x + x0.y * x0.y + x0.z * x0.z + x0.w * x0.w + x1.x * x1.x + x1.y * x1.y + x1.z * x1.z + x1.w * x1.w;
        s += __shfl_xor(s, 1); s += __shfl_xor(s, 2); s += __shfl_xor(s, 4); s += __shfl_xor(s, 8);
        const float rs = rsqrtf(s * (1.f / 128.f) + EPS);
        const u32x4 g = *(const u32x4*)(GR + (size_t)r * 512 + c0);
        u32x4 o;
        o.x = pk2(x0.x * rs * w0.x * bflo(g.x), x0.y * rs * w0.y * bfhi(g.x)); o.y = pk2(x0.z * rs * w0.z * bflo(g.y), x0.w * rs * w0.w * bfhi(g.y));
        o.z = pk2(x1.x * rs * w1.x * bflo(g.z), x1.y * rs * w1.y * bfhi(g.z)); o.w = pk2(x1.z * rs * w1.z * bflo(g.w), x1.w * rs * w1.w * bfhi(g.w));
        *(u32x4*)(MIX + (size_t)r * DM + 512 + c0) = o;
    }
}


#define TOPK_INS(L, x) do { float _x = (x); _Pragma("unroll") for (int _s = 0; _s < 16; ++_s) { const float _t = fmaxf(L[_s], _x); _x = fminf(L[_s], _x); L[_s] = _t; } } while (0)
constexpr int P4_QROW = 528, P4_SC0 = 128 * P4_QROW  , P4_TLROW = 144;

#define CE_DESC(a, b) do { const float _hi = fmaxf(a, b), _lo = fminf(a, b); a = _hi; b = _lo; } while (0)
__device__ __forceinline__ void bitonic_sort16_desc(float (&x)[16]) {
#pragma unroll
    for (int k = 2; k <= 16; k <<= 1)
#pragma unroll
        for (int j = k >> 1; j > 0; j >>= 1)
#pragma unroll
            for (int i = 0; i < 16; ++i) { const int l = i ^ j; if (l > i) { if ((i & k) == 0) CE_DESC(x[i], x[l]); else CE_DESC(x[l], x[i]); } }
}
__device__ __forceinline__ void bitonic_merge16_desc(float (&x)[16]) {
#pragma unroll
    for (int j = 8; j > 0; j >>= 1)
#pragma unroll
        for (int i = 0; i < 16; ++i) { const int l = i ^ j; if (l > i) CE_DESC(x[i], x[l]); }
}
__device__ __forceinline__ void top16_merge(float (&L)[16], const float (&x)[16]) {
#pragma unroll
    for (int i = 0; i < 16; ++i) L[i] = fmaxf(L[i], x[15 - i]);
    bitonic_merge16_desc(L);
}

template <int Q> struct CandIJ {
    static constexpr int compute() { int c = 0; for (int i = 0; i < 16; ++i) for (int j = 0; j < 16; ++j) if ((i + 1) * (j + 1) <= 16) { if (c == Q) return i * 16 + j; ++c; } return -1; }
    static constexpr int v = compute();
};
template <int G, int S> __device__ __forceinline__ void cand_fill(float (&x)[16], const float (&A)[16], const float (&Bv)[16]) {
    constexpr int ij = CandIJ<G * 16 + S>::v;
    if constexpr (ij >= 0) x[S] = __uint_as_float((__float_as_uint(A[ij >> 4] + Bv[ij & 15]) & ~255u) | (unsigned)ij); else x[S] = -3.0e38f;
    if constexpr (S + 1 < 16) cand_fill<G, S + 1>(x, A, Bv);
}
__device__ __forceinline__ void p4_route_half(const Params& p, LAS unsigned char* lds, int m0, int h) {
    int tid_ = threadIdx.x; asm volatile("" : "+v"(tid_));
    const int tid = tid_, lane = tid & 63, wave = __builtin_amdgcn_readfirstlane(tid >> 6), l15 = lane & 15, g = lane >> 4;
    const bf16_t* KEYS = (const bf16_t*)(p.ws + OFF_KEYS); unsigned* PW0 = (unsigned*)(p.ws + OFF_PW0);
        {
            const int wr = wave >> 1, wk = wave & 1;
            f32x4 sc[2][2][4];
#pragma unroll
            for (int pp = 0; pp < 2; ++pp) {
#pragma unroll
                for (int rb = 0; rb < 2; ++rb)
#pragma unroll
                    for (int kk = 0; kk < 4; ++kk) sc[pp][rb][kk] = (f32x4){0.f, 0.f, 0.f, 0.f};
                const bf16_t* kbase = KEYS + (size_t)((h * 2 + pp) * 128 + 64 * wk + l15) * 128 + 8 * g;
#pragma unroll
                for (int ks = 0; ks < 4; ++ks) {
                    bf16x8 qf[2], kf[4];
#pragma unroll
                    for (int rb = 0; rb < 2; ++rb) qf[rb] = *(const LAS bf16x8*)(lds + (32 * wr + 16 * rb + l15) * P4_QROW + (pp * 128 + ks * 32 + 8 * g) * 2);
#pragma unroll
                    for (int kk = 0; kk < 4; ++kk) kf[kk] = *(const bf16x8*)(kbase + (size_t)(16 * kk) * 128 + ks * 32);
#pragma unroll
                    for (int rb = 0; rb < 2; ++rb)
#pragma unroll
                        for (int kk = 0; kk < 4; ++kk) sc[pp][rb][kk] = __builtin_amdgcn_mfma_f32_16x16x32_bf16(kf[kk], qf[rb], sc[pp][rb][kk], 0, 0, 0);
                }
            }
#pragma unroll
            for (int rb = 0; rb < 2; ++rb)
#pragma unroll
                for (int kk = 0; kk < 4; ++kk) *(LAS f32x4*)(lds + P4_SC0 + (32 * wr + 16 * rb + l15) * P4_QROW + (64 * wk + 16 * kk + 4 * g) * 4) = sc[0][rb][kk];
            __syncthreads();
#pragma unroll
            for (int rb = 0; rb < 2; ++rb)
#pragma unroll
                for (int kk = 0; kk < 4; ++kk) *(LAS f32x4*)(lds + (32 * wr + 16 * rb + l15) * P4_QROW + (64 * wk + 16 * kk + 4 * g) * 4) = sc[1][rb][kk];
        }
        __syncthreads();
        {
            const int hf = tid & 1, row = (tid >> 1) & 127, pp = tid >> 8;
            const LAS unsigned char* sp = lds + (pp ? 0 : P4_SC0) + row * P4_QROW + hf * 256;
            float L[16];
#pragma unroll
            for (int grp = 0; grp < 4; ++grp) {
                float x[16];
#pragma unroll
                for (int q4 = 0; q4 < 4; ++q4) {
                    const f32x4 v = *(const LAS f32x4*)(sp + (grp * 4 + q4) * 16);
                    const unsigned kb = (unsigned)(hf * 64 + grp * 16 + q4 * 4);
                    x[4 * q4 + 0] = __uint_as_float((__float_as_uint(v.x) & ~127u) | kb);
                    x[4 * q4 + 1] = __uint_as_float((__float_as_uint(v.y) & ~127u) | (kb + 1));
                    x[4 * q4 + 2] = __uint_as_float((__float_as_uint(v.z) & ~127u) | (kb + 2));
                    x[4 * q4 + 3] = __uint_as_float((__float_as_uint(v.w) & ~127u) | (kb + 3));
                }
                bitonic_sort16_desc(x);
                if (grp == 0) {
#pragma unroll
                    for (int s = 0; s < 16; ++s) L[s] = x[s];
                } else top16_merge(L, x);
            }
            {
                float Oth[16];
#pragma unroll
                for (int s = 0; s < 16; ++s) Oth[s] = __shfl_xor(L[s], 1);
                top16_merge(L, Oth);
            }
            __syncthreads();
            if (hf == 0) {
                LAS f32x4* tl = (LAS f32x4*)(lds + P4_SC0 + row * (2 * P4_TLROW) + pp * P4_TLROW);
                tl[0] = (f32x4){L[0], L[1], L[2], L[3]}; tl[1] = (f32x4){L[4], L[5], L[6], L[7]}; tl[2] = (f32x4){L[8], L[9], L[10], L[11]}; tl[3] = (f32x4){L[12], L[13], L[14], L[15]};
            }
        }
        __syncthreads();
        if (tid < 128) {
            const LAS unsigned char* tl = lds + P4_SC0 + tid * (2 * P4_TLROW);
            float A[16], Bv[16];
#pragma unroll
            for (int q4 = 0; q4 < 4; ++q4) { const f32x4 a = *(const LAS f32x4*)(tl + q4 * 16), b = *(const LAS f32x4*)(tl + P4_TLROW + q4 * 16);
                A[4 * q4] = a.x; A[4 * q4 + 1] = a.y; A[4 * q4 + 2] = a.z; A[4 * q4 + 3] = a.w; Bv[4 * q4] = b.x; Bv[4 * q4 + 1] = b.y; Bv[4 * q4 + 2] = b.z; Bv[4 * q4 + 3] = b.w; }
#pragma unroll
            for (int s = 0; s < 16; ++s) { A[s] = __uint_as_float(__float_as_uint(A[s]) & ~127u); Bv[s] = __uint_as_float(__float_as_uint(Bv[s]) & ~127u); }
            float L[16];
            {
                float x[16];
                cand_fill<0, 0>(x, A, Bv); bitonic_sort16_desc(x);
#pragma unroll
                for (int s = 0; s < 16; ++s) L[s] = x[s];
                cand_fill<1, 0>(x, A, Bv); bitonic_sort16_desc(x); top16_merge(L, x);
                cand_fill<2, 0>(x, A, Bv); bitonic_sort16_desc(x); top16_merge(L, x);
                cand_fill<3, 0>(x, A, Bv); bitonic_sort16_desc(x); top16_merge(L, x);
            }
            const float v0 = __uint_as_float(__float_as_uint(L[0]) & ~255u);
            float e[16], den = 0.f; int id[16];
#pragma unroll
            for (int s = 0; s < 16; ++s) {
                const unsigned u = __float_as_uint(L[s]);
                e[s] = __expf(__uint_as_float(u & ~255u) - v0); den += e[s];
                const unsigned i = (u >> 4) & 15u, j = u & 15u;
                const unsigned ka = *(const LAS unsigned*)(tl + i * 4) & 127u, kb = *(const LAS unsigned*)(tl + P4_TLROW + j * 4) & 127u;
                id[s] = (int)(ka * 128u + kb);
            }
            const float inv = 1.f / den;
            unsigned* ip = PW0 + (size_t)(m0 + tid) * 128 + h * 16;
#pragma unroll
            for (int q4 = 0; q4 < 4; ++q4) { u32x4 o;
#pragma unroll
                for (int c = 0; c < 4; ++c) o[c] = (unsigned)id[4 * q4 + c] | (f2bf(e[4 * q4 + c] * inv) << 16);
                *(u32x4*)(ip + 4 * q4) = o; }
        }
        __syncthreads();
}

namespace pg8 {
struct EpiP4 {
    static constexpr bool PERM = true, AFTER_DRAIN = true, SWAPPABLE = false;
    const Params* pp; const float* ssq;
    __device__ __forceinline__ void operator()(const f32x4 (&)[2][2][4][2], const Unit&, int, int, int, int) const {}
    __device__ __forceinline__ void fused(f32x4 (&acc)[2][2][4][2], const Unit& u, int wr, int wc, int fr, int fq, PG8_LAS unsigned char* lds, int wid, int lane) const {
#pragma unroll
        for (int ai = 0; ai < 2; ++ai) {
            const int m0 = u.pm * BM + ai * HALF;
#pragma unroll
            for (int m = 0; m < 4; ++m) {
                const int rl = wr * 64 + m * 16 + fr;
                const float rstd = row_rstd(ssq, m0 + rl);
#pragma unroll
                for (int bj = 0; bj < 2; ++bj) { const f32x4 v0 = acc[ai][bj][m][0] * rstd, v1 = acc[ai][bj][m][1] * rstd;
                    *(PG8_LAS u32x4*)(lds + rl * P4_QROW + (bj * HALF + wc * 32 + 8 * fq) * 2) = (u32x4){pk2(v0.x, v0.y), pk2(v0.z, v0.w), pk2(v1.x, v1.y), pk2(v1.z, v1.w)}; }
            }
            __syncthreads();
            p4_route_half(*pp, lds, m0, u.pn);
        }
    }
};
}
__device__ __forceinline__ void phase4_mfma(const Params& p, LAS unsigned char* lds) {
    pg8::Gemm g{(const pg8::bf16_t*)(p.ws + OFF_H2B), (const pg8::bf16_t*)(p.ws + OFF_WQ), NTOK, 2048, DM};
    pg8::EpiP4 E{&p, (const float*)(p.ws + OFF_SSQP)};
    const int vcu = vcu_of_block();
    for (int r = 0; r * (int)gridDim.x < 512; ++r) {
        const int L = r * (int)gridDim.x + vcu;
        pg8::OneUnit S; S.u.pm = L >> 3; S.u.pn = L & 7; S.valid = L < 512;
        pg8::gemm_phase<pg8::EpiP4, pg8::OneUnit, false, true>(lds, g, S, E);
        __syncthreads();
    }
}


constexpr size_t OFF_PW = 73 * MiB;
constexpr size_t OFF_OUTS = 179 * MiB;
static_assert(OFF_OUTS >= OFF_PW0 + (size_t)NTOK * 128 * 4 && OFF_OUTS + (size_t)NTOK * DM * 4 <= 256 * MiB, "P5 map");
__device__ __forceinline__ float dot_fp8_bf16(u32x4 uq, u32x4 h0, u32x4 h1, float c) {
#define DQ2(word, hsel, hw) c = dot2(__builtin_bit_cast(unsigned, __builtin_amdgcn_cvt_scalef32_pk_bf16_fp8((int)(word), 1.0f, hsel)), hw, c)
    DQ2(uq.x, false, h0.x); DQ2(uq.x, true, h0.y); DQ2(uq.y, false, h0.z); DQ2(uq.y, true, h0.w);
    DQ2(uq.z, false, h1.x); DQ2(uq.z, true, h1.y); DQ2(uq.w, false, h1.z); DQ2(uq.w, true, h1.w);
#undef DQ2
    return c;
}
constexpr int P5A_RS = 1040, P5A_LIST = 16640, P5A_RES = 18688, P5A_TSC = 18752, P5A_WAVE = 19456;
constexpr size_t OFF_HQ = 146 * MiB;
constexpr size_t OFF_HSC = 192 * 1024;
static_assert(8 * P5A_WAVE <= LDS_BYTES - 32, "P5a LDS");
static_assert(OFF_HQ >= OFF_H2B + (size_t)NTOK * DM * 2 && OFF_HQ + (size_t)NTOK * DM <= OFF_PW0, "HQ map");
__device__ __forceinline__ void quantize_hn(const Params& p) {
    const int tid = threadIdx.x, lane = tid & 63, wave = tid >> 6;
    const bf16_t* H2B = (const bf16_t*)(p.ws + OFF_H2B); unsigned char* HQ = p.ws + OFF_HQ; float* HSC = (float*)(p.ws + OFF_HSC);
    for (int t = blockIdx.x * 8 + wave; t < NTOK; t += gridDim.x * 8) {
        const u32x4 h0 = *(const u32x4*)(H2B + (size_t)t * DM + 16 * lane), h1 = *(const u32x4*)(H2B + (size_t)t * DM + 16 * lane + 8);
        float m = 0.f;
#pragma unroll
        for (int c = 0; c < 4; ++c) { m = fmaxf(m, fmaxf(fabsf(bflo(h0[c])), fabsf(bfhi(h0[c])))); m = fmaxf(m, fmaxf(fabsf(bflo(h1[c])), fabsf(bfhi(h1[c])))); }
        const float am = fmaxf(wave_max(m), 1e-30f), qs = 224.f / am;
        u32x4 o;
#pragma unroll
        for (int c = 0; c < 2; ++c) {
            int w = __builtin_amdgcn_cvt_pk_fp8_f32(bflo(h0[2 * c]) * qs, bfhi(h0[2 * c]) * qs, 0, false); w = __builtin_amdgcn_cvt_pk_fp8_f32(bflo(h0[2 * c + 1]) * qs, bfhi(h0[2 * c + 1]) * qs, w, true); o[c] = (unsigned)w;
            int x = __builtin_amdgcn_cvt_pk_fp8_f32(bflo(h1[2 * c]) * qs, bfhi(h1[2 * c]) * qs, 0, false); x = __builtin_amdgcn_cvt_pk_fp8_f32(bflo(h1[2 * c + 1]) * qs, bfhi(h1[2 * c + 1]) * qs, x, true); o[2 + c] = (unsigned)x;
        }
        *(u32x4*)(HQ + (size_t)t * DM + 16 * lane) = o;
        if (lane == 0) HSC[t] = row_rstd((const float*)(p.ws + OFF_SSQP), t) * am * (1.f / 224.f);
    }
}
__device__ __forceinline__ void p5a_wave(const Params& p, LAS unsigned char* wl, int tb, int part, int lane, __amdgpu_buffer_rsrc_t urs, __amdgpu_buffer_rsrc_t hrs) {
    const float* USC = (const float*)(p.ws + OFF_USC); const float* VSC = (const float*)(p.ws + OFF_VSC); const float* HSC = (const float*)(p.ws + OFF_HSC);
    const unsigned* PW0 = (const unsigned*)(p.ws + OFF_PW0); unsigned* PW = (unsigned*)(p.ws + OFF_PW);
    const int l15 = lane & 15, g = lane >> 4;
    unsigned xl[4], xh[4]; float hsc = 0.f;
#define P5A_STAGE(t0_) do { _Pragma("unroll") for (int _k = 0; _k < 4; ++_k) { \
        __builtin_amdgcn_raw_ptr_buffer_load_lds(hrs, (LAS unsigned*)(wl + _k * 1024), 16, lane * 16, ((t0_) + _k) * 1024, 0, 0); \
        xl[_k] = PW0[(size_t)((t0_) + _k) * 128 + lane]; xh[_k] = PW0[(size_t)((t0_) + _k) * 128 + 64 + lane]; } \
        hsc = HSC[(t0_) + (lane & 3)]; } while (0)
#define P5A_GATHER(tile_) do { int _li = (tile_) * 16 + l15; _li = _li < n ? _li : n - 1; \
        const int _ev = (int)((*(const LAS unsigned*)(wl + P5A_LIST + _li * 4) & 0x3fffu) << 10); \
        _Pragma("unroll") for (int _r = 0; _r < 16; ++_r) \
            __builtin_amdgcn_raw_ptr_buffer_load_lds(urs, (LAS unsigned*)(wl + _r * P5A_RS), 16, lane * 16, __builtin_amdgcn_readlane(_ev, _r), 0, 0); } while (0)
    P5A_STAGE(tb);
    for (int st = 0; st < 4; ++st) {
        const int t0 = tb + 4 * st;
        asm volatile("s_waitcnt vmcnt(0)" ::: "memory");
        long bq[32];
#pragma unroll
        for (int i = 0; i < 16; ++i) { const u32x4 w = *(const LAS u32x4*)(wl + (l15 & 3) * 1024 + 64 * i + 16 * g);
            bq[2 * i] = __builtin_bit_cast(long, (u32x2){w.x, w.y}); bq[2 * i + 1] = __builtin_bit_cast(long, (u32x2){w.z, w.w}); }
        if (lane < 4) *(LAS float*)(wl + P5A_TSC + lane * 4) = hsc;
        int n = 0;
#pragma unroll
        for (int k = 0; k < 4; ++k) {
            const bool ml = (int)((xl[k] >> 11) & 7u) == part, mh = (int)((xh[k] >> 11) & 7u) == part;
            const unsigned long long bl = __ballot(ml), bh = __ballot(mh);
            const int rl = __builtin_amdgcn_mbcnt_hi((unsigned)(bl >> 32), __builtin_amdgcn_mbcnt_lo((unsigned)bl, 0u));
            if (ml) *(LAS unsigned*)(wl + P5A_LIST + (n + rl) * 4) = (xl[k] & 0x3fffu) | ((unsigned)lane << 14) | ((unsigned)k << 21);
            n += __popcll(bl);
            const int rh = __builtin_amdgcn_mbcnt_hi((unsigned)(bh >> 32), __builtin_amdgcn_mbcnt_lo((unsigned)bh, 0u));
            if (mh) *(LAS unsigned*)(wl + P5A_LIST + (n + rh) * 4) = (xh[k] & 0x3fffu) | ((unsigned)(64 + lane) << 14) | ((unsigned)k << 21);
            n += __popcll(bh);
        }
        __builtin_amdgcn_s_waitcnt(0xC07F); __builtin_amdgcn_wave_barrier();
        asm volatile("" ::: "memory");
        const int ntile = (n + 15) >> 4;
        if (ntile == 0) { if (st < 3) P5A_STAGE(t0 + 4); continue; }
#define P5A_OPS(tile_, EOK, EE, SL, TK, USCV, VSCV, XGV) do { int _ei = (tile_) * 16 + l15; EOK = _ei < n; _ei = EOK ? _ei : n - 1; \
        const unsigned _ent = *(const LAS unsigned*)(wl + P5A_LIST + _ei * 4); \
        EE = _ent & 0x3fffu; SL = (int)((_ent >> 14) & 127u); TK = (int)(_ent >> 21); \
        USCV = USC[EE]; VSCV = VSC[EE]; XGV = PW0[(size_t)(t0 + TK) * 128 + SL]; } while (0)
        bool eokN; unsigned eeN; int slN, tkN; float uscN, vscN; unsigned xgN;
        P5A_GATHER(0);
        P5A_OPS(0, eokN, eeN, slN, tkN, uscN, vscN, xgN);
        for (int tile = 0; tile < ntile; ++tile) {
            asm volatile("s_waitcnt vmcnt(0)" : "+v"(uscN), "+v"(vscN), "+v"(xgN) :: "memory");
            const bool eok = eokN; const unsigned ee = eeN; const int sl = slN, tk = tkN, t = t0 + tkN; const float usc = uscN, vsc = vscN; const unsigned xg = xgN;
            long aq[32];
#pragma unroll
            for (int i = 0; i < 16; ++i) { const u32x4 w = *(const LAS u32x4*)(wl + l15 * P5A_RS + 64 * i + 16 * g);
                aq[2 * i] = __builtin_bit_cast(long, (u32x2){w.x, w.y}); aq[2 * i + 1] = __builtin_bit_cast(long, (u32x2){w.z, w.w}); }
            asm volatile("s_waitcnt lgkmcnt(0)" ::: "memory");
#pragma unroll
            for (int s = 0; s < 32; ++s) asm volatile("" : "+v"(aq[s]));
            if (tile + 1 < ntile) { P5A_GATHER(tile + 1); P5A_OPS(tile + 1, eokN, eeN, slN, tkN, uscN, vscN, xgN); } else if (st < 3) P5A_STAGE(t0 + 4);
            f32x4 acc = (f32x4){0.f, 0.f, 0.f, 0.f};
#pragma unroll
            for (int s = 0; s < 32; ++s) acc = __builtin_amdgcn_mfma_f32_16x16x32_fp8_fp8(aq[s], bq[s], acc, 0, 0, 0);
            {
                const u32x4 en = *(const LAS u32x4*)(wl + P5A_LIST + (tile * 16 + 4 * g) * 4);
#pragma unroll
                for (int r = 0; r < 4; ++r) if ((int)(en[r] >> 21) == l15) *(LAS float*)(wl + P5A_RES + (4 * g + r) * 4) = acc[r];
            }
            __builtin_amdgcn_s_waitcnt(0xC07F); __builtin_amdgcn_wave_barrier();
            asm volatile("" ::: "memory");
            if (lane < 16 && eok) {
                const float d = *(const LAS float*)(wl + P5A_RES + lane * 4) * usc * *(const LAS float*)(wl + P5A_TSC + tk * 4);
                const float w = __uint_as_float(xg & 0xffff0000u) * gelu_f(d) * vsc;
                PW[(((size_t)(t >> 6) * 32 + (sl >> 2)) * 64 + (t & 63)) * 4 + (sl & 3)] = ee | (f2bf(w) << 16);
            }
            __builtin_amdgcn_s_waitcnt(0xC07F); __builtin_amdgcn_wave_barrier();
            asm volatile("" ::: "memory");
        }
#undef P5A_OPS
    }
    asm volatile("s_waitcnt vmcnt(0)" ::: "memory");
#undef P5A_STAGE
#undef P5A_GATHER
}
__device__ __forceinline__ void phase5a(const Params& p, LAS unsigned char* lds, int qoff = 0) {
    const int tid = threadIdx.x, lane = tid & 63, wave = __builtin_amdgcn_readfirstlane(tid >> 6);
    const int xcc = (int)(__builtin_amdgcn_s_getreg((3 << 11) | 20) & 7u);
    unsigned* qc = (unsigned*)(p.ws + OFF_CTL) + 256 + qoff;
    LAS unsigned char* wl = lds + wave * P5A_WAVE;
    const __amdgpu_buffer_rsrc_t urs = __builtin_amdgcn_make_buffer_rsrc((void*)(p.ws + OFF_UB), 0, NEXP * DM, 0x00020000);
    const __amdgpu_buffer_rsrc_t hrs = __builtin_amdgcn_make_buffer_rsrc((void*)(p.ws + OFF_HQ), 0, NTOK * DM, 0x00020000);
    for (int pi = 0; pi < 8; ++pi) {
        const int part = (xcc + pi) & 7;
        for (;;) {
            __syncthreads();
            if (tid == 0) *(LAS unsigned*)(lds + LDS_Q) = atomicAdd(qc + part * 64, 1u);
            __syncthreads();
            const int it = (int)*(LAS unsigned*)(lds + LDS_Q);
            if (it >= NTOK / 128) break;
            p5a_wave(p, wl, it * 128 + wave * 16, part, lane, urs, hrs);
        }
    }
}

__device__ __forceinline__ void p5b_quad(const LAS unsigned char* lds, u32x4 q, f32x2& a0, f32x2& a1, f32x2& a2, f32x2& a3) {
#pragma unroll
    for (int c = 0; c < 4; ++c) {
        const unsigned x = q[c];
        const u32x2 vv = *(const LAS u32x2*)(lds + ((x & 0x3fffu) << 3));
        const float w = __uint_as_float(x & 0xffff0000u); const f32x2 ww = (f32x2){w, w};
        a0 += ww * __builtin_amdgcn_cvt_pk_f32_fp8((int)vv.x, false); a1 += ww * __builtin_amdgcn_cvt_pk_f32_fp8((int)vv.x, true);
        a2 += ww * __builtin_amdgcn_cvt_pk_f32_fp8((int)vv.y, false); a3 += ww * __builtin_amdgcn_cvt_pk_f32_fp8((int)vv.y, true);
    }
}
__device__ __forceinline__ void phase5b(const Params& p, LAS unsigned char* lds) {
    const int tid = threadIdx.x, lane = tid & 63, wave = __builtin_amdgcn_readfirstlane(tid >> 6);
    const unsigned char* VS = p.ws + OFF_VB; const u32x4* PW = (const u32x4*)(p.ws + OFF_PW); bf16_t* OUTS = (bf16_t*)(p.ws + OFF_OUTS);
    for (int it = blockIdx.x; it < 256; it += gridDim.x) {
        const int s = it >> 1, tbase = (it & 1) * 128;
        __syncthreads();
#pragma unroll 4
        for (int i = 0; i < 16; ++i) *(LAS u32x4*)(lds + (tid + NTHR * i) * 16) = *(const u32x4*)(VS + (size_t)s * 131072 + (size_t)(tid + NTHR * i) * 16);
        __syncthreads();
        u32x4 A[8], Bq[8];
#define P5B_LOAD(R, gi) do { const int _T = tbase + wave + 8 * ((gi) >> 2), _g = (gi) & 3; const u32x4* _p = PW + ((size_t)_T * 32 + _g * 8) * 64 + lane; \
        _Pragma("unroll") for (int _i = 0; _i < 8; ++_i) R[_i] = _p[_i * 64]; } while (0)
        f32x2 a0 = {0.f, 0.f}, a1 = {0.f, 0.f}, a2 = {0.f, 0.f}, a3 = {0.f, 0.f};
        P5B_LOAD(A, 0);
        for (int gi = 0; gi < 64; gi += 2) {
            P5B_LOAD(Bq, gi + 1);
#pragma unroll
            for (int i = 0; i < 8; ++i) p5b_quad(lds, A[i], a0, a1, a2, a3);
            if (gi + 2 < 64) P5B_LOAD(A, gi + 2);
#pragma unroll
            for (int i = 0; i < 8; ++i) p5b_quad(lds, Bq[i], a0, a1, a2, a3);
            if (((gi + 1) & 3) == 3) {
                const int T = tbase + wave + 8 * (gi >> 2);
                *(u32x4*)(OUTS + ((size_t)s * NTOK + T * 64 + lane) * 8) = (u32x4){pk2(a0.x, a0.y), pk2(a1.x, a1.y), pk2(a2.x, a2.y), pk2(a3.x, a3.y)};
                a0 = (f32x2){0.f, 0.f}; a1 = a0; a2 = a0; a3 = a0;
            }
        }
#undef P5B_LOAD
    }
}

__device__ __forceinline__ void phase5c(const Params& p, LAS unsigned char* lds) {
    const int tid = threadIdx.x, lane = tid & 63, wave = __builtin_amdgcn_readfirstlane(tid >> 6);
    const bf16_t* OUTS = (const bf16_t*)(p.ws + OFF_OUTS); const bf16_t* H2B = (const bf16_t*)(p.ws + OFF_H2B); const float* fw = p.in[20];
    for (int it = blockIdx.x; it < NTOK / 32; it += gridDim.x) {
        const int t0 = it * 32;
        __syncthreads();
#pragma unroll 4
        for (int i = 0; i < 8; ++i) {
            const int q = tid + NTHR * i, s = q >> 5, tt = q & 31;
            *(LAS u32x4*)(lds + tt * 2064 + s * 16) = *(const u32x4*)(OUTS + ((size_t)s * NTOK + t0 + tt) * 8);
        }
        __syncthreads();
        for (int i = 0; i < 4; ++i) {
            const int tt = wave * 4 + i; float* orow = p.out + (size_t)(t0 + tt) * DM;
            f32x4 h[4]; float ss = 0.f;
#pragma unroll
            for (int j = 0; j < 2; ++j) {
                const u32x4 a = *(const u32x4*)(H2B + (size_t)(t0 + tt) * DM + 512 * j + 8 * lane), pq = *(const LAS u32x4*)(lds + tt * 2064 + (512 * j + 8 * lane) * 2);
                h[2 * j] = (f32x4){bflo(a.x) + bflo(pq.x), bfhi(a.x) + bfhi(pq.x), bflo(a.y) + bflo(pq.y), bfhi(a.y) + bfhi(pq.y)};
                h[2 * j + 1] = (f32x4){bflo(a.z) + bflo(pq.z), bfhi(a.z) + bfhi(pq.z), bflo(a.w) + bflo(pq.w), bfhi(a.w) + bfhi(pq.w)};
            }
#pragma unroll
            for (int j = 0; j < 4; ++j) ss += h[j].x * h[j].x + h[j].y * h[j].y + h[j].z * h[j].z + h[j].w * h[j].w;
            const float rs = rsqrtf(wave_sum(ss) * (1.f / DM) + EPS);
#pragma unroll
            for (int j = 0; j < 2; ++j) {
                float* o = orow + 512 * j + 8 * lane; const float* w = fw + 512 * j + 8 * lane;
                *(f32x4*)o = h[2 * j] * rs * *(const f32x4*)w; *(f32x4*)(o + 4) = h[2 * j + 1] * rs * *(const f32x4*)(w + 4);
            }
        }
    }
}


#define XB_TMO      128
#define XB_XCNT(j)  (256  + 64 * (j))
#define XB_XSUB(j)  (1280 + 64 * (j))
#define XB_XGEN(j)  (2304 + 64 * (j))
#define XB_TOP      3328
#define XB_TOPGEN   3392
#define XCD_BAR_WORDS 3456
#define XB_SPIN_CAP (1u << 18)
__device__ __forceinline__ unsigned xb_ld(unsigned* p)              { return __hip_atomic_load(p, __ATOMIC_RELAXED, __HIP_MEMORY_SCOPE_AGENT); }
__device__ __forceinline__ unsigned xb_add(unsigned* p, unsigned v) { return __hip_atomic_fetch_add(p, v, __ATOMIC_RELAXED, __HIP_MEMORY_SCOPE_AGENT); }
__device__ __forceinline__ unsigned xb_xcc_id() { return (unsigned)__builtin_amdgcn_s_getreg((3 << 11) | 20) & 0xFu; }
#define XB_SPIN(cond, bar) do { unsigned _sp = 0; while (cond) { __builtin_amdgcn_s_sleep(1); \
    if ((++_sp & 255u) == 0u) { if (xb_ld(&(bar)[XB_TMO])) break; if (_sp > XB_SPIN_CAP) { atomicAdd(&(bar)[XB_TMO], 1u); break; } } } } while (0)
struct XcdBarrier { unsigned* bar; unsigned x; volatile LAS unsigned* st; };
__device__ __forceinline__ XcdBarrier xcd_barrier_post(unsigned* bar, volatile LAS unsigned* st) {
    XcdBarrier b; b.bar = bar; b.x = xb_xcc_id(); b.st = st;
    if (threadIdx.x == 0) (void)xb_add(&bar[XB_XCNT(b.x)], 1u);
    return b;
}
__device__ __forceinline__ void xcd_barrier_complete(unsigned* bar, unsigned x, unsigned& nloc, unsigned& nx) {
    const unsigned G = gridDim.x * gridDim.y * gridDim.z;
    unsigned sum, cnt, mine, sp = 0u;
    for (;;) {
        sum = 0u; cnt = 0u; mine = 0u;
#pragma unroll
        for (unsigned j = 0; j < 16; ++j) { const unsigned c = xb_ld(&bar[XB_XCNT(j)]); sum += c; cnt += (c > 0u) ? 1u : 0u; mine = (j == x) ? c : mine; }
        if (sum == G) break;
        __builtin_amdgcn_s_sleep(1);
        if ((++sp & 255u) == 0u) { if (xb_ld(&bar[XB_TMO])) break; if (sp > XB_SPIN_CAP) { atomicAdd(&bar[XB_TMO], 1u); break; } }
    }
    nloc = mine > 0u ? mine : 1u; nx = cnt > 0u ? cnt : 1u;
}
__device__ __forceinline__ void xcd_barrier(const XcdBarrier& b) {
    asm volatile("s_waitcnt vmcnt(0)" ::: "memory");
    __syncthreads();
    if (threadIdx.x == 0) {
        unsigned* bar = b.bar;
        __builtin_amdgcn_s_waitcnt(0);
        unsigned nloc = b.st[0], nx = b.st[1];
        if (nloc == 0u) { xcd_barrier_complete(bar, b.x, nloc, nx); b.st[0] = nloc; b.st[1] = nx; }
        const unsigned old = xb_add(&bar[XB_XSUB(b.x)], 1u);
        const unsigned gen = old / nloc;
        if (old + 1u == (gen + 1u) * nloc) {
            __builtin_amdgcn_fence(__ATOMIC_RELEASE, "agent");
            asm volatile("s_waitcnt vmcnt(0)" ::: "memory");
            const unsigned og = xb_add(&bar[XB_TOP], 1u);
            const unsigned tg = og / nx;
            if (og + 1u == (tg + 1u) * nx) xb_add(&bar[XB_TOPGEN], 1u);
            else XB_SPIN(xb_ld(&bar[XB_TOPGEN]) == tg, bar);
            __builtin_amdgcn_fence(__ATOMIC_ACQUIRE, "agent");
            asm volatile("s_waitcnt vmcnt(0)" ::: "memory");
        } else {
            XB_SPIN(xb_ld(&bar[XB_TOPGEN]) == gen, bar);
            __builtin_amdgcn_fence(__ATOMIC_ACQUIRE, "agent");
            asm volatile("s_waitcnt vmcnt(0)" ::: "memory");
        }
    }
    __syncthreads();
}

constexpr int NPHASE = 9;
__global__ void __launch_bounds__(NTHR, 2) mega(Params p) {
    extern __shared__ __attribute__((aligned(16))) unsigned char lds[];
    cg::grid_group grid = cg::this_grid();
#define PH_ON(k) (p.ph_lo <= (k) && (k) < p.ph_hi)
    if (threadIdx.x < 2) ((LAS unsigned*)((LAS unsigned char*)lds + LDS_BYTES - 32))[threadIdx.x] = 0u;
    __syncthreads();
    const XcdBarrier xbar = xcd_barrier_post((unsigned*)(p.ws + OFF_CTL) + 8192, (volatile LAS unsigned*)((LAS unsigned char*)lds + LDS_BYTES - 32));
#define PH_SYNC(k) do { if (PH_ON(k) && PH_ON((k) + 1)) { xcd_barrier(xbar); } } while (0)
    if (PH_ON(0)) phase0(p, lds);
    PH_SYNC(0);
    if (PH_ON(1)) phase1_mfma(p, (LAS unsigned char*)lds);
#if PROBE_DUP == 1
    xcd_barrier(xbar); phase1_mfma(p, (LAS unsigned char*)lds);
#endif
    PH_SYNC(1);
    if (PH_ON(2)) phase2(p, (LAS unsigned char*)lds);
#if PROBE_DUP == 2
    xcd_barrier(xbar); phase2(p, (LAS unsigned char*)lds, 1);
#endif
#if PROBE_DUP == 21
    xcd_barrier(xbar); phase2(p, (LAS unsigned char*)lds, 2);
#endif
#if PROBE_DUP == 22
    xcd_barrier(xbar); phase2(p, (LAS unsigned char*)lds, 3);
#endif
    PH_SYNC(2);
    if (PH_ON(4)) phase3_mfma(p, (LAS unsigned char*)lds);
#if PROBE_DUP == 4
    xcd_barrier(xbar); phase3_mfma(p, (LAS unsigned char*)lds);
#endif
    PH_SYNC(4);
    if (PH_ON(5)) { phase4_mfma(p, (LAS unsigned char*)lds); quantize_hn(p); }
#if PROBE_DUP == 5
    xcd_barrier(xbar); phase4_mfma(p, (LAS unsigned char*)lds);
#endif
    PH_SYNC(5);
    if (PH_ON(6)) phase5a(p, (LAS unsigned char*)lds);
#if PROBE_DUP == 6
    xcd_barrier(xbar); phase5a(p, (LAS unsigned char*)lds, 1024);
#endif
    PH_SYNC(6);
    if (PH_ON(7)) phase5b(p, (LAS unsigned char*)lds);
#if PROBE_DUP == 7
    xcd_barrier(xbar); phase5b(p, (LAS unsigned char*)lds);
#endif
    PH_SYNC(7);
    if (PH_ON(8)) phase5c(p, (LAS unsigned char*)lds);
}

extern "C" void kernel_launch(void* const* d_in, const int* in_sizes, int n_in, void* d_out, int out_size, void* d_ws, size_t ws_size, hipStream_t stream) {
    static int grid = 0;
    if (grid == 0) {
        if (n_in != 21 || out_size != NTOK * DM || ws_size < WS_END) { fprintf(stderr, "kernel_launch: unexpected shapes (n_in %d out %d ws %zu)\n", n_in, out_size, ws_size); grid = -1; return; }
        int dev = 0, cus = 0, per_cu = 0;
        hipGetDevice(&dev);
        hipDeviceGetAttribute(&cus, hipDeviceAttributeMultiprocessorCount, dev);
        hipFuncSetAttribute((const void*)mega, hipFuncAttributeMaxDynamicSharedMemorySize, LDS_BYTES);
        hipOccupancyMaxActiveBlocksPerMultiprocessor(&per_cu, (const void*)mega, NTHR, LDS_BYTES);
        if (per_cu < 1) { fprintf(stderr, "kernel_launch: occupancy query says %d blocks/CU\n", per_cu); per_cu = 1; }
        grid = cus * 1;
        (void)hipGetLastError();
    }
    if (grid < 0) return;
    hipMemsetAsync((char*)d_ws + OFF_CTL, 0, CTL_BYTES, stream);
    Params p{};
    for (int i = 0; i < 21; ++i) p.in[i] = (const float*)d_in[i];
    p.out = (float*)d_out; p.ws = (unsigned char*)d_ws; p.ph_lo = 0; p.ph_hi = NPHASE;
    void* args[] = {&p};
    hipError_t e = hipLaunchCooperativeKernel((const void*)mega, dim3(grid), dim3(NTHR), args, LDS_BYTES, stream);
    if (e != hipSuccess) fprintf(stderr, "cooperative launch failed: %s (grid %d)\n", hipGetErrorString(e), grid);
}
```

```cpp
#include <hip/hip_runtime.h>
#include <hip/hip_cooperative_groups.h>
#include <cstdio>
#include <cstdint>
namespace cg = cooperative_groups;

constexpr int DM = 1024;
constexpr int NB = 8, SEQ = 2048, NMETA = 16;
constexpr int NTOK = NB * SEQ;
constexpr int MROWS = 16640;
constexpr int NIN = 3584;
constexpr int TPOS = NMETA + SEQ;
constexpr float EPS = 1e-6f;
constexpr float QSCALE = 0.125f * 1.4426950408889634f;
constexpr int NEXP = 16384;
constexpr int NTHR = 512;
#ifndef PROBE_DUP
#define PROBE_DUP 0
#endif

constexpr size_t MiB = 1u << 20;
constexpr size_t OFF_CTL = 0, CTL_BYTES = 64 * 1024;
constexpr size_t OFF_MISC = 512 * 1024;
constexpr size_t OFF_ROPE = 1 * MiB;
constexpr size_t OFF_WOUT = 2 * MiB;
constexpr size_t OFF_WQ = 4 * MiB;
constexpr size_t OFF_KEYS = 8 * MiB;
constexpr size_t OFF_SSQP = 25 * MiB;
constexpr size_t OFF_UB = 9 * MiB;
constexpr size_t OFF_VB = 41 * MiB;
constexpr size_t OFF_XN = 73 * MiB;
constexpr size_t OFF_MIX = 73 * MiB;
constexpr size_t OFF_WIN = 106 * MiB;
constexpr size_t OFF_QB = 113 * MiB;
constexpr size_t OFF_KB = OFF_QB + 16 * MiB + 256 * 1024;
constexpr size_t OFF_VT = OFF_KB + 16 * MiB + 256 * 1024;
constexpr size_t OFF_H2B = 113 * MiB;
constexpr size_t OFF_GQ = 162 * MiB;
constexpr size_t OFF_GK = OFF_GQ + 8 * MiB + 256 * 1024;
constexpr size_t OFF_GVT = OFF_GK + 8 * MiB + 256 * 1024;
constexpr size_t OFF_GF = OFF_GVT + 16 * MiB + 256 * 1024;
constexpr size_t OFF_GB = OFF_GF + 16 * MiB + 256 * 1024;
constexpr size_t OFF_GR = OFF_GB + 16 * MiB + 256 * 1024;
constexpr size_t OFF_PW0 = 162 * MiB;
constexpr size_t OFF_USC = 64 * 1024;
constexpr size_t OFF_VSC = 128 * 1024;
constexpr size_t WS_END = OFF_GR + 16 * MiB + 256 * 1024;
static_assert(WS_END <= 256 * MiB, "workspace map");
static_assert(OFF_VT + (size_t)512 * MROWS * 2 <= OFF_GQ, "map D");
static_assert(OFF_WIN + (size_t)NIN * DM * 2 <= OFF_QB, "map C");

constexpr int LDS_BYTES = 163840;
constexpr int LDS_Q = LDS_BYTES - 16;

typedef unsigned short bf16_t;
typedef float f32x4 __attribute__((ext_vector_type(4)));
typedef float f32x2 __attribute__((ext_vector_type(2)));
typedef unsigned u32x4 __attribute__((ext_vector_type(4)));
typedef unsigned u32x2 __attribute__((ext_vector_type(2)));
typedef __bf16 bf16x2_t __attribute__((ext_vector_type(2)));

struct Params {
    const float* in[21];
    float* out;
    unsigned char* ws;
    int ph_lo, ph_hi;
};

__device__ __forceinline__ unsigned f2bf(float f) { unsigned u = __float_as_uint(f); return (u + 0x7fffu + ((u >> 16) & 1u)) >> 16; }
__device__ __forceinline__ float bf2f(unsigned h) { return __uint_as_float(h << 16); }
__device__ __forceinline__ unsigned pk2(float lo, float hi) { return __builtin_bit_cast(unsigned, __builtin_convertvector((f32x2){lo, hi}, bf16x2_t)); }
__device__ __forceinline__ float bflo(unsigned w) { return __uint_as_float(w << 16); }
__device__ __forceinline__ float bfhi(unsigned w) { return __uint_as_float(w & 0xffff0000u); }
__device__ __forceinline__ float dot2(unsigned a, unsigned b, float c) {
    return __builtin_amdgcn_fdot2_f32_bf16(__builtin_bit_cast(bf16x2_t, a), __builtin_bit_cast(bf16x2_t, b), c, false);
}
__device__ __forceinline__ float dot8(u32x4 a, u32x4 b, float c) { c = dot2(a.x, b.x, c); c = dot2(a.y, b.y, c); c = dot2(a.z, b.z, c); return dot2(a.w, b.w, c); }
__device__ __forceinline__ float wave_sum(float v) {
#pragma unroll
    for (int o = 1; o < 64; o <<= 1) v += __shfl_xor(v, o);
    return v;
}
__device__ __forceinline__ float wave_max(float v) {
#pragma unroll
    for (int o = 1; o < 64; o <<= 1) v = fmaxf(v, __shfl_xor(v, o));
    return v;
}
__device__ __forceinline__ float silu_f(float x) { return x * __builtin_amdgcn_rcpf(1.f + __expf(-x)); }
__device__ __forceinline__ float logsig_f(float x) { return fminf(x, 0.f) - __logf(1.f + __expf(-fabsf(x))); }
__device__ __forceinline__ float gelu_f(float v) {
    const float av = fabsf(v), t = __builtin_amdgcn_rcpf(av * 0.2316418882f + 1.0f);
    float q = t * 0.5307027145f + (-0.7265760135f); q = q * t + 0.7107068705f; q = q * t + (-0.142248368f); q = q * t + 0.127414796f; q = q * t;
    const float m = v * (q * __builtin_amdgcn_exp2f(v * v * (-0.72134752044f)));
    return v < 0.f ? m : v - m;
}

__device__ __forceinline__ float win_src(const Params& p, int k, int n) {
    const float* W = p.in[3] + (size_t)k * 3104;
    if (n < 1024) {
        const int base = n & ~63, dp = n & 63, d = dp < 16 ? ((dp >> 1) + 8 * (dp & 1)) : dp;
        return W[base + d];
    } else if (n < 3072) return W[n];
    const int j = (n - 3072) & 255, dir = (n - 3072) >> 8;
    const float* w2 = p.in[dir ? 11 : 9];
    const float* wz = W + 3072 + dir * 16;
    float s = 0.f;
#pragma unroll
    for (int r = 0; r < 16; ++r) s += wz[r] * w2[r * 256 + j];
    return s;
}

template <int WHICH>
__device__ __forceinline__ void p0_transpose_item(const Params& p, float* scr, int item, int lane) {
    constexpr int N = WHICH == 0 ? NIN : (WHICH == 1 ? 1024 : 2048);
    constexpr int nblk = N / 32;
    const int kb = item / nblk, nb = item % nblk, k0 = 64 * kb, n0 = 32 * nb;
    bf16_t* WT = (bf16_t*)(p.ws + (WHICH == 0 ? OFF_WIN : (WHICH == 1 ? OFF_WOUT : OFF_WQ)));
#pragma unroll 4
    for (int i = 0; i < 32; ++i) {
        const int kk = 2 * i + (lane >> 5), k = k0 + kk, n = n0 + (lane & 31);
        float v;
        if (WHICH == 0) v = win_src(p, k, n);
        else if (WHICH == 1) v = p.in[14][(size_t)k * 1024 + n];
        else v = p.in[16][(size_t)k * 2048 + n] * p.in[15][k];
        scr[kk * 33 + (lane & 31)] = v;
    }
    __builtin_amdgcn_s_waitcnt(0xC07F); __builtin_amdgcn_wave_barrier();
    const int c = lane & 7;
#pragma unroll
    for (int j = 0; j < 4; ++j) {
        const int n = (lane >> 3) + 8 * j; const float* s = scr + (8 * c) * 33 + n;
        u32x4 o; o.x = pk2(s[0 * 33], s[1 * 33]); o.y = pk2(s[2 * 33], s[3 * 33]); o.z = pk2(s[4 * 33], s[5 * 33]); o.w = pk2(s[6 * 33], s[7 * 33]);
        *(u32x4*)(WT + (size_t)(n0 + n) * 1024 + k0 + 8 * c) = o;
    }
    __builtin_amdgcn_s_waitcnt(0xC07F); __builtin_amdgcn_wave_barrier();
}

__device__ __forceinline__ void phase0(const Params& p, unsigned char* lds) {
    const int tid = threadIdx.x, lane = tid & 63, wave = tid >> 6;
    const int gw = blockIdx.x * 8 + wave, NGW = gridDim.x * 8;
    const long gt = (long)blockIdx.x * NTHR + tid, NGT = (long)gridDim.x * NTHR;
    {
        const f32x4* lw = (const f32x4*)p.in[2];
        bf16_t* XN = (bf16_t*)(p.ws + OFF_XN);
        for (int r = gw; r < MROWS; r += NGW) {
            const float* src = r < NTOK ? p.in[0] + (size_t)r * DM : (r < NTOK + NMETA ? p.in[1] + (size_t)(r - NTOK) * DM : nullptr);
            f32x4 v[4]; float s = 0.f;
#pragma unroll
            for (int j = 0; j < 4; ++j) { v[j] = src ? ((const f32x4*)src)[lane + 64 * j] : (f32x4){0.f, 0.f, 0.f, 0.f}; s += v[j].x * v[j].x + v[j].y * v[j].y + v[j].z * v[j].z + v[j].w * v[j].w; }
            const float rs = rsqrtf(wave_sum(s) * (1.f / DM) + EPS);
#pragma unroll
            for (int j = 0; j < 4; ++j) { const f32x4 w = lw[lane + 64 * j]; u32x2 o; o.x = pk2(v[j].x * rs * w.x, v[j].y * rs * w.y); o.y = pk2(v[j].z * rs * w.z, v[j].w * rs * w.w);
                *(u32x2*)(XN + (size_t)r * DM + 4 * (lane + 64 * j)) = o; }
        }
    }
    {
        float* scr = (float*)lds + wave * (64 * 33);
        constexpr int I0 = 16 * (NIN / 32);
        for (int it = gw; it < I0; it += NGW) p0_transpose_item<0>(p, scr, it, lane);
    }
    {
        f32x2* rope = (f32x2*)(p.ws + OFF_ROPE);
        for (long i = gt; i < TPOS * 8; i += NGT) {
            const int t = (int)(i >> 3), j = (int)(i & 7);
            const float inv = powf(500000.0f, -(float)j * 0.125f);
            const float ang = (float)t * inv;
            rope[i] = (f32x2){cosf(ang), sinf(ang)};
        }
        if (gt == 0) {
            float a = 0.f, b = 0.f;
            for (int i = 0; i < 64; ++i) { a += p.in[4][i] * p.in[5][i]; b += p.in[6][i] * p.in[7][i]; }
            ((float*)(p.ws + OFF_MISC))[0] = expf(a) - expf(b) + 0.2f;
        }
    }
}
constexpr int CV_WOUT = 64, CV_WQ = 128, CV_KEYS = 8, CV_U = 256, CV_V = 256, CV_ITEMS = CV_WOUT + CV_WQ + CV_KEYS + CV_U + CV_V;
__device__ __forceinline__ void conv_item(const Params& p, unsigned char* lds, int c) {
    const int tid = threadIdx.x, lane = tid & 63, wave = tid >> 6;
    __syncthreads();
    if (c < CV_WOUT) { p0_transpose_item<1>(p, (float*)lds + wave * (64 * 33), c * 8 + wave, lane); return; }
    c -= CV_WOUT;
    if (c < CV_WQ) { p0_transpose_item<2>(p, (float*)lds + wave * (64 * 33), c * 8 + wave, lane); return; }
    c -= CV_WQ;
    if (c < CV_KEYS) {
        bf16_t* KEYS = (bf16_t*)(p.ws + OFF_KEYS);
#pragma unroll 2
        for (int j = 0; j < 8; ++j) {
            const long e = ((long)c * 4096 + tid + NTHR * j) * 8;
            const f32x4 a = *(const f32x4*)(p.in[17] + e), b = *(const f32x4*)(p.in[17] + e + 4);
            u32x4 o; o.x = pk2(a.x, a.y); o.y = pk2(a.z, a.w); o.z = pk2(b.x, b.y); o.w = pk2(b.z, b.w);
            *(u32x4*)(KEYS + e) = o;
        }
        return;
    }
    c -= CV_KEYS;
    if (c < CV_U) {
        unsigned char* UQ = p.ws + OFF_UB; float* USC = (float*)(p.ws + OFF_USC);
#pragma unroll 2
        for (int i = 0; i < 8; ++i) {
            const int r = c * 64 + wave * 8 + i;
            const float* ur = p.in[18] + (size_t)r * DM + 16 * lane; const float* lw = p.in[15] + 16 * lane;
            f32x4 v[4]; float am = 0.f;
#pragma unroll
            for (int j = 0; j < 4; ++j) { v[j] = ((const f32x4*)ur)[j] * ((const f32x4*)lw)[j]; am = fmaxf(am, fmaxf(fmaxf(fabsf(v[j].x), fabsf(v[j].y)), fmaxf(fabsf(v[j].z), fabsf(v[j].w)))); }
            am = fmaxf(wave_max(am), 1e-30f);
            const float sc = 224.f / am;
            u32x4 o;
#pragma unroll
            for (int j = 0; j < 4; ++j) { int w = __builtin_amdgcn_cvt_pk_fp8_f32(v[j].x * sc, v[j].y * sc, 0, false); w = __builtin_amdgcn_cvt_pk_fp8_f32(v[j].z * sc, v[j].w * sc, w, true); o[j] = (unsigned)w; }
            *(u32x4*)(UQ + (size_t)r * DM + 16 * lane) = o;
            if (lane == 0) USC[r] = am * (1.f / 224.f);
        }
        return;
    }
    c -= CV_U;
    {
        unsigned char* VS = p.ws + OFF_VB; float* VSC = (float*)(p.ws + OFF_VSC);
        const int tile = c;
#pragma unroll 2
        for (int i = 0; i < 8; ++i) {
            const int er = wave * 8 + i, r = tile * 64 + er;
            const float* vr = p.in[19] + (size_t)r * DM + 16 * lane;
            f32x4 v[4]; float am = 0.f;
#pragma unroll
            for (int j = 0; j < 4; ++j) { v[j] = ((const f32x4*)vr)[j]; am = fmaxf(am, fmaxf(fmaxf(fabsf(v[j].x), fabsf(v[j].y)), fmaxf(fabsf(v[j].z), fabsf(v[j].w)))); }
            am = fmaxf(wave_max(am), 1e-30f);
            const float sc = 224.f / am;
            u32x4 o;
#pragma unroll
            for (int j = 0; j < 4; ++j) { int w = __builtin_amdgcn_cvt_pk_fp8_f32(v[j].x * sc, v[j].y * sc, 0, false); w = __builtin_amdgcn_cvt_pk_fp8_f32(v[j].z * sc, v[j].w * sc, w, true); o[j] = (unsigned)w; }
            *(u32x2*)(lds + er * 1032 + 16 * lane) = (u32x2){o.x, o.y}; *(u32x2*)(lds + er * 1032 + 16 * lane + 8) = (u32x2){o.z, o.w};
            if (lane == 0) VSC[r] = am * (1.f / 224.f);
        }
        __syncthreads();
#pragma unroll 4
        for (int i = 0; i < 16; ++i) {
            const int s = wave + 8 * i;
            *(u32x2*)(VS + ((size_t)s * NEXP + tile * 64 + lane) * 8) = *(const u32x2*)(lds + lane * 1032 + s * 8);
        }
    }
}

struct P1Ptrs { unsigned char* ws; const float* bias_f; const float* bias_b; };
__device__ __forceinline__ void p1_store(const P1Ptrs p, int row, int n0, float v0, float v1, float v2, float v3) {
    if (n0 < 1024) {
        const int dp = n0 & 63;
        if (dp < 16) {
            const int pos = row < NTOK ? NMETA + (row & (SEQ - 1)) : (row - NTOK);
            const f32x4 cs = *(const f32x4*)((const float*)(p.ws + OFF_ROPE) + ((size_t)pos * 8 + (dp >> 1)) * 2);
            const float a0 = v0 * cs.x - v1 * cs.y, b0 = v1 * cs.x + v0 * cs.y;
            const float a1 = v2 * cs.z - v3 * cs.w, b1 = v3 * cs.z + v2 * cs.w;
            v0 = a0; v1 = b0; v2 = a1; v3 = b1;
        }
        if (n0 < 512) { u32x2 o; o.x = pk2(v0 * QSCALE, v1 * QSCALE); o.y = pk2(v2 * QSCALE, v3 * QSCALE); *(u32x2*)((bf16_t*)(p.ws + OFF_QB) + (size_t)row * 512 + n0) = o; }
        else { u32x2 o; o.x = pk2(v0, v1); o.y = pk2(v2, v3); *(u32x2*)((bf16_t*)(p.ws + OFF_KB) + (size_t)row * 512 + (n0 - 512)) = o; }
    } else if (n0 < 1536) {
        bf16_t* VT = (bf16_t*)(p.ws + OFF_VT) + (size_t)(n0 - 1024) * MROWS + row;
        VT[0] = (bf16_t)f2bf(v0); VT[MROWS] = (bf16_t)f2bf(v1); VT[2 * MROWS] = (bf16_t)f2bf(v2); VT[3 * (size_t)MROWS] = (bf16_t)f2bf(v3);
    } else if (n0 < 1792) {
        u32x2 o; o.x = pk2(v0 * 0.125f, v1 * 0.125f); o.y = pk2(v2 * 0.125f, v3 * 0.125f); *(u32x2*)((bf16_t*)(p.ws + OFF_GQ) + (size_t)row * 256 + (n0 - 1536)) = o;
    } else if (n0 < 2048) {
        u32x2 o; o.x = pk2(v0, v1); o.y = pk2(v2, v3); *(u32x2*)((bf16_t*)(p.ws + OFF_GK) + (size_t)row * 256 + (n0 - 1792)) = o;
    } else if (n0 < 2560) {
        bf16_t* VT = (bf16_t*)(p.ws + OFF_GVT) + (size_t)(n0 - 2048) * MROWS + row;
        VT[0] = (bf16_t)f2bf(v0); VT[MROWS] = (bf16_t)f2bf(v1); VT[2 * MROWS] = (bf16_t)f2bf(v2); VT[3 * (size_t)MROWS] = (bf16_t)f2bf(v3);
    } else if (n0 < 3072) {
        u32x2 o; o.x = pk2(silu_f(v0), silu_f(v1)); o.y = pk2(silu_f(v2), silu_f(v3)); *(u32x2*)((bf16_t*)(p.ws + OFF_GR) + (size_t)row * 512 + (n0 - 2560)) = o;
    } else {
        const int dir = (n0 - 3072) >> 8, j = (n0 - 3072) & 255;
        const f32x4 bb = *(const f32x4*)((dir ? p.bias_b : p.bias_f) + j);
        f32x4 o; o.x = logsig_f(v0 + bb.x) * 0.0625f; o.y = logsig_f(v1 + bb.y) * 0.0625f; o.z = logsig_f(v2 + bb.z) * 0.0625f; o.w = logsig_f(v3 + bb.w) * 0.0625f;
        *(f32x4*)((float*)(p.ws + (dir ? OFF_GB : OFF_GF)) + (size_t)row * 256 + j) = o;
    }
}


#define LAS __attribute__((address_space(3)))
typedef short bf16x8 __attribute__((ext_vector_type(8)));
constexpr int GBUF = 49152;

template <int ROWS>
__device__ __forceinline__ void stage_tile(const bf16_t* G, int ldk, int r0, int k0, LAS unsigned char* buf, int wave, int lane) {
    const int rr = lane >> 3, c = (lane & 7) ^ rr;
#pragma unroll
    for (int i = 0; i < ROWS / 64; ++i) {
        const int grp = wave + 8 * i;
        const bf16_t* src = G + (size_t)(r0 + grp * 8 + rr) * ldk + k0 + c * 8;
        __builtin_amdgcn_global_load_lds((const unsigned*)src, (LAS unsigned*)(buf + grp * 1024), 16, 0, 0);
    }
}
__device__ __forceinline__ bf16x8 ldfrag(const LAS unsigned char* buf, int row, int c) {
    return *(const LAS bf16x8*)(buf + row * 128 + ((c ^ (row & 7)) << 4));
}
template <bool SWAP>
__device__ __forceinline__ void gemm_tile_256(const bf16_t* A, const bf16_t* Bt, int K, int m0, int n0, LAS unsigned char* lds, f32x4 (&acc)[4][4]) {
    const int tid = threadIdx.x, lane = tid & 63, wave = __builtin_amdgcn_readfirstlane(tid >> 6), wm = wave >> 2, wn = wave & 3, l15 = lane & 15, g = lane >> 4;
#pragma unroll
    for (int i = 0; i < 4; ++i)
#pragma unroll
        for (int j = 0; j < 4; ++j) acc[i][j] = (f32x4){0.f, 0.f, 0.f, 0.f};
    const int nk = K / 64;
    stage_tile<128>(A, K, m0, 0, lds, wave, lane);
    stage_tile<256>(Bt, K, n0, 0, lds + 16384, wave, lane);
    for (int kt = 0; kt < nk; ++kt) {
        asm volatile("s_waitcnt vmcnt(0)" ::: "memory");
        __syncthreads();
        if (kt + 1 < nk) {
            LAS unsigned char* nb = lds + ((kt + 1) & 1) * GBUF;
            stage_tile<128>(A, K, m0, (kt + 1) * 64, nb, wave, lane);
            stage_tile<256>(Bt, K, n0, (kt + 1) * 64, nb + 16384, wave, lane);
        }
        const LAS unsigned char* a = lds + (kt & 1) * GBUF; const LAS unsigned char* b = a + 16384;
#pragma unroll
        for (int ks = 0; ks < 2; ++ks) {
            bf16x8 af[4], bfr[4];
#pragma unroll
            for (int i = 0; i < 4; ++i) { af[i] = ldfrag(a, wm * 64 + i * 16 + l15, ks * 4 + g); bfr[i] = ldfrag(b, wn * 64 + i * 16 + l15, ks * 4 + g); }
#pragma unroll
            for (int i = 0; i < 4; ++i)
#pragma unroll
                for (int j = 0; j < 4; ++j)
                    acc[i][j] = SWAP ? __builtin_amdgcn_mfma_f32_16x16x32_bf16(af[i], bfr[j], acc[i][j], 0, 0, 0)
                                     : __builtin_amdgcn_mfma_f32_16x16x32_bf16(bfr[j], af[i], acc[i][j], 0, 0, 0);
        }
    }
}
__device__ __forceinline__ int vcu_of_block() { const int G = gridDim.x, bx = blockIdx.x; return (G % 8 == 0) ? (bx % 8) * (G / 8) + bx / 8 : bx; }

namespace pg8 {
#define PG8_LAS __attribute__((address_space(3)))
typedef unsigned short bf16_t;
typedef short bf16x8 __attribute__((ext_vector_type(8)));
typedef float f32x4 __attribute__((ext_vector_type(4)));
typedef unsigned u32x4 __attribute__((ext_vector_type(4)));
constexpr int BM = 256, BK = 64, HALF = 128, HTB = HALF * BK * 2  , STAGE_BYTES = 8 * HTB, NXCD = 8, WGM = 8;

__host__ __device__ __forceinline__ int lds_byte(int r, int c) { const int st = (r >> 4) * 2 + (c >> 5), rr = r & 15, cc = c & 31, ob = rr * 64 + cc * 2; return st * 1024 + (ob ^ (((ob >> 9) & 1) << 5)); }
__host__ __device__ __forceinline__ void stage_rc(int b, int& R, int& C) { const int st = b / 1024, sb = b % 1024, swz = sb ^ (((sb >> 9) & 1) << 5); R = (st >> 1) * 16 + swz / 64; C = (st & 1) * 32 + (swz % 64) / 2; }
__host__ __device__ __forceinline__ int perm32(int rho) { const int n = rho >> 4, i = rho & 15; return 8 * (i >> 2) + 4 * n + (i & 3); }

struct Unit { int pm, pn; };
struct Gemm { const bf16_t* A; const bf16_t* Bt; int M, N, K; };

struct StaticOrder {
    int nM, nN, nwg, G, c;
    __host__ __device__ void init(int M, int N, int G_, int c_) { nM = M / BM; nN = N / BM; nwg = nM * nN; G = G_; c = c_; }
    __host__ __device__ bool next(int i, Unit& u) const {
        const long L = (long)i * G + c; if (L >= nwg) return false;
        int wgid = (int)L; { const int q = nwg / NXCD, r = nwg % NXCD, xcd = wgid % NXCD, off = wgid / NXCD; wgid = (xcd < r ? xcd * (q + 1) : r * (q + 1) + (xcd - r) * q) + off; }
        const int nig = WGM * nN, gid = wgid / nig, fm = gid * WGM, gsz = (nM - fm) < WGM ? (nM - fm) : WGM;
        u.pm = fm + ((wgid % nig) % gsz); u.pn = (wgid % nig) / gsz; return true;
    }
    __device__ __forceinline__ void a_ready(const Unit&) const {}
    __device__ __forceinline__ void done(const Unit&) const {}
};

struct EpiP1 {
    static constexpr bool PERM = true, AFTER_DRAIN = false, SWAPPABLE = true;
    P1Ptrs p;
    static __device__ __forceinline__ bool swap_unit(const Unit& u) { return u.pn == 4 || u.pn == 5 || u.pn == 8 || u.pn == 9; }
    __device__ __forceinline__ void operator()(const f32x4 (&acc)[2][2][4][2], const Unit& u, int wr, int wc, int fr, int fq) const {
        if (swap_unit(u)) {
            const int cb = u.pn * BM, nbase = cb < 1536 ? cb - 1024 : cb - 2048;
            bf16_t* T = (bf16_t*)(p.ws + (cb < 1536 ? OFF_VT : OFF_GVT)) + (size_t)(nbase + wc * 32 + 8 * (fr >> 2) + (fr & 3)) * MROWS + u.pm * BM + wr * 64 + 4 * fq;
#pragma unroll
            for (int bj = 0; bj < 2; ++bj)
#pragma unroll
                for (int n = 0; n < 2; ++n)
#pragma unroll
                    for (int ai = 0; ai < 2; ++ai)
#pragma unroll
                        for (int m = 0; m < 4; ++m) { const f32x4 v = acc[ai][bj][m][n];
                            *(u32x2*)(T + (size_t)(bj * HALF + n * 4) * MROWS + ai * HALF + m * 16) = (u32x2){pk2(v.x, v.y), pk2(v.z, v.w)}; }
            return;
        }
#pragma unroll
        for (int bj = 0; bj < 2; ++bj) {
            const int nw = u.pn * BM + bj * HALF + wc * 32;
            const int rowb = u.pm * BM + wr * 64 + fr;
            if (nw >= 3072) {
                const int dir = (nw - 3072) >> 8, j0 = ((nw - 3072) & 255) + 8 * fq;
                float* G = (float*)(p.ws + (dir ? OFF_GB : OFF_GF)); const float* bias = dir ? p.bias_b : p.bias_f;
                const f32x4 b0 = *(const f32x4*)(bias + j0), b1 = *(const f32x4*)(bias + j0 + 4);
#pragma unroll
                for (int ai = 0; ai < 2; ++ai)
#pragma unroll
                    for (int m = 0; m < 4; ++m) { const f32x4 v0 = acc[ai][bj][m][0], v1 = acc[ai][bj][m][1]; f32x4 o0, o1;
                        o0.x = logsig_f(v0.x + b0.x) * 0.0625f; o0.y = logsig_f(v0.y + b0.y) * 0.0625f; o0.z = logsig_f(v0.z + b0.z) * 0.0625f; o0.w = logsig_f(v0.w + b0.w) * 0.0625f;
                        o1.x = logsig_f(v1.x + b1.x) * 0.0625f; o1.y = logsig_f(v1.y + b1.y) * 0.0625f; o1.z = logsig_f(v1.z + b1.z) * 0.0625f; o1.w = logsig_f(v1.w + b1.w) * 0.0625f;
                        float* gp = G + (size_t)(rowb + ai * HALF + m * 16) * 256 + j0; *(f32x4*)gp = o0; *(f32x4*)(gp + 4) = o1; }
            } else {
                bf16_t* base; int ld, c0; float sc = 1.f; bool silu = false;
                if (nw < 512) { base = (bf16_t*)(p.ws + OFF_QB); ld = 512; c0 = nw; sc = QSCALE; }
                else if (nw < 1024) { base = (bf16_t*)(p.ws + OFF_KB); ld = 512; c0 = nw - 512; }
                else if (nw < 1792) { base = (bf16_t*)(p.ws + OFF_GQ); ld = 256; c0 = nw - 1536; sc = 0.125f; }
                else if (nw < 2048) { base = (bf16_t*)(p.ws + OFF_GK); ld = 256; c0 = nw - 1792; }
                else { base = (bf16_t*)(p.ws + OFF_GR); ld = 512; c0 = nw - 2560; silu = true; }
                const bool rope = nw < 1024 && (nw & 63) == 0 && fq < 2;
#pragma unroll
                for (int ai = 0; ai < 2; ++ai)
#pragma unroll
                    for (int m = 0; m < 4; ++m) {
                        const int row = rowb + ai * HALF + m * 16;
                        f32x4 v0 = acc[ai][bj][m][0], v1 = acc[ai][bj][m][1];
                        if (rope) {
                            const int pos = row < NTOK ? NMETA + (row & (SEQ - 1)) : (row - NTOK < TPOS ? row - NTOK : 0);
                            const f32x4* cp = (const f32x4*)((const float*)(p.ws + OFF_ROPE) + ((size_t)pos * 8 + 4 * fq) * 2);
                            const f32x4 ca = cp[0], cb2 = cp[1];
                            v0 = (f32x4){v0.x * ca.x - v0.y * ca.y, v0.y * ca.x + v0.x * ca.y, v0.z * ca.z - v0.w * ca.w, v0.w * ca.z + v0.z * ca.w};
                            v1 = (f32x4){v1.x * cb2.x - v1.y * cb2.y, v1.y * cb2.x + v1.x * cb2.y, v1.z * cb2.z - v1.w * cb2.w, v1.w * cb2.z + v1.z * cb2.w};
                        }
                        if (silu) { v0 = (f32x4){silu_f(v0.x), silu_f(v0.y), silu_f(v0.z), silu_f(v0.w)}; v1 = (f32x4){silu_f(v1.x), silu_f(v1.y), silu_f(v1.z), silu_f(v1.w)}; }
                        else { v0 = v0 * sc; v1 = v1 * sc; }
                        *(u32x4*)(base + (size_t)row * ld + c0 + 8 * fq) = (u32x4){pk2(v0.x, v0.y), pk2(v0.z, v0.w), pk2(v1.x, v1.y), pk2(v1.z, v1.w)};
                    }
            }
        }
    }
};
struct EpiP3 {
    static constexpr bool PERM = true, AFTER_DRAIN = false, SWAPPABLE = false;
    const float* x; float* out; bf16_t* h2b; float* ssq;
    __device__ __forceinline__ void operator()(const f32x4 (&acc)[2][2][4][2], const Unit& u, int wr, int wc, int fr, int fq) const {
#pragma unroll
        for (int ai = 0; ai < 2; ++ai)
#pragma unroll
            for (int m = 0; m < 4; ++m) { const int row = u.pm * BM + ai * HALF + wr * 64 + m * 16 + fr; float ss = 0.f;
#pragma unroll
                for (int bj = 0; bj < 2; ++bj) { const int col = u.pn * BM + bj * HALF + wc * 32 + 8 * fq;
                    const f32x4 h0 = *(const f32x4*)(x + (size_t)row * DM + col) + acc[ai][bj][m][0], h1 = *(const f32x4*)(x + (size_t)row * DM + col + 4) + acc[ai][bj][m][1];
                    *(u32x4*)(h2b + (size_t)row * DM + col) = (u32x4){pk2(h0.x, h0.y), pk2(h0.z, h0.w), pk2(h1.x, h1.y), pk2(h1.z, h1.w)};
                    ss += (h0.x * h0.x + h0.y * h0.y + h0.z * h0.z + h0.w * h0.w) + (h1.x * h1.x + h1.y * h1.y + h1.z * h1.z + h1.w * h1.w); }
                ss += __shfl_xor(ss, 16); ss += __shfl_xor(ss, 32);
                if (fq == 0) ssq[(size_t)row * 16 + u.pn * 4 + wc] = ss; }
    }
};

struct P1Order {
    int G, c, ncol, nM; bool vt;
    __device__ __forceinline__ bool next(int i, Unit& u) const {
        const int nwg = nM * ncol; const int L = i * G + (vt ? (G - 1 - c) : c); if (L >= nwg) return false;
        const int pm = L / ncol, j = L % ncol;
        u.pm = pm; u.pn = vt ? (j < 2 ? 4 + j : 6 + j) : (j < 4 ? j : (j < 6 ? j + 2 : j + 4));
        return true;
    }
    __device__ __forceinline__ void a_ready(const Unit&) const {}
    __device__ __forceinline__ void done(const Unit&) const {}
};
struct OneUnit {
    Unit u; bool valid;
    __device__ __forceinline__ bool next(int i, Unit& o) const { if (i != 0 || !valid) return false; o = u; return true; }
    __device__ __forceinline__ void a_ready(const Unit&) const {}
    __device__ __forceinline__ void done(const Unit&) const {}
};

template <class Epi, class Sched, bool ALIGN_EPI = false, bool SP2 = false, bool SWP = false>
__device__ __forceinline__ void gemm_phase(PG8_LAS unsigned char* lds, const Gemm g, const Sched& S, const Epi& E) {
    int tid_ = threadIdx.x; asm volatile("" : "+v"(tid_));
    const int tid = tid_, wid = __builtin_amdgcn_readfirstlane(tid >> 6), lane = tid & 63, wr = wid >> 2, wc = wid & 3, fr = lane & 15, fq = lane >> 4;
    const int K = g.K, nt = K / BK;
    unsigned voffA[2], voffB[2];
#pragma unroll
    for (int i = 0; i < 2; ++i) { int R, C; stage_rc(tid * 16 + i * 8192, R, C); const int Rb = Epi::PERM ? ((R & ~31) + perm32(R & 31)) : R;
        voffA[i] = (unsigned)(R * K + C) * 2u; voffB[i] = (unsigned)(Rb * K + C) * 2u; }
    const size_t kstep = (size_t)(BK * 2);
    const size_t hstep = (size_t)HALF * K * 2;
    const size_t tstep = 2 * hstep;
    const unsigned ldsw = (unsigned)wid * 1024u;
    const int aoff = lds_byte(wr * 64 + fr, fq * 8), boff = lds_byte(wc * 32 + fr, fq * 8);
#define PG8_SA(b, h) (((b) * 2 + (h)) * HTB)
#define PG8_SB(b, h) ((4 + (b) * 2 + (h)) * HTB)
#define PG8_STAGE(bufoff, gbase, voff) do { _Pragma("unroll") for (int _i = 0; _i < 2; ++_i) \
        __builtin_amdgcn_global_load_lds((const unsigned*)((const char*)(gbase) + (voff)[_i]), (PG8_LAS unsigned*)(lds + (bufoff) + ldsw + _i * 8192), 16, 0, 0); } while (0)
#define PG8_LDA(dst, b, h) do { _Pragma("unroll") for (int m = 0; m < 4; ++m) _Pragma("unroll") for (int k = 0; k < 2; ++k) dst[m][k] = *(const PG8_LAS bf16x8*)(lds + PG8_SA(b, h) + aoff + m * 2048 + k * 1024); } while (0)
#define PG8_LDB(dst, b, h) do { _Pragma("unroll") for (int n = 0; n < 2; ++n) _Pragma("unroll") for (int k = 0; k < 2; ++k) dst[n][k] = *(const PG8_LAS bf16x8*)(lds + PG8_SB(b, h) + boff + n * 2048 + k * 1024); } while (0)
#define PG8_MMA(ai, bj, At, Bt) do { __builtin_amdgcn_s_setprio(1); \
        if (SWP) { _Pragma("unroll") for (int m = 0; m < 4; ++m) _Pragma("unroll") for (int n = 0; n < 2; ++n) _Pragma("unroll") for (int k = 0; k < 2; ++k) \
            acc[ai][bj][m][n] = __builtin_amdgcn_mfma_f32_16x16x32_bf16(At[m][k], Bt[n][k], acc[ai][bj][m][n], 0, 0, 0); } \
        else { _Pragma("unroll") for (int m = 0; m < 4; ++m) _Pragma("unroll") for (int n = 0; n < 2; ++n) _Pragma("unroll") for (int k = 0; k < 2; ++k) \
            acc[ai][bj][m][n] = __builtin_amdgcn_mfma_f32_16x16x32_bf16(Bt[n][k], At[m][k], acc[ai][bj][m][n], 0, 0, 0); } \
        __builtin_amdgcn_s_setprio(0); } while (0)
#define PG8_WAIT_V(n) asm volatile("s_waitcnt vmcnt(" #n ")" ::: "memory")
#define PG8_WAIT_L(n) asm volatile("s_waitcnt lgkmcnt(" #n ")" ::: "memory")
#define PG8_BAR __builtin_amdgcn_s_barrier()
#define PG8_SCHED __builtin_amdgcn_sched_barrier(0)
    Unit cur, nxt; int ui = 0;
    if (!S.next(0, cur)) return;
    f32x4 acc[2][2][4][2];
#pragma unroll
    for (int a = 0; a < 2; ++a)
#pragma unroll
        for (int b = 0; b < 2; ++b)
#pragma unroll
            for (int m = 0; m < 4; ++m)
#pragma unroll
                for (int n = 0; n < 2; ++n) acc[a][b][m][n] = (f32x4){0.f, 0.f, 0.f, 0.f};
    bf16x8 At[4][2], B0[2][2], B1[2][2];
    const char* cA = (const char*)g.A + (size_t)cur.pm * tstep; const char* cB = (const char*)g.Bt + (size_t)cur.pn * tstep;
    S.a_ready(cur);
    if constexpr (SP2) {
        PG8_STAGE(PG8_SB(0, 0), cB, voffB); PG8_STAGE(PG8_SB(0, 1), cB + hstep, voffB); PG8_STAGE(PG8_SA(0, 0), cA, voffA); PG8_STAGE(PG8_SA(0, 1), cA + hstep, voffA);
        if (wr == 1) PG8_BAR;
        PG8_WAIT_V(2); PG8_BAR;
        PG8_STAGE(PG8_SB(1, 0), cB + kstep, voffB); PG8_STAGE(PG8_SA(1, 0), cA + kstep, voffA); PG8_STAGE(PG8_SB(1, 1), cB + hstep + kstep, voffB);
        PG8_WAIT_V(6); PG8_BAR;
    } else {
        PG8_STAGE(PG8_SB(0, 0), cB, voffB); PG8_STAGE(PG8_SA(0, 0), cA, voffA); PG8_STAGE(PG8_SB(0, 1), cB + hstep, voffB); PG8_STAGE(PG8_SA(0, 1), cA + hstep, voffA);
        if (wr == 1) PG8_BAR;
        PG8_WAIT_V(4); PG8_BAR;
        PG8_STAGE(PG8_SB(1, 0), cB + kstep, voffB); PG8_STAGE(PG8_SA(1, 0), cA + kstep, voffA); PG8_STAGE(PG8_SB(1, 1), cB + hstep + kstep, voffB);
        PG8_WAIT_V(6); PG8_BAR;
    }
    for (;;) {
        const bool has_next = S.next(ui + 1, nxt);
        const char* nA = has_next ? (const char*)g.A + (size_t)nxt.pm * tstep : cA; const char* nB = has_next ? (const char*)g.Bt + (size_t)nxt.pn * tstep : cB;
        for (int t = 0; t < nt; t += 2) {
            const bool last = (t == nt - 2);
            const char* a1 = cA + (size_t)(t + 1) * kstep;
            const char* a2 = last ? nA : cA + (size_t)(t + 2) * kstep; const char* b2 = last ? nB : cB + (size_t)(t + 2) * kstep;
            const char* a3 = a2 + kstep; const char* b3 = b2 + kstep;
            if (last && has_next) S.a_ready(nxt);
            if constexpr (SP2) {
            PG8_LDB(B0, 0, 0); PG8_LDB(B1, 0, 1); PG8_SCHED; PG8_LDA(At, 0, 0); PG8_STAGE(PG8_SA(1, 1), a1 + hstep, voffA);
            PG8_WAIT_V(8); PG8_WAIT_L(0); PG8_BAR; PG8_MMA(0, 0, At, B0); PG8_MMA(0, 1, At, B1); PG8_BAR; PG8_SCHED;
            PG8_LDA(At, 0, 1); PG8_STAGE(PG8_SB(0, 0), b2, voffB); PG8_STAGE(PG8_SB(0, 1), b2 + hstep, voffB); PG8_STAGE(PG8_SA(0, 0), a2, voffA);
            PG8_WAIT_V(8); PG8_WAIT_L(0); PG8_BAR; PG8_MMA(1, 0, At, B0); PG8_MMA(1, 1, At, B1); PG8_BAR; PG8_SCHED;
            PG8_LDB(B0, 1, 0); PG8_LDB(B1, 1, 1); PG8_SCHED; PG8_LDA(At, 1, 0); PG8_STAGE(PG8_SA(0, 1), a2 + hstep, voffA);
            PG8_WAIT_V(8); PG8_WAIT_L(0); PG8_BAR; PG8_MMA(0, 0, At, B0); PG8_MMA(0, 1, At, B1); PG8_BAR; PG8_SCHED;
            PG8_LDA(At, 1, 1); PG8_STAGE(PG8_SB(1, 0), b3, voffB); PG8_STAGE(PG8_SB(1, 1), b3 + hstep, voffB); PG8_STAGE(PG8_SA(1, 0), a3, voffA);
            PG8_WAIT_V(8); PG8_WAIT_L(0); PG8_BAR; PG8_MMA(1, 0, At, B0); PG8_MMA(1, 1, At, B1); PG8_BAR; PG8_SCHED;
            } else {
            PG8_LDB(B0, 0, 0); PG8_SCHED; PG8_LDA(At, 0, 0); PG8_STAGE(PG8_SA(1, 1), a1 + hstep, voffA);
            PG8_WAIT_L(8); PG8_BAR; PG8_WAIT_L(0); PG8_MMA(0, 0, At, B0); PG8_BAR; PG8_SCHED;
            PG8_LDB(B1, 0, 1); PG8_STAGE(PG8_SB(0, 0), b2, voffB);
            PG8_BAR; PG8_WAIT_L(0); PG8_MMA(0, 1, At, B1); PG8_BAR;
            PG8_LDA(At, 0, 1); PG8_STAGE(PG8_SA(0, 0), a2, voffA);
            PG8_BAR; PG8_WAIT_L(0); PG8_MMA(1, 0, At, B0); PG8_BAR; PG8_SCHED;
            PG8_STAGE(PG8_SB(0, 1), b2 + hstep, voffB);
            PG8_WAIT_V(6); PG8_BAR; PG8_MMA(1, 1, At, B1); PG8_BAR;
            PG8_LDB(B0, 1, 0); PG8_SCHED; PG8_LDA(At, 1, 0); PG8_STAGE(PG8_SA(0, 1), a2 + hstep, voffA);
            PG8_WAIT_L(8); PG8_BAR; PG8_WAIT_L(0); PG8_MMA(0, 0, At, B0); PG8_BAR; PG8_SCHED;
            PG8_LDB(B1, 1, 1); PG8_STAGE(PG8_SB(1, 0), b3, voffB);
            PG8_BAR; PG8_WAIT_L(0); PG8_MMA(0, 1, At, B1); PG8_BAR;
            PG8_LDA(At, 1, 1); PG8_STAGE(PG8_SA(1, 0), a3, voffA);
            PG8_BAR; PG8_WAIT_L(0); PG8_MMA(1, 0, At, B0); PG8_BAR; PG8_SCHED;
            PG8_STAGE(PG8_SB(1, 1), b3 + hstep, voffB);
            PG8_WAIT_V(6); PG8_BAR; PG8_MMA(1, 1, At, B1); PG8_BAR;
            }
        }
        if constexpr (ALIGN_EPI) { if (wr == 0) PG8_BAR; }
        if constexpr (!Epi::AFTER_DRAIN) { E(acc, cur, wr, wc, fr, fq); S.done(cur); }
        if (!has_next) break;
#pragma unroll
        for (int a = 0; a < 2; ++a)
#pragma unroll
            for (int b = 0; b < 2; ++b)
#pragma unroll
                for (int m = 0; m < 4; ++m)
#pragma unroll
                    for (int n = 0; n < 2; ++n) acc[a][b][m][n] = (f32x4){0.f, 0.f, 0.f, 0.f};
        cur = nxt; cA = nA; cB = nB; ++ui;
        if constexpr (ALIGN_EPI) { if (wr == 1) PG8_BAR; }
    }
    PG8_WAIT_V(0);
    if constexpr (!ALIGN_EPI) { if (wr == 0) PG8_BAR; }
    PG8_BAR;
    if constexpr (Epi::AFTER_DRAIN) { E.fused(acc, cur, wr, wc, fr, fq, lds, wid, lane); S.done(cur); }
#undef PG8_SA
#undef PG8_SB
#undef PG8_STAGE
#undef PG8_LDA
#undef PG8_LDB
#undef PG8_MMA
#undef PG8_WAIT_V
#undef PG8_WAIT_L
#undef PG8_BAR
#undef PG8_SCHED
}
}
__device__ __forceinline__ float row_rstd(const float* ssq, int row) {
    const f32x4* q = (const f32x4*)(ssq + (size_t)row * 16);
    const f32x4 a = q[0], b = q[1], c = q[2], d = q[3];
    return rsqrtf(((((a.x + a.y) + (a.z + a.w)) + ((b.x + b.y) + (b.z + b.w))) + (((c.x + c.y) + (c.z + c.w)) + ((d.x + d.y) + (d.z + d.w)))) * (1.f / DM) + EPS);
}
__device__ __forceinline__ void phase1_mfma(const Params& p, LAS unsigned char* lds) {
    pg8::Gemm g{(const pg8::bf16_t*)(p.ws + OFF_XN), (const pg8::bf16_t*)(p.ws + OFF_WIN), MROWS, NIN, DM};
    pg8::EpiP1 E{P1Ptrs{p.ws, p.in[10], p.in[12]}};
    const int vcu = vcu_of_block();
    pg8::P1Order S0{(int)gridDim.x, vcu, 10, MROWS / 256, false}, S1{(int)gridDim.x, vcu, 4, MROWS / 256, true};
    pg8::gemm_phase<pg8::EpiP1, pg8::P1Order, true, true, false>(lds, g, S0, E);
    pg8::gemm_phase<pg8::EpiP1, pg8::P1Order, true, true, true>(lds, g, S1, E);
    const int G = (int)gridDim.x, nun = MROWS / 256;
    const int mine = (10 * nun - vcu + G - 1) / G + (4 * nun - (G - 1 - vcu) + G - 1) / G, most = (10 * nun + G - 1) / G + 1;
    if (mine < most) {
        unsigned* ctr = (unsigned*)(p.ws + OFF_CTL) + 128;
        for (int k = 0; k < 3; ++k) {
            __syncthreads();
            if (threadIdx.x == 0) *(LAS unsigned*)(lds + LDS_Q) = atomicAdd(ctr, 1u);
            __syncthreads();
            const int c = (int)*(LAS unsigned*)(lds + LDS_Q);
            if (c >= CV_ITEMS) break;
            conv_item(p, (unsigned char*)lds, c);
        }
    }
}
__device__ __forceinline__ void phase3_mfma(const Params& p, LAS unsigned char* lds) {
    pg8::Gemm g{(const pg8::bf16_t*)(p.ws + OFF_MIX), (const pg8::bf16_t*)(p.ws + OFF_WOUT), NTOK, DM, DM};
    pg8::StaticOrder S; S.init(NTOK, DM, (int)gridDim.x, (int)blockIdx.x);
    pg8::EpiP3 E{p.in[0], p.out, (bf16_t*)(p.ws + OFF_H2B), (float*)(p.ws + OFF_SSQP)};
    pg8::gemm_phase<pg8::EpiP3, pg8::StaticOrder, true, true>(lds, g, S, E);
}

typedef float f32x16 __attribute__((ext_vector_type(16)));
constexpr int AT_KROW = 272, AT_VROW = 144, AT_KBYTES = 64 * AT_KROW, AT_VBYTES = 128 * AT_VROW, AT_STAGE = AT_KBYTES + AT_VBYTES;
__device__ __forceinline__ void attn_item(const Params& p, LAS unsigned char* lds, int item) {
    const int tid = threadIdx.x, lane = tid & 63, wave = __builtin_amdgcn_readfirstlane(tid >> 6), qg = wave >> 1, c = wave & 1, l31 = lane & 31, hh = lane >> 5;
    const int qt = item & 15, h = (item >> 4) & 3, b = item >> 6;
    const int r0 = b * SEQ + qt * 128;
    const bf16_t* QB = (const bf16_t*)(p.ws + OFF_QB); const bf16_t* KB = (const bf16_t*)(p.ws + OFF_KB); const bf16_t* VT = (const bf16_t*)(p.ws + OFF_VT);
    bf16x8 qf[4];
    {
        const bf16_t* qp = QB + (size_t)(r0 + qg * 32 + l31) * 512 + h * 128 + c * 64 + 8 * hh;
#pragma unroll
        for (int s = 0; s < 4; ++s) qf[s] = *(const bf16x8*)(qp + 16 * s);
    }
    f32x16 O[4];
#pragma unroll
    for (int i = 0; i < 4; ++i)
#pragma unroll
        for (int r = 0; r < 16; ++r) O[i][r] = 0.f;
    float m = 0.f, l = 0.f;
    const int kq0 = tid, kq1 = tid + 512;
    const bf16_t* kg0 = KB + (size_t)(kq0 >> 4) * 512 + h * 128 + (kq0 & 15) * 8; const bf16_t* kg1 = KB + (size_t)(kq1 >> 4) * 512 + h * 128 + (kq1 & 15) * 8;
    const bf16_t* vg0 = VT + (size_t)(h * 128 + (kq0 >> 3)) * MROWS + (kq0 & 7) * 8; const bf16_t* vg1 = VT + (size_t)(h * 128 + (kq1 >> 3)) * MROWS + (kq1 & 7) * 8;
    const int kl0 = (kq0 >> 4) * AT_KROW + (kq0 & 15) * 16, kl1 = (kq1 >> 4) * AT_KROW + (kq1 & 15) * 16;
    const int vl0 = AT_KBYTES + (kq0 >> 3) * AT_VROW + ((kq0 & 7) >> 1) * 32 + (kq0 & 1) * 8, vl1 = AT_KBYTES + (kq1 >> 3) * AT_VROW + ((kq1 & 7) >> 1) * 32 + (kq1 & 1) * 8;
    u32x4 kr0, kr1, vr0, vr1;
#define AT_LOAD(t) do { const size_t kro = (size_t)((t) < 32 ? b * SEQ + (t) * 64 : NTOK); \
        kr0 = *(const u32x4*)(kg0 + kro * 512); kr1 = *(const u32x4*)(kg1 + kro * 512); vr0 = *(const u32x4*)(vg0 + kro); vr1 = *(const u32x4*)(vg1 + kro); } while (0)
#define AT_WRITE(buf) do { LAS unsigned char* _b = lds + (buf) * AT_STAGE; \
        *(LAS u32x4*)(_b + kl0) = kr0; *(LAS u32x4*)(_b + kl1) = kr1; \
        *(LAS u32x2*)(_b + vl0) = (u32x2){vr0.x, vr0.y}; *(LAS u32x2*)(_b + vl0 + 16) = (u32x2){vr0.z, vr0.w}; \
        *(LAS u32x2*)(_b + vl1) = (u32x2){vr1.x, vr1.y}; *(LAS u32x2*)(_b + vl1 + 16) = (u32x2){vr1.z, vr1.w}; } while (0)
    __syncthreads();
    AT_LOAD(0); AT_WRITE(0); AT_LOAD(1); AT_WRITE(1);
    __syncthreads();
    int scur = 0;
    for (int t = 0; t < 33; ++t) {
        const int snxt2 = scur == 0 ? 2 : scur - 1;
        if (t + 2 < 33) AT_LOAD(t + 2);
        const LAS unsigned char* kb_ = lds + scur * AT_STAGE; const LAS unsigned char* vb_ = kb_ + AT_KBYTES;
        f32x16 s0, s1;
#pragma unroll
        for (int r = 0; r < 16; ++r) { s0[r] = -m; s1[r] = -m; }
#pragma unroll
        for (int s = 0; s < 4; ++s) {
            const bf16x8 k0 = *(const LAS bf16x8*)(kb_ + l31 * AT_KROW + (c * 64 + 16 * s + 8 * hh) * 2);
            s0 = __builtin_amdgcn_mfma_f32_32x32x16_bf16(k0, qf[s], s0, 0, 0, 0);
        }
#pragma unroll
        for (int s = 0; s < 4; ++s) {
            const bf16x8 k1 = *(const LAS bf16x8*)(kb_ + (32 + l31) * AT_KROW + (c * 64 + 16 * s + 8 * hh) * 2);
            s1 = __builtin_amdgcn_mfma_f32_32x32x16_bf16(k1, qf[s], s1, 0, 0, 0);
        }
        if (t == 32) {
#pragma unroll
            for (int r = 0; r < 16; ++r) { const int key = (r & 3) + 8 * (r >> 2) + 4 * hh; if (key >= 16) s0[r] = -1e30f; s1[r] = -1e30f; }
        }
        float mx = s0[0];
#pragma unroll
        for (int r = 1; r < 16; ++r) mx = fmaxf(mx, s0[r]);
#pragma unroll
        for (int r = 0; r < 16; ++r) mx = fmaxf(mx, s1[r]);
        { const u32x2 sw_ = __builtin_amdgcn_permlane32_swap(__float_as_uint(mx), __float_as_uint(mx), false, false); mx = fmaxf(__uint_as_float(sw_.x), __uint_as_float(sw_.y)); }
        if (t == 0 || __any(mx > 8.0f)) {
            const float d = t == 0 ? mx : fmaxf(mx, 0.f), alpha = __builtin_amdgcn_exp2f(-d);
            m += d; l *= alpha;
#pragma unroll
            for (int i = 0; i < 4; ++i) O[i] = O[i] * alpha;
#pragma unroll
            for (int r = 0; r < 16; ++r) { s0[r] -= d; s1[r] -= d; }
        }
        float ps = 0.f;
#define AT_PV(SREG, kb) do { \
        _Pragma("unroll") for (int r = 0; r < 16; ++r) { SREG[r] = __builtin_amdgcn_exp2f(SREG[r]); ps += SREG[r]; } \
        bf16x8 pf0, pf1; \
        { u32x4 a; a.x = pk2(SREG[0], SREG[1]); a.y = pk2(SREG[2], SREG[3]); a.z = pk2(SREG[4], SREG[5]); a.w = pk2(SREG[6], SREG[7]); pf0 = __builtin_bit_cast(bf16x8, a); \
          u32x4 bq; bq.x = pk2(SREG[8], SREG[9]); bq.y = pk2(SREG[10], SREG[11]); bq.z = pk2(SREG[12], SREG[13]); bq.w = pk2(SREG[14], SREG[15]); pf1 = __builtin_bit_cast(bf16x8, bq); } \
        _Pragma("unroll") for (int vb = 0; vb < 4; ++vb) { \
            const LAS unsigned char* vp = vb_ + (vb * 32 + l31) * AT_VROW + (kb) * 64 + hh * 16; \
            O[vb] = __builtin_amdgcn_mfma_f32_32x32x16_bf16(*(const LAS bf16x8*)vp, pf0, O[vb], 0, 0, 0); \
            O[vb] = __builtin_amdgcn_mfma_f32_32x32x16_bf16(*(const LAS bf16x8*)(vp + 32), pf1, O[vb], 0, 0, 0); } } while (0)
        AT_PV(s0, 0);
        AT_PV(s1, 1);
#undef AT_PV
        l += ps;
        if (t + 2 < 33) AT_WRITE(snxt2);
        __syncthreads();
        scur = scur == 2 ? 0 : scur + 1;
    }
    const float inv = 1.f / (l + __shfl_xor(l, 32));
    LAS float* X = (LAS float*)lds + qg * 4096;
    if (c == 1) {
#pragma unroll
        for (int vb = 0; vb < 4; ++vb)
#pragma unroll
            for (int r = 0; r < 16; ++r) X[(vb * 16 + r) * 64 + lane] = O[vb][r] * inv;
    }
    __syncthreads();
    if (c == 0) {
        const float lam = ((const float*)(p.ws + OFF_MISC))[0];
        float ss = 0.f;
#pragma unroll
        for (int vb = 0; vb < 4; ++vb)
#pragma unroll
            for (int r = 0; r < 16; ++r) { const float y = O[vb][r] * inv - lam * X[(vb * 16 + r) * 64 + lane]; O[vb][r] = y; ss += y * y; }
        ss += __shfl_xor(ss, 32);
        const float rs = rsqrtf(ss * (1.f / 128.f) + EPS) * 0.8f;
        bf16_t* orow = (bf16_t*)(p.ws + OFF_MIX) + (size_t)(r0 + qg * 32 + l31) * DM + h * 128;
#pragma unroll
        for (int vb = 0; vb < 4; ++vb)
#pragma unroll
            for (int rq = 0; rq < 4; ++rq) {
                const int v0 = vb * 32 + 8 * rq + 4 * hh;
                const f32x4 wlo = *(const f32x4*)(p.in[8] + vb * 32 + 8 * rq), whi = *(const f32x4*)(p.in[8] + vb * 32 + 8 * rq + 4);
                const f32x4 w = hh ? whi : wlo;
                u32x2 o; o.x = pk2(O[vb][4 * rq] * rs * w.x, O[vb][4 * rq + 1] * rs * w.y); o.y = pk2(O[vb][4 * rq + 2] * rs * w.z, O[vb][4 * rq + 3] * rs * w.w);
                *(u32x2*)(orow + v0) = o;
            }
    }
#undef AT_LOAD
#undef AT_WRITE
}
__device__ __forceinline__ void phase2_attn_mfma(const Params& p, LAS unsigned char* lds) {
    for (int it = vcu_of_block(); it < NB * 4 * 16; it += gridDim.x) attn_item(p, lds, it);
}


__device__ __forceinline__ int gsw(int row, int chunk) { return row * 128 + ((chunk ^ (row & 7)) << 4); }
constexpr int GL_SET = 40960;
constexpr int GL_QS = 0, GL_KS = 8192, GL_KT = 16384, GL_VT = 24576, GL_AT = 2 * GL_SET, GL_ST = GL_AT + 8192  , GL_DV = GL_ST + 32768  ;
__device__ __forceinline__ float dpp_scan64(float v) {
    v += __builtin_bit_cast(float, __builtin_amdgcn_update_dpp(0, __builtin_bit_cast(int, v), 0x111, 0xf, 0xf, false));
    v += __builtin_bit_cast(float, __builtin_amdgcn_update_dpp(0, __builtin_bit_cast(int, v), 0x112, 0xf, 0xf, false));
    v += __builtin_bit_cast(float, __builtin_amdgcn_update_dpp(0, __builtin_bit_cast(int, v), 0x114, 0xf, 0xf, false));
    v += __builtin_bit_cast(float, __builtin_amdgcn_update_dpp(0, __builtin_bit_cast(int, v), 0x118, 0xf, 0xf, false));
    v += __builtin_bit_cast(float, __builtin_amdgcn_update_dpp(0, __builtin_bit_cast(int, v), 0x142, 0xa, 0xf, false));
    v += __builtin_bit_cast(float, __builtin_amdgcn_update_dpp(0, __builtin_bit_cast(int, v), 0x143, 0xc, 0xf, false));
    return v;
}
#define DPP_STAGE8(CTRL, RM) _Pragma("unroll") for (int e = 0; e < 8; ++e) v[e] += __builtin_bit_cast(float, __builtin_amdgcn_update_dpp(0, __builtin_bit_cast(int, v[e]), CTRL, RM, 0xf, false))
__device__ __forceinline__ void dpp_scan64x8(float (&v)[8]) {
    DPP_STAGE8(0x111, 0xf); DPP_STAGE8(0x112, 0xf); DPP_STAGE8(0x114, 0xf); DPP_STAGE8(0x118, 0xf); DPP_STAGE8(0x142, 0xa); DPP_STAGE8(0x143, 0xc);
}
#undef DPP_STAGE8
struct GlaPre { f32x4 g0, g1; u32x4 q8, k8, v0, v1; };
struct GlaCtx { const bf16_t* GQ; const bf16_t* GK; const bf16_t* GVT; const float* G; bf16_t* O; int dir, h, b, nsteps, lane, wave, l15, g, vdv, vch; };
__device__ __forceinline__ int gla_rowbase(const GlaCtx& c, int st) { return c.dir ? c.b * SEQ + (31 - st) * 64 : (st == 0 ? NTOK : c.b * SEQ + (st - 1) * 64); }
__device__ __forceinline__ void gla_load(const GlaCtx& c, GlaPre& r, int st) {
    const int rb = gla_rowbase(c, st); const size_t row = (size_t)(rb + c.lane);
    r.g0 = *(const f32x4*)(c.G + row * 256 + c.h * 64 + 8 * c.wave); r.g1 = *(const f32x4*)(c.G + row * 256 + c.h * 64 + 8 * c.wave + 4);
    r.q8 = *(const u32x4*)(c.GQ + row * 256 + c.h * 64 + 8 * c.wave); r.k8 = *(const u32x4*)(c.GK + row * 256 + c.h * 64 + 8 * c.wave);
    r.v0 = *(const u32x4*)(c.GVT + (size_t)(c.h * 128 + c.vdv) * MROWS + rb + c.vch * 8); r.v1 = *(const u32x4*)(c.GVT + (size_t)(c.h * 128 + c.vdv) * MROWS + rb + c.vch * 8 + 8);
}
__device__ __forceinline__ void gla_step(const GlaCtx& c, LAS unsigned char* lds, GlaPre& r, f32x4 (&accS)[4], int st) {
    const int lane = c.lane, wave = c.wave, l15 = c.l15, g = c.g, dir = c.dir;
    const bool meta = (dir == 0 && st == 0);
    const int rowbase = gla_rowbase(c, st);
    LAS unsigned char* sb = lds + (st & 1) * GL_SET;
    float gg[8] = {r.g0.x, r.g0.y, r.g0.z, r.g0.w, r.g1.x, r.g1.y, r.g1.z, r.g1.w};
    if (meta && lane >= NMETA) {
#pragma unroll
        for (int e = 0; e < 8; ++e) gg[e] = 0.f;
    }
    const u32x4 q8 = r.q8, k8 = r.k8;
    float qv[8] = {bflo(q8.x), bfhi(q8.x), bflo(q8.y), bfhi(q8.y), bflo(q8.z), bfhi(q8.z), bflo(q8.w), bfhi(q8.w)};
    float kv[8] = {bflo(k8.x), bfhi(k8.x), bflo(k8.y), bfhi(k8.y), bflo(k8.z), bfhi(k8.z), bflo(k8.w), bfhi(k8.w)};
    float qn[8], kn[8], ks[8], eTv[8], Pv[8];
#pragma unroll
    for (int e = 0; e < 8; ++e) Pv[e] = gg[e];
    dpp_scan64x8(Pv);
#pragma unroll
    for (int e = 0; e < 8; ++e) {
        const float P = Pv[e];
        const float T = __builtin_bit_cast(float, __builtin_amdgcn_readlane(__builtin_bit_cast(int, P), 63));
        const float Bv = dir ? (T - P + gg[e]) : P;
        const float eb = __expf(Bv), en = __builtin_amdgcn_rcpf(eb), eT = __expf(T);
        qn[e] = qv[e] * eb; kn[e] = kv[e] * en; ks[e] = kn[e] * eT; eTv[e] = eT;
    }
    if (lane == 0) {
        *(LAS f32x4*)(lds + GL_DV + (st & 1) * 256 + 8 * wave * 4) = (f32x4){eTv[0], eTv[1], eTv[2], eTv[3]};
        *(LAS f32x4*)(lds + GL_DV + (st & 1) * 256 + 8 * wave * 4 + 16) = (f32x4){eTv[4], eTv[5], eTv[6], eTv[7]};
    }
    *(LAS u32x4*)(sb + GL_QS + gsw(lane, wave)) = (u32x4){pk2(qn[0], qn[1]), pk2(qn[2], qn[3]), pk2(qn[4], qn[5]), pk2(qn[6], qn[7])};
    *(LAS u32x4*)(sb + GL_KS + gsw(lane, wave)) = (u32x4){pk2(kn[0], kn[1]), pk2(kn[2], kn[3]), pk2(kn[4], kn[5]), pk2(kn[6], kn[7])};
#pragma unroll
    for (int e = 0; e < 8; e += 2) { const unsigned w = pk2(ks[e], ks[e + 1]);
        *(LAS unsigned short*)(sb + GL_KT + gsw(8 * wave + e, lane >> 3) + (lane & 7) * 2) = (unsigned short)w;
        *(LAS unsigned short*)(sb + GL_KT + gsw(8 * wave + e + 1, lane >> 3) + (lane & 7) * 2) = (unsigned short)(w >> 16); }
    *(LAS u32x4*)(sb + GL_VT + gsw(c.vdv, c.vch)) = r.v0; *(LAS u32x4*)(sb + GL_VT + gsw(c.vdv, c.vch + 1)) = r.v1;
    if (st + 2 < c.nsteps) gla_load(c, r, st + 2);
    __syncthreads();
    const LAS unsigned char* STo = lds + GL_ST + (st & 1) * 16384; LAS unsigned char* STn = lds + GL_ST + ((st + 1) & 1) * 16384;
    if (!meta) {
        const int jb = wave >> 1;
#pragma unroll
        for (int ii = 0; ii < 2; ++ii) {
            const int ib = 2 * (wave & 1) + ii;
            f32x4 a = (f32x4){0.f, 0.f, 0.f, 0.f};
            const bool live = dir ? (jb >= ib) : (jb <= ib);
            if (live) {
#pragma unroll
                for (int ks2 = 0; ks2 < 2; ++ks2) {
                    const bf16x8 kf = *(const LAS bf16x8*)(sb + GL_KS + gsw(jb * 16 + l15, ks2 * 4 + g));
                    const bf16x8 qf = *(const LAS bf16x8*)(sb + GL_QS + gsw(ib * 16 + l15, ks2 * 4 + g));
                    a = __builtin_amdgcn_mfma_f32_16x16x32_bf16(kf, qf, a, 0, 0, 0);
                }
                const int i = ib * 16 + l15, j0 = jb * 16 + 4 * g;
#pragma unroll
                for (int rr = 0; rr < 4; ++rr) { const bool keep = dir ? (j0 + rr >= i) : (j0 + rr <= i); a[rr] = keep ? a[rr] : 0.f; }
            }
            const int i = ib * 16 + l15, j0 = jb * 16 + 4 * g;
            *(LAS u32x2*)(lds + GL_AT + gsw(i, j0 >> 3) + (j0 & 7) * 2) = (u32x2){pk2(a[0], a[1]), pk2(a[2], a[3])};
        }
    }
    if (st + 1 < c.nsteps) {
#pragma unroll
        for (int kb = 0; kb < 4; ++kb) {
            const f32x4 dvv = *(const LAS f32x4*)(lds + GL_DV + (st & 1) * 256 + (kb * 16 + 4 * g) * 4);
            f32x4 a = accS[kb] * dvv;
#pragma unroll
            for (int ks2 = 0; ks2 < 2; ++ks2) {
                const bf16x8 kf = *(const LAS bf16x8*)(sb + GL_KT + gsw(kb * 16 + l15, ks2 * 4 + g));
                const bf16x8 vf = *(const LAS bf16x8*)(sb + GL_VT + gsw(wave * 16 + l15, ks2 * 4 + g));
                a = __builtin_amdgcn_mfma_f32_16x16x32_bf16(kf, vf, a, 0, 0, 0);
            }
            accS[kb] = a;
            const int dk0 = kb * 16 + 4 * g;
            *(LAS u32x2*)(STn + gsw(wave * 16 + l15, dk0 >> 3) + (dk0 & 7) * 2) = (u32x2){pk2(a[0], a[1]), pk2(a[2], a[3])};
        }
    }
    __syncthreads();
    if (!meta) {
#pragma unroll
        for (int ib = 0; ib < 4; ++ib) {
            f32x4 a = (f32x4){0.f, 0.f, 0.f, 0.f};
#pragma unroll
            for (int ks2 = 0; ks2 < 2; ++ks2) {
                const bf16x8 vf = *(const LAS bf16x8*)(sb + GL_VT + gsw(wave * 16 + l15, ks2 * 4 + g));
                const bf16x8 af = *(const LAS bf16x8*)(lds + GL_AT + gsw(ib * 16 + l15, ks2 * 4 + g));
                a = __builtin_amdgcn_mfma_f32_16x16x32_bf16(vf, af, a, 0, 0, 0);
                const bf16x8 sf = *(const LAS bf16x8*)(STo + gsw(wave * 16 + l15, ks2 * 4 + g));
                const bf16x8 qf = *(const LAS bf16x8*)(sb + GL_QS + gsw(ib * 16 + l15, ks2 * 4 + g));
                a = __builtin_amdgcn_mfma_f32_16x16x32_bf16(sf, qf, a, 0, 0, 0);
            }
            *(u32x2*)(c.O + (size_t)(rowbase + ib * 16 + l15) * 512 + c.h * 128 + wave * 16 + 4 * g) = (u32x2){pk2(a[0], a[1]), pk2(a[2], a[3])};
        }
    }
}
__device__ __forceinline__ void gla_chain(const Params& p, LAS unsigned char* lds, int item) {
    const int tid = threadIdx.x;
    GlaCtx c;
    c.lane = tid & 63; c.wave = __builtin_amdgcn_readfirstlane(tid >> 6); c.l15 = c.lane & 15; c.g = c.lane >> 4;
    c.dir = item & 1; c.h = (item >> 1) & 3; c.b = item >> 3;
    c.GQ = (const bf16_t*)(p.ws + OFF_GQ); c.GK = (const bf16_t*)(p.ws + OFF_GK); c.GVT = (const bf16_t*)(p.ws + OFF_GVT);
    c.G = (const float*)(p.ws + (c.dir ? OFF_GB : OFF_GF));
    c.O = (bf16_t*)p.out + (c.dir ? (size_t)NTOK * 512 : 0);
    c.nsteps = c.dir ? 32 : 33; c.vdv = tid >> 2; c.vch = (tid & 3) * 2;
    f32x4 accS[4];
#pragma unroll
    for (int i = 0; i < 4; ++i) accS[i] = (f32x4){0.f, 0.f, 0.f, 0.f};
    __syncthreads();
    *(LAS u32x4*)(lds + GL_ST + tid * 32) = (u32x4){0u, 0u, 0u, 0u}; *(LAS u32x4*)(lds + GL_ST + tid * 32 + 16) = (u32x4){0u, 0u, 0u, 0u};
    GlaPre X, Y;
    gla_load(c, X, 0); gla_load(c, Y, 1);
    for (int st = 0; st < c.nsteps; st += 2) {
        gla_step(c, lds, X, accS, st);
        if (st + 1 < c.nsteps) gla_step(c, lds, Y, accS, st + 1);
    }
    asm volatile("s_waitcnt vmcnt(0)" ::: "memory");
    __syncthreads();
    if (tid == 0) {
        __builtin_amdgcn_fence(__ATOMIC_RELEASE, "agent");
        asm volatile("s_waitcnt vmcnt(0)" ::: "memory");
        __hip_atomic_fetch_add((unsigned*)(p.ws + OFF_CTL) + 4096 + (item >> 1) * 64, 1u, __ATOMIC_RELAXED, __HIP_MEMORY_SCOPE_AGENT);
    }
}
__device__ __forceinline__ void gla_combine_item(const Params& p, LAS unsigned char* lds, int item) {
    const int tid = threadIdx.x, lane = tid & 63, wave = tid >> 6;
    const int bh = item >> 3, part = item & 7, b = bh >> 2, h = bh & 3;
    if (tid == 0) {
        unsigned* flag = (unsigned*)(p.ws + OFF_CTL) + 4096 + bh * 64;
        unsigned spins = 0;
        while (__hip_atomic_load(flag, __ATOMIC_RELAXED, __HIP_MEMORY_SCOPE_AGENT) < 2u) { __builtin_amdgcn_s_sleep(8); if (++spins > (1u << 22)) break; }
        __builtin_amdgcn_fence(__ATOMIC_ACQUIRE, "agent");
        asm volatile("s_waitcnt vmcnt(0)" ::: "memory");
    }
    __syncthreads();
    const bf16_t* GR = (const bf16_t*)(p.ws + OFF_GR); bf16_t* MIX = (bf16_t*)(p.ws + OFF_MIX);
    const bf16_t* OF = (const bf16_t*)p.out; const bf16_t* OBk = OF + (size_t)NTOK * 512;
    const int c0 = h * 128 + (lane & 15) * 8;
    const f32x4 w0 = *(const f32x4*)(p.in[13] + (lane & 15) * 8), w1 = *(const f32x4*)(p.in[13] + (lane & 15) * 8 + 4);
#pragma unroll 2
    for (int i = 0; i < 8; ++i) {
        const int r = b * SEQ + part * 256 + wave * 32 + i * 4 + (lane >> 4);
        const u32x4 a = *(const u32x4*)(OF + (size_t)r * 512 + c0), bq = *(const u32x4*)(OBk + (size_t)r * 512 + c0);
        const f32x4 x0 = (f32x4){bflo(a.x) + bflo(bq.x), bfhi(a.x) + bfhi(bq.x), bflo(a.y) + bflo(bq.y), bfhi(a.y) + bfhi(bq.y)};
        const f32x4 x1 = (f32x4){bflo(a.z) + bflo(bq.z), bfhi(a.z) + bfhi(bq.z), bflo(a.w) + bflo(bq.w), bfhi(a.w) + bfhi(bq.w)};
        float s = x0.x * x0.x + x0.y * x0.y + x0.z * x0.z + x0.w * x0.w + x1.x * x1.x + x1.y * x1.y + x1.z * x1.z + x1.w * x1.w;
        s += __shfl_xor(s, 1); s += __shfl_xor(s, 2); s += __shfl_xor(s, 4); s += __shfl_xor(s, 8);
        const float rs = rsqrtf(s * (1.f / 128.f) + EPS);
        const u32x4 g = *(const u32x4*)(GR + (size_t)r * 512 + c0);
        u32x4 o;
        o.x = pk2(x0.x * rs * w0.x * bflo(g.x), x0.y * rs * w0.y * bfhi(g.x)); o.y = pk2(x0.z * rs * w0.z * bflo(g.y), x0.w * rs * w0.w * bfhi(g.y));
        o.z = pk2(x1.x * rs * w1.x * bflo(g.z), x1.y * rs * w1.y * bfhi(g.z)); o.w = pk2(x1.z * rs * w1.z * bflo(g.w), x1.w * rs * w1.w * bfhi(g.w));
        *(u32x4*)(MIX + (size_t)r * DM + 512 + c0) = o;
    }
}

__device__ __forceinline__ void phase2(const Params& p, LAS unsigned char* lds, int qslot = 0) {
    unsigned* ctr = (unsigned*)(p.ws + OFF_CTL) + (qslot >= 2 ? 2048 + qslot * 64 : qslot * 64);
    int it;
#define P2_NEXT() do { __syncthreads(); if (threadIdx.x == 0) *(LAS unsigned*)(lds + LDS_Q) = atomicAdd(ctr, 1u); __syncthreads(); it = (int)*(LAS unsigned*)(lds + LDS_Q); } while (0)
    P2_NEXT();
    if (qslot != 3) { while (it < 64) { gla_chain(p, lds, it); P2_NEXT(); } }
    if (qslot == 2) return;
    if (qslot == 3) it += 64;
    while (it < 64 + NB * 4 * 16) { attn_item(p, lds, it - 64); P2_NEXT(); if (qslot == 3) it += 64; }
    if (qslot) return;
    for (;;) {
        __syncthreads();
        if (threadIdx.x == 0) *(LAS unsigned*)(lds + LDS_Q) = atomicAdd(ctr + 192, 1u);
        __syncthreads();
        const int c = (int)*(LAS unsigned*)(lds + LDS_Q);
        if (c >= 256) break;
        gla_combine_item(p, lds, c);
    }
    for (;;) {
        __syncthreads();
        if (threadIdx.x == 0) *(LAS unsigned*)(lds + LDS_Q) = atomicAdd(ctr + 128, 1u);
        __syncthreads();
        const int c = (int)*(LAS unsigned*)(lds + LDS_Q);
        if (c >= CV_ITEMS) break;
        conv_item(p, (unsigned char*)lds, c);
    }
#undef P2_NEXT
}

__device__ __forceinline__ void phase2c(const Params& p) {
    const int tid = threadIdx.x, lane = tid & 63, wave = tid >> 6;
    const int gw = blockIdx.x * 8 + wave, NGW = gridDim.x * 8;
    const bf16_t* GR = (const bf16_t*)(p.ws + OFF_GR); bf16_t* MIX = (bf16_t*)(p.ws + OFF_MIX);
    const bf16_t* OF = (const bf16_t*)p.out; const bf16_t* OBk = OF + (size_t)NTOK * 512;
    const int c0 = lane * 8;
    const f32x4 w0 = *(const f32x4*)(p.in[13] + (c0 & 127)), w1 = *(const f32x4*)(p.in[13] + (c0 & 127) + 4);
    for (int r = gw; r < NTOK; r += NGW) {
        const u32x4 a = *(const u32x4*)(OF + (size_t)r * 512 + c0), bq = *(const u32x4*)(OBk + (size_t)r * 512 + c0);
        const f32x4 x0 = (f32x4){bflo(a.x) + bflo(bq.x), bfhi(a.x) + bfhi(bq.x), bflo(a.y) + bflo(bq.y), bfhi(a.y) + bfhi(bq.y)};
        const f32x4 x1 = (f32x4){bflo(a.z) + bflo(bq.z), bfhi(a.z) + bfhi(bq.z), bflo(a.w) + bflo(bq.w), bfhi(a.w) + bfhi(bq.w)};
        float s = x0.x * x0.x + x0.y * x0.y + x0.z * x0.z + x0.w * x0.w + x1.x * x1.x + x1.y * x1.y + x1.z * x1.z + x1.w * x1.w;
        s += __shfl_xor(s, 1); s += __shfl_xor(s, 2); s += __shfl_xor(s, 4); s += __shfl_xor(s, 8);
        const float rs = rsqrtf(s * (1.f / 128.f) + EPS);
        const u32x4 g = *(const u32x4*)(GR + (size_t)r * 512 + c0);
        u32x4 o;
        o.x = pk2(x0.x * rs * w0.x * bflo(g.x), x0.y * rs * w0.y * bfhi(g.x)); o.y = pk2(x0.z * rs * w0.z * bflo(g.y), x0.w * rs * w0.w * bfhi(g.y));
        o.z = pk2(x1.x * rs * w1.x * bflo(g.z), x1.y * rs * w1.y * bfhi(g.z)); o.w = pk2(x1.z * rs * w1.z * bflo(g.w), x1.w * rs * w1.w * bfhi(g.w));
        *(u32x4*)(MIX + (size_t)r * DM + 512 + c0) = o;
    }
}


#define TOPK_INS(L, x) do { float _x = (x); _Pragma("unroll") for (int _s = 0; _s < 16; ++_s) { const float _t = fmaxf(L[_s], _x); _x = fminf(L[_s], _x); L[_s] = _t; } } while (0)
constexpr int P4_QROW = 528, P4_SC0 = 128 * P4_QROW  , P4_TLROW = 144;

#define CE_DESC(a, b) do { const float _hi = fmaxf(a, b), _lo = fminf(a, b); a = _hi; b = _lo; } while (0)
__device__ __forceinline__ void bitonic_sort16_desc(float (&x)[16]) {
#pragma unroll
    for (int k = 2; k <= 16; k <<= 1)
#pragma unroll
        for (int j = k >> 1; j > 0; j >>= 1)
#pragma unroll
            for (int i = 0; i < 16; ++i) { const int l = i ^ j; if (l > i) { if ((i & k) == 0) CE_DESC(x[i], x[l]); else CE_DESC(x[l], x[i]); } }
}
__device__ __forceinline__ void bitonic_merge16_desc(float (&x)[16]) {
#pragma unroll
    for (int j = 8; j > 0; j >>= 1)
#pragma unroll
        for (int i = 0; i < 16; ++i) { const int l = i ^ j; if (l > i) CE_DESC(x[i], x[l]); }
}
__device__ __forceinline__ void top16_merge(float (&L)[16], const float (&x)[16]) {
#pragma unroll
    for (int i = 0; i < 16; ++i) L[i] = fmaxf(L[i], x[15 - i]);
    bitonic_merge16_desc(L);
}

template <int Q> struct CandIJ {
    static constexpr int compute() { int c = 0; for (int i = 0; i < 16; ++i) for (int j = 0; j < 16; ++j) if ((i + 1) * (j + 1) <= 16) { if (c == Q) return i * 16 + j; ++c; } return -1; }
    static constexpr int v = compute();
};
template <int G, int S> __device__ __forceinline__ void cand_fill(float (&x)[16], const float (&A)[16], const float (&Bv)[16]) {
    constexpr int ij = CandIJ<G * 16 + S>::v;
    if constexpr (ij >= 0) x[S] = __uint_as_float((__float_as_uint(A[ij >> 4] + Bv[ij & 15]) & ~255u) | (unsigned)ij); else x[S] = -3.0e38f;
    if constexpr (S + 1 < 16) cand_fill<G, S + 1>(x, A, Bv);
}
__device__ __forceinline__ void p4_route_half(const Params& p, LAS unsigned char* lds, int m0, int h) {
    int tid_ = threadIdx.x; asm volatile("" : "+v"(tid_));
    const int tid = tid_, lane = tid & 63, wave = __builtin_amdgcn_readfirstlane(tid >> 6), l15 = lane & 15, g = lane >> 4;
    const bf16_t* KEYS = (const bf16_t*)(p.ws + OFF_KEYS); unsigned* PW0 = (unsigned*)(p.ws + OFF_PW0);
        {
            const int wr = wave >> 1, wk = wave & 1;
            f32x4 sc[2][2][4];
#pragma unroll
            for (int pp = 0; pp < 2; ++pp) {
#pragma unroll
                for (int rb = 0; rb < 2; ++rb)
#pragma unroll
                    for (int kk = 0; kk < 4; ++kk) sc[pp][rb][kk] = (f32x4){0.f, 0.f, 0.f, 0.f};
                const bf16_t* kbase = KEYS + (size_t)((h * 2 + pp) * 128 + 64 * wk + l15) * 128 + 8 * g;
#pragma unroll
                for (int ks = 0; ks < 4; ++ks) {
                    bf16x8 qf[2], kf[4];
#pragma unroll
                    for (int rb = 0; rb < 2; ++rb) qf[rb] = *(const LAS bf16x8*)(lds + (32 * wr + 16 * rb + l15) * P4_QROW + (pp * 128 + ks * 32 + 8 * g) * 2);
#pragma unroll
                    for (int kk = 0; kk < 4; ++kk) kf[kk] = *(const bf16x8*)(kbase + (size_t)(16 * kk) * 128 + ks * 32);
#pragma unroll
                    for (int rb = 0; rb < 2; ++rb)
#pragma unroll
                        for (int kk = 0; kk < 4; ++kk) sc[pp][rb][kk] = __builtin_amdgcn_mfma_f32_16x16x32_bf16(kf[kk], qf[rb], sc[pp][rb][kk], 0, 0, 0);
                }
            }
#pragma unroll
            for (int rb = 0; rb < 2; ++rb)
#pragma unroll
                for (int kk = 0; kk < 4; ++kk) *(LAS f32x4*)(lds + P4_SC0 + (32 * wr + 16 * rb + l15) * P4_QROW + (64 * wk + 16 * kk + 4 * g) * 4) = sc[0][rb][kk];
            __syncthreads();
#pragma unroll
            for (int rb = 0; rb < 2; ++rb)
#pragma unroll
                for (int kk = 0; kk < 4; ++kk) *(LAS f32x4*)(lds + (32 * wr + 16 * rb + l15) * P4_QROW + (64 * wk + 16 * kk + 4 * g) * 4) = sc[1][rb][kk];
        }
        __syncthreads();
        {
            const int hf = tid & 1, row = (tid >> 1) & 127, pp = tid >> 8;
            const LAS unsigned char* sp = lds + (pp ? 0 : P4_SC0) + row * P4_QROW + hf * 256;
            float L[16];
#pragma unroll
            for (int grp = 0; grp < 4; ++grp) {
                float x[16];
#pragma unroll
                for (int q4 = 0; q4 < 4; ++q4) {
                    const f32x4 v = *(const LAS f32x4*)(sp + (grp * 4 + q4) * 16);
                    const unsigned kb = (unsigned)(hf * 64 + grp * 16 + q4 * 4);
                    x[4 * q4 + 0] = __uint_as_float((__float_as_uint(v.x) & ~127u) | kb);
                    x[4 * q4 + 1] = __uint_as_float((__float_as_uint(v.y) & ~127u) | (kb + 1));
                    x[4 * q4 + 2] = __uint_as_float((__float_as_uint(v.z) & ~127u) | (kb + 2));
                    x[4 * q4 + 3] = __uint_as_float((__float_as_uint(v.w) & ~127u) | (kb + 3));
                }
                bitonic_sort16_desc(x);
                if (grp == 0) {
#pragma unroll
                    for (int s = 0; s < 16; ++s) L[s] = x[s];
                } else top16_merge(L, x);
            }
            {
                float Oth[16];
#pragma unroll
                for (int s = 0; s < 16; ++s) Oth[s] = __shfl_xor(L[s], 1);
                top16_merge(L, Oth);
            }
            __syncthreads();
            if (hf == 0) {
                LAS f32x4* tl = (LAS f32x4*)(lds + P4_SC0 + row * (2 * P4_TLROW) + pp * P4_TLROW);
                tl[0] = (f32x4){L[0], L[1], L[2], L[3]}; tl[1] = (f32x4){L[4], L[5], L[6], L[7]}; tl[2] = (f32x4){L[8], L[9], L[10], L[11]}; tl[3] = (f32x4){L[12], L[13], L[14], L[15]};
            }
        }
        __syncthreads();
        if (tid < 128) {
            const LAS unsigned char* tl = lds + P4_SC0 + tid * (2 * P4_TLROW);
            float A[16], Bv[16];
#pragma unroll
            for (int q4 = 0; q4 < 4; ++q4) { const f32x4 a = *(const LAS f32x4*)(tl + q4 * 16), b = *(const LAS f32x4*)(tl + P4_TLROW + q4 * 16);
                A[4 * q4] = a.x; A[4 * q4 + 1] = a.y; A[4 * q4 + 2] = a.z; A[4 * q4 + 3] = a.w; Bv[4 * q4] = b.x; Bv[4 * q4 + 1] = b.y; Bv[4 * q4 + 2] = b.z; Bv[4 * q4 + 3] = b.w; }
#pragma unroll
            for (int s = 0; s < 16; ++s) { A[s] = __uint_as_float(__float_as_uint(A[s]) & ~127u); Bv[s] = __uint_as_float(__float_as_uint(Bv[s]) & ~127u); }
            float L[16];
            {
                float x[16];
                cand_fill<0, 0>(x, A, Bv); bitonic_sort16_desc(x);
#pragma unroll
                for (int s = 0; s < 16; ++s) L[s] = x[s];
                cand_fill<1, 0>(x, A, Bv); bitonic_sort16_desc(x); top16_merge(L, x);
                cand_fill<2, 0>(x, A, Bv); bitonic_sort16_desc(x); top16_merge(L, x);
                cand_fill<3, 0>(x, A, Bv); bitonic_sort16_desc(x); top16_merge(L, x);
            }
            const float v0 = __uint_as_float(__float_as_uint(L[0]) & ~255u);
            float e[16], den = 0.f; int id[16];
#pragma unroll
            for (int s = 0; s < 16; ++s) {
                const unsigned u = __float_as_uint(L[s]);
                e[s] = __expf(__uint_as_float(u & ~255u) - v0); den += e[s];
                const unsigned i = (u >> 4) & 15u, j = u & 15u;
                const unsigned ka = *(const LAS unsigned*)(tl + i * 4) & 127u, kb = *(const LAS unsigned*)(tl + P4_TLROW + j * 4) & 127u;
                id[s] = (int)(ka * 128u + kb);
            }
            const float inv = 1.f / den;
            unsigned* ip = PW0 + (size_t)(m0 + tid) * 128 + h * 16;
#pragma unroll
            for (int q4 = 0; q4 < 4; ++q4) { u32x4 o;
#pragma unroll
                for (int c = 0; c < 4; ++c) o[c] = (unsigned)id[4 * q4 + c] | (f2bf(e[4 * q4 + c] * inv) << 16);
                *(u32x4*)(ip + 4 * q4) = o; }
        }
        __syncthreads();
}

namespace pg8 {
struct EpiP4 {
    static constexpr bool PERM = true, AFTER_DRAIN = true, SWAPPABLE = false;
    const Params* pp; const float* ssq;
    __device__ __forceinline__ void operator()(const f32x4 (&)[2][2][4][2], const Unit&, int, int, int, int) const {}
    __device__ __forceinline__ void fused(f32x4 (&acc)[2][2][4][2], const Unit& u, int wr, int wc, int fr, int fq, PG8_LAS unsigned char* lds, int wid, int lane) const {
#pragma unroll
        for (int ai = 0; ai < 2; ++ai) {
            const int m0 = u.pm * BM + ai * HALF;
#pragma unroll
            for (int m = 0; m < 4; ++m) {
                const int rl = wr * 64 + m * 16 + fr;
                const float rstd = row_rstd(ssq, m0 + rl);
#pragma unroll
                for (int bj = 0; bj < 2; ++bj) { const f32x4 v0 = acc[ai][bj][m][0] * rstd, v1 = acc[ai][bj][m][1] * rstd;
                    *(PG8_LAS u32x4*)(lds + rl * P4_QROW + (bj * HALF + wc * 32 + 8 * fq) * 2) = (u32x4){pk2(v0.x, v0.y), pk2(v0.z, v0.w), pk2(v1.x, v1.y), pk2(v1.z, v1.w)}; }
            }
            __syncthreads();
            p4_route_half(*pp, lds, m0, u.pn);
        }
    }
};
}
__device__ __forceinline__ void phase4_mfma(const Params& p, LAS unsigned char* lds) {
    pg8::Gemm g{(const pg8::bf16_t*)(p.ws + OFF_H2B), (const pg8::bf16_t*)(p.ws + OFF_WQ), NTOK, 2048, DM};
    pg8::EpiP4 E{&p, (const float*)(p.ws + OFF_SSQP)};
    const int vcu = vcu_of_block();
    for (int r = 0; r * (int)gridDim.x < 512; ++r) {
        const int L = r * (int)gridDim.x + vcu;
        pg8::OneUnit S; S.u.pm = L >> 3; S.u.pn = L & 7; S.valid = L < 512;
        pg8::gemm_phase<pg8::EpiP4, pg8::OneUnit, false, true>(lds, g, S, E);
        __syncthreads();
    }
}


constexpr size_t OFF_PW = 73 * MiB;
constexpr size_t OFF_OUTS = 179 * MiB;
static_assert(OFF_OUTS >= OFF_PW0 + (size_t)NTOK * 128 * 4 && OFF_OUTS + (size_t)NTOK * DM * 4 <= 256 * MiB, "P5 map");
__device__ __forceinline__ float dot_fp8_bf16(u32x4 uq, u32x4 h0, u32x4 h1, float c) {
#define DQ2(word, hsel, hw) c = dot2(__builtin_bit_cast(unsigned, __builtin_amdgcn_cvt_scalef32_pk_bf16_fp8((int)(word), 1.0f, hsel)), hw, c)
    DQ2(uq.x, false, h0.x); DQ2(uq.x, true, h0.y); DQ2(uq.y, false, h0.z); DQ2(uq.y, true, h0.w);
    DQ2(uq.z, false, h1.x); DQ2(uq.z, true, h1.y); DQ2(uq.w, false, h1.z); DQ2(uq.w, true, h1.w);
#undef DQ2
    return c;
}
constexpr int P5A_RS = 1040, P5A_LIST = 16640, P5A_CAP = 768, P5A_RES = P5A_LIST + 4 * P5A_CAP, P5A_TSC = P5A_RES + 64, P5A_WAVE = P5A_TSC + 64;
constexpr size_t OFF_HQ = 146 * MiB;
constexpr size_t OFF_HSC = 192 * 1024;
static_assert(8 * P5A_WAVE <= LDS_BYTES - 32, "P5a LDS");
static_assert(OFF_HQ >= OFF_H2B + (size_t)NTOK * DM * 2 && OFF_HQ + (size_t)NTOK * DM <= OFF_PW0, "HQ map");
__device__ __forceinline__ void quantize_hn(const Params& p) {
    const int tid = threadIdx.x, lane = tid & 63, wave = tid >> 6;
    const bf16_t* H2B = (const bf16_t*)(p.ws + OFF_H2B); unsigned char* HQ = p.ws + OFF_HQ; float* HSC = (float*)(p.ws + OFF_HSC);
    for (int t = blockIdx.x * 8 + wave; t < NTOK; t += gridDim.x * 8) {
        const u32x4 h0 = *(const u32x4*)(H2B + (size_t)t * DM + 16 * lane), h1 = *(const u32x4*)(H2B + (size_t)t * DM + 16 * lane + 8);
        float m = 0.f;
#pragma unroll
        for (int c = 0; c < 4; ++c) { m = fmaxf(m, fmaxf(fabsf(bflo(h0[c])), fabsf(bfhi(h0[c])))); m = fmaxf(m, fmaxf(fabsf(bflo(h1[c])), fabsf(bfhi(h1[c])))); }
        const float am = fmaxf(wave_max(m), 1e-30f), qs = 224.f / am;
        u32x4 o;
#pragma unroll
        for (int c = 0; c < 2; ++c) {
            int w = __builtin_amdgcn_cvt_pk_fp8_f32(bflo(h0[2 * c]) * qs, bfhi(h0[2 * c]) * qs, 0, false); w = __builtin_amdgcn_cvt_pk_fp8_f32(bflo(h0[2 * c + 1]) * qs, bfhi(h0[2 * c + 1]) * qs, w, true); o[c] = (unsigned)w;
            int x = __builtin_amdgcn_cvt_pk_fp8_f32(bflo(h1[2 * c]) * qs, bfhi(h1[2 * c]) * qs, 0, false); x = __builtin_amdgcn_cvt_pk_fp8_f32(bflo(h1[2 * c + 1]) * qs, bfhi(h1[2 * c + 1]) * qs, x, true); o[2 + c] = (unsigned)x;
        }
        *(u32x4*)(HQ + (size_t)t * DM + 16 * lane) = o;
        if (lane == 0) HSC[t] = row_rstd((const float*)(p.ws + OFF_SSQP), t) * am * (1.f / 224.f);
    }
}
__device__ __forceinline__ void p5a_wave(const Params& p, LAS unsigned char* wl, int tb, int part, int lane, __amdgpu_buffer_rsrc_t urs, __amdgpu_buffer_rsrc_t hrs) {
    const float* USC = (const float*)(p.ws + OFF_USC); const float* VSC = (const float*)(p.ws + OFF_VSC); const float* HSC = (const float*)(p.ws + OFF_HSC);
    const unsigned* PW0 = (const unsigned*)(p.ws + OFF_PW0); unsigned* PW = (unsigned*)(p.ws + OFF_PW);
    const int l15 = lane & 15, g = lane >> 4;
    unsigned xl[16], xh[16];
#define P5A_WORDS() do { _Pragma("unroll") for (int _k = 0; _k < 16; ++_k) { xl[_k] = PW0[(size_t)(tb + _k) * 128 + lane]; xh[_k] = PW0[(size_t)(tb + _k) * 128 + 64 + lane]; } } while (0)
#define P5A_GATHER(tile_) do { int _li = (tile_) * 16 + l15; _li = _li < n ? _li : n - 1; \
        const int _ev = (int)((*(const LAS unsigned*)(wl + P5A_LIST + _li * 4) & 0x3fffu) << 10); \
        _Pragma("unroll") for (int _r = 0; _r < 16; ++_r) \
            __builtin_amdgcn_raw_ptr_buffer_load_lds(urs, (LAS unsigned*)(wl + _r * P5A_RS), 16, lane * 16, __builtin_amdgcn_readlane(_ev, _r), 0, 0); } while (0)
#pragma unroll
    for (int k = 0; k < 16; ++k) __builtin_amdgcn_raw_ptr_buffer_load_lds(hrs, (LAS unsigned*)(wl + k * 1024), 16, lane * 16, (tb + k) * 1024, 0, 0);
    P5A_WORDS();
    const float hsc = HSC[tb + l15];
    asm volatile("s_waitcnt vmcnt(0)" ::: "memory");
    long bq[32];
#pragma unroll
    for (int i = 0; i < 16; ++i) { const u32x4 w = *(const LAS u32x4*)(wl + l15 * 1024 + 64 * i + 16 * g);
        bq[2 * i] = __builtin_bit_cast(long, (u32x2){w.x, w.y}); bq[2 * i + 1] = __builtin_bit_cast(long, (u32x2){w.z, w.w}); }
    if (lane < 16) *(LAS float*)(wl + P5A_TSC + lane * 4) = hsc;
    int ntot = 0;
#pragma unroll
    for (int k = 0; k < 16; ++k) ntot += __popcll(__ballot((int)((xl[k] >> 11) & 7u) == part)) + __popcll(__ballot((int)((xh[k] >> 11) & 7u) == part));
    const int npass = ntot <= P5A_CAP ? 1 : 4;
    for (int pass = 0; pass < npass; ++pass) {
        const int klo = npass == 1 ? 0 : 4 * pass, khi = npass == 1 ? 16 : klo + 4;
        if (pass > 0) { P5A_WORDS(); asm volatile("s_waitcnt vmcnt(0)" ::: "memory"); }
        int n = 0;
#pragma unroll
        for (int k = 0; k < 16; ++k) {
            if (k >= klo && k < khi) {
                const bool ml = (int)((xl[k] >> 11) & 7u) == part, mh = (int)((xh[k] >> 11) & 7u) == part;
                const unsigned long long bl = __ballot(ml), bh = __ballot(mh);
                const int rl = __builtin_amdgcn_mbcnt_hi((unsigned)(bl >> 32), __builtin_amdgcn_mbcnt_lo((unsigned)bl, 0u));
                if (ml) *(LAS unsigned*)(wl + P5A_LIST + (n + rl) * 4) = (xl[k] & 0x3fffu) | ((unsigned)lane << 14) | ((unsigned)k << 21);
                n += __popcll(bl);
                const int rh = __builtin_amdgcn_mbcnt_hi((unsigned)(bh >> 32), __builtin_amdgcn_mbcnt_lo((unsigned)bh, 0u));
                if (mh) *(LAS unsigned*)(wl + P5A_LIST + (n + rh) * 4) = (xh[k] & 0x3fffu) | ((unsigned)(64 + lane) << 14) | ((unsigned)k << 21);
                n += __popcll(bh);
            }
        }
        __builtin_amdgcn_s_waitcnt(0xC07F); __builtin_amdgcn_wave_barrier();
        asm volatile("" ::: "memory");
        const int ntile = (n + 15) >> 4;
        if (ntile == 0) continue;
#define P5A_OPS(tile_, EOK, EE, SL, TK, USCV, VSCV, XGV) do { int _ei = (tile_) * 16 + l15; EOK = _ei < n; _ei = EOK ? _ei : n - 1; \
        const unsigned _ent = *(const LAS unsigned*)(wl + P5A_LIST + _ei * 4); \
        EE = _ent & 0x3fffu; SL = (int)((_ent >> 14) & 127u); TK = (int)(_ent >> 21); \
        USCV = USC[EE]; VSCV = VSC[EE]; XGV = PW0[(size_t)(tb + TK) * 128 + SL]; } while (0)
        bool eokN; unsigned eeN; int slN, tkN; float uscN, vscN; unsigned xgN;
        P5A_GATHER(0);
        P5A_OPS(0, eokN, eeN, slN, tkN, uscN, vscN, xgN);
        for (int tile = 0; tile < ntile; ++tile) {
            asm volatile("s_waitcnt vmcnt(0)" : "+v"(uscN), "+v"(vscN), "+v"(xgN) :: "memory");
            const bool eok = eokN; const unsigned ee = eeN; const int sl = slN, tk = tkN, t = tb + tkN; const float usc = uscN, vsc = vscN; const unsigned xg = xgN;
            long aq[32];
#pragma unroll
            for (int i = 0; i < 16; ++i) { const u32x4 w = *(const LAS u32x4*)(wl + l15 * P5A_RS + 64 * i + 16 * g);
                aq[2 * i] = __builtin_bit_cast(long, (u32x2){w.x, w.y}); aq[2 * i + 1] = __builtin_bit_cast(long, (u32x2){w.z, w.w}); }
            asm volatile("s_waitcnt lgkmcnt(0)" ::: "memory");
#pragma unroll
            for (int s = 0; s < 32; ++s) asm volatile("" : "+v"(aq[s]));
            if (tile + 1 < ntile) { P5A_GATHER(tile + 1); P5A_OPS(tile + 1, eokN, eeN, slN, tkN, uscN, vscN, xgN); }
            f32x4 acc = (f32x4){0.f, 0.f, 0.f, 0.f};
#pragma unroll
            for (int s = 0; s < 32; ++s) acc = __builtin_amdgcn_mfma_f32_16x16x32_fp8_fp8(aq[s], bq[s], acc, 0, 0, 0);
            {
                const u32x4 en = *(const LAS u32x4*)(wl + P5A_LIST + (tile * 16 + 4 * g) * 4);
#pragma unroll
                for (int r = 0; r < 4; ++r) if ((int)(en[r] >> 21) == l15) *(LAS float*)(wl + P5A_RES + (4 * g + r) * 4) = acc[r];
            }
            __builtin_amdgcn_s_waitcnt(0xC07F); __builtin_amdgcn_wave_barrier();
            asm volatile("" ::: "memory");
            if (lane < 16 && eok) {
                const float d = *(const LAS float*)(wl + P5A_RES + lane * 4) * usc * *(const LAS float*)(wl + P5A_TSC + tk * 4);
                const float w = __uint_as_float(xg & 0xffff0000u) * gelu_f(d) * vsc;
                PW[(((size_t)(t >> 6) * 32 + (sl >> 2)) * 64 + (t & 63)) * 4 + (sl & 3)] = ee | (f2bf(w) << 16);
            }
            __builtin_amdgcn_s_waitcnt(0xC07F); __builtin_amdgcn_wave_barrier();
            asm volatile("" ::: "memory");
        }
#undef P5A_OPS
    }
    asm volatile("s_waitcnt vmcnt(0)" ::: "memory");
#undef P5A_WORDS
#undef P5A_GATHER
}
__device__ __forceinline__ void phase5a(const Params& p, LAS unsigned char* lds, int qoff = 0) {
    const int tid = threadIdx.x, lane = tid & 63, wave = __builtin_amdgcn_readfirstlane(tid >> 6);
    const int xcc = (int)(__builtin_amdgcn_s_getreg((3 << 11) | 20) & 7u);
    unsigned* qc = (unsigned*)(p.ws + OFF_CTL) + 256 + qoff;
    LAS unsigned char* wl = lds + wave * P5A_WAVE;
    const __amdgpu_buffer_rsrc_t urs = __builtin_amdgcn_make_buffer_rsrc((void*)(p.ws + OFF_UB), 0, NEXP * DM, 0x00020000);
    const __amdgpu_buffer_rsrc_t hrs = __builtin_amdgcn_make_buffer_rsrc((void*)(p.ws + OFF_HQ), 0, NTOK * DM, 0x00020000);
    for (int pi = 0; pi < 8; ++pi) {
        const int part = (xcc + pi) & 7;
        for (;;) {
            __syncthreads();
            if (tid == 0) *(LAS unsigned*)(lds + LDS_Q) = atomicAdd(qc + part * 64, 1u);
            __syncthreads();
            const int it = (int)*(LAS unsigned*)(lds + LDS_Q);
            if (it >= NTOK / 128) break;
            p5a_wave(p, wl, it * 128 + wave * 16, part, lane, urs, hrs);
        }
    }
}

__device__ __forceinline__ void p5b_quad(const LAS unsigned char* lds, u32x4 q, f32x2& a0, f32x2& a1, f32x2& a2, f32x2& a3) {
#pragma unroll
    for (int c = 0; c < 4; ++c) {
        const unsigned x = q[c];
        const u32x2 vv = *(const LAS u32x2*)(lds + ((x & 0x3fffu) << 3));
        const float w = __uint_as_float(x & 0xffff0000u); const f32x2 ww = (f32x2){w, w};
        a0 += ww * __builtin_amdgcn_cvt_pk_f32_fp8((int)vv.x, false); a1 += ww * __builtin_amdgcn_cvt_pk_f32_fp8((int)vv.x, true);
        a2 += ww * __builtin_amdgcn_cvt_pk_f32_fp8((int)vv.y, false); a3 += ww * __builtin_amdgcn_cvt_pk_f32_fp8((int)vv.y, true);
    }
}
__device__ __forceinline__ void phase5b(const Params& p, LAS unsigned char* lds) {
    const int tid = threadIdx.x, lane = tid & 63, wave = __builtin_amdgcn_readfirstlane(tid >> 6);
    const unsigned char* VS = p.ws + OFF_VB; const u32x4* PW = (const u32x4*)(p.ws + OFF_PW); bf16_t* OUTS = (bf16_t*)(p.ws + OFF_OUTS);
    for (int it = blockIdx.x; it < 256; it += gridDim.x) {
        const int s = it >> 1, tbase = (it & 1) * 128;
        __syncthreads();
#pragma unroll 4
        for (int i = 0; i < 16; ++i) *(LAS u32x4*)(lds + (tid + NTHR * i) * 16) = *(const u32x4*)(VS + (size_t)s * 131072 + (size_t)(tid + NTHR * i) * 16);
        __syncthreads();
        u32x4 A[8], Bq[8];
#define P5B_LOAD(R, gi) do { const int _T = tbase + wave + 8 * ((gi) >> 2), _g = (gi) & 3; const u32x4* _p = PW + ((size_t)_T * 32 + _g * 8) * 64 + lane; \
        _Pragma("unroll") for (int _i = 0; _i < 8; ++_i) R[_i] = _p[_i * 64]; } while (0)
        f32x2 a0 = {0.f, 0.f}, a1 = {0.f, 0.f}, a2 = {0.f, 0.f}, a3 = {0.f, 0.f};
        P5B_LOAD(A, 0);
        for (int gi = 0; gi < 64; gi += 2) {
            P5B_LOAD(Bq, gi + 1);
#pragma unroll
            for (int i = 0; i < 8; ++i) p5b_quad(lds, A[i], a0, a1, a2, a3);
            if (gi + 2 < 64) P5B_LOAD(A, gi + 2);
#pragma unroll
            for (int i = 0; i < 8; ++i) p5b_quad(lds, Bq[i], a0, a1, a2, a3);
            if (((gi + 1) & 3) == 3) {
                const int T = tbase + wave + 8 * (gi >> 2);
                *(u32x4*)(OUTS + ((size_t)s * NTOK + T * 64 + lane) * 8) = (u32x4){pk2(a0.x, a0.y), pk2(a1.x, a1.y), pk2(a2.x, a2.y), pk2(a3.x, a3.y)};
                a0 = (f32x2){0.f, 0.f}; a1 = a0; a2 = a0; a3 = a0;
            }
        }
#undef P5B_LOAD
    }
}

__device__ __forceinline__ void phase5c(const Params& p, LAS unsigned char* lds) {
    const int tid = threadIdx.x, lane = tid & 63, wave = __builtin_amdgcn_readfirstlane(tid >> 6);
    const bf16_t* OUTS = (const bf16_t*)(p.ws + OFF_OUTS); const bf16_t* H2B = (const bf16_t*)(p.ws + OFF_H2B); const float* fw = p.in[20];
    for (int it = blockIdx.x; it < NTOK / 32; it += gridDim.x) {
        const int t0 = it * 32;
        __syncthreads();
#pragma unroll 4
        for (int i = 0; i < 8; ++i) {
            const int q = tid + NTHR * i, s = q >> 5, tt = q & 31;
            *(LAS u32x4*)(lds + tt * 2064 + s * 16) = *(const u32x4*)(OUTS + ((size_t)s * NTOK + t0 + tt) * 8);
        }
        __syncthreads();
        for (int i = 0; i < 4; ++i) {
            const int tt = wave * 4 + i; float* orow = p.out + (size_t)(t0 + tt) * DM;
            f32x4 h[4]; float ss = 0.f;
#pragma unroll
            for (int j = 0; j < 2; ++j) {
                const u32x4 a = *(const u32x4*)(H2B + (size_t)(t0 + tt) * DM + 512 * j + 8 * lane), pq = *(const LAS u32x4*)(lds + tt * 2064 + (512 * j + 8 * lane) * 2);
                h[2 * j] = (f32x4){bflo(a.x) + bflo(pq.x), bfhi(a.x) + bfhi(pq.x), bflo(a.y) + bflo(pq.y), bfhi(a.y) + bfhi(pq.y)};
                h[2 * j + 1] = (f32x4){bflo(a.z) + bflo(pq.z), bfhi(a.z) + bfhi(pq.z), bflo(a.w) + bflo(pq.w), bfhi(a.w) + bfhi(pq.w)};
            }
#pragma unroll
            for (int j = 0; j < 4; ++j) ss += h[j].x * h[j].x + h[j].y * h[j].y + h[j].z * h[j].z + h[j].w * h[j].w;
            const float rs = rsqrtf(wave_sum(ss) * (1.f / DM) + EPS);
#pragma unroll
            for (int j = 0; j < 2; ++j) {
                float* o = orow + 512 * j + 8 * lane; const float* w = fw + 512 * j + 8 * lane;
                *(f32x4*)o = h[2 * j] * rs * *(const f32x4*)w; *(f32x4*)(o + 4) = h[2 * j + 1] * rs * *(const f32x4*)(w + 4);
            }
        }
    }
}


#define XB_TMO      128
#define XB_XCNT(j)  (256  + 64 * (j))
#define XB_XSUB(j)  (1280 + 64 * (j))
#define XB_XGEN(j)  (2304 + 64 * (j))
#define XB_TOP      3328
#define XB_TOPGEN   3392
#define XCD_BAR_WORDS 3456
#define XB_SPIN_CAP (1u << 18)
__device__ __forceinline__ unsigned xb_ld(unsigned* p)              { return __hip_atomic_load(p, __ATOMIC_RELAXED, __HIP_MEMORY_SCOPE_AGENT); }
__device__ __forceinline__ unsigned xb_add(unsigned* p, unsigned v) { return __hip_atomic_fetch_add(p, v, __ATOMIC_RELAXED, __HIP_MEMORY_SCOPE_AGENT); }
__device__ __forceinline__ unsigned xb_xcc_id() { return (unsigned)__builtin_amdgcn_s_getreg((3 << 11) | 20) & 0xFu; }
#define XB_SPIN(cond, bar) do { unsigned _sp = 0; while (cond) { __builtin_amdgcn_s_sleep(1); \
    if ((++_sp & 255u) == 0u) { if (xb_ld(&(bar)[XB_TMO])) break; if (_sp > XB_SPIN_CAP) { atomicAdd(&(bar)[XB_TMO], 1u); break; } } } } while (0)
struct XcdBarrier { unsigned* bar; unsigned x; volatile LAS unsigned* st; };
__device__ __forceinline__ XcdBarrier xcd_barrier_post(unsigned* bar, volatile LAS unsigned* st) {
    XcdBarrier b; b.bar = bar; b.x = xb_xcc_id(); b.st = st;
    if (threadIdx.x == 0) (void)xb_add(&bar[XB_XCNT(b.x)], 1u);
    return b;
}
__device__ __forceinline__ void xcd_barrier_complete(unsigned* bar, unsigned x, unsigned& nloc, unsigned& nx) {
    const unsigned G = gridDim.x * gridDim.y * gridDim.z;
    unsigned sum, cnt, mine, sp = 0u;
    for (;;) {
        sum = 0u; cnt = 0u; mine = 0u;
#pragma unroll
        for (unsigned j = 0; j < 16; ++j) { const unsigned c = xb_ld(&bar[XB_XCNT(j)]); sum += c; cnt += (c > 0u) ? 1u : 0u; mine = (j == x) ? c : mine; }
        if (sum == G) break;
        __builtin_amdgcn_s_sleep(1);
        if ((++sp & 255u) == 0u) { if (xb_ld(&bar[XB_TMO])) break; if (sp > XB_SPIN_CAP) { atomicAdd(&bar[XB_TMO], 1u); break; } }
    }
    nloc = mine > 0u ? mine : 1u; nx = cnt > 0u ? cnt : 1u;
}
__device__ __forceinline__ void xcd_barrier(const XcdBarrier& b) {
    asm volatile("s_waitcnt vmcnt(0)" ::: "memory");
    __syncthreads();
    if (threadIdx.x == 0) {
        unsigned* bar = b.bar;
        __builtin_amdgcn_s_waitcnt(0);
        unsigned nloc = b.st[0], nx = b.st[1];
        if (nloc == 0u) { xcd_barrier_complete(bar, b.x, nloc, nx); b.st[0] = nloc; b.st[1] = nx; }
        const unsigned old = xb_add(&bar[XB_XSUB(b.x)], 1u);
        const unsigned gen = old / nloc;
        if (old + 1u == (gen + 1u) * nloc) {
            __builtin_amdgcn_fence(__ATOMIC_RELEASE, "agent");
            asm volatile("s_waitcnt vmcnt(0)" ::: "memory");
            const unsigned og = xb_add(&bar[XB_TOP], 1u);
            const unsigned tg = og / nx;
            if (og + 1u == (tg + 1u) * nx) xb_add(&bar[XB_TOPGEN], 1u);
            else XB_SPIN(xb_ld(&bar[XB_TOPGEN]) == tg, bar);
            __builtin_amdgcn_fence(__ATOMIC_ACQUIRE, "agent");
            asm volatile("s_waitcnt vmcnt(0)" ::: "memory");
        } else {
            XB_SPIN(xb_ld(&bar[XB_TOPGEN]) == gen, bar);
            __builtin_amdgcn_fence(__ATOMIC_ACQUIRE, "agent");
            asm volatile("s_waitcnt vmcnt(0)" ::: "memory");
        }
    }
    __syncthreads();
}

constexpr int NPHASE = 9;
__global__ void __launch_bounds__(NTHR, 2) mega(Params p) {
    extern __shared__ __attribute__((aligned(16))) unsigned char lds[];
    cg::grid_group grid = cg::this_grid();
#define PH_ON(k) (p.ph_lo <= (k) && (k) < p.ph_hi)
    if (threadIdx.x < 2) ((LAS unsigned*)((LAS unsigned char*)lds + LDS_BYTES - 32))[threadIdx.x] = 0u;
    __syncthreads();
    const XcdBarrier xbar = xcd_barrier_post((unsigned*)(p.ws + OFF_CTL) + 8192, (volatile LAS unsigned*)((LAS unsigned char*)lds + LDS_BYTES - 32));
#define PH_SYNC(k) do { if (PH_ON(k) && PH_ON((k) + 1)) { xcd_barrier(xbar); } } while (0)
    if (PH_ON(0)) phase0(p, lds);
    PH_SYNC(0);
    if (PH_ON(1)) phase1_mfma(p, (LAS unsigned char*)lds);
#if PROBE_DUP == 1
    xcd_barrier(xbar); phase1_mfma(p, (LAS unsigned char*)lds);
#endif
    PH_SYNC(1);
    if (PH_ON(2)) phase2(p, (LAS unsigned char*)lds);
#if PROBE_DUP == 2
    xcd_barrier(xbar); phase2(p, (LAS unsigned char*)lds, 1);
#endif
#if PROBE_DUP == 21
    xcd_barrier(xbar); phase2(p, (LAS unsigned char*)lds, 2);
#endif
#if PROBE_DUP == 22
    xcd_barrier(xbar); phase2(p, (LAS unsigned char*)lds, 3);
#endif
    PH_SYNC(2);
    if (PH_ON(4)) phase3_mfma(p, (LAS unsigned char*)lds);
#if PROBE_DUP == 4
    xcd_barrier(xbar); phase3_mfma(p, (LAS unsigned char*)lds);
#endif
    PH_SYNC(4);
    if (PH_ON(5)) { phase4_mfma(p, (LAS unsigned char*)lds); quantize_hn(p); }
#if PROBE_DUP == 5
    xcd_barrier(xbar); phase4_mfma(p, (LAS unsigned char*)lds);
#endif
    PH_SYNC(5);
    if (PH_ON(6)) phase5a(p, (LAS unsigned char*)lds);
#if PROBE_DUP == 6
    xcd_barrier(xbar); phase5a(p, (LAS unsigned char*)lds, 1024);
#endif
    PH_SYNC(6);
    if (PH_ON(7)) phase5b(p, (LAS unsigned char*)lds);
#if PROBE_DUP == 7
    xcd_barrier(xbar); phase5b(p, (LAS unsigned char*)lds);
#endif
    PH_SYNC(7);
    if (PH_ON(8)) phase5c(p, (LAS unsigned char*)lds);
}

extern "C" void kernel_launch(void* const* d_in, const int* in_sizes, int n_in, void* d_out, int out_size, void* d_ws, size_t ws_size, hipStream_t stream) {
    static int grid = 0;
    if (grid == 0) {
        if (n_in != 21 || out_size != NTOK * DM || ws_size < WS_END) { fprintf(stderr, "kernel_launch: unexpected shapes (n_in %d out %d ws %zu)\n", n_in, out_size, ws_size); grid = -1; return; }
        int dev = 0, cus = 0, per_cu = 0;
        hipGetDevice(&dev);
        hipDeviceGetAttribute(&cus, hipDeviceAttributeMultiprocessorCount, dev);
        hipFuncSetAttribute((const void*)mega, hipFuncAttributeMaxDynamicSharedMemorySize, LDS_BYTES);
        hipOccupancyMaxActiveBlocksPerMultiprocessor(&per_cu, (const void*)mega, NTHR, LDS_BYTES);
        if (per_cu < 1) { fprintf(stderr, "kernel_launch: occupancy query says %d blocks/CU\n", per_cu); per_cu = 1; }
        grid = cus * 1;
        (void)hipGetLastError();
    }
    if (grid < 0) return;
    hipMemsetAsync((char*)d_ws + OFF_CTL, 0, CTL_BYTES, stream);
    Params p{};
    for (int i = 0; i < 21; ++i) p.in[i] = (const float*)d_in[i];
    p.out = (float*)d_out; p.ws = (unsigned char*)d_ws; p.ph_lo = 0; p.ph_hi = NPHASE;
    void* args[] = {&p};
    hipError_t e = hipLaunchCooperativeKernel((const void*)mega, dim3(grid), dim3(NTHR), args, LDS_BYTES, stream);
    if (e != hipSuccess) fprintf(stderr, "cooperative launch failed: %s (grid %d)\n", hipGetErrorString(e), grid);
}
```

```cpp
#include <hip/hip_runtime.h>
#include <hip/hip_cooperative_groups.h>
#include <cstdio>
#include <cstdint>
namespace cg = cooperative_groups;

constexpr int DM = 1024;
constexpr int NB = 8, SEQ = 2048, NMETA = 16;
constexpr int NTOK = NB * SEQ;
constexpr int MROWS = 16640;
constexpr int NIN = 3584;
constexpr int TPOS = NMETA + SEQ;
constexpr float EPS = 1e-6f;
constexpr float QSCALE = 0.125f * 1.4426950408889634f;
constexpr int NEXP = 16384;
constexpr int NTHR = 512;
#ifndef PROBE_DUP
#define PROBE_DUP 0
#endif

constexpr size_t MiB = 1u << 20;
constexpr size_t OFF_CTL = 0, CTL_BYTES = 64 * 1024;
constexpr size_t OFF_MISC = 512 * 1024;
constexpr size_t OFF_ROPE = 1 * MiB;
constexpr size_t OFF_WOUT = 2 * MiB;
constexpr size_t OFF_WQ = 4 * MiB;
constexpr size_t OFF_KEYS = 8 * MiB;
constexpr size_t OFF_SSQP = 25 * MiB;
constexpr size_t OFF_UB = 9 * MiB;
constexpr size_t OFF_VB = 41 * MiB;
constexpr size_t OFF_XN = 73 * MiB;
constexpr size_t OFF_MIX = 73 * MiB;
constexpr size_t OFF_WIN = 106 * MiB;
constexpr size_t OFF_QB = 113 * MiB;
constexpr size_t OFF_KB = OFF_QB + 16 * MiB + 256 * 1024;
constexpr size_t OFF_VT = OFF_KB + 16 * MiB + 256 * 1024;
constexpr size_t OFF_H2B = 113 * MiB;
constexpr size_t OFF_GQ = 162 * MiB;
constexpr size_t OFF_GK = OFF_GQ + 8 * MiB + 256 * 1024;
constexpr size_t OFF_GVT = OFF_GK + 8 * MiB + 256 * 1024;
constexpr size_t OFF_GF = OFF_GVT + 16 * MiB + 256 * 1024;
constexpr size_t OFF_GB = OFF_GF + 16 * MiB + 256 * 1024;
constexpr size_t OFF_GR = OFF_GB + 16 * MiB + 256 * 1024;
constexpr size_t OFF_PW0 = 162 * MiB;
constexpr size_t OFF_USC = 64 * 1024;
constexpr size_t OFF_VSC = 128 * 1024;
constexpr size_t WS_END = OFF_GR + 16 * MiB + 256 * 1024;
static_assert(WS_END <= 256 * MiB, "workspace map");
static_assert(OFF_VT + (size_t)512 * MROWS * 2 <= OFF_GQ, "map D");
static_assert(OFF_WIN + (size_t)NIN * DM * 2 <= OFF_QB, "map C");

constexpr int LDS_BYTES = 163840;
constexpr int LDS_Q = LDS_BYTES - 16;

typedef unsigned short bf16_t;
typedef float f32x4 __attribute__((ext_vector_type(4)));
typedef float f32x2 __attribute__((ext_vector_type(2)));
typedef unsigned u32x4 __attribute__((ext_vector_type(4)));
typedef unsigned u32x2 __attribute__((ext_vector_type(2)));
typedef __bf16 bf16x2_t __attribute__((ext_vector_type(2)));

struct Params {
    const float* in[21];
    float* out;
    unsigned char* ws;
    int ph_lo, ph_hi;
};

__device__ __forceinline__ unsigned f2bf(float f) { unsigned u = __float_as_uint(f); return (u + 0x7fffu + ((u >> 16) & 1u)) >> 16; }
__device__ __forceinline__ float bf2f(unsigned h) { return __uint_as_float(h << 16); }
__device__ __forceinline__ unsigned pk2(float lo, float hi) { return __builtin_bit_cast(unsigned, __builtin_convertvector((f32x2){lo, hi}, bf16x2_t)); }
__device__ __forceinline__ float bflo(unsigned w) { return __uint_as_float(w << 16); }
__device__ __forceinline__ float bfhi(unsigned w) { return __uint_as_float(w & 0xffff0000u); }
__device__ __forceinline__ float dot2(unsigned a, unsigned b, float c) {
    return __builtin_amdgcn_fdot2_f32_bf16(__builtin_bit_cast(bf16x2_t, a), __builtin_bit_cast(bf16x2_t, b), c, false);
}
__device__ __forceinline__ float dot8(u32x4 a, u32x4 b, float c) { c = dot2(a.x, b.x, c); c = dot2(a.y, b.y, c); c = dot2(a.z, b.z, c); return dot2(a.w, b.w, c); }
__device__ __forceinline__ float wave_sum(float v) {
#pragma unroll
    for (int o = 1; o < 64; o <<= 1) v += __shfl_xor(v, o);
    return v;
}
__device__ __forceinline__ float wave_max(float v) {
#pragma unroll
    for (int o = 1; o < 64; o <<= 1) v = fmaxf(v, __shfl_xor(v, o));
    return v;
}
__device__ __forceinline__ float silu_f(float x) { return x * __builtin_amdgcn_rcpf(1.f + __expf(-x)); }
__device__ __forceinline__ float logsig_f(float x) { return fminf(x, 0.f) - __logf(1.f + __expf(-fabsf(x))); }
__device__ __forceinline__ float gelu_f(float v) {
    const float av = fabsf(v), t = __builtin_amdgcn_rcpf(av * 0.2316418882f + 1.0f);
    float q = t * 0.5307027145f + (-0.7265760135f); q = q * t + 0.7107068705f; q = q * t + (-0.142248368f); q = q * t + 0.127414796f; q = q * t;
    const float m = v * (q * __builtin_amdgcn_exp2f(v * v * (-0.72134752044f)));
    return v < 0.f ? m : v - m;
}

__device__ __forceinline__ float win_src(const Params& p, int k, int n) {
    const float* W = p.in[3] + (size_t)k * 3104;
    if (n < 1024) {
        const int base = n & ~63, dp = n & 63, d = dp < 16 ? ((dp >> 1) + 8 * (dp & 1)) : dp;
        return W[base + d];
    } else if (n < 3072) return W[n];
    const int j = (n - 3072) & 255, dir = (n - 3072) >> 8;
    const float* w2 = p.in[dir ? 11 : 9];
    const float* wz = W + 3072 + dir * 16;
    float s = 0.f;
#pragma unroll
    for (int r = 0; r < 16; ++r) s += wz[r] * w2[r * 256 + j];
    return s;
}

template <int WHICH>
__device__ __forceinline__ void p0_transpose_item(const Params& p, float* scr, int item, int lane) {
    constexpr int N = WHICH == 0 ? NIN : (WHICH == 1 ? 1024 : 2048);
    constexpr int nblk = N / 32;
    const int kb = item / nblk, nb = item % nblk, k0 = 64 * kb, n0 = 32 * nb;
    bf16_t* WT = (bf16_t*)(p.ws + (WHICH == 0 ? OFF_WIN : (WHICH == 1 ? OFF_WOUT : OFF_WQ)));
#pragma unroll 4
    for (int i = 0; i < 32; ++i) {
        const int kk = 2 * i + (lane >> 5), k = k0 + kk, n = n0 + (lane & 31);
        float v;
        if (WHICH == 0) v = win_src(p, k, n);
        else if (WHICH == 1) v = p.in[14][(size_t)k * 1024 + n];
        else v = p.in[16][(size_t)k * 2048 + n] * p.in[15][k];
        scr[kk * 33 + (lane & 31)] = v;
    }
    __builtin_amdgcn_s_waitcnt(0xC07F); __builtin_amdgcn_wave_barrier();
    const int c = lane & 7;
#pragma unroll
    for (int j = 0; j < 4; ++j) {
        const int n = (lane >> 3) + 8 * j; const float* s = scr + (8 * c) * 33 + n;
        u32x4 o; o.x = pk2(s[0 * 33], s[1 * 33]); o.y = pk2(s[2 * 33], s[3 * 33]); o.z = pk2(s[4 * 33], s[5 * 33]); o.w = pk2(s[6 * 33], s[7 * 33]);
        *(u32x4*)(WT + (size_t)(n0 + n) * 1024 + k0 + 8 * c) = o;
    }
    __builtin_amdgcn_s_waitcnt(0xC07F); __builtin_amdgcn_wave_barrier();
}

__device__ __forceinline__ void phase0(const Params& p, unsigned char* lds) {
    const int tid = threadIdx.x, lane = tid & 63, wave = tid >> 6;
    const int gw = blockIdx.x * 8 + wave, NGW = gridDim.x * 8;
    const long gt = (long)blockIdx.x * NTHR + tid, NGT = (long)gridDim.x * NTHR;
    {
        const f32x4* lw = (const f32x4*)p.in[2];
        bf16_t* XN = (bf16_t*)(p.ws + OFF_XN);
        for (int r = gw; r < MROWS; r += NGW) {
            const float* src = r < NTOK ? p.in[0] + (size_t)r * DM : (r < NTOK + NMETA ? p.in[1] + (size_t)(r - NTOK) * DM : nullptr);
            f32x4 v[4]; float s = 0.f;
#pragma unroll
            for (int j = 0; j < 4; ++j) { v[j] = src ? ((const f32x4*)src)[lane + 64 * j] : (f32x4){0.f, 0.f, 0.f, 0.f}; s += v[j].x * v[j].x + v[j].y * v[j].y + v[j].z * v[j].z + v[j].w * v[j].w; }
            const float rs = rsqrtf(wave_sum(s) * (1.f / DM) + EPS);
#pragma unroll
            for (int j = 0; j < 4; ++j) { const f32x4 w = lw[lane + 64 * j]; u32x2 o; o.x = pk2(v[j].x * rs * w.x, v[j].y * rs * w.y); o.y = pk2(v[j].z * rs * w.z, v[j].w * rs * w.w);
                *(u32x2*)(XN + (size_t)r * DM + 4 * (lane + 64 * j)) = o; }
        }
    }
    {
        float* scr = (float*)lds + wave * (64 * 33);
        constexpr int I0 = 16 * (NIN / 32);
        for (int it = gw; it < I0; it += NGW) p0_transpose_item<0>(p, scr, it, lane);
    }
    {
        f32x2* rope = (f32x2*)(p.ws + OFF_ROPE);
        for (long i = gt; i < TPOS * 8; i += NGT) {
            const int t = (int)(i >> 3), j = (int)(i & 7);
            const float inv = powf(500000.0f, -(float)j * 0.125f);
            const float ang = (float)t * inv;
            rope[i] = (f32x2){cosf(ang), sinf(ang)};
        }
        if (gt == 0) {
            float a = 0.f, b = 0.f;
            for (int i = 0; i < 64; ++i) { a += p.in[4][i] * p.in[5][i]; b += p.in[6][i] * p.in[7][i]; }
            ((float*)(p.ws + OFF_MISC))[0] = expf(a) - expf(b) + 0.2f;
        }
    }
}
constexpr int CV_WOUT = 64, CV_WQ = 128, CV_KEYS = 8, CV_U = 256, CV_V = 256, CV_ITEMS = CV_WOUT + CV_WQ + CV_KEYS + CV_U + CV_V;
__device__ __forceinline__ void conv_item(const Params& p, unsigned char* lds, int c) {
    const int tid = threadIdx.x, lane = tid & 63, wave = tid >> 6;
    __syncthreads();
    if (c < CV_WOUT) { p0_transpose_item<1>(p, (float*)lds + wave * (64 * 33), c * 8 + wave, lane); return; }
    c -= CV_WOUT;
    if (c < CV_WQ) { p0_transpose_item<2>(p, (float*)lds + wave * (64 * 33), c * 8 + wave, lane); return; }
    c -= CV_WQ;
    if (c < CV_KEYS) {
        bf16_t* KEYS = (bf16_t*)(p.ws + OFF_KEYS);
#pragma unroll 2
        for (int j = 0; j < 8; ++j) {
            const long e = ((long)c * 4096 + tid + NTHR * j) * 8;
            const f32x4 a = *(const f32x4*)(p.in[17] + e), b = *(const f32x4*)(p.in[17] + e + 4);
            u32x4 o; o.x = pk2(a.x, a.y); o.y = pk2(a.z, a.w); o.z = pk2(b.x, b.y); o.w = pk2(b.z, b.w);
            *(u32x4*)(KEYS + e) = o;
        }
        return;
    }
    c -= CV_KEYS;
    if (c < CV_U) {
        unsigned char* UQ = p.ws + OFF_UB; float* USC = (float*)(p.ws + OFF_USC);
#pragma unroll 2
        for (int i = 0; i < 8; ++i) {
            const int r = c * 64 + wave * 8 + i;
            const float* ur = p.in[18] + (size_t)r * DM + 16 * lane; const float* lw = p.in[15] + 16 * lane;
            f32x4 v[4]; float am = 0.f;
#pragma unroll
            for (int j = 0; j < 4; ++j) { v[j] = ((const f32x4*)ur)[j] * ((const f32x4*)lw)[j]; am = fmaxf(am, fmaxf(fmaxf(fabsf(v[j].x), fabsf(v[j].y)), fmaxf(fabsf(v[j].z), fabsf(v[j].w)))); }
            am = fmaxf(wave_max(am), 1e-30f);
            const float sc = 224.f / am;
            u32x4 o;
#pragma unroll
            for (int j = 0; j < 4; ++j) { int w = __builtin_amdgcn_cvt_pk_fp8_f32(v[j].x * sc, v[j].y * sc, 0, false); w = __builtin_amdgcn_cvt_pk_fp8_f32(v[j].z * sc, v[j].w * sc, w, true); o[j] = (unsigned)w; }
            *(u32x4*)(UQ + (size_t)r * DM + 16 * lane) = o;
            if (lane == 0) USC[r] = am * (1.f / 224.f);
        }
        return;
    }
    c -= CV_U;
    {
        unsigned char* VS = p.ws + OFF_VB; float* VSC = (float*)(p.ws + OFF_VSC);
        const int tile = c;
#pragma unroll 2
        for (int i = 0; i < 8; ++i) {
            const int er = wave * 8 + i, r = tile * 64 + er;
            const float* vr = p.in[19] + (size_t)r * DM + 16 * lane;
            f32x4 v[4]; float am = 0.f;
#pragma unroll
            for (int j = 0; j < 4; ++j) { v[j] = ((const f32x4*)vr)[j]; am = fmaxf(am, fmaxf(fmaxf(fabsf(v[j].x), fabsf(v[j].y)), fmaxf(fabsf(v[j].z), fabsf(v[j].w)))); }
            am = fmaxf(wave_max(am), 1e-30f);
            const float sc = 224.f / am;
            u32x4 o;
#pragma unroll
            for (int j = 0; j < 4; ++j) { int w = __builtin_amdgcn_cvt_pk_fp8_f32(v[j].x * sc, v[j].y * sc, 0, false); w = __builtin_amdgcn_cvt_pk_fp8_f32(v[j].z * sc, v[j].w * sc, w, true); o[j] = (unsigned)w; }
            *(u32x2*)(lds + er * 1032 + 16 * lane) = (u32x2){o.x, o.y}; *(u32x2*)(lds + er * 1032 + 16 * lane + 8) = (u32x2){o.z, o.w};
            if (lane == 0) VSC[r] = am * (1.f / 224.f);
        }
        __syncthreads();
#pragma unroll 4
        for (int i = 0; i < 16; ++i) {
            const int s = wave + 8 * i;
            *(u32x2*)(VS + ((size_t)s * NEXP + tile * 64 + lane) * 8) = *(const u32x2*)(lds + lane * 1032 + s * 8);
        }
    }
}

struct P1Ptrs { unsigned char* ws; const float* bias_f; const float* bias_b; };
__device__ __forceinline__ void p1_store(const P1Ptrs p, int row, int n0, float v0, float v1, float v2, float v3) {
    if (n0 < 1024) {
        const int dp = n0 & 63;
        if (dp < 16) {
            const int pos = row < NTOK ? NMETA + (row & (SEQ - 1)) : (row - NTOK);
            const f32x4 cs = *(const f32x4*)((const float*)(p.ws + OFF_ROPE) + ((size_t)pos * 8 + (dp >> 1)) * 2);
            const float a0 = v0 * cs.x - v1 * cs.y, b0 = v1 * cs.x + v0 * cs.y;
            const float a1 = v2 * cs.z - v3 * cs.w, b1 = v3 * cs.z + v2 * cs.w;
            v0 = a0; v1 = b0; v2 = a1; v3 = b1;
        }
        if (n0 < 512) { u32x2 o; o.x = pk2(v0 * QSCALE, v1 * QSCALE); o.y = pk2(v2 * QSCALE, v3 * QSCALE); *(u32x2*)((bf16_t*)(p.ws + OFF_QB) + (size_t)row * 512 + n0) = o; }
        else { u32x2 o; o.x = pk2(v0, v1); o.y = pk2(v2, v3); *(u32x2*)((bf16_t*)(p.ws + OFF_KB) + (size_t)row * 512 + (n0 - 512)) = o; }
    } else if (n0 < 1536) {
        bf16_t* VT = (bf16_t*)(p.ws + OFF_VT) + (size_t)(n0 - 1024) * MROWS + row;
        VT[0] = (bf16_t)f2bf(v0); VT[MROWS] = (bf16_t)f2bf(v1); VT[2 * MROWS] = (bf16_t)f2bf(v2); VT[3 * (size_t)MROWS] = (bf16_t)f2bf(v3);
    } else if (n0 < 1792) {
        u32x2 o; o.x = pk2(v0 * 0.125f, v1 * 0.125f); o.y = pk2(v2 * 0.125f, v3 * 0.125f); *(u32x2*)((bf16_t*)(p.ws + OFF_GQ) + (size_t)row * 256 + (n0 - 1536)) = o;
    } else if (n0 < 2048) {
        u32x2 o; o.x = pk2(v0, v1); o.y = pk2(v2, v3); *(u32x2*)((bf16_t*)(p.ws + OFF_GK) + (size_t)row * 256 + (n0 - 1792)) = o;
    } else if (n0 < 2560) {
        bf16_t* VT = (bf16_t*)(p.ws + OFF_GVT) + (size_t)(n0 - 2048) * MROWS + row;
        VT[0] = (bf16_t)f2bf(v0); VT[MROWS] = (bf16_t)f2bf(v1); VT[2 * MROWS] = (bf16_t)f2bf(v2); VT[3 * (size_t)MROWS] = (bf16_t)f2bf(v3);
    } else if (n0 < 3072) {
        u32x2 o; o.x = pk2(silu_f(v0), silu_f(v1)); o.y = pk2(silu_f(v2), silu_f(v3)); *(u32x2*)((bf16_t*)(p.ws + OFF_GR) + (size_t)row * 512 + (n0 - 2560)) = o;
    } else {
        const int dir = (n0 - 3072) >> 8, j = (n0 - 3072) & 255;
        const f32x4 bb = *(const f32x4*)((dir ? p.bias_b : p.bias_f) + j);
        f32x4 o; o.x = logsig_f(v0 + bb.x) * 0.0625f; o.y = logsig_f(v1 + bb.y) * 0.0625f; o.z = logsig_f(v2 + bb.z) * 0.0625f; o.w = logsig_f(v3 + bb.w) * 0.0625f;
        *(f32x4*)((float*)(p.ws + (dir ? OFF_GB : OFF_GF)) + (size_t)row * 256 + j) = o;
    }
}


#define LAS __attribute__((address_space(3)))
typedef short bf16x8 __attribute__((ext_vector_type(8)));
constexpr int GBUF = 49152;

template <int ROWS>
__device__ __forceinline__ void stage_tile(const bf16_t* G, int ldk, int r0, int k0, LAS unsigned char* buf, int wave, int lane) {
    const int rr = lane >> 3, c = (lane & 7) ^ rr;
#pragma unroll
    for (int i = 0; i < ROWS / 64; ++i) {
        const int grp = wave + 8 * i;
        const bf16_t* src = G + (size_t)(r0 + grp * 8 + rr) * ldk + k0 + c * 8;
        __builtin_amdgcn_global_load_lds((const unsigned*)src, (LAS unsigned*)(buf + grp * 1024), 16, 0, 0);
    }
}
__device__ __forceinline__ bf16x8 ldfrag(const LAS unsigned char* buf, int row, int c) {
    return *(const LAS bf16x8*)(buf + row * 128 + ((c ^ (row & 7)) << 4));
}
template <bool SWAP>
__device__ __forceinline__ void gemm_tile_256(const bf16_t* A, const bf16_t* Bt, int K, int m0, int n0, LAS unsigned char* lds, f32x4 (&acc)[4][4]) {
    const int tid = threadIdx.x, lane = tid & 63, wave = __builtin_amdgcn_readfirstlane(tid >> 6), wm = wave >> 2, wn = wave & 3, l15 = lane & 15, g = lane >> 4;
#pragma unroll
    for (int i = 0; i < 4; ++i)
#pragma unroll
        for (int j = 0; j < 4; ++j) acc[i][j] = (f32x4){0.f, 0.f, 0.f, 0.f};
    const int nk = K / 64;
    stage_tile<128>(A, K, m0, 0, lds, wave, lane);
    stage_tile<256>(Bt, K, n0, 0, lds + 16384, wave, lane);
    for (int kt = 0; kt < nk; ++kt) {
        asm volatile("s_waitcnt vmcnt(0)" ::: "memory");
        __syncthreads();
        if (kt + 1 < nk) {
            LAS unsigned char* nb = lds + ((kt + 1) & 1) * GBUF;
            stage_tile<128>(A, K, m0, (kt + 1) * 64, nb, wave, lane);
            stage_tile<256>(Bt, K, n0, (kt + 1) * 64, nb + 16384, wave, lane);
        }
        const LAS unsigned char* a = lds + (kt & 1) * GBUF; const LAS unsigned char* b = a + 16384;
#pragma unroll
        for (int ks = 0; ks < 2; ++ks) {
            bf16x8 af[4], bfr[4];
#pragma unroll
            for (int i = 0; i < 4; ++i) { af[i] = ldfrag(a, wm * 64 + i * 16 + l15, ks * 4 + g); bfr[i] = ldfrag(b, wn * 64 + i * 16 + l15, ks * 4 + g); }
#pragma unroll
            for (int i = 0; i < 4; ++i)
#pragma unroll
                for (int j = 0; j < 4; ++j)
                    acc[i][j] = SWAP ? __builtin_amdgcn_mfma_f32_16x16x32_bf16(af[i], bfr[j], acc[i][j], 0, 0, 0)
                                     : __builtin_amdgcn_mfma_f32_16x16x32_bf16(bfr[j], af[i], acc[i][j], 0, 0, 0);
        }
    }
}
__device__ __forceinline__ int vcu_of_block() { const int G = gridDim.x, bx = blockIdx.x; return (G % 8 == 0) ? (bx % 8) * (G / 8) + bx / 8 : bx; }

namespace pg8 {
#define PG8_LAS __attribute__((address_space(3)))
typedef unsigned short bf16_t;
typedef short bf16x8 __attribute__((ext_vector_type(8)));
typedef float f32x4 __attribute__((ext_vector_type(4)));
typedef unsigned u32x4 __attribute__((ext_vector_type(4)));
constexpr int BM = 256, BK = 64, HALF = 128, HTB = HALF * BK * 2  , STAGE_BYTES = 8 * HTB, NXCD = 8, WGM = 8;

__host__ __device__ __forceinline__ int lds_byte(int r, int c) { const int st = (r >> 4) * 2 + (c >> 5), rr = r & 15, cc = c & 31, ob = rr * 64 + cc * 2; return st * 1024 + (ob ^ (((ob >> 9) & 1) << 5)); }
__host__ __device__ __forceinline__ void stage_rc(int b, int& R, int& C) { const int st = b / 1024, sb = b % 1024, swz = sb ^ (((sb >> 9) & 1) << 5); R = (st >> 1) * 16 + swz / 64; C = (st & 1) * 32 + (swz % 64) / 2; }
__host__ __device__ __forceinline__ int perm32(int rho) { const int n = rho >> 4, i = rho & 15; return 8 * (i >> 2) + 4 * n + (i & 3); }

struct Unit { int pm, pn; };
struct Gemm { const bf16_t* A; const bf16_t* Bt; int M, N, K; };

struct StaticOrder {
    int nM, nN, nwg, G, c;
    __host__ __device__ void init(int M, int N, int G_, int c_) { nM = M / BM; nN = N / BM; nwg = nM * nN; G = G_; c = c_; }
    __host__ __device__ bool next(int i, Unit& u) const {
        const long L = (long)i * G + c; if (L >= nwg) return false;
        int wgid = (int)L; { const int q = nwg / NXCD, r = nwg % NXCD, xcd = wgid % NXCD, off = wgid / NXCD; wgid = (xcd < r ? xcd * (q + 1) : r * (q + 1) + (xcd - r) * q) + off; }
        const int nig = WGM * nN, gid = wgid / nig, fm = gid * WGM, gsz = (nM - fm) < WGM ? (nM - fm) : WGM;
        u.pm = fm + ((wgid % nig) % gsz); u.pn = (wgid % nig) / gsz; return true;
    }
    __device__ __forceinline__ void a_ready(const Unit&) const {}
    __device__ __forceinline__ void done(const Unit&) const {}
};

struct EpiP1 {
    static constexpr bool PERM = true, AFTER_DRAIN = false, SWAPPABLE = true;
    P1Ptrs p;
    static __device__ __forceinline__ bool swap_unit(const Unit& u) { return u.pn == 4 || u.pn == 5 || u.pn == 8 || u.pn == 9; }
    __device__ __forceinline__ void operator()(const f32x4 (&acc)[2][2][4][2], const Unit& u, int wr, int wc, int fr, int fq) const {
        if (swap_unit(u)) {
            const int cb = u.pn * BM, nbase = cb < 1536 ? cb - 1024 : cb - 2048;
            bf16_t* T = (bf16_t*)(p.ws + (cb < 1536 ? OFF_VT : OFF_GVT)) + (size_t)(nbase + wc * 32 + 8 * (fr >> 2) + (fr & 3)) * MROWS + u.pm * BM + wr * 64 + 4 * fq;
#pragma unroll
            for (int bj = 0; bj < 2; ++bj)
#pragma unroll
                for (int n = 0; n < 2; ++n)
#pragma unroll
                    for (int ai = 0; ai < 2; ++ai)
#pragma unroll
                        for (int m = 0; m < 4; ++m) { const f32x4 v = acc[ai][bj][m][n];
                            *(u32x2*)(T + (size_t)(bj * HALF + n * 4) * MROWS + ai * HALF + m * 16) = (u32x2){pk2(v.x, v.y), pk2(v.z, v.w)}; }
            return;
        }
#pragma unroll
        for (int bj = 0; bj < 2; ++bj) {
            const int nw = u.pn * BM + bj * HALF + wc * 32;
            const int rowb = u.pm * BM + wr * 64 + fr;
            if (nw >= 3072) {
                const int dir = (nw - 3072) >> 8, j0 = ((nw - 3072) & 255) + 8 * fq;
                float* G = (float*)(p.ws + (dir ? OFF_GB : OFF_GF)); const float* bias = dir ? p.bias_b : p.bias_f;
                const f32x4 b0 = *(const f32x4*)(bias + j0), b1 = *(const f32x4*)(bias + j0 + 4);
#pragma unroll
                for (int ai = 0; ai < 2; ++ai)
#pragma unroll
                    for (int m = 0; m < 4; ++m) { const f32x4 v0 = acc[ai][bj][m][0], v1 = acc[ai][bj][m][1]; f32x4 o0, o1;
                        o0.x = logsig_f(v0.x + b0.x) * 0.0625f; o0.y = logsig_f(v0.y + b0.y) * 0.0625f; o0.z = logsig_f(v0.z + b0.z) * 0.0625f; o0.w = logsig_f(v0.w + b0.w) * 0.0625f;
                        o1.x = logsig_f(v1.x + b1.x) * 0.0625f; o1.y = logsig_f(v1.y + b1.y) * 0.0625f; o1.z = logsig_f(v1.z + b1.z) * 0.0625f; o1.w = logsig_f(v1.w + b1.w) * 0.0625f;
                        float* gp = G + (size_t)(rowb + ai * HALF + m * 16) * 256 + j0; *(f32x4*)gp = o0; *(f32x4*)(gp + 4) = o1; }
            } else {
                bf16_t* base; int ld, c0; float sc = 1.f; bool silu = false;
                if (nw < 512) { base = (bf16_t*)(p.ws + OFF_QB); ld = 512; c0 = nw; sc = QSCALE; }
                else if (nw < 1024) { base = (bf16_t*)(p.ws + OFF_KB); ld = 512; c0 = nw - 512; }
                else if (nw < 1792) { base = (bf16_t*)(p.ws + OFF_GQ); ld = 256; c0 = nw - 1536; sc = 0.125f; }
                else if (nw < 2048) { base = (bf16_t*)(p.ws + OFF_GK); ld = 256; c0 = nw - 1792; }
                else { base = (bf16_t*)(p.ws + OFF_GR); ld = 512; c0 = nw - 2560; silu = true; }
                const bool rope = nw < 1024 && (nw & 63) == 0 && fq < 2;
#pragma unroll
                for (int ai = 0; ai < 2; ++ai)
#pragma unroll
                    for (int m = 0; m < 4; ++m) {
                        const int row = rowb + ai * HALF + m * 16;
                        f32x4 v0 = acc[ai][bj][m][0], v1 = acc[ai][bj][m][1];
                        if (rope) {
                            const int pos = row < NTOK ? NMETA + (row & (SEQ - 1)) : (row - NTOK < TPOS ? row - NTOK : 0);
                            const f32x4* cp = (const f32x4*)((const float*)(p.ws + OFF_ROPE) + ((size_t)pos * 8 + 4 * fq) * 2);
                            const f32x4 ca = cp[0], cb2 = cp[1];
                            v0 = (f32x4){v0.x * ca.x - v0.y * ca.y, v0.y * ca.x + v0.x * ca.y, v0.z * ca.z - v0.w * ca.w, v0.w * ca.z + v0.z * ca.w};
                            v1 = (f32x4){v1.x * cb2.x - v1.y * cb2.y, v1.y * cb2.x + v1.x * cb2.y, v1.z * cb2.z - v1.w * cb2.w, v1.w * cb2.z + v1.z * cb2.w};
                        }
                        if (silu) { v0 = (f32x4){silu_f(v0.x), silu_f(v0.y), silu_f(v0.z), silu_f(v0.w)}; v1 = (f32x4){silu_f(v1.x), silu_f(v1.y), silu_f(v1.z), silu_f(v1.w)}; }
                        else { v0 = v0 * sc; v1 = v1 * sc; }
                        *(u32x4*)(base + (size_t)row * ld + c0 + 8 * fq) = (u32x4){pk2(v0.x, v0.y), pk2(v0.z, v0.w), pk2(v1.x, v1.y), pk2(v1.z, v1.w)};
                    }
            }
        }
    }
};
struct EpiP3 {
    static constexpr bool PERM = true, AFTER_DRAIN = false, SWAPPABLE = false;
    const float* x; float* out; bf16_t* h2b; float* ssq;
    __device__ __forceinline__ void operator()(const f32x4 (&acc)[2][2][4][2], const Unit& u, int wr, int wc, int fr, int fq) const {
#pragma unroll
        for (int ai = 0; ai < 2; ++ai)
#pragma unroll
            for (int m = 0; m < 4; ++m) { const int row = u.pm * BM + ai * HALF + wr * 64 + m * 16 + fr; float ss = 0.f;
#pragma unroll
                for (int bj = 0; bj < 2; ++bj) { const int col = u.pn * BM + bj * HALF + wc * 32 + 8 * fq;
                    const f32x4 h0 = *(const f32x4*)(x + (size_t)row * DM + col) + acc[ai][bj][m][0], h1 = *(const f32x4*)(x + (size_t)row * DM + col + 4) + acc[ai][bj][m][1];
                    *(u32x4*)(h2b + (size_t)row * DM + col) = (u32x4){pk2(h0.x, h0.y), pk2(h0.z, h0.w), pk2(h1.x, h1.y), pk2(h1.z, h1.w)};
                    ss += (h0.x * h0.x + h0.y * h0.y + h0.z * h0.z + h0.w * h0.w) + (h1.x * h1.x + h1.y * h1.y + h1.z * h1.z + h1.w * h1.w); }
                ss += __shfl_xor(ss, 16); ss += __shfl_xor(ss, 32);
                if (fq == 0) ssq[(size_t)row * 16 + u.pn * 4 + wc] = ss; }
    }
};

struct P1Order {
    int G, c, ncol, nM; bool vt;
    __device__ __forceinline__ bool next(int i, Unit& u) const {
        const int nwg = nM * ncol; const int L = i * G + (vt ? (G - 1 - c) : c); if (L >= nwg) return false;
        const int pm = L / ncol, j = L % ncol;
        u.pm = pm; u.pn = vt ? (j < 2 ? 4 + j : 6 + j) : (j < 4 ? j : (j < 6 ? j + 2 : j + 4));
        return true;
    }
    __device__ __forceinline__ void a_ready(const Unit&) const {}
    __device__ __forceinline__ void done(const Unit&) const {}
};
struct OneUnit {
    Unit u; bool valid;
    __device__ __forceinline__ bool next(int i, Unit& o) const { if (i != 0 || !valid) return false; o = u; return true; }
    __device__ __forceinline__ void a_ready(const Unit&) const {}
    __device__ __forceinline__ void done(const Unit&) const {}
};

template <class Epi, class Sched, bool ALIGN_EPI = false, bool SP2 = false, bool SWP = false>
__device__ __forceinline__ void gemm_phase(PG8_LAS unsigned char* lds, const Gemm g, const Sched& S, const Epi& E) {
    int tid_ = threadIdx.x; asm volatile("" : "+v"(tid_));
    const int tid = tid_, wid = __builtin_amdgcn_readfirstlane(tid >> 6), lane = tid & 63, wr = wid >> 2, wc = wid & 3, fr = lane & 15, fq = lane >> 4;
    const int K = g.K, nt = K / BK;
    unsigned voffA[2], voffB[2];
#pragma unroll
    for (int i = 0; i < 2; ++i) { int R, C; stage_rc(tid * 16 + i * 8192, R, C); const int Rb = Epi::PERM ? ((R & ~31) + perm32(R & 31)) : R;
        voffA[i] = (unsigned)(R * K + C) * 2u; voffB[i] = (unsigned)(Rb * K + C) * 2u; }
    const size_t kstep = (size_t)(BK * 2);
    const size_t hstep = (size_t)HALF * K * 2;
    const size_t tstep = 2 * hstep;
    const unsigned ldsw = (unsigned)wid * 1024u;
    const int aoff = lds_byte(wr * 64 + fr, fq * 8), boff = lds_byte(wc * 32 + fr, fq * 8);
#define PG8_SA(b, h) (((b) * 2 + (h)) * HTB)
#define PG8_SB(b, h) ((4 + (b) * 2 + (h)) * HTB)
#define PG8_STAGE(bufoff, gbase, voff) do { _Pragma("unroll") for (int _i = 0; _i < 2; ++_i) \
        __builtin_amdgcn_global_load_lds((const unsigned*)((const char*)(gbase) + (voff)[_i]), (PG8_LAS unsigned*)(lds + (bufoff) + ldsw + _i * 8192), 16, 0, 0); } while (0)
#define PG8_LDA(dst, b, h) do { _Pragma("unroll") for (int m = 0; m < 4; ++m) _Pragma("unroll") for (int k = 0; k < 2; ++k) dst[m][k] = *(const PG8_LAS bf16x8*)(lds + PG8_SA(b, h) + aoff + m * 2048 + k * 1024); } while (0)
#define PG8_LDB(dst, b, h) do { _Pragma("unroll") for (int n = 0; n < 2; ++n) _Pragma("unroll") for (int k = 0; k < 2; ++k) dst[n][k] = *(const PG8_LAS bf16x8*)(lds + PG8_SB(b, h) + boff + n * 2048 + k * 1024); } while (0)
#define PG8_MMA(ai, bj, At, Bt) do { __builtin_amdgcn_s_setprio(1); \
        if (SWP) { _Pragma("unroll") for (int m = 0; m < 4; ++m) _Pragma("unroll") for (int n = 0; n < 2; ++n) _Pragma("unroll") for (int k = 0; k < 2; ++k) \
            acc[ai][bj][m][n] = __builtin_amdgcn_mfma_f32_16x16x32_bf16(At[m][k], Bt[n][k], acc[ai][bj][m][n], 0, 0, 0); } \
        else { _Pragma("unroll") for (int m = 0; m < 4; ++m) _Pragma("unroll") for (int n = 0; n < 2; ++n) _Pragma("unroll") for (int k = 0; k < 2; ++k) \
            acc[ai][bj][m][n] = __builtin_amdgcn_mfma_f32_16x16x32_bf16(Bt[n][k], At[m][k], acc[ai][bj][m][n], 0, 0, 0); } \
        __builtin_amdgcn_s_setprio(0); } while (0)
#define PG8_WAIT_V(n) asm volatile("s_waitcnt vmcnt(" #n ")" ::: "memory")
#define PG8_WAIT_L(n) asm volatile("s_waitcnt lgkmcnt(" #n ")" ::: "memory")
#define PG8_BAR __builtin_amdgcn_s_barrier()
#define PG8_SCHED __builtin_amdgcn_sched_barrier(0)
    Unit cur, nxt; int ui = 0;
    if (!S.next(0, cur)) return;
    f32x4 acc[2][2][4][2];
#pragma unroll
    for (int a = 0; a < 2; ++a)
#pragma unroll
        for (int b = 0; b < 2; ++b)
#pragma unroll
            for (int m = 0; m < 4; ++m)
#pragma unroll
                for (int n = 0; n < 2; ++n) acc[a][b][m][n] = (f32x4){0.f, 0.f, 0.f, 0.f};
    bf16x8 At[4][2], B0[2][2], B1[2][2];
    const char* cA = (const char*)g.A + (size_t)cur.pm * tstep; const char* cB = (const char*)g.Bt + (size_t)cur.pn * tstep;
    S.a_ready(cur);
    if constexpr (SP2) {
        PG8_STAGE(PG8_SB(0, 0), cB, voffB); PG8_STAGE(PG8_SB(0, 1), cB + hstep, voffB); PG8_STAGE(PG8_SA(0, 0), cA, voffA); PG8_STAGE(PG8_SA(0, 1), cA + hstep, voffA);
        if (wr == 1) PG8_BAR;
        PG8_WAIT_V(2); PG8_BAR;
        PG8_STAGE(PG8_SB(1, 0), cB + kstep, voffB); PG8_STAGE(PG8_SA(1, 0), cA + kstep, voffA); PG8_STAGE(PG8_SB(1, 1), cB + hstep + kstep, voffB);
        PG8_WAIT_V(6); PG8_BAR;
    } else {
        PG8_STAGE(PG8_SB(0, 0), cB, voffB); PG8_STAGE(PG8_SA(0, 0), cA, voffA); PG8_STAGE(PG8_SB(0, 1), cB + hstep, voffB); PG8_STAGE(PG8_SA(0, 1), cA + hstep, voffA);
        if (wr == 1) PG8_BAR;
        PG8_WAIT_V(4); PG8_BAR;
        PG8_STAGE(PG8_SB(1, 0), cB + kstep, voffB); PG8_STAGE(PG8_SA(1, 0), cA + kstep, voffA); PG8_STAGE(PG8_SB(1, 1), cB + hstep + kstep, voffB);
        PG8_WAIT_V(6); PG8_BAR;
    }
    for (;;) {
        const bool has_next = S.next(ui + 1, nxt);
        const char* nA = has_next ? (const char*)g.A + (size_t)nxt.pm * tstep : cA; const char* nB = has_next ? (const char*)g.Bt + (size_t)nxt.pn * tstep : cB;
        for (int t = 0; t < nt; t += 2) {
            const bool last = (t == nt - 2);
            const char* a1 = cA + (size_t)(t + 1) * kstep;
            const char* a2 = last ? nA : cA + (size_t)(t + 2) * kstep; const char* b2 = last ? nB : cB + (size_t)(t + 2) * kstep;
            const char* a3 = a2 + kstep; const char* b3 = b2 + kstep;
            if (last && has_next) S.a_ready(nxt);
            if constexpr (SP2) {
            PG8_LDB(B0, 0, 0); PG8_LDB(B1, 0, 1); PG8_SCHED; PG8_LDA(At, 0, 0); PG8_STAGE(PG8_SA(1, 1), a1 + hstep, voffA);
            PG8_WAIT_V(8); PG8_WAIT_L(0); PG8_BAR; PG8_MMA(0, 0, At, B0); PG8_MMA(0, 1, At, B1); PG8_BAR; PG8_SCHED;
            PG8_LDA(At, 0, 1); PG8_STAGE(PG8_SB(0, 0), b2, voffB); PG8_STAGE(PG8_SB(0, 1), b2 + hstep, voffB); PG8_STAGE(PG8_SA(0, 0), a2, voffA);
            PG8_WAIT_V(8); PG8_WAIT_L(0); PG8_BAR; PG8_MMA(1, 0, At, B0); PG8_MMA(1, 1, At, B1); PG8_BAR; PG8_SCHED;
            PG8_LDB(B0, 1, 0); PG8_LDB(B1, 1, 1); PG8_SCHED; PG8_LDA(At, 1, 0); PG8_STAGE(PG8_SA(0, 1), a2 + hstep, voffA);
            PG8_WAIT_V(8); PG8_WAIT_L(0); PG8_BAR; PG8_MMA(0, 0, At, B0); PG8_MMA(0, 1, At, B1); PG8_BAR; PG8_SCHED;
            PG8_LDA(At, 1, 1); PG8_STAGE(PG8_SB(1, 0), b3, voffB); PG8_STAGE(PG8_SB(1, 1), b3 + hstep, voffB); PG8_STAGE(PG8_SA(1, 0), a3, voffA);
            PG8_WAIT_V(8); PG8_WAIT_L(0); PG8_BAR; PG8_MMA(1, 0, At, B0); PG8_MMA(1, 1, At, B1); PG8_BAR; PG8_SCHED;
            } else {
            PG8_LDB(B0, 0, 0); PG8_SCHED; PG8_LDA(At, 0, 0); PG8_STAGE(PG8_SA(1, 1), a1 + hstep, voffA);
            PG8_WAIT_L(8); PG8_BAR; PG8_WAIT_L(0); PG8_MMA(0, 0, At, B0); PG8_BAR; PG8_SCHED;
            PG8_LDB(B1, 0, 1); PG8_STAGE(PG8_SB(0, 0), b2, voffB);
            PG8_BAR; PG8_WAIT_L(0); PG8_MMA(0, 1, At, B1); PG8_BAR;
            PG8_LDA(At, 0, 1); PG8_STAGE(PG8_SA(0, 0), a2, voffA);
            PG8_BAR; PG8_WAIT_L(0); PG8_MMA(1, 0, At, B0); PG8_BAR; PG8_SCHED;
            PG8_STAGE(PG8_SB(0, 1), b2 + hstep, voffB);
            PG8_WAIT_V(6); PG8_BAR; PG8_MMA(1, 1, At, B1); PG8_BAR;
            PG8_LDB(B0, 1, 0); PG8_SCHED; PG8_LDA(At, 1, 0); PG8_STAGE(PG8_SA(0, 1), a2 + hstep, voffA);
            PG8_WAIT_L(8); PG8_BAR; PG8_WAIT_L(0); PG8_MMA(0, 0, At, B0); PG8_BAR; PG8_SCHED;
            PG8_LDB(B1, 1, 1); PG8_STAGE(PG8_SB(1, 0), b3, voffB);
            PG8_BAR; PG8_WAIT_L(0); PG8_MMA(0, 1, At, B1); PG8_BAR;
            PG8_LDA(At, 1, 1); PG8_STAGE(PG8_SA(1, 0), a3, voffA);
            PG8_BAR; PG8_WAIT_L(0); PG8_MMA(1, 0, At, B0); PG8_BAR; PG8_SCHED;
            PG8_STAGE(PG8_SB(1, 1), b3 + hstep, voffB);
            PG8_WAIT_V(6); PG8_BAR; PG8_MMA(1, 1, At, B1); PG8_BAR;
            }
        }
        if constexpr (ALIGN_EPI) { if (wr == 0) PG8_BAR; }
        if constexpr (!Epi::AFTER_DRAIN) { E(acc, cur, wr, wc, fr, fq); S.done(cur); }
        if (!has_next) break;
#pragma unroll
        for (int a = 0; a < 2; ++a)
#pragma unroll
            for (int b = 0; b < 2; ++b)
#pragma unroll
                for (int m = 0; m < 4; ++m)
#pragma unroll
                    for (int n = 0; n < 2; ++n) acc[a][b][m][n] = (f32x4){0.f, 0.f, 0.f, 0.f};
        cur = nxt; cA = nA; cB = nB; ++ui;
        if constexpr (ALIGN_EPI) { if (wr == 1) PG8_BAR; }
    }
    PG8_WAIT_V(0);
    if constexpr (!ALIGN_EPI) { if (wr == 0) PG8_BAR; }
    PG8_BAR;
    if constexpr (Epi::AFTER_DRAIN) { E.fused(acc, cur, wr, wc, fr, fq, lds, wid, lane); S.done(cur); }
#undef PG8_SA
#undef PG8_SB
#undef PG8_STAGE
#undef PG8_LDA
#undef PG8_LDB
#undef PG8_MMA
#undef PG8_WAIT_V
#undef PG8_WAIT_L
#undef PG8_BAR
#undef PG8_SCHED
}
}
__device__ __forceinline__ float row_rstd(const float* ssq, int row) {
    const f32x4* q = (const f32x4*)(ssq + (size_t)row * 16);
    const f32x4 a = q[0], b = q[1], c = q[2], d = q[3];
    return rsqrtf(((((a.x + a.y) + (a.z + a.w)) + ((b.x + b.y) + (b.z + b.w))) + (((c.x + c.y) + (c.z + c.w)) + ((d.x + d.y) + (d.z + d.w)))) * (1.f / DM) + EPS);
}
__device__ __forceinline__ void phase1_mfma(const Params& p, LAS unsigned char* lds) {
    pg8::Gemm g{(const pg8::bf16_t*)(p.ws + OFF_XN), (const pg8::bf16_t*)(p.ws + OFF_WIN), MROWS, NIN, DM};
    pg8::EpiP1 E{P1Ptrs{p.ws, p.in[10], p.in[12]}};
    const int vcu = vcu_of_block();
    pg8::P1Order S0{(int)gridDim.x, vcu, 10, MROWS / 256, false}, S1{(int)gridDim.x, vcu, 4, MROWS / 256, true};
    pg8::gemm_phase<pg8::EpiP1, pg8::P1Order, true, true, false>(lds, g, S0, E);
    pg8::gemm_phase<pg8::EpiP1, pg8::P1Order, true, true, true>(lds, g, S1, E);
    const int G = (int)gridDim.x, nun = MROWS / 256;
    const int mine = (10 * nun - vcu + G - 1) / G + (4 * nun - (G - 1 - vcu) + G - 1) / G, most = (10 * nun + G - 1) / G + 1;
    if (mine < most) {
        unsigned* ctr = (unsigned*)(p.ws + OFF_CTL) + 128;
        for (int k = 0; k < 3; ++k) {
            __syncthreads();
            if (threadIdx.x == 0) *(LAS unsigned*)(lds + LDS_Q) = atomicAdd(ctr, 1u);
            __syncthreads();
            const int c = (int)*(LAS unsigned*)(lds + LDS_Q);
            if (c >= CV_ITEMS) break;
            conv_item(p, (unsigned char*)lds, c);
        }
    }
}
__device__ __forceinline__ void phase3_mfma(const Params& p, LAS unsigned char* lds) {
    pg8::Gemm g{(const pg8::bf16_t*)(p.ws + OFF_MIX), (const pg8::bf16_t*)(p.ws + OFF_WOUT), NTOK, DM, DM};
    pg8::StaticOrder S; S.init(NTOK, DM, (int)gridDim.x, (int)blockIdx.x);
    pg8::EpiP3 E{p.in[0], p.out, (bf16_t*)(p.ws + OFF_H2B), (float*)(p.ws + OFF_SSQP)};
    pg8::gemm_phase<pg8::EpiP3, pg8::StaticOrder, true, true>(lds, g, S, E);
}

typedef float f32x16 __attribute__((ext_vector_type(16)));
constexpr int AT_KROW = 272, AT_VROW = 144, AT_KBYTES = 64 * AT_KROW, AT_VBYTES = 128 * AT_VROW, AT_STAGE = AT_KBYTES + AT_VBYTES;
__device__ __forceinline__ void attn_item(const Params& p, LAS unsigned char* lds, int item) {
    const int tid = threadIdx.x, lane = tid & 63, wave = __builtin_amdgcn_readfirstlane(tid >> 6), qg = wave >> 1, c = wave & 1, l31 = lane & 31, hh = lane >> 5;
    const int qt = item & 15, h = (item >> 4) & 3, b = item >> 6;
    const int r0 = b * SEQ + qt * 128;
    const bf16_t* QB = (const bf16_t*)(p.ws + OFF_QB); const bf16_t* KB = (const bf16_t*)(p.ws + OFF_KB); const bf16_t* VT = (const bf16_t*)(p.ws + OFF_VT);
    bf16x8 qf[4];
    {
        const bf16_t* qp = QB + (size_t)(r0 + qg * 32 + l31) * 512 + h * 128 + c * 64 + 8 * hh;
#pragma unroll
        for (int s = 0; s < 4; ++s) qf[s] = *(const bf16x8*)(qp + 16 * s);
    }
    f32x16 O[4];
#pragma unroll
    for (int i = 0; i < 4; ++i)
#pragma unroll
        for (int r = 0; r < 16; ++r) O[i][r] = 0.f;
    float m = 0.f, l = 0.f;
    const int kq0 = tid, kq1 = tid + 512;
    const bf16_t* kg0 = KB + (size_t)(kq0 >> 4) * 512 + h * 128 + (kq0 & 15) * 8; const bf16_t* kg1 = KB + (size_t)(kq1 >> 4) * 512 + h * 128 + (kq1 & 15) * 8;
    const bf16_t* vg0 = VT + (size_t)(h * 128 + (kq0 >> 3)) * MROWS + (kq0 & 7) * 8; const bf16_t* vg1 = VT + (size_t)(h * 128 + (kq1 >> 3)) * MROWS + (kq1 & 7) * 8;
    const int kl0 = (kq0 >> 4) * AT_KROW + (kq0 & 15) * 16, kl1 = (kq1 >> 4) * AT_KROW + (kq1 & 15) * 16;
    const int vl0 = AT_KBYTES + (kq0 >> 3) * AT_VROW + ((kq0 & 7) >> 1) * 32 + (kq0 & 1) * 8, vl1 = AT_KBYTES + (kq1 >> 3) * AT_VROW + ((kq1 & 7) >> 1) * 32 + (kq1 & 1) * 8;
    u32x4 kr0, kr1, vr0, vr1;
#define AT_LOAD(t) do { const size_t kro = (size_t)((t) < 32 ? b * SEQ + (t) * 64 : NTOK); \
        kr0 = *(const u32x4*)(kg0 + kro * 512); kr1 = *(const u32x4*)(kg1 + kro * 512); vr0 = *(const u32x4*)(vg0 + kro); vr1 = *(const u32x4*)(vg1 + kro); } while (0)
#define AT_WRITE(buf) do { LAS unsigned char* _b = lds + (buf) * AT_STAGE; \
        *(LAS u32x4*)(_b + kl0) = kr0; *(LAS u32x4*)(_b + kl1) = kr1; \
        *(LAS u32x2*)(_b + vl0) = (u32x2){vr0.x, vr0.y}; *(LAS u32x2*)(_b + vl0 + 16) = (u32x2){vr0.z, vr0.w}; \
        *(LAS u32x2*)(_b + vl1) = (u32x2){vr1.x, vr1.y}; *(LAS u32x2*)(_b + vl1 + 16) = (u32x2){vr1.z, vr1.w}; } while (0)
    __syncthreads();
    AT_LOAD(0); AT_WRITE(0); AT_LOAD(1); AT_WRITE(1);
    __syncthreads();
    int scur = 0;
    for (int t = 0; t < 33; ++t) {
        const int snxt2 = scur == 0 ? 2 : scur - 1;
        if (t + 2 < 33) AT_LOAD(t + 2);
        const LAS unsigned char* kb_ = lds + scur * AT_STAGE; const LAS unsigned char* vb_ = kb_ + AT_KBYTES;
        f32x16 s0, s1;
#pragma unroll
        for (int r = 0; r < 16; ++r) { s0[r] = -m; s1[r] = -m; }
#pragma unroll
        for (int s = 0; s < 4; ++s) {
            const bf16x8 k0 = *(const LAS bf16x8*)(kb_ + l31 * AT_KROW + (c * 64 + 16 * s + 8 * hh) * 2);
            s0 = __builtin_amdgcn_mfma_f32_32x32x16_bf16(k0, qf[s], s0, 0, 0, 0);
        }
#pragma unroll
        for (int s = 0; s < 4; ++s) {
            const bf16x8 k1 = *(const LAS bf16x8*)(kb_ + (32 + l31) * AT_KROW + (c * 64 + 16 * s + 8 * hh) * 2);
            s1 = __builtin_amdgcn_mfma_f32_32x32x16_bf16(k1, qf[s], s1, 0, 0, 0);
        }
        if (t == 32) {
#pragma unroll
            for (int r = 0; r < 16; ++r) { const int key = (r & 3) + 8 * (r >> 2) + 4 * hh; if (key >= 16) s0[r] = -1e30f; s1[r] = -1e30f; }
        }
        float mx = s0[0];
#pragma unroll
        for (int r = 1; r < 16; ++r) mx = fmaxf(mx, s0[r]);
#pragma unroll
        for (int r = 0; r < 16; ++r) mx = fmaxf(mx, s1[r]);
        { const u32x2 sw_ = __builtin_amdgcn_permlane32_swap(__float_as_uint(mx), __float_as_uint(mx), false, false); mx = fmaxf(__uint_as_float(sw_.x), __uint_as_float(sw_.y)); }
        if (t == 0 || __any(mx > 8.0f)) {
            const float d = t == 0 ? mx : fmaxf(mx, 0.f), alpha = __builtin_amdgcn_exp2f(-d);
            m += d; l *= alpha;
#pragma unroll
            for (int i = 0; i < 4; ++i) O[i] = O[i] * alpha;
#pragma unroll
            for (int r = 0; r < 16; ++r) { s0[r] -= d; s1[r] -= d; }
        }
        float ps = 0.f;
#define AT_PV(SREG, kb) do { \
        _Pragma("unroll") for (int r = 0; r < 16; ++r) { SREG[r] = __builtin_amdgcn_exp2f(SREG[r]); ps += SREG[r]; } \
        bf16x8 pf0, pf1; \
        { u32x4 a; a.x = pk2(SREG[0], SREG[1]); a.y = pk2(SREG[2], SREG[3]); a.z = pk2(SREG[4], SREG[5]); a.w = pk2(SREG[6], SREG[7]); pf0 = __builtin_bit_cast(bf16x8, a); \
          u32x4 bq; bq.x = pk2(SREG[8], SREG[9]); bq.y = pk2(SREG[10], SREG[11]); bq.z = pk2(SREG[12], SREG[13]); bq.w = pk2(SREG[14], SREG[15]); pf1 = __builtin_bit_cast(bf16x8, bq); } \
        _Pragma("unroll") for (int vb = 0; vb < 4; ++vb) { \
            const LAS unsigned char* vp = vb_ + (vb * 32 + l31) * AT_VROW + (kb) * 64 + hh * 16; \
            O[vb] = __builtin_amdgcn_mfma_f32_32x32x16_bf16(*(const LAS bf16x8*)vp, pf0, O[vb], 0, 0, 0); \
            O[vb] = __builtin_amdgcn_mfma_f32_32x32x16_bf16(*(const LAS bf16x8*)(vp + 32), pf1, O[vb], 0, 0, 0); } } while (0)
        AT_PV(s0, 0);
        AT_PV(s1, 1);
#undef AT_PV
        l += ps;
        if (t + 2 < 33) AT_WRITE(snxt2);
        __syncthreads();
        scur = scur == 2 ? 0 : scur + 1;
    }
    const float inv = 1.f / (l + __shfl_xor(l, 32));
    LAS float* X = (LAS float*)lds + qg * 4096;
    if (c == 1) {
#pragma unroll
        for (int vb = 0; vb < 4; ++vb)
#pragma unroll
            for (int r = 0; r < 16; ++r) X[(vb * 16 + r) * 64 + lane] = O[vb][r] * inv;
    }
    __syncthreads();
    if (c == 0) {
        const float lam = ((const float*)(p.ws + OFF_MISC))[0];
        float ss = 0.f;
#pragma unroll
        for (int vb = 0; vb < 4; ++vb)
#pragma unroll
            for (int r = 0; r < 16; ++r) { const float y = O[vb][r] * inv - lam * X[(vb * 16 + r) * 64 + lane]; O[vb][r] = y; ss += y * y; }
        ss += __shfl_xor(ss, 32);
        const float rs = rsqrtf(ss * (1.f / 128.f) + EPS) * 0.8f;
        bf16_t* orow = (bf16_t*)(p.ws + OFF_MIX) + (size_t)(r0 + qg * 32 + l31) * DM + h * 128;
#pragma unroll
        for (int vb = 0; vb < 4; ++vb)
#pragma unroll
            for (int rq = 0; rq < 4; ++rq) {
                const int v0 = vb * 32 + 8 * rq + 4 * hh;
                const f32x4 wlo = *(const f32x4*)(p.in[8] + vb * 32 + 8 * rq), whi = *(const f32x4*)(p.in[8] + vb * 32 + 8 * rq + 4);
                const f32x4 w = hh ? whi : wlo;
                u32x2 o; o.x = pk2(O[vb][4 * rq] * rs * w.x, O[vb][4 * rq + 1] * rs * w.y); o.y = pk2(O[vb][4 * rq + 2] * rs * w.z, O[vb][4 * rq + 3] * rs * w.w);
                *(u32x2*)(orow + v0) = o;
            }
    }
#undef AT_LOAD
#undef AT_WRITE
}
__device__ __forceinline__ void phase2_attn_mfma(const Params& p, LAS unsigned char* lds) {
    for (int it = vcu_of_block(); it < NB * 4 * 16; it += gridDim.x) attn_item(p, lds, it);
}


__device__ __forceinline__ int gsw(int row, int chunk) { return row * 128 + ((chunk ^ (row & 7)) << 4); }
constexpr int GL_SET = 40960;
constexpr int GL_QS = 0, GL_KS = 8192, GL_KT = 16384, GL_VT = 24576, GL_AT = 2 * GL_SET, GL_ST = GL_AT + 8192  , GL_DV = GL_ST + 32768  ;
__device__ __forceinline__ float dpp_scan64(float v) {
    v += __builtin_bit_cast(float, __builtin_amdgcn_update_dpp(0, __builtin_bit_cast(int, v), 0x111, 0xf, 0xf, false));
    v += __builtin_bit_cast(float, __builtin_amdgcn_update_dpp(0, __builtin_bit_cast(int, v), 0x112, 0xf, 0xf, false));
    v += __builtin_bit_cast(float, __builtin_amdgcn_update_dpp(0, __builtin_bit_cast(int, v), 0x114, 0xf, 0xf, false));
    v += __builtin_bit_cast(float, __builtin_amdgcn_update_dpp(0, __builtin_bit_cast(int, v), 0x118, 0xf, 0xf, false));
    v += __builtin_bit_cast(float, __builtin_amdgcn_update_dpp(0, __builtin_bit_cast(int, v), 0x142, 0xa, 0xf, false));
    v += __builtin_bit_cast(float, __builtin_amdgcn_update_dpp(0, __builtin_bit_cast(int, v), 0x143, 0xc, 0xf, false));
    return v;
}
#define DPP_STAGE8(CTRL, RM) _Pragma("unroll") for (int e = 0; e < 8; ++e) v[e] += __builtin_bit_cast(float, __builtin_amdgcn_update_dpp(0, __builtin_bit_cast(int, v[e]), CTRL, RM, 0xf, false))
__device__ __forceinline__ void dpp_scan64x8(float (&v)[8]) {
    DPP_STAGE8(0x111, 0xf); DPP_STAGE8(0x112, 0xf); DPP_STAGE8(0x114, 0xf); DPP_STAGE8(0x118, 0xf); DPP_STAGE8(0x142, 0xa); DPP_STAGE8(0x143, 0xc);
}
#undef DPP_STAGE8
struct GlaPre { f32x4 g0, g1; u32x4 q8, k8, v0, v1; };
struct GlaCtx { const bf16_t* GQ; const bf16_t* GK; const bf16_t* GVT; const float* G; bf16_t* O; int dir, h, b, nsteps, lane, wave, l15, g, vdv, vch; };
__device__ __forceinline__ int gla_rowbase(const GlaCtx& c, int st) { return c.dir ? c.b * SEQ + (31 - st) * 64 : (st == 0 ? NTOK : c.b * SEQ + (st - 1) * 64); }
__device__ __forceinline__ void gla_load(const GlaCtx& c, GlaPre& r, int st) {
    const int rb = gla_rowbase(c, st); const size_t row = (size_t)(rb + c.lane);
    r.g0 = *(const f32x4*)(c.G + row * 256 + c.h * 64 + 8 * c.wave); r.g1 = *(const f32x4*)(c.G + row * 256 + c.h * 64 + 8 * c.wave + 4);
    r.q8 = *(const u32x4*)(c.GQ + row * 256 + c.h * 64 + 8 * c.wave); r.k8 = *(const u32x4*)(c.GK + row * 256 + c.h * 64 + 8 * c.wave);
    r.v0 = *(const u32x4*)(c.GVT + (size_t)(c.h * 128 + c.vdv) * MROWS + rb + c.vch * 8); r.v1 = *(const u32x4*)(c.GVT + (size_t)(c.h * 128 + c.vdv) * MROWS + rb + c.vch * 8 + 8);
}
__device__ __forceinline__ void gla_step(const GlaCtx& c, LAS unsigned char* lds, GlaPre& r, f32x4 (&accS)[4], int st) {
    const int lane = c.lane, wave = c.wave, l15 = c.l15, g = c.g, dir = c.dir;
    const bool meta = (dir == 0 && st == 0);
    const int rowbase = gla_rowbase(c, st);
    LAS unsigned char* sb = lds + (st & 1) * GL_SET;
    float gg[8] = {r.g0.x, r.g0.y, r.g0.z, r.g0.w, r.g1.x, r.g1.y, r.g1.z, r.g1.w};
    if (meta && lane >= NMETA) {
#pragma unroll
        for (int e = 0; e < 8; ++e) gg[e] = 0.f;
    }
    const u32x4 q8 = r.q8, k8 = r.k8;
    float qv[8] = {bflo(q8.x), bfhi(q8.x), bflo(q8.y), bfhi(q8.y), bflo(q8.z), bfhi(q8.z), bflo(q8.w), bfhi(q8.w)};
    float kv[8] = {bflo(k8.x), bfhi(k8.x), bflo(k8.y), bfhi(k8.y), bflo(k8.z), bfhi(k8.z), bflo(k8.w), bfhi(k8.w)};
    float qn[8], kn[8], ks[8], eTv[8], Pv[8];
#pragma unroll
    for (int e = 0; e < 8; ++e) Pv[e] = gg[e];
    dpp_scan64x8(Pv);
#pragma unroll
    for (int e = 0; e < 8; ++e) {
        const float P = Pv[e];
        const float T = __builtin_bit_cast(float, __builtin_amdgcn_readlane(__builtin_bit_cast(int, P), 63));
        const float Bv = dir ? (T - P + gg[e]) : P;
        const float eb = __expf(Bv), en = __builtin_amdgcn_rcpf(eb), eT = __expf(T);
        qn[e] = qv[e] * eb; kn[e] = kv[e] * en; ks[e] = kn[e] * eT; eTv[e] = eT;
    }
    if (lane == 0) {
        *(LAS f32x4*)(lds + GL_DV + (st & 1) * 256 + 8 * wave * 4) = (f32x4){eTv[0], eTv[1], eTv[2], eTv[3]};
        *(LAS f32x4*)(lds + GL_DV + (st & 1) * 256 + 8 * wave * 4 + 16) = (f32x4){eTv[4], eTv[5], eTv[6], eTv[7]};
    }
    *(LAS u32x4*)(sb + GL_QS + gsw(lane, wave)) = (u32x4){pk2(qn[0], qn[1]), pk2(qn[2], qn[3]), pk2(qn[4], qn[5]), pk2(qn[6], qn[7])};
    *(LAS u32x4*)(sb + GL_KS + gsw(lane, wave)) = (u32x4){pk2(kn[0], kn[1]), pk2(kn[2], kn[3]), pk2(kn[4], kn[5]), pk2(kn[6], kn[7])};
#pragma unroll
    for (int e = 0; e < 8; e += 2) { const unsigned w = pk2(ks[e], ks[e + 1]);
        *(LAS unsigned short*)(sb + GL_KT + gsw(8 * wave + e, lane >> 3) + (lane & 7) * 2) = (unsigned short)w;
        *(LAS unsigned short*)(sb + GL_KT + gsw(8 * wave + e + 1, lane >> 3) + (lane & 7) * 2) = (unsigned short)(w >> 16); }
    *(LAS u32x4*)(sb + GL_VT + gsw(c.vdv, c.vch)) = r.v0; *(LAS u32x4*)(sb + GL_VT + gsw(c.vdv, c.vch + 1)) = r.v1;
    if (st + 2 < c.nsteps) gla_load(c, r, st + 2);
    __syncthreads();
    const LAS unsigned char* STo = lds + GL_ST + (st & 1) * 16384; LAS unsigned char* STn = lds + GL_ST + ((st + 1) & 1) * 16384;
    if (!meta) {
        const int jb = wave >> 1;
#pragma unroll
        for (int ii = 0; ii < 2; ++ii) {
            const int ib = 2 * (wave & 1) + ii;
            f32x4 a = (f32x4){0.f, 0.f, 0.f, 0.f};
            const bool live = dir ? (jb >= ib) : (jb <= ib);
            if (live) {
#pragma unroll
                for (int ks2 = 0; ks2 < 2; ++ks2) {
                    const bf16x8 kf = *(const LAS bf16x8*)(sb + GL_KS + gsw(jb * 16 + l15, ks2 * 4 + g));
                    const bf16x8 qf = *(const LAS bf16x8*)(sb + GL_QS + gsw(ib * 16 + l15, ks2 * 4 + g));
                    a = __builtin_amdgcn_mfma_f32_16x16x32_bf16(kf, qf, a, 0, 0, 0);
                }
                const int i = ib * 16 + l15, j0 = jb * 16 + 4 * g;
#pragma unroll
                for (int rr = 0; rr < 4; ++rr) { const bool keep = dir ? (j0 + rr >= i) : (j0 + rr <= i); a[rr] = keep ? a[rr] : 0.f; }
            }
            const int i = ib * 16 + l15, j0 = jb * 16 + 4 * g;
            *(LAS u32x2*)(lds + GL_AT + gsw(i, j0 >> 3) + (j0 & 7) * 2) = (u32x2){pk2(a[0], a[1]), pk2(a[2], a[3])};
        }
    }
    if (st + 1 < c.nsteps) {
#pragma unroll
        for (int kb = 0; kb < 4; ++kb) {
            const f32x4 dvv = *(const LAS f32x4*)(lds + GL_DV + (st & 1) * 256 + (kb * 16 + 4 * g) * 4);
            f32x4 a = accS[kb] * dvv;
#pragma unroll
            for (int ks2 = 0; ks2 < 2; ++ks2) {
                const bf16x8 kf = *(const LAS bf16x8*)(sb + GL_KT + gsw(kb * 16 + l15, ks2 * 4 + g));
                const bf16x8 vf = *(const LAS bf16x8*)(sb + GL_VT + gsw(wave * 16 + l15, ks2 * 4 + g));
                a = __builtin_amdgcn_mfma_f32_16x16x32_bf16(kf, vf, a, 0, 0, 0);
            }
            accS[kb] = a;
            const int dk0 = kb * 16 + 4 * g;
            *(LAS u32x2*)(STn + gsw(wave * 16 + l15, dk0 >> 3) + (dk0 & 7) * 2) = (u32x2){pk2(a[0], a[1]), pk2(a[2], a[3])};
        }
    }
    __syncthreads();
    if (!meta) {
#pragma unroll
        for (int ib = 0; ib < 4; ++ib) {
            f32x4 a = (f32x4){0.f, 0.f, 0.f, 0.f};
#pragma unroll
            for (int ks2 = 0; ks2 < 2; ++ks2) {
                const bf16x8 vf = *(const LAS bf16x8*)(sb + GL_VT + gsw(wave * 16 + l15, ks2 * 4 + g));
                const bf16x8 af = *(const LAS bf16x8*)(lds + GL_AT + gsw(ib * 16 + l15, ks2 * 4 + g));
                a = __builtin_amdgcn_mfma_f32_16x16x32_bf16(vf, af, a, 0, 0, 0);
                const bf16x8 sf = *(const LAS bf16x8*)(STo + gsw(wave * 16 + l15, ks2 * 4 + g));
                const bf16x8 qf = *(const LAS bf16x8*)(sb + GL_QS + gsw(ib * 16 + l15, ks2 * 4 + g));
                a = __builtin_amdgcn_mfma_f32_16x16x32_bf16(sf, qf, a, 0, 0, 0);
            }
            *(u32x2*)(c.O + (size_t)(rowbase + ib * 16 + l15) * 512 + c.h * 128 + wave * 16 + 4 * g) = (u32x2){pk2(a[0], a[1]), pk2(a[2], a[3])};
        }
    }
}
__device__ __forceinline__ void gla_chain(const Params& p, LAS unsigned char* lds, int item) {
    const int tid = threadIdx.x;
    GlaCtx c;
    c.lane = tid & 63; c.wave = __builtin_amdgcn_readfirstlane(tid >> 6); c.l15 = c.lane & 15; c.g = c.lane >> 4;
    c.dir = item & 1; c.h = (item >> 1) & 3; c.b = item >> 3;
    c.GQ = (const bf16_t*)(p.ws + OFF_GQ); c.GK = (const bf16_t*)(p.ws + OFF_GK); c.GVT = (const bf16_t*)(p.ws + OFF_GVT);
    c.G = (const float*)(p.ws + (c.dir ? OFF_GB : OFF_GF));
    c.O = (bf16_t*)p.out + (c.dir ? (size_t)NTOK * 512 : 0);
    c.nsteps = c.dir ? 32 : 33; c.vdv = tid >> 2; c.vch = (tid & 3) * 2;
    f32x4 accS[4];
#pragma unroll
    for (int i = 0; i < 4; ++i) accS[i] = (f32x4){0.f, 0.f, 0.f, 0.f};
    __syncthreads();
    *(LAS u32x4*)(lds + GL_ST + tid * 32) = (u32x4){0u, 0u, 0u, 0u}; *(LAS u32x4*)(lds + GL_ST + tid * 32 + 16) = (u32x4){0u, 0u, 0u, 0u};
    GlaPre X, Y;
    gla_load(c, X, 0); gla_load(c, Y, 1);
    for (int st = 0; st < c.nsteps; st += 2) {
        gla_step(c, lds, X, accS, st);
        if (st + 1 < c.nsteps) gla_step(c, lds, Y, accS, st + 1);
    }
    asm volatile("s_waitcnt vmcnt(0)" ::: "memory");
    __syncthreads();
    if (tid == 0) {
        __builtin_amdgcn_fence(__ATOMIC_RELEASE, "agent");
        asm volatile("s_waitcnt vmcnt(0)" ::: "memory");
        __hip_atomic_fetch_add((unsigned*)(p.ws + OFF_CTL) + 4096 + (item >> 1) * 64, 1u, __ATOMIC_RELAXED, __HIP_MEMORY_SCOPE_AGENT);
    }
}
__device__ __forceinline__ void gla_combine_item(const Params& p, LAS unsigned char* lds, int item) {
    const int tid = threadIdx.x, lane = tid & 63, wave = tid >> 6;
    const int bh = item >> 3, part = item & 7, b = bh >> 2, h = bh & 3;
    if (tid == 0) {
        unsigned* flag = (unsigned*)(p.ws + OFF_CTL) + 4096 + bh * 64;
        unsigned spins = 0;
        while (__hip_atomic_load(flag, __ATOMIC_RELAXED, __HIP_MEMORY_SCOPE_AGENT) < 2u) { __builtin_amdgcn_s_sleep(8); if (++spins > (1u << 22)) break; }
        __builtin_amdgcn_fence(__ATOMIC_ACQUIRE, "agent");
        asm volatile("s_waitcnt vmcnt(0)" ::: "memory");
    }
    __syncthreads();
    const bf16_t* GR = (const bf16_t*)(p.ws + OFF_GR); bf16_t* MIX = (bf16_t*)(p.ws + OFF_MIX);
    const bf16_t* OF = (const bf16_t*)p.out; const bf16_t* OBk = OF + (size_t)NTOK * 512;
    const int c0 = h * 128 + (lane & 15) * 8;
    const f32x4 w0 = *(const f32x4*)(p.in[13] + (lane & 15) * 8), w1 = *(const f32x4*)(p.in[13] + (lane & 15) * 8 + 4);
#pragma unroll 2
    for (int i = 0; i < 8; ++i) {
        const int r = b * SEQ + part * 256 + wave * 32 + i * 4 + (lane >> 4);
        const u32x4 a = *(const u32x4*)(OF + (size_t)r * 512 + c0), bq = *(const u32x4*)(OBk + (size_t)r * 512 + c0);
        const f32x4 x0 = (f32x4){bflo(a.x) + bflo(bq.x), bfhi(a.x) + bfhi(bq.x), bflo(a.y) + bflo(bq.y), bfhi(a.y) + bfhi(bq.y)};
        const f32x4 x1 = (f32x4){bflo(a.z) + bflo(bq.z), bfhi(a.z) + bfhi(bq.z), bflo(a.w) + bflo(bq.w), bfhi(a.w) + bfhi(bq.w)};
        float s = x0.x * x0.x + x0.y * x0.y + x0.z * x0.z + x0.w * x0.w + x1.x * x1.x + x1.y * x1.y + x1.z * x1.z + x1.w * x1.w;
        s += __shfl_xor(s, 1); s += __shfl_xor(s, 2); s += __shfl_xor(s, 4); s += __shfl_xor(s, 8);
        const float rs = rsqrtf(s * (1.f / 128.f) + EPS);
        const u32x4 g = *(const u32x4*)(GR + (size_t)r * 512 + c0);
        u32x4 o;
        o.x = pk2(x0.x * rs * w0.x * bflo(g.x), x0.y * rs * w0.y * bfhi(g.x)); o.y = pk2(x0.z * rs * w0.z * bflo(g.y), x0.w * rs * w0.w * bfhi(g.y));
        o.z = pk2(x1.x * rs * w1.x * bflo(g.z), x1.y * rs * w1.y * bfhi(g.z)); o.w = pk2(x1.z * rs * w1.z * bflo(g.w), x1.w * rs * w1.w * bfhi(g.w));
        *(u32x4*)(MIX + (size_t)r * DM + 512 + c0) = o;
    }
}

__device__ __forceinline__ void phase2(const Params& p, LAS unsigned char* lds, int qslot = 0) {
    unsigned* ctr = (unsigned*)(p.ws + OFF_CTL) + (qslot >= 2 ? 2048 + qslot * 64 : qslot * 64);
    int it;
#define P2_NEXT() do { __syncthreads(); if (threadIdx.x == 0) *(LAS unsigned*)(lds + LDS_Q) = atomicAdd(ctr, 1u); __syncthreads(); it = (int)*(LAS unsigned*)(lds + LDS_Q); } while (0)
    P2_NEXT();
    if (qslot != 3) { while (it < 64) { gla_chain(p, lds, it); P2_NEXT(); } }
    if (qslot == 2) return;
    if (qslot == 3) it += 64;
    while (it < 64 + NB * 4 * 16) { attn_item(p, lds, it - 64); P2_NEXT(); if (qslot == 3) it += 64; }
    if (qslot) return;
    for (;;) {
        __syncthreads();
        if (threadIdx.x == 0) *(LAS unsigned*)(lds + LDS_Q) = atomicAdd(ctr + 192, 1u);
        __syncthreads();
        const int c = (int)*(LAS unsigned*)(lds + LDS_Q);
        if (c >= 256) break;
        gla_combine_item(p, lds, c);
    }
    for (;;) {
        __syncthreads();
        if (threadIdx.x == 0) *(LAS unsigned*)(lds + LDS_Q) = atomicAdd(ctr + 128, 1u);
        __syncthreads();
        const int c = (int)*(LAS unsigned*)(lds + LDS_Q);
        if (c >= CV_ITEMS) break;
        conv_item(p, (unsigned char*)lds, c);
    }
#undef P2_NEXT
}

__device__ __forceinline__ void phase2c(const Params& p) {
    const int tid = threadIdx.x, lane = tid & 63, wave = tid >> 6;
    const int gw = blockIdx.x * 8 + wave, NGW = gridDim.x * 8;
    const bf16_t* GR = (const bf16_t*)(p.ws + OFF_GR); bf16_t* MIX = (bf16_t*)(p.ws + OFF_MIX);
    const bf16_t* OF = (const bf16_t*)p.out; const bf16_t* OBk = OF + (size_t)NTOK * 512;
    const int c0 = lane * 8;
    const f32x4 w0 = *(const f32x4*)(p.in[13] + (c0 & 127)), w1 = *(const f32x4*)(p.in[13] + (c0 & 127) + 4);
    for (int r = gw; r < NTOK; r += NGW) {
        const u32x4 a = *(const u32x4*)(OF + (size_t)r * 512 + c0), bq = *(const u32x4*)(OBk + (size_t)r * 512 + c0);
        const f32x4 x0 = (f32x4){bflo(a.x) + bflo(bq.x), bfhi(a.x) + bfhi(bq.x), bflo(a.y) + bflo(bq.y), bfhi(a.y) + bfhi(bq.y)};
        const f32x4 x1 = (f32x4){bflo(a.z) + bflo(bq.z), bfhi(a.z) + bfhi(bq.z), bflo(a.w) + bflo(bq.w), bfhi(a.w) + bfhi(bq.w)};
        float s = x0.x * x0.x + x0.y * x0.y + x0.z * x0.z + x0.w * x0.w + x1.x * x1.x + x1.y * x1.y + x1.z * x1.z + x1.w * x1.w;
        s += __shfl_xor(s, 1); s += __shfl_xor(s, 2); s += __shfl_xor(s, 4); s += __shfl_xor(s, 8);
        const float rs = rsqrtf(s * (1.f / 128.f) + EPS);
        const u32x4 g = *(const u32x4*)(GR + (size_t)r * 512 + c0);
        u32x4 o;
        o.x = pk2(x0.x * rs * w0.x * bflo(g.x), x0.y * rs * w0.y * bfhi(g.x)); o.y = pk2(x0.z * rs * w0.z * bflo(g.y), x0.w * rs * w0.w * bfhi(g.y));
        o.z = pk2(x1.x * rs * w1.x * bflo(g.z), x1.y * rs * w1.y * bfhi(g.z)); o.w = pk2(x1.z * rs * w1.z * bflo(g.w), x1.w * rs * w1.w * bfhi(g.w));
        *(u32x4*)(MIX + (size_t)r * DM + 512 + c0) = o;
    }
}


#define TOPK_INS(L, x) do { float _x = (x); _Pragma("unroll") for (int _s = 0; _s < 16; ++_s) { const float _t = fmaxf(L[_s], _x); _x = fminf(L[_s], _x); L[_s] = _t; } } while (0)
constexpr int P4_QROW = 528, P4_SC0 = 128 * P4_QROW  , P4_TLROW = 144;

#define CE_DESC(a, b) do { const float _hi = fmaxf(a, b), _lo = fminf(a, b); a = _hi; b = _lo; } while (0)
__device__ __forceinline__ void bitonic_sort16_desc(float (&x)[16]) {
#pragma unroll
    for (int k = 2; k <= 16; k <<= 1)
#pragma unroll
        for (int j = k >> 1; j > 0; j >>= 1)
#pragma unroll
            for (int i = 0; i < 16; ++i) { const int l = i ^ j; if (l > i) { if ((i & k) == 0) CE_DESC(x[i], x[l]); else CE_DESC(x[l], x[i]); } }
}
__device__ __forceinline__ void bitonic_merge16_desc(float (&x)[16]) {
#pragma unroll
    for (int j = 8; j > 0; j >>= 1)
#pragma unroll
        for (int i = 0; i < 16; ++i) { const int l = i ^ j; if (l > i) CE_DESC(x[i], x[l]); }
}
__device__ __forceinline__ void top16_merge(float (&L)[16], const float (&x)[16]) {
#pragma unroll
    for (int i = 0; i < 16; ++i) L[i] = fmaxf(L[i], x[15 - i]);
    bitonic_merge16_desc(L);
}

template <int Q> struct CandIJ {
    static constexpr int compute() { int c = 0; for (int i = 0; i < 16; ++i) for (int j = 0; j < 16; ++j) if ((i + 1) * (j + 1) <= 16) { if (c == Q) return i * 16 + j; ++c; } return -1; }
    static constexpr int v = compute();
};
template <int G, int S> __device__ __forceinline__ void cand_fill(float (&x)[16], const float (&A)[16], const float (&Bv)[16]) {
    constexpr int ij = CandIJ<G * 16 + S>::v;
    if constexpr (ij >= 0) x[S] = __uint_as_float((__float_as_uint(A[ij >> 4] + Bv[ij & 15]) & ~255u) | (unsigned)ij); else x[S] = -3.0e38f;
    if constexpr (S + 1 < 16) cand_fill<G, S + 1>(x, A, Bv);
}
__device__ __forceinline__ void p4_route_half(const Params& p, LAS unsigned char* lds, int m0, int h) {
    int tid_ = threadIdx.x; asm volatile("" : "+v"(tid_));
    const int tid = tid_, lane = tid & 63, wave = __builtin_amdgcn_readfirstlane(tid >> 6), l15 = lane & 15, g = lane >> 4;
    const bf16_t* KEYS = (const bf16_t*)(p.ws + OFF_KEYS); unsigned* PW0 = (unsigned*)(p.ws + OFF_PW0);
        {
            const int wr = wave >> 1, wk = wave & 1;
            f32x4 sc[2][2][4];
#pragma unroll
            for (int pp = 0; pp < 2; ++pp) {
#pragma unroll
                for (int rb = 0; rb < 2; ++rb)
#pragma unroll
                    for (int kk = 0; kk < 4; ++kk) sc[pp][rb][kk] = (f32x4){0.f, 0.f, 0.f, 0.f};
                const bf16_t* kbase = KEYS + (size_t)((h * 2 + pp) * 128 + 64 * wk + l15) * 128 + 8 * g;
#pragma unroll
                for (int ks = 0; ks < 4; ++ks) {
                    bf16x8 qf[2], kf[4];
#pragma unroll
                    for (int rb = 0; rb < 2; ++rb) qf[rb] = *(const LAS bf16x8*)(lds + (32 * wr + 16 * rb + l15) * P4_QROW + (pp * 128 + ks * 32 + 8 * g) * 2);
#pragma unroll
                    for (int kk = 0; kk < 4; ++kk) kf[kk] = *(const bf16x8*)(kbase + (size_t)(16 * kk) * 128 + ks * 32);
#pragma unroll
                    for (int rb = 0; rb < 2; ++rb)
#pragma unroll
                        for (int kk = 0; kk < 4; ++kk) sc[pp][rb][kk] = __builtin_amdgcn_mfma_f32_16x16x32_bf16(kf[kk], qf[rb], sc[pp][rb][kk], 0, 0, 0);
                }
            }
#pragma unroll
            for (int rb = 0; rb < 2; ++rb)
#pragma unroll
                for (int kk = 0; kk < 4; ++kk) *(LAS f32x4*)(lds + P4_SC0 + (32 * wr + 16 * rb + l15) * P4_QROW + (64 * wk + 16 * kk + 4 * g) * 4) = sc[0][rb][kk];
            __syncthreads();
#pragma unroll
            for (int rb = 0; rb < 2; ++rb)
#pragma unroll
                for (int kk = 0; kk < 4; ++kk) *(LAS f32x4*)(lds + (32 * wr + 16 * rb + l15) * P4_QROW + (64 * wk + 16 * kk + 4 * g) * 4) = sc[1][rb][kk];
        }
        __syncthreads();
        {
            const int hf = tid & 1, row = (tid >> 1) & 127, pp = tid >> 8;
            const LAS unsigned char* sp = lds + (pp ? 0 : P4_SC0) + row * P4_QROW + hf * 256;
            float L[16];
#pragma unroll
            for (int grp = 0; grp < 4; ++grp) {
                float x[16];
#pragma unroll
                for (int q4 = 0; q4 < 4; ++q4) {
                    const f32x4 v = *(const LAS f32x4*)(sp + (grp * 4 + q4) * 16);
                    const unsigned kb = (unsigned)(hf * 64 + grp * 16 + q4 * 4);
                    x[4 * q4 + 0] = __uint_as_float((__float_as_uint(v.x) & ~127u) | kb);
                    x[4 * q4 + 1] = __uint_as_float((__float_as_uint(v.y) & ~127u) | (kb + 1));
                    x[4 * q4 + 2] = __uint_as_float((__float_as_uint(v.z) & ~127u) | (kb + 2));
                    x[4 * q4 + 3] = __uint_as_float((__float_as_uint(v.w) & ~127u) | (kb + 3));
                }
                bitonic_sort16_desc(x);
                if (grp == 0) {
#pragma unroll
                    for (int s = 0; s < 16; ++s) L[s] = x[s];
                } else top16_merge(L, x);
            }
            {
                float Oth[16];
#pragma unroll
                for (int s = 0; s < 16; ++s) Oth[s] = __shfl_xor(L[s], 1);
                top16_merge(L, Oth);
            }
            __syncthreads();
            if (hf == 0) {
                LAS f32x4* tl = (LAS f32x4*)(lds + P4_SC0 + row * (2 * P4_TLROW) + pp * P4_TLROW);
                tl[0] = (f32x4){L[0], L[1], L[2], L[3]}; tl[1] = (f32x4){L[4], L[5], L[6], L[7]}; tl[2] = (f32x4){L[8], L[9], L[10], L[11]}; tl[3] = (f32x4){L[12], L[13], L[14], L[15]};
            }
        }
        __syncthreads();
        if (tid < 128) {
            const LAS unsigned char* tl = lds + P4_SC0 + tid * (2 * P4_TLROW);
            float A[16], Bv[16];
#pragma unroll
            for (int q4 = 0; q4 < 4; ++q4) { const f32x4 a = *(const LAS f32x4*)(tl + q4 * 16), b = *(const LAS f32x4*)(tl + P4_TLROW + q4 * 16);
                A[4 * q4] = a.x; A[4 * q4 + 1] = a.y; A[4 * q4 + 2] = a.z; A[4 * q4 + 3] = a.w; Bv[4 * q4] = b.x; Bv[4 * q4 + 1] = b.y; Bv[4 * q4 + 2] = b.z; Bv[4 * q4 + 3] = b.w; }
#pragma unroll
            for (int s = 0; s < 16; ++s) { A[s] = __uint_as_float(__float_as_uint(A[s]) & ~127u); Bv[s] = __uint_as_float(__float_as_uint(Bv[s]) & ~127u); }
            float L[16];
            {
                float x[16];
                cand_fill<0, 0>(x, A, Bv); bitonic_sort16_desc(x);
#pragma unroll
                for (int s = 0; s < 16; ++s) L[s] = x[s];
                cand_fill<1, 0>(x, A, Bv); bitonic_sort16_desc(x); top16_merge(L, x);
                cand_fill<2, 0>(x, A, Bv); bitonic_sort16_desc(x); top16_merge(L, x);
                cand_fill<3, 0>(x, A, Bv); bitonic_sort16_desc(x); top16_merge(L, x);
            }
            const float v0 = __uint_as_float(__float_as_uint(L[0]) & ~255u);
            float e[16], den = 0.f; int id[16];
#pragma unroll
            for (int s = 0; s < 16; ++s) {
                const unsigned u = __float_as_uint(L[s]);
                e[s] = __expf(__uint_as_float(u & ~255u) - v0); den += e[s];
                const unsigned i = (u >> 4) & 15u, j = u & 15u;
                const unsigned ka = *(const LAS unsigned*)(tl + i * 4) & 127u, kb = *(const LAS unsigned*)(tl + P4_TLROW + j * 4) & 127u;
                id[s] = (int)(ka * 128u + kb);
            }
            const float inv = 1.f / den;
            unsigned* ip = PW0 + (size_t)(m0 + tid) * 128 + h * 16;
#pragma unroll
            for (int q4 = 0; q4 < 4; ++q4) { u32x4 o;
#pragma unroll
                for (int c = 0; c < 4; ++c) o[c] = (unsigned)id[4 * q4 + c] | (f2bf(e[4 * q4 + c] * inv) << 16);
                *(u32x4*)(ip + 4 * q4) = o; }
        }
        __syncthreads();
}

namespace pg8 {
struct EpiP4 {
    static constexpr bool PERM = true, AFTER_DRAIN = true, SWAPPABLE = false;
    const Params* pp; const float* ssq;
    __device__ __forceinline__ void operator()(const f32x4 (&)[2][2][4][2], const Unit&, int, int, int, int) const {}
    __device__ __forceinline__ void fused(f32x4 (&acc)[2][2][4][2], const Unit& u, int wr, int wc, int fr, int fq, PG8_LAS unsigned char* lds, int wid, int lane) const {
#pragma unroll
        for (int ai = 0; ai < 2; ++ai) {
            const int m0 = u.pm * BM + ai * HALF;
#pragma unroll
            for (int m = 0; m < 4; ++m) {
                const int rl = wr * 64 + m * 16 + fr;
                const float rstd = row_rstd(ssq, m0 + rl);
#pragma unroll
                for (int bj = 0; bj < 2; ++bj) { const f32x4 v0 = acc[ai][bj][m][0] * rstd, v1 = acc[ai][bj][m][1] * rstd;
                    *(PG8_LAS u32x4*)(lds + rl * P4_QROW + (bj * HALF + wc * 32 + 8 * fq) * 2) = (u32x4){pk2(v0.x, v0.y), pk2(v0.z, v0.w), pk2(v1.x, v1.y), pk2(v1.z, v1.w)}; }
            }
            __syncthreads();
            p4_route_half(*pp, lds, m0, u.pn);
        }
    }
};
}
__device__ __forceinline__ void phase4_mfma(const Params& p, LAS unsigned char* lds) {
    pg8::Gemm g{(const pg8::bf16_t*)(p.ws + OFF_H2B), (const pg8::bf16_t*)(p.ws + OFF_WQ), NTOK, 2048, DM};
    pg8::EpiP4 E{&p, (const float*)(p.ws + OFF_SSQP)};
    const int vcu = vcu_of_block();
    for (int r = 0; r * (int)gridDim.x < 512; ++r) {
        const int L = r * (int)gridDim.x + vcu;
        pg8::OneUnit S; S.u.pm = L >> 3; S.u.pn = L & 7; S.valid = L < 512;
        pg8::gemm_phase<pg8::EpiP4, pg8::OneUnit, false, true>(lds, g, S, E);
        __syncthreads();
    }
}


constexpr size_t OFF_PW = 73 * MiB;
constexpr size_t OFF_OUTS = 179 * MiB;
static_assert(OFF_OUTS >= OFF_PW0 + (size_t)NTOK * 128 * 4 && OFF_OUTS + (size_t)NTOK * DM * 4 <= 256 * MiB, "P5 map");
__device__ __forceinline__ float dot_fp8_bf16(u32x4 uq, u32x4 h0, u32x4 h1, float c) {
#define DQ2(word, hsel, hw) c = dot2(__builtin_bit_cast(unsigned, __builtin_amdgcn_cvt_scalef32_pk_bf16_fp8((int)(word), 1.0f, hsel)), hw, c)
    DQ2(uq.x, false, h0.x); DQ2(uq.x, true, h0.y); DQ2(uq.y, false, h0.z); DQ2(uq.y, true, h0.w);
    DQ2(uq.z, false, h1.x); DQ2(uq.z, true, h1.y); DQ2(uq.w, false, h1.z); DQ2(uq.w, true, h1.w);
#undef DQ2
    return c;
}
constexpr int P5A_RS = 1040, P5A_LIST = 16640, P5A_CAP = 768, P5A_RES = P5A_LIST + 4 * P5A_CAP, P5A_TSC = P5A_RES + 64, P5A_WAVE = P5A_TSC + 64;
constexpr size_t OFF_HQ = 146 * MiB;
constexpr size_t OFF_HSC = 192 * 1024;
static_assert(8 * P5A_WAVE <= LDS_BYTES - 32, "P5a LDS");
static_assert(OFF_HQ >= OFF_H2B + (size_t)NTOK * DM * 2 && OFF_HQ + (size_t)NTOK * DM <= OFF_PW0, "HQ map");
__device__ __forceinline__ void quantize_hn(const Params& p) {
    const int tid = threadIdx.x, lane = tid & 63, wave = tid >> 6;
    const bf16_t* H2B = (const bf16_t*)(p.ws + OFF_H2B); unsigned char* HQ = p.ws + OFF_HQ; float* HSC = (float*)(p.ws + OFF_HSC);
    for (int t = blockIdx.x * 8 + wave; t < NTOK; t += gridDim.x * 8) {
        const u32x4 h0 = *(const u32x4*)(H2B + (size_t)t * DM + 16 * lane), h1 = *(const u32x4*)(H2B + (size_t)t * DM + 16 * lane + 8);
        float m = 0.f;
#pragma unroll
        for (int c = 0; c < 4; ++c) { m = fmaxf(m, fmaxf(fabsf(bflo(h0[c])), fabsf(bfhi(h0[c])))); m = fmaxf(m, fmaxf(fabsf(bflo(h1[c])), fabsf(bfhi(h1[c])))); }
        const float am = fmaxf(wave_max(m), 1e-30f), qs = 224.f / am;
        u32x4 o;
#pragma unroll
        for (int c = 0; c < 2; ++c) {
            int w = __builtin_amdgcn_cvt_pk_fp8_f32(bflo(h0[2 * c]) * qs, bfhi(h0[2 * c]) * qs, 0, false); w = __builtin_amdgcn_cvt_pk_fp8_f32(bflo(h0[2 * c + 1]) * qs, bfhi(h0[2 * c + 1]) * qs, w, true); o[c] = (unsigned)w;
            int x = __builtin_amdgcn_cvt_pk_fp8_f32(bflo(h1[2 * c]) * qs, bfhi(h1[2 * c]) * qs, 0, false); x = __builtin_amdgcn_cvt_pk_fp8_f32(bflo(h1[2 * c + 1]) * qs, bfhi(h1[2 * c + 1]) * qs, x, true); o[2 + c] = (unsigned)x;
        }
        *(u32x4*)(HQ + (size_t)t * DM + 16 * lane) = o;
        if (lane == 0) HSC[t] = row_rstd((const float*)(p.ws + OFF_SSQP), t) * am * (1.f / 224.f);
    }
}
__device__ __forceinline__ void p5a_wave(const Params& p, LAS unsigned char* wl, int tb, int part, int lane, __amdgpu_buffer_rsrc_t urs, __amdgpu_buffer_rsrc_t hrs) {
    const float* USC = (const float*)(p.ws + OFF_USC); const float* VSC = (const float*)(p.ws + OFF_VSC); const float* HSC = (const float*)(p.ws + OFF_HSC);
    const unsigned* PW0 = (const unsigned*)(p.ws + OFF_PW0); unsigned* PW = (unsigned*)(p.ws + OFF_PW);
    const int l15 = lane & 15, g = lane >> 4;
    unsigned xl[16], xh[16];
#define P5A_WORDS() do { _Pragma("unroll") for (int _k = 0; _k < 16; ++_k) { xl[_k] = PW0[(size_t)(tb + _k) * 128 + lane]; xh[_k] = PW0[(size_t)(tb + _k) * 128 + 64 + lane]; } } while (0)
#define P5A_GATHER(tile_) do { int _li = (tile_) * 16 + l15; _li = _li < n ? _li : n - 1; \
        const int _ev = (int)((*(const LAS unsigned*)(wl + P5A_LIST + _li * 4) & 0x3fffu) << 10); \
        _Pragma("unroll") for (int _r = 0; _r < 16; ++_r) \
            __builtin_amdgcn_raw_ptr_buffer_load_lds(urs, (LAS unsigned*)(wl + _r * P5A_RS), 16, lane * 16, __builtin_amdgcn_readlane(_ev, _r), 0, 0); } while (0)
#pragma unroll
    for (int k = 0; k < 16; ++k) __builtin_amdgcn_raw_ptr_buffer_load_lds(hrs, (LAS unsigned*)(wl + k * 1024), 16, lane * 16, (tb + k) * 1024, 0, 0);
    P5A_WORDS();
    const float hsc = HSC[tb + l15];
    asm volatile("s_waitcnt vmcnt(0)" ::: "memory");
    long bq[32];
#pragma unroll
    for (int i = 0; i < 16; ++i) { const u32x4 w = *(const LAS u32x4*)(wl + l15 * 1024 + 64 * i + 16 * g);
        bq[2 * i] = __builtin_bit_cast(long, (u32x2){w.x, w.y}); bq[2 * i + 1] = __builtin_bit_cast(long, (u32x2){w.z, w.w}); }
    if (lane < 16) *(LAS float*)(wl + P5A_TSC + lane * 4) = hsc;
    int ntot = 0;
#pragma unroll
    for (int k = 0; k < 16; ++k) ntot += __popcll(__ballot((int)((xl[k] >> 11) & 7u) == part)) + __popcll(__ballot((int)((xh[k] >> 11) & 7u) == part));
    const int npass = ntot <= P5A_CAP ? 1 : 4;
    for (int pass = 0; pass < npass; ++pass) {
        const int klo = npass == 1 ? 0 : 4 * pass, khi = npass == 1 ? 16 : klo + 4;
        if (pass > 0) { P5A_WORDS(); asm volatile("s_waitcnt vmcnt(0)" ::: "memory"); }
        int n = 0;
#pragma unroll
        for (int k = 0; k < 16; ++k) {
            if (k >= klo && k < khi) {
                const bool ml = (int)((xl[k] >> 11) & 7u) == part, mh = (int)((xh[k] >> 11) & 7u) == part;
                const unsigned long long bl = __ballot(ml), bh = __ballot(mh);
                const int rl = __builtin_amdgcn_mbcnt_hi((unsigned)(bl >> 32), __builtin_amdgcn_mbcnt_lo((unsigned)bl, 0u));
                if (ml) *(LAS unsigned*)(wl + P5A_LIST + (n + rl) * 4) = (xl[k] & 0x3fffu) | ((unsigned)lane << 14) | ((unsigned)k << 21);
                n += __popcll(bl);
                const int rh = __builtin_amdgcn_mbcnt_hi((unsigned)(bh >> 32), __builtin_amdgcn_mbcnt_lo((unsigned)bh, 0u));
                if (mh) *(LAS unsigned*)(wl + P5A_LIST + (n + rh) * 4) = (xh[k] & 0x3fffu) | ((unsigned)(64 + lane) << 14) | ((unsigned)k << 21);
                n += __popcll(bh);
            }
        }
        __builtin_amdgcn_s_waitcnt(0xC07F); __builtin_amdgcn_wave_barrier();
        asm volatile("" ::: "memory");
        const int ntile = (n + 15) >> 4;
        if (ntile == 0) continue;
#define P5A_OPS(tile_, EOK, EE, SL, TK, USCV, VSCV, XGV) do { int _ei = (tile_) * 16 + l15; EOK = _ei < n; _ei = EOK ? _ei : n - 1; \
        const unsigned _ent = *(const LAS unsigned*)(wl + P5A_LIST + _ei * 4); \
        EE = _ent & 0x3fffu; SL = (int)((_ent >> 14) & 127u); TK = (int)(_ent >> 21); \
        USCV = USC[EE]; VSCV = VSC[EE]; XGV = PW0[(size_t)(tb + TK) * 128 + SL]; } while (0)
        bool eokN; unsigned eeN; int slN, tkN; float uscN, vscN; unsigned xgN;
        P5A_GATHER(0);
        P5A_OPS(0, eokN, eeN, slN, tkN, uscN, vscN, xgN);
        for (int tile = 0; tile < ntile; ++tile) {
            asm volatile("s_waitcnt vmcnt(0)" : "+v"(uscN), "+v"(vscN), "+v"(xgN) :: "memory");
            const bool eok = eokN; const unsigned ee = eeN; const int sl = slN, tk = tkN, t = tb + tkN; const float usc = uscN, vsc = vscN; const unsigned xg = xgN;
            long aq[32];
#pragma unroll
            for (int i = 0; i < 16; ++i) { const u32x4 w = *(const LAS u32x4*)(wl + l15 * P5A_RS + 64 * i + 16 * g);
                aq[2 * i] = __builtin_bit_cast(long, (u32x2){w.x, w.y}); aq[2 * i + 1] = __builtin_bit_cast(long, (u32x2){w.z, w.w}); }
            asm volatile("s_waitcnt lgkmcnt(0)" ::: "memory");
#pragma unroll
            for (int s = 0; s < 32; ++s) asm volatile("" : "+v"(aq[s]));
            if (tile + 1 < ntile) { P5A_GATHER(tile + 1); P5A_OPS(tile + 1, eokN, eeN, slN, tkN, uscN, vscN, xgN); }
            f32x4 acc = (f32x4){0.f, 0.f, 0.f, 0.f};
#pragma unroll
            for (int s = 0; s < 32; ++s) acc = __builtin_amdgcn_mfma_f32_16x16x32_fp8_fp8(aq[s], bq[s], acc, 0, 0, 0);
            {
                const u32x4 en = *(const LAS u32x4*)(wl + P5A_LIST + (tile * 16 + 4 * g) * 4);
#pragma unroll
                for (int r = 0; r < 4; ++r) if ((int)(en[r] >> 21) == l15) *(LAS float*)(wl + P5A_RES + (4 * g + r) * 4) = acc[r];
            }
            __builtin_amdgcn_s_waitcnt(0xC07F); __builtin_amdgcn_wave_barrier();
            asm volatile("" ::: "memory");
            if (lane < 16 && eok) {
                const float d = *(const LAS float*)(wl + P5A_RES + lane * 4) * usc * *(const LAS float*)(wl + P5A_TSC + tk * 4);
                const float w = __uint_as_float(xg & 0xffff0000u) * gelu_f(d) * vsc;
                PW[(((size_t)(t >> 6) * 32 + (sl >> 2)) * 64 + (t & 63)) * 4 + (sl & 3)] = ee | (f2bf(w) << 16);
            }
            __builtin_amdgcn_s_waitcnt(0xC07F); __builtin_amdgcn_wave_barrier();
            asm volatile("" ::: "memory");
        }
#undef P5A_OPS
    }
    asm volatile("s_waitcnt vmcnt(0)" ::: "memory");
#undef P5A_WORDS
#undef P5A_GATHER
}
__device__ __forceinline__ void phase5a(const Params& p, LAS unsigned char* lds, int qoff = 0) {
    const int tid = threadIdx.x, lane = tid & 63, wave = __builtin_amdgcn_readfirstlane(tid >> 6);
    const int xcc = (int)(__builtin_amdgcn_s_getreg((3 << 11) | 20) & 7u);
    unsigned* qc = (unsigned*)(p.ws + OFF_CTL) + 256 + qoff;
    LAS unsigned char* wl = lds + wave * P5A_WAVE;
    const __amdgpu_buffer_rsrc_t urs = __builtin_amdgcn_make_buffer_rsrc((void*)(p.ws + OFF_UB), 0, NEXP * DM, 0x00020000);
    const __amdgpu_buffer_rsrc_t hrs = __builtin_amdgcn_make_buffer_rsrc((void*)(p.ws + OFF_HQ), 0, NTOK * DM, 0x00020000);
    for (int pi = 0; pi < 8; ++pi) {
        const int part = (xcc + pi) & 7;
        unsigned nxt = 0u;
        if (lane == 0) nxt = atomicAdd(qc + part * 64, 1u);
        for (;;) {
            const int it = (int)__builtin_amdgcn_readfirstlane(nxt);
            if (it >= NTOK / 16) break;
            if (lane == 0) nxt = atomicAdd(qc + part * 64, 1u);
            p5a_wave(p, wl, it * 16, part, lane, urs, hrs);
        }
    }
}

__device__ __forceinline__ void p5b_quad(const LAS unsigned char* lds, u32x4 q, f32x2& a0, f32x2& a1, f32x2& a2, f32x2& a3) {
#pragma unroll
    for (int c = 0; c < 4; ++c) {
        const unsigned x = q[c];
        const u32x2 vv = *(const LAS u32x2*)(lds + ((x & 0x3fffu) << 3));
        const float w = __uint_as_float(x & 0xffff0000u); const f32x2 ww = (f32x2){w, w};
        a0 += ww * __builtin_amdgcn_cvt_pk_f32_fp8((int)vv.x, false); a1 += ww * __builtin_amdgcn_cvt_pk_f32_fp8((int)vv.x, true);
        a2 += ww * __builtin_amdgcn_cvt_pk_f32_fp8((int)vv.y, false); a3 += ww * __builtin_amdgcn_cvt_pk_f32_fp8((int)vv.y, true);
    }
}
__device__ __forceinline__ void phase5b(const Params& p, LAS unsigned char* lds) {
    const int tid = threadIdx.x, lane = tid & 63, wave = __builtin_amdgcn_readfirstlane(tid >> 6);
    const unsigned char* VS = p.ws + OFF_VB; const u32x4* PW = (const u32x4*)(p.ws + OFF_PW); bf16_t* OUTS = (bf16_t*)(p.ws + OFF_OUTS);
    for (int it = blockIdx.x; it < 256; it += gridDim.x) {
        const int s = it >> 1, tbase = (it & 1) * 128;
        __syncthreads();
#pragma unroll 4
        for (int i = 0; i < 16; ++i) *(LAS u32x4*)(lds + (tid + NTHR * i) * 16) = *(const u32x4*)(VS + (size_t)s * 131072 + (size_t)(tid + NTHR * i) * 16);
        __syncthreads();
        u32x4 A[8], Bq[8];
#define P5B_LOAD(R, gi) do { const int _T = tbase + wave + 8 * ((gi) >> 2), _g = (gi) & 3; const u32x4* _p = PW + ((size_t)_T * 32 + _g * 8) * 64 + lane; \
        _Pragma("unroll") for (int _i = 0; _i < 8; ++_i) R[_i] = _p[_i * 64]; } while (0)
        f32x2 a0 = {0.f, 0.f}, a1 = {0.f, 0.f}, a2 = {0.f, 0.f}, a3 = {0.f, 0.f};
        P5B_LOAD(A, 0);
        for (int gi = 0; gi < 64; gi += 2) {
            P5B_LOAD(Bq, gi + 1);
#pragma unroll
            for (int i = 0; i < 8; ++i) p5b_quad(lds, A[i], a0, a1, a2, a3);
            if (gi + 2 < 64) P5B_LOAD(A, gi + 2);
#pragma unroll
            for (int i = 0; i < 8; ++i) p5b_quad(lds, Bq[i], a0, a1, a2, a3);
            if (((gi + 1) & 3) == 3) {
                const int T = tbase + wave + 8 * (gi >> 2);
                *(u32x4*)(OUTS + ((size_t)s * NTOK + T * 64 + lane) * 8) = (u32x4){pk2(a0.x, a0.y), pk2(a1.x, a1.y), pk2(a2.x, a2.y), pk2(a3.x, a3.y)};
                a0 = (f32x2){0.f, 0.f}; a1 = a0; a2 = a0; a3 = a0;
            }
        }
#undef P5B_LOAD
    }
}

__device__ __forceinline__ void phase5c(const Params& p, LAS unsigned char* lds) {
    const int tid = threadIdx.x, lane = tid & 63, wave = __builtin_amdgcn_readfirstlane(tid >> 6);
    const bf16_t* OUTS = (const bf16_t*)(p.ws + OFF_OUTS); const bf16_t* H2B = (const bf16_t*)(p.ws + OFF_H2B); const float* fw = p.in[20];
    for (int it = blockIdx.x; it < NTOK / 32; it += gridDim.x) {
        const int t0 = it * 32;
        __syncthreads();
#pragma unroll 4
        for (int i = 0; i < 8; ++i) {
            const int q = tid + NTHR * i, s = q >> 5, tt = q & 31;
            *(LAS u32x4*)(lds + tt * 2064 + s * 16) = *(const u32x4*)(OUTS + ((size_t)s * NTOK + t0 + tt) * 8);
        }
        __syncthreads();
        for (int i = 0; i < 4; ++i) {
            const int tt = wave * 4 + i; float* orow = p.out + (size_t)(t0 + tt) * DM;
            f32x4 h[4]; float ss = 0.f;
#pragma unroll
            for (int j = 0; j < 2; ++j) {
                const u32x4 a = *(const u32x4*)(H2B + (size_t)(t0 + tt) * DM + 512 * j + 8 * lane), pq = *(const LAS u32x4*)(lds + tt * 2064 + (512 * j + 8 * lane) * 2);
                h[2 * j] = (f32x4){bflo(a.x) + bflo(pq.x), bfhi(a.x) + bfhi(pq.x), bflo(a.y) + bflo(pq.y), bfhi(a.y) + bfhi(pq.y)};
                h[2 * j + 1] = (f32x4){bflo(a.z) + bflo(pq.z), bfhi(a.z) + bfhi(pq.z), bflo(a.w) + bflo(pq.w), bfhi(a.w) + bfhi(pq.w)};
            }
#pragma unroll
            for (int j = 0; j < 4; ++j) ss += h[j].x * h[j].x + h[j].y * h[j].y + h[j].z * h[j].z + h[j].w * h[j].w;
            const float rs = rsqrtf(wave_sum(ss) * (1.f / DM) + EPS);
#pragma unroll
            for (int j = 0; j < 2; ++j) {
                float* o = orow + 512 * j + 8 * lane; const float* w = fw + 512 * j + 8 * lane;
                *(f32x4*)o = h[2 * j] * rs * *(const f32x4*)w; *(f32x4*)(o + 4) = h[2 * j + 1] * rs * *(const f32x4*)(w + 4);
            }
        }
    }
}


#define XB_TMO      128
#define XB_XCNT(j)  (256  + 64 * (j))
#define XB_XSUB(j)  (1280 + 64 * (j))
#define XB_XGEN(j)  (2304 + 64 * (j))
#define XB_TOP      3328
#define XB_TOPGEN   3392
#define XCD_BAR_WORDS 3456
#define XB_SPIN_CAP (1u << 18)
__device__ __forceinline__ unsigned xb_ld(unsigned* p)              { return __hip_atomic_load(p, __ATOMIC_RELAXED, __HIP_MEMORY_SCOPE_AGENT); }
__device__ __forceinline__ unsigned xb_add(unsigned* p, unsigned v) { return __hip_atomic_fetch_add(p, v, __ATOMIC_RELAXED, __HIP_MEMORY_SCOPE_AGENT); }
__device__ __forceinline__ unsigned xb_xcc_id() { return (unsigned)__builtin_amdgcn_s_getreg((3 << 11) | 20) & 0xFu; }
#define XB_SPIN(cond, bar) do { unsigned _sp = 0; while (cond) { __builtin_amdgcn_s_sleep(1); \
    if ((++_sp & 255u) == 0u) { if (xb_ld(&(bar)[XB_TMO])) break; if (_sp > XB_SPIN_CAP) { atomicAdd(&(bar)[XB_TMO], 1u); break; } } } } while (0)
struct XcdBarrier { unsigned* bar; unsigned x; volatile LAS unsigned* st; };
__device__ __forceinline__ XcdBarrier xcd_barrier_post(unsigned* bar, volatile LAS unsigned* st) {
    XcdBarrier b; b.bar = bar; b.x = xb_xcc_id(); b.st = st;
    if (threadIdx.x == 0) (void)xb_add(&bar[XB_XCNT(b.x)], 1u);
    return b;
}
__device__ __forceinline__ void xcd_barrier_complete(unsigned* bar, unsigned x, unsigned& nloc, unsigned& nx) {
    const unsigned G = gridDim.x * gridDim.y * gridDim.z;
    unsigned sum, cnt, mine, sp = 0u;
    for (;;) {
        sum = 0u; cnt = 0u; mine = 0u;
#pragma unroll
        for (unsigned j = 0; j < 16; ++j) { const unsigned c = xb_ld(&bar[XB_XCNT(j)]); sum += c; cnt += (c > 0u) ? 1u : 0u; mine = (j == x) ? c : mine; }
        if (sum == G) break;
        __builtin_amdgcn_s_sleep(1);
        if ((++sp & 255u) == 0u) { if (xb_ld(&bar[XB_TMO])) break; if (sp > XB_SPIN_CAP) { atomicAdd(&bar[XB_TMO], 1u); break; } }
    }
    nloc = mine > 0u ? mine : 1u; nx = cnt > 0u ? cnt : 1u;
}
__device__ __forceinline__ void xcd_barrier(const XcdBarrier& b) {
    asm volatile("s_waitcnt vmcnt(0)" ::: "memory");
    __syncthreads();
    if (threadIdx.x == 0) {
        unsigned* bar = b.bar;
        __builtin_amdgcn_s_waitcnt(0);
        unsigned nloc = b.st[0], nx = b.st[1];
        if (nloc == 0u) { xcd_barrier_complete(bar, b.x, nloc, nx); b.st[0] = nloc; b.st[1] = nx; }
        const unsigned old = xb_add(&bar[XB_XSUB(b.x)], 1u);
        const unsigned gen = old / nloc;
        if (old + 1u == (gen + 1u) * nloc) {
            __builtin_amdgcn_fence(__ATOMIC_RELEASE, "agent");
            asm volatile("s_waitcnt vmcnt(0)" ::: "memory");
            const unsigned og = xb_add(&bar[XB_TOP], 1u);
            const unsigned tg = og / nx;
            if (og + 1u == (tg + 1u) * nx) xb_add(&bar[XB_TOPGEN], 1u);
            else XB_SPIN(xb_ld(&bar[XB_TOPGEN]) == tg, bar);
            __builtin_amdgcn_fence(__ATOMIC_ACQUIRE, "agent");
            asm volatile("s_waitcnt vmcnt(0)" ::: "memory");
        } else {
            XB_SPIN(xb_ld(&bar[XB_TOPGEN]) == gen, bar);
            __builtin_amdgcn_fence(__ATOMIC_ACQUIRE, "agent");
            asm volatile("s_waitcnt vmcnt(0)" ::: "memory");
        }
    }
    __syncthreads();
}

constexpr int NPHASE = 9;
__global__ void __launch_bounds__(NTHR, 2) mega(Params p) {
    extern __shared__ __attribute__((aligned(16))) unsigned char lds[];
    cg::grid_group grid = cg::this_grid();
#define PH_ON(k) (p.ph_lo <= (k) && (k) < p.ph_hi)
    if (threadIdx.x < 2) ((LAS unsigned*)((LAS unsigned char*)lds + LDS_BYTES - 32))[threadIdx.x] = 0u;
    __syncthreads();
    const XcdBarrier xbar = xcd_barrier_post((unsigned*)(p.ws + OFF_CTL) + 8192, (volatile LAS unsigned*)((LAS unsigned char*)lds + LDS_BYTES - 32));
#define PH_SYNC(k) do { if (PH_ON(k) && PH_ON((k) + 1)) { xcd_barrier(xbar); } } while (0)
    if (PH_ON(0)) phase0(p, lds);
    PH_SYNC(0);
    if (PH_ON(1)) phase1_mfma(p, (LAS unsigned char*)lds);
#if PROBE_DUP == 1
    xcd_barrier(xbar); phase1_mfma(p, (LAS unsigned char*)lds);
#endif
    PH_SYNC(1);
    if (PH_ON(2)) phase2(p, (LAS unsigned char*)lds);
#if PROBE_DUP == 2
    xcd_barrier(xbar); phase2(p, (LAS unsigned char*)lds, 1);
#endif
#if PROBE_DUP == 21
    xcd_barrier(xbar); phase2(p, (LAS unsigned char*)lds, 2);
#endif
#if PROBE_DUP == 22
    xcd_barrier(xbar); phase2(p, (LAS unsigned char*)lds, 3);
#endif
    PH_SYNC(2);
    if (PH_ON(4)) phase3_mfma(p, (LAS unsigned char*)lds);
#if PROBE_DUP == 4
    xcd_barrier(xbar); phase3_mfma(p, (LAS unsigned char*)lds);
#endif
    PH_SYNC(4);
    if (PH_ON(5)) { phase4_mfma(p, (LAS unsigned char*)lds); quantize_hn(p); }
#if PROBE_DUP == 5
    xcd_barrier(xbar); phase4_mfma(p, (LAS unsigned char*)lds);
#endif
    PH_SYNC(5);
    if (PH_ON(6)) phase5a(p, (LAS unsigned char*)lds);
#if PROBE_DUP == 6
    xcd_barrier(xbar); phase5a(p, (LAS unsigned char*)lds, 1024);
#endif
    PH_SYNC(6);
    if (PH_ON(7)) phase5b(p, (LAS unsigned char*)lds);
#if PROBE_DUP == 7
    xcd_barrier(xbar); phase5b(p, (LAS unsigned char*)lds);
#endif
    PH_SYNC(7);
    if (PH_ON(8)) phase5c(p, (LAS unsigned char*)lds);
}

extern "C" void kernel_launch(void* const* d_in, const int* in_sizes, int n_in, void* d_out, int out_size, void* d_ws, size_t ws_size, hipStream_t stream) {
    static int grid = 0;
    if (grid == 0) {
        if (n_in != 21 || out_size != NTOK * DM || ws_size < WS_END) { fprintf(stderr, "kernel_launch: unexpected shapes (n_in %d out %d ws %zu)\n", n_in, out_size, ws_size); grid = -1; return; }
        int dev = 0, cus = 0, per_cu = 0;
        hipGetDevice(&dev);
        hipDeviceGetAttribute(&cus, hipDeviceAttributeMultiprocessorCount, dev);
        hipFuncSetAttribute((const void*)mega, hipFuncAttributeMaxDynamicSharedMemorySize, LDS_BYTES);
        hipOccupancyMaxActiveBlocksPerMultiprocessor(&per_cu, (const void*)mega, NTHR, LDS_BYTES);
        if (per_cu < 1) { fprintf(stderr, "kernel_launch: occupancy query says %d blocks/CU\n", per_cu); per_cu = 1; }
        grid = cus * 1;
        (void)hipGetLastError();
    }
    if (grid < 0) return;
    hipMemsetAsync((char*)d_ws + OFF_CTL, 0, CTL_BYTES, stream);
    Params p{};
    for (int i = 0; i < 21; ++i) p.in[i] = (const float*)d_in[i];
    p.out = (float*)d_out; p.ws = (unsigned char*)d_ws; p.ph_lo = 0; p.ph_hi = NPHASE;
    void* args[] = {&p};
    hipError_t e = hipLaunchCooperativeKernel((const void*)mega, dim3(grid), dim3(NTHR), args, LDS_BYTES, stream);
    if (e != hipSuccess) fprintf(stderr, "cooperative launch failed: %s (grid %d)\n", hipGetErrorString(e), grid);
}
```

```cpp
#include <hip/hip_runtime.h>
#include <hip/hip_cooperative_groups.h>
#include <cstdio>
#include <cstdint>
namespace cg = cooperative_groups;

constexpr int DM = 1024;
constexpr int NB = 8, SEQ = 2048, NMETA = 16;
constexpr int NTOK = NB * SEQ;
constexpr int MROWS = 16640;
constexpr int NIN = 3584;
constexpr int TPOS = NMETA + SEQ;
constexpr float EPS = 1e-6f;
constexpr float QSCALE = 0.125f * 1.4426950408889634f;
constexpr int NEXP = 16384;
constexpr int NTHR = 512;
#ifndef PROBE_DUP
#define PROBE_DUP 0
#endif

constexpr size_t MiB = 1u << 20;
constexpr size_t OFF_CTL = 0, CTL_BYTES = 64 * 1024;
constexpr size_t OFF_MISC = 512 * 1024;
constexpr size_t OFF_ROPE = 1 * MiB;
constexpr size_t OFF_WOUT = 2 * MiB;
constexpr size_t OFF_WQ = 4 * MiB;
constexpr size_t OFF_KEYS = 8 * MiB;
constexpr size_t OFF_SSQP = 25 * MiB;
constexpr size_t OFF_UB = 9 * MiB;
constexpr size_t OFF_VB = 41 * MiB;
constexpr size_t OFF_XN = 73 * MiB;
constexpr size_t OFF_MIX = 73 * MiB;
constexpr size_t OFF_WIN = 106 * MiB;
constexpr size_t OFF_QB = 113 * MiB;
constexpr size_t OFF_KB = OFF_QB + 16 * MiB + 256 * 1024;
constexpr size_t OFF_VT = OFF_KB + 16 * MiB + 256 * 1024;
constexpr size_t OFF_H2B = 113 * MiB;
constexpr size_t OFF_GQ = 162 * MiB;
constexpr size_t OFF_GK = OFF_GQ + 8 * MiB + 256 * 1024;
constexpr size_t OFF_GVT = OFF_GK + 8 * MiB + 256 * 1024;
constexpr size_t OFF_GF = OFF_GVT + 16 * MiB + 256 * 1024;
constexpr size_t OFF_GB = OFF_GF + 16 * MiB + 256 * 1024;
constexpr size_t OFF_GR = OFF_GB + 16 * MiB + 256 * 1024;
constexpr size_t OFF_PW0 = 162 * MiB;
constexpr size_t OFF_USC = 64 * 1024;
constexpr size_t OFF_VSC = 128 * 1024;
constexpr size_t WS_END = OFF_GR + 16 * MiB + 256 * 1024;
static_assert(WS_END <= 256 * MiB, "workspace map");
static_assert(OFF_VT + (size_t)512 * MROWS * 2 <= OFF_GQ, "map D");
static_assert(OFF_WIN + (size_t)NIN * DM * 2 <= OFF_QB, "map C");

constexpr int LDS_BYTES = 163840;
constexpr int LDS_Q = LDS_BYTES - 16;

typedef unsigned short bf16_t;
typedef float f32x4 __attribute__((ext_vector_type(4)));
typedef float f32x2 __attribute__((ext_vector_type(2)));
typedef unsigned u32x4 __attribute__((ext_vector_type(4)));
typedef unsigned u32x2 __attribute__((ext_vector_type(2)));
typedef __bf16 bf16x2_t __attribute__((ext_vector_type(2)));

struct Params {
    const float* in[21];
    float* out;
    unsigned char* ws;
    int ph_lo, ph_hi;
};

__device__ __forceinline__ unsigned f2bf(float f) { unsigned u = __float_as_uint(f); return (u + 0x7fffu + ((u >> 16) & 1u)) >> 16; }
__device__ __forceinline__ float bf2f(unsigned h) { return __uint_as_float(h << 16); }
__device__ __forceinline__ unsigned pk2(float lo, float hi) { return __builtin_bit_cast(unsigned, __builtin_convertvector((f32x2){lo, hi}, bf16x2_t)); }
__device__ __forceinline__ float bflo(unsigned w) { return __uint_as_float(w << 16); }
__device__ __forceinline__ float bfhi(unsigned w) { return __uint_as_float(w & 0xffff0000u); }
__device__ __forceinline__ float dot2(unsigned a, unsigned b, float c) {
    return __builtin_amdgcn_fdot2_f32_bf16(__builtin_bit_cast(bf16x2_t, a), __builtin_bit_cast(bf16x2_t, b), c, false);
}
__device__ __forceinline__ float dot8(u32x4 a, u32x4 b, float c) { c = dot2(a.x, b.x, c); c = dot2(a.y, b.y, c); c = dot2(a.z, b.z, c); return dot2(a.w, b.w, c); }
__device__ __forceinline__ float wave_sum(float v) {
#pragma unroll
    for (int o = 1; o < 64; o <<= 1) v += __shfl_xor(v, o);
    return v;
}
__device__ __forceinline__ float wave_max(float v) {
#pragma unroll
    for (int o = 1; o < 64; o <<= 1) v = fmaxf(v, __shfl_xor(v, o));
    return v;
}
__device__ __forceinline__ float silu_f(float x) { return x * __builtin_amdgcn_rcpf(1.f + __expf(-x)); }
__device__ __forceinline__ float logsig_f(float x) { return fminf(x, 0.f) - __logf(1.f + __expf(-fabsf(x))); }
__device__ __forceinline__ float gelu_f(float v) {
    const float av = fabsf(v), t = __builtin_amdgcn_rcpf(av * 0.2316418882f + 1.0f);
    float q = t * 0.5307027145f + (-0.7265760135f); q = q * t + 0.7107068705f; q = q * t + (-0.142248368f); q = q * t + 0.127414796f; q = q * t;
    const float m = v * (q * __builtin_amdgcn_exp2f(v * v * (-0.72134752044f)));
    return v < 0.f ? m : v - m;
}

__device__ __forceinline__ float win_src(const Params& p, int k, int n) {
    const float* W = p.in[3] + (size_t)k * 3104;
    if (n < 1024) {
        const int base = n & ~63, dp = n & 63, d = dp < 16 ? ((dp >> 1) + 8 * (dp & 1)) : dp;
        return W[base + d];
    } else if (n < 3072) return W[n];
    const int j = (n - 3072) & 255, dir = (n - 3072) >> 8;
    const float* w2 = p.in[dir ? 11 : 9];
    const float* wz = W + 3072 + dir * 16;
    float s = 0.f;
#pragma unroll
    for (int r = 0; r < 16; ++r) s += wz[r] * w2[r * 256 + j];
    return s;
}

template <int WHICH>
__device__ __forceinline__ void p0_transpose_item(const Params& p, float* scr, int item, int lane) {
    constexpr int N = WHICH == 0 ? NIN : (WHICH == 1 ? 1024 : 2048);
    constexpr int nblk = N / 32;
    const int kb = item / nblk, nb = item % nblk, k0 = 64 * kb, n0 = 32 * nb;
    bf16_t* WT = (bf16_t*)(p.ws + (WHICH == 0 ? OFF_WIN : (WHICH == 1 ? OFF_WOUT : OFF_WQ)));
#pragma unroll 4
    for (int i = 0; i < 32; ++i) {
        const int kk = 2 * i + (lane >> 5), k = k0 + kk, n = n0 + (lane & 31);
        float v;
        if (WHICH == 0) v = win_src(p, k, n);
        else if (WHICH == 1) v = p.in[14][(size_t)k * 1024 + n];
        else v = p.in[16][(size_t)k * 2048 + n] * p.in[15][k];
        scr[kk * 33 + (lane & 31)] = v;
    }
    __builtin_amdgcn_s_waitcnt(0xC07F); __builtin_amdgcn_wave_barrier();
    const int c = lane & 7;
#pragma unroll
    for (int j = 0; j < 4; ++j) {
        const int n = (lane >> 3) + 8 * j; const float* s = scr + (8 * c) * 33 + n;
        u32x4 o; o.x = pk2(s[0 * 33], s[1 * 33]); o.y = pk2(s[2 * 33], s[3 * 33]); o.z = pk2(s[4 * 33], s[5 * 33]); o.w = pk2(s[6 * 33], s[7 * 33]);
        *(u32x4*)(WT + (size_t)(n0 + n) * 1024 + k0 + 8 * c) = o;
    }
    __builtin_amdgcn_s_waitcnt(0xC07F); __builtin_amdgcn_wave_barrier();
}

__device__ __forceinline__ void phase0(const Params& p, unsigned char* lds) {
    const int tid = threadIdx.x, lane = tid & 63, wave = tid >> 6;
    const int gw = blockIdx.x * 8 + wave, NGW = gridDim.x * 8;
    const long gt = (long)blockIdx.x * NTHR + tid, NGT = (long)gridDim.x * NTHR;
    {
        const f32x4* lw = (const f32x4*)p.in[2];
        bf16_t* XN = (bf16_t*)(p.ws + OFF_XN);
        for (int r = gw; r < MROWS; r += NGW) {
            const float* src = r < NTOK ? p.in[0] + (size_t)r * DM : (r < NTOK + NMETA ? p.in[1] + (size_t)(r - NTOK) * DM : nullptr);
            f32x4 v[4]; float s = 0.f;
#pragma unroll
            for (int j = 0; j < 4; ++j) { v[j] = src ? ((const f32x4*)src)[lane + 64 * j] : (f32x4){0.f, 0.f, 0.f, 0.f}; s += v[j].x * v[j].x + v[j].y * v[j].y + v[j].z * v[j].z + v[j].w * v[j].w; }
            const float rs = rsqrtf(wave_sum(s) * (1.f / DM) + EPS);
#pragma unroll
            for (int j = 0; j < 4; ++j) { const f32x4 w = lw[lane + 64 * j]; u32x2 o; o.x = pk2(v[j].x * rs * w.x, v[j].y * rs * w.y); o.y = pk2(v[j].z * rs * w.z, v[j].w * rs * w.w);
                *(u32x2*)(XN + (size_t)r * DM + 4 * (lane + 64 * j)) = o; }
        }
    }
    {
        float* scr = (float*)lds + wave * (64 * 33);
        constexpr int I0 = 16 * (NIN / 32);
        for (int it = gw; it < I0; it += NGW) p0_transpose_item<0>(p, scr, it, lane);
    }
    {
        f32x2* rope = (f32x2*)(p.ws + OFF_ROPE);
        for (long i = gt; i < TPOS * 8; i += NGT) {
            const int t = (int)(i >> 3), j = (int)(i & 7);
            const float inv = powf(500000.0f, -(float)j * 0.125f);
            const float ang = (float)t * inv;
            rope[i] = (f32x2){cosf(ang), sinf(ang)};
        }
        if (gt == 0) {
            float a = 0.f, b = 0.f;
            for (int i = 0; i < 64; ++i) { a += p.in[4][i] * p.in[5][i]; b += p.in[6][i] * p.in[7][i]; }
            ((float*)(p.ws + OFF_MISC))[0] = expf(a) - expf(b) + 0.2f;
        }
    }
}
constexpr int CV_WOUT = 64, CV_WQ = 128, CV_KEYS = 8, CV_U = 256, CV_V = 256, CV_ITEMS = CV_WOUT + CV_WQ + CV_KEYS + CV_U + CV_V;
__device__ __forceinline__ void conv_item(const Params& p, unsigned char* lds, int c) {
    const int tid = threadIdx.x, lane = tid & 63, wave = tid >> 6;
    __syncthreads();
    if (c < CV_WOUT) { p0_transpose_item<1>(p, (float*)lds + wave * (64 * 33), c * 8 + wave, lane); return; }
    c -= CV_WOUT;
    if (c < CV_WQ) { p0_transpose_item<2>(p, (float*)lds + wave * (64 * 33), c * 8 + wave, lane); return; }
    c -= CV_WQ;
    if (c < CV_KEYS) {
        bf16_t* KEYS = (bf16_t*)(p.ws + OFF_KEYS);
#pragma unroll 2
        for (int j = 0; j < 8; ++j) {
            const long e = ((long)c * 4096 + tid + NTHR * j) * 8;
            const f32x4 a = *(const f32x4*)(p.in[17] + e), b = *(const f32x4*)(p.in[17] + e + 4);
            u32x4 o; o.x = pk2(a.x, a.y); o.y = pk2(a.z, a.w); o.z = pk2(b.x, b.y); o.w = pk2(b.z, b.w);
            *(u32x4*)(KEYS + e) = o;
        }
        return;
    }
    c -= CV_KEYS;
    if (c < CV_U) {
        unsigned char* UQ = p.ws + OFF_UB; float* USC = (float*)(p.ws + OFF_USC);
#pragma unroll 2
        for (int i = 0; i < 8; ++i) {
            const int r = c * 64 + wave * 8 + i;
            const float* ur = p.in[18] + (size_t)r * DM + 16 * lane; const float* lw = p.in[15] + 16 * lane;
            f32x4 v[4]; float am = 0.f;
#pragma unroll
            for (int j = 0; j < 4; ++j) { v[j] = ((const f32x4*)ur)[j] * ((const f32x4*)lw)[j]; am = fmaxf(am, fmaxf(fmaxf(fabsf(v[j].x), fabsf(v[j].y)), fmaxf(fabsf(v[j].z), fabsf(v[j].w)))); }
            am = fmaxf(wave_max(am), 1e-30f);
            const float sc = 224.f / am;
            u32x4 o;
#pragma unroll
            for (int j = 0; j < 4; ++j) { int w = __builtin_amdgcn_cvt_pk_fp8_f32(v[j].x * sc, v[j].y * sc, 0, false); w = __builtin_amdgcn_cvt_pk_fp8_f32(v[j].z * sc, v[j].w * sc, w, true); o[j] = (unsigned)w; }
            *(u32x4*)(UQ + (size_t)r * DM + 16 * lane) = o;
            if (lane == 0) USC[r] = am * (1.f / 224.f);
        }
        return;
    }
    c -= CV_U;
    {
        unsigned char* VS = p.ws + OFF_VB; float* VSC = (float*)(p.ws + OFF_VSC);
        const int tile = c;
#pragma unroll 2
        for (int i = 0; i < 8; ++i) {
            const int er = wave * 8 + i, r = tile * 64 + er;
            const float* vr = p.in[19] + (size_t)r * DM + 16 * lane;
            f32x4 v[4]; float am = 0.f;
#pragma unroll
            for (int j = 0; j < 4; ++j) { v[j] = ((const f32x4*)vr)[j]; am = fmaxf(am, fmaxf(fmaxf(fabsf(v[j].x), fabsf(v[j].y)), fmaxf(fabsf(v[j].z), fabsf(v[j].w)))); }
            am = fmaxf(wave_max(am), 1e-30f);
            const float sc = 224.f / am;
            u32x4 o;
#pragma unroll
            for (int j = 0; j < 4; ++j) { int w = __builtin_amdgcn_cvt_pk_fp8_f32(v[j].x * sc, v[j].y * sc, 0, false); w = __builtin_amdgcn_cvt_pk_fp8_f32(v[j].z * sc, v[j].w * sc, w, true); o[j] = (unsigned)w; }
            *(u32x2*)(lds + er * 1032 + 16 * lane) = (u32x2){o.x, o.y}; *(u32x2*)(lds + er * 1032 + 16 * lane + 8) = (u32x2){o.z, o.w};
            if (lane == 0) VSC[r] = am * (1.f / 224.f);
        }
        __syncthreads();
#pragma unroll 4
        for (int i = 0; i < 16; ++i) {
            const int s = wave + 8 * i;
            *(u32x2*)(VS + ((size_t)s * NEXP + tile * 64 + lane) * 8) = *(const u32x2*)(lds + lane * 1032 + s * 8);
        }
    }
}

struct P1Ptrs { unsigned char* ws; const float* bias_f; const float* bias_b; };
__device__ __forceinline__ void p1_store(const P1Ptrs p, int row, int n0, float v0, float v1, float v2, float v3) {
    if (n0 < 1024) {
        const int dp = n0 & 63;
        if (dp < 16) {
            const int pos = row < NTOK ? NMETA + (row & (SEQ - 1)) : (row - NTOK);
            const f32x4 cs = *(const f32x4*)((const float*)(p.ws + OFF_ROPE) + ((size_t)pos * 8 + (dp >> 1)) * 2);
            const float a0 = v0 * cs.x - v1 * cs.y, b0 = v1 * cs.x + v0 * cs.y;
            const float a1 = v2 * cs.z - v3 * cs.w, b1 = v3 * cs.z + v2 * cs.w;
            v0 = a0; v1 = b0; v2 = a1; v3 = b1;
        }
        if (n0 < 512) { u32x2 o; o.x = pk2(v0 * QSCALE, v1 * QSCALE); o.y = pk2(v2 * QSCALE, v3 * QSCALE); *(u32x2*)((bf16_t*)(p.ws + OFF_QB) + (size_t)row * 512 + n0) = o; }
        else { u32x2 o; o.x = pk2(v0, v1); o.y = pk2(v2, v3); *(u32x2*)((bf16_t*)(p.ws + OFF_KB) + (size_t)row * 512 + (n0 - 512)) = o; }
    } else if (n0 < 1536) {
        bf16_t* VT = (bf16_t*)(p.ws + OFF_VT) + (size_t)(n0 - 1024) * MROWS + row;
        VT[0] = (bf16_t)f2bf(v0); VT[MROWS] = (bf16_t)f2bf(v1); VT[2 * MROWS] = (bf16_t)f2bf(v2); VT[3 * (size_t)MROWS] = (bf16_t)f2bf(v3);
    } else if (n0 < 1792) {
        u32x2 o; o.x = pk2(v0 * 0.125f, v1 * 0.125f); o.y = pk2(v2 * 0.125f, v3 * 0.125f); *(u32x2*)((bf16_t*)(p.ws + OFF_GQ) + (size_t)row * 256 + (n0 - 1536)) = o;
    } else if (n0 < 2048) {
        u32x2 o; o.x = pk2(v0, v1); o.y = pk2(v2, v3); *(u32x2*)((bf16_t*)(p.ws + OFF_GK) + (size_t)row * 256 + (n0 - 1792)) = o;
    } else if (n0 < 2560) {
        bf16_t* VT = (bf16_t*)(p.ws + OFF_GVT) + (size_t)(n0 - 2048) * MROWS + row;
        VT[0] = (bf16_t)f2bf(v0); VT[MROWS] = (bf16_t)f2bf(v1); VT[2 * MROWS] = (bf16_t)f2bf(v2); VT[3 * (size_t)MROWS] = (bf16_t)f2bf(v3);
    } else if (n0 < 3072) {
        u32x2 o; o.x = pk2(silu_f(v0), silu_f(v1)); o.y = pk2(silu_f(v2), silu_f(v3)); *(u32x2*)((bf16_t*)(p.ws + OFF_GR) + (size_t)row * 512 + (n0 - 2560)) = o;
    } else {
        const int dir = (n0 - 3072) >> 8, j = (n0 - 3072) & 255;
        const f32x4 bb = *(const f32x4*)((dir ? p.bias_b : p.bias_f) + j);
        f32x4 o; o.x = logsig_f(v0 + bb.x) * 0.0625f; o.y = logsig_f(v1 + bb.y) * 0.0625f; o.z = logsig_f(v2 + bb.z) * 0.0625f; o.w = logsig_f(v3 + bb.w) * 0.0625f;
        *(f32x4*)((float*)(p.ws + (dir ? OFF_GB : OFF_GF)) + (size_t)row * 256 + j) = o;
    }
}


#define LAS __attribute__((address_space(3)))
typedef short bf16x8 __attribute__((ext_vector_type(8)));
constexpr int GBUF = 49152;

template <int ROWS>
__device__ __forceinline__ void stage_tile(const bf16_t* G, int ldk, int r0, int k0, LAS unsigned char* buf, int wave, int lane) {
    const int rr = lane >> 3, c = (lane & 7) ^ rr;
#pragma unroll
    for (int i = 0; i < ROWS / 64; ++i) {
        const int grp = wave + 8 * i;
        const bf16_t* src = G + (size_t)(r0 + grp * 8 + rr) * ldk + k0 + c * 8;
        __builtin_amdgcn_global_load_lds((const unsigned*)src, (LAS unsigned*)(buf + grp * 1024), 16, 0, 0);
    }
}
__device__ __forceinline__ bf16x8 ldfrag(const LAS unsigned char* buf, int row, int c) {
    return *(const LAS bf16x8*)(buf + row * 128 + ((c ^ (row & 7)) << 4));
}
template <bool SWAP>
__device__ __forceinline__ void gemm_tile_256(const bf16_t* A, const bf16_t* Bt, int K, int m0, int n0, LAS unsigned char* lds, f32x4 (&acc)[4][4]) {
    const int tid = threadIdx.x, lane = tid & 63, wave = __builtin_amdgcn_readfirstlane(tid >> 6), wm = wave >> 2, wn = wave & 3, l15 = lane & 15, g = lane >> 4;
#pragma unroll
    for (int i = 0; i < 4; ++i)
#pragma unroll
        for (int j = 0; j < 4; ++j) acc[i][j] = (f32x4){0.f, 0.f, 0.f, 0.f};
    const int nk = K / 64;
    stage_tile<128>(A, K, m0, 0, lds, wave, lane);
    stage_tile<256>(Bt, K, n0, 0, lds + 16384, wave, lane);
    for (int kt = 0; kt < nk; ++kt) {
        asm volatile("s_waitcnt vmcnt(0)" ::: "memory");
        __syncthreads();
        if (kt + 1 < nk) {
            LAS unsigned char* nb = lds + ((kt + 1) & 1) * GBUF;
            stage_tile<128>(A, K, m0, (kt + 1) * 64, nb, wave, lane);
            stage_tile<256>(Bt, K, n0, (kt + 1) * 64, nb + 16384, wave, lane);
        }
        const LAS unsigned char* a = lds + (kt & 1) * GBUF; const LAS unsigned char* b = a + 16384;
#pragma unroll
        for (int ks = 0; ks < 2; ++ks) {
            bf16x8 af[4], bfr[4];
#pragma unroll
            for (int i = 0; i < 4; ++i) { af[i] = ldfrag(a, wm * 64 + i * 16 + l15, ks * 4 + g); bfr[i] = ldfrag(b, wn * 64 + i * 16 + l15, ks * 4 + g); }
#pragma unroll
            for (int i = 0; i < 4; ++i)
#pragma unroll
                for (int j = 0; j < 4; ++j)
                    acc[i][j] = SWAP ? __builtin_amdgcn_mfma_f32_16x16x32_bf16(af[i], bfr[j], acc[i][j], 0, 0, 0)
                                     : __builtin_amdgcn_mfma_f32_16x16x32_bf16(bfr[j], af[i], acc[i][j], 0, 0, 0);
        }
    }
}
__device__ __forceinline__ int vcu_of_block() { const int G = gridDim.x, bx = blockIdx.x; return (G % 8 == 0) ? (bx % 8) * (G / 8) + bx / 8 : bx; }

namespace pg8 {
#define PG8_LAS __attribute__((address_space(3)))
typedef unsigned short bf16_t;
typedef short bf16x8 __attribute__((ext_vector_type(8)));
typedef float f32x4 __attribute__((ext_vector_type(4)));
typedef unsigned u32x4 __attribute__((ext_vector_type(4)));
constexpr int BM = 256, BK = 64, HALF = 128, HTB = HALF * BK * 2  , STAGE_BYTES = 8 * HTB, NXCD = 8, WGM = 8;

__host__ __device__ __forceinline__ int lds_byte(int r, int c) { const int st = (r >> 4) * 2 + (c >> 5), rr = r & 15, cc = c & 31, ob = rr * 64 + cc * 2; return st * 1024 + (ob ^ (((ob >> 9) & 1) << 5)); }
__host__ __device__ __forceinline__ void stage_rc(int b, int& R, int& C) { const int st = b / 1024, sb = b % 1024, swz = sb ^ (((sb >> 9) & 1) << 5); R = (st >> 1) * 16 + swz / 64; C = (st & 1) * 32 + (swz % 64) / 2; }
__host__ __device__ __forceinline__ int perm32(int rho) { const int n = rho >> 4, i = rho & 15; return 8 * (i >> 2) + 4 * n + (i & 3); }

struct Unit { int pm, pn; };
struct Gemm { const bf16_t* A; const bf16_t* Bt; int M, N, K; };

struct StaticOrder {
    int nM, nN, nwg, G, c;
    __host__ __device__ void init(int M, int N, int G_, int c_) { nM = M / BM; nN = N / BM; nwg = nM * nN; G = G_; c = c_; }
    __host__ __device__ bool next(int i, Unit& u) const {
        const long L = (long)i * G + c; if (L >= nwg) return false;
        int wgid = (int)L; { const int q = nwg / NXCD, r = nwg % NXCD, xcd = wgid % NXCD, off = wgid / NXCD; wgid = (xcd < r ? xcd * (q + 1) : r * (q + 1) + (xcd - r) * q) + off; }
        const int nig = WGM * nN, gid = wgid / nig, fm = gid * WGM, gsz = (nM - fm) < WGM ? (nM - fm) : WGM;
        u.pm = fm + ((wgid % nig) % gsz); u.pn = (wgid % nig) / gsz; return true;
    }
    __device__ __forceinline__ void a_ready(const Unit&) const {}
    __device__ __forceinline__ void done(const Unit&) const {}
};

struct EpiP1 {
    static constexpr bool PERM = true, AFTER_DRAIN = false, SWAPPABLE = true;
    P1Ptrs p;
    static __device__ __forceinline__ bool swap_unit(const Unit& u) { return u.pn == 4 || u.pn == 5 || u.pn == 8 || u.pn == 9; }
    __device__ __forceinline__ void operator()(const f32x4 (&acc)[2][2][4][2], const Unit& u, int wr, int wc, int fr, int fq) const {
        if (swap_unit(u)) {
            const int cb = u.pn * BM, nbase = cb < 1536 ? cb - 1024 : cb - 2048;
            bf16_t* T = (bf16_t*)(p.ws + (cb < 1536 ? OFF_VT : OFF_GVT)) + (size_t)(nbase + wc * 32 + 8 * (fr >> 2) + (fr & 3)) * MROWS + u.pm * BM + wr * 64 + 4 * fq;
#pragma unroll
            for (int bj = 0; bj < 2; ++bj)
#pragma unroll
                for (int n = 0; n < 2; ++n)
#pragma unroll
                    for (int ai = 0; ai < 2; ++ai)
#pragma unroll
                        for (int m = 0; m < 4; ++m) { const f32x4 v = acc[ai][bj][m][n];
                            *(u32x2*)(T + (size_t)(bj * HALF + n * 4) * MROWS + ai * HALF + m * 16) = (u32x2){pk2(v.x, v.y), pk2(v.z, v.w)}; }
            return;
        }
#pragma unroll
        for (int bj = 0; bj < 2; ++bj) {
            const int nw = u.pn * BM + bj * HALF + wc * 32;
            const int rowb = u.pm * BM + wr * 64 + fr;
            if (nw >= 3072) {
                const int dir = (nw - 3072) >> 8, j0 = ((nw - 3072) & 255) + 8 * fq;
                float* G = (float*)(p.ws + (dir ? OFF_GB : OFF_GF)); const float* bias = dir ? p.bias_b : p.bias_f;
                const f32x4 b0 = *(const f32x4*)(bias + j0), b1 = *(const f32x4*)(bias + j0 + 4);
#pragma unroll
                for (int ai = 0; ai < 2; ++ai)
#pragma unroll
                    for (int m = 0; m < 4; ++m) { const f32x4 v0 = acc[ai][bj][m][0], v1 = acc[ai][bj][m][1]; f32x4 o0, o1;
                        o0.x = logsig_f(v0.x + b0.x) * 0.0625f; o0.y = logsig_f(v0.y + b0.y) * 0.0625f; o0.z = logsig_f(v0.z + b0.z) * 0.0625f; o0.w = logsig_f(v0.w + b0.w) * 0.0625f;
                        o1.x = logsig_f(v1.x + b1.x) * 0.0625f; o1.y = logsig_f(v1.y + b1.y) * 0.0625f; o1.z = logsig_f(v1.z + b1.z) * 0.0625f; o1.w = logsig_f(v1.w + b1.w) * 0.0625f;
                        float* gp = G + (size_t)(rowb + ai * HALF + m * 16) * 256 + j0; *(f32x4*)gp = o0; *(f32x4*)(gp + 4) = o1; }
            } else {
                bf16_t* base; int ld, c0; float sc = 1.f; bool silu = false;
                if (nw < 512) { base = (bf16_t*)(p.ws + OFF_QB); ld = 512; c0 = nw; sc = QSCALE; }
                else if (nw < 1024) { base = (bf16_t*)(p.ws + OFF_KB); ld = 512; c0 = nw - 512; }
                else if (nw < 1792) { base = (bf16_t*)(p.ws + OFF_GQ); ld = 256; c0 = nw - 1536; sc = 0.125f; }
                else if (nw < 2048) { base = (bf16_t*)(p.ws + OFF_GK); ld = 256; c0 = nw - 1792; }
                else { base = (bf16_t*)(p.ws + OFF_GR); ld = 512; c0 = nw - 2560; silu = true; }
                const bool rope = nw < 1024 && (nw & 63) == 0 && fq < 2;
#pragma unroll
                for (int ai = 0; ai < 2; ++ai)
#pragma unroll
                    for (int m = 0; m < 4; ++m) {
                        const int row = rowb + ai * HALF + m * 16;
                        f32x4 v0 = acc[ai][bj][m][0], v1 = acc[ai][bj][m][1];
                        if (rope) {
                            const int pos = row < NTOK ? NMETA + (row & (SEQ - 1)) : (row - NTOK < TPOS ? row - NTOK : 0);
                            const f32x4* cp = (const f32x4*)((const float*)(p.ws + OFF_ROPE) + ((size_t)pos * 8 + 4 * fq) * 2);
                            const f32x4 ca = cp[0], cb2 = cp[1];
                            v0 = (f32x4){v0.x * ca.x - v0.y * ca.y, v0.y * ca.x + v0.x * ca.y, v0.z * ca.z - v0.w * ca.w, v0.w * ca.z + v0.z * ca.w};
                            v1 = (f32x4){v1.x * cb2.x - v1.y * cb2.y, v1.y * cb2.x + v1.x * cb2.y, v1.z * cb2.z - v1.w * cb2.w, v1.w * cb2.z + v1.z * cb2.w};
                        }
                        if (silu) { v0 = (f32x4){silu_f(v0.x), silu_f(v0.y), silu_f(v0.z), silu_f(v0.w)}; v1 = (f32x4){silu_f(v1.x), silu_f(v1.y), silu_f(v1.z), silu_f(v1.w)}; }
                        else { v0 = v0 * sc; v1 = v1 * sc; }
                        *(u32x4*)(base + (size_t)row * ld + c0 + 8 * fq) = (u32x4){pk2(v0.x, v0.y), pk2(v0.z, v0.w), pk2(v1.x, v1.y), pk2(v1.z, v1.w)};
                    }
            }
        }
    }
};
struct EpiP3 {
    static constexpr bool PERM = true, AFTER_DRAIN = false, SWAPPABLE = false;
    const float* x; float* out; bf16_t* h2b; float* ssq;
    __device__ __forceinline__ void operator()(const f32x4 (&acc)[2][2][4][2], const Unit& u, int wr, int wc, int fr, int fq) const {
#pragma unroll
        for (int ai = 0; ai < 2; ++ai)
#pragma unroll
            for (int m = 0; m < 4; ++m) { const int row = u.pm * BM + ai * HALF + wr * 64 + m * 16 + fr; float ss = 0.f;
#pragma unroll
                for (int bj = 0; bj < 2; ++bj) { const int col = u.pn * BM + bj * HALF + wc * 32 + 8 * fq;
                    const f32x4 h0 = *(const f32x4*)(x + (size_t)row * DM + col) + acc[ai][bj][m][0], h1 = *(const f32x4*)(x + (size_t)row * DM + col + 4) + acc[ai][bj][m][1];
                    *(u32x4*)(h2b + (size_t)row * DM + col) = (u32x4){pk2(h0.x, h0.y), pk2(h0.z, h0.w), pk2(h1.x, h1.y), pk2(h1.z, h1.w)};
                    ss += (h0.x * h0.x + h0.y * h0.y + h0.z * h0.z + h0.w * h0.w) + (h1.x * h1.x + h1.y * h1.y + h1.z * h1.z + h1.w * h1.w); }
                ss += __shfl_xor(ss, 16); ss += __shfl_xor(ss, 32);
                if (fq == 0) ssq[(size_t)row * 16 + u.pn * 4 + wc] = ss; }
    }
};

struct P1Order {
    int G, c, ncol, nM; bool vt;
    __device__ __forceinline__ bool next(int i, Unit& u) const {
        const int nwg = nM * ncol; const int L = i * G + (vt ? (G - 1 - c) : c); if (L >= nwg) return false;
        const int pm = L / ncol, j = L % ncol;
        u.pm = pm; u.pn = vt ? (j < 2 ? 4 + j : 6 + j) : (j < 4 ? j : (j < 6 ? j + 2 : j + 4));
        return true;
    }
    __device__ __forceinline__ void a_ready(const Unit&) const {}
    __device__ __forceinline__ void done(const Unit&) const {}
};
struct OneUnit {
    Unit u; bool valid;
    __device__ __forceinline__ bool next(int i, Unit& o) const { if (i != 0 || !valid) return false; o = u; return true; }
    __device__ __forceinline__ void a_ready(const Unit&) const {}
    __device__ __forceinline__ void done(const Unit&) const {}
};

template <class Epi, class Sched, bool ALIGN_EPI = false, bool SP2 = false, bool SWP = false>
__device__ __forceinline__ void gemm_phase(PG8_LAS unsigned char* lds, const Gemm g, const Sched& S, const Epi& E) {
    int tid_ = threadIdx.x; asm volatile("" : "+v"(tid_));
    const int tid = tid_, wid = __builtin_amdgcn_readfirstlane(tid >> 6), lane = tid & 63, wr = wid >> 2, wc = wid & 3, fr = lane & 15, fq = lane >> 4;
    const int K = g.K, nt = K / BK;
    unsigned voffA[2], voffB[2];
#pragma unroll
    for (int i = 0; i < 2; ++i) { int R, C; stage_rc(tid * 16 + i * 8192, R, C); const int Rb = Epi::PERM ? ((R & ~31) + perm32(R & 31)) : R;
        voffA[i] = (unsigned)(R * K + C) * 2u; voffB[i] = (unsigned)(Rb * K + C) * 2u; }
    const size_t kstep = (size_t)(BK * 2);
    const size_t hstep = (size_t)HALF * K * 2;
    const size_t tstep = 2 * hstep;
    const unsigned ldsw = (unsigned)wid * 1024u;
    const int aoff = lds_byte(wr * 64 + fr, fq * 8), boff = lds_byte(wc * 32 + fr, fq * 8);
#define PG8_SA(b, h) (((b) * 2 + (h)) * HTB)
#define PG8_SB(b, h) ((4 + (b) * 2 + (h)) * HTB)
#define PG8_STAGE(bufoff, gbase, voff) do { _Pragma("unroll") for (int _i = 0; _i < 2; ++_i) \
        __builtin_amdgcn_global_load_lds((const unsigned*)((const char*)(gbase) + (voff)[_i]), (PG8_LAS unsigned*)(lds + (bufoff) + ldsw + _i * 8192), 16, 0, 0); } while (0)
#define PG8_LDA(dst, b, h) do { _Pragma("unroll") for (int m = 0; m < 4; ++m) _Pragma("unroll") for (int k = 0; k < 2; ++k) dst[m][k] = *(const PG8_LAS bf16x8*)(lds + PG8_SA(b, h) + aoff + m * 2048 + k * 1024); } while (0)
#define PG8_LDB(dst, b, h) do { _Pragma("unroll") for (int n = 0; n < 2; ++n) _Pragma("unroll") for (int k = 0; k < 2; ++k) dst[n][k] = *(const PG8_LAS bf16x8*)(lds + PG8_SB(b, h) + boff + n * 2048 + k * 1024); } while (0)
#define PG8_MMA(ai, bj, At, Bt) do { __builtin_amdgcn_s_setprio(1); \
        if (SWP) { _Pragma("unroll") for (int m = 0; m < 4; ++m) _Pragma("unroll") for (int n = 0; n < 2; ++n) _Pragma("unroll") for (int k = 0; k < 2; ++k) \
            acc[ai][bj][m][n] = __builtin_amdgcn_mfma_f32_16x16x32_bf16(At[m][k], Bt[n][k], acc[ai][bj][m][n], 0, 0, 0); } \
        else { _Pragma("unroll") for (int m = 0; m < 4; ++m) _Pragma("unroll") for (int n = 0; n < 2; ++n) _Pragma("unroll") for (int k = 0; k < 2; ++k) \
            acc[ai][bj][m][n] = __builtin_amdgcn_mfma_f32_16x16x32_bf16(Bt[n][k], At[m][k], acc[ai][bj][m][n], 0, 0, 0); } \
        __builtin_amdgcn_s_setprio(0); } while (0)
#define PG8_WAIT_V(n) asm volatile("s_waitcnt vmcnt(" #n ")" ::: "memory")
#define PG8_WAIT_L(n) asm volatile("s_waitcnt lgkmcnt(" #n ")" ::: "memory")
#define PG8_BAR __builtin_amdgcn_s_barrier()
#define PG8_SCHED __builtin_amdgcn_sched_barrier(0)
    Unit cur, nxt; int ui = 0;
    if (!S.next(0, cur)) return;
    f32x4 acc[2][2][4][2];
#pragma unroll
    for (int a = 0; a < 2; ++a)
#pragma unroll
        for (int b = 0; b < 2; ++b)
#pragma unroll
            for (int m = 0; m < 4; ++m)
#pragma unroll
                for (int n = 0; n < 2; ++n) acc[a][b][m][n] = (f32x4){0.f, 0.f, 0.f, 0.f};
    bf16x8 At[4][2], B0[2][2], B1[2][2];
    const char* cA = (const char*)g.A + (size_t)cur.pm * tstep; const char* cB = (const char*)g.Bt + (size_t)cur.pn * tstep;
    S.a_ready(cur);
    if constexpr (SP2) {
        PG8_STAGE(PG8_SB(0, 0), cB, voffB); PG8_STAGE(PG8_SB(0, 1), cB + hstep, voffB); PG8_STAGE(PG8_SA(0, 0), cA, voffA); PG8_STAGE(PG8_SA(0, 1), cA + hstep, voffA);
        if (wr == 1) PG8_BAR;
        PG8_WAIT_V(2); PG8_BAR;
        PG8_STAGE(PG8_SB(1, 0), cB + kstep, voffB); PG8_STAGE(PG8_SA(1, 0), cA + kstep, voffA); PG8_STAGE(PG8_SB(1, 1), cB + hstep + kstep, voffB);
        PG8_WAIT_V(6); PG8_BAR;
    } else {
        PG8_STAGE(PG8_SB(0, 0), cB, voffB); PG8_STAGE(PG8_SA(0, 0), cA, voffA); PG8_STAGE(PG8_SB(0, 1), cB + hstep, voffB); PG8_STAGE(PG8_SA(0, 1), cA + hstep, voffA);
        if (wr == 1) PG8_BAR;
        PG8_WAIT_V(4); PG8_BAR;
        PG8_STAGE(PG8_SB(1, 0), cB + kstep, voffB); PG8_STAGE(PG8_SA(1, 0), cA + kstep, voffA); PG8_STAGE(PG8_SB(1, 1), cB + hstep + kstep, voffB);
        PG8_WAIT_V(6); PG8_BAR;
    }
    for (;;) {
        const bool has_next = S.next(ui + 1, nxt);
        const char* nA = has_next ? (const char*)g.A + (size_t)nxt.pm * tstep : cA; const char* nB = has_next ? (const char*)g.Bt + (size_t)nxt.pn * tstep : cB;
        for (int t = 0; t < nt; t += 2) {
            const bool last = (t == nt - 2);
            const char* a1 = cA + (size_t)(t + 1) * kstep;
            const char* a2 = last ? nA : cA + (size_t)(t + 2) * kstep; const char* b2 = last ? nB : cB + (size_t)(t + 2) * kstep;
            const char* a3 = a2 + kstep; const char* b3 = b2 + kstep;
            if (last && has_next) S.a_ready(nxt);
            if constexpr (SP2) {
            PG8_LDB(B0, 0, 0); PG8_LDB(B1, 0, 1); PG8_SCHED; PG8_LDA(At, 0, 0); PG8_STAGE(PG8_SA(1, 1), a1 + hstep, voffA);
            PG8_WAIT_V(8); PG8_WAIT_L(0); PG8_BAR; PG8_MMA(0, 0, At, B0); PG8_MMA(0, 1, At, B1); PG8_BAR; PG8_SCHED;
            PG8_LDA(At, 0, 1); PG8_STAGE(PG8_SB(0, 0), b2, voffB); PG8_STAGE(PG8_SB(0, 1), b2 + hstep, voffB); PG8_STAGE(PG8_SA(0, 0), a2, voffA);
            PG8_WAIT_V(8); PG8_WAIT_L(0); PG8_BAR; PG8_MMA(1, 0, At, B0); PG8_MMA(1, 1, At, B1); PG8_BAR; PG8_SCHED;
            PG8_LDB(B0, 1, 0); PG8_LDB(B1, 1, 1); PG8_SCHED; PG8_LDA(At, 1, 0); PG8_STAGE(PG8_SA(0, 1), a2 + hstep, voffA);
            PG8_WAIT_V(8); PG8_WAIT_L(0); PG8_BAR; PG8_MMA(0, 0, At, B0); PG8_MMA(0, 1, At, B1); PG8_BAR; PG8_SCHED;
            PG8_LDA(At, 1, 1); PG8_STAGE(PG8_SB(1, 0), b3, voffB); PG8_STAGE(PG8_SB(1, 1), b3 + hstep, voffB); PG8_STAGE(PG8_SA(1, 0), a3, voffA);
            PG8_WAIT_V(8); PG8_WAIT_L(0); PG8_BAR; PG8_MMA(1, 0, At, B0); PG8_MMA(1, 1, At, B1); PG8_BAR; PG8_SCHED;
            } else {
            PG8_LDB(B0, 0, 0); PG8_SCHED; PG8_LDA(At, 0, 0); PG8_STAGE(PG8_SA(1, 1), a1 + hstep, voffA);
            PG8_WAIT_L(8); PG8_BAR; PG8_WAIT_L(0); PG8_MMA(0, 0, At, B0); PG8_BAR; PG8_SCHED;
            PG8_LDB(B1, 0, 1); PG8_STAGE(PG8_SB(0, 0), b2, voffB);
            PG8_BAR; PG8_WAIT_L(0); PG8_MMA(0, 1, At, B1); PG8_BAR;
            PG8_LDA(At, 0, 1); PG8_STAGE(PG8_SA(0, 0), a2, voffA);
            PG8_BAR; PG8_WAIT_L(0); PG8_MMA(1, 0, At, B0); PG8_BAR; PG8_SCHED;
            PG8_STAGE(PG8_SB(0, 1), b2 + hstep, voffB);
            PG8_WAIT_V(6); PG8_BAR; PG8_MMA(1, 1, At, B1); PG8_BAR;
            PG8_LDB(B0, 1, 0); PG8_SCHED; PG8_LDA(At, 1, 0); PG8_STAGE(PG8_SA(0, 1), a2 + hstep, voffA);
            PG8_WAIT_L(8); PG8_BAR; PG8_WAIT_L(0); PG8_MMA(0, 0, At, B0); PG8_BAR; PG8_SCHED;
            PG8_LDB(B1, 1, 1); PG8_STAGE(PG8_SB(1, 0), b3, voffB);
            PG8_BAR; PG8_WAIT_L(0); PG8_MMA(0, 1, At, B1); PG8_BAR;
            PG8_LDA(At, 1, 1); PG8_STAGE(PG8_SA(1, 0), a3, voffA);
            PG8_BAR; PG8_WAIT_L(0); PG8_MMA(1, 0, At, B0); PG8_BAR; PG8_SCHED;
            PG8_STAGE(PG8_SB(1, 1), b3 + hstep, voffB);
            PG8_WAIT_V(6); PG8_BAR; PG8_MMA(1, 1, At, B1); PG8_BAR;
            }
        }
        if constexpr (ALIGN_EPI) { if (wr == 0) PG8_BAR; }
        if constexpr (!Epi::AFTER_DRAIN) { E(acc, cur, wr, wc, fr, fq); S.done(cur); }
        if (!has_next) break;
#pragma unroll
        for (int a = 0; a < 2; ++a)
#pragma unroll
            for (int b = 0; b < 2; ++b)
#pragma unroll
                for (int m = 0; m < 4; ++m)
#pragma unroll
                    for (int n = 0; n < 2; ++n) acc[a][b][m][n] = (f32x4){0.f, 0.f, 0.f, 0.f};
        cur = nxt; cA = nA; cB = nB; ++ui;
        if constexpr (ALIGN_EPI) { if (wr == 1) PG8_BAR; }
    }
    PG8_WAIT_V(0);
    if constexpr (!ALIGN_EPI) { if (wr == 0) PG8_BAR; }
    PG8_BAR;
    if constexpr (Epi::AFTER_DRAIN) { E.fused(acc, cur, wr, wc, fr, fq, lds, wid, lane); S.done(cur); }
#undef PG8_SA
#undef PG8_SB
#undef PG8_STAGE
#undef PG8_LDA
#undef PG8_LDB
#undef PG8_MMA
#undef PG8_WAIT_V
#undef PG8_WAIT_L
#undef PG8_BAR
#undef PG8_SCHED
}
}
__device__ __forceinline__ float row_rstd(const float* ssq, int row) {
    const f32x4* q = (const f32x4*)(ssq + (size_t)row * 16);
    const f32x4 a = q[0], b = q[1], c = q[2], d = q[3];
    return rsqrtf(((((a.x + a.y) + (a.z + a.w)) + ((b.x + b.y) + (b.z + b.w))) + (((c.x + c.y) + (c.z + c.w)) + ((d.x + d.y) + (d.z + d.w)))) * (1.f / DM) + EPS);
}
__device__ __forceinline__ void phase1_mfma(const Params& p, LAS unsigned char* lds) {
    pg8::Gemm g{(const pg8::bf16_t*)(p.ws + OFF_XN), (const pg8::bf16_t*)(p.ws + OFF_WIN), MROWS, NIN, DM};
    pg8::EpiP1 E{P1Ptrs{p.ws, p.in[10], p.in[12]}};
    const int vcu = vcu_of_block();
    pg8::P1Order S0{(int)gridDim.x, vcu, 10, MROWS / 256, false}, S1{(int)gridDim.x, vcu, 4, MROWS / 256, true};
    pg8::gemm_phase<pg8::EpiP1, pg8::P1Order, true, true, false>(lds, g, S0, E);
    pg8::gemm_phase<pg8::EpiP1, pg8::P1Order, true, true, true>(lds, g, S1, E);
    const int G = (int)gridDim.x, nun = MROWS / 256;
    const int mine = (10 * nun - vcu + G - 1) / G + (4 * nun - (G - 1 - vcu) + G - 1) / G, most = (10 * nun + G - 1) / G + 1;
    if (mine < most) {
        unsigned* ctr = (unsigned*)(p.ws + OFF_CTL) + 128;
        for (int k = 0; k < 3; ++k) {
            __syncthreads();
            if (threadIdx.x == 0) *(LAS unsigned*)(lds + LDS_Q) = atomicAdd(ctr, 1u);
            __syncthreads();
            const int c = (int)*(LAS unsigned*)(lds + LDS_Q);
            if (c >= CV_ITEMS) break;
            conv_item(p, (unsigned char*)lds, c);
        }
    }
}
__device__ __forceinline__ void phase3_mfma(const Params& p, LAS unsigned char* lds) {
    pg8::Gemm g{(const pg8::bf16_t*)(p.ws + OFF_MIX), (const pg8::bf16_t*)(p.ws + OFF_WOUT), NTOK, DM, DM};
    pg8::StaticOrder S; S.init(NTOK, DM, (int)gridDim.x, (int)blockIdx.x);
    pg8::EpiP3 E{p.in[0], p.out, (bf16_t*)(p.ws + OFF_H2B), (float*)(p.ws + OFF_SSQP)};
    pg8::gemm_phase<pg8::EpiP3, pg8::StaticOrder, true, true>(lds, g, S, E);
}

typedef float f32x16 __attribute__((ext_vector_type(16)));
constexpr int AT_KROW = 272, AT_VROW = 144, AT_KBYTES = 64 * AT_KROW, AT_VBYTES = 128 * AT_VROW, AT_STAGE = AT_KBYTES + AT_VBYTES;
__device__ __forceinline__ void attn_item(const Params& p, LAS unsigned char* lds, int item) {
    const int tid = threadIdx.x, lane = tid & 63, wave = __builtin_amdgcn_readfirstlane(tid >> 6), qg = wave >> 1, c = wave & 1, l31 = lane & 31, hh = lane >> 5;
    const int qt = item & 15, h = (item >> 4) & 3, b = item >> 6;
    const int r0 = b * SEQ + qt * 128;
    const bf16_t* QB = (const bf16_t*)(p.ws + OFF_QB); const bf16_t* KB = (const bf16_t*)(p.ws + OFF_KB); const bf16_t* VT = (const bf16_t*)(p.ws + OFF_VT);
    bf16x8 qf[4];
    {
        const bf16_t* qp = QB + (size_t)(r0 + qg * 32 + l31) * 512 + h * 128 + c * 64 + 8 * hh;
#pragma unroll
        for (int s = 0; s < 4; ++s) qf[s] = *(const bf16x8*)(qp + 16 * s);
    }
    f32x16 O[4];
#pragma unroll
    for (int i = 0; i < 4; ++i)
#pragma unroll
        for (int r = 0; r < 16; ++r) O[i][r] = 0.f;
    float m = 0.f, l = 0.f;
    const int kq0 = tid, kq1 = tid + 512;
    const bf16_t* kg0 = KB + (size_t)(kq0 >> 4) * 512 + h * 128 + (kq0 & 15) * 8; const bf16_t* kg1 = KB + (size_t)(kq1 >> 4) * 512 + h * 128 + (kq1 & 15) * 8;
    const bf16_t* vg0 = VT + (size_t)(h * 128 + (kq0 >> 3)) * MROWS + (kq0 & 7) * 8; const bf16_t* vg1 = VT + (size_t)(h * 128 + (kq1 >> 3)) * MROWS + (kq1 & 7) * 8;
    const int kl0 = (kq0 >> 4) * AT_KROW + (kq0 & 15) * 16, kl1 = (kq1 >> 4) * AT_KROW + (kq1 & 15) * 16;
    const int vl0 = AT_KBYTES + (kq0 >> 3) * AT_VROW + ((kq0 & 7) >> 1) * 32 + (kq0 & 1) * 8, vl1 = AT_KBYTES + (kq1 >> 3) * AT_VROW + ((kq1 & 7) >> 1) * 32 + (kq1 & 1) * 8;
    u32x4 kr0, kr1, vr0, vr1;
#define AT_LOAD(t) do { const size_t kro = (size_t)((t) < 32 ? b * SEQ + (t) * 64 : NTOK); \
        kr0 = *(const u32x4*)(kg0 + kro * 512); kr1 = *(const u32x4*)(kg1 + kro * 512); vr0 = *(const u32x4*)(vg0 + kro); vr1 = *(const u32x4*)(vg1 + kro); } while (0)
#define AT_WRITE(buf) do { LAS unsigned char* _b = lds + (buf) * AT_STAGE; \
        *(LAS u32x4*)(_b + kl0) = kr0; *(LAS u32x4*)(_b + kl1) = kr1; \
        *(LAS u32x2*)(_b + vl0) = (u32x2){vr0.x, vr0.y}; *(LAS u32x2*)(_b + vl0 + 16) = (u32x2){vr0.z, vr0.w}; \
        *(LAS u32x2*)(_b + vl1) = (u32x2){vr1.x, vr1.y}; *(LAS u32x2*)(_b + vl1 + 16) = (u32x2){vr1.z, vr1.w}; } while (0)
    __syncthreads();
    AT_LOAD(0); AT_WRITE(0); AT_LOAD(1); AT_WRITE(1);
    __syncthreads();
    int scur = 0;
    for (int t = 0; t < 33; ++t) {
        const int snxt2 = scur == 0 ? 2 : scur - 1;
        if (t + 2 < 33) AT_LOAD(t + 2);
        const LAS unsigned char* kb_ = lds + scur * AT_STAGE; const LAS unsigned char* vb_ = kb_ + AT_KBYTES;
        f32x16 s0, s1;
#pragma unroll
        for (int r = 0; r < 16; ++r) { s0[r] = -m; s1[r] = -m; }
#pragma unroll
        for (int s = 0; s < 4; ++s) {
            const bf16x8 k0 = *(const LAS bf16x8*)(kb_ + l31 * AT_KROW + (c * 64 + 16 * s + 8 * hh) * 2);
            s0 = __builtin_amdgcn_mfma_f32_32x32x16_bf16(k0, qf[s], s0, 0, 0, 0);
        }
#pragma unroll
        for (int s = 0; s < 4; ++s) {
            const bf16x8 k1 = *(const LAS bf16x8*)(kb_ + (32 + l31) * AT_KROW + (c * 64 + 16 * s + 8 * hh) * 2);
            s1 = __builtin_amdgcn_mfma_f32_32x32x16_bf16(k1, qf[s], s1, 0, 0, 0);
        }
        if (t == 32) {
#pragma unroll
            for (int r = 0; r < 16; ++r) { const int key = (r & 3) + 8 * (r >> 2) + 4 * hh; if (key >= 16) s0[r] = -1e30f; s1[r] = -1e30f; }
        }
        float mx = s0[0];
#pragma unroll
        for (int r = 1; r < 16; ++r) mx = fmaxf(mx, s0[r]);
#pragma unroll
        for (int r = 0; r < 16; ++r) mx = fmaxf(mx, s1[r]);
        { const u32x2 sw_ = __builtin_amdgcn_permlane32_swap(__float_as_uint(mx), __float_as_uint(mx), false, false); mx = fmaxf(__uint_as_float(sw_.x), __uint_as_float(sw_.y)); }
        if (t == 0 || __any(mx > 8.0f)) {
            const float d = t == 0 ? mx : fmaxf(mx, 0.f), alpha = __builtin_amdgcn_exp2f(-d);
            m += d; l *= alpha;
#pragma unroll
            for (int i = 0; i < 4; ++i) O[i] = O[i] * alpha;
#pragma unroll
            for (int r = 0; r < 16; ++r) { s0[r] -= d; s1[r] -= d; }
        }
        float ps = 0.f;
#define AT_PV(SREG, kb) do { \
        _Pragma("unroll") for (int r = 0; r < 16; ++r) { SREG[r] = __builtin_amdgcn_exp2f(SREG[r]); ps += SREG[r]; } \
        bf16x8 pf0, pf1; \
        { u32x4 a; a.x = pk2(SREG[0], SREG[1]); a.y = pk2(SREG[2], SREG[3]); a.z = pk2(SREG[4], SREG[5]); a.w = pk2(SREG[6], SREG[7]); pf0 = __builtin_bit_cast(bf16x8, a); \
          u32x4 bq; bq.x = pk2(SREG[8], SREG[9]); bq.y = pk2(SREG[10], SREG[11]); bq.z = pk2(SREG[12], SREG[13]); bq.w = pk2(SREG[14], SREG[15]); pf1 = __builtin_bit_cast(bf16x8, bq); } \
        _Pragma("unroll") for (int vb = 0; vb < 4; ++vb) { \
            const LAS unsigned char* vp = vb_ + (vb * 32 + l31) * AT_VROW + (kb) * 64 + hh * 16; \
            O[vb] = __builtin_amdgcn_mfma_f32_32x32x16_bf16(*(const LAS bf16x8*)vp, pf0, O[vb], 0, 0, 0); \
            O[vb] = __builtin_amdgcn_mfma_f32_32x32x16_bf16(*(const LAS bf16x8*)(vp + 32), pf1, O[vb], 0, 0, 0); } } while (0)
        AT_PV(s0, 0);
        AT_PV(s1, 1);
#undef AT_PV
        l += ps;
        if (t + 2 < 33) AT_WRITE(snxt2);
        __syncthreads();
        scur = scur == 2 ? 0 : scur + 1;
    }
    const float inv = 1.f / (l + __shfl_xor(l, 32));
    LAS float* X = (LAS float*)lds + qg * 4096;
    if (c == 1) {
#pragma unroll
        for (int vb = 0; vb < 4; ++vb)
#pragma unroll
            for (int r = 0; r < 16; ++r) X[(vb * 16 + r) * 64 + lane] = O[vb][r] * inv;
    }
    __syncthreads();
    if (c == 0) {
        const float lam = ((const float*)(p.ws + OFF_MISC))[0];
        float ss = 0.f;
#pragma unroll
        for (int vb = 0; vb < 4; ++vb)
#pragma unroll
            for (int r = 0; r < 16; ++r) { const float y = O[vb][r] * inv - lam * X[(vb * 16 + r) * 64 + lane]; O[vb][r] = y; ss += y * y; }
        ss += __shfl_xor(ss, 32);
        const float rs = rsqrtf(ss * (1.f / 128.f) + EPS) * 0.8f;
        bf16_t* orow = (bf16_t*)(p.ws + OFF_MIX) + (size_t)(r0 + qg * 32 + l31) * DM + h * 128;
#pragma unroll
        for (int vb = 0; vb < 4; ++vb)
#pragma unroll
            for (int rq = 0; rq < 4; ++rq) {
                const int v0 = vb * 32 + 8 * rq + 4 * hh;
                const f32x4 wlo = *(const f32x4*)(p.in[8] + vb * 32 + 8 * rq), whi = *(const f32x4*)(p.in[8] + vb * 32 + 8 * rq + 4);
                const f32x4 w = hh ? whi : wlo;
                u32x2 o; o.x = pk2(O[vb][4 * rq] * rs * w.x, O[vb][4 * rq + 1] * rs * w.y); o.y = pk2(O[vb][4 * rq + 2] * rs * w.z, O[vb][4 * rq + 3] * rs * w.w);
                *(u32x2*)(orow + v0) = o;
            }
    }
#undef AT_LOAD
#undef AT_WRITE
}
__device__ __forceinline__ void phase2_attn_mfma(const Params& p, LAS unsigned char* lds) {
    for (int it = vcu_of_block(); it < NB * 4 * 16; it += gridDim.x) attn_item(p, lds, it);
}


__device__ __forceinline__ int gsw(int row, int chunk) { return row * 128 + ((chunk ^ (row & 7)) << 4); }
constexpr int GL_SET = 40960;
constexpr int GL_QS = 0, GL_KS = 8192, GL_KT = 16384, GL_VT = 24576, GL_AT = 2 * GL_SET, GL_ST = GL_AT + 8192  , GL_DV = GL_ST + 32768  ;
__device__ __forceinline__ float dpp_scan64(float v) {
    v += __builtin_bit_cast(float, __builtin_amdgcn_update_dpp(0, __builtin_bit_cast(int, v), 0x111, 0xf, 0xf, false));
    v += __builtin_bit_cast(float, __builtin_amdgcn_update_dpp(0, __builtin_bit_cast(int, v), 0x112, 0xf, 0xf, false));
    v += __builtin_bit_cast(float, __builtin_amdgcn_update_dpp(0, __builtin_bit_cast(int, v), 0x114, 0xf, 0xf, false));
    v += __builtin_bit_cast(float, __builtin_amdgcn_update_dpp(0, __builtin_bit_cast(int, v), 0x118, 0xf, 0xf, false));
    v += __builtin_bit_cast(float, __builtin_amdgcn_update_dpp(0, __builtin_bit_cast(int, v), 0x142, 0xa, 0xf, false));
    v += __builtin_bit_cast(float, __builtin_amdgcn_update_dpp(0, __builtin_bit_cast(int, v), 0x143, 0xc, 0xf, false));
    return v;
}
#define DPP_STAGE8(CTRL, RM) _Pragma("unroll") for (int e = 0; e < 8; ++e) v[e] += __builtin_bit_cast(float, __builtin_amdgcn_update_dpp(0, __builtin_bit_cast(int, v[e]), CTRL, RM, 0xf, false))
__device__ __forceinline__ void dpp_scan64x8(float (&v)[8]) {
    DPP_STAGE8(0x111, 0xf); DPP_STAGE8(0x112, 0xf); DPP_STAGE8(0x114, 0xf); DPP_STAGE8(0x118, 0xf); DPP_STAGE8(0x142, 0xa); DPP_STAGE8(0x143, 0xc);
}
#undef DPP_STAGE8
struct GlaPre { f32x4 g0, g1; u32x4 q8, k8, v0, v1; };
struct GlaCtx { const bf16_t* GQ; const bf16_t* GK; const bf16_t* GVT; const float* G; bf16_t* O; int dir, h, b, nsteps, lane, wave, l15, g, vdv, vch; };
__device__ __forceinline__ int gla_rowbase(const GlaCtx& c, int st) { return c.dir ? c.b * SEQ + (31 - st) * 64 : (st == 0 ? NTOK : c.b * SEQ + (st - 1) * 64); }
__device__ __forceinline__ void gla_load(const GlaCtx& c, GlaPre& r, int st) {
    const int rb = gla_rowbase(c, st); const size_t row = (size_t)(rb + c.lane);
    r.g0 = *(const f32x4*)(c.G + row * 256 + c.h * 64 + 8 * c.wave); r.g1 = *(const f32x4*)(c.G + row * 256 + c.h * 64 + 8 * c.wave + 4);
    r.q8 = *(const u32x4*)(c.GQ + row * 256 + c.h * 64 + 8 * c.wave); r.k8 = *(const u32x4*)(c.GK + row * 256 + c.h * 64 + 8 * c.wave);
    r.v0 = *(const u32x4*)(c.GVT + (size_t)(c.h * 128 + c.vdv) * MROWS + rb + c.vch * 8); r.v1 = *(const u32x4*)(c.GVT + (size_t)(c.h * 128 + c.vdv) * MROWS + rb + c.vch * 8 + 8);
}
__device__ __forceinline__ void gla_step(const GlaCtx& c, LAS unsigned char* lds, GlaPre& r, f32x4 (&accS)[4], int st) {
    const int lane = c.lane, wave = c.wave, l15 = c.l15, g = c.g, dir = c.dir;
    const bool meta = (dir == 0 && st == 0);
    const int rowbase = gla_rowbase(c, st);
    LAS unsigned char* sb = lds + (st & 1) * GL_SET;
    float gg[8] = {r.g0.x, r.g0.y, r.g0.z, r.g0.w, r.g1.x, r.g1.y, r.g1.z, r.g1.w};
    if (meta && lane >= NMETA) {
#pragma unroll
        for (int e = 0; e < 8; ++e) gg[e] = 0.f;
    }
    const u32x4 q8 = r.q8, k8 = r.k8;
    float qv[8] = {bflo(q8.x), bfhi(q8.x), bflo(q8.y), bfhi(q8.y), bflo(q8.z), bfhi(q8.z), bflo(q8.w), bfhi(q8.w)};
    float kv[8] = {bflo(k8.x), bfhi(k8.x), bflo(k8.y), bfhi(k8.y), bflo(k8.z), bfhi(k8.z), bflo(k8.w), bfhi(k8.w)};
    float qn[8], kn[8], ks[8], eTv[8], Pv[8];
#pragma unroll
    for (int e = 0; e < 8; ++e) Pv[e] = gg[e];
    dpp_scan64x8(Pv);
#pragma unroll
    for (int e = 0; e < 8; ++e) {
        const float P = Pv[e];
        const float T = __builtin_bit_cast(float, __builtin_amdgcn_readlane(__builtin_bit_cast(int, P), 63));
        const float Bv = dir ? (T - P + gg[e]) : P;
        const float eb = __expf(Bv), en = __builtin_amdgcn_rcpf(eb), eT = __expf(T);
        qn[e] = qv[e] * eb; kn[e] = kv[e] * en; ks[e] = kn[e] * eT; eTv[e] = eT;
    }
    if (lane == 0) {
        *(LAS f32x4*)(lds + GL_DV + (st & 1) * 256 + 8 * wave * 4) = (f32x4){eTv[0], eTv[1], eTv[2], eTv[3]};
        *(LAS f32x4*)(lds + GL_DV + (st & 1) * 256 + 8 * wave * 4 + 16) = (f32x4){eTv[4], eTv[5], eTv[6], eTv[7]};
    }
    *(LAS u32x4*)(sb + GL_QS + gsw(lane, wave)) = (u32x4){pk2(qn[0], qn[1]), pk2(qn[2], qn[3]), pk2(qn[4], qn[5]), pk2(qn[6], qn[7])};
    *(LAS u32x4*)(sb + GL_KS + gsw(lane, wave)) = (u32x4){pk2(kn[0], kn[1]), pk2(kn[2], kn[3]), pk2(kn[4], kn[5]), pk2(kn[6], kn[7])};
#pragma unroll
    for (int e = 0; e < 8; e += 2) { const unsigned w = pk2(ks[e], ks[e + 1]);
        *(LAS unsigned short*)(sb + GL_KT + gsw(8 * wave + e, lane >> 3) + (lane & 7) * 2) = (unsigned short)w;
        *(LAS unsigned short*)(sb + GL_KT + gsw(8 * wave + e + 1, lane >> 3) + (lane & 7) * 2) = (unsigned short)(w >> 16); }
    *(LAS u32x4*)(sb + GL_VT + gsw(c.vdv, c.vch)) = r.v0; *(LAS u32x4*)(sb + GL_VT + gsw(c.vdv, c.vch + 1)) = r.v1;
    if (st + 2 < c.nsteps) gla_load(c, r, st + 2);
    __syncthreads();
    const LAS unsigned char* STo = lds + GL_ST + (st & 1) * 16384; LAS unsigned char* STn = lds + GL_ST + ((st + 1) & 1) * 16384;
    if (!meta) {
        const int jb = wave >> 1;
#pragma unroll
        for (int ii = 0; ii < 2; ++ii) {
            const int ib = 2 * (wave & 1) + ii;
            f32x4 a = (f32x4){0.f, 0.f, 0.f, 0.f};
            const bool live = dir ? (jb >= ib) : (jb <= ib);
            if (live) {
#pragma unroll
                for (int ks2 = 0; ks2 < 2; ++ks2) {
                    const bf16x8 kf = *(const LAS bf16x8*)(sb + GL_KS + gsw(jb * 16 + l15, ks2 * 4 + g));
                    const bf16x8 qf = *(const LAS bf16x8*)(sb + GL_QS + gsw(ib * 16 + l15, ks2 * 4 + g));
                    a = __builtin_amdgcn_mfma_f32_16x16x32_bf16(kf, qf, a, 0, 0, 0);
                }
                const int i = ib * 16 + l15, j0 = jb * 16 + 4 * g;
#pragma unroll
                for (int rr = 0; rr < 4; ++rr) { const bool keep = dir ? (j0 + rr >= i) : (j0 + rr <= i); a[rr] = keep ? a[rr] : 0.f; }
            }
            const int i = ib * 16 + l15, j0 = jb * 16 + 4 * g;
            *(LAS u32x2*)(lds + GL_AT + gsw(i, j0 >> 3) + (j0 & 7) * 2) = (u32x2){pk2(a[0], a[1]), pk2(a[2], a[3])};
        }
    }
    if (st + 1 < c.nsteps) {
#pragma unroll
        for (int kb = 0; kb < 4; ++kb) {
            const f32x4 dvv = *(const LAS f32x4*)(lds + GL_DV + (st & 1) * 256 + (kb * 16 + 4 * g) * 4);
            f32x4 a = accS[kb] * dvv;
#pragma unroll
            for (int ks2 = 0; ks2 < 2; ++ks2) {
                const bf16x8 kf = *(const LAS bf16x8*)(sb + GL_KT + gsw(kb * 16 + l15, ks2 * 4 + g));
                const bf16x8 vf = *(const LAS bf16x8*)(sb + GL_VT + gsw(wave * 16 + l15, ks2 * 4 + g));
                a = __builtin_amdgcn_mfma_f32_16x16x32_bf16(kf, vf, a, 0, 0, 0);
            }
            accS[kb] = a;
            const int dk0 = kb * 16 + 4 * g;
            *(LAS u32x2*)(STn + gsw(wave * 16 + l15, dk0 >> 3) + (dk0 & 7) * 2) = (u32x2){pk2(a[0], a[1]), pk2(a[2], a[3])};
        }
    }
    __syncthreads();
    if (!meta) {
#pragma unroll
        for (int ib = 0; ib < 4; ++ib) {
            f32x4 a = (f32x4){0.f, 0.f, 0.f, 0.f};
#pragma unroll
            for (int ks2 = 0; ks2 < 2; ++ks2) {
                const bf16x8 vf = *(const LAS bf16x8*)(sb + GL_VT + gsw(wave * 16 + l15, ks2 * 4 + g));
                const bf16x8 af = *(const LAS bf16x8*)(lds + GL_AT + gsw(ib * 16 + l15, ks2 * 4 + g));
                a = __builtin_amdgcn_mfma_f32_16x16x32_bf16(vf, af, a, 0, 0, 0);
                const bf16x8 sf = *(const LAS bf16x8*)(STo + gsw(wave * 16 + l15, ks2 * 4 + g));
                const bf16x8 qf = *(const LAS bf16x8*)(sb + GL_QS + gsw(ib * 16 + l15, ks2 * 4 + g));
                a = __builtin_amdgcn_mfma_f32_16x16x32_bf16(sf, qf, a, 0, 0, 0);
            }
            *(u32x2*)(c.O + (size_t)(rowbase + ib * 16 + l15) * 512 + c.h * 128 + wave * 16 + 4 * g) = (u32x2){pk2(a[0], a[1]), pk2(a[2], a[3])};
        }
    }
}
__device__ __forceinline__ void gla_chain(const Params& p, LAS unsigned char* lds, int item) {
    const int tid = threadIdx.x;
    GlaCtx c;
    c.lane = tid & 63; c.wave = __builtin_amdgcn_readfirstlane(tid >> 6); c.l15 = c.lane & 15; c.g = c.lane >> 4;
    c.dir = item & 1; c.h = (item >> 1) & 3; c.b = item >> 3;
    c.GQ = (const bf16_t*)(p.ws + OFF_GQ); c.GK = (const bf16_t*)(p.ws + OFF_GK); c.GVT = (const bf16_t*)(p.ws + OFF_GVT);
    c.G = (const float*)(p.ws + (c.dir ? OFF_GB : OFF_GF));
    c.O = (bf16_t*)p.out + (c.dir ? (size_t)NTOK * 512 : 0);
    c.nsteps = c.dir ? 32 : 33; c.vdv = tid >> 2; c.vch = (tid & 3) * 2;
    f32x4 accS[4];
#pragma unroll
    for (int i = 0; i < 4; ++i) accS[i] = (f32x4){0.f, 0.f, 0.f, 0.f};
    __syncthreads();
    *(LAS u32x4*)(lds + GL_ST + tid * 32) = (u32x4){0u, 0u, 0u, 0u}; *(LAS u32x4*)(lds + GL_ST + tid * 32 + 16) = (u32x4){0u, 0u, 0u, 0u};
    GlaPre X, Y;
    gla_load(c, X, 0); gla_load(c, Y, 1);
    for (int st = 0; st < c.nsteps; st += 2) {
        gla_step(c, lds, X, accS, st);
        if (st + 1 < c.nsteps) gla_step(c, lds, Y, accS, st + 1);
    }
    asm volatile("s_waitcnt vmcnt(0)" ::: "memory");
    __syncthreads();
    if (tid == 0) {
        __builtin_amdgcn_fence(__ATOMIC_RELEASE, "agent");
        asm volatile("s_waitcnt vmcnt(0)" ::: "memory");
        __hip_atomic_fetch_add((unsigned*)(p.ws + OFF_CTL) + 4096 + (item >> 1) * 64, 1u, __ATOMIC_RELAXED, __HIP_MEMORY_SCOPE_AGENT);
    }
}
__device__ __forceinline__ void gla_combine_item(const Params& p, LAS unsigned char* lds, int item) {
    const int tid = threadIdx.x, lane = tid & 63, wave = tid >> 6;
    const int bh = item >> 3, part = item & 7, b = bh >> 2, h = bh & 3;
    if (tid == 0) {
        unsigned* flag = (unsigned*)(p.ws + OFF_CTL) + 4096 + bh * 64;
        unsigned spins = 0;
        while (__hip_atomic_load(flag, __ATOMIC_RELAXED, __HIP_MEMORY_SCOPE_AGENT) < 2u) { __builtin_amdgcn_s_sleep(8); if (++spins > (1u << 22)) break; }
        __builtin_amdgcn_fence(__ATOMIC_ACQUIRE, "agent");
        asm volatile("s_waitcnt vmcnt(0)" ::: "memory");
    }
    __syncthreads();
    const bf16_t* GR = (const bf16_t*)(p.ws + OFF_GR); bf16_t* MIX = (bf16_t*)(p.ws + OFF_MIX);
    const bf16_t* OF = (const bf16_t*)p.out; const bf16_t* OBk = OF + (size_t)NTOK * 512;
    const int c0 = h * 128 + (lane & 15) * 8;
    const f32x4 w0 = *(const f32x4*)(p.in[13] + (lane & 15) * 8), w1 = *(const f32x4*)(p.in[13] + (lane & 15) * 8 + 4);
#pragma unroll 2
    for (int i = 0; i < 8; ++i) {
        const int r = b * SEQ + part * 256 + wave * 32 + i * 4 + (lane >> 4);
        const u32x4 a = *(const u32x4*)(OF + (size_t)r * 512 + c0), bq = *(const u32x4*)(OBk + (size_t)r * 512 + c0);
        const f32x4 x0 = (f32x4){bflo(a.x) + bflo(bq.x), bfhi(a.x) + bfhi(bq.x), bflo(a.y) + bflo(bq.y), bfhi(a.y) + bfhi(bq.y)};
        const f32x4 x1 = (f32x4){bflo(a.z) + bflo(bq.z), bfhi(a.z) + bfhi(bq.z), bflo(a.w) + bflo(bq.w), bfhi(a.w) + bfhi(bq.w)};
        float s = x0.x * x0.x + x0.y * x0.y + x0.z * x0.z + x0.w * x0.w + x1.x * x1.x + x1.y * x1.y + x1.z * x1.z + x1.w * x1.w;
        s += __shfl_xor(s, 1); s += __shfl_xor(s, 2); s += __shfl_xor(s, 4); s += __shfl_xor(s, 8);
        const float rs = rsqrtf(s * (1.f / 128.f) + EPS);
        const u32x4 g = *(const u32x4*)(GR + (size_t)r * 512 + c0);
        u32x4 o;
        o.x = pk2(x0.x * rs * w0.x * bflo(g.x), x0.y * rs * w0.y * bfhi(g.x)); o.y = pk2(x0.z * rs * w0.z * bflo(g.y), x0.w * rs * w0.w * bfhi(g.y));
        o.z = pk2(x1.x * rs * w1.x * bflo(g.z), x1.y * rs * w1.y * bfhi(g.z)); o.w = pk2(x1.z * rs * w1.z * bflo(g.w), x1.w * rs * w1.w * bfhi(g.w));
        *(u32x4*)(MIX + (size_t)r * DM + 512 + c0) = o;
    }
}

__device__ __forceinline__ void phase2(const Params& p, LAS unsigned char* lds, int qslot = 0) {
    unsigned* ctr = (unsigned*)(p.ws + OFF_CTL) + (qslot >= 2 ? 2048 + qslot * 64 : qslot * 64);
    int it;
#define P2_NEXT() do { __syncthreads(); if (threadIdx.x == 0) *(LAS unsigned*)(lds + LDS_Q) = atomicAdd(ctr, 1u); __syncthreads(); it = (int)*(LAS unsigned*)(lds + LDS_Q); } while (0)
    P2_NEXT();
    if (qslot != 3) { while (it < 64) { gla_chain(p, lds, it); P2_NEXT(); } }
    if (qslot == 2) return;
    if (qslot == 3) it += 64;
    while (it < 64 + NB * 4 * 16) { attn_item(p, lds, it - 64); P2_NEXT(); if (qslot == 3) it += 64; }
    if (qslot) return;
    for (;;) {
        __syncthreads();
        if (threadIdx.x == 0) *(LAS unsigned*)(lds + LDS_Q) = atomicAdd(ctr + 192, 1u);
        __syncthreads();
        const int c = (int)*(LAS unsigned*)(lds + LDS_Q);
        if (c >= 256) break;
        gla_combine_item(p, lds, c);
    }
    for (;;) {
        __syncthreads();
        if (threadIdx.x == 0) *(LAS unsigned*)(lds + LDS_Q) = atomicAdd(ctr + 128, 1u);
        __syncthreads();
        const int c = (int)*(LAS unsigned*)(lds + LDS_Q);
        if (c >= CV_ITEMS) break;
        conv_item(p, (unsigned char*)lds, c);
    }
#undef P2_NEXT
}

__device__ __forceinline__ void phase2c(const Params& p) {
    const int tid = threadIdx.x, lane = tid & 63, wave = tid >> 6;
    const int gw = blockIdx.x * 8 + wave, NGW = gridDim.x * 8;
    const bf16_t* GR = (const bf16_t*)(p.ws + OFF_GR); bf16_t* MIX = (bf16_t*)(p.ws + OFF_MIX);
    const bf16_t* OF = (const bf16_t*)p.out; const bf16_t* OBk = OF + (size_t)NTOK * 512;
    const int c0 = lane * 8;
    const f32x4 w0 = *(const f32x4*)(p.in[13] + (c0 & 127)), w1 = *(const f32x4*)(p.in[13] + (c0 & 127) + 4);
    for (int r = gw; r < NTOK; r += NGW) {
        const u32x4 a = *(const u32x4*)(OF + (size_t)r * 512 + c0), bq = *(const u32x4*)(OBk + (size_t)r * 512 + c0);
        const f32x4 x0 = (f32x4){bflo(a.x) + bflo(bq.x), bfhi(a.x) + bfhi(bq.x), bflo(a.y) + bflo(bq.y), bfhi(a.y) + bfhi(bq.y)};
        const f32x4 x1 = (f32x4){bflo(a.z) + bflo(bq.z), bfhi(a.z) + bfhi(bq.z), bflo(a.w) + bflo(bq.w), bfhi(a.w) + bfhi(bq.w)};
        float s = x0.x * x0.x + x0.y * x0.y + x0.z * x0.z + x0.w * x0.w + x1.x * x1.x + x1.y * x1.y + x1.z * x1.z + x1.w * x1.w;
        s += __shfl_xor(s, 1); s += __shfl_xor(s, 2); s += __shfl_xor(s, 4); s += __shfl_xor(s, 8);
        const float rs = rsqrtf(s * (1.f / 128.f) + EPS);
        const u32x4 g = *(const u32x4*)(GR + (size_t)r * 512 + c0);
        u32x4 o;
        o.x = pk2(x0.x * rs * w0.x * bflo(g.x), x0.y * rs * w0.y * bfhi(g.x)); o.y = pk2(x0.z * rs * w0.z * bflo(g.y), x0.w * rs * w0.w * bfhi(g.y));
        o.z = pk2(x1.x * rs * w1.x * bflo(g.z), x1.y * rs * w1.y * bfhi(g.z)); o.w = pk2(x1.z * rs * w1.z * bflo(g.w), x1.w * rs * w1.w * bfhi(g.w));
        *(u32x4*)(MIX + (size_t)r * DM + 512 + c0) = o;
    }
}


#define TOPK_INS(L, x) do { float _x = (x); _Pragma("unroll") for (int _s = 0; _s < 16; ++_s) { const float _t = fmaxf(L[_s], _x); _x = fminf(L[_s], _x); L[_s] = _t; } } while (0)
constexpr int P4_QROW = 528, P4_SC0 = 128 * P4_QROW  , P4_TLROW = 144;

#define CE_DESC(a, b) do { const float _hi = fmaxf(a, b), _lo = fminf(a, b); a = _hi; b = _lo; } while (0)
__device__ __forceinline__ void bitonic_sort16_desc(float (&x)[16]) {
#pragma unroll
    for (int k = 2; k <= 16; k <<= 1)
#pragma unroll
        for (int j = k >> 1; j > 0; j >>= 1)
#pragma unroll
            for (int i = 0; i < 16; ++i) { const int l = i ^ j; if (l > i) { if ((i & k) == 0) CE_DESC(x[i], x[l]); else CE_DESC(x[l], x[i]); } }
}
__device__ __forceinline__ void bitonic_merge16_desc(float (&x)[16]) {
#pragma unroll
    for (int j = 8; j > 0; j >>= 1)
#pragma unroll
        for (int i = 0; i < 16; ++i) { const int l = i ^ j; if (l > i) CE_DESC(x[i], x[l]); }
}
__device__ __forceinline__ void top16_merge(float (&L)[16], const float (&x)[16]) {
#pragma unroll
    for (int i = 0; i < 16; ++i) L[i] = fmaxf(L[i], x[15 - i]);
    bitonic_merge16_desc(L);
}

template <int Q> struct CandIJ {
    static constexpr int compute() { int c = 0; for (int i = 0; i < 16; ++i) for (int j = 0; j < 16; ++j) if ((i + 1) * (j + 1) <= 16) { if (c == Q) return i * 16 + j; ++c; } return -1; }
    static constexpr int v = compute();
};
template <int G, int S> __device__ __forceinline__ void cand_fill(float (&x)[16], const float (&A)[16], const float (&Bv)[16]) {
    constexpr int ij = CandIJ<G * 16 + S>::v;
    if constexpr (ij >= 0) x[S] = __uint_as_float((__float_as_uint(A[ij >> 4] + Bv[ij & 15]) & ~255u) | (unsigned)ij); else x[S] = -3.0e38f;
    if constexpr (S + 1 < 16) cand_fill<G, S + 1>(x, A, Bv);
}
__device__ __forceinline__ void p4_route_half(const Params& p, LAS unsigned char* lds, int m0, int h) {
    int tid_ = threadIdx.x; asm volatile("" : "+v"(tid_));
    const int tid = tid_, lane = tid & 63, wave = __builtin_amdgcn_readfirstlane(tid >> 6), l15 = lane & 15, g = lane >> 4;
    const bf16_t* KEYS = (const bf16_t*)(p.ws + OFF_KEYS); unsigned* PW0 = (unsigned*)(p.ws + OFF_PW0);
        {
            const int wr = wave >> 1, wk = wave & 1;
            f32x4 sc[2][2][4];
#pragma unroll
            for (int pp = 0; pp < 2; ++pp) {
#pragma unroll
                for (int rb = 0; rb < 2; ++rb)
#pragma unroll
                    for (int kk = 0; kk < 4; ++kk) sc[pp][rb][kk] = (f32x4){0.f, 0.f, 0.f, 0.f};
                const bf16_t* kbase = KEYS + (size_t)((h * 2 + pp) * 128 + 64 * wk + l15) * 128 + 8 * g;
#pragma unroll
                for (int ks = 0; ks < 4; ++ks) {
                    bf16x8 qf[2], kf[4];
#pragma unroll
                    for (int rb = 0; rb < 2; ++rb) qf[rb] = *(const LAS bf16x8*)(lds + (32 * wr + 16 * rb + l15) * P4_QROW + (pp * 128 + ks * 32 + 8 * g) * 2);
#pragma unroll
                    for (int kk = 0; kk < 4; ++kk) kf[kk] = *(const bf16x8*)(kbase + (size_t)(16 * kk) * 128 + ks * 32);
#pragma unroll
                    for (int rb = 0; rb < 2; ++rb)
#pragma unroll
                        for (int kk = 0; kk < 4; ++kk) sc[pp][rb][kk] = __builtin_amdgcn_mfma_f32_16x16x32_bf16(kf[kk], qf[rb], sc[pp][rb][kk], 0, 0, 0);
                }
            }
#pragma unroll
            for (int rb = 0; rb < 2; ++rb)
#pragma unroll
                for (int kk = 0; kk < 4; ++kk) *(LAS f32x4*)(lds + P4_SC0 + (32 * wr + 16 * rb + l15) * P4_QROW + (64 * wk + 16 * kk + 4 * g) * 4) = sc[0][rb][kk];
            __syncthreads();
#pragma unroll
            for (int rb = 0; rb < 2; ++rb)
#pragma unroll
                for (int kk = 0; kk < 4; ++kk) *(LAS f32x4*)(lds + (32 * wr + 16 * rb + l15) * P4_QROW + (64 * wk + 16 * kk + 4 * g) * 4) = sc[1][rb][kk];
        }
        __syncthreads();
        {
            const int hf = tid & 1, row = (tid >> 1) & 127, pp = tid >> 8;
            const LAS unsigned char* sp = lds + (pp ? 0 : P4_SC0) + row * P4_QROW + hf * 256;
            float L[16];
#pragma unroll
            for (int grp = 0; grp < 4; ++grp) {
                float x[16];
#pragma unroll
                for (int q4 = 0; q4 < 4; ++q4) {
                    const f32x4 v = *(const LAS f32x4*)(sp + (grp * 4 + q4) * 16);
                    const unsigned kb = (unsigned)(hf * 64 + grp * 16 + q4 * 4);
                    x[4 * q4 + 0] = __uint_as_float((__float_as_uint(v.x) & ~127u) | kb);
                    x[4 * q4 + 1] = __uint_as_float((__float_as_uint(v.y) & ~127u) | (kb + 1));
                    x[4 * q4 + 2] = __uint_as_float((__float_as_uint(v.z) & ~127u) | (kb + 2));
                    x[4 * q4 + 3] = __uint_as_float((__float_as_uint(v.w) & ~127u) | (kb + 3));
                }
                bitonic_sort16_desc(x);
                if (grp == 0) {
#pragma unroll
                    for (int s = 0; s < 16; ++s) L[s] = x[s];
                } else top16_merge(L, x);
            }
            {
                float Oth[16];
#pragma unroll
                for (int s = 0; s < 16; ++s) Oth[s] = __shfl_xor(L[s], 1);
                top16_merge(L, Oth);
            }
            __syncthreads();
            if (hf == 0) {
                LAS f32x4* tl = (LAS f32x4*)(lds + P4_SC0 + row * (2 * P4_TLROW) + pp * P4_TLROW);
                tl[0] = (f32x4){L[0], L[1], L[2], L[3]}; tl[1] = (f32x4){L[4], L[5], L[6], L[7]}; tl[2] = (f32x4){L[8], L[9], L[10], L[11]}; tl[3] = (f32x4){L[12], L[13], L[14], L[15]};
            }
        }
        __syncthreads();
        if (tid < 128) {
            const LAS unsigned char* tl = lds + P4_SC0 + tid * (2 * P4_TLROW);
            float A[16], Bv[16];
#pragma unroll
            for (int q4 = 0; q4 < 4; ++q4) { const f32x4 a = *(const LAS f32x4*)(tl + q4 * 16), b = *(const LAS f32x4*)(tl + P4_TLROW + q4 * 16);
                A[4 * q4] = a.x; A[4 * q4 + 1] = a.y; A[4 * q4 + 2] = a.z; A[4 * q4 + 3] = a.w; Bv[4 * q4] = b.x; Bv[4 * q4 + 1] = b.y; Bv[4 * q4 + 2] = b.z; Bv[4 * q4 + 3] = b.w; }
#pragma unroll
            for (int s = 0; s < 16; ++s) { A[s] = __uint_as_float(__float_as_uint(A[s]) & ~127u); Bv[s] = __uint_as_float(__float_as_uint(Bv[s]) & ~127u); }
            float L[16];
            {
                float x[16];
                cand_fill<0, 0>(x, A, Bv); bitonic_sort16_desc(x);
#pragma unroll
                for (int s = 0; s < 16; ++s) L[s] = x[s];
                cand_fill<1, 0>(x, A, Bv); bitonic_sort16_desc(x); top16_merge(L, x);
                cand_fill<2, 0>(x, A, Bv); bitonic_sort16_desc(x); top16_merge(L, x);
                cand_fill<3, 0>(x, A, Bv); bitonic_sort16_desc(x); top16_merge(L, x);
            }
            const float v0 = __uint_as_float(__float_as_uint(L[0]) & ~255u);
            float e[16], den = 0.f; int id[16];
#pragma unroll
            for (int s = 0; s < 16; ++s) {
                const unsigned u = __float_as_uint(L[s]);
                e[s] = __expf(__uint_as_float(u & ~255u) - v0); den += e[s];
                const unsigned i = (u >> 4) & 15u, j = u & 15u;
                const unsigned ka = *(const LAS unsigned*)(tl + i * 4) & 127u, kb = *(const LAS unsigned*)(tl + P4_TLROW + j * 4) & 127u;
                id[s] = (int)(ka * 128u + kb);
            }
            const float inv = 1.f / den;
            unsigned* ip = PW0 + (size_t)(m0 + tid) * 128 + h * 16;
#pragma unroll
            for (int q4 = 0; q4 < 4; ++q4) { u32x4 o;
#pragma unroll
                for (int c = 0; c < 4; ++c) o[c] = (unsigned)id[4 * q4 + c] | (f2bf(e[4 * q4 + c] * inv) << 16);
                *(u32x4*)(ip + 4 * q4) = o; }
        }
        __syncthreads();
}

namespace pg8 {
struct EpiP4 {
    static constexpr bool PERM = true, AFTER_DRAIN = true, SWAPPABLE = false;
    const Params* pp; const float* ssq;
    __device__ __forceinline__ void operator()(const f32x4 (&)[2][2][4][2], const Unit&, int, int, int, int) const {}
    __device__ __forceinline__ void fused(f32x4 (&acc)[2][2][4][2], const Unit& u, int wr, int wc, int fr, int fq, PG8_LAS unsigned char* lds, int wid, int lane) const {
#pragma unroll
        for (int ai = 0; ai < 2; ++ai) {
            const int m0 = u.pm * BM + ai * HALF;
#pragma unroll
            for (int m = 0; m < 4; ++m) {
                const int rl = wr * 64 + m * 16 + fr;
                const float rstd = row_rstd(ssq, m0 + rl);
#pragma unroll
                for (int bj = 0; bj < 2; ++bj) { const f32x4 v0 = acc[ai][bj][m][0] * rstd, v1 = acc[ai][bj][m][1] * rstd;
                    *(PG8_LAS u32x4*)(lds + rl * P4_QROW + (bj * HALF + wc * 32 + 8 * fq) * 2) = (u32x4){pk2(v0.x, v0.y), pk2(v0.z, v0.w), pk2(v1.x, v1.y), pk2(v1.z, v1.w)}; }
            }
            __syncthreads();
            p4_route_half(*pp, lds, m0, u.pn);
        }
    }
};
}
__device__ __forceinline__ void phase4_mfma(const Params& p, LAS unsigned char* lds) {
    pg8::Gemm g{(const pg8::bf16_t*)(p.ws + OFF_H2B), (const pg8::bf16_t*)(p.ws + OFF_WQ), NTOK, 2048, DM};
    pg8::EpiP4 E{&p, (const float*)(p.ws + OFF_SSQP)};
    const int vcu = vcu_of_block();
    for (int r = 0; r * (int)gridDim.x < 512; ++r) {
        const int L = r * (int)gridDim.x + vcu;
        pg8::OneUnit S; S.u.pm = L >> 3; S.u.pn = L & 7; S.valid = L < 512;
        pg8::gemm_phase<pg8::EpiP4, pg8::OneUnit, false, true>(lds, g, S, E);
        __syncthreads();
    }
}


constexpr size_t OFF_PW = 73 * MiB;
constexpr size_t OFF_OUTS = 179 * MiB;
static_assert(OFF_OUTS >= OFF_PW0 + (size_t)NTOK * 128 * 4 && OFF_OUTS + (size_t)NTOK * DM * 4 <= 256 * MiB, "P5 map");
__device__ __forceinline__ float dot_fp8_bf16(u32x4 uq, u32x4 h0, u32x4 h1, float c) {
#define DQ2(word, hsel, hw) c = dot2(__builtin_bit_cast(unsigned, __builtin_amdgcn_cvt_scalef32_pk_bf16_fp8((int)(word), 1.0f, hsel)), hw, c)
    DQ2(uq.x, false, h0.x); DQ2(uq.x, true, h0.y); DQ2(uq.y, false, h0.z); DQ2(uq.y, true, h0.w);
    DQ2(uq.z, false, h1.x); DQ2(uq.z, true, h1.y); DQ2(uq.w, false, h1.z); DQ2(uq.w, true, h1.w);
#undef DQ2
    return c;
}
constexpr int P5A_RS = 1040, P5A_LIST = 16640, P5A_CAP = 768, P5A_RES = P5A_LIST + 4 * P5A_CAP, P5A_TSC = P5A_RES + 64, P5A_WAVE = P5A_TSC + 64;
constexpr size_t OFF_HQ = 146 * MiB;
constexpr size_t OFF_HSC = 192 * 1024;
static_assert(8 * P5A_WAVE <= LDS_BYTES - 32, "P5a LDS");
static_assert(OFF_HQ >= OFF_H2B + (size_t)NTOK * DM * 2 && OFF_HQ + (size_t)NTOK * DM <= OFF_PW0, "HQ map");
__device__ __forceinline__ void quantize_hn(const Params& p) {
    const int tid = threadIdx.x, lane = tid & 63, wave = tid >> 6;
    const bf16_t* H2B = (const bf16_t*)(p.ws + OFF_H2B); unsigned char* HQ = p.ws + OFF_HQ; float* HSC = (float*)(p.ws + OFF_HSC);
    for (int t = blockIdx.x * 8 + wave; t < NTOK; t += gridDim.x * 8) {
        const u32x4 h0 = *(const u32x4*)(H2B + (size_t)t * DM + 16 * lane), h1 = *(const u32x4*)(H2B + (size_t)t * DM + 16 * lane + 8);
        float m = 0.f;
#pragma unroll
        for (int c = 0; c < 4; ++c) { m = fmaxf(m, fmaxf(fabsf(bflo(h0[c])), fabsf(bfhi(h0[c])))); m = fmaxf(m, fmaxf(fabsf(bflo(h1[c])), fabsf(bfhi(h1[c])))); }
        const float am = fmaxf(wave_max(m), 1e-30f), qs = 224.f / am;
        u32x4 o;
#pragma unroll
        for (int c = 0; c < 2; ++c) {
            int w = __builtin_amdgcn_cvt_pk_fp8_f32(bflo(h0[2 * c]) * qs, bfhi(h0[2 * c]) * qs, 0, false); w = __builtin_amdgcn_cvt_pk_fp8_f32(bflo(h0[2 * c + 1]) * qs, bfhi(h0[2 * c + 1]) * qs, w, true); o[c] = (unsigned)w;
            int x = __builtin_amdgcn_cvt_pk_fp8_f32(bflo(h1[2 * c]) * qs, bfhi(h1[2 * c]) * qs, 0, false); x = __builtin_amdgcn_cvt_pk_fp8_f32(bflo(h1[2 * c + 1]) * qs, bfhi(h1[2 * c + 1]) * qs, x, true); o[2 + c] = (unsigned)x;
        }
        *(u32x4*)(HQ + (size_t)t * DM + 16 * lane) = o;
        if (lane == 0) HSC[t] = row_rstd((const float*)(p.ws + OFF_SSQP), t) * am * (1.f / 224.f);
    }
}
__device__ __forceinline__ void p5a_wave(const Params& p, LAS unsigned char* wl, int tb, int part, int lane, __amdgpu_buffer_rsrc_t urs, __amdgpu_buffer_rsrc_t hrs) {
    const float* USC = (const float*)(p.ws + OFF_USC); const float* VSC = (const float*)(p.ws + OFF_VSC); const float* HSC = (const float*)(p.ws + OFF_HSC);
    const unsigned* PW0 = (const unsigned*)(p.ws + OFF_PW0); unsigned* PW = (unsigned*)(p.ws + OFF_PW);
    const int l15 = lane & 15, g = lane >> 4;
    unsigned xl[16], xh[16];
#define P5A_WORDS() do { _Pragma("unroll") for (int _k = 0; _k < 16; ++_k) { xl[_k] = PW0[(size_t)(tb + _k) * 128 + lane]; xh[_k] = PW0[(size_t)(tb + _k) * 128 + 64 + lane]; } } while (0)
#define P5A_GATHER(tile_) do { int _li = (tile_) * 16 + l15; _li = _li < n ? _li : n - 1; \
        const int _ev = (int)((*(const LAS unsigned*)(wl + P5A_LIST + _li * 4) & 0x3fffu) << 10); \
        _Pragma("unroll") for (int _r = 0; _r < 16; ++_r) \
            __builtin_amdgcn_raw_ptr_buffer_load_lds(urs, (LAS unsigned*)(wl + _r * P5A_RS), 16, lane * 16, __builtin_amdgcn_readlane(_ev, _r), 0, 0); } while (0)
#pragma unroll
    for (int k = 0; k < 16; ++k) __builtin_amdgcn_raw_ptr_buffer_load_lds(hrs, (LAS unsigned*)(wl + k * 1024), 16, lane * 16, (tb + k) * 1024, 0, 0);
    P5A_WORDS();
    const float hsc = HSC[tb + l15];
    asm volatile("s_waitcnt vmcnt(0)" ::: "memory");
    long bq[32];
#pragma unroll
    for (int i = 0; i < 16; ++i) { const u32x4 w = *(const LAS u32x4*)(wl + l15 * 1024 + 64 * i + 16 * g);
        bq[2 * i] = __builtin_bit_cast(long, (u32x2){w.x, w.y}); bq[2 * i + 1] = __builtin_bit_cast(long, (u32x2){w.z, w.w}); }
    if (lane < 16) *(LAS float*)(wl + P5A_TSC + lane * 4) = hsc;
    int ntot = 0;
#pragma unroll
    for (int k = 0; k < 16; ++k) ntot += __popcll(__ballot((int)((xl[k] >> 11) & 7u) == part)) + __popcll(__ballot((int)((xh[k] >> 11) & 7u) == part));
    const int npass = ntot <= P5A_CAP ? 1 : 4;
    for (int pass = 0; pass < npass; ++pass) {
        const int klo = npass == 1 ? 0 : 4 * pass, khi = npass == 1 ? 16 : klo + 4;
        if (pass > 0) { P5A_WORDS(); asm volatile("s_waitcnt vmcnt(0)" ::: "memory"); }
        int n = 0;
#pragma unroll
        for (int k = 0; k < 16; ++k) {
            if (k >= klo && k < khi) {
                const bool ml = (int)((xl[k] >> 11) & 7u) == part, mh = (int)((xh[k] >> 11) & 7u) == part;
                const unsigned long long bl = __ballot(ml), bh = __ballot(mh);
                const int rl = __builtin_amdgcn_mbcnt_hi((unsigned)(bl >> 32), __builtin_amdgcn_mbcnt_lo((unsigned)bl, 0u));
                if (ml) *(LAS unsigned*)(wl + P5A_LIST + (n + rl) * 4) = (xl[k] & 0x3fffu) | ((unsigned)lane << 14) | ((unsigned)k << 21);
                n += __popcll(bl);
                const int rh = __builtin_amdgcn_mbcnt_hi((unsigned)(bh >> 32), __builtin_amdgcn_mbcnt_lo((unsigned)bh, 0u));
                if (mh) *(LAS unsigned*)(wl + P5A_LIST + (n + rh) * 4) = (xh[k] & 0x3fffu) | ((unsigned)(64 + lane) << 14) | ((unsigned)k << 21);
                n += __popcll(bh);
            }
        }
        __builtin_amdgcn_s_waitcnt(0xC07F); __builtin_amdgcn_wave_barrier();
        asm volatile("" ::: "memory");
        const int ntile = (n + 15) >> 4;
        if (ntile == 0) continue;
#define P5A_OPS(tile_, EOK, EE, SL, TK, USCV, VSCV, XGV) do { int _ei = (tile_) * 16 + l15; EOK = _ei < n; _ei = EOK ? _ei : n - 1; \
        const unsigned _ent = *(const LAS unsigned*)(wl + P5A_LIST + _ei * 4); \
        EE = _ent & 0x3fffu; SL = (int)((_ent >> 14) & 127u); TK = (int)(_ent >> 21); \
        USCV = USC[EE]; VSCV = VSC[EE]; XGV = PW0[(size_t)(tb + TK) * 128 + SL]; } while (0)
        bool eokN; unsigned eeN; int slN, tkN; float uscN, vscN; unsigned xgN;
        P5A_GATHER(0);
        P5A_OPS(0, eokN, eeN, slN, tkN, uscN, vscN, xgN);
        for (int tile = 0; tile < ntile; ++tile) {
            asm volatile("s_waitcnt vmcnt(0)" : "+v"(uscN), "+v"(vscN), "+v"(xgN) :: "memory");
            const bool eok = eokN; const unsigned ee = eeN; const int sl = slN, tk = tkN, t = tb + tkN; const float usc = uscN, vsc = vscN; const unsigned xg = xgN;
            long aq[32];
#pragma unroll
            for (int i = 0; i < 16; ++i) { const u32x4 w = *(const LAS u32x4*)(wl + l15 * P5A_RS + 64 * i + 16 * g);
                aq[2 * i] = __builtin_bit_cast(long, (u32x2){w.x, w.y}); aq[2 * i + 1] = __builtin_bit_cast(long, (u32x2){w.z, w.w}); }
            asm volatile("s_waitcnt lgkmcnt(0)" ::: "memory");
#pragma unroll
            for (int s = 0; s < 32; ++s) asm volatile("" : "+v"(aq[s]));
            if (tile + 1 < ntile) { P5A_GATHER(tile + 1); P5A_OPS(tile + 1, eokN, eeN, slN, tkN, uscN, vscN, xgN); }
            f32x4 acc = (f32x4){0.f, 0.f, 0.f, 0.f};
#pragma unroll
            for (int s = 0; s < 32; ++s) acc = __builtin_amdgcn_mfma_f32_16x16x32_fp8_fp8(aq[s], bq[s], acc, 0, 0, 0);
            {
                const u32x4 en = *(const LAS u32x4*)(wl + P5A_LIST + (tile * 16 + 4 * g) * 4);
#pragma unroll
                for (int r = 0; r < 4; ++r) if ((int)(en[r] >> 21) == l15) *(LAS float*)(wl + P5A_RES + (4 * g + r) * 4) = acc[r];
            }
            __builtin_amdgcn_s_waitcnt(0xC07F); __builtin_amdgcn_wave_barrier();
            asm volatile("" ::: "memory");
            if (lane < 16 && eok) {
                const float d = *(const LAS float*)(wl + P5A_RES + lane * 4) * usc * *(const LAS float*)(wl + P5A_TSC + tk * 4);
                const float w = __uint_as_float(xg & 0xffff0000u) * gelu_f(d) * vsc;
                PW[(((size_t)(t >> 6) * 32 + (sl >> 2)) * 64 + (t & 63)) * 4 + (sl & 3)] = (ee << 3) | (__float_as_uint(w) & 0xfffe0000u);
            }
            __builtin_amdgcn_s_waitcnt(0xC07F); __builtin_amdgcn_wave_barrier();
            asm volatile("" ::: "memory");
        }
#undef P5A_OPS
    }
    asm volatile("s_waitcnt vmcnt(0)" ::: "memory");
#undef P5A_WORDS
#undef P5A_GATHER
}
__device__ __forceinline__ void phase5a(const Params& p, LAS unsigned char* lds, int qoff = 0) {
    const int tid = threadIdx.x, lane = tid & 63, wave = __builtin_amdgcn_readfirstlane(tid >> 6);
    const int xcc = (int)(__builtin_amdgcn_s_getreg((3 << 11) | 20) & 7u);
    unsigned* qc = (unsigned*)(p.ws + OFF_CTL) + 256 + qoff;
    LAS unsigned char* wl = lds + wave * P5A_WAVE;
    const __amdgpu_buffer_rsrc_t urs = __builtin_amdgcn_make_buffer_rsrc((void*)(p.ws + OFF_UB), 0, NEXP * DM, 0x00020000);
    const __amdgpu_buffer_rsrc_t hrs = __builtin_amdgcn_make_buffer_rsrc((void*)(p.ws + OFF_HQ), 0, NTOK * DM, 0x00020000);
    for (int pi = 0; pi < 8; ++pi) {
        const int part = (xcc + pi) & 7;
        unsigned nxt = 0u;
        if (lane == 0) nxt = atomicAdd(qc + part * 64, 1u);
        for (;;) {
            const int it = (int)__builtin_amdgcn_readfirstlane(nxt);
            if (it >= NTOK / 16) break;
            if (lane == 0) nxt = atomicAdd(qc + part * 64, 1u);
            p5a_wave(p, wl, it * 16, part, lane, urs, hrs);
        }
    }
}

__device__ __forceinline__ void p5b_quad(const LAS unsigned char* lds, u32x4 q, f32x2& a0, f32x2& a1, f32x2& a2, f32x2& a3) {
#pragma unroll
    for (int c = 0; c < 4; ++c) {
        const unsigned x = q[c];
        const u32x2 vv = *(const LAS u32x2*)(lds + (x & 0x1fff8u));
        const float w = __uint_as_float(x); const f32x2 ww = (f32x2){w, w};
        a0 += ww * __builtin_amdgcn_cvt_pk_f32_fp8((int)vv.x, false); a1 += ww * __builtin_amdgcn_cvt_pk_f32_fp8((int)vv.x, true);
        a2 += ww * __builtin_amdgcn_cvt_pk_f32_fp8((int)vv.y, false); a3 += ww * __builtin_amdgcn_cvt_pk_f32_fp8((int)vv.y, true);
    }
}
__device__ __forceinline__ void phase5b(const Params& p, LAS unsigned char* lds) {
    const int tid = threadIdx.x, lane = tid & 63, wave = __builtin_amdgcn_readfirstlane(tid >> 6);
    const unsigned char* VS = p.ws + OFF_VB; const u32x4* PW = (const u32x4*)(p.ws + OFF_PW); bf16_t* OUTS = (bf16_t*)(p.ws + OFF_OUTS);
    for (int it = blockIdx.x; it < 256; it += gridDim.x) {
        const int s = it >> 1, tbase = (it & 1) * 128;
        __syncthreads();
#pragma unroll 4
        for (int i = 0; i < 16; ++i) *(LAS u32x4*)(lds + (tid + NTHR * i) * 16) = *(const u32x4*)(VS + (size_t)s * 131072 + (size_t)(tid + NTHR * i) * 16);
        __syncthreads();
        u32x4 A[8], Bq[8];
#define P5B_LOAD(R, gi) do { const int _T = tbase + wave + 8 * ((gi) >> 2), _g = (gi) & 3; const u32x4* _p = PW + ((size_t)_T * 32 + _g * 8) * 64 + lane; \
        _Pragma("unroll") for (int _i = 0; _i < 8; ++_i) R[_i] = _p[_i * 64]; } while (0)
        f32x2 a0 = {0.f, 0.f}, a1 = {0.f, 0.f}, a2 = {0.f, 0.f}, a3 = {0.f, 0.f};
        P5B_LOAD(A, 0);
        for (int gi = 0; gi < 64; gi += 2) {
            P5B_LOAD(Bq, gi + 1);
#pragma unroll
            for (int i = 0; i < 8; ++i) p5b_quad(lds, A[i], a0, a1, a2, a3);
            if (gi + 2 < 64) P5B_LOAD(A, gi + 2);
#pragma unroll
            for (int i = 0; i < 8; ++i) p5b_quad(lds, Bq[i], a0, a1, a2, a3);
            if (((gi + 1) & 3) == 3) {
                const int T = tbase + wave + 8 * (gi >> 2);
                *(u32x4*)(OUTS + ((size_t)s * NTOK + T * 64 + lane) * 8) = (u32x4){pk2(a0.x, a0.y), pk2(a1.x, a1.y), pk2(a2.x, a2.y), pk2(a3.x, a3.y)};
                a0 = (f32x2){0.f, 0.f}; a1 = a0; a2 = a0; a3 = a0;
            }
        }
#undef P5B_LOAD
    }
}

__device__ __forceinline__ void phase5c(const Params& p, LAS unsigned char* lds) {
    const int tid = threadIdx.x, lane = tid & 63, wave = __builtin_amdgcn_readfirstlane(tid >> 6);
    const bf16_t* OUTS = (const bf16_t*)(p.ws + OFF_OUTS); const bf16_t* H2B = (const bf16_t*)(p.ws + OFF_H2B); const float* fw = p.in[20];
    for (int it = blockIdx.x; it < NTOK / 32; it += gridDim.x) {
        const int t0 = it * 32;
        __syncthreads();
#pragma unroll 4
        for (int i = 0; i < 8; ++i) {
            const int q = tid + NTHR * i, s = q >> 5, tt = q & 31;
            *(LAS u32x4*)(lds + tt * 2064 + s * 16) = *(const u32x4*)(OUTS + ((size_t)s * NTOK + t0 + tt) * 8);
        }
        __syncthreads();
        for (int i = 0; i < 4; ++i) {
            const int tt = wave * 4 + i; float* orow = p.out + (size_t)(t0 + tt) * DM;
            f32x4 h[4]; float ss = 0.f;
#pragma unroll
            for (int j = 0; j < 2; ++j) {
                const u32x4 a = *(const u32x4*)(H2B + (size_t)(t0 + tt) * DM + 512 * j + 8 * lane), pq = *(const LAS u32x4*)(lds + tt * 2064 + (512 * j + 8 * lane) * 2);
                h[2 * j] = (f32x4){bflo(a.x) + bflo(pq.x), bfhi(a.x) + bfhi(pq.x), bflo(a.y) + bflo(pq.y), bfhi(a.y) + bfhi(pq.y)};
                h[2 * j + 1] = (f32x4){bflo(a.z) + bflo(pq.z), bfhi(a.z) + bfhi(pq.z), bflo(a.w) + bflo(pq.w), bfhi(a.w) + bfhi(pq.w)};
            }
#pragma unroll
            for (int j = 0; j < 4; ++j) ss += h[j].x * h[j].x + h[j].y * h[j].y + h[j].z * h[j].z + h[j].w * h[j].w;
            const float rs = rsqrtf(wave_sum(ss) * (1.f / DM) + EPS);
#pragma unroll
            for (int j = 0; j < 2; ++j) {
                float* o = orow + 512 * j + 8 * lane; const float* w = fw + 512 * j + 8 * lane;
                *(f32x4*)o = h[2 * j] * rs * *(const f32x4*)w; *(f32x4*)(o + 4) = h[2 * j + 1] * rs * *(const f32x4*)(w + 4);
            }
        }
    }
}


#define XB_TMO      128
#define XB_XCNT(j)  (256  + 64 * (j))
#define XB_XSUB(j)  (1280 + 64 * (j))
#define XB_XGEN(j)  (2304 + 64 * (j))
#define XB_TOP      3328
#define XB_TOPGEN   3392
#define XCD_BAR_WORDS 3456
#define XB_SPIN_CAP (1u << 18)
__device__ __forceinline__ unsigned xb_ld(unsigned* p)              { return __hip_atomic_load(p, __ATOMIC_RELAXED, __HIP_MEMORY_SCOPE_AGENT); }
__device__ __forceinline__ unsigned xb_add(unsigned* p, unsigned v) { return __hip_atomic_fetch_add(p, v, __ATOMIC_RELAXED, __HIP_MEMORY_SCOPE_AGENT); }
__device__ __forceinline__ unsigned xb_xcc_id() { return (unsigned)__builtin_amdgcn_s_getreg((3 << 11) | 20) & 0xFu; }
#define XB_SPIN(cond, bar) do { unsigned _sp = 0; while (cond) { __builtin_amdgcn_s_sleep(1); \
    if ((++_sp & 255u) == 0u) { if (xb_ld(&(bar)[XB_TMO])) break; if (_sp > XB_SPIN_CAP) { atomicAdd(&(bar)[XB_TMO], 1u); break; } } } } while (0)
struct XcdBarrier { unsigned* bar; unsigned x; volatile LAS unsigned* st; };
__device__ __forceinline__ XcdBarrier xcd_barrier_post(unsigned* bar, volatile LAS unsigned* st) {
    XcdBarrier b; b.bar = bar; b.x = xb_xcc_id(); b.st = st;
    if (threadIdx.x == 0) (void)xb_add(&bar[XB_XCNT(b.x)], 1u);
    return b;
}
__device__ __forceinline__ void xcd_barrier_complete(unsigned* bar, unsigned x, unsigned& nloc, unsigned& nx) {
    const unsigned G = gridDim.x * gridDim.y * gridDim.z;
    unsigned sum, cnt, mine, sp = 0u;
    for (;;) {
        sum = 0u; cnt = 0u; mine = 0u;
#pragma unroll
        for (unsigned j = 0; j < 16; ++j) { const unsigned c = xb_ld(&bar[XB_XCNT(j)]); sum += c; cnt += (c > 0u) ? 1u : 0u; mine = (j == x) ? c : mine; }
        if (sum == G) break;
        __builtin_amdgcn_s_sleep(1);
        if ((++sp & 255u) == 0u) { if (xb_ld(&bar[XB_TMO])) break; if (sp > XB_SPIN_CAP) { atomicAdd(&bar[XB_TMO], 1u); break; } }
    }
    nloc = mine > 0u ? mine : 1u; nx = cnt > 0u ? cnt : 1u;
}
__device__ __forceinline__ void xcd_barrier(const XcdBarrier& b) {
    asm volatile("s_waitcnt vmcnt(0)" ::: "memory");
    __syncthreads();
    if (threadIdx.x == 0) {
        unsigned* bar = b.bar;
        __builtin_amdgcn_s_waitcnt(0);
        unsigned nloc = b.st[0], nx = b.st[1];
        if (nloc == 0u) { xcd_barrier_complete(bar, b.x, nloc, nx); b.st[0] = nloc; b.st[1] = nx; }
        const unsigned old = xb_add(&bar[XB_XSUB(b.x)], 1u);
        const unsigned gen = old / nloc;
        if (old + 1u == (gen + 1u) * nloc) {
            __builtin_amdgcn_fence(__ATOMIC_RELEASE, "agent");
            asm volatile("s_waitcnt vmcnt(0)" ::: "memory");
            const unsigned og = xb_add(&bar[XB_TOP], 1u);
            const unsigned tg = og / nx;
            if (og + 1u == (tg + 1u) * nx) xb_add(&bar[XB_TOPGEN], 1u);
            else XB_SPIN(xb_ld(&bar[XB_TOPGEN]) == tg, bar);
            __builtin_amdgcn_fence(__ATOMIC_ACQUIRE, "agent");
            asm volatile("s_waitcnt vmcnt(0)" ::: "memory");
        } else {
            XB_SPIN(xb_ld(&bar[XB_TOPGEN]) == gen, bar);
            __builtin_amdgcn_fence(__ATOMIC_ACQUIRE, "agent");
            asm volatile("s_waitcnt vmcnt(0)" ::: "memory");
        }
    }
    __syncthreads();
}

constexpr int NPHASE = 9;
__global__ void __launch_bounds__(NTHR, 2) mega(Params p) {
    extern __shared__ __attribute__((aligned(16))) unsigned char lds[];
    cg::grid_group grid = cg::this_grid();
#define PH_ON(k) (p.ph_lo <= (k) && (k) < p.ph_hi)
    if (threadIdx.x < 2) ((LAS unsigned*)((LAS unsigned char*)lds + LDS_BYTES - 32))[threadIdx.x] = 0u;
    __syncthreads();
    const XcdBarrier xbar = xcd_barrier_post((unsigned*)(p.ws + OFF_CTL) + 8192, (volatile LAS unsigned*)((LAS unsigned char*)lds + LDS_BYTES - 32));
#define PH_SYNC(k) do { if (PH_ON(k) && PH_ON((k) + 1)) { xcd_barrier(xbar); } } while (0)
    if (PH_ON(0)) phase0(p, lds);
    PH_SYNC(0);
    if (PH_ON(1)) phase1_mfma(p, (LAS unsigned char*)lds);
#if PROBE_DUP == 1
    xcd_barrier(xbar); phase1_mfma(p, (LAS unsigned char*)lds);
#endif
    PH_SYNC(1);
    if (PH_ON(2)) phase2(p, (LAS unsigned char*)lds);
#if PROBE_DUP == 2
    xcd_barrier(xbar); phase2(p, (LAS unsigned char*)lds, 1);
#endif
#if PROBE_DUP == 21
    xcd_barrier(xbar); phase2(p, (LAS unsigned char*)lds, 2);
#endif
#if PROBE_DUP == 22
    xcd_barrier(xbar); phase2(p, (LAS unsigned char*)lds, 3);
#endif
    PH_SYNC(2);
    if (PH_ON(4)) phase3_mfma(p, (LAS unsigned char*)lds);
#if PROBE_DUP == 4
    xcd_barrier(xbar); phase3_mfma(p, (LAS unsigned char*)lds);
#endif
    PH_SYNC(4);
    if (PH_ON(5)) { phase4_mfma(p, (LAS unsigned char*)lds); quantize_hn(p); }
#if PROBE_DUP == 5
    xcd_barrier(xbar); phase4_mfma(p, (LAS unsigned char*)lds);
#endif
    PH_SYNC(5);
    if (PH_ON(6)) phase5a(p, (LAS unsigned char*)lds);
#if PROBE_DUP == 6
    xcd_barrier(xbar); phase5a(p, (LAS unsigned char*)lds, 1024);
#endif
    PH_SYNC(6);
    if (PH_ON(7)) phase5b(p, (LAS unsigned char*)lds);
#if PROBE_DUP == 7
    xcd_barrier(xbar); phase5b(p, (LAS unsigned char*)lds);
#endif
    PH_SYNC(7);
    if (PH_ON(8)) phase5c(p, (LAS unsigned char*)lds);
}

extern "C" void kernel_launch(void* const* d_in, const int* in_sizes, int n_in, void* d_out, int out_size, void* d_ws, size_t ws_size, hipStream_t stream) {
    static int grid = 0;
    if (grid == 0) {
        if (n_in != 21 || out_size != NTOK * DM || ws_size < WS_END) { fprintf(stderr, "kernel_launch: unexpected shapes (n_in %d out %d ws %zu)\n", n_in, out_size, ws_size); grid = -1; return; }
        int dev = 0, cus = 0, per_cu = 0;
        hipGetDevice(&dev);
        hipDeviceGetAttribute(&cus, hipDeviceAttributeMultiprocessorCount, dev);
        hipFuncSetAttribute((const void*)mega, hipFuncAttributeMaxDynamicSharedMemorySize, LDS_BYTES);
        hipOccupancyMaxActiveBlocksPerMultiprocessor(&per_cu, (const void*)mega, NTHR, LDS_BYTES);
        if (per_cu < 1) { fprintf(stderr, "kernel_launch: occupancy query says %d blocks/CU\n", per_cu); per_cu = 1; }
        grid = cus * 1;
        (void)hipGetLastError();
    }
    if (grid < 0) return;
    hipMemsetAsync((char*)d_ws + OFF_CTL, 0, CTL_BYTES, stream);
    Params p{};
    for (int i = 0; i < 21; ++i) p.in[i] = (const float*)d_in[i];
    p.out = (float*)d_out; p.ws = (unsigned char*)d_ws; p.ph_lo = 0; p.ph_hi = NPHASE;
    void* args[] = {&p};
    hipError_t e = hipLaunchCooperativeKernel((const void*)mega, dim3(grid), dim3(NTHR), args, LDS_BYTES, stream);
    if (e != hipSuccess) fprintf(stderr, "cooperative launch failed: %s (grid %d)\n", hipGetErrorString(e), grid);
}
```

```cpp
#include <hip/hip_runtime.h>
#include <hip/hip_cooperative_groups.h>
#include <cstdio>
#include <cstdint>
namespace cg = cooperative_groups;

constexpr int DM = 1024;
constexpr int NB = 8, SEQ = 2048, NMETA = 16;
constexpr int NTOK = NB * SEQ;
constexpr int MROWS = 16640;
constexpr int NIN = 3584;
constexpr int TPOS = NMETA + SEQ;
constexpr float EPS = 1e-6f;
constexpr float QSCALE = 0.125f * 1.4426950408889634f;
constexpr int NEXP = 16384;
constexpr int NTHR = 512;
#ifndef PROBE_DUP
#define PROBE_DUP 0
#endif

constexpr size_t MiB = 1u << 20;
constexpr size_t OFF_CTL = 0, CTL_BYTES = 64 * 1024;
constexpr size_t OFF_MISC = 512 * 1024;
constexpr size_t OFF_ROPE = 1 * MiB;
constexpr size_t OFF_WOUT = 2 * MiB;
constexpr size_t OFF_WQ = 4 * MiB;
constexpr size_t OFF_KEYS = 8 * MiB;
constexpr size_t OFF_SSQP = 25 * MiB;
constexpr size_t OFF_UB = 9 * MiB;
constexpr size_t OFF_VB = 41 * MiB;
constexpr size_t OFF_XN = 73 * MiB;
constexpr size_t OFF_MIX = 73 * MiB;
constexpr size_t OFF_WIN = 106 * MiB;
constexpr size_t OFF_QB = 113 * MiB;
constexpr size_t OFF_KB = OFF_QB + 16 * MiB + 256 * 1024;
constexpr size_t OFF_VT = OFF_KB + 16 * MiB + 256 * 1024;
constexpr size_t OFF_H2B = 113 * MiB;
constexpr size_t OFF_GQ = 162 * MiB;
constexpr size_t OFF_GK = OFF_GQ + 8 * MiB + 256 * 1024;
constexpr size_t OFF_GVT = OFF_GK + 8 * MiB + 256 * 1024;
constexpr size_t OFF_GF = OFF_GVT + 16 * MiB + 256 * 1024;
constexpr size_t OFF_GB = OFF_GF + 16 * MiB + 256 * 1024;
constexpr size_t OFF_GR = OFF_GB + 16 * MiB + 256 * 1024;
constexpr size_t OFF_PW0 = 162 * MiB;
constexpr size_t OFF_USC = 64 * 1024;
constexpr size_t OFF_VSC = 128 * 1024;
constexpr size_t WS_END = OFF_GR + 16 * MiB + 256 * 1024;
static_assert(WS_END <= 256 * MiB, "workspace map");
static_assert(OFF_VT + (size_t)512 * MROWS * 2 <= OFF_GQ, "map D");
static_assert(OFF_WIN + (size_t)NIN * DM * 2 <= OFF_QB, "map C");

constexpr int LDS_BYTES = 163840;
constexpr int LDS_Q = LDS_BYTES - 16;

typedef unsigned short bf16_t;
typedef float f32x4 __attribute__((ext_vector_type(4)));
typedef float f32x2 __attribute__((ext_vector_type(2)));
typedef unsigned u32x4 __attribute__((ext_vector_type(4)));
typedef unsigned u32x2 __attribute__((ext_vector_type(2)));
typedef __bf16 bf16x2_t __attribute__((ext_vector_type(2)));

struct Params {
    const float* in[21];
    float* out;
    unsigned char* ws;
    int ph_lo, ph_hi;
};

__device__ __forceinline__ unsigned f2bf(float f) { unsigned u = __float_as_uint(f); return (u + 0x7fffu + ((u >> 16) & 1u)) >> 16; }
__device__ __forceinline__ float bf2f(unsigned h) { return __uint_as_float(h << 16); }
__device__ __forceinline__ unsigned pk2(float lo, float hi) { return __builtin_bit_cast(unsigned, __builtin_convertvector((f32x2){lo, hi}, bf16x2_t)); }
__device__ __forceinline__ float bflo(unsigned w) { return __uint_as_float(w << 16); }
__device__ __forceinline__ float bfhi(unsigned w) { return __uint_as_float(w & 0xffff0000u); }
__device__ __forceinline__ float dot2(unsigned a, unsigned b, float c) {
    return __builtin_amdgcn_fdot2_f32_bf16(__builtin_bit_cast(bf16x2_t, a), __builtin_bit_cast(bf16x2_t, b), c, false);
}
__device__ __forceinline__ float dot8(u32x4 a, u32x4 b, float c) { c = dot2(a.x, b.x, c); c = dot2(a.y, b.y, c); c = dot2(a.z, b.z, c); return dot2(a.w, b.w, c); }
__device__ __forceinline__ float wave_sum(float v) {
#pragma unroll
    for (int o = 1; o < 64; o <<= 1) v += __shfl_xor(v, o);
    return v;
}
__device__ __forceinline__ float wave_max(float v) {
#pragma unroll
    for (int o = 1; o < 64; o <<= 1) v = fmaxf(v, __shfl_xor(v, o));
    return v;
}
__device__ __forceinline__ float silu_f(float x) { return x * __builtin_amdgcn_rcpf(1.f + __expf(-x)); }
__device__ __forceinline__ float logsig_f(float x) { return fminf(x, 0.f) - __logf(1.f + __expf(-fabsf(x))); }
__device__ __forceinline__ float gelu_f(float v) {
    const float av = fabsf(v), t = __builtin_amdgcn_rcpf(av * 0.2316418882f + 1.0f);
    float q = t * 0.5307027145f + (-0.7265760135f); q = q * t + 0.7107068705f; q = q * t + (-0.142248368f); q = q * t + 0.127414796f; q = q * t;
    const float m = v * (q * __builtin_amdgcn_exp2f(v * v * (-0.72134752044f)));
    return v < 0.f ? m : v - m;
}

__device__ __forceinline__ float win_src(const Params& p, int k, int n) {
    const float* W = p.in[3] + (size_t)k * 3104;
    if (n < 1024) {
        const int base = n & ~63, dp = n & 63, d = dp < 16 ? ((dp >> 1) + 8 * (dp & 1)) : dp;
        return W[base + d];
    }
    return W[n];
}

template <int WHICH>
__device__ __forceinline__ void p0_transpose_item(const Params& p, float* scr, int item, int lane) {
    constexpr int N = WHICH == 0 ? 3072 : (WHICH == 1 ? 1024 : 2048);
    constexpr int nblk = N / 32;
    const int kb = item / nblk, nb = item % nblk, k0 = 64 * kb, n0 = 32 * nb;
    bf16_t* WT = (bf16_t*)(p.ws + (WHICH == 0 ? OFF_WIN : (WHICH == 1 ? OFF_WOUT : OFF_WQ)));
    float v[32];
#pragma unroll
    for (int i = 0; i < 32; ++i) {
        const int kk = 2 * i + (lane >> 5), k = k0 + kk, n = n0 + (lane & 31);
        if (WHICH == 0) v[i] = win_src(p, k, n);
        else if (WHICH == 1) v[i] = p.in[14][(size_t)k * 1024 + n];
        else v[i] = p.in[16][(size_t)k * 2048 + n] * p.in[15][k];
    }
#pragma unroll
    for (int i = 0; i < 32; ++i) scr[(2 * i + (lane >> 5)) * 33 + (lane & 31)] = v[i];
    __builtin_amdgcn_s_waitcnt(0xC07F); __builtin_amdgcn_wave_barrier();
    const int c = lane & 7;
#pragma unroll
    for (int j = 0; j < 4; ++j) {
        const int n = (lane >> 3) + 8 * j; const float* s = scr + (8 * c) * 33 + n;
        u32x4 o; o.x = pk2(s[0 * 33], s[1 * 33]); o.y = pk2(s[2 * 33], s[3 * 33]); o.z = pk2(s[4 * 33], s[5 * 33]); o.w = pk2(s[6 * 33], s[7 * 33]);
        *(u32x4*)(WT + (size_t)(n0 + n) * 1024 + k0 + 8 * c) = o;
    }
    __builtin_amdgcn_s_waitcnt(0xC07F); __builtin_amdgcn_wave_barrier();
}

__device__ __forceinline__ void p0_gate_item(const Params& p, float* scr, int item, int lane) {
    const int kb = item >> 4, nb = item & 15, k0 = 8 * kb, jl = lane & 31, nn = 32 * nb + jl, j = nn & 255, dir = nn >> 8;
    const float* w2 = p.in[dir ? 11 : 9];
    bf16_t* WT = (bf16_t*)(p.ws + OFF_WIN);
    float w2c[16];
#pragma unroll
    for (int r = 0; r < 16; ++r) w2c[r] = w2[r * 256 + j];
    f32x4 wz[4][4];
#pragma unroll
    for (int i = 0; i < 4; ++i) { const f32x4* z = (const f32x4*)(p.in[3] + (size_t)(k0 + 2 * i + (lane >> 5)) * 3104 + 3072 + dir * 16);
#pragma unroll
        for (int q = 0; q < 4; ++q) wz[i][q] = z[q]; }
#pragma unroll
    for (int i = 0; i < 4; ++i) { float s = 0.f;
#pragma unroll
        for (int q = 0; q < 4; ++q) { s += wz[i][q].x * w2c[4 * q]; s += wz[i][q].y * w2c[4 * q + 1]; s += wz[i][q].z * w2c[4 * q + 2]; s += wz[i][q].w * w2c[4 * q + 3]; }
        scr[(2 * i + (lane >> 5)) * 33 + jl] = s; }
    __builtin_amdgcn_s_waitcnt(0xC07F); __builtin_amdgcn_wave_barrier();
    if (lane < 32) { const float* s = scr + lane;
        u32x4 o; o.x = pk2(s[0 * 33], s[1 * 33]); o.y = pk2(s[2 * 33], s[3 * 33]); o.z = pk2(s[4 * 33], s[5 * 33]); o.w = pk2(s[6 * 33], s[7 * 33]);
        *(u32x4*)(WT + (size_t)(3072 + 32 * nb + lane) * 1024 + k0) = o; }
    __builtin_amdgcn_s_waitcnt(0xC07F); __builtin_amdgcn_wave_barrier();
}

__device__ __forceinline__ void phase0(const Params& p, unsigned char* lds) {
    const int tid = threadIdx.x, lane = tid & 63, wave = tid >> 6;
    const int gw = blockIdx.x * 8 + wave, NGW = gridDim.x * 8;
    const long gt = (long)blockIdx.x * NTHR + tid, NGT = (long)gridDim.x * NTHR;
    {
        const f32x4* lw = (const f32x4*)p.in[2];
        bf16_t* XN = (bf16_t*)(p.ws + OFF_XN);
#define P0_SRC(r_) ((r_) < NTOK ? p.in[0] + (size_t)(r_) * DM : ((r_) < NTOK + NMETA ? p.in[1] + (size_t)((r_) - NTOK) * DM : nullptr))
#define P0_LOAD(V, r_) do { const float* _s = P0_SRC(r_); _Pragma("unroll") for (int j = 0; j < 4; ++j) V[j] = _s ? ((const f32x4*)_s)[lane + 64 * j] : (f32x4){0.f, 0.f, 0.f, 0.f}; } while (0)
        f32x4 vn[4];
        if (gw < MROWS) P0_LOAD(vn, gw);
        for (int r = gw; r < MROWS; r += NGW) {
            f32x4 v[4]; float s = 0.f;
#pragma unroll
            for (int j = 0; j < 4; ++j) { v[j] = vn[j]; s += v[j].x * v[j].x + v[j].y * v[j].y + v[j].z * v[j].z + v[j].w * v[j].w; }
            if (r + NGW < MROWS) P0_LOAD(vn, r + NGW);
            const float rs = rsqrtf(wave_sum(s) * (1.f / DM) + EPS);
#pragma unroll
            for (int j = 0; j < 4; ++j) { const f32x4 w = lw[lane + 64 * j]; u32x2 o; o.x = pk2(v[j].x * rs * w.x, v[j].y * rs * w.y); o.y = pk2(v[j].z * rs * w.z, v[j].w * rs * w.w);
                *(u32x2*)(XN + (size_t)r * DM + 4 * (lane + 64 * j)) = o; }
        }
#undef P0_LOAD
#undef P0_SRC
    }
    {
        float* scr = (float*)lds + wave * (64 * 33);
        constexpr int I0 = 16 * (3072 / 32);
        for (int it = gw; it < I0; it += NGW) p0_transpose_item<0>(p, scr, it, lane);
        for (int it = gw; it < (DM / 8) * 16; it += NGW) p0_gate_item(p, scr, it, lane);
    }
    {
        f32x2* rope = (f32x2*)(p.ws + OFF_ROPE);
        for (long i = gt; i < TPOS * 8; i += NGT) {
            const int t = (int)(i >> 3), j = (int)(i & 7);
            const float inv = powf(500000.0f, -(float)j * 0.125f);
            const float ang = (float)t * inv;
            rope[i] = (f32x2){cosf(ang), sinf(ang)};
        }
        if (blockIdx.x == 0 && wave == 0) {
            const float a = wave_sum(p.in[4][lane] * p.in[5][lane]), b = wave_sum(p.in[6][lane] * p.in[7][lane]);
            if (lane == 0) ((float*)(p.ws + OFF_MISC))[0] = expf(a) - expf(b) + 0.2f;
        }
    }
}
constexpr int CV_WOUT = 64, CV_WQ = 128, CV_KEYS = 8, CV_U = 256, CV_V = 256, CV_ITEMS = CV_WOUT + CV_WQ + CV_KEYS + CV_U + CV_V;
__device__ __forceinline__ void conv_item(const Params& p, unsigned char* lds, int c) {
    const int tid = threadIdx.x, lane = tid & 63, wave = tid >> 6;
    __syncthreads();
    if (c < CV_WOUT) { p0_transpose_item<1>(p, (float*)lds + wave * (64 * 33), c * 8 + wave, lane); return; }
    c -= CV_WOUT;
    if (c < CV_WQ) { p0_transpose_item<2>(p, (float*)lds + wave * (64 * 33), c * 8 + wave, lane); return; }
    c -= CV_WQ;
    if (c < CV_KEYS) {
        bf16_t* KEYS = (bf16_t*)(p.ws + OFF_KEYS);
        f32x4 a[8], b[8];
#pragma unroll
        for (int j = 0; j < 8; ++j) { const long e = ((long)c * 4096 + tid + NTHR * j) * 8; a[j] = *(const f32x4*)(p.in[17] + e); b[j] = *(const f32x4*)(p.in[17] + e + 4); }
#pragma unroll
        for (int j = 0; j < 8; ++j) {
            const long e = ((long)c * 4096 + tid + NTHR * j) * 8;
            u32x4 o; o.x = pk2(a[j].x, a[j].y); o.y = pk2(a[j].z, a[j].w); o.z = pk2(b[j].x, b[j].y); o.w = pk2(b[j].z, b[j].w);
            *(u32x4*)(KEYS + e) = o;
        }
        return;
    }
    c -= CV_KEYS;
    if (c < CV_U) {
        unsigned char* UQ = p.ws + OFF_UB; float* USC = (float*)(p.ws + OFF_USC);
        f32x4 vv[8][4];
#pragma unroll
        for (int i = 0; i < 8; ++i)
#pragma unroll
            for (int j = 0; j < 4; ++j) vv[i][j] = ((const f32x4*)(p.in[18] + (size_t)(c * 64 + wave * 8 + i) * DM + 16 * lane))[j];
        f32x4 lwv[4];
#pragma unroll
        for (int j = 0; j < 4; ++j) lwv[j] = ((const f32x4*)(p.in[15] + 16 * lane))[j];
#pragma unroll
        for (int i = 0; i < 8; ++i) {
            const int r = c * 64 + wave * 8 + i;
            f32x4 v[4]; float am = 0.f;
#pragma unroll
            for (int j = 0; j < 4; ++j) { v[j] = vv[i][j] * lwv[j]; am = fmaxf(am, fmaxf(fmaxf(fabsf(v[j].x), fabsf(v[j].y)), fmaxf(fabsf(v[j].z), fabsf(v[j].w)))); }
            am = fmaxf(wave_max(am), 1e-30f);
            const float sc = 224.f / am;
            u32x4 o;
#pragma unroll
            for (int j = 0; j < 4; ++j) { int w = __builtin_amdgcn_cvt_pk_fp8_f32(v[j].x * sc, v[j].y * sc, 0, false); w = __builtin_amdgcn_cvt_pk_fp8_f32(v[j].z * sc, v[j].w * sc, w, true); o[j] = (unsigned)w; }
            *(u32x4*)(UQ + (size_t)r * DM + 16 * lane) = o;
            if (lane == 0) USC[r] = am * (1.f / 224.f);
        }
        return;
    }
    c -= CV_U;
    {
        unsigned char* VS = p.ws + OFF_VB; float* VSC = (float*)(p.ws + OFF_VSC);
        const int tile = c;
        f32x4 vv[8][4];
#pragma unroll
        for (int i = 0; i < 8; ++i)
#pragma unroll
            for (int j = 0; j < 4; ++j) vv[i][j] = ((const f32x4*)(p.in[19] + (size_t)(tile * 64 + wave * 8 + i) * DM + 16 * lane))[j];
#pragma unroll
        for (int i = 0; i < 8; ++i) {
            const int er = wave * 8 + i, r = tile * 64 + er;
            f32x4 v[4]; float am = 0.f;
#pragma unroll
            for (int j = 0; j < 4; ++j) { v[j] = vv[i][j]; am = fmaxf(am, fmaxf(fmaxf(fabsf(v[j].x), fabsf(v[j].y)), fmaxf(fabsf(v[j].z), fabsf(v[j].w)))); }
            am = fmaxf(wave_max(am), 1e-30f);
            const float sc = 224.f / am;
            u32x4 o;
#pragma unroll
            for (int j = 0; j < 4; ++j) { int w = __builtin_amdgcn_cvt_pk_fp8_f32(v[j].x * sc, v[j].y * sc, 0, false); w = __builtin_amdgcn_cvt_pk_fp8_f32(v[j].z * sc, v[j].w * sc, w, true); o[j] = (unsigned)w; }
            *(u32x2*)(lds + er * 1032 + 16 * lane) = (u32x2){o.x, o.y}; *(u32x2*)(lds + er * 1032 + 16 * lane + 8) = (u32x2){o.z, o.w};
            if (lane == 0) VSC[r] = am * (1.f / 224.f);
        }
        __syncthreads();
#pragma unroll 4
        for (int i = 0; i < 8; ++i) {
            const int s = wave + 16 * i + 8 * (lane >> 5), e2 = 2 * (lane & 31);
            const u32x2 a = *(const u32x2*)(lds + e2 * 1032 + s * 8), b = *(const u32x2*)(lds + (e2 + 1) * 1032 + s * 8);
            *(u32x4*)(VS + ((size_t)s * NEXP + tile * 64 + e2) * 8) = (u32x4){a.x, a.y, b.x, b.y};
        }
    }
}

struct P1Ptrs { unsigned char* ws; const float* bias_f; const float* bias_b; };
__device__ __forceinline__ void p1_store(const P1Ptrs p, int row, int n0, float v0, float v1, float v2, float v3) {
    if (n0 < 1024) {
        const int dp = n0 & 63;
        if (dp < 16) {
            const int pos = row < NTOK ? NMETA + (row & (SEQ - 1)) : (row - NTOK);
            const f32x4 cs = *(const f32x4*)((const float*)(p.ws + OFF_ROPE) + ((size_t)pos * 8 + (dp >> 1)) * 2);
            const float a0 = v0 * cs.x - v1 * cs.y, b0 = v1 * cs.x + v0 * cs.y;
            const float a1 = v2 * cs.z - v3 * cs.w, b1 = v3 * cs.z + v2 * cs.w;
            v0 = a0; v1 = b0; v2 = a1; v3 = b1;
        }
        if (n0 < 512) { u32x2 o; o.x = pk2(v0 * QSCALE, v1 * QSCALE); o.y = pk2(v2 * QSCALE, v3 * QSCALE); *(u32x2*)((bf16_t*)(p.ws + OFF_QB) + (size_t)row * 512 + n0) = o; }
        else { u32x2 o; o.x = pk2(v0, v1); o.y = pk2(v2, v3); *(u32x2*)((bf16_t*)(p.ws + OFF_KB) + (size_t)row * 512 + (n0 - 512)) = o; }
    } else if (n0 < 1536) {
        bf16_t* VT = (bf16_t*)(p.ws + OFF_VT) + (size_t)(n0 - 1024) * MROWS + row;
        VT[0] = (bf16_t)f2bf(v0); VT[MROWS] = (bf16_t)f2bf(v1); VT[2 * MROWS] = (bf16_t)f2bf(v2); VT[3 * (size_t)MROWS] = (bf16_t)f2bf(v3);
    } else if (n0 < 1792) {
        u32x2 o; o.x = pk2(v0 * 0.125f, v1 * 0.125f); o.y = pk2(v2 * 0.125f, v3 * 0.125f); *(u32x2*)((bf16_t*)(p.ws + OFF_GQ) + (size_t)row * 256 + (n0 - 1536)) = o;
    } else if (n0 < 2048) {
        u32x2 o; o.x = pk2(v0, v1); o.y = pk2(v2, v3); *(u32x2*)((bf16_t*)(p.ws + OFF_GK) + (size_t)row * 256 + (n0 - 1792)) = o;
    } else if (n0 < 2560) {
        bf16_t* VT = (bf16_t*)(p.ws + OFF_GVT) + (size_t)(n0 - 2048) * MROWS + row;
        VT[0] = (bf16_t)f2bf(v0); VT[MROWS] = (bf16_t)f2bf(v1); VT[2 * MROWS] = (bf16_t)f2bf(v2); VT[3 * (size_t)MROWS] = (bf16_t)f2bf(v3);
    } else if (n0 < 3072) {
        u32x2 o; o.x = pk2(silu_f(v0), silu_f(v1)); o.y = pk2(silu_f(v2), silu_f(v3)); *(u32x2*)((bf16_t*)(p.ws + OFF_GR) + (size_t)row * 512 + (n0 - 2560)) = o;
    } else {
        const int dir = (n0 - 3072) >> 8, j = (n0 - 3072) & 255;
        const f32x4 bb = *(const f32x4*)((dir ? p.bias_b : p.bias_f) + j);
        f32x4 o; o.x = logsig_f(v0 + bb.x) * 0.0625f; o.y = logsig_f(v1 + bb.y) * 0.0625f; o.z = logsig_f(v2 + bb.z) * 0.0625f; o.w = logsig_f(v3 + bb.w) * 0.0625f;
        *(f32x4*)((float*)(p.ws + (dir ? OFF_GB : OFF_GF)) + (size_t)row * 256 + j) = o;
    }
}


#define LAS __attribute__((address_space(3)))
typedef short bf16x8 __attribute__((ext_vector_type(8)));
constexpr int GBUF = 49152;

template <int ROWS>
__device__ __forceinline__ void stage_tile(const bf16_t* G, int ldk, int r0, int k0, LAS unsigned char* buf, int wave, int lane) {
    const int rr = lane >> 3, c = (lane & 7) ^ rr;
#pragma unroll
    for (int i = 0; i < ROWS / 64; ++i) {
        const int grp = wave + 8 * i;
        const bf16_t* src = G + (size_t)(r0 + grp * 8 + rr) * ldk + k0 + c * 8;
        __builtin_amdgcn_global_load_lds((const unsigned*)src, (LAS unsigned*)(buf + grp * 1024), 16, 0, 0);
    }
}
__device__ __forceinline__ bf16x8 ldfrag(const LAS unsigned char* buf, int row, int c) {
    return *(const LAS bf16x8*)(buf + row * 128 + ((c ^ (row & 7)) << 4));
}
template <bool SWAP>
__device__ __forceinline__ void gemm_tile_256(const bf16_t* A, const bf16_t* Bt, int K, int m0, int n0, LAS unsigned char* lds, f32x4 (&acc)[4][4]) {
    const int tid = threadIdx.x, lane = tid & 63, wave = __builtin_amdgcn_readfirstlane(tid >> 6), wm = wave >> 2, wn = wave & 3, l15 = lane & 15, g = lane >> 4;
#pragma unroll
    for (int i = 0; i < 4; ++i)
#pragma unroll
        for (int j = 0; j < 4; ++j) acc[i][j] = (f32x4){0.f, 0.f, 0.f, 0.f};
    const int nk = K / 64;
    stage_tile<128>(A, K, m0, 0, lds, wave, lane);
    stage_tile<256>(Bt, K, n0, 0, lds + 16384, wave, lane);
    for (int kt = 0; kt < nk; ++kt) {
        asm volatile("s_waitcnt vmcnt(0)" ::: "memory");
        __syncthreads();
        if (kt + 1 < nk) {
            LAS unsigned char* nb = lds + ((kt + 1) & 1) * GBUF;
            stage_tile<128>(A, K, m0, (kt + 1) * 64, nb, wave, lane);
            stage_tile<256>(Bt, K, n0, (kt + 1) * 64, nb + 16384, wave, lane);
        }
        const LAS unsigned char* a = lds + (kt & 1) * GBUF; const LAS unsigned char* b = a + 16384;
#pragma unroll
        for (int ks = 0; ks < 2; ++ks) {
            bf16x8 af[4], bfr[4];
#pragma unroll
            for (int i = 0; i < 4; ++i) { af[i] = ldfrag(a, wm * 64 + i * 16 + l15, ks * 4 + g); bfr[i] = ldfrag(b, wn * 64 + i * 16 + l15, ks * 4 + g); }
#pragma unroll
            for (int i = 0; i < 4; ++i)
#pragma unroll
                for (int j = 0; j < 4; ++j)
                    acc[i][j] = SWAP ? __builtin_amdgcn_mfma_f32_16x16x32_bf16(af[i], bfr[j], acc[i][j], 0, 0, 0)
                                     : __builtin_amdgcn_mfma_f32_16x16x32_bf16(bfr[j], af[i], acc[i][j], 0, 0, 0);
        }
    }
}
__device__ __forceinline__ int vcu_of_block() { const int G = gridDim.x, bx = blockIdx.x; return (G % 8 == 0) ? (bx % 8) * (G / 8) + bx / 8 : bx; }

namespace pg8 {
#define PG8_LAS __attribute__((address_space(3)))
typedef unsigned short bf16_t;
typedef short bf16x8 __attribute__((ext_vector_type(8)));
typedef float f32x4 __attribute__((ext_vector_type(4)));
typedef unsigned u32x4 __attribute__((ext_vector_type(4)));
constexpr int BM = 256, BK = 64, HALF = 128, HTB = HALF * BK * 2  , STAGE_BYTES = 8 * HTB, NXCD = 8, WGM = 8;

__host__ __device__ __forceinline__ int lds_byte(int r, int c) { const int st = (r >> 4) * 2 + (c >> 5), rr = r & 15, cc = c & 31, ob = rr * 64 + cc * 2; return st * 1024 + (ob ^ (((ob >> 9) & 1) << 5)); }
__host__ __device__ __forceinline__ void stage_rc(int b, int& R, int& C) { const int st = b / 1024, sb = b % 1024, swz = sb ^ (((sb >> 9) & 1) << 5); R = (st >> 1) * 16 + swz / 64; C = (st & 1) * 32 + (swz % 64) / 2; }
__host__ __device__ __forceinline__ int perm32(int rho) { const int n = rho >> 4, i = rho & 15; return 8 * (i >> 2) + 4 * n + (i & 3); }

struct Unit { int pm, pn; };
struct Gemm { const bf16_t* A; const bf16_t* Bt; int M, N, K; };

struct StaticOrder {
    int nM, nN, nwg, G, c;
    __host__ __device__ void init(int M, int N, int G_, int c_) { nM = M / BM; nN = N / BM; nwg = nM * nN; G = G_; c = c_; }
    __host__ __device__ bool next(int i, Unit& u) const {
        const long L = (long)i * G + c; if (L >= nwg) return false;
        int wgid = (int)L; { const int q = nwg / NXCD, r = nwg % NXCD, xcd = wgid % NXCD, off = wgid / NXCD; wgid = (xcd < r ? xcd * (q + 1) : r * (q + 1) + (xcd - r) * q) + off; }
        const int nig = WGM * nN, gid = wgid / nig, fm = gid * WGM, gsz = (nM - fm) < WGM ? (nM - fm) : WGM;
        u.pm = fm + ((wgid % nig) % gsz); u.pn = (wgid % nig) / gsz; return true;
    }
    __device__ __forceinline__ void a_ready(const Unit&) const {}
    __device__ __forceinline__ void done(const Unit&) const {}
};

struct EpiP1 {
    static constexpr bool PERM = true, AFTER_DRAIN = false, SWAPPABLE = true;
    P1Ptrs p;
    static __device__ __forceinline__ bool swap_unit(const Unit& u) { return u.pn == 4 || u.pn == 5 || u.pn == 8 || u.pn == 9; }
    __device__ __forceinline__ void operator()(const f32x4 (&acc)[2][2][4][2], const Unit& u, int wr, int wc, int fr, int fq) const {
        if (swap_unit(u)) {
            const int cb = u.pn * BM, nbase = cb < 1536 ? cb - 1024 : cb - 2048;
            bf16_t* T = (bf16_t*)(p.ws + (cb < 1536 ? OFF_VT : OFF_GVT)) + (size_t)(nbase + wc * 32 + 8 * (fr >> 2) + (fr & 3)) * MROWS + u.pm * BM + wr * 64 + 16 * (fq & 1) + 8 * (fq >> 1);
#pragma unroll
            for (int bj = 0; bj < 2; ++bj)
#pragma unroll
                for (int n = 0; n < 2; ++n)
#pragma unroll
                    for (int ai = 0; ai < 2; ++ai)
#pragma unroll
                        for (int m = 0; m < 4; m += 2) { const f32x4 va = acc[ai][bj][m][n], vb = acc[ai][bj][m + 1][n];
                            const u32x2 sx = __builtin_amdgcn_permlane16_swap(pk2(va.x, va.y), pk2(vb.x, vb.y), false, false), sy = __builtin_amdgcn_permlane16_swap(pk2(va.z, va.w), pk2(vb.z, vb.w), false, false);
                            *(u32x4*)(T + (size_t)(bj * HALF + n * 4) * MROWS + ai * HALF + m * 16) = (u32x4){sx.x, sy.x, sx.y, sy.y}; }
            return;
        }
#pragma unroll
        for (int bj = 0; bj < 2; ++bj) {
            const int nw = u.pn * BM + bj * HALF + wc * 32;
            const int rowb = u.pm * BM + wr * 64 + fr;
            if (nw >= 3072) {
                const int dir = (nw - 3072) >> 8, j0 = ((nw - 3072) & 255) + 8 * fq;
                float* G = (float*)(p.ws + (dir ? OFF_GB : OFF_GF)); const float* bias = dir ? p.bias_b : p.bias_f;
                const f32x4 b0 = *(const f32x4*)(bias + j0), b1 = *(const f32x4*)(bias + j0 + 4);
#pragma unroll
                for (int ai = 0; ai < 2; ++ai)
#pragma unroll
                    for (int m = 0; m < 4; ++m) { const f32x4 v0 = acc[ai][bj][m][0], v1 = acc[ai][bj][m][1]; f32x4 o0, o1;
                        o0.x = logsig_f(v0.x + b0.x) * 0.0625f; o0.y = logsig_f(v0.y + b0.y) * 0.0625f; o0.z = logsig_f(v0.z + b0.z) * 0.0625f; o0.w = logsig_f(v0.w + b0.w) * 0.0625f;
                        o1.x = logsig_f(v1.x + b1.x) * 0.0625f; o1.y = logsig_f(v1.y + b1.y) * 0.0625f; o1.z = logsig_f(v1.z + b1.z) * 0.0625f; o1.w = logsig_f(v1.w + b1.w) * 0.0625f;
                        float* gp = G + (size_t)(rowb + ai * HALF + m * 16) * 256 + j0; *(f32x4*)gp = o0; *(f32x4*)(gp + 4) = o1; }
            } else {
                bf16_t* base; int ld, c0; float sc = 1.f; bool silu = false;
                if (nw < 512) { base = (bf16_t*)(p.ws + OFF_QB); ld = 512; c0 = nw; sc = QSCALE; }
                else if (nw < 1024) { base = (bf16_t*)(p.ws + OFF_KB); ld = 512; c0 = nw - 512; }
                else if (nw < 1792) { base = (bf16_t*)(p.ws + OFF_GQ); ld = 256; c0 = nw - 1536; sc = 0.125f; }
                else if (nw < 2048) { base = (bf16_t*)(p.ws + OFF_GK); ld = 256; c0 = nw - 1792; }
                else { base = (bf16_t*)(p.ws + OFF_GR); ld = 512; c0 = nw - 2560; silu = true; }
                const bool rope = nw < 1024 && (nw & 63) == 0 && fq < 2;
#pragma unroll
                for (int ai = 0; ai < 2; ++ai)
#pragma unroll
                    for (int m = 0; m < 4; ++m) {
                        const int row = rowb + ai * HALF + m * 16;
                        f32x4 v0 = acc[ai][bj][m][0], v1 = acc[ai][bj][m][1];
                        if (rope) {
                            const int pos = row < NTOK ? NMETA + (row & (SEQ - 1)) : (row - NTOK < TPOS ? row - NTOK : 0);
                            const f32x4* cp = (const f32x4*)((const float*)(p.ws + OFF_ROPE) + ((size_t)pos * 8 + 4 * fq) * 2);
                            const f32x4 ca = cp[0], cb2 = cp[1];
                            v0 = (f32x4){v0.x * ca.x - v0.y * ca.y, v0.y * ca.x + v0.x * ca.y, v0.z * ca.z - v0.w * ca.w, v0.w * ca.z + v0.z * ca.w};
                            v1 = (f32x4){v1.x * cb2.x - v1.y * cb2.y, v1.y * cb2.x + v1.x * cb2.y, v1.z * cb2.z - v1.w * cb2.w, v1.w * cb2.z + v1.z * cb2.w};
                        }
                        if (silu) { v0 = (f32x4){silu_f(v0.x), silu_f(v0.y), silu_f(v0.z), silu_f(v0.w)}; v1 = (f32x4){silu_f(v1.x), silu_f(v1.y), silu_f(v1.z), silu_f(v1.w)}; }
                        else { v0 = v0 * sc; v1 = v1 * sc; }
                        *(u32x4*)(base + (size_t)row * ld + c0 + 8 * fq) = (u32x4){pk2(v0.x, v0.y), pk2(v0.z, v0.w), pk2(v1.x, v1.y), pk2(v1.z, v1.w)};
                    }
            }
        }
    }
};
struct EpiP3 {
    static constexpr bool PERM = true, AFTER_DRAIN = false, SWAPPABLE = false;
    const float* x; float* out; bf16_t* h2b; float* ssq;
    __device__ __forceinline__ void operator()(const f32x4 (&acc)[2][2][4][2], const Unit& u, int wr, int wc, int fr, int fq) const {
#pragma unroll
        for (int ai = 0; ai < 2; ++ai)
#pragma unroll
            for (int m = 0; m < 4; ++m) { const int row = u.pm * BM + ai * HALF + wr * 64 + m * 16 + fr; float ss = 0.f;
#pragma unroll
                for (int bj = 0; bj < 2; ++bj) { const int col = u.pn * BM + bj * HALF + wc * 32 + 8 * fq;
                    const f32x4 h0 = *(const f32x4*)(x + (size_t)row * DM + col) + acc[ai][bj][m][0], h1 = *(const f32x4*)(x + (size_t)row * DM + col + 4) + acc[ai][bj][m][1];
                    *(u32x4*)(h2b + (size_t)row * DM + col) = (u32x4){pk2(h0.x, h0.y), pk2(h0.z, h0.w), pk2(h1.x, h1.y), pk2(h1.z, h1.w)};
                    ss += (h0.x * h0.x + h0.y * h0.y + h0.z * h0.z + h0.w * h0.w) + (h1.x * h1.x + h1.y * h1.y + h1.z * h1.z + h1.w * h1.w); }
                ss += __shfl_xor(ss, 16); ss += __shfl_xor(ss, 32);
                if (fq == 0) ssq[(size_t)row * 16 + u.pn * 4 + wc] = ss; }
    }
};

struct P1Order {
    int G, c, ncol, nM; bool vt;
    __device__ __forceinline__ bool next(int i, Unit& u) const {
        const int nwg = nM * ncol; const int L = i * G + (vt ? (G - 1 - c) : c); if (L >= nwg) return false;
        const int pm = L / ncol, j = L % ncol;
        u.pm = pm; u.pn = vt ? (j < 2 ? 4 + j : 6 + j) : (j < 4 ? j : (j < 6 ? j + 2 : j + 4));
        return true;
    }
    __device__ __forceinline__ void a_ready(const Unit&) const {}
    __device__ __forceinline__ void done(const Unit&) const {}
};
struct OneUnit {
    Unit u; bool valid;
    __device__ __forceinline__ bool next(int i, Unit& o) const { if (i != 0 || !valid) return false; o = u; return true; }
    __device__ __forceinline__ void a_ready(const Unit&) const {}
    __device__ __forceinline__ void done(const Unit&) const {}
};

template <class Epi, class Sched, bool ALIGN_EPI = false, bool SP2 = false, bool SWP = false>
__device__ __forceinline__ void gemm_phase(PG8_LAS unsigned char* lds, const Gemm g, const Sched& S, const Epi& E) {
    int tid_ = threadIdx.x; asm volatile("" : "+v"(tid_));
    const int tid = tid_, wid = __builtin_amdgcn_readfirstlane(tid >> 6), lane = tid & 63, wr = wid >> 2, wc = wid & 3, fr = lane & 15, fq = lane >> 4;
    const int K = g.K, nt = K / BK;
    unsigned voffA[2], voffB[2];
#pragma unroll
    for (int i = 0; i < 2; ++i) { int R, C; stage_rc(tid * 16 + i * 8192, R, C); const int Rb = Epi::PERM ? ((R & ~31) + perm32(R & 31)) : R;
        voffA[i] = (unsigned)(R * K + C) * 2u; voffB[i] = (unsigned)(Rb * K + C) * 2u; }
    const size_t kstep = (size_t)(BK * 2);
    const size_t hstep = (size_t)HALF * K * 2;
    const size_t tstep = 2 * hstep;
    const unsigned ldsw = (unsigned)wid * 1024u;
    const int aoff = lds_byte(wr * 64 + fr, fq * 8), boff = lds_byte(wc * 32 + fr, fq * 8);
#define PG8_SA(b, h) (((b) * 2 + (h)) * HTB)
#define PG8_SB(b, h) ((4 + (b) * 2 + (h)) * HTB)
#define PG8_STAGE(bufoff, gbase, voff) do { _Pragma("unroll") for (int _i = 0; _i < 2; ++_i) \
        __builtin_amdgcn_global_load_lds((const unsigned*)((const char*)(gbase) + (voff)[_i]), (PG8_LAS unsigned*)(lds + (bufoff) + ldsw + _i * 8192), 16, 0, 0); } while (0)
#define PG8_LDA(dst, b, h) do { _Pragma("unroll") for (int m = 0; m < 4; ++m) _Pragma("unroll") for (int k = 0; k < 2; ++k) dst[m][k] = *(const PG8_LAS bf16x8*)(lds + PG8_SA(b, h) + aoff + m * 2048 + k * 1024); } while (0)
#define PG8_LDB(dst, b, h) do { _Pragma("unroll") for (int n = 0; n < 2; ++n) _Pragma("unroll") for (int k = 0; k < 2; ++k) dst[n][k] = *(const PG8_LAS bf16x8*)(lds + PG8_SB(b, h) + boff + n * 2048 + k * 1024); } while (0)
#define PG8_MMA(ai, bj, At, Bt) do { __builtin_amdgcn_s_setprio(1); \
        if (SWP) { _Pragma("unroll") for (int m = 0; m < 4; ++m) _Pragma("unroll") for (int n = 0; n < 2; ++n) _Pragma("unroll") for (int k = 0; k < 2; ++k) \
            acc[ai][bj][m][n] = __builtin_amdgcn_mfma_f32_16x16x32_bf16(At[m][k], Bt[n][k], acc[ai][bj][m][n], 0, 0, 0); } \
        else { _Pragma("unroll") for (int m = 0; m < 4; ++m) _Pragma("unroll") for (int n = 0; n < 2; ++n) _Pragma("unroll") for (int k = 0; k < 2; ++k) \
            acc[ai][bj][m][n] = __builtin_amdgcn_mfma_f32_16x16x32_bf16(Bt[n][k], At[m][k], acc[ai][bj][m][n], 0, 0, 0); } \
        __builtin_amdgcn_s_setprio(0); } while (0)
#define PG8_WAIT_V(n) asm volatile("s_waitcnt vmcnt(" #n ")" ::: "memory")
#define PG8_WAIT_L(n) asm volatile("s_waitcnt lgkmcnt(" #n ")" ::: "memory")
#define PG8_BAR __builtin_amdgcn_s_barrier()
#define PG8_SCHED __builtin_amdgcn_sched_barrier(0)
    Unit cur, nxt; int ui = 0;
    if (!S.next(0, cur)) return;
    f32x4 acc[2][2][4][2];
#pragma unroll
    for (int a = 0; a < 2; ++a)
#pragma unroll
        for (int b = 0; b < 2; ++b)
#pragma unroll
            for (int m = 0; m < 4; ++m)
#pragma unroll
                for (int n = 0; n < 2; ++n) acc[a][b][m][n] = (f32x4){0.f, 0.f, 0.f, 0.f};
    bf16x8 At[4][2], B0[2][2], B1[2][2];
    const char* cA = (const char*)g.A + (size_t)cur.pm * tstep; const char* cB = (const char*)g.Bt + (size_t)cur.pn * tstep;
    S.a_ready(cur);
    if constexpr (SP2) {
        PG8_STAGE(PG8_SB(0, 0), cB, voffB); PG8_STAGE(PG8_SB(0, 1), cB + hstep, voffB); PG8_STAGE(PG8_SA(0, 0), cA, voffA); PG8_STAGE(PG8_SA(0, 1), cA + hstep, voffA);
        if (wr == 1) PG8_BAR;
        PG8_WAIT_V(2); PG8_BAR;
        PG8_STAGE(PG8_SB(1, 0), cB + kstep, voffB); PG8_STAGE(PG8_SA(1, 0), cA + kstep, voffA); PG8_STAGE(PG8_SB(1, 1), cB + hstep + kstep, voffB);
        PG8_WAIT_V(6); PG8_BAR;
    } else {
        PG8_STAGE(PG8_SB(0, 0), cB, voffB); PG8_STAGE(PG8_SA(0, 0), cA, voffA); PG8_STAGE(PG8_SB(0, 1), cB + hstep, voffB); PG8_STAGE(PG8_SA(0, 1), cA + hstep, voffA);
        if (wr == 1) PG8_BAR;
        PG8_WAIT_V(4); PG8_BAR;
        PG8_STAGE(PG8_SB(1, 0), cB + kstep, voffB); PG8_STAGE(PG8_SA(1, 0), cA + kstep, voffA); PG8_STAGE(PG8_SB(1, 1), cB + hstep + kstep, voffB);
        PG8_WAIT_V(6); PG8_BAR;
    }
    for (;;) {
        const bool has_next = S.next(ui + 1, nxt);
        const char* nA = has_next ? (const char*)g.A + (size_t)nxt.pm * tstep : cA; const char* nB = has_next ? (const char*)g.Bt + (size_t)nxt.pn * tstep : cB;
        for (int t = 0; t < nt; t += 2) {
            const bool last = (t == nt - 2);
            const char* a1 = cA + (size_t)(t + 1) * kstep;
            const char* a2 = last ? nA : cA + (size_t)(t + 2) * kstep; const char* b2 = last ? nB : cB + (size_t)(t + 2) * kstep;
            const char* a3 = a2 + kstep; const char* b3 = b2 + kstep;
            if (last && has_next) S.a_ready(nxt);
            if constexpr (SP2) {
            PG8_LDB(B0, 0, 0); PG8_LDB(B1, 0, 1); PG8_SCHED; PG8_LDA(At, 0, 0); PG8_STAGE(PG8_SA(1, 1), a1 + hstep, voffA);
            PG8_WAIT_V(8); PG8_WAIT_L(0); PG8_BAR; PG8_MMA(0, 0, At, B0); PG8_MMA(0, 1, At, B1); PG8_BAR; PG8_SCHED;
            PG8_LDA(At, 0, 1); PG8_STAGE(PG8_SB(0, 0), b2, voffB); PG8_STAGE(PG8_SB(0, 1), b2 + hstep, voffB); PG8_STAGE(PG8_SA(0, 0), a2, voffA);
            PG8_WAIT_V(8); PG8_WAIT_L(0); PG8_BAR; PG8_MMA(1, 0, At, B0); PG8_MMA(1, 1, At, B1); PG8_BAR; PG8_SCHED;
            PG8_LDB(B0, 1, 0); PG8_LDB(B1, 1, 1); PG8_SCHED; PG8_LDA(At, 1, 0); PG8_STAGE(PG8_SA(0, 1), a2 + hstep, voffA);
            PG8_WAIT_V(8); PG8_WAIT_L(0); PG8_BAR; PG8_MMA(0, 0, At, B0); PG8_MMA(0, 1, At, B1); PG8_BAR; PG8_SCHED;
            PG8_LDA(At, 1, 1); PG8_STAGE(PG8_SB(1, 0), b3, voffB); PG8_STAGE(PG8_SB(1, 1), b3 + hstep, voffB); PG8_STAGE(PG8_SA(1, 0), a3, voffA);
            PG8_WAIT_V(8); PG8_WAIT_L(0); PG8_BAR; PG8_MMA(1, 0, At, B0); PG8_MMA(1, 1, At, B1); PG8_BAR; PG8_SCHED;
            } else {
            PG8_LDB(B0, 0, 0); PG8_SCHED; PG8_LDA(At, 0, 0); PG8_STAGE(PG8_SA(1, 1), a1 + hstep, voffA);
            PG8_WAIT_L(8); PG8_BAR; PG8_WAIT_L(0); PG8_MMA(0, 0, At, B0); PG8_BAR; PG8_SCHED;
            PG8_LDB(B1, 0, 1); PG8_STAGE(PG8_SB(0, 0), b2, voffB);
            PG8_BAR; PG8_WAIT_L(0); PG8_MMA(0, 1, At, B1); PG8_BAR;
            PG8_LDA(At, 0, 1); PG8_STAGE(PG8_SA(0, 0), a2, voffA);
            PG8_BAR; PG8_WAIT_L(0); PG8_MMA(1, 0, At, B0); PG8_BAR; PG8_SCHED;
            PG8_STAGE(PG8_SB(0, 1), b2 + hstep, voffB);
            PG8_WAIT_V(6); PG8_BAR; PG8_MMA(1, 1, At, B1); PG8_BAR;
            PG8_LDB(B0, 1, 0); PG8_SCHED; PG8_LDA(At, 1, 0); PG8_STAGE(PG8_SA(0, 1), a2 + hstep, voffA);
            PG8_WAIT_L(8); PG8_BAR; PG8_WAIT_L(0); PG8_MMA(0, 0, At, B0); PG8_BAR; PG8_SCHED;
            PG8_LDB(B1, 1, 1); PG8_STAGE(PG8_SB(1, 0), b3, voffB);
            PG8_BAR; PG8_WAIT_L(0); PG8_MMA(0, 1, At, B1); PG8_BAR;
            PG8_LDA(At, 1, 1); PG8_STAGE(PG8_SA(1, 0), a3, voffA);
            PG8_BAR; PG8_WAIT_L(0); PG8_MMA(1, 0, At, B0); PG8_BAR; PG8_SCHED;
            PG8_STAGE(PG8_SB(1, 1), b3 + hstep, voffB);
            PG8_WAIT_V(6); PG8_BAR; PG8_MMA(1, 1, At, B1); PG8_BAR;
            }
        }
        if constexpr (ALIGN_EPI) { if (wr == 0) PG8_BAR; }
        if constexpr (!Epi::AFTER_DRAIN) { E(acc, cur, wr, wc, fr, fq); S.done(cur); }
        if (!has_next) break;
#pragma unroll
        for (int a = 0; a < 2; ++a)
#pragma unroll
            for (int b = 0; b < 2; ++b)
#pragma unroll
                for (int m = 0; m < 4; ++m)
#pragma unroll
                    for (int n = 0; n < 2; ++n) acc[a][b][m][n] = (f32x4){0.f, 0.f, 0.f, 0.f};
        cur = nxt; cA = nA; cB = nB; ++ui;
        if constexpr (ALIGN_EPI) { if (wr == 1) PG8_BAR; }
    }
    PG8_WAIT_V(0);
    if constexpr (!ALIGN_EPI) { if (wr == 0) PG8_BAR; }
    PG8_BAR;
    if constexpr (Epi::AFTER_DRAIN) { E.fused(acc, cur, wr, wc, fr, fq, lds, wid, lane); S.done(cur); }
#undef PG8_SA
#undef PG8_SB
#undef PG8_STAGE
#undef PG8_LDA
#undef PG8_LDB
#undef PG8_MMA
#undef PG8_WAIT_V
#undef PG8_WAIT_L
#undef PG8_BAR
#undef PG8_SCHED
}
}
__device__ __forceinline__ float row_rstd(const float* ssq, int row) {
    const f32x4* q = (const f32x4*)(ssq + (size_t)row * 16);
    const f32x4 a = q[0], b = q[1], c = q[2], d = q[3];
    return rsqrtf(((((a.x + a.y) + (a.z + a.w)) + ((b.x + b.y) + (b.z + b.w))) + (((c.x + c.y) + (c.z + c.w)) + ((d.x + d.y) + (d.z + d.w)))) * (1.f / DM) + EPS);
}
__device__ __forceinline__ void phase1_mfma(const Params& p, LAS unsigned char* lds) {
    pg8::Gemm g{(const pg8::bf16_t*)(p.ws + OFF_XN), (const pg8::bf16_t*)(p.ws + OFF_WIN), MROWS, NIN, DM};
    pg8::EpiP1 E{P1Ptrs{p.ws, p.in[10], p.in[12]}};
    const int vcu = vcu_of_block();
    pg8::P1Order S0{(int)gridDim.x, vcu, 10, MROWS / 256, false}, S1{(int)gridDim.x, vcu, 4, MROWS / 256, true};
    pg8::gemm_phase<pg8::EpiP1, pg8::P1Order, true, true, false>(lds, g, S0, E);
    pg8::gemm_phase<pg8::EpiP1, pg8::P1Order, true, true, true>(lds, g, S1, E);
    const int G = (int)gridDim.x, nun = MROWS / 256;
    const int mine = (10 * nun - vcu + G - 1) / G + (4 * nun - (G - 1 - vcu) + G - 1) / G, most = (10 * nun + G - 1) / G + 1;
    if (mine < most) {
        unsigned* ctr = (unsigned*)(p.ws + OFF_CTL) + 128;
        for (int k = 0; k < 3; ++k) {
            __syncthreads();
            if (threadIdx.x == 0) *(LAS unsigned*)(lds + LDS_Q) = atomicAdd(ctr, 1u);
            __syncthreads();
            const int c = (int)*(LAS unsigned*)(lds + LDS_Q);
            if (c >= CV_ITEMS) break;
            conv_item(p, (unsigned char*)lds, c);
        }
    }
}
__device__ __forceinline__ void phase3_mfma(const Params& p, LAS unsigned char* lds) {
    pg8::Gemm g{(const pg8::bf16_t*)(p.ws + OFF_MIX), (const pg8::bf16_t*)(p.ws + OFF_WOUT), NTOK, DM, DM};
    pg8::StaticOrder S; S.init(NTOK, DM, (int)gridDim.x, (int)blockIdx.x);
    pg8::EpiP3 E{p.in[0], p.out, (bf16_t*)(p.ws + OFF_H2B), (float*)(p.ws + OFF_SSQP)};
    pg8::gemm_phase<pg8::EpiP3, pg8::StaticOrder, true, true>(lds, g, S, E);
}

typedef float f32x16 __attribute__((ext_vector_type(16)));
constexpr int AT_KROW = 272, AT_VROW = 144, AT_KBYTES = 64 * AT_KROW, AT_VBYTES = 128 * AT_VROW, AT_STAGE = AT_KBYTES + AT_VBYTES;
__device__ __forceinline__ void attn_item(const Params& p, LAS unsigned char* lds, int item, unsigned* qctr = nullptr) {
    const int tid = threadIdx.x, lane = tid & 63, wave = __builtin_amdgcn_readfirstlane(tid >> 6), qg = wave >> 1, c = wave & 1, l31 = lane & 31, hh = lane >> 5;
    const int qt = item & 15, h = (item >> 4) & 3, b = item >> 6;
    const int r0 = b * SEQ + qt * 128;
    const bf16_t* QB = (const bf16_t*)(p.ws + OFF_QB); const bf16_t* KB = (const bf16_t*)(p.ws + OFF_KB); const bf16_t* VT = (const bf16_t*)(p.ws + OFF_VT);
    bf16x8 qf[4];
    {
        const bf16_t* qp = QB + (size_t)(r0 + qg * 32 + l31) * 512 + h * 128 + c * 64 + 8 * hh;
#pragma unroll
        for (int s = 0; s < 4; ++s) qf[s] = *(const bf16x8*)(qp + 16 * s);
    }
    f32x16 O[4];
#pragma unroll
    for (int i = 0; i < 4; ++i)
#pragma unroll
        for (int r = 0; r < 16; ++r) O[i][r] = 0.f;
    float m = 0.f, l = 0.f;
    f32x16 negm;
#pragma unroll
    for (int r = 0; r < 16; ++r) negm[r] = 0.f;
    const int kq0 = tid, kq1 = tid + 512;
    const bf16_t* kg0 = KB + (size_t)(kq0 >> 4) * 512 + h * 128 + (kq0 & 15) * 8; const bf16_t* kg1 = KB + (size_t)(kq1 >> 4) * 512 + h * 128 + (kq1 & 15) * 8;
    const bf16_t* vg0 = VT + (size_t)(h * 128 + (kq0 >> 3)) * MROWS + (kq0 & 7) * 8; const bf16_t* vg1 = VT + (size_t)(h * 128 + (kq1 >> 3)) * MROWS + (kq1 & 7) * 8;
    const int kl0 = (kq0 >> 4) * AT_KROW + (kq0 & 15) * 16, kl1 = (kq1 >> 4) * AT_KROW + (kq1 & 15) * 16;
    const int vl0 = AT_KBYTES + (kq0 >> 3) * AT_VROW + ((kq0 & 7) >> 1) * 32 + (kq0 & 1) * 8, vl1 = AT_KBYTES + (kq1 >> 3) * AT_VROW + ((kq1 & 7) >> 1) * 32 + (kq1 & 1) * 8;
    u32x4 kr0, kr1, vr0, vr1;
#define AT_LOAD(t) do { const size_t kro = (size_t)((t) < 32 ? b * SEQ + (t) * 64 : NTOK); \
        kr0 = *(const u32x4*)(kg0 + kro * 512); kr1 = *(const u32x4*)(kg1 + kro * 512); vr0 = *(const u32x4*)(vg0 + kro); vr1 = *(const u32x4*)(vg1 + kro); } while (0)
#define AT_WRITE(buf) do { LAS unsigned char* _b = lds + (buf) * AT_STAGE; \
        *(LAS u32x4*)(_b + kl0) = kr0; *(LAS u32x4*)(_b + kl1) = kr1; \
        *(LAS u32x2*)(_b + vl0) = (u32x2){vr0.x, vr0.y}; *(LAS u32x2*)(_b + vl0 + 16) = (u32x2){vr0.z, vr0.w}; \
        *(LAS u32x2*)(_b + vl1) = (u32x2){vr1.x, vr1.y}; *(LAS u32x2*)(_b + vl1 + 16) = (u32x2){vr1.z, vr1.w}; } while (0)
    __syncthreads();
    {
        AT_LOAD(0);
        const size_t kro1 = (size_t)(b * SEQ + 64);
        const u32x4 kr0b = *(const u32x4*)(kg0 + kro1 * 512), kr1b = *(const u32x4*)(kg1 + kro1 * 512), vr0b = *(const u32x4*)(vg0 + kro1), vr1b = *(const u32x4*)(vg1 + kro1);
        AT_WRITE(0);
        LAS unsigned char* _b = lds + AT_STAGE;
        *(LAS u32x4*)(_b + kl0) = kr0b; *(LAS u32x4*)(_b + kl1) = kr1b;
        *(LAS u32x2*)(_b + vl0) = (u32x2){vr0b.x, vr0b.y}; *(LAS u32x2*)(_b + vl0 + 16) = (u32x2){vr0b.z, vr0b.w};
        *(LAS u32x2*)(_b + vl1) = (u32x2){vr1b.x, vr1b.y}; *(LAS u32x2*)(_b + vl1 + 16) = (u32x2){vr1b.z, vr1b.w};
        AT_LOAD(2);
    }
    __syncthreads();
    int scur = 0;
    for (int t = 0; t < 33; ++t) {
        const int snxt2 = scur == 0 ? 2 : scur - 1;
        if (t + 2 < 33) { AT_WRITE(snxt2); if (t + 3 < 33) AT_LOAD(t + 3); }
        const LAS unsigned char* kb_ = lds + scur * AT_STAGE; const LAS unsigned char* vb_ = kb_ + AT_KBYTES;
        f32x16 s0, s1;
#pragma unroll
        for (int s = 0; s < 4; ++s) {
            const bf16x8 k0 = *(const LAS bf16x8*)(kb_ + l31 * AT_KROW + (c * 64 + 16 * s + 8 * hh) * 2);
            s0 = __builtin_amdgcn_mfma_f32_32x32x16_bf16(k0, qf[s], s == 0 ? negm : s0, 0, 0, 0);
        }
#pragma unroll
        for (int s = 0; s < 4; ++s) {
            const bf16x8 k1 = *(const LAS bf16x8*)(kb_ + (32 + l31) * AT_KROW + (c * 64 + 16 * s + 8 * hh) * 2);
            s1 = __builtin_amdgcn_mfma_f32_32x32x16_bf16(k1, qf[s], s == 0 ? negm : s1, 0, 0, 0);
        }
        if (t == 32) {
#pragma unroll
            for (int r = 0; r < 16; ++r) { const int key = (r & 3) + 8 * (r >> 2) + 4 * hh; if (key >= 16) s0[r] = -1e30f; s1[r] = -1e30f; }
        }
        float mx = s0[0];
#pragma unroll
        for (int r = 1; r < 16; ++r) mx = fmaxf(mx, s0[r]);
#pragma unroll
        for (int r = 0; r < 16; ++r) mx = fmaxf(mx, s1[r]);
        { const u32x2 sw_ = __builtin_amdgcn_permlane32_swap(__float_as_uint(mx), __float_as_uint(mx), false, false); mx = fmaxf(__uint_as_float(sw_.x), __uint_as_float(sw_.y)); }
        if (t == 0 || __any(mx > 8.0f)) {
            const float d = t == 0 ? mx : fmaxf(mx, 0.f), alpha = __builtin_amdgcn_exp2f(-d);
            m += d; l *= alpha;
#pragma unroll
            for (int r = 0; r < 16; ++r) negm[r] = -m;
#pragma unroll
            for (int i = 0; i < 4; ++i) O[i] = O[i] * alpha;
#pragma unroll
            for (int r = 0; r < 16; ++r) { s0[r] -= d; s1[r] -= d; }
        }
        float ps = 0.f;
#define AT_PV(SREG, kb) do { \
        _Pragma("unroll") for (int r = 0; r < 16; ++r) { SREG[r] = __builtin_amdgcn_exp2f(SREG[r]); ps += SREG[r]; } \
        bf16x8 pf0, pf1; \
        { u32x4 a; a.x = pk2(SREG[0], SREG[1]); a.y = pk2(SREG[2], SREG[3]); a.z = pk2(SREG[4], SREG[5]); a.w = pk2(SREG[6], SREG[7]); pf0 = __builtin_bit_cast(bf16x8, a); \
          u32x4 bq; bq.x = pk2(SREG[8], SREG[9]); bq.y = pk2(SREG[10], SREG[11]); bq.z = pk2(SREG[12], SREG[13]); bq.w = pk2(SREG[14], SREG[15]); pf1 = __builtin_bit_cast(bf16x8, bq); } \
        _Pragma("unroll") for (int vb = 0; vb < 4; ++vb) { \
            const LAS unsigned char* vp = vb_ + (vb * 32 + l31) * AT_VROW + (kb) * 64 + hh * 16; \
            O[vb] = __builtin_amdgcn_mfma_f32_32x32x16_bf16(*(const LAS bf16x8*)vp, pf0, O[vb], 0, 0, 0); \
            O[vb] = __builtin_amdgcn_mfma_f32_32x32x16_bf16(*(const LAS bf16x8*)(vp + 32), pf1, O[vb], 0, 0, 0); } } while (0)
        AT_PV(s0, 0);
        AT_PV(s1, 1);
#undef AT_PV
        l += ps;
        __syncthreads();
        scur = scur == 2 ? 0 : scur + 1;
    }
    unsigned qnext = 0u;
    if (qctr && tid == 0) qnext = atomicAdd(qctr, 1u);
    const float inv = 1.f / (l + __shfl_xor(l, 32));
    LAS float* X = (LAS float*)lds + qg * 4096;
    if (c == 1) {
#pragma unroll
        for (int vb = 0; vb < 4; ++vb)
#pragma unroll
            for (int r = 0; r < 16; ++r) X[(vb * 16 + r) * 64 + lane] = O[vb][r] * inv;
    }
    __syncthreads();
    if (c == 0) {
        const float lam = ((const float*)(p.ws + OFF_MISC))[0];
        float ss = 0.f;
#pragma unroll
        for (int vb = 0; vb < 4; ++vb)
#pragma unroll
            for (int r = 0; r < 16; ++r) { const float y = O[vb][r] * inv - lam * X[(vb * 16 + r) * 64 + lane]; O[vb][r] = y; ss += y * y; }
        ss += __shfl_xor(ss, 32);
        const float rs = rsqrtf(ss * (1.f / 128.f) + EPS) * 0.8f;
        bf16_t* orow = (bf16_t*)(p.ws + OFF_MIX) + (size_t)(r0 + qg * 32 + l31) * DM + h * 128;
#pragma unroll
        for (int vb = 0; vb < 4; ++vb) {
            u32x2 o[4];
#pragma unroll
            for (int rq = 0; rq < 4; ++rq) {
                const f32x4 wlo = *(const f32x4*)(p.in[8] + vb * 32 + 8 * rq), whi = *(const f32x4*)(p.in[8] + vb * 32 + 8 * rq + 4);
                const f32x4 w = hh ? whi : wlo;
                o[rq].x = pk2(O[vb][4 * rq] * rs * w.x, O[vb][4 * rq + 1] * rs * w.y); o[rq].y = pk2(O[vb][4 * rq + 2] * rs * w.z, O[vb][4 * rq + 3] * rs * w.w);
            }
#pragma unroll
            for (int rq = 0; rq < 4; rq += 2) {
                const u32x2 sx = __builtin_amdgcn_permlane32_swap(o[rq].x, o[rq + 1].x, false, false), sy = __builtin_amdgcn_permlane32_swap(o[rq].y, o[rq + 1].y, false, false);
                *(u32x4*)(orow + vb * 32 + 8 * rq + 8 * hh) = (u32x4){sx.x, sy.x, sx.y, sy.y};
            }
        }
    }
    if (qctr && tid == 0) *(LAS unsigned*)(lds + LDS_Q) = qnext;
#undef AT_LOAD
#undef AT_WRITE
}
__device__ __forceinline__ void phase2_attn_mfma(const Params& p, LAS unsigned char* lds) {
    for (int it = vcu_of_block(); it < NB * 4 * 16; it += gridDim.x) attn_item(p, lds, it);
}


__device__ __forceinline__ int gsw(int row, int chunk) { return row * 128 + ((chunk ^ (row & 7)) << 4); }
constexpr int GL_SET = 40960;
constexpr int GL_QS = 0, GL_KS = 8192, GL_KT = 16384, GL_VT = 24576, GL_AT = 2 * GL_SET, GL_ST = GL_AT + 8192  , GL_DV = GL_ST + 32768  ;
__device__ __forceinline__ float dpp_scan64(float v) {
    v += __builtin_bit_cast(float, __builtin_amdgcn_update_dpp(0, __builtin_bit_cast(int, v), 0x111, 0xf, 0xf, false));
    v += __builtin_bit_cast(float, __builtin_amdgcn_update_dpp(0, __builtin_bit_cast(int, v), 0x112, 0xf, 0xf, false));
    v += __builtin_bit_cast(float, __builtin_amdgcn_update_dpp(0, __builtin_bit_cast(int, v), 0x114, 0xf, 0xf, false));
    v += __builtin_bit_cast(float, __builtin_amdgcn_update_dpp(0, __builtin_bit_cast(int, v), 0x118, 0xf, 0xf, false));
    v += __builtin_bit_cast(float, __builtin_amdgcn_update_dpp(0, __builtin_bit_cast(int, v), 0x142, 0xa, 0xf, false));
    v += __builtin_bit_cast(float, __builtin_amdgcn_update_dpp(0, __builtin_bit_cast(int, v), 0x143, 0xc, 0xf, false));
    return v;
}
#define DPP_STAGE8(CTRL, RM) _Pragma("unroll") for (int e = 0; e < 8; ++e) v[e] += __builtin_bit_cast(float, __builtin_amdgcn_update_dpp(0, __builtin_bit_cast(int, v[e]), CTRL, RM, 0xf, false))
__device__ __forceinline__ void dpp_scan64x8(float (&v)[8]) {
    DPP_STAGE8(0x111, 0xf); DPP_STAGE8(0x112, 0xf); DPP_STAGE8(0x114, 0xf); DPP_STAGE8(0x118, 0xf); DPP_STAGE8(0x142, 0xa); DPP_STAGE8(0x143, 0xc);
}
#undef DPP_STAGE8
struct GlaPre { f32x4 g0, g1; u32x4 q8, k8, v0, v1; };
struct GlaCtx { const bf16_t* GQ; const bf16_t* GK; const bf16_t* GVT; const float* G; bf16_t* O; int dir, h, b, nsteps, lane, wave, l15, g, vdv, vch, tid; };
__device__ __forceinline__ int gla_rowbase(const GlaCtx& c, int st) { return c.dir ? c.b * SEQ + (31 - st) * 64 : (st == 0 ? NTOK : c.b * SEQ + (st - 1) * 64); }
constexpr int GL_GSTG = GL_DV + 512, GL_GROW = 272, GL_QSTG = GL_GSTG + 64 * GL_GROW, GL_QROW = 144, GL_KSTG = GL_QSTG + 64 * GL_QROW, GL_END = GL_KSTG + 64 * GL_QROW;
static_assert(GL_END <= LDS_BYTES - 32, "GLA LDS");
__device__ __forceinline__ void gla_load(const GlaCtx& c, GlaPre& r, int st) {
    const int rb = gla_rowbase(c, st), t = c.tid;
    r.g0 = *(const f32x4*)(c.G + (size_t)(rb + (t >> 4)) * 256 + c.h * 64 + (t & 15) * 4); r.g1 = *(const f32x4*)(c.G + (size_t)(rb + 32 + (t >> 4)) * 256 + c.h * 64 + (t & 15) * 4);
    r.q8 = *(const u32x4*)(c.GQ + (size_t)(rb + (t >> 3)) * 256 + c.h * 64 + (t & 7) * 8); r.k8 = *(const u32x4*)(c.GK + (size_t)(rb + (t >> 3)) * 256 + c.h * 64 + (t & 7) * 8);
    r.v0 = *(const u32x4*)(c.GVT + (size_t)(c.h * 128 + c.vdv) * MROWS + rb + c.vch * 8); r.v1 = *(const u32x4*)(c.GVT + (size_t)(c.h * 128 + c.vdv) * MROWS + rb + c.vch * 8 + 8);
}
__device__ __forceinline__ void gla_stage(const GlaCtx& c, LAS unsigned char* lds, const GlaPre& r, int st) {
    const int t = c.tid;
    *(LAS f32x4*)(lds + GL_GSTG + (t >> 4) * GL_GROW + (t & 15) * 16) = r.g0; *(LAS f32x4*)(lds + GL_GSTG + (32 + (t >> 4)) * GL_GROW + (t & 15) * 16) = r.g1;
    *(LAS u32x4*)(lds + GL_QSTG + (t >> 3) * GL_QROW + (t & 7) * 16) = r.q8; *(LAS u32x4*)(lds + GL_KSTG + (t >> 3) * GL_QROW + (t & 7) * 16) = r.k8;
    LAS unsigned char* sb = lds + (st & 1) * GL_SET;
    *(LAS u32x4*)(sb + GL_VT + gsw(c.vdv, c.vch)) = r.v0; *(LAS u32x4*)(sb + GL_VT + gsw(c.vdv, c.vch + 1)) = r.v1;
}
__device__ __forceinline__ void gla_step(const GlaCtx& c, LAS unsigned char* lds, GlaPre& r, f32x4 (&accS)[4], int st) {
    const int lane = c.lane, wave = c.wave, l15 = c.l15, g = c.g, dir = c.dir;
    const bool meta = (dir == 0 && st == 0);
    const int rowbase = gla_rowbase(c, st);
    LAS unsigned char* sb = lds + (st & 1) * GL_SET;
    const f32x4 sg0 = *(const LAS f32x4*)(lds + GL_GSTG + lane * GL_GROW + 32 * wave), sg1 = *(const LAS f32x4*)(lds + GL_GSTG + lane * GL_GROW + 32 * wave + 16);
    float gg[8] = {sg0.x, sg0.y, sg0.z, sg0.w, sg1.x, sg1.y, sg1.z, sg1.w};
    if (meta && lane >= NMETA) {
#pragma unroll
        for (int e = 0; e < 8; ++e) gg[e] = 0.f;
    }
    const u32x4 q8 = *(const LAS u32x4*)(lds + GL_QSTG + lane * GL_QROW + 16 * wave), k8 = *(const LAS u32x4*)(lds + GL_KSTG + lane * GL_QROW + 16 * wave);
    float qv[8] = {bflo(q8.x), bfhi(q8.x), bflo(q8.y), bfhi(q8.y), bflo(q8.z), bfhi(q8.z), bflo(q8.w), bfhi(q8.w)};
    float kv[8] = {bflo(k8.x), bfhi(k8.x), bflo(k8.y), bfhi(k8.y), bflo(k8.z), bfhi(k8.z), bflo(k8.w), bfhi(k8.w)};
    float qn[8], kn[8], ks[8], eTv[8], Pv[8];
#pragma unroll
    for (int e = 0; e < 8; ++e) Pv[e] = gg[e];
    dpp_scan64x8(Pv);
#pragma unroll
    for (int e = 0; e < 8; ++e) {
        const float P = Pv[e];
        const float T = __builtin_bit_cast(float, __builtin_amdgcn_readlane(__builtin_bit_cast(int, P), 63));
        const float Bv = dir ? (T - P + gg[e]) : P;
        const float eb = __expf(Bv), en = __builtin_amdgcn_rcpf(eb), eT = __expf(T);
        qn[e] = qv[e] * eb; kn[e] = kv[e] * en; ks[e] = kn[e] * eT; eTv[e] = eT;
    }
    if (lane == 0) {
        *(LAS f32x4*)(lds + GL_DV + (st & 1) * 256 + 8 * wave * 4) = (f32x4){eTv[0], eTv[1], eTv[2], eTv[3]};
        *(LAS f32x4*)(lds + GL_DV + (st & 1) * 256 + 8 * wave * 4 + 16) = (f32x4){eTv[4], eTv[5], eTv[6], eTv[7]};
    }
    *(LAS u32x4*)(sb + GL_QS + gsw(lane, wave)) = (u32x4){pk2(qn[0], qn[1]), pk2(qn[2], qn[3]), pk2(qn[4], qn[5]), pk2(qn[6], qn[7])};
    *(LAS u32x4*)(sb + GL_KS + gsw(lane, wave)) = (u32x4){pk2(kn[0], kn[1]), pk2(kn[2], kn[3]), pk2(kn[4], kn[5]), pk2(kn[6], kn[7])};
#pragma unroll
    for (int e = 0; e < 8; e += 2) { const unsigned w = pk2(ks[e], ks[e + 1]);
        *(LAS unsigned short*)(sb + GL_KT + gsw(8 * wave + e, lane >> 3) + (lane & 7) * 2) = (unsigned short)w;
        *(LAS unsigned short*)(sb + GL_KT + gsw(8 * wave + e + 1, lane >> 3) + (lane & 7) * 2) = (unsigned short)(w >> 16); }
    __syncthreads();
    if (st + 1 < c.nsteps) { gla_stage(c, lds, r, st + 1); if (st + 2 < c.nsteps) gla_load(c, r, st + 2); }
    const LAS unsigned char* STo = lds + GL_ST + (st & 1) * 16384; LAS unsigned char* STn = lds + GL_ST + ((st + 1) & 1) * 16384;
    if (!meta) {
        const int jb = wave >> 1;
#pragma unroll
        for (int ii = 0; ii < 2; ++ii) {
            const int ib = 2 * (wave & 1) + ii;
            f32x4 a = (f32x4){0.f, 0.f, 0.f, 0.f};
            const bool live = dir ? (jb >= ib) : (jb <= ib);
            if (live) {
#pragma unroll
                for (int ks2 = 0; ks2 < 2; ++ks2) {
                    const bf16x8 kf = *(const LAS bf16x8*)(sb + GL_KS + gsw(jb * 16 + l15, ks2 * 4 + g));
                    const bf16x8 qf = *(const LAS bf16x8*)(sb + GL_QS + gsw(ib * 16 + l15, ks2 * 4 + g));
                    a = __builtin_amdgcn_mfma_f32_16x16x32_bf16(kf, qf, a, 0, 0, 0);
                }
                const int i = ib * 16 + l15, j0 = jb * 16 + 4 * g;
#pragma unroll
                for (int rr = 0; rr < 4; ++rr) { const bool keep = dir ? (j0 + rr >= i) : (j0 + rr <= i); a[rr] = keep ? a[rr] : 0.f; }
            }
            const int i = ib * 16 + l15, j0 = jb * 16 + 4 * g;
            *(LAS u32x2*)(lds + GL_AT + gsw(i, j0 >> 3) + (j0 & 7) * 2) = (u32x2){pk2(a[0], a[1]), pk2(a[2], a[3])};
        }
    }
    if (st + 1 < c.nsteps) {
#pragma unroll
        for (int kb = 0; kb < 4; ++kb) {
            const f32x4 dvv = *(const LAS f32x4*)(lds + GL_DV + (st & 1) * 256 + (kb * 16 + 4 * g) * 4);
            f32x4 a = accS[kb] * dvv;
#pragma unroll
            for (int ks2 = 0; ks2 < 2; ++ks2) {
                const bf16x8 kf = *(const LAS bf16x8*)(sb + GL_KT + gsw(kb * 16 + l15, ks2 * 4 + g));
                const bf16x8 vf = *(const LAS bf16x8*)(sb + GL_VT + gsw(wave * 16 + l15, ks2 * 4 + g));
                a = __builtin_amdgcn_mfma_f32_16x16x32_bf16(kf, vf, a, 0, 0, 0);
            }
            accS[kb] = a;
            const int dk0 = kb * 16 + 4 * g;
            *(LAS u32x2*)(STn + gsw(wave * 16 + l15, dk0 >> 3) + (dk0 & 7) * 2) = (u32x2){pk2(a[0], a[1]), pk2(a[2], a[3])};
        }
    }
    __syncthreads();
    if (!meta) {
        u32x2 ov[4];
#pragma unroll
        for (int ib = 0; ib < 4; ++ib) {
            f32x4 a = (f32x4){0.f, 0.f, 0.f, 0.f};
#pragma unroll
            for (int ks2 = 0; ks2 < 2; ++ks2) {
                const bf16x8 vf = *(const LAS bf16x8*)(sb + GL_VT + gsw(wave * 16 + l15, ks2 * 4 + g));
                const bf16x8 af = *(const LAS bf16x8*)(lds + GL_AT + gsw(ib * 16 + l15, ks2 * 4 + g));
                a = __builtin_amdgcn_mfma_f32_16x16x32_bf16(vf, af, a, 0, 0, 0);
                const bf16x8 sf = *(const LAS bf16x8*)(STo + gsw(wave * 16 + l15, ks2 * 4 + g));
                const bf16x8 qf = *(const LAS bf16x8*)(sb + GL_QS + gsw(ib * 16 + l15, ks2 * 4 + g));
                a = __builtin_amdgcn_mfma_f32_16x16x32_bf16(sf, qf, a, 0, 0, 0);
            }
            ov[ib] = (u32x2){pk2(a[0], a[1]), pk2(a[2], a[3])};
        }
#pragma unroll
        for (int ib = 0; ib < 4; ib += 2) {
            const u32x2 sx = __builtin_amdgcn_permlane16_swap(ov[ib].x, ov[ib + 1].x, false, false), sy = __builtin_amdgcn_permlane16_swap(ov[ib].y, ov[ib + 1].y, false, false);
            *(u32x4*)(c.O + (size_t)(rowbase + (ib + (g & 1)) * 16 + l15) * 512 + c.h * 128 + wave * 16 + 8 * (g >> 1)) = (u32x4){sx.x, sy.x, sx.y, sy.y};
        }
    }
}
__device__ __forceinline__ void gla_chain(const Params& p, LAS unsigned char* lds, int item) {
    const int tid = threadIdx.x;
    GlaCtx c;
    c.tid = tid; c.lane = tid & 63; c.wave = __builtin_amdgcn_readfirstlane(tid >> 6); c.l15 = c.lane & 15; c.g = c.lane >> 4;
    c.dir = item & 1; c.h = (item >> 1) & 3; c.b = item >> 3;
    c.GQ = (const bf16_t*)(p.ws + OFF_GQ); c.GK = (const bf16_t*)(p.ws + OFF_GK); c.GVT = (const bf16_t*)(p.ws + OFF_GVT);
    c.G = (const float*)(p.ws + (c.dir ? OFF_GB : OFF_GF));
    c.O = (bf16_t*)p.out + (c.dir ? (size_t)NTOK * 512 : 0);
    c.nsteps = c.dir ? 32 : 33; c.vdv = tid >> 2; c.vch = (tid & 3) * 2;
    f32x4 accS[4];
#pragma unroll
    for (int i = 0; i < 4; ++i) accS[i] = (f32x4){0.f, 0.f, 0.f, 0.f};
    __syncthreads();
    *(LAS u32x4*)(lds + GL_ST + tid * 32) = (u32x4){0u, 0u, 0u, 0u}; *(LAS u32x4*)(lds + GL_ST + tid * 32 + 16) = (u32x4){0u, 0u, 0u, 0u};
    GlaPre R;
    gla_load(c, R, 0); gla_stage(c, lds, R, 0); gla_load(c, R, 1);
    __syncthreads();
    for (int st = 0; st < c.nsteps; ++st) gla_step(c, lds, R, accS, st);
    asm volatile("s_waitcnt vmcnt(0)" ::: "memory");
    __syncthreads();
    if (tid == 0) {
        __builtin_amdgcn_fence(__ATOMIC_RELEASE, "agent");
        asm volatile("s_waitcnt vmcnt(0)" ::: "memory");
        __hip_atomic_fetch_add((unsigned*)(p.ws + OFF_CTL) + 4096 + (item >> 1) * 64, 1u, __ATOMIC_RELAXED, __HIP_MEMORY_SCOPE_AGENT);
    }
}
__device__ __forceinline__ void gla_combine_item(const Params& p, LAS unsigned char* lds, int item) {
    const int tid = threadIdx.x, lane = tid & 63, wave = tid >> 6;
    const int bh = item >> 3, part = item & 7, b = bh >> 2, h = bh & 3;
    if (tid == 0) {
        unsigned* flag = (unsigned*)(p.ws + OFF_CTL) + 4096 + bh * 64;
        unsigned spins = 0;
        while (__hip_atomic_load(flag, __ATOMIC_RELAXED, __HIP_MEMORY_SCOPE_AGENT) < 2u) { __builtin_amdgcn_s_sleep(8); if (++spins > (1u << 22)) break; }
        __builtin_amdgcn_fence(__ATOMIC_ACQUIRE, "agent");
        asm volatile("s_waitcnt vmcnt(0)" ::: "memory");
    }
    __syncthreads();
    const bf16_t* GR = (const bf16_t*)(p.ws + OFF_GR); bf16_t* MIX = (bf16_t*)(p.ws + OFF_MIX);
    const bf16_t* OF = (const bf16_t*)p.out; const bf16_t* OBk = OF + (size_t)NTOK * 512;
    const int c0 = h * 128 + (lane & 15) * 8;
    const f32x4 w0 = *(const f32x4*)(p.in[13] + (lane & 15) * 8), w1 = *(const f32x4*)(p.in[13] + (lane & 15) * 8 + 4);
#pragma unroll 2
    for (int i = 0; i < 8; ++i) {
        const int r = b * SEQ + part * 256 + wave * 32 + i * 4 + (lane >> 4);
        const u32x4 a = *(const u32x4*)(OF + (size_t)r * 512 + c0), bq = *(const u32x4*)(OBk + (size_t)r * 512 + c0);
        const f32x4 x0 = (f32x4){bflo(a.x) + bflo(bq.x), bfhi(a.x) + bfhi(bq.x), bflo(a.y) + bflo(bq.y), bfhi(a.y) + bfhi(bq.y)};
        const f32x4 x1 = (f32x4){bflo(a.z) + bflo(bq.z), bfhi(a.z) + bfhi(bq.z), bflo(a.w) + bflo(bq.w), bfhi(a.w) + bfhi(bq.w)};
        float s = x0.x * x0.x + x0.y * x0.y + x0.z * x0.z + x0.w * x0.w + x1.x * x1.x + x1.y * x1.y + x1.z * x1.z + x1.w * x1.w;
        s += __shfl_xor(s, 1); s += __shfl_xor(s, 2); s += __shfl_xor(s, 4); s += __shfl_xor(s, 8);
        const float rs = rsqrtf(s * (1.f / 128.f) + EPS);
        const u32x4 g = *(const u32x4*)(GR + (size_t)r * 512 + c0);
        u32x4 o;
        o.x = pk2(x0.x * rs * w0.x * bflo(g.x), x0.y * rs * w0.y * bfhi(g.x)); o.y = pk2(x0.z * rs * w0.z * bflo(g.y), x0.w * rs * w0.w * bfhi(g.y));
        o.z = pk2(x1.x * rs * w1.x * bflo(g.z), x1.y * rs * w1.y * bfhi(g.z)); o.w = pk2(x1.z * rs * w1.z * bflo(g.w), x1.w * rs * w1.w * bfhi(g.w));
        *(u32x4*)(MIX + (size_t)r * DM + 512 + c0) = o;
    }
}

__device__ __forceinline__ void phase2(const Params& p, LAS unsigned char* lds, int qslot = 0) {
    unsigned* ctr = (unsigned*)(p.ws + OFF_CTL) + (qslot >= 2 ? 2048 + qslot * 64 : qslot * 64);
    int it;
#define P2_NEXT() do { __syncthreads(); if (threadIdx.x == 0) *(LAS unsigned*)(lds + LDS_Q) = atomicAdd(ctr, 1u); __syncthreads(); it = (int)*(LAS unsigned*)(lds + LDS_Q); } while (0)
    P2_NEXT();
    if (qslot != 3) { while (it < 64) { gla_chain(p, lds, it); P2_NEXT(); } }
    if (qslot == 2) return;
    if (qslot == 3) it += 64;
    while (it < 64 + NB * 4 * 16) { attn_item(p, lds, it - 64, ctr); __syncthreads(); it = (int)*(LAS unsigned*)(lds + LDS_Q); if (qslot == 3) it += 64; }
    if (qslot) return;
    for (;;) {
        __syncthreads();
        if (threadIdx.x == 0) *(LAS unsigned*)(lds + LDS_Q) = atomicAdd(ctr + 192, 1u);
        __syncthreads();
        const int c = (int)*(LAS unsigned*)(lds + LDS_Q);
        if (c >= 256) break;
        gla_combine_item(p, lds, c);
    }
    for (;;) {
        __syncthreads();
        if (threadIdx.x == 0) *(LAS unsigned*)(lds + LDS_Q) = atomicAdd(ctr + 128, 1u);
        __syncthreads();
        const int c = (int)*(LAS unsigned*)(lds + LDS_Q);
        if (c >= CV_ITEMS) break;
        conv_item(p, (unsigned char*)lds, c);
    }
#undef P2_NEXT
}

__device__ __forceinline__ void phase2c(const Params& p) {
    const int tid = threadIdx.x, lane = tid & 63, wave = tid >> 6;
    const int gw = blockIdx.x * 8 + wave, NGW = gridDim.x * 8;
    const bf16_t* GR = (const bf16_t*)(p.ws + OFF_GR); bf16_t* MIX = (bf16_t*)(p.ws + OFF_MIX);
    const bf16_t* OF = (const bf16_t*)p.out; const bf16_t* OBk = OF + (size_t)NTOK * 512;
    const int c0 = lane * 8;
    const f32x4 w0 = *(const f32x4*)(p.in[13] + (c0 & 127)), w1 = *(const f32x4*)(p.in[13] + (c0 & 127) + 4);
    for (int r = gw; r < NTOK; r += NGW) {
        const u32x4 a = *(const u32x4*)(OF + (size_t)r * 512 + c0), bq = *(const u32x4*)(OBk + (size_t)r * 512 + c0);
        const f32x4 x0 = (f32x4){bflo(a.x) + bflo(bq.x), bfhi(a.x) + bfhi(bq.x), bflo(a.y) + bflo(bq.y), bfhi(a.y) + bfhi(bq.y)};
        const f32x4 x1 = (f32x4){bflo(a.z) + bflo(bq.z), bfhi(a.z) + bfhi(bq.z), bflo(a.w) + bflo(bq.w), bfhi(a.w) + bfhi(bq.w)};
        float s = x0.x * x0.x + x0.y * x0.y + x0.z * x0.z + x0.w * x0.w + x1.x * x1.x + x1.y * x1.y + x1.z * x1.z + x1.w * x1.w;
        s += __shfl_xor(s, 1); s += __shfl_xor(s, 2); s += __shfl_xor(s, 4); s += __shfl_xor(s, 8);
        const float rs = rsqrtf(s * (1.f / 128.f) + EPS);
        const u32x4 g = *(const u32x4*)(GR + (size_t)r * 512 + c0);
        u32x4 o;
        o.x = pk2(x0.x * rs * w0.x * bflo(g.x), x0.y * rs * w0.y * bfhi(g.x)); o.y = pk2(x0.z * rs * w0.z * bflo(g.y), x0.w * rs * w0.w * bfhi(g.y));
        o.z = pk2(x1.x * rs * w1.x * bflo(g.z), x1.y * rs * w1.y * bfhi(g.z)); o.w = pk2(x1.z * rs * w1.z * bflo(g.w), x1.w * rs * w1.w * bfhi(g.w));
        *(u32x4*)(MIX + (size_t)r * DM + 512 + c0) = o;
    }
}


#define TOPK_INS(L, x) do { float _x = (x); _Pragma("unroll") for (int _s = 0; _s < 16; ++_s) { const float _t = fmaxf(L[_s], _x); _x = fminf(L[_s], _x); L[_s] = _t; } } while (0)
constexpr int P4_QROW = 528, P4_SC0 = 128 * P4_QROW  , P4_TLROW = 144;

#define CE_DESC(a, b) do { const float _hi = fmaxf(a, b), _lo = fminf(a, b); a = _hi; b = _lo; } while (0)
__device__ __forceinline__ void bitonic_sort16_desc(float (&x)[16]) {
#define S16(a, b) CE_DESC(x[a], x[b])
    S16(0,13); S16(1,12); S16(2,15); S16(3,14); S16(4,8); S16(5,6); S16(7,11); S16(9,10);
    S16(0,5); S16(1,7); S16(2,9); S16(3,4); S16(6,13); S16(8,14); S16(10,15); S16(11,12);
    S16(0,1); S16(2,3); S16(4,5); S16(6,8); S16(7,9); S16(10,11); S16(12,13); S16(14,15);
    S16(0,2); S16(1,3); S16(4,10); S16(5,11); S16(6,7); S16(8,9); S16(12,14); S16(13,15);
    S16(1,2); S16(3,12); S16(4,6); S16(5,7); S16(8,10); S16(9,11); S16(13,14);
    S16(1,4); S16(2,6); S16(5,8); S16(7,10); S16(9,13); S16(11,14);
    S16(2,4); S16(3,6); S16(9,12); S16(11,13);
    S16(3,5); S16(6,8); S16(7,9); S16(10,12);
    S16(3,4); S16(5,6); S16(7,8); S16(9,10); S16(11,12);
    S16(6,7); S16(8,9);
#undef S16
}
__device__ __forceinline__ void bitonic_merge16_desc(float (&x)[16]) {
#pragma unroll
    for (int j = 8; j > 0; j >>= 1)
#pragma unroll
        for (int i = 0; i < 16; ++i) { const int l = i ^ j; if (l > i) CE_DESC(x[i], x[l]); }
}
__device__ __forceinline__ void top16_merge(float (&L)[16], const float (&x)[16]) {
#pragma unroll
    for (int i = 0; i < 16; ++i) L[i] = fmaxf(L[i], x[15 - i]);
    bitonic_merge16_desc(L);
}

template <int Q> struct CandIJ {
    static constexpr int compute() { int c = 0; for (int i = 0; i < 16; ++i) for (int j = 0; j < 16; ++j) if ((i + 1) * (j + 1) <= 16) { if (c == Q) return i * 16 + j; ++c; } return -1; }
    static constexpr int v = compute();
};
template <int G, int S> __device__ __forceinline__ void cand_fill(float (&x)[16], const float (&A)[16], const float (&Bv)[16]) {
    constexpr int ij = CandIJ<G * 16 + S>::v;
    if constexpr (ij >= 0) x[S] = __uint_as_float((__float_as_uint(A[ij >> 4] + Bv[ij & 15]) & ~255u) | (unsigned)ij); else x[S] = -3.0e38f;
    if constexpr (S + 1 < 16) cand_fill<G, S + 1>(x, A, Bv);
}
constexpr int P4_TL0 = 135168, P4_TLS = 144;
static_assert(P4_TL0 + 128 * P4_TLS <= LDS_BYTES - 32, "P4 top lists");
__device__ __forceinline__ void p4_keys_dma(const Params& p, LAS unsigned char* lds, int h, int wave, int lane) {
    const unsigned char* kb = p.ws + OFF_KEYS + (size_t)h * 65536;
#pragma unroll
    for (int i = 0; i < 8; ++i) {
        const int blk = wave + 8 * i, row = 4 * blk + (lane >> 4), cp = lane & 15;
        __builtin_amdgcn_global_load_lds((const unsigned*)(kb + row * 256 + ((cp ^ (row & 15)) << 4)), (LAS unsigned*)(lds + P4_SC0 + blk * 1024), 16, 0, 0);
    }
}
__device__ __forceinline__ void p4_route_half(const Params& p, LAS unsigned char* lds, int h, LAS unsigned char* tlb) {
    int tid_ = threadIdx.x; asm volatile("" : "+v"(tid_));
    const int tid = tid_, lane = tid & 63, wave = __builtin_amdgcn_readfirstlane(tid >> 6), l15 = lane & 15, g = lane >> 4;
    const bf16_t* KEYS = (const bf16_t*)(p.ws + OFF_KEYS); unsigned* PW0 = (unsigned*)(p.ws + OFF_PW0);
        {
            const int wr = wave >> 1, wk = wave & 1;
            f32x4 sc[2][2][4];
            const LAS unsigned char* kreg = lds + P4_SC0;
#pragma unroll
            for (int pp = 0; pp < 2; ++pp) {
                bf16x8 qf[2][4];
#pragma unroll
                for (int rb = 0; rb < 2; ++rb)
#pragma unroll
                    for (int ks = 0; ks < 4; ++ks) qf[rb][ks] = *(const LAS bf16x8*)(lds + (32 * wr + 16 * rb + l15) * P4_QROW + (pp * 128 + ks * 32 + 8 * g) * 2);
#pragma unroll
                for (int kk = 0; kk < 4; ++kk) {
                    bf16x8 kf[4];
#pragma unroll
                    for (int ks = 0; ks < 4; ++ks) kf[ks] = *(const LAS bf16x8*)(kreg + (pp * 128 + 64 * wk + 16 * kk + l15) * 256 + (((4 * ks + g) ^ l15) << 4));
#pragma unroll
                    for (int rb = 0; rb < 2; ++rb) { f32x4 a = (f32x4){0.f, 0.f, 0.f, 0.f};
#pragma unroll
                        for (int ks = 0; ks < 4; ++ks) a = __builtin_amdgcn_mfma_f32_16x16x32_bf16(kf[ks], qf[rb][ks], a, 0, 0, 0);
                        sc[pp][rb][kk] = a; }
                }
            }
            __syncthreads();
#pragma unroll
            for (int rb = 0; rb < 2; ++rb)
#pragma unroll
                for (int kk = 0; kk < 4; ++kk) *(LAS f32x4*)(lds + P4_SC0 + (32 * wr + 16 * rb + l15) * P4_QROW + (64 * wk + 16 * kk + 4 * g) * 4) = sc[0][rb][kk];
#pragma unroll
            for (int rb = 0; rb < 2; ++rb)
#pragma unroll
                for (int kk = 0; kk < 4; ++kk) *(LAS f32x4*)(lds + (32 * wr + 16 * rb + l15) * P4_QROW + (64 * wk + 16 * kk + 4 * g) * 4) = sc[1][rb][kk];
        }
        __syncthreads();
        {
            const int hf = tid & 1, row = (tid >> 1) & 127, pp = tid >> 8;
            const LAS unsigned char* sp = lds + (pp ? 0 : P4_SC0) + row * P4_QROW + hf * 256;
            float L[16];
#pragma unroll
            for (int grp = 0; grp < 4; ++grp) {
                float x[16];
#pragma unroll
                for (int q4 = 0; q4 < 4; ++q4) {
                    const f32x4 v = *(const LAS f32x4*)(sp + (grp * 4 + q4) * 16);
                    const unsigned kb = (unsigned)(hf * 64 + grp * 16 + q4 * 4);
                    x[4 * q4 + 0] = __uint_as_float((__float_as_uint(v.x) & ~127u) | kb);
                    x[4 * q4 + 1] = __uint_as_float((__float_as_uint(v.y) & ~127u) | (kb + 1));
                    x[4 * q4 + 2] = __uint_as_float((__float_as_uint(v.z) & ~127u) | (kb + 2));
                    x[4 * q4 + 3] = __uint_as_float((__float_as_uint(v.w) & ~127u) | (kb + 3));
                }
                bitonic_sort16_desc(x);
                if (grp == 0) {
#pragma unroll
                    for (int s = 0; s < 16; ++s) L[s] = x[s];
                } else top16_merge(L, x);
            }
            {
                float Oth[16];
#pragma unroll
                for (int s = 0; s < 16; ++s) Oth[s] = __shfl_xor(L[s], 1);
                top16_merge(L, Oth);
            }
            __syncthreads();
            if (hf == 0) {
                LAS f32x4* tl = (LAS f32x4*)(tlb + row * P4_TLS + pp * 64);
                tl[0] = (f32x4){L[0], L[1], L[2], L[3]}; tl[1] = (f32x4){L[4], L[5], L[6], L[7]}; tl[2] = (f32x4){L[8], L[9], L[10], L[11]}; tl[3] = (f32x4){L[12], L[13], L[14], L[15]};
            }
        }
        __syncthreads();
}
constexpr size_t OFF_HQ = 146 * MiB;
constexpr size_t OFF_HSC = 192 * 1024;
__device__ __forceinline__ void quantize_hn8(const Params& p, int t0, int lane) {
    const bf16_t* H2B = (const bf16_t*)(p.ws + OFF_H2B); unsigned char* HQ = p.ws + OFF_HQ; float* HSC = (float*)(p.ws + OFF_HSC);
    u32x4 h0[8], h1[8];
#pragma unroll
    for (int k = 0; k < 8; ++k) { h0[k] = *(const u32x4*)(H2B + (size_t)(t0 + k) * DM + 16 * lane); h1[k] = *(const u32x4*)(H2B + (size_t)(t0 + k) * DM + 16 * lane + 8); }
    const float rstd = lane < 8 ? row_rstd((const float*)(p.ws + OFF_SSQP), t0 + lane) : 0.f;
    float amv = 0.f;
#pragma unroll
    for (int k = 0; k < 8; ++k) {
        float m = 0.f;
#pragma unroll
        for (int c = 0; c < 4; ++c) { m = fmaxf(m, fmaxf(fabsf(bflo(h0[k][c])), fabsf(bfhi(h0[k][c])))); m = fmaxf(m, fmaxf(fabsf(bflo(h1[k][c])), fabsf(bfhi(h1[k][c])))); }
        const float am = fmaxf(wave_max(m), 1e-30f), qs = 224.f / am;
        u32x4 o;
#pragma unroll
        for (int c = 0; c < 2; ++c) {
            int w = __builtin_amdgcn_cvt_pk_fp8_f32(bflo(h0[k][2 * c]) * qs, bfhi(h0[k][2 * c]) * qs, 0, false); w = __builtin_amdgcn_cvt_pk_fp8_f32(bflo(h0[k][2 * c + 1]) * qs, bfhi(h0[k][2 * c + 1]) * qs, w, true); o[c] = (unsigned)w;
            int x = __builtin_amdgcn_cvt_pk_fp8_f32(bflo(h1[k][2 * c]) * qs, bfhi(h1[k][2 * c]) * qs, 0, false); x = __builtin_amdgcn_cvt_pk_fp8_f32(bflo(h1[k][2 * c + 1]) * qs, bfhi(h1[k][2 * c + 1]) * qs, x, true); o[2 + c] = (unsigned)x;
        }
        *(u32x4*)(HQ + (size_t)(t0 + k) * DM + 16 * lane) = o;
        amv = lane == k ? am : amv;
    }
    if (lane < 8) HSC[t0 + lane] = rstd * amv * (1.f / 224.f);
}
__device__ __forceinline__ void p4_route_product(const Params& p, LAS unsigned char* lds, int m0, int h) {
    int tid_ = threadIdx.x; asm volatile("" : "+v"(tid_));
    const int tid = tid_;
    unsigned* PW0 = (unsigned*)(p.ws + OFF_PW0);
        if (tid < 256) {
            const LAS unsigned char* tl = lds + (tid < 128 ? P4_TL0 : P4_SC0) + (tid & 127) * P4_TLS;
            float A[16], Bv[16];
#pragma unroll
            for (int q4 = 0; q4 < 4; ++q4) { const f32x4 a = *(const LAS f32x4*)(tl + q4 * 16), b = *(const LAS f32x4*)(tl + 64 + q4 * 16);
                A[4 * q4] = a.x; A[4 * q4 + 1] = a.y; A[4 * q4 + 2] = a.z; A[4 * q4 + 3] = a.w; Bv[4 * q4] = b.x; Bv[4 * q4 + 1] = b.y; Bv[4 * q4 + 2] = b.z; Bv[4 * q4 + 3] = b.w; }
#pragma unroll
            for (int s = 0; s < 16; ++s) { A[s] = __uint_as_float(__float_as_uint(A[s]) & ~127u); Bv[s] = __uint_as_float(__float_as_uint(Bv[s]) & ~127u); }
            float L[16];
            {
                float x[16];
                cand_fill<0, 0>(x, A, Bv); bitonic_sort16_desc(x);
#pragma unroll
                for (int s = 0; s < 16; ++s) L[s] = x[s];
                cand_fill<1, 0>(x, A, Bv); bitonic_sort16_desc(x); top16_merge(L, x);
                cand_fill<2, 0>(x, A, Bv); bitonic_sort16_desc(x); top16_merge(L, x);
                cand_fill<3, 0>(x, A, Bv); bitonic_sort16_desc(x); top16_merge(L, x);
            }
            const float v0 = __uint_as_float(__float_as_uint(L[0]) & ~255u);
            float e[16], den = 0.f; int id[16];
#pragma unroll
            for (int s = 0; s < 16; ++s) {
                const unsigned u = __float_as_uint(L[s]);
                e[s] = __expf(__uint_as_float(u & ~255u) - v0); den += e[s];
                const unsigned i = (u >> 4) & 15u, j = u & 15u;
                const unsigned ka = *(const LAS unsigned*)(tl + i * 4) & 127u, kb = *(const LAS unsigned*)(tl + 64 + j * 4) & 127u;
                id[s] = (int)(ka * 128u + kb);
            }
            const float inv = 1.f / den;
            unsigned* ip = PW0 + (size_t)(m0 + tid) * 128 + h * 16;
#pragma unroll
            for (int q4 = 0; q4 < 4; ++q4) { u32x4 o;
#pragma unroll
                for (int c = 0; c < 4; ++c) o[c] = (unsigned)id[4 * q4 + c] | (f2bf(e[4 * q4 + c] * inv) << 16);
                *(u32x4*)(ip + 4 * q4) = o; }
        } else quantize_hn8(p, m0 + h * 32 + ((tid >> 6) - 4) * 8, tid & 63);
        __syncthreads();
}

namespace pg8 {
struct EpiP4 {
    static constexpr bool PERM = true, AFTER_DRAIN = true, SWAPPABLE = false;
    const Params* pp; const float* ssq;
    __device__ __forceinline__ void operator()(const f32x4 (&)[2][2][4][2], const Unit&, int, int, int, int) const {}
    __device__ __forceinline__ void fused(f32x4 (&acc)[2][2][4][2], const Unit& u, int wr, int wc, int fr, int fq, PG8_LAS unsigned char* lds, int wid, int lane) const {
        float rstdv[2][4];
#pragma unroll
        for (int ai = 0; ai < 2; ++ai)
#pragma unroll
            for (int m = 0; m < 4; ++m) rstdv[ai][m] = row_rstd(ssq, u.pm * BM + ai * HALF + wr * 64 + m * 16 + fr);
#pragma unroll
        for (int ai = 0; ai < 2; ++ai) {
            p4_keys_dma(*pp, lds, u.pn, wid, lane);
#pragma unroll
            for (int m = 0; m < 4; ++m) {
                const int rl = wr * 64 + m * 16 + fr;
                const float rstd = rstdv[ai][m];
#pragma unroll
                for (int bj = 0; bj < 2; ++bj) { const f32x4 v0 = acc[ai][bj][m][0] * rstd, v1 = acc[ai][bj][m][1] * rstd;
                    *(PG8_LAS u32x4*)(lds + rl * P4_QROW + (bj * HALF + wc * 32 + 8 * fq) * 2) = (u32x4){pk2(v0.x, v0.y), pk2(v0.z, v0.w), pk2(v1.x, v1.y), pk2(v1.z, v1.w)}; }
            }
            asm volatile("s_waitcnt vmcnt(0)" ::: "memory");
            __syncthreads();
            p4_route_half(*pp, lds, u.pn, lds + (ai ? P4_SC0 : P4_TL0));
        }
        p4_route_product(*pp, lds, u.pm * BM, u.pn);
    }
};
}
__device__ __forceinline__ void phase4_mfma(const Params& p, LAS unsigned char* lds) {
    pg8::Gemm g{(const pg8::bf16_t*)(p.ws + OFF_H2B), (const pg8::bf16_t*)(p.ws + OFF_WQ), NTOK, 2048, DM};
    pg8::EpiP4 E{&p, (const float*)(p.ws + OFF_SSQP)};
    const int vcu = vcu_of_block();
    for (int r = 0; r * (int)gridDim.x < 512; ++r) {
        const int L = r * (int)gridDim.x + vcu;
        pg8::OneUnit S; S.u.pm = L >> 3; S.u.pn = L & 7; S.valid = L < 512;
        pg8::gemm_phase<pg8::EpiP4, pg8::OneUnit, false, true>(lds, g, S, E);
        __syncthreads();
    }
}


constexpr size_t OFF_PW = 73 * MiB;
constexpr size_t OFF_OUTS = 179 * MiB;
static_assert(OFF_OUTS >= OFF_PW0 + (size_t)NTOK * 128 * 4 && OFF_OUTS + (size_t)NTOK * DM * 4 <= 256 * MiB, "P5 map");
__device__ __forceinline__ float dot_fp8_bf16(u32x4 uq, u32x4 h0, u32x4 h1, float c) {
#define DQ2(word, hsel, hw) c = dot2(__builtin_bit_cast(unsigned, __builtin_amdgcn_cvt_scalef32_pk_bf16_fp8((int)(word), 1.0f, hsel)), hw, c)
    DQ2(uq.x, false, h0.x); DQ2(uq.x, true, h0.y); DQ2(uq.y, false, h0.z); DQ2(uq.y, true, h0.w);
    DQ2(uq.z, false, h1.x); DQ2(uq.z, true, h1.y); DQ2(uq.w, false, h1.z); DQ2(uq.w, true, h1.w);
#undef DQ2
    return c;
}
constexpr int P5A_RS = 1040, P5A_LIST = 16640, P5A_CAP = 768, P5A_RES = P5A_LIST + 4 * P5A_CAP  , P5A_TSC = P5A_RES + 256, P5A_WAVE = P5A_TSC + 64;
static_assert(8 * P5A_WAVE <= LDS_BYTES - 32, "P5a LDS");
static_assert(OFF_HQ >= OFF_H2B + (size_t)NTOK * DM * 2 && OFF_HQ + (size_t)NTOK * DM <= OFF_PW0, "HQ map");
__device__ __forceinline__ void quantize_hn(const Params& p) {
    const int tid = threadIdx.x, lane = tid & 63, wave = tid >> 6;
    const bf16_t* H2B = (const bf16_t*)(p.ws + OFF_H2B); unsigned char* HQ = p.ws + OFF_HQ; float* HSC = (float*)(p.ws + OFF_HSC);
    for (int t = blockIdx.x * 8 + wave; t < NTOK; t += gridDim.x * 8) {
        const u32x4 h0 = *(const u32x4*)(H2B + (size_t)t * DM + 16 * lane), h1 = *(const u32x4*)(H2B + (size_t)t * DM + 16 * lane + 8);
        float m = 0.f;
#pragma unroll
        for (int c = 0; c < 4; ++c) { m = fmaxf(m, fmaxf(fabsf(bflo(h0[c])), fabsf(bfhi(h0[c])))); m = fmaxf(m, fmaxf(fabsf(bflo(h1[c])), fabsf(bfhi(h1[c])))); }
        const float am = fmaxf(wave_max(m), 1e-30f), qs = 224.f / am;
        u32x4 o;
#pragma unroll
        for (int c = 0; c < 2; ++c) {
            int w = __builtin_amdgcn_cvt_pk_fp8_f32(bflo(h0[2 * c]) * qs, bfhi(h0[2 * c]) * qs, 0, false); w = __builtin_amdgcn_cvt_pk_fp8_f32(bflo(h0[2 * c + 1]) * qs, bfhi(h0[2 * c + 1]) * qs, w, true); o[c] = (unsigned)w;
            int x = __builtin_amdgcn_cvt_pk_fp8_f32(bflo(h1[2 * c]) * qs, bfhi(h1[2 * c]) * qs, 0, false); x = __builtin_amdgcn_cvt_pk_fp8_f32(bflo(h1[2 * c + 1]) * qs, bfhi(h1[2 * c + 1]) * qs, x, true); o[2 + c] = (unsigned)x;
        }
        *(u32x4*)(HQ + (size_t)t * DM + 16 * lane) = o;
        if (lane == 0) HSC[t] = row_rstd((const float*)(p.ws + OFF_SSQP), t) * am * (1.f / 224.f);
    }
}
__device__ __forceinline__ void p5a_wave(const Params& p, LAS unsigned char* wl, int tb, int part, int lane, __amdgpu_buffer_rsrc_t urs, __amdgpu_buffer_rsrc_t hrs) {
    const float* USC = (const float*)(p.ws + OFF_USC); const float* VSC = (const float*)(p.ws + OFF_VSC); const float* HSC = (const float*)(p.ws + OFF_HSC);
    const unsigned* PW0 = (const unsigned*)(p.ws + OFF_PW0); unsigned* PW = (unsigned*)(p.ws + OFF_PW);
    const int l15 = lane & 15, g = lane >> 4;
    unsigned xl[16], xh[16];
#define P5A_WORDS() do { _Pragma("unroll") for (int _k = 0; _k < 16; ++_k) { xl[_k] = PW0[(size_t)(tb + _k) * 128 + lane]; xh[_k] = PW0[(size_t)(tb + _k) * 128 + 64 + lane]; } } while (0)
#define P5A_GATHER(tile_) do { int _li = (tile_) * 16 + l15; _li = _li < n ? _li : n - 1; \
        const int _ev = (int)((*(const LAS unsigned*)(wl + P5A_LIST + _li * 4) & 0x3fffu) << 10); \
        int _so[16];       \
        _Pragma("unroll") for (int _r = 0; _r < 16; ++_r) _so[_r] = __builtin_amdgcn_readlane(_ev, _r); \
        _Pragma("unroll") for (int _r = 0; _r < 16; ++_r) asm volatile("" : "+s"(_so[_r])); \
        _Pragma("unroll") for (int _r = 0; _r < 16; ++_r) \
            __builtin_amdgcn_raw_ptr_buffer_load_lds(urs, (LAS unsigned*)(wl + _r * P5A_RS), 16, lane * 16, _so[_r], 0, 0); } while (0)
#pragma unroll
    for (int k = 0; k < 16; ++k) __builtin_amdgcn_raw_ptr_buffer_load_lds(hrs, (LAS unsigned*)(wl + k * 1024), 16, lane * 16, (tb + k) * 1024, 0, 0);
    P5A_WORDS();
    const float hsc = HSC[tb + l15];
    asm volatile("s_waitcnt vmcnt(0)" ::: "memory");
    typedef int p5a_i32x8 __attribute__((ext_vector_type(8)));
    p5a_i32x8 bq[8];
#pragma unroll
    for (int i = 0; i < 8; ++i) { const u32x4 w0 = *(const LAS u32x4*)(wl + l15 * 1024 + 128 * i + 16 * g), w1 = *(const LAS u32x4*)(wl + l15 * 1024 + 128 * i + 64 + 16 * g);
        bq[i] = (p5a_i32x8){(int)w0.x, (int)w0.y, (int)w0.z, (int)w0.w, (int)w1.x, (int)w1.y, (int)w1.z, (int)w1.w}; }
    if (lane < 16) *(LAS float*)(wl + P5A_TSC + lane * 4) = hsc;
    int ntot = 0;
#pragma unroll
    for (int k = 0; k < 16; ++k) ntot += __popcll(__ballot((int)((xl[k] >> 11) & 7u) == part)) + __popcll(__ballot((int)((xh[k] >> 11) & 7u) == part));
    const int npass = ntot <= P5A_CAP ? 1 : 4;
    for (int pass = 0; pass < npass; ++pass) {
        const int klo = npass == 1 ? 0 : 4 * pass, khi = npass == 1 ? 16 : klo + 4;
        if (pass > 0) { P5A_WORDS(); asm volatile("s_waitcnt vmcnt(0)" ::: "memory"); }
        int n = 0;
#pragma unroll
        for (int k = 0; k < 16; ++k) {
            if (k >= klo && k < khi) {
                const bool ml = (int)((xl[k] >> 11) & 7u) == part, mh = (int)((xh[k] >> 11) & 7u) == part;
                const unsigned long long bl = __ballot(ml), bh = __ballot(mh);
                const int rl = __builtin_amdgcn_mbcnt_hi((unsigned)(bl >> 32), __builtin_amdgcn_mbcnt_lo((unsigned)bl, 0u));
                if (ml) *(LAS unsigned*)(wl + P5A_LIST + (n + rl) * 4) = (xl[k] & 0x3fffu) | ((unsigned)lane << 14) | ((unsigned)k << 21);
                n += __popcll(bl);
                const int rh = __builtin_amdgcn_mbcnt_hi((unsigned)(bh >> 32), __builtin_amdgcn_mbcnt_lo((unsigned)bh, 0u));
                if (mh) *(LAS unsigned*)(wl + P5A_LIST + (n + rh) * 4) = (xh[k] & 0x3fffu) | ((unsigned)(64 + lane) << 14) | ((unsigned)k << 21);
                n += __popcll(bh);
            }
        }
        __builtin_amdgcn_s_waitcnt(0xC07F); __builtin_amdgcn_wave_barrier();
        asm volatile("" ::: "memory");
        const int ntile = (n + 15) >> 4;
        if (ntile == 0) continue;
#define P5A_OPS(b_) do { int _ei = (b_) * 64 + lane; eokB = _ei < n; _ei = eokB ? _ei : n - 1; \
        entB = *(const LAS unsigned*)(wl + P5A_LIST + _ei * 4);        \
        uscB = USC[entB & 0x3fffu]; vscB = VSC[entB & 0x3fffu]; xgB = PW0[(size_t)(tb + (int)(entB >> 21)) * 128 + (int)((entB >> 14) & 127u)]; } while (0)
        bool eokB; unsigned entB; float uscB, vscB; unsigned xgB;
        P5A_GATHER(0);
        P5A_OPS(0);
        for (int tile = 0; tile < ntile; ++tile) {
            asm volatile("s_waitcnt vmcnt(0)" ::: "memory");
            p5a_i32x8 aq[8];
#pragma unroll
            for (int i = 0; i < 8; ++i) { const u32x4 w0 = *(const LAS u32x4*)(wl + l15 * P5A_RS + 128 * i + 16 * g), w1 = *(const LAS u32x4*)(wl + l15 * P5A_RS + 128 * i + 64 + 16 * g);
                aq[i] = (p5a_i32x8){(int)w0.x, (int)w0.y, (int)w0.z, (int)w0.w, (int)w1.x, (int)w1.y, (int)w1.z, (int)w1.w}; }
            asm volatile("s_waitcnt lgkmcnt(0)" ::: "memory");
#pragma unroll
            for (int s = 0; s < 8; ++s) asm volatile("" : "+v"(aq[s]));
            if (tile + 1 < ntile) P5A_GATHER(tile + 1);
            if ((tile & 3) == 0 && tile > 0) P5A_OPS(tile >> 2);
            f32x4 acc = (f32x4){0.f, 0.f, 0.f, 0.f};
#pragma unroll
            for (int s = 0; s < 8; ++s) acc = __builtin_amdgcn_mfma_scale_f32_16x16x128_f8f6f4(aq[s], bq[s], acc, 0, 0, 0, 0, 0, 0);
            {
                const u32x4 en = *(const LAS u32x4*)(wl + P5A_LIST + (tile * 16 + 4 * g) * 4);
#pragma unroll
                for (int r = 0; r < 4; ++r) if ((int)(en[r] >> 21) == l15) *(LAS float*)(wl + P5A_RES + (16 * (tile & 3) + 4 * g + r) * 4) = acc[r];
            }
            if ((tile & 3) == 3 || tile + 1 == ntile) {
                __builtin_amdgcn_s_waitcnt(0xC07F); __builtin_amdgcn_wave_barrier();
                asm volatile("" ::: "memory");
                if (eokB) {
                    const unsigned ee = entB & 0x3fffu; const int sl = (int)((entB >> 14) & 127u), tk = (int)(entB >> 21), t = tb + tk;
                    const float d = *(const LAS float*)(wl + P5A_RES + lane * 4) * uscB * *(const LAS float*)(wl + P5A_TSC + tk * 4);
                    const float w = __uint_as_float(xgB & 0xffff0000u) * gelu_f(d) * vscB;
                    PW[(((size_t)(t >> 6) * 32 + (sl >> 2)) * 64 + (t & 63)) * 4 + (sl & 3)] = (ee << 3) | (__float_as_uint(w) & 0xfffe0000u);
                }
                __builtin_amdgcn_s_waitcnt(0xC07F); __builtin_amdgcn_wave_barrier();
                asm volatile("" ::: "memory");
            }
        }
#undef P5A_OPS
    }
    asm volatile("s_waitcnt vmcnt(0)" ::: "memory");
#undef P5A_WORDS
#undef P5A_GATHER
}
__device__ __forceinline__ void phase5a(const Params& p, LAS unsigned char* lds, int qoff = 0) {
    const int tid = threadIdx.x, lane = tid & 63, wave = __builtin_amdgcn_readfirstlane(tid >> 6);
    const int xcc = (int)(__builtin_amdgcn_s_getreg((3 << 11) | 20) & 7u);
    unsigned* qc = (unsigned*)(p.ws + OFF_CTL) + 256 + qoff;
    LAS unsigned char* wl = lds + wave * P5A_WAVE;
    const __amdgpu_buffer_rsrc_t urs = __builtin_amdgcn_make_buffer_rsrc((void*)(p.ws + OFF_UB), 0, NEXP * DM, 0x00020000);
    const __amdgpu_buffer_rsrc_t hrs = __builtin_amdgcn_make_buffer_rsrc((void*)(p.ws + OFF_HQ), 0, NTOK * DM, 0x00020000);
    for (int pi = 0; pi < 8; ++pi) {
        const int part = (xcc + pi) & 7;
        unsigned nxt = 0u;
        if (lane == 0) nxt = atomicAdd(qc + part * 64, 1u);
        for (;;) {
            const int it = (int)__builtin_amdgcn_readfirstlane(nxt);
            if (it >= NTOK / 16) break;
            if (lane == 0) nxt = atomicAdd(qc + part * 64, 1u);
            p5a_wave(p, wl, it * 16, part, lane, urs, hrs);
        }
    }
}

__device__ __forceinline__ void p5b_quad(const LAS unsigned char* lds, u32x4 q, f32x2& a0, f32x2& a1, f32x2& a2, f32x2& a3) {
#pragma unroll
    for (int c = 0; c < 4; ++c) {
        const unsigned x = q[c];
        const u32x2 vv = *(const LAS u32x2*)(unsigned)(x & 0x1fff8u);
        const float w = __uint_as_float(x); const f32x2 ww = (f32x2){w, w};
        a0 += ww * __builtin_amdgcn_cvt_pk_f32_fp8((int)vv.x, false); a1 += ww * __builtin_amdgcn_cvt_pk_f32_fp8((int)vv.x, true);
        a2 += ww * __builtin_amdgcn_cvt_pk_f32_fp8((int)vv.y, false); a3 += ww * __builtin_amdgcn_cvt_pk_f32_fp8((int)vv.y, true);
    }
}
__device__ __forceinline__ void p5b_load_slice(const Params& p, LAS unsigned char* lds, int it) {
    int tid_ = threadIdx.x; asm volatile("" : "+v"(tid_));
    const int tid = tid_; const unsigned char* VS = p.ws + OFF_VB; const int s = it >> 1;
#pragma unroll 4
    for (int i = 0; i < 16; ++i) *(LAS u32x4*)(lds + (tid + NTHR * i) * 16) = *(const u32x4*)(VS + (size_t)s * 131072 + (size_t)(tid + NTHR * i) * 16);
}
__device__ __forceinline__ void phase5b(const Params& p, LAS unsigned char* lds, bool first_loaded = false) {
    int tid_ = threadIdx.x; asm volatile("" : "+v"(tid_));
    const int tid = tid_, lane = tid & 63, wave = __builtin_amdgcn_readfirstlane(tid >> 6);
    const u32x4* PW = (const u32x4*)(p.ws + OFF_PW); bf16_t* OUTS = (bf16_t*)(p.ws + OFF_OUTS);
    for (int it = blockIdx.x; it < 256; it += gridDim.x) {
        const int s = it >> 1, tbase = (it & 1) * 128;
        if (!(first_loaded && it == (int)blockIdx.x)) { __syncthreads(); p5b_load_slice(p, lds, it); }
        __syncthreads();
        u32x4 A[8], Bq[8];
#define P5B_LOAD(R, gi) do { const int _T = tbase + wave + 8 * ((gi) >> 2), _g = (gi) & 3; const u32x4* _p = PW + ((size_t)_T * 32 + _g * 8) * 64 + lane; \
        _Pragma("unroll") for (int _i = 0; _i < 8; ++_i) R[_i] = _p[_i * 64]; } while (0)
        f32x2 a0 = {0.f, 0.f}, a1 = {0.f, 0.f}, a2 = {0.f, 0.f}, a3 = {0.f, 0.f};
#define P5B_GROUP(R) do { _Pragma("unroll") for (int i = 0; i < 8; ++i) { p5b_quad(lds, R[i], a0, a1, a2, a3); if ((i & 3) == 3) asm volatile("" ::: "memory"); } } while (0)
#define P5B_STORE(gi_) do { const int T = tbase + wave + 8 * ((gi_) >> 2); \
              \
            { const u32x4 _o = (u32x4){pk2(a0.x, a0.y), pk2(a1.x, a1.y), pk2(a2.x, a2.y), pk2(a3.x, a3.y)}; bf16_t* _q = OUTS + ((size_t)s * NTOK + T * 64 + lane) * 8; \
              asm volatile("global_store_dwordx4 %0, %1, off\n\ts_nop 1" :: "v"(_q), "v"(_o) : "memory"); } \
            a0 = (f32x2){0.f, 0.f}; a1 = a0; a2 = a0; a3 = a0; } while (0)
        P5B_LOAD(A, 0); P5B_LOAD(Bq, 1);
#pragma unroll 1
        for (int gi = 0; gi < 62; gi += 2) {
            P5B_GROUP(A);  P5B_LOAD(A, gi + 2);
            P5B_GROUP(Bq); P5B_LOAD(Bq, gi + 3);
            if (((gi + 1) & 3) == 3) P5B_STORE(gi);
        }
        P5B_GROUP(A); P5B_GROUP(Bq); P5B_STORE(62);
#undef P5B_STORE
#undef P5B_GROUP
#undef P5B_LOAD
    }
}

__device__ __forceinline__ void phase5c(const Params& p, LAS unsigned char* lds) {
    int tid_ = threadIdx.x; asm volatile("" : "+v"(tid_));
    const int tid = tid_, lane = tid & 63, wave = __builtin_amdgcn_readfirstlane(tid >> 6);
    const bf16_t* OUTS = (const bf16_t*)(p.ws + OFF_OUTS); const bf16_t* H2B = (const bf16_t*)(p.ws + OFF_H2B); const float* fw = p.in[20];
    for (int it = blockIdx.x; it < NTOK / 32; it += gridDim.x) {
        const int t0 = it * 32;
        __syncthreads();
#pragma unroll 4
        for (int i = 0; i < 8; ++i) {
            const int q = tid + NTHR * i, s = q >> 5, tt = q & 31;
            *(LAS u32x4*)(lds + tt * 2064 + s * 16) = *(const u32x4*)(OUTS + ((size_t)s * NTOK + t0 + tt) * 8);
        }
        __syncthreads();
        for (int i = 0; i < 4; ++i) {
            const int tt = wave * 4 + i; float* orow = p.out + (size_t)(t0 + tt) * DM;
            f32x4 h[4]; float ss = 0.f;
#pragma unroll
            for (int j = 0; j < 2; ++j) {
                const u32x4 a = *(const u32x4*)(H2B + (size_t)(t0 + tt) * DM + 512 * j + 8 * lane), pq = *(const LAS u32x4*)(lds + tt * 2064 + (512 * j + 8 * lane) * 2);
                h[2 * j] = (f32x4){bflo(a.x) + bflo(pq.x), bfhi(a.x) + bfhi(pq.x), bflo(a.y) + bflo(pq.y), bfhi(a.y) + bfhi(pq.y)};
                h[2 * j + 1] = (f32x4){bflo(a.z) + bflo(pq.z), bfhi(a.z) + bfhi(pq.z), bflo(a.w) + bflo(pq.w), bfhi(a.w) + bfhi(pq.w)};
            }
#pragma unroll
            for (int j = 0; j < 4; ++j) ss += h[j].x * h[j].x + h[j].y * h[j].y + h[j].z * h[j].z + h[j].w * h[j].w;
            const float rs = rsqrtf(wave_sum(ss) * (1.f / DM) + EPS);
#pragma unroll
            for (int j = 0; j < 2; ++j) {
                float* o = orow + 512 * j + 8 * lane; const float* w = fw + 512 * j + 8 * lane;
                *(f32x4*)o = h[2 * j] * rs * *(const f32x4*)w; *(f32x4*)(o + 4) = h[2 * j + 1] * rs * *(const f32x4*)(w + 4);
            }
        }
    }
}


#define XB_TMO      128
#define XB_XCNT(j)  (256  + 64 * (j))
#define XB_XSUB(j)  (1280 + 64 * (j))
#define XB_XGEN(j)  (2304 + 64 * (j))
#define XB_TOP      3328
#define XB_TOPGEN   3392
#define XCD_BAR_WORDS 3456
#define XB_SPIN_CAP (1u << 18)
__device__ __forceinline__ unsigned xb_ld(unsigned* p)              { return __hip_atomic_load(p, __ATOMIC_RELAXED, __HIP_MEMORY_SCOPE_AGENT); }
__device__ __forceinline__ unsigned xb_add(unsigned* p, unsigned v) { return __hip_atomic_fetch_add(p, v, __ATOMIC_RELAXED, __HIP_MEMORY_SCOPE_AGENT); }
__device__ __forceinline__ unsigned xb_xcc_id() { return (unsigned)__builtin_amdgcn_s_getreg((3 << 11) | 20) & 0xFu; }
#define XB_SPIN(cond, bar) do { unsigned _sp = 0; while (cond) { __builtin_amdgcn_s_sleep(1); \
    if ((++_sp & 255u) == 0u) { if (xb_ld(&(bar)[XB_TMO])) break; if (_sp > XB_SPIN_CAP) { atomicAdd(&(bar)[XB_TMO], 1u); break; } } } } while (0)
struct XcdBarrier { unsigned* bar; unsigned x; volatile LAS unsigned* st; };
__device__ __forceinline__ XcdBarrier xcd_barrier_post(unsigned* bar, volatile LAS unsigned* st) {
    XcdBarrier b; b.bar = bar; b.x = xb_xcc_id(); b.st = st;
    if (threadIdx.x == 0) (void)xb_add(&bar[XB_XCNT(b.x)], 1u);
    return b;
}
__device__ __forceinline__ void xcd_barrier_complete(unsigned* bar, unsigned x, unsigned& nloc, unsigned& nx) {
    const unsigned G = gridDim.x * gridDim.y * gridDim.z;
    unsigned sum, cnt, mine, sp = 0u;
    for (;;) {
        sum = 0u; cnt = 0u; mine = 0u;
#pragma unroll
        for (unsigned j = 0; j < 16; ++j) { const unsigned c = xb_ld(&bar[XB_XCNT(j)]); sum += c; cnt += (c > 0u) ? 1u : 0u; mine = (j == x) ? c : mine; }
        if (sum == G) break;
        __builtin_amdgcn_s_sleep(1);
        if ((++sp & 255u) == 0u) { if (xb_ld(&bar[XB_TMO])) break; if (sp > XB_SPIN_CAP) { atomicAdd(&bar[XB_TMO], 1u); break; } }
    }
    nloc = mine > 0u ? mine : 1u; nx = cnt > 0u ? cnt : 1u;
}
__device__ __forceinline__ void xcd_barrier(const XcdBarrier& b) {
    asm volatile("s_waitcnt vmcnt(0)" ::: "memory");
    __syncthreads();
    if (threadIdx.x == 0) {
        unsigned* bar = b.bar;
        __builtin_amdgcn_s_waitcnt(0);
        unsigned nloc = b.st[0], nx = b.st[1];
        if (nloc == 0u) { xcd_barrier_complete(bar, b.x, nloc, nx); b.st[0] = nloc; b.st[1] = nx; }
        const unsigned old = xb_add(&bar[XB_XSUB(b.x)], 1u);
        const unsigned gen = old / nloc;
        if (old + 1u == (gen + 1u) * nloc) {
            __builtin_amdgcn_fence(__ATOMIC_RELEASE, "agent");
            asm volatile("s_waitcnt vmcnt(0)" ::: "memory");
            const unsigned og = xb_add(&bar[XB_TOP], 1u);
            const unsigned tg = og / nx;
            if (og + 1u == (tg + 1u) * nx) xb_add(&bar[XB_TOPGEN], 1u);
            else XB_SPIN(xb_ld(&bar[XB_TOPGEN]) == tg, bar);
            __builtin_amdgcn_fence(__ATOMIC_ACQUIRE, "agent");
            asm volatile("s_waitcnt vmcnt(0)" ::: "memory");
        } else {
            XB_SPIN(xb_ld(&bar[XB_TOPGEN]) == gen, bar);
            __builtin_amdgcn_fence(__ATOMIC_ACQUIRE, "agent");
            asm volatile("s_waitcnt vmcnt(0)" ::: "memory");
        }
    }
    __syncthreads();
}

__device__ __forceinline__ unsigned xcd_barrier_arrive(const XcdBarrier& b) {
    asm volatile("s_waitcnt vmcnt(0)" ::: "memory");
    __syncthreads();
    unsigned gen = 0u;
    if (threadIdx.x == 0) {
        unsigned* bar = b.bar;
        __builtin_amdgcn_s_waitcnt(0);
        unsigned nloc = b.st[0], nx = b.st[1];
        if (nloc == 0u) { xcd_barrier_complete(bar, b.x, nloc, nx); b.st[0] = nloc; b.st[1] = nx; }
        const unsigned old = xb_add(&bar[XB_XSUB(b.x)], 1u);
        gen = old / nloc;
        if (old + 1u == (gen + 1u) * nloc) {
            __builtin_amdgcn_fence(__ATOMIC_RELEASE, "agent");
            asm volatile("s_waitcnt vmcnt(0)" ::: "memory");
            const unsigned og = xb_add(&bar[XB_TOP], 1u);
            const unsigned tg = og / nx;
            if (og + 1u == (tg + 1u) * nx) xb_add(&bar[XB_TOPGEN], 1u);
        }
    }
    return gen;
}
__device__ __forceinline__ void xcd_barrier_wait(const XcdBarrier& b, unsigned gen) {
    if (threadIdx.x == 0) {
        unsigned* bar = b.bar;
        XB_SPIN(xb_ld(&bar[XB_TOPGEN]) == gen, bar);
        __builtin_amdgcn_fence(__ATOMIC_ACQUIRE, "agent");
        asm volatile("s_waitcnt vmcnt(0)" ::: "memory");
    }
    __syncthreads();
}

constexpr int NPHASE = 9;
__global__ void __launch_bounds__(NTHR, 2) mega(Params p) {
    extern __shared__ __attribute__((aligned(16))) unsigned char lds[];
    cg::grid_group grid = cg::this_grid();
#define PH_ON(k) (p.ph_lo <= (k) && (k) < p.ph_hi)
    if (threadIdx.x < 2) ((LAS unsigned*)((LAS unsigned char*)lds + LDS_BYTES - 32))[threadIdx.x] = 0u;
    __syncthreads();
    const XcdBarrier xbar = xcd_barrier_post((unsigned*)(p.ws + OFF_CTL) + 8192, (volatile LAS unsigned*)((LAS unsigned char*)lds + LDS_BYTES - 32));
#define PH_SYNC(k) do { if (PH_ON(k) && PH_ON((k) + 1)) { xcd_barrier(xbar); } } while (0)
    if (PH_ON(0)) phase0(p, lds);
    PH_SYNC(0);
    if (PH_ON(1)) phase1_mfma(p, (LAS unsigned char*)lds);
#if PROBE_DUP == 1
    xcd_barrier(xbar); phase1_mfma(p, (LAS unsigned char*)lds);
#endif
    PH_SYNC(1);
    if (PH_ON(2)) phase2(p, (LAS unsigned char*)lds);
#if PROBE_DUP == 2
    xcd_barrier(xbar); phase2(p, (LAS unsigned char*)lds, 1);
#endif
#if PROBE_DUP == 21
    xcd_barrier(xbar); phase2(p, (LAS unsigned char*)lds, 2);
#endif
#if PROBE_DUP == 22
    xcd_barrier(xbar); phase2(p, (LAS unsigned char*)lds, 3);
#endif
    PH_SYNC(2);
    if (PH_ON(4)) phase3_mfma(p, (LAS unsigned char*)lds);
#if PROBE_DUP == 4
    xcd_barrier(xbar); phase3_mfma(p, (LAS unsigned char*)lds);
#endif
    PH_SYNC(4);
    if (PH_ON(5)) phase4_mfma(p, (LAS unsigned char*)lds);
#if PROBE_DUP == 5
    xcd_barrier(xbar); phase4_mfma(p, (LAS unsigned char*)lds);
#endif
    PH_SYNC(5);
    if (PH_ON(6)) phase5a(p, (LAS unsigned char*)lds);
#if PROBE_DUP == 6
    xcd_barrier(xbar); phase5a(p, (LAS unsigned char*)lds, 1024);
#endif
    {
        const unsigned bgen = xcd_barrier_arrive(xbar);
        if ((int)blockIdx.x < 256) p5b_load_slice(p, (LAS unsigned char*)lds, (int)blockIdx.x);
        xcd_barrier_wait(xbar, bgen);
    }
    if (PH_ON(7)) phase5b(p, (LAS unsigned char*)lds, true);
#if PROBE_DUP == 7
    xcd_barrier(xbar); phase5b(p, (LAS unsigned char*)lds);
#endif
    PH_SYNC(7);
    if (PH_ON(8)) phase5c(p, (LAS unsigned char*)lds);
}

extern "C" void kernel_launch(void* const* d_in, const int* in_sizes, int n_in, void* d_out, int out_size, void* d_ws, size_t ws_size, hipStream_t stream) {
    static int grid = 0;
    if (grid == 0) {
        if (n_in != 21 || out_size != NTOK * DM || ws_size < WS_END) { fprintf(stderr, "kernel_launch: unexpected shapes (n_in %d out %d ws %zu)\n", n_in, out_size, ws_size); grid = -1; return; }
        int dev = 0, cus = 0, per_cu = 0;
        hipGetDevice(&dev);
        hipDeviceGetAttribute(&cus, hipDeviceAttributeMultiprocessorCount, dev);
        hipFuncSetAttribute((const void*)mega, hipFuncAttributeMaxDynamicSharedMemorySize, LDS_BYTES);
        hipOccupancyMaxActiveBlocksPerMultiprocessor(&per_cu, (const void*)mega, NTHR, LDS_BYTES);
        if (per_cu < 1) { fprintf(stderr, "kernel_launch: occupancy query says %d blocks/CU\n", per_cu); per_cu = 1; }
        grid = cus * 1;
        (void)hipGetLastError();
    }
    if (grid < 0) return;
    hipMemsetAsync((char*)d_ws + OFF_CTL, 0, CTL_BYTES, stream);
    Params p{};
    for (int i = 0; i < 21; ++i) p.in[i] = (const float*)d_in[i];
    p.out = (float*)d_out; p.ws = (unsigned char*)d_ws; p.ph_lo = 0; p.ph_hi = NPHASE;
    void* args[] = {&p};
    hipError_t e = hipLaunchCooperativeKernel((const void*)mega, dim3(grid), dim3(NTHR), args, LDS_BYTES, stream);
    if (e != hipSuccess) fprintf(stderr, "cooperative launch failed: %s (grid %d)\n", hipGetErrorString(e), grid);
}
```
